# Optimizing an MI355X kernel written in HIP

```python
import jax, jax.numpy as jnp
from jax import lax
import numpy as np

D_MODEL = 1024
BATCH = 2
SEQ = 8192
DEPTH = 2

HEAD_DIM = 64
N_NSA_HEADS = 8
N_NSA_KV = 2
NSA_REP = N_NSA_HEADS // N_NSA_KV
N_FOX_HEADS = 4
N_SB_HEADS = 4
D_NSA = N_NSA_HEADS * HEAD_DIM
D_FOX = N_FOX_HEADS * HEAD_DIM
D_SB = N_SB_HEADS * HEAD_DIM
D_MIX = D_NSA + D_FOX + D_SB
N_NSA_BRANCH = 3
CMP_LEN = 32
CMP_STRIDE = 16
CMP_HIDDEN = 128
SEL_LEN = 64
SEL_TOPK = 16
WINDOW = 512
Q_BLOCK = 128
N_EXPERTS = 32
TOP_K = 4
D_EXPERT = D_MODEL
SWIGLU_LIMIT = 7.0
SWIGLU_ALPHA = 1.702
MOE_BLOCK = 256
DEEPNORM_ALPHA = (2 * DEPTH) ** 0.25
DEEPNORM_BETA = (8 * DEPTH) ** -0.25
LN_EPS = 1e-5
RMS_EPS = 1e-6
NEG_INF = -1e30
FORGET_BIAS_INIT = 3.0

COL_NSA_Q = D_NSA
COL_NSA_KV = N_NSA_BRANCH * 2 * N_NSA_KV * HEAD_DIM
COL_NSA_GATE = N_NSA_BRANCH * N_NSA_HEADS
COL_FOX_QKV = 3 * D_FOX
COL_FOX_F = N_FOX_HEADS
COL_SB_QKV = 3 * D_SB
OFF_NSA_KV = COL_NSA_Q
OFF_NSA_GATE = OFF_NSA_KV + COL_NSA_KV
OFF_FOX_QKV = OFF_NSA_GATE + COL_NSA_GATE
OFF_FOX_F = OFF_FOX_QKV + COL_FOX_QKV
OFF_SB_QKV = OFF_FOX_F + COL_FOX_F
D_IN = OFF_SB_QKV + COL_SB_QKV

kernel_name = "hybrid_nsa_fox_stickbreak_moe_deepnorm"

F32 = jnp.float32


def layer_norm(x, g, b):
    xf = x.astype(F32)
    mu = jnp.mean(xf, axis=-1, keepdims=True)
    var = jnp.mean(jnp.square(xf - mu), axis=-1, keepdims=True)
    return ((xf - mu) * lax.rsqrt(var + LN_EPS) * g + b).astype(x.dtype)


def rms_norm(x, g):
    xf = x.astype(F32)
    return xf * lax.rsqrt(jnp.mean(jnp.square(xf), axis=-1, keepdims=True) + RMS_EPS) * g


def masked_softmax(s, mask):
    s = jnp.where(mask, s.astype(F32), NEG_INF)
    p = jax.nn.softmax(s, axis=-1)
    return p * jnp.any(mask, axis=-1, keepdims=True)


def alibi_slopes(n):
    return jnp.exp2(-8.0 * jnp.arange(1, n + 1, dtype=F32) / n)


def blocks_to_seq(o):
    nqb, b, h, qb, d = o.shape
    return o.transpose(1, 0, 3, 2, 4).reshape(b, nqb * qb, h * d)


def nsa_attention(q, k_br, v_br, gates, pos_k, pos_v, w1_k, w2_k, w1_v, w2_v):
    B, H, S, dh = q.shape
    G, R = N_NSA_KV, NSA_REP
    scale = dh ** -0.5
    kc, ks, kw = k_br[0], k_br[1], k_br[2]
    vc, vs, vw = v_br[0], v_br[1], v_br[2]
    n_cmp = (S - CMP_LEN) // CMP_STRIDE + 1
    cmp_idx = jnp.arange(n_cmp)[:, None] * CMP_STRIDE + jnp.arange(CMP_LEN)[None, :]
    cmp_end = cmp_idx[:, -1]

    def compress(kv, pos, w1, w2):
        blk = kv[:, :, cmp_idx] + pos
        hid = jax.nn.gelu(blk.reshape(B, G, n_cmp, CMP_LEN * dh) @ w1)
        return hid @ w2

    k_cmp = compress(kc, pos_k, w1_k, w2_k)
    v_cmp = compress(vc, pos_v, w1_v, w2_v)
    n_blk = S // SEL_LEN
    n_sel = min(SEL_TOPK, n_blk)
    overlap = jax.nn.one_hot(cmp_idx // SEL_LEN, n_blk, dtype=F32).mean(axis=1)
    ks_blk = ks.reshape(B, G, n_blk, SEL_LEN, dh)
    vs_blk = vs.reshape(B, G, n_blk, SEL_LEN, dh)
    kw_pad = jnp.pad(kw, ((0, 0), (0, 0), (WINDOW, 0), (0, 0)))
    vw_pad = jnp.pad(vw, ((0, 0), (0, 0), (WINDOW, 0), (0, 0)))
    slopes = alibi_slopes(H).reshape(1, G, R, 1, 1)
    b_ix = jnp.arange(B)[:, None, None, None]
    g_ix = jnp.arange(G)[None, :, None, None]
    blk_ids = jnp.arange(n_blk)
    sel_off = jnp.arange(SEL_LEN)
    win_off = jnp.arange(Q_BLOCK + WINDOW)

    def block(i):
        q0 = i * Q_BLOCK
        t = q0 + jnp.arange(Q_BLOCK)
        tf = t.astype(F32)
        qb = lax.dynamic_slice_in_dim(q, q0, Q_BLOCK, axis=2).reshape(B, G, R, Q_BLOCK, dh)
        gb = lax.dynamic_slice_in_dim(gates, q0, Q_BLOCK, axis=2).reshape(B, G, R, Q_BLOCK, N_NSA_BRANCH)
        s_c = jnp.einsum('bgrqd,bgnd->bgrqn', qb, k_cmp).astype(F32) * scale \
            - slopes * (tf[:, None] - cmp_end[None, :].astype(F32))
        p_c = masked_softmax(s_c, cmp_end[None, :] <= t[:, None])
        o_c = jnp.einsum('bgrqn,bgnd->bgrqd', p_c, v_cmp)
        imp = jnp.einsum('bgrqn,nj->bgqj', p_c, overlap)
        cur = (t // SEL_LEN)[:, None]
        valid = blk_ids[None, :] <= cur
        forced = valid & ((blk_ids[None, :] == 0) | (blk_ids[None, :] >= cur - 1))
        imp = jnp.where(forced, jnp.inf, jnp.where(valid, imp, -jnp.inf))
        _, sel = lax.top_k(imp, n_sel)
        k_sel = ks_blk[b_ix, g_ix, sel].reshape(B, G, Q_BLOCK, n_sel * SEL_LEN, dh)
        v_sel = vs_blk[b_ix, g_ix, sel].reshape(B, G, Q_BLOCK, n_sel * SEL_LEN, dh)
        pos_sel = (sel[..., None] * SEL_LEN + sel_off).reshape(B, G, Q_BLOCK, n_sel * SEL_LEN)
        dist_sel = t[None, None, :, None] - pos_sel
        s_s = jnp.einsum('bgrqd,bgqkd->bgrqk', qb, k_sel).astype(F32) * scale \
            - slopes * dist_sel[:, :, None].astype(F32)
        p_s = masked_softmax(s_s, (dist_sel >= 0)[:, :, None])
        o_s = jnp.einsum('bgrqk,bgqkd->bgrqd', p_s, v_sel)
        k_win = lax.dynamic_slice_in_dim(kw_pad, q0, Q_BLOCK + WINDOW, axis=2)
        v_win = lax.dynamic_slice_in_dim(vw_pad, q0, Q_BLOCK + WINDOW, axis=2)
        pos_w = q0 - WINDOW + win_off
        dist_w = t[:, None] - pos_w[None, :]
        mask_w = (pos_w[None, :] >= 0) & (dist_w >= 0) & (dist_w < WINDOW)
        s_w = jnp.einsum('bgrqd,bgkd->bgrqk', qb, k_win).astype(F32) * scale \
            - slopes * dist_w.astype(F32)
        p_w = masked_softmax(s_w, mask_w)
        o_w = jnp.einsum('bgrqk,bgkd->bgrqd', p_w, v_win)
        o = gb[..., 0:1] * o_c + gb[..., 1:2] * o_s + gb[..., 2:3] * o_w
        return o.reshape(B, H, Q_BLOCK, dh)

    return blocks_to_seq(lax.map(block, jnp.arange(S // Q_BLOCK)))


def forgetting_attention(q, k, v, log_f):
    B, H, S, dh = q.shape
    scale = dh ** -0.5
    c = jnp.cumsum(log_f, axis=-1)
    key_pos = jnp.arange(S)

    def block(i):
        q0 = i * Q_BLOCK
        t = q0 + jnp.arange(Q_BLOCK)
        qb = lax.dynamic_slice_in_dim(q, q0, Q_BLOCK, axis=2)
        cb = lax.dynamic_slice_in_dim(c, q0, Q_BLOCK, axis=2)
        s = jnp.einsum('bhqd,bhkd->bhqk', qb, k).astype(F32) * scale \
            + cb[..., :, None] - c[..., None, :]
        p = masked_softmax(s, key_pos[None, :] <= t[:, None])
        return jnp.einsum('bhqk,bhkd->bhqd', p, v)

    return blocks_to_seq(lax.map(block, jnp.arange(S // Q_BLOCK)))


def stick_breaking_attention(q, k, v):
    B, H, S, dh = q.shape
    scale = dh ** -0.5
    key_pos = jnp.arange(S)

    def block(i):
        q0 = i * Q_BLOCK
        t = q0 + jnp.arange(Q_BLOCK)
        qb = lax.dynamic_slice_in_dim(q, q0, Q_BLOCK, axis=2)
        z = jnp.einsum('bhqd,bhkd->bhqk', qb, k).astype(F32) * scale
        strict = key_pos[None, :] < t[:, None]
        log_beta = jax.nn.log_sigmoid(z)
        log_keep = jnp.where(strict, jax.nn.log_sigmoid(-z), 0.0)
        shifted = jnp.concatenate([log_keep[..., 1:], jnp.zeros_like(log_keep[..., :1])], axis=-1)
        later = lax.cumsum(shifted, axis=3, reverse=True)
        a = jnp.where(strict, jnp.exp(log_beta + later), 0.0)
        return jnp.einsum('bhqk,bhkd->bhqd', a, v)

    return blocks_to_seq(lax.map(block, jnp.arange(S // Q_BLOCK)))


def hybrid_mixer(x, w_in, b_in, pos_k, pos_v, w1_k, w2_k, w1_v, w2_v, g_out, w_out):
    B, S, _ = x.shape
    proj = x @ w_in + b_in
    q_nsa = proj[..., :OFF_NSA_KV].reshape(B, S, N_NSA_HEADS, HEAD_DIM).transpose(0, 2, 1, 3)
    kv_nsa = proj[..., OFF_NSA_KV:OFF_NSA_GATE].reshape(
        B, S, N_NSA_BRANCH, 2, N_NSA_KV, HEAD_DIM).transpose(2, 3, 0, 4, 1, 5)
    gates = jax.nn.sigmoid(proj[..., OFF_NSA_GATE:OFF_FOX_QKV].reshape(
        B, S, N_NSA_BRANCH, N_NSA_HEADS)).transpose(0, 3, 1, 2)
    fox = proj[..., OFF_FOX_QKV:OFF_FOX_F].reshape(B, S, 3, N_FOX_HEADS, HEAD_DIM).transpose(2, 0, 3, 1, 4)
    log_f = jax.nn.log_sigmoid(proj[..., OFF_FOX_F:OFF_SB_QKV].astype(F32)).transpose(0, 2, 1)
    sb = proj[..., OFF_SB_QKV:].reshape(B, S, 3, N_SB_HEADS, HEAD_DIM).transpose(2, 0, 3, 1, 4)
    o_nsa = nsa_attention(q_nsa, kv_nsa[:, 0], kv_nsa[:, 1], gates, pos_k, pos_v, w1_k, w2_k, w1_v, w2_v)
    o_fox = forgetting_attention(fox[0], fox[1], fox[2], log_f)
    o_sb = stick_breaking_attention(sb[0], sb[1], sb[2])
    o = jnp.concatenate([
        rms_norm(o_nsa, g_out[:D_NSA]),
        rms_norm(o_fox, g_out[D_NSA:D_NSA + D_FOX]),
        rms_norm(o_sb, g_out[D_NSA + D_FOX:]),
    ], axis=-1).astype(x.dtype)
    return o @ w_out


def moe_ffn(h, router_w, router_b, w_gu, b_gu, w_dn, b_dn):
    B, S, D = h.shape
    T = B * S
    M = T * TOP_K
    xt = h.reshape(T, D)
    logits = (xt @ router_w + router_b).astype(F32)
    top_logit, top_e = lax.top_k(logits, TOP_K)
    top_w = jax.nn.softmax(top_logit, axis=-1)
    flat_e = top_e.reshape(M)
    flat_tok = jnp.repeat(jnp.arange(T, dtype=jnp.int32), TOP_K)
    flat_w = top_w.reshape(M)
    order = jnp.argsort(flat_e)
    sorted_e = flat_e[order]
    counts = jnp.bincount(flat_e, length=N_EXPERTS)
    start = jnp.cumsum(counts) - counts
    padded = (counts + MOE_BLOCK - 1) // MOE_BLOCK * MOE_BLOCK
    pad_end = jnp.cumsum(padded)
    pad_start = pad_end - padded
    dest = pad_start[sorted_e] + jnp.arange(M) - start[sorted_e]
    n_blocks = -(-M // MOE_BLOCK) + N_EXPERTS
    P = n_blocks * MOE_BLOCK
    buf_tok = jnp.zeros((P,), jnp.int32).at[dest].set(flat_tok[order])
    buf_w = jnp.zeros((P,), F32).at[dest].set(flat_w[order])
    blk_e = jnp.minimum(jnp.searchsorted(pad_end, jnp.arange(n_blocks) * MOE_BLOCK, side='right'),
                        N_EXPERTS - 1)

    def expert_block(args):
        e, tok, w = args
        xb = xt[tok]
        gu = xb @ w_gu[e] + b_gu[e]
        gate = jnp.minimum(gu[:, :D_EXPERT], SWIGLU_LIMIT)
        up = jnp.clip(gu[:, D_EXPERT:], -SWIGLU_LIMIT, SWIGLU_LIMIT)
        act = gate * jax.nn.sigmoid(SWIGLU_ALPHA * gate) * (up + 1.0)
        y = act @ w_dn[e] + b_dn[e]
        return (y * w[:, None]).astype(h.dtype)

    ys = lax.map(expert_block, (blk_e, buf_tok.reshape(n_blocks, MOE_BLOCK), buf_w.reshape(n_blocks, MOE_BLOCK)))
    out = jnp.zeros((T, D), h.dtype).at[buf_tok].add(ys.reshape(P, D))
    return out.reshape(B, S, D)


def setup_inputs(seed: int = 0) -> dict:
    key = jax.random.key(seed)
    ks = jax.random.split(key, 24)
    L = DEPTH

    def nrm(k, shape, scale):
        return jax.random.normal(k, shape, F32) * scale

    x = nrm(ks[0], (BATCH, SEQ, D_MODEL), 1.0)
    w_in = nrm(ks[1], (L, D_MODEL, D_IN), D_MODEL ** -0.5)
    b_in = nrm(ks[2], (L, D_IN), 0.01).at[:, OFF_FOX_F:OFF_SB_QKV].add(FORGET_BIAS_INIT)
    cmp_pos_k = nrm(ks[3], (L, CMP_LEN, HEAD_DIM), 0.1)
    cmp_pos_v = nrm(ks[4], (L, CMP_LEN, HEAD_DIM), 0.1)
    cmp_w1_k = nrm(ks[5], (L, CMP_LEN * HEAD_DIM, CMP_HIDDEN), (CMP_LEN * HEAD_DIM) ** -0.5)
    cmp_w2_k = nrm(ks[6], (L, CMP_HIDDEN, HEAD_DIM), CMP_HIDDEN ** -0.5)
    cmp_w1_v = nrm(ks[7], (L, CMP_LEN * HEAD_DIM, CMP_HIDDEN), (CMP_LEN * HEAD_DIM) ** -0.5)
    cmp_w2_v = nrm(ks[8], (L, CMP_HIDDEN, HEAD_DIM), CMP_HIDDEN ** -0.5)
    g_out = 1.0 + nrm(ks[9], (L, D_MIX), 0.02)
    w_out = nrm(ks[10], (L, D_MIX, D_MODEL), D_MIX ** -0.5 * DEEPNORM_BETA)
    ln1_g = 1.0 + nrm(ks[11], (L, D_MODEL), 0.02)
    ln1_b = nrm(ks[12], (L, D_MODEL), 0.02)
    router_w = nrm(ks[13], (L, D_MODEL, N_EXPERTS), D_MODEL ** -0.5)
    router_b = nrm(ks[14], (L, N_EXPERTS), 0.01)
    w_gate_up = nrm(ks[15], (L, N_EXPERTS, D_MODEL, 2 * D_EXPERT), D_MODEL ** -0.5)
    b_gate_up = nrm(ks[16], (L, N_EXPERTS, 2 * D_EXPERT), 0.01)
    w_down = nrm(ks[17], (L, N_EXPERTS, D_EXPERT, D_MODEL), D_EXPERT ** -0.5 * DEEPNORM_BETA)
    b_down = nrm(ks[18], (L, N_EXPERTS, D_MODEL), 0.01)
    ln2_g = 1.0 + nrm(ks[19], (L, D_MODEL), 0.02)
    ln2_b = nrm(ks[20], (L, D_MODEL), 0.02)
    return {'x': x, 'w_in': w_in, 'b_in': b_in, 'cmp_pos_k': cmp_pos_k, 'cmp_pos_v': cmp_pos_v,
            'cmp_w1_k': cmp_w1_k, 'cmp_w2_k': cmp_w2_k, 'cmp_w1_v': cmp_w1_v, 'cmp_w2_v': cmp_w2_v,
            'g_out': g_out, 'w_out': w_out, 'ln1_g': ln1_g, 'ln1_b': ln1_b,
            'router_w': router_w, 'router_b': router_b, 'w_gate_up': w_gate_up, 'b_gate_up': b_gate_up,
            'w_down': w_down, 'b_down': b_down, 'ln2_g': ln2_g, 'ln2_b': ln2_b}


def reference(x, w_in, b_in, cmp_pos_k, cmp_pos_v, cmp_w1_k, cmp_w2_k, cmp_w1_v, cmp_w2_v,
              g_out, w_out, ln1_g, ln1_b, router_w, router_b, w_gate_up, b_gate_up,
              w_down, b_down, ln2_g, ln2_b):
    for l in range(DEPTH):
        mix = hybrid_mixer(x, w_in[l], b_in[l], cmp_pos_k[l], cmp_pos_v[l], cmp_w1_k[l], cmp_w2_k[l],
                           cmp_w1_v[l], cmp_w2_v[l], g_out[l], w_out[l])
        x = layer_norm(DEEPNORM_ALPHA * x + mix, ln1_g[l], ln1_b[l])
        ffn = moe_ffn(x, router_w[l], router_b[l], w_gate_up[l], b_gate_up[l], w_down[l], b_down[l])
        x = layer_norm(DEEPNORM_ALPHA * x + ffn, ln2_g[l], ln2_b[l])
    return x
```

```cpp
#include <hip/hip_runtime.h>
#include <hip/hip_cooperative_groups.h>
#include <cstdio>
#include <cstdint>
namespace nv {

constexpr int B_ = 2, S_ = 8192, D_ = 1024, T_ = B_ * S_, L_ = 2;
constexpr int DIN = 2844;
constexpr int OFF_NSA_KV = 512, OFF_NSA_GATE = 1280, OFF_FOX_QKV = 1304, OFF_FOX_F = 2072, OFF_SB_QKV = 2076;
constexpr int NCMP = 511, NBLK = 128, NSEL = 16;
constexpr int NE = 32, TOPK = 4, MROWS = T_ * TOPK;
constexpr float LN_EPS = 1e-5f, RMS_EPS = 1e-6f;
constexpr float ALPHA = 1.4142135623730951f;
constexpr float SCALE = 0.125f;

__device__ __forceinline__ float sigmoidf_(float x) { return 1.f / (1.f + __expf(-x)); }
__device__ __forceinline__ float logsig(float x) { return fminf(x, 0.f) - log1pf(expf(-fabsf(x))); }

__global__ void __launch_bounds__(256) gemm(const float* __restrict__ A, int lda, const float* __restrict__ Bm, int ldb,
                                            float* __restrict__ C, int ldc, const float* __restrict__ bias, int M, int N, int K) {
    __shared__ float As[16][68];
    __shared__ float Bs[16][68];
    const int tid = threadIdx.x, tx = tid & 15, ty = tid >> 4;
    const int m0 = blockIdx.y * 64, n0 = blockIdx.x * 64;
    float acc[4][4];
#pragma unroll
    for (int i = 0; i < 4; ++i)
#pragma unroll
        for (int j = 0; j < 4; ++j) acc[i][j] = 0.f;
    for (int k0 = 0; k0 < K; k0 += 16) {
        {
            const int r = tid >> 2, kq = (tid & 3) * 4;
            const float4 a = *(const float4*)&A[(size_t)(m0 + r) * lda + k0 + kq];
            As[kq + 0][r] = a.x; As[kq + 1][r] = a.y; As[kq + 2][r] = a.z; As[kq + 3][r] = a.w;
            const int kk = tid >> 4, nq = (tid & 15) * 4;
            float4 b = make_float4(0.f, 0.f, 0.f, 0.f);
            if (n0 + nq < N) b = *(const float4*)&Bm[(size_t)(k0 + kk) * ldb + n0 + nq];
            Bs[kk][nq + 0] = b.x; Bs[kk][nq + 1] = b.y; Bs[kk][nq + 2] = b.z; Bs[kk][nq + 3] = b.w;
        }
        __syncthreads();
#pragma unroll
        for (int kk = 0; kk < 16; ++kk) {
            float a[4], b[4];
#pragma unroll
            for (int i = 0; i < 4; ++i) a[i] = As[kk][ty * 4 + i];
#pragma unroll
            for (int j = 0; j < 4; ++j) b[j] = Bs[kk][tx * 4 + j];
#pragma unroll
            for (int i = 0; i < 4; ++i)
#pragma unroll
                for (int j = 0; j < 4; ++j) acc[i][j] += a[i] * b[j];
        }
        __syncthreads();
    }
#pragma unroll
    for (int i = 0; i < 4; ++i)
#pragma unroll
        for (int j = 0; j < 4; ++j) {
            const int m = m0 + ty * 4 + i, n = n0 + tx * 4 + j;
            if (n < N) C[(size_t)m * ldc + n] = acc[i][j] + (bias ? bias[n] : 0.f);
        }
}

__global__ void __launch_bounds__(256) fox_cumsum(const float* __restrict__ proj, float* __restrict__ c) {
    __shared__ float sh[256];
    const int bh = blockIdx.x, b = bh >> 2, h = bh & 3, tid = threadIdx.x;
    float carry = 0.f;
    for (int t0 = 0; t0 < S_; t0 += 256) {
        const float v = logsig(proj[(size_t)(b * S_ + t0 + tid) * DIN + OFF_FOX_F + h]);
        sh[tid] = v; __syncthreads();
        for (int o = 1; o < 256; o <<= 1) { float add = (tid >= o) ? sh[tid - o] : 0.f; __syncthreads(); sh[tid] += add; __syncthreads(); }
        c[(size_t)bh * S_ + t0 + tid] = carry + sh[tid];
        carry += sh[255]; __syncthreads();
    }
}

__device__ __forceinline__ float gelu_tanh(float x) { return 0.5f * x * (1.f + tanhf(0.7978845608028654f * (x + 0.044715f * x * x * x))); }
__global__ void __launch_bounds__(128) compress(const float* __restrict__ proj, const float* __restrict__ pos_k, const float* __restrict__ pos_v,
                                                const float* __restrict__ w1k, const float* __restrict__ w2k, const float* __restrict__ w1v, const float* __restrict__ w2v,
                                                float* __restrict__ kcmp, float* __restrict__ vcmp) {
    __shared__ float blk[2048];
    __shared__ float hid[128];
    const int n = blockIdx.x, bg = blockIdx.y, kv = blockIdx.z, b = bg >> 1, g = bg & 1, tid = threadIdx.x;
    const float* pos = kv ? pos_v : pos_k; const float* w1 = kv ? w1v : w1k; const float* w2 = kv ? w2v : w2k; float* out = kv ? vcmp : kcmp;
    for (int i = tid; i < 2048; i += 128) { const int l = i >> 6, d = i & 63;
        blk[i] = proj[(size_t)(b * S_ + 16 * n + l) * DIN + OFF_NSA_KV + ((0 * 2 + kv) * 2 + g) * 64 + d] + pos[l * 64 + d]; }
    __syncthreads();
    float a = 0.f;
    for (int i = 0; i < 2048; ++i) a += blk[i] * w1[(size_t)i * 128 + tid];
    hid[tid] = gelu_tanh(a);
    __syncthreads();
    if (tid < 64) { float o = 0.f; for (int j = 0; j < 128; ++j) o += hid[j] * w2[j * 64 + tid]; out[((size_t)bg * NCMP + n) * 64 + tid] = o; }
}

__device__ __forceinline__ void load_tile(float (*dst)[64], const float* __restrict__ src, size_t stride, int nrows_valid) {
    const int tid = threadIdx.x, r = tid >> 2, c0 = (tid & 3) * 16;
#pragma unroll
    for (int j = 0; j < 4; ++j) { float4 v = make_float4(0.f, 0.f, 0.f, 0.f); if (r < nrows_valid) v = *(const float4*)(src + (size_t)r * stride + c0 + 4 * j); *(float4*)&dst[r][c0 + 4 * j] = v; }
}
#define NV_DOT(q, kr, res) do { float s0_ = 0.f, s1_ = 0.f, s2_ = 0.f, s3_ = 0.f; _Pragma("unroll") for (int d_ = 0; d_ < 64; d_ += 4) { const float4 k4_ = *(const float4*)&(kr)[d_]; s0_ += q[d_] * k4_.x; s1_ += q[d_ + 1] * k4_.y; s2_ += q[d_ + 2] * k4_.z; s3_ += q[d_ + 3] * k4_.w; } res = (s0_ + s1_) + (s2_ + s3_); } while (0)
#define NV_AXPY(o, p, vr) do { _Pragma("unroll") for (int d_ = 0; d_ < 64; d_ += 4) { const float4 v4_ = *(const float4*)&(vr)[d_]; o[d_] += p * v4_.x; o[d_ + 1] += p * v4_.y; o[d_ + 2] += p * v4_.z; o[d_ + 3] += p * v4_.w; } } while (0)
#define NV_ONLINE(sc, vr) do { if (sc > m) { const float al_ = __expf(m - sc); l *= al_; _Pragma("unroll") for (int d_ = 0; d_ < 64; ++d_) o[d_] *= al_; m = sc; } const float p_ = __expf(sc - m); l += p_; NV_AXPY(o, p_, vr); } while (0)

template <int MODE>
__global__ void __launch_bounds__(256) attn_dense(const float* __restrict__ proj, const float* __restrict__ cc, float* __restrict__ out) {
    __shared__ float Ks[64][64];
    __shared__ float Vs[64][64];
    __shared__ float Cs[64];
    const int tid = threadIdx.x, q0 = blockIdx.x * 256, t = q0 + tid;
    int b, h, qcol, kcol, vcol, ocol; float slope = 0.f;
    if (MODE == 0) { b = blockIdx.y >> 2; h = blockIdx.y & 3; qcol = OFF_FOX_QKV + (0 * 4 + h) * 64; kcol = OFF_FOX_QKV + (1 * 4 + h) * 64; vcol = OFF_FOX_QKV + (2 * 4 + h) * 64; ocol = 512 + h * 64; }
    else { b = blockIdx.y >> 3; h = blockIdx.y & 7; const int g = h >> 2; qcol = h * 64; kcol = OFF_NSA_KV + ((2 * 2 + 0) * 2 + g) * 64; vcol = OFF_NSA_KV + ((2 * 2 + 1) * 2 + g) * 64; ocol = h * 64; slope = exp2f(-(float)(h + 1)); }
    const float* prow = proj + (size_t)(b * S_ + t) * DIN;
    float q[64], o[64];
#pragma unroll
    for (int d = 0; d < 64; ++d) { q[d] = prow[qcol + d] * SCALE; o[d] = 0.f; }
    float m = -1e30f, l = 0.f;
    float ct = 0.f; const float* cb = nullptr;
    if (MODE == 0) { cb = cc + (size_t)(b * 4 + h) * S_; ct = cb[t]; }
    int kt0 = 0; const int kt1 = (q0 + 255) >> 6;
    if (MODE == 1) { kt0 = (q0 - 511) >> 6; if (kt0 < 0) kt0 = 0; }
    for (int kt = kt0; kt <= kt1; ++kt) {
        __syncthreads();
        load_tile(Ks, proj + (size_t)(b * S_ + kt * 64) * DIN + kcol, DIN, 64);
        load_tile(Vs, proj + (size_t)(b * S_ + kt * 64) * DIN + vcol, DIN, 64);
        if (MODE == 0 && tid < 64) Cs[tid] = cb[kt * 64 + tid];
        __syncthreads();
        for (int r = 0; r < 64; ++r) {
            const int s = kt * 64 + r;
            bool ok = (s <= t); if (MODE == 1) ok = ok && (t - s < 512);
            if (ok) {
                float sc; NV_DOT(q, Ks[r], sc);
                if (MODE == 0) sc += ct - Cs[r]; else sc -= slope * (float)(t - s);
                NV_ONLINE(sc, Vs[r]);
            }
        }
    }
    const float inv = (l > 0.f) ? 1.f / l : 0.f;
    float* orow = out + (size_t)(b * S_ + t) * D_ + ocol;
    if (MODE == 0) {
#pragma unroll
        for (int d = 0; d < 64; ++d) orow[d] = o[d] * inv;
    } else {
        const float gate = sigmoidf_(prow[OFF_NSA_GATE + 2 * 8 + h]);
#pragma unroll
        for (int d = 0; d < 64; ++d) orow[d] += gate * o[d] * inv;
    }
}

__global__ void __launch_bounds__(256) attn_sb(const float* __restrict__ proj, float* __restrict__ out) {
    __shared__ float Ks[64][64];
    __shared__ float Vs[64][64];
    const int tid = threadIdx.x, q0 = blockIdx.x * 256, t = q0 + tid;
    const int b = blockIdx.y >> 2, h = blockIdx.y & 3;
    const int qcol = OFF_SB_QKV + (0 * 4 + h) * 64, kcol = OFF_SB_QKV + (1 * 4 + h) * 64, vcol = OFF_SB_QKV + (2 * 4 + h) * 64, ocol = 768 + h * 64;
    const float* prow = proj + (size_t)(b * S_ + t) * DIN;
    float q[64], o[64];
#pragma unroll
    for (int d = 0; d < 64; ++d) { q[d] = prow[qcol + d] * SCALE; o[d] = 0.f; }
    float later = 0.f;
    for (int kt = (q0 + 255) >> 6; kt >= 0; --kt) {
        __syncthreads();
        load_tile(Ks, proj + (size_t)(b * S_ + kt * 64) * DIN + kcol, DIN, 64);
        load_tile(Vs, proj + (size_t)(b * S_ + kt * 64) * DIN + vcol, DIN, 64);
        __syncthreads();
        for (int r = 63; r >= 0; --r) {
            const int s = kt * 64 + r;
            if (s < t) {
                float z; NV_DOT(q, Ks[r], z);
                const float a = expf(logsig(z) + later);
                NV_AXPY(o, a, Vs[r]);
                later += logsig(-z);
            }
        }
    }
    float* orow = out + (size_t)(b * S_ + t) * D_ + ocol;
#pragma unroll
    for (int d = 0; d < 64; ++d) orow[d] = o[d];
}

__global__ void __launch_bounds__(256) attn_cmp(const float* __restrict__ proj, const float* __restrict__ kcmp, const float* __restrict__ vcmp,
                                                float* __restrict__ out, float* __restrict__ ptot) {
    __shared__ float Ks[64][64];
    __shared__ float Vs[64][64];
    const int tid = threadIdx.x, q0 = blockIdx.x * 256, t = q0 + tid;
    const int bg = blockIdx.y, b = bg >> 1, g = bg & 1;
    const float* prow = proj + (size_t)(b * S_ + t) * DIN;
    float* prow_t = ptot + (size_t)(bg * S_ + t) * 512;
    int nmax = (q0 + 255 - 31) / 16 + 1; if (q0 + 255 < 31) nmax = 0; if (nmax > NCMP) nmax = NCMP;
    const int ntile = (nmax + 63) / 64;
    for (int r4 = 0; r4 < 4; ++r4) {
        const int h = g * 4 + r4; const float slope = exp2f(-(float)(h + 1));
        float q[64], o[64];
#pragma unroll
        for (int d = 0; d < 64; ++d) { q[d] = prow[h * 64 + d] * SCALE; o[d] = 0.f; }
        float m = -1e30f, l = 0.f;
        for (int kt = 0; kt < ntile; ++kt) {
            __syncthreads();
            const int nv = (NCMP - kt * 64) < 64 ? (NCMP - kt * 64) : 64;
            load_tile(Ks, kcmp + ((size_t)bg * NCMP + kt * 64) * 64, 64, nv);
            load_tile(Vs, vcmp + ((size_t)bg * NCMP + kt * 64) * 64, 64, nv);
            __syncthreads();
            for (int r = 0; r < nv; ++r) {
                const int n = kt * 64 + r, ce = 16 * n + 31;
                if (ce <= t) { float sc; NV_DOT(q, Ks[r], sc); sc -= slope * (float)(t - ce); NV_ONLINE(sc, Vs[r]); }
            }
        }
        const float inv = (l > 0.f) ? 1.f / l : 0.f;
        const float gate = sigmoidf_(prow[OFF_NSA_GATE + 0 * 8 + h]);
        float* orow = out + (size_t)(b * S_ + t) * D_ + h * 64;
#pragma unroll
        for (int d = 0; d < 64; ++d) orow[d] = gate * o[d] * inv;
        for (int kt = 0; kt < 8; ++kt) {
            __syncthreads();
            const int nv = (NCMP - kt * 64) < 64 ? (NCMP - kt * 64) : 64;
            if (kt < ntile) load_tile(Ks, kcmp + ((size_t)bg * NCMP + kt * 64) * 64, 64, nv);
            __syncthreads();
            for (int r = 0; r < 64; ++r) {
                const int n = kt * 64 + r, ce = 16 * n + 31; float p = 0.f;
                if (kt < ntile && r < nv && ce <= t) { float sc; NV_DOT(q, Ks[r], sc); sc -= slope * (float)(t - ce); p = __expf(sc - m) * inv; }
                if (r4 == 0) prow_t[n] = p; else prow_t[n] += p;
            }
        }
    }
}

__global__ void __launch_bounds__(256) select_blocks(const float* __restrict__ ptot, int* __restrict__ sel) {
    const int wave = (blockIdx.x * 256 + threadIdx.x) >> 6, lane = threadIdx.x & 63;
    if (wave >= B_ * 2 * S_) return;
    const int t = wave % S_;
    const float* p = ptot + (size_t)wave * 512;
    const int cur = t >> 6;
    float v[2];
#pragma unroll
    for (int k = 0; k < 2; ++k) {
        const int j = lane + 64 * k;
        float imp = p[4 * j] + p[4 * j + 1] + p[4 * j + 2];
        if (4 * j + 3 < NCMP) imp += 0.5f * p[4 * j + 3];
        if (j >= 1) imp += 0.5f * p[4 * j - 1];
        const bool valid = j <= cur, forced = valid && (j == 0 || j >= cur - 1);
        v[k] = forced ? 3.0e38f : (valid ? imp : -3.0e38f);
    }
    for (int it = 0; it < NSEL; ++it) {
        float bv = v[0]; int bi = lane;
        if (v[1] > bv) { bv = v[1]; bi = lane + 64; }
#pragma unroll
        for (int o = 32; o >= 1; o >>= 1) {
            const float ov = __shfl_xor(bv, o); const int oi = __shfl_xor(bi, o);
            if (ov > bv || (ov == bv && oi < bi)) { bv = ov; bi = oi; }
        }
        if (lane == 0) sel[(size_t)wave * NSEL + it] = bi;
        if (bi == lane) v[0] = -3.4e38f;
        if (bi == lane + 64) v[1] = -3.4e38f;
    }
}

__global__ void __launch_bounds__(256) attn_sel(const float* __restrict__ proj, const int* __restrict__ sel, float* __restrict__ out) {
    const int tid = threadIdx.x, t = blockIdx.x * 256 + tid;
    const int b = blockIdx.y >> 3, h = blockIdx.y & 7, g = h >> 2;
    const float slope = exp2f(-(float)(h + 1));
    const float* prow = proj + (size_t)(b * S_ + t) * DIN;
    const int kcol = OFF_NSA_KV + ((1 * 2 + 0) * 2 + g) * 64, vcol = OFF_NSA_KV + ((1 * 2 + 1) * 2 + g) * 64;
    const int* sl = sel + ((size_t)(b * 2 + g) * S_ + t) * NSEL;
    float q[64], o[64];
#pragma unroll
    for (int d = 0; d < 64; ++d) { q[d] = prow[h * 64 + d] * SCALE; o[d] = 0.f; }
    float m = -1e30f, l = 0.f;
    for (int i = 0; i < NSEL; ++i) {
        const int blk = sl[i];
        for (int r = 0; r < 64; ++r) {
            const int s = blk * 64 + r;
            if (s <= t) {
                const float* kr = proj + (size_t)(b * S_ + s) * DIN + kcol; const float* vr = proj + (size_t)(b * S_ + s) * DIN + vcol;
                float sc; NV_DOT(q, kr, sc); sc -= slope * (float)(t - s);
                NV_ONLINE(sc, vr);
            }
        }
    }
    const float inv = (l > 0.f) ? 1.f / l : 0.f;
    const float gate = sigmoidf_(prow[OFF_NSA_GATE + 1 * 8 + h]);
    float* orow = out + (size_t)(b * S_ + t) * D_ + h * 64;
#pragma unroll
    for (int d = 0; d < 64; ++d) orow[d] += gate * o[d] * inv;
}

__device__ __forceinline__ float wsum(float v) {
#pragma unroll
    for (int o = 1; o < 64; o <<= 1) v += __shfl_xor(v, o);
    return v;
}
__global__ void __launch_bounds__(256) rmsnorm3(float* __restrict__ o, const float* __restrict__ g) {
    const int row = (blockIdx.x * 256 + threadIdx.x) >> 6, lane = threadIdx.x & 63;
    float* r = o + (size_t)row * D_;
    float a[8], s = 0.f;
#pragma unroll
    for (int i = 0; i < 8; ++i) { a[i] = r[lane + 64 * i]; s += a[i] * a[i]; }
    float sc = rsqrtf(wsum(s) * (1.f / 512.f) + RMS_EPS);
#pragma unroll
    for (int i = 0; i < 8; ++i) r[lane + 64 * i] = a[i] * sc * g[lane + 64 * i];
#pragma unroll
    for (int seg = 0; seg < 2; ++seg) {
        const int c0 = 512 + 256 * seg; s = 0.f;
#pragma unroll
        for (int i = 0; i < 4; ++i) { a[i] = r[c0 + lane + 64 * i]; s += a[i] * a[i]; }
        sc = rsqrtf(wsum(s) * (1.f / 256.f) + RMS_EPS);
#pragma unroll
        for (int i = 0; i < 4; ++i) r[c0 + lane + 64 * i] = a[i] * sc * g[c0 + lane + 64 * i];
    }
}

template <bool ROUTER>
__global__ void __launch_bounds__(256) ln_res(const float* __restrict__ x, const float* __restrict__ add, const float* __restrict__ g, const float* __restrict__ bb,
                                              float* __restrict__ y, const float* __restrict__ rw, const float* __restrict__ rb,
                                              int* __restrict__ top_e, float* __restrict__ top_w, int* __restrict__ counts, int* __restrict__ pos_in_e) {
    const int row = (blockIdx.x * 256 + threadIdx.x) >> 6, lane = threadIdx.x & 63;
    float v[16], s = 0.f;
#pragma unroll
    for (int i = 0; i < 16; ++i) { const int c = lane + 64 * i; v[i] = ALPHA * x[(size_t)row * D_ + c] + add[(size_t)row * D_ + c]; s += v[i]; }
    const float mu = wsum(s) * (1.f / D_); float s2 = 0.f;
#pragma unroll
    for (int i = 0; i < 16; ++i) { v[i] -= mu; s2 += v[i] * v[i]; }
    const float rstd = rsqrtf(wsum(s2) * (1.f / D_) + LN_EPS);
#pragma unroll
    for (int i = 0; i < 16; ++i) { const int c = lane + 64 * i; v[i] = v[i] * rstd * g[c] + bb[c]; y[(size_t)row * D_ + c] = v[i]; }
    if (ROUTER) {
        float lg[NE];
#pragma unroll
        for (int e = 0; e < NE; ++e) lg[e] = 0.f;
#pragma unroll
        for (int i = 0; i < 16; ++i) { const int c = lane + 64 * i; const float* wr = rw + (size_t)c * NE;
#pragma unroll
            for (int e = 0; e < NE; ++e) lg[e] += v[i] * wr[e]; }
#pragma unroll
        for (int e = 0; e < NE; ++e) lg[e] = wsum(lg[e]) + rb[e];
        int te[TOPK]; float tv[TOPK];
#pragma unroll
        for (int k = 0; k < TOPK; ++k) { float bv = -3.0e38f; int bi = 0;
#pragma unroll
            for (int e = 0; e < NE; ++e) if (lg[e] > bv) { bv = lg[e]; bi = e; }
            te[k] = bi; tv[k] = bv;
#pragma unroll
            for (int e = 0; e < NE; ++e) if (e == bi) lg[e] = -3.4e38f; }
        float den = 0.f, w[TOPK];
#pragma unroll
        for (int k = 0; k < TOPK; ++k) { w[k] = __expf(tv[k] - tv[0]); den += w[k]; }
        if (lane < TOPK) {
            int e = te[0]; float ww = w[0];
#pragma unroll
            for (int k = 1; k < TOPK; ++k) if (lane == k) { e = te[k]; ww = w[k]; }
            top_e[row * TOPK + lane] = e; top_w[row * TOPK + lane] = ww / den;
            pos_in_e[row * TOPK + lane] = atomicAdd(&counts[e], 1);
        }
    }
}

__global__ void moe_plan(const int* __restrict__ counts, int* __restrict__ meta) {
    if (threadIdx.x == 0) {
        int off = 0, nt = 0;
        for (int e = 0; e < NE; ++e) { meta[e] = off; const int c = counts[e];
            for (int r = 0; r < c; r += 64) { meta[64 + 3 * nt] = e; meta[64 + 3 * nt + 1] = off + r; meta[64 + 3 * nt + 2] = (c - r) < 64 ? (c - r) : 64; ++nt; }
            off += c; }
        meta[32] = nt;
    }
}
__global__ void __launch_bounds__(256) moe_scatter(const int* __restrict__ top_e, const float* __restrict__ top_w, const int* __restrict__ pos_in_e, const int* __restrict__ meta,
                                                   int* __restrict__ rowtok, float* __restrict__ roww, int* __restrict__ slot) {
    const int i = blockIdx.x * 256 + threadIdx.x; if (i >= MROWS) return;
    const int row = meta[top_e[i]] + pos_in_e[i];
    rowtok[row] = i >> 2; roww[row] = top_w[i]; slot[i] = row;
}
__global__ void __launch_bounds__(256) moe_gu(const float* __restrict__ x1, const float* __restrict__ wgu, const float* __restrict__ bgu, const int* __restrict__ meta,
                                              const int* __restrict__ rowtok, float* __restrict__ act) {
    const int ti = blockIdx.y; if (ti >= meta[32]) return;
    const int e = meta[64 + 3 * ti], r0 = meta[64 + 3 * ti + 1], nr = meta[64 + 3 * ti + 2];
    __shared__ float As[16][68];
    __shared__ float Bg[16][68];
    __shared__ float Bu[16][68];
    const int tid = threadIdx.x, tx = tid & 15, ty = tid >> 4, n0 = blockIdx.x * 64;
    const float* W = wgu + (size_t)e * D_ * 2048;
    const int lr = tid >> 2; const int tok = rowtok[r0 + (lr < nr ? lr : 0)];
    const float* arow = x1 + (size_t)tok * D_;
    float ag[4][4], au[4][4];
#pragma unroll
    for (int i = 0; i < 4; ++i)
#pragma unroll
        for (int j = 0; j < 4; ++j) { ag[i][j] = 0.f; au[i][j] = 0.f; }
    for (int k0 = 0; k0 < D_; k0 += 16) {
        { const int kq = (tid & 3) * 4; const float4 a = *(const float4*)&arow[k0 + kq];
          As[kq + 0][lr] = a.x; As[kq + 1][lr] = a.y; As[kq + 2][lr] = a.z; As[kq + 3][lr] = a.w;
          const int kk = tid >> 4, nq = (tid & 15) * 4;
          const float4 bg4 = *(const float4*)&W[(size_t)(k0 + kk) * 2048 + n0 + nq];
          const float4 bu4 = *(const float4*)&W[(size_t)(k0 + kk) * 2048 + 1024 + n0 + nq];
          Bg[kk][nq + 0] = bg4.x; Bg[kk][nq + 1] = bg4.y; Bg[kk][nq + 2] = bg4.z; Bg[kk][nq + 3] = bg4.w;
          Bu[kk][nq + 0] = bu4.x; Bu[kk][nq + 1] = bu4.y; Bu[kk][nq + 2] = bu4.z; Bu[kk][nq + 3] = bu4.w; }
        __syncthreads();
#pragma unroll
        for (int kk = 0; kk < 16; ++kk) {
            float a[4], b1[4], b2[4];
#pragma unroll
            for (int i = 0; i < 4; ++i) a[i] = As[kk][ty * 4 + i];
#pragma unroll
            for (int j = 0; j < 4; ++j) { b1[j] = Bg[kk][tx * 4 + j]; b2[j] = Bu[kk][tx * 4 + j]; }
#pragma unroll
            for (int i = 0; i < 4; ++i)
#pragma unroll
                for (int j = 0; j < 4; ++j) { ag[i][j] += a[i] * b1[j]; au[i][j] += a[i] * b2[j]; }
        }
        __syncthreads();
    }
#pragma unroll
    for (int i = 0; i < 4; ++i) { const int r = ty * 4 + i; if (r < nr) {
#pragma unroll
        for (int j = 0; j < 4; ++j) { const int n = n0 + tx * 4 + j;
            const float gt = fminf(ag[i][j] + bgu[(size_t)e * 2048 + n], 7.0f);
            const float up = fminf(fmaxf(au[i][j] + bgu[(size_t)e * 2048 + 1024 + n], -7.0f), 7.0f);
            act[(size_t)(r0 + r) * D_ + n] = gt * sigmoidf_(1.702f * gt) * (up + 1.0f); } } }
}
__global__ void __launch_bounds__(256) moe_dn(const float* __restrict__ act, const float* __restrict__ wdn, const float* __restrict__ bdn, const int* __restrict__ meta,
                                              const float* __restrict__ roww, float* __restrict__ y) {
    const int ti = blockIdx.y; if (ti >= meta[32]) return;
    const int e = meta[64 + 3 * ti], r0 = meta[64 + 3 * ti + 1], nr = meta[64 + 3 * ti + 2];
    __shared__ float As[16][68];
    __shared__ float Bs[16][68];
    const int tid = threadIdx.x, tx = tid & 15, ty = tid >> 4, n0 = blockIdx.x * 64;
    const float* W = wdn + (size_t)e * D_ * D_;
    const int lr = tid >> 2;
    const float* arow = act + (size_t)(r0 + (lr < nr ? lr : 0)) * D_;
    float acc[4][4];
#pragma unroll
    for (int i = 0; i < 4; ++i)
#pragma unroll
        for (int j = 0; j < 4; ++j) acc[i][j] = 0.f;
    for (int k0 = 0; k0 < D_; k0 += 16) {
        { const int kq = (tid & 3) * 4; const float4 a = *(const float4*)&arow[k0 + kq];
          As[kq + 0][lr] = a.x; As[kq + 1][lr] = a.y; As[kq + 2][lr] = a.z; As[kq + 3][lr] = a.w;
          const int kk = tid >> 4, nq = (tid & 15) * 4;
          const float4 b4 = *(const float4*)&W[(size_t)(k0 + kk) * D_ + n0 + nq];
          Bs[kk][nq + 0] = b4.x; Bs[kk][nq + 1] = b4.y; Bs[kk][nq + 2] = b4.z; Bs[kk][nq + 3] = b4.w; }
        __syncthreads();
#pragma unroll
        for (int kk = 0; kk < 16; ++kk) {
            float a[4], b[4];
#pragma unroll
            for (int i = 0; i < 4; ++i) a[i] = As[kk][ty * 4 + i];
#pragma unroll
            for (int j = 0; j < 4; ++j) b[j] = Bs[kk][tx * 4 + j];
#pragma unroll
            for (int i = 0; i < 4; ++i)
#pragma unroll
                for (int j = 0; j < 4; ++j) acc[i][j] += a[i] * b[j];
        }
        __syncthreads();
    }
#pragma unroll
    for (int i = 0; i < 4; ++i) { const int r = ty * 4 + i; if (r < nr) { const float w = roww[r0 + r];
#pragma unroll
        for (int j = 0; j < 4; ++j) { const int n = n0 + tx * 4 + j; y[(size_t)(r0 + r) * D_ + n] = (acc[i][j] + bdn[(size_t)e * D_ + n]) * w; } } }
}
__global__ void __launch_bounds__(256) moe_combine(const float* __restrict__ y, const int* __restrict__ slot, float* __restrict__ ffn) {
    const size_t i = (size_t)blockIdx.x * 256 + threadIdx.x;
    const int tok = (int)(i >> 8), c4 = (int)(i & 255);
    float4 a = make_float4(0.f, 0.f, 0.f, 0.f);
#pragma unroll
    for (int k = 0; k < TOPK; ++k) { const float4 v = *(const float4*)&y[(size_t)slot[tok * TOPK + k] * D_ + c4 * 4]; a.x += v.x; a.y += v.y; a.z += v.z; a.w += v.w; }
    *(float4*)&ffn[(size_t)tok * D_ + c4 * 4] = a;
}

struct WS {
    float *proj, *cfox, *kcmp, *vcmp, *o, *ptot, *mix, *x1, *xa, *xb, *act, *y, *ffn, *topw, *roww;
    int *sel, *tope, *pos, *counts, *meta, *rowtok, *slot;
};
inline WS carve(void* ws, size_t base) {
    char* p = (char*)ws + base; WS w;
    auto take = [&](size_t bytes) { char* r = p; p += (bytes + 255) & ~(size_t)255; return r; };
    w.proj = (float*)take((size_t)T_ * DIN * 4);
    w.cfox = (float*)take((size_t)B_ * 4 * S_ * 4);
    w.kcmp = (float*)take((size_t)B_ * 2 * 512 * 64 * 4);
    w.vcmp = (float*)take((size_t)B_ * 2 * 512 * 64 * 4);
    w.o = (float*)take((size_t)T_ * D_ * 4);
    w.ptot = (float*)take((size_t)B_ * 2 * S_ * 512 * 4);
    w.mix = (float*)take((size_t)T_ * D_ * 4);
    w.x1 = (float*)take((size_t)T_ * D_ * 4);
    w.xa = (float*)take((size_t)T_ * D_ * 4);
    w.xb = (float*)take((size_t)T_ * D_ * 4);
    w.act = (float*)take((size_t)MROWS * D_ * 4);
    w.y = (float*)take((size_t)MROWS * D_ * 4);
    w.ffn = (float*)take((size_t)T_ * D_ * 4);
    w.topw = (float*)take((size_t)MROWS * 4);
    w.roww = (float*)take((size_t)MROWS * 4);
    w.sel = (int*)take((size_t)B_ * 2 * S_ * NSEL * 4);
    w.tope = (int*)take((size_t)MROWS * 4);
    w.pos = (int*)take((size_t)MROWS * 4);
    w.counts = (int*)take(256);
    w.meta = (int*)take((64 + 3 * 1100) * 4);
    w.rowtok = (int*)take((size_t)MROWS * 4);
    w.slot = (int*)take((size_t)MROWS * 4);
    return w;
}

struct In {
    const float *x, *w_in, *b_in, *pos_k, *pos_v, *w1k, *w2k, *w1v, *w2v, *g_out, *w_out, *ln1_g, *ln1_b, *rw, *rb, *wgu, *bgu, *wdn, *bdn, *ln2_g, *ln2_b;
};
inline In inputs(void* const* d) {
    In i; i.x = (const float*)d[0]; i.w_in = (const float*)d[1]; i.b_in = (const float*)d[2]; i.pos_k = (const float*)d[3]; i.pos_v = (const float*)d[4];
    i.w1k = (const float*)d[5]; i.w2k = (const float*)d[6]; i.w1v = (const float*)d[7]; i.w2v = (const float*)d[8]; i.g_out = (const float*)d[9]; i.w_out = (const float*)d[10];
    i.ln1_g = (const float*)d[11]; i.ln1_b = (const float*)d[12]; i.rw = (const float*)d[13]; i.rb = (const float*)d[14]; i.wgu = (const float*)d[15]; i.bgu = (const float*)d[16];
    i.wdn = (const float*)d[17]; i.bdn = (const float*)d[18]; i.ln2_g = (const float*)d[19]; i.ln2_b = (const float*)d[20]; return i;
}

inline void layer(const In& I, const WS& W, int l, const float* xin, float* xout, hipStream_t st) {
    gemm<<<dim3((DIN + 63) / 64, T_ / 64), 256, 0, st>>>(xin, D_, I.w_in + (size_t)l * D_ * DIN, DIN, W.proj, DIN, I.b_in + (size_t)l * DIN, T_, DIN, D_);
    fox_cumsum<<<B_ * 4, 256, 0, st>>>(W.proj, W.cfox);
    compress<<<dim3(NCMP, B_ * 2, 2), 128, 0, st>>>(W.proj, I.pos_k + (size_t)l * 2048, I.pos_v + (size_t)l * 2048, I.w1k + (size_t)l * 2048 * 128, I.w2k + (size_t)l * 128 * 64,
                                                  I.w1v + (size_t)l * 2048 * 128, I.w2v + (size_t)l * 128 * 64, W.kcmp, W.vcmp);
    attn_cmp<<<dim3(S_ / 256, B_ * 2), 256, 0, st>>>(W.proj, W.kcmp, W.vcmp, W.o, W.ptot);
    select_blocks<<<(B_ * 2 * S_ * 64) / 256, 256, 0, st>>>(W.ptot, W.sel);
    attn_sel<<<dim3(S_ / 256, B_ * 8), 256, 0, st>>>(W.proj, W.sel, W.o);
    attn_dense<1><<<dim3(S_ / 256, B_ * 8), 256, 0, st>>>(W.proj, nullptr, W.o);
    attn_dense<0><<<dim3(S_ / 256, B_ * 4), 256, 0, st>>>(W.proj, W.cfox, W.o);
    attn_sb<<<dim3(S_ / 256, B_ * 4), 256, 0, st>>>(W.proj, W.o);
    rmsnorm3<<<T_ * 64 / 256, 256, 0, st>>>(W.o, I.g_out + (size_t)l * D_);
    gemm<<<dim3(D_ / 64, T_ / 64), 256, 0, st>>>(W.o, D_, I.w_out + (size_t)l * D_ * D_, D_, W.mix, D_, nullptr, T_, D_, D_);
    hipMemsetAsync(W.counts, 0, 256, st);
    ln_res<true><<<T_ * 64 / 256, 256, 0, st>>>(xin, W.mix, I.ln1_g + (size_t)l * D_, I.ln1_b + (size_t)l * D_, W.x1, I.rw + (size_t)l * D_ * NE, I.rb + (size_t)l * NE,
                                                W.tope, W.topw, W.counts, W.pos);
    moe_plan<<<1, 64, 0, st>>>(W.counts, W.meta);
    moe_scatter<<<MROWS / 256, 256, 0, st>>>(W.tope, W.topw, W.pos, W.meta, W.rowtok, W.roww, W.slot);
    moe_gu<<<dim3(D_ / 64, MROWS / 64 + NE), 256, 0, st>>>(W.x1, I.wgu + (size_t)l * NE * D_ * 2048, I.bgu + (size_t)l * NE * 2048, W.meta, W.rowtok, W.act);
    moe_dn<<<dim3(D_ / 64, MROWS / 64 + NE), 256, 0, st>>>(W.act, I.wdn + (size_t)l * NE * D_ * D_, I.bdn + (size_t)l * NE * D_, W.meta, W.roww, W.y);
    moe_combine<<<T_ * 256 / 256, 256, 0, st>>>(W.y, W.slot, W.ffn);
    ln_res<false><<<T_ * 64 / 256, 256, 0, st>>>(W.x1, W.ffn, I.ln2_g + (size_t)l * D_, I.ln2_b + (size_t)l * D_, xout, nullptr, nullptr, nullptr, nullptr, nullptr, nullptr);
}

}
extern "C" void kernel_launch(void* const* d_in, const int* in_sizes, int n_in,
                              void* d_out, int out_size, void* d_ws, size_t ws_size,
                              hipStream_t stream) {
    const nv::In I = nv::inputs(d_in);
    const nv::WS W = nv::carve(d_ws, 0);
    nv::layer(I, W, 0, I.x, W.xa, stream);
    nv::layer(I, W, 1, W.xa, (float*)d_out, stream);
}
```

```cpp
#include <hip/hip_runtime.h>
#include <hip/hip_cooperative_groups.h>
#include <cstdio>
#include <cstdint>
namespace nv {

constexpr int B_ = 2, S_ = 8192, D_ = 1024, T_ = B_ * S_, L_ = 2;
constexpr int DIN = 2844;
constexpr int OFF_NSA_KV = 512, OFF_NSA_GATE = 1280, OFF_FOX_QKV = 1304, OFF_FOX_F = 2072, OFF_SB_QKV = 2076;
constexpr int NCMP = 511, NBLK = 128, NSEL = 16;
constexpr int NE = 32, TOPK = 4, MROWS = T_ * TOPK;
constexpr float LN_EPS = 1e-5f, RMS_EPS = 1e-6f;
constexpr float ALPHA = 1.4142135623730951f;
constexpr float SCALE = 0.125f;

__device__ __forceinline__ float sigmoidf_(float x) { return 1.f / (1.f + __expf(-x)); }
__device__ __forceinline__ float logsig(float x) { return fminf(x, 0.f) - log1pf(expf(-fabsf(x))); }

__global__ void __launch_bounds__(256) gemm(const float* __restrict__ A, int lda, const float* __restrict__ Bm, int ldb,
                                            float* __restrict__ C, int ldc, const float* __restrict__ bias, int M, int N, int K) {
    __shared__ float As[16][68];
    __shared__ float Bs[16][68];
    const int tid = threadIdx.x, tx = tid & 15, ty = tid >> 4;
    const int m0 = blockIdx.y * 64, n0 = blockIdx.x * 64;
    float acc[4][4];
#pragma unroll
    for (int i = 0; i < 4; ++i)
#pragma unroll
        for (int j = 0; j < 4; ++j) acc[i][j] = 0.f;
    for (int k0 = 0; k0 < K; k0 += 16) {
        {
            const int r = tid >> 2, kq = (tid & 3) * 4;
            const float4 a = *(const float4*)&A[(size_t)(m0 + r) * lda + k0 + kq];
            As[kq + 0][r] = a.x; As[kq + 1][r] = a.y; As[kq + 2][r] = a.z; As[kq + 3][r] = a.w;
            const int kk = tid >> 4, nq = (tid & 15) * 4;
            float4 b = make_float4(0.f, 0.f, 0.f, 0.f);
            if (n0 + nq < N) b = *(const float4*)&Bm[(size_t)(k0 + kk) * ldb + n0 + nq];
            Bs[kk][nq + 0] = b.x; Bs[kk][nq + 1] = b.y; Bs[kk][nq + 2] = b.z; Bs[kk][nq + 3] = b.w;
        }
        __syncthreads();
#pragma unroll
        for (int kk = 0; kk < 16; ++kk) {
            float a[4], b[4];
#pragma unroll
            for (int i = 0; i < 4; ++i) a[i] = As[kk][ty * 4 + i];
#pragma unroll
            for (int j = 0; j < 4; ++j) b[j] = Bs[kk][tx * 4 + j];
#pragma unroll
            for (int i = 0; i < 4; ++i)
#pragma unroll
                for (int j = 0; j < 4; ++j) acc[i][j] += a[i] * b[j];
        }
        __syncthreads();
    }
#pragma unroll
    for (int i = 0; i < 4; ++i)
#pragma unroll
        for (int j = 0; j < 4; ++j) {
            const int m = m0 + ty * 4 + i, n = n0 + tx * 4 + j;
            if (n < N) C[(size_t)m * ldc + n] = acc[i][j] + (bias ? bias[n] : 0.f);
        }
}

__global__ void __launch_bounds__(256) fox_cumsum(const float* __restrict__ proj, float* __restrict__ c) {
    __shared__ float sh[256];
    const int bh = blockIdx.x, b = bh >> 2, h = bh & 3, tid = threadIdx.x;
    float carry = 0.f;
    for (int t0 = 0; t0 < S_; t0 += 256) {
        const float v = logsig(proj[(size_t)(b * S_ + t0 + tid) * DIN + OFF_FOX_F + h]);
        sh[tid] = v; __syncthreads();
        for (int o = 1; o < 256; o <<= 1) { float add = (tid >= o) ? sh[tid - o] : 0.f; __syncthreads(); sh[tid] += add; __syncthreads(); }
        c[(size_t)bh * S_ + t0 + tid] = carry + sh[tid];
        carry += sh[255]; __syncthreads();
    }
}

__device__ __forceinline__ float gelu_tanh(float x) { return 0.5f * x * (1.f + tanhf(0.7978845608028654f * (x + 0.044715f * x * x * x))); }
__global__ void __launch_bounds__(128) compress(const float* __restrict__ proj, const float* __restrict__ pos_k, const float* __restrict__ pos_v,
                                                const float* __restrict__ w1k, const float* __restrict__ w2k, const float* __restrict__ w1v, const float* __restrict__ w2v,
                                                float* __restrict__ kcmp, float* __restrict__ vcmp) {
    __shared__ float blk[2048];
    __shared__ float hid[128];
    const int n = blockIdx.x, bg = blockIdx.y, kv = blockIdx.z, b = bg >> 1, g = bg & 1, tid = threadIdx.x;
    const float* pos = kv ? pos_v : pos_k; const float* w1 = kv ? w1v : w1k; const float* w2 = kv ? w2v : w2k; float* out = kv ? vcmp : kcmp;
    for (int i = tid; i < 2048; i += 128) { const int l = i >> 6, d = i & 63;
        blk[i] = proj[(size_t)(b * S_ + 16 * n + l) * DIN + OFF_NSA_KV + ((0 * 2 + kv) * 2 + g) * 64 + d] + pos[l * 64 + d]; }
    __syncthreads();
    float a = 0.f;
    for (int i = 0; i < 2048; ++i) a += blk[i] * w1[(size_t)i * 128 + tid];
    hid[tid] = gelu_tanh(a);
    __syncthreads();
    if (tid < 64) { float o = 0.f; for (int j = 0; j < 128; ++j) o += hid[j] * w2[j * 64 + tid]; out[((size_t)bg * NCMP + n) * 64 + tid] = o; }
}

__device__ __forceinline__ void load_tile(float (*dst)[64], const float* __restrict__ src, size_t stride, int nrows_valid) {
    const int tid = threadIdx.x, r = tid >> 2, c0 = (tid & 3) * 16;
#pragma unroll
    for (int j = 0; j < 4; ++j) { float4 v = make_float4(0.f, 0.f, 0.f, 0.f); if (r < nrows_valid) v = *(const float4*)(src + (size_t)r * stride + c0 + 4 * j); *(float4*)&dst[r][c0 + 4 * j] = v; }
}
#define NV_DOT(q, kr, res) do { float s0_ = 0.f, s1_ = 0.f, s2_ = 0.f, s3_ = 0.f; _Pragma("unroll") for (int d_ = 0; d_ < 64; d_ += 4) { const float4 k4_ = *(const float4*)&(kr)[d_]; s0_ += q[d_] * k4_.x; s1_ += q[d_ + 1] * k4_.y; s2_ += q[d_ + 2] * k4_.z; s3_ += q[d_ + 3] * k4_.w; } res = (s0_ + s1_) + (s2_ + s3_); } while (0)
#define NV_AXPY(o, p, vr) do { _Pragma("unroll") for (int d_ = 0; d_ < 64; d_ += 4) { const float4 v4_ = *(const float4*)&(vr)[d_]; o[d_] += p * v4_.x; o[d_ + 1] += p * v4_.y; o[d_ + 2] += p * v4_.z; o[d_ + 3] += p * v4_.w; } } while (0)
#define NV_ONLINE(sc, vr) do { if (sc > m) { const float al_ = __expf(m - sc); l *= al_; _Pragma("unroll") for (int d_ = 0; d_ < 64; ++d_) o[d_] *= al_; m = sc; } const float p_ = __expf(sc - m); l += p_; NV_AXPY(o, p_, vr); } while (0)

template <int MODE>
__global__ void __launch_bounds__(256) attn_dense(const float* __restrict__ proj, const float* __restrict__ cc, float* __restrict__ out) {
    __shared__ float Ks[64][64];
    __shared__ float Vs[64][64];
    __shared__ float Cs[64];
    const int tid = threadIdx.x, q0 = blockIdx.x * 256, t = q0 + tid;
    int b, h, qcol, kcol, vcol, ocol; float slope = 0.f;
    if (MODE == 0) { b = blockIdx.y >> 2; h = blockIdx.y & 3; qcol = OFF_FOX_QKV + (0 * 4 + h) * 64; kcol = OFF_FOX_QKV + (1 * 4 + h) * 64; vcol = OFF_FOX_QKV + (2 * 4 + h) * 64; ocol = 512 + h * 64; }
    else { b = blockIdx.y >> 3; h = blockIdx.y & 7; const int g = h >> 2; qcol = h * 64; kcol = OFF_NSA_KV + ((2 * 2 + 0) * 2 + g) * 64; vcol = OFF_NSA_KV + ((2 * 2 + 1) * 2 + g) * 64; ocol = h * 64; slope = exp2f(-(float)(h + 1)); }
    const float* prow = proj + (size_t)(b * S_ + t) * DIN;
    float q[64], o[64];
#pragma unroll
    for (int d = 0; d < 64; ++d) { q[d] = prow[qcol + d] * SCALE; o[d] = 0.f; }
    float m = -1e30f, l = 0.f;
    float ct = 0.f; const float* cb = nullptr;
    if (MODE == 0) { cb = cc + (size_t)(b * 4 + h) * S_; ct = cb[t]; }
    int kt0 = 0; const int kt1 = (q0 + 255) >> 6;
    if (MODE == 1) { kt0 = (q0 - 511) >> 6; if (kt0 < 0) kt0 = 0; }
    for (int kt = kt0; kt <= kt1; ++kt) {
        __syncthreads();
        load_tile(Ks, proj + (size_t)(b * S_ + kt * 64) * DIN + kcol, DIN, 64);
        load_tile(Vs, proj + (size_t)(b * S_ + kt * 64) * DIN + vcol, DIN, 64);
        if (MODE == 0 && tid < 64) Cs[tid] = cb[kt * 64 + tid];
        __syncthreads();
        for (int r = 0; r < 64; ++r) {
            const int s = kt * 64 + r;
            bool ok = (s <= t); if (MODE == 1) ok = ok && (t - s < 512);
            if (ok) {
                float sc; NV_DOT(q, Ks[r], sc);
                if (MODE == 0) sc += ct - Cs[r]; else sc -= slope * (float)(t - s);
                NV_ONLINE(sc, Vs[r]);
            }
        }
    }
    const float inv = (l > 0.f) ? 1.f / l : 0.f;
    float* orow = out + (size_t)(b * S_ + t) * D_ + ocol;
    if (MODE == 0) {
#pragma unroll
        for (int d = 0; d < 64; ++d) orow[d] = o[d] * inv;
    } else {
        const float gate = sigmoidf_(prow[OFF_NSA_GATE + 2 * 8 + h]);
#pragma unroll
        for (int d = 0; d < 64; ++d) orow[d] += gate * o[d] * inv;
    }
}

__global__ void __launch_bounds__(256) attn_sb(const float* __restrict__ proj, float* __restrict__ out) {
    __shared__ float Ks[64][64];
    __shared__ float Vs[64][64];
    const int tid = threadIdx.x, q0 = blockIdx.x * 256, t = q0 + tid;
    const int b = blockIdx.y >> 2, h = blockIdx.y & 3;
    const int qcol = OFF_SB_QKV + (0 * 4 + h) * 64, kcol = OFF_SB_QKV + (1 * 4 + h) * 64, vcol = OFF_SB_QKV + (2 * 4 + h) * 64, ocol = 768 + h * 64;
    const float* prow = proj + (size_t)(b * S_ + t) * DIN;
    float q[64], o[64];
#pragma unroll
    for (int d = 0; d < 64; ++d) { q[d] = prow[qcol + d] * SCALE; o[d] = 0.f; }
    float later = 0.f;
    for (int kt = (q0 + 255) >> 6; kt >= 0; --kt) {
        __syncthreads();
        load_tile(Ks, proj + (size_t)(b * S_ + kt * 64) * DIN + kcol, DIN, 64);
        load_tile(Vs, proj + (size_t)(b * S_ + kt * 64) * DIN + vcol, DIN, 64);
        __syncthreads();
        for (int r = 63; r >= 0; --r) {
            const int s = kt * 64 + r;
            if (s < t) {
                float z; NV_DOT(q, Ks[r], z);
                const float a = expf(logsig(z) + later);
                NV_AXPY(o, a, Vs[r]);
                later += logsig(-z);
            }
        }
    }
    float* orow = out + (size_t)(b * S_ + t) * D_ + ocol;
#pragma unroll
    for (int d = 0; d < 64; ++d) orow[d] = o[d];
}

__global__ void __launch_bounds__(256) attn_cmp(const float* __restrict__ proj, const float* __restrict__ kcmp, const float* __restrict__ vcmp,
                                                float* __restrict__ out, float* __restrict__ ptot) {
    __shared__ float Ks[64][64];
    __shared__ float Vs[64][64];
    const int tid = threadIdx.x, q0 = blockIdx.x * 256, t = q0 + tid;
    const int bg = blockIdx.y, b = bg >> 1, g = bg & 1;
    const float* prow = proj + (size_t)(b * S_ + t) * DIN;
    float* prow_t = ptot + (size_t)(bg * S_ + t) * 512;
    int nmax = (q0 + 255 - 31) / 16 + 1; if (q0 + 255 < 31) nmax = 0; if (nmax > NCMP) nmax = NCMP;
    const int ntile = (nmax + 63) / 64;
    for (int r4 = 0; r4 < 4; ++r4) {
        const int h = g * 4 + r4; const float slope = exp2f(-(float)(h + 1));
        float q[64], o[64];
#pragma unroll
        for (int d = 0; d < 64; ++d) { q[d] = prow[h * 64 + d] * SCALE; o[d] = 0.f; }
        float m = -1e30f, l = 0.f;
        for (int kt = 0; kt < ntile; ++kt) {
            __syncthreads();
            const int nv = (NCMP - kt * 64) < 64 ? (NCMP - kt * 64) : 64;
            load_tile(Ks, kcmp + ((size_t)bg * NCMP + kt * 64) * 64, 64, nv);
            load_tile(Vs, vcmp + ((size_t)bg * NCMP + kt * 64) * 64, 64, nv);
            __syncthreads();
            for (int r = 0; r < nv; ++r) {
                const int n = kt * 64 + r, ce = 16 * n + 31;
                if (ce <= t) { float sc; NV_DOT(q, Ks[r], sc); sc -= slope * (float)(t - ce); NV_ONLINE(sc, Vs[r]); }
            }
        }
        const float inv = (l > 0.f) ? 1.f / l : 0.f;
        const float gate = sigmoidf_(prow[OFF_NSA_GATE + 0 * 8 + h]);
        float* orow = out + (size_t)(b * S_ + t) * D_ + h * 64;
#pragma unroll
        for (int d = 0; d < 64; ++d) orow[d] = gate * o[d] * inv;
        for (int kt = 0; kt < 8; ++kt) {
            __syncthreads();
            const int nv = (NCMP - kt * 64) < 64 ? (NCMP - kt * 64) : 64;
            if (kt < ntile) load_tile(Ks, kcmp + ((size_t)bg * NCMP + kt * 64) * 64, 64, nv);
            __syncthreads();
            for (int r = 0; r < 64; ++r) {
                const int n = kt * 64 + r, ce = 16 * n + 31; float p = 0.f;
                if (kt < ntile && r < nv && ce <= t) { float sc; NV_DOT(q, Ks[r], sc); sc -= slope * (float)(t - ce); p = __expf(sc - m) * inv; }
                if (r4 == 0) prow_t[n] = p; else prow_t[n] += p;
            }
        }
    }
}

__global__ void __launch_bounds__(256) select_blocks(const float* __restrict__ ptot, int* __restrict__ sel) {
    const int wave = (blockIdx.x * 256 + threadIdx.x) >> 6, lane = threadIdx.x & 63;
    if (wave >= B_ * 2 * S_) return;
    const int t = wave % S_;
    const float* p = ptot + (size_t)wave * 512;
    const int cur = t >> 6;
    float v[2];
#pragma unroll
    for (int k = 0; k < 2; ++k) {
        const int j = lane + 64 * k;
        float imp = p[4 * j] + p[4 * j + 1] + p[4 * j + 2];
        if (4 * j + 3 < NCMP) imp += 0.5f * p[4 * j + 3];
        if (j >= 1) imp += 0.5f * p[4 * j - 1];
        const bool valid = j <= cur, forced = valid && (j == 0 || j >= cur - 1);
        v[k] = forced ? 3.0e38f : (valid ? imp : -3.0e38f);
    }
    for (int it = 0; it < NSEL; ++it) {
        float bv = v[0]; int bi = lane;
        if (v[1] > bv) { bv = v[1]; bi = lane + 64; }
#pragma unroll
        for (int o = 32; o >= 1; o >>= 1) {
            const float ov = __shfl_xor(bv, o); const int oi = __shfl_xor(bi, o);
            if (ov > bv || (ov == bv && oi < bi)) { bv = ov; bi = oi; }
        }
        if (lane == 0) sel[(size_t)wave * NSEL + it] = bi;
        if (bi == lane) v[0] = -3.4e38f;
        if (bi == lane + 64) v[1] = -3.4e38f;
    }
}

__global__ void __launch_bounds__(256) attn_sel(const float* __restrict__ proj, const int* __restrict__ sel, float* __restrict__ out) {
    const int tid = threadIdx.x, t = blockIdx.x * 256 + tid;
    const int b = blockIdx.y >> 3, h = blockIdx.y & 7, g = h >> 2;
    const float slope = exp2f(-(float)(h + 1));
    const float* prow = proj + (size_t)(b * S_ + t) * DIN;
    const int kcol = OFF_NSA_KV + ((1 * 2 + 0) * 2 + g) * 64, vcol = OFF_NSA_KV + ((1 * 2 + 1) * 2 + g) * 64;
    const int* sl = sel + ((size_t)(b * 2 + g) * S_ + t) * NSEL;
    float q[64], o[64];
#pragma unroll
    for (int d = 0; d < 64; ++d) { q[d] = prow[h * 64 + d] * SCALE; o[d] = 0.f; }
    float m = -1e30f, l = 0.f;
    for (int i = 0; i < NSEL; ++i) {
        const int blk = sl[i];
        for (int r = 0; r < 64; ++r) {
            const int s = blk * 64 + r;
            if (s <= t) {
                const float* kr = proj + (size_t)(b * S_ + s) * DIN + kcol; const float* vr = proj + (size_t)(b * S_ + s) * DIN + vcol;
                float sc; NV_DOT(q, kr, sc); sc -= slope * (float)(t - s);
                NV_ONLINE(sc, vr);
            }
        }
    }
    const float inv = (l > 0.f) ? 1.f / l : 0.f;
    const float gate = sigmoidf_(prow[OFF_NSA_GATE + 1 * 8 + h]);
    float* orow = out + (size_t)(b * S_ + t) * D_ + h * 64;
#pragma unroll
    for (int d = 0; d < 64; ++d) orow[d] += gate * o[d] * inv;
}

__device__ __forceinline__ float wsum(float v) {
#pragma unroll
    for (int o = 1; o < 64; o <<= 1) v += __shfl_xor(v, o);
    return v;
}
__global__ void __launch_bounds__(256) rmsnorm3(float* __restrict__ o, const float* __restrict__ g) {
    const int row = (blockIdx.x * 256 + threadIdx.x) >> 6, lane = threadIdx.x & 63;
    float* r = o + (size_t)row * D_;
    float a[8], s = 0.f;
#pragma unroll
    for (int i = 0; i < 8; ++i) { a[i] = r[lane + 64 * i]; s += a[i] * a[i]; }
    float sc = rsqrtf(wsum(s) * (1.f / 512.f) + RMS_EPS);
#pragma unroll
    for (int i = 0; i < 8; ++i) r[lane + 64 * i] = a[i] * sc * g[lane + 64 * i];
#pragma unroll
    for (int seg = 0; seg < 2; ++seg) {
        const int c0 = 512 + 256 * seg; s = 0.f;
#pragma unroll
        for (int i = 0; i < 4; ++i) { a[i] = r[c0 + lane + 64 * i]; s += a[i] * a[i]; }
        sc = rsqrtf(wsum(s) * (1.f / 256.f) + RMS_EPS);
#pragma unroll
        for (int i = 0; i < 4; ++i) r[c0 + lane + 64 * i] = a[i] * sc * g[c0 + lane + 64 * i];
    }
}

template <bool ROUTER>
__global__ void __launch_bounds__(256) ln_res(const float* __restrict__ x, const float* __restrict__ add, const float* __restrict__ g, const float* __restrict__ bb,
                                              float* __restrict__ y, const float* __restrict__ rw, const float* __restrict__ rb,
                                              int* __restrict__ top_e, float* __restrict__ top_w, int* __restrict__ counts, int* __restrict__ pos_in_e) {
    const int row = (blockIdx.x * 256 + threadIdx.x) >> 6, lane = threadIdx.x & 63;
    float v[16], s = 0.f;
#pragma unroll
    for (int i = 0; i < 16; ++i) { const int c = lane + 64 * i; v[i] = ALPHA * x[(size_t)row * D_ + c] + add[(size_t)row * D_ + c]; s += v[i]; }
    const float mu = wsum(s) * (1.f / D_); float s2 = 0.f;
#pragma unroll
    for (int i = 0; i < 16; ++i) { v[i] -= mu; s2 += v[i] * v[i]; }
    const float rstd = rsqrtf(wsum(s2) * (1.f / D_) + LN_EPS);
#pragma unroll
    for (int i = 0; i < 16; ++i) { const int c = lane + 64 * i; v[i] = v[i] * rstd * g[c] + bb[c]; y[(size_t)row * D_ + c] = v[i]; }
    if (ROUTER) {
        float lg[NE];
#pragma unroll
        for (int e = 0; e < NE; ++e) lg[e] = 0.f;
#pragma unroll
        for (int i = 0; i < 16; ++i) { const int c = lane + 64 * i; const float* wr = rw + (size_t)c * NE;
#pragma unroll
            for (int e = 0; e < NE; ++e) lg[e] += v[i] * wr[e]; }
#pragma unroll
        for (int e = 0; e < NE; ++e) lg[e] = wsum(lg[e]) + rb[e];
        int te[TOPK]; float tv[TOPK];
#pragma unroll
        for (int k = 0; k < TOPK; ++k) { float bv = -3.0e38f; int bi = 0;
#pragma unroll
            for (int e = 0; e < NE; ++e) if (lg[e] > bv) { bv = lg[e]; bi = e; }
            te[k] = bi; tv[k] = bv;
#pragma unroll
            for (int e = 0; e < NE; ++e) if (e == bi) lg[e] = -3.4e38f; }
        float den = 0.f, w[TOPK];
#pragma unroll
        for (int k = 0; k < TOPK; ++k) { w[k] = __expf(tv[k] - tv[0]); den += w[k]; }
        if (lane < TOPK) {
            int e = te[0]; float ww = w[0];
#pragma unroll
            for (int k = 1; k < TOPK; ++k) if (lane == k) { e = te[k]; ww = w[k]; }
            top_e[row * TOPK + lane] = e; top_w[row * TOPK + lane] = ww / den;
            pos_in_e[row * TOPK + lane] = atomicAdd(&counts[e], 1);
        }
    }
}

__global__ void moe_plan(const int* __restrict__ counts, int* __restrict__ meta) {
    if (threadIdx.x == 0) {
        int off = 0, nt = 0;
        for (int e = 0; e < NE; ++e) { meta[e] = off; const int c = counts[e];
            for (int r = 0; r < c; r += 64) { meta[64 + 3 * nt] = e; meta[64 + 3 * nt + 1] = off + r; meta[64 + 3 * nt + 2] = (c - r) < 64 ? (c - r) : 64; ++nt; }
            off += c; }
        meta[32] = nt;
    }
}
__global__ void __launch_bounds__(256) moe_scatter(const int* __restrict__ top_e, const float* __restrict__ top_w, const int* __restrict__ pos_in_e, const int* __restrict__ meta,
                                                   int* __restrict__ rowtok, float* __restrict__ roww, int* __restrict__ slot) {
    const int i = blockIdx.x * 256 + threadIdx.x; if (i >= MROWS) return;
    const int row = meta[top_e[i]] + pos_in_e[i];
    rowtok[row] = i >> 2; roww[row] = top_w[i]; slot[i] = row;
}
__global__ void __launch_bounds__(256) moe_gu(const float* __restrict__ x1, const float* __restrict__ wgu, const float* __restrict__ bgu, const int* __restrict__ meta,
                                              const int* __restrict__ rowtok, float* __restrict__ act) {
    const int ti = blockIdx.y; if (ti >= meta[32]) return;
    const int e = meta[64 + 3 * ti], r0 = meta[64 + 3 * ti + 1], nr = meta[64 + 3 * ti + 2];
    __shared__ float As[16][68];
    __shared__ float Bg[16][68];
    __shared__ float Bu[16][68];
    const int tid = threadIdx.x, tx = tid & 15, ty = tid >> 4, n0 = blockIdx.x * 64;
    const float* W = wgu + (size_t)e * D_ * 2048;
    const int lr = tid >> 2; const int tok = rowtok[r0 + (lr < nr ? lr : 0)];
    const float* arow = x1 + (size_t)tok * D_;
    float ag[4][4], au[4][4];
#pragma unroll
    for (int i = 0; i < 4; ++i)
#pragma unroll
        for (int j = 0; j < 4; ++j) { ag[i][j] = 0.f; au[i][j] = 0.f; }
    for (int k0 = 0; k0 < D_; k0 += 16) {
        { const int kq = (tid & 3) * 4; const float4 a = *(const float4*)&arow[k0 + kq];
          As[kq + 0][lr] = a.x; As[kq + 1][lr] = a.y; As[kq + 2][lr] = a.z; As[kq + 3][lr] = a.w;
          const int kk = tid >> 4, nq = (tid & 15) * 4;
          const float4 bg4 = *(const float4*)&W[(size_t)(k0 + kk) * 2048 + n0 + nq];
          const float4 bu4 = *(const float4*)&W[(size_t)(k0 + kk) * 2048 + 1024 + n0 + nq];
          Bg[kk][nq + 0] = bg4.x; Bg[kk][nq + 1] = bg4.y; Bg[kk][nq + 2] = bg4.z; Bg[kk][nq + 3] = bg4.w;
          Bu[kk][nq + 0] = bu4.x; Bu[kk][nq + 1] = bu4.y; Bu[kk][nq + 2] = bu4.z; Bu[kk][nq + 3] = bu4.w; }
        __syncthreads();
#pragma unroll
        for (int kk = 0; kk < 16; ++kk) {
            float a[4], b1[4], b2[4];
#pragma unroll
            for (int i = 0; i < 4; ++i) a[i] = As[kk][ty * 4 + i];
#pragma unroll
            for (int j = 0; j < 4; ++j) { b1[j] = Bg[kk][tx * 4 + j]; b2[j] = Bu[kk][tx * 4 + j]; }
#pragma unroll
            for (int i = 0; i < 4; ++i)
#pragma unroll
                for (int j = 0; j < 4; ++j) { ag[i][j] += a[i] * b1[j]; au[i][j] += a[i] * b2[j]; }
        }
        __syncthreads();
    }
#pragma unroll
    for (int i = 0; i < 4; ++i) { const int r = ty * 4 + i; if (r < nr) {
#pragma unroll
        for (int j = 0; j < 4; ++j) { const int n = n0 + tx * 4 + j;
            const float gt = fminf(ag[i][j] + bgu[(size_t)e * 2048 + n], 7.0f);
            const float up = fminf(fmaxf(au[i][j] + bgu[(size_t)e * 2048 + 1024 + n], -7.0f), 7.0f);
            act[(size_t)(r0 + r) * D_ + n] = gt * sigmoidf_(1.702f * gt) * (up + 1.0f); } } }
}
__global__ void __launch_bounds__(256) moe_dn(const float* __restrict__ act, const float* __restrict__ wdn, const float* __restrict__ bdn, const int* __restrict__ meta,
                                              const float* __restrict__ roww, float* __restrict__ y) {
    const int ti = blockIdx.y; if (ti >= meta[32]) return;
    const int e = meta[64 + 3 * ti], r0 = meta[64 + 3 * ti + 1], nr = meta[64 + 3 * ti + 2];
    __shared__ float As[16][68];
    __shared__ float Bs[16][68];
    const int tid = threadIdx.x, tx = tid & 15, ty = tid >> 4, n0 = blockIdx.x * 64;
    const float* W = wdn + (size_t)e * D_ * D_;
    const int lr = tid >> 2;
    const float* arow = act + (size_t)(r0 + (lr < nr ? lr : 0)) * D_;
    float acc[4][4];
#pragma unroll
    for (int i = 0; i < 4; ++i)
#pragma unroll
        for (int j = 0; j < 4; ++j) acc[i][j] = 0.f;
    for (int k0 = 0; k0 < D_; k0 += 16) {
        { const int kq = (tid & 3) * 4; const float4 a = *(const float4*)&arow[k0 + kq];
          As[kq + 0][lr] = a.x; As[kq + 1][lr] = a.y; As[kq + 2][lr] = a.z; As[kq + 3][lr] = a.w;
          const int kk = tid >> 4, nq = (tid & 15) * 4;
          const float4 b4 = *(const float4*)&W[(size_t)(k0 + kk) * D_ + n0 + nq];
          Bs[kk][nq + 0] = b4.x; Bs[kk][nq + 1] = b4.y; Bs[kk][nq + 2] = b4.z; Bs[kk][nq + 3] = b4.w; }
        __syncthreads();
#pragma unroll
        for (int kk = 0; kk < 16; ++kk) {
            float a[4], b[4];
#pragma unroll
            for (int i = 0; i < 4; ++i) a[i] = As[kk][ty * 4 + i];
#pragma unroll
            for (int j = 0; j < 4; ++j) b[j] = Bs[kk][tx * 4 + j];
#pragma unroll
            for (int i = 0; i < 4; ++i)
#pragma unroll
                for (int j = 0; j < 4; ++j) acc[i][j] += a[i] * b[j];
        }
        __syncthreads();
    }
#pragma unroll
    for (int i = 0; i < 4; ++i) { const int r = ty * 4 + i; if (r < nr) { const float w = roww[r0 + r];
#pragma unroll
        for (int j = 0; j < 4; ++j) { const int n = n0 + tx * 4 + j; y[(size_t)(r0 + r) * D_ + n] = (acc[i][j] + bdn[(size_t)e * D_ + n]) * w; } } }
}
__global__ void __launch_bounds__(256) moe_combine(const float* __restrict__ y, const int* __restrict__ slot, float* __restrict__ ffn) {
    const size_t i = (size_t)blockIdx.x * 256 + threadIdx.x;
    const int tok = (int)(i >> 8), c4 = (int)(i & 255);
    float4 a = make_float4(0.f, 0.f, 0.f, 0.f);
#pragma unroll
    for (int k = 0; k < TOPK; ++k) { const float4 v = *(const float4*)&y[(size_t)slot[tok * TOPK + k] * D_ + c4 * 4]; a.x += v.x; a.y += v.y; a.z += v.z; a.w += v.w; }
    *(float4*)&ffn[(size_t)tok * D_ + c4 * 4] = a;
}

struct WS {
    float *proj, *cfox, *kcmp, *vcmp, *o, *ptot, *mix, *x1, *xa, *xb, *act, *y, *ffn, *topw, *roww;
    int *sel, *tope, *pos, *counts, *meta, *rowtok, *slot;
};
inline WS carve(void* ws, size_t base) {
    char* p = (char*)ws + base; WS w;
    auto take = [&](size_t bytes) { char* r = p; p += (bytes + 255) & ~(size_t)255; return r; };
    w.proj = (float*)take((size_t)T_ * DIN * 4);
    w.cfox = (float*)take((size_t)B_ * 4 * S_ * 4);
    w.kcmp = (float*)take((size_t)B_ * 2 * 512 * 64 * 4);
    w.vcmp = (float*)take((size_t)B_ * 2 * 512 * 64 * 4);
    w.o = (float*)take((size_t)T_ * D_ * 4);
    w.ptot = (float*)take((size_t)B_ * 2 * S_ * 512 * 4);
    w.mix = (float*)take((size_t)T_ * D_ * 4);
    w.x1 = (float*)take((size_t)T_ * D_ * 4);
    w.xa = (float*)take((size_t)T_ * D_ * 4);
    w.xb = (float*)take((size_t)T_ * D_ * 4);
    w.act = (float*)take((size_t)MROWS * D_ * 4);
    w.y = (float*)take((size_t)MROWS * D_ * 4);
    w.ffn = (float*)take((size_t)T_ * D_ * 4);
    w.topw = (float*)take((size_t)MROWS * 4);
    w.roww = (float*)take((size_t)MROWS * 4);
    w.sel = (int*)take((size_t)B_ * 2 * S_ * NSEL * 4);
    w.tope = (int*)take((size_t)MROWS * 4);
    w.pos = (int*)take((size_t)MROWS * 4);
    w.counts = (int*)take(256);
    w.meta = (int*)take((64 + 3 * 1100) * 4);
    w.rowtok = (int*)take((size_t)MROWS * 4);
    w.slot = (int*)take((size_t)MROWS * 4);
    return w;
}

struct In {
    const float *x, *w_in, *b_in, *pos_k, *pos_v, *w1k, *w2k, *w1v, *w2v, *g_out, *w_out, *ln1_g, *ln1_b, *rw, *rb, *wgu, *bgu, *wdn, *bdn, *ln2_g, *ln2_b;
};
inline In inputs(void* const* d) {
    In i; i.x = (const float*)d[0]; i.w_in = (const float*)d[1]; i.b_in = (const float*)d[2]; i.pos_k = (const float*)d[3]; i.pos_v = (const float*)d[4];
    i.w1k = (const float*)d[5]; i.w2k = (const float*)d[6]; i.w1v = (const float*)d[7]; i.w2v = (const float*)d[8]; i.g_out = (const float*)d[9]; i.w_out = (const float*)d[10];
    i.ln1_g = (const float*)d[11]; i.ln1_b = (const float*)d[12]; i.rw = (const float*)d[13]; i.rb = (const float*)d[14]; i.wgu = (const float*)d[15]; i.bgu = (const float*)d[16];
    i.wdn = (const float*)d[17]; i.bdn = (const float*)d[18]; i.ln2_g = (const float*)d[19]; i.ln2_b = (const float*)d[20]; return i;
}

inline void layer(const In& I, const WS& W, int l, const float* xin, float* xout, hipStream_t st) {
    gemm<<<dim3((DIN + 63) / 64, T_ / 64), 256, 0, st>>>(xin, D_, I.w_in + (size_t)l * D_ * DIN, DIN, W.proj, DIN, I.b_in + (size_t)l * DIN, T_, DIN, D_);
    fox_cumsum<<<B_ * 4, 256, 0, st>>>(W.proj, W.cfox);
    compress<<<dim3(NCMP, B_ * 2, 2), 128, 0, st>>>(W.proj, I.pos_k + (size_t)l * 2048, I.pos_v + (size_t)l * 2048, I.w1k + (size_t)l * 2048 * 128, I.w2k + (size_t)l * 128 * 64,
                                                  I.w1v + (size_t)l * 2048 * 128, I.w2v + (size_t)l * 128 * 64, W.kcmp, W.vcmp);
    attn_cmp<<<dim3(S_ / 256, B_ * 2), 256, 0, st>>>(W.proj, W.kcmp, W.vcmp, W.o, W.ptot);
    select_blocks<<<(B_ * 2 * S_ * 64) / 256, 256, 0, st>>>(W.ptot, W.sel);
    attn_sel<<<dim3(S_ / 256, B_ * 8), 256, 0, st>>>(W.proj, W.sel, W.o);
    attn_dense<1><<<dim3(S_ / 256, B_ * 8), 256, 0, st>>>(W.proj, nullptr, W.o);
    attn_dense<0><<<dim3(S_ / 256, B_ * 4), 256, 0, st>>>(W.proj, W.cfox, W.o);
    attn_sb<<<dim3(S_ / 256, B_ * 4), 256, 0, st>>>(W.proj, W.o);
    rmsnorm3<<<T_ * 64 / 256, 256, 0, st>>>(W.o, I.g_out + (size_t)l * D_);
    gemm<<<dim3(D_ / 64, T_ / 64), 256, 0, st>>>(W.o, D_, I.w_out + (size_t)l * D_ * D_, D_, W.mix, D_, nullptr, T_, D_, D_);
    hipMemsetAsync(W.counts, 0, 256, st);
    ln_res<true><<<T_ * 64 / 256, 256, 0, st>>>(xin, W.mix, I.ln1_g + (size_t)l * D_, I.ln1_b + (size_t)l * D_, W.x1, I.rw + (size_t)l * D_ * NE, I.rb + (size_t)l * NE,
                                                W.tope, W.topw, W.counts, W.pos);
    moe_plan<<<1, 64, 0, st>>>(W.counts, W.meta);
    moe_scatter<<<MROWS / 256, 256, 0, st>>>(W.tope, W.topw, W.pos, W.meta, W.rowtok, W.roww, W.slot);
    moe_gu<<<dim3(D_ / 64, MROWS / 64 + NE), 256, 0, st>>>(W.x1, I.wgu + (size_t)l * NE * D_ * 2048, I.bgu + (size_t)l * NE * 2048, W.meta, W.rowtok, W.act);
    moe_dn<<<dim3(D_ / 64, MROWS / 64 + NE), 256, 0, st>>>(W.act, I.wdn + (size_t)l * NE * D_ * D_, I.bdn + (size_t)l * NE * D_, W.meta, W.roww, W.y);
    moe_combine<<<T_ * 256 / 256, 256, 0, st>>>(W.y, W.slot, W.ffn);
    ln_res<false><<<T_ * 64 / 256, 256, 0, st>>>(W.x1, W.ffn, I.ln2_g + (size_t)l * D_, I.ln2_b + (size_t)l * D_, xout, nullptr, nullptr, nullptr, nullptr, nullptr, nullptr);
}

}
namespace mk {
using namespace nv;
constexpr int NT = 512;
__device__ __forceinline__ int ftid() { int t = threadIdx.x; asm volatile("" : "+v"(t)); return t; }
__device__ __forceinline__ int fbid() { int b = blockIdx.x; asm volatile("" : "+s"(b)); return b; }
#define MK_LOOP(vb, n) for (int vb = fbid(); vb < (n); vb += gridDim.x)

struct P {
    In in; WS w; float* out;
};

__device__ __forceinline__ void ph_gemm(float* lds, const float* __restrict__ A, int lda, const float* __restrict__ Bm, int ldb, float* __restrict__ C, int ldc,
                                        const float* __restrict__ bias, int M, int N, int K) {
    float (*As)[68] = (float (*)[68])lds; float (*Bs)[132] = (float (*)[132])(lds + 16 * 68);
    const int tid = ftid(), tx = tid & 31, ty = tid >> 5;
    const int ntn = (N + 127) / 128, nvb = (M / 64) * ntn;
    MK_LOOP(vb, nvb) {
        const int m0 = (vb / ntn) * 64, n0 = (vb % ntn) * 128;
        float acc[4][4];
#pragma unroll
        for (int i = 0; i < 4; ++i)
#pragma unroll
            for (int j = 0; j < 4; ++j) acc[i][j] = 0.f;
        for (int k0 = 0; k0 < K; k0 += 16) {
            if (tid < 256) { const int r = tid >> 2, kq = (tid & 3) * 4; const float4 a = *(const float4*)&A[(size_t)(m0 + r) * lda + k0 + kq];
                As[kq + 0][r] = a.x; As[kq + 1][r] = a.y; As[kq + 2][r] = a.z; As[kq + 3][r] = a.w; }
            { const int kk = tid >> 5, nq = (tid & 31) * 4; float4 b = make_float4(0.f, 0.f, 0.f, 0.f);
              if (n0 + nq < N) b = *(const float4*)&Bm[(size_t)(k0 + kk) * ldb + n0 + nq];
              *(float4*)&Bs[kk][nq] = b; }
            __syncthreads();
#pragma unroll
            for (int kk = 0; kk < 16; ++kk) {
                float a[4]; const float4 b4 = *(const float4*)&Bs[kk][tx * 4]; const float b[4] = {b4.x, b4.y, b4.z, b4.w};
#pragma unroll
                for (int i = 0; i < 4; ++i) a[i] = As[kk][ty * 4 + i];
#pragma unroll
                for (int i = 0; i < 4; ++i)
#pragma unroll
                    for (int j = 0; j < 4; ++j) acc[i][j] += a[i] * b[j];
            }
            __syncthreads();
        }
#pragma unroll
        for (int i = 0; i < 4; ++i)
#pragma unroll
            for (int j = 0; j < 4; ++j) { const int m = m0 + ty * 4 + i, n = n0 + tx * 4 + j; if (n < N) C[(size_t)m * ldc + n] = acc[i][j] + (bias ? bias[n] : 0.f); }
    }
}

__device__ __forceinline__ void ph_prep(float* lds, const P& p, int l) {
    const int tid = ftid();
    const float* proj = p.w.proj;
    constexpr int NCB = (NCMP + 3) / 4;
    constexpr int NV_CMP = NCB * B_ * 2 * 2;
    MK_LOOP(vb, NV_CMP + B_ * 4) {
        if (vb < NV_CMP) {
            float* blk = lds; float* hid = lds + 4 * 2048;
            const int kv = vb & 1, bg = (vb >> 1) & 3, nb = vb >> 3, b = bg >> 1, g = bg & 1;
            const float* pos = (kv ? p.in.pos_v : p.in.pos_k) + (size_t)l * 2048; const float* w1 = (kv ? p.in.w1v : p.in.w1k) + (size_t)l * 2048 * 128;
            const float* w2 = (kv ? p.in.w2v : p.in.w2k) + (size_t)l * 128 * 64; float* outp = kv ? p.w.vcmp : p.w.kcmp;
            __syncthreads();
            for (int i = tid; i < 4 * 2048; i += NT) { const int sub = i >> 11, e = i & 2047, ll = e >> 6, d = e & 63; int n = nb * 4 + sub; if (n >= NCMP) n = NCMP - 1;
                blk[i] = proj[(size_t)(b * S_ + 16 * n + ll) * DIN + OFF_NSA_KV + ((0 * 2 + kv) * 2 + g) * 64 + d] + pos[e]; }
            __syncthreads();
            const int sub = tid >> 7, j = tid & 127; const float* bl = blk + sub * 2048;
            float a = 0.f;
            for (int i = 0; i < 2048; ++i) a += bl[i] * w1[(size_t)i * 128 + j];
            hid[tid] = gelu_tanh(a);
            __syncthreads();
            const int n = nb * 4 + sub;
            if (j < 64 && n < NCMP) { float o = 0.f; for (int jj = 0; jj < 128; ++jj) o += hid[sub * 128 + jj] * w2[jj * 64 + j]; outp[((size_t)bg * NCMP + n) * 64 + j] = o; }
        } else {
            float* sh = lds; const int bh = vb - NV_CMP, b = bh >> 2, h = bh & 3; float carry = 0.f;
            for (int t0 = 0; t0 < S_; t0 += NT) {
                __syncthreads();
                sh[tid] = logsig(proj[(size_t)(b * S_ + t0 + tid) * DIN + OFF_FOX_F + h]); __syncthreads();
                for (int o = 1; o < NT; o <<= 1) { const float add = (tid >= o) ? sh[tid - o] : 0.f; __syncthreads(); sh[tid] += add; __syncthreads(); }
                p.w.cfox[(size_t)bh * S_ + t0 + tid] = carry + sh[tid];
                carry += sh[NT - 1];
            }
        }
    }
}

__device__ __forceinline__ void load_tile512(float (*dst)[64], const float* __restrict__ src, size_t stride, int nrows_valid) {
    const int tid = ftid(), r = tid >> 3, c0 = (tid & 7) * 8;
#pragma unroll
    for (int j = 0; j < 2; ++j) { float4 v = make_float4(0.f, 0.f, 0.f, 0.f); if (r < nrows_valid) v = *(const float4*)(src + (size_t)r * stride + c0 + 4 * j); *(float4*)&dst[r][c0 + 4 * j] = v; }
}

template <int KIND>
__device__ __forceinline__ void attn_vblock(float* lds, const P& p, int qb, int bh) {
    float (*Ks)[64] = (float (*)[64])lds; float (*Vs)[64] = (float (*)[64])(lds + 4096); float* Cs = lds + 8192;
    const float* proj = p.w.proj;
    const int tid = ftid(), q0 = qb * NT, t = q0 + tid;
    if (KIND == 0 || KIND == 1) {
        int b, h, qcol, kcol, vcol, ocol; float slope = 0.f;
        if (KIND == 0) { b = bh >> 2; h = bh & 3; qcol = OFF_FOX_QKV + h * 64; kcol = OFF_FOX_QKV + (4 + h) * 64; vcol = OFF_FOX_QKV + (8 + h) * 64; ocol = 512 + h * 64; }
        else { b = bh >> 3; h = bh & 7; const int g = h >> 2; qcol = h * 64; kcol = OFF_NSA_KV + ((2 * 2 + 0) * 2 + g) * 64; vcol = OFF_NSA_KV + ((2 * 2 + 1) * 2 + g) * 64; ocol = h * 64; slope = exp2f(-(float)(h + 1)); }
        const float* prow = proj + (size_t)(b * S_ + t) * DIN;
        float q[64], o[64];
#pragma unroll
        for (int d = 0; d < 64; ++d) { q[d] = prow[qcol + d] * SCALE; o[d] = 0.f; }
        float m = -1e30f, l = 0.f, ct = 0.f; const float* cb = p.w.cfox + (size_t)(b * 4 + (h & 3)) * S_;
        if (KIND == 0) ct = cb[t];
        int kt0 = 0; const int kt1 = (q0 + NT - 1) >> 6;
        if (KIND == 1) { kt0 = (q0 - 511) >> 6; if (kt0 < 0) kt0 = 0; }
        for (int kt = kt0; kt <= kt1; ++kt) {
            __syncthreads();
            load_tile512(Ks, proj + (size_t)(b * S_ + kt * 64) * DIN + kcol, DIN, 64);
            load_tile512(Vs, proj + (size_t)(b * S_ + kt * 64) * DIN + vcol, DIN, 64);
            if (KIND == 0 && tid < 64) Cs[tid] = cb[kt * 64 + tid];
            __syncthreads();
            for (int r = 0; r < 64; ++r) {
                const int s = kt * 64 + r; bool ok = (s <= t); if (KIND == 1) ok = ok && (t - s < 512);
                if (ok) { float sc; NV_DOT(q, Ks[r], sc); if (KIND == 0) sc += ct - Cs[r]; else sc -= slope * (float)(t - s); NV_ONLINE(sc, Vs[r]); }
            }
        }
        const float inv = (l > 0.f) ? 1.f / l : 0.f;
        float* orow = p.w.o + (size_t)(b * S_ + t) * D_ + ocol;
        if (KIND == 0) {
#pragma unroll
            for (int d = 0; d < 64; ++d) orow[d] = o[d] * inv;
        } else { const float gate = sigmoidf_(prow[OFF_NSA_GATE + 2 * 8 + h]);
#pragma unroll
            for (int d = 0; d < 64; ++d) orow[d] += gate * o[d] * inv; }
    } else if (KIND == 2) {
        const int b = bh >> 2, h = bh & 3;
        const int qcol = OFF_SB_QKV + h * 64, kcol = OFF_SB_QKV + (4 + h) * 64, vcol = OFF_SB_QKV + (8 + h) * 64, ocol = 768 + h * 64;
        const float* prow = proj + (size_t)(b * S_ + t) * DIN;
        float q[64], o[64];
#pragma unroll
        for (int d = 0; d < 64; ++d) { q[d] = prow[qcol + d] * SCALE; o[d] = 0.f; }
        float later = 0.f;
        for (int kt = (q0 + NT - 1) >> 6; kt >= 0; --kt) {
            __syncthreads();
            load_tile512(Ks, proj + (size_t)(b * S_ + kt * 64) * DIN + kcol, DIN, 64);
            load_tile512(Vs, proj + (size_t)(b * S_ + kt * 64) * DIN + vcol, DIN, 64);
            __syncthreads();
            for (int r = 63; r >= 0; --r) { const int s = kt * 64 + r;
                if (s < t) { float z; NV_DOT(q, Ks[r], z); const float a = expf(logsig(z) + later); NV_AXPY(o, a, Vs[r]); later += logsig(-z); } }
        }
        float* orow = p.w.o + (size_t)(b * S_ + t) * D_ + ocol;
#pragma unroll
        for (int d = 0; d < 64; ++d) orow[d] = o[d];
    } else {
        const int bg = bh, b = bg >> 1, g = bg & 1;
        const float* prow = proj + (size_t)(b * S_ + t) * DIN;
        float* prow_t = p.w.ptot + (size_t)(bg * S_ + t) * 512;
        int nmax = (q0 + NT - 1 - 31) / 16 + 1; if (nmax > NCMP) nmax = NCMP;
        const int ntile = (nmax + 63) / 64;
        for (int r4 = 0; r4 < 4; ++r4) {
            const int h = g * 4 + r4; const float slope = exp2f(-(float)(h + 1));
            float q[64], o[64];
#pragma unroll
            for (int d = 0; d < 64; ++d) { q[d] = prow[h * 64 + d] * SCALE; o[d] = 0.f; }
            float m = -1e30f, l = 0.f;
            for (int kt = 0; kt < ntile; ++kt) {
                __syncthreads();
                const int nvr = (NCMP - kt * 64) < 64 ? (NCMP - kt * 64) : 64;
                load_tile512(Ks, p.w.kcmp + ((size_t)bg * NCMP + kt * 64) * 64, 64, nvr);
                load_tile512(Vs, p.w.vcmp + ((size_t)bg * NCMP + kt * 64) * 64, 64, nvr);
                __syncthreads();
                for (int r = 0; r < nvr; ++r) { const int ce = 16 * (kt * 64 + r) + 31;
                    if (ce <= t) { float sc; NV_DOT(q, Ks[r], sc); sc -= slope * (float)(t - ce); NV_ONLINE(sc, Vs[r]); } }
            }
            const float inv = (l > 0.f) ? 1.f / l : 0.f;
            const float gate = sigmoidf_(prow[OFF_NSA_GATE + 0 * 8 + h]);
            float* orow = p.w.o + (size_t)(b * S_ + t) * D_ + h * 64;
#pragma unroll
            for (int d = 0; d < 64; ++d) orow[d] = gate * o[d] * inv;
            for (int kt = 0; kt < 8; ++kt) {
                __syncthreads();
                const int nvr = (NCMP - kt * 64) < 64 ? (NCMP - kt * 64) : 64;
                if (kt < ntile) load_tile512(Ks, p.w.kcmp + ((size_t)bg * NCMP + kt * 64) * 64, 64, nvr);
                __syncthreads();
                for (int r = 0; r < 64; ++r) { const int n = kt * 64 + r, ce = 16 * n + 31; float pp = 0.f;
                    if (kt < ntile && r < nvr && ce <= t) { float sc; NV_DOT(q, Ks[r], sc); sc -= slope * (float)(t - ce); pp = __expf(sc - m) * inv; }
                    if (r4 == 0) prow_t[n] = pp; else prow_t[n] += pp; }
            }
        }
    }
}
__device__ __forceinline__ void ph_attn_a(float* lds, const P& p) {
    constexpr int NQB = S_ / NT;
    constexpr int N_CMP = NQB * B_ * 2, N_FOX = NQB * B_ * 4, N_SB = NQB * B_ * 4;
    MK_LOOP(vb, N_CMP + N_FOX + N_SB) {
        if (vb < N_FOX) { const int qb = NQB - 1 - vb / (B_ * 4); attn_vblock<0>(lds, p, qb, vb % (B_ * 4)); }
        else if (vb < N_FOX + N_SB) { const int v = vb - N_FOX; const int qb = NQB - 1 - v / (B_ * 4); attn_vblock<2>(lds, p, qb, v % (B_ * 4)); }
        else { const int v = vb - N_FOX - N_SB; attn_vblock<3>(lds, p, v / (B_ * 2), v % (B_ * 2)); }
    }
}
__device__ __forceinline__ void ph_select(const P& p) {
    const int lane = ftid() & 63, wv = ftid() >> 6;
    for (int wave = fbid() * 8 + wv; wave < B_ * 2 * S_; wave += gridDim.x * 8) {
        const int t = wave % S_; const float* pt = p.w.ptot + (size_t)wave * 512; const int cur = t >> 6;
        float v[2];
#pragma unroll
        for (int k = 0; k < 2; ++k) { const int j = lane + 64 * k;
            float imp = pt[4 * j] + pt[4 * j + 1] + pt[4 * j + 2];
            if (4 * j + 3 < NCMP) imp += 0.5f * pt[4 * j + 3];
            if (j >= 1) imp += 0.5f * pt[4 * j - 1];
            const bool valid = j <= cur, forced = valid && (j == 0 || j >= cur - 1);
            v[k] = forced ? 3.0e38f : (valid ? imp : -3.0e38f); }
        for (int it = 0; it < NSEL; ++it) {
            float bv = v[0]; int bi = lane; if (v[1] > bv) { bv = v[1]; bi = lane + 64; }
#pragma unroll
            for (int o = 32; o >= 1; o >>= 1) { const float ov = __shfl_xor(bv, o); const int oi = __shfl_xor(bi, o); if (ov > bv || (ov == bv && oi < bi)) { bv = ov; bi = oi; } }
            if (lane == 0) p.w.sel[(size_t)wave * NSEL + it] = bi;
            if (bi == lane) v[0] = -3.4e38f;
            if (bi == lane + 64) v[1] = -3.4e38f;
        }
    }
}
__device__ __forceinline__ void ph_attn_sel(const P& p) {
    const float* proj = p.w.proj; const int tid = ftid();
    MK_LOOP(vb, (S_ / NT) * B_ * 8) {
        const int qb = vb / (B_ * 8), bh = vb % (B_ * 8), b = bh >> 3, h = bh & 7, g = h >> 2, t = qb * NT + tid;
        const float slope = exp2f(-(float)(h + 1));
        const float* prow = proj + (size_t)(b * S_ + t) * DIN;
        const int kcol = OFF_NSA_KV + ((1 * 2 + 0) * 2 + g) * 64, vcol = OFF_NSA_KV + ((1 * 2 + 1) * 2 + g) * 64;
        const int* sl = p.w.sel + ((size_t)(b * 2 + g) * S_ + t) * NSEL;
        float q[64], o[64];
#pragma unroll
        for (int d = 0; d < 64; ++d) { q[d] = prow[h * 64 + d] * SCALE; o[d] = 0.f; }
        float m = -1e30f, l = 0.f;
        for (int i = 0; i < NSEL; ++i) { const int blk = sl[i];
            for (int r = 0; r < 64; ++r) { const int s = blk * 64 + r;
                if (s <= t) { const float* kr = proj + (size_t)(b * S_ + s) * DIN + kcol; const float* vr = proj + (size_t)(b * S_ + s) * DIN + vcol;
                    float sc = 0.f;
#pragma unroll
                    for (int c = 0; c < 4; ++c) { float4 k4[4];
#pragma unroll
                        for (int u = 0; u < 4; ++u) k4[u] = *(const float4*)&kr[c * 16 + u * 4];
#pragma unroll
                        for (int u = 0; u < 4; ++u) { sc += q[c * 16 + u * 4] * k4[u].x; sc += q[c * 16 + u * 4 + 1] * k4[u].y; sc += q[c * 16 + u * 4 + 2] * k4[u].z; sc += q[c * 16 + u * 4 + 3] * k4[u].w; }
                        asm volatile("" : "+v"(sc)); }
                    sc -= slope * (float)(t - s);
                    if (sc > m) { const float al = __expf(m - sc); l *= al;
#pragma unroll
                        for (int d = 0; d < 64; ++d) o[d] *= al;
                        m = sc; }
                    const float pp = __expf(sc - m); l += pp;
#pragma unroll
                    for (int c = 0; c < 4; ++c) { float4 v4[4];
#pragma unroll
                        for (int u = 0; u < 4; ++u) v4[u] = *(const float4*)&vr[c * 16 + u * 4];
#pragma unroll
                        for (int u = 0; u < 4; ++u) { o[c * 16 + u * 4] += pp * v4[u].x; o[c * 16 + u * 4 + 1] += pp * v4[u].y; o[c * 16 + u * 4 + 2] += pp * v4[u].z; o[c * 16 + u * 4 + 3] += pp * v4[u].w; }
                        asm volatile("" : "+v"(o[c * 16])); }
                } } }
        const float inv = (l > 0.f) ? 1.f / l : 0.f; const float gate = sigmoidf_(prow[OFF_NSA_GATE + 1 * 8 + h]);
        float* orow = p.w.o + (size_t)(b * S_ + t) * D_ + h * 64;
#pragma unroll
        for (int d = 0; d < 64; ++d) orow[d] += gate * o[d] * inv;
    }
}
__device__ __forceinline__ void ph_attn_win(float* lds, const P& p) {
    MK_LOOP(vb, (S_ / NT) * B_ * 8) attn_vblock<1>(lds, p, vb / (B_ * 8), vb % (B_ * 8));
}
__device__ __forceinline__ void ph_rmsnorm(const P& p, int l) {
    const int lane = ftid() & 63, wv = ftid() >> 6; const float* g = p.in.g_out + (size_t)l * D_;
    for (int row = fbid() * 8 + wv; row < T_; row += gridDim.x * 8) {
        float* r = p.w.o + (size_t)row * D_; float a[8], s = 0.f;
#pragma unroll
        for (int i = 0; i < 8; ++i) { a[i] = r[lane + 64 * i]; s += a[i] * a[i]; }
        float sc = rsqrtf(wsum(s) * (1.f / 512.f) + RMS_EPS);
#pragma unroll
        for (int i = 0; i < 8; ++i) r[lane + 64 * i] = a[i] * sc * g[lane + 64 * i];
#pragma unroll
        for (int seg = 0; seg < 2; ++seg) { const int c0 = 512 + 256 * seg; s = 0.f;
#pragma unroll
            for (int i = 0; i < 4; ++i) { a[i] = r[c0 + lane + 64 * i]; s += a[i] * a[i]; }
            sc = rsqrtf(wsum(s) * (1.f / 256.f) + RMS_EPS);
#pragma unroll
            for (int i = 0; i < 4; ++i) r[c0 + lane + 64 * i] = a[i] * sc * g[c0 + lane + 64 * i]; }
    }
}
template <bool ROUTER, bool COMBINE>
__device__ __forceinline__ void ph_ln(float* lds, const P& p, int l, const float* __restrict__ x, const float* __restrict__ add, const float* __restrict__ g, const float* __restrict__ bb, float* __restrict__ y) {
    const int lane = ftid() & 63, wv = ftid() >> 6;
    for (int row = fbid() * 8 + wv; row < T_; row += gridDim.x * 8) {
        float v[16], s = 0.f;
#pragma unroll
        for (int i = 0; i < 16; ++i) { const int c = lane + 64 * i; float a;
            if (COMBINE) { a = 0.f;
#pragma unroll
                for (int k = 0; k < TOPK; ++k) a += p.w.y[(size_t)p.w.slot[row * TOPK + k] * D_ + c]; }
            else a = add[(size_t)row * D_ + c];
            v[i] = ALPHA * x[(size_t)row * D_ + c] + a; s += v[i]; }
        const float mu = wsum(s) * (1.f / D_); float s2 = 0.f;
#pragma unroll
        for (int i = 0; i < 16; ++i) { v[i] -= mu; s2 += v[i] * v[i]; }
        const float rstd = rsqrtf(wsum(s2) * (1.f / D_) + LN_EPS);
#pragma unroll
        for (int i = 0; i < 16; ++i) { const int c = lane + 64 * i; v[i] = v[i] * rstd * g[c] + bb[c]; y[(size_t)row * D_ + c] = v[i]; }
        if (ROUTER) {
            const float* rw = p.in.rw + (size_t)l * D_ * NE; const float* rb = p.in.rb + (size_t)l * NE; int* counts = p.w.counts + l * 32;
            float* rowl = lds + wv * 1024;
#pragma unroll
            for (int i = 0; i < 16; ++i) rowl[lane + 64 * i] = v[i];
            asm volatile("s_waitcnt lgkmcnt(0)" ::: "memory");
            const int e = lane & 31, half = lane >> 5; float lg = 0.f;
            for (int k = 0; k < 512; ++k) lg += rowl[half * 512 + k] * rw[(size_t)(half * 512 + k) * NE + e];
            lg += __shfl_xor(lg, 32); lg += rb[e];
            float cur = lg, tv0 = 0.f, den = 0.f, myw = 0.f; int mye = 0;
#pragma unroll
            for (int k = 0; k < TOPK; ++k) { float bv = cur; int bi = e;
#pragma unroll
                for (int o = 16; o >= 1; o >>= 1) { const float ov = __shfl_xor(bv, o); const int oi = __shfl_xor(bi, o); if (ov > bv || (ov == bv && oi < bi)) { bv = ov; bi = oi; } }
                if (k == 0) tv0 = bv;
                const float w = __expf(bv - tv0); den += w;
                if (lane == k) { mye = bi; myw = w; }
                if (e == bi) cur = -3.4e38f; }
            if (lane < TOPK) { p.w.tope[row * TOPK + lane] = mye; p.w.topw[row * TOPK + lane] = myw / den; p.w.pos[row * TOPK + lane] = atomicAdd(&counts[mye], 1); }
            asm volatile("s_waitcnt lgkmcnt(0)" ::: "memory");
        }
    }
}
__device__ __forceinline__ void ph_moe_plan(const P& p, int l) {
    if (fbid() == 0 && ftid() == 0) { const int* counts = p.w.counts + l * 32; int* meta = p.w.meta; int off = 0, nt = 0;
        for (int e = 0; e < NE; ++e) { meta[e] = off; const int c = counts[e];
            for (int r = 0; r < c; r += 64) { meta[64 + 3 * nt] = e; meta[64 + 3 * nt + 1] = off + r; meta[64 + 3 * nt + 2] = (c - r) < 64 ? (c - r) : 64; ++nt; }
            off += c; }
        meta[32] = nt; }
}
__device__ __forceinline__ void ph_moe_scatter(const P& p) {
    for (int i = fbid() * NT + ftid(); i < MROWS; i += gridDim.x * NT) {
        const int row = p.w.meta[p.w.tope[i]] + p.w.pos[i];
        p.w.rowtok[row] = i >> 2; p.w.roww[row] = p.w.topw[i]; p.w.slot[i] = row; }
}
__device__ __forceinline__ void ph_moe_gu(float* lds, const P& p, int l) {
    float (*As)[68] = (float (*)[68])lds; float (*Bs)[132] = (float (*)[132])(lds + 16 * 68);
    const int tid = ftid(), tx = tid & 15, ty = tid >> 4;
    const int ntiles = p.w.meta[32];
    MK_LOOP(vb, ntiles * 16) {
        const int ti = vb >> 4, n0 = (vb & 15) * 64;
        const int e = p.w.meta[64 + 3 * ti], r0 = p.w.meta[64 + 3 * ti + 1], nr = p.w.meta[64 + 3 * ti + 2];
        const float* W = p.in.wgu + ((size_t)l * NE + e) * D_ * 2048; const float* bgu = p.in.bgu + ((size_t)l * NE + e) * 2048;
        const int lr = (tid >> 2) & 63; const int tok = p.w.rowtok[r0 + (lr < nr ? lr : 0)]; const float* arow = p.w.x1 + (size_t)tok * D_;
        float ag[2][4], au[2][4];
#pragma unroll
        for (int i = 0; i < 2; ++i)
#pragma unroll
            for (int j = 0; j < 4; ++j) { ag[i][j] = 0.f; au[i][j] = 0.f; }
        for (int k0 = 0; k0 < D_; k0 += 16) {
            if (tid < 256) { const int kq = (tid & 3) * 4; const float4 a = *(const float4*)&arow[k0 + kq]; As[kq + 0][lr] = a.x; As[kq + 1][lr] = a.y; As[kq + 2][lr] = a.z; As[kq + 3][lr] = a.w; }
            { const int kk = tid >> 5, nq = (tid & 31) * 4; const int col = (nq < 64) ? (n0 + nq) : (1024 + n0 + nq - 64);
              *(float4*)&Bs[kk][nq] = *(const float4*)&W[(size_t)(k0 + kk) * 2048 + col]; }
            __syncthreads();
#pragma unroll
            for (int kk = 0; kk < 16; ++kk) { const float a0 = As[kk][ty * 2], a1 = As[kk][ty * 2 + 1];
                const float4 g4 = *(const float4*)&Bs[kk][tx * 4]; const float4 u4 = *(const float4*)&Bs[kk][64 + tx * 4];
                ag[0][0] += a0 * g4.x; ag[0][1] += a0 * g4.y; ag[0][2] += a0 * g4.z; ag[0][3] += a0 * g4.w; ag[1][0] += a1 * g4.x; ag[1][1] += a1 * g4.y; ag[1][2] += a1 * g4.z; ag[1][3] += a1 * g4.w;
                au[0][0] += a0 * u4.x; au[0][1] += a0 * u4.y; au[0][2] += a0 * u4.z; au[0][3] += a0 * u4.w; au[1][0] += a1 * u4.x; au[1][1] += a1 * u4.y; au[1][2] += a1 * u4.z; au[1][3] += a1 * u4.w; }
            __syncthreads();
        }
#pragma unroll
        for (int i = 0; i < 2; ++i) { const int r = ty * 2 + i; if (r < nr) {
#pragma unroll
            for (int j = 0; j < 4; ++j) { const int n = n0 + tx * 4 + j; const float gt = fminf(ag[i][j] + bgu[n], 7.0f); const float up = fminf(fmaxf(au[i][j] + bgu[1024 + n], -7.0f), 7.0f);
                p.w.act[(size_t)(r0 + r) * D_ + n] = gt * sigmoidf_(1.702f * gt) * (up + 1.0f); } } }
    }
}
__device__ __forceinline__ void ph_moe_dn(float* lds, const P& p, int l) {
    float (*As)[68] = (float (*)[68])lds; float (*Bs)[132] = (float (*)[132])(lds + 16 * 68);
    const int tid = ftid(), tx = tid & 31, ty = tid >> 5;
    const int ntiles = p.w.meta[32];
    MK_LOOP(vb, ntiles * 8) {
        const int ti = vb >> 3, n0 = (vb & 7) * 128;
        const int e = p.w.meta[64 + 3 * ti], r0 = p.w.meta[64 + 3 * ti + 1], nr = p.w.meta[64 + 3 * ti + 2];
        const float* W = p.in.wdn + ((size_t)l * NE + e) * D_ * D_; const float* bdn = p.in.bdn + ((size_t)l * NE + e) * D_;
        const int lr = (tid >> 2) & 63; const float* arow = p.w.act + (size_t)(r0 + (lr < nr ? lr : 0)) * D_;
        float acc[4][4];
#pragma unroll
        for (int i = 0; i < 4; ++i)
#pragma unroll
            for (int j = 0; j < 4; ++j) acc[i][j] = 0.f;
        for (int k0 = 0; k0 < D_; k0 += 16) {
            if (tid < 256) { const int kq = (tid & 3) * 4; const float4 a = *(const float4*)&arow[k0 + kq]; As[kq + 0][lr] = a.x; As[kq + 1][lr] = a.y; As[kq + 2][lr] = a.z; As[kq + 3][lr] = a.w; }
            { const int kk = tid >> 5, nq = (tid & 31) * 4; *(float4*)&Bs[kk][nq] = *(const float4*)&W[(size_t)(k0 + kk) * D_ + n0 + nq]; }
            __syncthreads();
#pragma unroll
            for (int kk = 0; kk < 16; ++kk) { float a[4]; const float4 b4 = *(const float4*)&Bs[kk][tx * 4]; const float b[4] = {b4.x, b4.y, b4.z, b4.w};
#pragma unroll
                for (int i = 0; i < 4; ++i) a[i] = As[kk][ty * 4 + i];
#pragma unroll
                for (int i = 0; i < 4; ++i)
#pragma unroll
                    for (int j = 0; j < 4; ++j) acc[i][j] += a[i] * b[j]; }
            __syncthreads();
        }
#pragma unroll
        for (int i = 0; i < 4; ++i) { const int r = ty * 4 + i; if (r < nr) { const float w = p.w.roww[r0 + r];
#pragma unroll
            for (int j = 0; j < 4; ++j) { const int n = n0 + tx * 4 + j; p.w.y[(size_t)(r0 + r) * D_ + n] = (acc[i][j] + bdn[n]) * w; } } }
    }
}
}
namespace cg = cooperative_groups;
__global__ void __launch_bounds__(512, 2) mega(mk::P p) {
    extern __shared__ __attribute__((aligned(16))) unsigned char lds_raw[];
    float* lds = (float*)lds_raw;
    cg::grid_group grid = cg::this_grid();
    using namespace nv;
    for (int l = 0; l < 2; ++l) {
        const float* xin = (l == 0) ? p.in.x : p.w.xa; float* xout = (l == 1) ? p.out : p.w.xa;
#ifndef NOPH0
        mk::ph_gemm(lds, xin, D_, p.in.w_in + (size_t)l * D_ * DIN, DIN, p.w.proj, DIN, p.in.b_in + (size_t)l * DIN, T_, DIN, D_); grid.sync();
#endif
#ifndef NOPH1
        mk::ph_prep(lds, p, l); grid.sync();
#endif
#ifndef NOPH2
        mk::ph_attn_a(lds, p); grid.sync();
#endif
#ifndef NOPH3
        mk::ph_select(p); grid.sync();
#endif
#ifndef NOPH4
        mk::ph_attn_sel(p); grid.sync();
#endif
#ifndef NOPH5
        mk::ph_attn_win(lds, p); grid.sync();
#endif
#ifndef NOPH6
        mk::ph_rmsnorm(p, l); grid.sync();
#endif
#ifndef NOPH7
        mk::ph_gemm(lds, p.w.o, D_, p.in.w_out + (size_t)l * D_ * D_, D_, p.w.mix, D_, nullptr, T_, D_, D_); grid.sync();
#endif
#ifndef NOPH8
        mk::ph_ln<true, false>(lds, p, l, xin, p.w.mix, p.in.ln1_g + (size_t)l * D_, p.in.ln1_b + (size_t)l * D_, p.w.x1); grid.sync();
#endif
#ifndef NOPH9
        mk::ph_moe_plan(p, l); grid.sync();
#endif
#ifndef NOPH10
        mk::ph_moe_scatter(p); grid.sync();
#endif
#ifndef NOPH11
        mk::ph_moe_gu(lds, p, l); grid.sync();
#endif
#ifndef NOPH12
        mk::ph_moe_dn(lds, p, l); grid.sync();
#endif
#ifndef NOPH13
        mk::ph_ln<false, true>(lds, p, l, p.w.x1, nullptr, p.in.ln2_g + (size_t)l * D_, p.in.ln2_b + (size_t)l * D_, xout); grid.sync();
#endif
    }
}

extern "C" void kernel_launch(void* const* d_in, const int* in_sizes, int n_in,
                              void* d_out, int out_size, void* d_ws, size_t ws_size,
                              hipStream_t stream) {
    constexpr size_t kDynLds = 65536;
    static int grid_blocks = 0;
    if (!grid_blocks) {
        int dev = 0, cus = 0, per_cu = 0;
        (void)hipGetDevice(&dev);
        (void)hipDeviceGetAttribute(&cus, hipDeviceAttributeMultiprocessorCount, dev);
        (void)hipFuncSetAttribute((const void*)mega, hipFuncAttributeMaxDynamicSharedMemorySize, (int)kDynLds);
        (void)hipOccupancyMaxActiveBlocksPerMultiprocessor(&per_cu, mega, 512, kDynLds);
        if (per_cu < 1) per_cu = 1;
        if (per_cu > 1) per_cu = 1;
        grid_blocks = cus * per_cu;
    }
    mk::P p{};
    p.in = nv::inputs(d_in); p.w = nv::carve(d_ws, 0); p.out = (float*)d_out;
    (void)hipMemsetAsync(p.w.counts, 0, 256, stream);
    void* args[] = {&p};
    hipError_t e = hipLaunchCooperativeKernel((void*)mega, dim3(grid_blocks), dim3(512), args, kDynLds, stream);
    if (e != hipSuccess) fprintf(stderr, "cooperative launch failed: %s (grid %d)\n", hipGetErrorString(e), grid_blocks);
}
```

```cpp
#include <hip/hip_runtime.h>
#include <hip/hip_cooperative_groups.h>
#include <cstdio>
#include <cstdint>
namespace nv {

constexpr int B_ = 2, S_ = 8192, D_ = 1024, T_ = B_ * S_, L_ = 2;
constexpr int DIN = 2844;
constexpr int OFF_NSA_KV = 512, OFF_NSA_GATE = 1280, OFF_FOX_QKV = 1304, OFF_FOX_F = 2072, OFF_SB_QKV = 2076;
constexpr int NCMP = 511, NBLK = 128, NSEL = 16;
constexpr int NE = 32, TOPK = 4, MROWS = T_ * TOPK;
constexpr float LN_EPS = 1e-5f, RMS_EPS = 1e-6f;
constexpr float ALPHA = 1.4142135623730951f;
constexpr float SCALE = 0.125f;

__device__ __forceinline__ float sigmoidf_(float x) { return 1.f / (1.f + __expf(-x)); }
__device__ __forceinline__ float logsig(float x) { return fminf(x, 0.f) - log1pf(expf(-fabsf(x))); }

__device__ __forceinline__ float gelu_tanh(float x) { return 0.5f * x * (1.f + tanhf(0.7978845608028654f * (x + 0.044715f * x * x * x))); }
#define NV_DOT(q, kr, res) do { float s0_ = 0.f, s1_ = 0.f, s2_ = 0.f, s3_ = 0.f; _Pragma("unroll") for (int d_ = 0; d_ < 64; d_ += 4) { const float4 k4_ = *(const float4*)&(kr)[d_]; s0_ += q[d_] * k4_.x; s1_ += q[d_ + 1] * k4_.y; s2_ += q[d_ + 2] * k4_.z; s3_ += q[d_ + 3] * k4_.w; } res = (s0_ + s1_) + (s2_ + s3_); } while (0)
#define NV_AXPY(o, p, vr) do { _Pragma("unroll") for (int d_ = 0; d_ < 64; d_ += 4) { const float4 v4_ = *(const float4*)&(vr)[d_]; o[d_] += p * v4_.x; o[d_ + 1] += p * v4_.y; o[d_ + 2] += p * v4_.z; o[d_ + 3] += p * v4_.w; } } while (0)
#define NV_ONLINE(sc, vr) do { if (sc > m) { const float al_ = __expf(m - sc); l *= al_; _Pragma("unroll") for (int d_ = 0; d_ < 64; ++d_) o[d_] *= al_; m = sc; } const float p_ = __expf(sc - m); l += p_; NV_AXPY(o, p_, vr); } while (0)

__device__ __forceinline__ float wsum(float v) {
#pragma unroll
    for (int o = 1; o < 64; o <<= 1) v += __shfl_xor(v, o);
    return v;
}
struct In {
    const float *x, *w_in, *b_in, *pos_k, *pos_v, *w1k, *w2k, *w1v, *w2v, *g_out, *w_out, *ln1_g, *ln1_b, *rw, *rb, *wgu, *bgu, *wdn, *bdn, *ln2_g, *ln2_b;
};
inline In inputs(void* const* d) {
    In i; i.x = (const float*)d[0]; i.w_in = (const float*)d[1]; i.b_in = (const float*)d[2]; i.pos_k = (const float*)d[3]; i.pos_v = (const float*)d[4];
    i.w1k = (const float*)d[5]; i.w2k = (const float*)d[6]; i.w1v = (const float*)d[7]; i.w2v = (const float*)d[8]; i.g_out = (const float*)d[9]; i.w_out = (const float*)d[10];
    i.ln1_g = (const float*)d[11]; i.ln1_b = (const float*)d[12]; i.rw = (const float*)d[13]; i.rb = (const float*)d[14]; i.wgu = (const float*)d[15]; i.bgu = (const float*)d[16];
    i.wdn = (const float*)d[17]; i.bdn = (const float*)d[18]; i.ln2_g = (const float*)d[19]; i.ln2_b = (const float*)d[20]; return i;
}


}
namespace pg8 {
#define PG8_LAS __attribute__((address_space(3)))
typedef unsigned short bf16_t;
typedef short bf16x8 __attribute__((ext_vector_type(8)));
typedef float f32x4 __attribute__((ext_vector_type(4)));
typedef unsigned u32x4 __attribute__((ext_vector_type(4)));
constexpr int BM = 256, BK = 64, HALF = 128, HTB = HALF * BK * 2  , STAGE_BYTES = 8 * HTB, NXCD = 8, WGM = 8;

__host__ __device__ __forceinline__ int lds_byte(int r, int c) { const int st = (r >> 4) * 2 + (c >> 5), rr = r & 15, cc = c & 31, ob = rr * 64 + cc * 2; return st * 1024 + (ob ^ (((ob >> 9) & 1) << 5)); }
__host__ __device__ __forceinline__ void stage_rc(int b, int& R, int& C) { const int st = b / 1024, sb = b % 1024, swz = sb ^ (((sb >> 9) & 1) << 5); R = (st >> 1) * 16 + swz / 64; C = (st & 1) * 32 + (swz % 64) / 2; }
__host__ __device__ __forceinline__ int perm32(int rho) { const int n = rho >> 4, i = rho & 15; return 8 * (i >> 2) + 4 * n + (i & 3); }

struct Unit { int pm, pn, e, nr; };

struct StaticOrder {
    int nM, nN, nwg, G, c;
    __host__ __device__ void init(int M, int N, int G_, int c_) { nM = M / BM; nN = N / BM; nwg = nM * nN; G = G_; c = c_; }
    __host__ __device__ bool next(int i, Unit& u) const {
        const long L = (long)i * G + c; if (L >= nwg) return false;
        int wgid = (int)L; { const int q = nwg / NXCD, r = nwg % NXCD, xcd = wgid % NXCD, off = wgid / NXCD; wgid = (xcd < r ? xcd * (q + 1) : r * (q + 1) + (xcd - r) * q) + off; }
        const int nig = WGM * nN, gid = wgid / nig, fm = gid * WGM, gsz = (nM - fm) < WGM ? (nM - fm) : WGM;
        u.pm = fm + ((wgid % nig) % gsz); u.pn = (wgid % nig) / gsz; u.e = 0; u.nr = BM; return true;
    }
    const char* Bt; size_t tstep;
    __device__ __forceinline__ unsigned a_row(const Unit& u, int r) const { return (unsigned)(u.pm * BM + r); }
    __device__ __forceinline__ const char* b_base(const Unit& u) const { return Bt + (size_t)u.pn * tstep; }
};


__device__ __forceinline__ unsigned cvt_pk_bf16(float lo, float hi) { unsigned r; asm volatile("v_cvt_pk_bf16_f32 %0, %1, %2" : "=v"(r) : "v"(lo), "v"(hi)); return r; }
template <class Epi, class Sched, bool ALIGN_EPI = true, bool SP2 = true>
__device__ __forceinline__ void gemm_phase(PG8_LAS unsigned char* lds, const char* Abase, const int K, const Sched& S, const Epi& E) {
    int tid_ = threadIdx.x; asm volatile("" : "+v"(tid_));
    const int tid = tid_, wid = __builtin_amdgcn_readfirstlane(tid >> 6), lane = tid & 63, wr = wid >> 2, wc = wid & 3, fr = lane & 15, fq = lane >> 4;
    const int nt = K / BK;
    unsigned voffB[2];
#pragma unroll
    for (int i = 0; i < 2; ++i) { int R, C; stage_rc(tid * 16 + i * 8192, R, C); const int Rb = Epi::PERM ? ((R & ~31) + perm32(R & 31)) : R;
        voffB[i] = (unsigned)(Rb * K + C) * 2u; }
#define PG8_AOFF(u, o0, o1) do { int _t = tid; asm volatile("" : "+v"(_t)); _Pragma("unroll") for (int _i = 0; _i < 2; ++_i) { int _R, _C; stage_rc(_t * 16 + _i * 8192, _R, _C); \
        (o0)[_i] = (S.a_row((u), _R) * (unsigned)K + (unsigned)_C) * 2u; (o1)[_i] = (S.a_row((u), HALF + _R) * (unsigned)K + (unsigned)_C) * 2u; } } while (0)
    const size_t kstep = (size_t)(BK * 2);
    const size_t hstep = (size_t)HALF * K * 2;
    const unsigned ldsw = (unsigned)wid * 1024u;
    const int aoff = lds_byte(wr * 64 + fr, fq * 8), boff = lds_byte(wc * 32 + fr, fq * 8);
#define PG8_SA(b, h) (((b) * 2 + (h)) * HTB)
#define PG8_SB(b, h) ((4 + (b) * 2 + (h)) * HTB)
#define PG8_STAGE(bufoff, gbase, voff) do { _Pragma("unroll") for (int _i = 0; _i < 2; ++_i) { unsigned _o = (voff)[_i]; asm volatile("" : "+v"(_o));     \
        __builtin_amdgcn_global_load_lds((const unsigned*)((const char*)(gbase) + _o), (PG8_LAS unsigned*)(lds + (bufoff) + ldsw + _i * 8192), 16, 0, 0); } } while (0)
#define PG8_LDA(dst, b, h) do { _Pragma("unroll") for (int m = 0; m < 4; ++m) _Pragma("unroll") for (int k = 0; k < 2; ++k) dst[m][k] = *(const PG8_LAS bf16x8*)(lds + PG8_SA(b, h) + aoff + m * 2048 + k * 1024); } while (0)
#define PG8_LDB(dst, b, h) do { _Pragma("unroll") for (int n = 0; n < 2; ++n) _Pragma("unroll") for (int k = 0; k < 2; ++k) dst[n][k] = *(const PG8_LAS bf16x8*)(lds + PG8_SB(b, h) + boff + n * 2048 + k * 1024); } while (0)
#define PG8_MMA(ai, bj, At, Bt) do { __builtin_amdgcn_s_setprio(1); _Pragma("unroll") for (int m = 0; m < 4; ++m) _Pragma("unroll") for (int n = 0; n < 2; ++n) _Pragma("unroll") for (int k = 0; k < 2; ++k) \
        acc[ai][bj][m][n] = __builtin_amdgcn_mfma_f32_16x16x32_bf16(Bt[n][k], At[m][k], acc[ai][bj][m][n], 0, 0, 0); __builtin_amdgcn_s_setprio(0); } while (0)
#define PG8_WAIT_V(n) asm volatile("s_waitcnt vmcnt(" #n ")" ::: "memory")
#define PG8_WAIT_L(n) asm volatile("s_waitcnt lgkmcnt(" #n ")" ::: "memory")
#define PG8_BAR __builtin_amdgcn_s_barrier()
#define PG8_SCHED __builtin_amdgcn_sched_barrier(0)
    Unit cur, nxt; int ui = 0;
    if (!S.next(0, cur)) return;
    f32x4 acc[2][2][4][2];
#pragma unroll
    for (int a = 0; a < 2; ++a)
#pragma unroll
        for (int b = 0; b < 2; ++b)
#pragma unroll
            for (int m = 0; m < 4; ++m)
#pragma unroll
                for (int n = 0; n < 2; ++n) acc[a][b][m][n] = (f32x4){0.f, 0.f, 0.f, 0.f};
    bf16x8 At[4][2], B0[2][2], B1[2][2];
    unsigned ca0[2], ca1[2], na0[2], na1[2];
    PG8_AOFF(cur, ca0, ca1);
    const char* const cA = Abase; const char* cB = S.b_base(cur);
    if constexpr (SP2) {
        PG8_STAGE(PG8_SB(0, 0), cB, voffB); PG8_STAGE(PG8_SB(0, 1), cB + hstep, voffB); PG8_STAGE(PG8_SA(0, 0), cA, ca0); PG8_STAGE(PG8_SA(0, 1), cA, ca1);
        if (wr == 1) PG8_BAR;
        PG8_WAIT_V(2); PG8_BAR;
        PG8_STAGE(PG8_SB(1, 0), cB + kstep, voffB); PG8_STAGE(PG8_SA(1, 0), cA + kstep, ca0); PG8_STAGE(PG8_SB(1, 1), cB + hstep + kstep, voffB);
        PG8_WAIT_V(6); PG8_BAR;
    } else { static_assert(SP2, "only the SP2 loop is kept"); }
    for (;;) {
        const bool has_next = S.next(ui + 1, nxt);
        const char* nB = has_next ? S.b_base(nxt) : cB;
        if (has_next) { PG8_AOFF(nxt, na0, na1); } else { na0[0] = ca0[0]; na0[1] = ca0[1]; na1[0] = ca1[0]; na1[1] = ca1[1]; }
        for (int t = 0; t < nt - 2; t += 2) {
            const char* a1 = cA + (size_t)(t + 1) * kstep;
            const char* a2 = cA + (size_t)(t + 2) * kstep; const char* b2 = cB + (size_t)(t + 2) * kstep;
            const char* a3 = a2 + kstep; const char* b3 = b2 + kstep;
            PG8_LDB(B0, 0, 0); PG8_LDB(B1, 0, 1); PG8_SCHED; PG8_LDA(At, 0, 0); PG8_STAGE(PG8_SA(1, 1), a1, ca1);
            PG8_WAIT_V(8); PG8_WAIT_L(0); PG8_BAR; PG8_MMA(0, 0, At, B0); PG8_MMA(0, 1, At, B1); PG8_BAR; PG8_SCHED;
            PG8_LDA(At, 0, 1); PG8_STAGE(PG8_SB(0, 0), b2, voffB); PG8_STAGE(PG8_SB(0, 1), b2 + hstep, voffB); PG8_STAGE(PG8_SA(0, 0), a2, ca0);
            PG8_WAIT_V(8); PG8_WAIT_L(0); PG8_BAR; PG8_MMA(1, 0, At, B0); PG8_MMA(1, 1, At, B1); PG8_BAR; PG8_SCHED;
            PG8_LDB(B0, 1, 0); PG8_LDB(B1, 1, 1); PG8_SCHED; PG8_LDA(At, 1, 0); PG8_STAGE(PG8_SA(0, 1), a2, ca1);
            PG8_WAIT_V(8); PG8_WAIT_L(0); PG8_BAR; PG8_MMA(0, 0, At, B0); PG8_MMA(0, 1, At, B1); PG8_BAR; PG8_SCHED;
            PG8_LDA(At, 1, 1); PG8_STAGE(PG8_SB(1, 0), b3, voffB); PG8_STAGE(PG8_SB(1, 1), b3 + hstep, voffB); PG8_STAGE(PG8_SA(1, 0), a3, ca0);
            PG8_WAIT_V(8); PG8_WAIT_L(0); PG8_BAR; PG8_MMA(1, 0, At, B0); PG8_MMA(1, 1, At, B1); PG8_BAR; PG8_SCHED;
        }
        {
            const char* a1 = cA + (size_t)(nt - 1) * kstep;
            const char* a2 = cA; const char* b2 = nB; const char* a3 = a2 + kstep; const char* b3 = b2 + kstep;
            PG8_LDB(B0, 0, 0); PG8_LDB(B1, 0, 1); PG8_SCHED; PG8_LDA(At, 0, 0); PG8_STAGE(PG8_SA(1, 1), a1, ca1);
            PG8_WAIT_V(8); PG8_WAIT_L(0); PG8_BAR; PG8_MMA(0, 0, At, B0); PG8_MMA(0, 1, At, B1); PG8_BAR; PG8_SCHED;
            PG8_LDA(At, 0, 1); PG8_STAGE(PG8_SB(0, 0), b2, voffB); PG8_STAGE(PG8_SB(0, 1), b2 + hstep, voffB); PG8_STAGE(PG8_SA(0, 0), a2, na0);
            PG8_WAIT_V(8); PG8_WAIT_L(0); PG8_BAR; PG8_MMA(1, 0, At, B0); PG8_MMA(1, 1, At, B1); PG8_BAR; PG8_SCHED;
            PG8_LDB(B0, 1, 0); PG8_LDB(B1, 1, 1); PG8_SCHED; PG8_LDA(At, 1, 0); PG8_STAGE(PG8_SA(0, 1), a2, na1);
            PG8_WAIT_V(8); PG8_WAIT_L(0); PG8_BAR; PG8_MMA(0, 0, At, B0); PG8_MMA(0, 1, At, B1); PG8_BAR; PG8_SCHED;
            PG8_LDA(At, 1, 1); PG8_STAGE(PG8_SB(1, 0), b3, voffB); PG8_STAGE(PG8_SB(1, 1), b3 + hstep, voffB); PG8_STAGE(PG8_SA(1, 0), a3, na0);
            PG8_WAIT_V(8); PG8_WAIT_L(0); PG8_BAR; PG8_MMA(1, 0, At, B0); PG8_MMA(1, 1, At, B1); PG8_BAR; PG8_SCHED;
        }
        if constexpr (ALIGN_EPI) { if (wr == 0) PG8_BAR; }
        E(acc, cur, wr, wc, fr, fq);
        if (!has_next) break;
#pragma unroll
        for (int a = 0; a < 2; ++a)
#pragma unroll
            for (int b = 0; b < 2; ++b)
#pragma unroll
                for (int m = 0; m < 4; ++m)
#pragma unroll
                    for (int n = 0; n < 2; ++n) acc[a][b][m][n] = (f32x4){0.f, 0.f, 0.f, 0.f};
        cur = nxt; cB = nB; ++ui; ca0[0] = na0[0]; ca0[1] = na0[1]; ca1[0] = na1[0]; ca1[1] = na1[1];
        if constexpr (ALIGN_EPI) { if (wr == 1) PG8_BAR; }
    }
    PG8_WAIT_V(0);
    if constexpr (!ALIGN_EPI) { if (wr == 0) PG8_BAR; }
    PG8_BAR;
#undef PG8_AOFF
#undef PG8_SA
#undef PG8_SB
#undef PG8_STAGE
#undef PG8_LDA
#undef PG8_LDB
#undef PG8_MMA
#undef PG8_WAIT_V
#undef PG8_WAIT_L
#undef PG8_BAR
#undef PG8_SCHED
}

}
namespace mk {
using namespace nv;
typedef unsigned short bf16_t;
typedef unsigned u32x4 __attribute__((ext_vector_type(4)));
typedef float f32x4 __attribute__((ext_vector_type(4)));
#define LAS __attribute__((address_space(3)))
constexpr int NT = 512;
constexpr int PB = 2816;
constexpr int NPAD = 3072;
constexpr int C_KV = 512, C_FOX = 1280, C_SB = 2048, C_GATE = 2816;
constexpr int MAXT = MROWS / 256 + NE;
constexpr int PROWS = MAXT * 256;
__device__ __forceinline__ int ftid() { int t = threadIdx.x; asm volatile("" : "+v"(t)); return t; }
__device__ __forceinline__ int fbid() { int b = blockIdx.x; asm volatile("" : "+s"(b)); return b; }
#define MK_LOOP(vb, n) for (int vb = fbid(); vb < (n); vb += gridDim.x)

constexpr size_t al_(size_t x) { return (x + 4095) & ~(size_t)4095; }
constexpr size_t O_WTIN = 0;
constexpr size_t O_WTOUT = O_WTIN + al_((size_t)L_ * NPAD * D_ * 2);
constexpr size_t O_WTGU = O_WTOUT + al_((size_t)L_ * D_ * D_ * 2);
constexpr size_t O_WTDN = O_WTGU + al_((size_t)L_ * NE * 2048 * D_ * 2);
constexpr size_t O_BIASP = O_WTDN + al_((size_t)L_ * NE * D_ * D_ * 2);
constexpr size_t O_XB = O_BIASP + al_((size_t)L_ * NPAD * 4);
constexpr size_t O_PROJB = O_XB + al_((size_t)T_ * D_ * 2);
constexpr size_t O_GF = O_PROJB + al_((size_t)T_ * PB * 2);
constexpr size_t O_CFOX = O_GF + al_((size_t)T_ * 32 * 4);
constexpr size_t O_KCMP = O_CFOX + al_((size_t)B_ * 4 * S_ * 4);
constexpr size_t O_VCMP = O_KCMP + al_((size_t)B_ * 2 * 512 * 64 * 4);
constexpr size_t O_O = O_VCMP + al_((size_t)B_ * 2 * 512 * 64 * 4);
constexpr size_t O_OB = O_O + al_((size_t)T_ * D_ * 4);
constexpr size_t O_PTOT = O_OB + al_((size_t)T_ * D_ * 2);
constexpr size_t O_SEL = O_PTOT + al_((size_t)B_ * 2 * S_ * 512 * 4);
constexpr size_t O_MIX = O_SEL + al_((size_t)B_ * 2 * S_ * NSEL * 4);
constexpr size_t O_X1 = O_MIX + al_((size_t)T_ * D_ * 4);
constexpr size_t O_X1B = O_X1 + al_((size_t)T_ * D_ * 4);
constexpr size_t O_XA = O_X1B + al_((size_t)T_ * D_ * 2);
constexpr size_t O_ACT = O_XA + al_((size_t)T_ * D_ * 4);
constexpr size_t O_Y = O_ACT + al_((size_t)PROWS * D_ * 2);
constexpr size_t O_TOPE = O_Y + al_((size_t)PROWS * D_ * 2);
constexpr size_t O_TOPW = O_TOPE + al_((size_t)MROWS * 4);
constexpr size_t O_POS = O_TOPW + al_((size_t)MROWS * 4);
constexpr size_t O_ROWTOK = O_POS + al_((size_t)MROWS * 4);
constexpr size_t O_ROWW = O_ROWTOK + al_((size_t)PROWS * 4);
constexpr size_t O_SLOT = O_ROWW + al_((size_t)PROWS * 4);
constexpr size_t O_COUNTS = O_SLOT + al_((size_t)MROWS * 4);
constexpr size_t O_META = O_COUNTS + 4096;
constexpr size_t O_END = O_META + 4096;

struct P {
    In in; unsigned char* ws; float* out;
};
typedef const __attribute__((address_space(4))) P* KP;
__device__ __forceinline__ KP fresh_kp() { KP k = (KP)__builtin_amdgcn_kernarg_segment_ptr(); asm volatile("" : "+s"(k)); return k; }
#define WSP(T, off) ((T*)(p->ws + (off)))

__device__ __forceinline__ float bf2f(unsigned short b) { return __uint_as_float((unsigned)b << 16); }
__device__ __forceinline__ unsigned f2bf(float f) { unsigned u = __float_as_uint(f); return (u + 0x7fffu + ((u >> 16) & 1u)) >> 16; }
__device__ __forceinline__ unsigned pk2(float lo, float hi) { return f2bf(lo) | (f2bf(hi) << 16); }
__device__ __forceinline__ void ld8(const bf16_t* __restrict__ src, float* dst) {
    const u32x4 v = *(const u32x4*)src;
    dst[0] = __uint_as_float(v.x << 16); dst[1] = __uint_as_float(v.x & 0xffff0000u); dst[2] = __uint_as_float(v.y << 16); dst[3] = __uint_as_float(v.y & 0xffff0000u);
    dst[4] = __uint_as_float(v.z << 16); dst[5] = __uint_as_float(v.z & 0xffff0000u); dst[6] = __uint_as_float(v.w << 16); dst[7] = __uint_as_float(v.w & 0xffff0000u);
}


__device__ __forceinline__ int perm_in(int n) {
    if (n < 1280) return n;
    if (n < 1304) return C_GATE + (n - 1280);
    if (n < 2072) return C_FOX + (n - 1304);
    if (n < 2076) return C_GATE + 24 + (n - 2072);
    return C_SB + (n - 2076);
}
__device__ __forceinline__ int perm_gu(int n) { const int up = n >> 10, c = n & 1023; return 256 * (c >> 7) + 128 * up + (c & 127); }
template <int MAP>
__device__ __forceinline__ void transpose_item(const float* __restrict__ W, int K, int N, bf16_t* __restrict__ WT, LAS float* scr, int item, int lane) {
    const int nblk = (N + 31) / 32, kb = item / nblk, nb = item % nblk, k0 = 64 * kb, n0 = 32 * nb;
    const int nl = lane & 31; const bool okn = (n0 + nl) < N;
#pragma unroll 8
    for (int i = 0; i < 32; ++i) { const int kk = 2 * i + (lane >> 5); scr[kk * 33 + nl] = okn ? W[(size_t)(k0 + kk) * N + n0 + nl] : 0.f; }
    asm volatile("s_waitcnt lgkmcnt(0)" ::: "memory");
    const int c = lane & 7;
#pragma unroll
    for (int j = 0; j < 4; ++j) { const int n = (lane >> 3) + 8 * j; const LAS float* sp = scr + (8 * c) * 33 + n;
        u32x4 o; o.x = pk2(sp[0 * 33], sp[1 * 33]); o.y = pk2(sp[2 * 33], sp[3 * 33]); o.z = pk2(sp[4 * 33], sp[5 * 33]); o.w = pk2(sp[6 * 33], sp[7 * 33]);
        const int ng = n0 + n;
        if (ng < N) { const int ro = (MAP == 1) ? perm_in(ng) : (MAP == 2) ? perm_gu(ng) : ng; *(u32x4*)(WT + (size_t)ro * K + k0 + 8 * c) = o; } }
    asm volatile("s_waitcnt lgkmcnt(0)" ::: "memory");
}
__device__ __forceinline__ void ph_convert(LAS unsigned char* lds, KP p) {
    const int tid = ftid(), lane = tid & 63, wv = tid >> 6;
    LAS float* scr = (LAS float*)(lds + wv * 8448);
    const int gw = fbid() * 8 + wv, NGW = gridDim.x * 8;
    constexpr int I_IN = 16 * 89, I_OUT = 16 * 32, I_GU = 16 * 64, I_DN = 16 * 32;
    constexpr int N_IN = L_ * I_IN, N_OUT = L_ * I_OUT, N_GU = L_ * NE * I_GU, N_DN = L_ * NE * I_DN;
    for (int it = gw; it < N_IN + N_OUT + N_GU + N_DN; it += NGW) {
        int r = it;
        if (r < N_GU) { const int mtx = r / I_GU; transpose_item<2>(p->in.wgu + (size_t)mtx * D_ * 2048, D_, 2048, WSP(bf16_t, O_WTGU) + (size_t)mtx * 2048 * D_, scr, r % I_GU, lane); continue; } r -= N_GU;
        if (r < N_DN) { const int mtx = r / I_DN; transpose_item<0>(p->in.wdn + (size_t)mtx * D_ * D_, D_, D_, WSP(bf16_t, O_WTDN) + (size_t)mtx * D_ * D_, scr, r % I_DN, lane); continue; } r -= N_DN;
        if (r < N_IN) { const int mtx = r / I_IN; transpose_item<1>(p->in.w_in + (size_t)mtx * D_ * DIN, D_, DIN, WSP(bf16_t, O_WTIN) + (size_t)mtx * NPAD * D_, scr, r % I_IN, lane); continue; } r -= N_IN;
        { const int mtx = r / I_OUT; transpose_item<0>(p->in.w_out + (size_t)mtx * D_ * D_, D_, D_, WSP(bf16_t, O_WTOUT) + (size_t)mtx * D_ * D_, scr, r % I_OUT, lane); }
    }
    const int gt = fbid() * NT + tid, NG = gridDim.x * NT;
    for (int i = gt; i < L_ * (NPAD - DIN) * (D_ / 8); i += NG) { const int l = i / ((NPAD - DIN) * (D_ / 8)), r = i % ((NPAD - DIN) * (D_ / 8));
        *(u32x4*)(WSP(bf16_t, O_WTIN) + ((size_t)l * NPAD + DIN) * D_ + (size_t)r * 8) = (u32x4){0u, 0u, 0u, 0u}; }
    for (int i = gt; i < L_ * NPAD; i += NG) { const int l = i / NPAD, c = i % NPAD; if (c >= DIN) WSP(float, O_BIASP)[i] = 0.f; }
    for (int i = gt; i < L_ * DIN; i += NG) { const int l = i / DIN, n = i % DIN; WSP(float, O_BIASP)[l * NPAD + perm_in(n)] = p->in.b_in[i]; }
    for (int i = gt; i < T_ * D_ / 8; i += NG) { const f32x4 a = *(const f32x4*)(p->in.x + (size_t)i * 8), b = *(const f32x4*)(p->in.x + (size_t)i * 8 + 4);
        *(u32x4*)(WSP(bf16_t, O_XB) + (size_t)i * 8) = (u32x4){pk2(a.x, a.y), pk2(a.z, a.w), pk2(b.x, b.y), pk2(b.z, b.w)}; }
}

struct EpiProj {
    static constexpr bool PERM = true;
    bf16_t* projb; float* gf; const float* bias;
    __device__ __forceinline__ void operator()(const pg8::f32x4 (&acc)[2][2][4][2], const pg8::Unit& u, int wr, int wc, int fr, int fq) const {
        const int row0 = u.pm * 256 + wr * 64 + fr, col0 = u.pn * 256 + wc * 32 + 8 * fq;
        if (u.pn < 11) {
#pragma unroll
            for (int ai = 0; ai < 2; ++ai)
#pragma unroll
                for (int m = 0; m < 4; ++m) { bf16_t* rowp = projb + (size_t)(row0 + ai * 128 + m * 16) * PB + col0;
#pragma unroll
                    for (int bj = 0; bj < 2; ++bj) { const f32x4 v0 = acc[ai][bj][m][0] + *(const f32x4*)(bias + col0 + bj * 128), v1 = acc[ai][bj][m][1] + *(const f32x4*)(bias + col0 + bj * 128 + 4);
                        u32x4 w; w.x = pg8::cvt_pk_bf16(v0[0], v0[1]); w.y = pg8::cvt_pk_bf16(v0[2], v0[3]); w.z = pg8::cvt_pk_bf16(v1[0], v1[1]); w.w = pg8::cvt_pk_bf16(v1[2], v1[3]);
                        *(u32x4*)(rowp + bj * 128) = w; }
                    asm volatile("" ::: "memory"); }
        } else if (wc == 0) {
            const f32x4 b0 = *(const f32x4*)(bias + col0), b1 = *(const f32x4*)(bias + col0 + 4);
#pragma unroll
            for (int ai = 0; ai < 2; ++ai)
#pragma unroll
                for (int m = 0; m < 4; ++m) { float* rowp = gf + (size_t)(row0 + ai * 128 + m * 16) * 32 + 8 * fq;
                    const f32x4 v0 = acc[ai][0][m][0] + b0, v1 = acc[ai][0][m][1] + b1; f32x4 o0, o1;
#pragma unroll
                    for (int i = 0; i < 4; ++i) { const int j0 = 8 * fq + i, j1 = j0 + 4;
                        o0[i] = (j0 < 24) ? sigmoidf_(v0[i]) : (j0 < 28 ? logsig(v0[i]) : 0.f); o1[i] = (j1 < 24) ? sigmoidf_(v1[i]) : (j1 < 28 ? logsig(v1[i]) : 0.f); }
                    *(f32x4*)rowp = o0; *(f32x4*)(rowp + 4) = o1; }
        }
    }
};
struct EpiOut {
    static constexpr bool PERM = true;
    const float* x; float* y1;
    __device__ __forceinline__ void operator()(const pg8::f32x4 (&acc)[2][2][4][2], const pg8::Unit& u, int wr, int wc, int fr, int fq) const {
        const int row0 = u.pm * 256 + wr * 64 + fr, col0 = u.pn * 256 + wc * 32 + 8 * fq;
#pragma unroll
        for (int ai = 0; ai < 2; ++ai)
#pragma unroll
            for (int m = 0; m < 4; ++m) { const size_t off = (size_t)(row0 + ai * 128 + m * 16) * D_ + col0;
#pragma unroll
                for (int bj = 0; bj < 2; ++bj) { const f32x4 x0 = *(const f32x4*)(x + off + bj * 128), x1 = *(const f32x4*)(x + off + bj * 128 + 4);
                    *(f32x4*)(y1 + off + bj * 128) = x0 * ALPHA + acc[ai][bj][m][0]; *(f32x4*)(y1 + off + bj * 128 + 4) = x1 * ALPHA + acc[ai][bj][m][1]; }
                asm volatile("" ::: "memory"); }
    }
};
struct EpiGU {
    static constexpr bool PERM = true;
    bf16_t* act; const float* bgu;
    __device__ __forceinline__ void operator()(const pg8::f32x4 (&acc)[2][2][4][2], const pg8::Unit& u, int wr, int wc, int fr, int fq) const {
        const int row0 = u.pm * 256 + wr * 64 + fr, col0 = u.pn * 128 + wc * 32 + 8 * fq;
        const float* bb = bgu + (size_t)u.e * 2048 + col0;
        const f32x4 bg0 = *(const f32x4*)bb, bg1 = *(const f32x4*)(bb + 4), bu0 = *(const f32x4*)(bb + 1024), bu1 = *(const f32x4*)(bb + 1028);
#pragma unroll
        for (int ai = 0; ai < 2; ++ai)
#pragma unroll
            for (int m = 0; m < 4; ++m) { f32x4 a0, a1;
                const f32x4 g0 = acc[ai][0][m][0] + bg0, g1 = acc[ai][0][m][1] + bg1, u0 = acc[ai][1][m][0] + bu0, u1 = acc[ai][1][m][1] + bu1;
#pragma unroll
                for (int i = 0; i < 4; ++i) { const float gt0 = fminf(g0[i], 7.0f), up0 = fminf(fmaxf(u0[i], -7.0f), 7.0f), gt1 = fminf(g1[i], 7.0f), up1 = fminf(fmaxf(u1[i], -7.0f), 7.0f);
                    a0[i] = gt0 * sigmoidf_(1.702f * gt0) * (up0 + 1.0f); a1[i] = gt1 * sigmoidf_(1.702f * gt1) * (up1 + 1.0f); }
                u32x4 w; w.x = pg8::cvt_pk_bf16(a0[0], a0[1]); w.y = pg8::cvt_pk_bf16(a0[2], a0[3]); w.z = pg8::cvt_pk_bf16(a1[0], a1[1]); w.w = pg8::cvt_pk_bf16(a1[2], a1[3]);
                *(u32x4*)(act + (size_t)(row0 + ai * 128 + m * 16) * D_ + col0) = w; asm volatile("" ::: "memory"); }
    }
};
struct EpiDN {
    static constexpr bool PERM = true;
    bf16_t* y; const float* bdn; const float* roww;
    __device__ __forceinline__ void operator()(const pg8::f32x4 (&acc)[2][2][4][2], const pg8::Unit& u, int wr, int wc, int fr, int fq) const {
        const int row0 = u.pm * 256 + wr * 64 + fr, col0 = u.pn * 256 + wc * 32 + 8 * fq;
        const float* bb = bdn + (size_t)u.e * D_ + col0;
#pragma unroll
        for (int ai = 0; ai < 2; ++ai)
#pragma unroll
            for (int m = 0; m < 4; ++m) { const int row = row0 + ai * 128 + m * 16; const float w = roww[row];
#pragma unroll
                for (int bj = 0; bj < 2; ++bj) { const f32x4 v0 = (acc[ai][bj][m][0] + *(const f32x4*)(bb + bj * 128)) * w, v1 = (acc[ai][bj][m][1] + *(const f32x4*)(bb + bj * 128 + 4)) * w;
                    u32x4 o; o.x = pg8::cvt_pk_bf16(v0[0], v0[1]); o.y = pg8::cvt_pk_bf16(v0[2], v0[3]); o.z = pg8::cvt_pk_bf16(v1[0], v1[1]); o.w = pg8::cvt_pk_bf16(v1[2], v1[3]);
                    *(u32x4*)(y + (size_t)row * D_ + col0 + bj * 128) = o; }
                asm volatile("" ::: "memory"); }
    }
};
struct MoeOrder {
    const int* meta; const int* rowtok; const char* Wt; size_t estep, tstep; int nN, G, c, nunits;
    __device__ __forceinline__ bool next(int i, pg8::Unit& u) const {
        const int L = i * G + c; if (L >= nunits) return false;
        const int gt = L / nN; u.pm = gt; u.pn = L - gt * nN; u.e = meta[64 + 2 * gt]; u.nr = meta[65 + 2 * gt]; return true; }
    __device__ __forceinline__ unsigned a_row(const pg8::Unit& u, int r) const { const int rr = r < u.nr ? r : u.nr - 1; const int row = u.pm * 256 + rr; return rowtok ? (unsigned)rowtok[row] : (unsigned)row; }
    __device__ __forceinline__ const char* b_base(const pg8::Unit& u) const { return Wt + (size_t)u.e * estep + (size_t)u.pn * tstep; }
};

struct GEpi {
    static constexpr bool PERM = true;
    int kind, l;
    __device__ __forceinline__ void operator()(const pg8::f32x4 (&acc)[2][2][4][2], const pg8::Unit& u, int wr, int wc, int fr, int fq) const {
        const KP p = fresh_kp();
        if (kind == 0) { const EpiProj e{WSP(bf16_t, O_PROJB), WSP(float, O_GF), WSP(float, O_BIASP) + l * NPAD}; e(acc, u, wr, wc, fr, fq); }
        else if (kind == 1) { const EpiOut e{(l == 0) ? p->in.x : WSP(float, O_XA), WSP(float, O_MIX)}; e(acc, u, wr, wc, fr, fq); }
        else if (kind == 2) { const EpiGU e{WSP(bf16_t, O_ACT), p->in.bgu + (size_t)l * NE * 2048}; e(acc, u, wr, wc, fr, fq); }
        else { const EpiDN e{WSP(bf16_t, O_Y), p->in.bdn + (size_t)l * NE * D_, WSP(float, O_ROWW)}; e(acc, u, wr, wc, fr, fq); }
    }
};
struct GSched {
    int kind, nM, nN, nunits, G, c; const int* meta; const int* rowtok; const char* Bt; size_t estep;
    __device__ __forceinline__ bool next(int i, pg8::Unit& u) const {
        const int L = i * G + c; if (L >= nunits) return false;
        if (kind < 2) {
            int wgid = L; { const int q = nunits / pg8::NXCD, r = nunits % pg8::NXCD, xcd = wgid % pg8::NXCD, off = wgid / pg8::NXCD; wgid = (xcd < r ? xcd * (q + 1) : r * (q + 1) + (xcd - r) * q) + off; }
            const int nig = pg8::WGM * nN, gid = wgid / nig, fm = gid * pg8::WGM, gsz = (nM - fm) < pg8::WGM ? (nM - fm) : pg8::WGM;
            u.pm = fm + ((wgid % nig) % gsz); u.pn = (wgid % nig) / gsz; u.e = 0; u.nr = 256;
        } else { const int gt = L / nN; u.pm = gt; u.pn = L - gt * nN; u.e = meta[64 + 2 * gt]; u.nr = meta[65 + 2 * gt]; }
        return true; }
    __device__ __forceinline__ unsigned a_row(const pg8::Unit& u, int r) const { const int rr = r < u.nr ? r : u.nr - 1; const int row = u.pm * 256 + rr; return (kind == 2) ? (unsigned)rowtok[row] : (unsigned)row; }
    __device__ __forceinline__ const char* b_base(const pg8::Unit& u) const { return Bt + (size_t)u.e * estep + (size_t)u.pn * ((size_t)256 * D_ * 2); }
};

__device__ __forceinline__ void ph_prep(float* lds, KP p, int l) {
    const int tid = ftid();
    const bf16_t* projb = WSP(bf16_t, O_PROJB);
    constexpr int NCB = (NCMP + 3) / 4;
    constexpr int NV_CMP = NCB * B_ * 2 * 2;
    MK_LOOP(vb, NV_CMP + B_ * 4) {
        if (vb < NV_CMP) {
            float* blk = lds; float* hid = lds + 4 * 2048;
            const int kv = vb & 1, bg = (vb >> 1) & 3, nb = vb >> 3, b = bg >> 1, g = bg & 1;
            const float* pos = (kv ? p->in.pos_v : p->in.pos_k) + (size_t)l * 2048; const float* w1 = (kv ? p->in.w1v : p->in.w1k) + (size_t)l * 2048 * 128;
            const float* w2 = (kv ? p->in.w2v : p->in.w2k) + (size_t)l * 128 * 64; float* outp = kv ? WSP(float, O_VCMP) : WSP(float, O_KCMP);
            __syncthreads();
            for (int i = tid; i < 4 * 2048; i += NT) { const int sub = i >> 11, e = i & 2047, ll = e >> 6, d = e & 63; int n = nb * 4 + sub; if (n >= NCMP) n = NCMP - 1;
                blk[i] = bf2f(projb[(size_t)(b * S_ + 16 * n + ll) * PB + C_KV + ((0 * 2 + kv) * 2 + g) * 64 + d]) + pos[e]; }
            __syncthreads();
            const int sub = tid >> 7, j = tid & 127; const float* bl = blk + sub * 2048;
            float a = 0.f;
            for (int i = 0; i < 2048; ++i) a += bl[i] * w1[(size_t)i * 128 + j];
            hid[tid] = gelu_tanh(a);
            __syncthreads();
            const int n = nb * 4 + sub;
            if (j < 64 && n < NCMP) { float o = 0.f; for (int jj = 0; jj < 128; ++jj) o += hid[sub * 128 + jj] * w2[jj * 64 + j]; outp[((size_t)bg * NCMP + n) * 64 + j] = o; }
        } else {
            float* sh = lds; const int bh = vb - NV_CMP, b = bh >> 2, h = bh & 3; float carry = 0.f;
            for (int t0 = 0; t0 < S_; t0 += NT) {
                __syncthreads();
                sh[tid] = WSP(float, O_GF)[(size_t)(b * S_ + t0 + tid) * 32 + 24 + h]; __syncthreads();
                for (int o = 1; o < NT; o <<= 1) { const float add = (tid >= o) ? sh[tid - o] : 0.f; __syncthreads(); sh[tid] += add; __syncthreads(); }
                WSP(float, O_CFOX)[(size_t)bh * S_ + t0 + tid] = carry + sh[tid];
                carry += sh[NT - 1];
            }
        }
    }
}

__device__ __forceinline__ void load_tile_bf(float (*dst)[64], const bf16_t* __restrict__ src, size_t pitch) {
    const int tid = ftid(), r = tid >> 3, c0 = (tid & 7) * 8; float v[8]; ld8(src + (size_t)r * pitch + c0, v);
    *(float4*)&dst[r][c0] = make_float4(v[0], v[1], v[2], v[3]); *(float4*)&dst[r][c0 + 4] = make_float4(v[4], v[5], v[6], v[7]);
}
__device__ __forceinline__ void load_tile512(float (*dst)[64], const float* __restrict__ src, size_t stride, int nrows_valid) {
    const int tid = ftid(), r = tid >> 3, c0 = (tid & 7) * 8;
#pragma unroll
    for (int j = 0; j < 2; ++j) { float4 v = make_float4(0.f, 0.f, 0.f, 0.f); if (r < nrows_valid) v = *(const float4*)(src + (size_t)r * stride + c0 + 4 * j); *(float4*)&dst[r][c0 + 4 * j] = v; }
}
#define MK_LOADQ(q, src) do { _Pragma("unroll") for (int c_ = 0; c_ < 8; ++c_) { float t8_[8]; ld8((src) + 8 * c_, t8_); _Pragma("unroll") for (int e_ = 0; e_ < 8; ++e_) q[8 * c_ + e_] = t8_[e_] * SCALE; } } while (0)

template <int KIND>
__device__ __forceinline__ void attn_vblock(float* lds, KP p, int qb, int bh) {
    float (*Ks)[64] = (float (*)[64])lds; float (*Vs)[64] = (float (*)[64])(lds + 4096); float* Cs = lds + 8192;
    const bf16_t* projb = WSP(bf16_t, O_PROJB); const float* gf = WSP(float, O_GF); float* ob = WSP(float, O_O);
    const int tid = ftid(), q0 = qb * NT, t = q0 + tid;
    if (KIND == 0 || KIND == 1) {
        int b, h, qcol, kcol, vcol, ocol; float slope = 0.f;
        if (KIND == 0) { b = bh >> 2; h = bh & 3; qcol = C_FOX + h * 64; kcol = C_FOX + (4 + h) * 64; vcol = C_FOX + (8 + h) * 64; ocol = 512 + h * 64; }
        else { b = bh >> 3; h = bh & 7; const int g = h >> 2; qcol = h * 64; kcol = C_KV + ((2 * 2 + 0) * 2 + g) * 64; vcol = C_KV + ((2 * 2 + 1) * 2 + g) * 64; ocol = h * 64; slope = exp2f(-(float)(h + 1)); }
        const bf16_t* prow = projb + (size_t)(b * S_ + t) * PB;
        float q[64], o[64];
        MK_LOADQ(q, prow + qcol);
#pragma unroll
        for (int d = 0; d < 64; ++d) o[d] = 0.f;
        float m = -1e30f, l = 0.f, ct = 0.f; const float* cb = WSP(float, O_CFOX) + (size_t)(b * 4 + (h & 3)) * S_;
        if (KIND == 0) ct = cb[t];
        int kt0 = 0; const int kt1 = (q0 + NT - 1) >> 6;
        if (KIND == 1) { kt0 = (q0 - 511) >> 6; if (kt0 < 0) kt0 = 0; }
        for (int kt = kt0; kt <= kt1; ++kt) {
            __syncthreads();
            load_tile_bf(Ks, projb + (size_t)(b * S_ + kt * 64) * PB + kcol, PB);
            load_tile_bf(Vs, projb + (size_t)(b * S_ + kt * 64) * PB + vcol, PB);
            if (KIND == 0 && tid < 64) Cs[tid] = cb[kt * 64 + tid];
            __syncthreads();
            for (int r = 0; r < 64; ++r) {
                const int s = kt * 64 + r; bool ok = (s <= t); if (KIND == 1) ok = ok && (t - s < 512);
                if (ok) { float sc; NV_DOT(q, Ks[r], sc); if (KIND == 0) sc += ct - Cs[r]; else sc -= slope * (float)(t - s); NV_ONLINE(sc, Vs[r]); }
            }
        }
        const float inv = (l > 0.f) ? 1.f / l : 0.f;
        float* orow = ob + (size_t)(b * S_ + t) * D_ + ocol;
        if (KIND == 0) {
#pragma unroll
            for (int d = 0; d < 64; ++d) orow[d] = o[d] * inv;
        } else { const float gate = gf[(size_t)(b * S_ + t) * 32 + 2 * 8 + h];
#pragma unroll
            for (int d = 0; d < 64; ++d) orow[d] += gate * o[d] * inv; }
    } else if (KIND == 2) {
        const int b = bh >> 2, h = bh & 3;
        const int qcol = C_SB + h * 64, kcol = C_SB + (4 + h) * 64, vcol = C_SB + (8 + h) * 64, ocol = 768 + h * 64;
        const bf16_t* prow = projb + (size_t)(b * S_ + t) * PB;
        float q[64], o[64];
        MK_LOADQ(q, prow + qcol);
#pragma unroll
        for (int d = 0; d < 64; ++d) o[d] = 0.f;
        float later = 0.f;
        for (int kt = (q0 + NT - 1) >> 6; kt >= 0; --kt) {
            __syncthreads();
            load_tile_bf(Ks, projb + (size_t)(b * S_ + kt * 64) * PB + kcol, PB);
            load_tile_bf(Vs, projb + (size_t)(b * S_ + kt * 64) * PB + vcol, PB);
            __syncthreads();
            for (int r = 63; r >= 0; --r) { const int s = kt * 64 + r;
                if (s < t) { float z; NV_DOT(q, Ks[r], z); const float a = expf(logsig(z) + later); NV_AXPY(o, a, Vs[r]); later += logsig(-z); } }
        }
        float* orow = ob + (size_t)(b * S_ + t) * D_ + ocol;
#pragma unroll
        for (int d = 0; d < 64; ++d) orow[d] = o[d];
    } else {
        const int bg = bh, b = bg >> 1, g = bg & 1;
        const bf16_t* prow = projb + (size_t)(b * S_ + t) * PB;
        float* prow_t = WSP(float, O_PTOT) + (size_t)(bg * S_ + t) * 512;
        const float* kcmp = WSP(float, O_KCMP); const float* vcmp = WSP(float, O_VCMP);
        int nmax = (q0 + NT - 1 - 31) / 16 + 1; if (nmax > NCMP) nmax = NCMP;
        const int ntile = (nmax + 63) / 64;
        for (int r4 = 0; r4 < 4; ++r4) {
            const int h = g * 4 + r4; const float slope = exp2f(-(float)(h + 1));
            float q[64], o[64];
            MK_LOADQ(q, prow + h * 64);
#pragma unroll
            for (int d = 0; d < 64; ++d) o[d] = 0.f;
            float m = -1e30f, l = 0.f;
            for (int kt = 0; kt < ntile; ++kt) {
                __syncthreads();
                const int nvr = (NCMP - kt * 64) < 64 ? (NCMP - kt * 64) : 64;
                load_tile512(Ks, kcmp + ((size_t)bg * NCMP + kt * 64) * 64, 64, nvr);
                load_tile512(Vs, vcmp + ((size_t)bg * NCMP + kt * 64) * 64, 64, nvr);
                __syncthreads();
                for (int r = 0; r < nvr; ++r) { const int ce = 16 * (kt * 64 + r) + 31;
                    if (ce <= t) { float sc; NV_DOT(q, Ks[r], sc); sc -= slope * (float)(t - ce); NV_ONLINE(sc, Vs[r]); } }
            }
            const float inv = (l > 0.f) ? 1.f / l : 0.f;
            const float gate = gf[(size_t)(b * S_ + t) * 32 + 0 * 8 + h];
            float* orow = ob + (size_t)(b * S_ + t) * D_ + h * 64;
#pragma unroll
            for (int d = 0; d < 64; ++d) orow[d] = gate * o[d] * inv;
            for (int kt = 0; kt < 8; ++kt) {
                __syncthreads();
                const int nvr = (NCMP - kt * 64) < 64 ? (NCMP - kt * 64) : 64;
                if (kt < ntile) load_tile512(Ks, kcmp + ((size_t)bg * NCMP + kt * 64) * 64, 64, nvr);
                __syncthreads();
                for (int r = 0; r < 64; ++r) { const int n = kt * 64 + r, ce = 16 * n + 31; float pp = 0.f;
                    if (kt < ntile && r < nvr && ce <= t) { float sc; NV_DOT(q, Ks[r], sc); sc -= slope * (float)(t - ce); pp = __expf(sc - m) * inv; }
                    if (r4 == 0) prow_t[n] = pp; else prow_t[n] += pp; }
            }
        }
    }
}
__device__ __forceinline__ void ph_attn_a(float* lds, KP p) {
    constexpr int NQB = S_ / NT;
    constexpr int N_CMP = NQB * B_ * 2, N_FOX = NQB * B_ * 4, N_SB = NQB * B_ * 4;
    MK_LOOP(vb, N_CMP + N_FOX + N_SB) {
        if (vb < N_FOX) { const int qb = NQB - 1 - vb / (B_ * 4); attn_vblock<0>(lds, p, qb, vb % (B_ * 4)); }
        else if (vb < N_FOX + N_SB) { const int v = vb - N_FOX; const int qb = NQB - 1 - v / (B_ * 4); attn_vblock<2>(lds, p, qb, v % (B_ * 4)); }
        else { const int v = vb - N_FOX - N_SB; attn_vblock<3>(lds, p, v / (B_ * 2), v % (B_ * 2)); }
    }
}
__device__ __forceinline__ void ph_select(KP p) {
    const int lane = ftid() & 63, wv = ftid() >> 6; int* sel = WSP(int, O_SEL);
    for (int wave = fbid() * 8 + wv; wave < B_ * 2 * S_; wave += gridDim.x * 8) {
        const int t = wave % S_; const float* pt = WSP(float, O_PTOT) + (size_t)wave * 512; const int cur = t >> 6;
        float v[2];
#pragma unroll
        for (int k = 0; k < 2; ++k) { const int j = lane + 64 * k;
            float imp = pt[4 * j] + pt[4 * j + 1] + pt[4 * j + 2];
            if (4 * j + 3 < NCMP) imp += 0.5f * pt[4 * j + 3];
            if (j >= 1) imp += 0.5f * pt[4 * j - 1];
            const bool valid = j <= cur, forced = valid && (j == 0 || j >= cur - 1);
            v[k] = forced ? 3.0e38f : (valid ? imp : -3.0e38f); }
        for (int it = 0; it < NSEL; ++it) {
            float bv = v[0]; int bi = lane; if (v[1] > bv) { bv = v[1]; bi = lane + 64; }
#pragma unroll
            for (int o = 32; o >= 1; o >>= 1) { const float ov = __shfl_xor(bv, o); const int oi = __shfl_xor(bi, o); if (ov > bv || (ov == bv && oi < bi)) { bv = ov; bi = oi; } }
            if (lane == 0) sel[(size_t)wave * NSEL + it] = bi;
            if (bi == lane) v[0] = -3.4e38f;
            if (bi == lane + 64) v[1] = -3.4e38f;
        }
    }
}
__device__ __forceinline__ void ph_attn_sel(KP p) {
    const bf16_t* projb = WSP(bf16_t, O_PROJB); const int tid = ftid();
    MK_LOOP(vb, (S_ / NT) * B_ * 8) {
        const int qb = vb / (B_ * 8), bh = vb % (B_ * 8), b = bh >> 3, h = bh & 7, g = h >> 2, t = qb * NT + tid;
        const float slope = exp2f(-(float)(h + 1));
        const bf16_t* prow = projb + (size_t)(b * S_ + t) * PB;
        const int kcol = C_KV + ((1 * 2 + 0) * 2 + g) * 64, vcol = C_KV + ((1 * 2 + 1) * 2 + g) * 64;
        const int* sl = WSP(int, O_SEL) + ((size_t)(b * 2 + g) * S_ + t) * NSEL;
        float q[64], o[64];
        MK_LOADQ(q, prow + h * 64);
#pragma unroll
        for (int d = 0; d < 64; ++d) o[d] = 0.f;
        float m = -1e30f, l = 0.f;
        for (int i = 0; i < NSEL; ++i) { const int blk = sl[i];
            for (int r = 0; r < 64; ++r) { const int s = blk * 64 + r;
                if (s <= t) { const bf16_t* kr = projb + (size_t)(b * S_ + s) * PB + kcol; const bf16_t* vr = projb + (size_t)(b * S_ + s) * PB + vcol;
                    float sc = 0.f;
#pragma unroll
                    for (int c = 0; c < 8; ++c) { float k8[8]; ld8(kr + 8 * c, k8);
#pragma unroll
                        for (int e = 0; e < 8; ++e) sc += q[8 * c + e] * k8[e]; }
                    sc -= slope * (float)(t - s);
                    if (sc > m) { const float al = __expf(m - sc); l *= al;
#pragma unroll
                        for (int d = 0; d < 64; ++d) o[d] *= al;
                        m = sc; }
                    const float pp = __expf(sc - m); l += pp;
#pragma unroll
                    for (int c = 0; c < 8; ++c) { float v8[8]; ld8(vr + 8 * c, v8);
#pragma unroll
                        for (int e = 0; e < 8; ++e) o[8 * c + e] += pp * v8[e]; }
                } } }
        const float inv = (l > 0.f) ? 1.f / l : 0.f; const float gate = WSP(float, O_GF)[(size_t)(b * S_ + t) * 32 + 1 * 8 + h];
        float* orow = WSP(float, O_O) + (size_t)(b * S_ + t) * D_ + h * 64;
#pragma unroll
        for (int d = 0; d < 64; ++d) orow[d] += gate * o[d] * inv;
    }
}
__device__ __forceinline__ void ph_attn_win(float* lds, KP p) {
    MK_LOOP(vb, (S_ / NT) * B_ * 8) attn_vblock<1>(lds, p, vb / (B_ * 8), vb % (B_ * 8));
}
__device__ __forceinline__ void ph_rmsnorm(KP p, int l) {
    const int lane = ftid() & 63, wv = ftid() >> 6; const float* g = p->in.g_out + (size_t)l * D_;
    for (int row = fbid() * 8 + wv; row < T_; row += gridDim.x * 8) {
        const float* r = WSP(float, O_O) + (size_t)row * D_; bf16_t* ro = WSP(bf16_t, O_OB) + (size_t)row * D_;
        float a[8], bq[8], s = 0.f, s2 = 0.f;
#pragma unroll
        for (int i = 0; i < 8; ++i) { a[i] = r[lane * 8 + i]; s += a[i] * a[i]; bq[i] = r[512 + lane * 8 + i]; s2 += bq[i] * bq[i]; }
        const float sc0 = rsqrtf(wsum(s) * (1.f / 512.f) + RMS_EPS);
#pragma unroll
        for (int o = 1; o < 32; o <<= 1) s2 += __shfl_xor(s2, o);
        const float sc1 = rsqrtf(s2 * (1.f / 256.f) + RMS_EPS);
        float x0[8], x1[8];
#pragma unroll
        for (int i = 0; i < 8; ++i) { x0[i] = a[i] * sc0 * g[lane * 8 + i]; x1[i] = bq[i] * sc1 * g[512 + lane * 8 + i]; }
        *(u32x4*)(ro + lane * 8) = (u32x4){pk2(x0[0], x0[1]), pk2(x0[2], x0[3]), pk2(x0[4], x0[5]), pk2(x0[6], x0[7])};
        *(u32x4*)(ro + 512 + lane * 8) = (u32x4){pk2(x1[0], x1[1]), pk2(x1[2], x1[3]), pk2(x1[4], x1[5]), pk2(x1[6], x1[7])};
    }
}
template <bool ROUTER>
__device__ __forceinline__ void ph_ln(float* lds, KP p, int l, float* __restrict__ yout) {
    const int lane = ftid() & 63, wv = ftid() >> 6;
    const float* g = (ROUTER ? p->in.ln1_g : p->in.ln2_g) + (size_t)l * D_; const float* bb = (ROUTER ? p->in.ln1_b : p->in.ln2_b) + (size_t)l * D_;
    for (int row = fbid() * 8 + wv; row < T_; row += gridDim.x * 8) {
        float v[16], s = 0.f;
        if (ROUTER) { const float* src = WSP(float, O_MIX) + (size_t)row * D_;
#pragma unroll
            for (int j = 0; j < 2; ++j) { const f32x4 a = *(const f32x4*)(src + 512 * j + lane * 8), b = *(const f32x4*)(src + 512 * j + lane * 8 + 4);
                v[8 * j + 0] = a.x; v[8 * j + 1] = a.y; v[8 * j + 2] = a.z; v[8 * j + 3] = a.w; v[8 * j + 4] = b.x; v[8 * j + 5] = b.y; v[8 * j + 6] = b.z; v[8 * j + 7] = b.w; }
        } else { const float* src = WSP(float, O_X1) + (size_t)row * D_; const int* sl = WSP(int, O_SLOT) + row * TOPK; const bf16_t* y = WSP(bf16_t, O_Y);
#pragma unroll
            for (int j = 0; j < 2; ++j) { const f32x4 a = *(const f32x4*)(src + 512 * j + lane * 8), b = *(const f32x4*)(src + 512 * j + lane * 8 + 4);
                v[8 * j + 0] = ALPHA * a.x; v[8 * j + 1] = ALPHA * a.y; v[8 * j + 2] = ALPHA * a.z; v[8 * j + 3] = ALPHA * a.w; v[8 * j + 4] = ALPHA * b.x; v[8 * j + 5] = ALPHA * b.y; v[8 * j + 6] = ALPHA * b.z; v[8 * j + 7] = ALPHA * b.w; }
            float acc[16];
#pragma unroll
            for (int i = 0; i < 16; ++i) acc[i] = 0.f;
#pragma unroll
            for (int k = 0; k < TOPK; ++k) { const bf16_t* yr = y + (size_t)sl[k] * D_;
#pragma unroll
                for (int j = 0; j < 2; ++j) { float t8[8]; ld8(yr + 512 * j + lane * 8, t8);
#pragma unroll
                    for (int e = 0; e < 8; ++e) acc[8 * j + e] += t8[e]; } }
#pragma unroll
            for (int i = 0; i < 16; ++i) v[i] += acc[i]; }
#pragma unroll
        for (int i = 0; i < 16; ++i) s += v[i];
        const float mu = wsum(s) * (1.f / D_); float s2 = 0.f;
#pragma unroll
        for (int i = 0; i < 16; ++i) { v[i] -= mu; s2 += v[i] * v[i]; }
        const float rstd = rsqrtf(wsum(s2) * (1.f / D_) + LN_EPS);
        bf16_t* ybf = (ROUTER ? WSP(bf16_t, O_X1B) : WSP(bf16_t, O_XB)) + (size_t)row * D_;
#pragma unroll
        for (int j = 0; j < 2; ++j) { const int c0 = 512 * j + lane * 8;
#pragma unroll
            for (int e = 0; e < 8; ++e) v[8 * j + e] = v[8 * j + e] * rstd * g[c0 + e] + bb[c0 + e];
            *(f32x4*)(yout + (size_t)row * D_ + c0) = (f32x4){v[8 * j], v[8 * j + 1], v[8 * j + 2], v[8 * j + 3]};
            *(f32x4*)(yout + (size_t)row * D_ + c0 + 4) = (f32x4){v[8 * j + 4], v[8 * j + 5], v[8 * j + 6], v[8 * j + 7]};
            *(u32x4*)(ybf + c0) = (u32x4){pk2(v[8 * j], v[8 * j + 1]), pk2(v[8 * j + 2], v[8 * j + 3]), pk2(v[8 * j + 4], v[8 * j + 5]), pk2(v[8 * j + 6], v[8 * j + 7])}; }
        if (ROUTER) {
            const float* rw = p->in.rw + (size_t)l * D_ * NE; const float* rb = p->in.rb + (size_t)l * NE; int* counts = WSP(int, O_COUNTS) + l * 32;
            float* rowl = lds + wv * 1024;
#pragma unroll
            for (int j = 0; j < 2; ++j)
#pragma unroll
                for (int e = 0; e < 8; ++e) rowl[512 * j + lane * 8 + e] = v[8 * j + e];
            asm volatile("s_waitcnt lgkmcnt(0)" ::: "memory");
            const int e = lane & 31, half = lane >> 5; float lg = 0.f;
            for (int k = 0; k < 512; ++k) lg += rowl[half * 512 + k] * rw[(size_t)(half * 512 + k) * NE + e];
            lg += __shfl_xor(lg, 32); lg += rb[e];
            float cur = lg, tv0 = 0.f, den = 0.f, myw = 0.f; int mye = 0;
#pragma unroll
            for (int k = 0; k < TOPK; ++k) { float bv = cur; int bi = e;
#pragma unroll
                for (int o = 16; o >= 1; o >>= 1) { const float ov = __shfl_xor(bv, o); const int oi = __shfl_xor(bi, o); if (ov > bv || (ov == bv && oi < bi)) { bv = ov; bi = oi; } }
                if (k == 0) tv0 = bv;
                const float w = __expf(bv - tv0); den += w;
                if (lane == k) { mye = bi; myw = w; }
                if (e == bi) cur = -3.4e38f; }
            if (lane < TOPK) { WSP(int, O_TOPE)[row * TOPK + lane] = mye; WSP(float, O_TOPW)[row * TOPK + lane] = myw / den; WSP(int, O_POS)[row * TOPK + lane] = atomicAdd(&counts[mye], 1); }
            asm volatile("s_waitcnt lgkmcnt(0)" ::: "memory");
        }
    }
}
__device__ __forceinline__ void ph_moe_plan(KP p, int l) {
    if (fbid() == 0 && ftid() == 0) { const int* counts = WSP(int, O_COUNTS) + l * 32; int* meta = WSP(int, O_META); int nt = 0;
        for (int e = 0; e < NE; ++e) { meta[e] = nt; const int c = counts[e];
            for (int r = 0; r < c; r += 256) { meta[64 + 2 * nt] = e; meta[65 + 2 * nt] = (c - r) < 256 ? (c - r) : 256; ++nt; } }
        meta[32] = nt; }
}
__device__ __forceinline__ void ph_moe_scatter(KP p) {
    const int* meta = WSP(int, O_META);
    for (int i = fbid() * NT + ftid(); i < MROWS; i += gridDim.x * NT) {
        const int row = meta[WSP(int, O_TOPE)[i]] * 256 + WSP(int, O_POS)[i];
        WSP(int, O_ROWTOK)[row] = i >> 2; WSP(float, O_ROWW)[row] = WSP(float, O_TOPW)[i]; WSP(int, O_SLOT)[i] = row; }
}
}
namespace cg = cooperative_groups;
__global__ void __launch_bounds__(512, 2) mega(mk::P p_unused) {
    extern __shared__ __attribute__((aligned(16))) unsigned char lds_raw[];
    float* lds = (float*)lds_raw;
    LAS unsigned char* lds3 = (LAS unsigned char*)lds_raw;
    cg::grid_group grid = cg::this_grid();
    using namespace nv; using namespace mk;
    for (int step = 0; step < 1 + 14 * L_; ++step) {
        const KP p = fresh_kp();
        const int l = (step - 1) / 14, k = (step == 0) ? -1 : (step - 1) % 14;
        const bool isg = (k == 0 || k == 7 || k == 11 || k == 12);
        if (isg) {
            const int kind = (k == 0) ? 0 : (k == 7) ? 1 : (k == 11) ? 2 : 3;
            GSched S; GEpi E; S.kind = kind; E.kind = kind; E.l = l;
            S.G = (int)gridDim.x; S.c = fbid(); S.meta = WSP(int, O_META); S.rowtok = WSP(int, O_ROWTOK); S.estep = 0;
            const char* A; int N;
            if (kind == 0) { A = (const char*)WSP(bf16_t, O_XB); S.Bt = (const char*)(WSP(bf16_t, O_WTIN) + (size_t)l * NPAD * D_); N = NPAD; }
            else if (kind == 1) { A = (const char*)WSP(bf16_t, O_OB); S.Bt = (const char*)(WSP(bf16_t, O_WTOUT) + (size_t)l * D_ * D_); N = D_; }
            else if (kind == 2) { A = (const char*)WSP(bf16_t, O_X1B); S.Bt = (const char*)(WSP(bf16_t, O_WTGU) + (size_t)l * NE * 2048 * D_); S.estep = (size_t)2048 * D_ * 2; N = 2048; }
            else { A = (const char*)WSP(bf16_t, O_ACT); S.Bt = (const char*)(WSP(bf16_t, O_WTDN) + (size_t)l * NE * D_ * D_); S.estep = (size_t)D_ * D_ * 2; N = D_; }
            S.nN = N / 256; S.nM = (kind < 2) ? T_ / 256 : S.meta[32]; S.nunits = S.nM * S.nN;
            pg8::gemm_phase<GEpi, GSched>(lds3, A, D_, S, E);
        } else {
            switch (k) {
                case -1: ph_convert(lds3, p); break;
                case 1: ph_prep(lds, p, l); break;
                case 2: ph_attn_a(lds, p); break;
                case 3: ph_select(p); break;
                case 4: ph_attn_sel(p); break;
                case 5: ph_attn_win(lds, p); break;
                case 6: ph_rmsnorm(p, l); break;
                case 8: ph_ln<true>(lds, p, l, WSP(float, O_X1)); break;
                case 9: ph_moe_plan(p, l); break;
                case 10: ph_moe_scatter(p); break;
                default: { float* xout = (l == L_ - 1) ? p->out : WSP(float, O_XA); ph_ln<false>(lds, p, l, xout); } break;
            }
        }
        grid.sync();
    }
}

extern "C" void kernel_launch(void* const* d_in, const int* in_sizes, int n_in,
                              void* d_out, int out_size, void* d_ws, size_t ws_size,
                              hipStream_t stream) {
    constexpr size_t kDynLds = 147456;
    static int grid_blocks = 0;
    if (!grid_blocks) {
        int dev = 0, cus = 0, per_cu = 0;
        (void)hipGetDevice(&dev);
        (void)hipDeviceGetAttribute(&cus, hipDeviceAttributeMultiprocessorCount, dev);
        (void)hipFuncSetAttribute((const void*)mega, hipFuncAttributeMaxDynamicSharedMemorySize, (int)kDynLds);
        (void)hipOccupancyMaxActiveBlocksPerMultiprocessor(&per_cu, mega, 512, kDynLds);
        if (per_cu < 1) per_cu = 1;
        if (per_cu > 1) per_cu = 1;
        grid_blocks = cus * per_cu;
        if (ws_size < mk::O_END) fprintf(stderr, "workspace too small: %zu < %zu\n", ws_size, (size_t)mk::O_END);
    }
    mk::P p{};
    p.in = nv::inputs(d_in); p.ws = (unsigned char*)d_ws; p.out = (float*)d_out;
    (void)hipMemsetAsync((char*)d_ws + mk::O_COUNTS, 0, 4096, stream);
    void* args[] = {&p};
    hipError_t e = hipLaunchCooperativeKernel((void*)mega, dim3(grid_blocks), dim3(512), args, kDynLds, stream);
    if (e != hipSuccess) fprintf(stderr, "cooperative launch failed: %s (grid %d)\n", hipGetErrorString(e), grid_blocks);
}
```

```cpp
#include <hip/hip_runtime.h>
#include <hip/hip_cooperative_groups.h>
#include <cstdio>
#include <cstdint>

namespace nv {

constexpr int B_ = 2, S_ = 8192, D_ = 1024, T_ = B_ * S_, L_ = 2;
constexpr int DIN = 2844;
constexpr int OFF_NSA_KV = 512, OFF_NSA_GATE = 1280, OFF_FOX_QKV = 1304, OFF_FOX_F = 2072, OFF_SB_QKV = 2076;
constexpr int NCMP = 511, NBLK = 128, NSEL = 16;
constexpr int NE = 32, TOPK = 4, MROWS = T_ * TOPK;
constexpr float LN_EPS = 1e-5f, RMS_EPS = 1e-6f;
constexpr float ALPHA = 1.4142135623730951f;
constexpr float SCALE = 0.125f;

__device__ __forceinline__ float sigmoidf_(float x) { return 1.f / (1.f + __expf(-x)); }
__device__ __forceinline__ float logsig(float x) { return fminf(x, 0.f) - log1pf(expf(-fabsf(x))); }

__device__ __forceinline__ float gelu_tanh(float x) { return 0.5f * x * (1.f + tanhf(0.7978845608028654f * (x + 0.044715f * x * x * x))); }
#define NV_DOT(q, kr, res) do { float s0_ = 0.f, s1_ = 0.f, s2_ = 0.f, s3_ = 0.f; _Pragma("unroll") for (int d_ = 0; d_ < 64; d_ += 4) { const float4 k4_ = *(const float4*)&(kr)[d_]; s0_ += q[d_] * k4_.x; s1_ += q[d_ + 1] * k4_.y; s2_ += q[d_ + 2] * k4_.z; s3_ += q[d_ + 3] * k4_.w; } res = (s0_ + s1_) + (s2_ + s3_); } while (0)
#define NV_AXPY(o, p, vr) do { _Pragma("unroll") for (int d_ = 0; d_ < 64; d_ += 4) { const float4 v4_ = *(const float4*)&(vr)[d_]; o[d_] += p * v4_.x; o[d_ + 1] += p * v4_.y; o[d_ + 2] += p * v4_.z; o[d_ + 3] += p * v4_.w; } } while (0)
#define NV_ONLINE(sc, vr) do { if (sc > m) { const float al_ = __expf(m - sc); l *= al_; _Pragma("unroll") for (int d_ = 0; d_ < 64; ++d_) o[d_] *= al_; m = sc; } const float p_ = __expf(sc - m); l += p_; NV_AXPY(o, p_, vr); } while (0)

__device__ __forceinline__ float wsum(float v) {
#pragma unroll
    for (int o = 1; o < 64; o <<= 1) v += __shfl_xor(v, o);
    return v;
}
struct In {
    const float *x, *w_in, *b_in, *pos_k, *pos_v, *w1k, *w2k, *w1v, *w2v, *g_out, *w_out, *ln1_g, *ln1_b, *rw, *rb, *wgu, *bgu, *wdn, *bdn, *ln2_g, *ln2_b;
};
inline In inputs(void* const* d) {
    In i; i.x = (const float*)d[0]; i.w_in = (const float*)d[1]; i.b_in = (const float*)d[2]; i.pos_k = (const float*)d[3]; i.pos_v = (const float*)d[4];
    i.w1k = (const float*)d[5]; i.w2k = (const float*)d[6]; i.w1v = (const float*)d[7]; i.w2v = (const float*)d[8]; i.g_out = (const float*)d[9]; i.w_out = (const float*)d[10];
    i.ln1_g = (const float*)d[11]; i.ln1_b = (const float*)d[12]; i.rw = (const float*)d[13]; i.rb = (const float*)d[14]; i.wgu = (const float*)d[15]; i.bgu = (const float*)d[16];
    i.wdn = (const float*)d[17]; i.bdn = (const float*)d[18]; i.ln2_g = (const float*)d[19]; i.ln2_b = (const float*)d[20]; return i;
}


}
namespace pg8 {
#define PG8_LAS __attribute__((address_space(3)))
typedef unsigned short bf16_t;
typedef short bf16x8 __attribute__((ext_vector_type(8)));
typedef float f32x4 __attribute__((ext_vector_type(4)));
typedef unsigned u32x4 __attribute__((ext_vector_type(4)));
constexpr int BM = 256, BK = 64, HALF = 128, HTB = HALF * BK * 2  , STAGE_BYTES = 8 * HTB, NXCD = 8, WGM = 8;

__host__ __device__ __forceinline__ int lds_byte(int r, int c) { const int st = (r >> 4) * 2 + (c >> 5), rr = r & 15, cc = c & 31, ob = rr * 64 + cc * 2; return st * 1024 + (ob ^ (((ob >> 9) & 1) << 5)); }
__host__ __device__ __forceinline__ void stage_rc(int b, int& R, int& C) { const int st = b / 1024, sb = b % 1024, swz = sb ^ (((sb >> 9) & 1) << 5); R = (st >> 1) * 16 + swz / 64; C = (st & 1) * 32 + (swz % 64) / 2; }
__host__ __device__ __forceinline__ int perm32(int rho) { const int n = rho >> 4, i = rho & 15; return 8 * (i >> 2) + 4 * n + (i & 3); }

struct Unit { int pm, pn, e, nr; };

struct StaticOrder {
    int nM, nN, nwg, G, c;
    __host__ __device__ void init(int M, int N, int G_, int c_) { nM = M / BM; nN = N / BM; nwg = nM * nN; G = G_; c = c_; }
    __host__ __device__ bool next(int i, Unit& u) const {
        const long L = (long)i * G + c; if (L >= nwg) return false;
        int wgid = (int)L; { const int q = nwg / NXCD, r = nwg % NXCD, xcd = wgid % NXCD, off = wgid / NXCD; wgid = (xcd < r ? xcd * (q + 1) : r * (q + 1) + (xcd - r) * q) + off; }
        const int nig = WGM * nN, gid = wgid / nig, fm = gid * WGM, gsz = (nM - fm) < WGM ? (nM - fm) : WGM;
        u.pm = fm + ((wgid % nig) % gsz); u.pn = (wgid % nig) / gsz; u.e = 0; u.nr = BM; return true;
    }
    const char* Bt; size_t tstep;
    __device__ __forceinline__ unsigned a_row(const Unit& u, int r) const { return (unsigned)(u.pm * BM + r); }
    __device__ __forceinline__ const char* b_base(const Unit& u) const { return Bt + (size_t)u.pn * tstep; }
};


__device__ __forceinline__ unsigned cvt_pk_bf16(float lo, float hi) { unsigned r; asm volatile("v_cvt_pk_bf16_f32 %0, %1, %2" : "=v"(r) : "v"(lo), "v"(hi)); return r; }
template <class Epi, class Sched, bool ALIGN_EPI = true, bool SP2 = true>
__device__ __forceinline__ void gemm_phase(PG8_LAS unsigned char* lds, const char* Abase, const int K, const Sched& S, const Epi& E) {
    int tid_ = threadIdx.x; asm volatile("" : "+v"(tid_));
    const int tid = tid_, wid = __builtin_amdgcn_readfirstlane(tid >> 6), lane = tid & 63, wr = wid >> 2, wc = wid & 3, fr = lane & 15, fq = lane >> 4;
    const int nt = K / BK;
    unsigned voffB[2];
#pragma unroll
    for (int i = 0; i < 2; ++i) { int R, C; stage_rc(tid * 16 + i * 8192, R, C); const int Rb = Epi::PERM ? ((R & ~31) + perm32(R & 31)) : R;
        voffB[i] = (unsigned)(Rb * K + C) * 2u; }
#define PG8_AOFF(u, o0, o1) do { int _t = tid; asm volatile("" : "+v"(_t)); _Pragma("unroll") for (int _i = 0; _i < 2; ++_i) { int _R, _C; stage_rc(_t * 16 + _i * 8192, _R, _C); \
        (o0)[_i] = (S.a_row((u), _R) * (unsigned)K + (unsigned)_C) * 2u; (o1)[_i] = (S.a_row((u), HALF + _R) * (unsigned)K + (unsigned)_C) * 2u; } } while (0)
    const size_t kstep = (size_t)(BK * 2);
    const size_t hstep = (size_t)HALF * K * 2;
    const unsigned ldsw = (unsigned)wid * 1024u;
    const int aoff = lds_byte(wr * 64 + fr, fq * 8), boff = lds_byte(wc * 32 + fr, fq * 8);
#define PG8_SA(b, h) (((b) * 2 + (h)) * HTB)
#define PG8_SB(b, h) ((4 + (b) * 2 + (h)) * HTB)
#define PG8_STAGE(bufoff, gbase, voff) do { _Pragma("unroll") for (int _i = 0; _i < 2; ++_i) { unsigned _o = (voff)[_i]; asm volatile("" : "+v"(_o));     \
        __builtin_amdgcn_global_load_lds((const unsigned*)((const char*)(gbase) + _o), (PG8_LAS unsigned*)(lds + (bufoff) + ldsw + _i * 8192), 16, 0, 0); } } while (0)
#define PG8_LDA(dst, b, h) do { _Pragma("unroll") for (int m = 0; m < 4; ++m) _Pragma("unroll") for (int k = 0; k < 2; ++k) dst[m][k] = *(const PG8_LAS bf16x8*)(lds + PG8_SA(b, h) + aoff + m * 2048 + k * 1024); } while (0)
#define PG8_LDB(dst, b, h) do { _Pragma("unroll") for (int n = 0; n < 2; ++n) _Pragma("unroll") for (int k = 0; k < 2; ++k) dst[n][k] = *(const PG8_LAS bf16x8*)(lds + PG8_SB(b, h) + boff + n * 2048 + k * 1024); } while (0)
#define PG8_MMA(ai, bj, At, Bt) do { __builtin_amdgcn_s_setprio(1); _Pragma("unroll") for (int m = 0; m < 4; ++m) _Pragma("unroll") for (int n = 0; n < 2; ++n) _Pragma("unroll") for (int k = 0; k < 2; ++k) \
        acc[ai][bj][m][n] = __builtin_amdgcn_mfma_f32_16x16x32_bf16(Bt[n][k], At[m][k], acc[ai][bj][m][n], 0, 0, 0); __builtin_amdgcn_s_setprio(0); } while (0)
#define PG8_WAIT_V(n) asm volatile("s_waitcnt vmcnt(" #n ")" ::: "memory")
#define PG8_WAIT_L(n) asm volatile("s_waitcnt lgkmcnt(" #n ")" ::: "memory")
#define PG8_BAR __builtin_amdgcn_s_barrier()
#define PG8_SCHED __builtin_amdgcn_sched_barrier(0)
    Unit cur, nxt; int ui = 0;
    if (!S.next(0, cur)) return;
    f32x4 acc[2][2][4][2];
#pragma unroll
    for (int a = 0; a < 2; ++a)
#pragma unroll
        for (int b = 0; b < 2; ++b)
#pragma unroll
            for (int m = 0; m < 4; ++m)
#pragma unroll
                for (int n = 0; n < 2; ++n) acc[a][b][m][n] = (f32x4){0.f, 0.f, 0.f, 0.f};
    bf16x8 At[4][2], B0[2][2], B1[2][2];
    unsigned ca0[2], ca1[2], na0[2], na1[2];
    PG8_AOFF(cur, ca0, ca1);
    const char* const cA = Abase; const char* cB = S.b_base(cur);
    if constexpr (SP2) {
        PG8_STAGE(PG8_SB(0, 0), cB, voffB); PG8_STAGE(PG8_SB(0, 1), cB + hstep, voffB); PG8_STAGE(PG8_SA(0, 0), cA, ca0); PG8_STAGE(PG8_SA(0, 1), cA, ca1);
        if (wr == 1) PG8_BAR;
        PG8_WAIT_V(2); PG8_BAR;
        PG8_STAGE(PG8_SB(1, 0), cB + kstep, voffB); PG8_STAGE(PG8_SA(1, 0), cA + kstep, ca0); PG8_STAGE(PG8_SB(1, 1), cB + hstep + kstep, voffB);
        PG8_WAIT_V(6); PG8_BAR;
    } else { static_assert(SP2, "only the SP2 loop is kept"); }
    for (;;) {
        const bool has_next = S.next(ui + 1, nxt);
        const char* nB = has_next ? S.b_base(nxt) : cB;
        if (has_next) { PG8_AOFF(nxt, na0, na1); } else { na0[0] = ca0[0]; na0[1] = ca0[1]; na1[0] = ca1[0]; na1[1] = ca1[1]; }
        for (int t = 0; t < nt - 2; t += 2) {
            const char* a1 = cA + (size_t)(t + 1) * kstep;
            const char* a2 = cA + (size_t)(t + 2) * kstep; const char* b2 = cB + (size_t)(t + 2) * kstep;
            const char* a3 = a2 + kstep; const char* b3 = b2 + kstep;
            PG8_LDB(B0, 0, 0); PG8_LDB(B1, 0, 1); PG8_SCHED; PG8_LDA(At, 0, 0); PG8_STAGE(PG8_SA(1, 1), a1, ca1);
            PG8_WAIT_V(8); PG8_WAIT_L(0); PG8_BAR; PG8_MMA(0, 0, At, B0); PG8_MMA(0, 1, At, B1); PG8_BAR; PG8_SCHED;
            PG8_LDA(At, 0, 1); PG8_STAGE(PG8_SB(0, 0), b2, voffB); PG8_STAGE(PG8_SB(0, 1), b2 + hstep, voffB); PG8_STAGE(PG8_SA(0, 0), a2, ca0);
            PG8_WAIT_V(8); PG8_WAIT_L(0); PG8_BAR; PG8_MMA(1, 0, At, B0); PG8_MMA(1, 1, At, B1); PG8_BAR; PG8_SCHED;
            PG8_LDB(B0, 1, 0); PG8_LDB(B1, 1, 1); PG8_SCHED; PG8_LDA(At, 1, 0); PG8_STAGE(PG8_SA(0, 1), a2, ca1);
            PG8_WAIT_V(8); PG8_WAIT_L(0); PG8_BAR; PG8_MMA(0, 0, At, B0); PG8_MMA(0, 1, At, B1); PG8_BAR; PG8_SCHED;
            PG8_LDA(At, 1, 1); PG8_STAGE(PG8_SB(1, 0), b3, voffB); PG8_STAGE(PG8_SB(1, 1), b3 + hstep, voffB); PG8_STAGE(PG8_SA(1, 0), a3, ca0);
            PG8_WAIT_V(8); PG8_WAIT_L(0); PG8_BAR; PG8_MMA(1, 0, At, B0); PG8_MMA(1, 1, At, B1); PG8_BAR; PG8_SCHED;
        }
        {
            const char* a1 = cA + (size_t)(nt - 1) * kstep;
            const char* a2 = cA; const char* b2 = nB; const char* a3 = a2 + kstep; const char* b3 = b2 + kstep;
            PG8_LDB(B0, 0, 0); PG8_LDB(B1, 0, 1); PG8_SCHED; PG8_LDA(At, 0, 0); PG8_STAGE(PG8_SA(1, 1), a1, ca1);
            PG8_WAIT_V(8); PG8_WAIT_L(0); PG8_BAR; PG8_MMA(0, 0, At, B0); PG8_MMA(0, 1, At, B1); PG8_BAR; PG8_SCHED;
            PG8_LDA(At, 0, 1); PG8_STAGE(PG8_SB(0, 0), b2, voffB); PG8_STAGE(PG8_SB(0, 1), b2 + hstep, voffB); PG8_STAGE(PG8_SA(0, 0), a2, na0);
            PG8_WAIT_V(8); PG8_WAIT_L(0); PG8_BAR; PG8_MMA(1, 0, At, B0); PG8_MMA(1, 1, At, B1); PG8_BAR; PG8_SCHED;
            PG8_LDB(B0, 1, 0); PG8_LDB(B1, 1, 1); PG8_SCHED; PG8_LDA(At, 1, 0); PG8_STAGE(PG8_SA(0, 1), a2, na1);
            PG8_WAIT_V(8); PG8_WAIT_L(0); PG8_BAR; PG8_MMA(0, 0, At, B0); PG8_MMA(0, 1, At, B1); PG8_BAR; PG8_SCHED;
            PG8_LDA(At, 1, 1); PG8_STAGE(PG8_SB(1, 0), b3, voffB); PG8_STAGE(PG8_SB(1, 1), b3 + hstep, voffB); PG8_STAGE(PG8_SA(1, 0), a3, na0);
            PG8_WAIT_V(8); PG8_WAIT_L(0); PG8_BAR; PG8_MMA(1, 0, At, B0); PG8_MMA(1, 1, At, B1); PG8_BAR; PG8_SCHED;
        }
        if constexpr (ALIGN_EPI) { if (wr == 0) PG8_BAR; }
        E(acc, cur, wr, wc, fr, fq);
        if (!has_next) break;
#pragma unroll
        for (int a = 0; a < 2; ++a)
#pragma unroll
            for (int b = 0; b < 2; ++b)
#pragma unroll
                for (int m = 0; m < 4; ++m)
#pragma unroll
                    for (int n = 0; n < 2; ++n) acc[a][b][m][n] = (f32x4){0.f, 0.f, 0.f, 0.f};
        cur = nxt; cB = nB; ++ui; ca0[0] = na0[0]; ca0[1] = na0[1]; ca1[0] = na1[0]; ca1[1] = na1[1];
        if constexpr (ALIGN_EPI) { if (wr == 1) PG8_BAR; }
    }
    PG8_WAIT_V(0);
    if constexpr (!ALIGN_EPI) { if (wr == 0) PG8_BAR; }
    PG8_BAR;
#undef PG8_AOFF
#undef PG8_SA
#undef PG8_SB
#undef PG8_STAGE
#undef PG8_LDA
#undef PG8_LDB
#undef PG8_MMA
#undef PG8_WAIT_V
#undef PG8_WAIT_L
#undef PG8_BAR
#undef PG8_SCHED
}

}
namespace mk {
using namespace nv;
typedef unsigned short bf16_t;
typedef unsigned u32x4 __attribute__((ext_vector_type(4)));
typedef float f32x4 __attribute__((ext_vector_type(4)));
#define LAS __attribute__((address_space(3)))
constexpr int NT = 512;
constexpr int PB = 2816;
constexpr int NPAD = 3072;
constexpr int C_KV = 512, C_FOX = 1280, C_SB = 2048, C_GATE = 2816;
constexpr int MAXT = MROWS / 256 + NE;
constexpr int PROWS = MAXT * 256;
__device__ __forceinline__ int ftid() { int t = threadIdx.x; asm volatile("" : "+v"(t)); return t; }
__device__ __forceinline__ int fbid() { int b = blockIdx.x; asm volatile("" : "+s"(b)); return b; }
#define MK_LOOP(vb, n) for (int vb = fbid(); vb < (n); vb += gridDim.x)

constexpr size_t al_(size_t x) { return (x + 4095) & ~(size_t)4095; }
constexpr size_t O_WTIN = 0;
constexpr size_t O_WTOUT = O_WTIN + al_((size_t)L_ * NPAD * D_ * 2);
constexpr size_t O_WTGU = O_WTOUT + al_((size_t)L_ * D_ * D_ * 2);
constexpr size_t O_WTDN = O_WTGU + al_((size_t)L_ * NE * 2048 * D_ * 2);
constexpr size_t O_BIASP = O_WTDN + al_((size_t)L_ * NE * D_ * D_ * 2);
constexpr size_t O_XB = O_BIASP + al_((size_t)L_ * NPAD * 4);
constexpr size_t O_PROJB = O_XB + al_((size_t)T_ * D_ * 2);
constexpr size_t O_GF = O_PROJB + al_((size_t)T_ * PB * 2);
constexpr size_t O_CFOX = O_GF + al_((size_t)T_ * 32 * 4);
constexpr size_t O_KCMP = O_CFOX + al_((size_t)B_ * 4 * S_ * 4);
constexpr size_t O_VCMP = O_KCMP + al_((size_t)B_ * 2 * 512 * 64 * 4);
constexpr size_t O_O = O_VCMP + al_((size_t)B_ * 2 * 512 * 64 * 4);
constexpr size_t O_OB = O_O + al_((size_t)T_ * D_ * 4);
constexpr size_t O_PTOT = O_OB + al_((size_t)T_ * D_ * 2);
constexpr size_t O_SEL = O_PTOT + al_((size_t)B_ * 2 * S_ * 512 * 4);
constexpr size_t O_MIX = O_SEL + al_((size_t)B_ * 2 * S_ * NSEL * 4);
constexpr size_t O_X1 = O_MIX + al_((size_t)T_ * D_ * 4);
constexpr size_t O_X1B = O_X1 + al_((size_t)T_ * D_ * 4);
constexpr size_t O_XA = O_X1B + al_((size_t)T_ * D_ * 2);
constexpr size_t O_ACT = O_XA + al_((size_t)T_ * D_ * 4);
constexpr size_t O_Y = O_ACT + al_((size_t)PROWS * D_ * 2);
constexpr size_t O_TOPE = O_Y + al_((size_t)PROWS * D_ * 2);
constexpr size_t O_TOPW = O_TOPE + al_((size_t)MROWS * 4);
constexpr size_t O_POS = O_TOPW + al_((size_t)MROWS * 4);
constexpr size_t O_ROWTOK = O_POS + al_((size_t)MROWS * 4);
constexpr size_t O_ROWW = O_ROWTOK + al_((size_t)PROWS * 4);
constexpr size_t O_SLOT = O_ROWW + al_((size_t)PROWS * 4);
constexpr size_t O_COUNTS = O_SLOT + al_((size_t)MROWS * 4);
constexpr size_t O_META = O_COUNTS + 4096;
constexpr size_t O_OWIN = O_META + 4096;
constexpr size_t O_O2 = O_OWIN + al_((size_t)T_ * 512 * 4);
constexpr size_t O_OWIN2 = O_O2 + al_((size_t)T_ * D_ * 4);
constexpr size_t O_END = O_OWIN2 + al_((size_t)T_ * 512 * 4);

struct P {
    In in; unsigned char* ws; float* out;
};
typedef const __attribute__((address_space(4))) P* KP;
__device__ __forceinline__ KP fresh_kp() { KP k = (KP)__builtin_amdgcn_kernarg_segment_ptr(); asm volatile("" : "+s"(k)); return k; }
#define WSP(T, off) ((T*)(p->ws + (off)))

__device__ __forceinline__ float bf2f(unsigned short b) { return __uint_as_float((unsigned)b << 16); }
__device__ __forceinline__ unsigned f2bf(float f) { unsigned u = __float_as_uint(f); return (u + 0x7fffu + ((u >> 16) & 1u)) >> 16; }
__device__ __forceinline__ unsigned pk2(float lo, float hi) { return f2bf(lo) | (f2bf(hi) << 16); }
__device__ __forceinline__ void ld8(const bf16_t* __restrict__ src, float* dst) {
    const u32x4 v = *(const u32x4*)src;
    dst[0] = __uint_as_float(v.x << 16); dst[1] = __uint_as_float(v.x & 0xffff0000u); dst[2] = __uint_as_float(v.y << 16); dst[3] = __uint_as_float(v.y & 0xffff0000u);
    dst[4] = __uint_as_float(v.z << 16); dst[5] = __uint_as_float(v.z & 0xffff0000u); dst[6] = __uint_as_float(v.w << 16); dst[7] = __uint_as_float(v.w & 0xffff0000u);
}


__device__ __forceinline__ int perm_in(int n) {
    if (n < 1280) return n;
    if (n < 1304) return C_GATE + (n - 1280);
    if (n < 2072) return C_FOX + (n - 1304);
    if (n < 2076) return C_GATE + 24 + (n - 2072);
    return C_SB + (n - 2076);
}
__device__ __forceinline__ int perm_gu(int n) { const int up = n >> 10, c = n & 1023; return 256 * (c >> 7) + 128 * up + (c & 127); }
template <int MAP>
__device__ __forceinline__ void transpose_item(const float* __restrict__ W, int K, int N, bf16_t* __restrict__ WT, LAS float* scr, int item, int lane) {
    const int nblk = (N + 31) / 32, kb = item / nblk, nb = item % nblk, k0 = 64 * kb, n0 = 32 * nb;
    const int nl = lane & 31; const bool okn = (n0 + nl) < N;
#pragma unroll 8
    for (int i = 0; i < 32; ++i) { const int kk = 2 * i + (lane >> 5); scr[kk * 33 + nl] = okn ? W[(size_t)(k0 + kk) * N + n0 + nl] : 0.f; }
    asm volatile("s_waitcnt lgkmcnt(0)" ::: "memory");
    const int c = lane & 7;
#pragma unroll
    for (int j = 0; j < 4; ++j) { const int n = (lane >> 3) + 8 * j; const LAS float* sp = scr + (8 * c) * 33 + n;
        u32x4 o; o.x = pk2(sp[0 * 33], sp[1 * 33]); o.y = pk2(sp[2 * 33], sp[3 * 33]); o.z = pk2(sp[4 * 33], sp[5 * 33]); o.w = pk2(sp[6 * 33], sp[7 * 33]);
        const int ng = n0 + n;
        if (ng < N) { const int ro = (MAP == 1) ? perm_in(ng) : (MAP == 2) ? perm_gu(ng) : ng; *(u32x4*)(WT + (size_t)ro * K + k0 + 8 * c) = o; } }
    asm volatile("s_waitcnt lgkmcnt(0)" ::: "memory");
}
__device__ __forceinline__ void ph_convert(LAS unsigned char* lds, KP p) {
    const int tid = ftid(), lane = tid & 63, wv = tid >> 6;
    LAS float* scr = (LAS float*)(lds + wv * 8448);
    const int gw = fbid() * 8 + wv, NGW = gridDim.x * 8;
    constexpr int I_IN = 16 * 89, I_OUT = 16 * 32, I_GU = 16 * 64, I_DN = 16 * 32;
    constexpr int N_IN = L_ * I_IN, N_OUT = L_ * I_OUT, N_GU = L_ * NE * I_GU, N_DN = L_ * NE * I_DN;
    for (int it = gw; it < N_IN + N_OUT + N_GU + N_DN; it += NGW) {
        int r = it;
        if (r < N_GU) { const int mtx = r / I_GU; transpose_item<2>(p->in.wgu + (size_t)mtx * D_ * 2048, D_, 2048, WSP(bf16_t, O_WTGU) + (size_t)mtx * 2048 * D_, scr, r % I_GU, lane); continue; } r -= N_GU;
        if (r < N_DN) { const int mtx = r / I_DN; transpose_item<0>(p->in.wdn + (size_t)mtx * D_ * D_, D_, D_, WSP(bf16_t, O_WTDN) + (size_t)mtx * D_ * D_, scr, r % I_DN, lane); continue; } r -= N_DN;
        if (r < N_IN) { const int mtx = r / I_IN; transpose_item<1>(p->in.w_in + (size_t)mtx * D_ * DIN, D_, DIN, WSP(bf16_t, O_WTIN) + (size_t)mtx * NPAD * D_, scr, r % I_IN, lane); continue; } r -= N_IN;
        { const int mtx = r / I_OUT; transpose_item<0>(p->in.w_out + (size_t)mtx * D_ * D_, D_, D_, WSP(bf16_t, O_WTOUT) + (size_t)mtx * D_ * D_, scr, r % I_OUT, lane); }
    }
    const int gt = fbid() * NT + tid, NG = gridDim.x * NT;
    for (int i = gt; i < L_ * (NPAD - DIN) * (D_ / 8); i += NG) { const int l = i / ((NPAD - DIN) * (D_ / 8)), r = i % ((NPAD - DIN) * (D_ / 8));
        *(u32x4*)(WSP(bf16_t, O_WTIN) + ((size_t)l * NPAD + DIN) * D_ + (size_t)r * 8) = (u32x4){0u, 0u, 0u, 0u}; }
    for (int i = gt; i < L_ * NPAD; i += NG) { const int l = i / NPAD, c = i % NPAD; if (c >= DIN) WSP(float, O_BIASP)[i] = 0.f; }
    for (int i = gt; i < L_ * DIN; i += NG) { const int l = i / DIN, n = i % DIN; WSP(float, O_BIASP)[l * NPAD + perm_in(n)] = p->in.b_in[i]; }
    for (int i = gt; i < T_ * D_ / 8; i += NG) { const f32x4 a = *(const f32x4*)(p->in.x + (size_t)i * 8), b = *(const f32x4*)(p->in.x + (size_t)i * 8 + 4);
        *(u32x4*)(WSP(bf16_t, O_XB) + (size_t)i * 8) = (u32x4){pk2(a.x, a.y), pk2(a.z, a.w), pk2(b.x, b.y), pk2(b.z, b.w)}; }
}

struct EpiProj {
    static constexpr bool PERM = true;
    bf16_t* projb; float* gf; const float* bias;
    __device__ __forceinline__ void operator()(const pg8::f32x4 (&acc)[2][2][4][2], const pg8::Unit& u, int wr, int wc, int fr, int fq) const {
        const int row0 = u.pm * 256 + wr * 64 + fr, col0 = u.pn * 256 + wc * 32 + 8 * fq;
        if (u.pn < 11) {
#pragma unroll
            for (int ai = 0; ai < 2; ++ai)
#pragma unroll
                for (int m = 0; m < 4; ++m) { bf16_t* rowp = projb + (size_t)(row0 + ai * 128 + m * 16) * PB + col0;
#pragma unroll
                    for (int bj = 0; bj < 2; ++bj) { const f32x4 v0 = acc[ai][bj][m][0] + *(const f32x4*)(bias + col0 + bj * 128), v1 = acc[ai][bj][m][1] + *(const f32x4*)(bias + col0 + bj * 128 + 4);
                        u32x4 w; w.x = pg8::cvt_pk_bf16(v0[0], v0[1]); w.y = pg8::cvt_pk_bf16(v0[2], v0[3]); w.z = pg8::cvt_pk_bf16(v1[0], v1[1]); w.w = pg8::cvt_pk_bf16(v1[2], v1[3]);
                        *(u32x4*)(rowp + bj * 128) = w; }
                    asm volatile("" ::: "memory"); }
        } else if (wc == 0) {
            const f32x4 b0 = *(const f32x4*)(bias + col0), b1 = *(const f32x4*)(bias + col0 + 4);
#pragma unroll
            for (int ai = 0; ai < 2; ++ai)
#pragma unroll
                for (int m = 0; m < 4; ++m) { float* rowp = gf + (size_t)(row0 + ai * 128 + m * 16) * 32 + 8 * fq;
                    const f32x4 v0 = acc[ai][0][m][0] + b0, v1 = acc[ai][0][m][1] + b1; f32x4 o0, o1;
#pragma unroll
                    for (int i = 0; i < 4; ++i) { const int j0 = 8 * fq + i, j1 = j0 + 4;
                        o0[i] = (j0 < 24) ? sigmoidf_(v0[i]) : (j0 < 28 ? logsig(v0[i]) : 0.f); o1[i] = (j1 < 24) ? sigmoidf_(v1[i]) : (j1 < 28 ? logsig(v1[i]) : 0.f); }
                    *(f32x4*)rowp = o0; *(f32x4*)(rowp + 4) = o1; }
        }
    }
};
struct EpiOut {
    static constexpr bool PERM = true;
    const float* x; float* y1;
    __device__ __forceinline__ void operator()(const pg8::f32x4 (&acc)[2][2][4][2], const pg8::Unit& u, int wr, int wc, int fr, int fq) const {
        const int row0 = u.pm * 256 + wr * 64 + fr, col0 = u.pn * 256 + wc * 32 + 8 * fq;
#pragma unroll
        for (int ai = 0; ai < 2; ++ai)
#pragma unroll
            for (int m = 0; m < 4; ++m) { const size_t off = (size_t)(row0 + ai * 128 + m * 16) * D_ + col0;
#pragma unroll
                for (int bj = 0; bj < 2; ++bj) { const f32x4 x0 = *(const f32x4*)(x + off + bj * 128), x1 = *(const f32x4*)(x + off + bj * 128 + 4);
                    *(f32x4*)(y1 + off + bj * 128) = x0 * ALPHA + acc[ai][bj][m][0]; *(f32x4*)(y1 + off + bj * 128 + 4) = x1 * ALPHA + acc[ai][bj][m][1]; }
                asm volatile("" ::: "memory"); }
    }
};
struct EpiGU {
    static constexpr bool PERM = true;
    bf16_t* act; const float* bgu;
    __device__ __forceinline__ void operator()(const pg8::f32x4 (&acc)[2][2][4][2], const pg8::Unit& u, int wr, int wc, int fr, int fq) const {
        const int row0 = u.pm * 256 + wr * 64 + fr, col0 = u.pn * 128 + wc * 32 + 8 * fq;
        const float* bb = bgu + (size_t)u.e * 2048 + col0;
        const f32x4 bg0 = *(const f32x4*)bb, bg1 = *(const f32x4*)(bb + 4), bu0 = *(const f32x4*)(bb + 1024), bu1 = *(const f32x4*)(bb + 1028);
#pragma unroll
        for (int ai = 0; ai < 2; ++ai)
#pragma unroll
            for (int m = 0; m < 4; ++m) { f32x4 a0, a1;
                const f32x4 g0 = acc[ai][0][m][0] + bg0, g1 = acc[ai][0][m][1] + bg1, u0 = acc[ai][1][m][0] + bu0, u1 = acc[ai][1][m][1] + bu1;
#pragma unroll
                for (int i = 0; i < 4; ++i) { const float gt0 = fminf(g0[i], 7.0f), up0 = fminf(fmaxf(u0[i], -7.0f), 7.0f), gt1 = fminf(g1[i], 7.0f), up1 = fminf(fmaxf(u1[i], -7.0f), 7.0f);
                    a0[i] = gt0 * sigmoidf_(1.702f * gt0) * (up0 + 1.0f); a1[i] = gt1 * sigmoidf_(1.702f * gt1) * (up1 + 1.0f); }
                u32x4 w; w.x = pg8::cvt_pk_bf16(a0[0], a0[1]); w.y = pg8::cvt_pk_bf16(a0[2], a0[3]); w.z = pg8::cvt_pk_bf16(a1[0], a1[1]); w.w = pg8::cvt_pk_bf16(a1[2], a1[3]);
                *(u32x4*)(act + (size_t)(row0 + ai * 128 + m * 16) * D_ + col0) = w; asm volatile("" ::: "memory"); }
    }
};
struct EpiDN {
    static constexpr bool PERM = true;
    bf16_t* y; const float* bdn; const float* roww;
    __device__ __forceinline__ void operator()(const pg8::f32x4 (&acc)[2][2][4][2], const pg8::Unit& u, int wr, int wc, int fr, int fq) const {
        const int row0 = u.pm * 256 + wr * 64 + fr, col0 = u.pn * 256 + wc * 32 + 8 * fq;
        const float* bb = bdn + (size_t)u.e * D_ + col0;
#pragma unroll
        for (int ai = 0; ai < 2; ++ai)
#pragma unroll
            for (int m = 0; m < 4; ++m) { const int row = row0 + ai * 128 + m * 16; const float w = roww[row];
#pragma unroll
                for (int bj = 0; bj < 2; ++bj) { const f32x4 v0 = (acc[ai][bj][m][0] + *(const f32x4*)(bb + bj * 128)) * w, v1 = (acc[ai][bj][m][1] + *(const f32x4*)(bb + bj * 128 + 4)) * w;
                    u32x4 o; o.x = pg8::cvt_pk_bf16(v0[0], v0[1]); o.y = pg8::cvt_pk_bf16(v0[2], v0[3]); o.z = pg8::cvt_pk_bf16(v1[0], v1[1]); o.w = pg8::cvt_pk_bf16(v1[2], v1[3]);
                    *(u32x4*)(y + (size_t)row * D_ + col0 + bj * 128) = o; }
                asm volatile("" ::: "memory"); }
    }
};
struct MoeOrder {
    const int* meta; const int* rowtok; const char* Wt; size_t estep, tstep; int nN, G, c, nunits;
    __device__ __forceinline__ bool next(int i, pg8::Unit& u) const {
        const int L = i * G + c; if (L >= nunits) return false;
        const int gt = L / nN; u.pm = gt; u.pn = L - gt * nN; u.e = meta[64 + 2 * gt]; u.nr = meta[65 + 2 * gt]; return true; }
    __device__ __forceinline__ unsigned a_row(const pg8::Unit& u, int r) const { const int rr = r < u.nr ? r : u.nr - 1; const int row = u.pm * 256 + rr; return rowtok ? (unsigned)rowtok[row] : (unsigned)row; }
    __device__ __forceinline__ const char* b_base(const pg8::Unit& u) const { return Wt + (size_t)u.e * estep + (size_t)u.pn * tstep; }
};

struct GEpi {
    static constexpr bool PERM = true;
    int kind, l;
    __device__ __forceinline__ void operator()(const pg8::f32x4 (&acc)[2][2][4][2], const pg8::Unit& u, int wr, int wc, int fr, int fq) const {
        const KP p = fresh_kp();
        if (kind == 0) { const EpiProj e{WSP(bf16_t, O_PROJB), WSP(float, O_GF), WSP(float, O_BIASP) + l * NPAD}; e(acc, u, wr, wc, fr, fq); }
        else if (kind == 1) { const EpiOut e{(l == 0) ? p->in.x : WSP(float, O_XA), WSP(float, O_MIX)}; e(acc, u, wr, wc, fr, fq); }
        else if (kind == 2) { const EpiGU e{WSP(bf16_t, O_ACT), p->in.bgu + (size_t)l * NE * 2048}; e(acc, u, wr, wc, fr, fq); }
        else { const EpiDN e{WSP(bf16_t, O_Y), p->in.bdn + (size_t)l * NE * D_, WSP(float, O_ROWW)}; e(acc, u, wr, wc, fr, fq); }
    }
};
struct GSched {
    int kind, nM, nN, nunits, G, c; const int* meta; const int* rowtok; const char* Bt; size_t estep;
    __device__ __forceinline__ bool next(int i, pg8::Unit& u) const {
        const int L = i * G + c; if (L >= nunits) return false;
        if (kind < 2) {
            int wgid = L; { const int q = nunits / pg8::NXCD, r = nunits % pg8::NXCD, xcd = wgid % pg8::NXCD, off = wgid / pg8::NXCD; wgid = (xcd < r ? xcd * (q + 1) : r * (q + 1) + (xcd - r) * q) + off; }
            const int nig = pg8::WGM * nN, gid = wgid / nig, fm = gid * pg8::WGM, gsz = (nM - fm) < pg8::WGM ? (nM - fm) : pg8::WGM;
            u.pm = fm + ((wgid % nig) % gsz); u.pn = (wgid % nig) / gsz; u.e = 0; u.nr = 256;
        } else { const int gt = L / nN; u.pm = gt; u.pn = L - gt * nN; u.e = meta[64 + 2 * gt]; u.nr = meta[65 + 2 * gt]; }
        return true; }
    __device__ __forceinline__ unsigned a_row(const pg8::Unit& u, int r) const { const int rr = r < u.nr ? r : u.nr - 1; const int row = u.pm * 256 + rr; return (kind == 2) ? (unsigned)rowtok[row] : (unsigned)row; }
    __device__ __forceinline__ const char* b_base(const pg8::Unit& u) const { return Bt + (size_t)u.e * estep + (size_t)u.pn * ((size_t)256 * D_ * 2); }
};

__device__ __forceinline__ void ph_prep(float* lds, KP p, int l) {
    const int tid = ftid();
    const bf16_t* projb = WSP(bf16_t, O_PROJB);
    constexpr int NCB = (NCMP + 3) / 4;
    constexpr int NV_CMP = NCB * B_ * 2 * 2;
    MK_LOOP(vb, NV_CMP + B_ * 4) {
        if (vb < NV_CMP) {
            float* blk = lds; float* hid = lds + 4 * 2048;
            const int kv = vb & 1, bg = (vb >> 1) & 3, nb = vb >> 3, b = bg >> 1, g = bg & 1;
            const float* pos = (kv ? p->in.pos_v : p->in.pos_k) + (size_t)l * 2048; const float* w1 = (kv ? p->in.w1v : p->in.w1k) + (size_t)l * 2048 * 128;
            const float* w2 = (kv ? p->in.w2v : p->in.w2k) + (size_t)l * 128 * 64; float* outp = kv ? WSP(float, O_VCMP) : WSP(float, O_KCMP);
            __syncthreads();
            for (int i = tid; i < 4 * 2048; i += NT) { const int sub = i >> 11, e = i & 2047, ll = e >> 6, d = e & 63; int n = nb * 4 + sub; if (n >= NCMP) n = NCMP - 1;
                blk[i] = bf2f(projb[(size_t)(b * S_ + 16 * n + ll) * PB + C_KV + ((0 * 2 + kv) * 2 + g) * 64 + d]) + pos[e]; }
            __syncthreads();
            const int sub = tid >> 7, j = tid & 127; const float* bl = blk + sub * 2048;
            float a = 0.f;
            for (int i = 0; i < 2048; ++i) a += bl[i] * w1[(size_t)i * 128 + j];
            hid[tid] = gelu_tanh(a);
            __syncthreads();
            const int n = nb * 4 + sub;
            if (j < 64 && n < NCMP) { float o = 0.f; for (int jj = 0; jj < 128; ++jj) o += hid[sub * 128 + jj] * w2[jj * 64 + j]; outp[((size_t)bg * NCMP + n) * 64 + j] = o; }
        } else {
            float* sh = lds; const int bh = vb - NV_CMP, b = bh >> 2, h = bh & 3; float carry = 0.f;
            for (int t0 = 0; t0 < S_; t0 += NT) {
                __syncthreads();
                sh[tid] = WSP(float, O_GF)[(size_t)(b * S_ + t0 + tid) * 32 + 24 + h]; __syncthreads();
                for (int o = 1; o < NT; o <<= 1) { const float add = (tid >= o) ? sh[tid - o] : 0.f; __syncthreads(); sh[tid] += add; __syncthreads(); }
                WSP(float, O_CFOX)[(size_t)bh * S_ + t0 + tid] = carry + sh[tid];
                carry += sh[NT - 1];
            }
        }
    }
}

__device__ __forceinline__ void load_tile_bf(float (*dst)[64], const bf16_t* __restrict__ src, size_t pitch) {
    const int tid = ftid(), r = tid >> 3, c0 = (tid & 7) * 8; float v[8]; ld8(src + (size_t)r * pitch + c0, v);
    *(float4*)&dst[r][c0] = make_float4(v[0], v[1], v[2], v[3]); *(float4*)&dst[r][c0 + 4] = make_float4(v[4], v[5], v[6], v[7]);
}
__device__ __forceinline__ void load_tile512(float (*dst)[64], const float* __restrict__ src, size_t stride, int nrows_valid) {
    const int tid = ftid(), r = tid >> 3, c0 = (tid & 7) * 8;
#pragma unroll
    for (int j = 0; j < 2; ++j) { float4 v = make_float4(0.f, 0.f, 0.f, 0.f); if (r < nrows_valid) v = *(const float4*)(src + (size_t)r * stride + c0 + 4 * j); *(float4*)&dst[r][c0 + 4 * j] = v; }
}
#define MK_LOADQ(q, src) do { _Pragma("unroll") for (int c_ = 0; c_ < 8; ++c_) { float t8_[8]; ld8((src) + 8 * c_, t8_); _Pragma("unroll") for (int e_ = 0; e_ < 8; ++e_) q[8 * c_ + e_] = t8_[e_] * SCALE; } } while (0)

template <int KIND>
__device__ __forceinline__ void attn_vblock(float* lds, KP p, int qb, int bh) {
    float (*Ks)[64] = (float (*)[64])lds; float (*Vs)[64] = (float (*)[64])(lds + 4096); float* Cs = lds + 8192;
    const bf16_t* projb = WSP(bf16_t, O_PROJB); const float* gf = WSP(float, O_GF); float* ob = WSP(float, O_O);
    const int tid = ftid(), q0 = qb * NT, t = q0 + tid;
    if (KIND == 0 || KIND == 1) {
        int b, h, qcol, kcol, vcol, ocol; float slope = 0.f;
        if (KIND == 0) { b = bh >> 2; h = bh & 3; qcol = C_FOX + h * 64; kcol = C_FOX + (4 + h) * 64; vcol = C_FOX + (8 + h) * 64; ocol = 512 + h * 64; }
        else { b = bh >> 3; h = bh & 7; const int g = h >> 2; qcol = h * 64; kcol = C_KV + ((2 * 2 + 0) * 2 + g) * 64; vcol = C_KV + ((2 * 2 + 1) * 2 + g) * 64; ocol = h * 64; slope = exp2f(-(float)(h + 1)); }
        const bf16_t* prow = projb + (size_t)(b * S_ + t) * PB;
        float q[64], o[64];
        MK_LOADQ(q, prow + qcol);
#pragma unroll
        for (int d = 0; d < 64; ++d) o[d] = 0.f;
        float m = -1e30f, l = 0.f, ct = 0.f; const float* cb = WSP(float, O_CFOX) + (size_t)(b * 4 + (h & 3)) * S_;
        if (KIND == 0) ct = cb[t];
        int kt0 = 0; const int kt1 = (q0 + NT - 1) >> 6;
        if (KIND == 1) { kt0 = (q0 - 511) >> 6; if (kt0 < 0) kt0 = 0; }
        for (int kt = kt0; kt <= kt1; ++kt) {
            __syncthreads();
            load_tile_bf(Ks, projb + (size_t)(b * S_ + kt * 64) * PB + kcol, PB);
            load_tile_bf(Vs, projb + (size_t)(b * S_ + kt * 64) * PB + vcol, PB);
            if (KIND == 0 && tid < 64) Cs[tid] = cb[kt * 64 + tid];
            __syncthreads();
            for (int r = 0; r < 64; ++r) {
                const int s = kt * 64 + r; bool ok = (s <= t); if (KIND == 1) ok = ok && (t - s < 512);
                if (ok) { float sc; NV_DOT(q, Ks[r], sc); if (KIND == 0) sc += ct - Cs[r]; else sc -= slope * (float)(t - s); NV_ONLINE(sc, Vs[r]); }
            }
        }
        const float inv = (l > 0.f) ? 1.f / l : 0.f;
        float* orow = ob + (size_t)(b * S_ + t) * D_ + ocol;
        if (KIND == 0) {
#pragma unroll
            for (int d = 0; d < 64; ++d) orow[d] = o[d] * inv;
        } else { const float gate = gf[(size_t)(b * S_ + t) * 32 + 2 * 8 + h]; float* wrow = WSP(float, O_OWIN) + (size_t)(b * S_ + t) * 512 + h * 64;
#pragma unroll
            for (int d = 0; d < 64; ++d) wrow[d] = gate * o[d] * inv; }
    } else if (KIND == 2) {
        const int b = bh >> 2, h = bh & 3;
        const int qcol = C_SB + h * 64, kcol = C_SB + (4 + h) * 64, vcol = C_SB + (8 + h) * 64, ocol = 768 + h * 64;
        const bf16_t* prow = projb + (size_t)(b * S_ + t) * PB;
        float q[64], o[64];
        MK_LOADQ(q, prow + qcol);
#pragma unroll
        for (int d = 0; d < 64; ++d) o[d] = 0.f;
        float later = 0.f;
        for (int kt = (q0 + NT - 1) >> 6; kt >= 0; --kt) {
            __syncthreads();
            load_tile_bf(Ks, projb + (size_t)(b * S_ + kt * 64) * PB + kcol, PB);
            load_tile_bf(Vs, projb + (size_t)(b * S_ + kt * 64) * PB + vcol, PB);
            __syncthreads();
            for (int r = 63; r >= 0; --r) { const int s = kt * 64 + r;
                if (s < t) { float z; NV_DOT(q, Ks[r], z); const float a = expf(logsig(z) + later); NV_AXPY(o, a, Vs[r]); later += logsig(-z); } }
        }
        float* orow = ob + (size_t)(b * S_ + t) * D_ + ocol;
#pragma unroll
        for (int d = 0; d < 64; ++d) orow[d] = o[d];
    } else {
        const int bg = bh, b = bg >> 1, g = bg & 1;
        const bf16_t* prow = projb + (size_t)(b * S_ + t) * PB;
        float* prow_t = WSP(float, O_PTOT) + (size_t)(bg * S_ + t) * 512;
        const float* kcmp = WSP(float, O_KCMP); const float* vcmp = WSP(float, O_VCMP);
        int nmax = (q0 + NT - 1 - 31) / 16 + 1; if (nmax > NCMP) nmax = NCMP;
        const int ntile = (nmax + 63) / 64;
        for (int r4 = 0; r4 < 4; ++r4) {
            const int h = g * 4 + r4; const float slope = exp2f(-(float)(h + 1));
            float q[64], o[64];
            MK_LOADQ(q, prow + h * 64);
#pragma unroll
            for (int d = 0; d < 64; ++d) o[d] = 0.f;
            float m = -1e30f, l = 0.f;
            for (int kt = 0; kt < ntile; ++kt) {
                __syncthreads();
                const int nvr = (NCMP - kt * 64) < 64 ? (NCMP - kt * 64) : 64;
                load_tile512(Ks, kcmp + ((size_t)bg * NCMP + kt * 64) * 64, 64, nvr);
                load_tile512(Vs, vcmp + ((size_t)bg * NCMP + kt * 64) * 64, 64, nvr);
                __syncthreads();
                for (int r = 0; r < nvr; ++r) { const int ce = 16 * (kt * 64 + r) + 31;
                    if (ce <= t) { float sc; NV_DOT(q, Ks[r], sc); sc -= slope * (float)(t - ce); NV_ONLINE(sc, Vs[r]); } }
            }
            const float inv = (l > 0.f) ? 1.f / l : 0.f;
            const float gate = gf[(size_t)(b * S_ + t) * 32 + 0 * 8 + h];
            float* orow = ob + (size_t)(b * S_ + t) * D_ + h * 64;
#pragma unroll
            for (int d = 0; d < 64; ++d) orow[d] = gate * o[d] * inv;
            for (int kt = 0; kt < 8; ++kt) {
                __syncthreads();
                const int nvr = (NCMP - kt * 64) < 64 ? (NCMP - kt * 64) : 64;
                if (kt < ntile) load_tile512(Ks, kcmp + ((size_t)bg * NCMP + kt * 64) * 64, 64, nvr);
                __syncthreads();
                for (int r = 0; r < 64; ++r) { const int n = kt * 64 + r, ce = 16 * n + 31; float pp = 0.f;
                    if (kt < ntile && r < nvr && ce <= t) { float sc; NV_DOT(q, Ks[r], sc); sc -= slope * (float)(t - ce); pp = __expf(sc - m) * inv; }
                    if (r4 == 0) prow_t[n] = pp; else prow_t[n] += pp; }
            }
        }
    }
}
__device__ __forceinline__ void ph_attn_a(float* lds, KP p) {
    constexpr int NQB = S_ / NT;
    constexpr int N_CMP = NQB * B_ * 2, N_FOX = NQB * B_ * 4, N_SB = NQB * B_ * 4;
    MK_LOOP(vb, N_CMP + N_FOX + N_SB) {
        if (vb < N_FOX) { const int qb = NQB - 1 - vb / (B_ * 4); attn_vblock<0>(lds, p, qb, vb % (B_ * 4)); }
        else if (vb < N_FOX + N_SB) { const int v = vb - N_FOX; const int qb = NQB - 1 - v / (B_ * 4); attn_vblock<2>(lds, p, qb, v % (B_ * 4)); }
        else { const int v = vb - N_FOX - N_SB; attn_vblock<3>(lds, p, v / (B_ * 2), v % (B_ * 2)); }
    }
}
__device__ __forceinline__ void ph_select(KP p) {
    const int lane = ftid() & 63, wv = ftid() >> 6; int* sel = WSP(int, O_SEL);
    for (int wave = fbid() * 8 + wv; wave < B_ * 2 * S_; wave += gridDim.x * 8) {
        const int t = wave % S_; const float* pt = WSP(float, O_PTOT) + (size_t)wave * 512; const int cur = t >> 6;
        float v[2];
#pragma unroll
        for (int k = 0; k < 2; ++k) { const int j = lane + 64 * k;
            float imp = pt[4 * j] + pt[4 * j + 1] + pt[4 * j + 2];
            if (4 * j + 3 < NCMP) imp += 0.5f * pt[4 * j + 3];
            if (j >= 1) imp += 0.5f * pt[4 * j - 1];
            const bool valid = j <= cur, forced = valid && (j == 0 || j >= cur - 1);
            v[k] = forced ? 3.0e38f : (valid ? imp : -3.0e38f); }
        for (int it = 0; it < NSEL; ++it) {
            float bv = v[0]; int bi = lane; if (v[1] > bv) { bv = v[1]; bi = lane + 64; }
#pragma unroll
            for (int o = 32; o >= 1; o >>= 1) { const float ov = __shfl_xor(bv, o); const int oi = __shfl_xor(bi, o); if (ov > bv || (ov == bv && oi < bi)) { bv = ov; bi = oi; } }
            if (lane == 0) sel[(size_t)wave * NSEL + it] = bi;
            if (bi == lane) v[0] = -3.4e38f;
            if (bi == lane + 64) v[1] = -3.4e38f;
        }
    }
}
__device__ __forceinline__ void ph_attn_sel(KP p) {
    const bf16_t* projb = WSP(bf16_t, O_PROJB); const int tid = ftid();
    MK_LOOP(vb, (S_ / NT) * B_ * 8) {
        const int qb = vb / (B_ * 8), bh = vb % (B_ * 8), b = bh >> 3, h = bh & 7, g = h >> 2, t = qb * NT + tid;
        const float slope = exp2f(-(float)(h + 1));
        const bf16_t* prow = projb + (size_t)(b * S_ + t) * PB;
        const int kcol = C_KV + ((1 * 2 + 0) * 2 + g) * 64, vcol = C_KV + ((1 * 2 + 1) * 2 + g) * 64;
        const int* sl = WSP(int, O_SEL) + ((size_t)(b * 2 + g) * S_ + t) * NSEL;
        float q[64], o[64];
        MK_LOADQ(q, prow + h * 64);
#pragma unroll
        for (int d = 0; d < 64; ++d) o[d] = 0.f;
        float m = -1e30f, l = 0.f;
        for (int i = 0; i < NSEL; ++i) { const int blk = sl[i];
            for (int r = 0; r < 64; ++r) { const int s = blk * 64 + r;
                if (s <= t) { const bf16_t* kr = projb + (size_t)(b * S_ + s) * PB + kcol; const bf16_t* vr = projb + (size_t)(b * S_ + s) * PB + vcol;
                    float sc = 0.f;
#pragma unroll
                    for (int c = 0; c < 8; ++c) { float k8[8]; ld8(kr + 8 * c, k8);
#pragma unroll
                        for (int e = 0; e < 8; ++e) sc += q[8 * c + e] * k8[e]; }
                    sc -= slope * (float)(t - s);
                    if (sc > m) { const float al = __expf(m - sc); l *= al;
#pragma unroll
                        for (int d = 0; d < 64; ++d) o[d] *= al;
                        m = sc; }
                    const float pp = __expf(sc - m); l += pp;
#pragma unroll
                    for (int c = 0; c < 8; ++c) { float v8[8]; ld8(vr + 8 * c, v8);
#pragma unroll
                        for (int e = 0; e < 8; ++e) o[8 * c + e] += pp * v8[e]; }
                } } }
        const float inv = (l > 0.f) ? 1.f / l : 0.f; const float gate = WSP(float, O_GF)[(size_t)(b * S_ + t) * 32 + 1 * 8 + h];
        float* orow = WSP(float, O_O) + (size_t)(b * S_ + t) * D_ + h * 64;
#pragma unroll
        for (int d = 0; d < 64; ++d) orow[d] += gate * o[d] * inv;
    }
}
__device__ __forceinline__ void ph_attn_win(float* lds, KP p) {
    MK_LOOP(vb, (S_ / NT) * B_ * 8) attn_vblock<1>(lds, p, vb / (B_ * 8), vb % (B_ * 8));
}
__device__ __forceinline__ void ph_rmsnorm(KP p, int l) {
    const int lane = ftid() & 63, wv = ftid() >> 6; const float* g = p->in.g_out + (size_t)l * D_;
    for (int row = fbid() * 8 + wv; row < T_; row += gridDim.x * 8) {
        const float* r = WSP(float, O_O) + (size_t)row * D_; bf16_t* ro = WSP(bf16_t, O_OB) + (size_t)row * D_;
        float a[8], bq[8], s = 0.f, s2 = 0.f;
#pragma unroll
        for (int i = 0; i < 8; ++i) { a[i] = r[lane * 8 + i] + WSP(float, O_OWIN)[(size_t)row * 512 + lane * 8 + i]; s += a[i] * a[i]; bq[i] = r[512 + lane * 8 + i]; s2 += bq[i] * bq[i]; }
        const float sc0 = rsqrtf(wsum(s) * (1.f / 512.f) + RMS_EPS);
#pragma unroll
        for (int o = 1; o < 32; o <<= 1) s2 += __shfl_xor(s2, o);
        const float sc1 = rsqrtf(s2 * (1.f / 256.f) + RMS_EPS);
        float x0[8], x1[8];
#pragma unroll
        for (int i = 0; i < 8; ++i) { x0[i] = a[i] * sc0 * g[lane * 8 + i]; x1[i] = bq[i] * sc1 * g[512 + lane * 8 + i]; }
        *(u32x4*)(ro + lane * 8) = (u32x4){pk2(x0[0], x0[1]), pk2(x0[2], x0[3]), pk2(x0[4], x0[5]), pk2(x0[6], x0[7])};
        *(u32x4*)(ro + 512 + lane * 8) = (u32x4){pk2(x1[0], x1[1]), pk2(x1[2], x1[3]), pk2(x1[4], x1[5]), pk2(x1[6], x1[7])};
    }
}
template <bool ROUTER>
__device__ __forceinline__ void ph_ln(float* lds, KP p, int l, float* __restrict__ yout) {
    const int lane = ftid() & 63, wv = ftid() >> 6;
    const float* g = (ROUTER ? p->in.ln1_g : p->in.ln2_g) + (size_t)l * D_; const float* bb = (ROUTER ? p->in.ln1_b : p->in.ln2_b) + (size_t)l * D_;
    for (int row = fbid() * 8 + wv; row < T_; row += gridDim.x * 8) {
        float v[16], s = 0.f;
        if (ROUTER) { const float* src = WSP(float, O_MIX) + (size_t)row * D_;
#pragma unroll
            for (int j = 0; j < 2; ++j) { const f32x4 a = *(const f32x4*)(src + 512 * j + lane * 8), b = *(const f32x4*)(src + 512 * j + lane * 8 + 4);
                v[8 * j + 0] = a.x; v[8 * j + 1] = a.y; v[8 * j + 2] = a.z; v[8 * j + 3] = a.w; v[8 * j + 4] = b.x; v[8 * j + 5] = b.y; v[8 * j + 6] = b.z; v[8 * j + 7] = b.w; }
        } else { const float* src = WSP(float, O_X1) + (size_t)row * D_; const int* sl = WSP(int, O_SLOT) + row * TOPK; const bf16_t* y = WSP(bf16_t, O_Y);
#pragma unroll
            for (int j = 0; j < 2; ++j) { const f32x4 a = *(const f32x4*)(src + 512 * j + lane * 8), b = *(const f32x4*)(src + 512 * j + lane * 8 + 4);
                v[8 * j + 0] = ALPHA * a.x; v[8 * j + 1] = ALPHA * a.y; v[8 * j + 2] = ALPHA * a.z; v[8 * j + 3] = ALPHA * a.w; v[8 * j + 4] = ALPHA * b.x; v[8 * j + 5] = ALPHA * b.y; v[8 * j + 6] = ALPHA * b.z; v[8 * j + 7] = ALPHA * b.w; }
            float acc[16];
#pragma unroll
            for (int i = 0; i < 16; ++i) acc[i] = 0.f;
#pragma unroll
            for (int k = 0; k < TOPK; ++k) { const bf16_t* yr = y + (size_t)sl[k] * D_;
#pragma unroll
                for (int j = 0; j < 2; ++j) { float t8[8]; ld8(yr + 512 * j + lane * 8, t8);
#pragma unroll
                    for (int e = 0; e < 8; ++e) acc[8 * j + e] += t8[e]; } }
#pragma unroll
            for (int i = 0; i < 16; ++i) v[i] += acc[i]; }
#pragma unroll
        for (int i = 0; i < 16; ++i) s += v[i];
        const float mu = wsum(s) * (1.f / D_); float s2 = 0.f;
#pragma unroll
        for (int i = 0; i < 16; ++i) { v[i] -= mu; s2 += v[i] * v[i]; }
        const float rstd = rsqrtf(wsum(s2) * (1.f / D_) + LN_EPS);
        bf16_t* ybf = (ROUTER ? WSP(bf16_t, O_X1B) : WSP(bf16_t, O_XB)) + (size_t)row * D_;
#pragma unroll
        for (int j = 0; j < 2; ++j) { const int c0 = 512 * j + lane * 8;
#pragma unroll
            for (int e = 0; e < 8; ++e) v[8 * j + e] = v[8 * j + e] * rstd * g[c0 + e] + bb[c0 + e];
            *(f32x4*)(yout + (size_t)row * D_ + c0) = (f32x4){v[8 * j], v[8 * j + 1], v[8 * j + 2], v[8 * j + 3]};
            *(f32x4*)(yout + (size_t)row * D_ + c0 + 4) = (f32x4){v[8 * j + 4], v[8 * j + 5], v[8 * j + 6], v[8 * j + 7]};
            *(u32x4*)(ybf + c0) = (u32x4){pk2(v[8 * j], v[8 * j + 1]), pk2(v[8 * j + 2], v[8 * j + 3]), pk2(v[8 * j + 4], v[8 * j + 5]), pk2(v[8 * j + 6], v[8 * j + 7])}; }
        if (ROUTER) {
            const float* rw = p->in.rw + (size_t)l * D_ * NE; const float* rb = p->in.rb + (size_t)l * NE; int* counts = WSP(int, O_COUNTS) + l * 32;
            float* rowl = lds + wv * 1024;
#pragma unroll
            for (int j = 0; j < 2; ++j)
#pragma unroll
                for (int e = 0; e < 8; ++e) rowl[512 * j + lane * 8 + e] = v[8 * j + e];
            asm volatile("s_waitcnt lgkmcnt(0)" ::: "memory");
            const int e = lane & 31, half = lane >> 5; float lg = 0.f;
            for (int k = 0; k < 512; ++k) lg += rowl[half * 512 + k] * rw[(size_t)(half * 512 + k) * NE + e];
            lg += __shfl_xor(lg, 32); lg += rb[e];
            float cur = lg, tv0 = 0.f, den = 0.f, myw = 0.f; int mye = 0;
#pragma unroll
            for (int k = 0; k < TOPK; ++k) { float bv = cur; int bi = e;
#pragma unroll
                for (int o = 16; o >= 1; o >>= 1) { const float ov = __shfl_xor(bv, o); const int oi = __shfl_xor(bi, o); if (ov > bv || (ov == bv && oi < bi)) { bv = ov; bi = oi; } }
                if (k == 0) tv0 = bv;
                const float w = __expf(bv - tv0); den += w;
                if (lane == k) { mye = bi; myw = w; }
                if (e == bi) cur = -3.4e38f; }
            if (lane < TOPK) { WSP(int, O_TOPE)[row * TOPK + lane] = mye; WSP(float, O_TOPW)[row * TOPK + lane] = myw / den; WSP(int, O_POS)[row * TOPK + lane] = atomicAdd(&counts[mye], 1); }
            asm volatile("s_waitcnt lgkmcnt(0)" ::: "memory");
        }
    }
}
__device__ __forceinline__ void ph_moe_plan(KP p, int l) {
    if (fbid() == 0 && ftid() == 0) { const int* counts = WSP(int, O_COUNTS) + l * 32; int* meta = WSP(int, O_META); int nt = 0;
        for (int e = 0; e < NE; ++e) { meta[e] = nt; const int c = counts[e];
            for (int r = 0; r < c; r += 256) { meta[64 + 2 * nt] = e; meta[65 + 2 * nt] = (c - r) < 256 ? (c - r) : 256; ++nt; } }
        meta[32] = nt; }
}
__device__ __forceinline__ void ph_moe_scatter(KP p) {
    const int* meta = WSP(int, O_META);
    for (int i = fbid() * NT + ftid(); i < MROWS; i += gridDim.x * NT) {
        const int row = meta[WSP(int, O_TOPE)[i]] * 256 + WSP(int, O_POS)[i];
        WSP(int, O_ROWTOK)[row] = i >> 2; WSP(float, O_ROWW)[row] = WSP(float, O_TOPW)[i]; WSP(int, O_SLOT)[i] = row; }
}
}
namespace mk {
typedef short bf16x8 __attribute__((ext_vector_type(8)));
typedef float f32x16 __attribute__((ext_vector_type(16)));
typedef float f32x2_t __attribute__((ext_vector_type(2)));
typedef __bf16 bf16x2_t __attribute__((ext_vector_type(2)));
typedef unsigned u32x2 __attribute__((ext_vector_type(2)));
__device__ __forceinline__ unsigned cvtpk(float lo, float hi) { f32x2_t v = {lo, hi}; bf16x2_t b = __builtin_convertvector(v, bf16x2_t); return __builtin_bit_cast(unsigned, b); }
constexpr int KROW = 144, VROW = 136;
constexpr int E1_K = 0, E1_V = 64 * KROW, E1_C = E1_V + 64 * VROW, E1_BUF = E1_C + 256;
constexpr int E1_FLAGS = 2 * E1_BUF;
constexpr float LOG2E = 1.4426950408889634f;
constexpr float RESC_THR = 8.0f;
#define CROW(reg, hh) (((reg) & 3) + 8 * ((reg) >> 2) + 4 * (hh))

struct E1Geom { int b, q0, h; const bf16_t* qp; const bf16_t* kp; const bf16_t* vp; size_t pitch; };

template <int KIND>
__device__ __forceinline__ void e1_unit(LAS unsigned char* lds, KP p, int b, int hg, int qb, float* __restrict__ obase, float* __restrict__ owin) {
    const int tid = ftid(), lane = tid & 63, w = __builtin_amdgcn_readfirstlane(tid >> 6), r32 = lane & 31, hh = lane >> 5;
    const bf16_t* projb = WSP(bf16_t, O_PROJB);
    int h, q0, qrow0, qcol, kcol, vcol, nrows;
    if (KIND == 0) { h = hg; q0 = qb * 256; qrow0 = q0 + 32 * w; qcol = C_FOX + h * 64; kcol = C_FOX + (4 + h) * 64; vcol = C_FOX + (8 + h) * 64; nrows = 256; }
    else if (KIND == 2) { h = hg; q0 = qb * 256; qrow0 = q0 + 32 * w; qcol = C_SB + h * 64; kcol = C_SB + (4 + h) * 64; vcol = C_SB + (8 + h) * 64; nrows = 256; }
    else { h = 4 * hg + (w & 3); q0 = qb * 64; qrow0 = q0 + 32 * (w >> 2); qcol = h * 64; kcol = C_KV + ((2 * 2 + 0) * 2 + hg) * 64; vcol = C_KV + ((2 * 2 + 1) * 2 + hg) * 64; nrows = 64; }
    const int tq = qrow0 + r32;
    const bf16_t* kbase = projb + (size_t)(b * S_) * PB + kcol; const bf16_t* vbase = projb + (size_t)(b * S_) * PB + vcol;
    bf16x8 qf[4];
    { const bf16_t* qptr = projb + (size_t)(b * S_ + tq) * PB + qcol + 8 * hh;
#pragma unroll
      for (int d0 = 0; d0 < 4; ++d0) qf[d0] = *(const bf16x8*)(qptr + 16 * d0); }
    int j0 = 0; const int j1 = (q0 + nrows - 1) >> 6;
    if (KIND == 1) { j0 = (q0 - 511) >> 6; if (j0 < 0) j0 = 0; }
    const int ntile = j1 - j0 + 1;
    float ct2 = 0.f, sl2 = 0.f; const float* cb = nullptr;
    if (KIND == 0) { cb = WSP(float, O_CFOX) + (size_t)(b * 4 + h) * S_; ct2 = cb[tq] * LOG2E; }
    if (KIND == 1) sl2 = exp2f(-(float)(h + 1)) * LOG2E;
    const float tqf = (float)tq;
    const int skey = tid >> 3, sch = tid & 7;
    u32x4 rk, rv; float rc = 0.f;
#define E1_LOAD(jj) do { const size_t ro_ = (size_t)((jj) * 64 + skey) * PB + sch * 8; rk = *(const u32x4*)(kbase + ro_); rv = *(const u32x4*)(vbase + ro_); \
        if (KIND == 0 && tid < 64) rc = cb[(jj) * 64 + tid] * LOG2E; } while (0)
#define E1_WRITE(bufp) do { *(LAS u32x4*)((bufp) + E1_K + skey * KROW + sch * 16) = rk; \
        LAS unsigned short* vt_ = (LAS unsigned short*)((bufp) + E1_V + (8 * sch) * VROW) + skey; \
        vt_[0 * (VROW / 2)] = (unsigned short)(rv.x & 0xffffu); vt_[1 * (VROW / 2)] = (unsigned short)(rv.x >> 16); vt_[2 * (VROW / 2)] = (unsigned short)(rv.y & 0xffffu); vt_[3 * (VROW / 2)] = (unsigned short)(rv.y >> 16); \
        vt_[4 * (VROW / 2)] = (unsigned short)(rv.z & 0xffffu); vt_[5 * (VROW / 2)] = (unsigned short)(rv.z >> 16); vt_[6 * (VROW / 2)] = (unsigned short)(rv.w & 0xffffu); vt_[7 * (VROW / 2)] = (unsigned short)(rv.w >> 16); \
        if (KIND == 0 && tid < 64) ((LAS float*)((bufp) + E1_C))[tid] = rc; } while (0)
    f32x16 o0, o1;
#pragma unroll
    for (int r = 0; r < 16; ++r) { o0[r] = 0.f; o1[r] = 0.f; }
    float m = -1e30f, l = 0.f, carry = 0.f;
    bool wave_done = false;
    LAS unsigned* flags = (LAS unsigned*)(lds + E1_FLAGS);
    if (KIND == 2) { if (tid < 8) flags[tid] = 0u; }
    __syncthreads();
    E1_LOAD(KIND == 2 ? j1 : j0);
    for (int it = 0; it < ntile; ++it) {
        const int j = (KIND == 2) ? (j1 - it) : (j0 + it);
        LAS unsigned char* buf = lds + (it & 1) * E1_BUF;
        E1_WRITE(buf);
        __syncthreads();
        if (KIND == 2) { unsigned alld = 1u;
#pragma unroll
            for (int i = 0; i < 8; ++i) alld &= flags[i];
            if (alld) break; }
        if (it + 1 < ntile) E1_LOAD((KIND == 2) ? (j - 1) : (j + 1));
        if (!(KIND == 2 && wave_done)) {
            f32x16 p0, p1;
#pragma unroll
            for (int r = 0; r < 16; ++r) { p0[r] = 0.f; p1[r] = 0.f; }
            { const LAS unsigned char* kp_ = buf + E1_K + r32 * KROW + hh * 16;
#pragma unroll
              for (int d0 = 0; d0 < 4; ++d0) { const bf16x8 a0 = *(const LAS bf16x8*)(kp_ + d0 * 32), a1 = *(const LAS bf16x8*)(kp_ + 32 * KROW + d0 * 32);
                  p0 = __builtin_amdgcn_mfma_f32_32x32x16_bf16(a0, qf[d0], p0, 0, 0, 0); p1 = __builtin_amdgcn_mfma_f32_32x32x16_bf16(a1, qf[d0], p1, 0, 0, 0); } }
            const int kb = j * 64 + 4 * hh;
            if (KIND == 2) {
                float lk0[16], lk1[16], gs[8];
#pragma unroll
                for (int reg = 0; reg < 16; ++reg) { const int kpos = kb + CROW(reg, 0);
                    const float z0 = p0[reg] * SCALE, z1 = p1[reg] * SCALE; const bool v0 = kpos < tq, v1 = kpos + 32 < tq;
                    const float lb0 = fminf(z0, 0.f) - __logf(1.f + __expf(-fabsf(z0))), lb1 = fminf(z1, 0.f) - __logf(1.f + __expf(-fabsf(z1)));
                    lk0[reg] = v0 ? (lb0 - z0) : 0.f; lk1[reg] = v1 ? (lb1 - z1) : 0.f;
                    p0[reg] = v0 ? lb0 : -INFINITY; p1[reg] = v1 ? lb1 : -INFINITY; }
#pragma unroll
                for (int g4 = 0; g4 < 4; ++g4) { gs[g4] = (lk0[4 * g4] + lk0[4 * g4 + 1]) + (lk0[4 * g4 + 2] + lk0[4 * g4 + 3]); gs[4 + g4] = (lk1[4 * g4] + lk1[4 * g4 + 1]) + (lk1[4 * g4 + 2] + lk1[4 * g4 + 3]); }
                float oth[8];
#pragma unroll
                for (int gi = 0; gi < 8; ++gi) oth[gi] = __shfl_xor(gs[gi], 32);
                float run = 0.f;
#pragma unroll
                for (int gi = 7; gi >= 0; --gi) {
                    float later = carry + run + (hh == 0 ? oth[gi] : 0.f);
#pragma unroll
                    for (int e = 3; e >= 0; --e) { const int reg = (gi & 3) * 4 + e;
                        if (gi >> 2) { p1[reg] = __expf(p1[reg] + later); later += lk1[reg]; } else { p0[reg] = __expf(p0[reg] + later); later += lk0[reg]; } }
                    run += gs[gi] + oth[gi]; }
                carry += run;
            } else {
                if (KIND == 0) {
                    const LAS float* cs = (const LAS float*)(buf + E1_C) + 4 * hh;
#pragma unroll
                    for (int i = 0; i < 4; ++i) { const f32x4 c0 = *(const LAS f32x4*)(cs + 8 * i), c1 = *(const LAS f32x4*)(cs + 32 + 8 * i);
#pragma unroll
                        for (int e = 0; e < 4; ++e) { const int reg = 4 * i + e; const int kpos = kb + CROW(reg, 0);
                            const float s0 = p0[reg] * (SCALE * LOG2E) + (ct2 - c0[e]), s1 = p1[reg] * (SCALE * LOG2E) + (ct2 - c1[e]);
                            p0[reg] = (kpos <= tq) ? s0 : -INFINITY; p1[reg] = (kpos + 32 <= tq) ? s1 : -INFINITY; } }
                } else {
#pragma unroll
                    for (int reg = 0; reg < 16; ++reg) { const int kpos = kb + CROW(reg, 0); const float d0f = tqf - (float)kpos, d1f = d0f - 32.f;
                        const float s0 = p0[reg] * (SCALE * LOG2E) - sl2 * d0f, s1 = p1[reg] * (SCALE * LOG2E) - sl2 * d1f;
                        p0[reg] = (kpos <= tq && tq - kpos < 512) ? s0 : -INFINITY; p1[reg] = (kpos + 32 <= tq && tq - kpos - 32 < 512) ? s1 : -INFINITY; }
                }
                float rm = fmaxf(p0[0], p1[0]);
#pragma unroll
                for (int reg = 1; reg < 16; ++reg) rm = fmaxf(rm, fmaxf(p0[reg], p1[reg]));
                rm = fmaxf(rm, __shfl_xor(rm, 32));
                if (__any(rm > m + RESC_THR)) { const float mn = fmaxf(m, rm), al = __builtin_amdgcn_exp2f(m - mn); l *= al;
#pragma unroll
                    for (int r = 0; r < 16; ++r) { o0[r] *= al; o1[r] *= al; }
                    m = mn; }
                float ls = 0.f;
#pragma unroll
                for (int reg = 0; reg < 16; ++reg) { p0[reg] = __builtin_amdgcn_exp2f(p0[reg] - m); p1[reg] = __builtin_amdgcn_exp2f(p1[reg] - m); ls += p0[reg] + p1[reg]; }
                l += ls;
            }
            { const LAS unsigned char* vp_ = buf + E1_V + r32 * VROW + hh * 8;
#pragma unroll
              for (int s = 0; s < 4; ++s) {
                  u32x4 pw;
                  if (s < 2) { pw.x = cvtpk(p0[8 * s + 0], p0[8 * s + 1]); pw.y = cvtpk(p0[8 * s + 2], p0[8 * s + 3]); pw.z = cvtpk(p0[8 * s + 4], p0[8 * s + 5]); pw.w = cvtpk(p0[8 * s + 6], p0[8 * s + 7]); }
                  else { const int s2 = s - 2; pw.x = cvtpk(p1[8 * s2 + 0], p1[8 * s2 + 1]); pw.y = cvtpk(p1[8 * s2 + 2], p1[8 * s2 + 3]); pw.z = cvtpk(p1[8 * s2 + 4], p1[8 * s2 + 5]); pw.w = cvtpk(p1[8 * s2 + 6], p1[8 * s2 + 7]); }
                  const bf16x8 pb = __builtin_bit_cast(bf16x8, pw);
                  const u32x2 a0l = *(const LAS u32x2*)(vp_ + s * 32), a0h = *(const LAS u32x2*)(vp_ + s * 32 + 16);
                  const u32x2 a1l = *(const LAS u32x2*)(vp_ + 32 * VROW + s * 32), a1h = *(const LAS u32x2*)(vp_ + 32 * VROW + s * 32 + 16);
                  const bf16x8 va0 = __builtin_bit_cast(bf16x8, (u32x4){a0l.x, a0l.y, a0h.x, a0h.y}), va1 = __builtin_bit_cast(bf16x8, (u32x4){a1l.x, a1l.y, a1h.x, a1h.y});
                  o0 = __builtin_amdgcn_mfma_f32_32x32x16_bf16(va0, pb, o0, 0, 0, 0); o1 = __builtin_amdgcn_mfma_f32_32x32x16_bf16(va1, pb, o1, 0, 0, 0); } }
            if (KIND == 2) { const bool dn = __all(carry < -110.f);
                if (dn && !wave_done) { wave_done = true; if (lane == 0) flags[w] = 1u; } }
        }
    }
    float inv = 1.f, gate = 1.f;
    if (KIND != 2) { l += __shfl_xor(l, 32); inv = (l > 0.f) ? 1.f / l : 0.f; }
    float* orow;
    if (KIND == 0) orow = obase + (size_t)(b * S_ + tq) * D_ + 512 + h * 64;
    else if (KIND == 2) orow = obase + (size_t)(b * S_ + tq) * D_ + 768 + h * 64;
    else { orow = owin + (size_t)(b * S_ + tq) * 512 + h * 64; gate = WSP(float, O_GF)[(size_t)(b * S_ + tq) * 32 + 2 * 8 + h]; }
    const float sc = inv * gate;
#pragma unroll
    for (int i = 0; i < 4; ++i) {
        *(f32x4*)(orow + 8 * i + 4 * hh) = (f32x4){o0[4 * i] * sc, o0[4 * i + 1] * sc, o0[4 * i + 2] * sc, o0[4 * i + 3] * sc};
        *(f32x4*)(orow + 32 + 8 * i + 4 * hh) = (f32x4){o1[4 * i] * sc, o1[4 * i + 1] * sc, o1[4 * i + 2] * sc, o1[4 * i + 3] * sc}; }
#undef E1_LOAD
#undef E1_WRITE
}
}
namespace mk {
template <bool WITH_CMP>
__device__ __forceinline__ void ph_attn1(float* lds, LAS unsigned char* lds3, KP p, unsigned* qctr, float* obase, float* owin) {
    LAS int* qslot = (LAS int*)(lds3 + E1_FLAGS + 64);
    constexpr int N_CMP = WITH_CMP ? 64 : 0, N_FOX = 256, N_WIN = 512, N_SB = 256;
    for (;;) {
        __syncthreads();
        if (ftid() == 0) *qslot = (int)atomicAdd(qctr, 1u);
        __syncthreads();
        const int u = __builtin_amdgcn_readfirstlane(*qslot);
        if (u >= N_CMP + N_FOX + N_WIN + N_SB) break;
        if (u < N_CMP) attn_vblock<3>(lds, p, 15 - (u >> 2), u & 3);
        else if (u < N_CMP + N_FOX) { const int v = u - N_CMP; e1_unit<0>(lds3, p, (v & 7) >> 2, v & 3, 31 - (v >> 3), obase, owin); }
        else if (u < N_CMP + N_FOX + N_WIN) { const int v = u - N_CMP - N_FOX; e1_unit<1>(lds3, p, (v & 3) >> 1, v & 1, 127 - (v >> 2), obase, owin); }
        else { const int v = u - N_CMP - N_FOX - N_WIN; e1_unit<2>(lds3, p, (v & 7) >> 2, v & 3, 31 - (v >> 3), obase, owin); }
    }
}
__device__ __forceinline__ void ph_dbg_compare(KP p) {
    float num[3] = {0.f, 0.f, 0.f}, den[3] = {0.f, 0.f, 0.f};
    for (size_t i = (size_t)fbid() * NT + ftid(); i < (size_t)T_ * 512; i += (size_t)gridDim.x * NT) {
        const size_t row = i >> 9; const int c = (int)(i & 511);
        const float a = WSP(float, O_O2)[row * D_ + 512 + c], b = WSP(float, O_O)[row * D_ + 512 + c];
        const int k = c >> 8; num[k] += (a - b) * (a - b); den[k] += b * b;
        const float aw = WSP(float, O_OWIN2)[i], bw = WSP(float, O_OWIN)[i]; num[2] += (aw - bw) * (aw - bw); den[2] += bw * bw; }
    float* dbg = WSP(float, O_COUNTS) + 256;
#pragma unroll
    for (int k = 0; k < 3; ++k) { const float n = wsum(num[k]), d = wsum(den[k]); if ((ftid() & 63) == 0) { atomicAdd(&dbg[2 * k], n); atomicAdd(&dbg[2 * k + 1], d); } }
}
__device__ __forceinline__ void ph_dbg_encode(KP p, int ka, int kb) {
    const float* dbg = WSP(float, O_COUNTS) + 256;
    const float ea = sqrtf(dbg[2 * ka] / fmaxf(dbg[2 * ka + 1], 1e-30f)), eb = sqrtf(dbg[2 * kb] / fmaxf(dbg[2 * kb + 1], 1e-30f));
    for (size_t i = (size_t)fbid() * NT + ftid(); i < (size_t)T_ * D_; i += (size_t)gridDim.x * NT) { float v = p->out[i] * (1.f + 10.f * ea); if (i == 0) v += 1e4f * eb; p->out[i] = v; }
}
}
namespace cg = cooperative_groups;
__global__ void __launch_bounds__(512, 2) mega(mk::P p_unused) {
    extern __shared__ __attribute__((aligned(16))) unsigned char lds_raw[];
    float* lds = (float*)lds_raw;
    LAS unsigned char* lds3 = (LAS unsigned char*)lds_raw;
    cg::grid_group grid = cg::this_grid();
    using namespace nv; using namespace mk;
    for (int step = 0; step < 1 + 14 * L_; ++step) {
        const KP p = fresh_kp();
        const int l = (step - 1) / 14, k = (step == 0) ? -1 : (step - 1) % 14;
        const bool isg = (k == 0 || k == 7 || k == 11 || k == 12);
        if (isg) {
            const int kind = (k == 0) ? 0 : (k == 7) ? 1 : (k == 11) ? 2 : 3;
            GSched S; GEpi E; S.kind = kind; E.kind = kind; E.l = l;
            S.G = (int)gridDim.x; S.c = fbid(); S.meta = WSP(int, O_META); S.rowtok = WSP(int, O_ROWTOK); S.estep = 0;
            const char* A; int N;
            if (kind == 0) { A = (const char*)WSP(bf16_t, O_XB); S.Bt = (const char*)(WSP(bf16_t, O_WTIN) + (size_t)l * NPAD * D_); N = NPAD; }
            else if (kind == 1) { A = (const char*)WSP(bf16_t, O_OB); S.Bt = (const char*)(WSP(bf16_t, O_WTOUT) + (size_t)l * D_ * D_); N = D_; }
            else if (kind == 2) { A = (const char*)WSP(bf16_t, O_X1B); S.Bt = (const char*)(WSP(bf16_t, O_WTGU) + (size_t)l * NE * 2048 * D_); S.estep = (size_t)2048 * D_ * 2; N = 2048; }
            else { A = (const char*)WSP(bf16_t, O_ACT); S.Bt = (const char*)(WSP(bf16_t, O_WTDN) + (size_t)l * NE * D_ * D_); S.estep = (size_t)D_ * D_ * 2; N = D_; }
            S.nN = N / 256; S.nM = (kind < 2) ? T_ / 256 : S.meta[32]; S.nunits = S.nM * S.nN;
            pg8::gemm_phase<GEpi, GSched>(lds3, A, D_, S, E);
        } else {
            switch (k) {
                case -1: ph_convert(lds3, p); break;
                case 1: ph_prep(lds, p, l); break;
#ifdef DBG_ATTN
                case 2: ph_attn_a(lds, p); break;
#else
                case 2: ph_attn1<true>(lds, lds3, p, WSP(unsigned, O_COUNTS) + 128 + l, WSP(float, O_O), WSP(float, O_OWIN)); break;
#endif
                case 3: ph_select(p); break;
                case 4: ph_attn_sel(p); break;
#ifdef DBG_ATTN
                case 5: ph_attn_win(lds, p); grid.sync();
                        if (l == 0) { ph_attn1<false>(lds, lds3, p, WSP(unsigned, O_COUNTS) + 128 + l, WSP(float, O_O2), WSP(float, O_OWIN2)); grid.sync(); ph_dbg_compare(p); }
                        break;
#else
                case 5: break;
#endif
                case 6: ph_rmsnorm(p, l); break;
                case 8: ph_ln<true>(lds, p, l, WSP(float, O_X1)); break;
                case 9: ph_moe_plan(p, l); break;
                case 10: ph_moe_scatter(p); break;
                default: { float* xout = (l == L_ - 1) ? p->out : WSP(float, O_XA); ph_ln<false>(lds, p, l, xout); } break;
            }
        }
        grid.sync();
    }
#ifdef DBG_ATTN
    { const KP p = fresh_kp(); ph_dbg_encode(p, DBG_KA, DBG_KB); }
#endif
}

extern "C" void kernel_launch(void* const* d_in, const int* in_sizes, int n_in,
                              void* d_out, int out_size, void* d_ws, size_t ws_size,
                              hipStream_t stream) {
    constexpr size_t kDynLds = 147456;
    static int grid_blocks = 0;
    if (!grid_blocks) {
        int dev = 0, cus = 0, per_cu = 0;
        (void)hipGetDevice(&dev);
        (void)hipDeviceGetAttribute(&cus, hipDeviceAttributeMultiprocessorCount, dev);
        (void)hipFuncSetAttribute((const void*)mega, hipFuncAttributeMaxDynamicSharedMemorySize, (int)kDynLds);
        (void)hipOccupancyMaxActiveBlocksPerMultiprocessor(&per_cu, mega, 512, kDynLds);
        if (per_cu < 1) per_cu = 1;
        if (per_cu > 1) per_cu = 1;
        grid_blocks = cus * per_cu;
        if (ws_size < mk::O_END) fprintf(stderr, "workspace too small: %zu < %zu\n", ws_size, (size_t)mk::O_END);
    }
    mk::P p{};
    p.in = nv::inputs(d_in); p.ws = (unsigned char*)d_ws; p.out = (float*)d_out;
    (void)hipMemsetAsync((char*)d_ws + mk::O_COUNTS, 0, 4096, stream);
    void* args[] = {&p};
    hipError_t e = hipLaunchCooperativeKernel((void*)mega, dim3(grid_blocks), dim3(512), args, kDynLds, stream);
    if (e != hipSuccess) fprintf(stderr, "cooperative launch failed: %s (grid %d)\n", hipGetErrorString(e), grid_blocks);
}
```

```cpp
#include <hip/hip_runtime.h>
#include <hip/hip_cooperative_groups.h>
#include <cstdio>
#include <cstdint>

namespace nv {

constexpr int B_ = 2, S_ = 8192, D_ = 1024, T_ = B_ * S_, L_ = 2;
constexpr int DIN = 2844;
constexpr int OFF_NSA_KV = 512, OFF_NSA_GATE = 1280, OFF_FOX_QKV = 1304, OFF_FOX_F = 2072, OFF_SB_QKV = 2076;
constexpr int NCMP = 511, NBLK = 128, NSEL = 16;
constexpr int NE = 32, TOPK = 4, MROWS = T_ * TOPK;
constexpr float LN_EPS = 1e-5f, RMS_EPS = 1e-6f;
constexpr float ALPHA = 1.4142135623730951f;
constexpr float SCALE = 0.125f;

__device__ __forceinline__ float sigmoidf_(float x) { return 1.f / (1.f + __expf(-x)); }
__device__ __forceinline__ float logsig(float x) { return fminf(x, 0.f) - log1pf(expf(-fabsf(x))); }

__device__ __forceinline__ float gelu_tanh(float x) { return 0.5f * x * (1.f + tanhf(0.7978845608028654f * (x + 0.044715f * x * x * x))); }
#define NV_DOT(q, kr, res) do { float s0_ = 0.f, s1_ = 0.f, s2_ = 0.f, s3_ = 0.f; _Pragma("unroll") for (int d_ = 0; d_ < 64; d_ += 4) { const float4 k4_ = *(const float4*)&(kr)[d_]; s0_ += q[d_] * k4_.x; s1_ += q[d_ + 1] * k4_.y; s2_ += q[d_ + 2] * k4_.z; s3_ += q[d_ + 3] * k4_.w; } res = (s0_ + s1_) + (s2_ + s3_); } while (0)
#define NV_AXPY(o, p, vr) do { _Pragma("unroll") for (int d_ = 0; d_ < 64; d_ += 4) { const float4 v4_ = *(const float4*)&(vr)[d_]; o[d_] += p * v4_.x; o[d_ + 1] += p * v4_.y; o[d_ + 2] += p * v4_.z; o[d_ + 3] += p * v4_.w; } } while (0)
#define NV_ONLINE(sc, vr) do { if (sc > m) { const float al_ = __expf(m - sc); l *= al_; _Pragma("unroll") for (int d_ = 0; d_ < 64; ++d_) o[d_] *= al_; m = sc; } const float p_ = __expf(sc - m); l += p_; NV_AXPY(o, p_, vr); } while (0)

__device__ __forceinline__ float wsum(float v) {
#pragma unroll
    for (int o = 1; o < 64; o <<= 1) v += __shfl_xor(v, o);
    return v;
}
struct In {
    const float *x, *w_in, *b_in, *pos_k, *pos_v, *w1k, *w2k, *w1v, *w2v, *g_out, *w_out, *ln1_g, *ln1_b, *rw, *rb, *wgu, *bgu, *wdn, *bdn, *ln2_g, *ln2_b;
};
inline In inputs(void* const* d) {
    In i; i.x = (const float*)d[0]; i.w_in = (const float*)d[1]; i.b_in = (const float*)d[2]; i.pos_k = (const float*)d[3]; i.pos_v = (const float*)d[4];
    i.w1k = (const float*)d[5]; i.w2k = (const float*)d[6]; i.w1v = (const float*)d[7]; i.w2v = (const float*)d[8]; i.g_out = (const float*)d[9]; i.w_out = (const float*)d[10];
    i.ln1_g = (const float*)d[11]; i.ln1_b = (const float*)d[12]; i.rw = (const float*)d[13]; i.rb = (const float*)d[14]; i.wgu = (const float*)d[15]; i.bgu = (const float*)d[16];
    i.wdn = (const float*)d[17]; i.bdn = (const float*)d[18]; i.ln2_g = (const float*)d[19]; i.ln2_b = (const float*)d[20]; return i;
}


}
namespace pg8 {
#define PG8_LAS __attribute__((address_space(3)))
typedef unsigned short bf16_t;
typedef short bf16x8 __attribute__((ext_vector_type(8)));
typedef float f32x4 __attribute__((ext_vector_type(4)));
typedef unsigned u32x4 __attribute__((ext_vector_type(4)));
constexpr int BM = 256, BK = 64, HALF = 128, HTB = HALF * BK * 2  , STAGE_BYTES = 8 * HTB, NXCD = 8, WGM = 8;

__host__ __device__ __forceinline__ int lds_byte(int r, int c) { const int st = (r >> 4) * 2 + (c >> 5), rr = r & 15, cc = c & 31, ob = rr * 64 + cc * 2; return st * 1024 + (ob ^ (((ob >> 9) & 1) << 5)); }
__host__ __device__ __forceinline__ void stage_rc(int b, int& R, int& C) { const int st = b / 1024, sb = b % 1024, swz = sb ^ (((sb >> 9) & 1) << 5); R = (st >> 1) * 16 + swz / 64; C = (st & 1) * 32 + (swz % 64) / 2; }
__host__ __device__ __forceinline__ int perm32(int rho) { const int n = rho >> 4, i = rho & 15; return 8 * (i >> 2) + 4 * n + (i & 3); }

struct Unit { int pm, pn, e, nr; };

struct StaticOrder {
    int nM, nN, nwg, G, c;
    __host__ __device__ void init(int M, int N, int G_, int c_) { nM = M / BM; nN = N / BM; nwg = nM * nN; G = G_; c = c_; }
    __host__ __device__ bool next(int i, Unit& u) const {
        const long L = (long)i * G + c; if (L >= nwg) return false;
        int wgid = (int)L; { const int q = nwg / NXCD, r = nwg % NXCD, xcd = wgid % NXCD, off = wgid / NXCD; wgid = (xcd < r ? xcd * (q + 1) : r * (q + 1) + (xcd - r) * q) + off; }
        const int nig = WGM * nN, gid = wgid / nig, fm = gid * WGM, gsz = (nM - fm) < WGM ? (nM - fm) : WGM;
        u.pm = fm + ((wgid % nig) % gsz); u.pn = (wgid % nig) / gsz; u.e = 0; u.nr = BM; return true;
    }
    const char* Bt; size_t tstep;
    __device__ __forceinline__ unsigned a_row(const Unit& u, int r) const { return (unsigned)(u.pm * BM + r); }
    __device__ __forceinline__ const char* b_base(const Unit& u) const { return Bt + (size_t)u.pn * tstep; }
};


__device__ __forceinline__ unsigned cvt_pk_bf16(float lo, float hi) { unsigned r; asm volatile("v_cvt_pk_bf16_f32 %0, %1, %2" : "=v"(r) : "v"(lo), "v"(hi)); return r; }
template <class Epi, class Sched, bool ALIGN_EPI = true, bool SP2 = true>
__device__ __forceinline__ void gemm_phase(PG8_LAS unsigned char* lds, const char* Abase, const int K, const Sched& S, const Epi& E) {
    int tid_ = threadIdx.x; asm volatile("" : "+v"(tid_));
    const int tid = tid_, wid = __builtin_amdgcn_readfirstlane(tid >> 6), lane = tid & 63, wr = wid >> 2, wc = wid & 3, fr = lane & 15, fq = lane >> 4;
    const int nt = K / BK;
    unsigned voffB[2];
#pragma unroll
    for (int i = 0; i < 2; ++i) { int R, C; stage_rc(tid * 16 + i * 8192, R, C); const int Rb = Epi::PERM ? ((R & ~31) + perm32(R & 31)) : R;
        voffB[i] = (unsigned)(Rb * K + C) * 2u; }
#define PG8_AOFF(u, o0, o1) do { int _t = tid; asm volatile("" : "+v"(_t)); _Pragma("unroll") for (int _i = 0; _i < 2; ++_i) { int _R, _C; stage_rc(_t * 16 + _i * 8192, _R, _C); \
        (o0)[_i] = (S.a_row((u), _R) * (unsigned)K + (unsigned)_C) * 2u; (o1)[_i] = (S.a_row((u), HALF + _R) * (unsigned)K + (unsigned)_C) * 2u; } } while (0)
    const size_t kstep = (size_t)(BK * 2);
    const size_t hstep = (size_t)HALF * K * 2;
    const unsigned ldsw = (unsigned)wid * 1024u;
    const int aoff = lds_byte(wr * 64 + fr, fq * 8), boff = lds_byte(wc * 32 + fr, fq * 8);
#define PG8_SA(b, h) (((b) * 2 + (h)) * HTB)
#define PG8_SB(b, h) ((4 + (b) * 2 + (h)) * HTB)
#define PG8_STAGE(bufoff, gbase, voff) do { _Pragma("unroll") for (int _i = 0; _i < 2; ++_i) { unsigned _o = (voff)[_i]; asm volatile("" : "+v"(_o));     \
        __builtin_amdgcn_global_load_lds((const unsigned*)((const char*)(gbase) + _o), (PG8_LAS unsigned*)(lds + (bufoff) + ldsw + _i * 8192), 16, 0, 0); } } while (0)
#define PG8_LDA(dst, b, h) do { _Pragma("unroll") for (int m = 0; m < 4; ++m) _Pragma("unroll") for (int k = 0; k < 2; ++k) dst[m][k] = *(const PG8_LAS bf16x8*)(lds + PG8_SA(b, h) + aoff + m * 2048 + k * 1024); } while (0)
#define PG8_LDB(dst, b, h) do { _Pragma("unroll") for (int n = 0; n < 2; ++n) _Pragma("unroll") for (int k = 0; k < 2; ++k) dst[n][k] = *(const PG8_LAS bf16x8*)(lds + PG8_SB(b, h) + boff + n * 2048 + k * 1024); } while (0)
#define PG8_MMA(ai, bj, At, Bt) do { __builtin_amdgcn_s_setprio(1); _Pragma("unroll") for (int m = 0; m < 4; ++m) _Pragma("unroll") for (int n = 0; n < 2; ++n) _Pragma("unroll") for (int k = 0; k < 2; ++k) \
        acc[ai][bj][m][n] = __builtin_amdgcn_mfma_f32_16x16x32_bf16(Bt[n][k], At[m][k], acc[ai][bj][m][n], 0, 0, 0); __builtin_amdgcn_s_setprio(0); } while (0)
#define PG8_WAIT_V(n) asm volatile("s_waitcnt vmcnt(" #n ")" ::: "memory")
#define PG8_WAIT_L(n) asm volatile("s_waitcnt lgkmcnt(" #n ")" ::: "memory")
#define PG8_BAR __builtin_amdgcn_s_barrier()
#define PG8_SCHED __builtin_amdgcn_sched_barrier(0)
    Unit cur, nxt; int ui = 0;
    if (!S.next(0, cur)) return;
    f32x4 acc[2][2][4][2];
    float zf_ = 0.f; asm volatile("" : "+v"(zf_));
#pragma unroll
    for (int a = 0; a < 2; ++a)
#pragma unroll
        for (int b = 0; b < 2; ++b)
#pragma unroll
            for (int m = 0; m < 4; ++m)
#pragma unroll
                for (int n = 0; n < 2; ++n) acc[a][b][m][n] = (f32x4){zf_, zf_, zf_, zf_};
    bf16x8 At[4][2], B0[2][2], B1[2][2];
    unsigned ca0[2], ca1[2], na0[2], na1[2];
    PG8_AOFF(cur, ca0, ca1);
    const char* const cA = Abase; const char* cB = S.b_base(cur);
    if constexpr (SP2) {
        PG8_STAGE(PG8_SB(0, 0), cB, voffB); PG8_STAGE(PG8_SB(0, 1), cB + hstep, voffB); PG8_STAGE(PG8_SA(0, 0), cA, ca0); PG8_STAGE(PG8_SA(0, 1), cA, ca1);
        if (wr == 1) PG8_BAR;
        PG8_WAIT_V(2); PG8_BAR;
        PG8_STAGE(PG8_SB(1, 0), cB + kstep, voffB); PG8_STAGE(PG8_SA(1, 0), cA + kstep, ca0); PG8_STAGE(PG8_SB(1, 1), cB + hstep + kstep, voffB);
        PG8_WAIT_V(6); PG8_BAR;
    } else { static_assert(SP2, "only the SP2 loop is kept"); }
    for (;;) {
        const bool has_next = S.next(ui + 1, nxt);
        const char* nB = has_next ? S.b_base(nxt) : cB;
        if (has_next) { PG8_AOFF(nxt, na0, na1); } else { na0[0] = ca0[0]; na0[1] = ca0[1]; na1[0] = ca1[0]; na1[1] = ca1[1]; }
        for (int t = 0; t < nt - 2; t += 2) {
            const char* a1 = cA + (size_t)(t + 1) * kstep;
            const char* a2 = cA + (size_t)(t + 2) * kstep; const char* b2 = cB + (size_t)(t + 2) * kstep;
            const char* a3 = a2 + kstep; const char* b3 = b2 + kstep;
            PG8_LDB(B0, 0, 0); PG8_LDB(B1, 0, 1); PG8_SCHED; PG8_LDA(At, 0, 0); PG8_STAGE(PG8_SA(1, 1), a1, ca1);
            PG8_WAIT_V(8); PG8_WAIT_L(0); PG8_BAR; PG8_MMA(0, 0, At, B0); PG8_MMA(0, 1, At, B1); PG8_BAR; PG8_SCHED;
            PG8_LDA(At, 0, 1); PG8_STAGE(PG8_SB(0, 0), b2, voffB); PG8_STAGE(PG8_SB(0, 1), b2 + hstep, voffB); PG8_STAGE(PG8_SA(0, 0), a2, ca0);
            PG8_WAIT_V(8); PG8_WAIT_L(0); PG8_BAR; PG8_MMA(1, 0, At, B0); PG8_MMA(1, 1, At, B1); PG8_BAR; PG8_SCHED;
            PG8_LDB(B0, 1, 0); PG8_LDB(B1, 1, 1); PG8_SCHED; PG8_LDA(At, 1, 0); PG8_STAGE(PG8_SA(0, 1), a2, ca1);
            PG8_WAIT_V(8); PG8_WAIT_L(0); PG8_BAR; PG8_MMA(0, 0, At, B0); PG8_MMA(0, 1, At, B1); PG8_BAR; PG8_SCHED;
            PG8_LDA(At, 1, 1); PG8_STAGE(PG8_SB(1, 0), b3, voffB); PG8_STAGE(PG8_SB(1, 1), b3 + hstep, voffB); PG8_STAGE(PG8_SA(1, 0), a3, ca0);
            PG8_WAIT_V(8); PG8_WAIT_L(0); PG8_BAR; PG8_MMA(1, 0, At, B0); PG8_MMA(1, 1, At, B1); PG8_BAR; PG8_SCHED;
        }
        {
            const char* a1 = cA + (size_t)(nt - 1) * kstep;
            const char* a2 = cA; const char* b2 = nB; const char* a3 = a2 + kstep; const char* b3 = b2 + kstep;
            PG8_LDB(B0, 0, 0); PG8_LDB(B1, 0, 1); PG8_SCHED; PG8_LDA(At, 0, 0); PG8_STAGE(PG8_SA(1, 1), a1, ca1);
            PG8_WAIT_V(8); PG8_WAIT_L(0); PG8_BAR; PG8_MMA(0, 0, At, B0); PG8_MMA(0, 1, At, B1); PG8_BAR; PG8_SCHED;
            PG8_LDA(At, 0, 1); PG8_STAGE(PG8_SB(0, 0), b2, voffB); PG8_STAGE(PG8_SB(0, 1), b2 + hstep, voffB); PG8_STAGE(PG8_SA(0, 0), a2, na0);
            PG8_WAIT_V(8); PG8_WAIT_L(0); PG8_BAR; PG8_MMA(1, 0, At, B0); PG8_MMA(1, 1, At, B1); PG8_BAR; PG8_SCHED;
            PG8_LDB(B0, 1, 0); PG8_LDB(B1, 1, 1); PG8_SCHED; PG8_LDA(At, 1, 0); PG8_STAGE(PG8_SA(0, 1), a2, na1);
            PG8_WAIT_V(8); PG8_WAIT_L(0); PG8_BAR; PG8_MMA(0, 0, At, B0); PG8_MMA(0, 1, At, B1); PG8_BAR; PG8_SCHED;
            PG8_LDA(At, 1, 1); PG8_STAGE(PG8_SB(1, 0), b3, voffB); PG8_STAGE(PG8_SB(1, 1), b3 + hstep, voffB); PG8_STAGE(PG8_SA(1, 0), a3, na0);
            PG8_WAIT_V(8); PG8_WAIT_L(0); PG8_BAR; PG8_MMA(1, 0, At, B0); PG8_MMA(1, 1, At, B1); PG8_BAR; PG8_SCHED;
        }
        if constexpr (ALIGN_EPI) { if (wr == 0) PG8_BAR; }
        E(acc, cur, wr, wc, fr, fq);
        if (!has_next) break;
#pragma unroll
        for (int a = 0; a < 2; ++a)
#pragma unroll
            for (int b = 0; b < 2; ++b)
#pragma unroll
                for (int m = 0; m < 4; ++m)
#pragma unroll
                    for (int n = 0; n < 2; ++n) acc[a][b][m][n] = (f32x4){zf_, zf_, zf_, zf_};
        cur = nxt; cB = nB; ++ui; ca0[0] = na0[0]; ca0[1] = na0[1]; ca1[0] = na1[0]; ca1[1] = na1[1];
        if constexpr (ALIGN_EPI) { if (wr == 1) PG8_BAR; }
    }
    PG8_WAIT_V(0);
    if constexpr (!ALIGN_EPI) { if (wr == 0) PG8_BAR; }
    PG8_BAR;
#undef PG8_AOFF
#undef PG8_SA
#undef PG8_SB
#undef PG8_STAGE
#undef PG8_LDA
#undef PG8_LDB
#undef PG8_MMA
#undef PG8_WAIT_V
#undef PG8_WAIT_L
#undef PG8_BAR
#undef PG8_SCHED
}

}
namespace mk {
using namespace nv;
typedef unsigned short bf16_t;
typedef unsigned u32x4 __attribute__((ext_vector_type(4)));
typedef float f32x4 __attribute__((ext_vector_type(4)));
#define LAS __attribute__((address_space(3)))
constexpr int NT = 512;
constexpr int PB = 2816;
constexpr int NPAD = 3072;
constexpr int C_KV = 512, C_FOX = 1280, C_SB = 2048, C_GATE = 2816;
constexpr int MAXT = MROWS / 256 + NE;
constexpr int PROWS = MAXT * 256;
__device__ __forceinline__ int ftid() { int t = threadIdx.x; asm volatile("" : "+v"(t)); return t; }
__device__ __forceinline__ int fbid() { int b = blockIdx.x; asm volatile("" : "+s"(b)); return b; }
#define MK_LOOP(vb, n) for (int vb = fbid(); vb < (n); vb += gridDim.x)

constexpr size_t al_(size_t x) { return (x + 4095) & ~(size_t)4095; }
constexpr size_t O_WTIN = 0;
constexpr size_t O_WTOUT = O_WTIN + al_((size_t)L_ * NPAD * D_ * 2);
constexpr size_t O_WTGU = O_WTOUT + al_((size_t)L_ * D_ * D_ * 2);
constexpr size_t O_WTDN = O_WTGU + al_((size_t)L_ * NE * 2048 * D_ * 2);
constexpr size_t O_BIASP = O_WTDN + al_((size_t)L_ * NE * D_ * D_ * 2);
constexpr size_t O_XB = O_BIASP + al_((size_t)L_ * NPAD * 4);
constexpr size_t O_PROJB = O_XB + al_((size_t)T_ * D_ * 2);
constexpr size_t O_GF = O_PROJB + al_((size_t)T_ * PB * 2);
constexpr size_t O_CFOX = O_GF + al_((size_t)T_ * 32 * 4);
constexpr size_t O_KCMP = O_CFOX + al_((size_t)B_ * 4 * S_ * 4);
constexpr size_t O_VCMP = O_KCMP + al_((size_t)B_ * 2 * 512 * 64 * 4);
constexpr size_t O_O = O_VCMP + al_((size_t)B_ * 2 * 512 * 64 * 4);
constexpr size_t O_OB = O_O + al_((size_t)T_ * D_ * 4);
constexpr size_t O_PTOT = O_OB + al_((size_t)T_ * D_ * 2);
constexpr size_t O_SEL = O_PTOT + al_((size_t)B_ * 2 * S_ * 512 * 4);
constexpr size_t O_MIX = O_SEL + al_((size_t)B_ * 2 * S_ * NSEL * 4);
constexpr size_t O_X1 = O_MIX + al_((size_t)T_ * D_ * 4);
constexpr size_t O_X1B = O_X1 + al_((size_t)T_ * D_ * 4);
constexpr size_t O_XA = O_X1B + al_((size_t)T_ * D_ * 2);
constexpr size_t O_ACT = O_XA + al_((size_t)T_ * D_ * 4);
constexpr size_t O_Y = O_ACT + al_((size_t)PROWS * D_ * 2);
constexpr size_t O_TOPE = O_Y + al_((size_t)PROWS * D_ * 2);
constexpr size_t O_TOPW = O_TOPE + al_((size_t)MROWS * 4);
constexpr size_t O_POS = O_TOPW + al_((size_t)MROWS * 4);
constexpr size_t O_ROWTOK = O_POS + al_((size_t)MROWS * 4);
constexpr size_t O_ROWW = O_ROWTOK + al_((size_t)PROWS * 4);
constexpr size_t O_SLOT = O_ROWW + al_((size_t)PROWS * 4);
constexpr size_t O_COUNTS = O_SLOT + al_((size_t)MROWS * 4);
constexpr size_t O_META = O_COUNTS + 4096;
constexpr size_t O_OWIN = O_META + 4096;
constexpr size_t O_O2 = O_OWIN + al_((size_t)T_ * 512 * 4);
constexpr size_t O_OWIN2 = O_O2 + al_((size_t)T_ * D_ * 4);
constexpr size_t O_KCMPB = O_OWIN2 + al_((size_t)T_ * 512 * 4);
constexpr size_t O_VCMPB = O_KCMPB + al_((size_t)B_ * 2 * 512 * 64 * 2);
constexpr size_t O_OCMP = O_VCMPB + al_((size_t)B_ * 2 * 512 * 64 * 2);
constexpr size_t O_SELMASK = O_OCMP + al_((size_t)T_ * 512 * 4);
constexpr size_t O_END = O_SELMASK + al_((size_t)B_ * 2 * S_ * 16);

struct P {
    In in; unsigned char* ws; float* out;
};
typedef const __attribute__((address_space(4))) P* KP;
__device__ __forceinline__ KP fresh_kp() { KP k = (KP)__builtin_amdgcn_kernarg_segment_ptr(); asm volatile("" : "+s"(k)); return k; }
#define WSP(T, off) ((T*)(p->ws + (off)))

__device__ __forceinline__ float bf2f(unsigned short b) { return __uint_as_float((unsigned)b << 16); }
__device__ __forceinline__ unsigned f2bf(float f) { unsigned u = __float_as_uint(f); return (u + 0x7fffu + ((u >> 16) & 1u)) >> 16; }
__device__ __forceinline__ unsigned pk2(float lo, float hi) { return f2bf(lo) | (f2bf(hi) << 16); }
__device__ __forceinline__ void ld8(const bf16_t* __restrict__ src, float* dst) {
    const u32x4 v = *(const u32x4*)src;
    dst[0] = __uint_as_float(v.x << 16); dst[1] = __uint_as_float(v.x & 0xffff0000u); dst[2] = __uint_as_float(v.y << 16); dst[3] = __uint_as_float(v.y & 0xffff0000u);
    dst[4] = __uint_as_float(v.z << 16); dst[5] = __uint_as_float(v.z & 0xffff0000u); dst[6] = __uint_as_float(v.w << 16); dst[7] = __uint_as_float(v.w & 0xffff0000u);
}


__device__ __forceinline__ int perm_in(int n) {
    if (n < 1280) return n;
    if (n < 1304) return C_GATE + (n - 1280);
    if (n < 2072) return C_FOX + (n - 1304);
    if (n < 2076) return C_GATE + 24 + (n - 2072);
    return C_SB + (n - 2076);
}
__device__ __forceinline__ int perm_gu(int n) { const int up = n >> 10, c = n & 1023; return 256 * (c >> 7) + 128 * up + (c & 127); }
template <int MAP>
__device__ __forceinline__ void transpose_item(const float* __restrict__ W, int K, int N, bf16_t* __restrict__ WT, LAS float* scr, int item, int lane) {
    const int nblk = (N + 31) / 32, kb = item / nblk, nb = item % nblk, k0 = 64 * kb, n0 = 32 * nb;
    const int nl = lane & 31; const bool okn = (n0 + nl) < N;
#pragma unroll 8
    for (int i = 0; i < 32; ++i) { const int kk = 2 * i + (lane >> 5); scr[kk * 33 + nl] = okn ? W[(size_t)(k0 + kk) * N + n0 + nl] : 0.f; }
    asm volatile("s_waitcnt lgkmcnt(0)" ::: "memory");
    const int c = lane & 7;
#pragma unroll
    for (int j = 0; j < 4; ++j) { const int n = (lane >> 3) + 8 * j; const LAS float* sp = scr + (8 * c) * 33 + n;
        u32x4 o; o.x = pk2(sp[0 * 33], sp[1 * 33]); o.y = pk2(sp[2 * 33], sp[3 * 33]); o.z = pk2(sp[4 * 33], sp[5 * 33]); o.w = pk2(sp[6 * 33], sp[7 * 33]);
        const int ng = n0 + n;
        if (ng < N) { const int ro = (MAP == 1) ? perm_in(ng) : (MAP == 2) ? perm_gu(ng) : ng; *(u32x4*)(WT + (size_t)ro * K + k0 + 8 * c) = o; } }
    asm volatile("s_waitcnt lgkmcnt(0)" ::: "memory");
}
__device__ __forceinline__ void ph_convert(LAS unsigned char* lds, KP p) {
    const int tid = ftid(), lane = tid & 63, wv = tid >> 6;
    LAS float* scr = (LAS float*)(lds + wv * 8448);
    const int gw = fbid() * 8 + wv, NGW = gridDim.x * 8;
    constexpr int I_IN = 16 * 89, I_OUT = 16 * 32, I_GU = 16 * 64, I_DN = 16 * 32;
    constexpr int N_IN = L_ * I_IN, N_OUT = L_ * I_OUT, N_GU = L_ * NE * I_GU, N_DN = L_ * NE * I_DN;
    for (int it = gw; it < N_IN + N_OUT + N_GU + N_DN; it += NGW) {
        int r = it;
        if (r < N_GU) { const int mtx = r / I_GU; transpose_item<2>(p->in.wgu + (size_t)mtx * D_ * 2048, D_, 2048, WSP(bf16_t, O_WTGU) + (size_t)mtx * 2048 * D_, scr, r % I_GU, lane); continue; } r -= N_GU;
        if (r < N_DN) { const int mtx = r / I_DN; transpose_item<0>(p->in.wdn + (size_t)mtx * D_ * D_, D_, D_, WSP(bf16_t, O_WTDN) + (size_t)mtx * D_ * D_, scr, r % I_DN, lane); continue; } r -= N_DN;
        if (r < N_IN) { const int mtx = r / I_IN; transpose_item<1>(p->in.w_in + (size_t)mtx * D_ * DIN, D_, DIN, WSP(bf16_t, O_WTIN) + (size_t)mtx * NPAD * D_, scr, r % I_IN, lane); continue; } r -= N_IN;
        { const int mtx = r / I_OUT; transpose_item<0>(p->in.w_out + (size_t)mtx * D_ * D_, D_, D_, WSP(bf16_t, O_WTOUT) + (size_t)mtx * D_ * D_, scr, r % I_OUT, lane); }
    }
    const int gt = fbid() * NT + tid, NG = gridDim.x * NT;
    for (int i = gt; i < L_ * (NPAD - DIN) * (D_ / 8); i += NG) { const int l = i / ((NPAD - DIN) * (D_ / 8)), r = i % ((NPAD - DIN) * (D_ / 8));
        unsigned z_ = 0u; asm volatile("" : "+v"(z_));
        *(u32x4*)(WSP(bf16_t, O_WTIN) + ((size_t)l * NPAD + DIN) * D_ + (size_t)r * 8) = (u32x4){z_, z_, z_, z_}; }
    for (int i = gt; i < L_ * NPAD; i += NG) { const int l = i / NPAD, c = i % NPAD; if (c >= DIN) WSP(float, O_BIASP)[i] = 0.f; }
    for (int i = gt; i < L_ * DIN; i += NG) { const int l = i / DIN, n = i % DIN; WSP(float, O_BIASP)[l * NPAD + perm_in(n)] = p->in.b_in[i]; }
    for (int i = gt; i < T_ * D_ / 8; i += NG) { const f32x4 a = *(const f32x4*)(p->in.x + (size_t)i * 8), b = *(const f32x4*)(p->in.x + (size_t)i * 8 + 4);
        *(u32x4*)(WSP(bf16_t, O_XB) + (size_t)i * 8) = (u32x4){pk2(a.x, a.y), pk2(a.z, a.w), pk2(b.x, b.y), pk2(b.z, b.w)}; }
}

struct EpiProj {
    static constexpr bool PERM = true;
    bf16_t* projb; float* gf; const float* bias;
    __device__ __forceinline__ void operator()(const pg8::f32x4 (&acc)[2][2][4][2], const pg8::Unit& u, int wr, int wc, int fr, int fq) const {
        const int row0 = u.pm * 256 + wr * 64 + fr, col0 = u.pn * 256 + wc * 32 + 8 * fq;
        if (u.pn < 11) {
#pragma unroll
            for (int ai = 0; ai < 2; ++ai)
#pragma unroll
                for (int m = 0; m < 4; ++m) { bf16_t* rowp = projb + (size_t)(row0 + ai * 128 + m * 16) * PB + col0;
#pragma unroll
                    for (int bj = 0; bj < 2; ++bj) { const f32x4 v0 = acc[ai][bj][m][0] + *(const f32x4*)(bias + col0 + bj * 128), v1 = acc[ai][bj][m][1] + *(const f32x4*)(bias + col0 + bj * 128 + 4);
                        u32x4 w; w.x = pg8::cvt_pk_bf16(v0[0], v0[1]); w.y = pg8::cvt_pk_bf16(v0[2], v0[3]); w.z = pg8::cvt_pk_bf16(v1[0], v1[1]); w.w = pg8::cvt_pk_bf16(v1[2], v1[3]);
                        *(u32x4*)(rowp + bj * 128) = w; }
                    asm volatile("" ::: "memory"); }
        } else if (wc == 0) {
            const f32x4 b0 = *(const f32x4*)(bias + col0), b1 = *(const f32x4*)(bias + col0 + 4);
#pragma unroll
            for (int ai = 0; ai < 2; ++ai)
#pragma unroll
                for (int m = 0; m < 4; ++m) { float* rowp = gf + (size_t)(row0 + ai * 128 + m * 16) * 32 + 8 * fq;
                    const f32x4 v0 = acc[ai][0][m][0] + b0, v1 = acc[ai][0][m][1] + b1; f32x4 o0, o1;
#pragma unroll
                    for (int i = 0; i < 4; ++i) { const int j0 = 8 * fq + i, j1 = j0 + 4;
                        o0[i] = (j0 < 24) ? sigmoidf_(v0[i]) : (j0 < 28 ? logsig(v0[i]) : 0.f); o1[i] = (j1 < 24) ? sigmoidf_(v1[i]) : (j1 < 28 ? logsig(v1[i]) : 0.f); }
                    *(f32x4*)rowp = o0; *(f32x4*)(rowp + 4) = o1; }
        }
    }
};
struct EpiOut {
    static constexpr bool PERM = true;
    const float* x; float* y1;
    __device__ __forceinline__ void operator()(const pg8::f32x4 (&acc)[2][2][4][2], const pg8::Unit& u, int wr, int wc, int fr, int fq) const {
        const int row0 = u.pm * 256 + wr * 64 + fr, col0 = u.pn * 256 + wc * 32 + 8 * fq;
#pragma unroll
        for (int ai = 0; ai < 2; ++ai)
#pragma unroll
            for (int m = 0; m < 4; ++m) { const size_t off = (size_t)(row0 + ai * 128 + m * 16) * D_ + col0;
#pragma unroll
                for (int bj = 0; bj < 2; ++bj) { const f32x4 x0 = *(const f32x4*)(x + off + bj * 128), x1 = *(const f32x4*)(x + off + bj * 128 + 4);
                    *(f32x4*)(y1 + off + bj * 128) = x0 * ALPHA + acc[ai][bj][m][0]; *(f32x4*)(y1 + off + bj * 128 + 4) = x1 * ALPHA + acc[ai][bj][m][1]; }
                asm volatile("" ::: "memory"); }
    }
};
struct EpiGU {
    static constexpr bool PERM = true;
    bf16_t* act; const float* bgu;
    __device__ __forceinline__ void operator()(const pg8::f32x4 (&acc)[2][2][4][2], const pg8::Unit& u, int wr, int wc, int fr, int fq) const {
        const int row0 = u.pm * 256 + wr * 64 + fr, col0 = u.pn * 128 + wc * 32 + 8 * fq;
        const float* bb = bgu + (size_t)u.e * 2048 + col0;
        const f32x4 bg0 = *(const f32x4*)bb, bg1 = *(const f32x4*)(bb + 4), bu0 = *(const f32x4*)(bb + 1024), bu1 = *(const f32x4*)(bb + 1028);
#pragma unroll
        for (int ai = 0; ai < 2; ++ai)
#pragma unroll
            for (int m = 0; m < 4; ++m) { f32x4 a0, a1;
                const f32x4 g0 = acc[ai][0][m][0] + bg0, g1 = acc[ai][0][m][1] + bg1, u0 = acc[ai][1][m][0] + bu0, u1 = acc[ai][1][m][1] + bu1;
#pragma unroll
                for (int i = 0; i < 4; ++i) { const float gt0 = fminf(g0[i], 7.0f), up0 = fminf(fmaxf(u0[i], -7.0f), 7.0f), gt1 = fminf(g1[i], 7.0f), up1 = fminf(fmaxf(u1[i], -7.0f), 7.0f);
                    a0[i] = gt0 * sigmoidf_(1.702f * gt0) * (up0 + 1.0f); a1[i] = gt1 * sigmoidf_(1.702f * gt1) * (up1 + 1.0f); }
                u32x4 w; w.x = pg8::cvt_pk_bf16(a0[0], a0[1]); w.y = pg8::cvt_pk_bf16(a0[2], a0[3]); w.z = pg8::cvt_pk_bf16(a1[0], a1[1]); w.w = pg8::cvt_pk_bf16(a1[2], a1[3]);
                *(u32x4*)(act + (size_t)(row0 + ai * 128 + m * 16) * D_ + col0) = w; asm volatile("" ::: "memory"); }
    }
};
struct EpiDN {
    static constexpr bool PERM = true;
    bf16_t* y; const float* bdn; const float* roww;
    __device__ __forceinline__ void operator()(const pg8::f32x4 (&acc)[2][2][4][2], const pg8::Unit& u, int wr, int wc, int fr, int fq) const {
        const int row0 = u.pm * 256 + wr * 64 + fr, col0 = u.pn * 256 + wc * 32 + 8 * fq;
        const float* bb = bdn + (size_t)u.e * D_ + col0;
#pragma unroll
        for (int ai = 0; ai < 2; ++ai)
#pragma unroll
            for (int m = 0; m < 4; ++m) { const int row = row0 + ai * 128 + m * 16; const float w = roww[row];
#pragma unroll
                for (int bj = 0; bj < 2; ++bj) { const f32x4 v0 = (acc[ai][bj][m][0] + *(const f32x4*)(bb + bj * 128)) * w, v1 = (acc[ai][bj][m][1] + *(const f32x4*)(bb + bj * 128 + 4)) * w;
                    u32x4 o; o.x = pg8::cvt_pk_bf16(v0[0], v0[1]); o.y = pg8::cvt_pk_bf16(v0[2], v0[3]); o.z = pg8::cvt_pk_bf16(v1[0], v1[1]); o.w = pg8::cvt_pk_bf16(v1[2], v1[3]);
                    *(u32x4*)(y + (size_t)row * D_ + col0 + bj * 128) = o; }
                asm volatile("" ::: "memory"); }
    }
};
struct MoeOrder {
    const int* meta; const int* rowtok; const char* Wt; size_t estep, tstep; int nN, G, c, nunits;
    __device__ __forceinline__ bool next(int i, pg8::Unit& u) const {
        const int L = i * G + c; if (L >= nunits) return false;
        const int gt = L / nN; u.pm = gt; u.pn = L - gt * nN; u.e = meta[64 + 2 * gt]; u.nr = meta[65 + 2 * gt]; return true; }
    __device__ __forceinline__ unsigned a_row(const pg8::Unit& u, int r) const { const int rr = r < u.nr ? r : u.nr - 1; const int row = u.pm * 256 + rr; return rowtok ? (unsigned)rowtok[row] : (unsigned)row; }
    __device__ __forceinline__ const char* b_base(const pg8::Unit& u) const { return Wt + (size_t)u.e * estep + (size_t)u.pn * tstep; }
};

struct GEpi {
    static constexpr bool PERM = true;
    int kind, l;
    __device__ __forceinline__ void operator()(const pg8::f32x4 (&acc)[2][2][4][2], const pg8::Unit& u, int wr, int wc, int fr, int fq) const {
        const KP p = fresh_kp();
        if (kind == 0) { const EpiProj e{WSP(bf16_t, O_PROJB), WSP(float, O_GF), WSP(float, O_BIASP) + l * NPAD}; e(acc, u, wr, wc, fr, fq); }
        else if (kind == 1) { const EpiOut e{(l == 0) ? p->in.x : WSP(float, O_XA), WSP(float, O_MIX)}; e(acc, u, wr, wc, fr, fq); }
        else if (kind == 2) { const EpiGU e{WSP(bf16_t, O_ACT), p->in.bgu + (size_t)l * NE * 2048}; e(acc, u, wr, wc, fr, fq); }
        else { const EpiDN e{WSP(bf16_t, O_Y), p->in.bdn + (size_t)l * NE * D_, WSP(float, O_ROWW)}; e(acc, u, wr, wc, fr, fq); }
    }
};
struct GSched {
    int kind, nM, nN, nunits, G, c; const int* meta; const int* rowtok; const char* Bt; size_t estep;
    __device__ __forceinline__ bool next(int i, pg8::Unit& u) const {
        const int L = i * G + c; if (L >= nunits) return false;
        if (kind < 2) {
            int wgid = L; { const int q = nunits / pg8::NXCD, r = nunits % pg8::NXCD, xcd = wgid % pg8::NXCD, off = wgid / pg8::NXCD; wgid = (xcd < r ? xcd * (q + 1) : r * (q + 1) + (xcd - r) * q) + off; }
            const int nig = pg8::WGM * nN, gid = wgid / nig, fm = gid * pg8::WGM, gsz = (nM - fm) < pg8::WGM ? (nM - fm) : pg8::WGM;
            u.pm = fm + ((wgid % nig) % gsz); u.pn = (wgid % nig) / gsz; u.e = 0; u.nr = 256;
        } else { const int gt = L / nN; u.pm = gt; u.pn = L - gt * nN; u.e = meta[64 + 2 * gt]; u.nr = meta[65 + 2 * gt]; }
        return true; }
    __device__ __forceinline__ unsigned a_row(const pg8::Unit& u, int r) const { const int rr = r < u.nr ? r : u.nr - 1; const int row = u.pm * 256 + rr; return (kind == 2) ? (unsigned)rowtok[row] : (unsigned)row; }
    __device__ __forceinline__ const char* b_base(const pg8::Unit& u) const { return Bt + (size_t)u.e * estep + (size_t)u.pn * ((size_t)256 * D_ * 2); }
};

__device__ __forceinline__ void ph_prep(float* lds, KP p, int l) {
    const int tid = ftid();
    const bf16_t* projb = WSP(bf16_t, O_PROJB);
    constexpr int NCB = (NCMP + 3) / 4;
    constexpr int NV_CMP = NCB * B_ * 2 * 2;
    MK_LOOP(vb, NV_CMP + B_ * 4) {
        if (vb < NV_CMP) {
            float* blk = lds; float* hid = lds + 4 * 2048;
            const int kv = vb & 1, bg = (vb >> 1) & 3, nb = vb >> 3, b = bg >> 1, g = bg & 1;
            const float* pos = (kv ? p->in.pos_v : p->in.pos_k) + (size_t)l * 2048; const float* w1 = (kv ? p->in.w1v : p->in.w1k) + (size_t)l * 2048 * 128;
            const float* w2 = (kv ? p->in.w2v : p->in.w2k) + (size_t)l * 128 * 64; float* outp = kv ? WSP(float, O_VCMP) : WSP(float, O_KCMP);
            __syncthreads();
            for (int i = tid; i < 4 * 2048; i += NT) { const int sub = i >> 11, e = i & 2047, ll = e >> 6, d = e & 63; int n = nb * 4 + sub; if (n >= NCMP) n = NCMP - 1;
                blk[i] = bf2f(projb[(size_t)(b * S_ + 16 * n + ll) * PB + C_KV + ((0 * 2 + kv) * 2 + g) * 64 + d]) + pos[e]; }
            __syncthreads();
            const int sub = tid >> 7, j = tid & 127; const float* bl = blk + sub * 2048;
            float a = 0.f;
            for (int i = 0; i < 2048; ++i) a += bl[i] * w1[(size_t)i * 128 + j];
            hid[tid] = gelu_tanh(a);
            __syncthreads();
            const int n = nb * 4 + sub;
            if (j < 64 && n < NCMP) { float o = 0.f; for (int jj = 0; jj < 128; ++jj) o += hid[sub * 128 + jj] * w2[jj * 64 + j]; outp[((size_t)bg * NCMP + n) * 64 + j] = o;
                (kv ? WSP(bf16_t, O_VCMPB) : WSP(bf16_t, O_KCMPB))[((size_t)bg * 512 + n) * 64 + j] = (bf16_t)f2bf(o); }
            if (j < 64 && n == NCMP) (kv ? WSP(bf16_t, O_VCMPB) : WSP(bf16_t, O_KCMPB))[((size_t)bg * 512 + 511) * 64 + j] = 0;
        } else {
            float* sh = lds; const int bh = vb - NV_CMP, b = bh >> 2, h = bh & 3; float carry = 0.f;
            for (int t0 = 0; t0 < S_; t0 += NT) {
                __syncthreads();
                sh[tid] = WSP(float, O_GF)[(size_t)(b * S_ + t0 + tid) * 32 + 24 + h]; __syncthreads();
                for (int o = 1; o < NT; o <<= 1) { const float add = (tid >= o) ? sh[tid - o] : 0.f; __syncthreads(); sh[tid] += add; __syncthreads(); }
                WSP(float, O_CFOX)[(size_t)bh * S_ + t0 + tid] = carry + sh[tid];
                carry += sh[NT - 1];
            }
        }
    }
}

__device__ __forceinline__ void load_tile_bf(float (*dst)[64], const bf16_t* __restrict__ src, size_t pitch) {
    const int tid = ftid(), r = tid >> 3, c0 = (tid & 7) * 8; float v[8]; ld8(src + (size_t)r * pitch + c0, v);
    *(float4*)&dst[r][c0] = make_float4(v[0], v[1], v[2], v[3]); *(float4*)&dst[r][c0 + 4] = make_float4(v[4], v[5], v[6], v[7]);
}
__device__ __forceinline__ void load_tile512(float (*dst)[64], const float* __restrict__ src, size_t stride, int nrows_valid) {
    const int tid = ftid(), r = tid >> 3, c0 = (tid & 7) * 8;
#pragma unroll
    for (int j = 0; j < 2; ++j) { float4 v = make_float4(0.f, 0.f, 0.f, 0.f); if (r < nrows_valid) v = *(const float4*)(src + (size_t)r * stride + c0 + 4 * j); *(float4*)&dst[r][c0 + 4 * j] = v; }
}
#define MK_LOADQ(q, src) do { _Pragma("unroll") for (int c_ = 0; c_ < 8; ++c_) { float t8_[8]; ld8((src) + 8 * c_, t8_); _Pragma("unroll") for (int e_ = 0; e_ < 8; ++e_) q[8 * c_ + e_] = t8_[e_] * SCALE; } } while (0)

template <int KIND>
__device__ __forceinline__ void attn_vblock(float* lds, KP p, int qb, int bh) {
    float (*Ks)[64] = (float (*)[64])lds; float (*Vs)[64] = (float (*)[64])(lds + 4096); float* Cs = lds + 8192;
    const bf16_t* projb = WSP(bf16_t, O_PROJB); const float* gf = WSP(float, O_GF); float* ob = WSP(float, O_O);
    const int tid = ftid(), q0 = qb * NT, t = q0 + tid;
    if (KIND == 0 || KIND == 1) {
        int b, h, qcol, kcol, vcol, ocol; float slope = 0.f;
        if (KIND == 0) { b = bh >> 2; h = bh & 3; qcol = C_FOX + h * 64; kcol = C_FOX + (4 + h) * 64; vcol = C_FOX + (8 + h) * 64; ocol = 512 + h * 64; }
        else { b = bh >> 3; h = bh & 7; const int g = h >> 2; qcol = h * 64; kcol = C_KV + ((2 * 2 + 0) * 2 + g) * 64; vcol = C_KV + ((2 * 2 + 1) * 2 + g) * 64; ocol = h * 64; slope = exp2f(-(float)(h + 1)); }
        const bf16_t* prow = projb + (size_t)(b * S_ + t) * PB;
        float q[64], o[64];
        MK_LOADQ(q, prow + qcol);
#pragma unroll
        for (int d = 0; d < 64; ++d) o[d] = 0.f;
        float m = -1e30f, l = 0.f, ct = 0.f; const float* cb = WSP(float, O_CFOX) + (size_t)(b * 4 + (h & 3)) * S_;
        if (KIND == 0) ct = cb[t];
        int kt0 = 0; const int kt1 = (q0 + NT - 1) >> 6;
        if (KIND == 1) { kt0 = (q0 - 511) >> 6; if (kt0 < 0) kt0 = 0; }
        for (int kt = kt0; kt <= kt1; ++kt) {
            __syncthreads();
            load_tile_bf(Ks, projb + (size_t)(b * S_ + kt * 64) * PB + kcol, PB);
            load_tile_bf(Vs, projb + (size_t)(b * S_ + kt * 64) * PB + vcol, PB);
            if (KIND == 0 && tid < 64) Cs[tid] = cb[kt * 64 + tid];
            __syncthreads();
            for (int r = 0; r < 64; ++r) {
                const int s = kt * 64 + r; bool ok = (s <= t); if (KIND == 1) ok = ok && (t - s < 512);
                if (ok) { float sc; NV_DOT(q, Ks[r], sc); if (KIND == 0) sc += ct - Cs[r]; else sc -= slope * (float)(t - s); NV_ONLINE(sc, Vs[r]); }
            }
        }
        const float inv = (l > 0.f) ? 1.f / l : 0.f;
        float* orow = ob + (size_t)(b * S_ + t) * D_ + ocol;
        if (KIND == 0) {
#pragma unroll
            for (int d = 0; d < 64; ++d) orow[d] = o[d] * inv;
        } else { const float gate = gf[(size_t)(b * S_ + t) * 32 + 2 * 8 + h]; float* wrow = WSP(float, O_OWIN) + (size_t)(b * S_ + t) * 512 + h * 64;
#pragma unroll
            for (int d = 0; d < 64; ++d) wrow[d] = gate * o[d] * inv; }
    } else if (KIND == 2) {
        const int b = bh >> 2, h = bh & 3;
        const int qcol = C_SB + h * 64, kcol = C_SB + (4 + h) * 64, vcol = C_SB + (8 + h) * 64, ocol = 768 + h * 64;
        const bf16_t* prow = projb + (size_t)(b * S_ + t) * PB;
        float q[64], o[64];
        MK_LOADQ(q, prow + qcol);
#pragma unroll
        for (int d = 0; d < 64; ++d) o[d] = 0.f;
        float later = 0.f;
        for (int kt = (q0 + NT - 1) >> 6; kt >= 0; --kt) {
            __syncthreads();
            load_tile_bf(Ks, projb + (size_t)(b * S_ + kt * 64) * PB + kcol, PB);
            load_tile_bf(Vs, projb + (size_t)(b * S_ + kt * 64) * PB + vcol, PB);
            __syncthreads();
            for (int r = 63; r >= 0; --r) { const int s = kt * 64 + r;
                if (s < t) { float z; NV_DOT(q, Ks[r], z); const float a = expf(logsig(z) + later); NV_AXPY(o, a, Vs[r]); later += logsig(-z); } }
        }
        float* orow = ob + (size_t)(b * S_ + t) * D_ + ocol;
#pragma unroll
        for (int d = 0; d < 64; ++d) orow[d] = o[d];
    } else {
        const int bg = bh, b = bg >> 1, g = bg & 1;
        const bf16_t* prow = projb + (size_t)(b * S_ + t) * PB;
        float* prow_t = WSP(float, O_PTOT) + (size_t)(bg * S_ + t) * 512;
        const float* kcmp = WSP(float, O_KCMP); const float* vcmp = WSP(float, O_VCMP);
        int nmax = (q0 + NT - 1 - 31) / 16 + 1; if (nmax > NCMP) nmax = NCMP;
        const int ntile = (nmax + 63) / 64;
        for (int r4 = 0; r4 < 4; ++r4) {
            const int h = g * 4 + r4; const float slope = exp2f(-(float)(h + 1));
            float q[64], o[64];
            MK_LOADQ(q, prow + h * 64);
#pragma unroll
            for (int d = 0; d < 64; ++d) o[d] = 0.f;
            float m = -1e30f, l = 0.f;
            for (int kt = 0; kt < ntile; ++kt) {
                __syncthreads();
                const int nvr = (NCMP - kt * 64) < 64 ? (NCMP - kt * 64) : 64;
                load_tile512(Ks, kcmp + ((size_t)bg * NCMP + kt * 64) * 64, 64, nvr);
                load_tile512(Vs, vcmp + ((size_t)bg * NCMP + kt * 64) * 64, 64, nvr);
                __syncthreads();
                for (int r = 0; r < nvr; ++r) { const int ce = 16 * (kt * 64 + r) + 31;
                    if (ce <= t) { float sc; NV_DOT(q, Ks[r], sc); sc -= slope * (float)(t - ce); NV_ONLINE(sc, Vs[r]); } }
            }
            const float inv = (l > 0.f) ? 1.f / l : 0.f;
            const float gate = gf[(size_t)(b * S_ + t) * 32 + 0 * 8 + h];
            float* orow = ob + (size_t)(b * S_ + t) * D_ + h * 64;
#pragma unroll
            for (int d = 0; d < 64; ++d) orow[d] = gate * o[d] * inv;
            for (int kt = 0; kt < 8; ++kt) {
                __syncthreads();
                const int nvr = (NCMP - kt * 64) < 64 ? (NCMP - kt * 64) : 64;
                if (kt < ntile) load_tile512(Ks, kcmp + ((size_t)bg * NCMP + kt * 64) * 64, 64, nvr);
                __syncthreads();
                for (int r = 0; r < 64; ++r) { const int n = kt * 64 + r, ce = 16 * n + 31; float pp = 0.f;
                    if (kt < ntile && r < nvr && ce <= t) { float sc; NV_DOT(q, Ks[r], sc); sc -= slope * (float)(t - ce); pp = __expf(sc - m) * inv; }
                    if (r4 == 0) prow_t[n] = pp; else prow_t[n] += pp; }
            }
        }
    }
}
__device__ __forceinline__ void ph_attn_a(float* lds, KP p) {
    constexpr int NQB = S_ / NT;
    constexpr int N_CMP = NQB * B_ * 2, N_FOX = NQB * B_ * 4, N_SB = NQB * B_ * 4;
    MK_LOOP(vb, N_CMP + N_FOX + N_SB) {
        if (vb < N_FOX) { const int qb = NQB - 1 - vb / (B_ * 4); attn_vblock<0>(lds, p, qb, vb % (B_ * 4)); }
        else if (vb < N_FOX + N_SB) { const int v = vb - N_FOX; const int qb = NQB - 1 - v / (B_ * 4); attn_vblock<2>(lds, p, qb, v % (B_ * 4)); }
        else { const int v = vb - N_FOX - N_SB; attn_vblock<3>(lds, p, v / (B_ * 2), v % (B_ * 2)); }
    }
}
__device__ __forceinline__ void ph_select(KP p) {
    const int lane = ftid() & 63, wv = ftid() >> 6; int* sel = WSP(int, O_SEL);
    for (int wave = fbid() * 8 + wv; wave < B_ * 2 * S_; wave += gridDim.x * 8) {
        const int t = wave % S_; const float* pt = WSP(float, O_PTOT) + (size_t)wave * 512; const int cur = t >> 6;
        float v[2];
#pragma unroll
        for (int k = 0; k < 2; ++k) { const int j = lane + 64 * k;
            float imp = pt[4 * j] + pt[4 * j + 1] + pt[4 * j + 2];
            if (4 * j + 3 < NCMP) imp += 0.5f * pt[4 * j + 3];
            if (j >= 1) imp += 0.5f * pt[4 * j - 1];
            const bool valid = j <= cur, forced = valid && (j == 0 || j >= cur - 1);
            v[k] = forced ? 3.0e38f : (valid ? imp : -3.0e38f); }
        for (int it = 0; it < NSEL; ++it) {
            float bv = v[0]; int bi = lane; if (v[1] > bv) { bv = v[1]; bi = lane + 64; }
#pragma unroll
            for (int o = 32; o >= 1; o >>= 1) { const float ov = __shfl_xor(bv, o); const int oi = __shfl_xor(bi, o); if (ov > bv || (ov == bv && oi < bi)) { bv = ov; bi = oi; } }
            if (lane == 0) sel[(size_t)wave * NSEL + it] = bi;
            if (bi == lane) v[0] = -3.4e38f;
            if (bi == lane + 64) v[1] = -3.4e38f;
        }
    }
}
__device__ __forceinline__ void ph_attn_sel(KP p) {
    const bf16_t* projb = WSP(bf16_t, O_PROJB); const int tid = ftid();
    MK_LOOP(vb, (S_ / NT) * B_ * 8) {
        const int qb = vb / (B_ * 8), bh = vb % (B_ * 8), b = bh >> 3, h = bh & 7, g = h >> 2, t = qb * NT + tid;
        const float slope = exp2f(-(float)(h + 1));
        const bf16_t* prow = projb + (size_t)(b * S_ + t) * PB;
        const int kcol = C_KV + ((1 * 2 + 0) * 2 + g) * 64, vcol = C_KV + ((1 * 2 + 1) * 2 + g) * 64;
        const int* sl = WSP(int, O_SEL) + ((size_t)(b * 2 + g) * S_ + t) * NSEL;
        float q[64], o[64];
        MK_LOADQ(q, prow + h * 64);
#pragma unroll
        for (int d = 0; d < 64; ++d) o[d] = 0.f;
        float m = -1e30f, l = 0.f;
        for (int i = 0; i < NSEL; ++i) { const int blk = sl[i];
            for (int r = 0; r < 64; ++r) { const int s = blk * 64 + r;
                if (s <= t) { const bf16_t* kr = projb + (size_t)(b * S_ + s) * PB + kcol; const bf16_t* vr = projb + (size_t)(b * S_ + s) * PB + vcol;
                    float sc = 0.f;
#pragma unroll
                    for (int c = 0; c < 8; ++c) { float k8[8]; ld8(kr + 8 * c, k8);
#pragma unroll
                        for (int e = 0; e < 8; ++e) sc += q[8 * c + e] * k8[e]; }
                    sc -= slope * (float)(t - s);
                    if (sc > m) { const float al = __expf(m - sc); l *= al;
#pragma unroll
                        for (int d = 0; d < 64; ++d) o[d] *= al;
                        m = sc; }
                    const float pp = __expf(sc - m); l += pp;
#pragma unroll
                    for (int c = 0; c < 8; ++c) { float v8[8]; ld8(vr + 8 * c, v8);
#pragma unroll
                        for (int e = 0; e < 8; ++e) o[8 * c + e] += pp * v8[e]; }
                } } }
        const float inv = (l > 0.f) ? 1.f / l : 0.f; const float gate = WSP(float, O_GF)[(size_t)(b * S_ + t) * 32 + 1 * 8 + h];
        float* orow = WSP(float, O_O) + (size_t)(b * S_ + t) * D_ + h * 64;
#pragma unroll
        for (int d = 0; d < 64; ++d) orow[d] += gate * o[d] * inv;
    }
}
__device__ __forceinline__ void ph_attn_win(float* lds, KP p) {
    MK_LOOP(vb, (S_ / NT) * B_ * 8) attn_vblock<1>(lds, p, vb / (B_ * 8), vb % (B_ * 8));
}
__device__ __forceinline__ void ph_rmsnorm(KP p, int l) {
    const int lane = ftid() & 63, wv = ftid() >> 6; const float* g = p->in.g_out + (size_t)l * D_;
    for (int row = fbid() * 8 + wv; row < T_; row += gridDim.x * 8) {
        const float* r = WSP(float, O_O) + (size_t)row * D_; bf16_t* ro = WSP(bf16_t, O_OB) + (size_t)row * D_;
        float a[8], bq[8], s = 0.f, s2 = 0.f;
#pragma unroll
        for (int i = 0; i < 8; ++i) { a[i] = r[lane * 8 + i] + WSP(float, O_OWIN)[(size_t)row * 512 + lane * 8 + i]; s += a[i] * a[i]; bq[i] = r[512 + lane * 8 + i]; s2 += bq[i] * bq[i]; }
        const float sc0 = rsqrtf(wsum(s) * (1.f / 512.f) + RMS_EPS);
#pragma unroll
        for (int o = 1; o < 32; o <<= 1) s2 += __shfl_xor(s2, o);
        const float sc1 = rsqrtf(s2 * (1.f / 256.f) + RMS_EPS);
        float x0[8], x1[8];
#pragma unroll
        for (int i = 0; i < 8; ++i) { x0[i] = a[i] * sc0 * g[lane * 8 + i]; x1[i] = bq[i] * sc1 * g[512 + lane * 8 + i]; }
        *(u32x4*)(ro + lane * 8) = (u32x4){pk2(x0[0], x0[1]), pk2(x0[2], x0[3]), pk2(x0[4], x0[5]), pk2(x0[6], x0[7])};
        *(u32x4*)(ro + 512 + lane * 8) = (u32x4){pk2(x1[0], x1[1]), pk2(x1[2], x1[3]), pk2(x1[4], x1[5]), pk2(x1[6], x1[7])};
    }
}
template <bool ROUTER>
__device__ __forceinline__ void ph_ln(float* lds, KP p, int l, float* __restrict__ yout) {
    const int lane = ftid() & 63, wv = ftid() >> 6;
    const float* g = (ROUTER ? p->in.ln1_g : p->in.ln2_g) + (size_t)l * D_; const float* bb = (ROUTER ? p->in.ln1_b : p->in.ln2_b) + (size_t)l * D_;
    for (int row = fbid() * 8 + wv; row < T_; row += gridDim.x * 8) {
        float v[16], s = 0.f;
        if (ROUTER) { const float* src = WSP(float, O_MIX) + (size_t)row * D_;
#pragma unroll
            for (int j = 0; j < 2; ++j) { const f32x4 a = *(const f32x4*)(src + 512 * j + lane * 8), b = *(const f32x4*)(src + 512 * j + lane * 8 + 4);
                v[8 * j + 0] = a.x; v[8 * j + 1] = a.y; v[8 * j + 2] = a.z; v[8 * j + 3] = a.w; v[8 * j + 4] = b.x; v[8 * j + 5] = b.y; v[8 * j + 6] = b.z; v[8 * j + 7] = b.w; }
        } else { const float* src = WSP(float, O_X1) + (size_t)row * D_; const int* sl = WSP(int, O_SLOT) + row * TOPK; const bf16_t* y = WSP(bf16_t, O_Y);
#pragma unroll
            for (int j = 0; j < 2; ++j) { const f32x4 a = *(const f32x4*)(src + 512 * j + lane * 8), b = *(const f32x4*)(src + 512 * j + lane * 8 + 4);
                v[8 * j + 0] = ALPHA * a.x; v[8 * j + 1] = ALPHA * a.y; v[8 * j + 2] = ALPHA * a.z; v[8 * j + 3] = ALPHA * a.w; v[8 * j + 4] = ALPHA * b.x; v[8 * j + 5] = ALPHA * b.y; v[8 * j + 6] = ALPHA * b.z; v[8 * j + 7] = ALPHA * b.w; }
            float acc[16];
#pragma unroll
            for (int i = 0; i < 16; ++i) acc[i] = 0.f;
#pragma unroll
            for (int k = 0; k < TOPK; ++k) { const bf16_t* yr = y + (size_t)sl[k] * D_;
#pragma unroll
                for (int j = 0; j < 2; ++j) { float t8[8]; ld8(yr + 512 * j + lane * 8, t8);
#pragma unroll
                    for (int e = 0; e < 8; ++e) acc[8 * j + e] += t8[e]; } }
#pragma unroll
            for (int i = 0; i < 16; ++i) v[i] += acc[i]; }
#pragma unroll
        for (int i = 0; i < 16; ++i) s += v[i];
        const float mu = wsum(s) * (1.f / D_); float s2 = 0.f;
#pragma unroll
        for (int i = 0; i < 16; ++i) { v[i] -= mu; s2 += v[i] * v[i]; }
        const float rstd = rsqrtf(wsum(s2) * (1.f / D_) + LN_EPS);
        bf16_t* ybf = (ROUTER ? WSP(bf16_t, O_X1B) : WSP(bf16_t, O_XB)) + (size_t)row * D_;
#pragma unroll
        for (int j = 0; j < 2; ++j) { const int c0 = 512 * j + lane * 8;
#pragma unroll
            for (int e = 0; e < 8; ++e) v[8 * j + e] = v[8 * j + e] * rstd * g[c0 + e] + bb[c0 + e];
            *(f32x4*)(yout + (size_t)row * D_ + c0) = (f32x4){v[8 * j], v[8 * j + 1], v[8 * j + 2], v[8 * j + 3]};
            *(f32x4*)(yout + (size_t)row * D_ + c0 + 4) = (f32x4){v[8 * j + 4], v[8 * j + 5], v[8 * j + 6], v[8 * j + 7]};
            *(u32x4*)(ybf + c0) = (u32x4){pk2(v[8 * j], v[8 * j + 1]), pk2(v[8 * j + 2], v[8 * j + 3]), pk2(v[8 * j + 4], v[8 * j + 5]), pk2(v[8 * j + 6], v[8 * j + 7])}; }
        if (ROUTER) {
            const float* rw = p->in.rw + (size_t)l * D_ * NE; const float* rb = p->in.rb + (size_t)l * NE; int* counts = WSP(int, O_COUNTS) + l * 32;
            float* rowl = lds + wv * 1024;
#pragma unroll
            for (int j = 0; j < 2; ++j)
#pragma unroll
                for (int e = 0; e < 8; ++e) rowl[512 * j + lane * 8 + e] = v[8 * j + e];
            asm volatile("s_waitcnt lgkmcnt(0)" ::: "memory");
            const int e = lane & 31, half = lane >> 5; float lg = 0.f;
            for (int k = 0; k < 512; ++k) lg += rowl[half * 512 + k] * rw[(size_t)(half * 512 + k) * NE + e];
            lg += __shfl_xor(lg, 32); lg += rb[e];
            float cur = lg, tv0 = 0.f, den = 0.f, myw = 0.f; int mye = 0;
#pragma unroll
            for (int k = 0; k < TOPK; ++k) { float bv = cur; int bi = e;
#pragma unroll
                for (int o = 16; o >= 1; o >>= 1) { const float ov = __shfl_xor(bv, o); const int oi = __shfl_xor(bi, o); if (ov > bv || (ov == bv && oi < bi)) { bv = ov; bi = oi; } }
                if (k == 0) tv0 = bv;
                const float w = __expf(bv - tv0); den += w;
                if (lane == k) { mye = bi; myw = w; }
                if (e == bi) cur = -3.4e38f; }
            if (lane < TOPK) { WSP(int, O_TOPE)[row * TOPK + lane] = mye; WSP(float, O_TOPW)[row * TOPK + lane] = myw / den; WSP(int, O_POS)[row * TOPK + lane] = atomicAdd(&counts[mye], 1); }
            asm volatile("s_waitcnt lgkmcnt(0)" ::: "memory");
        }
    }
}
__device__ __forceinline__ void ph_moe_plan(KP p, int l) {
    if (fbid() == 0 && ftid() == 0) { const int* counts = WSP(int, O_COUNTS) + l * 32; int* meta = WSP(int, O_META); int nt = 0;
        for (int e = 0; e < NE; ++e) { meta[e] = nt; const int c = counts[e];
            for (int r = 0; r < c; r += 256) { meta[64 + 2 * nt] = e; meta[65 + 2 * nt] = (c - r) < 256 ? (c - r) : 256; ++nt; } }
        meta[32] = nt; }
}
__device__ __forceinline__ void ph_moe_scatter(KP p) {
    const int* meta = WSP(int, O_META);
    for (int i = fbid() * NT + ftid(); i < MROWS; i += gridDim.x * NT) {
        const int row = meta[WSP(int, O_TOPE)[i]] * 256 + WSP(int, O_POS)[i];
        WSP(int, O_ROWTOK)[row] = i >> 2; WSP(float, O_ROWW)[row] = WSP(float, O_TOPW)[i]; WSP(int, O_SLOT)[i] = row; }
}
}
namespace mk {
typedef short bf16x8 __attribute__((ext_vector_type(8)));
typedef float f32x16 __attribute__((ext_vector_type(16)));
typedef float f32x2_t __attribute__((ext_vector_type(2)));
typedef __bf16 bf16x2_t __attribute__((ext_vector_type(2)));
typedef unsigned u32x2 __attribute__((ext_vector_type(2)));
__device__ __forceinline__ unsigned cvtpk(float lo, float hi) { f32x2_t v = {lo, hi}; bf16x2_t b = __builtin_convertvector(v, bf16x2_t); return __builtin_bit_cast(unsigned, b); }
constexpr int KROW = 144, VROW = 136;
constexpr int E1_K = 0, E1_V = 64 * KROW, E1_C = E1_V + 64 * VROW, E1_BUF = E1_C + 256;
constexpr int E1_FLAGS = 2 * E1_BUF;
constexpr float LOG2E = 1.4426950408889634f;
constexpr float RESC_THR = 8.0f;
#define CROW(reg, hh) (((reg) & 3) + 8 * ((reg) >> 2) + 4 * (hh))

struct E1Geom { int b, q0, h; const bf16_t* qp; const bf16_t* kp; const bf16_t* vp; size_t pitch; };

template <int KIND>
__device__ __forceinline__ void e1_unit(LAS unsigned char* lds, KP p, int b, int hg, int qb, float* __restrict__ obase, float* __restrict__ owin) {
    const int tid = ftid(), lane = tid & 63, w = __builtin_amdgcn_readfirstlane(tid >> 6), r32 = lane & 31, hh = lane >> 5;
    const bf16_t* projb = WSP(bf16_t, O_PROJB);
    int h, q0, qrow0, qcol, kcol, vcol, nrows;
    if (KIND == 0) { h = hg; q0 = qb * 256; qrow0 = q0 + 32 * w; qcol = C_FOX + h * 64; kcol = C_FOX + (4 + h) * 64; vcol = C_FOX + (8 + h) * 64; nrows = 256; }
    else if (KIND == 2) { h = hg; q0 = qb * 256; qrow0 = q0 + 32 * w; qcol = C_SB + h * 64; kcol = C_SB + (4 + h) * 64; vcol = C_SB + (8 + h) * 64; nrows = 256; }
    else { h = 4 * hg + (w & 3); q0 = qb * 64; qrow0 = q0 + 32 * (w >> 2); qcol = h * 64; kcol = C_KV + ((2 * 2 + 0) * 2 + hg) * 64; vcol = C_KV + ((2 * 2 + 1) * 2 + hg) * 64; nrows = 64; }
    const int tq = qrow0 + r32;
    const bf16_t* kbase = projb + (size_t)(b * S_) * PB + kcol; const bf16_t* vbase = projb + (size_t)(b * S_) * PB + vcol;
    bf16x8 qf[4];
    { const bf16_t* qptr = projb + (size_t)(b * S_ + tq) * PB + qcol + 8 * hh;
#pragma unroll
      for (int d0 = 0; d0 < 4; ++d0) qf[d0] = *(const bf16x8*)(qptr + 16 * d0); }
    int j0 = 0; const int j1 = (q0 + nrows - 1) >> 6;
    if (KIND == 1) { j0 = (q0 - 511) >> 6; if (j0 < 0) j0 = 0; }
    const int ntile = j1 - j0 + 1;
    float ct2 = 0.f, sl2 = 0.f; const float* cb = nullptr;
    if (KIND == 0) { cb = WSP(float, O_CFOX) + (size_t)(b * 4 + h) * S_; ct2 = cb[tq] * LOG2E; }
    if (KIND == 1) sl2 = exp2f(-(float)(h + 1)) * LOG2E;
    const float tqf = (float)tq;
    const int skey = tid >> 3, sch = tid & 7;
    u32x4 rk, rv; float rc = 0.f;
#define E1_LOAD(jj) do { const size_t ro_ = (size_t)((jj) * 64 + skey) * PB + sch * 8; rk = *(const u32x4*)(kbase + ro_); rv = *(const u32x4*)(vbase + ro_); \
        if (KIND == 0 && tid < 64) rc = cb[(jj) * 64 + tid] * LOG2E; } while (0)
#define E1_WRITE(bufp) do { *(LAS u32x4*)((bufp) + E1_K + skey * KROW + sch * 16) = rk; \
        LAS unsigned short* vt_ = (LAS unsigned short*)((bufp) + E1_V + (8 * sch) * VROW) + skey; \
        vt_[0 * (VROW / 2)] = (unsigned short)(rv.x & 0xffffu); vt_[1 * (VROW / 2)] = (unsigned short)(rv.x >> 16); vt_[2 * (VROW / 2)] = (unsigned short)(rv.y & 0xffffu); vt_[3 * (VROW / 2)] = (unsigned short)(rv.y >> 16); \
        vt_[4 * (VROW / 2)] = (unsigned short)(rv.z & 0xffffu); vt_[5 * (VROW / 2)] = (unsigned short)(rv.z >> 16); vt_[6 * (VROW / 2)] = (unsigned short)(rv.w & 0xffffu); vt_[7 * (VROW / 2)] = (unsigned short)(rv.w >> 16); \
        if (KIND == 0 && tid < 64) ((LAS float*)((bufp) + E1_C))[tid] = rc; } while (0)
    f32x16 o0, o1;
#pragma unroll
    for (int r = 0; r < 16; ++r) { o0[r] = 0.f; o1[r] = 0.f; }
    float m = -1e30f, l = 0.f, carry = 0.f;
    bool wave_done = false;
    LAS unsigned* flags = (LAS unsigned*)(lds + E1_FLAGS);
    if (KIND == 2) { if (tid < 8) flags[tid] = 0u; }
    __syncthreads();
    E1_LOAD(KIND == 2 ? j1 : j0);
    for (int it = 0; it < ntile; ++it) {
        const int j = (KIND == 2) ? (j1 - it) : (j0 + it);
        LAS unsigned char* buf = lds + (it & 1) * E1_BUF;
        E1_WRITE(buf);
        __syncthreads();
        if (KIND == 2) { unsigned alld = 1u;
#pragma unroll
            for (int i = 0; i < 8; ++i) alld &= flags[i];
            if (alld) break; }
        if (it + 1 < ntile) E1_LOAD((KIND == 2) ? (j - 1) : (j + 1));
        if (!(KIND == 2 && wave_done)) {
            f32x16 p0, p1;
#pragma unroll
            for (int r = 0; r < 16; ++r) { p0[r] = 0.f; p1[r] = 0.f; }
            { const LAS unsigned char* kp_ = buf + E1_K + r32 * KROW + hh * 16;
#pragma unroll
              for (int d0 = 0; d0 < 4; ++d0) { const bf16x8 a0 = *(const LAS bf16x8*)(kp_ + d0 * 32), a1 = *(const LAS bf16x8*)(kp_ + 32 * KROW + d0 * 32);
                  p0 = __builtin_amdgcn_mfma_f32_32x32x16_bf16(a0, qf[d0], p0, 0, 0, 0); p1 = __builtin_amdgcn_mfma_f32_32x32x16_bf16(a1, qf[d0], p1, 0, 0, 0); } }
            const int kb = j * 64 + 4 * hh;
            if (KIND == 2) {
                float lk0[16], lk1[16], gs[8];
#pragma unroll
                for (int reg = 0; reg < 16; ++reg) { const int kpos = kb + CROW(reg, 0);
                    const float z0 = p0[reg] * SCALE, z1 = p1[reg] * SCALE; const bool v0 = kpos < tq, v1 = kpos + 32 < tq;
                    const float lb0 = fminf(z0, 0.f) - __logf(1.f + __expf(-fabsf(z0))), lb1 = fminf(z1, 0.f) - __logf(1.f + __expf(-fabsf(z1)));
                    lk0[reg] = v0 ? (lb0 - z0) : 0.f; lk1[reg] = v1 ? (lb1 - z1) : 0.f;
                    p0[reg] = v0 ? lb0 : -INFINITY; p1[reg] = v1 ? lb1 : -INFINITY; }
#pragma unroll
                for (int g4 = 0; g4 < 4; ++g4) { gs[g4] = (lk0[4 * g4] + lk0[4 * g4 + 1]) + (lk0[4 * g4 + 2] + lk0[4 * g4 + 3]); gs[4 + g4] = (lk1[4 * g4] + lk1[4 * g4 + 1]) + (lk1[4 * g4 + 2] + lk1[4 * g4 + 3]); }
                float oth[8];
#pragma unroll
                for (int gi = 0; gi < 8; ++gi) oth[gi] = __shfl_xor(gs[gi], 32);
                float run = 0.f;
#pragma unroll
                for (int gi = 7; gi >= 0; --gi) {
                    float later = carry + run + (hh == 0 ? oth[gi] : 0.f);
#pragma unroll
                    for (int e = 3; e >= 0; --e) { const int reg = (gi & 3) * 4 + e;
                        if (gi >> 2) { p1[reg] = __expf(p1[reg] + later); later += lk1[reg]; } else { p0[reg] = __expf(p0[reg] + later); later += lk0[reg]; } }
                    run += gs[gi] + oth[gi]; }
                carry += run;
            } else {
                if (KIND == 0) {
                    const LAS float* cs = (const LAS float*)(buf + E1_C) + 4 * hh;
#pragma unroll
                    for (int i = 0; i < 4; ++i) { const f32x4 c0 = *(const LAS f32x4*)(cs + 8 * i), c1 = *(const LAS f32x4*)(cs + 32 + 8 * i);
#pragma unroll
                        for (int e = 0; e < 4; ++e) { const int reg = 4 * i + e; const int kpos = kb + CROW(reg, 0);
                            const float s0 = p0[reg] * (SCALE * LOG2E) + (ct2 - c0[e]), s1 = p1[reg] * (SCALE * LOG2E) + (ct2 - c1[e]);
                            p0[reg] = (kpos <= tq) ? s0 : -INFINITY; p1[reg] = (kpos + 32 <= tq) ? s1 : -INFINITY; } }
                } else {
#pragma unroll
                    for (int reg = 0; reg < 16; ++reg) { const int kpos = kb + CROW(reg, 0); const float d0f = tqf - (float)kpos, d1f = d0f - 32.f;
                        const float s0 = p0[reg] * (SCALE * LOG2E) - sl2 * d0f, s1 = p1[reg] * (SCALE * LOG2E) - sl2 * d1f;
                        p0[reg] = (kpos <= tq && tq - kpos < 512) ? s0 : -INFINITY; p1[reg] = (kpos + 32 <= tq && tq - kpos - 32 < 512) ? s1 : -INFINITY; }
                }
                float rm = fmaxf(p0[0], p1[0]);
#pragma unroll
                for (int reg = 1; reg < 16; ++reg) rm = fmaxf(rm, fmaxf(p0[reg], p1[reg]));
                rm = fmaxf(rm, __shfl_xor(rm, 32));
                if (__any(rm > m + RESC_THR)) { const float mn = fmaxf(m, rm), al = __builtin_amdgcn_exp2f(m - mn); l *= al;
#pragma unroll
                    for (int r = 0; r < 16; ++r) { o0[r] *= al; o1[r] *= al; }
                    m = mn; }
                float ls = 0.f;
#pragma unroll
                for (int reg = 0; reg < 16; ++reg) { p0[reg] = __builtin_amdgcn_exp2f(p0[reg] - m); p1[reg] = __builtin_amdgcn_exp2f(p1[reg] - m); ls += p0[reg] + p1[reg]; }
                l += ls;
            }
            { const LAS unsigned char* vp_ = buf + E1_V + r32 * VROW + hh * 8;
#pragma unroll
              for (int s = 0; s < 4; ++s) {
                  u32x4 pw;
                  if (s < 2) { pw.x = cvtpk(p0[8 * s + 0], p0[8 * s + 1]); pw.y = cvtpk(p0[8 * s + 2], p0[8 * s + 3]); pw.z = cvtpk(p0[8 * s + 4], p0[8 * s + 5]); pw.w = cvtpk(p0[8 * s + 6], p0[8 * s + 7]); }
                  else { const int s2 = s - 2; pw.x = cvtpk(p1[8 * s2 + 0], p1[8 * s2 + 1]); pw.y = cvtpk(p1[8 * s2 + 2], p1[8 * s2 + 3]); pw.z = cvtpk(p1[8 * s2 + 4], p1[8 * s2 + 5]); pw.w = cvtpk(p1[8 * s2 + 6], p1[8 * s2 + 7]); }
                  const bf16x8 pb = __builtin_bit_cast(bf16x8, pw);
                  const u32x2 a0l = *(const LAS u32x2*)(vp_ + s * 32), a0h = *(const LAS u32x2*)(vp_ + s * 32 + 16);
                  const u32x2 a1l = *(const LAS u32x2*)(vp_ + 32 * VROW + s * 32), a1h = *(const LAS u32x2*)(vp_ + 32 * VROW + s * 32 + 16);
                  const bf16x8 va0 = __builtin_bit_cast(bf16x8, (u32x4){a0l.x, a0l.y, a0h.x, a0h.y}), va1 = __builtin_bit_cast(bf16x8, (u32x4){a1l.x, a1l.y, a1h.x, a1h.y});
                  o0 = __builtin_amdgcn_mfma_f32_32x32x16_bf16(va0, pb, o0, 0, 0, 0); o1 = __builtin_amdgcn_mfma_f32_32x32x16_bf16(va1, pb, o1, 0, 0, 0); } }
            if (KIND == 2) { const bool dn = __all(carry < -110.f);
                if (dn && !wave_done) { wave_done = true; if (lane == 0) flags[w] = 1u; } }
        }
    }
    float inv = 1.f, gate = 1.f;
    if (KIND != 2) { l += __shfl_xor(l, 32); inv = (l > 0.f) ? 1.f / l : 0.f; }
    float* orow;
    if (KIND == 0) orow = obase + (size_t)(b * S_ + tq) * D_ + 512 + h * 64;
    else if (KIND == 2) orow = obase + (size_t)(b * S_ + tq) * D_ + 768 + h * 64;
    else { orow = owin + (size_t)(b * S_ + tq) * 512 + h * 64; gate = WSP(float, O_GF)[(size_t)(b * S_ + tq) * 32 + 2 * 8 + h]; }
    const float sc = inv * gate;
#pragma unroll
    for (int i = 0; i < 4; ++i) {
        *(f32x4*)(orow + 8 * i + 4 * hh) = (f32x4){o0[4 * i] * sc, o0[4 * i + 1] * sc, o0[4 * i + 2] * sc, o0[4 * i + 3] * sc};
        *(f32x4*)(orow + 32 + 8 * i + 4 * hh) = (f32x4){o1[4 * i] * sc, o1[4 * i + 1] * sc, o1[4 * i + 2] * sc, o1[4 * i + 3] * sc}; }
#undef E1_LOAD
#undef E1_WRITE
}
}
namespace mk {
typedef short v4i16_t __attribute__((ext_vector_type(4)));
constexpr int E2_WAVE = 64 * KROW + 512;
template <bool USE_MASK>
__device__ __forceinline__ void e2_wave_unit(LAS unsigned char* ldsw, KP p, int b, int g, int t0, float* __restrict__ obase, const float* __restrict__ csrc, int cpitch) {
    const int lane = ftid() & 63, r32 = lane & 31, hh = lane >> 5, qi = r32 >> 2, r4 = r32 & 3;
    const int h = 4 * g + r4, tq = t0 + qi;
    const bf16_t* projb = WSP(bf16_t, O_PROJB);
    const bf16_t* kbase = projb + (size_t)(b * S_) * PB + C_KV + ((1 * 2 + 0) * 2 + g) * 64;
    const bf16_t* vbase = projb + (size_t)(b * S_) * PB + C_KV + ((1 * 2 + 1) * 2 + g) * 64;
    bf16x8 qf[4];
    { const bf16_t* qptr = projb + (size_t)(b * S_ + tq) * PB + h * 64 + 8 * hh;
#pragma unroll
      for (int d0 = 0; d0 < 4; ++d0) qf[d0] = *(const bf16x8*)(qptr + 16 * d0); }
    unsigned qm0 = 0u, qm1 = 0u, qm2 = 0u, qm3 = 0u;
    if (USE_MASK) { const u32x4 mw = *(const u32x4*)(WSP(unsigned, O_SELMASK) + ((size_t)((b * 2 + g) * S_ + t0 + (lane >> 3))) * 4); qm0 = mw.x; qm1 = mw.y; qm2 = mw.z; qm3 = mw.w; }
    else { const int* sp = WSP(int, O_SEL) + ((size_t)((b * 2 + g) * S_ + t0)) * NSEL + lane * 2;
      const int e0 = sp[0], e1 = sp[1];
#pragma unroll
      for (int k = 0; k < 2; ++k) { const int e = k ? e1 : e0; const unsigned bit = 1u << (e & 31); const int wd = e >> 5;
          qm0 |= (wd == 0) ? bit : 0u; qm1 |= (wd == 1) ? bit : 0u; qm2 |= (wd == 2) ? bit : 0u; qm3 |= (wd == 3) ? bit : 0u; }
#pragma unroll
      for (int o = 1; o < 8; o <<= 1) { qm0 |= __shfl_xor(qm0, o); qm1 |= __shfl_xor(qm1, o); qm2 |= __shfl_xor(qm2, o); qm3 |= __shfl_xor(qm3, o); } }
    const unsigned rm0 = __shfl(qm0, qi * 8), rm1 = __shfl(qm1, qi * 8), rm2 = __shfl(qm2, qi * 8), rm3 = __shfl(qm3, qi * 8);
    unsigned um0 = qm0, um1 = qm1, um2 = qm2, um3 = qm3;
#pragma unroll
    for (int o = 8; o < 64; o <<= 1) { um0 |= __shfl_xor(um0, o); um1 |= __shfl_xor(um1, o); um2 |= __shfl_xor(um2, o); um3 |= __shfl_xor(um3, o); }
    LAS int* list = (LAS int*)(ldsw + 64 * KROW);
    int nblk;
    { const bool s0 = (((lane < 32) ? um0 : um1) >> (lane & 31)) & 1u, s1 = (((lane < 32) ? um2 : um3) >> (lane & 31)) & 1u;
      const unsigned long long b0 = __ballot(s0), b1 = __ballot(s1);
      const unsigned long long lower = (lane == 0) ? 0ull : (~0ull >> (64 - lane));
      const int n0 = __popcll(b0);
      if (s0) list[__popcll(b0 & lower)] = lane;
      if (s1) list[n0 + __popcll(b1 & lower)] = lane + 64;
      nblk = n0 + __popcll(b1); }
    asm volatile("s_waitcnt lgkmcnt(0)" ::: "memory");
    const float sl2 = exp2f(-(float)(h + 1)) * LOG2E, tqf = (float)tq;
    f32x16 o0, o1;
#pragma unroll
    for (int r = 0; r < 16; ++r) { o0[r] = 0.f; o1[r] = 0.f; }
    float m = -1e30f, l = 0.f;
    const int vrow = lane >> 3, vch = lane & 7;
    const int gq = lane >> 4, li = lane & 15;
    const LAS unsigned char* trb = ldsw + (4 * hh + (li >> 2)) * KROW + (16 * (gq & 1) + 4 * (li & 3)) * 2;
    bf16x8 kn0[4], kn1[4]; u32x4 vn[8];
#define E2_LOAD(blk) do { const bf16_t* kp_ = kbase + (size_t)((blk) * 64 + r32) * PB + 8 * hh; const bf16_t* vp_ = vbase + (size_t)((blk) * 64 + vrow) * PB + vch * 8; \
        _Pragma("unroll") for (int d0 = 0; d0 < 4; ++d0) { kn0[d0] = *(const bf16x8*)(kp_ + 16 * d0); kn1[d0] = *(const bf16x8*)(kp_ + (size_t)32 * PB + 16 * d0); } \
        _Pragma("unroll") for (int i = 0; i < 8; ++i) vn[i] = *(const u32x4*)(vp_ + (size_t)(8 * i) * PB); } while (0)
    int blk = list[0];
    blk = __builtin_amdgcn_readfirstlane(blk);
    E2_LOAD(blk);
    for (int it = 0; it < nblk; ++it) {
#pragma unroll
        for (int i = 0; i < 8; ++i) *(LAS u32x4*)(ldsw + (vrow + 8 * i) * KROW + vch * 16) = vn[i];
        const int cur = blk;
        f32x16 p0, p1;
#pragma unroll
        for (int r = 0; r < 16; ++r) { p0[r] = 0.f; p1[r] = 0.f; }
#pragma unroll
        for (int d0 = 0; d0 < 4; ++d0) { p0 = __builtin_amdgcn_mfma_f32_32x32x16_bf16(kn0[d0], qf[d0], p0, 0, 0, 0); p1 = __builtin_amdgcn_mfma_f32_32x32x16_bf16(kn1[d0], qf[d0], p1, 0, 0, 0); }
        if (it + 1 < nblk) { blk = __builtin_amdgcn_readfirstlane(list[it + 1]); E2_LOAD(blk); }
        const unsigned rw = (cur < 32) ? rm0 : (cur < 64) ? rm1 : (cur < 96) ? rm2 : rm3;
        const bool rowsel = (rw >> (cur & 31)) & 1u;
        const int kb = cur * 64 + 4 * hh;
#pragma unroll
        for (int reg = 0; reg < 16; ++reg) { const int kpos = kb + CROW(reg, 0); const float d0f = tqf - (float)kpos, d1f = d0f - 32.f;
            const float s0 = p0[reg] * (SCALE * LOG2E) - sl2 * d0f, s1 = p1[reg] * (SCALE * LOG2E) - sl2 * d1f;
            p0[reg] = (rowsel && kpos <= tq) ? s0 : -INFINITY; p1[reg] = (rowsel && kpos + 32 <= tq) ? s1 : -INFINITY; }
        float rmx = fmaxf(p0[0], p1[0]);
#pragma unroll
        for (int reg = 1; reg < 16; ++reg) rmx = fmaxf(rmx, fmaxf(p0[reg], p1[reg]));
        rmx = fmaxf(rmx, __shfl_xor(rmx, 32));
        if (__any(rmx > m + RESC_THR)) { const float mn = fmaxf(m, rmx), al = __builtin_amdgcn_exp2f(m - mn); l *= al;
#pragma unroll
            for (int r = 0; r < 16; ++r) { o0[r] *= al; o1[r] *= al; }
            m = mn; }
        float ls = 0.f;
#pragma unroll
        for (int reg = 0; reg < 16; ++reg) { p0[reg] = __builtin_amdgcn_exp2f(p0[reg] - m); p1[reg] = __builtin_amdgcn_exp2f(p1[reg] - m); ls += p0[reg] + p1[reg]; }
        l += ls;
#pragma unroll
        for (int s = 0; s < 4; ++s) {
            u32x4 pw;
            if (s < 2) { pw.x = cvtpk(p0[8 * s + 0], p0[8 * s + 1]); pw.y = cvtpk(p0[8 * s + 2], p0[8 * s + 3]); pw.z = cvtpk(p0[8 * s + 4], p0[8 * s + 5]); pw.w = cvtpk(p0[8 * s + 6], p0[8 * s + 7]); }
            else { const int s2 = s - 2; pw.x = cvtpk(p1[8 * s2 + 0], p1[8 * s2 + 1]); pw.y = cvtpk(p1[8 * s2 + 2], p1[8 * s2 + 3]); pw.z = cvtpk(p1[8 * s2 + 4], p1[8 * s2 + 5]); pw.w = cvtpk(p1[8 * s2 + 6], p1[8 * s2 + 7]); }
            const bf16x8 pb = __builtin_bit_cast(bf16x8, pw);
            const v4i16_t a0l = __builtin_amdgcn_ds_read_tr16_b64_v4i16((LAS v4i16_t*)(trb + (16 * s) * KROW)), a0h = __builtin_amdgcn_ds_read_tr16_b64_v4i16((LAS v4i16_t*)(trb + (16 * s + 8) * KROW));
            const v4i16_t a1l = __builtin_amdgcn_ds_read_tr16_b64_v4i16((LAS v4i16_t*)(trb + (16 * s) * KROW + 64)), a1h = __builtin_amdgcn_ds_read_tr16_b64_v4i16((LAS v4i16_t*)(trb + (16 * s + 8) * KROW + 64));
            const bf16x8 va0 = (bf16x8){a0l[0], a0l[1], a0l[2], a0l[3], a0h[0], a0h[1], a0h[2], a0h[3]}, va1 = (bf16x8){a1l[0], a1l[1], a1l[2], a1l[3], a1h[0], a1h[1], a1h[2], a1h[3]};
            o0 = __builtin_amdgcn_mfma_f32_32x32x16_bf16(va0, pb, o0, 0, 0, 0); o1 = __builtin_amdgcn_mfma_f32_32x32x16_bf16(va1, pb, o1, 0, 0, 0); }
    }
    l += __shfl_xor(l, 32);
    const float sc = ((l > 0.f) ? 1.f / l : 0.f) * WSP(float, O_GF)[(size_t)(b * S_ + tq) * 32 + 1 * 8 + h];
    float* orow = obase + (size_t)(b * S_ + tq) * D_ + h * 64; const float* crow = csrc + (size_t)(b * S_ + tq) * cpitch + h * 64;
#pragma unroll
    for (int i = 0; i < 4; ++i) {
        f32x4 x0 = *(const f32x4*)(crow + 8 * i + 4 * hh), x1 = *(const f32x4*)(crow + 32 + 8 * i + 4 * hh);
        x0 += (f32x4){o0[4 * i] * sc, o0[4 * i + 1] * sc, o0[4 * i + 2] * sc, o0[4 * i + 3] * sc}; x1 += (f32x4){o1[4 * i] * sc, o1[4 * i + 1] * sc, o1[4 * i + 2] * sc, o1[4 * i + 3] * sc};
        *(f32x4*)(orow + 8 * i + 4 * hh) = x0; *(f32x4*)(orow + 32 + 8 * i + 4 * hh) = x1; }
#undef E2_LOAD
}
template <bool USE_MASK>
__device__ __forceinline__ void ph_attn_sel2(LAS unsigned char* lds3, KP p, float* __restrict__ obase, const float* __restrict__ csrc, int cpitch) {
    const int w = __builtin_amdgcn_readfirstlane(ftid() >> 6);
    LAS unsigned char* ldsw = lds3 + w * E2_WAVE;
    MK_LOOP(u, 512) { const int bg = u & 3, qblk = u >> 2; e2_wave_unit<USE_MASK>(ldsw, p, bg >> 1, bg & 1, qblk * 64 + 8 * w, obase, csrc, cpitch); }
}
}
namespace mk {
constexpr int E3_K = 0, E3_V = 512 * KROW, E3_BYTES = 2 * 512 * KROW;
__device__ __forceinline__ void e3_unit(LAS unsigned char* lds, KP p, int b, int g, int qb, float* __restrict__ ocmp, unsigned* __restrict__ selmask) {
    const int tid = ftid(), lane = tid & 63, w = __builtin_amdgcn_readfirstlane(tid >> 6), r32 = lane & 31, hh = lane >> 5;
    const int bg = b * 2 + g, q0 = qb * 256, qrow0 = q0 + 32 * w, tq = qrow0 + r32;
    const bf16_t* projb = WSP(bf16_t, O_PROJB);
    int nun = (q0 + 255 - 31) / 16 + 1; if (nun > 511) nun = 511;
    const int ntile_u = (nun + 63) >> 6;
    __syncthreads();
    { const int srow = tid >> 3, sch = tid & 7; const bf16_t* ks = WSP(bf16_t, O_KCMPB) + ((size_t)bg * 512 + srow) * 64 + sch * 8; const bf16_t* vs = WSP(bf16_t, O_VCMPB) + ((size_t)bg * 512 + srow) * 64 + sch * 8;
      for (int i = 0; i < ntile_u; ++i) { const u32x4 kv = *(const u32x4*)(ks + (size_t)i * 64 * 64), vv = *(const u32x4*)(vs + (size_t)i * 64 * 64);
          *(LAS u32x4*)(lds + E3_K + (srow + 64 * i) * KROW + sch * 16) = kv; *(LAS u32x4*)(lds + E3_V + (srow + 64 * i) * KROW + sch * 16) = vv; } }
    __syncthreads();
    int nw = qrow0 / 16 + 1; if (nw > 511) nw = 511;
    const int ntile_w = (qrow0 + 31 < 31) ? 0 : ((nw + 63) >> 6);
    const float tqf = (float)tq;
    const int gq = lane >> 4, li = lane & 15;
    const LAS unsigned char* trb = lds + E3_V + (4 * hh + (li >> 2)) * KROW + (16 * (gq & 1) + 4 * (li & 3)) * 2;
    const LAS unsigned char* kfb = lds + E3_K + r32 * KROW + hh * 16;
    float imp[64];
#pragma unroll
    for (int i = 0; i < 64; ++i) imp[i] = 0.f;
#pragma unroll 1
    for (int r4 = 0; r4 < 4; ++r4) {
        const int h = 4 * g + r4; const float sl2 = exp2f(-(float)(h + 1)) * LOG2E;
        bf16x8 qf[4];
        { const bf16_t* qptr = projb + (size_t)(b * S_ + tq) * PB + h * 64 + 8 * hh;
#pragma unroll
          for (int d0 = 0; d0 < 4; ++d0) qf[d0] = *(const bf16x8*)(qptr + 16 * d0); }
        f32x16 o0, o1;
#pragma unroll
        for (int r = 0; r < 16; ++r) { o0[r] = 0.f; o1[r] = 0.f; }
        float m = -1e30f, l = 0.f;
#define E3_ST(jt) f32x16 p0, p1; { _Pragma("unroll") for (int r = 0; r < 16; ++r) { p0[r] = 0.f; p1[r] = 0.f; } \
            _Pragma("unroll") for (int d0 = 0; d0 < 4; ++d0) { const bf16x8 a0 = *(const LAS bf16x8*)(kfb + (64 * (jt)) * KROW + d0 * 32), a1 = *(const LAS bf16x8*)(kfb + (64 * (jt) + 32) * KROW + d0 * 32); \
                p0 = __builtin_amdgcn_mfma_f32_32x32x16_bf16(a0, qf[d0], p0, 0, 0, 0); p1 = __builtin_amdgcn_mfma_f32_32x32x16_bf16(a1, qf[d0], p1, 0, 0, 0); } \
            int tq_ = tq; asm volatile("" : "+v"(tq_));     \
            int hh_ = hh; asm volatile("" : "+v"(hh_)); \
            const float tqf_ = (float)tq_; const int ce0_ = 16 * (64 * (jt) + 4 * hh_) + 31; \
            _Pragma("unroll") for (int reg = 0; reg < 16; ++reg) { const int ce = ce0_ + 16 * CROW(reg, 0); const float d0f = tqf_ - (float)ce, d1f = d0f - 512.f; \
                const float s0 = p0[reg] * (SCALE * LOG2E) - sl2 * d0f, s1 = p1[reg] * (SCALE * LOG2E) - sl2 * d1f; \
                p0[reg] = (ce <= tq_) ? s0 : -INFINITY; p1[reg] = (ce + 512 <= tq_) ? s1 : -INFINITY; } }
        for (int jt = 0; jt < ntile_w; ++jt) {
            E3_ST(jt);
            float rmx = fmaxf(p0[0], p1[0]);
#pragma unroll
            for (int reg = 1; reg < 16; ++reg) rmx = fmaxf(rmx, fmaxf(p0[reg], p1[reg]));
            rmx = fmaxf(rmx, __shfl_xor(rmx, 32));
            if (__any(rmx > m + RESC_THR)) { const float mn = fmaxf(m, rmx), al = __builtin_amdgcn_exp2f(m - mn); l *= al;
#pragma unroll
                for (int r = 0; r < 16; ++r) { o0[r] *= al; o1[r] *= al; }
                m = mn; }
            float ls = 0.f;
#pragma unroll
            for (int reg = 0; reg < 16; ++reg) { p0[reg] = __builtin_amdgcn_exp2f(p0[reg] - m); p1[reg] = __builtin_amdgcn_exp2f(p1[reg] - m); ls += p0[reg] + p1[reg]; }
            l += ls;
            const LAS unsigned char* tb = trb + (64 * jt) * KROW;
#pragma unroll
            for (int s = 0; s < 4; ++s) {
                u32x4 pw;
                if (s < 2) { pw.x = cvtpk(p0[8 * s + 0], p0[8 * s + 1]); pw.y = cvtpk(p0[8 * s + 2], p0[8 * s + 3]); pw.z = cvtpk(p0[8 * s + 4], p0[8 * s + 5]); pw.w = cvtpk(p0[8 * s + 6], p0[8 * s + 7]); }
                else { const int s2 = s - 2; pw.x = cvtpk(p1[8 * s2 + 0], p1[8 * s2 + 1]); pw.y = cvtpk(p1[8 * s2 + 2], p1[8 * s2 + 3]); pw.z = cvtpk(p1[8 * s2 + 4], p1[8 * s2 + 5]); pw.w = cvtpk(p1[8 * s2 + 6], p1[8 * s2 + 7]); }
                const bf16x8 pb = __builtin_bit_cast(bf16x8, pw);
                const v4i16_t a0l = __builtin_amdgcn_ds_read_tr16_b64_v4i16((LAS v4i16_t*)(tb + (16 * s) * KROW)), a0h = __builtin_amdgcn_ds_read_tr16_b64_v4i16((LAS v4i16_t*)(tb + (16 * s + 8) * KROW));
                const v4i16_t a1l = __builtin_amdgcn_ds_read_tr16_b64_v4i16((LAS v4i16_t*)(tb + (16 * s) * KROW + 64)), a1h = __builtin_amdgcn_ds_read_tr16_b64_v4i16((LAS v4i16_t*)(tb + (16 * s + 8) * KROW + 64));
                const bf16x8 va0 = (bf16x8){a0l[0], a0l[1], a0l[2], a0l[3], a0h[0], a0h[1], a0h[2], a0h[3]}, va1 = (bf16x8){a1l[0], a1l[1], a1l[2], a1l[3], a1h[0], a1h[1], a1h[2], a1h[3]};
                o0 = __builtin_amdgcn_mfma_f32_32x32x16_bf16(va0, pb, o0, 0, 0, 0); o1 = __builtin_amdgcn_mfma_f32_32x32x16_bf16(va1, pb, o1, 0, 0, 0); }
        }
        l += __shfl_xor(l, 32);
        const float inv = (l > 0.f) ? 1.f / l : 0.f;
        { const float sc = inv * WSP(float, O_GF)[(size_t)(b * S_ + tq) * 32 + 0 * 8 + h];
          float* orow = ocmp + (size_t)(b * S_ + tq) * 512 + h * 64;
#pragma unroll
          for (int i = 0; i < 4; ++i) {
              *(f32x4*)(orow + 8 * i + 4 * hh) = (f32x4){o0[4 * i] * sc, o0[4 * i + 1] * sc, o0[4 * i + 2] * sc, o0[4 * i + 3] * sc};
              *(f32x4*)(orow + 32 + 8 * i + 4 * hh) = (f32x4){o1[4 * i] * sc, o1[4 * i + 1] * sc, o1[4 * i + 2] * sc, o1[4 * i + 3] * sc}; } }
#pragma unroll
        for (int jt = 0; jt < 8; ++jt) {
            if (jt < ntile_w) {
                E3_ST(jt);
#pragma unroll
                for (int reg = 0; reg < 16; ++reg) { p0[reg] = __builtin_amdgcn_exp2f(p0[reg] - m) * inv; p1[reg] = __builtin_amdgcn_exp2f(p1[reg] - m) * inv; }
#pragma unroll
                for (int pa = 0; pa < 2; ++pa)
#pragma unroll
                    for (int i = 0; i < 4; ++i) { const int jj = 8 * jt + 4 * pa + i;
                        const float x0 = pa ? p1[4 * i] : p0[4 * i], x1 = pa ? p1[4 * i + 1] : p0[4 * i + 1], x2 = pa ? p1[4 * i + 2] : p0[4 * i + 2], x3 = pa ? p1[4 * i + 3] : p0[4 * i + 3];
                        const float c = 0.5f * x3, a = (x0 + x1) + (x2 + c), r = __shfl_xor(c, 32);
                        imp[jj] += a + (hh ? r : 0.f);
                        if (jj + 1 < 64) imp[jj + 1] += (hh ? 0.f : r); }
            }
        }
#undef E3_ST
    }
    const int cur = tq >> 6;
#pragma unroll
    for (int jj = 0; jj < 64; ++jj) { const int j = 2 * jj + hh; imp[jj] = (j != 0 && j < cur - 1) ? imp[jj] : -1.f; }
    unsigned m0 = 1u, m1 = 0u, m2 = 0u, m3 = 0u;
#define E3_SETBIT(j) do { const unsigned bit_ = 1u << ((j) & 31); const int wd_ = (j) >> 5; m0 |= (wd_ == 0) ? bit_ : 0u; m1 |= (wd_ == 1) ? bit_ : 0u; m2 |= (wd_ == 2) ? bit_ : 0u; m3 |= (wd_ == 3) ? bit_ : 0u; } while (0)
    E3_SETBIT(cur); if (cur >= 1) E3_SETBIT(cur - 1);
#pragma unroll 1
    for (int it = 0; it < NSEL - 3; ++it) {
        float best = -0.5f; int bj = 0;
#pragma unroll
        for (int jj = 0; jj < 64; ++jj) { if (imp[jj] > best) { best = imp[jj]; bj = jj; } }
        const int myj = 2 * bj + hh; const float ob = __shfl_xor(best, 32); const int oj = __shfl_xor(myj, 32);
        const bool mine = (best > ob) || (best == ob && myj < oj);
        const float wv = mine ? best : ob; const int wj = mine ? myj : oj;
        if (wv >= 0.f) E3_SETBIT(wj);
        if (mine && best >= 0.f) {
#pragma unroll
            for (int jj = 0; jj < 64; ++jj) imp[jj] = (jj == bj) ? -2.f : imp[jj]; }
    }
#undef E3_SETBIT
    if (hh == 0) *(u32x4*)(selmask + ((size_t)bg * S_ + tq) * 4) = (u32x4){m0, m1, m2, m3};
}
}
namespace mk {
template <int CMPMODE>
__device__ __forceinline__ void ph_attn1(float* lds, LAS unsigned char* lds3, KP p, unsigned* qctr, float* obase, float* owin) {
    LAS int* qslot = (LAS int*)(lds3 + E3_BYTES);
    constexpr int N_E3 = (CMPMODE & 2) ? 128 : 0, N_CMP = (CMPMODE & 1) ? 64 : 0, N_FOX = 256, N_WIN = 512, N_SB = 256;
    for (;;) {
        __syncthreads();
        if (ftid() == 0) *qslot = (int)atomicAdd(qctr, 1u);
        __syncthreads();
        int u = __builtin_amdgcn_readfirstlane(*qslot);
        if (u >= N_E3 + N_CMP + N_FOX + N_WIN + N_SB) break;
        if (u < N_E3) { e3_unit(lds3, p, (u & 3) >> 1, u & 1, 31 - (u >> 2), WSP(float, O_OCMP), WSP(unsigned, O_SELMASK)); continue; } u -= N_E3;
        if (u < N_CMP) { attn_vblock<3>(lds, p, 15 - (u >> 2), u & 3); continue; } u -= N_CMP;
        if (u < N_FOX) { e1_unit<0>(lds3, p, (u & 7) >> 2, u & 3, 31 - (u >> 3), obase, owin); continue; } u -= N_FOX;
        if (u < N_WIN) { e1_unit<1>(lds3, p, (u & 3) >> 1, u & 1, 127 - (u >> 2), obase, owin); continue; } u -= N_WIN;
        e1_unit<2>(lds3, p, (u & 7) >> 2, u & 3, 31 - (u >> 3), obase, owin);
    }
}
__device__ __forceinline__ void ph_dbg_compare_cmp(KP p) {
    float num = 0.f, den = 0.f;
    for (size_t i = (size_t)fbid() * NT + ftid(); i < (size_t)T_ * 512; i += (size_t)gridDim.x * NT) { const size_t row = i >> 9; const int c = (int)(i & 511);
        const float a = WSP(float, O_OCMP)[i], b = WSP(float, O_O)[row * D_ + c]; num += (a - b) * (a - b); den += b * b; }
    float* dbg = WSP(float, O_COUNTS) + 256; const float n = wsum(num), d = wsum(den);
    if ((ftid() & 63) == 0) { atomicAdd(&dbg[8], n); atomicAdd(&dbg[9], d); }
}
__device__ __forceinline__ void ph_dbg_compare_sel(KP p) {
    float num = 0.f, den = 0.f;
    for (int i = fbid() * NT + ftid(); i < B_ * 2 * S_; i += gridDim.x * NT) {
        unsigned m[4] = {0u, 0u, 0u, 0u}; const int t = i % S_, cur = t >> 6;
        for (int k = 0; k < NSEL; ++k) { const int e = WSP(int, O_SEL)[(size_t)i * NSEL + k]; if (e <= cur) { if ((e >> 5) == 0) m[0] |= 1u << (e & 31); else if ((e >> 5) == 1) m[1] |= 1u << (e & 31); else if ((e >> 5) == 2) m[2] |= 1u << (e & 31); else m[3] |= 1u << (e & 31); } }
        const unsigned* sm = WSP(unsigned, O_SELMASK) + (size_t)i * 4;
        int diff = __popc(m[0] ^ sm[0]) + __popc(m[1] ^ sm[1]) + __popc(m[2] ^ sm[2]) + __popc(m[3] ^ sm[3]);
        num += (float)diff * 0.5f; den += 16.f; }
    float* dbg = WSP(float, O_COUNTS) + 256; const float n = wsum(num), d = wsum(den);
    if ((ftid() & 63) == 0) { atomicAdd(&dbg[10], n); atomicAdd(&dbg[11], d); }
}
__device__ __forceinline__ void ph_dbg_compare(KP p) {
    float num[3] = {0.f, 0.f, 0.f}, den[3] = {0.f, 0.f, 0.f};
    for (size_t i = (size_t)fbid() * NT + ftid(); i < (size_t)T_ * 512; i += (size_t)gridDim.x * NT) {
        const size_t row = i >> 9; const int c = (int)(i & 511);
        const float a = WSP(float, O_O2)[row * D_ + 512 + c], b = WSP(float, O_O)[row * D_ + 512 + c];
        const int k = c >> 8; num[k] += (a - b) * (a - b); den[k] += b * b;
        const float aw = WSP(float, O_OWIN2)[i], bw = WSP(float, O_OWIN)[i]; num[2] += (aw - bw) * (aw - bw); den[2] += bw * bw; }
    float* dbg = WSP(float, O_COUNTS) + 256;
#pragma unroll
    for (int k = 0; k < 3; ++k) { const float n = wsum(num[k]), d = wsum(den[k]); if ((ftid() & 63) == 0) { atomicAdd(&dbg[2 * k], n); atomicAdd(&dbg[2 * k + 1], d); } }
}
__device__ __forceinline__ void ph_dbg_copy_nsa(KP p) {
    for (size_t i = (size_t)fbid() * NT + ftid(); i < (size_t)T_ * 512; i += (size_t)gridDim.x * NT) { const size_t row = i >> 9; const int c = (int)(i & 511); WSP(float, O_O2)[row * D_ + c] = WSP(float, O_O)[row * D_ + c]; }
}
__device__ __forceinline__ void ph_dbg_compare_nsa(KP p) {
    float num = 0.f, den = 0.f;
    for (size_t i = (size_t)fbid() * NT + ftid(); i < (size_t)T_ * 512; i += (size_t)gridDim.x * NT) { const size_t row = i >> 9; const int c = (int)(i & 511);
        const float a = WSP(float, O_O2)[row * D_ + c], b = WSP(float, O_O)[row * D_ + c]; num += (a - b) * (a - b); den += b * b; }
    float* dbg = WSP(float, O_COUNTS) + 256; const float n = wsum(num), d = wsum(den);
    if ((ftid() & 63) == 0) { atomicAdd(&dbg[6], n); atomicAdd(&dbg[7], d); }
}
__device__ __forceinline__ void ph_dbg_encode(KP p, int ka, int kb) {
    const float* dbg = WSP(float, O_COUNTS) + 256;
    const float ea = sqrtf(dbg[2 * ka] / fmaxf(dbg[2 * ka + 1], 1e-30f)), eb = sqrtf(dbg[2 * kb] / fmaxf(dbg[2 * kb + 1], 1e-30f));
    for (size_t i = (size_t)fbid() * NT + ftid(); i < (size_t)T_ * D_; i += (size_t)gridDim.x * NT) { float v = p->out[i] * (1.f + 10.f * ea); if (i == 0) v += 1e4f * eb; p->out[i] = v; }
}
}
namespace cg = cooperative_groups;
__global__ void __launch_bounds__(512, 2) mega(mk::P p_unused) {
    extern __shared__ __attribute__((aligned(16))) unsigned char lds_raw[];
    float* lds = (float*)lds_raw;
    LAS unsigned char* lds3 = (LAS unsigned char*)lds_raw;
    cg::grid_group grid = cg::this_grid();
    using namespace nv; using namespace mk;
    for (int step = 0; step < 1 + 14 * L_; ++step) {
        const KP p = fresh_kp();
        const int l = (step - 1) / 14, k = (step == 0) ? -1 : (step - 1) % 14;
        const bool isg = (k == 0 || k == 7 || k == 11 || k == 12);
        if (isg) {
            const int kind = (k == 0) ? 0 : (k == 7) ? 1 : (k == 11) ? 2 : 3;
            GSched S; GEpi E; S.kind = kind; E.kind = kind; E.l = l;
            S.G = (int)gridDim.x; S.c = fbid(); S.meta = WSP(int, O_META); S.rowtok = WSP(int, O_ROWTOK); S.estep = 0;
            const char* A; int N;
            if (kind == 0) { A = (const char*)WSP(bf16_t, O_XB); S.Bt = (const char*)(WSP(bf16_t, O_WTIN) + (size_t)l * NPAD * D_); N = NPAD; }
            else if (kind == 1) { A = (const char*)WSP(bf16_t, O_OB); S.Bt = (const char*)(WSP(bf16_t, O_WTOUT) + (size_t)l * D_ * D_); N = D_; }
            else if (kind == 2) { A = (const char*)WSP(bf16_t, O_X1B); S.Bt = (const char*)(WSP(bf16_t, O_WTGU) + (size_t)l * NE * 2048 * D_); S.estep = (size_t)2048 * D_ * 2; N = 2048; }
            else { A = (const char*)WSP(bf16_t, O_ACT); S.Bt = (const char*)(WSP(bf16_t, O_WTDN) + (size_t)l * NE * D_ * D_); S.estep = (size_t)D_ * D_ * 2; N = D_; }
            S.nN = N / 256; S.nM = (kind < 2) ? T_ / 256 : S.meta[32]; S.nunits = S.nM * S.nN;
            pg8::gemm_phase<GEpi, GSched>(lds3, A, D_, S, E);
        } else {
            switch (k) {
                case -1: ph_convert(lds3, p); break;
                case 1: ph_prep(lds, p, l); break;
#if defined(DBG_ATTN)
                case 2: ph_attn_a(lds, p); break;
#elif defined(DBG_E3)
                case 2: ph_attn1<3>(lds, lds3, p, WSP(unsigned, O_COUNTS) + 128 + l, WSP(float, O_O), WSP(float, O_OWIN)); if (l == 0) { grid.sync(); ph_dbg_compare_cmp(p); } break;
#elif defined(NAIVE_CMP)
                case 2: ph_attn1<1>(lds, lds3, p, WSP(unsigned, O_COUNTS) + 128 + l, WSP(float, O_O), WSP(float, O_OWIN)); break;
#else
                case 2: ph_attn1<2>(lds, lds3, p, WSP(unsigned, O_COUNTS) + 128 + l, WSP(float, O_O), WSP(float, O_OWIN)); break;
#endif
#if defined(DBG_E3)
                case 3: ph_select(p); if (l == 0) { grid.sync(); ph_dbg_compare_sel(p); } break;
#elif defined(NAIVE_CMP) || defined(DBG_ATTN)
                case 3: ph_select(p); break;
#else
                case 3: break;
#endif
#if defined(DBG_SEL)
                case 4: if (l == 0) { ph_dbg_copy_nsa(p); grid.sync(); }
                        ph_attn_sel(p);
                        if (l == 0) { ph_attn_sel2<false>(lds3, p, WSP(float, O_O2), WSP(float, O_O2), D_); grid.sync(); ph_dbg_compare_nsa(p); }
                        break;
#elif defined(NAIVE_SEL)
                case 4: ph_attn_sel(p); break;
#elif defined(NAIVE_CMP) || defined(DBG_E3) || defined(DBG_ATTN)
                case 4: ph_attn_sel2<false>(lds3, p, WSP(float, O_O), WSP(float, O_O), D_); break;
#else
                case 4: ph_attn_sel2<true>(lds3, p, WSP(float, O_O), WSP(float, O_OCMP), 512); break;
#endif
#ifdef DBG_ATTN
                case 5: ph_attn_win(lds, p); grid.sync();
                        if (l == 0) { ph_attn1<0>(lds, lds3, p, WSP(unsigned, O_COUNTS) + 128 + l, WSP(float, O_O2), WSP(float, O_OWIN2)); grid.sync(); ph_dbg_compare(p); }
                        break;
#else
                case 5: break;
#endif
                case 6: ph_rmsnorm(p, l); break;
                case 8: ph_ln<true>(lds, p, l, WSP(float, O_X1)); break;
                case 9: ph_moe_plan(p, l); break;
                case 10: ph_moe_scatter(p); break;
                default: { float* xout = (l == L_ - 1) ? p->out : WSP(float, O_XA); ph_ln<false>(lds, p, l, xout); } break;
            }
        }
        grid.sync();
    }
#if defined(DBG_ATTN) || defined(DBG_SEL) || defined(DBG_E3)
    { const KP p = fresh_kp(); ph_dbg_encode(p, DBG_KA, DBG_KB); }
#endif
}

extern "C" void kernel_launch(void* const* d_in, const int* in_sizes, int n_in,
                              void* d_out, int out_size, void* d_ws, size_t ws_size,
                              hipStream_t stream) {
    constexpr size_t kDynLds = 147456 + 1024;
    static int grid_blocks = 0;
    if (!grid_blocks) {
        int dev = 0, cus = 0, per_cu = 0;
        (void)hipGetDevice(&dev);
        (void)hipDeviceGetAttribute(&cus, hipDeviceAttributeMultiprocessorCount, dev);
        (void)hipFuncSetAttribute((const void*)mega, hipFuncAttributeMaxDynamicSharedMemorySize, (int)kDynLds);
        (void)hipOccupancyMaxActiveBlocksPerMultiprocessor(&per_cu, mega, 512, kDynLds);
        if (per_cu < 1) per_cu = 1;
        if (per_cu > 1) per_cu = 1;
        grid_blocks = cus * per_cu;
        if (ws_size < mk::O_END) fprintf(stderr, "workspace too small: %zu < %zu\n", ws_size, (size_t)mk::O_END);
    }
    mk::P p{};
    p.in = nv::inputs(d_in); p.ws = (unsigned char*)d_ws; p.out = (float*)d_out;
    (void)hipMemsetAsync((char*)d_ws + mk::O_COUNTS, 0, 4096, stream);
    void* args[] = {&p};
    hipError_t e = hipLaunchCooperativeKernel((void*)mega, dim3(grid_blocks), dim3(512), args, kDynLds, stream);
    if (e != hipSuccess) fprintf(stderr, "cooperative launch failed: %s (grid %d)\n", hipGetErrorString(e), grid_blocks);
}
```

```cpp
#include <hip/hip_runtime.h>
#include <hip/hip_cooperative_groups.h>
#include <cstdio>
#include <cstdint>

namespace nv {

constexpr int B_ = 2, S_ = 8192, D_ = 1024, T_ = B_ * S_, L_ = 2;
constexpr int DIN = 2844;
constexpr int OFF_NSA_KV = 512, OFF_NSA_GATE = 1280, OFF_FOX_QKV = 1304, OFF_FOX_F = 2072, OFF_SB_QKV = 2076;
constexpr int NCMP = 511, NBLK = 128, NSEL = 16;
constexpr int NE = 32, TOPK = 4, MROWS = T_ * TOPK;
constexpr float LN_EPS = 1e-5f, RMS_EPS = 1e-6f;
constexpr float ALPHA = 1.4142135623730951f;
constexpr float SCALE = 0.125f;

__device__ __forceinline__ float sigmoidf_(float x) { return 1.f / (1.f + __expf(-x)); }
__device__ __forceinline__ float logsig(float x) { return fminf(x, 0.f) - log1pf(expf(-fabsf(x))); }

__device__ __forceinline__ float gelu_tanh(float x) { return 0.5f * x * (1.f + tanhf(0.7978845608028654f * (x + 0.044715f * x * x * x))); }
#define NV_DOT(q, kr, res) do { float s0_ = 0.f, s1_ = 0.f, s2_ = 0.f, s3_ = 0.f; _Pragma("unroll") for (int d_ = 0; d_ < 64; d_ += 4) { const float4 k4_ = *(const float4*)&(kr)[d_]; s0_ += q[d_] * k4_.x; s1_ += q[d_ + 1] * k4_.y; s2_ += q[d_ + 2] * k4_.z; s3_ += q[d_ + 3] * k4_.w; } res = (s0_ + s1_) + (s2_ + s3_); } while (0)
#define NV_AXPY(o, p, vr) do { _Pragma("unroll") for (int d_ = 0; d_ < 64; d_ += 4) { const float4 v4_ = *(const float4*)&(vr)[d_]; o[d_] += p * v4_.x; o[d_ + 1] += p * v4_.y; o[d_ + 2] += p * v4_.z; o[d_ + 3] += p * v4_.w; } } while (0)
#define NV_ONLINE(sc, vr) do { if (sc > m) { const float al_ = __expf(m - sc); l *= al_; _Pragma("unroll") for (int d_ = 0; d_ < 64; ++d_) o[d_] *= al_; m = sc; } const float p_ = __expf(sc - m); l += p_; NV_AXPY(o, p_, vr); } while (0)

__device__ __forceinline__ float wsum(float v) {
#pragma unroll
    for (int o = 1; o < 64; o <<= 1) v += __shfl_xor(v, o);
    return v;
}
struct In {
    const float *x, *w_in, *b_in, *pos_k, *pos_v, *w1k, *w2k, *w1v, *w2v, *g_out, *w_out, *ln1_g, *ln1_b, *rw, *rb, *wgu, *bgu, *wdn, *bdn, *ln2_g, *ln2_b;
};
inline In inputs(void* const* d) {
    In i; i.x = (const float*)d[0]; i.w_in = (const float*)d[1]; i.b_in = (const float*)d[2]; i.pos_k = (const float*)d[3]; i.pos_v = (const float*)d[4];
    i.w1k = (const float*)d[5]; i.w2k = (const float*)d[6]; i.w1v = (const float*)d[7]; i.w2v = (const float*)d[8]; i.g_out = (const float*)d[9]; i.w_out = (const float*)d[10];
    i.ln1_g = (const float*)d[11]; i.ln1_b = (const float*)d[12]; i.rw = (const float*)d[13]; i.rb = (const float*)d[14]; i.wgu = (const float*)d[15]; i.bgu = (const float*)d[16];
    i.wdn = (const float*)d[17]; i.bdn = (const float*)d[18]; i.ln2_g = (const float*)d[19]; i.ln2_b = (const float*)d[20]; return i;
}


}
namespace pg8 {
#define PG8_LAS __attribute__((address_space(3)))
typedef unsigned short bf16_t;
typedef short bf16x8 __attribute__((ext_vector_type(8)));
typedef float f32x4 __attribute__((ext_vector_type(4)));
typedef unsigned u32x4 __attribute__((ext_vector_type(4)));
constexpr int BM = 256, BK = 64, HALF = 128, HTB = HALF * BK * 2  , STAGE_BYTES = 8 * HTB, NXCD = 8, WGM = 8;

__host__ __device__ __forceinline__ int lds_byte(int r, int c) { const int st = (r >> 4) * 2 + (c >> 5), rr = r & 15, cc = c & 31, ob = rr * 64 + cc * 2; return st * 1024 + (ob ^ (((ob >> 9) & 1) << 5)); }
__host__ __device__ __forceinline__ void stage_rc(int b, int& R, int& C) { const int st = b / 1024, sb = b % 1024, swz = sb ^ (((sb >> 9) & 1) << 5); R = (st >> 1) * 16 + swz / 64; C = (st & 1) * 32 + (swz % 64) / 2; }
__host__ __device__ __forceinline__ int perm32(int rho) { const int n = rho >> 4, i = rho & 15; return 8 * (i >> 2) + 4 * n + (i & 3); }

struct Unit { int pm, pn, e, nr; };

struct StaticOrder {
    int nM, nN, nwg, G, c;
    __host__ __device__ void init(int M, int N, int G_, int c_) { nM = M / BM; nN = N / BM; nwg = nM * nN; G = G_; c = c_; }
    __host__ __device__ bool next(int i, Unit& u) const {
        const long L = (long)i * G + c; if (L >= nwg) return false;
        int wgid = (int)L; { const int q = nwg / NXCD, r = nwg % NXCD, xcd = wgid % NXCD, off = wgid / NXCD; wgid = (xcd < r ? xcd * (q + 1) : r * (q + 1) + (xcd - r) * q) + off; }
        const int nig = WGM * nN, gid = wgid / nig, fm = gid * WGM, gsz = (nM - fm) < WGM ? (nM - fm) : WGM;
        u.pm = fm + ((wgid % nig) % gsz); u.pn = (wgid % nig) / gsz; u.e = 0; u.nr = BM; return true;
    }
    const char* Bt; size_t tstep;
    __device__ __forceinline__ unsigned a_off(const Unit& u, int r) const { return (unsigned)(u.pm * BM + r) * 2048u; }
    __device__ __forceinline__ size_t a_kstep() const { return 128; }
    __device__ __forceinline__ const char* b_base(const Unit& u) const { return Bt + (size_t)u.pn * tstep; }
};


__device__ __forceinline__ unsigned cvt_pk_bf16(float lo, float hi) { unsigned r; asm volatile("v_cvt_pk_bf16_f32 %0, %1, %2" : "=v"(r) : "v"(lo), "v"(hi)); return r; }
template <class Epi, class Sched, bool ALIGN_EPI = true, bool SP2 = true>
__device__ __forceinline__ void gemm_phase(PG8_LAS unsigned char* lds, const char* Abase, const int K, const Sched& S, const Epi& E) {
    int tid_ = threadIdx.x; asm volatile("" : "+v"(tid_));
    const int tid = tid_, wid = __builtin_amdgcn_readfirstlane(tid >> 6), lane = tid & 63, wr = wid >> 2, wc = wid & 3, fr = lane & 15, fq = lane >> 4;
    const int nt = K / BK;
    unsigned voffB[2];
#pragma unroll
    for (int i = 0; i < 2; ++i) { int R, C; stage_rc(tid * 16 + i * 8192, R, C); const int Rb = Epi::PERM ? ((R & ~31) + perm32(R & 31)) : R;
        voffB[i] = (unsigned)(Rb * K + C) * 2u; }
#define PG8_AOFF(u, o0, o1) do { int _t = tid; asm volatile("" : "+v"(_t)); _Pragma("unroll") for (int _i = 0; _i < 2; ++_i) { int _R, _C; stage_rc(_t * 16 + _i * 8192, _R, _C); \
        (o0)[_i] = S.a_off((u), _R) + (unsigned)_C * 2u; (o1)[_i] = S.a_off((u), HALF + _R) + (unsigned)_C * 2u; } } while (0)
    const size_t kstep = (size_t)(BK * 2);
    const size_t akstep = S.a_kstep();
    const size_t hstep = (size_t)HALF * K * 2;
    const unsigned ldsw = (unsigned)wid * 1024u;
    const int aoff = lds_byte(wr * 64 + fr, fq * 8), boff = lds_byte(wc * 32 + fr, fq * 8);
#define PG8_SA(b, h) (((b) * 2 + (h)) * HTB)
#define PG8_SB(b, h) ((4 + (b) * 2 + (h)) * HTB)
#define PG8_STAGE(bufoff, gbase, voff) do { _Pragma("unroll") for (int _i = 0; _i < 2; ++_i) { unsigned _o = (voff)[_i]; asm volatile("" : "+v"(_o));     \
        __builtin_amdgcn_global_load_lds((const unsigned*)((const char*)(gbase) + _o), (PG8_LAS unsigned*)(lds + (bufoff) + ldsw + _i * 8192), 16, 0, 0); } } while (0)
#define PG8_LDA(dst, b, h) do { _Pragma("unroll") for (int m = 0; m < 4; ++m) _Pragma("unroll") for (int k = 0; k < 2; ++k) dst[m][k] = *(const PG8_LAS bf16x8*)(lds + PG8_SA(b, h) + aoff + m * 2048 + k * 1024); } while (0)
#define PG8_LDB(dst, b, h) do { _Pragma("unroll") for (int n = 0; n < 2; ++n) _Pragma("unroll") for (int k = 0; k < 2; ++k) dst[n][k] = *(const PG8_LAS bf16x8*)(lds + PG8_SB(b, h) + boff + n * 2048 + k * 1024); } while (0)
#define PG8_MMA(ai, bj, At, Bt) do { __builtin_amdgcn_s_setprio(1); _Pragma("unroll") for (int m = 0; m < 4; ++m) _Pragma("unroll") for (int n = 0; n < 2; ++n) _Pragma("unroll") for (int k = 0; k < 2; ++k) \
        acc[ai][bj][m][n] = __builtin_amdgcn_mfma_f32_16x16x32_bf16(Bt[n][k], At[m][k], acc[ai][bj][m][n], 0, 0, 0); __builtin_amdgcn_s_setprio(0); } while (0)
#define PG8_WAIT_V(n) asm volatile("s_waitcnt vmcnt(" #n ")" ::: "memory")
#define PG8_WAIT_L(n) asm volatile("s_waitcnt lgkmcnt(" #n ")" ::: "memory")
#define PG8_BAR __builtin_amdgcn_s_barrier()
#define PG8_SCHED __builtin_amdgcn_sched_barrier(0)
    Unit cur, nxt; int ui = 0;
    if (!S.next(0, cur)) return;
    f32x4 acc[2][2][4][2];
    float zf_ = 0.f; asm volatile("" : "+v"(zf_));
#pragma unroll
    for (int a = 0; a < 2; ++a)
#pragma unroll
        for (int b = 0; b < 2; ++b)
#pragma unroll
            for (int m = 0; m < 4; ++m)
#pragma unroll
                for (int n = 0; n < 2; ++n) acc[a][b][m][n] = (f32x4){zf_, zf_, zf_, zf_};
    bf16x8 At[4][2], B0[2][2], B1[2][2];
    unsigned ca0[2], ca1[2], na0[2], na1[2];
    PG8_AOFF(cur, ca0, ca1);
    const char* const cA = Abase; const char* cB = S.b_base(cur);
    if constexpr (SP2) {
        PG8_STAGE(PG8_SB(0, 0), cB, voffB); PG8_STAGE(PG8_SB(0, 1), cB + hstep, voffB); PG8_STAGE(PG8_SA(0, 0), cA, ca0); PG8_STAGE(PG8_SA(0, 1), cA, ca1);
        if (wr == 1) PG8_BAR;
        PG8_WAIT_V(2); PG8_BAR;
        PG8_STAGE(PG8_SB(1, 0), cB + kstep, voffB); PG8_STAGE(PG8_SA(1, 0), cA + akstep, ca0); PG8_STAGE(PG8_SB(1, 1), cB + hstep + kstep, voffB);
        PG8_WAIT_V(6); PG8_BAR;
    } else { static_assert(SP2, "only the SP2 loop is kept"); }
    for (;;) {
        const bool has_next = S.next(ui + 1, nxt);
        const char* nB = has_next ? S.b_base(nxt) : cB;
        if (has_next) { PG8_AOFF(nxt, na0, na1); } else { na0[0] = ca0[0]; na0[1] = ca0[1]; na1[0] = ca1[0]; na1[1] = ca1[1]; }
        for (int t = 0; t < nt - 2; t += 2) {
            const char* a1 = cA + (size_t)(t + 1) * akstep;
            const char* a2 = cA + (size_t)(t + 2) * akstep; const char* b2 = cB + (size_t)(t + 2) * kstep;
            const char* a3 = a2 + akstep; const char* b3 = b2 + kstep;
            PG8_LDB(B0, 0, 0); PG8_LDB(B1, 0, 1); PG8_SCHED; PG8_LDA(At, 0, 0); PG8_STAGE(PG8_SA(1, 1), a1, ca1);
            PG8_WAIT_V(8); PG8_WAIT_L(0); PG8_BAR; PG8_MMA(0, 0, At, B0); PG8_MMA(0, 1, At, B1); PG8_BAR; PG8_SCHED;
            PG8_LDA(At, 0, 1); PG8_STAGE(PG8_SB(0, 0), b2, voffB); PG8_STAGE(PG8_SB(0, 1), b2 + hstep, voffB); PG8_STAGE(PG8_SA(0, 0), a2, ca0);
            PG8_WAIT_V(8); PG8_WAIT_L(0); PG8_BAR; PG8_MMA(1, 0, At, B0); PG8_MMA(1, 1, At, B1); PG8_BAR; PG8_SCHED;
            PG8_LDB(B0, 1, 0); PG8_LDB(B1, 1, 1); PG8_SCHED; PG8_LDA(At, 1, 0); PG8_STAGE(PG8_SA(0, 1), a2, ca1);
            PG8_WAIT_V(8); PG8_WAIT_L(0); PG8_BAR; PG8_MMA(0, 0, At, B0); PG8_MMA(0, 1, At, B1); PG8_BAR; PG8_SCHED;
            PG8_LDA(At, 1, 1); PG8_STAGE(PG8_SB(1, 0), b3, voffB); PG8_STAGE(PG8_SB(1, 1), b3 + hstep, voffB); PG8_STAGE(PG8_SA(1, 0), a3, ca0);
            PG8_WAIT_V(8); PG8_WAIT_L(0); PG8_BAR; PG8_MMA(1, 0, At, B0); PG8_MMA(1, 1, At, B1); PG8_BAR; PG8_SCHED;
        }
        {
            const char* a1 = cA + (size_t)(nt - 1) * akstep;
            const char* a2 = cA; const char* b2 = nB; const char* a3 = a2 + akstep; const char* b3 = b2 + kstep;
            PG8_LDB(B0, 0, 0); PG8_LDB(B1, 0, 1); PG8_SCHED; PG8_LDA(At, 0, 0); PG8_STAGE(PG8_SA(1, 1), a1, ca1);
            PG8_WAIT_V(8); PG8_WAIT_L(0); PG8_BAR; PG8_MMA(0, 0, At, B0); PG8_MMA(0, 1, At, B1); PG8_BAR; PG8_SCHED;
            PG8_LDA(At, 0, 1); PG8_STAGE(PG8_SB(0, 0), b2, voffB); PG8_STAGE(PG8_SB(0, 1), b2 + hstep, voffB); PG8_STAGE(PG8_SA(0, 0), a2, na0);
            PG8_WAIT_V(8); PG8_WAIT_L(0); PG8_BAR; PG8_MMA(1, 0, At, B0); PG8_MMA(1, 1, At, B1); PG8_BAR; PG8_SCHED;
            PG8_LDB(B0, 1, 0); PG8_LDB(B1, 1, 1); PG8_SCHED; PG8_LDA(At, 1, 0); PG8_STAGE(PG8_SA(0, 1), a2, na1);
            PG8_WAIT_V(8); PG8_WAIT_L(0); PG8_BAR; PG8_MMA(0, 0, At, B0); PG8_MMA(0, 1, At, B1); PG8_BAR; PG8_SCHED;
            PG8_LDA(At, 1, 1); PG8_STAGE(PG8_SB(1, 0), b3, voffB); PG8_STAGE(PG8_SB(1, 1), b3 + hstep, voffB); PG8_STAGE(PG8_SA(1, 0), a3, na0);
            PG8_WAIT_V(8); PG8_WAIT_L(0); PG8_BAR; PG8_MMA(1, 0, At, B0); PG8_MMA(1, 1, At, B1); PG8_BAR; PG8_SCHED;
        }
        if constexpr (ALIGN_EPI) { if (wr == 0) PG8_BAR; }
        E(acc, cur, wr, wc, fr, fq);
        if (!has_next) break;
#pragma unroll
        for (int a = 0; a < 2; ++a)
#pragma unroll
            for (int b = 0; b < 2; ++b)
#pragma unroll
                for (int m = 0; m < 4; ++m)
#pragma unroll
                    for (int n = 0; n < 2; ++n) acc[a][b][m][n] = (f32x4){zf_, zf_, zf_, zf_};
        cur = nxt; cB = nB; ++ui; ca0[0] = na0[0]; ca0[1] = na0[1]; ca1[0] = na1[0]; ca1[1] = na1[1];
        if constexpr (ALIGN_EPI) { if (wr == 1) PG8_BAR; }
    }
    PG8_WAIT_V(0);
    if constexpr (!ALIGN_EPI) { if (wr == 0) PG8_BAR; }
    PG8_BAR;
#undef PG8_AOFF
#undef PG8_SA
#undef PG8_SB
#undef PG8_STAGE
#undef PG8_LDA
#undef PG8_LDB
#undef PG8_MMA
#undef PG8_WAIT_V
#undef PG8_WAIT_L
#undef PG8_BAR
#undef PG8_SCHED
}

}
namespace mk {
using namespace nv;
typedef unsigned short bf16_t;
typedef unsigned u32x4 __attribute__((ext_vector_type(4)));
typedef float f32x4 __attribute__((ext_vector_type(4)));
#define LAS __attribute__((address_space(3)))
constexpr int NT = 512;
constexpr int PB = 2816;
constexpr int NPAD = 3072;
constexpr int C_KV = 512, C_FOX = 1280, C_SB = 2048, C_GATE = 2816;
constexpr int MAXT = MROWS / 256 + NE;
constexpr int PROWS = MAXT * 256;
__device__ __forceinline__ int ftid() { int t = threadIdx.x; asm volatile("" : "+v"(t)); return t; }
__device__ __forceinline__ int fbid() { int b = blockIdx.x; asm volatile("" : "+s"(b)); return b; }
#define MK_LOOP(vb, n) for (int vb = fbid(); vb < (n); vb += gridDim.x)

constexpr size_t al_(size_t x) { return (x + 4095) & ~(size_t)4095; }
constexpr size_t O_WTIN = 0;
constexpr size_t O_WTOUT = O_WTIN + al_((size_t)L_ * NPAD * D_ * 2);
constexpr size_t O_WTGU = O_WTOUT + al_((size_t)L_ * D_ * D_ * 2);
constexpr size_t O_WTDN = O_WTGU + al_((size_t)L_ * NE * 2048 * D_ * 2);
constexpr size_t O_BIASP = O_WTDN + al_((size_t)L_ * NE * D_ * D_ * 2);
constexpr size_t O_XB = O_BIASP + al_((size_t)L_ * NPAD * 4);
constexpr size_t O_PROJB = O_XB + al_((size_t)T_ * D_ * 2);
constexpr size_t O_GF = O_PROJB + al_((size_t)T_ * PB * 2);
constexpr size_t O_CFOX = O_GF + al_((size_t)T_ * 32 * 4);
constexpr size_t O_KCMP = O_CFOX + al_((size_t)B_ * 4 * S_ * 4);
constexpr size_t O_VCMP = O_KCMP + al_((size_t)B_ * 2 * 512 * 64 * 4);
constexpr size_t O_O = O_VCMP + al_((size_t)B_ * 2 * 512 * 64 * 4);
constexpr size_t O_OB = O_O + al_((size_t)T_ * D_ * 4);
constexpr size_t O_PTOT = O_OB + al_((size_t)T_ * D_ * 2);
constexpr size_t O_SEL = O_PTOT + al_((size_t)B_ * 2 * S_ * 512 * 4);
constexpr size_t O_MIX = O_SEL + al_((size_t)B_ * 2 * S_ * NSEL * 4);
constexpr size_t O_X1 = O_MIX + al_((size_t)T_ * D_ * 4);
constexpr size_t O_X1B = O_X1 + al_((size_t)T_ * D_ * 4);
constexpr size_t O_XA = O_X1B + al_((size_t)T_ * D_ * 2);
constexpr size_t O_ACT = O_XA + al_((size_t)T_ * D_ * 4);
constexpr size_t O_Y = O_ACT + al_((size_t)PROWS * D_ * 2);
constexpr size_t O_TOPE = O_Y + al_((size_t)PROWS * D_ * 2);
constexpr size_t O_TOPW = O_TOPE + al_((size_t)MROWS * 4);
constexpr size_t O_POS = O_TOPW + al_((size_t)MROWS * 4);
constexpr size_t O_ROWTOK = O_POS + al_((size_t)MROWS * 4);
constexpr size_t O_ROWW = O_ROWTOK + al_((size_t)PROWS * 4);
constexpr size_t O_SLOT = O_ROWW + al_((size_t)PROWS * 4);
constexpr size_t O_COUNTS = O_SLOT + al_((size_t)MROWS * 4);
constexpr size_t O_META = O_COUNTS + 65536;
constexpr size_t O_OWIN = O_META + 4096;
constexpr size_t O_O2 = O_OWIN + al_((size_t)T_ * 512 * 4);
constexpr size_t O_OWIN2 = O_O2 + al_((size_t)T_ * D_ * 4);
constexpr size_t O_KCMPB = O_OWIN2 + al_((size_t)T_ * 512 * 4);
constexpr size_t O_VCMPB = O_KCMPB + al_((size_t)B_ * 2 * 512 * 64 * 2);
constexpr size_t O_OCMP = O_VCMPB + al_((size_t)B_ * 2 * 512 * 64 * 2);
constexpr size_t O_SELMASK = O_OCMP + al_((size_t)T_ * 512 * 4);
constexpr size_t O_WT1 = O_SELMASK + al_((size_t)B_ * 2 * S_ * 16);
constexpr size_t O_BIAS1 = O_WT1 + al_((size_t)L_ * 2 * 256 * 2048 * 2);
constexpr size_t O_HID = O_BIAS1 + al_((size_t)L_ * 2 * 128 * 4);
constexpr size_t O_END = O_HID + al_((size_t)8 * 512 * 128 * 2);

struct P {
    In in; unsigned char* ws; float* out;
};
typedef const __attribute__((address_space(4))) P* KP;
__device__ __forceinline__ KP fresh_kp() { KP k = (KP)__builtin_amdgcn_kernarg_segment_ptr(); asm volatile("" : "+s"(k)); return k; }
#define WSP(T, off) ((T*)(p->ws + (off)))

__device__ __forceinline__ float bf2f(unsigned short b) { return __uint_as_float((unsigned)b << 16); }
__device__ __forceinline__ unsigned f2bf(float f) { unsigned u = __float_as_uint(f); return (u + 0x7fffu + ((u >> 16) & 1u)) >> 16; }
__device__ __forceinline__ unsigned pk2(float lo, float hi) { return f2bf(lo) | (f2bf(hi) << 16); }
__device__ __forceinline__ void ld8(const bf16_t* __restrict__ src, float* dst) {
    const u32x4 v = *(const u32x4*)src;
    dst[0] = __uint_as_float(v.x << 16); dst[1] = __uint_as_float(v.x & 0xffff0000u); dst[2] = __uint_as_float(v.y << 16); dst[3] = __uint_as_float(v.y & 0xffff0000u);
    dst[4] = __uint_as_float(v.z << 16); dst[5] = __uint_as_float(v.z & 0xffff0000u); dst[6] = __uint_as_float(v.w << 16); dst[7] = __uint_as_float(v.w & 0xffff0000u);
}


__device__ __forceinline__ int perm_in(int n) {
    if (n < 1280) return n;
    if (n < 1304) return C_GATE + (n - 1280);
    if (n < 2072) return C_FOX + (n - 1304);
    if (n < 2076) return C_GATE + 24 + (n - 2072);
    return C_SB + (n - 2076);
}
__device__ __forceinline__ int perm_gu(int n) { const int up = n >> 10, c = n & 1023; return 256 * (c >> 7) + 128 * up + (c & 127); }
template <int MAP>
__device__ __forceinline__ void transpose_item(const float* __restrict__ W, int K, int N, bf16_t* __restrict__ WT, LAS float* scr, int item, int lane) {
    const int nblk = (N + 31) / 32, kb = item / nblk, nb = item % nblk, k0 = 64 * kb, n0 = 32 * nb;
    const int nl = lane & 31; const bool okn = (n0 + nl) < N;
#pragma unroll 8
    for (int i = 0; i < 32; ++i) { const int kk = 2 * i + (lane >> 5); scr[kk * 33 + nl] = okn ? W[(size_t)(k0 + kk) * N + n0 + nl] : 0.f; }
    asm volatile("s_waitcnt lgkmcnt(0)" ::: "memory");
    const int c = lane & 7;
#pragma unroll
    for (int j = 0; j < 4; ++j) { const int n = (lane >> 3) + 8 * j; const LAS float* sp = scr + (8 * c) * 33 + n;
        u32x4 o; o.x = pk2(sp[0 * 33], sp[1 * 33]); o.y = pk2(sp[2 * 33], sp[3 * 33]); o.z = pk2(sp[4 * 33], sp[5 * 33]); o.w = pk2(sp[6 * 33], sp[7 * 33]);
        const int ng = n0 + n;
        if (ng < N) { const int ro = (MAP == 1) ? perm_in(ng) : (MAP == 2) ? perm_gu(ng) : ng; *(u32x4*)(WT + (size_t)ro * K + k0 + 8 * c) = o; } }
    asm volatile("s_waitcnt lgkmcnt(0)" ::: "memory");
}
__device__ __forceinline__ void ph_convert(LAS unsigned char* lds, KP p) {
    const int tid = ftid(), lane = tid & 63, wv = tid >> 6;
    LAS float* scr = (LAS float*)(lds + wv * 8448);
    const int gw = fbid() * 8 + wv, NGW = gridDim.x * 8;
    constexpr int I_IN = 16 * 89, I_OUT = 16 * 32, I_GU = 16 * 64, I_DN = 16 * 32, I_W1 = 32 * 4;
    constexpr int N_IN = L_ * I_IN, N_OUT = L_ * I_OUT, N_GU = L_ * NE * I_GU, N_DN = L_ * NE * I_DN, N_W1 = L_ * 2 * I_W1;
    for (int it = gw; it < N_IN + N_OUT + N_GU + N_DN + N_W1; it += NGW) {
        int r = it;
        if (r < N_W1) { const int mtx = r / I_W1, ll = mtx >> 1, kv = mtx & 1; transpose_item<0>((kv ? p->in.w1v : p->in.w1k) + (size_t)ll * 2048 * 128, 2048, 128, WSP(bf16_t, O_WT1) + (size_t)mtx * 256 * 2048, scr, r % I_W1, lane); continue; } r -= N_W1;
        if (r < N_GU) { const int mtx = r / I_GU; transpose_item<2>(p->in.wgu + (size_t)mtx * D_ * 2048, D_, 2048, WSP(bf16_t, O_WTGU) + (size_t)mtx * 2048 * D_, scr, r % I_GU, lane); continue; } r -= N_GU;
        if (r < N_DN) { const int mtx = r / I_DN; transpose_item<0>(p->in.wdn + (size_t)mtx * D_ * D_, D_, D_, WSP(bf16_t, O_WTDN) + (size_t)mtx * D_ * D_, scr, r % I_DN, lane); continue; } r -= N_DN;
        if (r < N_IN) { const int mtx = r / I_IN; transpose_item<1>(p->in.w_in + (size_t)mtx * D_ * DIN, D_, DIN, WSP(bf16_t, O_WTIN) + (size_t)mtx * NPAD * D_, scr, r % I_IN, lane); continue; } r -= N_IN;
        { const int mtx = r / I_OUT; transpose_item<0>(p->in.w_out + (size_t)mtx * D_ * D_, D_, D_, WSP(bf16_t, O_WTOUT) + (size_t)mtx * D_ * D_, scr, r % I_OUT, lane); }
    }
    const int gt = fbid() * NT + tid, NG = gridDim.x * NT;
    for (int i = gt; i < L_ * (NPAD - DIN) * (D_ / 8); i += NG) { const int l = i / ((NPAD - DIN) * (D_ / 8)), r = i % ((NPAD - DIN) * (D_ / 8));
        unsigned z_ = 0u; asm volatile("" : "+v"(z_));
        *(u32x4*)(WSP(bf16_t, O_WTIN) + ((size_t)l * NPAD + DIN) * D_ + (size_t)r * 8) = (u32x4){z_, z_, z_, z_}; }
    for (int i = gt; i < L_ * 2 * 128 * (2048 / 8); i += NG) { const int mtx = i / (128 * 256), r = i % (128 * 256); unsigned z_ = 0u; asm volatile("" : "+v"(z_));
        *(u32x4*)(WSP(bf16_t, O_WT1) + ((size_t)mtx * 256 + 128) * 2048 + (size_t)r * 8) = (u32x4){z_, z_, z_, z_}; }
    for (int i = gt; i < L_ * 2 * 128; i += NG) { const int mtx = i >> 7, j = i & 127, ll = mtx >> 1, kv = mtx & 1;
        const float* pos = (kv ? p->in.pos_v : p->in.pos_k) + (size_t)ll * 2048; const float* w1 = (kv ? p->in.w1v : p->in.w1k) + (size_t)ll * 2048 * 128; float a = 0.f;
        for (int k = 0; k < 2048; ++k) a += pos[k] * w1[(size_t)k * 128 + j];
        WSP(float, O_BIAS1)[i] = a; }
    for (int i = gt; i < L_ * NPAD; i += NG) { const int l = i / NPAD, c = i % NPAD; if (c >= DIN) WSP(float, O_BIASP)[i] = 0.f; }
    for (int i = gt; i < L_ * DIN; i += NG) { const int l = i / DIN, n = i % DIN; WSP(float, O_BIASP)[l * NPAD + perm_in(n)] = p->in.b_in[i]; }
    for (int i = gt; i < T_ * D_ / 8; i += NG) { const f32x4 a = *(const f32x4*)(p->in.x + (size_t)i * 8), b = *(const f32x4*)(p->in.x + (size_t)i * 8 + 4);
        *(u32x4*)(WSP(bf16_t, O_XB) + (size_t)i * 8) = (u32x4){pk2(a.x, a.y), pk2(a.z, a.w), pk2(b.x, b.y), pk2(b.z, b.w)}; }
}

struct EpiProj {
    static constexpr bool PERM = true;
    bf16_t* projb; float* gf; const float* bias;
    __device__ __forceinline__ void operator()(const pg8::f32x4 (&acc)[2][2][4][2], const pg8::Unit& u, int wr, int wc, int fr, int fq) const {
        const int row0 = u.pm * 256 + wr * 64 + fr, col0 = u.pn * 256 + wc * 32 + 8 * fq;
        if (u.pn < 11) {
#pragma unroll
            for (int ai = 0; ai < 2; ++ai)
#pragma unroll
                for (int m = 0; m < 4; ++m) { bf16_t* rowp = projb + (size_t)(row0 + ai * 128 + m * 16) * PB + col0;
#pragma unroll
                    for (int bj = 0; bj < 2; ++bj) { const f32x4 v0 = acc[ai][bj][m][0] + *(const f32x4*)(bias + col0 + bj * 128), v1 = acc[ai][bj][m][1] + *(const f32x4*)(bias + col0 + bj * 128 + 4);
                        u32x4 w; w.x = pg8::cvt_pk_bf16(v0[0], v0[1]); w.y = pg8::cvt_pk_bf16(v0[2], v0[3]); w.z = pg8::cvt_pk_bf16(v1[0], v1[1]); w.w = pg8::cvt_pk_bf16(v1[2], v1[3]);
                        *(u32x4*)(rowp + bj * 128) = w; }
                    asm volatile("" ::: "memory"); }
        } else if (wc == 0) {
            const f32x4 b0 = *(const f32x4*)(bias + col0), b1 = *(const f32x4*)(bias + col0 + 4);
#pragma unroll
            for (int ai = 0; ai < 2; ++ai)
#pragma unroll
                for (int m = 0; m < 4; ++m) { float* rowp = gf + (size_t)(row0 + ai * 128 + m * 16) * 32 + 8 * fq;
                    const f32x4 v0 = acc[ai][0][m][0] + b0, v1 = acc[ai][0][m][1] + b1; f32x4 o0, o1;
#pragma unroll
                    for (int i = 0; i < 4; ++i) { const int j0 = 8 * fq + i, j1 = j0 + 4;
                        o0[i] = (j0 < 24) ? sigmoidf_(v0[i]) : (j0 < 28 ? logsig(v0[i]) : 0.f); o1[i] = (j1 < 24) ? sigmoidf_(v1[i]) : (j1 < 28 ? logsig(v1[i]) : 0.f); }
                    *(f32x4*)rowp = o0; *(f32x4*)(rowp + 4) = o1; }
        }
    }
};
struct EpiOut {
    static constexpr bool PERM = true;
    const float* x; float* y1;
    __device__ __forceinline__ void operator()(const pg8::f32x4 (&acc)[2][2][4][2], const pg8::Unit& u, int wr, int wc, int fr, int fq) const {
        const int row0 = u.pm * 256 + wr * 64 + fr, col0 = u.pn * 256 + wc * 32 + 8 * fq;
#pragma unroll
        for (int ai = 0; ai < 2; ++ai)
#pragma unroll
            for (int m = 0; m < 4; ++m) { const size_t off = (size_t)(row0 + ai * 128 + m * 16) * D_ + col0;
#pragma unroll
                for (int bj = 0; bj < 2; ++bj) { const f32x4 x0 = *(const f32x4*)(x + off + bj * 128), x1 = *(const f32x4*)(x + off + bj * 128 + 4);
                    *(f32x4*)(y1 + off + bj * 128) = x0 * ALPHA + acc[ai][bj][m][0]; *(f32x4*)(y1 + off + bj * 128 + 4) = x1 * ALPHA + acc[ai][bj][m][1]; }
                asm volatile("" ::: "memory"); }
    }
};
struct EpiGU {
    static constexpr bool PERM = true;
    bf16_t* act; const float* bgu;
    __device__ __forceinline__ void operator()(const pg8::f32x4 (&acc)[2][2][4][2], const pg8::Unit& u, int wr, int wc, int fr, int fq) const {
        const int row0 = u.pm * 256 + wr * 64 + fr, col0 = u.pn * 128 + wc * 32 + 8 * fq;
        const float* bb = bgu + (size_t)u.e * 2048 + col0;
        const f32x4 bg0 = *(const f32x4*)bb, bg1 = *(const f32x4*)(bb + 4), bu0 = *(const f32x4*)(bb + 1024), bu1 = *(const f32x4*)(bb + 1028);
#pragma unroll
        for (int ai = 0; ai < 2; ++ai)
#pragma unroll
            for (int m = 0; m < 4; ++m) { f32x4 a0, a1;
                const f32x4 g0 = acc[ai][0][m][0] + bg0, g1 = acc[ai][0][m][1] + bg1, u0 = acc[ai][1][m][0] + bu0, u1 = acc[ai][1][m][1] + bu1;
#pragma unroll
                for (int i = 0; i < 4; ++i) { const float gt0 = fminf(g0[i], 7.0f), up0 = fminf(fmaxf(u0[i], -7.0f), 7.0f), gt1 = fminf(g1[i], 7.0f), up1 = fminf(fmaxf(u1[i], -7.0f), 7.0f);
                    a0[i] = gt0 * sigmoidf_(1.702f * gt0) * (up0 + 1.0f); a1[i] = gt1 * sigmoidf_(1.702f * gt1) * (up1 + 1.0f); }
                u32x4 w; w.x = pg8::cvt_pk_bf16(a0[0], a0[1]); w.y = pg8::cvt_pk_bf16(a0[2], a0[3]); w.z = pg8::cvt_pk_bf16(a1[0], a1[1]); w.w = pg8::cvt_pk_bf16(a1[2], a1[3]);
                *(u32x4*)(act + (size_t)(row0 + ai * 128 + m * 16) * D_ + col0) = w; asm volatile("" ::: "memory"); }
    }
};
struct EpiDN {
    static constexpr bool PERM = true;
    bf16_t* y; const float* bdn; const float* roww;
    __device__ __forceinline__ void operator()(const pg8::f32x4 (&acc)[2][2][4][2], const pg8::Unit& u, int wr, int wc, int fr, int fq) const {
        const int row0 = u.pm * 256 + wr * 64 + fr, col0 = u.pn * 256 + wc * 32 + 8 * fq;
        const float* bb = bdn + (size_t)u.e * D_ + col0;
#pragma unroll
        for (int ai = 0; ai < 2; ++ai)
#pragma unroll
            for (int m = 0; m < 4; ++m) { const int row = row0 + ai * 128 + m * 16; const float w = roww[row];
#pragma unroll
                for (int bj = 0; bj < 2; ++bj) { const f32x4 v0 = (acc[ai][bj][m][0] + *(const f32x4*)(bb + bj * 128)) * w, v1 = (acc[ai][bj][m][1] + *(const f32x4*)(bb + bj * 128 + 4)) * w;
                    u32x4 o; o.x = pg8::cvt_pk_bf16(v0[0], v0[1]); o.y = pg8::cvt_pk_bf16(v0[2], v0[3]); o.z = pg8::cvt_pk_bf16(v1[0], v1[1]); o.w = pg8::cvt_pk_bf16(v1[2], v1[3]);
                    *(u32x4*)(y + (size_t)row * D_ + col0 + bj * 128) = o; }
                asm volatile("" ::: "memory"); }
    }
};
struct MoeOrder {
    const int* meta; const int* rowtok; const char* Wt; size_t estep, tstep; int nN, G, c, nunits;
    __device__ __forceinline__ bool next(int i, pg8::Unit& u) const {
        const int L = i * G + c; if (L >= nunits) return false;
        const int gt = L / nN; u.pm = gt; u.pn = L - gt * nN; u.e = meta[64 + 2 * gt]; u.nr = meta[65 + 2 * gt]; return true; }
    __device__ __forceinline__ unsigned a_row(const pg8::Unit& u, int r) const { const int rr = r < u.nr ? r : u.nr - 1; const int row = u.pm * 256 + rr; return rowtok ? (unsigned)rowtok[row] : (unsigned)row; }
    __device__ __forceinline__ const char* b_base(const pg8::Unit& u) const { return Wt + (size_t)u.e * estep + (size_t)u.pn * tstep; }
};

struct EpiCmp {
    static constexpr bool PERM = true;
    bf16_t* hid; const float* bias1;
    __device__ __forceinline__ void operator()(const pg8::f32x4 (&acc)[2][2][4][2], const pg8::Unit& u, int wr, int wc, int fr, int fq) const {
        const int row0 = u.pm * 256 + wr * 64 + fr, col0 = wc * 32 + 8 * fq;
        const float* bb = bias1 + (u.e & 1) * 128 + col0; const f32x4 b0 = *(const f32x4*)bb, b1 = *(const f32x4*)(bb + 4);
#pragma unroll
        for (int ai = 0; ai < 2; ++ai)
#pragma unroll
            for (int m = 0; m < 4; ++m) { const f32x4 v0 = acc[ai][0][m][0] + b0, v1 = acc[ai][0][m][1] + b1;
                u32x4 w; w.x = pg8::cvt_pk_bf16(gelu_tanh(v0[0]), gelu_tanh(v0[1])); w.y = pg8::cvt_pk_bf16(gelu_tanh(v0[2]), gelu_tanh(v0[3])); w.z = pg8::cvt_pk_bf16(gelu_tanh(v1[0]), gelu_tanh(v1[1])); w.w = pg8::cvt_pk_bf16(gelu_tanh(v1[2]), gelu_tanh(v1[3]));
                *(u32x4*)(hid + ((size_t)u.e * 512 + row0 + ai * 128 + m * 16) * 128 + col0) = w; asm volatile("" ::: "memory"); }
    }
};
struct GEpi {
    static constexpr bool PERM = true;
    int kind, l;
    __device__ __forceinline__ void operator()(const pg8::f32x4 (&acc)[2][2][4][2], const pg8::Unit& u, int wr, int wc, int fr, int fq) const {
        const KP p = fresh_kp();
        if (kind == 0) { const EpiProj e{WSP(bf16_t, O_PROJB), WSP(float, O_GF), WSP(float, O_BIASP) + l * NPAD}; e(acc, u, wr, wc, fr, fq); }
        else if (kind == 1) { const EpiOut e{(l == 0) ? p->in.x : WSP(float, O_XA), WSP(float, O_MIX)}; e(acc, u, wr, wc, fr, fq); }
        else if (kind == 2) { const EpiGU e{WSP(bf16_t, O_ACT), p->in.bgu + (size_t)l * NE * 2048}; e(acc, u, wr, wc, fr, fq); }
        else if (kind == 3) { const EpiDN e{WSP(bf16_t, O_Y), p->in.bdn + (size_t)l * NE * D_, WSP(float, O_ROWW)}; e(acc, u, wr, wc, fr, fq); }
        else { const EpiCmp e{WSP(bf16_t, O_HID), WSP(float, O_BIAS1) + l * 256}; e(acc, u, wr, wc, fr, fq); }
    }
};
struct GSched {
    int kind, nM, nN, nunits, G, c; const int* meta; const int* rowtok; const char* Bt; size_t estep;
    __device__ __forceinline__ bool next(int i, pg8::Unit& u) const {
        const int L = i * G + c; if (L >= nunits) return false;
        if (kind < 2) {
            int wgid = L; { const int q = nunits / pg8::NXCD, r = nunits % pg8::NXCD, xcd = wgid % pg8::NXCD, off = wgid / pg8::NXCD; wgid = (xcd < r ? xcd * (q + 1) : r * (q + 1) + (xcd - r) * q) + off; }
            const int nig = pg8::WGM * nN, gid = wgid / nig, fm = gid * pg8::WGM, gsz = (nM - fm) < pg8::WGM ? (nM - fm) : pg8::WGM;
            u.pm = fm + ((wgid % nig) % gsz); u.pn = (wgid % nig) / gsz; u.e = 0; u.nr = 256;
        } else if (kind == 4) { u.e = L >> 1; u.pm = L & 1; u.pn = 0; u.nr = (L & 1) ? 255 : 256; }
        else { const int gt = L / nN; u.pm = gt; u.pn = L - gt * nN; u.e = meta[64 + 2 * gt]; u.nr = meta[65 + 2 * gt]; }
        return true; }
    __device__ __forceinline__ unsigned a_off(const pg8::Unit& u, int r) const { const int rr = r < u.nr ? r : u.nr - 1; const int row = u.pm * 256 + rr;
        if (kind == 4) { const int kv = u.e & 1, bg = u.e >> 1; return (unsigned)(((bg >> 1) * S_ + 16 * row) * PB + C_KV + ((0 * 2 + kv) * 2 + (bg & 1)) * 64) * 2u; }
        return (unsigned)((kind == 2) ? rowtok[row] : row) * (unsigned)(D_ * 2); }
    __device__ __forceinline__ size_t a_kstep() const { return kind == 4 ? (size_t)PB * 2 : (size_t)128; }
    __device__ __forceinline__ const char* b_base(const pg8::Unit& u) const { return Bt + (size_t)(kind == 4 ? (u.e & 1) : u.e) * estep + (size_t)u.pn * ((size_t)256 * D_ * 2); }
};

__device__ __forceinline__ void ph_prep(float* lds, KP p, int l) {
    const int tid = ftid();
    const bf16_t* projb = WSP(bf16_t, O_PROJB);
    constexpr int NCB = (NCMP + 3) / 4;
    constexpr int NV_CMP = NCB * B_ * 2 * 2;
    MK_LOOP(vb, NV_CMP + B_ * 4) {
        if (vb < NV_CMP) {
            float* blk = lds; float* hid = lds + 4 * 2048;
            const int kv = vb & 1, bg = (vb >> 1) & 3, nb = vb >> 3, b = bg >> 1, g = bg & 1;
            const float* pos = (kv ? p->in.pos_v : p->in.pos_k) + (size_t)l * 2048; const float* w1 = (kv ? p->in.w1v : p->in.w1k) + (size_t)l * 2048 * 128;
            const float* w2 = (kv ? p->in.w2v : p->in.w2k) + (size_t)l * 128 * 64; float* outp = kv ? WSP(float, O_VCMP) : WSP(float, O_KCMP);
            __syncthreads();
            for (int i = tid; i < 4 * 2048; i += NT) { const int sub = i >> 11, e = i & 2047, ll = e >> 6, d = e & 63; int n = nb * 4 + sub; if (n >= NCMP) n = NCMP - 1;
                blk[i] = bf2f(projb[(size_t)(b * S_ + 16 * n + ll) * PB + C_KV + ((0 * 2 + kv) * 2 + g) * 64 + d]) + pos[e]; }
            __syncthreads();
            const int sub = tid >> 7, j = tid & 127; const float* bl = blk + sub * 2048;
            float a = 0.f;
            for (int i = 0; i < 2048; ++i) a += bl[i] * w1[(size_t)i * 128 + j];
            hid[tid] = gelu_tanh(a);
            __syncthreads();
            const int n = nb * 4 + sub;
            if (j < 64 && n < NCMP) { float o = 0.f; for (int jj = 0; jj < 128; ++jj) o += hid[sub * 128 + jj] * w2[jj * 64 + j]; outp[((size_t)bg * NCMP + n) * 64 + j] = o;
                (kv ? WSP(bf16_t, O_VCMPB) : WSP(bf16_t, O_KCMPB))[((size_t)bg * 512 + n) * 64 + j] = (bf16_t)f2bf(o); }
            if (j < 64 && n == NCMP) (kv ? WSP(bf16_t, O_VCMPB) : WSP(bf16_t, O_KCMPB))[((size_t)bg * 512 + 511) * 64 + j] = 0;
        } else {
            float* sh = lds; const int bh = vb - NV_CMP, b = bh >> 2, h = bh & 3; float carry = 0.f;
            for (int t0 = 0; t0 < S_; t0 += NT) {
                __syncthreads();
                sh[tid] = WSP(float, O_GF)[(size_t)(b * S_ + t0 + tid) * 32 + 24 + h]; __syncthreads();
                for (int o = 1; o < NT; o <<= 1) { const float add = (tid >= o) ? sh[tid - o] : 0.f; __syncthreads(); sh[tid] += add; __syncthreads(); }
                WSP(float, O_CFOX)[(size_t)bh * S_ + t0 + tid] = carry + sh[tid];
                carry += sh[NT - 1];
            }
        }
    }
}

__device__ __forceinline__ void load_tile_bf(float (*dst)[64], const bf16_t* __restrict__ src, size_t pitch) {
    const int tid = ftid(), r = tid >> 3, c0 = (tid & 7) * 8; float v[8]; ld8(src + (size_t)r * pitch + c0, v);
    *(float4*)&dst[r][c0] = make_float4(v[0], v[1], v[2], v[3]); *(float4*)&dst[r][c0 + 4] = make_float4(v[4], v[5], v[6], v[7]);
}
__device__ __forceinline__ void load_tile512(float (*dst)[64], const float* __restrict__ src, size_t stride, int nrows_valid) {
    const int tid = ftid(), r = tid >> 3, c0 = (tid & 7) * 8;
#pragma unroll
    for (int j = 0; j < 2; ++j) { float4 v = make_float4(0.f, 0.f, 0.f, 0.f); if (r < nrows_valid) v = *(const float4*)(src + (size_t)r * stride + c0 + 4 * j); *(float4*)&dst[r][c0 + 4 * j] = v; }
}
#define MK_LOADQ(q, src) do { _Pragma("unroll") for (int c_ = 0; c_ < 8; ++c_) { float t8_[8]; ld8((src) + 8 * c_, t8_); _Pragma("unroll") for (int e_ = 0; e_ < 8; ++e_) q[8 * c_ + e_] = t8_[e_] * SCALE; } } while (0)

template <int KIND>
__device__ __forceinline__ void attn_vblock(float* lds, KP p, int qb, int bh) {
    float (*Ks)[64] = (float (*)[64])lds; float (*Vs)[64] = (float (*)[64])(lds + 4096); float* Cs = lds + 8192;
    const bf16_t* projb = WSP(bf16_t, O_PROJB); const float* gf = WSP(float, O_GF); float* ob = WSP(float, O_O);
    const int tid = ftid(), q0 = qb * NT, t = q0 + tid;
    if (KIND == 0 || KIND == 1) {
        int b, h, qcol, kcol, vcol, ocol; float slope = 0.f;
        if (KIND == 0) { b = bh >> 2; h = bh & 3; qcol = C_FOX + h * 64; kcol = C_FOX + (4 + h) * 64; vcol = C_FOX + (8 + h) * 64; ocol = 512 + h * 64; }
        else { b = bh >> 3; h = bh & 7; const int g = h >> 2; qcol = h * 64; kcol = C_KV + ((2 * 2 + 0) * 2 + g) * 64; vcol = C_KV + ((2 * 2 + 1) * 2 + g) * 64; ocol = h * 64; slope = exp2f(-(float)(h + 1)); }
        const bf16_t* prow = projb + (size_t)(b * S_ + t) * PB;
        float q[64], o[64];
        MK_LOADQ(q, prow + qcol);
#pragma unroll
        for (int d = 0; d < 64; ++d) o[d] = 0.f;
        float m = -1e30f, l = 0.f, ct = 0.f; const float* cb = WSP(float, O_CFOX) + (size_t)(b * 4 + (h & 3)) * S_;
        if (KIND == 0) ct = cb[t];
        int kt0 = 0; const int kt1 = (q0 + NT - 1) >> 6;
        if (KIND == 1) { kt0 = (q0 - 511) >> 6; if (kt0 < 0) kt0 = 0; }
        for (int kt = kt0; kt <= kt1; ++kt) {
            __syncthreads();
            load_tile_bf(Ks, projb + (size_t)(b * S_ + kt * 64) * PB + kcol, PB);
            load_tile_bf(Vs, projb + (size_t)(b * S_ + kt * 64) * PB + vcol, PB);
            if (KIND == 0 && tid < 64) Cs[tid] = cb[kt * 64 + tid];
            __syncthreads();
            for (int r = 0; r < 64; ++r) {
                const int s = kt * 64 + r; bool ok = (s <= t); if (KIND == 1) ok = ok && (t - s < 512);
                if (ok) { float sc; NV_DOT(q, Ks[r], sc); if (KIND == 0) sc += ct - Cs[r]; else sc -= slope * (float)(t - s); NV_ONLINE(sc, Vs[r]); }
            }
        }
        const float inv = (l > 0.f) ? 1.f / l : 0.f;
        float* orow = ob + (size_t)(b * S_ + t) * D_ + ocol;
        if (KIND == 0) {
#pragma unroll
            for (int d = 0; d < 64; ++d) orow[d] = o[d] * inv;
        } else { const float gate = gf[(size_t)(b * S_ + t) * 32 + 2 * 8 + h]; float* wrow = WSP(float, O_OWIN) + (size_t)(b * S_ + t) * 512 + h * 64;
#pragma unroll
            for (int d = 0; d < 64; ++d) wrow[d] = gate * o[d] * inv; }
    } else if (KIND == 2) {
        const int b = bh >> 2, h = bh & 3;
        const int qcol = C_SB + h * 64, kcol = C_SB + (4 + h) * 64, vcol = C_SB + (8 + h) * 64, ocol = 768 + h * 64;
        const bf16_t* prow = projb + (size_t)(b * S_ + t) * PB;
        float q[64], o[64];
        MK_LOADQ(q, prow + qcol);
#pragma unroll
        for (int d = 0; d < 64; ++d) o[d] = 0.f;
        float later = 0.f;
        for (int kt = (q0 + NT - 1) >> 6; kt >= 0; --kt) {
            __syncthreads();
            load_tile_bf(Ks, projb + (size_t)(b * S_ + kt * 64) * PB + kcol, PB);
            load_tile_bf(Vs, projb + (size_t)(b * S_ + kt * 64) * PB + vcol, PB);
            __syncthreads();
            for (int r = 63; r >= 0; --r) { const int s = kt * 64 + r;
                if (s < t) { float z; NV_DOT(q, Ks[r], z); const float a = expf(logsig(z) + later); NV_AXPY(o, a, Vs[r]); later += logsig(-z); } }
        }
        float* orow = ob + (size_t)(b * S_ + t) * D_ + ocol;
#pragma unroll
        for (int d = 0; d < 64; ++d) orow[d] = o[d];
    } else {
        const int bg = bh, b = bg >> 1, g = bg & 1;
        const bf16_t* prow = projb + (size_t)(b * S_ + t) * PB;
        float* prow_t = WSP(float, O_PTOT) + (size_t)(bg * S_ + t) * 512;
        const float* kcmp = WSP(float, O_KCMP); const float* vcmp = WSP(float, O_VCMP);
        int nmax = (q0 + NT - 1 - 31) / 16 + 1; if (nmax > NCMP) nmax = NCMP;
        const int ntile = (nmax + 63) / 64;
        for (int r4 = 0; r4 < 4; ++r4) {
            const int h = g * 4 + r4; const float slope = exp2f(-(float)(h + 1));
            float q[64], o[64];
            MK_LOADQ(q, prow + h * 64);
#pragma unroll
            for (int d = 0; d < 64; ++d) o[d] = 0.f;
            float m = -1e30f, l = 0.f;
            for (int kt = 0; kt < ntile; ++kt) {
                __syncthreads();
                const int nvr = (NCMP - kt * 64) < 64 ? (NCMP - kt * 64) : 64;
                load_tile512(Ks, kcmp + ((size_t)bg * NCMP + kt * 64) * 64, 64, nvr);
                load_tile512(Vs, vcmp + ((size_t)bg * NCMP + kt * 64) * 64, 64, nvr);
                __syncthreads();
                for (int r = 0; r < nvr; ++r) { const int ce = 16 * (kt * 64 + r) + 31;
                    if (ce <= t) { float sc; NV_DOT(q, Ks[r], sc); sc -= slope * (float)(t - ce); NV_ONLINE(sc, Vs[r]); } }
            }
            const float inv = (l > 0.f) ? 1.f / l : 0.f;
            const float gate = gf[(size_t)(b * S_ + t) * 32 + 0 * 8 + h];
            float* orow = ob + (size_t)(b * S_ + t) * D_ + h * 64;
#pragma unroll
            for (int d = 0; d < 64; ++d) orow[d] = gate * o[d] * inv;
            for (int kt = 0; kt < 8; ++kt) {
                __syncthreads();
                const int nvr = (NCMP - kt * 64) < 64 ? (NCMP - kt * 64) : 64;
                if (kt < ntile) load_tile512(Ks, kcmp + ((size_t)bg * NCMP + kt * 64) * 64, 64, nvr);
                __syncthreads();
                for (int r = 0; r < 64; ++r) { const int n = kt * 64 + r, ce = 16 * n + 31; float pp = 0.f;
                    if (kt < ntile && r < nvr && ce <= t) { float sc; NV_DOT(q, Ks[r], sc); sc -= slope * (float)(t - ce); pp = __expf(sc - m) * inv; }
                    if (r4 == 0) prow_t[n] = pp; else prow_t[n] += pp; }
            }
        }
    }
}
__device__ __forceinline__ void ph_attn_a(float* lds, KP p) {
    constexpr int NQB = S_ / NT;
    constexpr int N_CMP = NQB * B_ * 2, N_FOX = NQB * B_ * 4, N_SB = NQB * B_ * 4;
    MK_LOOP(vb, N_CMP + N_FOX + N_SB) {
        if (vb < N_FOX) { const int qb = NQB - 1 - vb / (B_ * 4); attn_vblock<0>(lds, p, qb, vb % (B_ * 4)); }
        else if (vb < N_FOX + N_SB) { const int v = vb - N_FOX; const int qb = NQB - 1 - v / (B_ * 4); attn_vblock<2>(lds, p, qb, v % (B_ * 4)); }
        else { const int v = vb - N_FOX - N_SB; attn_vblock<3>(lds, p, v / (B_ * 2), v % (B_ * 2)); }
    }
}
__device__ __forceinline__ void ph_select(KP p) {
    const int lane = ftid() & 63, wv = ftid() >> 6; int* sel = WSP(int, O_SEL);
    for (int wave = fbid() * 8 + wv; wave < B_ * 2 * S_; wave += gridDim.x * 8) {
        const int t = wave % S_; const float* pt = WSP(float, O_PTOT) + (size_t)wave * 512; const int cur = t >> 6;
        float v[2];
#pragma unroll
        for (int k = 0; k < 2; ++k) { const int j = lane + 64 * k;
            float imp = pt[4 * j] + pt[4 * j + 1] + pt[4 * j + 2];
            if (4 * j + 3 < NCMP) imp += 0.5f * pt[4 * j + 3];
            if (j >= 1) imp += 0.5f * pt[4 * j - 1];
            const bool valid = j <= cur, forced = valid && (j == 0 || j >= cur - 1);
            v[k] = forced ? 3.0e38f : (valid ? imp : -3.0e38f); }
        for (int it = 0; it < NSEL; ++it) {
            float bv = v[0]; int bi = lane; if (v[1] > bv) { bv = v[1]; bi = lane + 64; }
#pragma unroll
            for (int o = 32; o >= 1; o >>= 1) { const float ov = __shfl_xor(bv, o); const int oi = __shfl_xor(bi, o); if (ov > bv || (ov == bv && oi < bi)) { bv = ov; bi = oi; } }
            if (lane == 0) sel[(size_t)wave * NSEL + it] = bi;
            if (bi == lane) v[0] = -3.4e38f;
            if (bi == lane + 64) v[1] = -3.4e38f;
        }
    }
}
__device__ __forceinline__ void ph_attn_sel(KP p) {
    const bf16_t* projb = WSP(bf16_t, O_PROJB); const int tid = ftid();
    MK_LOOP(vb, (S_ / NT) * B_ * 8) {
        const int qb = vb / (B_ * 8), bh = vb % (B_ * 8), b = bh >> 3, h = bh & 7, g = h >> 2, t = qb * NT + tid;
        const float slope = exp2f(-(float)(h + 1));
        const bf16_t* prow = projb + (size_t)(b * S_ + t) * PB;
        const int kcol = C_KV + ((1 * 2 + 0) * 2 + g) * 64, vcol = C_KV + ((1 * 2 + 1) * 2 + g) * 64;
        const int* sl = WSP(int, O_SEL) + ((size_t)(b * 2 + g) * S_ + t) * NSEL;
        float q[64], o[64];
        MK_LOADQ(q, prow + h * 64);
#pragma unroll
        for (int d = 0; d < 64; ++d) o[d] = 0.f;
        float m = -1e30f, l = 0.f;
        for (int i = 0; i < NSEL; ++i) { const int blk = sl[i];
            for (int r = 0; r < 64; ++r) { const int s = blk * 64 + r;
                if (s <= t) { const bf16_t* kr = projb + (size_t)(b * S_ + s) * PB + kcol; const bf16_t* vr = projb + (size_t)(b * S_ + s) * PB + vcol;
                    float sc = 0.f;
#pragma unroll
                    for (int c = 0; c < 8; ++c) { float k8[8]; ld8(kr + 8 * c, k8);
#pragma unroll
                        for (int e = 0; e < 8; ++e) sc += q[8 * c + e] * k8[e]; }
                    sc -= slope * (float)(t - s);
                    if (sc > m) { const float al = __expf(m - sc); l *= al;
#pragma unroll
                        for (int d = 0; d < 64; ++d) o[d] *= al;
                        m = sc; }
                    const float pp = __expf(sc - m); l += pp;
#pragma unroll
                    for (int c = 0; c < 8; ++c) { float v8[8]; ld8(vr + 8 * c, v8);
#pragma unroll
                        for (int e = 0; e < 8; ++e) o[8 * c + e] += pp * v8[e]; }
                } } }
        const float inv = (l > 0.f) ? 1.f / l : 0.f; const float gate = WSP(float, O_GF)[(size_t)(b * S_ + t) * 32 + 1 * 8 + h];
        float* orow = WSP(float, O_O) + (size_t)(b * S_ + t) * D_ + h * 64;
#pragma unroll
        for (int d = 0; d < 64; ++d) orow[d] += gate * o[d] * inv;
    }
}
__device__ __forceinline__ void ph_attn_win(float* lds, KP p) {
    MK_LOOP(vb, (S_ / NT) * B_ * 8) attn_vblock<1>(lds, p, vb / (B_ * 8), vb % (B_ * 8));
}
__device__ __forceinline__ void ph_rmsnorm(KP p, int l) {
    const int lane = ftid() & 63, wv = ftid() >> 6; const float* g = p->in.g_out + (size_t)l * D_;
    for (int row = fbid() * 8 + wv; row < T_; row += gridDim.x * 8) {
        const float* r = WSP(float, O_O) + (size_t)row * D_; bf16_t* ro = WSP(bf16_t, O_OB) + (size_t)row * D_;
        float a[8], bq[8], s = 0.f, s2 = 0.f;
#pragma unroll
        for (int i = 0; i < 8; ++i) { a[i] = r[lane * 8 + i] + WSP(float, O_OWIN)[(size_t)row * 512 + lane * 8 + i]; s += a[i] * a[i]; bq[i] = r[512 + lane * 8 + i]; s2 += bq[i] * bq[i]; }
        const float sc0 = rsqrtf(wsum(s) * (1.f / 512.f) + RMS_EPS);
#pragma unroll
        for (int o = 1; o < 32; o <<= 1) s2 += __shfl_xor(s2, o);
        const float sc1 = rsqrtf(s2 * (1.f / 256.f) + RMS_EPS);
        float x0[8], x1[8];
#pragma unroll
        for (int i = 0; i < 8; ++i) { x0[i] = a[i] * sc0 * g[lane * 8 + i]; x1[i] = bq[i] * sc1 * g[512 + lane * 8 + i]; }
        *(u32x4*)(ro + lane * 8) = (u32x4){pk2(x0[0], x0[1]), pk2(x0[2], x0[3]), pk2(x0[4], x0[5]), pk2(x0[6], x0[7])};
        *(u32x4*)(ro + 512 + lane * 8) = (u32x4){pk2(x1[0], x1[1]), pk2(x1[2], x1[3]), pk2(x1[4], x1[5]), pk2(x1[6], x1[7])};
    }
}
template <bool ROUTER>
__device__ __forceinline__ void ph_ln(float* lds, KP p, int l, float* __restrict__ yout) {
    const int lane = ftid() & 63, wv = ftid() >> 6;
    const float* g = (ROUTER ? p->in.ln1_g : p->in.ln2_g) + (size_t)l * D_; const float* bb = (ROUTER ? p->in.ln1_b : p->in.ln2_b) + (size_t)l * D_;
    for (int row = fbid() * 8 + wv; row < T_; row += gridDim.x * 8) {
        float v[16], s = 0.f;
        if (ROUTER) { const float* src = WSP(float, O_MIX) + (size_t)row * D_;
#pragma unroll
            for (int j = 0; j < 2; ++j) { const f32x4 a = *(const f32x4*)(src + 512 * j + lane * 8), b = *(const f32x4*)(src + 512 * j + lane * 8 + 4);
                v[8 * j + 0] = a.x; v[8 * j + 1] = a.y; v[8 * j + 2] = a.z; v[8 * j + 3] = a.w; v[8 * j + 4] = b.x; v[8 * j + 5] = b.y; v[8 * j + 6] = b.z; v[8 * j + 7] = b.w; }
        } else { const float* src = WSP(float, O_X1) + (size_t)row * D_; const int* sl = WSP(int, O_SLOT) + row * TOPK; const bf16_t* y = WSP(bf16_t, O_Y);
#pragma unroll
            for (int j = 0; j < 2; ++j) { const f32x4 a = *(const f32x4*)(src + 512 * j + lane * 8), b = *(const f32x4*)(src + 512 * j + lane * 8 + 4);
                v[8 * j + 0] = ALPHA * a.x; v[8 * j + 1] = ALPHA * a.y; v[8 * j + 2] = ALPHA * a.z; v[8 * j + 3] = ALPHA * a.w; v[8 * j + 4] = ALPHA * b.x; v[8 * j + 5] = ALPHA * b.y; v[8 * j + 6] = ALPHA * b.z; v[8 * j + 7] = ALPHA * b.w; }
            float acc[16];
#pragma unroll
            for (int i = 0; i < 16; ++i) acc[i] = 0.f;
#pragma unroll
            for (int k = 0; k < TOPK; ++k) { const bf16_t* yr = y + (size_t)sl[k] * D_;
#pragma unroll
                for (int j = 0; j < 2; ++j) { float t8[8]; ld8(yr + 512 * j + lane * 8, t8);
#pragma unroll
                    for (int e = 0; e < 8; ++e) acc[8 * j + e] += t8[e]; } }
#pragma unroll
            for (int i = 0; i < 16; ++i) v[i] += acc[i]; }
#pragma unroll
        for (int i = 0; i < 16; ++i) s += v[i];
        const float mu = wsum(s) * (1.f / D_); float s2 = 0.f;
#pragma unroll
        for (int i = 0; i < 16; ++i) { v[i] -= mu; s2 += v[i] * v[i]; }
        const float rstd = rsqrtf(wsum(s2) * (1.f / D_) + LN_EPS);
        bf16_t* ybf = (ROUTER ? WSP(bf16_t, O_X1B) : WSP(bf16_t, O_XB)) + (size_t)row * D_;
#pragma unroll
        for (int j = 0; j < 2; ++j) { const int c0 = 512 * j + lane * 8;
#pragma unroll
            for (int e = 0; e < 8; ++e) v[8 * j + e] = v[8 * j + e] * rstd * g[c0 + e] + bb[c0 + e];
            *(f32x4*)(yout + (size_t)row * D_ + c0) = (f32x4){v[8 * j], v[8 * j + 1], v[8 * j + 2], v[8 * j + 3]};
            *(f32x4*)(yout + (size_t)row * D_ + c0 + 4) = (f32x4){v[8 * j + 4], v[8 * j + 5], v[8 * j + 6], v[8 * j + 7]};
            *(u32x4*)(ybf + c0) = (u32x4){pk2(v[8 * j], v[8 * j + 1]), pk2(v[8 * j + 2], v[8 * j + 3]), pk2(v[8 * j + 4], v[8 * j + 5]), pk2(v[8 * j + 6], v[8 * j + 7])}; }
    }
    if (ROUTER) {
        const float* rw = p->in.rw + (size_t)l * D_ * NE; const float* rb = p->in.rb + (size_t)l * NE; int* counts = WSP(int, O_COUNTS) + l * 32;
        float* lgl = lds + wv * 512;
        const int nrow = (T_ - (fbid() * 8 + wv) + (int)gridDim.x * 8 - 1) / ((int)gridDim.x * 8);
#pragma unroll 1
        for (int ps = 0; ps < 4; ++ps) {
            f32x4 w0[16], w1[16];
#pragma unroll
            for (int i = 0; i < 16; ++i) { const int c = 512 * (i >> 3) + lane * 8 + (i & 7); w0[i] = *(const f32x4*)(rw + (size_t)c * NE + 8 * ps); w1[i] = *(const f32x4*)(rw + (size_t)c * NE + 8 * ps + 4); }
#pragma unroll 1
            for (int ri = 0; ri < nrow; ++ri) { const int row = fbid() * 8 + wv + ri * (int)gridDim.x * 8; const float* src = yout + (size_t)row * D_;
                f32x4 a0 = {0.f, 0.f, 0.f, 0.f}, a1 = {0.f, 0.f, 0.f, 0.f};
#pragma unroll
                for (int j = 0; j < 2; ++j) { const f32x4 xa = *(const f32x4*)(src + 512 * j + lane * 8), xb = *(const f32x4*)(src + 512 * j + lane * 8 + 4);
                    a0 += w0[8 * j + 0] * xa.x + w0[8 * j + 1] * xa.y + w0[8 * j + 2] * xa.z + w0[8 * j + 3] * xa.w + w0[8 * j + 4] * xb.x + w0[8 * j + 5] * xb.y + w0[8 * j + 6] * xb.z + w0[8 * j + 7] * xb.w;
                    a1 += w1[8 * j + 0] * xa.x + w1[8 * j + 1] * xa.y + w1[8 * j + 2] * xa.z + w1[8 * j + 3] * xa.w + w1[8 * j + 4] * xb.x + w1[8 * j + 5] * xb.y + w1[8 * j + 6] * xb.z + w1[8 * j + 7] * xb.w; }
#pragma unroll
                for (int e = 0; e < 4; ++e) { a0[e] = wsum(a0[e]); a1[e] = wsum(a1[e]); }
                if (lane == 0) { *(f32x4*)(lgl + ri * 32 + 8 * ps) = a0; *(f32x4*)(lgl + ri * 32 + 8 * ps + 4) = a1; } }
        }
        asm volatile("s_waitcnt lgkmcnt(0)" ::: "memory");
#pragma unroll 1
        for (int ri = 0; ri < nrow; ++ri) { const int row = fbid() * 8 + wv + ri * (int)gridDim.x * 8;
            const int e = lane & 31; const float lg = lgl[ri * 32 + e] + rb[e];
            float cur = lg, tv0 = 0.f, den = 0.f, myw = 0.f; int mye = 0;
#pragma unroll
            for (int k = 0; k < TOPK; ++k) { float bv = cur; int bi = e;
#pragma unroll
                for (int o = 16; o >= 1; o >>= 1) { const float ov = __shfl_xor(bv, o); const int oi = __shfl_xor(bi, o); if (ov > bv || (ov == bv && oi < bi)) { bv = ov; bi = oi; } }
                if (k == 0) tv0 = bv;
                const float w = __expf(bv - tv0); den += w;
                if (lane == k) { mye = bi; myw = w; }
                if (e == bi) cur = -3.4e38f; }
            if (lane < TOPK) { WSP(int, O_TOPE)[row * TOPK + lane] = mye; WSP(float, O_TOPW)[row * TOPK + lane] = myw / den; WSP(int, O_POS)[row * TOPK + lane] = atomicAdd(&counts[mye], 1); } }
    }
}
__device__ __forceinline__ void ph_moe_plan(KP p, int l) {
    if (fbid() == 0 && ftid() == 0) { const int* counts = WSP(int, O_COUNTS) + l * 32; int* meta = WSP(int, O_META); int nt = 0;
        for (int e = 0; e < NE; ++e) { meta[e] = nt; const int c = counts[e];
            for (int r = 0; r < c; r += 256) { meta[64 + 2 * nt] = e; meta[65 + 2 * nt] = (c - r) < 256 ? (c - r) : 256; ++nt; } }
        meta[32] = nt; }
}
__device__ __forceinline__ void ph_moe_scatter(KP p) {
    const int* meta = WSP(int, O_META);
    for (int i = fbid() * NT + ftid(); i < MROWS; i += gridDim.x * NT) {
        const int row = meta[WSP(int, O_TOPE)[i]] * 256 + WSP(int, O_POS)[i];
        WSP(int, O_ROWTOK)[row] = i >> 2; WSP(float, O_ROWW)[row] = WSP(float, O_TOPW)[i]; WSP(int, O_SLOT)[i] = row; }
}
__device__ __forceinline__ void ph_cumsum(float* lds, KP p, int blk0) {
    const int tid = ftid(), lane = tid & 63, wv = tid >> 6; const int bh = fbid() - blk0;
    if (bh < 0 || bh >= B_ * 4) return;
    const int b = bh >> 2, h = bh & 3; const float* gf = WSP(float, O_GF) + (size_t)(b * S_ + tid * 16) * 32 + 24 + h;
    float v[16], run = 0.f;
#pragma unroll
    for (int i = 0; i < 16; ++i) { run += gf[(size_t)i * 32]; v[i] = run; }
    float inc = run;
#pragma unroll
    for (int o = 1; o < 64; o <<= 1) { const float t = __shfl_up(inc, o); if (lane >= o) inc += t; }
    if (lane == 63) lds[wv] = inc;
    __syncthreads();
    float woff = 0.f;
#pragma unroll
    for (int i = 0; i < 8; ++i) woff += (i < wv) ? lds[i] : 0.f;
    const float off = woff + inc - run; float* c = WSP(float, O_CFOX) + (size_t)bh * S_ + tid * 16;
#pragma unroll
    for (int i = 0; i < 4; ++i) *(f32x4*)(c + 4 * i) = (f32x4){v[4 * i] + off, v[4 * i + 1] + off, v[4 * i + 2] + off, v[4 * i + 3] + off};
    __syncthreads();
}
__device__ __forceinline__ void ph_prep2(KP p, int l) {
    for (int i = fbid() * NT + ftid(); i < 8 * 512 * 64; i += gridDim.x * NT) {
        const int d = i & 63, n = (i >> 6) & 511, combo = i >> 15, kv = combo & 1, bg = combo >> 1;
        const float* w2 = (kv ? p->in.w2v : p->in.w2k) + (size_t)l * 128 * 64; const bf16_t* hr = WSP(bf16_t, O_HID) + ((size_t)combo * 512 + n) * 128;
        float a = 0.f;
#pragma unroll 4
        for (int c = 0; c < 16; ++c) { float h8[8]; ld8(hr + 8 * c, h8);
#pragma unroll
            for (int e = 0; e < 8; ++e) a += h8[e] * w2[(8 * c + e) * 64 + d]; }
        (kv ? WSP(bf16_t, O_VCMPB) : WSP(bf16_t, O_KCMPB))[((size_t)bg * 512 + n) * 64 + d] = (n < NCMP) ? (bf16_t)f2bf(a) : (bf16_t)0; }
}
__device__ __forceinline__ void ph_moe_scatter2(float* lds, KP p, int l) {
    const int tid = ftid(); int* ts = (int*)lds;
    const int* counts = WSP(int, O_COUNTS) + l * 32; int* meta = WSP(int, O_META);
    __syncthreads();
    if (tid == 0) { int nt = 0; for (int e = 0; e < NE; ++e) { ts[e] = nt; nt += (counts[e] + 255) >> 8; } ts[32] = nt; }
    __syncthreads();
    if (fbid() == 0) { if (tid < NE) { const int c = counts[tid], t0 = ts[tid]; meta[tid] = t0; for (int r = 0, t = t0; r < c; r += 256, ++t) { meta[64 + 2 * t] = tid; meta[65 + 2 * t] = (c - r) < 256 ? (c - r) : 256; } }
        if (tid == 0) meta[32] = ts[32]; }
    for (int i = fbid() * NT + tid; i < MROWS; i += gridDim.x * NT) {
        const int row = ts[WSP(int, O_TOPE)[i]] * 256 + WSP(int, O_POS)[i];
        WSP(int, O_ROWTOK)[row] = i >> 2; WSP(float, O_ROWW)[row] = WSP(float, O_TOPW)[i]; WSP(int, O_SLOT)[i] = row; }
    __syncthreads();
}
}
namespace mk {
typedef short bf16x8 __attribute__((ext_vector_type(8)));
typedef float f32x16 __attribute__((ext_vector_type(16)));
typedef float f32x2_t __attribute__((ext_vector_type(2)));
typedef __bf16 bf16x2_t __attribute__((ext_vector_type(2)));
typedef unsigned u32x2 __attribute__((ext_vector_type(2)));
__device__ __forceinline__ unsigned cvtpk(float lo, float hi) { f32x2_t v = {lo, hi}; bf16x2_t b = __builtin_convertvector(v, bf16x2_t); return __builtin_bit_cast(unsigned, b); }
constexpr int KROW = 144, VROW = 136;
constexpr int E1_K = 0, E1_V = 64 * KROW, E1_C = E1_V + 64 * VROW, E1_BUF = E1_C + 256;
constexpr int E1_FLAGS = 2 * E1_BUF;
constexpr float LOG2E = 1.4426950408889634f;
constexpr float RESC_THR = 8.0f;
#define CROW(reg, hh) (((reg) & 3) + 8 * ((reg) >> 2) + 4 * (hh))

struct E1Geom { int b, q0, h; const bf16_t* qp; const bf16_t* kp; const bf16_t* vp; size_t pitch; };

template <int KIND>
__device__ __forceinline__ void e1_unit(LAS unsigned char* lds, KP p, int b, int hg, int qb, float* __restrict__ obase, float* __restrict__ owin) {
    const int tid = ftid(), lane = tid & 63, w = __builtin_amdgcn_readfirstlane(tid >> 6), r32 = lane & 31, hh = lane >> 5;
    const bf16_t* projb = WSP(bf16_t, O_PROJB);
    int h, q0, qrow0, qcol, kcol, vcol, nrows;
    if (KIND == 0) { h = hg; q0 = qb * 256; qrow0 = q0 + 32 * w; qcol = C_FOX + h * 64; kcol = C_FOX + (4 + h) * 64; vcol = C_FOX + (8 + h) * 64; nrows = 256; }
    else if (KIND == 2) { h = hg; q0 = qb * 256; qrow0 = q0 + 32 * w; qcol = C_SB + h * 64; kcol = C_SB + (4 + h) * 64; vcol = C_SB + (8 + h) * 64; nrows = 256; }
    else { h = 4 * hg + (w & 3); q0 = qb * 64; qrow0 = q0 + 32 * (w >> 2); qcol = h * 64; kcol = C_KV + ((2 * 2 + 0) * 2 + hg) * 64; vcol = C_KV + ((2 * 2 + 1) * 2 + hg) * 64; nrows = 64; }
    const int tq = qrow0 + r32;
    const bf16_t* kbase = projb + (size_t)(b * S_) * PB + kcol; const bf16_t* vbase = projb + (size_t)(b * S_) * PB + vcol;
    bf16x8 qf[4];
    { const bf16_t* qptr = projb + (size_t)(b * S_ + tq) * PB + qcol + 8 * hh;
#pragma unroll
      for (int d0 = 0; d0 < 4; ++d0) qf[d0] = *(const bf16x8*)(qptr + 16 * d0); }
    int j0 = 0; const int j1 = (q0 + nrows - 1) >> 6;
    if (KIND == 1) { j0 = (q0 - 511) >> 6; if (j0 < 0) j0 = 0; }
    const int ntile = j1 - j0 + 1;
    float ct2 = 0.f, sl2 = 0.f; const float* cb = nullptr;
    if (KIND == 0) { cb = WSP(float, O_CFOX) + (size_t)(b * 4 + h) * S_; ct2 = cb[tq] * LOG2E; }
    if (KIND == 1) sl2 = exp2f(-(float)(h + 1)) * LOG2E;
    const float tqf = (float)tq;
    const int skey = tid >> 3, sch = tid & 7;
    u32x4 rk, rv; float rc = 0.f;
#define E1_LOAD(jj) do { const size_t ro_ = (size_t)((jj) * 64 + skey) * PB + sch * 8; rk = *(const u32x4*)(kbase + ro_); rv = *(const u32x4*)(vbase + ro_); \
        if (KIND == 0 && tid < 64) rc = cb[(jj) * 64 + tid] * LOG2E; } while (0)
#define E1_WRITE(bufp) do { *(LAS u32x4*)((bufp) + E1_K + skey * KROW + sch * 16) = rk; \
        LAS unsigned short* vt_ = (LAS unsigned short*)((bufp) + E1_V + (8 * sch) * VROW) + skey; \
        vt_[0 * (VROW / 2)] = (unsigned short)(rv.x & 0xffffu); vt_[1 * (VROW / 2)] = (unsigned short)(rv.x >> 16); vt_[2 * (VROW / 2)] = (unsigned short)(rv.y & 0xffffu); vt_[3 * (VROW / 2)] = (unsigned short)(rv.y >> 16); \
        vt_[4 * (VROW / 2)] = (unsigned short)(rv.z & 0xffffu); vt_[5 * (VROW / 2)] = (unsigned short)(rv.z >> 16); vt_[6 * (VROW / 2)] = (unsigned short)(rv.w & 0xffffu); vt_[7 * (VROW / 2)] = (unsigned short)(rv.w >> 16); \
        if (KIND == 0 && tid < 64) ((LAS float*)((bufp) + E1_C))[tid] = rc; } while (0)
    f32x16 o0, o1;
#pragma unroll
    for (int r = 0; r < 16; ++r) { o0[r] = 0.f; o1[r] = 0.f; }
    float m = -1e30f, l = 0.f, carry = 0.f;
    bool wave_done = false;
    LAS unsigned* flags = (LAS unsigned*)(lds + E1_FLAGS);
    if (KIND == 2) { if (tid < 8) flags[tid] = 0u; }
    __syncthreads();
    E1_LOAD(KIND == 2 ? j1 : j0);
    for (int it = 0; it < ntile; ++it) {
        const int j = (KIND == 2) ? (j1 - it) : (j0 + it);
        LAS unsigned char* buf = lds + (it & 1) * E1_BUF;
        E1_WRITE(buf);
        __syncthreads();
        if (KIND == 2) { unsigned alld = 1u;
#pragma unroll
            for (int i = 0; i < 8; ++i) alld &= flags[i];
            if (alld) break; }
        if (it + 1 < ntile) E1_LOAD((KIND == 2) ? (j - 1) : (j + 1));
        if (!(KIND == 2 && wave_done)) {
            f32x16 p0, p1;
#pragma unroll
            for (int r = 0; r < 16; ++r) { p0[r] = 0.f; p1[r] = 0.f; }
            { const LAS unsigned char* kp_ = buf + E1_K + r32 * KROW + hh * 16;
#pragma unroll
              for (int d0 = 0; d0 < 4; ++d0) { const bf16x8 a0 = *(const LAS bf16x8*)(kp_ + d0 * 32), a1 = *(const LAS bf16x8*)(kp_ + 32 * KROW + d0 * 32);
                  p0 = __builtin_amdgcn_mfma_f32_32x32x16_bf16(a0, qf[d0], p0, 0, 0, 0); p1 = __builtin_amdgcn_mfma_f32_32x32x16_bf16(a1, qf[d0], p1, 0, 0, 0); } }
            const int kb = j * 64 + 4 * hh;
            if (KIND == 2) {
                float lk0[16], lk1[16], gs[8];
#pragma unroll
                for (int reg = 0; reg < 16; ++reg) { const int kpos = kb + CROW(reg, 0);
                    const float z0 = p0[reg] * SCALE, z1 = p1[reg] * SCALE; const bool v0 = kpos < tq, v1 = kpos + 32 < tq;
                    const float lb0 = fminf(z0, 0.f) - __logf(1.f + __expf(-fabsf(z0))), lb1 = fminf(z1, 0.f) - __logf(1.f + __expf(-fabsf(z1)));
                    lk0[reg] = v0 ? (lb0 - z0) : 0.f; lk1[reg] = v1 ? (lb1 - z1) : 0.f;
                    p0[reg] = v0 ? lb0 : -INFINITY; p1[reg] = v1 ? lb1 : -INFINITY; }
#pragma unroll
                for (int g4 = 0; g4 < 4; ++g4) { gs[g4] = (lk0[4 * g4] + lk0[4 * g4 + 1]) + (lk0[4 * g4 + 2] + lk0[4 * g4 + 3]); gs[4 + g4] = (lk1[4 * g4] + lk1[4 * g4 + 1]) + (lk1[4 * g4 + 2] + lk1[4 * g4 + 3]); }
                float oth[8];
#pragma unroll
                for (int gi = 0; gi < 8; ++gi) oth[gi] = __shfl_xor(gs[gi], 32);
                float run = 0.f;
#pragma unroll
                for (int gi = 7; gi >= 0; --gi) {
                    float later = carry + run + (hh == 0 ? oth[gi] : 0.f);
#pragma unroll
                    for (int e = 3; e >= 0; --e) { const int reg = (gi & 3) * 4 + e;
                        if (gi >> 2) { p1[reg] = __expf(p1[reg] + later); later += lk1[reg]; } else { p0[reg] = __expf(p0[reg] + later); later += lk0[reg]; } }
                    run += gs[gi] + oth[gi]; }
                carry += run;
            } else {
                if (KIND == 0) {
                    const LAS float* cs = (const LAS float*)(buf + E1_C) + 4 * hh;
#pragma unroll
                    for (int i = 0; i < 4; ++i) { const f32x4 c0 = *(const LAS f32x4*)(cs + 8 * i), c1 = *(const LAS f32x4*)(cs + 32 + 8 * i);
#pragma unroll
                        for (int e = 0; e < 4; ++e) { const int reg = 4 * i + e; const int kpos = kb + CROW(reg, 0);
                            const float s0 = p0[reg] * (SCALE * LOG2E) + (ct2 - c0[e]), s1 = p1[reg] * (SCALE * LOG2E) + (ct2 - c1[e]);
                            p0[reg] = (kpos <= tq) ? s0 : -INFINITY; p1[reg] = (kpos + 32 <= tq) ? s1 : -INFINITY; } }
                } else {
#pragma unroll
                    for (int reg = 0; reg < 16; ++reg) { const int kpos = kb + CROW(reg, 0); const float d0f = tqf - (float)kpos, d1f = d0f - 32.f;
                        const float s0 = p0[reg] * (SCALE * LOG2E) - sl2 * d0f, s1 = p1[reg] * (SCALE * LOG2E) - sl2 * d1f;
                        p0[reg] = (kpos <= tq && tq - kpos < 512) ? s0 : -INFINITY; p1[reg] = (kpos + 32 <= tq && tq - kpos - 32 < 512) ? s1 : -INFINITY; }
                }
                float rm = fmaxf(p0[0], p1[0]);
#pragma unroll
                for (int reg = 1; reg < 16; ++reg) rm = fmaxf(rm, fmaxf(p0[reg], p1[reg]));
                rm = fmaxf(rm, __shfl_xor(rm, 32));
                if (__any(rm > m + RESC_THR)) { const float mn = fmaxf(m, rm), al = __builtin_amdgcn_exp2f(m - mn); l *= al;
#pragma unroll
                    for (int r = 0; r < 16; ++r) { o0[r] *= al; o1[r] *= al; }
                    m = mn; }
                float ls = 0.f;
#pragma unroll
                for (int reg = 0; reg < 16; ++reg) { p0[reg] = __builtin_amdgcn_exp2f(p0[reg] - m); p1[reg] = __builtin_amdgcn_exp2f(p1[reg] - m); ls += p0[reg] + p1[reg]; }
                l += ls;
            }
            { const LAS unsigned char* vp_ = buf + E1_V + r32 * VROW + hh * 8;
#pragma unroll
              for (int s = 0; s < 4; ++s) {
                  u32x4 pw;
                  if (s < 2) { pw.x = cvtpk(p0[8 * s + 0], p0[8 * s + 1]); pw.y = cvtpk(p0[8 * s + 2], p0[8 * s + 3]); pw.z = cvtpk(p0[8 * s + 4], p0[8 * s + 5]); pw.w = cvtpk(p0[8 * s + 6], p0[8 * s + 7]); }
                  else { const int s2 = s - 2; pw.x = cvtpk(p1[8 * s2 + 0], p1[8 * s2 + 1]); pw.y = cvtpk(p1[8 * s2 + 2], p1[8 * s2 + 3]); pw.z = cvtpk(p1[8 * s2 + 4], p1[8 * s2 + 5]); pw.w = cvtpk(p1[8 * s2 + 6], p1[8 * s2 + 7]); }
                  const bf16x8 pb = __builtin_bit_cast(bf16x8, pw);
                  const u32x2 a0l = *(const LAS u32x2*)(vp_ + s * 32), a0h = *(const LAS u32x2*)(vp_ + s * 32 + 16);
                  const u32x2 a1l = *(const LAS u32x2*)(vp_ + 32 * VROW + s * 32), a1h = *(const LAS u32x2*)(vp_ + 32 * VROW + s * 32 + 16);
                  const bf16x8 va0 = __builtin_bit_cast(bf16x8, (u32x4){a0l.x, a0l.y, a0h.x, a0h.y}), va1 = __builtin_bit_cast(bf16x8, (u32x4){a1l.x, a1l.y, a1h.x, a1h.y});
                  o0 = __builtin_amdgcn_mfma_f32_32x32x16_bf16(va0, pb, o0, 0, 0, 0); o1 = __builtin_amdgcn_mfma_f32_32x32x16_bf16(va1, pb, o1, 0, 0, 0); } }
            if (KIND == 2) { const bool dn = __all(carry < -110.f);
                if (dn && !wave_done) { wave_done = true; if (lane == 0) flags[w] = 1u; } }
        }
    }
    float inv = 1.f, gate = 1.f;
    if (KIND != 2) { l += __shfl_xor(l, 32); inv = (l > 0.f) ? 1.f / l : 0.f; }
    float* orow;
    if (KIND == 0) orow = obase + (size_t)(b * S_ + tq) * D_ + 512 + h * 64;
    else if (KIND == 2) orow = obase + (size_t)(b * S_ + tq) * D_ + 768 + h * 64;
    else { orow = owin + (size_t)(b * S_ + tq) * 512 + h * 64; gate = WSP(float, O_GF)[(size_t)(b * S_ + tq) * 32 + 2 * 8 + h]; }
    const float sc = inv * gate;
#pragma unroll
    for (int i = 0; i < 4; ++i) {
        *(f32x4*)(orow + 8 * i + 4 * hh) = (f32x4){o0[4 * i] * sc, o0[4 * i + 1] * sc, o0[4 * i + 2] * sc, o0[4 * i + 3] * sc};
        *(f32x4*)(orow + 32 + 8 * i + 4 * hh) = (f32x4){o1[4 * i] * sc, o1[4 * i + 1] * sc, o1[4 * i + 2] * sc, o1[4 * i + 3] * sc}; }
#undef E1_LOAD
#undef E1_WRITE
}
}
namespace mk {
typedef short v4i16_t __attribute__((ext_vector_type(4)));
constexpr int E2_WAVE = 64 * KROW + 512;
template <bool USE_MASK>
__device__ __forceinline__ void e2_wave_unit(LAS unsigned char* ldsw, KP p, int b, int g, int t0, float* __restrict__ obase, const float* __restrict__ csrc, int cpitch) {
    const int lane = ftid() & 63, r32 = lane & 31, hh = lane >> 5, qi = r32 >> 2, r4 = r32 & 3;
    const int h = 4 * g + r4, tq = t0 + qi;
    const bf16_t* projb = WSP(bf16_t, O_PROJB);
    const bf16_t* kbase = projb + (size_t)(b * S_) * PB + C_KV + ((1 * 2 + 0) * 2 + g) * 64;
    const bf16_t* vbase = projb + (size_t)(b * S_) * PB + C_KV + ((1 * 2 + 1) * 2 + g) * 64;
    bf16x8 qf[4];
    { const bf16_t* qptr = projb + (size_t)(b * S_ + tq) * PB + h * 64 + 8 * hh;
#pragma unroll
      for (int d0 = 0; d0 < 4; ++d0) qf[d0] = *(const bf16x8*)(qptr + 16 * d0); }
    unsigned qm0 = 0u, qm1 = 0u, qm2 = 0u, qm3 = 0u;
    if (USE_MASK) { const u32x4 mw = *(const u32x4*)(WSP(unsigned, O_SELMASK) + ((size_t)((b * 2 + g) * S_ + t0 + (lane >> 3))) * 4); qm0 = mw.x; qm1 = mw.y; qm2 = mw.z; qm3 = mw.w; }
    else { const int* sp = WSP(int, O_SEL) + ((size_t)((b * 2 + g) * S_ + t0)) * NSEL + lane * 2;
      const int e0 = sp[0], e1 = sp[1];
#pragma unroll
      for (int k = 0; k < 2; ++k) { const int e = k ? e1 : e0; const unsigned bit = 1u << (e & 31); const int wd = e >> 5;
          qm0 |= (wd == 0) ? bit : 0u; qm1 |= (wd == 1) ? bit : 0u; qm2 |= (wd == 2) ? bit : 0u; qm3 |= (wd == 3) ? bit : 0u; }
#pragma unroll
      for (int o = 1; o < 8; o <<= 1) { qm0 |= __shfl_xor(qm0, o); qm1 |= __shfl_xor(qm1, o); qm2 |= __shfl_xor(qm2, o); qm3 |= __shfl_xor(qm3, o); } }
    const unsigned rm0 = __shfl(qm0, qi * 8), rm1 = __shfl(qm1, qi * 8), rm2 = __shfl(qm2, qi * 8), rm3 = __shfl(qm3, qi * 8);
    unsigned um0 = qm0, um1 = qm1, um2 = qm2, um3 = qm3;
#pragma unroll
    for (int o = 8; o < 64; o <<= 1) { um0 |= __shfl_xor(um0, o); um1 |= __shfl_xor(um1, o); um2 |= __shfl_xor(um2, o); um3 |= __shfl_xor(um3, o); }
    LAS int* list = (LAS int*)(ldsw + 64 * KROW);
    int nblk;
    { const bool s0 = (((lane < 32) ? um0 : um1) >> (lane & 31)) & 1u, s1 = (((lane < 32) ? um2 : um3) >> (lane & 31)) & 1u;
      const unsigned long long b0 = __ballot(s0), b1 = __ballot(s1);
      const unsigned long long lower = (lane == 0) ? 0ull : (~0ull >> (64 - lane));
      const int n0 = __popcll(b0);
      if (s0) list[__popcll(b0 & lower)] = lane;
      if (s1) list[n0 + __popcll(b1 & lower)] = lane + 64;
      nblk = n0 + __popcll(b1); }
    asm volatile("s_waitcnt lgkmcnt(0)" ::: "memory");
    const float sl2 = exp2f(-(float)(h + 1)) * LOG2E, tqf = (float)tq;
    f32x16 o0, o1;
#pragma unroll
    for (int r = 0; r < 16; ++r) { o0[r] = 0.f; o1[r] = 0.f; }
    float m = -1e30f, l = 0.f;
    const int vrow = lane >> 3, vch = lane & 7;
    const int gq = lane >> 4, li = lane & 15;
    const LAS unsigned char* trb = ldsw + (4 * hh + (li >> 2)) * KROW + (16 * (gq & 1) + 4 * (li & 3)) * 2;
    bf16x8 kn0[4], kn1[4]; u32x4 vn[8];
#define E2_LOAD(blk) do { const bf16_t* kp_ = kbase + (size_t)((blk) * 64 + r32) * PB + 8 * hh; const bf16_t* vp_ = vbase + (size_t)((blk) * 64 + vrow) * PB + vch * 8; \
        _Pragma("unroll") for (int d0 = 0; d0 < 4; ++d0) { kn0[d0] = *(const bf16x8*)(kp_ + 16 * d0); kn1[d0] = *(const bf16x8*)(kp_ + (size_t)32 * PB + 16 * d0); } \
        _Pragma("unroll") for (int i = 0; i < 8; ++i) vn[i] = *(const u32x4*)(vp_ + (size_t)(8 * i) * PB); } while (0)
    int blk = list[0];
    blk = __builtin_amdgcn_readfirstlane(blk);
    E2_LOAD(blk);
    for (int it = 0; it < nblk; ++it) {
#pragma unroll
        for (int i = 0; i < 8; ++i) *(LAS u32x4*)(ldsw + (vrow + 8 * i) * KROW + vch * 16) = vn[i];
        const int cur = blk;
        f32x16 p0, p1;
#pragma unroll
        for (int r = 0; r < 16; ++r) { p0[r] = 0.f; p1[r] = 0.f; }
#pragma unroll
        for (int d0 = 0; d0 < 4; ++d0) { p0 = __builtin_amdgcn_mfma_f32_32x32x16_bf16(kn0[d0], qf[d0], p0, 0, 0, 0); p1 = __builtin_amdgcn_mfma_f32_32x32x16_bf16(kn1[d0], qf[d0], p1, 0, 0, 0); }
        if (it + 1 < nblk) { blk = __builtin_amdgcn_readfirstlane(list[it + 1]); E2_LOAD(blk); }
        const unsigned rw = (cur < 32) ? rm0 : (cur < 64) ? rm1 : (cur < 96) ? rm2 : rm3;
        const bool rowsel = (rw >> (cur & 31)) & 1u;
        const int kb = cur * 64 + 4 * hh;
#pragma unroll
        for (int reg = 0; reg < 16; ++reg) { const int kpos = kb + CROW(reg, 0); const float d0f = tqf - (float)kpos, d1f = d0f - 32.f;
            const float s0 = p0[reg] * (SCALE * LOG2E) - sl2 * d0f, s1 = p1[reg] * (SCALE * LOG2E) - sl2 * d1f;
            p0[reg] = (rowsel && kpos <= tq) ? s0 : -INFINITY; p1[reg] = (rowsel && kpos + 32 <= tq) ? s1 : -INFINITY; }
        float rmx = fmaxf(p0[0], p1[0]);
#pragma unroll
        for (int reg = 1; reg < 16; ++reg) rmx = fmaxf(rmx, fmaxf(p0[reg], p1[reg]));
        rmx = fmaxf(rmx, __shfl_xor(rmx, 32));
        if (__any(rmx > m + RESC_THR)) { const float mn = fmaxf(m, rmx), al = __builtin_amdgcn_exp2f(m - mn); l *= al;
#pragma unroll
            for (int r = 0; r < 16; ++r) { o0[r] *= al; o1[r] *= al; }
            m = mn; }
        float ls = 0.f;
#pragma unroll
        for (int reg = 0; reg < 16; ++reg) { p0[reg] = __builtin_amdgcn_exp2f(p0[reg] - m); p1[reg] = __builtin_amdgcn_exp2f(p1[reg] - m); ls += p0[reg] + p1[reg]; }
        l += ls;
#pragma unroll
        for (int s = 0; s < 4; ++s) {
            u32x4 pw;
            if (s < 2) { pw.x = cvtpk(p0[8 * s + 0], p0[8 * s + 1]); pw.y = cvtpk(p0[8 * s + 2], p0[8 * s + 3]); pw.z = cvtpk(p0[8 * s + 4], p0[8 * s + 5]); pw.w = cvtpk(p0[8 * s + 6], p0[8 * s + 7]); }
            else { const int s2 = s - 2; pw.x = cvtpk(p1[8 * s2 + 0], p1[8 * s2 + 1]); pw.y = cvtpk(p1[8 * s2 + 2], p1[8 * s2 + 3]); pw.z = cvtpk(p1[8 * s2 + 4], p1[8 * s2 + 5]); pw.w = cvtpk(p1[8 * s2 + 6], p1[8 * s2 + 7]); }
            const bf16x8 pb = __builtin_bit_cast(bf16x8, pw);
            const v4i16_t a0l = __builtin_amdgcn_ds_read_tr16_b64_v4i16((LAS v4i16_t*)(trb + (16 * s) * KROW)), a0h = __builtin_amdgcn_ds_read_tr16_b64_v4i16((LAS v4i16_t*)(trb + (16 * s + 8) * KROW));
            const v4i16_t a1l = __builtin_amdgcn_ds_read_tr16_b64_v4i16((LAS v4i16_t*)(trb + (16 * s) * KROW + 64)), a1h = __builtin_amdgcn_ds_read_tr16_b64_v4i16((LAS v4i16_t*)(trb + (16 * s + 8) * KROW + 64));
            const bf16x8 va0 = (bf16x8){a0l[0], a0l[1], a0l[2], a0l[3], a0h[0], a0h[1], a0h[2], a0h[3]}, va1 = (bf16x8){a1l[0], a1l[1], a1l[2], a1l[3], a1h[0], a1h[1], a1h[2], a1h[3]};
            o0 = __builtin_amdgcn_mfma_f32_32x32x16_bf16(va0, pb, o0, 0, 0, 0); o1 = __builtin_amdgcn_mfma_f32_32x32x16_bf16(va1, pb, o1, 0, 0, 0); }
    }
    l += __shfl_xor(l, 32);
    const float sc = ((l > 0.f) ? 1.f / l : 0.f) * WSP(float, O_GF)[(size_t)(b * S_ + tq) * 32 + 1 * 8 + h];
    float* orow = obase + (size_t)(b * S_ + tq) * D_ + h * 64; const float* crow = csrc + (size_t)(b * S_ + tq) * cpitch + h * 64;
#pragma unroll
    for (int i = 0; i < 4; ++i) {
        f32x4 x0 = *(const f32x4*)(crow + 8 * i + 4 * hh), x1 = *(const f32x4*)(crow + 32 + 8 * i + 4 * hh);
        x0 += (f32x4){o0[4 * i] * sc, o0[4 * i + 1] * sc, o0[4 * i + 2] * sc, o0[4 * i + 3] * sc}; x1 += (f32x4){o1[4 * i] * sc, o1[4 * i + 1] * sc, o1[4 * i + 2] * sc, o1[4 * i + 3] * sc};
        *(f32x4*)(orow + 8 * i + 4 * hh) = x0; *(f32x4*)(orow + 32 + 8 * i + 4 * hh) = x1; }
#undef E2_LOAD
}
template <bool USE_MASK>
__device__ __forceinline__ void ph_attn_sel2(LAS unsigned char* lds3, KP p, float* __restrict__ obase, const float* __restrict__ csrc, int cpitch) {
    const int w = __builtin_amdgcn_readfirstlane(ftid() >> 6);
    LAS unsigned char* ldsw = lds3 + w * E2_WAVE;
    MK_LOOP(u, 512) { const int bg = u & 3, qblk = u >> 2; e2_wave_unit<USE_MASK>(ldsw, p, bg >> 1, bg & 1, qblk * 64 + 8 * w, obase, csrc, cpitch); }
}
}
namespace mk {
constexpr int E3_K = 0, E3_V = 512 * KROW, E3_BYTES = 2 * 512 * KROW;
__device__ __forceinline__ void e3_unit(LAS unsigned char* lds, KP p, int b, int g, int qb, float* __restrict__ ocmp, unsigned* __restrict__ selmask) {
    const int tid = ftid(), lane = tid & 63, w = __builtin_amdgcn_readfirstlane(tid >> 6), r32 = lane & 31, hh = lane >> 5;
    const int bg = b * 2 + g, q0 = qb * 256, qrow0 = q0 + 32 * w, tq = qrow0 + r32;
    const bf16_t* projb = WSP(bf16_t, O_PROJB);
    int nun = (q0 + 255 - 31) / 16 + 1; if (nun > 511) nun = 511;
    const int ntile_u = (nun + 63) >> 6;
    __syncthreads();
    { const int srow = tid >> 3, sch = tid & 7; const bf16_t* ks = WSP(bf16_t, O_KCMPB) + ((size_t)bg * 512 + srow) * 64 + sch * 8; const bf16_t* vs = WSP(bf16_t, O_VCMPB) + ((size_t)bg * 512 + srow) * 64 + sch * 8;
      for (int i = 0; i < ntile_u; ++i) { const u32x4 kv = *(const u32x4*)(ks + (size_t)i * 64 * 64), vv = *(const u32x4*)(vs + (size_t)i * 64 * 64);
          *(LAS u32x4*)(lds + E3_K + (srow + 64 * i) * KROW + sch * 16) = kv; *(LAS u32x4*)(lds + E3_V + (srow + 64 * i) * KROW + sch * 16) = vv; } }
    __syncthreads();
    int nw = qrow0 / 16 + 1; if (nw > 511) nw = 511;
    const int ntile_w = (qrow0 + 31 < 31) ? 0 : ((nw + 63) >> 6);
    const float tqf = (float)tq;
    const int gq = lane >> 4, li = lane & 15;
    const LAS unsigned char* trb = lds + E3_V + (4 * hh + (li >> 2)) * KROW + (16 * (gq & 1) + 4 * (li & 3)) * 2;
    const LAS unsigned char* kfb = lds + E3_K + r32 * KROW + hh * 16;
    float imp[64];
#pragma unroll
    for (int i = 0; i < 64; ++i) imp[i] = 0.f;
#pragma unroll 1
    for (int r4 = 0; r4 < 4; ++r4) {
        const int h = 4 * g + r4; const float sl2 = exp2f(-(float)(h + 1)) * LOG2E;
        bf16x8 qf[4];
        { const bf16_t* qptr = projb + (size_t)(b * S_ + tq) * PB + h * 64 + 8 * hh;
#pragma unroll
          for (int d0 = 0; d0 < 4; ++d0) qf[d0] = *(const bf16x8*)(qptr + 16 * d0); }
        f32x16 o0, o1;
#pragma unroll
        for (int r = 0; r < 16; ++r) { o0[r] = 0.f; o1[r] = 0.f; }
        float m = -1e30f, l = 0.f;
#define E3_ST(jt) f32x16 p0, p1; { _Pragma("unroll") for (int r = 0; r < 16; ++r) { p0[r] = 0.f; p1[r] = 0.f; } \
            _Pragma("unroll") for (int d0 = 0; d0 < 4; ++d0) { const bf16x8 a0 = *(const LAS bf16x8*)(kfb + (64 * (jt)) * KROW + d0 * 32), a1 = *(const LAS bf16x8*)(kfb + (64 * (jt) + 32) * KROW + d0 * 32); \
                p0 = __builtin_amdgcn_mfma_f32_32x32x16_bf16(a0, qf[d0], p0, 0, 0, 0); p1 = __builtin_amdgcn_mfma_f32_32x32x16_bf16(a1, qf[d0], p1, 0, 0, 0); } \
            int tq_ = tq; asm volatile("" : "+v"(tq_));     \
            int hh_ = hh; asm volatile("" : "+v"(hh_)); \
            const float tqf_ = (float)tq_; const int ce0_ = 16 * (64 * (jt) + 4 * hh_) + 31; \
            _Pragma("unroll") for (int reg = 0; reg < 16; ++reg) { const int ce = ce0_ + 16 * CROW(reg, 0); const float d0f = tqf_ - (float)ce, d1f = d0f - 512.f; \
                const float s0 = p0[reg] * (SCALE * LOG2E) - sl2 * d0f, s1 = p1[reg] * (SCALE * LOG2E) - sl2 * d1f; \
                p0[reg] = (ce <= tq_) ? s0 : -INFINITY; p1[reg] = (ce + 512 <= tq_) ? s1 : -INFINITY; } }
        for (int jt = 0; jt < ntile_w; ++jt) {
            E3_ST(jt);
            float rmx = fmaxf(p0[0], p1[0]);
#pragma unroll
            for (int reg = 1; reg < 16; ++reg) rmx = fmaxf(rmx, fmaxf(p0[reg], p1[reg]));
            rmx = fmaxf(rmx, __shfl_xor(rmx, 32));
            if (__any(rmx > m + RESC_THR)) { const float mn = fmaxf(m, rmx), al = __builtin_amdgcn_exp2f(m - mn); l *= al;
#pragma unroll
                for (int r = 0; r < 16; ++r) { o0[r] *= al; o1[r] *= al; }
                m = mn; }
            float ls = 0.f;
#pragma unroll
            for (int reg = 0; reg < 16; ++reg) { p0[reg] = __builtin_amdgcn_exp2f(p0[reg] - m); p1[reg] = __builtin_amdgcn_exp2f(p1[reg] - m); ls += p0[reg] + p1[reg]; }
            l += ls;
            const LAS unsigned char* tb = trb + (64 * jt) * KROW;
#pragma unroll
            for (int s = 0; s < 4; ++s) {
                u32x4 pw;
                if (s < 2) { pw.x = cvtpk(p0[8 * s + 0], p0[8 * s + 1]); pw.y = cvtpk(p0[8 * s + 2], p0[8 * s + 3]); pw.z = cvtpk(p0[8 * s + 4], p0[8 * s + 5]); pw.w = cvtpk(p0[8 * s + 6], p0[8 * s + 7]); }
                else { const int s2 = s - 2; pw.x = cvtpk(p1[8 * s2 + 0], p1[8 * s2 + 1]); pw.y = cvtpk(p1[8 * s2 + 2], p1[8 * s2 + 3]); pw.z = cvtpk(p1[8 * s2 + 4], p1[8 * s2 + 5]); pw.w = cvtpk(p1[8 * s2 + 6], p1[8 * s2 + 7]); }
                const bf16x8 pb = __builtin_bit_cast(bf16x8, pw);
                const v4i16_t a0l = __builtin_amdgcn_ds_read_tr16_b64_v4i16((LAS v4i16_t*)(tb + (16 * s) * KROW)), a0h = __builtin_amdgcn_ds_read_tr16_b64_v4i16((LAS v4i16_t*)(tb + (16 * s + 8) * KROW));
                const v4i16_t a1l = __builtin_amdgcn_ds_read_tr16_b64_v4i16((LAS v4i16_t*)(tb + (16 * s) * KROW + 64)), a1h = __builtin_amdgcn_ds_read_tr16_b64_v4i16((LAS v4i16_t*)(tb + (16 * s + 8) * KROW + 64));
                const bf16x8 va0 = (bf16x8){a0l[0], a0l[1], a0l[2], a0l[3], a0h[0], a0h[1], a0h[2], a0h[3]}, va1 = (bf16x8){a1l[0], a1l[1], a1l[2], a1l[3], a1h[0], a1h[1], a1h[2], a1h[3]};
                o0 = __builtin_amdgcn_mfma_f32_32x32x16_bf16(va0, pb, o0, 0, 0, 0); o1 = __builtin_amdgcn_mfma_f32_32x32x16_bf16(va1, pb, o1, 0, 0, 0); }
        }
        l += __shfl_xor(l, 32);
        const float inv = (l > 0.f) ? 1.f / l : 0.f;
        { const float sc = inv * WSP(float, O_GF)[(size_t)(b * S_ + tq) * 32 + 0 * 8 + h];
          float* orow = ocmp + (size_t)(b * S_ + tq) * 512 + h * 64;
#pragma unroll
          for (int i = 0; i < 4; ++i) {
              *(f32x4*)(orow + 8 * i + 4 * hh) = (f32x4){o0[4 * i] * sc, o0[4 * i + 1] * sc, o0[4 * i + 2] * sc, o0[4 * i + 3] * sc};
              *(f32x4*)(orow + 32 + 8 * i + 4 * hh) = (f32x4){o1[4 * i] * sc, o1[4 * i + 1] * sc, o1[4 * i + 2] * sc, o1[4 * i + 3] * sc}; } }
#pragma unroll
        for (int jt = 0; jt < 8; ++jt) {
            if (jt < ntile_w) {
                E3_ST(jt);
#pragma unroll
                for (int reg = 0; reg < 16; ++reg) { p0[reg] = __builtin_amdgcn_exp2f(p0[reg] - m) * inv; p1[reg] = __builtin_amdgcn_exp2f(p1[reg] - m) * inv; }
#pragma unroll
                for (int pa = 0; pa < 2; ++pa)
#pragma unroll
                    for (int i = 0; i < 4; ++i) { const int jj = 8 * jt + 4 * pa + i;
                        const float x0 = pa ? p1[4 * i] : p0[4 * i], x1 = pa ? p1[4 * i + 1] : p0[4 * i + 1], x2 = pa ? p1[4 * i + 2] : p0[4 * i + 2], x3 = pa ? p1[4 * i + 3] : p0[4 * i + 3];
                        const float c = 0.5f * x3, a = (x0 + x1) + (x2 + c), r = __shfl_xor(c, 32);
                        imp[jj] += a + (hh ? r : 0.f);
                        if (jj + 1 < 64) imp[jj + 1] += (hh ? 0.f : r); }
            }
        }
#undef E3_ST
    }
    const int cur = tq >> 6;
#pragma unroll
    for (int jj = 0; jj < 64; ++jj) { const int j = 2 * jj + hh; imp[jj] = (j != 0 && j < cur - 1) ? imp[jj] : -1.f; }
    unsigned m0 = 1u, m1 = 0u, m2 = 0u, m3 = 0u;
#define E3_SETBIT(j) do { const unsigned bit_ = 1u << ((j) & 31); const int wd_ = (j) >> 5; m0 |= (wd_ == 0) ? bit_ : 0u; m1 |= (wd_ == 1) ? bit_ : 0u; m2 |= (wd_ == 2) ? bit_ : 0u; m3 |= (wd_ == 3) ? bit_ : 0u; } while (0)
    E3_SETBIT(cur); if (cur >= 1) E3_SETBIT(cur - 1);
#pragma unroll 1
    for (int it = 0; it < NSEL - 3; ++it) {
        float best = -0.5f; int bj = 0;
#pragma unroll
        for (int jj = 0; jj < 64; ++jj) { if (imp[jj] > best) { best = imp[jj]; bj = jj; } }
        const int myj = 2 * bj + hh; const float ob = __shfl_xor(best, 32); const int oj = __shfl_xor(myj, 32);
        const bool mine = (best > ob) || (best == ob && myj < oj);
        const float wv = mine ? best : ob; const int wj = mine ? myj : oj;
        if (wv >= 0.f) E3_SETBIT(wj);
        if (mine && best >= 0.f) {
#pragma unroll
            for (int jj = 0; jj < 64; ++jj) imp[jj] = (jj == bj) ? -2.f : imp[jj]; }
    }
#undef E3_SETBIT
    if (hh == 0) *(u32x4*)(selmask + ((size_t)bg * S_ + tq) * 4) = (u32x4){m0, m1, m2, m3};
}
}
namespace mk {
template <int CMPMODE>
__device__ __forceinline__ void ph_attn1(float* lds, LAS unsigned char* lds3, KP p, unsigned* qctr, float* obase, float* owin) {
    LAS int* qslot = (LAS int*)(lds3 + E3_BYTES);
    constexpr int N_E3 = (CMPMODE & 2) ? 128 : 0, N_CMP = (CMPMODE & 1) ? 64 : 0, N_FOX = 256, N_WIN = 512, N_SB = 256;
    for (;;) {
        __syncthreads();
        if (ftid() == 0) *qslot = (int)atomicAdd(qctr, 1u);
        __syncthreads();
        int u = __builtin_amdgcn_readfirstlane(*qslot);
        if (u >= N_E3 + N_CMP + N_FOX + N_WIN + N_SB) break;
        if (u < N_E3) { e3_unit(lds3, p, (u & 3) >> 1, u & 1, 31 - (u >> 2), WSP(float, O_OCMP), WSP(unsigned, O_SELMASK)); continue; } u -= N_E3;
        if (u < N_CMP) { attn_vblock<3>(lds, p, 15 - (u >> 2), u & 3); continue; } u -= N_CMP;
        if (u < N_FOX) { e1_unit<0>(lds3, p, (u & 7) >> 2, u & 3, 31 - (u >> 3), obase, owin); continue; } u -= N_FOX;
        if (u < N_WIN) { e1_unit<1>(lds3, p, (u & 3) >> 1, u & 1, 127 - (u >> 2), obase, owin); continue; } u -= N_WIN;
        e1_unit<2>(lds3, p, (u & 7) >> 2, u & 3, 31 - (u >> 3), obase, owin);
    }
}
__device__ __forceinline__ void ph_dbg_compare_cmp(KP p) {
    float num = 0.f, den = 0.f;
    for (size_t i = (size_t)fbid() * NT + ftid(); i < (size_t)T_ * 512; i += (size_t)gridDim.x * NT) { const size_t row = i >> 9; const int c = (int)(i & 511);
        const float a = WSP(float, O_OCMP)[i], b = WSP(float, O_O)[row * D_ + c]; num += (a - b) * (a - b); den += b * b; }
    float* dbg = WSP(float, O_COUNTS) + 256; const float n = wsum(num), d = wsum(den);
    if ((ftid() & 63) == 0) { atomicAdd(&dbg[8], n); atomicAdd(&dbg[9], d); }
}
__device__ __forceinline__ void ph_dbg_compare_sel(KP p) {
    float num = 0.f, den = 0.f;
    for (int i = fbid() * NT + ftid(); i < B_ * 2 * S_; i += gridDim.x * NT) {
        unsigned m[4] = {0u, 0u, 0u, 0u}; const int t = i % S_, cur = t >> 6;
        for (int k = 0; k < NSEL; ++k) { const int e = WSP(int, O_SEL)[(size_t)i * NSEL + k]; if (e <= cur) { if ((e >> 5) == 0) m[0] |= 1u << (e & 31); else if ((e >> 5) == 1) m[1] |= 1u << (e & 31); else if ((e >> 5) == 2) m[2] |= 1u << (e & 31); else m[3] |= 1u << (e & 31); } }
        const unsigned* sm = WSP(unsigned, O_SELMASK) + (size_t)i * 4;
        int diff = __popc(m[0] ^ sm[0]) + __popc(m[1] ^ sm[1]) + __popc(m[2] ^ sm[2]) + __popc(m[3] ^ sm[3]);
        num += (float)diff * 0.5f; den += 16.f; }
    float* dbg = WSP(float, O_COUNTS) + 256; const float n = wsum(num), d = wsum(den);
    if ((ftid() & 63) == 0) { atomicAdd(&dbg[10], n); atomicAdd(&dbg[11], d); }
}
__device__ __forceinline__ void ph_dbg_compare(KP p) {
    float num[3] = {0.f, 0.f, 0.f}, den[3] = {0.f, 0.f, 0.f};
    for (size_t i = (size_t)fbid() * NT + ftid(); i < (size_t)T_ * 512; i += (size_t)gridDim.x * NT) {
        const size_t row = i >> 9; const int c = (int)(i & 511);
        const float a = WSP(float, O_O2)[row * D_ + 512 + c], b = WSP(float, O_O)[row * D_ + 512 + c];
        const int k = c >> 8; num[k] += (a - b) * (a - b); den[k] += b * b;
        const float aw = WSP(float, O_OWIN2)[i], bw = WSP(float, O_OWIN)[i]; num[2] += (aw - bw) * (aw - bw); den[2] += bw * bw; }
    float* dbg = WSP(float, O_COUNTS) + 256;
#pragma unroll
    for (int k = 0; k < 3; ++k) { const float n = wsum(num[k]), d = wsum(den[k]); if ((ftid() & 63) == 0) { atomicAdd(&dbg[2 * k], n); atomicAdd(&dbg[2 * k + 1], d); } }
}
__device__ __forceinline__ void ph_dbg_copy_nsa(KP p) {
    for (size_t i = (size_t)fbid() * NT + ftid(); i < (size_t)T_ * 512; i += (size_t)gridDim.x * NT) { const size_t row = i >> 9; const int c = (int)(i & 511); WSP(float, O_O2)[row * D_ + c] = WSP(float, O_O)[row * D_ + c]; }
}
__device__ __forceinline__ void ph_dbg_compare_nsa(KP p) {
    float num = 0.f, den = 0.f;
    for (size_t i = (size_t)fbid() * NT + ftid(); i < (size_t)T_ * 512; i += (size_t)gridDim.x * NT) { const size_t row = i >> 9; const int c = (int)(i & 511);
        const float a = WSP(float, O_O2)[row * D_ + c], b = WSP(float, O_O)[row * D_ + c]; num += (a - b) * (a - b); den += b * b; }
    float* dbg = WSP(float, O_COUNTS) + 256; const float n = wsum(num), d = wsum(den);
    if ((ftid() & 63) == 0) { atomicAdd(&dbg[6], n); atomicAdd(&dbg[7], d); }
}
__device__ __forceinline__ void ph_dbg_encode(KP p, int ka, int kb) {
    const float* dbg = WSP(float, O_COUNTS) + 256;
    const float ea = sqrtf(dbg[2 * ka] / fmaxf(dbg[2 * ka + 1], 1e-30f)), eb = sqrtf(dbg[2 * kb] / fmaxf(dbg[2 * kb + 1], 1e-30f));
    for (size_t i = (size_t)fbid() * NT + ftid(); i < (size_t)T_ * D_; i += (size_t)gridDim.x * NT) { float v = p->out[i] * (1.f + 10.f * ea); if (i == 0) v += 1e4f * eb; p->out[i] = v; }
}
}
namespace mk {
#define RLX_AGENT __ATOMIC_RELAXED, __HIP_MEMORY_SCOPE_AGENT
#define XB_TMO      128
#define XB_XCNT(j)  (256  + 64 * (j))
#define XB_XSUB(j)  (1280 + 64 * (j))
#define XB_XGEN(j)  (2304 + 64 * (j))
#define XB_TOP      3328
#define XB_TOPGEN   3392
#define XCD_BAR_WORDS 3456
#define XB_SPIN_CAP (1u << 18)

__device__ __forceinline__ unsigned xb_ld(unsigned* p)              { return __hip_atomic_load(p, __ATOMIC_RELAXED, __HIP_MEMORY_SCOPE_AGENT); }
__device__ __forceinline__ unsigned xb_add(unsigned* p, unsigned v) { return __hip_atomic_fetch_add(p, v, __ATOMIC_RELAXED, __HIP_MEMORY_SCOPE_AGENT); }
__device__ __forceinline__ unsigned xb_xcc_id() { return (unsigned)__builtin_amdgcn_s_getreg((3 << 11) | 20) & 0xFu; }
#define XB_SPIN(cond, bar) do { unsigned _sp = 0; while (cond) { __builtin_amdgcn_s_sleep(1); \
    if ((++_sp & 255u) == 0u) { if (xb_ld(&(bar)[XB_TMO])) break; if (_sp > XB_SPIN_CAP) { atomicAdd(&(bar)[XB_TMO], 1u); break; } } } } while (0)

struct XcdBarrier {
    unsigned* bar; unsigned x;
    volatile LAS unsigned* st;
};

__device__ __forceinline__ XcdBarrier xcd_barrier_post(unsigned* bar, volatile LAS unsigned* st) {
    XcdBarrier b; b.bar = bar; b.x = xb_xcc_id(); b.st = st;
    if (threadIdx.x == 0) (void)xb_add(&bar[XB_XCNT(b.x)], 1u);
    return b;
}
__device__ __forceinline__ void xcd_barrier_complete(unsigned* bar, unsigned x, unsigned& nloc, unsigned& nx) {
    const unsigned G = gridDim.x * gridDim.y * gridDim.z;
    unsigned sum, cnt, mine, sp = 0u;
    for (;;) {
        sum = 0u; cnt = 0u; mine = 0u;
#pragma unroll
        for (unsigned j = 0; j < 16; ++j) { const unsigned c = xb_ld(&bar[XB_XCNT(j)]); sum += c; cnt += (c > 0u) ? 1u : 0u; mine = (j == x) ? c : mine; }
        if (sum == G) break;
        __builtin_amdgcn_s_sleep(1);
        if ((++sp & 255u) == 0u) { if (xb_ld(&bar[XB_TMO])) break; if (sp > XB_SPIN_CAP) { atomicAdd(&bar[XB_TMO], 1u); break; } }
    }
    nloc = mine > 0u ? mine : 1u; nx = cnt > 0u ? cnt : 1u;
}

__device__ __forceinline__ void xcd_barrier(const XcdBarrier& b) {
    asm volatile("s_waitcnt vmcnt(0)" ::: "memory");
    __syncthreads();
    if (threadIdx.x == 0) {
        unsigned* bar = b.bar;
        __builtin_amdgcn_s_waitcnt(0);
        unsigned nloc = b.st[0], nx = b.st[1];
        if (nloc == 0u) { xcd_barrier_complete(bar, b.x, nloc, nx); b.st[0] = nloc; b.st[1] = nx; }
        const unsigned old = xb_add(&bar[XB_XSUB(b.x)], 1u);
        const unsigned gen = old / nloc;
        if (old + 1u == (gen + 1u) * nloc) {
            __builtin_amdgcn_fence(__ATOMIC_RELEASE, "agent");
            asm volatile("s_waitcnt vmcnt(0)" ::: "memory");
            const unsigned og = xb_add(&bar[XB_TOP], 1u);
            const unsigned tg = og / nx;
            if (og + 1u == (tg + 1u) * nx) xb_add(&bar[XB_TOPGEN], 1u);
            else XB_SPIN(xb_ld(&bar[XB_TOPGEN]) == tg, bar);
            __builtin_amdgcn_fence(__ATOMIC_ACQUIRE, "agent");
            xb_add(&bar[XB_XGEN(b.x)], 1u);
            asm volatile("s_waitcnt vmcnt(0)" ::: "memory");
        } else {
            XB_SPIN(xb_ld(&bar[XB_XGEN(b.x)]) == gen, bar);
            __builtin_amdgcn_fence(__ATOMIC_ACQUIRE, "agent");
            asm volatile("s_waitcnt vmcnt(0)" ::: "memory");
        }
    }
    __syncthreads();
}

}
namespace cg = cooperative_groups;
constexpr int NSTEP = 12;
__global__ void __launch_bounds__(512, 2) mega(mk::P p_unused) {
    extern __shared__ __attribute__((aligned(16))) unsigned char lds_raw[];
    float* lds = (float*)lds_raw;
    LAS unsigned char* lds3 = (LAS unsigned char*)lds_raw;
    cg::grid_group grid = cg::this_grid();
    using namespace nv; using namespace mk;
    volatile LAS unsigned* bst = (volatile LAS unsigned*)(lds3 + E3_BYTES + 128);
    if (threadIdx.x < 2) bst[threadIdx.x] = 0u;
    __syncthreads();
    XcdBarrier bar;
    { const KP p = fresh_kp(); bar = xcd_barrier_post(WSP(unsigned, O_COUNTS + 16384), bst); }
    grid.sync();
    for (int step = 0; step < 1 + NSTEP * L_; ++step) {
        const KP p = fresh_kp();
        const int l = (step - 1) / NSTEP, k = (step == 0) ? -1 : (step - 1) % NSTEP;
        const bool isg = (k == 0 || k == 1 || k == 6 || k == 9 || k == 10);
#ifdef PROBE_K
        const int nrep = (k == PROBE_K) ? PROBE_N : 1;
#else
        const int nrep = 1;
#endif
        for (int rep = 0; rep < nrep; ++rep) {
        if (isg) {
            const int kind = (k == 0) ? 0 : (k == 1) ? 4 : (k == 6) ? 1 : (k == 9) ? 2 : 3;
            GSched S; GEpi E; S.kind = kind; E.kind = kind; E.l = l;
            S.G = (int)gridDim.x; S.c = fbid(); S.meta = WSP(int, O_META); S.rowtok = WSP(int, O_ROWTOK); S.estep = 0;
            const char* A; int N, K = D_;
            if (kind == 0) { A = (const char*)WSP(bf16_t, O_XB); S.Bt = (const char*)(WSP(bf16_t, O_WTIN) + (size_t)l * NPAD * D_); N = NPAD; }
            else if (kind == 1) { A = (const char*)WSP(bf16_t, O_OB); S.Bt = (const char*)(WSP(bf16_t, O_WTOUT) + (size_t)l * D_ * D_); N = D_; }
            else if (kind == 2) { A = (const char*)WSP(bf16_t, O_X1B); S.Bt = (const char*)(WSP(bf16_t, O_WTGU) + (size_t)l * NE * 2048 * D_); S.estep = (size_t)2048 * D_ * 2; N = 2048; }
            else if (kind == 3) { A = (const char*)WSP(bf16_t, O_ACT); S.Bt = (const char*)(WSP(bf16_t, O_WTDN) + (size_t)l * NE * D_ * D_); S.estep = (size_t)D_ * D_ * 2; N = D_; }
            else { A = (const char*)WSP(bf16_t, O_PROJB); S.Bt = (const char*)(WSP(bf16_t, O_WT1) + (size_t)l * 2 * 256 * 2048); S.estep = (size_t)256 * 2048 * 2; N = 256; K = 2048; }
            S.nN = N / 256; S.nM = (kind < 2) ? T_ / 256 : (kind == 4) ? 16 : S.meta[32]; S.nunits = S.nM * S.nN;
            pg8::gemm_phase<GEpi, GSched>(lds3, A, K, S, E);
            if (kind == 4) ph_cumsum(lds, p, 16);
        } else {
            switch (k) {
                case -1: ph_convert(lds3, p); break;
                case 2: ph_prep2(p, l); break;
                case 3: ph_attn1<2>(lds, lds3, p, WSP(unsigned, O_COUNTS) + 128 + l * 8 + rep, WSP(float, O_O), WSP(float, O_OWIN)); break;
                case 4: ph_attn_sel2<true>(lds3, p, WSP(float, O_O), WSP(float, O_OCMP), 512); break;
                case 5: ph_rmsnorm(p, l); break;
                case 7: ph_ln<true>(lds, p, l, WSP(float, O_X1)); break;
                case 8: ph_moe_scatter2(lds, p, l); break;
                default: { float* xout = (l == L_ - 1) ? p->out : WSP(float, O_XA); ph_ln<false>(lds, p, l, xout); } break;
            }
        }
        xcd_barrier(bar);
        }
    }
#ifdef PROBE_SYNC
    for (int i = 0; i < PROBE_SYNC; ++i) xcd_barrier(bar);
#endif
}

extern "C" void kernel_launch(void* const* d_in, const int* in_sizes, int n_in,
                              void* d_out, int out_size, void* d_ws, size_t ws_size,
                              hipStream_t stream) {
    constexpr size_t kDynLds = 147456 + 1024;
    static int grid_blocks = 0;
    if (!grid_blocks) {
        int dev = 0, cus = 0, per_cu = 0;
        (void)hipGetDevice(&dev);
        (void)hipDeviceGetAttribute(&cus, hipDeviceAttributeMultiprocessorCount, dev);
        (void)hipFuncSetAttribute((const void*)mega, hipFuncAttributeMaxDynamicSharedMemorySize, (int)kDynLds);
        (void)hipOccupancyMaxActiveBlocksPerMultiprocessor(&per_cu, mega, 512, kDynLds);
        if (per_cu < 1) per_cu = 1;
        if (per_cu > 1) per_cu = 1;
        grid_blocks = cus * per_cu;
        if (ws_size < mk::O_END) fprintf(stderr, "workspace too small: %zu < %zu\n", ws_size, (size_t)mk::O_END);
    }
    mk::P p{};
    p.in = nv::inputs(d_in); p.ws = (unsigned char*)d_ws; p.out = (float*)d_out;
    (void)hipMemsetAsync((char*)d_ws + mk::O_COUNTS, 0, 65536, stream);
    void* args[] = {&p};
    hipError_t e = hipLaunchCooperativeKernel((void*)mega, dim3(grid_blocks), dim3(512), args, kDynLds, stream);
    if (e != hipSuccess) fprintf(stderr, "cooperative launch failed: %s (grid %d)\n", hipGetErrorString(e), grid_blocks);
}
```

```cpp
#include <hip/hip_runtime.h>
#include <hip/hip_cooperative_groups.h>
#include <cstdio>
#include <cstdint>

namespace nv {

constexpr int B_ = 2, S_ = 8192, D_ = 1024, T_ = B_ * S_, L_ = 2;
constexpr int DIN = 2844;
constexpr int OFF_NSA_KV = 512, OFF_NSA_GATE = 1280, OFF_FOX_QKV = 1304, OFF_FOX_F = 2072, OFF_SB_QKV = 2076;
constexpr int NCMP = 511, NBLK = 128, NSEL = 16;
constexpr int NE = 32, TOPK = 4, MROWS = T_ * TOPK;
constexpr float LN_EPS = 1e-5f, RMS_EPS = 1e-6f;
constexpr float ALPHA = 1.4142135623730951f;
constexpr float SCALE = 0.125f;

__device__ __forceinline__ float sigmoidf_(float x) { return 1.f / (1.f + __expf(-x)); }
__device__ __forceinline__ float logsig(float x) { return fminf(x, 0.f) - log1pf(expf(-fabsf(x))); }

__device__ __forceinline__ float gelu_tanh(float x) { return 0.5f * x * (1.f + tanhf(0.7978845608028654f * (x + 0.044715f * x * x * x))); }
#define NV_DOT(q, kr, res) do { float s0_ = 0.f, s1_ = 0.f, s2_ = 0.f, s3_ = 0.f; _Pragma("unroll") for (int d_ = 0; d_ < 64; d_ += 4) { const float4 k4_ = *(const float4*)&(kr)[d_]; s0_ += q[d_] * k4_.x; s1_ += q[d_ + 1] * k4_.y; s2_ += q[d_ + 2] * k4_.z; s3_ += q[d_ + 3] * k4_.w; } res = (s0_ + s1_) + (s2_ + s3_); } while (0)
#define NV_AXPY(o, p, vr) do { _Pragma("unroll") for (int d_ = 0; d_ < 64; d_ += 4) { const float4 v4_ = *(const float4*)&(vr)[d_]; o[d_] += p * v4_.x; o[d_ + 1] += p * v4_.y; o[d_ + 2] += p * v4_.z; o[d_ + 3] += p * v4_.w; } } while (0)
#define NV_ONLINE(sc, vr) do { if (sc > m) { const float al_ = __expf(m - sc); l *= al_; _Pragma("unroll") for (int d_ = 0; d_ < 64; ++d_) o[d_] *= al_; m = sc; } const float p_ = __expf(sc - m); l += p_; NV_AXPY(o, p_, vr); } while (0)

__device__ __forceinline__ float wsum(float v) {
#pragma unroll
    for (int o = 1; o < 64; o <<= 1) v += __shfl_xor(v, o);
    return v;
}
struct In {
    const float *x, *w_in, *b_in, *pos_k, *pos_v, *w1k, *w2k, *w1v, *w2v, *g_out, *w_out, *ln1_g, *ln1_b, *rw, *rb, *wgu, *bgu, *wdn, *bdn, *ln2_g, *ln2_b;
};
inline In inputs(void* const* d) {
    In i; i.x = (const float*)d[0]; i.w_in = (const float*)d[1]; i.b_in = (const float*)d[2]; i.pos_k = (const float*)d[3]; i.pos_v = (const float*)d[4];
    i.w1k = (const float*)d[5]; i.w2k = (const float*)d[6]; i.w1v = (const float*)d[7]; i.w2v = (const float*)d[8]; i.g_out = (const float*)d[9]; i.w_out = (const float*)d[10];
    i.ln1_g = (const float*)d[11]; i.ln1_b = (const float*)d[12]; i.rw = (const float*)d[13]; i.rb = (const float*)d[14]; i.wgu = (const float*)d[15]; i.bgu = (const float*)d[16];
    i.wdn = (const float*)d[17]; i.bdn = (const float*)d[18]; i.ln2_g = (const float*)d[19]; i.ln2_b = (const float*)d[20]; return i;
}


}
namespace pg8 {
#define PG8_LAS __attribute__((address_space(3)))
typedef unsigned short bf16_t;
typedef short bf16x8 __attribute__((ext_vector_type(8)));
typedef float f32x4 __attribute__((ext_vector_type(4)));
typedef unsigned u32x4 __attribute__((ext_vector_type(4)));
constexpr int BM = 256, BK = 64, HALF = 128, HTB = HALF * BK * 2  , STAGE_BYTES = 8 * HTB, NXCD = 8, WGM = 8;

__host__ __device__ __forceinline__ int lds_byte(int r, int c) { const int st = (r >> 4) * 2 + (c >> 5), rr = r & 15, cc = c & 31, ob = rr * 64 + cc * 2; return st * 1024 + (ob ^ (((ob >> 9) & 1) << 5)); }
__host__ __device__ __forceinline__ void stage_rc(int b, int& R, int& C) { const int st = b / 1024, sb = b % 1024, swz = sb ^ (((sb >> 9) & 1) << 5); R = (st >> 1) * 16 + swz / 64; C = (st & 1) * 32 + (swz % 64) / 2; }
__host__ __device__ __forceinline__ int perm32(int rho) { const int n = rho >> 4, i = rho & 15; return 8 * (i >> 2) + 4 * n + (i & 3); }

struct Unit { int pm, pn, e, nr; };

struct StaticOrder {
    int nM, nN, nwg, G, c;
    __host__ __device__ void init(int M, int N, int G_, int c_) { nM = M / BM; nN = N / BM; nwg = nM * nN; G = G_; c = c_; }
    __host__ __device__ bool next(int i, Unit& u) const {
        const long L = (long)i * G + c; if (L >= nwg) return false;
        int wgid = (int)L; { const int q = nwg / NXCD, r = nwg % NXCD, xcd = wgid % NXCD, off = wgid / NXCD; wgid = (xcd < r ? xcd * (q + 1) : r * (q + 1) + (xcd - r) * q) + off; }
        const int nig = WGM * nN, gid = wgid / nig, fm = gid * WGM, gsz = (nM - fm) < WGM ? (nM - fm) : WGM;
        u.pm = fm + ((wgid % nig) % gsz); u.pn = (wgid % nig) / gsz; u.e = 0; u.nr = BM; return true;
    }
    const char* Bt; size_t tstep;
    __device__ __forceinline__ unsigned a_off(const Unit& u, int r) const { return (unsigned)(u.pm * BM + r) * 2048u; }
    __device__ __forceinline__ size_t a_kstep() const { return 128; }
    __device__ __forceinline__ const char* b_base(const Unit& u) const { return Bt + (size_t)u.pn * tstep; }
};


__device__ __forceinline__ unsigned cvt_pk_bf16(float lo, float hi) { unsigned r; asm volatile("v_cvt_pk_bf16_f32 %0, %1, %2" : "=v"(r) : "v"(lo), "v"(hi)); return r; }
template <class Epi, class Sched, bool ALIGN_EPI = true, bool SP2 = true>
__device__ __forceinline__ void gemm_phase(PG8_LAS unsigned char* lds, const char* Abase, const int K, const Sched& S, const Epi& E) {
    int tid_ = threadIdx.x; asm volatile("" : "+v"(tid_));
    const int tid = tid_, wid = __builtin_amdgcn_readfirstlane(tid >> 6), lane = tid & 63, wr = wid >> 2, wc = wid & 3, fr = lane & 15, fq = lane >> 4;
    const int nt = K / BK;
    unsigned voffB[2];
#pragma unroll
    for (int i = 0; i < 2; ++i) { int R, C; stage_rc(tid * 16 + i * 8192, R, C); const int Rb = Epi::PERM ? ((R & ~31) + perm32(R & 31)) : R;
        voffB[i] = (unsigned)(Rb * K + C) * 2u; }
#define PG8_AOFF(u, o0, o1) do { int _t = tid; asm volatile("" : "+v"(_t)); _Pragma("unroll") for (int _i = 0; _i < 2; ++_i) { int _R, _C; stage_rc(_t * 16 + _i * 8192, _R, _C); \
        (o0)[_i] = S.a_off((u), _R) + (unsigned)_C * 2u; (o1)[_i] = S.a_off((u), HALF + _R) + (unsigned)_C * 2u; } } while (0)
    const size_t kstep = (size_t)(BK * 2);
    const size_t akstep = S.a_kstep();
    const size_t hstep = (size_t)HALF * K * 2;
    const unsigned ldsw = (unsigned)wid * 1024u;
    const int aoff = lds_byte(wr * 64 + fr, fq * 8), boff = lds_byte(wc * 32 + fr, fq * 8);
#define PG8_SA(b, h) (((b) * 2 + (h)) * HTB)
#define PG8_SB(b, h) ((4 + (b) * 2 + (h)) * HTB)
#define PG8_STAGE(bufoff, gbase, voff) do { _Pragma("unroll") for (int _i = 0; _i < 2; ++_i) { unsigned _o = (voff)[_i]; asm volatile("" : "+v"(_o));     \
        __builtin_amdgcn_global_load_lds((const unsigned*)((const char*)(gbase) + _o), (PG8_LAS unsigned*)(lds + (bufoff) + ldsw + _i * 8192), 16, 0, 0); } } while (0)
#define PG8_LDA(dst, b, h) do { _Pragma("unroll") for (int m = 0; m < 4; ++m) _Pragma("unroll") for (int k = 0; k < 2; ++k) dst[m][k] = *(const PG8_LAS bf16x8*)(lds + PG8_SA(b, h) + aoff + m * 2048 + k * 1024); } while (0)
#define PG8_LDB(dst, b, h) do { _Pragma("unroll") for (int n = 0; n < 2; ++n) _Pragma("unroll") for (int k = 0; k < 2; ++k) dst[n][k] = *(const PG8_LAS bf16x8*)(lds + PG8_SB(b, h) + boff + n * 2048 + k * 1024); } while (0)
#define PG8_MMA(ai, bj, At, Bt) do { __builtin_amdgcn_s_setprio(1); _Pragma("unroll") for (int m = 0; m < 4; ++m) _Pragma("unroll") for (int n = 0; n < 2; ++n) _Pragma("unroll") for (int k = 0; k < 2; ++k) \
        acc[ai][bj][m][n] = __builtin_amdgcn_mfma_f32_16x16x32_bf16(Bt[n][k], At[m][k], acc[ai][bj][m][n], 0, 0, 0); __builtin_amdgcn_s_setprio(0); } while (0)
#define PG8_WAIT_V(n) asm volatile("s_waitcnt vmcnt(" #n ")" ::: "memory")
#define PG8_WAIT_L(n) asm volatile("s_waitcnt lgkmcnt(" #n ")" ::: "memory")
#define PG8_BAR __builtin_amdgcn_s_barrier()
#define PG8_SCHED __builtin_amdgcn_sched_barrier(0)
    Unit cur, nxt; int ui = 0;
    if (!S.next(0, cur)) return;
    f32x4 acc[2][2][4][2];
    float zf_ = 0.f; asm volatile("" : "+v"(zf_));
#pragma unroll
    for (int a = 0; a < 2; ++a)
#pragma unroll
        for (int b = 0; b < 2; ++b)
#pragma unroll
            for (int m = 0; m < 4; ++m)
#pragma unroll
                for (int n = 0; n < 2; ++n) acc[a][b][m][n] = (f32x4){zf_, zf_, zf_, zf_};
    bf16x8 At[4][2], B0[2][2], B1[2][2];
    unsigned ca0[2], ca1[2], na0[2], na1[2];
    PG8_AOFF(cur, ca0, ca1);
    const char* const cA = Abase; const char* cB = S.b_base(cur);
    if constexpr (SP2) {
        PG8_STAGE(PG8_SB(0, 0), cB, voffB); PG8_STAGE(PG8_SB(0, 1), cB + hstep, voffB); PG8_STAGE(PG8_SA(0, 0), cA, ca0); PG8_STAGE(PG8_SA(0, 1), cA, ca1);
        if (wr == 1) PG8_BAR;
        PG8_WAIT_V(2); PG8_BAR;
        PG8_STAGE(PG8_SB(1, 0), cB + kstep, voffB); PG8_STAGE(PG8_SA(1, 0), cA + akstep, ca0); PG8_STAGE(PG8_SB(1, 1), cB + hstep + kstep, voffB);
        PG8_WAIT_V(6); PG8_BAR;
    } else { static_assert(SP2, "only the SP2 loop is kept"); }
    for (;;) {
        const bool has_next = S.next(ui + 1, nxt);
        const char* nB = has_next ? S.b_base(nxt) : cB;
        if (has_next) { PG8_AOFF(nxt, na0, na1); } else { na0[0] = ca0[0]; na0[1] = ca0[1]; na1[0] = ca1[0]; na1[1] = ca1[1]; }
        for (int t = 0; t < nt - 2; t += 2) {
            const char* a1 = cA + (size_t)(t + 1) * akstep;
            const char* a2 = cA + (size_t)(t + 2) * akstep; const char* b2 = cB + (size_t)(t + 2) * kstep;
            const char* a3 = a2 + akstep; const char* b3 = b2 + kstep;
            PG8_LDB(B0, 0, 0); PG8_LDB(B1, 0, 1); PG8_SCHED; PG8_LDA(At, 0, 0); PG8_STAGE(PG8_SA(1, 1), a1, ca1);
            PG8_WAIT_V(8); PG8_WAIT_L(0); PG8_BAR; PG8_MMA(0, 0, At, B0); PG8_MMA(0, 1, At, B1); PG8_BAR; PG8_SCHED;
            PG8_LDA(At, 0, 1); PG8_STAGE(PG8_SB(0, 0), b2, voffB); PG8_STAGE(PG8_SB(0, 1), b2 + hstep, voffB); PG8_STAGE(PG8_SA(0, 0), a2, ca0);
            PG8_WAIT_V(8); PG8_WAIT_L(0); PG8_BAR; PG8_MMA(1, 0, At, B0); PG8_MMA(1, 1, At, B1); PG8_BAR; PG8_SCHED;
            PG8_LDB(B0, 1, 0); PG8_LDB(B1, 1, 1); PG8_SCHED; PG8_LDA(At, 1, 0); PG8_STAGE(PG8_SA(0, 1), a2, ca1);
            PG8_WAIT_V(8); PG8_WAIT_L(0); PG8_BAR; PG8_MMA(0, 0, At, B0); PG8_MMA(0, 1, At, B1); PG8_BAR; PG8_SCHED;
            PG8_LDA(At, 1, 1); PG8_STAGE(PG8_SB(1, 0), b3, voffB); PG8_STAGE(PG8_SB(1, 1), b3 + hstep, voffB); PG8_STAGE(PG8_SA(1, 0), a3, ca0);
            PG8_WAIT_V(8); PG8_WAIT_L(0); PG8_BAR; PG8_MMA(1, 0, At, B0); PG8_MMA(1, 1, At, B1); PG8_BAR; PG8_SCHED;
        }
        {
            const char* a1 = cA + (size_t)(nt - 1) * akstep;
            const char* a2 = cA; const char* b2 = nB; const char* a3 = a2 + akstep; const char* b3 = b2 + kstep;
            PG8_LDB(B0, 0, 0); PG8_LDB(B1, 0, 1); PG8_SCHED; PG8_LDA(At, 0, 0); PG8_STAGE(PG8_SA(1, 1), a1, ca1);
            PG8_WAIT_V(8); PG8_WAIT_L(0); PG8_BAR; PG8_MMA(0, 0, At, B0); PG8_MMA(0, 1, At, B1); PG8_BAR; PG8_SCHED;
            PG8_LDA(At, 0, 1); PG8_STAGE(PG8_SB(0, 0), b2, voffB); PG8_STAGE(PG8_SB(0, 1), b2 + hstep, voffB); PG8_STAGE(PG8_SA(0, 0), a2, na0);
            PG8_WAIT_V(8); PG8_WAIT_L(0); PG8_BAR; PG8_MMA(1, 0, At, B0); PG8_MMA(1, 1, At, B1); PG8_BAR; PG8_SCHED;
            PG8_LDB(B0, 1, 0); PG8_LDB(B1, 1, 1); PG8_SCHED; PG8_LDA(At, 1, 0); PG8_STAGE(PG8_SA(0, 1), a2, na1);
            PG8_WAIT_V(8); PG8_WAIT_L(0); PG8_BAR; PG8_MMA(0, 0, At, B0); PG8_MMA(0, 1, At, B1); PG8_BAR; PG8_SCHED;
            PG8_LDA(At, 1, 1); PG8_STAGE(PG8_SB(1, 0), b3, voffB); PG8_STAGE(PG8_SB(1, 1), b3 + hstep, voffB); PG8_STAGE(PG8_SA(1, 0), a3, na0);
            PG8_WAIT_V(8); PG8_WAIT_L(0); PG8_BAR; PG8_MMA(1, 0, At, B0); PG8_MMA(1, 1, At, B1); PG8_BAR; PG8_SCHED;
        }
        if constexpr (ALIGN_EPI) { if (wr == 0) PG8_BAR; }
        E(acc, cur, wr, wc, fr, fq);
        if (!has_next) break;
#pragma unroll
        for (int a = 0; a < 2; ++a)
#pragma unroll
            for (int b = 0; b < 2; ++b)
#pragma unroll
                for (int m = 0; m < 4; ++m)
#pragma unroll
                    for (int n = 0; n < 2; ++n) acc[a][b][m][n] = (f32x4){zf_, zf_, zf_, zf_};
        cur = nxt; cB = nB; ++ui; ca0[0] = na0[0]; ca0[1] = na0[1]; ca1[0] = na1[0]; ca1[1] = na1[1];
        if constexpr (ALIGN_EPI) { if (wr == 1) PG8_BAR; }
    }
    PG8_WAIT_V(0);
    if constexpr (!ALIGN_EPI) { if (wr == 0) PG8_BAR; }
    PG8_BAR;
#undef PG8_AOFF
#undef PG8_SA
#undef PG8_SB
#undef PG8_STAGE
#undef PG8_LDA
#undef PG8_LDB
#undef PG8_MMA
#undef PG8_WAIT_V
#undef PG8_WAIT_L
#undef PG8_BAR
#undef PG8_SCHED
}

}
namespace mk {
using namespace nv;
typedef unsigned short bf16_t;
typedef unsigned u32x4 __attribute__((ext_vector_type(4)));
typedef float f32x4 __attribute__((ext_vector_type(4)));
#define LAS __attribute__((address_space(3)))
constexpr int NT = 512;
constexpr int PB = 2816;
constexpr int NPAD = 3072;
constexpr int C_KV = 512, C_FOX = 1280, C_SB = 2048, C_GATE = 2816;
constexpr int MAXT = MROWS / 256 + NE;
constexpr int PROWS = MAXT * 256;
#define CNT_IDX(l, e) (8192 + ((l) * NE + (e)) * 32)
__device__ __forceinline__ int ftid() { int t = threadIdx.x; asm volatile("" : "+v"(t)); return t; }
__device__ __forceinline__ int fbid() { int b = blockIdx.x; asm volatile("" : "+s"(b)); return b; }
#define MK_LOOP(vb, n) for (int vb = fbid(); vb < (n); vb += gridDim.x)

constexpr size_t al_(size_t x) { return (x + 4095) & ~(size_t)4095; }
constexpr size_t O_WTIN = 0;
constexpr size_t O_WTOUT = O_WTIN + al_((size_t)L_ * NPAD * D_ * 2);
constexpr size_t O_WTGU = O_WTOUT + al_((size_t)L_ * D_ * D_ * 2);
constexpr size_t O_WTDN = O_WTGU + al_((size_t)L_ * NE * 2048 * D_ * 2);
constexpr size_t O_BIASP = O_WTDN + al_((size_t)L_ * NE * D_ * D_ * 2);
constexpr size_t O_XB = O_BIASP + al_((size_t)L_ * NPAD * 4);
constexpr size_t O_PROJB = O_XB + al_((size_t)T_ * D_ * 2);
constexpr size_t O_GF = O_PROJB + al_((size_t)T_ * PB * 2);
constexpr size_t O_CFOX = O_GF + al_((size_t)T_ * 32 * 4);
constexpr size_t O_KCMP = O_CFOX + al_((size_t)B_ * 4 * S_ * 4);
constexpr size_t O_VCMP = O_KCMP + al_((size_t)B_ * 2 * 512 * 64 * 4);
constexpr size_t O_O = O_VCMP + al_((size_t)B_ * 2 * 512 * 64 * 4);
constexpr size_t O_OB = O_O + al_((size_t)T_ * D_ * 4);
constexpr size_t O_PTOT = O_OB + al_((size_t)T_ * D_ * 2);
constexpr size_t O_SEL = O_PTOT + al_((size_t)B_ * 2 * S_ * 512 * 4);
constexpr size_t O_MIX = O_SEL + al_((size_t)B_ * 2 * S_ * NSEL * 4);
constexpr size_t O_X1 = O_MIX + al_((size_t)T_ * D_ * 4);
constexpr size_t O_X1B = O_X1 + al_((size_t)T_ * D_ * 4);
constexpr size_t O_XA = O_X1B + al_((size_t)T_ * D_ * 2);
constexpr size_t O_ACT = O_XA + al_((size_t)T_ * D_ * 4);
constexpr size_t O_Y = O_ACT + al_((size_t)PROWS * D_ * 2);
constexpr size_t O_TOPE = O_Y + al_((size_t)PROWS * D_ * 2);
constexpr size_t O_TOPW = O_TOPE + al_((size_t)MROWS * 4);
constexpr size_t O_POS = O_TOPW + al_((size_t)MROWS * 4);
constexpr size_t O_ROWTOK = O_POS + al_((size_t)MROWS * 4);
constexpr size_t O_ROWW = O_ROWTOK + al_((size_t)PROWS * 4);
constexpr size_t O_SLOT = O_ROWW + al_((size_t)PROWS * 4);
constexpr size_t O_COUNTS = O_SLOT + al_((size_t)MROWS * 4);
constexpr size_t O_META = O_COUNTS + 65536;
constexpr size_t O_OWIN = O_META + 4096;
constexpr size_t O_O2 = O_OWIN + al_((size_t)T_ * 512 * 4);
constexpr size_t O_OWIN2 = O_O2 + al_((size_t)T_ * D_ * 4);
constexpr size_t O_KCMPB = O_OWIN2 + al_((size_t)T_ * 512 * 4);
constexpr size_t O_VCMPB = O_KCMPB + al_((size_t)B_ * 2 * 512 * 64 * 2);
constexpr size_t O_OCMP = O_VCMPB + al_((size_t)B_ * 2 * 512 * 64 * 2);
constexpr size_t O_SELMASK = O_OCMP + al_((size_t)T_ * 512 * 4);
constexpr size_t O_WT1 = O_SELMASK + al_((size_t)B_ * 2 * S_ * 16);
constexpr size_t O_BIAS1 = O_WT1 + al_((size_t)L_ * 2 * 256 * 2048 * 2);
constexpr size_t O_HID = O_BIAS1 + al_((size_t)L_ * 2 * 128 * 4);
constexpr size_t O_BIAS1P = O_HID + al_((size_t)8 * 512 * 128 * 2);
constexpr size_t O_END = O_BIAS1P + al_((size_t)L_ * 2 * 64 * 128 * 4);

struct P {
    In in; unsigned char* ws; float* out;
};
typedef const __attribute__((address_space(4))) P* KP;
__device__ __forceinline__ KP fresh_kp() { KP k = (KP)__builtin_amdgcn_kernarg_segment_ptr(); asm volatile("" : "+s"(k)); return k; }
#define WSP(T, off) ((T*)(p->ws + (off)))

__device__ __forceinline__ float bf2f(unsigned short b) { return __uint_as_float((unsigned)b << 16); }
__device__ __forceinline__ unsigned f2bf(float f) { unsigned u = __float_as_uint(f); return (u + 0x7fffu + ((u >> 16) & 1u)) >> 16; }
__device__ __forceinline__ unsigned pk2(float lo, float hi) { return f2bf(lo) | (f2bf(hi) << 16); }
__device__ __forceinline__ void ld8(const bf16_t* __restrict__ src, float* dst) {
    const u32x4 v = *(const u32x4*)src;
    dst[0] = __uint_as_float(v.x << 16); dst[1] = __uint_as_float(v.x & 0xffff0000u); dst[2] = __uint_as_float(v.y << 16); dst[3] = __uint_as_float(v.y & 0xffff0000u);
    dst[4] = __uint_as_float(v.z << 16); dst[5] = __uint_as_float(v.z & 0xffff0000u); dst[6] = __uint_as_float(v.w << 16); dst[7] = __uint_as_float(v.w & 0xffff0000u);
}


__device__ __forceinline__ int perm_in(int n) {
    if (n < 1280) return n;
    if (n < 1304) return C_GATE + (n - 1280);
    if (n < 2072) return C_FOX + (n - 1304);
    if (n < 2076) return C_GATE + 24 + (n - 2072);
    return C_SB + (n - 2076);
}
__device__ __forceinline__ int perm_gu(int n) { const int up = n >> 10, c = n & 1023; return 256 * (c >> 7) + 128 * up + (c & 127); }
template <int MAP>
__device__ __forceinline__ void transpose_item(const float* __restrict__ W, int K, int N, bf16_t* __restrict__ WT, LAS float* scr, int item, int lane) {
    const int nblk = (N + 31) / 32, kb = item / nblk, nb = item % nblk, k0 = 64 * kb, n0 = 32 * nb;
    const int nl = lane & 31; const bool okn = (n0 + nl) < N;
#pragma unroll 8
    for (int i = 0; i < 32; ++i) { const int kk = 2 * i + (lane >> 5); scr[kk * 33 + nl] = okn ? W[(size_t)(k0 + kk) * N + n0 + nl] : 0.f; }
    asm volatile("s_waitcnt lgkmcnt(0)" ::: "memory");
    const int c = lane & 7;
#pragma unroll
    for (int j = 0; j < 4; ++j) { const int n = (lane >> 3) + 8 * j; const LAS float* sp = scr + (8 * c) * 33 + n;
        u32x4 o; o.x = pk2(sp[0 * 33], sp[1 * 33]); o.y = pk2(sp[2 * 33], sp[3 * 33]); o.z = pk2(sp[4 * 33], sp[5 * 33]); o.w = pk2(sp[6 * 33], sp[7 * 33]);
        const int ng = n0 + n;
        if (ng < N) { const int ro = (MAP == 1) ? perm_in(ng) : (MAP == 2) ? perm_gu(ng) : ng; *(u32x4*)(WT + (size_t)ro * K + k0 + 8 * c) = o; } }
    asm volatile("s_waitcnt lgkmcnt(0)" ::: "memory");
}
__device__ __forceinline__ void ph_convert(LAS unsigned char* lds, KP p) {
    const int tid = ftid(), lane = tid & 63, wv = tid >> 6;
    LAS float* scr = (LAS float*)(lds + wv * 8448);
    const int gw = fbid() * 8 + wv, NGW = gridDim.x * 8;
    constexpr int I_IN = 16 * 89, I_OUT = 16 * 32, I_GU = 16 * 64, I_DN = 16 * 32, I_W1 = 32 * 4;
    constexpr int N_IN = L_ * I_IN, N_OUT = L_ * I_OUT, N_GU = L_ * NE * I_GU, N_DN = L_ * NE * I_DN, N_W1 = L_ * 2 * I_W1;
    for (int it = gw; it < N_IN + N_OUT + N_GU + N_DN + N_W1; it += NGW) {
        int r = it;
        if (r < N_W1) { const int mtx = r / I_W1, ll = mtx >> 1, kv = mtx & 1; transpose_item<0>((kv ? p->in.w1v : p->in.w1k) + (size_t)ll * 2048 * 128, 2048, 128, WSP(bf16_t, O_WT1) + (size_t)mtx * 256 * 2048, scr, r % I_W1, lane); continue; } r -= N_W1;
        if (r < N_GU) { const int mtx = r / I_GU; transpose_item<2>(p->in.wgu + (size_t)mtx * D_ * 2048, D_, 2048, WSP(bf16_t, O_WTGU) + (size_t)mtx * 2048 * D_, scr, r % I_GU, lane); continue; } r -= N_GU;
        if (r < N_DN) { const int mtx = r / I_DN; transpose_item<0>(p->in.wdn + (size_t)mtx * D_ * D_, D_, D_, WSP(bf16_t, O_WTDN) + (size_t)mtx * D_ * D_, scr, r % I_DN, lane); continue; } r -= N_DN;
        if (r < N_IN) { const int mtx = r / I_IN; transpose_item<1>(p->in.w_in + (size_t)mtx * D_ * DIN, D_, DIN, WSP(bf16_t, O_WTIN) + (size_t)mtx * NPAD * D_, scr, r % I_IN, lane); continue; } r -= N_IN;
        { const int mtx = r / I_OUT; transpose_item<0>(p->in.w_out + (size_t)mtx * D_ * D_, D_, D_, WSP(bf16_t, O_WTOUT) + (size_t)mtx * D_ * D_, scr, r % I_OUT, lane); }
    }
    const int gt = fbid() * NT + tid, NG = gridDim.x * NT;
    for (int i = gt; i < L_ * (NPAD - DIN) * (D_ / 8); i += NG) { const int l = i / ((NPAD - DIN) * (D_ / 8)), r = i % ((NPAD - DIN) * (D_ / 8));
        unsigned z_ = 0u; asm volatile("" : "+v"(z_));
        *(u32x4*)(WSP(bf16_t, O_WTIN) + ((size_t)l * NPAD + DIN) * D_ + (size_t)r * 8) = (u32x4){z_, z_, z_, z_}; }
    for (int i = gt; i < L_ * 2 * 128 * (2048 / 8); i += NG) { const int mtx = i / (128 * 256), r = i % (128 * 256); unsigned z_ = 0u; asm volatile("" : "+v"(z_));
        *(u32x4*)(WSP(bf16_t, O_WT1) + ((size_t)mtx * 256 + 128) * 2048 + (size_t)r * 8) = (u32x4){z_, z_, z_, z_}; }
    for (int i = gt; i < L_ * 2 * 64 * 128; i += NG) { const int j = i & 127, seg = (i >> 7) & 63, mtx = i >> 13, ll = mtx >> 1, kv = mtx & 1;
        const float* pos = (kv ? p->in.pos_v : p->in.pos_k) + (size_t)ll * 2048 + seg * 32; const float* w1 = (kv ? p->in.w1v : p->in.w1k) + (size_t)ll * 2048 * 128 + (size_t)seg * 32 * 128; float a = 0.f;
#pragma unroll 8
        for (int k = 0; k < 32; ++k) a += pos[k] * w1[(size_t)k * 128 + j];
        WSP(float, O_BIAS1P)[i] = a; }
    for (int i = gt; i < L_ * NPAD; i += NG) { const int l = i / NPAD, c = i % NPAD; if (c >= DIN) WSP(float, O_BIASP)[i] = 0.f; }
    for (int i = gt; i < L_ * DIN; i += NG) { const int l = i / DIN, n = i % DIN; WSP(float, O_BIASP)[l * NPAD + perm_in(n)] = p->in.b_in[i]; }
    for (int i = gt; i < T_ * D_ / 8; i += NG) { const f32x4 a = *(const f32x4*)(p->in.x + (size_t)i * 8), b = *(const f32x4*)(p->in.x + (size_t)i * 8 + 4);
        *(u32x4*)(WSP(bf16_t, O_XB) + (size_t)i * 8) = (u32x4){pk2(a.x, a.y), pk2(a.z, a.w), pk2(b.x, b.y), pk2(b.z, b.w)}; }
}

struct EpiProj {
    static constexpr bool PERM = true;
    bf16_t* projb; float* gf; const float* bias;
    __device__ __forceinline__ void operator()(const pg8::f32x4 (&acc)[2][2][4][2], const pg8::Unit& u, int wr, int wc, int fr, int fq) const {
        const int row0 = u.pm * 256 + wr * 64 + fr, col0 = u.pn * 256 + wc * 32 + 8 * fq;
        if (u.pn < 11) {
#pragma unroll
            for (int ai = 0; ai < 2; ++ai)
#pragma unroll
                for (int m = 0; m < 4; ++m) { bf16_t* rowp = projb + (size_t)(row0 + ai * 128 + m * 16) * PB + col0;
#pragma unroll
                    for (int bj = 0; bj < 2; ++bj) { const f32x4 v0 = acc[ai][bj][m][0] + *(const f32x4*)(bias + col0 + bj * 128), v1 = acc[ai][bj][m][1] + *(const f32x4*)(bias + col0 + bj * 128 + 4);
                        u32x4 w; w.x = pg8::cvt_pk_bf16(v0[0], v0[1]); w.y = pg8::cvt_pk_bf16(v0[2], v0[3]); w.z = pg8::cvt_pk_bf16(v1[0], v1[1]); w.w = pg8::cvt_pk_bf16(v1[2], v1[3]);
                        *(u32x4*)(rowp + bj * 128) = w; }
                    asm volatile("" ::: "memory"); }
        } else if (wc == 0) {
            const f32x4 b0 = *(const f32x4*)(bias + col0), b1 = *(const f32x4*)(bias + col0 + 4);
#pragma unroll
            for (int ai = 0; ai < 2; ++ai)
#pragma unroll
                for (int m = 0; m < 4; ++m) { float* rowp = gf + (size_t)(row0 + ai * 128 + m * 16) * 32 + 8 * fq;
                    const f32x4 v0 = acc[ai][0][m][0] + b0, v1 = acc[ai][0][m][1] + b1; f32x4 o0, o1;
#pragma unroll
                    for (int i = 0; i < 4; ++i) { const int j0 = 8 * fq + i, j1 = j0 + 4;
                        o0[i] = (j0 < 24) ? sigmoidf_(v0[i]) : (j0 < 28 ? logsig(v0[i]) : 0.f); o1[i] = (j1 < 24) ? sigmoidf_(v1[i]) : (j1 < 28 ? logsig(v1[i]) : 0.f); }
                    *(f32x4*)rowp = o0; *(f32x4*)(rowp + 4) = o1; }
        }
    }
};
struct EpiOut {
    static constexpr bool PERM = true;
    const float* x; float* y1;
    __device__ __forceinline__ void operator()(const pg8::f32x4 (&acc)[2][2][4][2], const pg8::Unit& u, int wr, int wc, int fr, int fq) const {
        const int row0 = u.pm * 256 + wr * 64 + fr, col0 = u.pn * 256 + wc * 32 + 8 * fq;
#pragma unroll
        for (int ai = 0; ai < 2; ++ai)
#pragma unroll
            for (int m = 0; m < 4; ++m) { const size_t off = (size_t)(row0 + ai * 128 + m * 16) * D_ + col0;
#pragma unroll
                for (int bj = 0; bj < 2; ++bj) { const f32x4 x0 = *(const f32x4*)(x + off + bj * 128), x1 = *(const f32x4*)(x + off + bj * 128 + 4);
                    *(f32x4*)(y1 + off + bj * 128) = x0 * ALPHA + acc[ai][bj][m][0]; *(f32x4*)(y1 + off + bj * 128 + 4) = x1 * ALPHA + acc[ai][bj][m][1]; }
                asm volatile("" ::: "memory"); }
    }
};
struct EpiGU {
    static constexpr bool PERM = true;
    bf16_t* act; const float* bgu;
    __device__ __forceinline__ void operator()(const pg8::f32x4 (&acc)[2][2][4][2], const pg8::Unit& u, int wr, int wc, int fr, int fq) const {
        const int row0 = u.pm * 256 + wr * 64 + fr, col0 = u.pn * 128 + wc * 32 + 8 * fq;
        const float* bb = bgu + (size_t)u.e * 2048 + col0;
        const f32x4 bg0 = *(const f32x4*)bb, bg1 = *(const f32x4*)(bb + 4), bu0 = *(const f32x4*)(bb + 1024), bu1 = *(const f32x4*)(bb + 1028);
#pragma unroll
        for (int ai = 0; ai < 2; ++ai)
#pragma unroll
            for (int m = 0; m < 4; ++m) { f32x4 a0, a1;
                const f32x4 g0 = acc[ai][0][m][0] + bg0, g1 = acc[ai][0][m][1] + bg1, u0 = acc[ai][1][m][0] + bu0, u1 = acc[ai][1][m][1] + bu1;
#pragma unroll
                for (int i = 0; i < 4; ++i) { const float gt0 = fminf(g0[i], 7.0f), up0 = fminf(fmaxf(u0[i], -7.0f), 7.0f), gt1 = fminf(g1[i], 7.0f), up1 = fminf(fmaxf(u1[i], -7.0f), 7.0f);
                    a0[i] = gt0 * sigmoidf_(1.702f * gt0) * (up0 + 1.0f); a1[i] = gt1 * sigmoidf_(1.702f * gt1) * (up1 + 1.0f); }
                u32x4 w; w.x = pg8::cvt_pk_bf16(a0[0], a0[1]); w.y = pg8::cvt_pk_bf16(a0[2], a0[3]); w.z = pg8::cvt_pk_bf16(a1[0], a1[1]); w.w = pg8::cvt_pk_bf16(a1[2], a1[3]);
                *(u32x4*)(act + (size_t)(row0 + ai * 128 + m * 16) * D_ + col0) = w; asm volatile("" ::: "memory"); }
    }
};
struct EpiDN {
    static constexpr bool PERM = true;
    bf16_t* y; const float* bdn; const float* roww;
    __device__ __forceinline__ void operator()(const pg8::f32x4 (&acc)[2][2][4][2], const pg8::Unit& u, int wr, int wc, int fr, int fq) const {
        const int row0 = u.pm * 256 + wr * 64 + fr, col0 = u.pn * 256 + wc * 32 + 8 * fq;
        const float* bb = bdn + (size_t)u.e * D_ + col0;
#pragma unroll
        for (int ai = 0; ai < 2; ++ai)
#pragma unroll
            for (int m = 0; m < 4; ++m) { const int row = row0 + ai * 128 + m * 16; const float w = roww[row];
#pragma unroll
                for (int bj = 0; bj < 2; ++bj) { const f32x4 v0 = (acc[ai][bj][m][0] + *(const f32x4*)(bb + bj * 128)) * w, v1 = (acc[ai][bj][m][1] + *(const f32x4*)(bb + bj * 128 + 4)) * w;
                    u32x4 o; o.x = pg8::cvt_pk_bf16(v0[0], v0[1]); o.y = pg8::cvt_pk_bf16(v0[2], v0[3]); o.z = pg8::cvt_pk_bf16(v1[0], v1[1]); o.w = pg8::cvt_pk_bf16(v1[2], v1[3]);
                    *(u32x4*)(y + (size_t)row * D_ + col0 + bj * 128) = o; }
                asm volatile("" ::: "memory"); }
    }
};
struct MoeOrder {
    const int* meta; const int* rowtok; const char* Wt; size_t estep, tstep; int nN, G, c, nunits;
    __device__ __forceinline__ bool next(int i, pg8::Unit& u) const {
        const int L = i * G + c; if (L >= nunits) return false;
        const int gt = L / nN; u.pm = gt; u.pn = L - gt * nN; u.e = meta[64 + 2 * gt]; u.nr = meta[65 + 2 * gt]; return true; }
    __device__ __forceinline__ unsigned a_row(const pg8::Unit& u, int r) const { const int rr = r < u.nr ? r : u.nr - 1; const int row = u.pm * 256 + rr; return rowtok ? (unsigned)rowtok[row] : (unsigned)row; }
    __device__ __forceinline__ const char* b_base(const pg8::Unit& u) const { return Wt + (size_t)u.e * estep + (size_t)u.pn * tstep; }
};

struct EpiCmp {
    static constexpr bool PERM = true;
    bf16_t* hid; const float* bias1;
    __device__ __forceinline__ void operator()(const pg8::f32x4 (&acc)[2][2][4][2], const pg8::Unit& u, int wr, int wc, int fr, int fq) const {
        const int row0 = u.pm * 256 + wr * 64 + fr, col0 = wc * 32 + 8 * fq;
        const float* bb = bias1 + (u.e & 1) * 128 + col0; const f32x4 b0 = *(const f32x4*)bb, b1 = *(const f32x4*)(bb + 4);
#pragma unroll
        for (int ai = 0; ai < 2; ++ai)
#pragma unroll
            for (int m = 0; m < 4; ++m) { const f32x4 v0 = acc[ai][0][m][0] + b0, v1 = acc[ai][0][m][1] + b1;
                u32x4 w; w.x = pg8::cvt_pk_bf16(gelu_tanh(v0[0]), gelu_tanh(v0[1])); w.y = pg8::cvt_pk_bf16(gelu_tanh(v0[2]), gelu_tanh(v0[3])); w.z = pg8::cvt_pk_bf16(gelu_tanh(v1[0]), gelu_tanh(v1[1])); w.w = pg8::cvt_pk_bf16(gelu_tanh(v1[2]), gelu_tanh(v1[3]));
                *(u32x4*)(hid + ((size_t)u.e * 512 + row0 + ai * 128 + m * 16) * 128 + col0) = w; asm volatile("" ::: "memory"); }
    }
};
struct GEpi {
    static constexpr bool PERM = true;
    int kind, l;
    __device__ __forceinline__ void operator()(const pg8::f32x4 (&acc)[2][2][4][2], const pg8::Unit& u, int wr, int wc, int fr, int fq) const {
        const KP p = fresh_kp();
        if (kind == 0) { const EpiProj e{WSP(bf16_t, O_PROJB), WSP(float, O_GF), WSP(float, O_BIASP) + l * NPAD}; e(acc, u, wr, wc, fr, fq); }
        else if (kind == 1) { const EpiOut e{(l == 0) ? p->in.x : WSP(float, O_XA), WSP(float, O_MIX)}; e(acc, u, wr, wc, fr, fq); }
        else if (kind == 2) { const EpiGU e{WSP(bf16_t, O_ACT), p->in.bgu + (size_t)l * NE * 2048}; e(acc, u, wr, wc, fr, fq); }
        else if (kind == 3) { const EpiDN e{WSP(bf16_t, O_Y), p->in.bdn + (size_t)l * NE * D_, WSP(float, O_ROWW)}; e(acc, u, wr, wc, fr, fq); }
        else { const EpiCmp e{WSP(bf16_t, O_HID), WSP(float, O_BIAS1) + l * 256}; e(acc, u, wr, wc, fr, fq); }
    }
};
struct GSched {
    int kind, nM, nN, nunits, G, c; const int* meta; const int* rowtok; const char* Bt; size_t estep;
    __device__ __forceinline__ bool next(int i, pg8::Unit& u) const {
        const int L = i * G + c; if (L >= nunits) return false;
        if (kind < 2) {
            int wgid = L; { const int q = nunits / pg8::NXCD, r = nunits % pg8::NXCD, xcd = wgid % pg8::NXCD, off = wgid / pg8::NXCD; wgid = (xcd < r ? xcd * (q + 1) : r * (q + 1) + (xcd - r) * q) + off; }
            const int nig = pg8::WGM * nN, gid = wgid / nig, fm = gid * pg8::WGM, gsz = (nM - fm) < pg8::WGM ? (nM - fm) : pg8::WGM;
            u.pm = fm + ((wgid % nig) % gsz); u.pn = (wgid % nig) / gsz; u.e = 0; u.nr = 256;
        } else if (kind == 4) { u.e = L >> 1; u.pm = L & 1; u.pn = 0; u.nr = (L & 1) ? 255 : 256; }
        else { const int gt = L / nN; u.pm = gt; u.pn = L - gt * nN; u.e = meta[64 + 2 * gt]; u.nr = meta[65 + 2 * gt]; }
        return true; }
    __device__ __forceinline__ unsigned a_off(const pg8::Unit& u, int r) const { const int rr = r < u.nr ? r : u.nr - 1; const int row = u.pm * 256 + rr;
        if (kind == 4) { const int kv = u.e & 1, bg = u.e >> 1; return (unsigned)(((bg >> 1) * S_ + 16 * row) * PB + C_KV + ((0 * 2 + kv) * 2 + (bg & 1)) * 64) * 2u; }
        return (unsigned)((kind == 2) ? rowtok[row] : row) * (unsigned)(D_ * 2); }
    __device__ __forceinline__ size_t a_kstep() const { return kind == 4 ? (size_t)PB * 2 : (size_t)128; }
    __device__ __forceinline__ const char* b_base(const pg8::Unit& u) const { return Bt + (size_t)(kind == 4 ? (u.e & 1) : u.e) * estep + (size_t)u.pn * ((size_t)256 * D_ * 2); }
};

__device__ __forceinline__ void ph_prep(float* lds, KP p, int l) {
    const int tid = ftid();
    const bf16_t* projb = WSP(bf16_t, O_PROJB);
    constexpr int NCB = (NCMP + 3) / 4;
    constexpr int NV_CMP = NCB * B_ * 2 * 2;
    MK_LOOP(vb, NV_CMP + B_ * 4) {
        if (vb < NV_CMP) {
            float* blk = lds; float* hid = lds + 4 * 2048;
            const int kv = vb & 1, bg = (vb >> 1) & 3, nb = vb >> 3, b = bg >> 1, g = bg & 1;
            const float* pos = (kv ? p->in.pos_v : p->in.pos_k) + (size_t)l * 2048; const float* w1 = (kv ? p->in.w1v : p->in.w1k) + (size_t)l * 2048 * 128;
            const float* w2 = (kv ? p->in.w2v : p->in.w2k) + (size_t)l * 128 * 64; float* outp = kv ? WSP(float, O_VCMP) : WSP(float, O_KCMP);
            __syncthreads();
            for (int i = tid; i < 4 * 2048; i += NT) { const int sub = i >> 11, e = i & 2047, ll = e >> 6, d = e & 63; int n = nb * 4 + sub; if (n >= NCMP) n = NCMP - 1;
                blk[i] = bf2f(projb[(size_t)(b * S_ + 16 * n + ll) * PB + C_KV + ((0 * 2 + kv) * 2 + g) * 64 + d]) + pos[e]; }
            __syncthreads();
            const int sub = tid >> 7, j = tid & 127; const float* bl = blk + sub * 2048;
            float a = 0.f;
            for (int i = 0; i < 2048; ++i) a += bl[i] * w1[(size_t)i * 128 + j];
            hid[tid] = gelu_tanh(a);
            __syncthreads();
            const int n = nb * 4 + sub;
            if (j < 64 && n < NCMP) { float o = 0.f; for (int jj = 0; jj < 128; ++jj) o += hid[sub * 128 + jj] * w2[jj * 64 + j]; outp[((size_t)bg * NCMP + n) * 64 + j] = o;
                (kv ? WSP(bf16_t, O_VCMPB) : WSP(bf16_t, O_KCMPB))[((size_t)bg * 512 + n) * 64 + j] = (bf16_t)f2bf(o); }
            if (j < 64 && n == NCMP) (kv ? WSP(bf16_t, O_VCMPB) : WSP(bf16_t, O_KCMPB))[((size_t)bg * 512 + 511) * 64 + j] = 0;
        } else {
            float* sh = lds; const int bh = vb - NV_CMP, b = bh >> 2, h = bh & 3; float carry = 0.f;
            for (int t0 = 0; t0 < S_; t0 += NT) {
                __syncthreads();
                sh[tid] = WSP(float, O_GF)[(size_t)(b * S_ + t0 + tid) * 32 + 24 + h]; __syncthreads();
                for (int o = 1; o < NT; o <<= 1) { const float add = (tid >= o) ? sh[tid - o] : 0.f; __syncthreads(); sh[tid] += add; __syncthreads(); }
                WSP(float, O_CFOX)[(size_t)bh * S_ + t0 + tid] = carry + sh[tid];
                carry += sh[NT - 1];
            }
        }
    }
}

__device__ __forceinline__ void load_tile_bf(float (*dst)[64], const bf16_t* __restrict__ src, size_t pitch) {
    const int tid = ftid(), r = tid >> 3, c0 = (tid & 7) * 8; float v[8]; ld8(src + (size_t)r * pitch + c0, v);
    *(float4*)&dst[r][c0] = make_float4(v[0], v[1], v[2], v[3]); *(float4*)&dst[r][c0 + 4] = make_float4(v[4], v[5], v[6], v[7]);
}
__device__ __forceinline__ void load_tile512(float (*dst)[64], const float* __restrict__ src, size_t stride, int nrows_valid) {
    const int tid = ftid(), r = tid >> 3, c0 = (tid & 7) * 8;
#pragma unroll
    for (int j = 0; j < 2; ++j) { float4 v = make_float4(0.f, 0.f, 0.f, 0.f); if (r < nrows_valid) v = *(const float4*)(src + (size_t)r * stride + c0 + 4 * j); *(float4*)&dst[r][c0 + 4 * j] = v; }
}
#define MK_LOADQ(q, src) do { _Pragma("unroll") for (int c_ = 0; c_ < 8; ++c_) { float t8_[8]; ld8((src) + 8 * c_, t8_); _Pragma("unroll") for (int e_ = 0; e_ < 8; ++e_) q[8 * c_ + e_] = t8_[e_] * SCALE; } } while (0)

template <int KIND>
__device__ __forceinline__ void attn_vblock(float* lds, KP p, int qb, int bh) {
    float (*Ks)[64] = (float (*)[64])lds; float (*Vs)[64] = (float (*)[64])(lds + 4096); float* Cs = lds + 8192;
    const bf16_t* projb = WSP(bf16_t, O_PROJB); const float* gf = WSP(float, O_GF); float* ob = WSP(float, O_O);
    const int tid = ftid(), q0 = qb * NT, t = q0 + tid;
    if (KIND == 0 || KIND == 1) {
        int b, h, qcol, kcol, vcol, ocol; float slope = 0.f;
        if (KIND == 0) { b = bh >> 2; h = bh & 3; qcol = C_FOX + h * 64; kcol = C_FOX + (4 + h) * 64; vcol = C_FOX + (8 + h) * 64; ocol = 512 + h * 64; }
        else { b = bh >> 3; h = bh & 7; const int g = h >> 2; qcol = h * 64; kcol = C_KV + ((2 * 2 + 0) * 2 + g) * 64; vcol = C_KV + ((2 * 2 + 1) * 2 + g) * 64; ocol = h * 64; slope = exp2f(-(float)(h + 1)); }
        const bf16_t* prow = projb + (size_t)(b * S_ + t) * PB;
        float q[64], o[64];
        MK_LOADQ(q, prow + qcol);
#pragma unroll
        for (int d = 0; d < 64; ++d) o[d] = 0.f;
        float m = -1e30f, l = 0.f, ct = 0.f; const float* cb = WSP(float, O_CFOX) + (size_t)(b * 4 + (h & 3)) * S_;
        if (KIND == 0) ct = cb[t];
        int kt0 = 0; const int kt1 = (q0 + NT - 1) >> 6;
        if (KIND == 1) { kt0 = (q0 - 511) >> 6; if (kt0 < 0) kt0 = 0; }
        for (int kt = kt0; kt <= kt1; ++kt) {
            __syncthreads();
            load_tile_bf(Ks, projb + (size_t)(b * S_ + kt * 64) * PB + kcol, PB);
            load_tile_bf(Vs, projb + (size_t)(b * S_ + kt * 64) * PB + vcol, PB);
            if (KIND == 0 && tid < 64) Cs[tid] = cb[kt * 64 + tid];
            __syncthreads();
            for (int r = 0; r < 64; ++r) {
                const int s = kt * 64 + r; bool ok = (s <= t); if (KIND == 1) ok = ok && (t - s < 512);
                if (ok) { float sc; NV_DOT(q, Ks[r], sc); if (KIND == 0) sc += ct - Cs[r]; else sc -= slope * (float)(t - s); NV_ONLINE(sc, Vs[r]); }
            }
        }
        const float inv = (l > 0.f) ? 1.f / l : 0.f;
        float* orow = ob + (size_t)(b * S_ + t) * D_ + ocol;
        if (KIND == 0) {
#pragma unroll
            for (int d = 0; d < 64; ++d) orow[d] = o[d] * inv;
        } else { const float gate = gf[(size_t)(b * S_ + t) * 32 + 2 * 8 + h]; float* wrow = WSP(float, O_OWIN) + (size_t)(b * S_ + t) * 512 + h * 64;
#pragma unroll
            for (int d = 0; d < 64; ++d) wrow[d] = gate * o[d] * inv; }
    } else if (KIND == 2) {
        const int b = bh >> 2, h = bh & 3;
        const int qcol = C_SB + h * 64, kcol = C_SB + (4 + h) * 64, vcol = C_SB + (8 + h) * 64, ocol = 768 + h * 64;
        const bf16_t* prow = projb + (size_t)(b * S_ + t) * PB;
        float q[64], o[64];
        MK_LOADQ(q, prow + qcol);
#pragma unroll
        for (int d = 0; d < 64; ++d) o[d] = 0.f;
        float later = 0.f;
        for (int kt = (q0 + NT - 1) >> 6; kt >= 0; --kt) {
            __syncthreads();
            load_tile_bf(Ks, projb + (size_t)(b * S_ + kt * 64) * PB + kcol, PB);
            load_tile_bf(Vs, projb + (size_t)(b * S_ + kt * 64) * PB + vcol, PB);
            __syncthreads();
            for (int r = 63; r >= 0; --r) { const int s = kt * 64 + r;
                if (s < t) { float z; NV_DOT(q, Ks[r], z); const float a = expf(logsig(z) + later); NV_AXPY(o, a, Vs[r]); later += logsig(-z); } }
        }
        float* orow = ob + (size_t)(b * S_ + t) * D_ + ocol;
#pragma unroll
        for (int d = 0; d < 64; ++d) orow[d] = o[d];
    } else {
        const int bg = bh, b = bg >> 1, g = bg & 1;
        const bf16_t* prow = projb + (size_t)(b * S_ + t) * PB;
        float* prow_t = WSP(float, O_PTOT) + (size_t)(bg * S_ + t) * 512;
        const float* kcmp = WSP(float, O_KCMP); const float* vcmp = WSP(float, O_VCMP);
        int nmax = (q0 + NT - 1 - 31) / 16 + 1; if (nmax > NCMP) nmax = NCMP;
        const int ntile = (nmax + 63) / 64;
        for (int r4 = 0; r4 < 4; ++r4) {
            const int h = g * 4 + r4; const float slope = exp2f(-(float)(h + 1));
            float q[64], o[64];
            MK_LOADQ(q, prow + h * 64);
#pragma unroll
            for (int d = 0; d < 64; ++d) o[d] = 0.f;
            float m = -1e30f, l = 0.f;
            for (int kt = 0; kt < ntile; ++kt) {
                __syncthreads();
                const int nvr = (NCMP - kt * 64) < 64 ? (NCMP - kt * 64) : 64;
                load_tile512(Ks, kcmp + ((size_t)bg * NCMP + kt * 64) * 64, 64, nvr);
                load_tile512(Vs, vcmp + ((size_t)bg * NCMP + kt * 64) * 64, 64, nvr);
                __syncthreads();
                for (int r = 0; r < nvr; ++r) { const int ce = 16 * (kt * 64 + r) + 31;
                    if (ce <= t) { float sc; NV_DOT(q, Ks[r], sc); sc -= slope * (float)(t - ce); NV_ONLINE(sc, Vs[r]); } }
            }
            const float inv = (l > 0.f) ? 1.f / l : 0.f;
            const float gate = gf[(size_t)(b * S_ + t) * 32 + 0 * 8 + h];
            float* orow = ob + (size_t)(b * S_ + t) * D_ + h * 64;
#pragma unroll
            for (int d = 0; d < 64; ++d) orow[d] = gate * o[d] * inv;
            for (int kt = 0; kt < 8; ++kt) {
                __syncthreads();
                const int nvr = (NCMP - kt * 64) < 64 ? (NCMP - kt * 64) : 64;
                if (kt < ntile) load_tile512(Ks, kcmp + ((size_t)bg * NCMP + kt * 64) * 64, 64, nvr);
                __syncthreads();
                for (int r = 0; r < 64; ++r) { const int n = kt * 64 + r, ce = 16 * n + 31; float pp = 0.f;
                    if (kt < ntile && r < nvr && ce <= t) { float sc; NV_DOT(q, Ks[r], sc); sc -= slope * (float)(t - ce); pp = __expf(sc - m) * inv; }
                    if (r4 == 0) prow_t[n] = pp; else prow_t[n] += pp; }
            }
        }
    }
}
__device__ __forceinline__ void ph_attn_a(float* lds, KP p) {
    constexpr int NQB = S_ / NT;
    constexpr int N_CMP = NQB * B_ * 2, N_FOX = NQB * B_ * 4, N_SB = NQB * B_ * 4;
    MK_LOOP(vb, N_CMP + N_FOX + N_SB) {
        if (vb < N_FOX) { const int qb = NQB - 1 - vb / (B_ * 4); attn_vblock<0>(lds, p, qb, vb % (B_ * 4)); }
        else if (vb < N_FOX + N_SB) { const int v = vb - N_FOX; const int qb = NQB - 1 - v / (B_ * 4); attn_vblock<2>(lds, p, qb, v % (B_ * 4)); }
        else { const int v = vb - N_FOX - N_SB; attn_vblock<3>(lds, p, v / (B_ * 2), v % (B_ * 2)); }
    }
}
__device__ __forceinline__ void ph_select(KP p) {
    const int lane = ftid() & 63, wv = ftid() >> 6; int* sel = WSP(int, O_SEL);
    for (int wave = fbid() * 8 + wv; wave < B_ * 2 * S_; wave += gridDim.x * 8) {
        const int t = wave % S_; const float* pt = WSP(float, O_PTOT) + (size_t)wave * 512; const int cur = t >> 6;
        float v[2];
#pragma unroll
        for (int k = 0; k < 2; ++k) { const int j = lane + 64 * k;
            float imp = pt[4 * j] + pt[4 * j + 1] + pt[4 * j + 2];
            if (4 * j + 3 < NCMP) imp += 0.5f * pt[4 * j + 3];
            if (j >= 1) imp += 0.5f * pt[4 * j - 1];
            const bool valid = j <= cur, forced = valid && (j == 0 || j >= cur - 1);
            v[k] = forced ? 3.0e38f : (valid ? imp : -3.0e38f); }
        for (int it = 0; it < NSEL; ++it) {
            float bv = v[0]; int bi = lane; if (v[1] > bv) { bv = v[1]; bi = lane + 64; }
#pragma unroll
            for (int o = 32; o >= 1; o >>= 1) { const float ov = __shfl_xor(bv, o); const int oi = __shfl_xor(bi, o); if (ov > bv || (ov == bv && oi < bi)) { bv = ov; bi = oi; } }
            if (lane == 0) sel[(size_t)wave * NSEL + it] = bi;
            if (bi == lane) v[0] = -3.4e38f;
            if (bi == lane + 64) v[1] = -3.4e38f;
        }
    }
}
__device__ __forceinline__ void ph_attn_sel(KP p) {
    const bf16_t* projb = WSP(bf16_t, O_PROJB); const int tid = ftid();
    MK_LOOP(vb, (S_ / NT) * B_ * 8) {
        const int qb = vb / (B_ * 8), bh = vb % (B_ * 8), b = bh >> 3, h = bh & 7, g = h >> 2, t = qb * NT + tid;
        const float slope = exp2f(-(float)(h + 1));
        const bf16_t* prow = projb + (size_t)(b * S_ + t) * PB;
        const int kcol = C_KV + ((1 * 2 + 0) * 2 + g) * 64, vcol = C_KV + ((1 * 2 + 1) * 2 + g) * 64;
        const int* sl = WSP(int, O_SEL) + ((size_t)(b * 2 + g) * S_ + t) * NSEL;
        float q[64], o[64];
        MK_LOADQ(q, prow + h * 64);
#pragma unroll
        for (int d = 0; d < 64; ++d) o[d] = 0.f;
        float m = -1e30f, l = 0.f;
        for (int i = 0; i < NSEL; ++i) { const int blk = sl[i];
            for (int r = 0; r < 64; ++r) { const int s = blk * 64 + r;
                if (s <= t) { const bf16_t* kr = projb + (size_t)(b * S_ + s) * PB + kcol; const bf16_t* vr = projb + (size_t)(b * S_ + s) * PB + vcol;
                    float sc = 0.f;
#pragma unroll
                    for (int c = 0; c < 8; ++c) { float k8[8]; ld8(kr + 8 * c, k8);
#pragma unroll
                        for (int e = 0; e < 8; ++e) sc += q[8 * c + e] * k8[e]; }
                    sc -= slope * (float)(t - s);
                    if (sc > m) { const float al = __expf(m - sc); l *= al;
#pragma unroll
                        for (int d = 0; d < 64; ++d) o[d] *= al;
                        m = sc; }
                    const float pp = __expf(sc - m); l += pp;
#pragma unroll
                    for (int c = 0; c < 8; ++c) { float v8[8]; ld8(vr + 8 * c, v8);
#pragma unroll
                        for (int e = 0; e < 8; ++e) o[8 * c + e] += pp * v8[e]; }
                } } }
        const float inv = (l > 0.f) ? 1.f / l : 0.f; const float gate = WSP(float, O_GF)[(size_t)(b * S_ + t) * 32 + 1 * 8 + h];
        float* orow = WSP(float, O_O) + (size_t)(b * S_ + t) * D_ + h * 64;
#pragma unroll
        for (int d = 0; d < 64; ++d) orow[d] += gate * o[d] * inv;
    }
}
__device__ __forceinline__ void ph_attn_win(float* lds, KP p) {
    MK_LOOP(vb, (S_ / NT) * B_ * 8) attn_vblock<1>(lds, p, vb / (B_ * 8), vb % (B_ * 8));
}
__device__ __forceinline__ void ph_rmsnorm(KP p, int l) {
    const int lane = ftid() & 63, wv = ftid() >> 6; const float* g = p->in.g_out + (size_t)l * D_;
    for (int row = fbid() * 8 + wv; row < T_; row += gridDim.x * 8) {
        const float* r = WSP(float, O_O) + (size_t)row * D_; bf16_t* ro = WSP(bf16_t, O_OB) + (size_t)row * D_;
        float a[8], bq[8], s = 0.f, s2 = 0.f;
#pragma unroll
        for (int i = 0; i < 8; ++i) { a[i] = r[lane * 8 + i] + WSP(float, O_OWIN)[(size_t)row * 512 + lane * 8 + i]; s += a[i] * a[i]; bq[i] = r[512 + lane * 8 + i]; s2 += bq[i] * bq[i]; }
        const float sc0 = rsqrtf(wsum(s) * (1.f / 512.f) + RMS_EPS);
#pragma unroll
        for (int o = 1; o < 32; o <<= 1) s2 += __shfl_xor(s2, o);
        const float sc1 = rsqrtf(s2 * (1.f / 256.f) + RMS_EPS);
        float x0[8], x1[8];
#pragma unroll
        for (int i = 0; i < 8; ++i) { x0[i] = a[i] * sc0 * g[lane * 8 + i]; x1[i] = bq[i] * sc1 * g[512 + lane * 8 + i]; }
        *(u32x4*)(ro + lane * 8) = (u32x4){pk2(x0[0], x0[1]), pk2(x0[2], x0[3]), pk2(x0[4], x0[5]), pk2(x0[6], x0[7])};
        *(u32x4*)(ro + 512 + lane * 8) = (u32x4){pk2(x1[0], x1[1]), pk2(x1[2], x1[3]), pk2(x1[4], x1[5]), pk2(x1[6], x1[7])};
    }
}
template <bool ROUTER>
__device__ __forceinline__ void ph_ln(float* lds, KP p, int l, float* __restrict__ yout, int cnt_off = 0) {
    const int lane = ftid() & 63, wv = ftid() >> 6;
    const float* g = (ROUTER ? p->in.ln1_g : p->in.ln2_g) + (size_t)l * D_; const float* bb = (ROUTER ? p->in.ln1_b : p->in.ln2_b) + (size_t)l * D_;
    for (int row = fbid() * 8 + wv; row < T_; row += gridDim.x * 8) {
        float v[16], s = 0.f;
        if (ROUTER) { const float* src = WSP(float, O_MIX) + (size_t)row * D_;
#pragma unroll
            for (int j = 0; j < 2; ++j) { const f32x4 a = *(const f32x4*)(src + 512 * j + lane * 8), b = *(const f32x4*)(src + 512 * j + lane * 8 + 4);
                v[8 * j + 0] = a.x; v[8 * j + 1] = a.y; v[8 * j + 2] = a.z; v[8 * j + 3] = a.w; v[8 * j + 4] = b.x; v[8 * j + 5] = b.y; v[8 * j + 6] = b.z; v[8 * j + 7] = b.w; }
        } else { const float* src = WSP(float, O_X1) + (size_t)row * D_; const int* sl = WSP(int, O_SLOT) + row * TOPK; const bf16_t* y = WSP(bf16_t, O_Y);
#pragma unroll
            for (int j = 0; j < 2; ++j) { const f32x4 a = *(const f32x4*)(src + 512 * j + lane * 8), b = *(const f32x4*)(src + 512 * j + lane * 8 + 4);
                v[8 * j + 0] = ALPHA * a.x; v[8 * j + 1] = ALPHA * a.y; v[8 * j + 2] = ALPHA * a.z; v[8 * j + 3] = ALPHA * a.w; v[8 * j + 4] = ALPHA * b.x; v[8 * j + 5] = ALPHA * b.y; v[8 * j + 6] = ALPHA * b.z; v[8 * j + 7] = ALPHA * b.w; }
            float acc[16];
#pragma unroll
            for (int i = 0; i < 16; ++i) acc[i] = 0.f;
#pragma unroll
            for (int k = 0; k < TOPK; ++k) { const bf16_t* yr = y + (size_t)sl[k] * D_;
#pragma unroll
                for (int j = 0; j < 2; ++j) { float t8[8]; ld8(yr + 512 * j + lane * 8, t8);
#pragma unroll
                    for (int e = 0; e < 8; ++e) acc[8 * j + e] += t8[e]; } }
#pragma unroll
            for (int i = 0; i < 16; ++i) v[i] += acc[i]; }
#pragma unroll
        for (int i = 0; i < 16; ++i) s += v[i];
        const float mu = wsum(s) * (1.f / D_); float s2 = 0.f;
#pragma unroll
        for (int i = 0; i < 16; ++i) { v[i] -= mu; s2 += v[i] * v[i]; }
        const float rstd = rsqrtf(wsum(s2) * (1.f / D_) + LN_EPS);
        bf16_t* ybf = (ROUTER ? WSP(bf16_t, O_X1B) : WSP(bf16_t, O_XB)) + (size_t)row * D_;
#pragma unroll
        for (int j = 0; j < 2; ++j) { const int c0 = 512 * j + lane * 8;
#pragma unroll
            for (int e = 0; e < 8; ++e) v[8 * j + e] = v[8 * j + e] * rstd * g[c0 + e] + bb[c0 + e];
            *(f32x4*)(yout + (size_t)row * D_ + c0) = (f32x4){v[8 * j], v[8 * j + 1], v[8 * j + 2], v[8 * j + 3]};
            *(f32x4*)(yout + (size_t)row * D_ + c0 + 4) = (f32x4){v[8 * j + 4], v[8 * j + 5], v[8 * j + 6], v[8 * j + 7]};
            *(u32x4*)(ybf + c0) = (u32x4){pk2(v[8 * j], v[8 * j + 1]), pk2(v[8 * j + 2], v[8 * j + 3]), pk2(v[8 * j + 4], v[8 * j + 5]), pk2(v[8 * j + 6], v[8 * j + 7])}; }
    }
    if (ROUTER) {
        const float* rw = p->in.rw + (size_t)l * D_ * NE; const float* rb = p->in.rb + (size_t)l * NE; float* lgl = lds + wv * 512;
        const int nrow = (T_ - (fbid() * 8 + wv) + (int)gridDim.x * 8 - 1) / ((int)gridDim.x * 8);
#pragma unroll 1
        for (int ps = 0; ps < 4; ++ps) {
            f32x4 w0[16], w1[16];
#pragma unroll
            for (int i = 0; i < 16; ++i) { const int c = 512 * (i >> 3) + lane * 8 + (i & 7); w0[i] = *(const f32x4*)(rw + (size_t)c * NE + 8 * ps); w1[i] = *(const f32x4*)(rw + (size_t)c * NE + 8 * ps + 4); }
#pragma unroll 1
            for (int ri = 0; ri < nrow; ++ri) { const int row = fbid() * 8 + wv + ri * (int)gridDim.x * 8; const float* src = yout + (size_t)row * D_;
                f32x4 a0 = {0.f, 0.f, 0.f, 0.f}, a1 = {0.f, 0.f, 0.f, 0.f};
#pragma unroll
                for (int j = 0; j < 2; ++j) { const f32x4 xa = *(const f32x4*)(src + 512 * j + lane * 8), xb = *(const f32x4*)(src + 512 * j + lane * 8 + 4);
                    a0 += w0[8 * j + 0] * xa.x + w0[8 * j + 1] * xa.y + w0[8 * j + 2] * xa.z + w0[8 * j + 3] * xa.w + w0[8 * j + 4] * xb.x + w0[8 * j + 5] * xb.y + w0[8 * j + 6] * xb.z + w0[8 * j + 7] * xb.w;
                    a1 += w1[8 * j + 0] * xa.x + w1[8 * j + 1] * xa.y + w1[8 * j + 2] * xa.z + w1[8 * j + 3] * xa.w + w1[8 * j + 4] * xb.x + w1[8 * j + 5] * xb.y + w1[8 * j + 6] * xb.z + w1[8 * j + 7] * xb.w; }
#pragma unroll
                for (int e = 0; e < 4; ++e) { a0[e] = wsum(a0[e]); a1[e] = wsum(a1[e]); }
                if (lane == 0) { *(f32x4*)(lgl + ri * 32 + 8 * ps) = a0; *(f32x4*)(lgl + ri * 32 + 8 * ps + 4) = a1; } }
        }
        int* lcnt = (int*)(lds + 8 * 512);
        if (ftid() < NE) lcnt[ftid()] = 0;
        __syncthreads();
#pragma unroll 1
        for (int ri = 0; ri < nrow; ++ri) { const int row = fbid() * 8 + wv + ri * (int)gridDim.x * 8;
            const int e = lane & 31; const float lg = lgl[ri * 32 + e] + rb[e];
            float cur = lg, tv0 = 0.f, den = 0.f, myw = 0.f; int mye = 0;
#pragma unroll
            for (int k = 0; k < TOPK; ++k) { float bv = cur; int bi = e;
#pragma unroll
                for (int o = 16; o >= 1; o >>= 1) { const float ov = __shfl_xor(bv, o); const int oi = __shfl_xor(bi, o); if (ov > bv || (ov == bv && oi < bi)) { bv = ov; bi = oi; } }
                if (k == 0) tv0 = bv;
                const float w = __expf(bv - tv0); den += w;
                if (lane == k) { mye = bi; myw = w; }
                if (e == bi) cur = -3.4e38f; }
            if (lane < TOPK) { WSP(int, O_TOPE)[row * TOPK + lane] = mye; WSP(float, O_TOPW)[row * TOPK + lane] = myw / den; WSP(int, O_POS)[row * TOPK + lane] = atomicAdd(&lcnt[mye], 1); } }
        __syncthreads();
        if (ftid() < NE) { const int c = lcnt[ftid()]; lcnt[ftid()] = (c > 0) ? atomicAdd(WSP(int, O_COUNTS) + CNT_IDX(l, ftid()) + cnt_off, c) : 0; }
        __syncthreads();
#pragma unroll 1
        for (int ri = 0; ri < nrow; ++ri) { const int row = fbid() * 8 + wv + ri * (int)gridDim.x * 8;
            if (lane < TOPK) WSP(int, O_POS)[row * TOPK + lane] += lcnt[WSP(int, O_TOPE)[row * TOPK + lane]]; }
        __syncthreads();
    }
}
__device__ __forceinline__ void ph_moe_plan(KP p, int l) {
    if (fbid() == 0 && ftid() == 0) { const int* counts = WSP(int, O_COUNTS) + l * 32; int* meta = WSP(int, O_META); int nt = 0;
        for (int e = 0; e < NE; ++e) { meta[e] = nt; const int c = counts[e];
            for (int r = 0; r < c; r += 256) { meta[64 + 2 * nt] = e; meta[65 + 2 * nt] = (c - r) < 256 ? (c - r) : 256; ++nt; } }
        meta[32] = nt; }
}
__device__ __forceinline__ void ph_moe_scatter(KP p) {
    const int* meta = WSP(int, O_META);
    for (int i = fbid() * NT + ftid(); i < MROWS; i += gridDim.x * NT) {
        const int row = meta[WSP(int, O_TOPE)[i]] * 256 + WSP(int, O_POS)[i];
        WSP(int, O_ROWTOK)[row] = i >> 2; WSP(float, O_ROWW)[row] = WSP(float, O_TOPW)[i]; WSP(int, O_SLOT)[i] = row; }
}
__device__ __forceinline__ void ph_bias1_reduce(KP p, int l) {
    if (fbid() != (int)gridDim.x - 1) return;
    const int tid = ftid(); if (tid < 256) { const float* pp = WSP(float, O_BIAS1P) + ((size_t)(l * 2 + (tid >> 7)) * 64) * 128 + (tid & 127); float a = 0.f;
        for (int s = 0; s < 64; ++s) a += pp[s * 128];
        WSP(float, O_BIAS1)[l * 256 + tid] = a; }
}
__device__ __forceinline__ void ph_cumsum(float* lds, KP p, int blk0) {
    const int tid = ftid(), lane = tid & 63, wv = tid >> 6; const int bh = fbid() - blk0;
    if (bh < 0 || bh >= B_ * 4) return;
    const int b = bh >> 2, h = bh & 3; const float* gf = WSP(float, O_GF) + (size_t)(b * S_ + tid * 16) * 32 + 24 + h;
    float v[16], run = 0.f;
#pragma unroll
    for (int i = 0; i < 16; ++i) { run += gf[(size_t)i * 32]; v[i] = run; }
    float inc = run;
#pragma unroll
    for (int o = 1; o < 64; o <<= 1) { const float t = __shfl_up(inc, o); if (lane >= o) inc += t; }
    if (lane == 63) lds[wv] = inc;
    __syncthreads();
    float woff = 0.f;
#pragma unroll
    for (int i = 0; i < 8; ++i) woff += (i < wv) ? lds[i] : 0.f;
    const float off = woff + inc - run; float* c = WSP(float, O_CFOX) + (size_t)bh * S_ + tid * 16;
#pragma unroll
    for (int i = 0; i < 4; ++i) *(f32x4*)(c + 4 * i) = (f32x4){v[4 * i] + off, v[4 * i + 1] + off, v[4 * i + 2] + off, v[4 * i + 3] + off};
    __syncthreads();
}
__device__ __forceinline__ void ph_prep2(KP p, int l) {
    for (int i = fbid() * NT + ftid(); i < 8 * 512 * 64; i += gridDim.x * NT) {
        const int d = i & 63, n = (i >> 6) & 511, combo = i >> 15, kv = combo & 1, bg = combo >> 1;
        const float* w2 = (kv ? p->in.w2v : p->in.w2k) + (size_t)l * 128 * 64; const bf16_t* hr = WSP(bf16_t, O_HID) + ((size_t)combo * 512 + n) * 128;
        float a = 0.f;
#pragma unroll 4
        for (int c = 0; c < 16; ++c) { float h8[8]; ld8(hr + 8 * c, h8);
#pragma unroll
            for (int e = 0; e < 8; ++e) a += h8[e] * w2[(8 * c + e) * 64 + d]; }
        (kv ? WSP(bf16_t, O_VCMPB) : WSP(bf16_t, O_KCMPB))[((size_t)bg * 512 + n) * 64 + d] = (n < NCMP) ? (bf16_t)f2bf(a) : (bf16_t)0; }
}
__device__ __forceinline__ void ph_moe_scatter2(float* lds, KP p, int l) {
    const int tid = ftid(); int* ts = (int*)lds;
    const int* counts = WSP(int, O_COUNTS) + CNT_IDX(l, 0); int* meta = WSP(int, O_META); int* cl = ts + 64;
    __syncthreads();
    if (tid < NE) cl[tid] = counts[tid * 32];
    __syncthreads();
    if (tid == 0) { int nt = 0; for (int e = 0; e < NE; ++e) { ts[e] = nt; nt += (cl[e] + 255) >> 8; } ts[32] = nt; }
    __syncthreads();
    if (fbid() == 0) { if (tid < NE) { const int c = cl[tid], t0 = ts[tid]; meta[tid] = t0; for (int r = 0, t = t0; r < c; r += 256, ++t) { meta[64 + 2 * t] = tid; meta[65 + 2 * t] = (c - r) < 256 ? (c - r) : 256; } }
        if (tid == 0) meta[32] = ts[32]; }
    for (int i = fbid() * NT + tid; i < MROWS; i += gridDim.x * NT) {
        const int row = ts[WSP(int, O_TOPE)[i]] * 256 + WSP(int, O_POS)[i];
        WSP(int, O_ROWTOK)[row] = i >> 2; WSP(float, O_ROWW)[row] = WSP(float, O_TOPW)[i]; WSP(int, O_SLOT)[i] = row; }
    __syncthreads();
}
}
namespace mk {
typedef short bf16x8 __attribute__((ext_vector_type(8)));
typedef float f32x16 __attribute__((ext_vector_type(16)));
typedef float f32x2_t __attribute__((ext_vector_type(2)));
typedef __bf16 bf16x2_t __attribute__((ext_vector_type(2)));
typedef unsigned u32x2 __attribute__((ext_vector_type(2)));
__device__ __forceinline__ unsigned cvtpk(float lo, float hi) { f32x2_t v = {lo, hi}; bf16x2_t b = __builtin_convertvector(v, bf16x2_t); return __builtin_bit_cast(unsigned, b); }
constexpr int KROW = 144, VROW = 136;
constexpr int E1_K = 0, E1_V = 64 * KROW, E1_C = E1_V + 64 * VROW, E1_BUF = E1_C + 256;
constexpr int E1_FLAGS = 2 * E1_BUF;
constexpr float LOG2E = 1.4426950408889634f;
constexpr float RESC_THR = 8.0f;
#define CROW(reg, hh) (((reg) & 3) + 8 * ((reg) >> 2) + 4 * (hh))

struct E1Geom { int b, q0, h; const bf16_t* qp; const bf16_t* kp; const bf16_t* vp; size_t pitch; };

template <int KIND>
__device__ __forceinline__ void e1_unit(LAS unsigned char* lds, KP p, int b, int hg, int qb, float* __restrict__ obase, float* __restrict__ owin) {
    const int tid = ftid(), lane = tid & 63, w = __builtin_amdgcn_readfirstlane(tid >> 6), r32 = lane & 31, hh = lane >> 5;
    const bf16_t* projb = WSP(bf16_t, O_PROJB);
    int h, q0, qrow0, qcol, kcol, vcol, nrows;
    if (KIND == 0) { h = hg; q0 = qb * 256; qrow0 = q0 + 32 * w; qcol = C_FOX + h * 64; kcol = C_FOX + (4 + h) * 64; vcol = C_FOX + (8 + h) * 64; nrows = 256; }
    else if (KIND == 2) { h = hg; q0 = qb * 256; qrow0 = q0 + 32 * w; qcol = C_SB + h * 64; kcol = C_SB + (4 + h) * 64; vcol = C_SB + (8 + h) * 64; nrows = 256; }
    else { h = 4 * hg + (w & 3); q0 = qb * 64; qrow0 = q0 + 32 * (w >> 2); qcol = h * 64; kcol = C_KV + ((2 * 2 + 0) * 2 + hg) * 64; vcol = C_KV + ((2 * 2 + 1) * 2 + hg) * 64; nrows = 64; }
    const int tq = qrow0 + r32;
    const bf16_t* kbase = projb + (size_t)(b * S_) * PB + kcol; const bf16_t* vbase = projb + (size_t)(b * S_) * PB + vcol;
    bf16x8 qf[4];
    { const bf16_t* qptr = projb + (size_t)(b * S_ + tq) * PB + qcol + 8 * hh;
#pragma unroll
      for (int d0 = 0; d0 < 4; ++d0) qf[d0] = *(const bf16x8*)(qptr + 16 * d0); }
    int j0 = 0; const int j1 = (q0 + nrows - 1) >> 6;
    if (KIND == 1) { j0 = (q0 - 511) >> 6; if (j0 < 0) j0 = 0; }
    const int ntile = j1 - j0 + 1;
    float ct2 = 0.f, sl2 = 0.f; const float* cb = nullptr;
    if (KIND == 0) { cb = WSP(float, O_CFOX) + (size_t)(b * 4 + h) * S_; ct2 = cb[tq] * LOG2E; }
    if (KIND == 1) sl2 = exp2f(-(float)(h + 1)) * LOG2E;
    const float tqf = (float)tq;
    const int skey = tid >> 3, sch = tid & 7;
    u32x4 rk, rv; float rc = 0.f;
#define E1_LOAD(jj) do { const size_t ro_ = (size_t)((jj) * 64 + skey) * PB + sch * 8; rk = *(const u32x4*)(kbase + ro_); rv = *(const u32x4*)(vbase + ro_); \
        if (KIND == 0 && tid < 64) rc = cb[(jj) * 64 + tid] * LOG2E; } while (0)
#define E1_WRITE(bufp) do { *(LAS u32x4*)((bufp) + E1_K + skey * KROW + sch * 16) = rk; \
        LAS unsigned short* vt_ = (LAS unsigned short*)((bufp) + E1_V + (8 * sch) * VROW) + skey; \
        vt_[0 * (VROW / 2)] = (unsigned short)(rv.x & 0xffffu); vt_[1 * (VROW / 2)] = (unsigned short)(rv.x >> 16); vt_[2 * (VROW / 2)] = (unsigned short)(rv.y & 0xffffu); vt_[3 * (VROW / 2)] = (unsigned short)(rv.y >> 16); \
        vt_[4 * (VROW / 2)] = (unsigned short)(rv.z & 0xffffu); vt_[5 * (VROW / 2)] = (unsigned short)(rv.z >> 16); vt_[6 * (VROW / 2)] = (unsigned short)(rv.w & 0xffffu); vt_[7 * (VROW / 2)] = (unsigned short)(rv.w >> 16); \
        if (KIND == 0 && tid < 64) ((LAS float*)((bufp) + E1_C))[tid] = rc; } while (0)
    f32x16 o0, o1;
#pragma unroll
    for (int r = 0; r < 16; ++r) { o0[r] = 0.f; o1[r] = 0.f; }
    float m = -1e30f, l = 0.f, carry = 0.f;
    bool wave_done = false;
    LAS unsigned* flags = (LAS unsigned*)(lds + E1_FLAGS);
    if (KIND == 2) { if (tid < 8) flags[tid] = 0u; }
    __syncthreads();
    E1_LOAD(KIND == 2 ? j1 : j0);
    for (int it = 0; it < ntile; ++it) {
        const int j = (KIND == 2) ? (j1 - it) : (j0 + it);
        LAS unsigned char* buf = lds + (it & 1) * E1_BUF;
        E1_WRITE(buf);
        __syncthreads();
        if (KIND == 2) { unsigned alld = 1u;
#pragma unroll
            for (int i = 0; i < 8; ++i) alld &= flags[i];
            if (alld) break; }
        if (it + 1 < ntile) E1_LOAD((KIND == 2) ? (j - 1) : (j + 1));
        if (!(KIND == 2 && wave_done)) {
            f32x16 p0, p1;
#pragma unroll
            for (int r = 0; r < 16; ++r) { p0[r] = 0.f; p1[r] = 0.f; }
            { const LAS unsigned char* kp_ = buf + E1_K + r32 * KROW + hh * 16;
#pragma unroll
              for (int d0 = 0; d0 < 4; ++d0) { const bf16x8 a0 = *(const LAS bf16x8*)(kp_ + d0 * 32), a1 = *(const LAS bf16x8*)(kp_ + 32 * KROW + d0 * 32);
                  p0 = __builtin_amdgcn_mfma_f32_32x32x16_bf16(a0, qf[d0], p0, 0, 0, 0); p1 = __builtin_amdgcn_mfma_f32_32x32x16_bf16(a1, qf[d0], p1, 0, 0, 0); } }
            const int kb = j * 64 + 4 * hh;
            if (KIND == 2) {
                float lk0[16], lk1[16], gs[8];
#pragma unroll
                for (int reg = 0; reg < 16; ++reg) { const int kpos = kb + CROW(reg, 0);
                    const float z0 = p0[reg] * SCALE, z1 = p1[reg] * SCALE; const bool v0 = kpos < tq, v1 = kpos + 32 < tq;
                    const float lb0 = fminf(z0, 0.f) - __logf(1.f + __expf(-fabsf(z0))), lb1 = fminf(z1, 0.f) - __logf(1.f + __expf(-fabsf(z1)));
                    lk0[reg] = v0 ? (lb0 - z0) : 0.f; lk1[reg] = v1 ? (lb1 - z1) : 0.f;
                    p0[reg] = v0 ? lb0 : -INFINITY; p1[reg] = v1 ? lb1 : -INFINITY; }
#pragma unroll
                for (int g4 = 0; g4 < 4; ++g4) { gs[g4] = (lk0[4 * g4] + lk0[4 * g4 + 1]) + (lk0[4 * g4 + 2] + lk0[4 * g4 + 3]); gs[4 + g4] = (lk1[4 * g4] + lk1[4 * g4 + 1]) + (lk1[4 * g4 + 2] + lk1[4 * g4 + 3]); }
                float oth[8];
#pragma unroll
                for (int gi = 0; gi < 8; ++gi) oth[gi] = __shfl_xor(gs[gi], 32);
                float run = 0.f;
#pragma unroll
                for (int gi = 7; gi >= 0; --gi) {
                    float later = carry + run + (hh == 0 ? oth[gi] : 0.f);
#pragma unroll
                    for (int e = 3; e >= 0; --e) { const int reg = (gi & 3) * 4 + e;
                        if (gi >> 2) { p1[reg] = __expf(p1[reg] + later); later += lk1[reg]; } else { p0[reg] = __expf(p0[reg] + later); later += lk0[reg]; } }
                    run += gs[gi] + oth[gi]; }
                carry += run;
            } else {
                if (KIND == 0) {
                    const LAS float* cs = (const LAS float*)(buf + E1_C) + 4 * hh;
#pragma unroll
                    for (int i = 0; i < 4; ++i) { const f32x4 c0 = *(const LAS f32x4*)(cs + 8 * i), c1 = *(const LAS f32x4*)(cs + 32 + 8 * i);
#pragma unroll
                        for (int e = 0; e < 4; ++e) { const int reg = 4 * i + e; const int kpos = kb + CROW(reg, 0);
                            const float s0 = p0[reg] * (SCALE * LOG2E) + (ct2 - c0[e]), s1 = p1[reg] * (SCALE * LOG2E) + (ct2 - c1[e]);
                            p0[reg] = (kpos <= tq) ? s0 : -INFINITY; p1[reg] = (kpos + 32 <= tq) ? s1 : -INFINITY; } }
                } else {
#pragma unroll
                    for (int reg = 0; reg < 16; ++reg) { const int kpos = kb + CROW(reg, 0); const float d0f = tqf - (float)kpos, d1f = d0f - 32.f;
                        const float s0 = p0[reg] * (SCALE * LOG2E) - sl2 * d0f, s1 = p1[reg] * (SCALE * LOG2E) - sl2 * d1f;
                        p0[reg] = (kpos <= tq && tq - kpos < 512) ? s0 : -INFINITY; p1[reg] = (kpos + 32 <= tq && tq - kpos - 32 < 512) ? s1 : -INFINITY; }
                }
                float rm = fmaxf(p0[0], p1[0]);
#pragma unroll
                for (int reg = 1; reg < 16; ++reg) rm = fmaxf(rm, fmaxf(p0[reg], p1[reg]));
                rm = fmaxf(rm, __shfl_xor(rm, 32));
                if (__any(rm > m + RESC_THR)) { const float mn = fmaxf(m, rm), al = __builtin_amdgcn_exp2f(m - mn); l *= al;
#pragma unroll
                    for (int r = 0; r < 16; ++r) { o0[r] *= al; o1[r] *= al; }
                    m = mn; }
                float ls = 0.f;
#pragma unroll
                for (int reg = 0; reg < 16; ++reg) { p0[reg] = __builtin_amdgcn_exp2f(p0[reg] - m); p1[reg] = __builtin_amdgcn_exp2f(p1[reg] - m); ls += p0[reg] + p1[reg]; }
                l += ls;
            }
            { const LAS unsigned char* vp_ = buf + E1_V + r32 * VROW + hh * 8;
#pragma unroll
              for (int s = 0; s < 4; ++s) {
                  u32x4 pw;
                  if (s < 2) { pw.x = cvtpk(p0[8 * s + 0], p0[8 * s + 1]); pw.y = cvtpk(p0[8 * s + 2], p0[8 * s + 3]); pw.z = cvtpk(p0[8 * s + 4], p0[8 * s + 5]); pw.w = cvtpk(p0[8 * s + 6], p0[8 * s + 7]); }
                  else { const int s2 = s - 2; pw.x = cvtpk(p1[8 * s2 + 0], p1[8 * s2 + 1]); pw.y = cvtpk(p1[8 * s2 + 2], p1[8 * s2 + 3]); pw.z = cvtpk(p1[8 * s2 + 4], p1[8 * s2 + 5]); pw.w = cvtpk(p1[8 * s2 + 6], p1[8 * s2 + 7]); }
                  const bf16x8 pb = __builtin_bit_cast(bf16x8, pw);
                  const u32x2 a0l = *(const LAS u32x2*)(vp_ + s * 32), a0h = *(const LAS u32x2*)(vp_ + s * 32 + 16);
                  const u32x2 a1l = *(const LAS u32x2*)(vp_ + 32 * VROW + s * 32), a1h = *(const LAS u32x2*)(vp_ + 32 * VROW + s * 32 + 16);
                  const bf16x8 va0 = __builtin_bit_cast(bf16x8, (u32x4){a0l.x, a0l.y, a0h.x, a0h.y}), va1 = __builtin_bit_cast(bf16x8, (u32x4){a1l.x, a1l.y, a1h.x, a1h.y});
                  o0 = __builtin_amdgcn_mfma_f32_32x32x16_bf16(va0, pb, o0, 0, 0, 0); o1 = __builtin_amdgcn_mfma_f32_32x32x16_bf16(va1, pb, o1, 0, 0, 0); } }
            if (KIND == 2) { const bool dn = __all(carry < -110.f);
                if (dn && !wave_done) { wave_done = true; if (lane == 0) flags[w] = 1u; } }
        }
    }
    float inv = 1.f, gate = 1.f;
    if (KIND != 2) { l += __shfl_xor(l, 32); inv = (l > 0.f) ? 1.f / l : 0.f; }
    float* orow;
    if (KIND == 0) orow = obase + (size_t)(b * S_ + tq) * D_ + 512 + h * 64;
    else if (KIND == 2) orow = obase + (size_t)(b * S_ + tq) * D_ + 768 + h * 64;
    else { orow = owin + (size_t)(b * S_ + tq) * 512 + h * 64; gate = WSP(float, O_GF)[(size_t)(b * S_ + tq) * 32 + 2 * 8 + h]; }
    const float sc = inv * gate;
#pragma unroll
    for (int i = 0; i < 4; ++i) {
        *(f32x4*)(orow + 8 * i + 4 * hh) = (f32x4){o0[4 * i] * sc, o0[4 * i + 1] * sc, o0[4 * i + 2] * sc, o0[4 * i + 3] * sc};
        *(f32x4*)(orow + 32 + 8 * i + 4 * hh) = (f32x4){o1[4 * i] * sc, o1[4 * i + 1] * sc, o1[4 * i + 2] * sc, o1[4 * i + 3] * sc}; }
#undef E1_LOAD
#undef E1_WRITE
}
}
namespace mk {
typedef short v4i16_t __attribute__((ext_vector_type(4)));
constexpr int E2_WAVE = 64 * KROW + 512;
template <bool USE_MASK>
__device__ __forceinline__ void e2_wave_unit(LAS unsigned char* ldsw, KP p, int b, int g, int t0, float* __restrict__ obase, const float* __restrict__ csrc, int cpitch) {
    const int lane = ftid() & 63, r32 = lane & 31, hh = lane >> 5, qi = r32 >> 2, r4 = r32 & 3;
    const int h = 4 * g + r4, tq = t0 + qi;
    const bf16_t* projb = WSP(bf16_t, O_PROJB);
    const bf16_t* kbase = projb + (size_t)(b * S_) * PB + C_KV + ((1 * 2 + 0) * 2 + g) * 64;
    const bf16_t* vbase = projb + (size_t)(b * S_) * PB + C_KV + ((1 * 2 + 1) * 2 + g) * 64;
    bf16x8 qf[4];
    { const bf16_t* qptr = projb + (size_t)(b * S_ + tq) * PB + h * 64 + 8 * hh;
#pragma unroll
      for (int d0 = 0; d0 < 4; ++d0) qf[d0] = *(const bf16x8*)(qptr + 16 * d0); }
    unsigned qm0 = 0u, qm1 = 0u, qm2 = 0u, qm3 = 0u;
    if (USE_MASK) { const u32x4 mw = *(const u32x4*)(WSP(unsigned, O_SELMASK) + ((size_t)((b * 2 + g) * S_ + t0 + (lane >> 3))) * 4); qm0 = mw.x; qm1 = mw.y; qm2 = mw.z; qm3 = mw.w; }
    else { const int* sp = WSP(int, O_SEL) + ((size_t)((b * 2 + g) * S_ + t0)) * NSEL + lane * 2;
      const int e0 = sp[0], e1 = sp[1];
#pragma unroll
      for (int k = 0; k < 2; ++k) { const int e = k ? e1 : e0; const unsigned bit = 1u << (e & 31); const int wd = e >> 5;
          qm0 |= (wd == 0) ? bit : 0u; qm1 |= (wd == 1) ? bit : 0u; qm2 |= (wd == 2) ? bit : 0u; qm3 |= (wd == 3) ? bit : 0u; }
#pragma unroll
      for (int o = 1; o < 8; o <<= 1) { qm0 |= __shfl_xor(qm0, o); qm1 |= __shfl_xor(qm1, o); qm2 |= __shfl_xor(qm2, o); qm3 |= __shfl_xor(qm3, o); } }
    const unsigned rm0 = __shfl(qm0, qi * 8), rm1 = __shfl(qm1, qi * 8), rm2 = __shfl(qm2, qi * 8), rm3 = __shfl(qm3, qi * 8);
    unsigned um0 = qm0, um1 = qm1, um2 = qm2, um3 = qm3;
#pragma unroll
    for (int o = 8; o < 64; o <<= 1) { um0 |= __shfl_xor(um0, o); um1 |= __shfl_xor(um1, o); um2 |= __shfl_xor(um2, o); um3 |= __shfl_xor(um3, o); }
    LAS int* list = (LAS int*)(ldsw + 64 * KROW);
    int nblk;
    { const bool s0 = (((lane < 32) ? um0 : um1) >> (lane & 31)) & 1u, s1 = (((lane < 32) ? um2 : um3) >> (lane & 31)) & 1u;
      const unsigned long long b0 = __ballot(s0), b1 = __ballot(s1);
      const unsigned long long lower = (lane == 0) ? 0ull : (~0ull >> (64 - lane));
      const int n0 = __popcll(b0);
      if (s0) list[__popcll(b0 & lower)] = lane;
      if (s1) list[n0 + __popcll(b1 & lower)] = lane + 64;
      nblk = n0 + __popcll(b1); }
    asm volatile("s_waitcnt lgkmcnt(0)" ::: "memory");
    const float sl2 = exp2f(-(float)(h + 1)) * LOG2E, tqf = (float)tq;
    f32x16 o0, o1;
#pragma unroll
    for (int r = 0; r < 16; ++r) { o0[r] = 0.f; o1[r] = 0.f; }
    float m = -1e30f, l = 0.f;
    const int vrow = lane >> 3, vch = lane & 7;
    const int gq = lane >> 4, li = lane & 15;
    const LAS unsigned char* trb = ldsw + (4 * hh + (li >> 2)) * KROW + (16 * (gq & 1) + 4 * (li & 3)) * 2;
    bf16x8 kn0[4], kn1[4]; u32x4 vn[8];
#define E2_LOAD(blk) do { const bf16_t* kp_ = kbase + (size_t)((blk) * 64 + r32) * PB + 8 * hh; const bf16_t* vp_ = vbase + (size_t)((blk) * 64 + vrow) * PB + vch * 8; \
        _Pragma("unroll") for (int d0 = 0; d0 < 4; ++d0) { kn0[d0] = *(const bf16x8*)(kp_ + 16 * d0); kn1[d0] = *(const bf16x8*)(kp_ + (size_t)32 * PB + 16 * d0); } \
        _Pragma("unroll") for (int i = 0; i < 8; ++i) vn[i] = *(const u32x4*)(vp_ + (size_t)(8 * i) * PB); } while (0)
    int blk = list[0];
    blk = __builtin_amdgcn_readfirstlane(blk);
    E2_LOAD(blk);
    for (int it = 0; it < nblk; ++it) {
#pragma unroll
        for (int i = 0; i < 8; ++i) *(LAS u32x4*)(ldsw + (vrow + 8 * i) * KROW + vch * 16) = vn[i];
        const int cur = blk;
        f32x16 p0, p1;
#pragma unroll
        for (int r = 0; r < 16; ++r) { p0[r] = 0.f; p1[r] = 0.f; }
#pragma unroll
        for (int d0 = 0; d0 < 4; ++d0) { p0 = __builtin_amdgcn_mfma_f32_32x32x16_bf16(kn0[d0], qf[d0], p0, 0, 0, 0); p1 = __builtin_amdgcn_mfma_f32_32x32x16_bf16(kn1[d0], qf[d0], p1, 0, 0, 0); }
        if (it + 1 < nblk) { blk = __builtin_amdgcn_readfirstlane(list[it + 1]); E2_LOAD(blk); }
        const unsigned rw = (cur < 32) ? rm0 : (cur < 64) ? rm1 : (cur < 96) ? rm2 : rm3;
        const bool rowsel = (rw >> (cur & 31)) & 1u;
        const int kb = cur * 64 + 4 * hh;
#pragma unroll
        for (int reg = 0; reg < 16; ++reg) { const int kpos = kb + CROW(reg, 0); const float d0f = tqf - (float)kpos, d1f = d0f - 32.f;
            const float s0 = p0[reg] * (SCALE * LOG2E) - sl2 * d0f, s1 = p1[reg] * (SCALE * LOG2E) - sl2 * d1f;
            p0[reg] = (rowsel && kpos <= tq) ? s0 : -INFINITY; p1[reg] = (rowsel && kpos + 32 <= tq) ? s1 : -INFINITY; }
        float rmx = fmaxf(p0[0], p1[0]);
#pragma unroll
        for (int reg = 1; reg < 16; ++reg) rmx = fmaxf(rmx, fmaxf(p0[reg], p1[reg]));
        rmx = fmaxf(rmx, __shfl_xor(rmx, 32));
        if (__any(rmx > m + RESC_THR)) { const float mn = fmaxf(m, rmx), al = __builtin_amdgcn_exp2f(m - mn); l *= al;
#pragma unroll
            for (int r = 0; r < 16; ++r) { o0[r] *= al; o1[r] *= al; }
            m = mn; }
        float ls = 0.f;
#pragma unroll
        for (int reg = 0; reg < 16; ++reg) { p0[reg] = __builtin_amdgcn_exp2f(p0[reg] - m); p1[reg] = __builtin_amdgcn_exp2f(p1[reg] - m); ls += p0[reg] + p1[reg]; }
        l += ls;
#pragma unroll
        for (int s = 0; s < 4; ++s) {
            u32x4 pw;
            if (s < 2) { pw.x = cvtpk(p0[8 * s + 0], p0[8 * s + 1]); pw.y = cvtpk(p0[8 * s + 2], p0[8 * s + 3]); pw.z = cvtpk(p0[8 * s + 4], p0[8 * s + 5]); pw.w = cvtpk(p0[8 * s + 6], p0[8 * s + 7]); }
            else { const int s2 = s - 2; pw.x = cvtpk(p1[8 * s2 + 0], p1[8 * s2 + 1]); pw.y = cvtpk(p1[8 * s2 + 2], p1[8 * s2 + 3]); pw.z = cvtpk(p1[8 * s2 + 4], p1[8 * s2 + 5]); pw.w = cvtpk(p1[8 * s2 + 6], p1[8 * s2 + 7]); }
            const bf16x8 pb = __builtin_bit_cast(bf16x8, pw);
            const v4i16_t a0l = __builtin_amdgcn_ds_read_tr16_b64_v4i16((LAS v4i16_t*)(trb + (16 * s) * KROW)), a0h = __builtin_amdgcn_ds_read_tr16_b64_v4i16((LAS v4i16_t*)(trb + (16 * s + 8) * KROW));
            const v4i16_t a1l = __builtin_amdgcn_ds_read_tr16_b64_v4i16((LAS v4i16_t*)(trb + (16 * s) * KROW + 64)), a1h = __builtin_amdgcn_ds_read_tr16_b64_v4i16((LAS v4i16_t*)(trb + (16 * s + 8) * KROW + 64));
            const bf16x8 va0 = (bf16x8){a0l[0], a0l[1], a0l[2], a0l[3], a0h[0], a0h[1], a0h[2], a0h[3]}, va1 = (bf16x8){a1l[0], a1l[1], a1l[2], a1l[3], a1h[0], a1h[1], a1h[2], a1h[3]};
            o0 = __builtin_amdgcn_mfma_f32_32x32x16_bf16(va0, pb, o0, 0, 0, 0); o1 = __builtin_amdgcn_mfma_f32_32x32x16_bf16(va1, pb, o1, 0, 0, 0); }
    }
    l += __shfl_xor(l, 32);
    const float sc = ((l > 0.f) ? 1.f / l : 0.f) * WSP(float, O_GF)[(size_t)(b * S_ + tq) * 32 + 1 * 8 + h];
    float* orow = obase + (size_t)(b * S_ + tq) * D_ + h * 64; const float* crow = csrc + (size_t)(b * S_ + tq) * cpitch + h * 64;
#pragma unroll
    for (int i = 0; i < 4; ++i) {
        f32x4 x0 = *(const f32x4*)(crow + 8 * i + 4 * hh), x1 = *(const f32x4*)(crow + 32 + 8 * i + 4 * hh);
        x0 += (f32x4){o0[4 * i] * sc, o0[4 * i + 1] * sc, o0[4 * i + 2] * sc, o0[4 * i + 3] * sc}; x1 += (f32x4){o1[4 * i] * sc, o1[4 * i + 1] * sc, o1[4 * i + 2] * sc, o1[4 * i + 3] * sc};
        *(f32x4*)(orow + 8 * i + 4 * hh) = x0; *(f32x4*)(orow + 32 + 8 * i + 4 * hh) = x1; }
#undef E2_LOAD
}
template <bool USE_MASK>
__device__ __forceinline__ void ph_attn_sel2(LAS unsigned char* lds3, KP p, float* __restrict__ obase, const float* __restrict__ csrc, int cpitch) {
    const int w = __builtin_amdgcn_readfirstlane(ftid() >> 6);
    LAS unsigned char* ldsw = lds3 + w * E2_WAVE;
    MK_LOOP(u, 512) { const int bg = u & 3, qblk = u >> 2; e2_wave_unit<USE_MASK>(ldsw, p, bg >> 1, bg & 1, qblk * 64 + 8 * w, obase, csrc, cpitch); }
}
}
namespace mk {
constexpr int E3_K = 0, E3_V = 512 * KROW, E3_BYTES = 2 * 512 * KROW;
__device__ __forceinline__ void e3_unit(LAS unsigned char* lds, KP p, int b, int g, int qb, float* __restrict__ ocmp, unsigned* __restrict__ selmask) {
    const int tid = ftid(), lane = tid & 63, w = __builtin_amdgcn_readfirstlane(tid >> 6), r32 = lane & 31, hh = lane >> 5;
    const int bg = b * 2 + g, q0 = qb * 256, qrow0 = q0 + 32 * w, tq = qrow0 + r32;
    const bf16_t* projb = WSP(bf16_t, O_PROJB);
    int nun = (q0 + 255 - 31) / 16 + 1; if (nun > 511) nun = 511;
    const int ntile_u = (nun + 63) >> 6;
    __syncthreads();
    { const int srow = tid >> 3, sch = tid & 7; const bf16_t* ks = WSP(bf16_t, O_KCMPB) + ((size_t)bg * 512 + srow) * 64 + sch * 8; const bf16_t* vs = WSP(bf16_t, O_VCMPB) + ((size_t)bg * 512 + srow) * 64 + sch * 8;
      for (int i = 0; i < ntile_u; ++i) { const u32x4 kv = *(const u32x4*)(ks + (size_t)i * 64 * 64), vv = *(const u32x4*)(vs + (size_t)i * 64 * 64);
          *(LAS u32x4*)(lds + E3_K + (srow + 64 * i) * KROW + sch * 16) = kv; *(LAS u32x4*)(lds + E3_V + (srow + 64 * i) * KROW + sch * 16) = vv; } }
    __syncthreads();
    int nw = qrow0 / 16 + 1; if (nw > 511) nw = 511;
    const int ntile_w = (qrow0 + 31 < 31) ? 0 : ((nw + 63) >> 6);
    const float tqf = (float)tq;
    const int gq = lane >> 4, li = lane & 15;
    const LAS unsigned char* trb = lds + E3_V + (4 * hh + (li >> 2)) * KROW + (16 * (gq & 1) + 4 * (li & 3)) * 2;
    const LAS unsigned char* kfb = lds + E3_K + r32 * KROW + hh * 16;
    float imp[64];
#pragma unroll
    for (int i = 0; i < 64; ++i) imp[i] = 0.f;
#pragma unroll 1
    for (int r4 = 0; r4 < 4; ++r4) {
        const int h = 4 * g + r4; const float sl2 = exp2f(-(float)(h + 1)) * LOG2E;
        bf16x8 qf[4];
        { const bf16_t* qptr = projb + (size_t)(b * S_ + tq) * PB + h * 64 + 8 * hh;
#pragma unroll
          for (int d0 = 0; d0 < 4; ++d0) qf[d0] = *(const bf16x8*)(qptr + 16 * d0); }
        f32x16 o0, o1;
#pragma unroll
        for (int r = 0; r < 16; ++r) { o0[r] = 0.f; o1[r] = 0.f; }
        float m = -1e30f, l = 0.f;
#define E3_ST(jt) f32x16 p0, p1; { _Pragma("unroll") for (int r = 0; r < 16; ++r) { p0[r] = 0.f; p1[r] = 0.f; } \
            _Pragma("unroll") for (int d0 = 0; d0 < 4; ++d0) { const bf16x8 a0 = *(const LAS bf16x8*)(kfb + (64 * (jt)) * KROW + d0 * 32), a1 = *(const LAS bf16x8*)(kfb + (64 * (jt) + 32) * KROW + d0 * 32); \
                p0 = __builtin_amdgcn_mfma_f32_32x32x16_bf16(a0, qf[d0], p0, 0, 0, 0); p1 = __builtin_amdgcn_mfma_f32_32x32x16_bf16(a1, qf[d0], p1, 0, 0, 0); } \
            int tq_ = tq; asm volatile("" : "+v"(tq_));     \
            int hh_ = hh; asm volatile("" : "+v"(hh_)); \
            const float tqf_ = (float)tq_; const int ce0_ = 16 * (64 * (jt) + 4 * hh_) + 31; \
            _Pragma("unroll") for (int reg = 0; reg < 16; ++reg) { const int ce = ce0_ + 16 * CROW(reg, 0); const float d0f = tqf_ - (float)ce, d1f = d0f - 512.f; \
                const float s0 = p0[reg] * (SCALE * LOG2E) - sl2 * d0f, s1 = p1[reg] * (SCALE * LOG2E) - sl2 * d1f; \
                p0[reg] = (ce <= tq_) ? s0 : -INFINITY; p1[reg] = (ce + 512 <= tq_) ? s1 : -INFINITY; } }
        for (int jt = 0; jt < ntile_w; ++jt) {
            E3_ST(jt);
            float rmx = fmaxf(p0[0], p1[0]);
#pragma unroll
            for (int reg = 1; reg < 16; ++reg) rmx = fmaxf(rmx, fmaxf(p0[reg], p1[reg]));
            rmx = fmaxf(rmx, __shfl_xor(rmx, 32));
            if (__any(rmx > m + RESC_THR)) { const float mn = fmaxf(m, rmx), al = __builtin_amdgcn_exp2f(m - mn); l *= al;
#pragma unroll
                for (int r = 0; r < 16; ++r) { o0[r] *= al; o1[r] *= al; }
                m = mn; }
            float ls = 0.f;
#pragma unroll
            for (int reg = 0; reg < 16; ++reg) { p0[reg] = __builtin_amdgcn_exp2f(p0[reg] - m); p1[reg] = __builtin_amdgcn_exp2f(p1[reg] - m); ls += p0[reg] + p1[reg]; }
            l += ls;
            const LAS unsigned char* tb = trb + (64 * jt) * KROW;
#pragma unroll
            for (int s = 0; s < 4; ++s) {
                u32x4 pw;
                if (s < 2) { pw.x = cvtpk(p0[8 * s + 0], p0[8 * s + 1]); pw.y = cvtpk(p0[8 * s + 2], p0[8 * s + 3]); pw.z = cvtpk(p0[8 * s + 4], p0[8 * s + 5]); pw.w = cvtpk(p0[8 * s + 6], p0[8 * s + 7]); }
                else { const int s2 = s - 2; pw.x = cvtpk(p1[8 * s2 + 0], p1[8 * s2 + 1]); pw.y = cvtpk(p1[8 * s2 + 2], p1[8 * s2 + 3]); pw.z = cvtpk(p1[8 * s2 + 4], p1[8 * s2 + 5]); pw.w = cvtpk(p1[8 * s2 + 6], p1[8 * s2 + 7]); }
                const bf16x8 pb = __builtin_bit_cast(bf16x8, pw);
                const v4i16_t a0l = __builtin_amdgcn_ds_read_tr16_b64_v4i16((LAS v4i16_t*)(tb + (16 * s) * KROW)), a0h = __builtin_amdgcn_ds_read_tr16_b64_v4i16((LAS v4i16_t*)(tb + (16 * s + 8) * KROW));
                const v4i16_t a1l = __builtin_amdgcn_ds_read_tr16_b64_v4i16((LAS v4i16_t*)(tb + (16 * s) * KROW + 64)), a1h = __builtin_amdgcn_ds_read_tr16_b64_v4i16((LAS v4i16_t*)(tb + (16 * s + 8) * KROW + 64));
                const bf16x8 va0 = (bf16x8){a0l[0], a0l[1], a0l[2], a0l[3], a0h[0], a0h[1], a0h[2], a0h[3]}, va1 = (bf16x8){a1l[0], a1l[1], a1l[2], a1l[3], a1h[0], a1h[1], a1h[2], a1h[3]};
                o0 = __builtin_amdgcn_mfma_f32_32x32x16_bf16(va0, pb, o0, 0, 0, 0); o1 = __builtin_amdgcn_mfma_f32_32x32x16_bf16(va1, pb, o1, 0, 0, 0); }
        }
        l += __shfl_xor(l, 32);
        const float inv = (l > 0.f) ? 1.f / l : 0.f;
        { const float sc = inv * WSP(float, O_GF)[(size_t)(b * S_ + tq) * 32 + 0 * 8 + h];
          float* orow = ocmp + (size_t)(b * S_ + tq) * 512 + h * 64;
#pragma unroll
          for (int i = 0; i < 4; ++i) {
              *(f32x4*)(orow + 8 * i + 4 * hh) = (f32x4){o0[4 * i] * sc, o0[4 * i + 1] * sc, o0[4 * i + 2] * sc, o0[4 * i + 3] * sc};
              *(f32x4*)(orow + 32 + 8 * i + 4 * hh) = (f32x4){o1[4 * i] * sc, o1[4 * i + 1] * sc, o1[4 * i + 2] * sc, o1[4 * i + 3] * sc}; } }
#pragma unroll
        for (int jt = 0; jt < 8; ++jt) {
            if (jt < ntile_w) {
                E3_ST(jt);
#pragma unroll
                for (int reg = 0; reg < 16; ++reg) { p0[reg] = __builtin_amdgcn_exp2f(p0[reg] - m) * inv; p1[reg] = __builtin_amdgcn_exp2f(p1[reg] - m) * inv; }
#pragma unroll
                for (int pa = 0; pa < 2; ++pa)
#pragma unroll
                    for (int i = 0; i < 4; ++i) { const int jj = 8 * jt + 4 * pa + i;
                        const float x0 = pa ? p1[4 * i] : p0[4 * i], x1 = pa ? p1[4 * i + 1] : p0[4 * i + 1], x2 = pa ? p1[4 * i + 2] : p0[4 * i + 2], x3 = pa ? p1[4 * i + 3] : p0[4 * i + 3];
                        const float c = 0.5f * x3, a = (x0 + x1) + (x2 + c), r = __shfl_xor(c, 32);
                        imp[jj] += a + (hh ? r : 0.f);
                        if (jj + 1 < 64) imp[jj + 1] += (hh ? 0.f : r); }
            }
        }
#undef E3_ST
    }
    const int cur = tq >> 6;
#pragma unroll
    for (int jj = 0; jj < 64; ++jj) { const int j = 2 * jj + hh; imp[jj] = (j != 0 && j < cur - 1) ? imp[jj] : -1.f; }
    unsigned m0 = 1u, m1 = 0u, m2 = 0u, m3 = 0u;
#define E3_SETBIT(j) do { const unsigned bit_ = 1u << ((j) & 31); const int wd_ = (j) >> 5; m0 |= (wd_ == 0) ? bit_ : 0u; m1 |= (wd_ == 1) ? bit_ : 0u; m2 |= (wd_ == 2) ? bit_ : 0u; m3 |= (wd_ == 3) ? bit_ : 0u; } while (0)
    E3_SETBIT(cur); if (cur >= 1) E3_SETBIT(cur - 1);
#pragma unroll 1
    for (int it = 0; it < NSEL - 3; ++it) {
        float best = -0.5f; int bj = 0;
#pragma unroll
        for (int jj = 0; jj < 64; ++jj) { if (imp[jj] > best) { best = imp[jj]; bj = jj; } }
        const int myj = 2 * bj + hh; const float ob = __shfl_xor(best, 32); const int oj = __shfl_xor(myj, 32);
        const bool mine = (best > ob) || (best == ob && myj < oj);
        const float wv = mine ? best : ob; const int wj = mine ? myj : oj;
        if (wv >= 0.f) E3_SETBIT(wj);
        if (mine && best >= 0.f) {
#pragma unroll
            for (int jj = 0; jj < 64; ++jj) imp[jj] = (jj == bj) ? -2.f : imp[jj]; }
    }
#undef E3_SETBIT
    if (hh == 0) *(u32x4*)(selmask + ((size_t)bg * S_ + tq) * 4) = (u32x4){m0, m1, m2, m3};
}
}
namespace mk {
template <int CMPMODE>
__device__ __forceinline__ void ph_attn1(float* lds, LAS unsigned char* lds3, KP p, unsigned* qctr, float* obase, float* owin) {
    LAS int* qslot = (LAS int*)(lds3 + E3_BYTES);
    constexpr int N_E3 = (CMPMODE & 2) ? 128 : 0, N_CMP = (CMPMODE & 1) ? 64 : 0, N_FOX = 256, N_WIN = 512, N_SB = 256;
    for (;;) {
        __syncthreads();
        if (ftid() == 0) *qslot = (int)atomicAdd(qctr, 1u);
        __syncthreads();
        int u = __builtin_amdgcn_readfirstlane(*qslot);
        if (u >= N_E3 + N_CMP + N_FOX + N_WIN + N_SB) break;
        if (u < N_E3) { e3_unit(lds3, p, (u & 3) >> 1, u & 1, 31 - (u >> 2), WSP(float, O_OCMP), WSP(unsigned, O_SELMASK)); continue; } u -= N_E3;
        if (u < N_CMP) { attn_vblock<3>(lds, p, 15 - (u >> 2), u & 3); continue; } u -= N_CMP;
        if (u < N_FOX) { e1_unit<0>(lds3, p, (u & 7) >> 2, u & 3, 31 - (u >> 3), obase, owin); continue; } u -= N_FOX;
        if (u < N_WIN) { e1_unit<1>(lds3, p, (u & 3) >> 1, u & 1, 127 - (u >> 2), obase, owin); continue; } u -= N_WIN;
        e1_unit<2>(lds3, p, (u & 7) >> 2, u & 3, 31 - (u >> 3), obase, owin);
    }
}
__device__ __forceinline__ void ph_dbg_compare_cmp(KP p) {
    float num = 0.f, den = 0.f;
    for (size_t i = (size_t)fbid() * NT + ftid(); i < (size_t)T_ * 512; i += (size_t)gridDim.x * NT) { const size_t row = i >> 9; const int c = (int)(i & 511);
        const float a = WSP(float, O_OCMP)[i], b = WSP(float, O_O)[row * D_ + c]; num += (a - b) * (a - b); den += b * b; }
    float* dbg = WSP(float, O_COUNTS) + 256; const float n = wsum(num), d = wsum(den);
    if ((ftid() & 63) == 0) { atomicAdd(&dbg[8], n); atomicAdd(&dbg[9], d); }
}
__device__ __forceinline__ void ph_dbg_compare_sel(KP p) {
    float num = 0.f, den = 0.f;
    for (int i = fbid() * NT + ftid(); i < B_ * 2 * S_; i += gridDim.x * NT) {
        unsigned m[4] = {0u, 0u, 0u, 0u}; const int t = i % S_, cur = t >> 6;
        for (int k = 0; k < NSEL; ++k) { const int e = WSP(int, O_SEL)[(size_t)i * NSEL + k]; if (e <= cur) { if ((e >> 5) == 0) m[0] |= 1u << (e & 31); else if ((e >> 5) == 1) m[1] |= 1u << (e & 31); else if ((e >> 5) == 2) m[2] |= 1u << (e & 31); else m[3] |= 1u << (e & 31); } }
        const unsigned* sm = WSP(unsigned, O_SELMASK) + (size_t)i * 4;
        int diff = __popc(m[0] ^ sm[0]) + __popc(m[1] ^ sm[1]) + __popc(m[2] ^ sm[2]) + __popc(m[3] ^ sm[3]);
        num += (float)diff * 0.5f; den += 16.f; }
    float* dbg = WSP(float, O_COUNTS) + 256; const float n = wsum(num), d = wsum(den);
    if ((ftid() & 63) == 0) { atomicAdd(&dbg[10], n); atomicAdd(&dbg[11], d); }
}
__device__ __forceinline__ void ph_dbg_compare(KP p) {
    float num[3] = {0.f, 0.f, 0.f}, den[3] = {0.f, 0.f, 0.f};
    for (size_t i = (size_t)fbid() * NT + ftid(); i < (size_t)T_ * 512; i += (size_t)gridDim.x * NT) {
        const size_t row = i >> 9; const int c = (int)(i & 511);
        const float a = WSP(float, O_O2)[row * D_ + 512 + c], b = WSP(float, O_O)[row * D_ + 512 + c];
        const int k = c >> 8; num[k] += (a - b) * (a - b); den[k] += b * b;
        const float aw = WSP(float, O_OWIN2)[i], bw = WSP(float, O_OWIN)[i]; num[2] += (aw - bw) * (aw - bw); den[2] += bw * bw; }
    float* dbg = WSP(float, O_COUNTS) + 256;
#pragma unroll
    for (int k = 0; k < 3; ++k) { const float n = wsum(num[k]), d = wsum(den[k]); if ((ftid() & 63) == 0) { atomicAdd(&dbg[2 * k], n); atomicAdd(&dbg[2 * k + 1], d); } }
}
__device__ __forceinline__ void ph_dbg_copy_nsa(KP p) {
    for (size_t i = (size_t)fbid() * NT + ftid(); i < (size_t)T_ * 512; i += (size_t)gridDim.x * NT) { const size_t row = i >> 9; const int c = (int)(i & 511); WSP(float, O_O2)[row * D_ + c] = WSP(float, O_O)[row * D_ + c]; }
}
__device__ __forceinline__ void ph_dbg_compare_nsa(KP p) {
    float num = 0.f, den = 0.f;
    for (size_t i = (size_t)fbid() * NT + ftid(); i < (size_t)T_ * 512; i += (size_t)gridDim.x * NT) { const size_t row = i >> 9; const int c = (int)(i & 511);
        const float a = WSP(float, O_O2)[row * D_ + c], b = WSP(float, O_O)[row * D_ + c]; num += (a - b) * (a - b); den += b * b; }
    float* dbg = WSP(float, O_COUNTS) + 256; const float n = wsum(num), d = wsum(den);
    if ((ftid() & 63) == 0) { atomicAdd(&dbg[6], n); atomicAdd(&dbg[7], d); }
}
__device__ __forceinline__ void ph_dbg_encode(KP p, int ka, int kb) {
    const float* dbg = WSP(float, O_COUNTS) + 256;
    const float ea = sqrtf(dbg[2 * ka] / fmaxf(dbg[2 * ka + 1], 1e-30f)), eb = sqrtf(dbg[2 * kb] / fmaxf(dbg[2 * kb + 1], 1e-30f));
    for (size_t i = (size_t)fbid() * NT + ftid(); i < (size_t)T_ * D_; i += (size_t)gridDim.x * NT) { float v = p->out[i] * (1.f + 10.f * ea); if (i == 0) v += 1e4f * eb; p->out[i] = v; }
}
}
namespace mk {
#define RLX_AGENT __ATOMIC_RELAXED, __HIP_MEMORY_SCOPE_AGENT
#define XB_TMO      128
#define XB_XCNT(j)  (256  + 64 * (j))
#define XB_XSUB(j)  (1280 + 64 * (j))
#define XB_XGEN(j)  (2304 + 64 * (j))
#define XB_TOP      3328
#define XB_TOPGEN   3392
#define XCD_BAR_WORDS 3456
#define XB_SPIN_CAP (1u << 18)

__device__ __forceinline__ unsigned xb_ld(unsigned* p)              { return __hip_atomic_load(p, __ATOMIC_RELAXED, __HIP_MEMORY_SCOPE_AGENT); }
__device__ __forceinline__ unsigned xb_add(unsigned* p, unsigned v) { return __hip_atomic_fetch_add(p, v, __ATOMIC_RELAXED, __HIP_MEMORY_SCOPE_AGENT); }
__device__ __forceinline__ unsigned xb_xcc_id() { return (unsigned)__builtin_amdgcn_s_getreg((3 << 11) | 20) & 0xFu; }
#define XB_SPIN(cond, bar) do { unsigned _sp = 0; while (cond) { __builtin_amdgcn_s_sleep(1); \
    if ((++_sp & 255u) == 0u) { if (xb_ld(&(bar)[XB_TMO])) break; if (_sp > XB_SPIN_CAP) { atomicAdd(&(bar)[XB_TMO], 1u); break; } } } } while (0)

struct XcdBarrier {
    unsigned* bar; unsigned x;
    volatile LAS unsigned* st;
};

__device__ __forceinline__ XcdBarrier xcd_barrier_post(unsigned* bar, volatile LAS unsigned* st) {
    XcdBarrier b; b.bar = bar; b.x = xb_xcc_id(); b.st = st;
    if (threadIdx.x == 0) (void)xb_add(&bar[XB_XCNT(b.x)], 1u);
    return b;
}
__device__ __forceinline__ void xcd_barrier_complete(unsigned* bar, unsigned x, unsigned& nloc, unsigned& nx) {
    const unsigned G = gridDim.x * gridDim.y * gridDim.z;
    unsigned sum, cnt, mine, sp = 0u;
    for (;;) {
        sum = 0u; cnt = 0u; mine = 0u;
#pragma unroll
        for (unsigned j = 0; j < 16; ++j) { const unsigned c = xb_ld(&bar[XB_XCNT(j)]); sum += c; cnt += (c > 0u) ? 1u : 0u; mine = (j == x) ? c : mine; }
        if (sum == G) break;
        __builtin_amdgcn_s_sleep(1);
        if ((++sp & 255u) == 0u) { if (xb_ld(&bar[XB_TMO])) break; if (sp > XB_SPIN_CAP) { atomicAdd(&bar[XB_TMO], 1u); break; } }
    }
    nloc = mine > 0u ? mine : 1u; nx = cnt > 0u ? cnt : 1u;
}

__device__ __forceinline__ void xcd_barrier(const XcdBarrier& b) {
    asm volatile("s_waitcnt vmcnt(0)" ::: "memory");
    __syncthreads();
    if (threadIdx.x == 0) {
        unsigned* bar = b.bar;
        __builtin_amdgcn_s_waitcnt(0);
        unsigned nloc = b.st[0], nx = b.st[1];
        if (nloc == 0u) { xcd_barrier_complete(bar, b.x, nloc, nx); b.st[0] = nloc; b.st[1] = nx; }
        const unsigned old = xb_add(&bar[XB_XSUB(b.x)], 1u);
        const unsigned gen = old / nloc;
        if (old + 1u == (gen + 1u) * nloc) {
            __builtin_amdgcn_fence(__ATOMIC_RELEASE, "agent");
            asm volatile("s_waitcnt vmcnt(0)" ::: "memory");
            const unsigned og = xb_add(&bar[XB_TOP], 1u);
            const unsigned tg = og / nx;
            if (og + 1u == (tg + 1u) * nx) xb_add(&bar[XB_TOPGEN], 1u);
            else XB_SPIN(xb_ld(&bar[XB_TOPGEN]) == tg, bar);
            __builtin_amdgcn_fence(__ATOMIC_ACQUIRE, "agent");
            xb_add(&bar[XB_XGEN(b.x)], 1u);
            asm volatile("s_waitcnt vmcnt(0)" ::: "memory");
        } else {
            XB_SPIN(xb_ld(&bar[XB_XGEN(b.x)]) == gen, bar);
            __builtin_amdgcn_fence(__ATOMIC_ACQUIRE, "agent");
            asm volatile("s_waitcnt vmcnt(0)" ::: "memory");
        }
    }
    __syncthreads();
}

}
namespace cg = cooperative_groups;
constexpr int NSTEP = 12;
__global__ void __launch_bounds__(512, 2) mega(mk::P p_unused) {
    extern __shared__ __attribute__((aligned(16))) unsigned char lds_raw[];
    float* lds = (float*)lds_raw;
    LAS unsigned char* lds3 = (LAS unsigned char*)lds_raw;
    cg::grid_group grid = cg::this_grid();
    using namespace nv; using namespace mk;
    volatile LAS unsigned* bst = (volatile LAS unsigned*)(lds3 + E3_BYTES + 128);
    if (threadIdx.x < 2) bst[threadIdx.x] = 0u;
    __syncthreads();
    XcdBarrier bar;
    { const KP p = fresh_kp(); bar = xcd_barrier_post(WSP(unsigned, O_COUNTS + 16384), bst); }
    grid.sync();
    for (int step = 0; step < 1 + NSTEP * L_; ++step) {
        const KP p = fresh_kp();
        const int l = (step - 1) / NSTEP, k = (step == 0) ? -1 : (step - 1) % NSTEP;
        const bool isg = (k == 0 || k == 1 || k == 6 || k == 9 || k == 10);
#ifdef PROBE_K
        const int nrep = (k == PROBE_K) ? PROBE_N : 1;
#else
        const int nrep = 1;
#endif
        for (int rep = 0; rep < nrep; ++rep) {
        if (isg) {
            const int kind = (k == 0) ? 0 : (k == 1) ? 4 : (k == 6) ? 1 : (k == 9) ? 2 : 3;
            GSched S; GEpi E; S.kind = kind; E.kind = kind; E.l = l;
            S.G = (int)gridDim.x; S.c = fbid(); S.meta = WSP(int, O_META); S.rowtok = WSP(int, O_ROWTOK); S.estep = 0;
            const char* A; int N, K = D_;
            if (kind == 0) { A = (const char*)WSP(bf16_t, O_XB); S.Bt = (const char*)(WSP(bf16_t, O_WTIN) + (size_t)l * NPAD * D_); N = NPAD; }
            else if (kind == 1) { A = (const char*)WSP(bf16_t, O_OB); S.Bt = (const char*)(WSP(bf16_t, O_WTOUT) + (size_t)l * D_ * D_); N = D_; }
            else if (kind == 2) { A = (const char*)WSP(bf16_t, O_X1B); S.Bt = (const char*)(WSP(bf16_t, O_WTGU) + (size_t)l * NE * 2048 * D_); S.estep = (size_t)2048 * D_ * 2; N = 2048; }
            else if (kind == 3) { A = (const char*)WSP(bf16_t, O_ACT); S.Bt = (const char*)(WSP(bf16_t, O_WTDN) + (size_t)l * NE * D_ * D_); S.estep = (size_t)D_ * D_ * 2; N = D_; }
            else { A = (const char*)WSP(bf16_t, O_PROJB); S.Bt = (const char*)(WSP(bf16_t, O_WT1) + (size_t)l * 2 * 256 * 2048); S.estep = (size_t)256 * 2048 * 2; N = 256; K = 2048; }
            S.nN = N / 256; S.nM = (kind < 2) ? T_ / 256 : (kind == 4) ? 16 : S.meta[32]; S.nunits = S.nM * S.nN;
            pg8::gemm_phase<GEpi, GSched>(lds3, A, K, S, E);
            if (kind == 4) ph_cumsum(lds, p, 16);
            if (kind == 0) ph_bias1_reduce(p, l);
        } else {
            switch (k) {
                case -1: ph_convert(lds3, p); break;
                case 2: ph_prep2(p, l); break;
                case 3: ph_attn1<2>(lds, lds3, p, WSP(unsigned, O_COUNTS) + 128 + l * 8 + rep, WSP(float, O_O), WSP(float, O_OWIN)); break;
                case 4: ph_attn_sel2<true>(lds3, p, WSP(float, O_O), WSP(float, O_OCMP), 512); break;
                case 5: ph_rmsnorm(p, l); break;
                case 7: ph_ln<true>(lds, p, l, WSP(float, O_X1), (rep + 1 < nrep) ? 2048 * (rep + 1) : 0); break;
                case 8: ph_moe_scatter2(lds, p, l); break;
                default: { float* xout = (l == L_ - 1) ? p->out : WSP(float, O_XA); ph_ln<false>(lds, p, l, xout); } break;
            }
        }
        xcd_barrier(bar);
        }
    }
#ifdef PROBE_SYNC
    for (int i = 0; i < PROBE_SYNC; ++i) xcd_barrier(bar);
#endif
}

extern "C" void kernel_launch(void* const* d_in, const int* in_sizes, int n_in,
                              void* d_out, int out_size, void* d_ws, size_t ws_size,
                              hipStream_t stream) {
    constexpr size_t kDynLds = 147456 + 1024;
    static int grid_blocks = 0;
    if (!grid_blocks) {
        int dev = 0, cus = 0, per_cu = 0;
        (void)hipGetDevice(&dev);
        (void)hipDeviceGetAttribute(&cus, hipDeviceAttributeMultiprocessorCount, dev);
        (void)hipFuncSetAttribute((const void*)mega, hipFuncAttributeMaxDynamicSharedMemorySize, (int)kDynLds);
        (void)hipOccupancyMaxActiveBlocksPerMultiprocessor(&per_cu, mega, 512, kDynLds);
        if (per_cu < 1) per_cu = 1;
        if (per_cu > 1) per_cu = 1;
        grid_blocks = cus * per_cu;
        if (ws_size < mk::O_END) fprintf(stderr, "workspace too small: %zu < %zu\n", ws_size, (size_t)mk::O_END);
    }
    mk::P p{};
    p.in = nv::inputs(d_in); p.ws = (unsigned char*)d_ws; p.out = (float*)d_out;
    (void)hipMemsetAsync((char*)d_ws + mk::O_COUNTS, 0, 65536, stream);
    void* args[] = {&p};
    hipError_t e = hipLaunchCooperativeKernel((void*)mega, dim3(grid_blocks), dim3(512), args, kDynLds, stream);
    if (e != hipSuccess) fprintf(stderr, "cooperative launch failed: %s (grid %d)\n", hipGetErrorString(e), grid_blocks);
}
```

```cpp
#include <hip/hip_runtime.h>
#include <hip/hip_cooperative_groups.h>
#include <cstdio>
#include <cstdint>

namespace nv {

constexpr int B_ = 2, S_ = 8192, D_ = 1024, T_ = B_ * S_, L_ = 2;
constexpr int DIN = 2844;
constexpr int OFF_NSA_KV = 512, OFF_NSA_GATE = 1280, OFF_FOX_QKV = 1304, OFF_FOX_F = 2072, OFF_SB_QKV = 2076;
constexpr int NCMP = 511, NBLK = 128, NSEL = 16;
constexpr int NE = 32, TOPK = 4, MROWS = T_ * TOPK;
constexpr float LN_EPS = 1e-5f, RMS_EPS = 1e-6f;
constexpr float ALPHA = 1.4142135623730951f;
constexpr float SCALE = 0.125f;

__device__ __forceinline__ float sigmoidf_(float x) { return 1.f / (1.f + __expf(-x)); }
__device__ __forceinline__ float logsig(float x) { return fminf(x, 0.f) - log1pf(expf(-fabsf(x))); }

__device__ __forceinline__ float gelu_tanh(float x) { return 0.5f * x * (1.f + tanhf(0.7978845608028654f * (x + 0.044715f * x * x * x))); }
#define NV_DOT(q, kr, res) do { float s0_ = 0.f, s1_ = 0.f, s2_ = 0.f, s3_ = 0.f; _Pragma("unroll") for (int d_ = 0; d_ < 64; d_ += 4) { const float4 k4_ = *(const float4*)&(kr)[d_]; s0_ += q[d_] * k4_.x; s1_ += q[d_ + 1] * k4_.y; s2_ += q[d_ + 2] * k4_.z; s3_ += q[d_ + 3] * k4_.w; } res = (s0_ + s1_) + (s2_ + s3_); } while (0)
#define NV_AXPY(o, p, vr) do { _Pragma("unroll") for (int d_ = 0; d_ < 64; d_ += 4) { const float4 v4_ = *(const float4*)&(vr)[d_]; o[d_] += p * v4_.x; o[d_ + 1] += p * v4_.y; o[d_ + 2] += p * v4_.z; o[d_ + 3] += p * v4_.w; } } while (0)
#define NV_ONLINE(sc, vr) do { if (sc > m) { const float al_ = __expf(m - sc); l *= al_; _Pragma("unroll") for (int d_ = 0; d_ < 64; ++d_) o[d_] *= al_; m = sc; } const float p_ = __expf(sc - m); l += p_; NV_AXPY(o, p_, vr); } while (0)

__device__ __forceinline__ float wsum(float v) {
#pragma unroll
    for (int o = 1; o < 64; o <<= 1) v += __shfl_xor(v, o);
    return v;
}
struct In {
    const float *x, *w_in, *b_in, *pos_k, *pos_v, *w1k, *w2k, *w1v, *w2v, *g_out, *w_out, *ln1_g, *ln1_b, *rw, *rb, *wgu, *bgu, *wdn, *bdn, *ln2_g, *ln2_b;
};
inline In inputs(void* const* d) {
    In i; i.x = (const float*)d[0]; i.w_in = (const float*)d[1]; i.b_in = (const float*)d[2]; i.pos_k = (const float*)d[3]; i.pos_v = (const float*)d[4];
    i.w1k = (const float*)d[5]; i.w2k = (const float*)d[6]; i.w1v = (const float*)d[7]; i.w2v = (const float*)d[8]; i.g_out = (const float*)d[9]; i.w_out = (const float*)d[10];
    i.ln1_g = (const float*)d[11]; i.ln1_b = (const float*)d[12]; i.rw = (const float*)d[13]; i.rb = (const float*)d[14]; i.wgu = (const float*)d[15]; i.bgu = (const float*)d[16];
    i.wdn = (const float*)d[17]; i.bdn = (const float*)d[18]; i.ln2_g = (const float*)d[19]; i.ln2_b = (const float*)d[20]; return i;
}


}
namespace pg8 {
#define PG8_LAS __attribute__((address_space(3)))
typedef unsigned short bf16_t;
typedef short bf16x8 __attribute__((ext_vector_type(8)));
typedef float f32x4 __attribute__((ext_vector_type(4)));
typedef unsigned u32x4 __attribute__((ext_vector_type(4)));
constexpr int BM = 256, BK = 64, HALF = 128, HTB = HALF * BK * 2  , STAGE_BYTES = 8 * HTB, NXCD = 8, WGM = 8;

__host__ __device__ __forceinline__ int lds_byte(int r, int c) { const int st = (r >> 4) * 2 + (c >> 5), rr = r & 15, cc = c & 31, ob = rr * 64 + cc * 2; return st * 1024 + (ob ^ (((ob >> 9) & 1) << 5)); }
__host__ __device__ __forceinline__ void stage_rc(int b, int& R, int& C) { const int st = b / 1024, sb = b % 1024, swz = sb ^ (((sb >> 9) & 1) << 5); R = (st >> 1) * 16 + swz / 64; C = (st & 1) * 32 + (swz % 64) / 2; }
__host__ __device__ __forceinline__ int perm32(int rho) { const int n = rho >> 4, i = rho & 15; return 8 * (i >> 2) + 4 * n + (i & 3); }

struct Unit { int pm, pn, e, nr; };

struct StaticOrder {
    int nM, nN, nwg, G, c;
    __host__ __device__ void init(int M, int N, int G_, int c_) { nM = M / BM; nN = N / BM; nwg = nM * nN; G = G_; c = c_; }
    __host__ __device__ bool next(int i, Unit& u) const {
        const long L = (long)i * G + c; if (L >= nwg) return false;
        int wgid = (int)L; { const int q = nwg / NXCD, r = nwg % NXCD, xcd = wgid % NXCD, off = wgid / NXCD; wgid = (xcd < r ? xcd * (q + 1) : r * (q + 1) + (xcd - r) * q) + off; }
        const int nig = WGM * nN, gid = wgid / nig, fm = gid * WGM, gsz = (nM - fm) < WGM ? (nM - fm) : WGM;
        u.pm = fm + ((wgid % nig) % gsz); u.pn = (wgid % nig) / gsz; u.e = 0; u.nr = BM; return true;
    }
    const char* Bt; size_t tstep;
    __device__ __forceinline__ unsigned a_off(const Unit& u, int r) const { return (unsigned)(u.pm * BM + r) * 2048u; }
    __device__ __forceinline__ size_t a_kstep() const { return 128; }
    __device__ __forceinline__ const char* b_base(const Unit& u) const { return Bt + (size_t)u.pn * tstep; }
};


__device__ __forceinline__ unsigned cvt_pk_bf16(float lo, float hi) { unsigned r; asm volatile("v_cvt_pk_bf16_f32 %0, %1, %2" : "=v"(r) : "v"(lo), "v"(hi)); return r; }
template <class Epi, class Sched, bool ALIGN_EPI = true, bool SP2 = true>
__device__ __forceinline__ void gemm_phase(PG8_LAS unsigned char* lds, const char* Abase, const int K, const Sched& S, const Epi& E) {
    int tid_ = threadIdx.x; asm volatile("" : "+v"(tid_));
    const int tid = tid_, wid = __builtin_amdgcn_readfirstlane(tid >> 6), lane = tid & 63, wr = wid >> 2, wc = wid & 3, fr = lane & 15, fq = lane >> 4;
    const int nt = K / BK;
    unsigned voffB[2];
#pragma unroll
    for (int i = 0; i < 2; ++i) { int R, C; stage_rc(tid * 16 + i * 8192, R, C); const int Rb = Epi::PERM ? ((R & ~31) + perm32(R & 31)) : R;
        voffB[i] = (unsigned)(Rb * K + C) * 2u; }
#define PG8_AOFF(u, o0, o1) do { int _t = tid; asm volatile("" : "+v"(_t)); _Pragma("unroll") for (int _i = 0; _i < 2; ++_i) { int _R, _C; stage_rc(_t * 16 + _i * 8192, _R, _C); \
        (o0)[_i] = S.a_off((u), _R) + (unsigned)_C * 2u; (o1)[_i] = S.a_off((u), HALF + _R) + (unsigned)_C * 2u; } } while (0)
    const size_t kstep = (size_t)(BK * 2);
    const size_t akstep = S.a_kstep();
    const size_t hstep = (size_t)HALF * K * 2;
    const unsigned ldsw = (unsigned)wid * 1024u;
    const int aoff = lds_byte(wr * 64 + fr, fq * 8), boff = lds_byte(wc * 32 + fr, fq * 8);
#define PG8_SA(b, h) (((b) * 2 + (h)) * HTB)
#define PG8_SB(b, h) ((4 + (b) * 2 + (h)) * HTB)
#define PG8_STAGE(bufoff, gbase, voff) do { _Pragma("unroll") for (int _i = 0; _i < 2; ++_i) { unsigned _o = (voff)[_i]; asm volatile("" : "+v"(_o));     \
        __builtin_amdgcn_global_load_lds((const unsigned*)((const char*)(gbase) + _o), (PG8_LAS unsigned*)(lds + (bufoff) + ldsw + _i * 8192), 16, 0, 0); } } while (0)
#define PG8_LDA(dst, b, h) do { _Pragma("unroll") for (int m = 0; m < 4; ++m) _Pragma("unroll") for (int k = 0; k < 2; ++k) dst[m][k] = *(const PG8_LAS bf16x8*)(lds + PG8_SA(b, h) + aoff + m * 2048 + k * 1024); } while (0)
#define PG8_LDB(dst, b, h) do { _Pragma("unroll") for (int n = 0; n < 2; ++n) _Pragma("unroll") for (int k = 0; k < 2; ++k) dst[n][k] = *(const PG8_LAS bf16x8*)(lds + PG8_SB(b, h) + boff + n * 2048 + k * 1024); } while (0)
#define PG8_MMA(ai, bj, At, Bt) do { __builtin_amdgcn_s_setprio(1); _Pragma("unroll") for (int m = 0; m < 4; ++m) _Pragma("unroll") for (int n = 0; n < 2; ++n) _Pragma("unroll") for (int k = 0; k < 2; ++k) \
        acc[ai][bj][m][n] = __builtin_amdgcn_mfma_f32_16x16x32_bf16(Bt[n][k], At[m][k], acc[ai][bj][m][n], 0, 0, 0); __builtin_amdgcn_s_setprio(0); } while (0)
#define PG8_WAIT_V(n) asm volatile("s_waitcnt vmcnt(" #n ")" ::: "memory")
#define PG8_WAIT_L(n) asm volatile("s_waitcnt lgkmcnt(" #n ")" ::: "memory")
#define PG8_BAR __builtin_amdgcn_s_barrier()
#define PG8_SCHED __builtin_amdgcn_sched_barrier(0)
    Unit cur, nxt; int ui = 0;
    if (!S.next(0, cur)) return;
    f32x4 acc[2][2][4][2];
    float zf_ = 0.f; asm volatile("" : "+v"(zf_));
#pragma unroll
    for (int a = 0; a < 2; ++a)
#pragma unroll
        for (int b = 0; b < 2; ++b)
#pragma unroll
            for (int m = 0; m < 4; ++m)
#pragma unroll
                for (int n = 0; n < 2; ++n) acc[a][b][m][n] = (f32x4){zf_, zf_, zf_, zf_};
    bf16x8 At[4][2], B0[2][2], B1[2][2];
    unsigned ca0[2], ca1[2], na0[2], na1[2];
    PG8_AOFF(cur, ca0, ca1);
    const char* const cA = Abase; const char* cB = S.b_base(cur);
    if constexpr (SP2) {
        PG8_STAGE(PG8_SB(0, 0), cB, voffB); PG8_STAGE(PG8_SB(0, 1), cB + hstep, voffB); PG8_STAGE(PG8_SA(0, 0), cA, ca0); PG8_STAGE(PG8_SA(0, 1), cA, ca1);
        if (wr == 1) PG8_BAR;
        PG8_WAIT_V(2); PG8_BAR;
        PG8_STAGE(PG8_SB(1, 0), cB + kstep, voffB); PG8_STAGE(PG8_SA(1, 0), cA + akstep, ca0); PG8_STAGE(PG8_SB(1, 1), cB + hstep + kstep, voffB);
        PG8_WAIT_V(6); PG8_BAR;
    } else { static_assert(SP2, "only the SP2 loop is kept"); }
    for (;;) {
        const bool has_next = S.next(ui + 1, nxt);
        const char* nB = has_next ? S.b_base(nxt) : cB;
        if (has_next) { PG8_AOFF(nxt, na0, na1); } else { na0[0] = ca0[0]; na0[1] = ca0[1]; na1[0] = ca1[0]; na1[1] = ca1[1]; }
        for (int t = 0; t < nt - 2; t += 2) {
            const char* a1 = cA + (size_t)(t + 1) * akstep;
            const char* a2 = cA + (size_t)(t + 2) * akstep; const char* b2 = cB + (size_t)(t + 2) * kstep;
            const char* a3 = a2 + akstep; const char* b3 = b2 + kstep;
            PG8_LDB(B0, 0, 0); PG8_LDB(B1, 0, 1); PG8_SCHED; PG8_LDA(At, 0, 0); PG8_STAGE(PG8_SA(1, 1), a1, ca1);
            PG8_WAIT_V(8); PG8_WAIT_L(0); PG8_BAR; PG8_MMA(0, 0, At, B0); PG8_MMA(0, 1, At, B1); PG8_BAR; PG8_SCHED;
            PG8_LDA(At, 0, 1); PG8_STAGE(PG8_SB(0, 0), b2, voffB); PG8_STAGE(PG8_SB(0, 1), b2 + hstep, voffB); PG8_STAGE(PG8_SA(0, 0), a2, ca0);
            PG8_WAIT_V(8); PG8_WAIT_L(0); PG8_BAR; PG8_MMA(1, 0, At, B0); PG8_MMA(1, 1, At, B1); PG8_BAR; PG8_SCHED;
            PG8_LDB(B0, 1, 0); PG8_LDB(B1, 1, 1); PG8_SCHED; PG8_LDA(At, 1, 0); PG8_STAGE(PG8_SA(0, 1), a2, ca1);
            PG8_WAIT_V(8); PG8_WAIT_L(0); PG8_BAR; PG8_MMA(0, 0, At, B0); PG8_MMA(0, 1, At, B1); PG8_BAR; PG8_SCHED;
            PG8_LDA(At, 1, 1); PG8_STAGE(PG8_SB(1, 0), b3, voffB); PG8_STAGE(PG8_SB(1, 1), b3 + hstep, voffB); PG8_STAGE(PG8_SA(1, 0), a3, ca0);
            PG8_WAIT_V(8); PG8_WAIT_L(0); PG8_BAR; PG8_MMA(1, 0, At, B0); PG8_MMA(1, 1, At, B1); PG8_BAR; PG8_SCHED;
        }
        {
            const char* a1 = cA + (size_t)(nt - 1) * akstep;
            const char* a2 = cA; const char* b2 = nB; const char* a3 = a2 + akstep; const char* b3 = b2 + kstep;
            PG8_LDB(B0, 0, 0); PG8_LDB(B1, 0, 1); PG8_SCHED; PG8_LDA(At, 0, 0); PG8_STAGE(PG8_SA(1, 1), a1, ca1);
            PG8_WAIT_V(8); PG8_WAIT_L(0); PG8_BAR; PG8_MMA(0, 0, At, B0); PG8_MMA(0, 1, At, B1); PG8_BAR; PG8_SCHED;
            PG8_LDA(At, 0, 1); PG8_STAGE(PG8_SB(0, 0), b2, voffB); PG8_STAGE(PG8_SB(0, 1), b2 + hstep, voffB); PG8_STAGE(PG8_SA(0, 0), a2, na0);
            PG8_WAIT_V(8); PG8_WAIT_L(0); PG8_BAR; PG8_MMA(1, 0, At, B0); PG8_MMA(1, 1, At, B1); PG8_BAR; PG8_SCHED;
            PG8_LDB(B0, 1, 0); PG8_LDB(B1, 1, 1); PG8_SCHED; PG8_LDA(At, 1, 0); PG8_STAGE(PG8_SA(0, 1), a2, na1);
            PG8_WAIT_V(8); PG8_WAIT_L(0); PG8_BAR; PG8_MMA(0, 0, At, B0); PG8_MMA(0, 1, At, B1); PG8_BAR; PG8_SCHED;
            PG8_LDA(At, 1, 1); PG8_STAGE(PG8_SB(1, 0), b3, voffB); PG8_STAGE(PG8_SB(1, 1), b3 + hstep, voffB); PG8_STAGE(PG8_SA(1, 0), a3, na0);
            PG8_WAIT_V(8); PG8_WAIT_L(0); PG8_BAR; PG8_MMA(1, 0, At, B0); PG8_MMA(1, 1, At, B1); PG8_BAR; PG8_SCHED;
        }
        if constexpr (ALIGN_EPI) { if (wr == 0) PG8_BAR; }
        E(acc, cur, wr, wc, fr, fq);
        if (!has_next) break;
#pragma unroll
        for (int a = 0; a < 2; ++a)
#pragma unroll
            for (int b = 0; b < 2; ++b)
#pragma unroll
                for (int m = 0; m < 4; ++m)
#pragma unroll
                    for (int n = 0; n < 2; ++n) acc[a][b][m][n] = (f32x4){zf_, zf_, zf_, zf_};
        cur = nxt; cB = nB; ++ui; ca0[0] = na0[0]; ca0[1] = na0[1]; ca1[0] = na1[0]; ca1[1] = na1[1];
        if constexpr (ALIGN_EPI) { if (wr == 1) PG8_BAR; }
    }
    PG8_WAIT_V(0);
    if constexpr (!ALIGN_EPI) { if (wr == 0) PG8_BAR; }
    PG8_BAR;
#undef PG8_AOFF
#undef PG8_SA
#undef PG8_SB
#undef PG8_STAGE
#undef PG8_LDA
#undef PG8_LDB
#undef PG8_MMA
#undef PG8_WAIT_V
#undef PG8_WAIT_L
#undef PG8_BAR
#undef PG8_SCHED
}

}
namespace mk {
using namespace nv;
typedef unsigned short bf16_t;
typedef unsigned u32x4 __attribute__((ext_vector_type(4)));
typedef float f32x4 __attribute__((ext_vector_type(4)));
#define LAS __attribute__((address_space(3)))
constexpr int NT = 512;
constexpr int PB = 2816;
constexpr int NPAD = 3072;
constexpr int C_KV = 512, C_FOX = 1280, C_SB = 2048, C_GATE = 2816;
constexpr int MAXT = MROWS / 256 + NE;
constexpr int PROWS = MAXT * 256;
#define CNT_IDX(l, e) (8192 + ((l) * NE + (e)) * 32)
__device__ __forceinline__ int ftid() { int t = threadIdx.x; asm volatile("" : "+v"(t)); return t; }
__device__ __forceinline__ int fbid() { int b = blockIdx.x; asm volatile("" : "+s"(b)); return b; }
#define MK_LOOP(vb, n) for (int vb = fbid(); vb < (n); vb += gridDim.x)

constexpr size_t al_(size_t x) { return (x + 4095) & ~(size_t)4095; }
constexpr size_t O_WTIN = 0;
constexpr size_t O_WTOUT = O_WTIN + al_((size_t)L_ * NPAD * D_ * 2);
constexpr size_t O_WTGU = O_WTOUT + al_((size_t)L_ * D_ * D_ * 2);
constexpr size_t O_WTDN = O_WTGU + al_((size_t)L_ * NE * 2048 * D_ * 2);
constexpr size_t O_BIASP = O_WTDN + al_((size_t)L_ * NE * D_ * D_ * 2);
constexpr size_t O_XB = O_BIASP + al_((size_t)L_ * NPAD * 4);
constexpr size_t O_PROJB = O_XB + al_((size_t)T_ * D_ * 2);
constexpr size_t O_GF = O_PROJB + al_((size_t)T_ * PB * 2);
constexpr size_t O_CFOX = O_GF + al_((size_t)T_ * 32 * 4);
constexpr size_t O_KCMP = O_CFOX + al_((size_t)B_ * 4 * S_ * 4);
constexpr size_t O_VCMP = O_KCMP + al_((size_t)B_ * 2 * 512 * 64 * 4);
constexpr size_t O_O = O_VCMP + al_((size_t)B_ * 2 * 512 * 64 * 4);
constexpr size_t O_OB = O_O + al_((size_t)T_ * D_ * 4);
constexpr size_t O_PTOT = O_OB + al_((size_t)T_ * D_ * 2);
constexpr size_t O_SEL = O_PTOT + al_((size_t)B_ * 2 * S_ * 512 * 4);
constexpr size_t O_MIX = O_SEL + al_((size_t)B_ * 2 * S_ * NSEL * 4);
constexpr size_t O_X1 = O_MIX + al_((size_t)T_ * D_ * 4);
constexpr size_t O_X1B = O_X1 + al_((size_t)T_ * D_ * 4);
constexpr size_t O_XA = O_X1B + al_((size_t)T_ * D_ * 2);
constexpr size_t O_ACT = O_XA + al_((size_t)T_ * D_ * 4);
constexpr size_t O_Y = O_ACT + al_((size_t)PROWS * D_ * 2);
constexpr size_t O_TOPE = O_Y + al_((size_t)PROWS * D_ * 2);
constexpr size_t O_TOPW = O_TOPE + al_((size_t)MROWS * 4);
constexpr size_t O_POS = O_TOPW + al_((size_t)MROWS * 4);
constexpr size_t O_ROWTOK = O_POS + al_((size_t)MROWS * 4);
constexpr size_t O_ROWW = O_ROWTOK + al_((size_t)PROWS * 4);
constexpr size_t O_SLOT = O_ROWW + al_((size_t)PROWS * 4);
constexpr size_t O_COUNTS = O_SLOT + al_((size_t)MROWS * 4);
constexpr size_t O_META = O_COUNTS + 65536;
constexpr size_t O_OWIN = O_META + 4096;
constexpr size_t O_O2 = O_OWIN + al_((size_t)T_ * 512 * 4);
constexpr size_t O_OWIN2 = O_O2 + al_((size_t)T_ * D_ * 4);
constexpr size_t O_KCMPB = O_OWIN2 + al_((size_t)T_ * 512 * 4);
constexpr size_t O_VCMPB = O_KCMPB + al_((size_t)B_ * 2 * 512 * 64 * 2);
constexpr size_t O_OCMP = O_VCMPB + al_((size_t)B_ * 2 * 512 * 64 * 2);
constexpr size_t O_SELMASK = O_OCMP + al_((size_t)T_ * 512 * 4);
constexpr size_t O_WT1 = O_SELMASK + al_((size_t)B_ * 2 * S_ * 16);
constexpr size_t O_BIAS1 = O_WT1 + al_((size_t)L_ * 2 * 256 * 2048 * 2);
constexpr size_t O_HID = O_BIAS1 + al_((size_t)L_ * 2 * 128 * 4);
constexpr size_t O_BIAS1P = O_HID + al_((size_t)8 * 512 * 128 * 2);
constexpr size_t O_END = O_BIAS1P + al_((size_t)L_ * 2 * 64 * 128 * 4);

struct P {
    In in; unsigned char* ws; float* out;
};
typedef const __attribute__((address_space(4))) P* KP;
__device__ __forceinline__ KP fresh_kp() { KP k = (KP)__builtin_amdgcn_kernarg_segment_ptr(); asm volatile("" : "+s"(k)); return k; }
#define WSP(T, off) ((T*)(p->ws + (off)))

__device__ __forceinline__ float bf2f(unsigned short b) { return __uint_as_float((unsigned)b << 16); }
__device__ __forceinline__ unsigned f2bf(float f) { unsigned u = __float_as_uint(f); return (u + 0x7fffu + ((u >> 16) & 1u)) >> 16; }
__device__ __forceinline__ unsigned pk2(float lo, float hi) { return f2bf(lo) | (f2bf(hi) << 16); }
__device__ __forceinline__ void ld8(const bf16_t* __restrict__ src, float* dst) {
    const u32x4 v = *(const u32x4*)src;
    dst[0] = __uint_as_float(v.x << 16); dst[1] = __uint_as_float(v.x & 0xffff0000u); dst[2] = __uint_as_float(v.y << 16); dst[3] = __uint_as_float(v.y & 0xffff0000u);
    dst[4] = __uint_as_float(v.z << 16); dst[5] = __uint_as_float(v.z & 0xffff0000u); dst[6] = __uint_as_float(v.w << 16); dst[7] = __uint_as_float(v.w & 0xffff0000u);
}


__device__ __forceinline__ int perm_in(int n) {
    if (n < 1280) return n;
    if (n < 1304) return C_GATE + (n - 1280);
    if (n < 2072) return C_FOX + (n - 1304);
    if (n < 2076) return C_GATE + 24 + (n - 2072);
    return C_SB + (n - 2076);
}
__device__ __forceinline__ int perm_gu(int n) { const int up = n >> 10, c = n & 1023; return 256 * (c >> 7) + 128 * up + (c & 127); }
template <int MAP>
__device__ __forceinline__ void transpose_item(const float* __restrict__ W, int K, int N, bf16_t* __restrict__ WT, LAS float* scr, int item, int lane) {
    const int nblk = (N + 31) / 32, kb = item / nblk, nb = item % nblk, k0 = 64 * kb, n0 = 32 * nb;
    { const int n4 = (lane & 7) * 4; const bool okn = (n0 + n4) < N;
      f32x4 t[8];
#pragma unroll
      for (int i = 0; i < 8; ++i) { const int kk = (lane >> 3) + 8 * i; t[i] = okn ? *(const f32x4*)(W + (size_t)(k0 + kk) * N + n0 + n4) : (f32x4){0.f, 0.f, 0.f, 0.f}; }
#pragma unroll
      for (int i = 0; i < 8; ++i) { const int kk = (lane >> 3) + 8 * i; LAS float* d = scr + kk * 33 + n4; d[0] = t[i].x; d[1] = t[i].y; d[2] = t[i].z; d[3] = t[i].w; } }
    asm volatile("s_waitcnt lgkmcnt(0)" ::: "memory");
    const int c = lane & 7;
#pragma unroll
    for (int j = 0; j < 4; ++j) { const int n = (lane >> 3) + 8 * j; const LAS float* sp = scr + (8 * c) * 33 + n;
        u32x4 o; o.x = pk2(sp[0 * 33], sp[1 * 33]); o.y = pk2(sp[2 * 33], sp[3 * 33]); o.z = pk2(sp[4 * 33], sp[5 * 33]); o.w = pk2(sp[6 * 33], sp[7 * 33]);
        const int ng = n0 + n;
        if (ng < N) { const int ro = (MAP == 1) ? perm_in(ng) : (MAP == 2) ? perm_gu(ng) : ng; *(u32x4*)(WT + (size_t)ro * K + k0 + 8 * c) = o; } }
    asm volatile("s_waitcnt lgkmcnt(0)" ::: "memory");
}
__device__ __forceinline__ void ph_convert(LAS unsigned char* lds, KP p) {
    const int tid = ftid(), lane = tid & 63, wv = tid >> 6;
    LAS float* scr = (LAS float*)(lds + wv * 8448);
    const int gw = fbid() * 8 + wv, NGW = gridDim.x * 8;
    constexpr int I_IN = 16 * 89, I_OUT = 16 * 32, I_GU = 16 * 64, I_DN = 16 * 32, I_W1 = 32 * 4;
    constexpr int N_IN = L_ * I_IN, N_OUT = L_ * I_OUT, N_GU = L_ * NE * I_GU, N_DN = L_ * NE * I_DN, N_W1 = L_ * 2 * I_W1;
    for (int it = gw; it < N_IN + N_OUT + N_GU + N_DN + N_W1; it += NGW) {
        int r = it;
        if (r < N_W1) { const int mtx = r / I_W1, ll = mtx >> 1, kv = mtx & 1; transpose_item<0>((kv ? p->in.w1v : p->in.w1k) + (size_t)ll * 2048 * 128, 2048, 128, WSP(bf16_t, O_WT1) + (size_t)mtx * 256 * 2048, scr, r % I_W1, lane); continue; } r -= N_W1;
        if (r < N_GU) { const int mtx = r / I_GU; transpose_item<2>(p->in.wgu + (size_t)mtx * D_ * 2048, D_, 2048, WSP(bf16_t, O_WTGU) + (size_t)mtx * 2048 * D_, scr, r % I_GU, lane); continue; } r -= N_GU;
        if (r < N_DN) { const int mtx = r / I_DN; transpose_item<0>(p->in.wdn + (size_t)mtx * D_ * D_, D_, D_, WSP(bf16_t, O_WTDN) + (size_t)mtx * D_ * D_, scr, r % I_DN, lane); continue; } r -= N_DN;
        if (r < N_IN) { const int mtx = r / I_IN; transpose_item<1>(p->in.w_in + (size_t)mtx * D_ * DIN, D_, DIN, WSP(bf16_t, O_WTIN) + (size_t)mtx * NPAD * D_, scr, r % I_IN, lane); continue; } r -= N_IN;
        { const int mtx = r / I_OUT; transpose_item<0>(p->in.w_out + (size_t)mtx * D_ * D_, D_, D_, WSP(bf16_t, O_WTOUT) + (size_t)mtx * D_ * D_, scr, r % I_OUT, lane); }
    }
    const int gt = fbid() * NT + tid, NG = gridDim.x * NT;
    for (int i = gt; i < L_ * (NPAD - DIN) * (D_ / 8); i += NG) { const int l = i / ((NPAD - DIN) * (D_ / 8)), r = i % ((NPAD - DIN) * (D_ / 8));
        unsigned z_ = 0u; asm volatile("" : "+v"(z_));
        *(u32x4*)(WSP(bf16_t, O_WTIN) + ((size_t)l * NPAD + DIN) * D_ + (size_t)r * 8) = (u32x4){z_, z_, z_, z_}; }
    for (int i = gt; i < L_ * 2 * 128 * (2048 / 8); i += NG) { const int mtx = i / (128 * 256), r = i % (128 * 256); unsigned z_ = 0u; asm volatile("" : "+v"(z_));
        *(u32x4*)(WSP(bf16_t, O_WT1) + ((size_t)mtx * 256 + 128) * 2048 + (size_t)r * 8) = (u32x4){z_, z_, z_, z_}; }
    for (int i = gt; i < L_ * 2 * 64 * 128; i += NG) { const int j = i & 127, seg = (i >> 7) & 63, mtx = i >> 13, ll = mtx >> 1, kv = mtx & 1;
        const float* pos = (kv ? p->in.pos_v : p->in.pos_k) + (size_t)ll * 2048 + seg * 32; const float* w1 = (kv ? p->in.w1v : p->in.w1k) + (size_t)ll * 2048 * 128 + (size_t)seg * 32 * 128; float a = 0.f;
#pragma unroll 8
        for (int k = 0; k < 32; ++k) a += pos[k] * w1[(size_t)k * 128 + j];
        WSP(float, O_BIAS1P)[i] = a; }
    for (int i = gt; i < L_ * NPAD; i += NG) { const int l = i / NPAD, c = i % NPAD; if (c >= DIN) WSP(float, O_BIASP)[i] = 0.f; }
    for (int i = gt; i < L_ * DIN; i += NG) { const int l = i / DIN, n = i % DIN; WSP(float, O_BIASP)[l * NPAD + perm_in(n)] = p->in.b_in[i]; }
    for (int i = gt; i < T_ * D_ / 8; i += NG) { const f32x4 a = *(const f32x4*)(p->in.x + (size_t)i * 8), b = *(const f32x4*)(p->in.x + (size_t)i * 8 + 4);
        *(u32x4*)(WSP(bf16_t, O_XB) + (size_t)i * 8) = (u32x4){pk2(a.x, a.y), pk2(a.z, a.w), pk2(b.x, b.y), pk2(b.z, b.w)}; }
}

struct EpiProj {
    static constexpr bool PERM = true;
    bf16_t* projb; float* gf; const float* bias;
    __device__ __forceinline__ void operator()(const pg8::f32x4 (&acc)[2][2][4][2], const pg8::Unit& u, int wr, int wc, int fr, int fq) const {
        const int row0 = u.pm * 256 + wr * 64 + fr, col0 = u.pn * 256 + wc * 32 + 8 * fq;
        if (u.pn < 11) {
#pragma unroll
            for (int ai = 0; ai < 2; ++ai)
#pragma unroll
                for (int m = 0; m < 4; ++m) { bf16_t* rowp = projb + (size_t)(row0 + ai * 128 + m * 16) * PB + col0;
#pragma unroll
                    for (int bj = 0; bj < 2; ++bj) { const f32x4 v0 = acc[ai][bj][m][0] + *(const f32x4*)(bias + col0 + bj * 128), v1 = acc[ai][bj][m][1] + *(const f32x4*)(bias + col0 + bj * 128 + 4);
                        u32x4 w; w.x = pg8::cvt_pk_bf16(v0[0], v0[1]); w.y = pg8::cvt_pk_bf16(v0[2], v0[3]); w.z = pg8::cvt_pk_bf16(v1[0], v1[1]); w.w = pg8::cvt_pk_bf16(v1[2], v1[3]);
                        *(u32x4*)(rowp + bj * 128) = w; }
                    asm volatile("" ::: "memory"); }
        } else if (wc == 0) {
            const f32x4 b0 = *(const f32x4*)(bias + col0), b1 = *(const f32x4*)(bias + col0 + 4);
#pragma unroll
            for (int ai = 0; ai < 2; ++ai)
#pragma unroll
                for (int m = 0; m < 4; ++m) { float* rowp = gf + (size_t)(row0 + ai * 128 + m * 16) * 32 + 8 * fq;
                    const f32x4 v0 = acc[ai][0][m][0] + b0, v1 = acc[ai][0][m][1] + b1; f32x4 o0, o1;
#pragma unroll
                    for (int i = 0; i < 4; ++i) { const int j0 = 8 * fq + i, j1 = j0 + 4;
                        o0[i] = (j0 < 24) ? sigmoidf_(v0[i]) : (j0 < 28 ? logsig(v0[i]) : 0.f); o1[i] = (j1 < 24) ? sigmoidf_(v1[i]) : (j1 < 28 ? logsig(v1[i]) : 0.f); }
                    *(f32x4*)rowp = o0; *(f32x4*)(rowp + 4) = o1; }
        }
    }
};
struct EpiOut {
    static constexpr bool PERM = true;
    const float* x; float* y1;
    __device__ __forceinline__ void operator()(const pg8::f32x4 (&acc)[2][2][4][2], const pg8::Unit& u, int wr, int wc, int fr, int fq) const {
        const int row0 = u.pm * 256 + wr * 64 + fr, col0 = u.pn * 256 + wc * 32 + 8 * fq;
#pragma unroll
        for (int ai = 0; ai < 2; ++ai)
#pragma unroll
            for (int m = 0; m < 4; ++m) { const size_t off = (size_t)(row0 + ai * 128 + m * 16) * D_ + col0;
#pragma unroll
                for (int bj = 0; bj < 2; ++bj) { const f32x4 x0 = *(const f32x4*)(x + off + bj * 128), x1 = *(const f32x4*)(x + off + bj * 128 + 4);
                    *(f32x4*)(y1 + off + bj * 128) = x0 * ALPHA + acc[ai][bj][m][0]; *(f32x4*)(y1 + off + bj * 128 + 4) = x1 * ALPHA + acc[ai][bj][m][1]; }
                asm volatile("" ::: "memory"); }
    }
};
struct EpiGU {
    static constexpr bool PERM = true;
    bf16_t* act; const float* bgu;
    __device__ __forceinline__ void operator()(const pg8::f32x4 (&acc)[2][2][4][2], const pg8::Unit& u, int wr, int wc, int fr, int fq) const {
        const int row0 = u.pm * 256 + wr * 64 + fr, col0 = u.pn * 128 + wc * 32 + 8 * fq;
        const float* bb = bgu + (size_t)u.e * 2048 + col0;
        const f32x4 bg0 = *(const f32x4*)bb, bg1 = *(const f32x4*)(bb + 4), bu0 = *(const f32x4*)(bb + 1024), bu1 = *(const f32x4*)(bb + 1028);
#pragma unroll
        for (int ai = 0; ai < 2; ++ai)
#pragma unroll
            for (int m = 0; m < 4; ++m) { f32x4 a0, a1;
                const f32x4 g0 = acc[ai][0][m][0] + bg0, g1 = acc[ai][0][m][1] + bg1, u0 = acc[ai][1][m][0] + bu0, u1 = acc[ai][1][m][1] + bu1;
#pragma unroll
                for (int i = 0; i < 4; ++i) { const float gt0 = fminf(g0[i], 7.0f), up0 = fminf(fmaxf(u0[i], -7.0f), 7.0f), gt1 = fminf(g1[i], 7.0f), up1 = fminf(fmaxf(u1[i], -7.0f), 7.0f);
                    a0[i] = gt0 * sigmoidf_(1.702f * gt0) * (up0 + 1.0f); a1[i] = gt1 * sigmoidf_(1.702f * gt1) * (up1 + 1.0f); }
                u32x4 w; w.x = pg8::cvt_pk_bf16(a0[0], a0[1]); w.y = pg8::cvt_pk_bf16(a0[2], a0[3]); w.z = pg8::cvt_pk_bf16(a1[0], a1[1]); w.w = pg8::cvt_pk_bf16(a1[2], a1[3]);
                *(u32x4*)(act + (size_t)(row0 + ai * 128 + m * 16) * D_ + col0) = w; asm volatile("" ::: "memory"); }
    }
};
struct EpiDN {
    static constexpr bool PERM = true;
    bf16_t* y; const float* bdn; const float* roww;
    __device__ __forceinline__ void operator()(const pg8::f32x4 (&acc)[2][2][4][2], const pg8::Unit& u, int wr, int wc, int fr, int fq) const {
        const int row0 = u.pm * 256 + wr * 64 + fr, col0 = u.pn * 256 + wc * 32 + 8 * fq;
        const float* bb = bdn + (size_t)u.e * D_ + col0;
#pragma unroll
        for (int ai = 0; ai < 2; ++ai)
#pragma unroll
            for (int m = 0; m < 4; ++m) { const int row = row0 + ai * 128 + m * 16; const float w = roww[row];
#pragma unroll
                for (int bj = 0; bj < 2; ++bj) { const f32x4 v0 = (acc[ai][bj][m][0] + *(const f32x4*)(bb + bj * 128)) * w, v1 = (acc[ai][bj][m][1] + *(const f32x4*)(bb + bj * 128 + 4)) * w;
                    u32x4 o; o.x = pg8::cvt_pk_bf16(v0[0], v0[1]); o.y = pg8::cvt_pk_bf16(v0[2], v0[3]); o.z = pg8::cvt_pk_bf16(v1[0], v1[1]); o.w = pg8::cvt_pk_bf16(v1[2], v1[3]);
                    *(u32x4*)(y + (size_t)row * D_ + col0 + bj * 128) = o; }
                asm volatile("" ::: "memory"); }
    }
};
struct MoeOrder {
    const int* meta; const int* rowtok; const char* Wt; size_t estep, tstep; int nN, G, c, nunits;
    __device__ __forceinline__ bool next(int i, pg8::Unit& u) const {
        const int L = i * G + c; if (L >= nunits) return false;
        const int gt = L / nN; u.pm = gt; u.pn = L - gt * nN; u.e = meta[64 + 2 * gt]; u.nr = meta[65 + 2 * gt]; return true; }
    __device__ __forceinline__ unsigned a_row(const pg8::Unit& u, int r) const { const int rr = r < u.nr ? r : u.nr - 1; const int row = u.pm * 256 + rr; return rowtok ? (unsigned)rowtok[row] : (unsigned)row; }
    __device__ __forceinline__ const char* b_base(const pg8::Unit& u) const { return Wt + (size_t)u.e * estep + (size_t)u.pn * tstep; }
};

struct EpiCmp {
    static constexpr bool PERM = true;
    bf16_t* hid; const float* bias1;
    __device__ __forceinline__ void operator()(const pg8::f32x4 (&acc)[2][2][4][2], const pg8::Unit& u, int wr, int wc, int fr, int fq) const {
        const int row0 = u.pm * 256 + wr * 64 + fr, col0 = wc * 32 + 8 * fq;
        const float* bb = bias1 + (u.e & 1) * 128 + col0; const f32x4 b0 = *(const f32x4*)bb, b1 = *(const f32x4*)(bb + 4);
#pragma unroll
        for (int ai = 0; ai < 2; ++ai)
#pragma unroll
            for (int m = 0; m < 4; ++m) { const f32x4 v0 = acc[ai][0][m][0] + b0, v1 = acc[ai][0][m][1] + b1;
                u32x4 w; w.x = pg8::cvt_pk_bf16(gelu_tanh(v0[0]), gelu_tanh(v0[1])); w.y = pg8::cvt_pk_bf16(gelu_tanh(v0[2]), gelu_tanh(v0[3])); w.z = pg8::cvt_pk_bf16(gelu_tanh(v1[0]), gelu_tanh(v1[1])); w.w = pg8::cvt_pk_bf16(gelu_tanh(v1[2]), gelu_tanh(v1[3]));
                *(u32x4*)(hid + ((size_t)u.e * 512 + row0 + ai * 128 + m * 16) * 128 + col0) = w; asm volatile("" ::: "memory"); }
    }
};
struct GEpi {
    static constexpr bool PERM = true;
    int kind, l;
    __device__ __forceinline__ void operator()(const pg8::f32x4 (&acc)[2][2][4][2], const pg8::Unit& u, int wr, int wc, int fr, int fq) const {
        const KP p = fresh_kp();
        if (kind == 0) { const EpiProj e{WSP(bf16_t, O_PROJB), WSP(float, O_GF), WSP(float, O_BIASP) + l * NPAD}; e(acc, u, wr, wc, fr, fq); }
        else if (kind == 1) { const EpiOut e{(l == 0) ? p->in.x : WSP(float, O_XA), WSP(float, O_MIX)}; e(acc, u, wr, wc, fr, fq); }
        else if (kind == 2) { const EpiGU e{WSP(bf16_t, O_ACT), p->in.bgu + (size_t)l * NE * 2048}; e(acc, u, wr, wc, fr, fq); }
        else if (kind == 3) { const EpiDN e{WSP(bf16_t, O_Y), p->in.bdn + (size_t)l * NE * D_, WSP(float, O_ROWW)}; e(acc, u, wr, wc, fr, fq); }
        else { const EpiCmp e{WSP(bf16_t, O_HID), WSP(float, O_BIAS1) + l * 256}; e(acc, u, wr, wc, fr, fq); }
    }
};
struct GSched {
    int kind, nM, nN, nunits, G, c; const int* meta; const int* rowtok; const char* Bt; size_t estep;
    __device__ __forceinline__ bool next(int i, pg8::Unit& u) const {
        const int L = i * G + c; if (L >= nunits) return false;
        if (kind < 2) {
            int wgid = L; { const int q = nunits / pg8::NXCD, r = nunits % pg8::NXCD, xcd = wgid % pg8::NXCD, off = wgid / pg8::NXCD; wgid = (xcd < r ? xcd * (q + 1) : r * (q + 1) + (xcd - r) * q) + off; }
            const int nig = pg8::WGM * nN, gid = wgid / nig, fm = gid * pg8::WGM, gsz = (nM - fm) < pg8::WGM ? (nM - fm) : pg8::WGM;
            u.pm = fm + ((wgid % nig) % gsz); u.pn = (wgid % nig) / gsz; u.e = 0; u.nr = 256;
        } else if (kind == 4) { u.e = L >> 1; u.pm = L & 1; u.pn = 0; u.nr = (L & 1) ? 255 : 256; }
        else { const int gt = L / nN; u.pm = gt; u.pn = L - gt * nN; u.e = meta[64 + 2 * gt]; u.nr = meta[65 + 2 * gt]; }
        return true; }
    __device__ __forceinline__ unsigned a_off(const pg8::Unit& u, int r) const { const int rr = r < u.nr ? r : u.nr - 1; const int row = u.pm * 256 + rr;
        if (kind == 4) { const int kv = u.e & 1, bg = u.e >> 1; return (unsigned)(((bg >> 1) * S_ + 16 * row) * PB + C_KV + ((0 * 2 + kv) * 2 + (bg & 1)) * 64) * 2u; }
        return (unsigned)((kind == 2) ? rowtok[row] : row) * (unsigned)(D_ * 2); }
    __device__ __forceinline__ size_t a_kstep() const { return kind == 4 ? (size_t)PB * 2 : (size_t)128; }
    __device__ __forceinline__ const char* b_base(const pg8::Unit& u) const { return Bt + (size_t)(kind == 4 ? (u.e & 1) : u.e) * estep + (size_t)u.pn * ((size_t)256 * D_ * 2); }
};

__device__ __forceinline__ void ph_prep(float* lds, KP p, int l) {
    const int tid = ftid();
    const bf16_t* projb = WSP(bf16_t, O_PROJB);
    constexpr int NCB = (NCMP + 3) / 4;
    constexpr int NV_CMP = NCB * B_ * 2 * 2;
    MK_LOOP(vb, NV_CMP + B_ * 4) {
        if (vb < NV_CMP) {
            float* blk = lds; float* hid = lds + 4 * 2048;
            const int kv = vb & 1, bg = (vb >> 1) & 3, nb = vb >> 3, b = bg >> 1, g = bg & 1;
            const float* pos = (kv ? p->in.pos_v : p->in.pos_k) + (size_t)l * 2048; const float* w1 = (kv ? p->in.w1v : p->in.w1k) + (size_t)l * 2048 * 128;
            const float* w2 = (kv ? p->in.w2v : p->in.w2k) + (size_t)l * 128 * 64; float* outp = kv ? WSP(float, O_VCMP) : WSP(float, O_KCMP);
            __syncthreads();
            for (int i = tid; i < 4 * 2048; i += NT) { const int sub = i >> 11, e = i & 2047, ll = e >> 6, d = e & 63; int n = nb * 4 + sub; if (n >= NCMP) n = NCMP - 1;
                blk[i] = bf2f(projb[(size_t)(b * S_ + 16 * n + ll) * PB + C_KV + ((0 * 2 + kv) * 2 + g) * 64 + d]) + pos[e]; }
            __syncthreads();
            const int sub = tid >> 7, j = tid & 127; const float* bl = blk + sub * 2048;
            float a = 0.f;
            for (int i = 0; i < 2048; ++i) a += bl[i] * w1[(size_t)i * 128 + j];
            hid[tid] = gelu_tanh(a);
            __syncthreads();
            const int n = nb * 4 + sub;
            if (j < 64 && n < NCMP) { float o = 0.f; for (int jj = 0; jj < 128; ++jj) o += hid[sub * 128 + jj] * w2[jj * 64 + j]; outp[((size_t)bg * NCMP + n) * 64 + j] = o;
                (kv ? WSP(bf16_t, O_VCMPB) : WSP(bf16_t, O_KCMPB))[((size_t)bg * 512 + n) * 64 + j] = (bf16_t)f2bf(o); }
            if (j < 64 && n == NCMP) (kv ? WSP(bf16_t, O_VCMPB) : WSP(bf16_t, O_KCMPB))[((size_t)bg * 512 + 511) * 64 + j] = 0;
        } else {
            float* sh = lds; const int bh = vb - NV_CMP, b = bh >> 2, h = bh & 3; float carry = 0.f;
            for (int t0 = 0; t0 < S_; t0 += NT) {
                __syncthreads();
                sh[tid] = WSP(float, O_GF)[(size_t)(b * S_ + t0 + tid) * 32 + 24 + h]; __syncthreads();
                for (int o = 1; o < NT; o <<= 1) { const float add = (tid >= o) ? sh[tid - o] : 0.f; __syncthreads(); sh[tid] += add; __syncthreads(); }
                WSP(float, O_CFOX)[(size_t)bh * S_ + t0 + tid] = carry + sh[tid];
                carry += sh[NT - 1];
            }
        }
    }
}

__device__ __forceinline__ void load_tile_bf(float (*dst)[64], const bf16_t* __restrict__ src, size_t pitch) {
    const int tid = ftid(), r = tid >> 3, c0 = (tid & 7) * 8; float v[8]; ld8(src + (size_t)r * pitch + c0, v);
    *(float4*)&dst[r][c0] = make_float4(v[0], v[1], v[2], v[3]); *(float4*)&dst[r][c0 + 4] = make_float4(v[4], v[5], v[6], v[7]);
}
__device__ __forceinline__ void load_tile512(float (*dst)[64], const float* __restrict__ src, size_t stride, int nrows_valid) {
    const int tid = ftid(), r = tid >> 3, c0 = (tid & 7) * 8;
#pragma unroll
    for (int j = 0; j < 2; ++j) { float4 v = make_float4(0.f, 0.f, 0.f, 0.f); if (r < nrows_valid) v = *(const float4*)(src + (size_t)r * stride + c0 + 4 * j); *(float4*)&dst[r][c0 + 4 * j] = v; }
}
#define MK_LOADQ(q, src) do { _Pragma("unroll") for (int c_ = 0; c_ < 8; ++c_) { float t8_[8]; ld8((src) + 8 * c_, t8_); _Pragma("unroll") for (int e_ = 0; e_ < 8; ++e_) q[8 * c_ + e_] = t8_[e_] * SCALE; } } while (0)

template <int KIND>
__device__ __forceinline__ void attn_vblock(float* lds, KP p, int qb, int bh) {
    float (*Ks)[64] = (float (*)[64])lds; float (*Vs)[64] = (float (*)[64])(lds + 4096); float* Cs = lds + 8192;
    const bf16_t* projb = WSP(bf16_t, O_PROJB); const float* gf = WSP(float, O_GF); float* ob = WSP(float, O_O);
    const int tid = ftid(), q0 = qb * NT, t = q0 + tid;
    if (KIND == 0 || KIND == 1) {
        int b, h, qcol, kcol, vcol, ocol; float slope = 0.f;
        if (KIND == 0) { b = bh >> 2; h = bh & 3; qcol = C_FOX + h * 64; kcol = C_FOX + (4 + h) * 64; vcol = C_FOX + (8 + h) * 64; ocol = 512 + h * 64; }
        else { b = bh >> 3; h = bh & 7; const int g = h >> 2; qcol = h * 64; kcol = C_KV + ((2 * 2 + 0) * 2 + g) * 64; vcol = C_KV + ((2 * 2 + 1) * 2 + g) * 64; ocol = h * 64; slope = exp2f(-(float)(h + 1)); }
        const bf16_t* prow = projb + (size_t)(b * S_ + t) * PB;
        float q[64], o[64];
        MK_LOADQ(q, prow + qcol);
#pragma unroll
        for (int d = 0; d < 64; ++d) o[d] = 0.f;
        float m = -1e30f, l = 0.f, ct = 0.f; const float* cb = WSP(float, O_CFOX) + (size_t)(b * 4 + (h & 3)) * S_;
        if (KIND == 0) ct = cb[t];
        int kt0 = 0; const int kt1 = (q0 + NT - 1) >> 6;
        if (KIND == 1) { kt0 = (q0 - 511) >> 6; if (kt0 < 0) kt0 = 0; }
        for (int kt = kt0; kt <= kt1; ++kt) {
            __syncthreads();
            load_tile_bf(Ks, projb + (size_t)(b * S_ + kt * 64) * PB + kcol, PB);
            load_tile_bf(Vs, projb + (size_t)(b * S_ + kt * 64) * PB + vcol, PB);
            if (KIND == 0 && tid < 64) Cs[tid] = cb[kt * 64 + tid];
            __syncthreads();
            for (int r = 0; r < 64; ++r) {
                const int s = kt * 64 + r; bool ok = (s <= t); if (KIND == 1) ok = ok && (t - s < 512);
                if (ok) { float sc; NV_DOT(q, Ks[r], sc); if (KIND == 0) sc += ct - Cs[r]; else sc -= slope * (float)(t - s); NV_ONLINE(sc, Vs[r]); }
            }
        }
        const float inv = (l > 0.f) ? 1.f / l : 0.f;
        float* orow = ob + (size_t)(b * S_ + t) * D_ + ocol;
        if (KIND == 0) {
#pragma unroll
            for (int d = 0; d < 64; ++d) orow[d] = o[d] * inv;
        } else { const float gate = gf[(size_t)(b * S_ + t) * 32 + 2 * 8 + h]; float* wrow = WSP(float, O_OWIN) + (size_t)(b * S_ + t) * 512 + h * 64;
#pragma unroll
            for (int d = 0; d < 64; ++d) wrow[d] = gate * o[d] * inv; }
    } else if (KIND == 2) {
        const int b = bh >> 2, h = bh & 3;
        const int qcol = C_SB + h * 64, kcol = C_SB + (4 + h) * 64, vcol = C_SB + (8 + h) * 64, ocol = 768 + h * 64;
        const bf16_t* prow = projb + (size_t)(b * S_ + t) * PB;
        float q[64], o[64];
        MK_LOADQ(q, prow + qcol);
#pragma unroll
        for (int d = 0; d < 64; ++d) o[d] = 0.f;
        float later = 0.f;
        for (int kt = (q0 + NT - 1) >> 6; kt >= 0; --kt) {
            __syncthreads();
            load_tile_bf(Ks, projb + (size_t)(b * S_ + kt * 64) * PB + kcol, PB);
            load_tile_bf(Vs, projb + (size_t)(b * S_ + kt * 64) * PB + vcol, PB);
            __syncthreads();
            for (int r = 63; r >= 0; --r) { const int s = kt * 64 + r;
                if (s < t) { float z; NV_DOT(q, Ks[r], z); const float a = expf(logsig(z) + later); NV_AXPY(o, a, Vs[r]); later += logsig(-z); } }
        }
        float* orow = ob + (size_t)(b * S_ + t) * D_ + ocol;
#pragma unroll
        for (int d = 0; d < 64; ++d) orow[d] = o[d];
    } else {
        const int bg = bh, b = bg >> 1, g = bg & 1;
        const bf16_t* prow = projb + (size_t)(b * S_ + t) * PB;
        float* prow_t = WSP(float, O_PTOT) + (size_t)(bg * S_ + t) * 512;
        const float* kcmp = WSP(float, O_KCMP); const float* vcmp = WSP(float, O_VCMP);
        int nmax = (q0 + NT - 1 - 31) / 16 + 1; if (nmax > NCMP) nmax = NCMP;
        const int ntile = (nmax + 63) / 64;
        for (int r4 = 0; r4 < 4; ++r4) {
            const int h = g * 4 + r4; const float slope = exp2f(-(float)(h + 1));
            float q[64], o[64];
            MK_LOADQ(q, prow + h * 64);
#pragma unroll
            for (int d = 0; d < 64; ++d) o[d] = 0.f;
            float m = -1e30f, l = 0.f;
            for (int kt = 0; kt < ntile; ++kt) {
                __syncthreads();
                const int nvr = (NCMP - kt * 64) < 64 ? (NCMP - kt * 64) : 64;
                load_tile512(Ks, kcmp + ((size_t)bg * NCMP + kt * 64) * 64, 64, nvr);
                load_tile512(Vs, vcmp + ((size_t)bg * NCMP + kt * 64) * 64, 64, nvr);
                __syncthreads();
                for (int r = 0; r < nvr; ++r) { const int ce = 16 * (kt * 64 + r) + 31;
                    if (ce <= t) { float sc; NV_DOT(q, Ks[r], sc); sc -= slope * (float)(t - ce); NV_ONLINE(sc, Vs[r]); } }
            }
            const float inv = (l > 0.f) ? 1.f / l : 0.f;
            const float gate = gf[(size_t)(b * S_ + t) * 32 + 0 * 8 + h];
            float* orow = ob + (size_t)(b * S_ + t) * D_ + h * 64;
#pragma unroll
            for (int d = 0; d < 64; ++d) orow[d] = gate * o[d] * inv;
            for (int kt = 0; kt < 8; ++kt) {
                __syncthreads();
                const int nvr = (NCMP - kt * 64) < 64 ? (NCMP - kt * 64) : 64;
                if (kt < ntile) load_tile512(Ks, kcmp + ((size_t)bg * NCMP + kt * 64) * 64, 64, nvr);
                __syncthreads();
                for (int r = 0; r < 64; ++r) { const int n = kt * 64 + r, ce = 16 * n + 31; float pp = 0.f;
                    if (kt < ntile && r < nvr && ce <= t) { float sc; NV_DOT(q, Ks[r], sc); sc -= slope * (float)(t - ce); pp = __expf(sc - m) * inv; }
                    if (r4 == 0) prow_t[n] = pp; else prow_t[n] += pp; }
            }
        }
    }
}
__device__ __forceinline__ void ph_attn_a(float* lds, KP p) {
    constexpr int NQB = S_ / NT;
    constexpr int N_CMP = NQB * B_ * 2, N_FOX = NQB * B_ * 4, N_SB = NQB * B_ * 4;
    MK_LOOP(vb, N_CMP + N_FOX + N_SB) {
        if (vb < N_FOX) { const int qb = NQB - 1 - vb / (B_ * 4); attn_vblock<0>(lds, p, qb, vb % (B_ * 4)); }
        else if (vb < N_FOX + N_SB) { const int v = vb - N_FOX; const int qb = NQB - 1 - v / (B_ * 4); attn_vblock<2>(lds, p, qb, v % (B_ * 4)); }
        else { const int v = vb - N_FOX - N_SB; attn_vblock<3>(lds, p, v / (B_ * 2), v % (B_ * 2)); }
    }
}
__device__ __forceinline__ void ph_select(KP p) {
    const int lane = ftid() & 63, wv = ftid() >> 6; int* sel = WSP(int, O_SEL);
    for (int wave = fbid() * 8 + wv; wave < B_ * 2 * S_; wave += gridDim.x * 8) {
        const int t = wave % S_; const float* pt = WSP(float, O_PTOT) + (size_t)wave * 512; const int cur = t >> 6;
        float v[2];
#pragma unroll
        for (int k = 0; k < 2; ++k) { const int j = lane + 64 * k;
            float imp = pt[4 * j] + pt[4 * j + 1] + pt[4 * j + 2];
            if (4 * j + 3 < NCMP) imp += 0.5f * pt[4 * j + 3];
            if (j >= 1) imp += 0.5f * pt[4 * j - 1];
            const bool valid = j <= cur, forced = valid && (j == 0 || j >= cur - 1);
            v[k] = forced ? 3.0e38f : (valid ? imp : -3.0e38f); }
        for (int it = 0; it < NSEL; ++it) {
            float bv = v[0]; int bi = lane; if (v[1] > bv) { bv = v[1]; bi = lane + 64; }
#pragma unroll
            for (int o = 32; o >= 1; o >>= 1) { const float ov = __shfl_xor(bv, o); const int oi = __shfl_xor(bi, o); if (ov > bv || (ov == bv && oi < bi)) { bv = ov; bi = oi; } }
            if (lane == 0) sel[(size_t)wave * NSEL + it] = bi;
            if (bi == lane) v[0] = -3.4e38f;
            if (bi == lane + 64) v[1] = -3.4e38f;
        }
    }
}
__device__ __forceinline__ void ph_attn_sel(KP p) {
    const bf16_t* projb = WSP(bf16_t, O_PROJB); const int tid = ftid();
    MK_LOOP(vb, (S_ / NT) * B_ * 8) {
        const int qb = vb / (B_ * 8), bh = vb % (B_ * 8), b = bh >> 3, h = bh & 7, g = h >> 2, t = qb * NT + tid;
        const float slope = exp2f(-(float)(h + 1));
        const bf16_t* prow = projb + (size_t)(b * S_ + t) * PB;
        const int kcol = C_KV + ((1 * 2 + 0) * 2 + g) * 64, vcol = C_KV + ((1 * 2 + 1) * 2 + g) * 64;
        const int* sl = WSP(int, O_SEL) + ((size_t)(b * 2 + g) * S_ + t) * NSEL;
        float q[64], o[64];
        MK_LOADQ(q, prow + h * 64);
#pragma unroll
        for (int d = 0; d < 64; ++d) o[d] = 0.f;
        float m = -1e30f, l = 0.f;
        for (int i = 0; i < NSEL; ++i) { const int blk = sl[i];
            for (int r = 0; r < 64; ++r) { const int s = blk * 64 + r;
                if (s <= t) { const bf16_t* kr = projb + (size_t)(b * S_ + s) * PB + kcol; const bf16_t* vr = projb + (size_t)(b * S_ + s) * PB + vcol;
                    float sc = 0.f;
#pragma unroll
                    for (int c = 0; c < 8; ++c) { float k8[8]; ld8(kr + 8 * c, k8);
#pragma unroll
                        for (int e = 0; e < 8; ++e) sc += q[8 * c + e] * k8[e]; }
                    sc -= slope * (float)(t - s);
                    if (sc > m) { const float al = __expf(m - sc); l *= al;
#pragma unroll
                        for (int d = 0; d < 64; ++d) o[d] *= al;
                        m = sc; }
                    const float pp = __expf(sc - m); l += pp;
#pragma unroll
                    for (int c = 0; c < 8; ++c) { float v8[8]; ld8(vr + 8 * c, v8);
#pragma unroll
                        for (int e = 0; e < 8; ++e) o[8 * c + e] += pp * v8[e]; }
                } } }
        const float inv = (l > 0.f) ? 1.f / l : 0.f; const float gate = WSP(float, O_GF)[(size_t)(b * S_ + t) * 32 + 1 * 8 + h];
        float* orow = WSP(float, O_O) + (size_t)(b * S_ + t) * D_ + h * 64;
#pragma unroll
        for (int d = 0; d < 64; ++d) orow[d] += gate * o[d] * inv;
    }
}
__device__ __forceinline__ void ph_attn_win(float* lds, KP p) {
    MK_LOOP(vb, (S_ / NT) * B_ * 8) attn_vblock<1>(lds, p, vb / (B_ * 8), vb % (B_ * 8));
}
__device__ __forceinline__ void ph_rmsnorm(KP p, int l) {
    const int lane = ftid() & 63, wv = ftid() >> 6; const float* g = p->in.g_out + (size_t)l * D_;
    for (int row = fbid() * 8 + wv; row < T_; row += gridDim.x * 8) {
        const float* r = WSP(float, O_O) + (size_t)row * D_; bf16_t* ro = WSP(bf16_t, O_OB) + (size_t)row * D_;
        float a[8], bq[8], s = 0.f, s2 = 0.f;
#pragma unroll
        for (int i = 0; i < 8; ++i) { a[i] = r[lane * 8 + i] + WSP(float, O_OWIN)[(size_t)row * 512 + lane * 8 + i]; s += a[i] * a[i]; bq[i] = r[512 + lane * 8 + i]; s2 += bq[i] * bq[i]; }
        const float sc0 = rsqrtf(wsum(s) * (1.f / 512.f) + RMS_EPS);
#pragma unroll
        for (int o = 1; o < 32; o <<= 1) s2 += __shfl_xor(s2, o);
        const float sc1 = rsqrtf(s2 * (1.f / 256.f) + RMS_EPS);
        float x0[8], x1[8];
#pragma unroll
        for (int i = 0; i < 8; ++i) { x0[i] = a[i] * sc0 * g[lane * 8 + i]; x1[i] = bq[i] * sc1 * g[512 + lane * 8 + i]; }
        *(u32x4*)(ro + lane * 8) = (u32x4){pk2(x0[0], x0[1]), pk2(x0[2], x0[3]), pk2(x0[4], x0[5]), pk2(x0[6], x0[7])};
        *(u32x4*)(ro + 512 + lane * 8) = (u32x4){pk2(x1[0], x1[1]), pk2(x1[2], x1[3]), pk2(x1[4], x1[5]), pk2(x1[6], x1[7])};
    }
}
template <bool ROUTER>
__device__ __forceinline__ void ph_ln(float* lds, KP p, int l, float* __restrict__ yout, int cnt_off = 0) {
    const int lane = ftid() & 63, wv = ftid() >> 6;
    const float* g = (ROUTER ? p->in.ln1_g : p->in.ln2_g) + (size_t)l * D_; const float* bb = (ROUTER ? p->in.ln1_b : p->in.ln2_b) + (size_t)l * D_;
    for (int row = fbid() * 8 + wv; row < T_; row += gridDim.x * 8) {
        float v[16], s = 0.f;
        if (ROUTER) { const float* src = WSP(float, O_MIX) + (size_t)row * D_;
#pragma unroll
            for (int j = 0; j < 2; ++j) { const f32x4 a = *(const f32x4*)(src + 512 * j + lane * 8), b = *(const f32x4*)(src + 512 * j + lane * 8 + 4);
                v[8 * j + 0] = a.x; v[8 * j + 1] = a.y; v[8 * j + 2] = a.z; v[8 * j + 3] = a.w; v[8 * j + 4] = b.x; v[8 * j + 5] = b.y; v[8 * j + 6] = b.z; v[8 * j + 7] = b.w; }
        } else { const float* src = WSP(float, O_X1) + (size_t)row * D_; const int* sl = WSP(int, O_SLOT) + row * TOPK; const bf16_t* y = WSP(bf16_t, O_Y);
#pragma unroll
            for (int j = 0; j < 2; ++j) { const f32x4 a = *(const f32x4*)(src + 512 * j + lane * 8), b = *(const f32x4*)(src + 512 * j + lane * 8 + 4);
                v[8 * j + 0] = ALPHA * a.x; v[8 * j + 1] = ALPHA * a.y; v[8 * j + 2] = ALPHA * a.z; v[8 * j + 3] = ALPHA * a.w; v[8 * j + 4] = ALPHA * b.x; v[8 * j + 5] = ALPHA * b.y; v[8 * j + 6] = ALPHA * b.z; v[8 * j + 7] = ALPHA * b.w; }
            float acc[16];
#pragma unroll
            for (int i = 0; i < 16; ++i) acc[i] = 0.f;
#pragma unroll
            for (int k = 0; k < TOPK; ++k) { const bf16_t* yr = y + (size_t)sl[k] * D_;
#pragma unroll
                for (int j = 0; j < 2; ++j) { float t8[8]; ld8(yr + 512 * j + lane * 8, t8);
#pragma unroll
                    for (int e = 0; e < 8; ++e) acc[8 * j + e] += t8[e]; } }
#pragma unroll
            for (int i = 0; i < 16; ++i) v[i] += acc[i]; }
#pragma unroll
        for (int i = 0; i < 16; ++i) s += v[i];
        const float mu = wsum(s) * (1.f / D_); float s2 = 0.f;
#pragma unroll
        for (int i = 0; i < 16; ++i) { v[i] -= mu; s2 += v[i] * v[i]; }
        const float rstd = rsqrtf(wsum(s2) * (1.f / D_) + LN_EPS);
        bf16_t* ybf = (ROUTER ? WSP(bf16_t, O_X1B) : WSP(bf16_t, O_XB)) + (size_t)row * D_;
#pragma unroll
        for (int j = 0; j < 2; ++j) { const int c0 = 512 * j + lane * 8;
#pragma unroll
            for (int e = 0; e < 8; ++e) v[8 * j + e] = v[8 * j + e] * rstd * g[c0 + e] + bb[c0 + e];
            *(f32x4*)(yout + (size_t)row * D_ + c0) = (f32x4){v[8 * j], v[8 * j + 1], v[8 * j + 2], v[8 * j + 3]};
            *(f32x4*)(yout + (size_t)row * D_ + c0 + 4) = (f32x4){v[8 * j + 4], v[8 * j + 5], v[8 * j + 6], v[8 * j + 7]};
            *(u32x4*)(ybf + c0) = (u32x4){pk2(v[8 * j], v[8 * j + 1]), pk2(v[8 * j + 2], v[8 * j + 3]), pk2(v[8 * j + 4], v[8 * j + 5]), pk2(v[8 * j + 6], v[8 * j + 7])}; }
    }
    if (ROUTER) {
        const float* rw = p->in.rw + (size_t)l * D_ * NE; const float* rb = p->in.rb + (size_t)l * NE; float* lgl = lds + wv * 512;
        const int nrow = (T_ - (fbid() * 8 + wv) + (int)gridDim.x * 8 - 1) / ((int)gridDim.x * 8);
#pragma unroll 1
        for (int ps = 0; ps < 4; ++ps) {
            f32x4 w0[16], w1[16];
#pragma unroll
            for (int i = 0; i < 16; ++i) { const int c = 512 * (i >> 3) + lane * 8 + (i & 7); w0[i] = *(const f32x4*)(rw + (size_t)c * NE + 8 * ps); w1[i] = *(const f32x4*)(rw + (size_t)c * NE + 8 * ps + 4); }
#pragma unroll 1
            for (int ri = 0; ri < nrow; ++ri) { const int row = fbid() * 8 + wv + ri * (int)gridDim.x * 8; const float* src = yout + (size_t)row * D_;
                f32x4 a0 = {0.f, 0.f, 0.f, 0.f}, a1 = {0.f, 0.f, 0.f, 0.f};
#pragma unroll
                for (int j = 0; j < 2; ++j) { const f32x4 xa = *(const f32x4*)(src + 512 * j + lane * 8), xb = *(const f32x4*)(src + 512 * j + lane * 8 + 4);
                    a0 += w0[8 * j + 0] * xa.x + w0[8 * j + 1] * xa.y + w0[8 * j + 2] * xa.z + w0[8 * j + 3] * xa.w + w0[8 * j + 4] * xb.x + w0[8 * j + 5] * xb.y + w0[8 * j + 6] * xb.z + w0[8 * j + 7] * xb.w;
                    a1 += w1[8 * j + 0] * xa.x + w1[8 * j + 1] * xa.y + w1[8 * j + 2] * xa.z + w1[8 * j + 3] * xa.w + w1[8 * j + 4] * xb.x + w1[8 * j + 5] * xb.y + w1[8 * j + 6] * xb.z + w1[8 * j + 7] * xb.w; }
#pragma unroll
                for (int e = 0; e < 4; ++e) { a0[e] = wsum(a0[e]); a1[e] = wsum(a1[e]); }
                if (lane == 0) { *(f32x4*)(lgl + ri * 32 + 8 * ps) = a0; *(f32x4*)(lgl + ri * 32 + 8 * ps + 4) = a1; } }
        }
        int* lcnt = (int*)(lds + 8 * 512);
        if (ftid() < NE) lcnt[ftid()] = 0;
        __syncthreads();
#pragma unroll 1
        for (int ri = 0; ri < nrow; ++ri) { const int row = fbid() * 8 + wv + ri * (int)gridDim.x * 8;
            const int e = lane & 31; const float lg = lgl[ri * 32 + e] + rb[e];
            float cur = lg, tv0 = 0.f, den = 0.f, myw = 0.f; int mye = 0;
#pragma unroll
            for (int k = 0; k < TOPK; ++k) { float bv = cur; int bi = e;
#pragma unroll
                for (int o = 16; o >= 1; o >>= 1) { const float ov = __shfl_xor(bv, o); const int oi = __shfl_xor(bi, o); if (ov > bv || (ov == bv && oi < bi)) { bv = ov; bi = oi; } }
                if (k == 0) tv0 = bv;
                const float w = __expf(bv - tv0); den += w;
                if (lane == k) { mye = bi; myw = w; }
                if (e == bi) cur = -3.4e38f; }
            if (lane < TOPK) { WSP(int, O_TOPE)[row * TOPK + lane] = mye; WSP(float, O_TOPW)[row * TOPK + lane] = myw / den; WSP(int, O_POS)[row * TOPK + lane] = atomicAdd(&lcnt[mye], 1); } }
        __syncthreads();
        if (ftid() < NE) { const int c = lcnt[ftid()]; lcnt[ftid()] = (c > 0) ? atomicAdd(WSP(int, O_COUNTS) + CNT_IDX(l, ftid()) + cnt_off, c) : 0; }
        __syncthreads();
#pragma unroll 1
        for (int ri = 0; ri < nrow; ++ri) { const int row = fbid() * 8 + wv + ri * (int)gridDim.x * 8;
            if (lane < TOPK) WSP(int, O_POS)[row * TOPK + lane] += lcnt[WSP(int, O_TOPE)[row * TOPK + lane]]; }
        __syncthreads();
    }
}
__device__ __forceinline__ void ph_moe_plan(KP p, int l) {
    if (fbid() == 0 && ftid() == 0) { const int* counts = WSP(int, O_COUNTS) + l * 32; int* meta = WSP(int, O_META); int nt = 0;
        for (int e = 0; e < NE; ++e) { meta[e] = nt; const int c = counts[e];
            for (int r = 0; r < c; r += 256) { meta[64 + 2 * nt] = e; meta[65 + 2 * nt] = (c - r) < 256 ? (c - r) : 256; ++nt; } }
        meta[32] = nt; }
}
__device__ __forceinline__ void ph_moe_scatter(KP p) {
    const int* meta = WSP(int, O_META);
    for (int i = fbid() * NT + ftid(); i < MROWS; i += gridDim.x * NT) {
        const int row = meta[WSP(int, O_TOPE)[i]] * 256 + WSP(int, O_POS)[i];
        WSP(int, O_ROWTOK)[row] = i >> 2; WSP(float, O_ROWW)[row] = WSP(float, O_TOPW)[i]; WSP(int, O_SLOT)[i] = row; }
}
__device__ __forceinline__ void ph_bias1_reduce(KP p, int l) {
    if (fbid() != (int)gridDim.x - 1) return;
    const int tid = ftid(); if (tid < 256) { const float* pp = WSP(float, O_BIAS1P) + ((size_t)(l * 2 + (tid >> 7)) * 64) * 128 + (tid & 127); float a = 0.f;
        for (int s = 0; s < 64; ++s) a += pp[s * 128];
        WSP(float, O_BIAS1)[l * 256 + tid] = a; }
}
__device__ __forceinline__ void ph_cumsum(float* lds, KP p, int blk0) {
    const int tid = ftid(), lane = tid & 63, wv = tid >> 6; const int bh = fbid() - blk0;
    if (bh < 0 || bh >= B_ * 4) return;
    const int b = bh >> 2, h = bh & 3; const float* gf = WSP(float, O_GF) + (size_t)(b * S_ + tid * 16) * 32 + 24 + h;
    float v[16], run = 0.f;
#pragma unroll
    for (int i = 0; i < 16; ++i) { run += gf[(size_t)i * 32]; v[i] = run; }
    float inc = run;
#pragma unroll
    for (int o = 1; o < 64; o <<= 1) { const float t = __shfl_up(inc, o); if (lane >= o) inc += t; }
    if (lane == 63) lds[wv] = inc;
    __syncthreads();
    float woff = 0.f;
#pragma unroll
    for (int i = 0; i < 8; ++i) woff += (i < wv) ? lds[i] : 0.f;
    const float off = woff + inc - run; float* c = WSP(float, O_CFOX) + (size_t)bh * S_ + tid * 16;
#pragma unroll
    for (int i = 0; i < 4; ++i) *(f32x4*)(c + 4 * i) = (f32x4){v[4 * i] + off, v[4 * i + 1] + off, v[4 * i + 2] + off, v[4 * i + 3] + off};
    __syncthreads();
}
__device__ __forceinline__ void ph_prep2(KP p, int l) {
    { unsigned* kmax2 = WSP(unsigned, O_COUNTS) + 192 + l * 8;
      for (int i = fbid() * NT + ftid(); i < B_ * 4 * S_ * 2; i += gridDim.x * NT) { const int half = i & 1, t = (i >> 1) % S_, bh = (i >> 1) / S_, b = bh >> 2, h = bh & 3;
          const bf16_t* kr = WSP(bf16_t, O_PROJB) + (size_t)(b * S_ + t) * PB + C_FOX + (4 + h) * 64 + half * 32; float ss = 0.f;
#pragma unroll
          for (int c = 0; c < 4; ++c) { float k8[8]; ld8(kr + 8 * c, k8);
#pragma unroll
              for (int e = 0; e < 8; ++e) ss += k8[e] * k8[e]; }
          ss += __shfl_xor(ss, 1);
#pragma unroll
          for (int o = 2; o < 64; o <<= 1) ss = fmaxf(ss, __shfl_xor(ss, o));
          if ((ftid() & 63) == 0) atomicMax(kmax2 + bh, __float_as_uint(ss)); } }
    for (int i = fbid() * NT + ftid(); i < 8 * 512 * 64; i += gridDim.x * NT) {
        const int d = i & 63, n = (i >> 6) & 511, combo = i >> 15, kv = combo & 1, bg = combo >> 1;
        const float* w2 = (kv ? p->in.w2v : p->in.w2k) + (size_t)l * 128 * 64; const bf16_t* hr = WSP(bf16_t, O_HID) + ((size_t)combo * 512 + n) * 128;
        float a = 0.f;
#pragma unroll 4
        for (int c = 0; c < 16; ++c) { float h8[8]; ld8(hr + 8 * c, h8);
#pragma unroll
            for (int e = 0; e < 8; ++e) a += h8[e] * w2[(8 * c + e) * 64 + d]; }
        (kv ? WSP(bf16_t, O_VCMPB) : WSP(bf16_t, O_KCMPB))[((size_t)bg * 512 + n) * 64 + d] = (n < NCMP) ? (bf16_t)f2bf(a) : (bf16_t)0; }
}
__device__ __forceinline__ void ph_moe_scatter2(float* lds, KP p, int l) {
    const int tid = ftid(); int* ts = (int*)lds;
    const int* counts = WSP(int, O_COUNTS) + CNT_IDX(l, 0); int* meta = WSP(int, O_META); int* cl = ts + 64;
    __syncthreads();
    if (tid < NE) cl[tid] = counts[tid * 32];
    __syncthreads();
    if (tid == 0) { int nt = 0; for (int e = 0; e < NE; ++e) { ts[e] = nt; nt += (cl[e] + 255) >> 8; } ts[32] = nt; }
    __syncthreads();
    if (fbid() == 0) { if (tid < NE) { const int c = cl[tid], t0 = ts[tid]; meta[tid] = t0; for (int r = 0, t = t0; r < c; r += 256, ++t) { meta[64 + 2 * t] = tid; meta[65 + 2 * t] = (c - r) < 256 ? (c - r) : 256; } }
        if (tid == 0) meta[32] = ts[32]; }
    for (int i = fbid() * NT + tid; i < MROWS; i += gridDim.x * NT) {
        const int row = ts[WSP(int, O_TOPE)[i]] * 256 + WSP(int, O_POS)[i];
        WSP(int, O_ROWTOK)[row] = i >> 2; WSP(float, O_ROWW)[row] = WSP(float, O_TOPW)[i]; WSP(int, O_SLOT)[i] = row; }
    __syncthreads();
}
}
namespace mk {
typedef short bf16x8 __attribute__((ext_vector_type(8)));
typedef float f32x16 __attribute__((ext_vector_type(16)));
typedef float f32x2_t __attribute__((ext_vector_type(2)));
typedef __bf16 bf16x2_t __attribute__((ext_vector_type(2)));
typedef unsigned u32x2 __attribute__((ext_vector_type(2)));
__device__ __forceinline__ unsigned cvtpk(float lo, float hi) { f32x2_t v = {lo, hi}; bf16x2_t b = __builtin_convertvector(v, bf16x2_t); return __builtin_bit_cast(unsigned, b); }
constexpr int KROW = 144, VROW = 136;
constexpr int E1_K = 0, E1_V = 64 * KROW, E1_C = E1_V + 64 * VROW, E1_BUF = E1_C + 256;
constexpr int E1_FLAGS = 2 * E1_BUF;
constexpr float LOG2E = 1.4426950408889634f;
constexpr float RESC_THR = 8.0f;
#define CROW(reg, hh) (((reg) & 3) + 8 * ((reg) >> 2) + 4 * (hh))

struct E1Geom { int b, q0, h; const bf16_t* qp; const bf16_t* kp; const bf16_t* vp; size_t pitch; };

template <int KIND>
__device__ __forceinline__ void e1_unit(LAS unsigned char* lds, KP p, int b, int hg, int qb, float* __restrict__ obase, float* __restrict__ owin, const unsigned* __restrict__ kmax2) {
    const int tid = ftid(), lane = tid & 63, w = __builtin_amdgcn_readfirstlane(tid >> 6), r32 = lane & 31, hh = lane >> 5;
    const bf16_t* projb = WSP(bf16_t, O_PROJB);
    int h, q0, qrow0, qcol, kcol, vcol, nrows;
    if (KIND == 0) { h = hg; q0 = qb * 256; qrow0 = q0 + 32 * w; qcol = C_FOX + h * 64; kcol = C_FOX + (4 + h) * 64; vcol = C_FOX + (8 + h) * 64; nrows = 256; }
    else if (KIND == 2) { h = hg; q0 = qb * 256; qrow0 = q0 + 32 * w; qcol = C_SB + h * 64; kcol = C_SB + (4 + h) * 64; vcol = C_SB + (8 + h) * 64; nrows = 256; }
    else { h = 4 * hg + (w & 3); q0 = qb * 64; qrow0 = q0 + 32 * (w >> 2); qcol = h * 64; kcol = C_KV + ((2 * 2 + 0) * 2 + hg) * 64; vcol = C_KV + ((2 * 2 + 1) * 2 + hg) * 64; nrows = 64; }
    const int tq = qrow0 + r32;
    const bf16_t* kbase = projb + (size_t)(b * S_) * PB + kcol; const bf16_t* vbase = projb + (size_t)(b * S_) * PB + vcol;
    bf16x8 qf[4];
    { const bf16_t* qptr = projb + (size_t)(b * S_ + tq) * PB + qcol + 8 * hh;
#pragma unroll
      for (int d0 = 0; d0 < 4; ++d0) qf[d0] = *(const bf16x8*)(qptr + 16 * d0); }
    int j0 = 0; const int j1 = (q0 + nrows - 1) >> 6;
    if (KIND == 1) { j0 = (q0 - 511) >> 6; if (j0 < 0) j0 = 0; }
    const int ntile = j1 - j0 + 1;
    float ct2 = 0.f, sl2 = 0.f; const float* cb = nullptr;
    if (KIND == 0) { cb = WSP(float, O_CFOX) + (size_t)(b * 4 + h) * S_; ct2 = cb[tq] * LOG2E; }
    if (KIND == 1) sl2 = exp2f(-(float)(h + 1)) * LOG2E;
    float qkb = 0.f;
    if (KIND == 0) { float qs = 0.f;
#pragma unroll
        for (int d0 = 0; d0 < 4; ++d0)
#pragma unroll
            for (int e = 0; e < 8; ++e) { const float x = bf2f((unsigned short)qf[d0][e]); qs += x * x; }
        qs += __shfl_xor(qs, 32);
        const float km2 = __uint_as_float(kmax2[b * 4 + h]);
        qkb = sqrtf(qs * km2) * (SCALE * LOG2E * 1.01f); }
    const float tqf = (float)tq;
    const int skey = tid >> 3, sch = tid & 7;
    u32x4 rk, rv; float rc = 0.f;
#define E1_LOAD(jj) do { const size_t ro_ = (size_t)((jj) * 64 + skey) * PB + sch * 8; rk = *(const u32x4*)(kbase + ro_); rv = *(const u32x4*)(vbase + ro_); \
        if (KIND == 0 && tid < 64) rc = cb[(jj) * 64 + tid] * LOG2E; } while (0)
#define E1_WRITE(bufp) do { *(LAS u32x4*)((bufp) + E1_K + skey * KROW + sch * 16) = rk; \
        LAS unsigned short* vt_ = (LAS unsigned short*)((bufp) + E1_V + (8 * sch) * VROW) + skey; \
        vt_[0 * (VROW / 2)] = (unsigned short)(rv.x & 0xffffu); vt_[1 * (VROW / 2)] = (unsigned short)(rv.x >> 16); vt_[2 * (VROW / 2)] = (unsigned short)(rv.y & 0xffffu); vt_[3 * (VROW / 2)] = (unsigned short)(rv.y >> 16); \
        vt_[4 * (VROW / 2)] = (unsigned short)(rv.z & 0xffffu); vt_[5 * (VROW / 2)] = (unsigned short)(rv.z >> 16); vt_[6 * (VROW / 2)] = (unsigned short)(rv.w & 0xffffu); vt_[7 * (VROW / 2)] = (unsigned short)(rv.w >> 16); \
        if (KIND == 0 && tid < 64) ((LAS float*)((bufp) + E1_C))[tid] = rc; } while (0)
    f32x16 o0, o1;
#pragma unroll
    for (int r = 0; r < 16; ++r) { o0[r] = 0.f; o1[r] = 0.f; }
    float m = -1e30f, l = 0.f, carry = 0.f;
    bool wave_done = false;
    LAS unsigned* flags = (LAS unsigned*)(lds + E1_FLAGS);
    if (KIND != 1) { if (tid < 8) flags[tid] = 0u; }
    __syncthreads();
    E1_LOAD(KIND != 1 ? j1 : j0);
    for (int it = 0; it < ntile; ++it) {
        const int j = (KIND != 1) ? (j1 - it) : (j0 + it);
        LAS unsigned char* buf = lds + (it & 1) * E1_BUF;
        E1_WRITE(buf);
        __syncthreads();
        if (KIND != 1) { unsigned alld = 1u;
#pragma unroll
            for (int i = 0; i < 8; ++i) alld &= flags[i];
            if (alld) break; }
        if (it + 1 < ntile) E1_LOAD((KIND != 1) ? (j - 1) : (j + 1));
        if (!(KIND != 1 && wave_done)) {
            f32x16 p0, p1;
#pragma unroll
            for (int r = 0; r < 16; ++r) { p0[r] = 0.f; p1[r] = 0.f; }
            { const LAS unsigned char* kp_ = buf + E1_K + r32 * KROW + hh * 16;
#pragma unroll
              for (int d0 = 0; d0 < 4; ++d0) { const bf16x8 a0 = *(const LAS bf16x8*)(kp_ + d0 * 32), a1 = *(const LAS bf16x8*)(kp_ + 32 * KROW + d0 * 32);
                  p0 = __builtin_amdgcn_mfma_f32_32x32x16_bf16(a0, qf[d0], p0, 0, 0, 0); p1 = __builtin_amdgcn_mfma_f32_32x32x16_bf16(a1, qf[d0], p1, 0, 0, 0); } }
            const int kb = j * 64 + 4 * hh;
            if (KIND == 2) {
                float lk0[16], lk1[16], gs[8];
#pragma unroll
                for (int reg = 0; reg < 16; ++reg) { const int kpos = kb + CROW(reg, 0);
                    const float z0 = p0[reg] * SCALE, z1 = p1[reg] * SCALE; const bool v0 = kpos < tq, v1 = kpos + 32 < tq;
                    const float lb0 = fminf(z0, 0.f) - __logf(1.f + __expf(-fabsf(z0))), lb1 = fminf(z1, 0.f) - __logf(1.f + __expf(-fabsf(z1)));
                    lk0[reg] = v0 ? (lb0 - z0) : 0.f; lk1[reg] = v1 ? (lb1 - z1) : 0.f;
                    p0[reg] = v0 ? lb0 : -INFINITY; p1[reg] = v1 ? lb1 : -INFINITY; }
#pragma unroll
                for (int g4 = 0; g4 < 4; ++g4) { gs[g4] = (lk0[4 * g4] + lk0[4 * g4 + 1]) + (lk0[4 * g4 + 2] + lk0[4 * g4 + 3]); gs[4 + g4] = (lk1[4 * g4] + lk1[4 * g4 + 1]) + (lk1[4 * g4 + 2] + lk1[4 * g4 + 3]); }
                float oth[8];
#pragma unroll
                for (int gi = 0; gi < 8; ++gi) oth[gi] = __shfl_xor(gs[gi], 32);
                float run = 0.f;
#pragma unroll
                for (int gi = 7; gi >= 0; --gi) {
                    float later = carry + run + (hh == 0 ? oth[gi] : 0.f);
#pragma unroll
                    for (int e = 3; e >= 0; --e) { const int reg = (gi & 3) * 4 + e;
                        if (gi >> 2) { p1[reg] = __expf(p1[reg] + later); later += lk1[reg]; } else { p0[reg] = __expf(p0[reg] + later); later += lk0[reg]; } }
                    run += gs[gi] + oth[gi]; }
                carry += run;
            } else {
                if (KIND == 0) {
                    const LAS float* cs = (const LAS float*)(buf + E1_C) + 4 * hh;
#pragma unroll
                    for (int i = 0; i < 4; ++i) { const f32x4 c0 = *(const LAS f32x4*)(cs + 8 * i), c1 = *(const LAS f32x4*)(cs + 32 + 8 * i);
#pragma unroll
                        for (int e = 0; e < 4; ++e) { const int reg = 4 * i + e; const int kpos = kb + CROW(reg, 0);
                            const float s0 = p0[reg] * (SCALE * LOG2E) + (ct2 - c0[e]), s1 = p1[reg] * (SCALE * LOG2E) + (ct2 - c1[e]);
                            p0[reg] = (kpos <= tq) ? s0 : -INFINITY; p1[reg] = (kpos + 32 <= tq) ? s1 : -INFINITY; } }
                } else {
#pragma unroll
                    for (int reg = 0; reg < 16; ++reg) { const int kpos = kb + CROW(reg, 0); const float d0f = tqf - (float)kpos, d1f = d0f - 32.f;
                        const float s0 = p0[reg] * (SCALE * LOG2E) - sl2 * d0f, s1 = p1[reg] * (SCALE * LOG2E) - sl2 * d1f;
                        p0[reg] = (kpos <= tq && tq - kpos < 512) ? s0 : -INFINITY; p1[reg] = (kpos + 32 <= tq && tq - kpos - 32 < 512) ? s1 : -INFINITY; }
                }
                float rm = fmaxf(p0[0], p1[0]);
#pragma unroll
                for (int reg = 1; reg < 16; ++reg) rm = fmaxf(rm, fmaxf(p0[reg], p1[reg]));
                rm = fmaxf(rm, __shfl_xor(rm, 32));
                if (__any(rm > m + RESC_THR)) { const float mn = fmaxf(m, rm), al = __builtin_amdgcn_exp2f(m - mn); l *= al;
#pragma unroll
                    for (int r = 0; r < 16; ++r) { o0[r] *= al; o1[r] *= al; }
                    m = mn; }
                float ls = 0.f;
#pragma unroll
                for (int reg = 0; reg < 16; ++reg) { p0[reg] = __builtin_amdgcn_exp2f(p0[reg] - m); p1[reg] = __builtin_amdgcn_exp2f(p1[reg] - m); ls += p0[reg] + p1[reg]; }
                l += ls;
            }
            { const LAS unsigned char* vp_ = buf + E1_V + r32 * VROW + hh * 8;
#pragma unroll
              for (int s = 0; s < 4; ++s) {
                  u32x4 pw;
                  if (s < 2) { pw.x = cvtpk(p0[8 * s + 0], p0[8 * s + 1]); pw.y = cvtpk(p0[8 * s + 2], p0[8 * s + 3]); pw.z = cvtpk(p0[8 * s + 4], p0[8 * s + 5]); pw.w = cvtpk(p0[8 * s + 6], p0[8 * s + 7]); }
                  else { const int s2 = s - 2; pw.x = cvtpk(p1[8 * s2 + 0], p1[8 * s2 + 1]); pw.y = cvtpk(p1[8 * s2 + 2], p1[8 * s2 + 3]); pw.z = cvtpk(p1[8 * s2 + 4], p1[8 * s2 + 5]); pw.w = cvtpk(p1[8 * s2 + 6], p1[8 * s2 + 7]); }
                  const bf16x8 pb = __builtin_bit_cast(bf16x8, pw);
                  const u32x2 a0l = *(const LAS u32x2*)(vp_ + s * 32), a0h = *(const LAS u32x2*)(vp_ + s * 32 + 16);
                  const u32x2 a1l = *(const LAS u32x2*)(vp_ + 32 * VROW + s * 32), a1h = *(const LAS u32x2*)(vp_ + 32 * VROW + s * 32 + 16);
                  const bf16x8 va0 = __builtin_bit_cast(bf16x8, (u32x4){a0l.x, a0l.y, a0h.x, a0h.y}), va1 = __builtin_bit_cast(bf16x8, (u32x4){a1l.x, a1l.y, a1h.x, a1h.y});
                  o0 = __builtin_amdgcn_mfma_f32_32x32x16_bf16(va0, pb, o0, 0, 0, 0); o1 = __builtin_amdgcn_mfma_f32_32x32x16_bf16(va1, pb, o1, 0, 0, 0); } }
            if (KIND == 0) {
                const float c0 = *(const LAS float*)(buf + E1_C); const bool dn = __all(qkb + (ct2 - c0) - m < -150.f);
                if (dn && !wave_done) { wave_done = true; if (lane == 0) flags[w] = 1u; } }
            if (KIND == 2) { const bool dn = __all(carry < -110.f);
                if (dn && !wave_done) { wave_done = true; if (lane == 0) flags[w] = 1u; } }
        }
    }
    float inv = 1.f, gate = 1.f;
    if (KIND != 2) { l += __shfl_xor(l, 32); inv = (l > 0.f) ? 1.f / l : 0.f; }
    float* orow;
    if (KIND == 0) orow = obase + (size_t)(b * S_ + tq) * D_ + 512 + h * 64;
    else if (KIND == 2) orow = obase + (size_t)(b * S_ + tq) * D_ + 768 + h * 64;
    else { orow = owin + (size_t)(b * S_ + tq) * 512 + h * 64; gate = WSP(float, O_GF)[(size_t)(b * S_ + tq) * 32 + 2 * 8 + h]; }
    const float sc = inv * gate;
#pragma unroll
    for (int i = 0; i < 4; ++i) {
        *(f32x4*)(orow + 8 * i + 4 * hh) = (f32x4){o0[4 * i] * sc, o0[4 * i + 1] * sc, o0[4 * i + 2] * sc, o0[4 * i + 3] * sc};
        *(f32x4*)(orow + 32 + 8 * i + 4 * hh) = (f32x4){o1[4 * i] * sc, o1[4 * i + 1] * sc, o1[4 * i + 2] * sc, o1[4 * i + 3] * sc}; }
#undef E1_LOAD
#undef E1_WRITE
}
}
namespace mk {
typedef short v4i16_t __attribute__((ext_vector_type(4)));
constexpr int E2_WAVE = 64 * KROW + 512;
template <bool USE_MASK>
__device__ __forceinline__ void e2_wave_unit(LAS unsigned char* ldsw, KP p, int b, int g, int t0, float* __restrict__ obase, const float* __restrict__ csrc, int cpitch) {
    const int lane = ftid() & 63, r32 = lane & 31, hh = lane >> 5, qi = r32 >> 2, r4 = r32 & 3;
    const int h = 4 * g + r4, tq = t0 + qi;
    const bf16_t* projb = WSP(bf16_t, O_PROJB);
    const bf16_t* kbase = projb + (size_t)(b * S_) * PB + C_KV + ((1 * 2 + 0) * 2 + g) * 64;
    const bf16_t* vbase = projb + (size_t)(b * S_) * PB + C_KV + ((1 * 2 + 1) * 2 + g) * 64;
    bf16x8 qf[4];
    { const bf16_t* qptr = projb + (size_t)(b * S_ + tq) * PB + h * 64 + 8 * hh;
#pragma unroll
      for (int d0 = 0; d0 < 4; ++d0) qf[d0] = *(const bf16x8*)(qptr + 16 * d0); }
    unsigned qm0 = 0u, qm1 = 0u, qm2 = 0u, qm3 = 0u;
    if (USE_MASK) { const u32x4 mw = *(const u32x4*)(WSP(unsigned, O_SELMASK) + ((size_t)((b * 2 + g) * S_ + t0 + (lane >> 3))) * 4); qm0 = mw.x; qm1 = mw.y; qm2 = mw.z; qm3 = mw.w; }
    else { const int* sp = WSP(int, O_SEL) + ((size_t)((b * 2 + g) * S_ + t0)) * NSEL + lane * 2;
      const int e0 = sp[0], e1 = sp[1];
#pragma unroll
      for (int k = 0; k < 2; ++k) { const int e = k ? e1 : e0; const unsigned bit = 1u << (e & 31); const int wd = e >> 5;
          qm0 |= (wd == 0) ? bit : 0u; qm1 |= (wd == 1) ? bit : 0u; qm2 |= (wd == 2) ? bit : 0u; qm3 |= (wd == 3) ? bit : 0u; }
#pragma unroll
      for (int o = 1; o < 8; o <<= 1) { qm0 |= __shfl_xor(qm0, o); qm1 |= __shfl_xor(qm1, o); qm2 |= __shfl_xor(qm2, o); qm3 |= __shfl_xor(qm3, o); } }
    const unsigned rm0 = __shfl(qm0, qi * 8), rm1 = __shfl(qm1, qi * 8), rm2 = __shfl(qm2, qi * 8), rm3 = __shfl(qm3, qi * 8);
    unsigned um0 = qm0, um1 = qm1, um2 = qm2, um3 = qm3;
#pragma unroll
    for (int o = 8; o < 64; o <<= 1) { um0 |= __shfl_xor(um0, o); um1 |= __shfl_xor(um1, o); um2 |= __shfl_xor(um2, o); um3 |= __shfl_xor(um3, o); }
    LAS int* list = (LAS int*)(ldsw + 64 * KROW);
    int nblk;
    { const bool s0 = (((lane < 32) ? um0 : um1) >> (lane & 31)) & 1u, s1 = (((lane < 32) ? um2 : um3) >> (lane & 31)) & 1u;
      const unsigned long long b0 = __ballot(s0), b1 = __ballot(s1);
      const unsigned long long lower = (lane == 0) ? 0ull : (~0ull >> (64 - lane));
      const int n0 = __popcll(b0);
      if (s0) list[__popcll(b0 & lower)] = lane;
      if (s1) list[n0 + __popcll(b1 & lower)] = lane + 64;
      nblk = n0 + __popcll(b1); }
    asm volatile("s_waitcnt lgkmcnt(0)" ::: "memory");
    const float sl2 = exp2f(-(float)(h + 1)) * LOG2E, tqf = (float)tq;
    f32x16 o0, o1;
#pragma unroll
    for (int r = 0; r < 16; ++r) { o0[r] = 0.f; o1[r] = 0.f; }
    float m = -1e30f, l = 0.f;
    const int vrow = lane >> 3, vch = lane & 7;
    const int gq = lane >> 4, li = lane & 15;
    const LAS unsigned char* trb = ldsw + (4 * hh + (li >> 2)) * KROW + (16 * (gq & 1) + 4 * (li & 3)) * 2;
    bf16x8 kn0[4], kn1[4]; u32x4 vn[8];
#define E2_LOAD(blk) do { const bf16_t* kp_ = kbase + (size_t)((blk) * 64 + r32) * PB + 8 * hh; const bf16_t* vp_ = vbase + (size_t)((blk) * 64 + vrow) * PB + vch * 8; \
        _Pragma("unroll") for (int d0 = 0; d0 < 4; ++d0) { kn0[d0] = *(const bf16x8*)(kp_ + 16 * d0); kn1[d0] = *(const bf16x8*)(kp_ + (size_t)32 * PB + 16 * d0); } \
        _Pragma("unroll") for (int i = 0; i < 8; ++i) vn[i] = *(const u32x4*)(vp_ + (size_t)(8 * i) * PB); } while (0)
    int blk = list[0];
    blk = __builtin_amdgcn_readfirstlane(blk);
    E2_LOAD(blk);
    for (int it = 0; it < nblk; ++it) {
#pragma unroll
        for (int i = 0; i < 8; ++i) *(LAS u32x4*)(ldsw + (vrow + 8 * i) * KROW + vch * 16) = vn[i];
        const int cur = blk;
        f32x16 p0, p1;
#pragma unroll
        for (int r = 0; r < 16; ++r) { p0[r] = 0.f; p1[r] = 0.f; }
#pragma unroll
        for (int d0 = 0; d0 < 4; ++d0) { p0 = __builtin_amdgcn_mfma_f32_32x32x16_bf16(kn0[d0], qf[d0], p0, 0, 0, 0); p1 = __builtin_amdgcn_mfma_f32_32x32x16_bf16(kn1[d0], qf[d0], p1, 0, 0, 0); }
        if (it + 1 < nblk) { blk = __builtin_amdgcn_readfirstlane(list[it + 1]); E2_LOAD(blk); }
        const unsigned rw = (cur < 32) ? rm0 : (cur < 64) ? rm1 : (cur < 96) ? rm2 : rm3;
        const bool rowsel = (rw >> (cur & 31)) & 1u;
        const int kb = cur * 64 + 4 * hh;
#pragma unroll
        for (int reg = 0; reg < 16; ++reg) { const int kpos = kb + CROW(reg, 0); const float d0f = tqf - (float)kpos, d1f = d0f - 32.f;
            const float s0 = p0[reg] * (SCALE * LOG2E) - sl2 * d0f, s1 = p1[reg] * (SCALE * LOG2E) - sl2 * d1f;
            p0[reg] = (rowsel && kpos <= tq) ? s0 : -INFINITY; p1[reg] = (rowsel && kpos + 32 <= tq) ? s1 : -INFINITY; }
        float rmx = fmaxf(p0[0], p1[0]);
#pragma unroll
        for (int reg = 1; reg < 16; ++reg) rmx = fmaxf(rmx, fmaxf(p0[reg], p1[reg]));
        rmx = fmaxf(rmx, __shfl_xor(rmx, 32));
        if (__any(rmx > m + RESC_THR)) { const float mn = fmaxf(m, rmx), al = __builtin_amdgcn_exp2f(m - mn); l *= al;
#pragma unroll
            for (int r = 0; r < 16; ++r) { o0[r] *= al; o1[r] *= al; }
            m = mn; }
        float ls = 0.f;
#pragma unroll
        for (int reg = 0; reg < 16; ++reg) { p0[reg] = __builtin_amdgcn_exp2f(p0[reg] - m); p1[reg] = __builtin_amdgcn_exp2f(p1[reg] - m); ls += p0[reg] + p1[reg]; }
        l += ls;
#pragma unroll
        for (int s = 0; s < 4; ++s) {
            u32x4 pw;
            if (s < 2) { pw.x = cvtpk(p0[8 * s + 0], p0[8 * s + 1]); pw.y = cvtpk(p0[8 * s + 2], p0[8 * s + 3]); pw.z = cvtpk(p0[8 * s + 4], p0[8 * s + 5]); pw.w = cvtpk(p0[8 * s + 6], p0[8 * s + 7]); }
            else { const int s2 = s - 2; pw.x = cvtpk(p1[8 * s2 + 0], p1[8 * s2 + 1]); pw.y = cvtpk(p1[8 * s2 + 2], p1[8 * s2 + 3]); pw.z = cvtpk(p1[8 * s2 + 4], p1[8 * s2 + 5]); pw.w = cvtpk(p1[8 * s2 + 6], p1[8 * s2 + 7]); }
            const bf16x8 pb = __builtin_bit_cast(bf16x8, pw);
            const v4i16_t a0l = __builtin_amdgcn_ds_read_tr16_b64_v4i16((LAS v4i16_t*)(trb + (16 * s) * KROW)), a0h = __builtin_amdgcn_ds_read_tr16_b64_v4i16((LAS v4i16_t*)(trb + (16 * s + 8) * KROW));
            const v4i16_t a1l = __builtin_amdgcn_ds_read_tr16_b64_v4i16((LAS v4i16_t*)(trb + (16 * s) * KROW + 64)), a1h = __builtin_amdgcn_ds_read_tr16_b64_v4i16((LAS v4i16_t*)(trb + (16 * s + 8) * KROW + 64));
            const bf16x8 va0 = (bf16x8){a0l[0], a0l[1], a0l[2], a0l[3], a0h[0], a0h[1], a0h[2], a0h[3]}, va1 = (bf16x8){a1l[0], a1l[1], a1l[2], a1l[3], a1h[0], a1h[1], a1h[2], a1h[3]};
            o0 = __builtin_amdgcn_mfma_f32_32x32x16_bf16(va0, pb, o0, 0, 0, 0); o1 = __builtin_amdgcn_mfma_f32_32x32x16_bf16(va1, pb, o1, 0, 0, 0); }
    }
    l += __shfl_xor(l, 32);
    const float sc = ((l > 0.f) ? 1.f / l : 0.f) * WSP(float, O_GF)[(size_t)(b * S_ + tq) * 32 + 1 * 8 + h];
    float* orow = obase + (size_t)(b * S_ + tq) * D_ + h * 64; const float* crow = csrc + (size_t)(b * S_ + tq) * cpitch + h * 64;
#pragma unroll
    for (int i = 0; i < 4; ++i) {
        f32x4 x0 = *(const f32x4*)(crow + 8 * i + 4 * hh), x1 = *(const f32x4*)(crow + 32 + 8 * i + 4 * hh);
        x0 += (f32x4){o0[4 * i] * sc, o0[4 * i + 1] * sc, o0[4 * i + 2] * sc, o0[4 * i + 3] * sc}; x1 += (f32x4){o1[4 * i] * sc, o1[4 * i + 1] * sc, o1[4 * i + 2] * sc, o1[4 * i + 3] * sc};
        *(f32x4*)(orow + 8 * i + 4 * hh) = x0; *(f32x4*)(orow + 32 + 8 * i + 4 * hh) = x1; }
#undef E2_LOAD
}
template <bool USE_MASK>
__device__ __forceinline__ void ph_attn_sel2(LAS unsigned char* lds3, KP p, float* __restrict__ obase, const float* __restrict__ csrc, int cpitch) {
    const int w = __builtin_amdgcn_readfirstlane(ftid() >> 6);
    LAS unsigned char* ldsw = lds3 + w * E2_WAVE;
    MK_LOOP(u, 512) { const int bg = u & 3, qblk = u >> 2; e2_wave_unit<USE_MASK>(ldsw, p, bg >> 1, bg & 1, qblk * 64 + 8 * w, obase, csrc, cpitch); }
}
}
namespace mk {
constexpr int E3_K = 0, E3_V = 512 * KROW, E3_BYTES = 2 * 512 * KROW;
__device__ __forceinline__ void e3_unit(LAS unsigned char* lds, KP p, int b, int g, int qb, float* __restrict__ ocmp, unsigned* __restrict__ selmask) {
    const int tid = ftid(), lane = tid & 63, w = __builtin_amdgcn_readfirstlane(tid >> 6), r32 = lane & 31, hh = lane >> 5;
    const int bg = b * 2 + g, q0 = qb * 256, qrow0 = q0 + 32 * w, tq = qrow0 + r32;
    const bf16_t* projb = WSP(bf16_t, O_PROJB);
    int nun = (q0 + 255 - 31) / 16 + 1; if (nun > 511) nun = 511;
    const int ntile_u = (nun + 63) >> 6;
    __syncthreads();
    { const int srow = tid >> 3, sch = tid & 7; const bf16_t* ks = WSP(bf16_t, O_KCMPB) + ((size_t)bg * 512 + srow) * 64 + sch * 8; const bf16_t* vs = WSP(bf16_t, O_VCMPB) + ((size_t)bg * 512 + srow) * 64 + sch * 8;
      for (int i = 0; i < ntile_u; ++i) { const u32x4 kv = *(const u32x4*)(ks + (size_t)i * 64 * 64), vv = *(const u32x4*)(vs + (size_t)i * 64 * 64);
          *(LAS u32x4*)(lds + E3_K + (srow + 64 * i) * KROW + sch * 16) = kv; *(LAS u32x4*)(lds + E3_V + (srow + 64 * i) * KROW + sch * 16) = vv; } }
    __syncthreads();
    int nw = qrow0 / 16 + 1; if (nw > 511) nw = 511;
    const int ntile_w = (qrow0 + 31 < 31) ? 0 : ((nw + 63) >> 6);
    const float tqf = (float)tq;
    const int gq = lane >> 4, li = lane & 15;
    const LAS unsigned char* trb = lds + E3_V + (4 * hh + (li >> 2)) * KROW + (16 * (gq & 1) + 4 * (li & 3)) * 2;
    const LAS unsigned char* kfb = lds + E3_K + r32 * KROW + hh * 16;
    float imp[64];
#pragma unroll
    for (int i = 0; i < 64; ++i) imp[i] = 0.f;
#pragma unroll 1
    for (int r4 = 0; r4 < 4; ++r4) {
        const int h = 4 * g + r4; const float sl2 = exp2f(-(float)(h + 1)) * LOG2E;
        bf16x8 qf[4];
        { const bf16_t* qptr = projb + (size_t)(b * S_ + tq) * PB + h * 64 + 8 * hh;
#pragma unroll
          for (int d0 = 0; d0 < 4; ++d0) qf[d0] = *(const bf16x8*)(qptr + 16 * d0); }
        f32x16 o0, o1;
#pragma unroll
        for (int r = 0; r < 16; ++r) { o0[r] = 0.f; o1[r] = 0.f; }
        float m = -1e30f, l = 0.f;
#define E3_ST(jt) f32x16 p0, p1; { _Pragma("unroll") for (int r = 0; r < 16; ++r) { p0[r] = 0.f; p1[r] = 0.f; } \
            _Pragma("unroll") for (int d0 = 0; d0 < 4; ++d0) { const bf16x8 a0 = *(const LAS bf16x8*)(kfb + (64 * (jt)) * KROW + d0 * 32), a1 = *(const LAS bf16x8*)(kfb + (64 * (jt) + 32) * KROW + d0 * 32); \
                p0 = __builtin_amdgcn_mfma_f32_32x32x16_bf16(a0, qf[d0], p0, 0, 0, 0); p1 = __builtin_amdgcn_mfma_f32_32x32x16_bf16(a1, qf[d0], p1, 0, 0, 0); } \
            int tq_ = tq; asm volatile("" : "+v"(tq_));     \
            int hh_ = hh; asm volatile("" : "+v"(hh_)); \
            const float tqf_ = (float)tq_; const int ce0_ = 16 * (64 * (jt) + 4 * hh_) + 31; \
            _Pragma("unroll") for (int reg = 0; reg < 16; ++reg) { const int ce = ce0_ + 16 * CROW(reg, 0); const float d0f = tqf_ - (float)ce, d1f = d0f - 512.f; \
                const float s0 = p0[reg] * (SCALE * LOG2E) - sl2 * d0f, s1 = p1[reg] * (SCALE * LOG2E) - sl2 * d1f; \
                p0[reg] = (ce <= tq_) ? s0 : -INFINITY; p1[reg] = (ce + 512 <= tq_) ? s1 : -INFINITY; } }
        for (int jt = 0; jt < ntile_w; ++jt) {
            E3_ST(jt);
            float rmx = fmaxf(p0[0], p1[0]);
#pragma unroll
            for (int reg = 1; reg < 16; ++reg) rmx = fmaxf(rmx, fmaxf(p0[reg], p1[reg]));
            rmx = fmaxf(rmx, __shfl_xor(rmx, 32));
            if (__any(rmx > m + RESC_THR)) { const float mn = fmaxf(m, rmx), al = __builtin_amdgcn_exp2f(m - mn); l *= al;
#pragma unroll
                for (int r = 0; r < 16; ++r) { o0[r] *= al; o1[r] *= al; }
                m = mn; }
            float ls = 0.f;
#pragma unroll
            for (int reg = 0; reg < 16; ++reg) { p0[reg] = __builtin_amdgcn_exp2f(p0[reg] - m); p1[reg] = __builtin_amdgcn_exp2f(p1[reg] - m); ls += p0[reg] + p1[reg]; }
            l += ls;
            const LAS unsigned char* tb = trb + (64 * jt) * KROW;
#pragma unroll
            for (int s = 0; s < 4; ++s) {
                u32x4 pw;
                if (s < 2) { pw.x = cvtpk(p0[8 * s + 0], p0[8 * s + 1]); pw.y = cvtpk(p0[8 * s + 2], p0[8 * s + 3]); pw.z = cvtpk(p0[8 * s + 4], p0[8 * s + 5]); pw.w = cvtpk(p0[8 * s + 6], p0[8 * s + 7]); }
                else { const int s2 = s - 2; pw.x = cvtpk(p1[8 * s2 + 0], p1[8 * s2 + 1]); pw.y = cvtpk(p1[8 * s2 + 2], p1[8 * s2 + 3]); pw.z = cvtpk(p1[8 * s2 + 4], p1[8 * s2 + 5]); pw.w = cvtpk(p1[8 * s2 + 6], p1[8 * s2 + 7]); }
                const bf16x8 pb = __builtin_bit_cast(bf16x8, pw);
                const v4i16_t a0l = __builtin_amdgcn_ds_read_tr16_b64_v4i16((LAS v4i16_t*)(tb + (16 * s) * KROW)), a0h = __builtin_amdgcn_ds_read_tr16_b64_v4i16((LAS v4i16_t*)(tb + (16 * s + 8) * KROW));
                const v4i16_t a1l = __builtin_amdgcn_ds_read_tr16_b64_v4i16((LAS v4i16_t*)(tb + (16 * s) * KROW + 64)), a1h = __builtin_amdgcn_ds_read_tr16_b64_v4i16((LAS v4i16_t*)(tb + (16 * s + 8) * KROW + 64));
                const bf16x8 va0 = (bf16x8){a0l[0], a0l[1], a0l[2], a0l[3], a0h[0], a0h[1], a0h[2], a0h[3]}, va1 = (bf16x8){a1l[0], a1l[1], a1l[2], a1l[3], a1h[0], a1h[1], a1h[2], a1h[3]};
                o0 = __builtin_amdgcn_mfma_f32_32x32x16_bf16(va0, pb, o0, 0, 0, 0); o1 = __builtin_amdgcn_mfma_f32_32x32x16_bf16(va1, pb, o1, 0, 0, 0); }
        }
        l += __shfl_xor(l, 32);
        const float inv = (l > 0.f) ? 1.f / l : 0.f;
        { const float sc = inv * WSP(float, O_GF)[(size_t)(b * S_ + tq) * 32 + 0 * 8 + h];
          float* orow = ocmp + (size_t)(b * S_ + tq) * 512 + h * 64;
#pragma unroll
          for (int i = 0; i < 4; ++i) {
              *(f32x4*)(orow + 8 * i + 4 * hh) = (f32x4){o0[4 * i] * sc, o0[4 * i + 1] * sc, o0[4 * i + 2] * sc, o0[4 * i + 3] * sc};
              *(f32x4*)(orow + 32 + 8 * i + 4 * hh) = (f32x4){o1[4 * i] * sc, o1[4 * i + 1] * sc, o1[4 * i + 2] * sc, o1[4 * i + 3] * sc}; } }
#pragma unroll
        for (int jt = 0; jt < 8; ++jt) {
            if (jt < ntile_w) {
                E3_ST(jt);
#pragma unroll
                for (int reg = 0; reg < 16; ++reg) { p0[reg] = __builtin_amdgcn_exp2f(p0[reg] - m) * inv; p1[reg] = __builtin_amdgcn_exp2f(p1[reg] - m) * inv; }
#pragma unroll
                for (int pa = 0; pa < 2; ++pa)
#pragma unroll
                    for (int i = 0; i < 4; ++i) { const int jj = 8 * jt + 4 * pa + i;
                        const float x0 = pa ? p1[4 * i] : p0[4 * i], x1 = pa ? p1[4 * i + 1] : p0[4 * i + 1], x2 = pa ? p1[4 * i + 2] : p0[4 * i + 2], x3 = pa ? p1[4 * i + 3] : p0[4 * i + 3];
                        const float c = 0.5f * x3, a = (x0 + x1) + (x2 + c), r = __shfl_xor(c, 32);
                        imp[jj] += a + (hh ? r : 0.f);
                        if (jj + 1 < 64) imp[jj + 1] += (hh ? 0.f : r); }
            }
        }
#undef E3_ST
    }
    const int cur = tq >> 6;
#pragma unroll
    for (int jj = 0; jj < 64; ++jj) { const int j = 2 * jj + hh; imp[jj] = (j != 0 && j < cur - 1) ? imp[jj] : -1.f; }
    unsigned m0 = 1u, m1 = 0u, m2 = 0u, m3 = 0u;
#define E3_SETBIT(j) do { const unsigned bit_ = 1u << ((j) & 31); const int wd_ = (j) >> 5; m0 |= (wd_ == 0) ? bit_ : 0u; m1 |= (wd_ == 1) ? bit_ : 0u; m2 |= (wd_ == 2) ? bit_ : 0u; m3 |= (wd_ == 3) ? bit_ : 0u; } while (0)
    E3_SETBIT(cur); if (cur >= 1) E3_SETBIT(cur - 1);
#pragma unroll 1
    for (int it = 0; it < NSEL - 3; ++it) {
        float best = -0.5f; int bj = 0;
#pragma unroll
        for (int jj = 0; jj < 64; ++jj) { if (imp[jj] > best) { best = imp[jj]; bj = jj; } }
        const int myj = 2 * bj + hh; const float ob = __shfl_xor(best, 32); const int oj = __shfl_xor(myj, 32);
        const bool mine = (best > ob) || (best == ob && myj < oj);
        const float wv = mine ? best : ob; const int wj = mine ? myj : oj;
        if (wv >= 0.f) E3_SETBIT(wj);
        if (mine && best >= 0.f) {
#pragma unroll
            for (int jj = 0; jj < 64; ++jj) imp[jj] = (jj == bj) ? -2.f : imp[jj]; }
    }
#undef E3_SETBIT
    if (hh == 0) *(u32x4*)(selmask + ((size_t)bg * S_ + tq) * 4) = (u32x4){m0, m1, m2, m3};
}
}
namespace mk {
template <int CMPMODE>
__device__ __forceinline__ void ph_attn1(float* lds, LAS unsigned char* lds3, KP p, unsigned* qctr, float* obase, float* owin, const unsigned* kmax2) {
    LAS int* qslot = (LAS int*)(lds3 + E3_BYTES);
    constexpr int N_E3 = (CMPMODE & 2) ? 128 : 0, N_CMP = (CMPMODE & 1) ? 64 : 0, N_FOX = 256, N_WIN = 512, N_SB = 256;
    for (;;) {
        __syncthreads();
        if (ftid() == 0) *qslot = (int)atomicAdd(qctr, 1u);
        __syncthreads();
        int u = __builtin_amdgcn_readfirstlane(*qslot);
        if (u >= N_E3 + N_CMP + N_FOX + N_WIN + N_SB) break;
        if (u < N_E3) { e3_unit(lds3, p, (u & 3) >> 1, u & 1, 31 - (u >> 2), WSP(float, O_OCMP), WSP(unsigned, O_SELMASK)); continue; } u -= N_E3;
        if (u < N_CMP) { attn_vblock<3>(lds, p, 15 - (u >> 2), u & 3); continue; } u -= N_CMP;
        if (u < N_FOX) { e1_unit<0>(lds3, p, (u & 7) >> 2, u & 3, 31 - (u >> 3), obase, owin, kmax2); continue; } u -= N_FOX;
        if (u < N_WIN) { e1_unit<1>(lds3, p, (u & 3) >> 1, u & 1, 127 - (u >> 2), obase, owin, kmax2); continue; } u -= N_WIN;
        e1_unit<2>(lds3, p, (u & 7) >> 2, u & 3, 31 - (u >> 3), obase, owin, kmax2);
    }
}
__device__ __forceinline__ void ph_dbg_compare_cmp(KP p) {
    float num = 0.f, den = 0.f;
    for (size_t i = (size_t)fbid() * NT + ftid(); i < (size_t)T_ * 512; i += (size_t)gridDim.x * NT) { const size_t row = i >> 9; const int c = (int)(i & 511);
        const float a = WSP(float, O_OCMP)[i], b = WSP(float, O_O)[row * D_ + c]; num += (a - b) * (a - b); den += b * b; }
    float* dbg = WSP(float, O_COUNTS) + 256; const float n = wsum(num), d = wsum(den);
    if ((ftid() & 63) == 0) { atomicAdd(&dbg[8], n); atomicAdd(&dbg[9], d); }
}
__device__ __forceinline__ void ph_dbg_compare_sel(KP p) {
    float num = 0.f, den = 0.f;
    for (int i = fbid() * NT + ftid(); i < B_ * 2 * S_; i += gridDim.x * NT) {
        unsigned m[4] = {0u, 0u, 0u, 0u}; const int t = i % S_, cur = t >> 6;
        for (int k = 0; k < NSEL; ++k) { const int e = WSP(int, O_SEL)[(size_t)i * NSEL + k]; if (e <= cur) { if ((e >> 5) == 0) m[0] |= 1u << (e & 31); else if ((e >> 5) == 1) m[1] |= 1u << (e & 31); else if ((e >> 5) == 2) m[2] |= 1u << (e & 31); else m[3] |= 1u << (e & 31); } }
        const unsigned* sm = WSP(unsigned, O_SELMASK) + (size_t)i * 4;
        int diff = __popc(m[0] ^ sm[0]) + __popc(m[1] ^ sm[1]) + __popc(m[2] ^ sm[2]) + __popc(m[3] ^ sm[3]);
        num += (float)diff * 0.5f; den += 16.f; }
    float* dbg = WSP(float, O_COUNTS) + 256; const float n = wsum(num), d = wsum(den);
    if ((ftid() & 63) == 0) { atomicAdd(&dbg[10], n); atomicAdd(&dbg[11], d); }
}
__device__ __forceinline__ void ph_dbg_compare(KP p) {
    float num[3] = {0.f, 0.f, 0.f}, den[3] = {0.f, 0.f, 0.f};
    for (size_t i = (size_t)fbid() * NT + ftid(); i < (size_t)T_ * 512; i += (size_t)gridDim.x * NT) {
        const size_t row = i >> 9; const int c = (int)(i & 511);
        const float a = WSP(float, O_O2)[row * D_ + 512 + c], b = WSP(float, O_O)[row * D_ + 512 + c];
        const int k = c >> 8; num[k] += (a - b) * (a - b); den[k] += b * b;
        const float aw = WSP(float, O_OWIN2)[i], bw = WSP(float, O_OWIN)[i]; num[2] += (aw - bw) * (aw - bw); den[2] += bw * bw; }
    float* dbg = WSP(float, O_COUNTS) + 256;
#pragma unroll
    for (int k = 0; k < 3; ++k) { const float n = wsum(num[k]), d = wsum(den[k]); if ((ftid() & 63) == 0) { atomicAdd(&dbg[2 * k], n); atomicAdd(&dbg[2 * k + 1], d); } }
}
__device__ __forceinline__ void ph_dbg_copy_nsa(KP p) {
    for (size_t i = (size_t)fbid() * NT + ftid(); i < (size_t)T_ * 512; i += (size_t)gridDim.x * NT) { const size_t row = i >> 9; const int c = (int)(i & 511); WSP(float, O_O2)[row * D_ + c] = WSP(float, O_O)[row * D_ + c]; }
}
__device__ __forceinline__ void ph_dbg_compare_nsa(KP p) {
    float num = 0.f, den = 0.f;
    for (size_t i = (size_t)fbid() * NT + ftid(); i < (size_t)T_ * 512; i += (size_t)gridDim.x * NT) { const size_t row = i >> 9; const int c = (int)(i & 511);
        const float a = WSP(float, O_O2)[row * D_ + c], b = WSP(float, O_O)[row * D_ + c]; num += (a - b) * (a - b); den += b * b; }
    float* dbg = WSP(float, O_COUNTS) + 256; const float n = wsum(num), d = wsum(den);
    if ((ftid() & 63) == 0) { atomicAdd(&dbg[6], n); atomicAdd(&dbg[7], d); }
}
__device__ __forceinline__ void ph_dbg_encode(KP p, int ka, int kb) {
    const float* dbg = WSP(float, O_COUNTS) + 256;
    const float ea = sqrtf(dbg[2 * ka] / fmaxf(dbg[2 * ka + 1], 1e-30f)), eb = sqrtf(dbg[2 * kb] / fmaxf(dbg[2 * kb + 1], 1e-30f));
    for (size_t i = (size_t)fbid() * NT + ftid(); i < (size_t)T_ * D_; i += (size_t)gridDim.x * NT) { float v = p->out[i] * (1.f + 10.f * ea); if (i == 0) v += 1e4f * eb; p->out[i] = v; }
}
}
namespace mk {
#define RLX_AGENT __ATOMIC_RELAXED, __HIP_MEMORY_SCOPE_AGENT
#define XB_TMO      128
#define XB_XCNT(j)  (256  + 64 * (j))
#define XB_XSUB(j)  (1280 + 64 * (j))
#define XB_XGEN(j)  (2304 + 64 * (j))
#define XB_TOP      3328
#define XB_TOPGEN   3392
#define XCD_BAR_WORDS 3456
#define XB_SPIN_CAP (1u << 18)

__device__ __forceinline__ unsigned xb_ld(unsigned* p)              { return __hip_atomic_load(p, __ATOMIC_RELAXED, __HIP_MEMORY_SCOPE_AGENT); }
__device__ __forceinline__ unsigned xb_add(unsigned* p, unsigned v) { return __hip_atomic_fetch_add(p, v, __ATOMIC_RELAXED, __HIP_MEMORY_SCOPE_AGENT); }
__device__ __forceinline__ unsigned xb_xcc_id() { return (unsigned)__builtin_amdgcn_s_getreg((3 << 11) | 20) & 0xFu; }
#define XB_SPIN(cond, bar) do { unsigned _sp = 0; while (cond) { __builtin_amdgcn_s_sleep(1); \
    if ((++_sp & 255u) == 0u) { if (xb_ld(&(bar)[XB_TMO])) break; if (_sp > XB_SPIN_CAP) { atomicAdd(&(bar)[XB_TMO], 1u); break; } } } } while (0)

struct XcdBarrier {
    unsigned* bar; unsigned x;
    volatile LAS unsigned* st;
};

__device__ __forceinline__ XcdBarrier xcd_barrier_post(unsigned* bar, volatile LAS unsigned* st) {
    XcdBarrier b; b.bar = bar; b.x = xb_xcc_id(); b.st = st;
    if (threadIdx.x == 0) (void)xb_add(&bar[XB_XCNT(b.x)], 1u);
    return b;
}
__device__ __forceinline__ void xcd_barrier_complete(unsigned* bar, unsigned x, unsigned& nloc, unsigned& nx) {
    const unsigned G = gridDim.x * gridDim.y * gridDim.z;
    unsigned sum, cnt, mine, sp = 0u;
    for (;;) {
        sum = 0u; cnt = 0u; mine = 0u;
#pragma unroll
        for (unsigned j = 0; j < 16; ++j) { const unsigned c = xb_ld(&bar[XB_XCNT(j)]); sum += c; cnt += (c > 0u) ? 1u : 0u; mine = (j == x) ? c : mine; }
        if (sum == G) break;
        __builtin_amdgcn_s_sleep(1);
        if ((++sp & 255u) == 0u) { if (xb_ld(&bar[XB_TMO])) break; if (sp > XB_SPIN_CAP) { atomicAdd(&bar[XB_TMO], 1u); break; } }
    }
    nloc = mine > 0u ? mine : 1u; nx = cnt > 0u ? cnt : 1u;
}

__device__ __forceinline__ void xcd_barrier(const XcdBarrier& b) {
    asm volatile("s_waitcnt vmcnt(0)" ::: "memory");
    __syncthreads();
    if (threadIdx.x == 0) {
        unsigned* bar = b.bar;
        __builtin_amdgcn_s_waitcnt(0);
        unsigned nloc = b.st[0], nx = b.st[1];
        if (nloc == 0u) { xcd_barrier_complete(bar, b.x, nloc, nx); b.st[0] = nloc; b.st[1] = nx; }
        const unsigned old = xb_add(&bar[XB_XSUB(b.x)], 1u);
        const unsigned gen = old / nloc;
        if (old + 1u == (gen + 1u) * nloc) {
            __builtin_amdgcn_fence(__ATOMIC_RELEASE, "agent");
            asm volatile("s_waitcnt vmcnt(0)" ::: "memory");
            const unsigned og = xb_add(&bar[XB_TOP], 1u);
            const unsigned tg = og / nx;
            if (og + 1u == (tg + 1u) * nx) xb_add(&bar[XB_TOPGEN], 1u);
            else XB_SPIN(xb_ld(&bar[XB_TOPGEN]) == tg, bar);
            __builtin_amdgcn_fence(__ATOMIC_ACQUIRE, "agent");
            xb_add(&bar[XB_XGEN(b.x)], 1u);
            asm volatile("s_waitcnt vmcnt(0)" ::: "memory");
        } else {
            XB_SPIN(xb_ld(&bar[XB_XGEN(b.x)]) == gen, bar);
            __builtin_amdgcn_fence(__ATOMIC_ACQUIRE, "agent");
            asm volatile("s_waitcnt vmcnt(0)" ::: "memory");
        }
    }
    __syncthreads();
}

}
namespace cg = cooperative_groups;
constexpr int NSTEP = 12;
__global__ void __launch_bounds__(512, 2) mega(mk::P p_unused) {
    extern __shared__ __attribute__((aligned(16))) unsigned char lds_raw[];
    float* lds = (float*)lds_raw;
    LAS unsigned char* lds3 = (LAS unsigned char*)lds_raw;
    cg::grid_group grid = cg::this_grid();
    using namespace nv; using namespace mk;
    volatile LAS unsigned* bst = (volatile LAS unsigned*)(lds3 + E3_BYTES + 128);
    if (threadIdx.x < 2) bst[threadIdx.x] = 0u;
    __syncthreads();
    XcdBarrier bar;
    { const KP p = fresh_kp(); bar = xcd_barrier_post(WSP(unsigned, O_COUNTS + 16384), bst); }
    grid.sync();
    for (int step = 0; step < 1 + NSTEP * L_; ++step) {
        const KP p = fresh_kp();
        const int l = (step - 1) / NSTEP, k = (step == 0) ? -1 : (step - 1) % NSTEP;
        const bool isg = (k == 0 || k == 1 || k == 6 || k == 9 || k == 10);
#ifdef PROBE_K
        const int nrep = (k == PROBE_K) ? PROBE_N : 1;
#else
        const int nrep = 1;
#endif
        for (int rep = 0; rep < nrep; ++rep) {
        if (isg) {
            const int kind = (k == 0) ? 0 : (k == 1) ? 4 : (k == 6) ? 1 : (k == 9) ? 2 : 3;
            GSched S; GEpi E; S.kind = kind; E.kind = kind; E.l = l;
            S.G = (int)gridDim.x; S.c = fbid(); S.meta = WSP(int, O_META); S.rowtok = WSP(int, O_ROWTOK); S.estep = 0;
            const char* A; int N, K = D_;
            if (kind == 0) { A = (const char*)WSP(bf16_t, O_XB); S.Bt = (const char*)(WSP(bf16_t, O_WTIN) + (size_t)l * NPAD * D_); N = NPAD; }
            else if (kind == 1) { A = (const char*)WSP(bf16_t, O_OB); S.Bt = (const char*)(WSP(bf16_t, O_WTOUT) + (size_t)l * D_ * D_); N = D_; }
            else if (kind == 2) { A = (const char*)WSP(bf16_t, O_X1B); S.Bt = (const char*)(WSP(bf16_t, O_WTGU) + (size_t)l * NE * 2048 * D_); S.estep = (size_t)2048 * D_ * 2; N = 2048; }
            else if (kind == 3) { A = (const char*)WSP(bf16_t, O_ACT); S.Bt = (const char*)(WSP(bf16_t, O_WTDN) + (size_t)l * NE * D_ * D_); S.estep = (size_t)D_ * D_ * 2; N = D_; }
            else { A = (const char*)WSP(bf16_t, O_PROJB); S.Bt = (const char*)(WSP(bf16_t, O_WT1) + (size_t)l * 2 * 256 * 2048); S.estep = (size_t)256 * 2048 * 2; N = 256; K = 2048; }
            S.nN = N / 256; S.nM = (kind < 2) ? T_ / 256 : (kind == 4) ? 16 : S.meta[32]; S.nunits = S.nM * S.nN;
            pg8::gemm_phase<GEpi, GSched>(lds3, A, K, S, E);
            if (kind == 4) ph_cumsum(lds, p, 16);
            if (kind == 0) ph_bias1_reduce(p, l);
        } else {
            switch (k) {
                case -1: ph_convert(lds3, p); break;
                case 2: ph_prep2(p, l); break;
                case 3: ph_attn1<2>(lds, lds3, p, WSP(unsigned, O_COUNTS) + 128 + l * 8 + rep, WSP(float, O_O), WSP(float, O_OWIN), WSP(unsigned, O_COUNTS) + 192 + l * 8); break;
                case 4: ph_attn_sel2<true>(lds3, p, WSP(float, O_O), WSP(float, O_OCMP), 512); break;
                case 5: ph_rmsnorm(p, l); break;
                case 7: ph_ln<true>(lds, p, l, WSP(float, O_X1), (rep + 1 < nrep) ? 2048 * (rep + 1) : 0); break;
                case 8: ph_moe_scatter2(lds, p, l); break;
                default: { float* xout = (l == L_ - 1) ? p->out : WSP(float, O_XA); ph_ln<false>(lds, p, l, xout); } break;
            }
        }
        xcd_barrier(bar);
        }
    }
#ifdef PROBE_SYNC
    for (int i = 0; i < PROBE_SYNC; ++i) xcd_barrier(bar);
#endif
}

extern "C" void kernel_launch(void* const* d_in, const int* in_sizes, int n_in,
                              void* d_out, int out_size, void* d_ws, size_t ws_size,
                              hipStream_t stream) {
    constexpr size_t kDynLds = 147456 + 1024;
    static int grid_blocks = 0;
    if (!grid_blocks) {
        int dev = 0, cus = 0, per_cu = 0;
        (void)hipGetDevice(&dev);
        (void)hipDeviceGetAttribute(&cus, hipDeviceAttributeMultiprocessorCount, dev);
        (void)hipFuncSetAttribute((const void*)mega, hipFuncAttributeMaxDynamicSharedMemorySize, (int)kDynLds);
        (void)hipOccupancyMaxActiveBlocksPerMultiprocessor(&per_cu, mega, 512, kDynLds);
        if (per_cu < 1) per_cu = 1;
        if (per_cu > 1) per_cu = 1;
        grid_blocks = cus * per_cu;
        if (ws_size < mk::O_END) fprintf(stderr, "workspace too small: %zu < %zu\n", ws_size, (size_t)mk::O_END);
    }
    mk::P p{};
    p.in = nv::inputs(d_in); p.ws = (unsigned char*)d_ws; p.out = (float*)d_out;
    (void)hipMemsetAsync((char*)d_ws + mk::O_COUNTS, 0, 65536, stream);
    void* args[] = {&p};
    hipError_t e = hipLaunchCooperativeKernel((void*)mega, dim3(grid_blocks), dim3(512), args, kDynLds, stream);
    if (e != hipSuccess) fprintf(stderr, "cooperative launch failed: %s (grid %d)\n", hipGetErrorString(e), grid_blocks);
}
```

```cpp
#include <hip/hip_runtime.h>
#include <hip/hip_cooperative_groups.h>
#include <cstdio>
#include <cstdint>

namespace nv {

constexpr int B_ = 2, S_ = 8192, D_ = 1024, T_ = B_ * S_, L_ = 2;
constexpr int DIN = 2844;
constexpr int OFF_NSA_KV = 512, OFF_NSA_GATE = 1280, OFF_FOX_QKV = 1304, OFF_FOX_F = 2072, OFF_SB_QKV = 2076;
constexpr int NCMP = 511, NBLK = 128, NSEL = 16;
constexpr int NE = 32, TOPK = 4, MROWS = T_ * TOPK;
constexpr float LN_EPS = 1e-5f, RMS_EPS = 1e-6f;
constexpr float ALPHA = 1.4142135623730951f;
constexpr float SCALE = 0.125f;

__device__ __forceinline__ float sigmoidf_(float x) { return 1.f / (1.f + __expf(-x)); }
__device__ __forceinline__ float logsig(float x) { return fminf(x, 0.f) - log1pf(expf(-fabsf(x))); }

__device__ __forceinline__ float gelu_tanh(float x) { return 0.5f * x * (1.f + tanhf(0.7978845608028654f * (x + 0.044715f * x * x * x))); }
#define NV_DOT(q, kr, res) do { float s0_ = 0.f, s1_ = 0.f, s2_ = 0.f, s3_ = 0.f; _Pragma("unroll") for (int d_ = 0; d_ < 64; d_ += 4) { const float4 k4_ = *(const float4*)&(kr)[d_]; s0_ += q[d_] * k4_.x; s1_ += q[d_ + 1] * k4_.y; s2_ += q[d_ + 2] * k4_.z; s3_ += q[d_ + 3] * k4_.w; } res = (s0_ + s1_) + (s2_ + s3_); } while (0)
#define NV_AXPY(o, p, vr) do { _Pragma("unroll") for (int d_ = 0; d_ < 64; d_ += 4) { const float4 v4_ = *(const float4*)&(vr)[d_]; o[d_] += p * v4_.x; o[d_ + 1] += p * v4_.y; o[d_ + 2] += p * v4_.z; o[d_ + 3] += p * v4_.w; } } while (0)
#define NV_ONLINE(sc, vr) do { if (sc > m) { const float al_ = __expf(m - sc); l *= al_; _Pragma("unroll") for (int d_ = 0; d_ < 64; ++d_) o[d_] *= al_; m = sc; } const float p_ = __expf(sc - m); l += p_; NV_AXPY(o, p_, vr); } while (0)

__device__ __forceinline__ float wsum(float v) {
#pragma unroll
    for (int o = 1; o < 64; o <<= 1) v += __shfl_xor(v, o);
    return v;
}
struct In {
    const float *x, *w_in, *b_in, *pos_k, *pos_v, *w1k, *w2k, *w1v, *w2v, *g_out, *w_out, *ln1_g, *ln1_b, *rw, *rb, *wgu, *bgu, *wdn, *bdn, *ln2_g, *ln2_b;
};
inline In inputs(void* const* d) {
    In i; i.x = (const float*)d[0]; i.w_in = (const float*)d[1]; i.b_in = (const float*)d[2]; i.pos_k = (const float*)d[3]; i.pos_v = (const float*)d[4];
    i.w1k = (const float*)d[5]; i.w2k = (const float*)d[6]; i.w1v = (const float*)d[7]; i.w2v = (const float*)d[8]; i.g_out = (const float*)d[9]; i.w_out = (const float*)d[10];
    i.ln1_g = (const float*)d[11]; i.ln1_b = (const float*)d[12]; i.rw = (const float*)d[13]; i.rb = (const float*)d[14]; i.wgu = (const float*)d[15]; i.bgu = (const float*)d[16];
    i.wdn = (const float*)d[17]; i.bdn = (const float*)d[18]; i.ln2_g = (const float*)d[19]; i.ln2_b = (const float*)d[20]; return i;
}


}
namespace pg8 {
#define PG8_LAS __attribute__((address_space(3)))
typedef unsigned short bf16_t;
typedef short bf16x8 __attribute__((ext_vector_type(8)));
typedef float f32x4 __attribute__((ext_vector_type(4)));
typedef unsigned u32x4 __attribute__((ext_vector_type(4)));
constexpr int BM = 256, BK = 64, HALF = 128, HTB = HALF * BK * 2  , STAGE_BYTES = 8 * HTB, NXCD = 8, WGM = 8;

__host__ __device__ __forceinline__ int lds_byte(int r, int c) { const int st = (r >> 4) * 2 + (c >> 5), rr = r & 15, cc = c & 31, ob = rr * 64 + cc * 2; return st * 1024 + (ob ^ (((ob >> 9) & 1) << 5)); }
__host__ __device__ __forceinline__ void stage_rc(int b, int& R, int& C) { const int st = b / 1024, sb = b % 1024, swz = sb ^ (((sb >> 9) & 1) << 5); R = (st >> 1) * 16 + swz / 64; C = (st & 1) * 32 + (swz % 64) / 2; }
__host__ __device__ __forceinline__ int perm32(int rho) { const int n = rho >> 4, i = rho & 15; return 8 * (i >> 2) + 4 * n + (i & 3); }

struct Unit { int pm, pn, e, nr; };

struct StaticOrder {
    int nM, nN, nwg, G, c;
    __host__ __device__ void init(int M, int N, int G_, int c_) { nM = M / BM; nN = N / BM; nwg = nM * nN; G = G_; c = c_; }
    __host__ __device__ bool next(int i, Unit& u) const {
        const long L = (long)i * G + c; if (L >= nwg) return false;
        int wgid = (int)L; { const int q = nwg / NXCD, r = nwg % NXCD, xcd = wgid % NXCD, off = wgid / NXCD; wgid = (xcd < r ? xcd * (q + 1) : r * (q + 1) + (xcd - r) * q) + off; }
        const int nig = WGM * nN, gid = wgid / nig, fm = gid * WGM, gsz = (nM - fm) < WGM ? (nM - fm) : WGM;
        u.pm = fm + ((wgid % nig) % gsz); u.pn = (wgid % nig) / gsz; u.e = 0; u.nr = BM; return true;
    }
    const char* Bt; size_t tstep;
    __device__ __forceinline__ unsigned a_off(const Unit& u, int r) const { return (unsigned)(u.pm * BM + r) * 2048u; }
    __device__ __forceinline__ size_t a_kstep() const { return 128; }
    __device__ __forceinline__ const char* b_base(const Unit& u) const { return Bt + (size_t)u.pn * tstep; }
};


__device__ __forceinline__ unsigned cvt_pk_bf16(float lo, float hi) { unsigned r; asm volatile("v_cvt_pk_bf16_f32 %0, %1, %2" : "=v"(r) : "v"(lo), "v"(hi)); return r; }
template <class Epi, class Sched, bool ALIGN_EPI = true, bool SP2 = true>
__device__ __forceinline__ void gemm_phase(PG8_LAS unsigned char* lds, const char* Abase, const int K, const Sched& S, const Epi& E) {
    int tid_ = threadIdx.x; asm volatile("" : "+v"(tid_));
    const int tid = tid_, wid = __builtin_amdgcn_readfirstlane(tid >> 6), lane = tid & 63, wr = wid >> 2, wc = wid & 3, fr = lane & 15, fq = lane >> 4;
    const int nt = K / BK;
    unsigned voffB[2];
#pragma unroll
    for (int i = 0; i < 2; ++i) { int R, C; stage_rc(tid * 16 + i * 8192, R, C); const int Rb = Epi::PERM ? ((R & ~31) + perm32(R & 31)) : R;
        voffB[i] = (unsigned)(Rb * K + C) * 2u; }
#define PG8_AOFF(u, o0, o1) do { int _t = tid; asm volatile("" : "+v"(_t)); _Pragma("unroll") for (int _i = 0; _i < 2; ++_i) { int _R, _C; stage_rc(_t * 16 + _i * 8192, _R, _C); \
        (o0)[_i] = S.a_off((u), _R) + (unsigned)_C * 2u; (o1)[_i] = S.a_off((u), HALF + _R) + (unsigned)_C * 2u; } } while (0)
    const size_t kstep = (size_t)(BK * 2);
    const size_t akstep = S.a_kstep();
    const size_t hstep = (size_t)HALF * K * 2;
    const unsigned ldsw = (unsigned)wid * 1024u;
    const int aoff = lds_byte(wr * 64 + fr, fq * 8), boff = lds_byte(wc * 32 + fr, fq * 8);
#define PG8_SA(b, h) (((b) * 2 + (h)) * HTB)
#define PG8_SB(b, h) ((4 + (b) * 2 + (h)) * HTB)
#define PG8_STAGE(bufoff, gbase, voff) do { _Pragma("unroll") for (int _i = 0; _i < 2; ++_i) { unsigned _o = (voff)[_i]; asm volatile("" : "+v"(_o));     \
        __builtin_amdgcn_global_load_lds((const unsigned*)((const char*)(gbase) + _o), (PG8_LAS unsigned*)(lds + (bufoff) + ldsw + _i * 8192), 16, 0, 0); } } while (0)
#define PG8_LDA(dst, b, h) do { _Pragma("unroll") for (int m = 0; m < 4; ++m) _Pragma("unroll") for (int k = 0; k < 2; ++k) dst[m][k] = *(const PG8_LAS bf16x8*)(lds + PG8_SA(b, h) + aoff + m * 2048 + k * 1024); } while (0)
#define PG8_LDB(dst, b, h) do { _Pragma("unroll") for (int n = 0; n < 2; ++n) _Pragma("unroll") for (int k = 0; k < 2; ++k) dst[n][k] = *(const PG8_LAS bf16x8*)(lds + PG8_SB(b, h) + boff + n * 2048 + k * 1024); } while (0)
#define PG8_MMA(ai, bj, At, Bt) do { __builtin_amdgcn_s_setprio(1); _Pragma("unroll") for (int m = 0; m < 4; ++m) _Pragma("unroll") for (int n = 0; n < 2; ++n) _Pragma("unroll") for (int k = 0; k < 2; ++k) \
        acc[ai][bj][m][n] = __builtin_amdgcn_mfma_f32_16x16x32_bf16(Bt[n][k], At[m][k], acc[ai][bj][m][n], 0, 0, 0); __builtin_amdgcn_s_setprio(0); } while (0)
#define PG8_WAIT_V(n) asm volatile("s_waitcnt vmcnt(" #n ")" ::: "memory")
#define PG8_WAIT_L(n) asm volatile("s_waitcnt lgkmcnt(" #n ")" ::: "memory")
#define PG8_BAR __builtin_amdgcn_s_barrier()
#define PG8_SCHED __builtin_amdgcn_sched_barrier(0)
    Unit cur, nxt; int ui = 0;
    if (!S.next(0, cur)) return;
    f32x4 acc[2][2][4][2];
    float zf_ = 0.f; asm volatile("" : "+v"(zf_));
#pragma unroll
    for (int a = 0; a < 2; ++a)
#pragma unroll
        for (int b = 0; b < 2; ++b)
#pragma unroll
            for (int m = 0; m < 4; ++m)
#pragma unroll
                for (int n = 0; n < 2; ++n) acc[a][b][m][n] = (f32x4){zf_, zf_, zf_, zf_};
    bf16x8 At[4][2], B0[2][2], B1[2][2];
    unsigned ca0[2], ca1[2], na0[2], na1[2];
    PG8_AOFF(cur, ca0, ca1);
    const char* const cA = Abase; const char* cB = S.b_base(cur);
    if constexpr (SP2) {
        PG8_STAGE(PG8_SB(0, 0), cB, voffB); PG8_STAGE(PG8_SB(0, 1), cB + hstep, voffB); PG8_STAGE(PG8_SA(0, 0), cA, ca0); PG8_STAGE(PG8_SA(0, 1), cA, ca1);
        if (wr == 1) PG8_BAR;
        PG8_WAIT_V(2); PG8_BAR;
        PG8_STAGE(PG8_SB(1, 0), cB + kstep, voffB); PG8_STAGE(PG8_SA(1, 0), cA + akstep, ca0); PG8_STAGE(PG8_SB(1, 1), cB + hstep + kstep, voffB);
        PG8_WAIT_V(6); PG8_BAR;
    } else { static_assert(SP2, "only the SP2 loop is kept"); }
    for (;;) {
        const bool has_next = S.next(ui + 1, nxt);
        const char* nB = has_next ? S.b_base(nxt) : cB;
        if (has_next) { PG8_AOFF(nxt, na0, na1); } else { na0[0] = ca0[0]; na0[1] = ca0[1]; na1[0] = ca1[0]; na1[1] = ca1[1]; }
        for (int t = 0; t < nt - 2; t += 2) {
            const char* a1 = cA + (size_t)(t + 1) * akstep;
            const char* a2 = cA + (size_t)(t + 2) * akstep; const char* b2 = cB + (size_t)(t + 2) * kstep;
            const char* a3 = a2 + akstep; const char* b3 = b2 + kstep;
            PG8_LDB(B0, 0, 0); PG8_LDB(B1, 0, 1); PG8_SCHED; PG8_LDA(At, 0, 0); PG8_STAGE(PG8_SA(1, 1), a1, ca1);
            PG8_WAIT_V(8); PG8_WAIT_L(0); PG8_BAR; PG8_MMA(0, 0, At, B0); PG8_MMA(0, 1, At, B1); PG8_BAR; PG8_SCHED;
            PG8_LDA(At, 0, 1); PG8_STAGE(PG8_SB(0, 0), b2, voffB); PG8_STAGE(PG8_SB(0, 1), b2 + hstep, voffB); PG8_STAGE(PG8_SA(0, 0), a2, ca0);
            PG8_WAIT_V(8); PG8_WAIT_L(0); PG8_BAR; PG8_MMA(1, 0, At, B0); PG8_MMA(1, 1, At, B1); PG8_BAR; PG8_SCHED;
            PG8_LDB(B0, 1, 0); PG8_LDB(B1, 1, 1); PG8_SCHED; PG8_LDA(At, 1, 0); PG8_STAGE(PG8_SA(0, 1), a2, ca1);
            PG8_WAIT_V(8); PG8_WAIT_L(0); PG8_BAR; PG8_MMA(0, 0, At, B0); PG8_MMA(0, 1, At, B1); PG8_BAR; PG8_SCHED;
            PG8_LDA(At, 1, 1); PG8_STAGE(PG8_SB(1, 0), b3, voffB); PG8_STAGE(PG8_SB(1, 1), b3 + hstep, voffB); PG8_STAGE(PG8_SA(1, 0), a3, ca0);
            PG8_WAIT_V(8); PG8_WAIT_L(0); PG8_BAR; PG8_MMA(1, 0, At, B0); PG8_MMA(1, 1, At, B1); PG8_BAR; PG8_SCHED;
        }
        {
            const char* a1 = cA + (size_t)(nt - 1) * akstep;
            const char* a2 = cA; const char* b2 = nB; const char* a3 = a2 + akstep; const char* b3 = b2 + kstep;
            PG8_LDB(B0, 0, 0); PG8_LDB(B1, 0, 1); PG8_SCHED; PG8_LDA(At, 0, 0); PG8_STAGE(PG8_SA(1, 1), a1, ca1);
            PG8_WAIT_V(8); PG8_WAIT_L(0); PG8_BAR; PG8_MMA(0, 0, At, B0); PG8_MMA(0, 1, At, B1); PG8_BAR; PG8_SCHED;
            PG8_LDA(At, 0, 1); PG8_STAGE(PG8_SB(0, 0), b2, voffB); PG8_STAGE(PG8_SB(0, 1), b2 + hstep, voffB); PG8_STAGE(PG8_SA(0, 0), a2, na0);
            PG8_WAIT_V(8); PG8_WAIT_L(0); PG8_BAR; PG8_MMA(1, 0, At, B0); PG8_MMA(1, 1, At, B1); PG8_BAR; PG8_SCHED;
            PG8_LDB(B0, 1, 0); PG8_LDB(B1, 1, 1); PG8_SCHED; PG8_LDA(At, 1, 0); PG8_STAGE(PG8_SA(0, 1), a2, na1);
            PG8_WAIT_V(8); PG8_WAIT_L(0); PG8_BAR; PG8_MMA(0, 0, At, B0); PG8_MMA(0, 1, At, B1); PG8_BAR; PG8_SCHED;
            PG8_LDA(At, 1, 1); PG8_STAGE(PG8_SB(1, 0), b3, voffB); PG8_STAGE(PG8_SB(1, 1), b3 + hstep, voffB); PG8_STAGE(PG8_SA(1, 0), a3, na0);
            PG8_WAIT_V(8); PG8_WAIT_L(0); PG8_BAR; PG8_MMA(1, 0, At, B0); PG8_MMA(1, 1, At, B1); PG8_BAR; PG8_SCHED;
        }
        if constexpr (ALIGN_EPI) { if (wr == 0) PG8_BAR; }
        E(acc, cur, wr, wc, fr, fq);
        if (!has_next) break;
#pragma unroll
        for (int a = 0; a < 2; ++a)
#pragma unroll
            for (int b = 0; b < 2; ++b)
#pragma unroll
                for (int m = 0; m < 4; ++m)
#pragma unroll
                    for (int n = 0; n < 2; ++n) acc[a][b][m][n] = (f32x4){zf_, zf_, zf_, zf_};
        cur = nxt; cB = nB; ++ui; ca0[0] = na0[0]; ca0[1] = na0[1]; ca1[0] = na1[0]; ca1[1] = na1[1];
        if constexpr (ALIGN_EPI) { if (wr == 1) PG8_BAR; }
    }
    PG8_WAIT_V(0);
    if constexpr (!ALIGN_EPI) { if (wr == 0) PG8_BAR; }
    PG8_BAR;
#undef PG8_AOFF
#undef PG8_SA
#undef PG8_SB
#undef PG8_STAGE
#undef PG8_LDA
#undef PG8_LDB
#undef PG8_MMA
#undef PG8_WAIT_V
#undef PG8_WAIT_L
#undef PG8_BAR
#undef PG8_SCHED
}

}
namespace mk {
using namespace nv;
typedef unsigned short bf16_t;
typedef unsigned u32x4 __attribute__((ext_vector_type(4)));
typedef float f32x4 __attribute__((ext_vector_type(4)));
#define LAS __attribute__((address_space(3)))
constexpr int NT = 512;
constexpr int PB = 2816;
constexpr int NPAD = 3072;
constexpr int C_KV = 512, C_FOX = 1280, C_SB = 2048, C_GATE = 2816;
constexpr int MAXT = MROWS / 256 + NE;
constexpr int PROWS = MAXT * 256;
#define CNT_IDX(l, e) (8192 + ((l) * NE + (e)) * 32)
__device__ __forceinline__ int ftid() { int t = threadIdx.x; asm volatile("" : "+v"(t)); return t; }
__device__ __forceinline__ int fbid() { int b = blockIdx.x; asm volatile("" : "+s"(b)); return b; }
#define MK_LOOP(vb, n) for (int vb = fbid(); vb < (n); vb += gridDim.x)

constexpr size_t al_(size_t x) { return (x + 4095) & ~(size_t)4095; }
constexpr size_t O_WTIN = 0;
constexpr size_t O_WTOUT = O_WTIN + al_((size_t)L_ * NPAD * D_ * 2);
constexpr size_t O_WTGU = O_WTOUT + al_((size_t)L_ * D_ * D_ * 2);
constexpr size_t O_WTDN = O_WTGU + al_((size_t)L_ * NE * 2048 * D_ * 2);
constexpr size_t O_BIASP = O_WTDN + al_((size_t)L_ * NE * D_ * D_ * 2);
constexpr size_t O_XB = O_BIASP + al_((size_t)L_ * NPAD * 4);
constexpr size_t O_PROJB = O_XB + al_((size_t)T_ * D_ * 2);
constexpr size_t O_GF = O_PROJB + al_((size_t)T_ * PB * 2);
constexpr size_t O_CFOX = O_GF + al_((size_t)T_ * 32 * 4);
constexpr size_t O_KCMP = O_CFOX + al_((size_t)B_ * 4 * S_ * 4);
constexpr size_t O_VCMP = O_KCMP + al_((size_t)B_ * 2 * 512 * 64 * 4);
constexpr size_t O_O = O_VCMP + al_((size_t)B_ * 2 * 512 * 64 * 4);
constexpr size_t O_OB = O_O + al_((size_t)T_ * D_ * 4);
constexpr size_t O_PTOT = O_OB + al_((size_t)T_ * D_ * 2);
constexpr size_t O_SEL = O_PTOT + al_((size_t)B_ * 2 * S_ * 512 * 4);
constexpr size_t O_MIX = O_SEL + al_((size_t)B_ * 2 * S_ * NSEL * 4);
constexpr size_t O_X1 = O_MIX + al_((size_t)T_ * D_ * 4);
constexpr size_t O_X1B = O_X1 + al_((size_t)T_ * D_ * 4);
constexpr size_t O_XA = O_X1B + al_((size_t)T_ * D_ * 2);
constexpr size_t O_ACT = O_XA + al_((size_t)T_ * D_ * 4);
constexpr size_t O_Y = O_ACT + al_((size_t)PROWS * D_ * 2);
constexpr size_t O_TOPE = O_Y + al_((size_t)PROWS * D_ * 2);
constexpr size_t O_TOPW = O_TOPE + al_((size_t)MROWS * 4);
constexpr size_t O_POS = O_TOPW + al_((size_t)MROWS * 4);
constexpr size_t O_ROWTOK = O_POS + al_((size_t)MROWS * 4);
constexpr size_t O_ROWW = O_ROWTOK + al_((size_t)PROWS * 4);
constexpr size_t O_SLOT = O_ROWW + al_((size_t)PROWS * 4);
constexpr size_t O_COUNTS = O_SLOT + al_((size_t)MROWS * 4);
constexpr size_t O_META = O_COUNTS + 65536;
constexpr size_t O_OWIN = O_META + 4096;
constexpr size_t O_O2 = O_OWIN + al_((size_t)T_ * 512 * 4);
constexpr size_t O_OWIN2 = O_O2 + al_((size_t)T_ * D_ * 4);
constexpr size_t O_KCMPB = O_OWIN2 + al_((size_t)T_ * 512 * 4);
constexpr size_t O_VCMPB = O_KCMPB + al_((size_t)B_ * 2 * 512 * 64 * 2);
constexpr size_t O_OCMP = O_VCMPB + al_((size_t)B_ * 2 * 512 * 64 * 2);
constexpr size_t O_SELMASK = O_OCMP + al_((size_t)T_ * 512 * 4);
constexpr size_t O_WT1 = O_SELMASK + al_((size_t)B_ * 2 * S_ * 16);
constexpr size_t O_BIAS1 = O_WT1 + al_((size_t)L_ * 2 * 256 * 2048 * 2);
constexpr size_t O_HID = O_BIAS1 + al_((size_t)L_ * 2 * 128 * 4);
constexpr size_t O_BIAS1P = O_HID + al_((size_t)8 * 512 * 128 * 2);
constexpr size_t O_END = O_BIAS1P + al_((size_t)L_ * 2 * 64 * 128 * 4);

struct P {
    In in; unsigned char* ws; float* out;
};
typedef const __attribute__((address_space(4))) P* KP;
__device__ __forceinline__ KP fresh_kp() { KP k = (KP)__builtin_amdgcn_kernarg_segment_ptr(); asm volatile("" : "+s"(k)); return k; }
#define WSP(T, off) ((T*)(p->ws + (off)))

__device__ __forceinline__ float bf2f(unsigned short b) { return __uint_as_float((unsigned)b << 16); }
__device__ __forceinline__ unsigned f2bf(float f) { unsigned u = __float_as_uint(f); return (u + 0x7fffu + ((u >> 16) & 1u)) >> 16; }
__device__ __forceinline__ unsigned pk2(float lo, float hi) { return f2bf(lo) | (f2bf(hi) << 16); }
__device__ __forceinline__ void ld8(const bf16_t* __restrict__ src, float* dst) {
    const u32x4 v = *(const u32x4*)src;
    dst[0] = __uint_as_float(v.x << 16); dst[1] = __uint_as_float(v.x & 0xffff0000u); dst[2] = __uint_as_float(v.y << 16); dst[3] = __uint_as_float(v.y & 0xffff0000u);
    dst[4] = __uint_as_float(v.z << 16); dst[5] = __uint_as_float(v.z & 0xffff0000u); dst[6] = __uint_as_float(v.w << 16); dst[7] = __uint_as_float(v.w & 0xffff0000u);
}


__device__ __forceinline__ int perm_in(int n) {
    if (n < 1280) return n;
    if (n < 1304) return C_GATE + (n - 1280);
    if (n < 2072) return C_FOX + (n - 1304);
    if (n < 2076) return C_GATE + 24 + (n - 2072);
    return C_SB + (n - 2076);
}
__device__ __forceinline__ int perm_gu(int n) { const int up = n >> 10, c = n & 1023; return 256 * (c >> 7) + 128 * up + (c & 127); }
template <int MAP>
__device__ __forceinline__ void transpose_item(const float* __restrict__ W, int K, int N, bf16_t* __restrict__ WT, LAS float* scr, int item, int lane) {
    const int nblk = (N + 31) / 32, kb = item / nblk, nb = item % nblk, k0 = 64 * kb, n0 = 32 * nb;
    { const int n4 = (lane & 7) * 4; const bool okn = (n0 + n4) < N;
      f32x4 t[8];
#pragma unroll
      for (int i = 0; i < 8; ++i) { const int kk = (lane >> 3) + 8 * i; t[i] = okn ? *(const f32x4*)(W + (size_t)(k0 + kk) * N + n0 + n4) : (f32x4){0.f, 0.f, 0.f, 0.f}; }
#pragma unroll
      for (int i = 0; i < 8; ++i) { const int kk = (lane >> 3) + 8 * i; LAS float* d = scr + kk * 33 + n4; d[0] = t[i].x; d[1] = t[i].y; d[2] = t[i].z; d[3] = t[i].w; } }
    asm volatile("s_waitcnt lgkmcnt(0)" ::: "memory");
    const int c = lane & 7;
#pragma unroll
    for (int j = 0; j < 4; ++j) { const int n = (lane >> 3) + 8 * j; const LAS float* sp = scr + (8 * c) * 33 + n;
        u32x4 o; o.x = pk2(sp[0 * 33], sp[1 * 33]); o.y = pk2(sp[2 * 33], sp[3 * 33]); o.z = pk2(sp[4 * 33], sp[5 * 33]); o.w = pk2(sp[6 * 33], sp[7 * 33]);
        const int ng = n0 + n;
        if (ng < N) { const int ro = (MAP == 1) ? perm_in(ng) : (MAP == 2) ? perm_gu(ng) : ng; *(u32x4*)(WT + (size_t)ro * K + k0 + 8 * c) = o; } }
    asm volatile("s_waitcnt lgkmcnt(0)" ::: "memory");
}
__device__ __forceinline__ void ph_convert(LAS unsigned char* lds, KP p) {
    const int tid = ftid(), lane = tid & 63, wv = tid >> 6;
    LAS float* scr = (LAS float*)(lds + wv * 8448);
    const int gw = fbid() * 8 + wv, NGW = gridDim.x * 8;
    constexpr int I_IN = 16 * 89, I_OUT = 16 * 32, I_GU = 16 * 64, I_DN = 16 * 32, I_W1 = 32 * 4;
    constexpr int N_IN = L_ * I_IN, N_OUT = L_ * I_OUT, N_GU = L_ * NE * I_GU, N_DN = L_ * NE * I_DN, N_W1 = L_ * 2 * I_W1;
    for (int it = gw; it < N_IN + N_OUT + N_GU + N_DN + N_W1; it += NGW) {
        int r = it;
        if (r < N_W1) { const int mtx = r / I_W1, ll = mtx >> 1, kv = mtx & 1; transpose_item<0>((kv ? p->in.w1v : p->in.w1k) + (size_t)ll * 2048 * 128, 2048, 128, WSP(bf16_t, O_WT1) + (size_t)mtx * 256 * 2048, scr, r % I_W1, lane); continue; } r -= N_W1;
        if (r < N_GU) { const int mtx = r / I_GU; transpose_item<2>(p->in.wgu + (size_t)mtx * D_ * 2048, D_, 2048, WSP(bf16_t, O_WTGU) + (size_t)mtx * 2048 * D_, scr, r % I_GU, lane); continue; } r -= N_GU;
        if (r < N_DN) { const int mtx = r / I_DN; transpose_item<0>(p->in.wdn + (size_t)mtx * D_ * D_, D_, D_, WSP(bf16_t, O_WTDN) + (size_t)mtx * D_ * D_, scr, r % I_DN, lane); continue; } r -= N_DN;
        if (r < N_IN) { const int mtx = r / I_IN; transpose_item<1>(p->in.w_in + (size_t)mtx * D_ * DIN, D_, DIN, WSP(bf16_t, O_WTIN) + (size_t)mtx * NPAD * D_, scr, r % I_IN, lane); continue; } r -= N_IN;
        { const int mtx = r / I_OUT; transpose_item<0>(p->in.w_out + (size_t)mtx * D_ * D_, D_, D_, WSP(bf16_t, O_WTOUT) + (size_t)mtx * D_ * D_, scr, r % I_OUT, lane); }
    }
    const int gt = fbid() * NT + tid, NG = gridDim.x * NT;
    for (int i = gt; i < L_ * (NPAD - DIN) * (D_ / 8); i += NG) { const int l = i / ((NPAD - DIN) * (D_ / 8)), r = i % ((NPAD - DIN) * (D_ / 8));
        unsigned z_ = 0u; asm volatile("" : "+v"(z_));
        *(u32x4*)(WSP(bf16_t, O_WTIN) + ((size_t)l * NPAD + DIN) * D_ + (size_t)r * 8) = (u32x4){z_, z_, z_, z_}; }
    for (int i = gt; i < L_ * 2 * 128 * (2048 / 8); i += NG) { const int mtx = i / (128 * 256), r = i % (128 * 256); unsigned z_ = 0u; asm volatile("" : "+v"(z_));
        *(u32x4*)(WSP(bf16_t, O_WT1) + ((size_t)mtx * 256 + 128) * 2048 + (size_t)r * 8) = (u32x4){z_, z_, z_, z_}; }
    for (int i = gt; i < L_ * 2 * 64 * 128; i += NG) { const int j = i & 127, seg = (i >> 7) & 63, mtx = i >> 13, ll = mtx >> 1, kv = mtx & 1;
        const float* pos = (kv ? p->in.pos_v : p->in.pos_k) + (size_t)ll * 2048 + seg * 32; const float* w1 = (kv ? p->in.w1v : p->in.w1k) + (size_t)ll * 2048 * 128 + (size_t)seg * 32 * 128; float a = 0.f;
#pragma unroll 8
        for (int k = 0; k < 32; ++k) a += pos[k] * w1[(size_t)k * 128 + j];
        WSP(float, O_BIAS1P)[i] = a; }
    for (int i = gt; i < L_ * NPAD; i += NG) { const int l = i / NPAD, c = i % NPAD; if (c >= DIN) WSP(float, O_BIASP)[i] = 0.f; }
    for (int i = gt; i < L_ * DIN; i += NG) { const int l = i / DIN, n = i % DIN; WSP(float, O_BIASP)[l * NPAD + perm_in(n)] = p->in.b_in[i]; }
    for (int i = gt; i < T_ * D_ / 8; i += NG) { const f32x4 a = *(const f32x4*)(p->in.x + (size_t)i * 8), b = *(const f32x4*)(p->in.x + (size_t)i * 8 + 4);
        *(u32x4*)(WSP(bf16_t, O_XB) + (size_t)i * 8) = (u32x4){pk2(a.x, a.y), pk2(a.z, a.w), pk2(b.x, b.y), pk2(b.z, b.w)}; }
}

struct EpiProj {
    static constexpr bool PERM = true;
    bf16_t* projb; float* gf; const float* bias;
    __device__ __forceinline__ void operator()(const pg8::f32x4 (&acc)[2][2][4][2], const pg8::Unit& u, int wr, int wc, int fr, int fq) const {
        const int row0 = u.pm * 256 + wr * 64 + fr, col0 = u.pn * 256 + wc * 32 + 8 * fq;
        if (u.pn < 11) {
#pragma unroll
            for (int ai = 0; ai < 2; ++ai)
#pragma unroll
                for (int m = 0; m < 4; ++m) { bf16_t* rowp = projb + (size_t)(row0 + ai * 128 + m * 16) * PB + col0;
#pragma unroll
                    for (int bj = 0; bj < 2; ++bj) { const f32x4 v0 = acc[ai][bj][m][0] + *(const f32x4*)(bias + col0 + bj * 128), v1 = acc[ai][bj][m][1] + *(const f32x4*)(bias + col0 + bj * 128 + 4);
                        u32x4 w; w.x = pg8::cvt_pk_bf16(v0[0], v0[1]); w.y = pg8::cvt_pk_bf16(v0[2], v0[3]); w.z = pg8::cvt_pk_bf16(v1[0], v1[1]); w.w = pg8::cvt_pk_bf16(v1[2], v1[3]);
                        *(u32x4*)(rowp + bj * 128) = w; }
                    asm volatile("" ::: "memory"); }
        } else if (wc == 0) {
            const f32x4 b0 = *(const f32x4*)(bias + col0), b1 = *(const f32x4*)(bias + col0 + 4);
#pragma unroll
            for (int ai = 0; ai < 2; ++ai)
#pragma unroll
                for (int m = 0; m < 4; ++m) { float* rowp = gf + (size_t)(row0 + ai * 128 + m * 16) * 32 + 8 * fq;
                    const f32x4 v0 = acc[ai][0][m][0] + b0, v1 = acc[ai][0][m][1] + b1; f32x4 o0, o1;
#pragma unroll
                    for (int i = 0; i < 4; ++i) { const int j0 = 8 * fq + i, j1 = j0 + 4;
                        o0[i] = (j0 < 24) ? sigmoidf_(v0[i]) : (j0 < 28 ? logsig(v0[i]) : 0.f); o1[i] = (j1 < 24) ? sigmoidf_(v1[i]) : (j1 < 28 ? logsig(v1[i]) : 0.f); }
                    *(f32x4*)rowp = o0; *(f32x4*)(rowp + 4) = o1; }
        }
    }
};
struct EpiOut {
    static constexpr bool PERM = true;
    const float* x; float* y1;
    __device__ __forceinline__ void operator()(const pg8::f32x4 (&acc)[2][2][4][2], const pg8::Unit& u, int wr, int wc, int fr, int fq) const {
        const int row0 = u.pm * 256 + wr * 64 + fr, col0 = u.pn * 256 + wc * 32 + 8 * fq;
#pragma unroll
        for (int ai = 0; ai < 2; ++ai)
#pragma unroll
            for (int m = 0; m < 4; ++m) { const size_t off = (size_t)(row0 + ai * 128 + m * 16) * D_ + col0;
#pragma unroll
                for (int bj = 0; bj < 2; ++bj) { const f32x4 x0 = *(const f32x4*)(x + off + bj * 128), x1 = *(const f32x4*)(x + off + bj * 128 + 4);
                    *(f32x4*)(y1 + off + bj * 128) = x0 * ALPHA + acc[ai][bj][m][0]; *(f32x4*)(y1 + off + bj * 128 + 4) = x1 * ALPHA + acc[ai][bj][m][1]; }
                asm volatile("" ::: "memory"); }
    }
};
struct EpiGU {
    static constexpr bool PERM = true;
    bf16_t* act; const float* bgu;
    __device__ __forceinline__ void operator()(const pg8::f32x4 (&acc)[2][2][4][2], const pg8::Unit& u, int wr, int wc, int fr, int fq) const {
        const int row0 = u.pm * 256 + wr * 64 + fr, col0 = u.pn * 128 + wc * 32 + 8 * fq;
        const float* bb = bgu + (size_t)u.e * 2048 + col0;
        const f32x4 bg0 = *(const f32x4*)bb, bg1 = *(const f32x4*)(bb + 4), bu0 = *(const f32x4*)(bb + 1024), bu1 = *(const f32x4*)(bb + 1028);
#pragma unroll
        for (int ai = 0; ai < 2; ++ai)
#pragma unroll
            for (int m = 0; m < 4; ++m) { f32x4 a0, a1;
                const f32x4 g0 = acc[ai][0][m][0] + bg0, g1 = acc[ai][0][m][1] + bg1, u0 = acc[ai][1][m][0] + bu0, u1 = acc[ai][1][m][1] + bu1;
#pragma unroll
                for (int i = 0; i < 4; ++i) { const float gt0 = fminf(g0[i], 7.0f), up0 = fminf(fmaxf(u0[i], -7.0f), 7.0f), gt1 = fminf(g1[i], 7.0f), up1 = fminf(fmaxf(u1[i], -7.0f), 7.0f);
                    a0[i] = gt0 * sigmoidf_(1.702f * gt0) * (up0 + 1.0f); a1[i] = gt1 * sigmoidf_(1.702f * gt1) * (up1 + 1.0f); }
                u32x4 w; w.x = pg8::cvt_pk_bf16(a0[0], a0[1]); w.y = pg8::cvt_pk_bf16(a0[2], a0[3]); w.z = pg8::cvt_pk_bf16(a1[0], a1[1]); w.w = pg8::cvt_pk_bf16(a1[2], a1[3]);
                *(u32x4*)(act + (size_t)(row0 + ai * 128 + m * 16) * D_ + col0) = w; asm volatile("" ::: "memory"); }
    }
};
struct EpiDN {
    static constexpr bool PERM = true;
    bf16_t* y; const float* bdn; const float* roww;
    __device__ __forceinline__ void operator()(const pg8::f32x4 (&acc)[2][2][4][2], const pg8::Unit& u, int wr, int wc, int fr, int fq) const {
        const int row0 = u.pm * 256 + wr * 64 + fr, col0 = u.pn * 256 + wc * 32 + 8 * fq;
        const float* bb = bdn + (size_t)u.e * D_ + col0;
#pragma unroll
        for (int ai = 0; ai < 2; ++ai)
#pragma unroll
            for (int m = 0; m < 4; ++m) { const int row = row0 + ai * 128 + m * 16; const float w = roww[row];
#pragma unroll
                for (int bj = 0; bj < 2; ++bj) { const f32x4 v0 = (acc[ai][bj][m][0] + *(const f32x4*)(bb + bj * 128)) * w, v1 = (acc[ai][bj][m][1] + *(const f32x4*)(bb + bj * 128 + 4)) * w;
                    u32x4 o; o.x = pg8::cvt_pk_bf16(v0[0], v0[1]); o.y = pg8::cvt_pk_bf16(v0[2], v0[3]); o.z = pg8::cvt_pk_bf16(v1[0], v1[1]); o.w = pg8::cvt_pk_bf16(v1[2], v1[3]);
                    *(u32x4*)(y + (size_t)row * D_ + col0 + bj * 128) = o; }
                asm volatile("" ::: "memory"); }
    }
};
struct MoeOrder {
    const int* meta; const int* rowtok; const char* Wt; size_t estep, tstep; int nN, G, c, nunits;
    __device__ __forceinline__ bool next(int i, pg8::Unit& u) const {
        const int L = i * G + c; if (L >= nunits) return false;
        const int gt = L / nN; u.pm = gt; u.pn = L - gt * nN; u.e = meta[64 + 2 * gt]; u.nr = meta[65 + 2 * gt]; return true; }
    __device__ __forceinline__ unsigned a_row(const pg8::Unit& u, int r) const { const int rr = r < u.nr ? r : u.nr - 1; const int row = u.pm * 256 + rr; return rowtok ? (unsigned)rowtok[row] : (unsigned)row; }
    __device__ __forceinline__ const char* b_base(const pg8::Unit& u) const { return Wt + (size_t)u.e * estep + (size_t)u.pn * tstep; }
};

struct EpiCmp {
    static constexpr bool PERM = true;
    bf16_t* hid; const float* bias1;
    __device__ __forceinline__ void operator()(const pg8::f32x4 (&acc)[2][2][4][2], const pg8::Unit& u, int wr, int wc, int fr, int fq) const {
        const int row0 = u.pm * 256 + wr * 64 + fr, col0 = wc * 32 + 8 * fq;
        const float* bb = bias1 + (u.e & 1) * 128 + col0; const f32x4 b0 = *(const f32x4*)bb, b1 = *(const f32x4*)(bb + 4);
#pragma unroll
        for (int ai = 0; ai < 2; ++ai)
#pragma unroll
            for (int m = 0; m < 4; ++m) { const f32x4 v0 = acc[ai][0][m][0] + b0, v1 = acc[ai][0][m][1] + b1;
                u32x4 w; w.x = pg8::cvt_pk_bf16(gelu_tanh(v0[0]), gelu_tanh(v0[1])); w.y = pg8::cvt_pk_bf16(gelu_tanh(v0[2]), gelu_tanh(v0[3])); w.z = pg8::cvt_pk_bf16(gelu_tanh(v1[0]), gelu_tanh(v1[1])); w.w = pg8::cvt_pk_bf16(gelu_tanh(v1[2]), gelu_tanh(v1[3]));
                *(u32x4*)(hid + ((size_t)u.e * 512 + row0 + ai * 128 + m * 16) * 128 + col0) = w; asm volatile("" ::: "memory"); }
    }
};
struct GEpi {
    static constexpr bool PERM = true;
    int kind, l;
    __device__ __forceinline__ void operator()(const pg8::f32x4 (&acc)[2][2][4][2], const pg8::Unit& u, int wr, int wc, int fr, int fq) const {
        const KP p = fresh_kp();
        if (kind == 0) { const EpiProj e{WSP(bf16_t, O_PROJB), WSP(float, O_GF), WSP(float, O_BIASP) + l * NPAD}; e(acc, u, wr, wc, fr, fq); }
        else if (kind == 1) { const EpiOut e{(l == 0) ? p->in.x : WSP(float, O_XA), WSP(float, O_MIX)}; e(acc, u, wr, wc, fr, fq); }
        else if (kind == 2) { const EpiGU e{WSP(bf16_t, O_ACT), p->in.bgu + (size_t)l * NE * 2048}; e(acc, u, wr, wc, fr, fq); }
        else if (kind == 3) { const EpiDN e{WSP(bf16_t, O_Y), p->in.bdn + (size_t)l * NE * D_, WSP(float, O_ROWW)}; e(acc, u, wr, wc, fr, fq); }
        else { const EpiCmp e{WSP(bf16_t, O_HID), WSP(float, O_BIAS1) + l * 256}; e(acc, u, wr, wc, fr, fq); }
    }
};
struct GSched {
    int kind, nM, nN, nunits, G, c; const int* meta; const int* rowtok; const char* Bt; size_t estep;
    __device__ __forceinline__ bool next(int i, pg8::Unit& u) const {
        const int L = i * G + c; if (L >= nunits) return false;
        if (kind < 2) {
            int wgid = L; { const int q = nunits / pg8::NXCD, r = nunits % pg8::NXCD, xcd = wgid % pg8::NXCD, off = wgid / pg8::NXCD; wgid = (xcd < r ? xcd * (q + 1) : r * (q + 1) + (xcd - r) * q) + off; }
            const int nig = pg8::WGM * nN, gid = wgid / nig, fm = gid * pg8::WGM, gsz = (nM - fm) < pg8::WGM ? (nM - fm) : pg8::WGM;
            u.pm = fm + ((wgid % nig) % gsz); u.pn = (wgid % nig) / gsz; u.e = 0; u.nr = 256;
        } else if (kind == 4) { u.e = L >> 1; u.pm = L & 1; u.pn = 0; u.nr = (L & 1) ? 255 : 256; }
        else { const int gt = L / nN; u.pm = gt; u.pn = L - gt * nN; u.e = meta[64 + 2 * gt]; u.nr = meta[65 + 2 * gt]; }
        return true; }
    __device__ __forceinline__ unsigned a_off(const pg8::Unit& u, int r) const { const int rr = r < u.nr ? r : u.nr - 1; const int row = u.pm * 256 + rr;
        if (kind == 4) { const int kv = u.e & 1, bg = u.e >> 1; return (unsigned)(((bg >> 1) * S_ + 16 * row) * PB + C_KV + ((0 * 2 + kv) * 2 + (bg & 1)) * 64) * 2u; }
        return (unsigned)((kind == 2) ? rowtok[row] : row) * (unsigned)(D_ * 2); }
    __device__ __forceinline__ size_t a_kstep() const { return kind == 4 ? (size_t)PB * 2 : (size_t)128; }
    __device__ __forceinline__ const char* b_base(const pg8::Unit& u) const { return Bt + (size_t)(kind == 4 ? (u.e & 1) : u.e) * estep + (size_t)u.pn * ((size_t)256 * D_ * 2); }
};

__device__ __forceinline__ void ph_prep(float* lds, KP p, int l) {
    const int tid = ftid();
    const bf16_t* projb = WSP(bf16_t, O_PROJB);
    constexpr int NCB = (NCMP + 3) / 4;
    constexpr int NV_CMP = NCB * B_ * 2 * 2;
    MK_LOOP(vb, NV_CMP + B_ * 4) {
        if (vb < NV_CMP) {
            float* blk = lds; float* hid = lds + 4 * 2048;
            const int kv = vb & 1, bg = (vb >> 1) & 3, nb = vb >> 3, b = bg >> 1, g = bg & 1;
            const float* pos = (kv ? p->in.pos_v : p->in.pos_k) + (size_t)l * 2048; const float* w1 = (kv ? p->in.w1v : p->in.w1k) + (size_t)l * 2048 * 128;
            const float* w2 = (kv ? p->in.w2v : p->in.w2k) + (size_t)l * 128 * 64; float* outp = kv ? WSP(float, O_VCMP) : WSP(float, O_KCMP);
            __syncthreads();
            for (int i = tid; i < 4 * 2048; i += NT) { const int sub = i >> 11, e = i & 2047, ll = e >> 6, d = e & 63; int n = nb * 4 + sub; if (n >= NCMP) n = NCMP - 1;
                blk[i] = bf2f(projb[(size_t)(b * S_ + 16 * n + ll) * PB + C_KV + ((0 * 2 + kv) * 2 + g) * 64 + d]) + pos[e]; }
            __syncthreads();
            const int sub = tid >> 7, j = tid & 127; const float* bl = blk + sub * 2048;
            float a = 0.f;
            for (int i = 0; i < 2048; ++i) a += bl[i] * w1[(size_t)i * 128 + j];
            hid[tid] = gelu_tanh(a);
            __syncthreads();
            const int n = nb * 4 + sub;
            if (j < 64 && n < NCMP) { float o = 0.f; for (int jj = 0; jj < 128; ++jj) o += hid[sub * 128 + jj] * w2[jj * 64 + j]; outp[((size_t)bg * NCMP + n) * 64 + j] = o;
                (kv ? WSP(bf16_t, O_VCMPB) : WSP(bf16_t, O_KCMPB))[((size_t)bg * 512 + n) * 64 + j] = (bf16_t)f2bf(o); }
            if (j < 64 && n == NCMP) (kv ? WSP(bf16_t, O_VCMPB) : WSP(bf16_t, O_KCMPB))[((size_t)bg * 512 + 511) * 64 + j] = 0;
        } else {
            float* sh = lds; const int bh = vb - NV_CMP, b = bh >> 2, h = bh & 3; float carry = 0.f;
            for (int t0 = 0; t0 < S_; t0 += NT) {
                __syncthreads();
                sh[tid] = WSP(float, O_GF)[(size_t)(b * S_ + t0 + tid) * 32 + 24 + h]; __syncthreads();
                for (int o = 1; o < NT; o <<= 1) { const float add = (tid >= o) ? sh[tid - o] : 0.f; __syncthreads(); sh[tid] += add; __syncthreads(); }
                WSP(float, O_CFOX)[(size_t)bh * S_ + t0 + tid] = carry + sh[tid];
                carry += sh[NT - 1];
            }
        }
    }
}

__device__ __forceinline__ void load_tile_bf(float (*dst)[64], const bf16_t* __restrict__ src, size_t pitch) {
    const int tid = ftid(), r = tid >> 3, c0 = (tid & 7) * 8; float v[8]; ld8(src + (size_t)r * pitch + c0, v);
    *(float4*)&dst[r][c0] = make_float4(v[0], v[1], v[2], v[3]); *(float4*)&dst[r][c0 + 4] = make_float4(v[4], v[5], v[6], v[7]);
}
__device__ __forceinline__ void load_tile512(float (*dst)[64], const float* __restrict__ src, size_t stride, int nrows_valid) {
    const int tid = ftid(), r = tid >> 3, c0 = (tid & 7) * 8;
#pragma unroll
    for (int j = 0; j < 2; ++j) { float4 v = make_float4(0.f, 0.f, 0.f, 0.f); if (r < nrows_valid) v = *(const float4*)(src + (size_t)r * stride + c0 + 4 * j); *(float4*)&dst[r][c0 + 4 * j] = v; }
}
#define MK_LOADQ(q, src) do { _Pragma("unroll") for (int c_ = 0; c_ < 8; ++c_) { float t8_[8]; ld8((src) + 8 * c_, t8_); _Pragma("unroll") for (int e_ = 0; e_ < 8; ++e_) q[8 * c_ + e_] = t8_[e_] * SCALE; } } while (0)

template <int KIND>
__device__ __forceinline__ void attn_vblock(float* lds, KP p, int qb, int bh) {
    float (*Ks)[64] = (float (*)[64])lds; float (*Vs)[64] = (float (*)[64])(lds + 4096); float* Cs = lds + 8192;
    const bf16_t* projb = WSP(bf16_t, O_PROJB); const float* gf = WSP(float, O_GF); float* ob = WSP(float, O_O);
    const int tid = ftid(), q0 = qb * NT, t = q0 + tid;
    if (KIND == 0 || KIND == 1) {
        int b, h, qcol, kcol, vcol, ocol; float slope = 0.f;
        if (KIND == 0) { b = bh >> 2; h = bh & 3; qcol = C_FOX + h * 64; kcol = C_FOX + (4 + h) * 64; vcol = C_FOX + (8 + h) * 64; ocol = 512 + h * 64; }
        else { b = bh >> 3; h = bh & 7; const int g = h >> 2; qcol = h * 64; kcol = C_KV + ((2 * 2 + 0) * 2 + g) * 64; vcol = C_KV + ((2 * 2 + 1) * 2 + g) * 64; ocol = h * 64; slope = exp2f(-(float)(h + 1)); }
        const bf16_t* prow = projb + (size_t)(b * S_ + t) * PB;
        float q[64], o[64];
        MK_LOADQ(q, prow + qcol);
#pragma unroll
        for (int d = 0; d < 64; ++d) o[d] = 0.f;
        float m = -1e30f, l = 0.f, ct = 0.f; const float* cb = WSP(float, O_CFOX) + (size_t)(b * 4 + (h & 3)) * S_;
        if (KIND == 0) ct = cb[t];
        int kt0 = 0; const int kt1 = (q0 + NT - 1) >> 6;
        if (KIND == 1) { kt0 = (q0 - 511) >> 6; if (kt0 < 0) kt0 = 0; }
        for (int kt = kt0; kt <= kt1; ++kt) {
            __syncthreads();
            load_tile_bf(Ks, projb + (size_t)(b * S_ + kt * 64) * PB + kcol, PB);
            load_tile_bf(Vs, projb + (size_t)(b * S_ + kt * 64) * PB + vcol, PB);
            if (KIND == 0 && tid < 64) Cs[tid] = cb[kt * 64 + tid];
            __syncthreads();
            for (int r = 0; r < 64; ++r) {
                const int s = kt * 64 + r; bool ok = (s <= t); if (KIND == 1) ok = ok && (t - s < 512);
                if (ok) { float sc; NV_DOT(q, Ks[r], sc); if (KIND == 0) sc += ct - Cs[r]; else sc -= slope * (float)(t - s); NV_ONLINE(sc, Vs[r]); }
            }
        }
        const float inv = (l > 0.f) ? 1.f / l : 0.f;
        float* orow = ob + (size_t)(b * S_ + t) * D_ + ocol;
        if (KIND == 0) {
#pragma unroll
            for (int d = 0; d < 64; ++d) orow[d] = o[d] * inv;
        } else { const float gate = gf[(size_t)(b * S_ + t) * 32 + 2 * 8 + h]; float* wrow = WSP(float, O_OWIN) + (size_t)(b * S_ + t) * 512 + h * 64;
#pragma unroll
            for (int d = 0; d < 64; ++d) wrow[d] = gate * o[d] * inv; }
    } else if (KIND == 2) {
        const int b = bh >> 2, h = bh & 3;
        const int qcol = C_SB + h * 64, kcol = C_SB + (4 + h) * 64, vcol = C_SB + (8 + h) * 64, ocol = 768 + h * 64;
        const bf16_t* prow = projb + (size_t)(b * S_ + t) * PB;
        float q[64], o[64];
        MK_LOADQ(q, prow + qcol);
#pragma unroll
        for (int d = 0; d < 64; ++d) o[d] = 0.f;
        float later = 0.f;
        for (int kt = (q0 + NT - 1) >> 6; kt >= 0; --kt) {
            __syncthreads();
            load_tile_bf(Ks, projb + (size_t)(b * S_ + kt * 64) * PB + kcol, PB);
            load_tile_bf(Vs, projb + (size_t)(b * S_ + kt * 64) * PB + vcol, PB);
            __syncthreads();
            for (int r = 63; r >= 0; --r) { const int s = kt * 64 + r;
                if (s < t) { float z; NV_DOT(q, Ks[r], z); const float a = expf(logsig(z) + later); NV_AXPY(o, a, Vs[r]); later += logsig(-z); } }
        }
        float* orow = ob + (size_t)(b * S_ + t) * D_ + ocol;
#pragma unroll
        for (int d = 0; d < 64; ++d) orow[d] = o[d];
    } else {
        const int bg = bh, b = bg >> 1, g = bg & 1;
        const bf16_t* prow = projb + (size_t)(b * S_ + t) * PB;
        float* prow_t = WSP(float, O_PTOT) + (size_t)(bg * S_ + t) * 512;
        const float* kcmp = WSP(float, O_KCMP); const float* vcmp = WSP(float, O_VCMP);
        int nmax = (q0 + NT - 1 - 31) / 16 + 1; if (nmax > NCMP) nmax = NCMP;
        const int ntile = (nmax + 63) / 64;
        for (int r4 = 0; r4 < 4; ++r4) {
            const int h = g * 4 + r4; const float slope = exp2f(-(float)(h + 1));
            float q[64], o[64];
            MK_LOADQ(q, prow + h * 64);
#pragma unroll
            for (int d = 0; d < 64; ++d) o[d] = 0.f;
            float m = -1e30f, l = 0.f;
            for (int kt = 0; kt < ntile; ++kt) {
                __syncthreads();
                const int nvr = (NCMP - kt * 64) < 64 ? (NCMP - kt * 64) : 64;
                load_tile512(Ks, kcmp + ((size_t)bg * NCMP + kt * 64) * 64, 64, nvr);
                load_tile512(Vs, vcmp + ((size_t)bg * NCMP + kt * 64) * 64, 64, nvr);
                __syncthreads();
                for (int r = 0; r < nvr; ++r) { const int ce = 16 * (kt * 64 + r) + 31;
                    if (ce <= t) { float sc; NV_DOT(q, Ks[r], sc); sc -= slope * (float)(t - ce); NV_ONLINE(sc, Vs[r]); } }
            }
            const float inv = (l > 0.f) ? 1.f / l : 0.f;
            const float gate = gf[(size_t)(b * S_ + t) * 32 + 0 * 8 + h];
            float* orow = ob + (size_t)(b * S_ + t) * D_ + h * 64;
#pragma unroll
            for (int d = 0; d < 64; ++d) orow[d] = gate * o[d] * inv;
            for (int kt = 0; kt < 8; ++kt) {
                __syncthreads();
                const int nvr = (NCMP - kt * 64) < 64 ? (NCMP - kt * 64) : 64;
                if (kt < ntile) load_tile512(Ks, kcmp + ((size_t)bg * NCMP + kt * 64) * 64, 64, nvr);
                __syncthreads();
                for (int r = 0; r < 64; ++r) { const int n = kt * 64 + r, ce = 16 * n + 31; float pp = 0.f;
                    if (kt < ntile && r < nvr && ce <= t) { float sc; NV_DOT(q, Ks[r], sc); sc -= slope * (float)(t - ce); pp = __expf(sc - m) * inv; }
                    if (r4 == 0) prow_t[n] = pp; else prow_t[n] += pp; }
            }
        }
    }
}
__device__ __forceinline__ void ph_attn_a(float* lds, KP p) {
    constexpr int NQB = S_ / NT;
    constexpr int N_CMP = NQB * B_ * 2, N_FOX = NQB * B_ * 4, N_SB = NQB * B_ * 4;
    MK_LOOP(vb, N_CMP + N_FOX + N_SB) {
        if (vb < N_FOX) { const int qb = NQB - 1 - vb / (B_ * 4); attn_vblock<0>(lds, p, qb, vb % (B_ * 4)); }
        else if (vb < N_FOX + N_SB) { const int v = vb - N_FOX; const int qb = NQB - 1 - v / (B_ * 4); attn_vblock<2>(lds, p, qb, v % (B_ * 4)); }
        else { const int v = vb - N_FOX - N_SB; attn_vblock<3>(lds, p, v / (B_ * 2), v % (B_ * 2)); }
    }
}
__device__ __forceinline__ void ph_select(KP p) {
    const int lane = ftid() & 63, wv = ftid() >> 6; int* sel = WSP(int, O_SEL);
    for (int wave = fbid() * 8 + wv; wave < B_ * 2 * S_; wave += gridDim.x * 8) {
        const int t = wave % S_; const float* pt = WSP(float, O_PTOT) + (size_t)wave * 512; const int cur = t >> 6;
        float v[2];
#pragma unroll
        for (int k = 0; k < 2; ++k) { const int j = lane + 64 * k;
            float imp = pt[4 * j] + pt[4 * j + 1] + pt[4 * j + 2];
            if (4 * j + 3 < NCMP) imp += 0.5f * pt[4 * j + 3];
            if (j >= 1) imp += 0.5f * pt[4 * j - 1];
            const bool valid = j <= cur, forced = valid && (j == 0 || j >= cur - 1);
            v[k] = forced ? 3.0e38f : (valid ? imp : -3.0e38f); }
        for (int it = 0; it < NSEL; ++it) {
            float bv = v[0]; int bi = lane; if (v[1] > bv) { bv = v[1]; bi = lane + 64; }
#pragma unroll
            for (int o = 32; o >= 1; o >>= 1) { const float ov = __shfl_xor(bv, o); const int oi = __shfl_xor(bi, o); if (ov > bv || (ov == bv && oi < bi)) { bv = ov; bi = oi; } }
            if (lane == 0) sel[(size_t)wave * NSEL + it] = bi;
            if (bi == lane) v[0] = -3.4e38f;
            if (bi == lane + 64) v[1] = -3.4e38f;
        }
    }
}
__device__ __forceinline__ void ph_attn_sel(KP p) {
    const bf16_t* projb = WSP(bf16_t, O_PROJB); const int tid = ftid();
    MK_LOOP(vb, (S_ / NT) * B_ * 8) {
        const int qb = vb / (B_ * 8), bh = vb % (B_ * 8), b = bh >> 3, h = bh & 7, g = h >> 2, t = qb * NT + tid;
        const float slope = exp2f(-(float)(h + 1));
        const bf16_t* prow = projb + (size_t)(b * S_ + t) * PB;
        const int kcol = C_KV + ((1 * 2 + 0) * 2 + g) * 64, vcol = C_KV + ((1 * 2 + 1) * 2 + g) * 64;
        const int* sl = WSP(int, O_SEL) + ((size_t)(b * 2 + g) * S_ + t) * NSEL;
        float q[64], o[64];
        MK_LOADQ(q, prow + h * 64);
#pragma unroll
        for (int d = 0; d < 64; ++d) o[d] = 0.f;
        float m = -1e30f, l = 0.f;
        for (int i = 0; i < NSEL; ++i) { const int blk = sl[i];
            for (int r = 0; r < 64; ++r) { const int s = blk * 64 + r;
                if (s <= t) { const bf16_t* kr = projb + (size_t)(b * S_ + s) * PB + kcol; const bf16_t* vr = projb + (size_t)(b * S_ + s) * PB + vcol;
                    float sc = 0.f;
#pragma unroll
                    for (int c = 0; c < 8; ++c) { float k8[8]; ld8(kr + 8 * c, k8);
#pragma unroll
                        for (int e = 0; e < 8; ++e) sc += q[8 * c + e] * k8[e]; }
                    sc -= slope * (float)(t - s);
                    if (sc > m) { const float al = __expf(m - sc); l *= al;
#pragma unroll
                        for (int d = 0; d < 64; ++d) o[d] *= al;
                        m = sc; }
                    const float pp = __expf(sc - m); l += pp;
#pragma unroll
                    for (int c = 0; c < 8; ++c) { float v8[8]; ld8(vr + 8 * c, v8);
#pragma unroll
                        for (int e = 0; e < 8; ++e) o[8 * c + e] += pp * v8[e]; }
                } } }
        const float inv = (l > 0.f) ? 1.f / l : 0.f; const float gate = WSP(float, O_GF)[(size_t)(b * S_ + t) * 32 + 1 * 8 + h];
        float* orow = WSP(float, O_O) + (size_t)(b * S_ + t) * D_ + h * 64;
#pragma unroll
        for (int d = 0; d < 64; ++d) orow[d] += gate * o[d] * inv;
    }
}
__device__ __forceinline__ void ph_attn_win(float* lds, KP p) {
    MK_LOOP(vb, (S_ / NT) * B_ * 8) attn_vblock<1>(lds, p, vb / (B_ * 8), vb % (B_ * 8));
}
__device__ __forceinline__ void ph_rmsnorm(KP p, int l) {
    const int lane = ftid() & 63, wv = ftid() >> 6; const float* g = p->in.g_out + (size_t)l * D_;
    constexpr int NB = 4; const int rstride = (int)gridDim.x * 8;
    f32x4 gg[4];
#pragma unroll
    for (int j = 0; j < 2; ++j) { gg[2 * j] = *(const f32x4*)(g + 512 * j + lane * 8); gg[2 * j + 1] = *(const f32x4*)(g + 512 * j + lane * 8 + 4); }
    for (int row0 = fbid() * 8 + wv; row0 < T_; row0 += rstride * NB) {
        f32x4 a[NB][2], bq[NB][2], ww[NB][2];
#pragma unroll
        for (int bi = 0; bi < NB; ++bi) { const int row = (row0 + bi * rstride < T_) ? row0 + bi * rstride : row0; const float* r = WSP(float, O_O) + (size_t)row * D_ + lane * 8; const float* wr = WSP(float, O_OWIN) + (size_t)row * 512 + lane * 8;
            a[bi][0] = *(const f32x4*)r; a[bi][1] = *(const f32x4*)(r + 4); bq[bi][0] = *(const f32x4*)(r + 512); bq[bi][1] = *(const f32x4*)(r + 516); ww[bi][0] = *(const f32x4*)wr; ww[bi][1] = *(const f32x4*)(wr + 4); }
#pragma unroll
        for (int bi = 0; bi < NB; ++bi) { const int row = row0 + bi * rstride; if (row < T_) {
            const f32x4 x0 = a[bi][0] + ww[bi][0], x1 = a[bi][1] + ww[bi][1], y0 = bq[bi][0], y1 = bq[bi][1];
            float s = (x0.x * x0.x + x0.y * x0.y) + (x0.z * x0.z + x0.w * x0.w) + (x1.x * x1.x + x1.y * x1.y) + (x1.z * x1.z + x1.w * x1.w);
            float s2 = (y0.x * y0.x + y0.y * y0.y) + (y0.z * y0.z + y0.w * y0.w) + (y1.x * y1.x + y1.y * y1.y) + (y1.z * y1.z + y1.w * y1.w);
            const float sc0 = rsqrtf(wsum(s) * (1.f / 512.f) + RMS_EPS);
#pragma unroll
            for (int o = 1; o < 32; o <<= 1) s2 += __shfl_xor(s2, o);
            const float sc1 = rsqrtf(s2 * (1.f / 256.f) + RMS_EPS);
            const f32x4 u0 = x0 * sc0 * gg[0], u1 = x1 * sc0 * gg[1], w0 = y0 * sc1 * gg[2], w1 = y1 * sc1 * gg[3];
            bf16_t* ro = WSP(bf16_t, O_OB) + (size_t)row * D_;
            *(u32x4*)(ro + lane * 8) = (u32x4){pk2(u0.x, u0.y), pk2(u0.z, u0.w), pk2(u1.x, u1.y), pk2(u1.z, u1.w)};
            *(u32x4*)(ro + 512 + lane * 8) = (u32x4){pk2(w0.x, w0.y), pk2(w0.z, w0.w), pk2(w1.x, w1.y), pk2(w1.z, w1.w)}; } }
    }
}
template <bool ROUTER>
__device__ __forceinline__ void ph_ln(float* lds, KP p, int l, float* __restrict__ yout, int cnt_off = 0) {
    const int lane = ftid() & 63, wv = ftid() >> 6;
    const float* g = (ROUTER ? p->in.ln1_g : p->in.ln2_g) + (size_t)l * D_; const float* bb = (ROUTER ? p->in.ln1_b : p->in.ln2_b) + (size_t)l * D_;
    constexpr int NB = ROUTER ? 4 : 2;
    const int rstride = (int)gridDim.x * 8;
    for (int row0 = fbid() * 8 + wv; row0 < T_; row0 += rstride * NB) {
        float v[NB][16];
        if (ROUTER) {
#pragma unroll
            for (int bi = 0; bi < NB; ++bi) { const int row = row0 + bi * rstride; const float* src = WSP(float, O_MIX) + (size_t)(row < T_ ? row : row0) * D_;
#pragma unroll
                for (int j = 0; j < 2; ++j) { const f32x4 a = *(const f32x4*)(src + 512 * j + lane * 8), b = *(const f32x4*)(src + 512 * j + lane * 8 + 4);
                    v[bi][8 * j + 0] = a.x; v[bi][8 * j + 1] = a.y; v[bi][8 * j + 2] = a.z; v[bi][8 * j + 3] = a.w; v[bi][8 * j + 4] = b.x; v[bi][8 * j + 5] = b.y; v[bi][8 * j + 6] = b.z; v[bi][8 * j + 7] = b.w; } }
        } else { const bf16_t* y = WSP(bf16_t, O_Y);
            int sl[NB][TOPK];
#pragma unroll
            for (int bi = 0; bi < NB; ++bi) { const int row = (row0 + bi * rstride < T_) ? row0 + bi * rstride : row0;
#pragma unroll
                for (int k = 0; k < TOPK; ++k) sl[bi][k] = WSP(int, O_SLOT)[row * TOPK + k]; }
            u32x4 yv[NB][TOPK][2]; f32x4 xv[NB][4];
#pragma unroll
            for (int bi = 0; bi < NB; ++bi) { const int row = (row0 + bi * rstride < T_) ? row0 + bi * rstride : row0; const float* src = WSP(float, O_X1) + (size_t)row * D_;
#pragma unroll
                for (int j = 0; j < 2; ++j) { xv[bi][2 * j] = *(const f32x4*)(src + 512 * j + lane * 8); xv[bi][2 * j + 1] = *(const f32x4*)(src + 512 * j + lane * 8 + 4); }
#pragma unroll
                for (int k = 0; k < TOPK; ++k)
#pragma unroll
                    for (int j = 0; j < 2; ++j) yv[bi][k][j] = *(const u32x4*)(y + (size_t)sl[bi][k] * D_ + 512 * j + lane * 8); }
#pragma unroll
            for (int bi = 0; bi < NB; ++bi)
#pragma unroll
                for (int j = 0; j < 2; ++j) { float acc[8];
#pragma unroll
                    for (int e = 0; e < 8; ++e) acc[e] = 0.f;
#pragma unroll
                    for (int k = 0; k < TOPK; ++k) { const u32x4 q = yv[bi][k][j];
                        acc[0] += __uint_as_float(q.x << 16); acc[1] += __uint_as_float(q.x & 0xffff0000u); acc[2] += __uint_as_float(q.y << 16); acc[3] += __uint_as_float(q.y & 0xffff0000u);
                        acc[4] += __uint_as_float(q.z << 16); acc[5] += __uint_as_float(q.z & 0xffff0000u); acc[6] += __uint_as_float(q.w << 16); acc[7] += __uint_as_float(q.w & 0xffff0000u); }
                    const f32x4 a = xv[bi][2 * j], b = xv[bi][2 * j + 1];
                    v[bi][8 * j + 0] = ALPHA * a.x + acc[0]; v[bi][8 * j + 1] = ALPHA * a.y + acc[1]; v[bi][8 * j + 2] = ALPHA * a.z + acc[2]; v[bi][8 * j + 3] = ALPHA * a.w + acc[3];
                    v[bi][8 * j + 4] = ALPHA * b.x + acc[4]; v[bi][8 * j + 5] = ALPHA * b.y + acc[5]; v[bi][8 * j + 6] = ALPHA * b.z + acc[6]; v[bi][8 * j + 7] = ALPHA * b.w + acc[7]; } }
#pragma unroll
        for (int bi = 0; bi < NB; ++bi) { const int row = row0 + bi * rstride; if (row < T_) {
            float s = 0.f;
#pragma unroll
            for (int i = 0; i < 16; ++i) s += v[bi][i];
            const float mu = wsum(s) * (1.f / D_); float s2 = 0.f;
#pragma unroll
            for (int i = 0; i < 16; ++i) { v[bi][i] -= mu; s2 += v[bi][i] * v[bi][i]; }
            const float rstd = rsqrtf(wsum(s2) * (1.f / D_) + LN_EPS);
            bf16_t* ybf = (ROUTER ? WSP(bf16_t, O_X1B) : WSP(bf16_t, O_XB)) + (size_t)row * D_;
#pragma unroll
            for (int j = 0; j < 2; ++j) { const int c0 = 512 * j + lane * 8; float o8[8];
                const f32x4 g0 = *(const f32x4*)(g + c0), g1 = *(const f32x4*)(g + c0 + 4), b0 = *(const f32x4*)(bb + c0), b1 = *(const f32x4*)(bb + c0 + 4);
                o8[0] = v[bi][8 * j + 0] * rstd * g0.x + b0.x; o8[1] = v[bi][8 * j + 1] * rstd * g0.y + b0.y; o8[2] = v[bi][8 * j + 2] * rstd * g0.z + b0.z; o8[3] = v[bi][8 * j + 3] * rstd * g0.w + b0.w;
                o8[4] = v[bi][8 * j + 4] * rstd * g1.x + b1.x; o8[5] = v[bi][8 * j + 5] * rstd * g1.y + b1.y; o8[6] = v[bi][8 * j + 6] * rstd * g1.z + b1.z; o8[7] = v[bi][8 * j + 7] * rstd * g1.w + b1.w;
                *(f32x4*)(yout + (size_t)row * D_ + c0) = (f32x4){o8[0], o8[1], o8[2], o8[3]};
                *(f32x4*)(yout + (size_t)row * D_ + c0 + 4) = (f32x4){o8[4], o8[5], o8[6], o8[7]};
                *(u32x4*)(ybf + c0) = (u32x4){pk2(o8[0], o8[1]), pk2(o8[2], o8[3]), pk2(o8[4], o8[5]), pk2(o8[6], o8[7])}; } } }
    }
    if (ROUTER) {
        const float* rw = p->in.rw + (size_t)l * D_ * NE; const float* rb = p->in.rb + (size_t)l * NE;
        float* wl = lds; float* rl = lds + 16384 + wv * 2048; float* lgl = lds + 32768 + wv * 256;
        int nrow = 0; for (int r_ = fbid() * 8 + wv; r_ < T_; r_ += (int)gridDim.x * 8) { ++nrow; asm volatile("" : "+s"(nrow)); }
        const int e = lane & 31, half = lane >> 5;
        float acc[2][4];
#pragma unroll
        for (int gi = 0; gi < 2; ++gi)
#pragma unroll
            for (int bi = 0; bi < 4; ++bi) acc[gi][bi] = 0.f;
#pragma unroll 1
        for (int c = 0; c < 2; ++c) {
            __syncthreads();
#pragma unroll
            for (int i = 0; i < 8; ++i) { const int f4 = i * NT + ftid(); *(f32x4*)(wl + 4 * f4) = *(const f32x4*)(rw + (size_t)c * 512 * NE + 4 * f4); }
            __syncthreads();
#pragma unroll
            for (int gi = 0; gi < 2; ++gi) {
                asm volatile("s_waitcnt lgkmcnt(0)" ::: "memory");
#pragma unroll
                for (int bi = 0; bi < 4; ++bi) { const int ri = (4 * gi + bi < nrow) ? 4 * gi + bi : 0; const float* src = yout + (size_t)(fbid() * 8 + wv + ri * (int)gridDim.x * 8) * D_ + c * 512 + lane * 8;
                    *(f32x4*)(rl + bi * 512 + lane * 8) = *(const f32x4*)src; *(f32x4*)(rl + bi * 512 + lane * 8 + 4) = *(const f32x4*)(src + 4); }
                asm volatile("s_waitcnt lgkmcnt(0)" ::: "memory");
                const float* wp = wl + (half * 256) * NE + e; const float* rp = rl + half * 256;
#pragma unroll 4
                for (int kk = 0; kk < 64; ++kk) { const float w0 = wp[(4 * kk) * NE], w1 = wp[(4 * kk + 1) * NE], w2 = wp[(4 * kk + 2) * NE], w3 = wp[(4 * kk + 3) * NE];
#pragma unroll
                    for (int bi = 0; bi < 4; ++bi) { const f32x4 r = *(const f32x4*)(rp + bi * 512 + 4 * kk); acc[gi][bi] += (r.x * w0 + r.y * w1) + (r.z * w2 + r.w * w3); } }
            }
        }
#pragma unroll
        for (int gi = 0; gi < 2; ++gi)
#pragma unroll
            for (int bi = 0; bi < 4; ++bi) { const float t = acc[gi][bi] + __shfl_xor(acc[gi][bi], 32); if (lane < 32) lgl[(4 * gi + bi) * 32 + e] = t; }
        asm volatile("s_waitcnt lgkmcnt(0)" ::: "memory");
        int* lcnt = (int*)(lds + 32768 + 8 * 256);
        if (ftid() < NE) lcnt[ftid()] = 0;
        __syncthreads();
#pragma unroll 1
        for (int ri = 0; ri < nrow; ++ri) { const int row = fbid() * 8 + wv + ri * (int)gridDim.x * 8;
            const int e = lane & 31; const float lg = lgl[ri * 32 + e] + rb[e];
            float cur = lg, tv0 = 0.f, den = 0.f, myw = 0.f; int mye = 0;
#pragma unroll
            for (int k = 0; k < TOPK; ++k) { float bv = cur; int bi = e;
#pragma unroll
                for (int o = 16; o >= 1; o >>= 1) { const float ov = __shfl_xor(bv, o); const int oi = __shfl_xor(bi, o); if (ov > bv || (ov == bv && oi < bi)) { bv = ov; bi = oi; } }
                if (k == 0) tv0 = bv;
                const float w = __expf(bv - tv0); den += w;
                if (lane == k) { mye = bi; myw = w; }
                if (e == bi) cur = -3.4e38f; }
            if (lane < TOPK) { WSP(int, O_TOPE)[row * TOPK + lane] = mye; WSP(float, O_TOPW)[row * TOPK + lane] = myw / den; WSP(int, O_POS)[row * TOPK + lane] = atomicAdd(&lcnt[mye], 1); } }
        __syncthreads();
        if (ftid() < NE) { const int c = lcnt[ftid()]; lcnt[ftid()] = (c > 0) ? atomicAdd(WSP(int, O_COUNTS) + CNT_IDX(l, ftid()) + cnt_off, c) : 0; }
        __syncthreads();
#pragma unroll 1
        for (int ri = 0; ri < nrow; ++ri) { const int row = fbid() * 8 + wv + ri * (int)gridDim.x * 8;
            if (lane < TOPK) WSP(int, O_POS)[row * TOPK + lane] += lcnt[WSP(int, O_TOPE)[row * TOPK + lane]]; }
        __syncthreads();
    }
}
__device__ __forceinline__ void ph_moe_plan(KP p, int l) {
    if (fbid() == 0 && ftid() == 0) { const int* counts = WSP(int, O_COUNTS) + l * 32; int* meta = WSP(int, O_META); int nt = 0;
        for (int e = 0; e < NE; ++e) { meta[e] = nt; const int c = counts[e];
            for (int r = 0; r < c; r += 256) { meta[64 + 2 * nt] = e; meta[65 + 2 * nt] = (c - r) < 256 ? (c - r) : 256; ++nt; } }
        meta[32] = nt; }
}
__device__ __forceinline__ void ph_moe_scatter(KP p) {
    const int* meta = WSP(int, O_META);
    for (int i = fbid() * NT + ftid(); i < MROWS; i += gridDim.x * NT) {
        const int row = meta[WSP(int, O_TOPE)[i]] * 256 + WSP(int, O_POS)[i];
        WSP(int, O_ROWTOK)[row] = i >> 2; WSP(float, O_ROWW)[row] = WSP(float, O_TOPW)[i]; WSP(int, O_SLOT)[i] = row; }
}
__device__ __forceinline__ void ph_bias1_reduce(KP p, int l) {
    if (fbid() != (int)gridDim.x - 1) return;
    const int tid = ftid(); if (tid < 256) { const float* pp = WSP(float, O_BIAS1P) + ((size_t)(l * 2 + (tid >> 7)) * 64) * 128 + (tid & 127); float a = 0.f;
        for (int s = 0; s < 64; ++s) a += pp[s * 128];
        WSP(float, O_BIAS1)[l * 256 + tid] = a; }
}
__device__ __forceinline__ void ph_cumsum(float* lds, KP p, int blk0) {
    const int tid = ftid(), lane = tid & 63, wv = tid >> 6; const int bh = fbid() - blk0;
    if (bh < 0 || bh >= B_ * 4) return;
    const int b = bh >> 2, h = bh & 3; const float* gf = WSP(float, O_GF) + (size_t)(b * S_ + tid * 16) * 32 + 24 + h;
    float v[16], run = 0.f;
#pragma unroll
    for (int i = 0; i < 16; ++i) { run += gf[(size_t)i * 32]; v[i] = run; }
    float inc = run;
#pragma unroll
    for (int o = 1; o < 64; o <<= 1) { const float t = __shfl_up(inc, o); if (lane >= o) inc += t; }
    if (lane == 63) lds[wv] = inc;
    __syncthreads();
    float woff = 0.f;
#pragma unroll
    for (int i = 0; i < 8; ++i) woff += (i < wv) ? lds[i] : 0.f;
    const float off = woff + inc - run; float* c = WSP(float, O_CFOX) + (size_t)bh * S_ + tid * 16;
#pragma unroll
    for (int i = 0; i < 4; ++i) *(f32x4*)(c + 4 * i) = (f32x4){v[4 * i] + off, v[4 * i + 1] + off, v[4 * i + 2] + off, v[4 * i + 3] + off};
    __syncthreads();
}
__device__ __forceinline__ void ph_prep2(KP p, int l) {
    { unsigned* kmax2 = WSP(unsigned, O_COUNTS) + 192 + l * 8;
      for (int i = fbid() * NT + ftid(); i < B_ * 4 * S_ * 2; i += gridDim.x * NT) { const int half = i & 1, t = (i >> 1) % S_, bh = (i >> 1) / S_, b = bh >> 2, h = bh & 3;
          const bf16_t* kr = WSP(bf16_t, O_PROJB) + (size_t)(b * S_ + t) * PB + C_FOX + (4 + h) * 64 + half * 32; float ss = 0.f;
#pragma unroll
          for (int c = 0; c < 4; ++c) { float k8[8]; ld8(kr + 8 * c, k8);
#pragma unroll
              for (int e = 0; e < 8; ++e) ss += k8[e] * k8[e]; }
          ss += __shfl_xor(ss, 1);
#pragma unroll
          for (int o = 2; o < 64; o <<= 1) ss = fmaxf(ss, __shfl_xor(ss, o));
          if ((ftid() & 63) == 0) atomicMax(kmax2 + bh, __float_as_uint(ss)); } }
    for (int i = fbid() * NT + ftid(); i < 8 * 512 * 64; i += gridDim.x * NT) {
        const int d = i & 63, n = (i >> 6) & 511, combo = i >> 15, kv = combo & 1, bg = combo >> 1;
        const float* w2 = (kv ? p->in.w2v : p->in.w2k) + (size_t)l * 128 * 64; const bf16_t* hr = WSP(bf16_t, O_HID) + ((size_t)combo * 512 + n) * 128;
        float a = 0.f;
#pragma unroll 4
        for (int c = 0; c < 16; ++c) { float h8[8]; ld8(hr + 8 * c, h8);
#pragma unroll
            for (int e = 0; e < 8; ++e) a += h8[e] * w2[(8 * c + e) * 64 + d]; }
        (kv ? WSP(bf16_t, O_VCMPB) : WSP(bf16_t, O_KCMPB))[((size_t)bg * 512 + n) * 64 + d] = (n < NCMP) ? (bf16_t)f2bf(a) : (bf16_t)0; }
}
__device__ __forceinline__ void ph_moe_scatter2(float* lds, KP p, int l) {
    const int tid = ftid(); int* ts = (int*)lds;
    const int* counts = WSP(int, O_COUNTS) + CNT_IDX(l, 0); int* meta = WSP(int, O_META); int* cl = ts + 64;
    __syncthreads();
    if (tid < NE) cl[tid] = counts[tid * 32];
    __syncthreads();
    if (tid == 0) { int nt = 0; for (int e = 0; e < NE; ++e) { ts[e] = nt; nt += (cl[e] + 255) >> 8; } ts[32] = nt; }
    __syncthreads();
    if (fbid() == 0) { if (tid < NE) { const int c = cl[tid], t0 = ts[tid]; meta[tid] = t0; for (int r = 0, t = t0; r < c; r += 256, ++t) { meta[64 + 2 * t] = tid; meta[65 + 2 * t] = (c - r) < 256 ? (c - r) : 256; } }
        if (tid == 0) meta[32] = ts[32]; }
    for (int i = fbid() * NT + tid; i < MROWS; i += gridDim.x * NT) {
        const int row = ts[WSP(int, O_TOPE)[i]] * 256 + WSP(int, O_POS)[i];
        WSP(int, O_ROWTOK)[row] = i >> 2; WSP(float, O_ROWW)[row] = WSP(float, O_TOPW)[i]; WSP(int, O_SLOT)[i] = row; }
    __syncthreads();
}
}
namespace mk {
typedef short bf16x8 __attribute__((ext_vector_type(8)));
typedef float f32x16 __attribute__((ext_vector_type(16)));
typedef float f32x2_t __attribute__((ext_vector_type(2)));
typedef __bf16 bf16x2_t __attribute__((ext_vector_type(2)));
typedef unsigned u32x2 __attribute__((ext_vector_type(2)));
typedef short v4i16_t __attribute__((ext_vector_type(4)));
__device__ __forceinline__ unsigned cvtpk(float lo, float hi) { f32x2_t v = {lo, hi}; bf16x2_t b = __builtin_convertvector(v, bf16x2_t); return __builtin_bit_cast(unsigned, b); }
constexpr int KROW = 144, VROW = 136;
constexpr int E1_K = 0, E1_V = 64 * KROW, E1_C = E1_V + 64 * KROW, E1_BUF = E1_C + 256;
constexpr int E1_FLAGS = 2 * E1_BUF;
constexpr float LOG2E = 1.4426950408889634f;
constexpr float RESC_THR = 8.0f;
#define CROW(reg, hh) (((reg) & 3) + 8 * ((reg) >> 2) + 4 * (hh))

#define SM_CORE(p0, p1, m, l, have, o0, o1) do { \
    float rm_ = fmaxf(p0[0], p1[0]); \
    _Pragma("unroll") for (int reg_ = 1; reg_ < 16; ++reg_) rm_ = fmaxf(rm_, fmaxf(p0[reg_], p1[reg_])); \
    rm_ = fmaxf(rm_, __shfl_xor(rm_, 32)); \
    const bool fin_ = rm_ > -1e37f; \
    if (__any((rm_ > RESC_THR) || (!have && fin_))) { \
        const float dl_ = have ? fmaxf(rm_, 0.f) : (fin_ ? rm_ : 0.f); const float al_ = have ? __builtin_amdgcn_exp2f(-dl_) : 1.f; \
        m += dl_; l *= al_; have = have || fin_; \
        _Pragma("unroll") for (int r_ = 0; r_ < 16; ++r_) { o0[r_] *= al_; o1[r_] *= al_; p0[r_] -= dl_; p1[r_] -= dl_; } } \
    float ls_ = 0.f; \
    _Pragma("unroll") for (int reg_ = 0; reg_ < 16; ++reg_) { p0[reg_] = __builtin_amdgcn_exp2f(p0[reg_]); p1[reg_] = __builtin_amdgcn_exp2f(p1[reg_]); ls_ += p0[reg_] + p1[reg_]; } \
    l += ls_; } while (0)

struct E1Geom { int b, q0, h; const bf16_t* qp; const bf16_t* kp; const bf16_t* vp; size_t pitch; };

template <int KIND>
__device__ __forceinline__ void e1_unit(LAS unsigned char* lds, KP p, int b, int hg, int qb, float* __restrict__ obase, float* __restrict__ owin, const unsigned* __restrict__ kmax2) {
    const int tid = ftid(), lane = tid & 63, w = __builtin_amdgcn_readfirstlane(tid >> 6), r32 = lane & 31, hh = lane >> 5;
    const bf16_t* projb = WSP(bf16_t, O_PROJB);
    int h, q0, qrow0, qcol, kcol, vcol, nrows;
    if (KIND == 0) { h = hg; q0 = qb * 256; qrow0 = q0 + 32 * w; qcol = C_FOX + h * 64; kcol = C_FOX + (4 + h) * 64; vcol = C_FOX + (8 + h) * 64; nrows = 256; }
    else if (KIND == 2) { h = hg; q0 = qb * 256; qrow0 = q0 + 32 * w; qcol = C_SB + h * 64; kcol = C_SB + (4 + h) * 64; vcol = C_SB + (8 + h) * 64; nrows = 256; }
    else { h = 4 * hg + (w & 3); q0 = qb * 64; qrow0 = q0 + 32 * (w >> 2); qcol = h * 64; kcol = C_KV + ((2 * 2 + 0) * 2 + hg) * 64; vcol = C_KV + ((2 * 2 + 1) * 2 + hg) * 64; nrows = 64; }
    const int tq = qrow0 + r32;
    const bf16_t* kbase = projb + (size_t)(b * S_) * PB + kcol; const bf16_t* vbase = projb + (size_t)(b * S_) * PB + vcol;
    bf16x8 qf[4];
    { const bf16_t* qptr = projb + (size_t)(b * S_ + tq) * PB + qcol + 8 * hh;
#pragma unroll
      for (int d0 = 0; d0 < 4; ++d0) qf[d0] = *(const bf16x8*)(qptr + 16 * d0); }
    int j0 = 0; const int j1 = (q0 + nrows - 1) >> 6;
    if (KIND == 1) { j0 = (q0 - 511) >> 6; if (j0 < 0) j0 = 0; }
    const int ntile = j1 - j0 + 1;
    float ct2 = 0.f, sl2 = 0.f; const float* cb = nullptr;
    if (KIND == 0) { cb = WSP(float, O_CFOX) + (size_t)(b * 4 + h) * S_; ct2 = cb[tq] * LOG2E; }
    if (KIND == 1) sl2 = exp2f(-(float)(h + 1)) * LOG2E;
    float qkb = 0.f;
    if (KIND == 0) { float qs = 0.f;
#pragma unroll
        for (int d0 = 0; d0 < 4; ++d0)
#pragma unroll
            for (int e = 0; e < 8; ++e) { const float x = bf2f((unsigned short)qf[d0][e]); qs += x * x; }
        qs += __shfl_xor(qs, 32);
        const float km2 = __uint_as_float(kmax2[b * 4 + h]);
        qkb = sqrtf(qs * km2) * (SCALE * LOG2E * 1.01f); }
    const float tqf = (float)tq;
    const int skey = tid >> 3, sch = tid & 7;
    u32x4 rk, rv; float rc = 0.f;
#define E1_LOAD(jj) do { const size_t ro_ = (size_t)((jj) * 64 + skey) * PB + sch * 8; rk = *(const u32x4*)(kbase + ro_); rv = *(const u32x4*)(vbase + ro_); \
        if (KIND == 0 && tid < 64) rc = cb[(jj) * 64 + tid] * LOG2E; } while (0)
#define E1_WRITE(bufp) do { *(LAS u32x4*)((bufp) + E1_K + skey * KROW + sch * 16) = rk; *(LAS u32x4*)((bufp) + E1_V + skey * KROW + sch * 16) = rv; \
        if (KIND == 0 && tid < 64) ((LAS float*)((bufp) + E1_C))[tid] = rc; } while (0)
    f32x16 o0, o1;
#pragma unroll
    for (int r = 0; r < 16; ++r) { o0[r] = 0.f; o1[r] = 0.f; }
    float m = 0.f, l = 0.f, carry = 0.f; bool have = false;
    bool wave_done = false;
    LAS unsigned* flags = (LAS unsigned*)(lds + E1_FLAGS);
    if (KIND != 1) { if (tid < 8) flags[tid] = 0u; }
    __syncthreads();
    E1_LOAD(KIND != 1 ? j1 : j0);
    for (int it = 0; it < ntile; ++it) {
        const int j = (KIND != 1) ? (j1 - it) : (j0 + it);
        LAS unsigned char* buf = lds + (it & 1) * E1_BUF;
        E1_WRITE(buf);
        __syncthreads();
        if (KIND != 1) { unsigned alld = 1u;
#pragma unroll
            for (int i = 0; i < 8; ++i) alld &= flags[i];
            if (alld) break; }
        if (it + 1 < ntile) E1_LOAD((KIND != 1) ? (j - 1) : (j + 1));
        if (!(KIND != 1 && wave_done)) {
            f32x16 p0, p1;
#pragma unroll
            for (int r = 0; r < 16; ++r) { p0[r] = 0.f; p1[r] = 0.f; }
            { const LAS unsigned char* kp_ = buf + E1_K + r32 * KROW + hh * 16;
#pragma unroll
              for (int d0 = 0; d0 < 4; ++d0) { const bf16x8 a0 = *(const LAS bf16x8*)(kp_ + d0 * 32), a1 = *(const LAS bf16x8*)(kp_ + 32 * KROW + d0 * 32);
                  p0 = __builtin_amdgcn_mfma_f32_32x32x16_bf16(a0, qf[d0], p0, 0, 0, 0); p1 = __builtin_amdgcn_mfma_f32_32x32x16_bf16(a1, qf[d0], p1, 0, 0, 0); } }
            const int kb = j * 64 + 4 * hh;
            if (KIND == 2) {
                float lk0[16], lk1[16], gs[8];
#pragma unroll
                for (int reg = 0; reg < 16; ++reg) { const int kpos = kb + CROW(reg, 0);
                    const float z0 = p0[reg] * SCALE, z1 = p1[reg] * SCALE; const bool v0 = kpos < tq, v1 = kpos + 32 < tq;
                    const float lb0 = fminf(z0, 0.f) - __logf(1.f + __expf(-fabsf(z0))), lb1 = fminf(z1, 0.f) - __logf(1.f + __expf(-fabsf(z1)));
                    lk0[reg] = v0 ? (lb0 - z0) : 0.f; lk1[reg] = v1 ? (lb1 - z1) : 0.f;
                    p0[reg] = v0 ? lb0 : -INFINITY; p1[reg] = v1 ? lb1 : -INFINITY; }
#pragma unroll
                for (int g4 = 0; g4 < 4; ++g4) { gs[g4] = (lk0[4 * g4] + lk0[4 * g4 + 1]) + (lk0[4 * g4 + 2] + lk0[4 * g4 + 3]); gs[4 + g4] = (lk1[4 * g4] + lk1[4 * g4 + 1]) + (lk1[4 * g4 + 2] + lk1[4 * g4 + 3]); }
                float oth[8];
#pragma unroll
                for (int gi = 0; gi < 8; ++gi) oth[gi] = __shfl_xor(gs[gi], 32);
                float run = 0.f;
#pragma unroll
                for (int gi = 7; gi >= 0; --gi) {
                    float later = carry + run + (hh == 0 ? oth[gi] : 0.f);
#pragma unroll
                    for (int e = 3; e >= 0; --e) { const int reg = (gi & 3) * 4 + e;
                        if (gi >> 2) { p1[reg] = __expf(p1[reg] + later); later += lk1[reg]; } else { p0[reg] = __expf(p0[reg] + later); later += lk0[reg]; } }
                    run += gs[gi] + oth[gi]; }
                carry += run;
            } else {
                if (KIND == 0) {
                    const LAS float* cs = (const LAS float*)(buf + E1_C) + 4 * hh; const float ctm = ct2 - m;
#pragma unroll
                    for (int i = 0; i < 4; ++i) { const f32x4 c0 = *(const LAS f32x4*)(cs + 8 * i), c1 = *(const LAS f32x4*)(cs + 32 + 8 * i);
#pragma unroll
                        for (int e = 0; e < 4; ++e) { const int reg = 4 * i + e; p0[reg] = p0[reg] * (SCALE * LOG2E) + (ctm - c0[e]); p1[reg] = p1[reg] * (SCALE * LOG2E) + (ctm - c1[e]); } }
                    if (!(j * 64 + 63 <= qrow0)) {
#pragma unroll
                        for (int reg = 0; reg < 16; ++reg) { const int kpos = kb + CROW(reg, 0); p0[reg] = (kpos <= tq) ? p0[reg] : -INFINITY; p1[reg] = (kpos + 32 <= tq) ? p1[reg] : -INFINITY; } }
                } else {
                    const float basef = sl2 * ((float)kb - tqf) - m, base1 = basef + 32.f * sl2;
#pragma unroll
                    for (int reg = 0; reg < 16; ++reg) { p0[reg] = p0[reg] * (SCALE * LOG2E) + __builtin_fmaf(sl2, (float)CROW(reg, 0), basef); p1[reg] = p1[reg] * (SCALE * LOG2E) + __builtin_fmaf(sl2, (float)CROW(reg, 0), base1); }
                    if (!(j * 64 + 63 <= qrow0 && qrow0 + 31 - j * 64 < 512)) {
#pragma unroll
                        for (int reg = 0; reg < 16; ++reg) { const int kpos = kb + CROW(reg, 0);
                            p0[reg] = (kpos <= tq && tq - kpos < 512) ? p0[reg] : -INFINITY; p1[reg] = (kpos + 32 <= tq && tq - kpos - 32 < 512) ? p1[reg] : -INFINITY; } }
                }
                SM_CORE(p0, p1, m, l, have, o0, o1);
            }
            { const int gq_ = lane >> 4, li_ = lane & 15;
              const LAS unsigned char* tb = buf + E1_V + (4 * hh + (li_ >> 2)) * KROW + (16 * (gq_ & 1) + 4 * (li_ & 3)) * 2;
#pragma unroll
              for (int s = 0; s < 4; ++s) {
                  u32x4 pw;
                  if (s < 2) { pw.x = cvtpk(p0[8 * s + 0], p0[8 * s + 1]); pw.y = cvtpk(p0[8 * s + 2], p0[8 * s + 3]); pw.z = cvtpk(p0[8 * s + 4], p0[8 * s + 5]); pw.w = cvtpk(p0[8 * s + 6], p0[8 * s + 7]); }
                  else { const int s2 = s - 2; pw.x = cvtpk(p1[8 * s2 + 0], p1[8 * s2 + 1]); pw.y = cvtpk(p1[8 * s2 + 2], p1[8 * s2 + 3]); pw.z = cvtpk(p1[8 * s2 + 4], p1[8 * s2 + 5]); pw.w = cvtpk(p1[8 * s2 + 6], p1[8 * s2 + 7]); }
                  const bf16x8 pb = __builtin_bit_cast(bf16x8, pw);
                  const v4i16_t a0l = __builtin_amdgcn_ds_read_tr16_b64_v4i16((LAS v4i16_t*)(tb + (16 * s) * KROW)), a0h = __builtin_amdgcn_ds_read_tr16_b64_v4i16((LAS v4i16_t*)(tb + (16 * s + 8) * KROW));
                  const v4i16_t a1l = __builtin_amdgcn_ds_read_tr16_b64_v4i16((LAS v4i16_t*)(tb + (16 * s) * KROW + 64)), a1h = __builtin_amdgcn_ds_read_tr16_b64_v4i16((LAS v4i16_t*)(tb + (16 * s + 8) * KROW + 64));
                  const bf16x8 va0 = (bf16x8){a0l[0], a0l[1], a0l[2], a0l[3], a0h[0], a0h[1], a0h[2], a0h[3]}, va1 = (bf16x8){a1l[0], a1l[1], a1l[2], a1l[3], a1h[0], a1h[1], a1h[2], a1h[3]};
                  o0 = __builtin_amdgcn_mfma_f32_32x32x16_bf16(va0, pb, o0, 0, 0, 0); o1 = __builtin_amdgcn_mfma_f32_32x32x16_bf16(va1, pb, o1, 0, 0, 0); } }
            if (KIND == 0) {
                const float c0 = *(const LAS float*)(buf + E1_C); const bool dn = __all(have && (qkb + (ct2 - c0) - m < -150.f));
                if (dn && !wave_done) { wave_done = true; if (lane == 0) flags[w] = 1u; } }
            if (KIND == 2) { const bool dn = __all(carry < -110.f);
                if (dn && !wave_done) { wave_done = true; if (lane == 0) flags[w] = 1u; } }
        }
    }
    float inv = 1.f, gate = 1.f;
    if (KIND != 2) { l += __shfl_xor(l, 32); inv = (l > 0.f) ? 1.f / l : 0.f; }
    float* orow;
    if (KIND == 0) orow = obase + (size_t)(b * S_ + tq) * D_ + 512 + h * 64;
    else if (KIND == 2) orow = obase + (size_t)(b * S_ + tq) * D_ + 768 + h * 64;
    else { orow = owin + (size_t)(b * S_ + tq) * 512 + h * 64; gate = WSP(float, O_GF)[(size_t)(b * S_ + tq) * 32 + 2 * 8 + h]; }
    const float sc = inv * gate;
#pragma unroll
    for (int i = 0; i < 4; ++i) {
        *(f32x4*)(orow + 8 * i + 4 * hh) = (f32x4){o0[4 * i] * sc, o0[4 * i + 1] * sc, o0[4 * i + 2] * sc, o0[4 * i + 3] * sc};
        *(f32x4*)(orow + 32 + 8 * i + 4 * hh) = (f32x4){o1[4 * i] * sc, o1[4 * i + 1] * sc, o1[4 * i + 2] * sc, o1[4 * i + 3] * sc}; }
#undef E1_LOAD
#undef E1_WRITE
}
}
namespace mk {
constexpr int E2_WAVE = 64 * KROW + 512;
template <bool USE_MASK>
__device__ __forceinline__ void e2_wave_unit(LAS unsigned char* ldsw, KP p, int b, int g, int t0, float* __restrict__ obase, const float* __restrict__ csrc, int cpitch) {
    const int lane = ftid() & 63, r32 = lane & 31, hh = lane >> 5, qi = r32 >> 2, r4 = r32 & 3;
    const int h = 4 * g + r4, tq = t0 + qi;
    const bf16_t* projb = WSP(bf16_t, O_PROJB);
    const bf16_t* kbase = projb + (size_t)(b * S_) * PB + C_KV + ((1 * 2 + 0) * 2 + g) * 64;
    const bf16_t* vbase = projb + (size_t)(b * S_) * PB + C_KV + ((1 * 2 + 1) * 2 + g) * 64;
    bf16x8 qf[4];
    { const bf16_t* qptr = projb + (size_t)(b * S_ + tq) * PB + h * 64 + 8 * hh;
#pragma unroll
      for (int d0 = 0; d0 < 4; ++d0) qf[d0] = *(const bf16x8*)(qptr + 16 * d0); }
    unsigned qm0 = 0u, qm1 = 0u, qm2 = 0u, qm3 = 0u;
    if (USE_MASK) { const u32x4 mw = *(const u32x4*)(WSP(unsigned, O_SELMASK) + ((size_t)((b * 2 + g) * S_ + t0 + (lane >> 3))) * 4); qm0 = mw.x; qm1 = mw.y; qm2 = mw.z; qm3 = mw.w; }
    else { const int* sp = WSP(int, O_SEL) + ((size_t)((b * 2 + g) * S_ + t0)) * NSEL + lane * 2;
      const int e0 = sp[0], e1 = sp[1];
#pragma unroll
      for (int k = 0; k < 2; ++k) { const int e = k ? e1 : e0; const unsigned bit = 1u << (e & 31); const int wd = e >> 5;
          qm0 |= (wd == 0) ? bit : 0u; qm1 |= (wd == 1) ? bit : 0u; qm2 |= (wd == 2) ? bit : 0u; qm3 |= (wd == 3) ? bit : 0u; }
#pragma unroll
      for (int o = 1; o < 8; o <<= 1) { qm0 |= __shfl_xor(qm0, o); qm1 |= __shfl_xor(qm1, o); qm2 |= __shfl_xor(qm2, o); qm3 |= __shfl_xor(qm3, o); } }
    const unsigned rm0 = __shfl(qm0, qi * 8), rm1 = __shfl(qm1, qi * 8), rm2 = __shfl(qm2, qi * 8), rm3 = __shfl(qm3, qi * 8);
    unsigned um0 = qm0, um1 = qm1, um2 = qm2, um3 = qm3;
#pragma unroll
    for (int o = 8; o < 64; o <<= 1) { um0 |= __shfl_xor(um0, o); um1 |= __shfl_xor(um1, o); um2 |= __shfl_xor(um2, o); um3 |= __shfl_xor(um3, o); }
    LAS int* list = (LAS int*)(ldsw + 64 * KROW);
    int nblk;
    { const bool s0 = (((lane < 32) ? um0 : um1) >> (lane & 31)) & 1u, s1 = (((lane < 32) ? um2 : um3) >> (lane & 31)) & 1u;
      const unsigned long long b0 = __ballot(s0), b1 = __ballot(s1);
      const unsigned long long lower = (lane == 0) ? 0ull : (~0ull >> (64 - lane));
      const int n0 = __popcll(b0);
      if (s0) list[__popcll(b0 & lower)] = lane;
      if (s1) list[n0 + __popcll(b1 & lower)] = lane + 64;
      nblk = n0 + __popcll(b1); }
    asm volatile("s_waitcnt lgkmcnt(0)" ::: "memory");
    const float sl2 = exp2f(-(float)(h + 1)) * LOG2E, tqf = (float)tq;
    f32x16 o0, o1;
#pragma unroll
    for (int r = 0; r < 16; ++r) { o0[r] = 0.f; o1[r] = 0.f; }
    float m = 0.f, l = 0.f; bool have = false;
    const int curq = tq >> 6;
    const int vrow = lane >> 3, vch = lane & 7;
    const int gq = lane >> 4, li = lane & 15;
    const LAS unsigned char* trb = ldsw + (4 * hh + (li >> 2)) * KROW + (16 * (gq & 1) + 4 * (li & 3)) * 2;
    bf16x8 kn0[4], kn1[4]; u32x4 vn[8];
#define E2_LOAD(blk) do { const bf16_t* kp_ = kbase + (size_t)((blk) * 64 + r32) * PB + 8 * hh; const bf16_t* vp_ = vbase + (size_t)((blk) * 64 + vrow) * PB + vch * 8; \
        _Pragma("unroll") for (int d0 = 0; d0 < 4; ++d0) { kn0[d0] = *(const bf16x8*)(kp_ + 16 * d0); kn1[d0] = *(const bf16x8*)(kp_ + (size_t)32 * PB + 16 * d0); } \
        _Pragma("unroll") for (int i = 0; i < 8; ++i) vn[i] = *(const u32x4*)(vp_ + (size_t)(8 * i) * PB); } while (0)
    int blk = list[0];
    blk = __builtin_amdgcn_readfirstlane(blk);
    E2_LOAD(blk);
    for (int it = 0; it < nblk; ++it) {
#pragma unroll
        for (int i = 0; i < 8; ++i) *(LAS u32x4*)(ldsw + (vrow + 8 * i) * KROW + vch * 16) = vn[i];
        const int cur = blk;
        f32x16 p0, p1;
#pragma unroll
        for (int r = 0; r < 16; ++r) { p0[r] = 0.f; p1[r] = 0.f; }
#pragma unroll
        for (int d0 = 0; d0 < 4; ++d0) { p0 = __builtin_amdgcn_mfma_f32_32x32x16_bf16(kn0[d0], qf[d0], p0, 0, 0, 0); p1 = __builtin_amdgcn_mfma_f32_32x32x16_bf16(kn1[d0], qf[d0], p1, 0, 0, 0); }
        if (it + 1 < nblk) { blk = __builtin_amdgcn_readfirstlane(list[it + 1]); E2_LOAD(blk); }
        const unsigned rw = (cur < 32) ? rm0 : (cur < 64) ? rm1 : (cur < 96) ? rm2 : rm3;
        const bool rowsel = (rw >> (cur & 31)) & 1u;
        const int kb = cur * 64 + 4 * hh;
        { const float basef = rowsel ? (sl2 * ((float)kb - tqf) - m) : -INFINITY, base1 = basef + 32.f * sl2;
#pragma unroll
          for (int reg = 0; reg < 16; ++reg) { p0[reg] = p0[reg] * (SCALE * LOG2E) + __builtin_fmaf(sl2, (float)CROW(reg, 0), basef); p1[reg] = p1[reg] * (SCALE * LOG2E) + __builtin_fmaf(sl2, (float)CROW(reg, 0), base1); } }
        if (cur >= curq) {
#pragma unroll
            for (int reg = 0; reg < 16; ++reg) { const int kpos = kb + CROW(reg, 0); p0[reg] = (kpos <= tq) ? p0[reg] : -INFINITY; p1[reg] = (kpos + 32 <= tq) ? p1[reg] : -INFINITY; } }
        SM_CORE(p0, p1, m, l, have, o0, o1);
#pragma unroll
        for (int s = 0; s < 4; ++s) {
            u32x4 pw;
            if (s < 2) { pw.x = cvtpk(p0[8 * s + 0], p0[8 * s + 1]); pw.y = cvtpk(p0[8 * s + 2], p0[8 * s + 3]); pw.z = cvtpk(p0[8 * s + 4], p0[8 * s + 5]); pw.w = cvtpk(p0[8 * s + 6], p0[8 * s + 7]); }
            else { const int s2 = s - 2; pw.x = cvtpk(p1[8 * s2 + 0], p1[8 * s2 + 1]); pw.y = cvtpk(p1[8 * s2 + 2], p1[8 * s2 + 3]); pw.z = cvtpk(p1[8 * s2 + 4], p1[8 * s2 + 5]); pw.w = cvtpk(p1[8 * s2 + 6], p1[8 * s2 + 7]); }
            const bf16x8 pb = __builtin_bit_cast(bf16x8, pw);
            const v4i16_t a0l = __builtin_amdgcn_ds_read_tr16_b64_v4i16((LAS v4i16_t*)(trb + (16 * s) * KROW)), a0h = __builtin_amdgcn_ds_read_tr16_b64_v4i16((LAS v4i16_t*)(trb + (16 * s + 8) * KROW));
            const v4i16_t a1l = __builtin_amdgcn_ds_read_tr16_b64_v4i16((LAS v4i16_t*)(trb + (16 * s) * KROW + 64)), a1h = __builtin_amdgcn_ds_read_tr16_b64_v4i16((LAS v4i16_t*)(trb + (16 * s + 8) * KROW + 64));
            const bf16x8 va0 = (bf16x8){a0l[0], a0l[1], a0l[2], a0l[3], a0h[0], a0h[1], a0h[2], a0h[3]}, va1 = (bf16x8){a1l[0], a1l[1], a1l[2], a1l[3], a1h[0], a1h[1], a1h[2], a1h[3]};
            o0 = __builtin_amdgcn_mfma_f32_32x32x16_bf16(va0, pb, o0, 0, 0, 0); o1 = __builtin_amdgcn_mfma_f32_32x32x16_bf16(va1, pb, o1, 0, 0, 0); }
    }
    l += __shfl_xor(l, 32);
    const float sc = ((l > 0.f) ? 1.f / l : 0.f) * WSP(float, O_GF)[(size_t)(b * S_ + tq) * 32 + 1 * 8 + h];
    float* orow = obase + (size_t)(b * S_ + tq) * D_ + h * 64; const float* crow = csrc + (size_t)(b * S_ + tq) * cpitch + h * 64;
#pragma unroll
    for (int i = 0; i < 4; ++i) {
        f32x4 x0 = *(const f32x4*)(crow + 8 * i + 4 * hh), x1 = *(const f32x4*)(crow + 32 + 8 * i + 4 * hh);
        x0 += (f32x4){o0[4 * i] * sc, o0[4 * i + 1] * sc, o0[4 * i + 2] * sc, o0[4 * i + 3] * sc}; x1 += (f32x4){o1[4 * i] * sc, o1[4 * i + 1] * sc, o1[4 * i + 2] * sc, o1[4 * i + 3] * sc};
        *(f32x4*)(orow + 8 * i + 4 * hh) = x0; *(f32x4*)(orow + 32 + 8 * i + 4 * hh) = x1; }
#undef E2_LOAD
}
template <bool USE_MASK>
__device__ __forceinline__ void ph_attn_sel2(LAS unsigned char* lds3, KP p, float* __restrict__ obase, const float* __restrict__ csrc, int cpitch) {
    const int w = __builtin_amdgcn_readfirstlane(ftid() >> 6);
    LAS unsigned char* ldsw = lds3 + w * E2_WAVE;
    MK_LOOP(u, 512) { const int bg = u & 3, qblk = u >> 2; e2_wave_unit<USE_MASK>(ldsw, p, bg >> 1, bg & 1, qblk * 64 + 8 * w, obase, csrc, cpitch); }
}
}
namespace mk {
constexpr int E3_K = 0, E3_V = 512 * KROW, E3_BYTES = 2 * 512 * KROW;
__device__ __forceinline__ void e3_unit(LAS unsigned char* lds, KP p, int b, int g, int qb, float* __restrict__ ocmp, unsigned* __restrict__ selmask) {
    const int tid = ftid(), lane = tid & 63, w = __builtin_amdgcn_readfirstlane(tid >> 6), r32 = lane & 31, hh = lane >> 5;
    const int bg = b * 2 + g, q0 = qb * 256, qrow0 = q0 + 32 * w, tq = qrow0 + r32;
    const bf16_t* projb = WSP(bf16_t, O_PROJB);
    int nun = (q0 + 255 - 31) / 16 + 1; if (nun > 511) nun = 511;
    const int ntile_u = (nun + 63) >> 6;
    __syncthreads();
    { const int srow = tid >> 3, sch = tid & 7; const bf16_t* ks = WSP(bf16_t, O_KCMPB) + ((size_t)bg * 512 + srow) * 64 + sch * 8; const bf16_t* vs = WSP(bf16_t, O_VCMPB) + ((size_t)bg * 512 + srow) * 64 + sch * 8;
      for (int i = 0; i < ntile_u; ++i) { const u32x4 kv = *(const u32x4*)(ks + (size_t)i * 64 * 64), vv = *(const u32x4*)(vs + (size_t)i * 64 * 64);
          *(LAS u32x4*)(lds + E3_K + (srow + 64 * i) * KROW + sch * 16) = kv; *(LAS u32x4*)(lds + E3_V + (srow + 64 * i) * KROW + sch * 16) = vv; } }
    __syncthreads();
    int nw = qrow0 / 16 + 1; if (nw > 511) nw = 511;
    const int ntile_w = (qrow0 + 31 < 31) ? 0 : ((nw + 63) >> 6);
    const float tqf = (float)tq;
    const int gq = lane >> 4, li = lane & 15;
    const LAS unsigned char* trb = lds + E3_V + (4 * hh + (li >> 2)) * KROW + (16 * (gq & 1) + 4 * (li & 3)) * 2;
    const LAS unsigned char* kfb = lds + E3_K + r32 * KROW + hh * 16;
    float imp[64];
#pragma unroll
    for (int i = 0; i < 64; ++i) imp[i] = 0.f;
#pragma unroll 1
    for (int r4 = 0; r4 < 4; ++r4) {
        const int h = 4 * g + r4; const float sl2 = exp2f(-(float)(h + 1)) * LOG2E;
        bf16x8 qf[4];
        { const bf16_t* qptr = projb + (size_t)(b * S_ + tq) * PB + h * 64 + 8 * hh;
#pragma unroll
          for (int d0 = 0; d0 < 4; ++d0) qf[d0] = *(const bf16x8*)(qptr + 16 * d0); }
        f32x16 o0, o1;
#pragma unroll
        for (int r = 0; r < 16; ++r) { o0[r] = 0.f; o1[r] = 0.f; }
        float m = 0.f, l = 0.f; bool have = false;
#define E3_ST(jt) f32x16 p0, p1; { _Pragma("unroll") for (int r = 0; r < 16; ++r) { p0[r] = 0.f; p1[r] = 0.f; } \
            _Pragma("unroll") for (int d0 = 0; d0 < 4; ++d0) { const bf16x8 a0 = *(const LAS bf16x8*)(kfb + (64 * (jt)) * KROW + d0 * 32), a1 = *(const LAS bf16x8*)(kfb + (64 * (jt) + 32) * KROW + d0 * 32); \
                p0 = __builtin_amdgcn_mfma_f32_32x32x16_bf16(a0, qf[d0], p0, 0, 0, 0); p1 = __builtin_amdgcn_mfma_f32_32x32x16_bf16(a1, qf[d0], p1, 0, 0, 0); } \
            int tq_ = tq; asm volatile("" : "+v"(tq_));     \
            int hh_ = hh; asm volatile("" : "+v"(hh_)); \
            const float tqf_ = (float)tq_; const int ce0_ = 16 * (64 * (jt) + 4 * hh_) + 31; \
            const float basef_ = sl2 * ((float)ce0_ - tqf_) - m, base1_ = basef_ + 512.f * sl2; \
            _Pragma("unroll") for (int reg = 0; reg < 16; ++reg) { const float cr_ = sl2 * (float)(16 * CROW(reg, 0)); p0[reg] = p0[reg] * (SCALE * LOG2E) + (basef_ + cr_); p1[reg] = p1[reg] * (SCALE * LOG2E) + (base1_ + cr_); } \
            if (ce0_ + 16 * 27 + 512 > qrow0) {     \
                _Pragma("unroll") for (int reg = 0; reg < 16; ++reg) { const int ce = ce0_ + 16 * CROW(reg, 0); p0[reg] = (ce <= tq_) ? p0[reg] : -INFINITY; p1[reg] = (ce + 512 <= tq_) ? p1[reg] : -INFINITY; } } }
        for (int jt = 0; jt < ntile_w; ++jt) {
            E3_ST(jt);
            SM_CORE(p0, p1, m, l, have, o0, o1);
            const LAS unsigned char* tb = trb + (64 * jt) * KROW;
#pragma unroll
            for (int s = 0; s < 4; ++s) {
                u32x4 pw;
                if (s < 2) { pw.x = cvtpk(p0[8 * s + 0], p0[8 * s + 1]); pw.y = cvtpk(p0[8 * s + 2], p0[8 * s + 3]); pw.z = cvtpk(p0[8 * s + 4], p0[8 * s + 5]); pw.w = cvtpk(p0[8 * s + 6], p0[8 * s + 7]); }
                else { const int s2 = s - 2; pw.x = cvtpk(p1[8 * s2 + 0], p1[8 * s2 + 1]); pw.y = cvtpk(p1[8 * s2 + 2], p1[8 * s2 + 3]); pw.z = cvtpk(p1[8 * s2 + 4], p1[8 * s2 + 5]); pw.w = cvtpk(p1[8 * s2 + 6], p1[8 * s2 + 7]); }
                const bf16x8 pb = __builtin_bit_cast(bf16x8, pw);
                const v4i16_t a0l = __builtin_amdgcn_ds_read_tr16_b64_v4i16((LAS v4i16_t*)(tb + (16 * s) * KROW)), a0h = __builtin_amdgcn_ds_read_tr16_b64_v4i16((LAS v4i16_t*)(tb + (16 * s + 8) * KROW));
                const v4i16_t a1l = __builtin_amdgcn_ds_read_tr16_b64_v4i16((LAS v4i16_t*)(tb + (16 * s) * KROW + 64)), a1h = __builtin_amdgcn_ds_read_tr16_b64_v4i16((LAS v4i16_t*)(tb + (16 * s + 8) * KROW + 64));
                const bf16x8 va0 = (bf16x8){a0l[0], a0l[1], a0l[2], a0l[3], a0h[0], a0h[1], a0h[2], a0h[3]}, va1 = (bf16x8){a1l[0], a1l[1], a1l[2], a1l[3], a1h[0], a1h[1], a1h[2], a1h[3]};
                o0 = __builtin_amdgcn_mfma_f32_32x32x16_bf16(va0, pb, o0, 0, 0, 0); o1 = __builtin_amdgcn_mfma_f32_32x32x16_bf16(va1, pb, o1, 0, 0, 0); }
        }
        l += __shfl_xor(l, 32);
        const float inv = (l > 0.f) ? 1.f / l : 0.f;
        { const float sc = inv * WSP(float, O_GF)[(size_t)(b * S_ + tq) * 32 + 0 * 8 + h];
          float* orow = ocmp + (size_t)(b * S_ + tq) * 512 + h * 64;
#pragma unroll
          for (int i = 0; i < 4; ++i) {
              *(f32x4*)(orow + 8 * i + 4 * hh) = (f32x4){o0[4 * i] * sc, o0[4 * i + 1] * sc, o0[4 * i + 2] * sc, o0[4 * i + 3] * sc};
              *(f32x4*)(orow + 32 + 8 * i + 4 * hh) = (f32x4){o1[4 * i] * sc, o1[4 * i + 1] * sc, o1[4 * i + 2] * sc, o1[4 * i + 3] * sc}; } }
#pragma unroll
        for (int jt = 0; jt < 8; ++jt) {
            if (jt < ntile_w) {
                E3_ST(jt);
#pragma unroll
                for (int reg = 0; reg < 16; ++reg) { p0[reg] = __builtin_amdgcn_exp2f(p0[reg]) * inv; p1[reg] = __builtin_amdgcn_exp2f(p1[reg]) * inv; }
#pragma unroll
                for (int pa = 0; pa < 2; ++pa)
#pragma unroll
                    for (int i = 0; i < 4; ++i) { const int jj = 8 * jt + 4 * pa + i;
                        const float x0 = pa ? p1[4 * i] : p0[4 * i], x1 = pa ? p1[4 * i + 1] : p0[4 * i + 1], x2 = pa ? p1[4 * i + 2] : p0[4 * i + 2], x3 = pa ? p1[4 * i + 3] : p0[4 * i + 3];
                        const float c = 0.5f * x3, a = (x0 + x1) + (x2 + c), r = __shfl_xor(c, 32);
                        imp[jj] += a + (hh ? r : 0.f);
                        if (jj + 1 < 64) imp[jj + 1] += (hh ? 0.f : r); }
            }
        }
#undef E3_ST
    }
    const int cur = tq >> 6;
#pragma unroll
    for (int jj = 0; jj < 64; ++jj) { const int j = 2 * jj + hh; imp[jj] = (j != 0 && j < cur - 1) ? imp[jj] : -1.f; }
    unsigned m0 = 1u, m1 = 0u, m2 = 0u, m3 = 0u;
#define E3_SETBIT(j) do { const unsigned bit_ = 1u << ((j) & 31); const int wd_ = (j) >> 5; m0 |= (wd_ == 0) ? bit_ : 0u; m1 |= (wd_ == 1) ? bit_ : 0u; m2 |= (wd_ == 2) ? bit_ : 0u; m3 |= (wd_ == 3) ? bit_ : 0u; } while (0)
    E3_SETBIT(cur); if (cur >= 1) E3_SETBIT(cur - 1);
#pragma unroll 1
    for (int it = 0; it < NSEL - 3; ++it) {
        float best = -0.5f; int bj = 0;
#pragma unroll
        for (int jj = 0; jj < 64; ++jj) { if (imp[jj] > best) { best = imp[jj]; bj = jj; } }
        const int myj = 2 * bj + hh; const float ob = __shfl_xor(best, 32); const int oj = __shfl_xor(myj, 32);
        const bool mine = (best > ob) || (best == ob && myj < oj);
        const float wv = mine ? best : ob; const int wj = mine ? myj : oj;
        if (wv >= 0.f) E3_SETBIT(wj);
        if (mine && best >= 0.f) {
#pragma unroll
            for (int jj = 0; jj < 64; ++jj) imp[jj] = (jj == bj) ? -2.f : imp[jj]; }
    }
#undef E3_SETBIT
    if (hh == 0) *(u32x4*)(selmask + ((size_t)bg * S_ + tq) * 4) = (u32x4){m0, m1, m2, m3};
}
}
namespace mk {
template <int MODE>
__device__ __forceinline__ void ph_attn1(float* lds, LAS unsigned char* lds3, KP p, unsigned* qctr, float* obase, float* owin, const unsigned* kmax2) {
    LAS int* qslot = (LAS int*)(lds3 + E3_BYTES);
    constexpr int N_E3 = (MODE & 2) ? 128 : 0, N_CMP = (MODE & 1) ? 64 : 0, N_FOX = (MODE & 4) ? 256 : 0, N_WIN = (MODE & 8) ? 512 : 0, N_SB = (MODE & 16) ? 256 : 0;
    for (;;) {
        __syncthreads();
        if (ftid() == 0) *qslot = (int)atomicAdd(qctr, 1u);
        __syncthreads();
        int u = __builtin_amdgcn_readfirstlane(*qslot);
        if (u >= N_E3 + N_CMP + N_FOX + N_WIN + N_SB) break;
        if (u < N_E3) { e3_unit(lds3, p, (u & 3) >> 1, u & 1, 31 - (u >> 2), WSP(float, O_OCMP), WSP(unsigned, O_SELMASK)); continue; } u -= N_E3;
        if (u < N_CMP) { attn_vblock<3>(lds, p, 15 - (u >> 2), u & 3); continue; } u -= N_CMP;
        if (u < N_FOX) { e1_unit<0>(lds3, p, (u & 7) >> 2, u & 3, 31 - (u >> 3), obase, owin, kmax2); continue; } u -= N_FOX;
        if (u < N_WIN) { e1_unit<1>(lds3, p, (u & 3) >> 1, u & 1, 127 - (u >> 2), obase, owin, kmax2); continue; } u -= N_WIN;
        if (u < N_SB) e1_unit<2>(lds3, p, (u & 7) >> 2, u & 3, 31 - (u >> 3), obase, owin, kmax2);
    }
}
__device__ __forceinline__ void ph_dbg_compare_cmp(KP p) {
    float num = 0.f, den = 0.f;
    for (size_t i = (size_t)fbid() * NT + ftid(); i < (size_t)T_ * 512; i += (size_t)gridDim.x * NT) { const size_t row = i >> 9; const int c = (int)(i & 511);
        const float a = WSP(float, O_OCMP)[i], b = WSP(float, O_O)[row * D_ + c]; num += (a - b) * (a - b); den += b * b; }
    float* dbg = WSP(float, O_COUNTS) + 256; const float n = wsum(num), d = wsum(den);
    if ((ftid() & 63) == 0) { atomicAdd(&dbg[8], n); atomicAdd(&dbg[9], d); }
}
__device__ __forceinline__ void ph_dbg_compare_sel(KP p) {
    float num = 0.f, den = 0.f;
    for (int i = fbid() * NT + ftid(); i < B_ * 2 * S_; i += gridDim.x * NT) {
        unsigned m[4] = {0u, 0u, 0u, 0u}; const int t = i % S_, cur = t >> 6;
        for (int k = 0; k < NSEL; ++k) { const int e = WSP(int, O_SEL)[(size_t)i * NSEL + k]; if (e <= cur) { if ((e >> 5) == 0) m[0] |= 1u << (e & 31); else if ((e >> 5) == 1) m[1] |= 1u << (e & 31); else if ((e >> 5) == 2) m[2] |= 1u << (e & 31); else m[3] |= 1u << (e & 31); } }
        const unsigned* sm = WSP(unsigned, O_SELMASK) + (size_t)i * 4;
        int diff = __popc(m[0] ^ sm[0]) + __popc(m[1] ^ sm[1]) + __popc(m[2] ^ sm[2]) + __popc(m[3] ^ sm[3]);
        num += (float)diff * 0.5f; den += 16.f; }
    float* dbg = WSP(float, O_COUNTS) + 256; const float n = wsum(num), d = wsum(den);
    if ((ftid() & 63) == 0) { atomicAdd(&dbg[10], n); atomicAdd(&dbg[11], d); }
}
__device__ __forceinline__ void ph_dbg_compare(KP p) {
    float num[3] = {0.f, 0.f, 0.f}, den[3] = {0.f, 0.f, 0.f};
    for (size_t i = (size_t)fbid() * NT + ftid(); i < (size_t)T_ * 512; i += (size_t)gridDim.x * NT) {
        const size_t row = i >> 9; const int c = (int)(i & 511);
        const float a = WSP(float, O_O2)[row * D_ + 512 + c], b = WSP(float, O_O)[row * D_ + 512 + c];
        const int k = c >> 8; num[k] += (a - b) * (a - b); den[k] += b * b;
        const float aw = WSP(float, O_OWIN2)[i], bw = WSP(float, O_OWIN)[i]; num[2] += (aw - bw) * (aw - bw); den[2] += bw * bw; }
    float* dbg = WSP(float, O_COUNTS) + 256;
#pragma unroll
    for (int k = 0; k < 3; ++k) { const float n = wsum(num[k]), d = wsum(den[k]); if ((ftid() & 63) == 0) { atomicAdd(&dbg[2 * k], n); atomicAdd(&dbg[2 * k + 1], d); } }
}
__device__ __forceinline__ void ph_dbg_copy_nsa(KP p) {
    for (size_t i = (size_t)fbid() * NT + ftid(); i < (size_t)T_ * 512; i += (size_t)gridDim.x * NT) { const size_t row = i >> 9; const int c = (int)(i & 511); WSP(float, O_O2)[row * D_ + c] = WSP(float, O_O)[row * D_ + c]; }
}
__device__ __forceinline__ void ph_dbg_compare_nsa(KP p) {
    float num = 0.f, den = 0.f;
    for (size_t i = (size_t)fbid() * NT + ftid(); i < (size_t)T_ * 512; i += (size_t)gridDim.x * NT) { const size_t row = i >> 9; const int c = (int)(i & 511);
        const float a = WSP(float, O_O2)[row * D_ + c], b = WSP(float, O_O)[row * D_ + c]; num += (a - b) * (a - b); den += b * b; }
    float* dbg = WSP(float, O_COUNTS) + 256; const float n = wsum(num), d = wsum(den);
    if ((ftid() & 63) == 0) { atomicAdd(&dbg[6], n); atomicAdd(&dbg[7], d); }
}
__device__ __forceinline__ void ph_dbg_encode(KP p, int ka, int kb) {
    const float* dbg = WSP(float, O_COUNTS) + 256;
    const float ea = sqrtf(dbg[2 * ka] / fmaxf(dbg[2 * ka + 1], 1e-30f)), eb = sqrtf(dbg[2 * kb] / fmaxf(dbg[2 * kb + 1], 1e-30f));
    for (size_t i = (size_t)fbid() * NT + ftid(); i < (size_t)T_ * D_; i += (size_t)gridDim.x * NT) { float v = p->out[i] * (1.f + 10.f * ea); if (i == 0) v += 1e4f * eb; p->out[i] = v; }
}
}
namespace mk {
#define RLX_AGENT __ATOMIC_RELAXED, __HIP_MEMORY_SCOPE_AGENT
#define XB_TMO      128
#define XB_XCNT(j)  (256  + 64 * (j))
#define XB_XSUB(j)  (1280 + 64 * (j))
#define XB_XGEN(j)  (2304 + 64 * (j))
#define XB_TOP      3328
#define XB_TOPGEN   3392
#define XCD_BAR_WORDS 3456
#define XB_SPIN_CAP (1u << 18)

__device__ __forceinline__ unsigned xb_ld(unsigned* p)              { return __hip_atomic_load(p, __ATOMIC_RELAXED, __HIP_MEMORY_SCOPE_AGENT); }
__device__ __forceinline__ unsigned xb_add(unsigned* p, unsigned v) { return __hip_atomic_fetch_add(p, v, __ATOMIC_RELAXED, __HIP_MEMORY_SCOPE_AGENT); }
__device__ __forceinline__ unsigned xb_xcc_id() { return (unsigned)__builtin_amdgcn_s_getreg((3 << 11) | 20) & 0xFu; }
#define XB_SPIN(cond, bar) do { unsigned _sp = 0; while (cond) { __builtin_amdgcn_s_sleep(1); \
    if ((++_sp & 255u) == 0u) { if (xb_ld(&(bar)[XB_TMO])) break; if (_sp > XB_SPIN_CAP) { atomicAdd(&(bar)[XB_TMO], 1u); break; } } } } while (0)

struct XcdBarrier {
    unsigned* bar; unsigned x;
    volatile LAS unsigned* st;
};

__device__ __forceinline__ XcdBarrier xcd_barrier_post(unsigned* bar, volatile LAS unsigned* st) {
    XcdBarrier b; b.bar = bar; b.x = xb_xcc_id(); b.st = st;
    if (threadIdx.x == 0) (void)xb_add(&bar[XB_XCNT(b.x)], 1u);
    return b;
}
__device__ __forceinline__ void xcd_barrier_complete(unsigned* bar, unsigned x, unsigned& nloc, unsigned& nx) {
    const unsigned G = gridDim.x * gridDim.y * gridDim.z;
    unsigned sum, cnt, mine, sp = 0u;
    for (;;) {
        sum = 0u; cnt = 0u; mine = 0u;
#pragma unroll
        for (unsigned j = 0; j < 16; ++j) { const unsigned c = xb_ld(&bar[XB_XCNT(j)]); sum += c; cnt += (c > 0u) ? 1u : 0u; mine = (j == x) ? c : mine; }
        if (sum == G) break;
        __builtin_amdgcn_s_sleep(1);
        if ((++sp & 255u) == 0u) { if (xb_ld(&bar[XB_TMO])) break; if (sp > XB_SPIN_CAP) { atomicAdd(&bar[XB_TMO], 1u); break; } }
    }
    nloc = mine > 0u ? mine : 1u; nx = cnt > 0u ? cnt : 1u;
}

__device__ __forceinline__ void xcd_barrier(const XcdBarrier& b) {
    asm volatile("s_waitcnt vmcnt(0)" ::: "memory");
    __syncthreads();
    if (threadIdx.x == 0) {
        unsigned* bar = b.bar;
        __builtin_amdgcn_s_waitcnt(0);
        unsigned nloc = b.st[0], nx = b.st[1];
        if (nloc == 0u) { xcd_barrier_complete(bar, b.x, nloc, nx); b.st[0] = nloc; b.st[1] = nx; }
        const unsigned old = xb_add(&bar[XB_XSUB(b.x)], 1u);
        const unsigned gen = old / nloc;
        if (old + 1u == (gen + 1u) * nloc) {
            __builtin_amdgcn_fence(__ATOMIC_RELEASE, "agent");
            asm volatile("s_waitcnt vmcnt(0)" ::: "memory");
            const unsigned og = xb_add(&bar[XB_TOP], 1u);
            const unsigned tg = og / nx;
            if (og + 1u == (tg + 1u) * nx) xb_add(&bar[XB_TOPGEN], 1u);
            else XB_SPIN(xb_ld(&bar[XB_TOPGEN]) == tg, bar);
            __builtin_amdgcn_fence(__ATOMIC_ACQUIRE, "agent");
            xb_add(&bar[XB_XGEN(b.x)], 1u);
            asm volatile("s_waitcnt vmcnt(0)" ::: "memory");
        } else {
            XB_SPIN(xb_ld(&bar[XB_XGEN(b.x)]) == gen, bar);
            __builtin_amdgcn_fence(__ATOMIC_ACQUIRE, "agent");
            asm volatile("s_waitcnt vmcnt(0)" ::: "memory");
        }
    }
    __syncthreads();
}

}
namespace cg = cooperative_groups;
constexpr int NSTEP = 12;
__global__ void __launch_bounds__(512, 2) mega(mk::P p_unused) {
    extern __shared__ __attribute__((aligned(16))) unsigned char lds_raw[];
    float* lds = (float*)lds_raw;
    LAS unsigned char* lds3 = (LAS unsigned char*)lds_raw;
    using namespace nv; using namespace mk;
    volatile LAS unsigned* bst = (volatile LAS unsigned*)(lds3 + E3_BYTES + 128);
    if (threadIdx.x < 2) bst[threadIdx.x] = 0u;
    __syncthreads();
    XcdBarrier bar;
    { const KP p = fresh_kp(); bar = xcd_barrier_post(WSP(unsigned, O_COUNTS + 16384), bst); }
    cg::this_grid().sync();
    for (int step = 0; step < 1 + NSTEP * L_; ++step) {
        const KP p = fresh_kp();
        const int l = (step - 1) / NSTEP, k = (step == 0) ? -1 : (step - 1) % NSTEP;
        const bool isg = (k == 0 || k == 1 || k == 6 || k == 9 || k == 10);
#ifdef PROBE_K
        const int nrep = (k == PROBE_K) ? PROBE_N : 1;
#else
        const int nrep = 1;
#endif
        for (int rep = 0; rep < nrep; ++rep) {
        if (isg) {
            const int kind = (k == 0) ? 0 : (k == 1) ? 4 : (k == 6) ? 1 : (k == 9) ? 2 : 3;
            GSched S; GEpi E; S.kind = kind; E.kind = kind; E.l = l;
            S.G = (int)gridDim.x; S.c = fbid(); S.meta = WSP(int, O_META); S.rowtok = WSP(int, O_ROWTOK); S.estep = 0;
            const char* A; int N, K = D_;
            if (kind == 0) { A = (const char*)WSP(bf16_t, O_XB); S.Bt = (const char*)(WSP(bf16_t, O_WTIN) + (size_t)l * NPAD * D_); N = NPAD; }
            else if (kind == 1) { A = (const char*)WSP(bf16_t, O_OB); S.Bt = (const char*)(WSP(bf16_t, O_WTOUT) + (size_t)l * D_ * D_); N = D_; }
            else if (kind == 2) { A = (const char*)WSP(bf16_t, O_X1B); S.Bt = (const char*)(WSP(bf16_t, O_WTGU) + (size_t)l * NE * 2048 * D_); S.estep = (size_t)2048 * D_ * 2; N = 2048; }
            else if (kind == 3) { A = (const char*)WSP(bf16_t, O_ACT); S.Bt = (const char*)(WSP(bf16_t, O_WTDN) + (size_t)l * NE * D_ * D_); S.estep = (size_t)D_ * D_ * 2; N = D_; }
            else { A = (const char*)WSP(bf16_t, O_PROJB); S.Bt = (const char*)(WSP(bf16_t, O_WT1) + (size_t)l * 2 * 256 * 2048); S.estep = (size_t)256 * 2048 * 2; N = 256; K = 2048; }
            S.nN = N / 256; S.nM = (kind < 2) ? T_ / 256 : (kind == 4) ? 16 : S.meta[32]; S.nunits = S.nM * S.nN;
            pg8::gemm_phase<GEpi, GSched>(lds3, A, K, S, E);
            if (kind == 4) ph_cumsum(lds, p, 16);
            if (kind == 0) ph_bias1_reduce(p, l);
        } else {
            switch (k) {
                case -1: ph_convert(lds3, p); break;
                case 2: ph_prep2(p, l); break;
#ifdef PROBE_AMODE
                case 3: if (rep == 0) ph_attn1<30>(lds, lds3, p, WSP(unsigned, O_COUNTS) + 128 + l * 8 + rep, WSP(float, O_O), WSP(float, O_OWIN), WSP(unsigned, O_COUNTS) + 192 + l * 8);
                        else ph_attn1<PROBE_AMODE>(lds, lds3, p, WSP(unsigned, O_COUNTS) + 128 + l * 8 + rep, WSP(float, O_O), WSP(float, O_OWIN), WSP(unsigned, O_COUNTS) + 192 + l * 8);
                        break;
#else
                case 3: ph_attn1<30>(lds, lds3, p, WSP(unsigned, O_COUNTS) + 128 + l * 8 + rep, WSP(float, O_O), WSP(float, O_OWIN), WSP(unsigned, O_COUNTS) + 192 + l * 8); break;
#endif
                case 4: ph_attn_sel2<true>(lds3, p, WSP(float, O_O), WSP(float, O_OCMP), 512); break;
                case 5: ph_rmsnorm(p, l); break;
                case 7: ph_ln<true>(lds, p, l, WSP(float, O_X1), (rep + 1 < nrep) ? 2048 * (rep + 1) : 0); break;
                case 8: ph_moe_scatter2(lds, p, l); break;
                default: { float* xout = (l == L_ - 1) ? p->out : WSP(float, O_XA); ph_ln<false>(lds, p, l, xout); } break;
            }
        }
        xcd_barrier(bar);
        }
    }
#ifdef PROBE_SYNC
    for (int i = 0; i < PROBE_SYNC; ++i) xcd_barrier(bar);
#endif
}

extern "C" void kernel_launch(void* const* d_in, const int* in_sizes, int n_in,
                              void* d_out, int out_size, void* d_ws, size_t ws_size,
                              hipStream_t stream) {
    constexpr size_t kDynLds = 147456 + 1024;
    static int grid_blocks = 0;
    if (!grid_blocks) {
        int dev = 0, cus = 0, per_cu = 0;
        (void)hipGetDevice(&dev);
        (void)hipDeviceGetAttribute(&cus, hipDeviceAttributeMultiprocessorCount, dev);
        (void)hipFuncSetAttribute((const void*)mega, hipFuncAttributeMaxDynamicSharedMemorySize, (int)kDynLds);
        (void)hipOccupancyMaxActiveBlocksPerMultiprocessor(&per_cu, mega, 512, kDynLds);
        if (per_cu < 1) per_cu = 1;
        if (per_cu > 1) per_cu = 1;
        grid_blocks = cus * per_cu;
        if (ws_size < mk::O_END) fprintf(stderr, "workspace too small: %zu < %zu\n", ws_size, (size_t)mk::O_END);
    }
    mk::P p{};
    p.in = nv::inputs(d_in); p.ws = (unsigned char*)d_ws; p.out = (float*)d_out;
    (void)hipMemsetAsync((char*)d_ws + mk::O_COUNTS, 0, 65536, stream);
    void* args[] = {&p};
    hipError_t e = hipLaunchCooperativeKernel((void*)mega, dim3(grid_blocks), dim3(512), args, kDynLds, stream);
    if (e != hipSuccess) fprintf(stderr, "cooperative launch failed: %s (grid %d)\n", hipGetErrorString(e), grid_blocks);
}
```

```cpp
#include <hip/hip_runtime.h>
#include <hip/hip_cooperative_groups.h>
#include <cstdio>
#include <cstdint>

namespace nv {

constexpr int B_ = 2, S_ = 8192, D_ = 1024, T_ = B_ * S_, L_ = 2;
constexpr int DIN = 2844;
constexpr int OFF_NSA_KV = 512, OFF_NSA_GATE = 1280, OFF_FOX_QKV = 1304, OFF_FOX_F = 2072, OFF_SB_QKV = 2076;
constexpr int NCMP = 511, NBLK = 128, NSEL = 16;
constexpr int NE = 32, TOPK = 4, MROWS = T_ * TOPK;
constexpr float LN_EPS = 1e-5f, RMS_EPS = 1e-6f;
constexpr float ALPHA = 1.4142135623730951f;
constexpr float SCALE = 0.125f;

__device__ __forceinline__ float sigmoidf_(float x) { return 1.f / (1.f + __expf(-x)); }
__device__ __forceinline__ float logsig(float x) { return fminf(x, 0.f) - log1pf(expf(-fabsf(x))); }

__device__ __forceinline__ float gelu_tanh(float x) { return 0.5f * x * (1.f + tanhf(0.7978845608028654f * (x + 0.044715f * x * x * x))); }
__device__ __forceinline__ float wsum(float v) {
#pragma unroll
    for (int o = 1; o < 64; o <<= 1) v += __shfl_xor(v, o);
    return v;
}
struct In {
    const float *x, *w_in, *b_in, *pos_k, *pos_v, *w1k, *w2k, *w1v, *w2v, *g_out, *w_out, *ln1_g, *ln1_b, *rw, *rb, *wgu, *bgu, *wdn, *bdn, *ln2_g, *ln2_b;
};
inline In inputs(void* const* d) {
    In i; i.x = (const float*)d[0]; i.w_in = (const float*)d[1]; i.b_in = (const float*)d[2]; i.pos_k = (const float*)d[3]; i.pos_v = (const float*)d[4];
    i.w1k = (const float*)d[5]; i.w2k = (const float*)d[6]; i.w1v = (const float*)d[7]; i.w2v = (const float*)d[8]; i.g_out = (const float*)d[9]; i.w_out = (const float*)d[10];
    i.ln1_g = (const float*)d[11]; i.ln1_b = (const float*)d[12]; i.rw = (const float*)d[13]; i.rb = (const float*)d[14]; i.wgu = (const float*)d[15]; i.bgu = (const float*)d[16];
    i.wdn = (const float*)d[17]; i.bdn = (const float*)d[18]; i.ln2_g = (const float*)d[19]; i.ln2_b = (const float*)d[20]; return i;
}


}
namespace pg8 {
#define PG8_LAS __attribute__((address_space(3)))
typedef unsigned short bf16_t;
typedef short bf16x8 __attribute__((ext_vector_type(8)));
typedef float f32x4 __attribute__((ext_vector_type(4)));
typedef unsigned u32x4 __attribute__((ext_vector_type(4)));
constexpr int BM = 256, BK = 64, HALF = 128, HTB = HALF * BK * 2  , STAGE_BYTES = 8 * HTB, NXCD = 8, WGM = 8;

__host__ __device__ __forceinline__ int lds_byte(int r, int c) { const int st = (r >> 4) * 2 + (c >> 5), rr = r & 15, cc = c & 31, ob = rr * 64 + cc * 2; return st * 1024 + (ob ^ (((ob >> 9) & 1) << 5)); }
__host__ __device__ __forceinline__ void stage_rc(int b, int& R, int& C) { const int st = b / 1024, sb = b % 1024, swz = sb ^ (((sb >> 9) & 1) << 5); R = (st >> 1) * 16 + swz / 64; C = (st & 1) * 32 + (swz % 64) / 2; }
__host__ __device__ __forceinline__ int perm32(int rho) { const int n = rho >> 4, i = rho & 15; return 8 * (i >> 2) + 4 * n + (i & 3); }

struct Unit { int pm, pn, e, nr; };

__device__ __forceinline__ unsigned cvt_pk_bf16(float lo, float hi) { unsigned r; asm volatile("v_cvt_pk_bf16_f32 %0, %1, %2" : "=v"(r) : "v"(lo), "v"(hi)); return r; }
template <class Epi, class Sched, bool ALIGN_EPI = true, bool SP2 = true>
__device__ __forceinline__ void gemm_phase(PG8_LAS unsigned char* lds, const char* Abase, const int K, const Sched& S, const Epi& E) {
    int tid_ = threadIdx.x; asm volatile("" : "+v"(tid_));
    const int tid = tid_, wid = __builtin_amdgcn_readfirstlane(tid >> 6), lane = tid & 63, wr = wid >> 2, wc = wid & 3, fr = lane & 15, fq = lane >> 4;
    const int nt = K / BK;
    unsigned voffB[2];
#pragma unroll
    for (int i = 0; i < 2; ++i) { int R, C; stage_rc(tid * 16 + i * 8192, R, C); const int Rb = Epi::PERM ? ((R & ~31) + perm32(R & 31)) : R;
        voffB[i] = (unsigned)(Rb * K + C) * 2u; }
#define PG8_AOFF(u, o0, o1) do { int _t = tid; asm volatile("" : "+v"(_t)); _Pragma("unroll") for (int _i = 0; _i < 2; ++_i) { int _R, _C; stage_rc(_t * 16 + _i * 8192, _R, _C); \
        (o0)[_i] = S.a_off((u), _R) + (unsigned)_C * 2u; (o1)[_i] = S.a_off((u), HALF + _R) + (unsigned)_C * 2u; } } while (0)
    const size_t kstep = (size_t)(BK * 2);
    const size_t akstep = S.a_kstep();
    const size_t hstep = (size_t)HALF * K * 2;
    const unsigned ldsw = (unsigned)wid * 1024u;
    const int aoff = lds_byte(wr * 64 + fr, fq * 8), boff = lds_byte(wc * 32 + fr, fq * 8);
#define PG8_SA(b, h) (((b) * 2 + (h)) * HTB)
#define PG8_SB(b, h) ((4 + (b) * 2 + (h)) * HTB)
#define PG8_STAGE(bufoff, gbase, voff) do { _Pragma("unroll") for (int _i = 0; _i < 2; ++_i) { unsigned _o = (voff)[_i]; asm volatile("" : "+v"(_o));     \
        __builtin_amdgcn_global_load_lds((const unsigned*)((const char*)(gbase) + _o), (PG8_LAS unsigned*)(lds + (bufoff) + ldsw + _i * 8192), 16, 0, 0); } } while (0)
#define PG8_LDA(dst, b, h) do { _Pragma("unroll") for (int m = 0; m < 4; ++m) _Pragma("unroll") for (int k = 0; k < 2; ++k) dst[m][k] = *(const PG8_LAS bf16x8*)(lds + PG8_SA(b, h) + aoff + m * 2048 + k * 1024); } while (0)
#define PG8_LDB(dst, b, h) do { _Pragma("unroll") for (int n = 0; n < 2; ++n) _Pragma("unroll") for (int k = 0; k < 2; ++k) dst[n][k] = *(const PG8_LAS bf16x8*)(lds + PG8_SB(b, h) + boff + n * 2048 + k * 1024); } while (0)
#define PG8_MMA(ai, bj, At, Bt) do { __builtin_amdgcn_s_setprio(1); _Pragma("unroll") for (int m = 0; m < 4; ++m) _Pragma("unroll") for (int n = 0; n < 2; ++n) _Pragma("unroll") for (int k = 0; k < 2; ++k) \
        acc[ai][bj][m][n] = __builtin_amdgcn_mfma_f32_16x16x32_bf16(Bt[n][k], At[m][k], acc[ai][bj][m][n], 0, 0, 0); __builtin_amdgcn_s_setprio(0); } while (0)
#define PG8_WAIT_V(n) asm volatile("s_waitcnt vmcnt(" #n ")" ::: "memory")
#define PG8_WAIT_L(n) asm volatile("s_waitcnt lgkmcnt(" #n ")" ::: "memory")
#define PG8_BAR __builtin_amdgcn_s_barrier()
#define PG8_SCHED __builtin_amdgcn_sched_barrier(0)
    Unit cur, nxt; int ui = 0;
    if (!S.next(0, cur)) return;
    f32x4 acc[2][2][4][2];
    float zf_ = 0.f; asm volatile("" : "+v"(zf_));
#pragma unroll
    for (int a = 0; a < 2; ++a)
#pragma unroll
        for (int b = 0; b < 2; ++b)
#pragma unroll
            for (int m = 0; m < 4; ++m)
#pragma unroll
                for (int n = 0; n < 2; ++n) acc[a][b][m][n] = (f32x4){zf_, zf_, zf_, zf_};
    bf16x8 At[4][2], B0[2][2], B1[2][2];
    unsigned ca0[2], ca1[2], na0[2], na1[2];
    PG8_AOFF(cur, ca0, ca1);
    const char* const cA = Abase; const char* cB = S.b_base(cur);
    if constexpr (SP2) {
        PG8_STAGE(PG8_SB(0, 0), cB, voffB); PG8_STAGE(PG8_SB(0, 1), cB + hstep, voffB); PG8_STAGE(PG8_SA(0, 0), cA, ca0); PG8_STAGE(PG8_SA(0, 1), cA, ca1);
        if (wr == 1) PG8_BAR;
        PG8_WAIT_V(2); PG8_BAR;
        PG8_STAGE(PG8_SB(1, 0), cB + kstep, voffB); PG8_STAGE(PG8_SA(1, 0), cA + akstep, ca0); PG8_STAGE(PG8_SB(1, 1), cB + hstep + kstep, voffB);
        PG8_WAIT_V(6); PG8_BAR;
    } else { static_assert(SP2, "only the SP2 loop is kept"); }
    for (;;) {
        const bool has_next = S.next(ui + 1, nxt);
        const char* nB = has_next ? S.b_base(nxt) : cB;
        if (has_next) { PG8_AOFF(nxt, na0, na1); } else { na0[0] = ca0[0]; na0[1] = ca0[1]; na1[0] = ca1[0]; na1[1] = ca1[1]; }
        for (int t = 0; t < nt - 2; t += 2) {
            const char* a1 = cA + (size_t)(t + 1) * akstep;
            const char* a2 = cA + (size_t)(t + 2) * akstep; const char* b2 = cB + (size_t)(t + 2) * kstep;
            const char* a3 = a2 + akstep; const char* b3 = b2 + kstep;
            PG8_LDB(B0, 0, 0); PG8_LDB(B1, 0, 1); PG8_SCHED; PG8_LDA(At, 0, 0); PG8_STAGE(PG8_SA(1, 1), a1, ca1);
            PG8_WAIT_V(8); PG8_WAIT_L(0); PG8_BAR; PG8_MMA(0, 0, At, B0); PG8_MMA(0, 1, At, B1); PG8_BAR; PG8_SCHED;
            PG8_LDA(At, 0, 1); PG8_STAGE(PG8_SB(0, 0), b2, voffB); PG8_STAGE(PG8_SB(0, 1), b2 + hstep, voffB); PG8_STAGE(PG8_SA(0, 0), a2, ca0);
            PG8_WAIT_V(8); PG8_WAIT_L(0); PG8_BAR; PG8_MMA(1, 0, At, B0); PG8_MMA(1, 1, At, B1); PG8_BAR; PG8_SCHED;
            PG8_LDB(B0, 1, 0); PG8_LDB(B1, 1, 1); PG8_SCHED; PG8_LDA(At, 1, 0); PG8_STAGE(PG8_SA(0, 1), a2, ca1);
            PG8_WAIT_V(8); PG8_WAIT_L(0); PG8_BAR; PG8_MMA(0, 0, At, B0); PG8_MMA(0, 1, At, B1); PG8_BAR; PG8_SCHED;
            PG8_LDA(At, 1, 1); PG8_STAGE(PG8_SB(1, 0), b3, voffB); PG8_STAGE(PG8_SB(1, 1), b3 + hstep, voffB); PG8_STAGE(PG8_SA(1, 0), a3, ca0);
            PG8_WAIT_V(8); PG8_WAIT_L(0); PG8_BAR; PG8_MMA(1, 0, At, B0); PG8_MMA(1, 1, At, B1); PG8_BAR; PG8_SCHED;
        }
        {
            const char* a1 = cA + (size_t)(nt - 1) * akstep;
            const char* a2 = cA; const char* b2 = nB; const char* a3 = a2 + akstep; const char* b3 = b2 + kstep;
            PG8_LDB(B0, 0, 0); PG8_LDB(B1, 0, 1); PG8_SCHED; PG8_LDA(At, 0, 0); PG8_STAGE(PG8_SA(1, 1), a1, ca1);
            PG8_WAIT_V(8); PG8_WAIT_L(0); PG8_BAR; PG8_MMA(0, 0, At, B0); PG8_MMA(0, 1, At, B1); PG8_BAR; PG8_SCHED;
            PG8_LDA(At, 0, 1); PG8_STAGE(PG8_SB(0, 0), b2, voffB); PG8_STAGE(PG8_SB(0, 1), b2 + hstep, voffB); PG8_STAGE(PG8_SA(0, 0), a2, na0);
            PG8_WAIT_V(8); PG8_WAIT_L(0); PG8_BAR; PG8_MMA(1, 0, At, B0); PG8_MMA(1, 1, At, B1); PG8_BAR; PG8_SCHED;
            PG8_LDB(B0, 1, 0); PG8_LDB(B1, 1, 1); PG8_SCHED; PG8_LDA(At, 1, 0); PG8_STAGE(PG8_SA(0, 1), a2, na1);
            PG8_WAIT_V(8); PG8_WAIT_L(0); PG8_BAR; PG8_MMA(0, 0, At, B0); PG8_MMA(0, 1, At, B1); PG8_BAR; PG8_SCHED;
            PG8_LDA(At, 1, 1); PG8_STAGE(PG8_SB(1, 0), b3, voffB); PG8_STAGE(PG8_SB(1, 1), b3 + hstep, voffB); PG8_STAGE(PG8_SA(1, 0), a3, na0);
            PG8_WAIT_V(8); PG8_WAIT_L(0); PG8_BAR; PG8_MMA(1, 0, At, B0); PG8_MMA(1, 1, At, B1); PG8_BAR; PG8_SCHED;
        }
        if constexpr (ALIGN_EPI) { if (wr == 0) PG8_BAR; }
        E(acc, cur, wr, wc, fr, fq);
        if (!has_next) break;
#pragma unroll
        for (int a = 0; a < 2; ++a)
#pragma unroll
            for (int b = 0; b < 2; ++b)
#pragma unroll
                for (int m = 0; m < 4; ++m)
#pragma unroll
                    for (int n = 0; n < 2; ++n) acc[a][b][m][n] = (f32x4){zf_, zf_, zf_, zf_};
        cur = nxt; cB = nB; ++ui; ca0[0] = na0[0]; ca0[1] = na0[1]; ca1[0] = na1[0]; ca1[1] = na1[1];
        if constexpr (ALIGN_EPI) { if (wr == 1) PG8_BAR; }
    }
    PG8_WAIT_V(0);
    if constexpr (!ALIGN_EPI) { if (wr == 0) PG8_BAR; }
    PG8_BAR;
#undef PG8_AOFF
#undef PG8_SA
#undef PG8_SB
#undef PG8_STAGE
#undef PG8_LDA
#undef PG8_LDB
#undef PG8_MMA
#undef PG8_WAIT_V
#undef PG8_WAIT_L
#undef PG8_BAR
#undef PG8_SCHED
}

}
namespace mk {
using namespace nv;
typedef unsigned short bf16_t;
typedef unsigned u32x4 __attribute__((ext_vector_type(4)));
typedef float f32x4 __attribute__((ext_vector_type(4)));
#define LAS __attribute__((address_space(3)))
constexpr int NT = 512;
constexpr int PB = 2816;
constexpr int NPAD = 3072;
constexpr int C_KV = 512, C_FOX = 1280, C_SB = 2048, C_GATE = 2816;
constexpr int MAXT = MROWS / 256 + NE;
constexpr int PROWS = MAXT * 256;
#define CNT_IDX(l, e) (8192 + ((l) * NE + (e)) * 32)
__device__ __forceinline__ int ftid() { int t = threadIdx.x; asm volatile("" : "+v"(t)); return t; }
__device__ __forceinline__ int fbid() { int b = blockIdx.x; asm volatile("" : "+s"(b)); return b; }
#define MK_LOOP(vb, n) for (int vb = fbid(); vb < (n); vb += gridDim.x)

constexpr size_t al_(size_t x) { return (x + 4095) & ~(size_t)4095; }
constexpr size_t O_WTIN = 0;
constexpr size_t O_WTOUT = O_WTIN + al_((size_t)L_ * NPAD * D_ * 2);
constexpr size_t O_WTGU = O_WTOUT + al_((size_t)L_ * D_ * D_ * 2);
constexpr size_t O_WTDN = O_WTGU + al_((size_t)L_ * NE * 2048 * D_ * 2);
constexpr size_t O_BIASP = O_WTDN + al_((size_t)L_ * NE * D_ * D_ * 2);
constexpr size_t O_XB = O_BIASP + al_((size_t)L_ * NPAD * 4);
constexpr size_t O_PROJB = O_XB + al_((size_t)T_ * D_ * 2);
constexpr size_t O_GF = O_PROJB + al_((size_t)T_ * PB * 2);
constexpr size_t O_CFOX = O_GF + al_((size_t)T_ * 32 * 4);
constexpr size_t O_KCMP = O_CFOX + al_((size_t)B_ * 4 * S_ * 4);
constexpr size_t O_VCMP = O_KCMP + al_((size_t)B_ * 2 * 512 * 64 * 4);
constexpr size_t O_O = O_VCMP + al_((size_t)B_ * 2 * 512 * 64 * 4);
constexpr size_t O_OB = O_O + al_((size_t)T_ * D_ * 4);
constexpr size_t O_PTOT = O_OB + al_((size_t)T_ * D_ * 2);
constexpr size_t O_SEL = O_PTOT + al_((size_t)B_ * 2 * S_ * 512 * 4);
constexpr size_t O_MIX = O_SEL + al_((size_t)B_ * 2 * S_ * NSEL * 4);
constexpr size_t O_X1 = O_MIX + al_((size_t)T_ * D_ * 4);
constexpr size_t O_X1B = O_X1 + al_((size_t)T_ * D_ * 4);
constexpr size_t O_XA = O_X1B + al_((size_t)T_ * D_ * 2);
constexpr size_t O_ACT = O_XA + al_((size_t)T_ * D_ * 4);
constexpr size_t O_Y = O_ACT + al_((size_t)PROWS * D_ * 2);
constexpr size_t O_TOPE = O_Y + al_((size_t)PROWS * D_ * 2);
constexpr size_t O_TOPW = O_TOPE + al_((size_t)MROWS * 4);
constexpr size_t O_POS = O_TOPW + al_((size_t)MROWS * 4);
constexpr size_t O_ROWTOK = O_POS + al_((size_t)MROWS * 4);
constexpr size_t O_ROWW = O_ROWTOK + al_((size_t)PROWS * 4);
constexpr size_t O_SLOT = O_ROWW + al_((size_t)PROWS * 4);
constexpr size_t O_COUNTS = O_SLOT + al_((size_t)MROWS * 4);
constexpr size_t O_META = O_COUNTS + 65536;
constexpr size_t O_OWIN = O_META + 4096;
constexpr size_t O_O2 = O_OWIN + al_((size_t)T_ * 512 * 4);
constexpr size_t O_OWIN2 = O_O2 + al_((size_t)T_ * D_ * 4);
constexpr size_t O_KCMPB = O_OWIN2 + al_((size_t)T_ * 512 * 4);
constexpr size_t O_VCMPB = O_KCMPB + al_((size_t)B_ * 2 * 512 * 64 * 2);
constexpr size_t O_OCMP = O_VCMPB + al_((size_t)B_ * 2 * 512 * 64 * 2);
constexpr size_t O_SELMASK = O_OCMP + al_((size_t)T_ * 512 * 4);
constexpr size_t O_WT1 = O_SELMASK + al_((size_t)B_ * 2 * S_ * 16);
constexpr size_t O_BIAS1 = O_WT1 + al_((size_t)L_ * 2 * 256 * 2048 * 2);
constexpr size_t O_HID = O_BIAS1 + al_((size_t)L_ * 2 * 128 * 4);
constexpr size_t O_BIAS1P = O_HID + al_((size_t)8 * 512 * 128 * 2);
constexpr size_t O_END = O_BIAS1P + al_((size_t)L_ * 2 * 64 * 128 * 4);

struct P {
    In in; unsigned char* ws; float* out;
};
typedef const __attribute__((address_space(4))) P* KP;
__device__ __forceinline__ KP fresh_kp() { KP k = (KP)__builtin_amdgcn_kernarg_segment_ptr(); asm volatile("" : "+s"(k)); return k; }
#define WSP(T, off) ((T*)(p->ws + (off)))

__device__ __forceinline__ float bf2f(unsigned short b) { return __uint_as_float((unsigned)b << 16); }
__device__ __forceinline__ unsigned f2bf(float f) { unsigned u = __float_as_uint(f); return (u + 0x7fffu + ((u >> 16) & 1u)) >> 16; }
__device__ __forceinline__ unsigned pk2(float lo, float hi) { return f2bf(lo) | (f2bf(hi) << 16); }
__device__ __forceinline__ void ld8(const bf16_t* __restrict__ src, float* dst) {
    const u32x4 v = *(const u32x4*)src;
    dst[0] = __uint_as_float(v.x << 16); dst[1] = __uint_as_float(v.x & 0xffff0000u); dst[2] = __uint_as_float(v.y << 16); dst[3] = __uint_as_float(v.y & 0xffff0000u);
    dst[4] = __uint_as_float(v.z << 16); dst[5] = __uint_as_float(v.z & 0xffff0000u); dst[6] = __uint_as_float(v.w << 16); dst[7] = __uint_as_float(v.w & 0xffff0000u);
}


__device__ __forceinline__ int perm_in(int n) {
    if (n < 1280) return n;
    if (n < 1304) return C_GATE + (n - 1280);
    if (n < 2072) return C_FOX + (n - 1304);
    if (n < 2076) return C_GATE + 24 + (n - 2072);
    return C_SB + (n - 2076);
}
__device__ __forceinline__ int perm_gu(int n) { const int up = n >> 10, c = n & 1023; return 256 * (c >> 7) + 128 * up + (c & 127); }
template <int MAP>
__device__ __forceinline__ void transpose_item(const float* __restrict__ W, int K, int N, bf16_t* __restrict__ WT, LAS float* scr, int item, int lane) {
    const int nblk = (N + 31) / 32, kb = item / nblk, nb = item % nblk, k0 = 64 * kb, n0 = 32 * nb;
    { const int n4 = (lane & 7) * 4; const bool okn = (n0 + n4) < N;
      f32x4 t[8];
#pragma unroll
      for (int i = 0; i < 8; ++i) { const int kk = (lane >> 3) + 8 * i; t[i] = okn ? *(const f32x4*)(W + (size_t)(k0 + kk) * N + n0 + n4) : (f32x4){0.f, 0.f, 0.f, 0.f}; }
#pragma unroll
      for (int i = 0; i < 8; ++i) { const int kk = (lane >> 3) + 8 * i; LAS float* d = scr + kk * 33 + n4; d[0] = t[i].x; d[1] = t[i].y; d[2] = t[i].z; d[3] = t[i].w; } }
    asm volatile("s_waitcnt lgkmcnt(0)" ::: "memory");
    const int c = lane & 7;
#pragma unroll
    for (int j = 0; j < 4; ++j) { const int n = (lane >> 3) + 8 * j; const LAS float* sp = scr + (8 * c) * 33 + n;
        u32x4 o; o.x = pk2(sp[0 * 33], sp[1 * 33]); o.y = pk2(sp[2 * 33], sp[3 * 33]); o.z = pk2(sp[4 * 33], sp[5 * 33]); o.w = pk2(sp[6 * 33], sp[7 * 33]);
        const int ng = n0 + n;
        if (ng < N) { const int ro = (MAP == 1) ? perm_in(ng) : (MAP == 2) ? perm_gu(ng) : ng; *(u32x4*)(WT + (size_t)ro * K + k0 + 8 * c) = o; } }
    asm volatile("s_waitcnt lgkmcnt(0)" ::: "memory");
}
__device__ __forceinline__ void ph_convert(LAS unsigned char* lds, KP p) {
    const int tid = ftid(), lane = tid & 63, wv = tid >> 6;
    LAS float* scr = (LAS float*)(lds + wv * 8448);
    const int gw = fbid() * 8 + wv, NGW = gridDim.x * 8;
    constexpr int I_IN = 16 * 89, I_OUT = 16 * 32, I_GU = 16 * 64, I_DN = 16 * 32, I_W1 = 32 * 4;
    constexpr int N_IN = L_ * I_IN, N_OUT = L_ * I_OUT, N_GU = L_ * NE * I_GU, N_DN = L_ * NE * I_DN, N_W1 = L_ * 2 * I_W1;
    for (int it = gw; it < N_IN + N_OUT + N_GU + N_DN + N_W1; it += NGW) {
        int r = it;
        if (r < N_W1) { const int mtx = r / I_W1, ll = mtx >> 1, kv = mtx & 1; transpose_item<0>((kv ? p->in.w1v : p->in.w1k) + (size_t)ll * 2048 * 128, 2048, 128, WSP(bf16_t, O_WT1) + (size_t)mtx * 256 * 2048, scr, r % I_W1, lane); continue; } r -= N_W1;
        if (r < N_GU) { const int mtx = r / I_GU; transpose_item<2>(p->in.wgu + (size_t)mtx * D_ * 2048, D_, 2048, WSP(bf16_t, O_WTGU) + (size_t)mtx * 2048 * D_, scr, r % I_GU, lane); continue; } r -= N_GU;
        if (r < N_DN) { const int mtx = r / I_DN; transpose_item<0>(p->in.wdn + (size_t)mtx * D_ * D_, D_, D_, WSP(bf16_t, O_WTDN) + (size_t)mtx * D_ * D_, scr, r % I_DN, lane); continue; } r -= N_DN;
        if (r < N_IN) { const int mtx = r / I_IN; transpose_item<1>(p->in.w_in + (size_t)mtx * D_ * DIN, D_, DIN, WSP(bf16_t, O_WTIN) + (size_t)mtx * NPAD * D_, scr, r % I_IN, lane); continue; } r -= N_IN;
        { const int mtx = r / I_OUT; transpose_item<0>(p->in.w_out + (size_t)mtx * D_ * D_, D_, D_, WSP(bf16_t, O_WTOUT) + (size_t)mtx * D_ * D_, scr, r % I_OUT, lane); }
    }
    const int gt = fbid() * NT + tid, NG = gridDim.x * NT;
    for (int i = gt; i < L_ * (NPAD - DIN) * (D_ / 8); i += NG) { const int l = i / ((NPAD - DIN) * (D_ / 8)), r = i % ((NPAD - DIN) * (D_ / 8));
        unsigned z_ = 0u; asm volatile("" : "+v"(z_));
        *(u32x4*)(WSP(bf16_t, O_WTIN) + ((size_t)l * NPAD + DIN) * D_ + (size_t)r * 8) = (u32x4){z_, z_, z_, z_}; }
    for (int i = gt; i < L_ * 2 * 128 * (2048 / 8); i += NG) { const int mtx = i / (128 * 256), r = i % (128 * 256); unsigned z_ = 0u; asm volatile("" : "+v"(z_));
        *(u32x4*)(WSP(bf16_t, O_WT1) + ((size_t)mtx * 256 + 128) * 2048 + (size_t)r * 8) = (u32x4){z_, z_, z_, z_}; }
    for (int i = gt; i < L_ * 2 * 64 * 128; i += NG) { const int j = i & 127, seg = (i >> 7) & 63, mtx = i >> 13, ll = mtx >> 1, kv = mtx & 1;
        const float* pos = (kv ? p->in.pos_v : p->in.pos_k) + (size_t)ll * 2048 + seg * 32; const float* w1 = (kv ? p->in.w1v : p->in.w1k) + (size_t)ll * 2048 * 128 + (size_t)seg * 32 * 128; float a = 0.f;
#pragma unroll 8
        for (int k = 0; k < 32; ++k) a += pos[k] * w1[(size_t)k * 128 + j];
        WSP(float, O_BIAS1P)[i] = a; }
    for (int i = gt; i < L_ * NPAD; i += NG) { const int l = i / NPAD, c = i % NPAD; if (c >= DIN) WSP(float, O_BIASP)[i] = 0.f; }
    for (int i = gt; i < L_ * DIN; i += NG) { const int l = i / DIN, n = i % DIN; WSP(float, O_BIASP)[l * NPAD + perm_in(n)] = p->in.b_in[i]; }
    for (int i = gt; i < T_ * D_ / 8; i += NG) { const f32x4 a = *(const f32x4*)(p->in.x + (size_t)i * 8), b = *(const f32x4*)(p->in.x + (size_t)i * 8 + 4);
        *(u32x4*)(WSP(bf16_t, O_XB) + (size_t)i * 8) = (u32x4){pk2(a.x, a.y), pk2(a.z, a.w), pk2(b.x, b.y), pk2(b.z, b.w)}; }
}

struct EpiProj {
    static constexpr bool PERM = true;
    bf16_t* projb; float* gf; const float* bias;
    __device__ __forceinline__ void operator()(const pg8::f32x4 (&acc)[2][2][4][2], const pg8::Unit& u, int wr, int wc, int fr, int fq) const {
        const int row0 = u.pm * 256 + wr * 64 + fr, col0 = u.pn * 256 + wc * 32 + 8 * fq;
        if (u.pn < 11) {
#pragma unroll
            for (int ai = 0; ai < 2; ++ai)
#pragma unroll
                for (int m = 0; m < 4; ++m) { bf16_t* rowp = projb + (size_t)(row0 + ai * 128 + m * 16) * PB + col0;
#pragma unroll
                    for (int bj = 0; bj < 2; ++bj) { const f32x4 v0 = acc[ai][bj][m][0] + *(const f32x4*)(bias + col0 + bj * 128), v1 = acc[ai][bj][m][1] + *(const f32x4*)(bias + col0 + bj * 128 + 4);
                        u32x4 w; w.x = pg8::cvt_pk_bf16(v0[0], v0[1]); w.y = pg8::cvt_pk_bf16(v0[2], v0[3]); w.z = pg8::cvt_pk_bf16(v1[0], v1[1]); w.w = pg8::cvt_pk_bf16(v1[2], v1[3]);
                        *(u32x4*)(rowp + bj * 128) = w; }
                    asm volatile("" ::: "memory"); }
        } else if (wc == 0) {
            const f32x4 b0 = *(const f32x4*)(bias + col0), b1 = *(const f32x4*)(bias + col0 + 4);
#pragma unroll
            for (int ai = 0; ai < 2; ++ai)
#pragma unroll
                for (int m = 0; m < 4; ++m) { float* rowp = gf + (size_t)(row0 + ai * 128 + m * 16) * 32 + 8 * fq;
                    const f32x4 v0 = acc[ai][0][m][0] + b0, v1 = acc[ai][0][m][1] + b1; f32x4 o0, o1;
#pragma unroll
                    for (int i = 0; i < 4; ++i) { const int j0 = 8 * fq + i, j1 = j0 + 4;
                        o0[i] = (j0 < 24) ? sigmoidf_(v0[i]) : (j0 < 28 ? logsig(v0[i]) : 0.f); o1[i] = (j1 < 24) ? sigmoidf_(v1[i]) : (j1 < 28 ? logsig(v1[i]) : 0.f); }
                    *(f32x4*)rowp = o0; *(f32x4*)(rowp + 4) = o1; }
        }
    }
};
struct EpiOut {
    static constexpr bool PERM = true;
    const float* x; float* y1;
    __device__ __forceinline__ void operator()(const pg8::f32x4 (&acc)[2][2][4][2], const pg8::Unit& u, int wr, int wc, int fr, int fq) const {
        const int row0 = u.pm * 256 + wr * 64 + fr, col0 = u.pn * 256 + wc * 32 + 8 * fq;
#pragma unroll
        for (int ai = 0; ai < 2; ++ai)
#pragma unroll
            for (int m = 0; m < 4; ++m) { const size_t off = (size_t)(row0 + ai * 128 + m * 16) * D_ + col0;
#pragma unroll
                for (int bj = 0; bj < 2; ++bj) { const f32x4 x0 = *(const f32x4*)(x + off + bj * 128), x1 = *(const f32x4*)(x + off + bj * 128 + 4);
                    *(f32x4*)(y1 + off + bj * 128) = x0 * ALPHA + acc[ai][bj][m][0]; *(f32x4*)(y1 + off + bj * 128 + 4) = x1 * ALPHA + acc[ai][bj][m][1]; }
                asm volatile("" ::: "memory"); }
    }
};
struct EpiGU {
    static constexpr bool PERM = true;
    bf16_t* act; const float* bgu;
    __device__ __forceinline__ void operator()(const pg8::f32x4 (&acc)[2][2][4][2], const pg8::Unit& u, int wr, int wc, int fr, int fq) const {
        const int row0 = u.pm * 256 + wr * 64 + fr, col0 = u.pn * 128 + wc * 32 + 8 * fq;
        const float* bb = bgu + (size_t)u.e * 2048 + col0;
        const f32x4 bg0 = *(const f32x4*)bb, bg1 = *(const f32x4*)(bb + 4), bu0 = *(const f32x4*)(bb + 1024), bu1 = *(const f32x4*)(bb + 1028);
#pragma unroll
        for (int ai = 0; ai < 2; ++ai)
#pragma unroll
            for (int m = 0; m < 4; ++m) { f32x4 a0, a1;
                const f32x4 g0 = acc[ai][0][m][0] + bg0, g1 = acc[ai][0][m][1] + bg1, u0 = acc[ai][1][m][0] + bu0, u1 = acc[ai][1][m][1] + bu1;
#pragma unroll
                for (int i = 0; i < 4; ++i) { const float gt0 = fminf(g0[i], 7.0f), up0 = fminf(fmaxf(u0[i], -7.0f), 7.0f), gt1 = fminf(g1[i], 7.0f), up1 = fminf(fmaxf(u1[i], -7.0f), 7.0f);
                    a0[i] = gt0 * sigmoidf_(1.702f * gt0) * (up0 + 1.0f); a1[i] = gt1 * sigmoidf_(1.702f * gt1) * (up1 + 1.0f); }
                u32x4 w; w.x = pg8::cvt_pk_bf16(a0[0], a0[1]); w.y = pg8::cvt_pk_bf16(a0[2], a0[3]); w.z = pg8::cvt_pk_bf16(a1[0], a1[1]); w.w = pg8::cvt_pk_bf16(a1[2], a1[3]);
                *(u32x4*)(act + (size_t)(row0 + ai * 128 + m * 16) * D_ + col0) = w; asm volatile("" ::: "memory"); }
    }
};
struct EpiDN {
    static constexpr bool PERM = true;
    bf16_t* y; const float* bdn; const float* roww;
    __device__ __forceinline__ void operator()(const pg8::f32x4 (&acc)[2][2][4][2], const pg8::Unit& u, int wr, int wc, int fr, int fq) const {
        const int row0 = u.pm * 256 + wr * 64 + fr, col0 = u.pn * 256 + wc * 32 + 8 * fq;
        const float* bb = bdn + (size_t)u.e * D_ + col0;
#pragma unroll
        for (int ai = 0; ai < 2; ++ai)
#pragma unroll
            for (int m = 0; m < 4; ++m) { const int row = row0 + ai * 128 + m * 16; const float w = roww[row];
#pragma unroll
                for (int bj = 0; bj < 2; ++bj) { const f32x4 v0 = (acc[ai][bj][m][0] + *(const f32x4*)(bb + bj * 128)) * w, v1 = (acc[ai][bj][m][1] + *(const f32x4*)(bb + bj * 128 + 4)) * w;
                    u32x4 o; o.x = pg8::cvt_pk_bf16(v0[0], v0[1]); o.y = pg8::cvt_pk_bf16(v0[2], v0[3]); o.z = pg8::cvt_pk_bf16(v1[0], v1[1]); o.w = pg8::cvt_pk_bf16(v1[2], v1[3]);
                    *(u32x4*)(y + (size_t)row * D_ + col0 + bj * 128) = o; }
                asm volatile("" ::: "memory"); }
    }
};
struct EpiCmp {
    static constexpr bool PERM = true;
    bf16_t* hid; const float* bias1;
    __device__ __forceinline__ void operator()(const pg8::f32x4 (&acc)[2][2][4][2], const pg8::Unit& u, int wr, int wc, int fr, int fq) const {
        const int row0 = u.pm * 256 + wr * 64 + fr, col0 = wc * 32 + 8 * fq;
        const float* bb = bias1 + (u.e & 1) * 128 + col0; const f32x4 b0 = *(const f32x4*)bb, b1 = *(const f32x4*)(bb + 4);
#pragma unroll
        for (int ai = 0; ai < 2; ++ai)
#pragma unroll
            for (int m = 0; m < 4; ++m) { const f32x4 v0 = acc[ai][0][m][0] + b0, v1 = acc[ai][0][m][1] + b1;
                u32x4 w; w.x = pg8::cvt_pk_bf16(gelu_tanh(v0[0]), gelu_tanh(v0[1])); w.y = pg8::cvt_pk_bf16(gelu_tanh(v0[2]), gelu_tanh(v0[3])); w.z = pg8::cvt_pk_bf16(gelu_tanh(v1[0]), gelu_tanh(v1[1])); w.w = pg8::cvt_pk_bf16(gelu_tanh(v1[2]), gelu_tanh(v1[3]));
                *(u32x4*)(hid + ((size_t)u.e * 512 + row0 + ai * 128 + m * 16) * 128 + col0) = w; asm volatile("" ::: "memory"); }
    }
};
struct GEpi {
    static constexpr bool PERM = true;
    int kind, l;
    __device__ __forceinline__ void operator()(const pg8::f32x4 (&acc)[2][2][4][2], const pg8::Unit& u, int wr, int wc, int fr, int fq) const {
        const KP p = fresh_kp();
        if (kind == 0) { const EpiProj e{WSP(bf16_t, O_PROJB), WSP(float, O_GF), WSP(float, O_BIASP) + l * NPAD}; e(acc, u, wr, wc, fr, fq); }
        else if (kind == 1) { const EpiOut e{(l == 0) ? p->in.x : WSP(float, O_XA), WSP(float, O_MIX)}; e(acc, u, wr, wc, fr, fq); }
        else if (kind == 2) { const EpiGU e{WSP(bf16_t, O_ACT), p->in.bgu + (size_t)l * NE * 2048}; e(acc, u, wr, wc, fr, fq); }
        else if (kind == 3) { const EpiDN e{WSP(bf16_t, O_Y), p->in.bdn + (size_t)l * NE * D_, WSP(float, O_ROWW)}; e(acc, u, wr, wc, fr, fq); }
        else { const EpiCmp e{WSP(bf16_t, O_HID), WSP(float, O_BIAS1) + l * 256}; e(acc, u, wr, wc, fr, fq); }
    }
};
struct GSched {
    int kind, nM, nN, nunits, G, c; const int* meta; const int* rowtok; const char* Bt; size_t estep;
    __device__ __forceinline__ bool next(int i, pg8::Unit& u) const {
        const int L = i * G + c; if (L >= nunits) return false;
        if (kind < 2) {
            int wgid = L; { const int q = nunits / pg8::NXCD, r = nunits % pg8::NXCD, xcd = wgid % pg8::NXCD, off = wgid / pg8::NXCD; wgid = (xcd < r ? xcd * (q + 1) : r * (q + 1) + (xcd - r) * q) + off; }
            const int nig = pg8::WGM * nN, gid = wgid / nig, fm = gid * pg8::WGM, gsz = (nM - fm) < pg8::WGM ? (nM - fm) : pg8::WGM;
            u.pm = fm + ((wgid % nig) % gsz); u.pn = (wgid % nig) / gsz; u.e = 0; u.nr = 256;
        } else if (kind == 4) { u.e = L >> 1; u.pm = L & 1; u.pn = 0; u.nr = (L & 1) ? 255 : 256; }
        else { const int gt = L / nN; u.pm = gt; u.pn = L - gt * nN; u.e = meta[64 + 2 * gt]; u.nr = meta[65 + 2 * gt]; }
        return true; }
    __device__ __forceinline__ unsigned a_off(const pg8::Unit& u, int r) const { const int rr = r < u.nr ? r : u.nr - 1; const int row = u.pm * 256 + rr;
        if (kind == 4) { const int kv = u.e & 1, bg = u.e >> 1; return (unsigned)(((bg >> 1) * S_ + 16 * row) * PB + C_KV + ((0 * 2 + kv) * 2 + (bg & 1)) * 64) * 2u; }
        return (unsigned)((kind == 2) ? rowtok[row] : row) * (unsigned)(D_ * 2); }
    __device__ __forceinline__ size_t a_kstep() const { return kind == 4 ? (size_t)PB * 2 : (size_t)128; }
    __device__ __forceinline__ const char* b_base(const pg8::Unit& u) const { return Bt + (size_t)(kind == 4 ? (u.e & 1) : u.e) * estep + (size_t)u.pn * ((size_t)256 * D_ * 2); }
};

__device__ __forceinline__ void ph_rmsnorm(KP p, int l) {
    const int lane = ftid() & 63, wv = ftid() >> 6; const float* g = p->in.g_out + (size_t)l * D_;
    constexpr int NB = 4; const int rstride = (int)gridDim.x * 8;
    f32x4 gg[4];
#pragma unroll
    for (int j = 0; j < 2; ++j) { gg[2 * j] = *(const f32x4*)(g + 512 * j + lane * 8); gg[2 * j + 1] = *(const f32x4*)(g + 512 * j + lane * 8 + 4); }
    for (int row0 = fbid() * 8 + wv; row0 < T_; row0 += rstride * NB) {
        u32x4 ra[NB], rb2[NB], rw2[NB];
#pragma unroll
        for (int bi = 0; bi < NB; ++bi) { const int row = (row0 + bi * rstride < T_) ? row0 + bi * rstride : row0; const bf16_t* r = WSP(bf16_t, O_O) + (size_t)row * D_ + lane * 8;
            ra[bi] = *(const u32x4*)r; rb2[bi] = *(const u32x4*)(r + 512); rw2[bi] = *(const u32x4*)(WSP(bf16_t, O_OWIN) + (size_t)row * 512 + lane * 8); }
#pragma unroll
        for (int bi = 0; bi < NB; ++bi) { const int row = row0 + bi * rstride; if (row < T_) {
#define BF_LO(u) __uint_as_float((u) << 16)
#define BF_HI(u) __uint_as_float((u) & 0xffff0000u)
            const f32x4 x0 = (f32x4){BF_LO(ra[bi].x) + BF_LO(rw2[bi].x), BF_HI(ra[bi].x) + BF_HI(rw2[bi].x), BF_LO(ra[bi].y) + BF_LO(rw2[bi].y), BF_HI(ra[bi].y) + BF_HI(rw2[bi].y)};
            const f32x4 x1 = (f32x4){BF_LO(ra[bi].z) + BF_LO(rw2[bi].z), BF_HI(ra[bi].z) + BF_HI(rw2[bi].z), BF_LO(ra[bi].w) + BF_LO(rw2[bi].w), BF_HI(ra[bi].w) + BF_HI(rw2[bi].w)};
            const f32x4 y0 = (f32x4){BF_LO(rb2[bi].x), BF_HI(rb2[bi].x), BF_LO(rb2[bi].y), BF_HI(rb2[bi].y)}, y1 = (f32x4){BF_LO(rb2[bi].z), BF_HI(rb2[bi].z), BF_LO(rb2[bi].w), BF_HI(rb2[bi].w)};
#undef BF_LO
#undef BF_HI
            float s = (x0.x * x0.x + x0.y * x0.y) + (x0.z * x0.z + x0.w * x0.w) + (x1.x * x1.x + x1.y * x1.y) + (x1.z * x1.z + x1.w * x1.w);
            float s2 = (y0.x * y0.x + y0.y * y0.y) + (y0.z * y0.z + y0.w * y0.w) + (y1.x * y1.x + y1.y * y1.y) + (y1.z * y1.z + y1.w * y1.w);
            const float sc0 = rsqrtf(wsum(s) * (1.f / 512.f) + RMS_EPS);
#pragma unroll
            for (int o = 1; o < 32; o <<= 1) s2 += __shfl_xor(s2, o);
            const float sc1 = rsqrtf(s2 * (1.f / 256.f) + RMS_EPS);
            const f32x4 u0 = x0 * sc0 * gg[0], u1 = x1 * sc0 * gg[1], w0 = y0 * sc1 * gg[2], w1 = y1 * sc1 * gg[3];
            bf16_t* ro = WSP(bf16_t, O_OB) + (size_t)row * D_;
            *(u32x4*)(ro + lane * 8) = (u32x4){pk2(u0.x, u0.y), pk2(u0.z, u0.w), pk2(u1.x, u1.y), pk2(u1.z, u1.w)};
            *(u32x4*)(ro + 512 + lane * 8) = (u32x4){pk2(w0.x, w0.y), pk2(w0.z, w0.w), pk2(w1.x, w1.y), pk2(w1.z, w1.w)}; } }
    }
}
template <bool ROUTER>
__device__ __forceinline__ void ph_ln(float* lds, KP p, int l, float* __restrict__ yout, int cnt_off = 0) {
    const int lane = ftid() & 63, wv = ftid() >> 6;
    const float* g = (ROUTER ? p->in.ln1_g : p->in.ln2_g) + (size_t)l * D_; const float* bb = (ROUTER ? p->in.ln1_b : p->in.ln2_b) + (size_t)l * D_;
    constexpr int NB = ROUTER ? 4 : 2;
    const int rstride = (int)gridDim.x * 8;
    for (int row0 = fbid() * 8 + wv; row0 < T_; row0 += rstride * NB) {
        float v[NB][16];
        if (ROUTER) {
#pragma unroll
            for (int bi = 0; bi < NB; ++bi) { const int row = row0 + bi * rstride; const float* src = WSP(float, O_MIX) + (size_t)(row < T_ ? row : row0) * D_;
#pragma unroll
                for (int j = 0; j < 2; ++j) { const f32x4 a = *(const f32x4*)(src + 512 * j + lane * 8), b = *(const f32x4*)(src + 512 * j + lane * 8 + 4);
                    v[bi][8 * j + 0] = a.x; v[bi][8 * j + 1] = a.y; v[bi][8 * j + 2] = a.z; v[bi][8 * j + 3] = a.w; v[bi][8 * j + 4] = b.x; v[bi][8 * j + 5] = b.y; v[bi][8 * j + 6] = b.z; v[bi][8 * j + 7] = b.w; } }
        } else { const bf16_t* y = WSP(bf16_t, O_Y);
            int sl[NB][TOPK];
#pragma unroll
            for (int bi = 0; bi < NB; ++bi) { const int row = (row0 + bi * rstride < T_) ? row0 + bi * rstride : row0;
#pragma unroll
                for (int k = 0; k < TOPK; ++k) sl[bi][k] = WSP(int, O_SLOT)[row * TOPK + k]; }
            u32x4 yv[NB][TOPK][2]; f32x4 xv[NB][4];
#pragma unroll
            for (int bi = 0; bi < NB; ++bi) { const int row = (row0 + bi * rstride < T_) ? row0 + bi * rstride : row0; const float* src = WSP(float, O_X1) + (size_t)row * D_;
#pragma unroll
                for (int j = 0; j < 2; ++j) { xv[bi][2 * j] = *(const f32x4*)(src + 512 * j + lane * 8); xv[bi][2 * j + 1] = *(const f32x4*)(src + 512 * j + lane * 8 + 4); }
#pragma unroll
                for (int k = 0; k < TOPK; ++k)
#pragma unroll
                    for (int j = 0; j < 2; ++j) yv[bi][k][j] = *(const u32x4*)(y + (size_t)sl[bi][k] * D_ + 512 * j + lane * 8); }
#pragma unroll
            for (int bi = 0; bi < NB; ++bi)
#pragma unroll
                for (int j = 0; j < 2; ++j) { float acc[8];
#pragma unroll
                    for (int e = 0; e < 8; ++e) acc[e] = 0.f;
#pragma unroll
                    for (int k = 0; k < TOPK; ++k) { const u32x4 q = yv[bi][k][j];
                        acc[0] += __uint_as_float(q.x << 16); acc[1] += __uint_as_float(q.x & 0xffff0000u); acc[2] += __uint_as_float(q.y << 16); acc[3] += __uint_as_float(q.y & 0xffff0000u);
                        acc[4] += __uint_as_float(q.z << 16); acc[5] += __uint_as_float(q.z & 0xffff0000u); acc[6] += __uint_as_float(q.w << 16); acc[7] += __uint_as_float(q.w & 0xffff0000u); }
                    const f32x4 a = xv[bi][2 * j], b = xv[bi][2 * j + 1];
                    v[bi][8 * j + 0] = ALPHA * a.x + acc[0]; v[bi][8 * j + 1] = ALPHA * a.y + acc[1]; v[bi][8 * j + 2] = ALPHA * a.z + acc[2]; v[bi][8 * j + 3] = ALPHA * a.w + acc[3];
                    v[bi][8 * j + 4] = ALPHA * b.x + acc[4]; v[bi][8 * j + 5] = ALPHA * b.y + acc[5]; v[bi][8 * j + 6] = ALPHA * b.z + acc[6]; v[bi][8 * j + 7] = ALPHA * b.w + acc[7]; } }
#pragma unroll
        for (int bi = 0; bi < NB; ++bi) { const int row = row0 + bi * rstride; if (row < T_) {
            float s = 0.f;
#pragma unroll
            for (int i = 0; i < 16; ++i) s += v[bi][i];
            const float mu = wsum(s) * (1.f / D_); float s2 = 0.f;
#pragma unroll
            for (int i = 0; i < 16; ++i) { v[bi][i] -= mu; s2 += v[bi][i] * v[bi][i]; }
            const float rstd = rsqrtf(wsum(s2) * (1.f / D_) + LN_EPS);
            bf16_t* ybf = (ROUTER ? WSP(bf16_t, O_X1B) : WSP(bf16_t, O_XB)) + (size_t)row * D_;
#pragma unroll
            for (int j = 0; j < 2; ++j) { const int c0 = 512 * j + lane * 8; float o8[8];
                const f32x4 g0 = *(const f32x4*)(g + c0), g1 = *(const f32x4*)(g + c0 + 4), b0 = *(const f32x4*)(bb + c0), b1 = *(const f32x4*)(bb + c0 + 4);
                o8[0] = v[bi][8 * j + 0] * rstd * g0.x + b0.x; o8[1] = v[bi][8 * j + 1] * rstd * g0.y + b0.y; o8[2] = v[bi][8 * j + 2] * rstd * g0.z + b0.z; o8[3] = v[bi][8 * j + 3] * rstd * g0.w + b0.w;
                o8[4] = v[bi][8 * j + 4] * rstd * g1.x + b1.x; o8[5] = v[bi][8 * j + 5] * rstd * g1.y + b1.y; o8[6] = v[bi][8 * j + 6] * rstd * g1.z + b1.z; o8[7] = v[bi][8 * j + 7] * rstd * g1.w + b1.w;
                *(f32x4*)(yout + (size_t)row * D_ + c0) = (f32x4){o8[0], o8[1], o8[2], o8[3]};
                *(f32x4*)(yout + (size_t)row * D_ + c0 + 4) = (f32x4){o8[4], o8[5], o8[6], o8[7]};
                *(u32x4*)(ybf + c0) = (u32x4){pk2(o8[0], o8[1]), pk2(o8[2], o8[3]), pk2(o8[4], o8[5]), pk2(o8[6], o8[7])}; } } }
    }
    if (ROUTER) {
        const float* rw = p->in.rw + (size_t)l * D_ * NE; const float* rb = p->in.rb + (size_t)l * NE;
        float* wl = lds; float* rl = lds + 16384 + wv * 2048; float* lgl = lds + 32768 + wv * 256;
        int nrow = 0; for (int r_ = fbid() * 8 + wv; r_ < T_; r_ += (int)gridDim.x * 8) { ++nrow; asm volatile("" : "+s"(nrow)); }
        const int e = lane & 31, half = lane >> 5;
        float acc[2][4];
#pragma unroll
        for (int gi = 0; gi < 2; ++gi)
#pragma unroll
            for (int bi = 0; bi < 4; ++bi) acc[gi][bi] = 0.f;
#pragma unroll 1
        for (int c = 0; c < 2; ++c) {
            __syncthreads();
#pragma unroll
            for (int i = 0; i < 8; ++i) { const int f4 = i * NT + ftid(); *(f32x4*)(wl + 4 * f4) = *(const f32x4*)(rw + (size_t)c * 512 * NE + 4 * f4); }
            __syncthreads();
#pragma unroll
            for (int gi = 0; gi < 2; ++gi) {
                asm volatile("s_waitcnt lgkmcnt(0)" ::: "memory");
#pragma unroll
                for (int bi = 0; bi < 4; ++bi) { const int ri = (4 * gi + bi < nrow) ? 4 * gi + bi : 0; const float* src = yout + (size_t)(fbid() * 8 + wv + ri * (int)gridDim.x * 8) * D_ + c * 512 + lane * 8;
                    *(f32x4*)(rl + bi * 512 + lane * 8) = *(const f32x4*)src; *(f32x4*)(rl + bi * 512 + lane * 8 + 4) = *(const f32x4*)(src + 4); }
                asm volatile("s_waitcnt lgkmcnt(0)" ::: "memory");
                const float* wp = wl + (half * 256) * NE + e; const float* rp = rl + half * 256;
#pragma unroll 4
                for (int kk = 0; kk < 64; ++kk) { const float w0 = wp[(4 * kk) * NE], w1 = wp[(4 * kk + 1) * NE], w2 = wp[(4 * kk + 2) * NE], w3 = wp[(4 * kk + 3) * NE];
#pragma unroll
                    for (int bi = 0; bi < 4; ++bi) { const f32x4 r = *(const f32x4*)(rp + bi * 512 + 4 * kk); acc[gi][bi] += (r.x * w0 + r.y * w1) + (r.z * w2 + r.w * w3); } }
            }
        }
#pragma unroll
        for (int gi = 0; gi < 2; ++gi)
#pragma unroll
            for (int bi = 0; bi < 4; ++bi) { const float t = acc[gi][bi] + __shfl_xor(acc[gi][bi], 32); if (lane < 32) lgl[(4 * gi + bi) * 32 + e] = t; }
        asm volatile("s_waitcnt lgkmcnt(0)" ::: "memory");
        int* lcnt = (int*)(lds + 32768 + 8 * 256);
        if (ftid() < NE) lcnt[ftid()] = 0;
        __syncthreads();
#pragma unroll 1
        for (int ri = 0; ri < nrow; ++ri) { const int row = fbid() * 8 + wv + ri * (int)gridDim.x * 8;
            const int e = lane & 31; const float lg = lgl[ri * 32 + e] + rb[e];
            float cur = lg, tv0 = 0.f, den = 0.f, myw = 0.f; int mye = 0;
#pragma unroll
            for (int k = 0; k < TOPK; ++k) { float bv = cur; int bi = e;
#pragma unroll
                for (int o = 16; o >= 1; o >>= 1) { const float ov = __shfl_xor(bv, o); const int oi = __shfl_xor(bi, o); if (ov > bv || (ov == bv && oi < bi)) { bv = ov; bi = oi; } }
                if (k == 0) tv0 = bv;
                const float w = __expf(bv - tv0); den += w;
                if (lane == k) { mye = bi; myw = w; }
                if (e == bi) cur = -3.4e38f; }
            if (lane < TOPK) { WSP(int, O_TOPE)[row * TOPK + lane] = mye; WSP(float, O_TOPW)[row * TOPK + lane] = myw / den; WSP(int, O_POS)[row * TOPK + lane] = atomicAdd(&lcnt[mye], 1); } }
        __syncthreads();
        if (ftid() < NE) { const int c = lcnt[ftid()]; lcnt[ftid()] = (c > 0) ? atomicAdd(WSP(int, O_COUNTS) + CNT_IDX(l, ftid()) + cnt_off, c) : 0; }
        __syncthreads();
#pragma unroll 1
        for (int ri = 0; ri < nrow; ++ri) { const int row = fbid() * 8 + wv + ri * (int)gridDim.x * 8;
            if (lane < TOPK) WSP(int, O_POS)[row * TOPK + lane] += lcnt[WSP(int, O_TOPE)[row * TOPK + lane]]; }
        __syncthreads();
    }
}
__device__ __forceinline__ void ph_bias1_reduce(KP p, int l) {
    if (fbid() != (int)gridDim.x - 1) return;
    const int tid = ftid(); if (tid < 256) { const float* pp = WSP(float, O_BIAS1P) + ((size_t)(l * 2 + (tid >> 7)) * 64) * 128 + (tid & 127); float a = 0.f;
        for (int s = 0; s < 64; ++s) a += pp[s * 128];
        WSP(float, O_BIAS1)[l * 256 + tid] = a; }
}
__device__ __forceinline__ void ph_cumsum(float* lds, KP p, int blk0) {
    const int tid = ftid(), lane = tid & 63, wv = tid >> 6; const int bh = fbid() - blk0;
    if (bh < 0 || bh >= B_ * 4) return;
    const int b = bh >> 2, h = bh & 3; const float* gf = WSP(float, O_GF) + (size_t)(b * S_ + tid * 16) * 32 + 24 + h;
    float v[16], run = 0.f;
#pragma unroll
    for (int i = 0; i < 16; ++i) { run += gf[(size_t)i * 32]; v[i] = run; }
    float inc = run;
#pragma unroll
    for (int o = 1; o < 64; o <<= 1) { const float t = __shfl_up(inc, o); if (lane >= o) inc += t; }
    if (lane == 63) lds[wv] = inc;
    __syncthreads();
    float woff = 0.f;
#pragma unroll
    for (int i = 0; i < 8; ++i) woff += (i < wv) ? lds[i] : 0.f;
    const float off = woff + inc - run; float* c = WSP(float, O_CFOX) + (size_t)bh * S_ + tid * 16;
#pragma unroll
    for (int i = 0; i < 4; ++i) *(f32x4*)(c + 4 * i) = (f32x4){v[4 * i] + off, v[4 * i + 1] + off, v[4 * i + 2] + off, v[4 * i + 3] + off};
    __syncthreads();
}
__device__ __forceinline__ void ph_prep2(KP p, int l) {
    { unsigned* kmax2 = WSP(unsigned, O_COUNTS) + 192 + l * 8;
      for (int i = fbid() * NT + ftid(); i < B_ * 4 * S_ * 2; i += gridDim.x * NT) { const int half = i & 1, t = (i >> 1) % S_, bh = (i >> 1) / S_, b = bh >> 2, h = bh & 3;
          const bf16_t* kr = WSP(bf16_t, O_PROJB) + (size_t)(b * S_ + t) * PB + C_FOX + (4 + h) * 64 + half * 32; float ss = 0.f;
#pragma unroll
          for (int c = 0; c < 4; ++c) { float k8[8]; ld8(kr + 8 * c, k8);
#pragma unroll
              for (int e = 0; e < 8; ++e) ss += k8[e] * k8[e]; }
          ss += __shfl_xor(ss, 1);
#pragma unroll
          for (int o = 2; o < 64; o <<= 1) ss = fmaxf(ss, __shfl_xor(ss, o));
          if ((ftid() & 63) == 0) atomicMax(kmax2 + bh, __float_as_uint(ss)); } }
    for (int i = fbid() * NT + ftid(); i < 8 * 512 * 64; i += gridDim.x * NT) {
        const int d = i & 63, n = (i >> 6) & 511, combo = i >> 15, kv = combo & 1, bg = combo >> 1;
        const float* w2 = (kv ? p->in.w2v : p->in.w2k) + (size_t)l * 128 * 64; const bf16_t* hr = WSP(bf16_t, O_HID) + ((size_t)combo * 512 + n) * 128;
        float a = 0.f;
#pragma unroll 4
        for (int c = 0; c < 16; ++c) { float h8[8]; ld8(hr + 8 * c, h8);
#pragma unroll
            for (int e = 0; e < 8; ++e) a += h8[e] * w2[(8 * c + e) * 64 + d]; }
        (kv ? WSP(bf16_t, O_VCMPB) : WSP(bf16_t, O_KCMPB))[((size_t)bg * 512 + n) * 64 + d] = (n < NCMP) ? (bf16_t)f2bf(a) : (bf16_t)0; }
}
__device__ __forceinline__ void ph_moe_scatter2(float* lds, KP p, int l) {
    const int tid = ftid(); int* ts = (int*)lds;
    const int* counts = WSP(int, O_COUNTS) + CNT_IDX(l, 0); int* meta = WSP(int, O_META); int* cl = ts + 64;
    __syncthreads();
    if (tid < NE) cl[tid] = counts[tid * 32];
    __syncthreads();
    if (tid == 0) { int nt = 0; for (int e = 0; e < NE; ++e) { ts[e] = nt; nt += (cl[e] + 255) >> 8; } ts[32] = nt; }
    __syncthreads();
    if (fbid() == 0) { if (tid < NE) { const int c = cl[tid], t0 = ts[tid]; meta[tid] = t0; for (int r = 0, t = t0; r < c; r += 256, ++t) { meta[64 + 2 * t] = tid; meta[65 + 2 * t] = (c - r) < 256 ? (c - r) : 256; } }
        if (tid == 0) meta[32] = ts[32]; }
    for (int i = fbid() * NT + tid; i < MROWS; i += gridDim.x * NT) {
        const int row = ts[WSP(int, O_TOPE)[i]] * 256 + WSP(int, O_POS)[i];
        WSP(int, O_ROWTOK)[row] = i >> 2; WSP(float, O_ROWW)[row] = WSP(float, O_TOPW)[i]; WSP(int, O_SLOT)[i] = row; }
    __syncthreads();
}
}
namespace mk {
typedef short bf16x8 __attribute__((ext_vector_type(8)));
typedef float f32x16 __attribute__((ext_vector_type(16)));
typedef float f32x2_t __attribute__((ext_vector_type(2)));
typedef __bf16 bf16x2_t __attribute__((ext_vector_type(2)));
typedef unsigned u32x2 __attribute__((ext_vector_type(2)));
typedef short v4i16_t __attribute__((ext_vector_type(4)));
__device__ __forceinline__ unsigned cvtpk(float lo, float hi) { f32x2_t v = {lo, hi}; bf16x2_t b = __builtin_convertvector(v, bf16x2_t); return __builtin_bit_cast(unsigned, b); }
constexpr int KROW = 144, VROW = 136;
constexpr int E1_K = 0, E1_V = 64 * KROW, E1_C = E1_V + 64 * KROW, E1_BUF = E1_C + 256;
constexpr int E1_FLAGS = 2 * E1_BUF;
constexpr float LOG2E = 1.4426950408889634f;
constexpr float RESC_THR = 8.0f;
#define CROW(reg, hh) (((reg) & 3) + 8 * ((reg) >> 2) + 4 * (hh))

#define SM_CORE(p0, p1, m, l, have, o0, o1) do { \
    float rm_ = fmaxf(p0[0], p1[0]); \
    _Pragma("unroll") for (int reg_ = 1; reg_ < 16; ++reg_) rm_ = fmaxf(rm_, fmaxf(p0[reg_], p1[reg_])); \
    rm_ = fmaxf(rm_, __shfl_xor(rm_, 32)); \
    const bool fin_ = rm_ > -1e37f; \
    if (__any((rm_ > RESC_THR) || (!have && fin_))) { \
        const float dl_ = have ? fmaxf(rm_, 0.f) : (fin_ ? rm_ : 0.f); const float al_ = have ? __builtin_amdgcn_exp2f(-dl_) : 1.f; \
        m += dl_; l *= al_; have = have || fin_; \
        _Pragma("unroll") for (int r_ = 0; r_ < 16; ++r_) { o0[r_] *= al_; o1[r_] *= al_; p0[r_] -= dl_; p1[r_] -= dl_; } } \
    float ls_ = 0.f; \
    _Pragma("unroll") for (int reg_ = 0; reg_ < 16; ++reg_) { p0[reg_] = __builtin_amdgcn_exp2f(p0[reg_]); p1[reg_] = __builtin_amdgcn_exp2f(p1[reg_]); ls_ += p0[reg_] + p1[reg_]; } \
    l += ls_; } while (0)

struct E1Geom { int b, q0, h; const bf16_t* qp; const bf16_t* kp; const bf16_t* vp; size_t pitch; };

template <int KIND>
__device__ __forceinline__ void e1_unit(LAS unsigned char* lds, KP p, int b, int hg, int qb, bf16_t* __restrict__ obase, bf16_t* __restrict__ owin, const unsigned* __restrict__ kmax2) {
    const int tid = ftid(), lane = tid & 63, w = __builtin_amdgcn_readfirstlane(tid >> 6), r32 = lane & 31, hh = lane >> 5;
    const bf16_t* projb = WSP(bf16_t, O_PROJB);
    int h, q0, qrow0, qcol, kcol, vcol, nrows;
    if (KIND == 0) { h = hg; q0 = qb * 256; qrow0 = q0 + 32 * w; qcol = C_FOX + h * 64; kcol = C_FOX + (4 + h) * 64; vcol = C_FOX + (8 + h) * 64; nrows = 256; }
    else if (KIND == 2) { h = hg; q0 = qb * 256; qrow0 = q0 + 32 * w; qcol = C_SB + h * 64; kcol = C_SB + (4 + h) * 64; vcol = C_SB + (8 + h) * 64; nrows = 256; }
    else { h = 4 * hg + (w & 3); q0 = qb * 64; qrow0 = q0 + 32 * (w >> 2); qcol = h * 64; kcol = C_KV + ((2 * 2 + 0) * 2 + hg) * 64; vcol = C_KV + ((2 * 2 + 1) * 2 + hg) * 64; nrows = 64; }
    const int tq = qrow0 + r32;
    const bf16_t* kbase = projb + (size_t)(b * S_) * PB + kcol; const bf16_t* vbase = projb + (size_t)(b * S_) * PB + vcol;
    bf16x8 qf[4];
    { const bf16_t* qptr = projb + (size_t)(b * S_ + tq) * PB + qcol + 8 * hh;
#pragma unroll
      for (int d0 = 0; d0 < 4; ++d0) qf[d0] = *(const bf16x8*)(qptr + 16 * d0); }
    int j0 = 0; const int j1 = (q0 + nrows - 1) >> 6;
    if (KIND == 1) { j0 = (q0 - 511) >> 6; if (j0 < 0) j0 = 0; }
    const int ntile = j1 - j0 + 1;
    float ct2 = 0.f, sl2 = 0.f; const float* cb = nullptr;
    if (KIND == 0) { cb = WSP(float, O_CFOX) + (size_t)(b * 4 + h) * S_; ct2 = cb[tq] * LOG2E; }
    if (KIND == 1) sl2 = exp2f(-(float)(h + 1)) * LOG2E;
    float qkb = 0.f;
    if (KIND == 0) { float qs = 0.f;
#pragma unroll
        for (int d0 = 0; d0 < 4; ++d0)
#pragma unroll
            for (int e = 0; e < 8; ++e) { const float x = bf2f((unsigned short)qf[d0][e]); qs += x * x; }
        qs += __shfl_xor(qs, 32);
        const float km2 = __uint_as_float(kmax2[b * 4 + h]);
        qkb = sqrtf(qs * km2) * (SCALE * LOG2E * 1.01f); }
    const float tqf = (float)tq;
    const int skey = tid >> 3, sch = tid & 7;
    u32x4 rk, rv; float rc = 0.f;
#define E1_LOAD(jj) do { const size_t ro_ = (size_t)((jj) * 64 + skey) * PB + sch * 8; rk = *(const u32x4*)(kbase + ro_); rv = *(const u32x4*)(vbase + ro_); \
        if (KIND == 0 && tid < 64) rc = cb[(jj) * 64 + tid] * LOG2E; } while (0)
#define E1_WRITE(bufp) do { *(LAS u32x4*)((bufp) + E1_K + skey * KROW + sch * 16) = rk; *(LAS u32x4*)((bufp) + E1_V + skey * KROW + sch * 16) = rv; \
        if (KIND == 0 && tid < 64) ((LAS float*)((bufp) + E1_C))[tid] = rc; } while (0)
    f32x16 o0, o1;
#pragma unroll
    for (int r = 0; r < 16; ++r) { o0[r] = 0.f; o1[r] = 0.f; }
    float m = 0.f, l = 0.f, carry = 0.f; bool have = false;
    bool wave_done = false;
    LAS unsigned* flags = (LAS unsigned*)(lds + E1_FLAGS);
    if (KIND != 1) { if (tid < 8) flags[tid] = 0u; }
    __syncthreads();
    E1_LOAD(KIND != 1 ? j1 : j0);
    for (int it = 0; it < ntile; ++it) {
        const int j = (KIND != 1) ? (j1 - it) : (j0 + it);
        LAS unsigned char* buf = lds + (it & 1) * E1_BUF;
        E1_WRITE(buf);
        __syncthreads();
        if (KIND != 1) { unsigned alld = 1u;
#pragma unroll
            for (int i = 0; i < 8; ++i) alld &= flags[i];
            if (alld) break; }
        if (it + 1 < ntile) E1_LOAD((KIND != 1) ? (j - 1) : (j + 1));
        if (!(KIND != 1 && wave_done)) {
            f32x16 p0, p1;
#pragma unroll
            for (int r = 0; r < 16; ++r) { p0[r] = 0.f; p1[r] = 0.f; }
            { const LAS unsigned char* kp_ = buf + E1_K + r32 * KROW + hh * 16;
#pragma unroll
              for (int d0 = 0; d0 < 4; ++d0) { const bf16x8 a0 = *(const LAS bf16x8*)(kp_ + d0 * 32), a1 = *(const LAS bf16x8*)(kp_ + 32 * KROW + d0 * 32);
                  p0 = __builtin_amdgcn_mfma_f32_32x32x16_bf16(a0, qf[d0], p0, 0, 0, 0); p1 = __builtin_amdgcn_mfma_f32_32x32x16_bf16(a1, qf[d0], p1, 0, 0, 0); } }
            const int kb = j * 64 + 4 * hh;
            if (KIND == 2) {
                float lk0[16], lk1[16], gs[8];
#pragma unroll
                for (int reg = 0; reg < 16; ++reg) { const int kpos = kb + CROW(reg, 0);
                    const float z0 = p0[reg] * SCALE, z1 = p1[reg] * SCALE; const bool v0 = kpos < tq, v1 = kpos + 32 < tq;
                    const float lb0 = fminf(z0, 0.f) - __logf(1.f + __expf(-fabsf(z0))), lb1 = fminf(z1, 0.f) - __logf(1.f + __expf(-fabsf(z1)));
                    lk0[reg] = v0 ? (lb0 - z0) : 0.f; lk1[reg] = v1 ? (lb1 - z1) : 0.f;
                    p0[reg] = v0 ? lb0 : -INFINITY; p1[reg] = v1 ? lb1 : -INFINITY; }
#pragma unroll
                for (int g4 = 0; g4 < 4; ++g4) { gs[g4] = (lk0[4 * g4] + lk0[4 * g4 + 1]) + (lk0[4 * g4 + 2] + lk0[4 * g4 + 3]); gs[4 + g4] = (lk1[4 * g4] + lk1[4 * g4 + 1]) + (lk1[4 * g4 + 2] + lk1[4 * g4 + 3]); }
                float oth[8];
#pragma unroll
                for (int gi = 0; gi < 8; ++gi) oth[gi] = __shfl_xor(gs[gi], 32);
                float run = 0.f;
#pragma unroll
                for (int gi = 7; gi >= 0; --gi) {
                    float later = carry + run + (hh == 0 ? oth[gi] : 0.f);
#pragma unroll
                    for (int e = 3; e >= 0; --e) { const int reg = (gi & 3) * 4 + e;
                        if (gi >> 2) { p1[reg] = __expf(p1[reg] + later); later += lk1[reg]; } else { p0[reg] = __expf(p0[reg] + later); later += lk0[reg]; } }
                    run += gs[gi] + oth[gi]; }
                carry += run;
            } else {
                if (KIND == 0) {
                    const LAS float* cs = (const LAS float*)(buf + E1_C) + 4 * hh; const float ctm = ct2 - m;
#pragma unroll
                    for (int i = 0; i < 4; ++i) { const f32x4 c0 = *(const LAS f32x4*)(cs + 8 * i), c1 = *(const LAS f32x4*)(cs + 32 + 8 * i);
#pragma unroll
                        for (int e = 0; e < 4; ++e) { const int reg = 4 * i + e; p0[reg] = p0[reg] * (SCALE * LOG2E) + (ctm - c0[e]); p1[reg] = p1[reg] * (SCALE * LOG2E) + (ctm - c1[e]); } }
                    if (!(j * 64 + 63 <= qrow0)) {
#pragma unroll
                        for (int reg = 0; reg < 16; ++reg) { const int kpos = kb + CROW(reg, 0); p0[reg] = (kpos <= tq) ? p0[reg] : -INFINITY; p1[reg] = (kpos + 32 <= tq) ? p1[reg] : -INFINITY; } }
                } else {
                    const float basef = sl2 * ((float)kb - tqf) - m, base1 = basef + 32.f * sl2;
#pragma unroll
                    for (int reg = 0; reg < 16; ++reg) { p0[reg] = p0[reg] * (SCALE * LOG2E) + __builtin_fmaf(sl2, (float)CROW(reg, 0), basef); p1[reg] = p1[reg] * (SCALE * LOG2E) + __builtin_fmaf(sl2, (float)CROW(reg, 0), base1); }
                    if (!(j * 64 + 63 <= qrow0 && qrow0 + 31 - j * 64 < 512)) {
#pragma unroll
                        for (int reg = 0; reg < 16; ++reg) { const int kpos = kb + CROW(reg, 0);
                            p0[reg] = (kpos <= tq && tq - kpos < 512) ? p0[reg] : -INFINITY; p1[reg] = (kpos + 32 <= tq && tq - kpos - 32 < 512) ? p1[reg] : -INFINITY; } }
                }
                SM_CORE(p0, p1, m, l, have, o0, o1);
            }
            { const int gq_ = lane >> 4, li_ = lane & 15;
              const LAS unsigned char* tb = buf + E1_V + (4 * hh + (li_ >> 2)) * KROW + (16 * (gq_ & 1) + 4 * (li_ & 3)) * 2;
#pragma unroll
              for (int s = 0; s < 4; ++s) {
                  u32x4 pw;
                  if (s < 2) { pw.x = cvtpk(p0[8 * s + 0], p0[8 * s + 1]); pw.y = cvtpk(p0[8 * s + 2], p0[8 * s + 3]); pw.z = cvtpk(p0[8 * s + 4], p0[8 * s + 5]); pw.w = cvtpk(p0[8 * s + 6], p0[8 * s + 7]); }
                  else { const int s2 = s - 2; pw.x = cvtpk(p1[8 * s2 + 0], p1[8 * s2 + 1]); pw.y = cvtpk(p1[8 * s2 + 2], p1[8 * s2 + 3]); pw.z = cvtpk(p1[8 * s2 + 4], p1[8 * s2 + 5]); pw.w = cvtpk(p1[8 * s2 + 6], p1[8 * s2 + 7]); }
                  const bf16x8 pb = __builtin_bit_cast(bf16x8, pw);
                  const v4i16_t a0l = __builtin_amdgcn_ds_read_tr16_b64_v4i16((LAS v4i16_t*)(tb + (16 * s) * KROW)), a0h = __builtin_amdgcn_ds_read_tr16_b64_v4i16((LAS v4i16_t*)(tb + (16 * s + 8) * KROW));
                  const v4i16_t a1l = __builtin_amdgcn_ds_read_tr16_b64_v4i16((LAS v4i16_t*)(tb + (16 * s) * KROW + 64)), a1h = __builtin_amdgcn_ds_read_tr16_b64_v4i16((LAS v4i16_t*)(tb + (16 * s + 8) * KROW + 64));
                  const bf16x8 va0 = (bf16x8){a0l[0], a0l[1], a0l[2], a0l[3], a0h[0], a0h[1], a0h[2], a0h[3]}, va1 = (bf16x8){a1l[0], a1l[1], a1l[2], a1l[3], a1h[0], a1h[1], a1h[2], a1h[3]};
                  o0 = __builtin_amdgcn_mfma_f32_32x32x16_bf16(va0, pb, o0, 0, 0, 0); o1 = __builtin_amdgcn_mfma_f32_32x32x16_bf16(va1, pb, o1, 0, 0, 0); } }
            if (KIND == 0) {
                const float c0 = *(const LAS float*)(buf + E1_C); const bool dn = __all(have && (qkb + (ct2 - c0) - m < -150.f));
                if (dn && !wave_done) { wave_done = true; if (lane == 0) flags[w] = 1u; } }
            if (KIND == 2) { const bool dn = __all(carry < -110.f);
                if (dn && !wave_done) { wave_done = true; if (lane == 0) flags[w] = 1u; } }
        }
    }
    float inv = 1.f, gate = 1.f;
    if (KIND != 2) { l += __shfl_xor(l, 32); inv = (l > 0.f) ? 1.f / l : 0.f; }
    bf16_t* orow;
    if (KIND == 0) orow = obase + (size_t)(b * S_ + tq) * D_ + 512 + h * 64;
    else if (KIND == 2) orow = obase + (size_t)(b * S_ + tq) * D_ + 768 + h * 64;
    else { orow = owin + (size_t)(b * S_ + tq) * 512 + h * 64; gate = WSP(float, O_GF)[(size_t)(b * S_ + tq) * 32 + 2 * 8 + h]; }
    const float sc = inv * gate;
#pragma unroll
    for (int i = 0; i < 4; ++i) {
        *(u32x2*)(orow + 8 * i + 4 * hh) = (u32x2){cvtpk(o0[4 * i] * sc, o0[4 * i + 1] * sc), cvtpk(o0[4 * i + 2] * sc, o0[4 * i + 3] * sc)};
        *(u32x2*)(orow + 32 + 8 * i + 4 * hh) = (u32x2){cvtpk(o1[4 * i] * sc, o1[4 * i + 1] * sc), cvtpk(o1[4 * i + 2] * sc, o1[4 * i + 3] * sc)}; }
#undef E1_LOAD
#undef E1_WRITE
}
}
namespace mk {
constexpr int E2_WAVE = 64 * KROW + 512;
template <bool USE_MASK>
__device__ __forceinline__ void e2_wave_unit(LAS unsigned char* ldsw, KP p, int b, int g, int t0, bf16_t* __restrict__ obase, const bf16_t* __restrict__ csrc, int cpitch) {
    const int lane = ftid() & 63, r32 = lane & 31, hh = lane >> 5, qi = r32 >> 2, r4 = r32 & 3;
    const int h = 4 * g + r4, tq = t0 + qi;
    const bf16_t* projb = WSP(bf16_t, O_PROJB);
    const bf16_t* kbase = projb + (size_t)(b * S_) * PB + C_KV + ((1 * 2 + 0) * 2 + g) * 64;
    const bf16_t* vbase = projb + (size_t)(b * S_) * PB + C_KV + ((1 * 2 + 1) * 2 + g) * 64;
    bf16x8 qf[4];
    { const bf16_t* qptr = projb + (size_t)(b * S_ + tq) * PB + h * 64 + 8 * hh;
#pragma unroll
      for (int d0 = 0; d0 < 4; ++d0) qf[d0] = *(const bf16x8*)(qptr + 16 * d0); }
    unsigned qm0 = 0u, qm1 = 0u, qm2 = 0u, qm3 = 0u;
    if (USE_MASK) { const u32x4 mw = *(const u32x4*)(WSP(unsigned, O_SELMASK) + ((size_t)((b * 2 + g) * S_ + t0 + (lane >> 3))) * 4); qm0 = mw.x; qm1 = mw.y; qm2 = mw.z; qm3 = mw.w; }
    else { const int* sp = WSP(int, O_SEL) + ((size_t)((b * 2 + g) * S_ + t0)) * NSEL + lane * 2;
      const int e0 = sp[0], e1 = sp[1];
#pragma unroll
      for (int k = 0; k < 2; ++k) { const int e = k ? e1 : e0; const unsigned bit = 1u << (e & 31); const int wd = e >> 5;
          qm0 |= (wd == 0) ? bit : 0u; qm1 |= (wd == 1) ? bit : 0u; qm2 |= (wd == 2) ? bit : 0u; qm3 |= (wd == 3) ? bit : 0u; }
#pragma unroll
      for (int o = 1; o < 8; o <<= 1) { qm0 |= __shfl_xor(qm0, o); qm1 |= __shfl_xor(qm1, o); qm2 |= __shfl_xor(qm2, o); qm3 |= __shfl_xor(qm3, o); } }
    const unsigned rm0 = __shfl(qm0, qi * 8), rm1 = __shfl(qm1, qi * 8), rm2 = __shfl(qm2, qi * 8), rm3 = __shfl(qm3, qi * 8);
    unsigned um0 = qm0, um1 = qm1, um2 = qm2, um3 = qm3;
#pragma unroll
    for (int o = 8; o < 64; o <<= 1) { um0 |= __shfl_xor(um0, o); um1 |= __shfl_xor(um1, o); um2 |= __shfl_xor(um2, o); um3 |= __shfl_xor(um3, o); }
    LAS int* list = (LAS int*)(ldsw + 64 * KROW);
    int nblk;
    { const bool s0 = (((lane < 32) ? um0 : um1) >> (lane & 31)) & 1u, s1 = (((lane < 32) ? um2 : um3) >> (lane & 31)) & 1u;
      const unsigned long long b0 = __ballot(s0), b1 = __ballot(s1);
      const unsigned long long lower = (lane == 0) ? 0ull : (~0ull >> (64 - lane));
      const int n0 = __popcll(b0);
      if (s0) list[__popcll(b0 & lower)] = lane;
      if (s1) list[n0 + __popcll(b1 & lower)] = lane + 64;
      nblk = n0 + __popcll(b1); }
    asm volatile("s_waitcnt lgkmcnt(0)" ::: "memory");
    const float sl2 = exp2f(-(float)(h + 1)) * LOG2E, tqf = (float)tq;
    f32x16 o0, o1;
#pragma unroll
    for (int r = 0; r < 16; ++r) { o0[r] = 0.f; o1[r] = 0.f; }
    float m = 0.f, l = 0.f; bool have = false;
    const int curq = tq >> 6;
    const int vrow = lane >> 3, vch = lane & 7;
    const int gq = lane >> 4, li = lane & 15;
    const LAS unsigned char* trb = ldsw + (4 * hh + (li >> 2)) * KROW + (16 * (gq & 1) + 4 * (li & 3)) * 2;
    bf16x8 kn0[4], kn1[4]; u32x4 vn[8];
#define E2_LOAD(blk) do { const bf16_t* kp_ = kbase + (size_t)((blk) * 64 + r32) * PB + 8 * hh; const bf16_t* vp_ = vbase + (size_t)((blk) * 64 + vrow) * PB + vch * 8; \
        _Pragma("unroll") for (int d0 = 0; d0 < 4; ++d0) { kn0[d0] = *(const bf16x8*)(kp_ + 16 * d0); kn1[d0] = *(const bf16x8*)(kp_ + (size_t)32 * PB + 16 * d0); } \
        _Pragma("unroll") for (int i = 0; i < 8; ++i) vn[i] = *(const u32x4*)(vp_ + (size_t)(8 * i) * PB); } while (0)
    int blk = list[0];
    blk = __builtin_amdgcn_readfirstlane(blk);
    E2_LOAD(blk);
    for (int it = 0; it < nblk; ++it) {
#pragma unroll
        for (int i = 0; i < 8; ++i) *(LAS u32x4*)(ldsw + (vrow + 8 * i) * KROW + vch * 16) = vn[i];
        const int cur = blk;
        f32x16 p0, p1;
#pragma unroll
        for (int r = 0; r < 16; ++r) { p0[r] = 0.f; p1[r] = 0.f; }
#pragma unroll
        for (int d0 = 0; d0 < 4; ++d0) { p0 = __builtin_amdgcn_mfma_f32_32x32x16_bf16(kn0[d0], qf[d0], p0, 0, 0, 0); p1 = __builtin_amdgcn_mfma_f32_32x32x16_bf16(kn1[d0], qf[d0], p1, 0, 0, 0); }
        if (it + 1 < nblk) { blk = __builtin_amdgcn_readfirstlane(list[it + 1]); E2_LOAD(blk); }
        const unsigned rw = (cur < 32) ? rm0 : (cur < 64) ? rm1 : (cur < 96) ? rm2 : rm3;
        const bool rowsel = (rw >> (cur & 31)) & 1u;
        const int kb = cur * 64 + 4 * hh;
        { const float basef = rowsel ? (sl2 * ((float)kb - tqf) - m) : -INFINITY, base1 = basef + 32.f * sl2;
#pragma unroll
          for (int reg = 0; reg < 16; ++reg) { p0[reg] = p0[reg] * (SCALE * LOG2E) + __builtin_fmaf(sl2, (float)CROW(reg, 0), basef); p1[reg] = p1[reg] * (SCALE * LOG2E) + __builtin_fmaf(sl2, (float)CROW(reg, 0), base1); } }
        if (cur >= curq) {
#pragma unroll
            for (int reg = 0; reg < 16; ++reg) { const int kpos = kb + CROW(reg, 0); p0[reg] = (kpos <= tq) ? p0[reg] : -INFINITY; p1[reg] = (kpos + 32 <= tq) ? p1[reg] : -INFINITY; } }
        SM_CORE(p0, p1, m, l, have, o0, o1);
#pragma unroll
        for (int s = 0; s < 4; ++s) {
            u32x4 pw;
            if (s < 2) { pw.x = cvtpk(p0[8 * s + 0], p0[8 * s + 1]); pw.y = cvtpk(p0[8 * s + 2], p0[8 * s + 3]); pw.z = cvtpk(p0[8 * s + 4], p0[8 * s + 5]); pw.w = cvtpk(p0[8 * s + 6], p0[8 * s + 7]); }
            else { const int s2 = s - 2; pw.x = cvtpk(p1[8 * s2 + 0], p1[8 * s2 + 1]); pw.y = cvtpk(p1[8 * s2 + 2], p1[8 * s2 + 3]); pw.z = cvtpk(p1[8 * s2 + 4], p1[8 * s2 + 5]); pw.w = cvtpk(p1[8 * s2 + 6], p1[8 * s2 + 7]); }
            const bf16x8 pb = __builtin_bit_cast(bf16x8, pw);
            const v4i16_t a0l = __builtin_amdgcn_ds_read_tr16_b64_v4i16((LAS v4i16_t*)(trb + (16 * s) * KROW)), a0h = __builtin_amdgcn_ds_read_tr16_b64_v4i16((LAS v4i16_t*)(trb + (16 * s + 8) * KROW));
            const v4i16_t a1l = __builtin_amdgcn_ds_read_tr16_b64_v4i16((LAS v4i16_t*)(trb + (16 * s) * KROW + 64)), a1h = __builtin_amdgcn_ds_read_tr16_b64_v4i16((LAS v4i16_t*)(trb + (16 * s + 8) * KROW + 64));
            const bf16x8 va0 = (bf16x8){a0l[0], a0l[1], a0l[2], a0l[3], a0h[0], a0h[1], a0h[2], a0h[3]}, va1 = (bf16x8){a1l[0], a1l[1], a1l[2], a1l[3], a1h[0], a1h[1], a1h[2], a1h[3]};
            o0 = __builtin_amdgcn_mfma_f32_32x32x16_bf16(va0, pb, o0, 0, 0, 0); o1 = __builtin_amdgcn_mfma_f32_32x32x16_bf16(va1, pb, o1, 0, 0, 0); }
    }
    l += __shfl_xor(l, 32);
    const float sc = ((l > 0.f) ? 1.f / l : 0.f) * WSP(float, O_GF)[(size_t)(b * S_ + tq) * 32 + 1 * 8 + h];
    bf16_t* orow = obase + (size_t)(b * S_ + tq) * D_ + h * 64; const bf16_t* crow = csrc + (size_t)(b * S_ + tq) * cpitch + h * 64;
#pragma unroll
    for (int i = 0; i < 4; ++i) {
        const u32x2 c0 = *(const u32x2*)(crow + 8 * i + 4 * hh), c1 = *(const u32x2*)(crow + 32 + 8 * i + 4 * hh);
        const float x00 = __uint_as_float(c0.x << 16) + o0[4 * i] * sc, x01 = __uint_as_float(c0.x & 0xffff0000u) + o0[4 * i + 1] * sc, x02 = __uint_as_float(c0.y << 16) + o0[4 * i + 2] * sc, x03 = __uint_as_float(c0.y & 0xffff0000u) + o0[4 * i + 3] * sc;
        const float x10 = __uint_as_float(c1.x << 16) + o1[4 * i] * sc, x11 = __uint_as_float(c1.x & 0xffff0000u) + o1[4 * i + 1] * sc, x12 = __uint_as_float(c1.y << 16) + o1[4 * i + 2] * sc, x13 = __uint_as_float(c1.y & 0xffff0000u) + o1[4 * i + 3] * sc;
        *(u32x2*)(orow + 8 * i + 4 * hh) = (u32x2){cvtpk(x00, x01), cvtpk(x02, x03)}; *(u32x2*)(orow + 32 + 8 * i + 4 * hh) = (u32x2){cvtpk(x10, x11), cvtpk(x12, x13)}; }
#undef E2_LOAD
}
template <bool USE_MASK>
__device__ __forceinline__ void ph_attn_sel2(LAS unsigned char* lds3, KP p, bf16_t* __restrict__ obase, const bf16_t* __restrict__ csrc, int cpitch) {
    const int w = __builtin_amdgcn_readfirstlane(ftid() >> 6);
    LAS unsigned char* ldsw = lds3 + w * E2_WAVE;
    MK_LOOP(u, 512) { const int bg = u & 3, qblk = u >> 2; e2_wave_unit<USE_MASK>(ldsw, p, bg >> 1, bg & 1, qblk * 64 + 8 * w, obase, csrc, cpitch); }
}
}
namespace mk {
constexpr int E3_K = 0, E3_V = 512 * KROW, E3_BYTES = 2 * 512 * KROW;
__device__ __forceinline__ void e3_unit(LAS unsigned char* lds, KP p, int b, int g, int qb, bf16_t* __restrict__ ocmp, unsigned* __restrict__ selmask) {
    const int tid = ftid(), lane = tid & 63, w = __builtin_amdgcn_readfirstlane(tid >> 6), r32 = lane & 31, hh = lane >> 5;
    const int bg = b * 2 + g, q0 = qb * 256, qrow0 = q0 + 32 * w, tq = qrow0 + r32;
    const bf16_t* projb = WSP(bf16_t, O_PROJB);
    int nun = (q0 + 255 - 31) / 16 + 1; if (nun > 511) nun = 511;
    const int ntile_u = (nun + 63) >> 6;
    __syncthreads();
    { const int srow = tid >> 3, sch = tid & 7; const bf16_t* ks = WSP(bf16_t, O_KCMPB) + ((size_t)bg * 512 + srow) * 64 + sch * 8; const bf16_t* vs = WSP(bf16_t, O_VCMPB) + ((size_t)bg * 512 + srow) * 64 + sch * 8;
      for (int i = 0; i < ntile_u; ++i) { const u32x4 kv = *(const u32x4*)(ks + (size_t)i * 64 * 64), vv = *(const u32x4*)(vs + (size_t)i * 64 * 64);
          *(LAS u32x4*)(lds + E3_K + (srow + 64 * i) * KROW + sch * 16) = kv; *(LAS u32x4*)(lds + E3_V + (srow + 64 * i) * KROW + sch * 16) = vv; } }
    __syncthreads();
    int nw = qrow0 / 16 + 1; if (nw > 511) nw = 511;
    const int ntile_w = (qrow0 + 31 < 31) ? 0 : ((nw + 63) >> 6);
    const float tqf = (float)tq;
    const int gq = lane >> 4, li = lane & 15;
    const LAS unsigned char* trb = lds + E3_V + (4 * hh + (li >> 2)) * KROW + (16 * (gq & 1) + 4 * (li & 3)) * 2;
    const LAS unsigned char* kfb = lds + E3_K + r32 * KROW + hh * 16;
    float imp[64];
#pragma unroll
    for (int i = 0; i < 64; ++i) imp[i] = 0.f;
#pragma unroll 1
    for (int r4 = 0; r4 < 4; ++r4) {
        const int h = 4 * g + r4; const float sl2 = exp2f(-(float)(h + 1)) * LOG2E;
        bf16x8 qf[4];
        { const bf16_t* qptr = projb + (size_t)(b * S_ + tq) * PB + h * 64 + 8 * hh;
#pragma unroll
          for (int d0 = 0; d0 < 4; ++d0) qf[d0] = *(const bf16x8*)(qptr + 16 * d0); }
        f32x16 o0, o1;
#pragma unroll
        for (int r = 0; r < 16; ++r) { o0[r] = 0.f; o1[r] = 0.f; }
        float m = 0.f, l = 0.f; bool have = false;
#define E3_ST(jt) f32x16 p0, p1; { _Pragma("unroll") for (int r = 0; r < 16; ++r) { p0[r] = 0.f; p1[r] = 0.f; } \
            _Pragma("unroll") for (int d0 = 0; d0 < 4; ++d0) { const bf16x8 a0 = *(const LAS bf16x8*)(kfb + (64 * (jt)) * KROW + d0 * 32), a1 = *(const LAS bf16x8*)(kfb + (64 * (jt) + 32) * KROW + d0 * 32); \
                p0 = __builtin_amdgcn_mfma_f32_32x32x16_bf16(a0, qf[d0], p0, 0, 0, 0); p1 = __builtin_amdgcn_mfma_f32_32x32x16_bf16(a1, qf[d0], p1, 0, 0, 0); } \
            int tq_ = tq; asm volatile("" : "+v"(tq_));     \
            int hh_ = hh; asm volatile("" : "+v"(hh_)); \
            const float tqf_ = (float)tq_; const int ce0_ = 16 * (64 * (jt) + 4 * hh_) + 31; \
            const float basef_ = sl2 * ((float)ce0_ - tqf_) - m, base1_ = basef_ + 512.f * sl2; \
            _Pragma("unroll") for (int reg = 0; reg < 16; ++reg) { const float cr_ = sl2 * (float)(16 * CROW(reg, 0)); p0[reg] = p0[reg] * (SCALE * LOG2E) + (basef_ + cr_); p1[reg] = p1[reg] * (SCALE * LOG2E) + (base1_ + cr_); } \
            if (ce0_ + 16 * 27 + 512 > qrow0) {     \
                _Pragma("unroll") for (int reg = 0; reg < 16; ++reg) { const int ce = ce0_ + 16 * CROW(reg, 0); p0[reg] = (ce <= tq_) ? p0[reg] : -INFINITY; p1[reg] = (ce + 512 <= tq_) ? p1[reg] : -INFINITY; } } }
        for (int jt = 0; jt < ntile_w; ++jt) {
            E3_ST(jt);
            SM_CORE(p0, p1, m, l, have, o0, o1);
            const LAS unsigned char* tb = trb + (64 * jt) * KROW;
#pragma unroll
            for (int s = 0; s < 4; ++s) {
                u32x4 pw;
                if (s < 2) { pw.x = cvtpk(p0[8 * s + 0], p0[8 * s + 1]); pw.y = cvtpk(p0[8 * s + 2], p0[8 * s + 3]); pw.z = cvtpk(p0[8 * s + 4], p0[8 * s + 5]); pw.w = cvtpk(p0[8 * s + 6], p0[8 * s + 7]); }
                else { const int s2 = s - 2; pw.x = cvtpk(p1[8 * s2 + 0], p1[8 * s2 + 1]); pw.y = cvtpk(p1[8 * s2 + 2], p1[8 * s2 + 3]); pw.z = cvtpk(p1[8 * s2 + 4], p1[8 * s2 + 5]); pw.w = cvtpk(p1[8 * s2 + 6], p1[8 * s2 + 7]); }
                const bf16x8 pb = __builtin_bit_cast(bf16x8, pw);
                const v4i16_t a0l = __builtin_amdgcn_ds_read_tr16_b64_v4i16((LAS v4i16_t*)(tb + (16 * s) * KROW)), a0h = __builtin_amdgcn_ds_read_tr16_b64_v4i16((LAS v4i16_t*)(tb + (16 * s + 8) * KROW));
                const v4i16_t a1l = __builtin_amdgcn_ds_read_tr16_b64_v4i16((LAS v4i16_t*)(tb + (16 * s) * KROW + 64)), a1h = __builtin_amdgcn_ds_read_tr16_b64_v4i16((LAS v4i16_t*)(tb + (16 * s + 8) * KROW + 64));
                const bf16x8 va0 = (bf16x8){a0l[0], a0l[1], a0l[2], a0l[3], a0h[0], a0h[1], a0h[2], a0h[3]}, va1 = (bf16x8){a1l[0], a1l[1], a1l[2], a1l[3], a1h[0], a1h[1], a1h[2], a1h[3]};
                o0 = __builtin_amdgcn_mfma_f32_32x32x16_bf16(va0, pb, o0, 0, 0, 0); o1 = __builtin_amdgcn_mfma_f32_32x32x16_bf16(va1, pb, o1, 0, 0, 0); }
        }
        l += __shfl_xor(l, 32);
        const float inv = (l > 0.f) ? 1.f / l : 0.f;
        { const float sc = inv * WSP(float, O_GF)[(size_t)(b * S_ + tq) * 32 + 0 * 8 + h];
          bf16_t* orow = ocmp + (size_t)(b * S_ + tq) * 512 + h * 64;
#pragma unroll
          for (int i = 0; i < 4; ++i) {
              *(u32x2*)(orow + 8 * i + 4 * hh) = (u32x2){cvtpk(o0[4 * i] * sc, o0[4 * i + 1] * sc), cvtpk(o0[4 * i + 2] * sc, o0[4 * i + 3] * sc)};
              *(u32x2*)(orow + 32 + 8 * i + 4 * hh) = (u32x2){cvtpk(o1[4 * i] * sc, o1[4 * i + 1] * sc), cvtpk(o1[4 * i + 2] * sc, o1[4 * i + 3] * sc)}; } }
#pragma unroll
        for (int jt = 0; jt < 8; ++jt) {
            if (jt < ntile_w) {
                E3_ST(jt);
#pragma unroll
                for (int reg = 0; reg < 16; ++reg) { p0[reg] = __builtin_amdgcn_exp2f(p0[reg]) * inv; p1[reg] = __builtin_amdgcn_exp2f(p1[reg]) * inv; }
#pragma unroll
                for (int pa = 0; pa < 2; ++pa)
#pragma unroll
                    for (int i = 0; i < 4; ++i) { const int jj = 8 * jt + 4 * pa + i;
                        const float x0 = pa ? p1[4 * i] : p0[4 * i], x1 = pa ? p1[4 * i + 1] : p0[4 * i + 1], x2 = pa ? p1[4 * i + 2] : p0[4 * i + 2], x3 = pa ? p1[4 * i + 3] : p0[4 * i + 3];
                        const float c = 0.5f * x3, a = (x0 + x1) + (x2 + c), r = __shfl_xor(c, 32);
                        imp[jj] += a + (hh ? r : 0.f);
                        if (jj + 1 < 64) imp[jj + 1] += (hh ? 0.f : r); }
            }
        }
#undef E3_ST
    }
    const int cur = tq >> 6;
#pragma unroll
    for (int jj = 0; jj < 64; ++jj) { const int j = 2 * jj + hh; imp[jj] = (j != 0 && j < cur - 1) ? imp[jj] : -1.f; }
    unsigned m0 = 1u, m1 = 0u, m2 = 0u, m3 = 0u;
#define E3_SETBIT(j) do { const unsigned bit_ = 1u << ((j) & 31); const int wd_ = (j) >> 5; m0 |= (wd_ == 0) ? bit_ : 0u; m1 |= (wd_ == 1) ? bit_ : 0u; m2 |= (wd_ == 2) ? bit_ : 0u; m3 |= (wd_ == 3) ? bit_ : 0u; } while (0)
    E3_SETBIT(cur); if (cur >= 1) E3_SETBIT(cur - 1);
#pragma unroll 1
    for (int it = 0; it < NSEL - 3; ++it) {
        float best = -0.5f; int bj = 0;
#pragma unroll
        for (int jj = 0; jj < 64; ++jj) { if (imp[jj] > best) { best = imp[jj]; bj = jj; } }
        const int myj = 2 * bj + hh; const float ob = __shfl_xor(best, 32); const int oj = __shfl_xor(myj, 32);
        const bool mine = (best > ob) || (best == ob && myj < oj);
        const float wv = mine ? best : ob; const int wj = mine ? myj : oj;
        if (wv >= 0.f) E3_SETBIT(wj);
        if (mine && best >= 0.f) {
#pragma unroll
            for (int jj = 0; jj < 64; ++jj) imp[jj] = (jj == bj) ? -2.f : imp[jj]; }
    }
#undef E3_SETBIT
    if (hh == 0) *(u32x4*)(selmask + ((size_t)bg * S_ + tq) * 4) = (u32x4){m0, m1, m2, m3};
}
}
namespace mk {
template <int MODE>
__device__ __forceinline__ void ph_attn1(float* lds, LAS unsigned char* lds3, KP p, unsigned* qctr, bf16_t* obase, bf16_t* owin, const unsigned* kmax2) {
    LAS int* qslot = (LAS int*)(lds3 + E3_BYTES);
    constexpr int N_E3 = (MODE & 2) ? 128 : 0, N_CMP = (MODE & 1) ? 64 : 0, N_FOX = (MODE & 4) ? 256 : 0, N_WIN = (MODE & 8) ? 512 : 0, N_SB = (MODE & 16) ? 256 : 0;
    for (;;) {
        __syncthreads();
        if (ftid() == 0) *qslot = (int)atomicAdd(qctr, 1u);
        __syncthreads();
        int u = __builtin_amdgcn_readfirstlane(*qslot);
        if (u >= N_E3 + N_CMP + N_FOX + N_WIN + N_SB) break;
        if (u < N_E3) { e3_unit(lds3, p, (u & 3) >> 1, u & 1, 31 - (u >> 2), WSP(bf16_t, O_OCMP), WSP(unsigned, O_SELMASK)); continue; } u -= N_E3;
        if (u < N_FOX) { e1_unit<0>(lds3, p, (u & 7) >> 2, u & 3, 31 - (u >> 3), obase, owin, kmax2); continue; } u -= N_FOX;
        if (u < N_WIN) { e1_unit<1>(lds3, p, (u & 3) >> 1, u & 1, 127 - (u >> 2), obase, owin, kmax2); continue; } u -= N_WIN;
        if (u < N_SB) e1_unit<2>(lds3, p, (u & 7) >> 2, u & 3, 31 - (u >> 3), obase, owin, kmax2);
    }
}
}
namespace mk {
#define RLX_AGENT __ATOMIC_RELAXED, __HIP_MEMORY_SCOPE_AGENT
#define XB_TMO      128
#define XB_XCNT(j)  (256  + 64 * (j))
#define XB_XSUB(j)  (1280 + 64 * (j))
#define XB_XGEN(j)  (2304 + 64 * (j))
#define XB_TOP      3328
#define XB_TOPGEN   3392
#define XCD_BAR_WORDS 3456
#define XB_SPIN_CAP (1u << 18)

__device__ __forceinline__ unsigned xb_ld(unsigned* p)              { return __hip_atomic_load(p, __ATOMIC_RELAXED, __HIP_MEMORY_SCOPE_AGENT); }
__device__ __forceinline__ unsigned xb_add(unsigned* p, unsigned v) { return __hip_atomic_fetch_add(p, v, __ATOMIC_RELAXED, __HIP_MEMORY_SCOPE_AGENT); }
__device__ __forceinline__ unsigned xb_xcc_id() { return (unsigned)__builtin_amdgcn_s_getreg((3 << 11) | 20) & 0xFu; }
#define XB_SPIN(cond, bar) do { unsigned _sp = 0; while (cond) { __builtin_amdgcn_s_sleep(1); \
    if ((++_sp & 255u) == 0u) { if (xb_ld(&(bar)[XB_TMO])) break; if (_sp > XB_SPIN_CAP) { atomicAdd(&(bar)[XB_TMO], 1u); break; } } } } while (0)

struct XcdBarrier {
    unsigned* bar; unsigned x;
    volatile LAS unsigned* st;
};

__device__ __forceinline__ XcdBarrier xcd_barrier_post(unsigned* bar, volatile LAS unsigned* st) {
    XcdBarrier b; b.bar = bar; b.x = xb_xcc_id(); b.st = st;
    if (threadIdx.x == 0) (void)xb_add(&bar[XB_XCNT(b.x)], 1u);
    return b;
}
__device__ __forceinline__ void xcd_barrier_complete(unsigned* bar, unsigned x, unsigned& nloc, unsigned& nx) {
    const unsigned G = gridDim.x * gridDim.y * gridDim.z;
    unsigned sum, cnt, mine, sp = 0u;
    for (;;) {
        sum = 0u; cnt = 0u; mine = 0u;
#pragma unroll
        for (unsigned j = 0; j < 16; ++j) { const unsigned c = xb_ld(&bar[XB_XCNT(j)]); sum += c; cnt += (c > 0u) ? 1u : 0u; mine = (j == x) ? c : mine; }
        if (sum == G) break;
        __builtin_amdgcn_s_sleep(1);
        if ((++sp & 255u) == 0u) { if (xb_ld(&bar[XB_TMO])) break; if (sp > XB_SPIN_CAP) { atomicAdd(&bar[XB_TMO], 1u); break; } }
    }
    nloc = mine > 0u ? mine : 1u; nx = cnt > 0u ? cnt : 1u;
}

__device__ __forceinline__ void xcd_barrier(const XcdBarrier& b) {
    asm volatile("s_waitcnt vmcnt(0)" ::: "memory");
    __syncthreads();
    if (threadIdx.x == 0) {
        unsigned* bar = b.bar;
        __builtin_amdgcn_s_waitcnt(0);
        unsigned nloc = b.st[0], nx = b.st[1];
        if (nloc == 0u) { xcd_barrier_complete(bar, b.x, nloc, nx); b.st[0] = nloc; b.st[1] = nx; }
        const unsigned old = xb_add(&bar[XB_XSUB(b.x)], 1u);
        const unsigned gen = old / nloc;
        if (old + 1u == (gen + 1u) * nloc) {
            __builtin_amdgcn_fence(__ATOMIC_RELEASE, "agent");
            asm volatile("s_waitcnt vmcnt(0)" ::: "memory");
            const unsigned og = xb_add(&bar[XB_TOP], 1u);
            const unsigned tg = og / nx;
            if (og + 1u == (tg + 1u) * nx) xb_add(&bar[XB_TOPGEN], 1u);
            else XB_SPIN(xb_ld(&bar[XB_TOPGEN]) == tg, bar);
            __builtin_amdgcn_fence(__ATOMIC_ACQUIRE, "agent");
            xb_add(&bar[XB_XGEN(b.x)], 1u);
            asm volatile("s_waitcnt vmcnt(0)" ::: "memory");
        } else {
            XB_SPIN(xb_ld(&bar[XB_XGEN(b.x)]) == gen, bar);
            __builtin_amdgcn_fence(__ATOMIC_ACQUIRE, "agent");
            asm volatile("s_waitcnt vmcnt(0)" ::: "memory");
        }
    }
    __syncthreads();
}

}
namespace cg = cooperative_groups;
constexpr int NSTEP = 12;
__global__ void __launch_bounds__(512, 2) mega(mk::P p_unused) {
    extern __shared__ __attribute__((aligned(16))) unsigned char lds_raw[];
    float* lds = (float*)lds_raw;
    LAS unsigned char* lds3 = (LAS unsigned char*)lds_raw;
    using namespace nv; using namespace mk;
    volatile LAS unsigned* bst = (volatile LAS unsigned*)(lds3 + E3_BYTES + 128);
    if (threadIdx.x < 2) bst[threadIdx.x] = 0u;
    __syncthreads();
    XcdBarrier bar;
    { const KP p = fresh_kp(); bar = xcd_barrier_post(WSP(unsigned, O_COUNTS + 16384), bst); }
    cg::this_grid().sync();
    for (int step = 0; step < 1 + NSTEP * L_; ++step) {
        const KP p = fresh_kp();
        const int l = (step - 1) / NSTEP, k = (step == 0) ? -1 : (step - 1) % NSTEP;
        const bool isg = (k == 0 || k == 1 || k == 6 || k == 9 || k == 10);
#ifdef PROBE_K
        const int nrep = (k == PROBE_K) ? PROBE_N : 1;
#else
        const int nrep = 1;
#endif
        for (int rep = 0; rep < nrep; ++rep) {
        if (isg) {
            const int kind = (k == 0) ? 0 : (k == 1) ? 4 : (k == 6) ? 1 : (k == 9) ? 2 : 3;
            GSched S; GEpi E; S.kind = kind; E.kind = kind; E.l = l;
            S.G = (int)gridDim.x; S.c = fbid(); S.meta = WSP(int, O_META); S.rowtok = WSP(int, O_ROWTOK); S.estep = 0;
            const char* A; int N, K = D_;
            if (kind == 0) { A = (const char*)WSP(bf16_t, O_XB); S.Bt = (const char*)(WSP(bf16_t, O_WTIN) + (size_t)l * NPAD * D_); N = NPAD; }
            else if (kind == 1) { A = (const char*)WSP(bf16_t, O_OB); S.Bt = (const char*)(WSP(bf16_t, O_WTOUT) + (size_t)l * D_ * D_); N = D_; }
            else if (kind == 2) { A = (const char*)WSP(bf16_t, O_X1B); S.Bt = (const char*)(WSP(bf16_t, O_WTGU) + (size_t)l * NE * 2048 * D_); S.estep = (size_t)2048 * D_ * 2; N = 2048; }
            else if (kind == 3) { A = (const char*)WSP(bf16_t, O_ACT); S.Bt = (const char*)(WSP(bf16_t, O_WTDN) + (size_t)l * NE * D_ * D_); S.estep = (size_t)D_ * D_ * 2; N = D_; }
            else { A = (const char*)WSP(bf16_t, O_PROJB); S.Bt = (const char*)(WSP(bf16_t, O_WT1) + (size_t)l * 2 * 256 * 2048); S.estep = (size_t)256 * 2048 * 2; N = 256; K = 2048; }
            S.nN = N / 256; S.nM = (kind < 2) ? T_ / 256 : (kind == 4) ? 16 : S.meta[32]; S.nunits = S.nM * S.nN;
            pg8::gemm_phase<GEpi, GSched>(lds3, A, K, S, E);
            if (kind == 4) ph_cumsum(lds, p, 16);
            if (kind == 0) ph_bias1_reduce(p, l);
        } else {
            switch (k) {
                case -1: ph_convert(lds3, p); break;
                case 2: ph_prep2(p, l); break;
#ifdef PROBE_AMODE
                case 3: if (rep == 0) ph_attn1<30>(lds, lds3, p, WSP(unsigned, O_COUNTS) + 128 + l * 8 + rep, WSP(bf16_t, O_O), WSP(bf16_t, O_OWIN), WSP(unsigned, O_COUNTS) + 192 + l * 8);
                        else ph_attn1<PROBE_AMODE>(lds, lds3, p, WSP(unsigned, O_COUNTS) + 128 + l * 8 + rep, WSP(bf16_t, O_O), WSP(bf16_t, O_OWIN), WSP(unsigned, O_COUNTS) + 192 + l * 8);
                        break;
#else
                case 3: ph_attn1<30>(lds, lds3, p, WSP(unsigned, O_COUNTS) + 128 + l * 8 + rep, WSP(bf16_t, O_O), WSP(bf16_t, O_OWIN), WSP(unsigned, O_COUNTS) + 192 + l * 8); break;
#endif
                case 4: ph_attn_sel2<true>(lds3, p, WSP(bf16_t, O_O), WSP(bf16_t, O_OCMP), 512); break;
                case 5: ph_rmsnorm(p, l); break;
                case 7: ph_ln<true>(lds, p, l, WSP(float, O_X1), (rep + 1 < nrep) ? 2048 * (rep + 1) : 0); break;
                case 8: ph_moe_scatter2(lds, p, l); break;
                default: { float* xout = (l == L_ - 1) ? p->out : WSP(float, O_XA); ph_ln<false>(lds, p, l, xout); } break;
            }
        }
        xcd_barrier(bar);
        }
    }
#ifdef PROBE_SYNC
    for (int i = 0; i < PROBE_SYNC; ++i) xcd_barrier(bar);
#endif
}

extern "C" void kernel_launch(void* const* d_in, const int* in_sizes, int n_in,
                              void* d_out, int out_size, void* d_ws, size_t ws_size,
                              hipStream_t stream) {
    constexpr size_t kDynLds = 147456 + 1024;
    static int grid_blocks = 0;
    if (!grid_blocks) {
        int dev = 0, cus = 0, per_cu = 0;
        (void)hipGetDevice(&dev);
        (void)hipDeviceGetAttribute(&cus, hipDeviceAttributeMultiprocessorCount, dev);
        (void)hipFuncSetAttribute((const void*)mega, hipFuncAttributeMaxDynamicSharedMemorySize, (int)kDynLds);
        (void)hipOccupancyMaxActiveBlocksPerMultiprocessor(&per_cu, mega, 512, kDynLds);
        if (per_cu < 1) per_cu = 1;
        if (per_cu > 1) per_cu = 1;
        grid_blocks = cus * per_cu;
        if (ws_size < mk::O_END) fprintf(stderr, "workspace too small: %zu < %zu\n", ws_size, (size_t)mk::O_END);
    }
    mk::P p{};
    p.in = nv::inputs(d_in); p.ws = (unsigned char*)d_ws; p.out = (float*)d_out;
    (void)hipMemsetAsync((char*)d_ws + mk::O_COUNTS, 0, 65536, stream);
    void* args[] = {&p};
    hipError_t e = hipLaunchCooperativeKernel((void*)mega, dim3(grid_blocks), dim3(512), args, kDynLds, stream);
    if (e != hipSuccess) fprintf(stderr, "cooperative launch failed: %s (grid %d)\n", hipGetErrorString(e), grid_blocks);
}
```

```cpp
#include <hip/hip_runtime.h>
#include <hip/hip_cooperative_groups.h>
#include <cstdio>
#include <cstdint>

namespace nv {

constexpr int B_ = 2, S_ = 8192, D_ = 1024, T_ = B_ * S_, L_ = 2;
constexpr int DIN = 2844;
constexpr int OFF_NSA_KV = 512, OFF_NSA_GATE = 1280, OFF_FOX_QKV = 1304, OFF_FOX_F = 2072, OFF_SB_QKV = 2076;
constexpr int NCMP = 511, NBLK = 128, NSEL = 16;
constexpr int NE = 32, TOPK = 4, MROWS = T_ * TOPK;
constexpr float LN_EPS = 1e-5f, RMS_EPS = 1e-6f;
constexpr float ALPHA = 1.4142135623730951f;
constexpr float SCALE = 0.125f;

__device__ __forceinline__ float sigmoidf_(float x) { return 1.f / (1.f + __expf(-x)); }
__device__ __forceinline__ float logsig(float x) { return fminf(x, 0.f) - log1pf(expf(-fabsf(x))); }

__device__ __forceinline__ float gelu_tanh(float x) { return 0.5f * x * (1.f + tanhf(0.7978845608028654f * (x + 0.044715f * x * x * x))); }
__device__ __forceinline__ float wsum(float v) {
#pragma unroll
    for (int o = 1; o < 64; o <<= 1) v += __shfl_xor(v, o);
    return v;
}
struct In {
    const float *x, *w_in, *b_in, *pos_k, *pos_v, *w1k, *w2k, *w1v, *w2v, *g_out, *w_out, *ln1_g, *ln1_b, *rw, *rb, *wgu, *bgu, *wdn, *bdn, *ln2_g, *ln2_b;
};
inline In inputs(void* const* d) {
    In i; i.x = (const float*)d[0]; i.w_in = (const float*)d[1]; i.b_in = (const float*)d[2]; i.pos_k = (const float*)d[3]; i.pos_v = (const float*)d[4];
    i.w1k = (const float*)d[5]; i.w2k = (const float*)d[6]; i.w1v = (const float*)d[7]; i.w2v = (const float*)d[8]; i.g_out = (const float*)d[9]; i.w_out = (const float*)d[10];
    i.ln1_g = (const float*)d[11]; i.ln1_b = (const float*)d[12]; i.rw = (const float*)d[13]; i.rb = (const float*)d[14]; i.wgu = (const float*)d[15]; i.bgu = (const float*)d[16];
    i.wdn = (const float*)d[17]; i.bdn = (const float*)d[18]; i.ln2_g = (const float*)d[19]; i.ln2_b = (const float*)d[20]; return i;
}


}
namespace pg8 {
#define PG8_LAS __attribute__((address_space(3)))
typedef unsigned short bf16_t;
typedef short bf16x8 __attribute__((ext_vector_type(8)));
typedef float f32x4 __attribute__((ext_vector_type(4)));
typedef unsigned u32x4 __attribute__((ext_vector_type(4)));
constexpr int BM = 256, BK = 64, HALF = 128, HTB = HALF * BK * 2  , STAGE_BYTES = 8 * HTB, NXCD = 8, WGM = 8;

__host__ __device__ __forceinline__ int lds_byte(int r, int c) { const int st = (r >> 4) * 2 + (c >> 5), rr = r & 15, cc = c & 31, ob = rr * 64 + cc * 2; return st * 1024 + (ob ^ (((ob >> 9) & 1) << 5)); }
__host__ __device__ __forceinline__ void stage_rc(int b, int& R, int& C) { const int st = b / 1024, sb = b % 1024, swz = sb ^ (((sb >> 9) & 1) << 5); R = (st >> 1) * 16 + swz / 64; C = (st & 1) * 32 + (swz % 64) / 2; }
__host__ __device__ __forceinline__ int perm32(int rho) { const int n = rho >> 4, i = rho & 15; return 8 * (i >> 2) + 4 * n + (i & 3); }

struct Unit { int pm, pn, e, nr; };

__device__ __forceinline__ unsigned cvt_pk_bf16(float lo, float hi) { unsigned r; asm volatile("v_cvt_pk_bf16_f32 %0, %1, %2" : "=v"(r) : "v"(lo), "v"(hi)); return r; }
template <class Epi, class Sched, bool ALIGN_EPI = true, bool SP2 = true>
__device__ __forceinline__ void gemm_phase(PG8_LAS unsigned char* lds, const char* Abase, const int K, const Sched& S, const Epi& E) {
    int tid_ = threadIdx.x; asm volatile("" : "+v"(tid_));
    const int tid = tid_, wid = __builtin_amdgcn_readfirstlane(tid >> 6), lane = tid & 63, wr = wid >> 2, wc = wid & 3, fr = lane & 15, fq = lane >> 4;
    const int nt = K / BK;
    unsigned voffB[2];
#pragma unroll
    for (int i = 0; i < 2; ++i) { int R, C; stage_rc(tid * 16 + i * 8192, R, C); const int Rb = Epi::PERM ? ((R & ~31) + perm32(R & 31)) : R;
        voffB[i] = (unsigned)(Rb * K + C) * 2u; }
#define PG8_AOFF(u, o0, o1) do { int _t = tid; asm volatile("" : "+v"(_t)); _Pragma("unroll") for (int _i = 0; _i < 2; ++_i) { int _R, _C; stage_rc(_t * 16 + _i * 8192, _R, _C); \
        (o0)[_i] = S.a_off((u), _R) + (unsigned)_C * 2u; (o1)[_i] = S.a_off((u), HALF + _R) + (unsigned)_C * 2u; } } while (0)
    const size_t kstep = (size_t)(BK * 2);
    const size_t akstep = S.a_kstep();
    const size_t hstep = (size_t)HALF * K * 2;
    const unsigned ldsw = (unsigned)wid * 1024u;
    const int aoff = lds_byte(wr * 64 + fr, fq * 8), boff = lds_byte(wc * 32 + fr, fq * 8);
#define PG8_SA(b, h) (((b) * 2 + (h)) * HTB)
#define PG8_SB(b, h) ((4 + (b) * 2 + (h)) * HTB)
#define PG8_STAGE(bufoff, gbase, voff) do { _Pragma("unroll") for (int _i = 0; _i < 2; ++_i) { unsigned _o = (voff)[_i]; asm volatile("" : "+v"(_o));     \
        __builtin_amdgcn_global_load_lds((const unsigned*)((const char*)(gbase) + _o), (PG8_LAS unsigned*)(lds + (bufoff) + ldsw + _i * 8192), 16, 0, 0); } } while (0)
#define PG8_LDA(dst, b, h) do { _Pragma("unroll") for (int m = 0; m < 4; ++m) _Pragma("unroll") for (int k = 0; k < 2; ++k) dst[m][k] = *(const PG8_LAS bf16x8*)(lds + PG8_SA(b, h) + aoff + m * 2048 + k * 1024); } while (0)
#define PG8_LDB(dst, b, h) do { _Pragma("unroll") for (int n = 0; n < 2; ++n) _Pragma("unroll") for (int k = 0; k < 2; ++k) dst[n][k] = *(const PG8_LAS bf16x8*)(lds + PG8_SB(b, h) + boff + n * 2048 + k * 1024); } while (0)
#define PG8_MMA(ai, bj, At, Bt) do { __builtin_amdgcn_s_setprio(1); _Pragma("unroll") for (int m = 0; m < 4; ++m) _Pragma("unroll") for (int n = 0; n < 2; ++n) _Pragma("unroll") for (int k = 0; k < 2; ++k) \
        acc[ai][bj][m][n] = __builtin_amdgcn_mfma_f32_16x16x32_bf16(Bt[n][k], At[m][k], acc[ai][bj][m][n], 0, 0, 0); __builtin_amdgcn_s_setprio(0); } while (0)
#define PG8_WAIT_V(n) asm volatile("s_waitcnt vmcnt(" #n ")" ::: "memory")
#define PG8_WAIT_L(n) asm volatile("s_waitcnt lgkmcnt(" #n ")" ::: "memory")
#define PG8_BAR __builtin_amdgcn_s_barrier()
#define PG8_SCHED __builtin_amdgcn_sched_barrier(0)
    Unit cur, nxt; int ui = 0;
    if (!S.next(0, cur)) return;
    f32x4 acc[2][2][4][2];
    float zf_ = 0.f; asm volatile("" : "+v"(zf_));
#pragma unroll
    for (int a = 0; a < 2; ++a)
#pragma unroll
        for (int b = 0; b < 2; ++b)
#pragma unroll
            for (int m = 0; m < 4; ++m)
#pragma unroll
                for (int n = 0; n < 2; ++n) acc[a][b][m][n] = (f32x4){zf_, zf_, zf_, zf_};
    bf16x8 At[4][2], B0[2][2], B1[2][2];
    unsigned ca0[2], ca1[2], na0[2], na1[2];
    PG8_AOFF(cur, ca0, ca1);
    const char* const cA = Abase; const char* cB = S.b_base(cur);
    if constexpr (SP2) {
        PG8_STAGE(PG8_SB(0, 0), cB, voffB); PG8_STAGE(PG8_SB(0, 1), cB + hstep, voffB); PG8_STAGE(PG8_SA(0, 0), cA, ca0); PG8_STAGE(PG8_SA(0, 1), cA, ca1);
        if (wr == 1) PG8_BAR;
        PG8_WAIT_V(2); PG8_BAR;
        PG8_STAGE(PG8_SB(1, 0), cB + kstep, voffB); PG8_STAGE(PG8_SA(1, 0), cA + akstep, ca0); PG8_STAGE(PG8_SB(1, 1), cB + hstep + kstep, voffB);
        PG8_WAIT_V(6); PG8_BAR;
    } else { static_assert(SP2, "only the SP2 loop is kept"); }
    for (;;) {
        const bool has_next = S.next(ui + 1, nxt);
        const char* nB = has_next ? S.b_base(nxt) : cB;
        if (has_next) { PG8_AOFF(nxt, na0, na1); } else { na0[0] = ca0[0]; na0[1] = ca0[1]; na1[0] = ca1[0]; na1[1] = ca1[1]; }
        for (int t = 0; t < nt - 2; t += 2) {
            const char* a1 = cA + (size_t)(t + 1) * akstep;
            const char* a2 = cA + (size_t)(t + 2) * akstep; const char* b2 = cB + (size_t)(t + 2) * kstep;
            const char* a3 = a2 + akstep; const char* b3 = b2 + kstep;
            PG8_LDB(B0, 0, 0); PG8_LDB(B1, 0, 1); PG8_SCHED; PG8_LDA(At, 0, 0); PG8_STAGE(PG8_SA(1, 1), a1, ca1);
            PG8_WAIT_V(8); PG8_WAIT_L(0); PG8_BAR; PG8_MMA(0, 0, At, B0); PG8_MMA(0, 1, At, B1); PG8_BAR; PG8_SCHED;
            PG8_LDA(At, 0, 1); PG8_STAGE(PG8_SB(0, 0), b2, voffB); PG8_STAGE(PG8_SB(0, 1), b2 + hstep, voffB); PG8_STAGE(PG8_SA(0, 0), a2, ca0);
            PG8_WAIT_V(8); PG8_WAIT_L(0); PG8_BAR; PG8_MMA(1, 0, At, B0); PG8_MMA(1, 1, At, B1); PG8_BAR; PG8_SCHED;
            PG8_LDB(B0, 1, 0); PG8_LDB(B1, 1, 1); PG8_SCHED; PG8_LDA(At, 1, 0); PG8_STAGE(PG8_SA(0, 1), a2, ca1);
            PG8_WAIT_V(8); PG8_WAIT_L(0); PG8_BAR; PG8_MMA(0, 0, At, B0); PG8_MMA(0, 1, At, B1); PG8_BAR; PG8_SCHED;
            PG8_LDA(At, 1, 1); PG8_STAGE(PG8_SB(1, 0), b3, voffB); PG8_STAGE(PG8_SB(1, 1), b3 + hstep, voffB); PG8_STAGE(PG8_SA(1, 0), a3, ca0);
            PG8_WAIT_V(8); PG8_WAIT_L(0); PG8_BAR; PG8_MMA(1, 0, At, B0); PG8_MMA(1, 1, At, B1); PG8_BAR; PG8_SCHED;
        }
        {
            const char* a1 = cA + (size_t)(nt - 1) * akstep;
            const char* a2 = cA; const char* b2 = nB; const char* a3 = a2 + akstep; const char* b3 = b2 + kstep;
            PG8_LDB(B0, 0, 0); PG8_LDB(B1, 0, 1); PG8_SCHED; PG8_LDA(At, 0, 0); PG8_STAGE(PG8_SA(1, 1), a1, ca1);
            PG8_WAIT_V(8); PG8_WAIT_L(0); PG8_BAR; PG8_MMA(0, 0, At, B0); PG8_MMA(0, 1, At, B1); PG8_BAR; PG8_SCHED;
            PG8_LDA(At, 0, 1); PG8_STAGE(PG8_SB(0, 0), b2, voffB); PG8_STAGE(PG8_SB(0, 1), b2 + hstep, voffB); PG8_STAGE(PG8_SA(0, 0), a2, na0);
            PG8_WAIT_V(8); PG8_WAIT_L(0); PG8_BAR; PG8_MMA(1, 0, At, B0); PG8_MMA(1, 1, At, B1); PG8_BAR; PG8_SCHED;
            PG8_LDB(B0, 1, 0); PG8_LDB(B1, 1, 1); PG8_SCHED; PG8_LDA(At, 1, 0); PG8_STAGE(PG8_SA(0, 1), a2, na1);
            PG8_WAIT_V(8); PG8_WAIT_L(0); PG8_BAR; PG8_MMA(0, 0, At, B0); PG8_MMA(0, 1, At, B1); PG8_BAR; PG8_SCHED;
            PG8_LDA(At, 1, 1); PG8_STAGE(PG8_SB(1, 0), b3, voffB); PG8_STAGE(PG8_SB(1, 1), b3 + hstep, voffB); PG8_STAGE(PG8_SA(1, 0), a3, na0);
            PG8_WAIT_V(8); PG8_WAIT_L(0); PG8_BAR; PG8_MMA(1, 0, At, B0); PG8_MMA(1, 1, At, B1); PG8_BAR; PG8_SCHED;
        }
        if constexpr (ALIGN_EPI) { if (wr == 0) PG8_BAR; }
        E(acc, cur, wr, wc, fr, fq);
        if (!has_next) break;
#pragma unroll
        for (int a = 0; a < 2; ++a)
#pragma unroll
            for (int b = 0; b < 2; ++b)
#pragma unroll
                for (int m = 0; m < 4; ++m)
#pragma unroll
                    for (int n = 0; n < 2; ++n) acc[a][b][m][n] = (f32x4){zf_, zf_, zf_, zf_};
        cur = nxt; cB = nB; ++ui; ca0[0] = na0[0]; ca0[1] = na0[1]; ca1[0] = na1[0]; ca1[1] = na1[1];
        if constexpr (ALIGN_EPI) { if (wr == 1) PG8_BAR; }
    }
    PG8_WAIT_V(0);
    if constexpr (!ALIGN_EPI) { if (wr == 0) PG8_BAR; }
    PG8_BAR;
#undef PG8_AOFF
#undef PG8_SA
#undef PG8_SB
#undef PG8_STAGE
#undef PG8_LDA
#undef PG8_LDB
#undef PG8_MMA
#undef PG8_WAIT_V
#undef PG8_WAIT_L
#undef PG8_BAR
#undef PG8_SCHED
}

}
namespace mk {
using namespace nv;
typedef unsigned short bf16_t;
typedef unsigned u32x4 __attribute__((ext_vector_type(4)));
typedef float f32x4 __attribute__((ext_vector_type(4)));
#define LAS __attribute__((address_space(3)))
constexpr int NT = 512;
constexpr int PB = 2816;
constexpr int NPAD = 3072;
constexpr int C_KV = 512, C_FOX = 1280, C_SB = 2048, C_GATE = 2816;
constexpr int MAXT = MROWS / 256 + NE;
constexpr int PROWS = MAXT * 256;
#define CNT_IDX(l, e) (8192 + ((l) * NE + (e)) * 32)
__device__ __forceinline__ int ftid() { int t = threadIdx.x; asm volatile("" : "+v"(t)); return t; }
__device__ __forceinline__ int fbid() { int b = blockIdx.x; asm volatile("" : "+s"(b)); return b; }
#define MK_LOOP(vb, n) for (int vb = fbid(); vb < (n); vb += gridDim.x)

constexpr size_t al_(size_t x) { return (x + 4095) & ~(size_t)4095; }
constexpr size_t O_WTIN = 0;
constexpr size_t O_WTOUT = O_WTIN + al_((size_t)L_ * NPAD * D_ * 2);
constexpr size_t O_WTGU = O_WTOUT + al_((size_t)L_ * D_ * D_ * 2);
constexpr size_t O_WTDN = O_WTGU + al_((size_t)L_ * NE * 2048 * D_ * 2);
constexpr size_t O_BIASP = O_WTDN + al_((size_t)L_ * NE * D_ * D_ * 2);
constexpr size_t O_XB = O_BIASP + al_((size_t)L_ * NPAD * 4);
constexpr size_t O_PROJB = O_XB + al_((size_t)T_ * D_ * 2);
constexpr size_t O_GF = O_PROJB + al_((size_t)T_ * PB * 2);
constexpr size_t O_CFOX = O_GF + al_((size_t)T_ * 32 * 4);
constexpr size_t O_KCMP = O_CFOX + al_((size_t)B_ * 4 * S_ * 4);
constexpr size_t O_VCMP = O_KCMP + al_((size_t)B_ * 2 * 512 * 64 * 4);
constexpr size_t O_O = O_VCMP + al_((size_t)B_ * 2 * 512 * 64 * 4);
constexpr size_t O_OB = O_O + al_((size_t)T_ * D_ * 4);
constexpr size_t O_PTOT = O_OB + al_((size_t)T_ * D_ * 2);
constexpr size_t O_SEL = O_PTOT + al_((size_t)B_ * 2 * S_ * 512 * 4);
constexpr size_t O_MIX = O_SEL + al_((size_t)B_ * 2 * S_ * NSEL * 4);
constexpr size_t O_X1 = O_MIX + al_((size_t)T_ * D_ * 4);
constexpr size_t O_X1B = O_X1 + al_((size_t)T_ * D_ * 4);
constexpr size_t O_XA = O_X1B + al_((size_t)T_ * D_ * 2);
constexpr size_t O_ACT = O_XA + al_((size_t)T_ * D_ * 4);
constexpr size_t O_Y = O_ACT + al_((size_t)PROWS * D_ * 2);
constexpr size_t O_TOPE = O_Y + al_((size_t)PROWS * D_ * 2);
constexpr size_t O_TOPW = O_TOPE + al_((size_t)MROWS * 4);
constexpr size_t O_POS = O_TOPW + al_((size_t)MROWS * 4);
constexpr size_t O_ROWTOK = O_POS + al_((size_t)MROWS * 4);
constexpr size_t O_ROWW = O_ROWTOK + al_((size_t)PROWS * 4);
constexpr size_t O_SLOT = O_ROWW + al_((size_t)PROWS * 4);
constexpr size_t O_COUNTS = O_SLOT + al_((size_t)MROWS * 4);
constexpr size_t O_META = O_COUNTS + 65536;
constexpr size_t O_OWIN = O_META + 4096;
constexpr size_t O_O2 = O_OWIN + al_((size_t)T_ * 512 * 4);
constexpr size_t O_OWIN2 = O_O2 + al_((size_t)T_ * D_ * 4);
constexpr size_t O_KCMPB = O_OWIN2 + al_((size_t)T_ * 512 * 4);
constexpr size_t O_VCMPB = O_KCMPB + al_((size_t)B_ * 2 * 512 * 64 * 2);
constexpr size_t O_OCMP = O_VCMPB + al_((size_t)B_ * 2 * 512 * 64 * 2);
constexpr size_t O_SELMASK = O_OCMP + al_((size_t)T_ * 512 * 4);
constexpr size_t O_WT1 = O_SELMASK + al_((size_t)B_ * 2 * S_ * 16);
constexpr size_t O_BIAS1 = O_WT1 + al_((size_t)L_ * 2 * 256 * 2048 * 2);
constexpr size_t O_HID = O_BIAS1 + al_((size_t)L_ * 2 * 128 * 4);
constexpr size_t O_BIAS1P = O_HID + al_((size_t)8 * 512 * 128 * 2);
constexpr size_t O_END = O_BIAS1P + al_((size_t)L_ * 2 * 64 * 128 * 4);

struct P {
    In in; unsigned char* ws; float* out;
};
typedef const __attribute__((address_space(4))) P* KP;
__device__ __forceinline__ KP fresh_kp() { KP k = (KP)__builtin_amdgcn_kernarg_segment_ptr(); asm volatile("" : "+s"(k)); return k; }
#define WSP(T, off) ((T*)(p->ws + (off)))

__device__ __forceinline__ float bf2f(unsigned short b) { return __uint_as_float((unsigned)b << 16); }
__device__ __forceinline__ unsigned f2bf(float f) { unsigned u = __float_as_uint(f); return (u + 0x7fffu + ((u >> 16) & 1u)) >> 16; }
__device__ __forceinline__ unsigned pk2(float lo, float hi) { return f2bf(lo) | (f2bf(hi) << 16); }
__device__ __forceinline__ void ld8(const bf16_t* __restrict__ src, float* dst) {
    const u32x4 v = *(const u32x4*)src;
    dst[0] = __uint_as_float(v.x << 16); dst[1] = __uint_as_float(v.x & 0xffff0000u); dst[2] = __uint_as_float(v.y << 16); dst[3] = __uint_as_float(v.y & 0xffff0000u);
    dst[4] = __uint_as_float(v.z << 16); dst[5] = __uint_as_float(v.z & 0xffff0000u); dst[6] = __uint_as_float(v.w << 16); dst[7] = __uint_as_float(v.w & 0xffff0000u);
}


__device__ __forceinline__ int perm_in(int n) {
    if (n < 1280) return n;
    if (n < 1304) return C_GATE + (n - 1280);
    if (n < 2072) return C_FOX + (n - 1304);
    if (n < 2076) return C_GATE + 24 + (n - 2072);
    return C_SB + (n - 2076);
}
__device__ __forceinline__ int perm_gu(int n) { const int up = n >> 10, c = n & 1023; return 256 * (c >> 7) + 128 * up + (c & 127); }
template <int MAP>
__device__ __forceinline__ void transpose_item(const float* __restrict__ W, int K, int N, bf16_t* __restrict__ WT, LAS float* scr, int item, int lane) {
    const int nblk = (N + 31) / 32, kb = item / nblk, nb = item % nblk, k0 = 64 * kb, n0 = 32 * nb;
    { const int n4 = (lane & 7) * 4; const bool okn = (n0 + n4) < N;
      f32x4 t[8];
#pragma unroll
      for (int i = 0; i < 8; ++i) { const int kk = (lane >> 3) + 8 * i; t[i] = okn ? *(const f32x4*)(W + (size_t)(k0 + kk) * N + n0 + n4) : (f32x4){0.f, 0.f, 0.f, 0.f}; }
#pragma unroll
      for (int i = 0; i < 8; ++i) { const int kk = (lane >> 3) + 8 * i; LAS float* d = scr + kk * 33 + n4; d[0] = t[i].x; d[1] = t[i].y; d[2] = t[i].z; d[3] = t[i].w; } }
    asm volatile("s_waitcnt lgkmcnt(0)" ::: "memory");
    const int c = lane & 7;
#pragma unroll
    for (int j = 0; j < 4; ++j) { const int n = (lane >> 3) + 8 * j; const LAS float* sp = scr + (8 * c) * 33 + n;
        u32x4 o; o.x = pk2(sp[0 * 33], sp[1 * 33]); o.y = pk2(sp[2 * 33], sp[3 * 33]); o.z = pk2(sp[4 * 33], sp[5 * 33]); o.w = pk2(sp[6 * 33], sp[7 * 33]);
        const int ng = n0 + n;
        if (ng < N) { const int ro = (MAP == 1) ? perm_in(ng) : (MAP == 2) ? perm_gu(ng) : ng; *(u32x4*)(WT + (size_t)ro * K + k0 + 8 * c) = o; } }
    asm volatile("s_waitcnt lgkmcnt(0)" ::: "memory");
}
__device__ __forceinline__ void ph_convert(LAS unsigned char* lds, KP p) {
    const int tid = ftid(), lane = tid & 63, wv = tid >> 6;
    LAS float* scr = (LAS float*)(lds + wv * 8448);
    const int gw = fbid() * 8 + wv, NGW = gridDim.x * 8;
    constexpr int I_IN = 16 * 89, I_OUT = 16 * 32, I_GU = 16 * 64, I_DN = 16 * 32, I_W1 = 32 * 4;
    constexpr int N_IN = L_ * I_IN, N_OUT = L_ * I_OUT, N_GU = L_ * NE * I_GU, N_DN = L_ * NE * I_DN, N_W1 = L_ * 2 * I_W1;
    for (int it = gw; it < N_IN + N_OUT + N_GU + N_DN + N_W1; it += NGW) {
        int r = it;
        if (r < N_W1) { const int mtx = r / I_W1, ll = mtx >> 1, kv = mtx & 1; transpose_item<0>((kv ? p->in.w1v : p->in.w1k) + (size_t)ll * 2048 * 128, 2048, 128, WSP(bf16_t, O_WT1) + (size_t)mtx * 256 * 2048, scr, r % I_W1, lane); continue; } r -= N_W1;
        if (r < N_GU) { const int mtx = r / I_GU; transpose_item<2>(p->in.wgu + (size_t)mtx * D_ * 2048, D_, 2048, WSP(bf16_t, O_WTGU) + (size_t)mtx * 2048 * D_, scr, r % I_GU, lane); continue; } r -= N_GU;
        if (r < N_DN) { const int mtx = r / I_DN; transpose_item<0>(p->in.wdn + (size_t)mtx * D_ * D_, D_, D_, WSP(bf16_t, O_WTDN) + (size_t)mtx * D_ * D_, scr, r % I_DN, lane); continue; } r -= N_DN;
        if (r < N_IN) { const int mtx = r / I_IN; transpose_item<1>(p->in.w_in + (size_t)mtx * D_ * DIN, D_, DIN, WSP(bf16_t, O_WTIN) + (size_t)mtx * NPAD * D_, scr, r % I_IN, lane); continue; } r -= N_IN;
        { const int mtx = r / I_OUT; transpose_item<0>(p->in.w_out + (size_t)mtx * D_ * D_, D_, D_, WSP(bf16_t, O_WTOUT) + (size_t)mtx * D_ * D_, scr, r % I_OUT, lane); }
    }
    const int gt = fbid() * NT + tid, NG = gridDim.x * NT;
    for (int i = gt; i < L_ * (NPAD - DIN) * (D_ / 8); i += NG) { const int l = i / ((NPAD - DIN) * (D_ / 8)), r = i % ((NPAD - DIN) * (D_ / 8));
        unsigned z_ = 0u; asm volatile("" : "+v"(z_));
        *(u32x4*)(WSP(bf16_t, O_WTIN) + ((size_t)l * NPAD + DIN) * D_ + (size_t)r * 8) = (u32x4){z_, z_, z_, z_}; }
    for (int i = gt; i < L_ * 2 * 128 * (2048 / 8); i += NG) { const int mtx = i / (128 * 256), r = i % (128 * 256); unsigned z_ = 0u; asm volatile("" : "+v"(z_));
        *(u32x4*)(WSP(bf16_t, O_WT1) + ((size_t)mtx * 256 + 128) * 2048 + (size_t)r * 8) = (u32x4){z_, z_, z_, z_}; }
    for (int i = gt; i < L_ * 2 * 64 * 128; i += NG) { const int j = i & 127, seg = (i >> 7) & 63, mtx = i >> 13, ll = mtx >> 1, kv = mtx & 1;
        const float* pos = (kv ? p->in.pos_v : p->in.pos_k) + (size_t)ll * 2048 + seg * 32; const float* w1 = (kv ? p->in.w1v : p->in.w1k) + (size_t)ll * 2048 * 128 + (size_t)seg * 32 * 128; float a = 0.f;
#pragma unroll 8
        for (int k = 0; k < 32; ++k) a += pos[k] * w1[(size_t)k * 128 + j];
        WSP(float, O_BIAS1P)[i] = a; }
    for (int i = gt; i < L_ * NPAD; i += NG) { const int l = i / NPAD, c = i % NPAD; if (c >= DIN) WSP(float, O_BIASP)[i] = 0.f; }
    for (int i = gt; i < L_ * DIN; i += NG) { const int l = i / DIN, n = i % DIN; WSP(float, O_BIASP)[l * NPAD + perm_in(n)] = p->in.b_in[i]; }
    for (int i = gt; i < T_ * D_ / 8; i += NG) { const f32x4 a = *(const f32x4*)(p->in.x + (size_t)i * 8), b = *(const f32x4*)(p->in.x + (size_t)i * 8 + 4);
        *(u32x4*)(WSP(bf16_t, O_XB) + (size_t)i * 8) = (u32x4){pk2(a.x, a.y), pk2(a.z, a.w), pk2(b.x, b.y), pk2(b.z, b.w)}; }
}

struct EpiProj {
    static constexpr bool PERM = true;
    bf16_t* projb; float* gf; const float* bias;
    __device__ __forceinline__ void operator()(const pg8::f32x4 (&acc)[2][2][4][2], const pg8::Unit& u, int wr, int wc, int fr, int fq) const {
        const int row0 = u.pm * 256 + wr * 64 + fr, col0 = u.pn * 256 + wc * 32 + 8 * fq;
        if (u.pn < 11) {
#pragma unroll
            for (int ai = 0; ai < 2; ++ai)
#pragma unroll
                for (int m = 0; m < 4; ++m) { bf16_t* rowp = projb + (size_t)(row0 + ai * 128 + m * 16) * PB + col0;
#pragma unroll
                    for (int bj = 0; bj < 2; ++bj) { const f32x4 v0 = acc[ai][bj][m][0] + *(const f32x4*)(bias + col0 + bj * 128), v1 = acc[ai][bj][m][1] + *(const f32x4*)(bias + col0 + bj * 128 + 4);
                        u32x4 w; w.x = pg8::cvt_pk_bf16(v0[0], v0[1]); w.y = pg8::cvt_pk_bf16(v0[2], v0[3]); w.z = pg8::cvt_pk_bf16(v1[0], v1[1]); w.w = pg8::cvt_pk_bf16(v1[2], v1[3]);
                        *(u32x4*)(rowp + bj * 128) = w; }
                    asm volatile("" ::: "memory"); }
        } else if (wc == 0) {
            const f32x4 b0 = *(const f32x4*)(bias + col0), b1 = *(const f32x4*)(bias + col0 + 4);
#pragma unroll
            for (int ai = 0; ai < 2; ++ai)
#pragma unroll
                for (int m = 0; m < 4; ++m) { float* rowp = gf + (size_t)(row0 + ai * 128 + m * 16) * 32 + 8 * fq;
                    const f32x4 v0 = acc[ai][0][m][0] + b0, v1 = acc[ai][0][m][1] + b1; f32x4 o0, o1;
#pragma unroll
                    for (int i = 0; i < 4; ++i) { const int j0 = 8 * fq + i, j1 = j0 + 4;
                        o0[i] = (j0 < 24) ? sigmoidf_(v0[i]) : (j0 < 28 ? logsig(v0[i]) : 0.f); o1[i] = (j1 < 24) ? sigmoidf_(v1[i]) : (j1 < 28 ? logsig(v1[i]) : 0.f); }
                    *(f32x4*)rowp = o0; *(f32x4*)(rowp + 4) = o1; }
        }
    }
};
struct EpiOut {
    static constexpr bool PERM = true;
    const float* x; float* y1;
    __device__ __forceinline__ void operator()(const pg8::f32x4 (&acc)[2][2][4][2], const pg8::Unit& u, int wr, int wc, int fr, int fq) const {
        const int row0 = u.pm * 256 + wr * 64 + fr, col0 = u.pn * 256 + wc * 32 + 8 * fq;
#pragma unroll
        for (int ai = 0; ai < 2; ++ai)
#pragma unroll
            for (int m = 0; m < 4; ++m) { const size_t off = (size_t)(row0 + ai * 128 + m * 16) * D_ + col0;
#pragma unroll
                for (int bj = 0; bj < 2; ++bj) { const f32x4 x0 = *(const f32x4*)(x + off + bj * 128), x1 = *(const f32x4*)(x + off + bj * 128 + 4);
                    *(f32x4*)(y1 + off + bj * 128) = x0 * ALPHA + acc[ai][bj][m][0]; *(f32x4*)(y1 + off + bj * 128 + 4) = x1 * ALPHA + acc[ai][bj][m][1]; }
                asm volatile("" ::: "memory"); }
    }
};
struct EpiGU {
    static constexpr bool PERM = true;
    bf16_t* act; const float* bgu;
    __device__ __forceinline__ void operator()(const pg8::f32x4 (&acc)[2][2][4][2], const pg8::Unit& u, int wr, int wc, int fr, int fq) const {
        const int row0 = u.pm * 256 + wr * 64 + fr, col0 = u.pn * 128 + wc * 32 + 8 * fq;
        const float* bb = bgu + (size_t)u.e * 2048 + col0;
        const f32x4 bg0 = *(const f32x4*)bb, bg1 = *(const f32x4*)(bb + 4), bu0 = *(const f32x4*)(bb + 1024), bu1 = *(const f32x4*)(bb + 1028);
#pragma unroll
        for (int ai = 0; ai < 2; ++ai)
#pragma unroll
            for (int m = 0; m < 4; ++m) { f32x4 a0, a1;
                const f32x4 g0 = acc[ai][0][m][0] + bg0, g1 = acc[ai][0][m][1] + bg1, u0 = acc[ai][1][m][0] + bu0, u1 = acc[ai][1][m][1] + bu1;
#pragma unroll
                for (int i = 0; i < 4; ++i) { const float gt0 = fminf(g0[i], 7.0f), up0 = fminf(fmaxf(u0[i], -7.0f), 7.0f), gt1 = fminf(g1[i], 7.0f), up1 = fminf(fmaxf(u1[i], -7.0f), 7.0f);
                    a0[i] = gt0 * sigmoidf_(1.702f * gt0) * (up0 + 1.0f); a1[i] = gt1 * sigmoidf_(1.702f * gt1) * (up1 + 1.0f); }
                u32x4 w; w.x = pg8::cvt_pk_bf16(a0[0], a0[1]); w.y = pg8::cvt_pk_bf16(a0[2], a0[3]); w.z = pg8::cvt_pk_bf16(a1[0], a1[1]); w.w = pg8::cvt_pk_bf16(a1[2], a1[3]);
                *(u32x4*)(act + (size_t)(row0 + ai * 128 + m * 16) * D_ + col0) = w; asm volatile("" ::: "memory"); }
    }
};
struct EpiDN {
    static constexpr bool PERM = true;
    bf16_t* y; const float* bdn; const float* roww;
    __device__ __forceinline__ void operator()(const pg8::f32x4 (&acc)[2][2][4][2], const pg8::Unit& u, int wr, int wc, int fr, int fq) const {
        const int row0 = u.pm * 256 + wr * 64 + fr, col0 = u.pn * 256 + wc * 32 + 8 * fq;
        const float* bb = bdn + (size_t)u.e * D_ + col0;
#pragma unroll
        for (int ai = 0; ai < 2; ++ai)
#pragma unroll
            for (int m = 0; m < 4; ++m) { const int row = row0 + ai * 128 + m * 16; const float w = roww[row];
#pragma unroll
                for (int bj = 0; bj < 2; ++bj) { const f32x4 v0 = (acc[ai][bj][m][0] + *(const f32x4*)(bb + bj * 128)) * w, v1 = (acc[ai][bj][m][1] + *(const f32x4*)(bb + bj * 128 + 4)) * w;
                    u32x4 o; o.x = pg8::cvt_pk_bf16(v0[0], v0[1]); o.y = pg8::cvt_pk_bf16(v0[2], v0[3]); o.z = pg8::cvt_pk_bf16(v1[0], v1[1]); o.w = pg8::cvt_pk_bf16(v1[2], v1[3]);
                    *(u32x4*)(y + (size_t)row * D_ + col0 + bj * 128) = o; }
                asm volatile("" ::: "memory"); }
    }
};
struct EpiCmp {
    static constexpr bool PERM = true;
    bf16_t* hid; const float* bias1;
    __device__ __forceinline__ void operator()(const pg8::f32x4 (&acc)[2][2][4][2], const pg8::Unit& u, int wr, int wc, int fr, int fq) const {
        const int row0 = u.pm * 256 + wr * 64 + fr, col0 = wc * 32 + 8 * fq;
        const float* bb = bias1 + (u.e & 1) * 128 + col0; const f32x4 b0 = *(const f32x4*)bb, b1 = *(const f32x4*)(bb + 4);
#pragma unroll
        for (int ai = 0; ai < 2; ++ai)
#pragma unroll
            for (int m = 0; m < 4; ++m) { const f32x4 v0 = acc[ai][0][m][0] + b0, v1 = acc[ai][0][m][1] + b1;
                u32x4 w; w.x = pg8::cvt_pk_bf16(gelu_tanh(v0[0]), gelu_tanh(v0[1])); w.y = pg8::cvt_pk_bf16(gelu_tanh(v0[2]), gelu_tanh(v0[3])); w.z = pg8::cvt_pk_bf16(gelu_tanh(v1[0]), gelu_tanh(v1[1])); w.w = pg8::cvt_pk_bf16(gelu_tanh(v1[2]), gelu_tanh(v1[3]));
                *(u32x4*)(hid + ((size_t)u.e * 512 + row0 + ai * 128 + m * 16) * 128 + col0) = w; asm volatile("" ::: "memory"); }
    }
};
struct GEpi {
    static constexpr bool PERM = true;
    int kind, l;
    __device__ __forceinline__ void operator()(const pg8::f32x4 (&acc)[2][2][4][2], const pg8::Unit& u, int wr, int wc, int fr, int fq) const {
        const KP p = fresh_kp();
        if (kind == 0) { const EpiProj e{WSP(bf16_t, O_PROJB), WSP(float, O_GF), WSP(float, O_BIASP) + l * NPAD}; e(acc, u, wr, wc, fr, fq); }
        else if (kind == 1) { const EpiOut e{(l == 0) ? p->in.x : WSP(float, O_XA), WSP(float, O_MIX)}; e(acc, u, wr, wc, fr, fq); }
        else if (kind == 2) { const EpiGU e{WSP(bf16_t, O_ACT), p->in.bgu + (size_t)l * NE * 2048}; e(acc, u, wr, wc, fr, fq); }
        else if (kind == 3) { const EpiDN e{WSP(bf16_t, O_Y), p->in.bdn + (size_t)l * NE * D_, WSP(float, O_ROWW)}; e(acc, u, wr, wc, fr, fq); }
        else { const EpiCmp e{WSP(bf16_t, O_HID), WSP(float, O_BIAS1) + l * 256}; e(acc, u, wr, wc, fr, fq); }
    }
};
struct GSched {
    int kind, nM, nN, nunits, G, c; const int* meta; const int* rowtok; const char* Bt; size_t estep;
    __device__ __forceinline__ bool next(int i, pg8::Unit& u) const {
        const int L = i * G + c; if (L >= nunits) return false;
        if (kind == 1) {
            int wgid = L; { const int q = nunits / pg8::NXCD, r = nunits % pg8::NXCD, xcd = wgid % pg8::NXCD, off = wgid / pg8::NXCD; wgid = (xcd < r ? xcd * (q + 1) : r * (q + 1) + (xcd - r) * q) + off; }
            const int nig = pg8::WGM * nN, gid = wgid / nig, fm = gid * pg8::WGM, gsz = (nM - fm) < pg8::WGM ? (nM - fm) : pg8::WGM;
            u.pm = fm + ((wgid % nig) % gsz); u.pn = (wgid % nig) / gsz; u.e = 0; u.nr = 256;
        } else if (kind == 4) { u.e = L >> 1; u.pm = L & 1; u.pn = 0; u.nr = (L & 1) ? 255 : 256; }
        else if (kind == 0) { const int gt = L / nN; u.pm = gt; u.pn = L - gt * nN; u.e = 0; u.nr = 256; }
        else { const int gt = L / nN; u.pm = gt; u.pn = L - gt * nN; u.e = meta[64 + 2 * gt]; u.nr = meta[65 + 2 * gt]; }
        return true; }
    __device__ __forceinline__ unsigned a_off(const pg8::Unit& u, int r) const { const int rr = r < u.nr ? r : u.nr - 1; const int row = u.pm * 256 + rr;
        if (kind == 4) { const int kv = u.e & 1, bg = u.e >> 1; return (unsigned)(((bg >> 1) * S_ + 16 * row) * PB + C_KV + ((0 * 2 + kv) * 2 + (bg & 1)) * 64) * 2u; }
        return (unsigned)((kind == 2) ? rowtok[row] : row) * (unsigned)(D_ * 2); }
    __device__ __forceinline__ size_t a_kstep() const { return kind == 4 ? (size_t)PB * 2 : (size_t)128; }
    __device__ __forceinline__ const char* b_base(const pg8::Unit& u) const { return Bt + (size_t)(kind == 4 ? (u.e & 1) : u.e) * estep + (size_t)u.pn * ((size_t)256 * D_ * 2); }
};

__device__ __forceinline__ void ph_rmsnorm(KP p, int l) {
    const int lane = ftid() & 63, wv = ftid() >> 6; const float* g = p->in.g_out + (size_t)l * D_;
    constexpr int NB = 4; const int rstride = (int)gridDim.x * 8;
    f32x4 gg[4];
#pragma unroll
    for (int j = 0; j < 2; ++j) { gg[2 * j] = *(const f32x4*)(g + 512 * j + lane * 8); gg[2 * j + 1] = *(const f32x4*)(g + 512 * j + lane * 8 + 4); }
    for (int row0 = fbid() * 8 + wv; row0 < T_; row0 += rstride * NB) {
        u32x4 ra[NB], rb2[NB], rw2[NB];
#pragma unroll
        for (int bi = 0; bi < NB; ++bi) { const int row = (row0 + bi * rstride < T_) ? row0 + bi * rstride : row0; const bf16_t* r = WSP(bf16_t, O_O) + (size_t)row * D_ + lane * 8;
            ra[bi] = *(const u32x4*)r; rb2[bi] = *(const u32x4*)(r + 512); rw2[bi] = *(const u32x4*)(WSP(bf16_t, O_OWIN) + (size_t)row * 512 + lane * 8); }
#pragma unroll
        for (int bi = 0; bi < NB; ++bi) { const int row = row0 + bi * rstride; if (row < T_) {
#define BF_LO(u) __uint_as_float((u) << 16)
#define BF_HI(u) __uint_as_float((u) & 0xffff0000u)
            const f32x4 x0 = (f32x4){BF_LO(ra[bi].x) + BF_LO(rw2[bi].x), BF_HI(ra[bi].x) + BF_HI(rw2[bi].x), BF_LO(ra[bi].y) + BF_LO(rw2[bi].y), BF_HI(ra[bi].y) + BF_HI(rw2[bi].y)};
            const f32x4 x1 = (f32x4){BF_LO(ra[bi].z) + BF_LO(rw2[bi].z), BF_HI(ra[bi].z) + BF_HI(rw2[bi].z), BF_LO(ra[bi].w) + BF_LO(rw2[bi].w), BF_HI(ra[bi].w) + BF_HI(rw2[bi].w)};
            const f32x4 y0 = (f32x4){BF_LO(rb2[bi].x), BF_HI(rb2[bi].x), BF_LO(rb2[bi].y), BF_HI(rb2[bi].y)}, y1 = (f32x4){BF_LO(rb2[bi].z), BF_HI(rb2[bi].z), BF_LO(rb2[bi].w), BF_HI(rb2[bi].w)};
#undef BF_LO
#undef BF_HI
            float s = (x0.x * x0.x + x0.y * x0.y) + (x0.z * x0.z + x0.w * x0.w) + (x1.x * x1.x + x1.y * x1.y) + (x1.z * x1.z + x1.w * x1.w);
            float s2 = (y0.x * y0.x + y0.y * y0.y) + (y0.z * y0.z + y0.w * y0.w) + (y1.x * y1.x + y1.y * y1.y) + (y1.z * y1.z + y1.w * y1.w);
            const float sc0 = rsqrtf(wsum(s) * (1.f / 512.f) + RMS_EPS);
#pragma unroll
            for (int o = 1; o < 32; o <<= 1) s2 += __shfl_xor(s2, o);
            const float sc1 = rsqrtf(s2 * (1.f / 256.f) + RMS_EPS);
            const f32x4 u0 = x0 * sc0 * gg[0], u1 = x1 * sc0 * gg[1], w0 = y0 * sc1 * gg[2], w1 = y1 * sc1 * gg[3];
            bf16_t* ro = WSP(bf16_t, O_OB) + (size_t)row * D_;
            *(u32x4*)(ro + lane * 8) = (u32x4){pk2(u0.x, u0.y), pk2(u0.z, u0.w), pk2(u1.x, u1.y), pk2(u1.z, u1.w)};
            *(u32x4*)(ro + 512 + lane * 8) = (u32x4){pk2(w0.x, w0.y), pk2(w0.z, w0.w), pk2(w1.x, w1.y), pk2(w1.z, w1.w)}; } }
    }
}
template <bool ROUTER>
__device__ __forceinline__ void ph_ln(float* lds, KP p, int l, float* __restrict__ yout, int cnt_off = 0) {
    const int lane = ftid() & 63, wv = ftid() >> 6;
    const float* g = (ROUTER ? p->in.ln1_g : p->in.ln2_g) + (size_t)l * D_; const float* bb = (ROUTER ? p->in.ln1_b : p->in.ln2_b) + (size_t)l * D_;
    constexpr int NB = ROUTER ? 4 : 2;
    const int rstride = (int)gridDim.x * 8;
    for (int row0 = fbid() * 8 + wv; row0 < T_; row0 += rstride * NB) {
        float v[NB][16];
        if (ROUTER) {
#pragma unroll
            for (int bi = 0; bi < NB; ++bi) { const int row = row0 + bi * rstride; const float* src = WSP(float, O_MIX) + (size_t)(row < T_ ? row : row0) * D_;
#pragma unroll
                for (int j = 0; j < 2; ++j) { const f32x4 a = *(const f32x4*)(src + 512 * j + lane * 8), b = *(const f32x4*)(src + 512 * j + lane * 8 + 4);
                    v[bi][8 * j + 0] = a.x; v[bi][8 * j + 1] = a.y; v[bi][8 * j + 2] = a.z; v[bi][8 * j + 3] = a.w; v[bi][8 * j + 4] = b.x; v[bi][8 * j + 5] = b.y; v[bi][8 * j + 6] = b.z; v[bi][8 * j + 7] = b.w; } }
        } else { const bf16_t* y = WSP(bf16_t, O_Y);
            int sl[NB][TOPK];
#pragma unroll
            for (int bi = 0; bi < NB; ++bi) { const int row = (row0 + bi * rstride < T_) ? row0 + bi * rstride : row0;
#pragma unroll
                for (int k = 0; k < TOPK; ++k) sl[bi][k] = WSP(int, O_SLOT)[row * TOPK + k]; }
            u32x4 yv[NB][TOPK][2]; f32x4 xv[NB][4];
#pragma unroll
            for (int bi = 0; bi < NB; ++bi) { const int row = (row0 + bi * rstride < T_) ? row0 + bi * rstride : row0; const float* src = WSP(float, O_X1) + (size_t)row * D_;
#pragma unroll
                for (int j = 0; j < 2; ++j) { xv[bi][2 * j] = *(const f32x4*)(src + 512 * j + lane * 8); xv[bi][2 * j + 1] = *(const f32x4*)(src + 512 * j + lane * 8 + 4); }
#pragma unroll
                for (int k = 0; k < TOPK; ++k)
#pragma unroll
                    for (int j = 0; j < 2; ++j) yv[bi][k][j] = *(const u32x4*)(y + (size_t)sl[bi][k] * D_ + 512 * j + lane * 8); }
#pragma unroll
            for (int bi = 0; bi < NB; ++bi)
#pragma unroll
                for (int j = 0; j < 2; ++j) { float acc[8];
#pragma unroll
                    for (int e = 0; e < 8; ++e) acc[e] = 0.f;
#pragma unroll
                    for (int k = 0; k < TOPK; ++k) { const u32x4 q = yv[bi][k][j];
                        acc[0] += __uint_as_float(q.x << 16); acc[1] += __uint_as_float(q.x & 0xffff0000u); acc[2] += __uint_as_float(q.y << 16); acc[3] += __uint_as_float(q.y & 0xffff0000u);
                        acc[4] += __uint_as_float(q.z << 16); acc[5] += __uint_as_float(q.z & 0xffff0000u); acc[6] += __uint_as_float(q.w << 16); acc[7] += __uint_as_float(q.w & 0xffff0000u); }
                    const f32x4 a = xv[bi][2 * j], b = xv[bi][2 * j + 1];
                    v[bi][8 * j + 0] = ALPHA * a.x + acc[0]; v[bi][8 * j + 1] = ALPHA * a.y + acc[1]; v[bi][8 * j + 2] = ALPHA * a.z + acc[2]; v[bi][8 * j + 3] = ALPHA * a.w + acc[3];
                    v[bi][8 * j + 4] = ALPHA * b.x + acc[4]; v[bi][8 * j + 5] = ALPHA * b.y + acc[5]; v[bi][8 * j + 6] = ALPHA * b.z + acc[6]; v[bi][8 * j + 7] = ALPHA * b.w + acc[7]; } }
#pragma unroll
        for (int bi = 0; bi < NB; ++bi) { const int row = row0 + bi * rstride; if (row < T_) {
            float s = 0.f;
#pragma unroll
            for (int i = 0; i < 16; ++i) s += v[bi][i];
            const float mu = wsum(s) * (1.f / D_); float s2 = 0.f;
#pragma unroll
            for (int i = 0; i < 16; ++i) { v[bi][i] -= mu; s2 += v[bi][i] * v[bi][i]; }
            const float rstd = rsqrtf(wsum(s2) * (1.f / D_) + LN_EPS);
            bf16_t* ybf = (ROUTER ? WSP(bf16_t, O_X1B) : WSP(bf16_t, O_XB)) + (size_t)row * D_;
#pragma unroll
            for (int j = 0; j < 2; ++j) { const int c0 = 512 * j + lane * 8; float o8[8];
                const f32x4 g0 = *(const f32x4*)(g + c0), g1 = *(const f32x4*)(g + c0 + 4), b0 = *(const f32x4*)(bb + c0), b1 = *(const f32x4*)(bb + c0 + 4);
                o8[0] = v[bi][8 * j + 0] * rstd * g0.x + b0.x; o8[1] = v[bi][8 * j + 1] * rstd * g0.y + b0.y; o8[2] = v[bi][8 * j + 2] * rstd * g0.z + b0.z; o8[3] = v[bi][8 * j + 3] * rstd * g0.w + b0.w;
                o8[4] = v[bi][8 * j + 4] * rstd * g1.x + b1.x; o8[5] = v[bi][8 * j + 5] * rstd * g1.y + b1.y; o8[6] = v[bi][8 * j + 6] * rstd * g1.z + b1.z; o8[7] = v[bi][8 * j + 7] * rstd * g1.w + b1.w;
                *(f32x4*)(yout + (size_t)row * D_ + c0) = (f32x4){o8[0], o8[1], o8[2], o8[3]};
                *(f32x4*)(yout + (size_t)row * D_ + c0 + 4) = (f32x4){o8[4], o8[5], o8[6], o8[7]};
                *(u32x4*)(ybf + c0) = (u32x4){pk2(o8[0], o8[1]), pk2(o8[2], o8[3]), pk2(o8[4], o8[5]), pk2(o8[6], o8[7])}; } } }
    }
    if (ROUTER) {
        const float* rw = p->in.rw + (size_t)l * D_ * NE; const float* rb = p->in.rb + (size_t)l * NE;
        float* wl = lds; float* rl = lds + 16384 + wv * 2048; float* lgl = lds + 32768 + wv * 256;
        int nrow = 0; for (int r_ = fbid() * 8 + wv; r_ < T_; r_ += (int)gridDim.x * 8) { ++nrow; asm volatile("" : "+s"(nrow)); }
        const int e = lane & 31, half = lane >> 5;
        float acc[2][4];
#pragma unroll
        for (int gi = 0; gi < 2; ++gi)
#pragma unroll
            for (int bi = 0; bi < 4; ++bi) acc[gi][bi] = 0.f;
#pragma unroll 1
        for (int c = 0; c < 2; ++c) {
            __syncthreads();
#pragma unroll
            for (int i = 0; i < 8; ++i) { const int f4 = i * NT + ftid(); *(f32x4*)(wl + 4 * f4) = *(const f32x4*)(rw + (size_t)c * 512 * NE + 4 * f4); }
            __syncthreads();
#pragma unroll
            for (int gi = 0; gi < 2; ++gi) {
                asm volatile("s_waitcnt lgkmcnt(0)" ::: "memory");
#pragma unroll
                for (int bi = 0; bi < 4; ++bi) { const int ri = (4 * gi + bi < nrow) ? 4 * gi + bi : 0; const float* src = yout + (size_t)(fbid() * 8 + wv + ri * (int)gridDim.x * 8) * D_ + c * 512 + lane * 8;
                    *(f32x4*)(rl + bi * 512 + lane * 8) = *(const f32x4*)src; *(f32x4*)(rl + bi * 512 + lane * 8 + 4) = *(const f32x4*)(src + 4); }
                asm volatile("s_waitcnt lgkmcnt(0)" ::: "memory");
                const float* wp = wl + (half * 256) * NE + e; const float* rp = rl + half * 256;
#pragma unroll 4
                for (int kk = 0; kk < 64; ++kk) { const float w0 = wp[(4 * kk) * NE], w1 = wp[(4 * kk + 1) * NE], w2 = wp[(4 * kk + 2) * NE], w3 = wp[(4 * kk + 3) * NE];
#pragma unroll
                    for (int bi = 0; bi < 4; ++bi) { const f32x4 r = *(const f32x4*)(rp + bi * 512 + 4 * kk); acc[gi][bi] += (r.x * w0 + r.y * w1) + (r.z * w2 + r.w * w3); } }
            }
        }
#pragma unroll
        for (int gi = 0; gi < 2; ++gi)
#pragma unroll
            for (int bi = 0; bi < 4; ++bi) { const float t = acc[gi][bi] + __shfl_xor(acc[gi][bi], 32); if (lane < 32) lgl[(4 * gi + bi) * 32 + e] = t; }
        asm volatile("s_waitcnt lgkmcnt(0)" ::: "memory");
        int* lcnt = (int*)(lds + 32768 + 8 * 256);
        if (ftid() < NE) lcnt[ftid()] = 0;
        __syncthreads();
#pragma unroll 1
        for (int ri = 0; ri < nrow; ++ri) { const int row = fbid() * 8 + wv + ri * (int)gridDim.x * 8;
            const int e = lane & 31; const float lg = lgl[ri * 32 + e] + rb[e];
            float cur = lg, tv0 = 0.f, den = 0.f, myw = 0.f; int mye = 0;
#pragma unroll
            for (int k = 0; k < TOPK; ++k) { float bv = cur; int bi = e;
#pragma unroll
                for (int o = 16; o >= 1; o >>= 1) { const float ov = __shfl_xor(bv, o); const int oi = __shfl_xor(bi, o); if (ov > bv || (ov == bv && oi < bi)) { bv = ov; bi = oi; } }
                if (k == 0) tv0 = bv;
                const float w = __expf(bv - tv0); den += w;
                if (lane == k) { mye = bi; myw = w; }
                if (e == bi) cur = -3.4e38f; }
            if (lane < TOPK) { WSP(int, O_TOPE)[row * TOPK + lane] = mye; WSP(float, O_TOPW)[row * TOPK + lane] = myw / den; WSP(int, O_POS)[row * TOPK + lane] = atomicAdd(&lcnt[mye], 1); } }
        __syncthreads();
        if (ftid() < NE) { const int c = lcnt[ftid()]; lcnt[ftid()] = (c > 0) ? atomicAdd(WSP(int, O_COUNTS) + CNT_IDX(l, ftid()) + cnt_off, c) : 0; }
        __syncthreads();
#pragma unroll 1
        for (int ri = 0; ri < nrow; ++ri) { const int row = fbid() * 8 + wv + ri * (int)gridDim.x * 8;
            if (lane < TOPK) WSP(int, O_POS)[row * TOPK + lane] += lcnt[WSP(int, O_TOPE)[row * TOPK + lane]]; }
        __syncthreads();
    }
}
__device__ __forceinline__ void ph_bias1_reduce(KP p, int l) {
    if (fbid() != (int)gridDim.x - 1) return;
    const int tid = ftid(); if (tid < 256) { const float* pp = WSP(float, O_BIAS1P) + ((size_t)(l * 2 + (tid >> 7)) * 64) * 128 + (tid & 127); float a = 0.f;
        for (int s = 0; s < 64; ++s) a += pp[s * 128];
        WSP(float, O_BIAS1)[l * 256 + tid] = a; }
}
__device__ __forceinline__ void ph_cumsum(float* lds, KP p, int blk0) {
    const int tid = ftid(), lane = tid & 63, wv = tid >> 6; const int bh = fbid() - blk0;
    if (bh < 0 || bh >= B_ * 4) return;
    const int b = bh >> 2, h = bh & 3; const float* gf = WSP(float, O_GF) + (size_t)(b * S_ + tid * 16) * 32 + 24 + h;
    float v[16], run = 0.f;
#pragma unroll
    for (int i = 0; i < 16; ++i) { run += gf[(size_t)i * 32]; v[i] = run; }
    float inc = run;
#pragma unroll
    for (int o = 1; o < 64; o <<= 1) { const float t = __shfl_up(inc, o); if (lane >= o) inc += t; }
    if (lane == 63) lds[wv] = inc;
    __syncthreads();
    float woff = 0.f;
#pragma unroll
    for (int i = 0; i < 8; ++i) woff += (i < wv) ? lds[i] : 0.f;
    const float off = woff + inc - run; float* c = WSP(float, O_CFOX) + (size_t)bh * S_ + tid * 16;
#pragma unroll
    for (int i = 0; i < 4; ++i) *(f32x4*)(c + 4 * i) = (f32x4){v[4 * i] + off, v[4 * i + 1] + off, v[4 * i + 2] + off, v[4 * i + 3] + off};
    __syncthreads();
}
__device__ __forceinline__ void ph_prep2(KP p, int l) {
    { unsigned* kmax2 = WSP(unsigned, O_COUNTS) + 192 + l * 8;
      for (int i = fbid() * NT + ftid(); i < B_ * 4 * S_ * 2; i += gridDim.x * NT) { const int half = i & 1, t = (i >> 1) % S_, bh = (i >> 1) / S_, b = bh >> 2, h = bh & 3;
          const bf16_t* kr = WSP(bf16_t, O_PROJB) + (size_t)(b * S_ + t) * PB + C_FOX + (4 + h) * 64 + half * 32; float ss = 0.f;
#pragma unroll
          for (int c = 0; c < 4; ++c) { float k8[8]; ld8(kr + 8 * c, k8);
#pragma unroll
              for (int e = 0; e < 8; ++e) ss += k8[e] * k8[e]; }
          ss += __shfl_xor(ss, 1);
#pragma unroll
          for (int o = 2; o < 64; o <<= 1) ss = fmaxf(ss, __shfl_xor(ss, o));
          if ((ftid() & 63) == 0) atomicMax(kmax2 + bh, __float_as_uint(ss)); } }
    for (int i = fbid() * NT + ftid(); i < 8 * 512 * 64; i += gridDim.x * NT) {
        const int d = i & 63, n = (i >> 6) & 511, combo = i >> 15, kv = combo & 1, bg = combo >> 1;
        const float* w2 = (kv ? p->in.w2v : p->in.w2k) + (size_t)l * 128 * 64; const bf16_t* hr = WSP(bf16_t, O_HID) + ((size_t)combo * 512 + n) * 128;
        float a = 0.f;
#pragma unroll 4
        for (int c = 0; c < 16; ++c) { float h8[8]; ld8(hr + 8 * c, h8);
#pragma unroll
            for (int e = 0; e < 8; ++e) a += h8[e] * w2[(8 * c + e) * 64 + d]; }
        (kv ? WSP(bf16_t, O_VCMPB) : WSP(bf16_t, O_KCMPB))[((size_t)bg * 512 + n) * 64 + d] = (n < NCMP) ? (bf16_t)f2bf(a) : (bf16_t)0; }
}
__device__ __forceinline__ void ph_moe_scatter2(float* lds, KP p, int l) {
    const int tid = ftid(); int* ts = (int*)lds;
    const int* counts = WSP(int, O_COUNTS) + CNT_IDX(l, 0); int* meta = WSP(int, O_META); int* cl = ts + 64;
    __syncthreads();
    if (tid < NE) cl[tid] = counts[tid * 32];
    __syncthreads();
    if (tid == 0) { int nt = 0; for (int e = 0; e < NE; ++e) { ts[e] = nt; nt += (cl[e] + 255) >> 8; } ts[32] = nt; }
    __syncthreads();
    if (fbid() == 0) { if (tid < NE) { const int c = cl[tid], t0 = ts[tid]; meta[tid] = t0; for (int r = 0, t = t0; r < c; r += 256, ++t) { meta[64 + 2 * t] = tid; meta[65 + 2 * t] = (c - r) < 256 ? (c - r) : 256; } }
        if (tid == 0) meta[32] = ts[32]; }
    for (int i = fbid() * NT + tid; i < MROWS; i += gridDim.x * NT) {
        const int row = ts[WSP(int, O_TOPE)[i]] * 256 + WSP(int, O_POS)[i];
        WSP(int, O_ROWTOK)[row] = i >> 2; WSP(float, O_ROWW)[row] = WSP(float, O_TOPW)[i]; WSP(int, O_SLOT)[i] = row; }
    __syncthreads();
}
}
namespace mk {
typedef short bf16x8 __attribute__((ext_vector_type(8)));
typedef float f32x16 __attribute__((ext_vector_type(16)));
typedef float f32x2_t __attribute__((ext_vector_type(2)));
typedef __bf16 bf16x2_t __attribute__((ext_vector_type(2)));
typedef unsigned u32x2 __attribute__((ext_vector_type(2)));
typedef short v4i16_t __attribute__((ext_vector_type(4)));
__device__ __forceinline__ unsigned cvtpk(float lo, float hi) { f32x2_t v = {lo, hi}; bf16x2_t b = __builtin_convertvector(v, bf16x2_t); return __builtin_bit_cast(unsigned, b); }
constexpr int KROW = 144, VROW = 136;
constexpr int E1_K = 0, E1_V = 64 * KROW, E1_C = E1_V + 64 * KROW, E1_BUF = E1_C + 256;
constexpr int E1_FLAGS = 2 * E1_BUF;
constexpr float LOG2E = 1.4426950408889634f;
constexpr float RESC_THR = 8.0f;
#define CROW(reg, hh) (((reg) & 3) + 8 * ((reg) >> 2) + 4 * (hh))

#define SM_CORE(p0, p1, m, l, have, o0, o1) do { \
    float rm_ = fmaxf(p0[0], p1[0]); \
    _Pragma("unroll") for (int reg_ = 1; reg_ < 16; ++reg_) rm_ = fmaxf(rm_, fmaxf(p0[reg_], p1[reg_])); \
    rm_ = fmaxf(rm_, __shfl_xor(rm_, 32)); \
    const bool fin_ = rm_ > -1e37f; \
    if (__any((rm_ > RESC_THR) || (!have && fin_))) { \
        const float dl_ = have ? fmaxf(rm_, 0.f) : (fin_ ? rm_ : 0.f); const float al_ = have ? __builtin_amdgcn_exp2f(-dl_) : 1.f; \
        m += dl_; l *= al_; have = have || fin_; \
        _Pragma("unroll") for (int r_ = 0; r_ < 16; ++r_) { o0[r_] *= al_; o1[r_] *= al_; p0[r_] -= dl_; p1[r_] -= dl_; } } \
    float ls_ = 0.f; \
    _Pragma("unroll") for (int reg_ = 0; reg_ < 16; ++reg_) { p0[reg_] = __builtin_amdgcn_exp2f(p0[reg_]); p1[reg_] = __builtin_amdgcn_exp2f(p1[reg_]); ls_ += p0[reg_] + p1[reg_]; } \
    l += ls_; } while (0)

struct E1Geom { int b, q0, h; const bf16_t* qp; const bf16_t* kp; const bf16_t* vp; size_t pitch; };

template <int KIND>
__device__ __forceinline__ void e1_unit(LAS unsigned char* lds, KP p, int b, int hg, int qb, bf16_t* __restrict__ obase, bf16_t* __restrict__ owin, const unsigned* __restrict__ kmax2) {
    const int tid = ftid(), lane = tid & 63, w = __builtin_amdgcn_readfirstlane(tid >> 6), r32 = lane & 31, hh = lane >> 5;
    const bf16_t* projb = WSP(bf16_t, O_PROJB);
    int h, q0, qrow0, qcol, kcol, vcol, nrows;
    if (KIND == 0) { h = hg; q0 = qb * 256; qrow0 = q0 + 32 * w; qcol = C_FOX + h * 64; kcol = C_FOX + (4 + h) * 64; vcol = C_FOX + (8 + h) * 64; nrows = 256; }
    else if (KIND == 2) { h = hg; q0 = qb * 256; qrow0 = q0 + 32 * w; qcol = C_SB + h * 64; kcol = C_SB + (4 + h) * 64; vcol = C_SB + (8 + h) * 64; nrows = 256; }
    else { h = 4 * hg + (w & 3); q0 = qb * 64; qrow0 = q0 + 32 * (w >> 2); qcol = h * 64; kcol = C_KV + ((2 * 2 + 0) * 2 + hg) * 64; vcol = C_KV + ((2 * 2 + 1) * 2 + hg) * 64; nrows = 64; }
    const int tq = qrow0 + r32;
    const bf16_t* kbase = projb + (size_t)(b * S_) * PB + kcol; const bf16_t* vbase = projb + (size_t)(b * S_) * PB + vcol;
    bf16x8 qf[4];
    { const bf16_t* qptr = projb + (size_t)(b * S_ + tq) * PB + qcol + 8 * hh;
#pragma unroll
      for (int d0 = 0; d0 < 4; ++d0) qf[d0] = *(const bf16x8*)(qptr + 16 * d0); }
    int j0 = 0; const int j1 = (q0 + nrows - 1) >> 6;
    if (KIND == 1) { j0 = (q0 - 511) >> 6; if (j0 < 0) j0 = 0; }
    const int ntile = j1 - j0 + 1;
    float ct2 = 0.f, sl2 = 0.f; const float* cb = nullptr;
    if (KIND == 0) { cb = WSP(float, O_CFOX) + (size_t)(b * 4 + h) * S_; ct2 = cb[tq] * LOG2E; }
    if (KIND == 1) sl2 = exp2f(-(float)(h + 1)) * LOG2E;
    float qkb = 0.f;
    if (KIND == 0) { float qs = 0.f;
#pragma unroll
        for (int d0 = 0; d0 < 4; ++d0)
#pragma unroll
            for (int e = 0; e < 8; ++e) { const float x = bf2f((unsigned short)qf[d0][e]); qs += x * x; }
        qs += __shfl_xor(qs, 32);
        const float km2 = __uint_as_float(kmax2[b * 4 + h]);
        qkb = sqrtf(qs * km2) * (SCALE * LOG2E * 1.01f); }
    const float tqf = (float)tq;
    const int skey = tid >> 3, sch = tid & 7;
    u32x4 rk, rv; float rc = 0.f;
#define E1_LOAD(jj) do { const size_t ro_ = (size_t)((jj) * 64 + skey) * PB + sch * 8; rk = *(const u32x4*)(kbase + ro_); rv = *(const u32x4*)(vbase + ro_); \
        if (KIND == 0 && tid < 64) rc = cb[(jj) * 64 + tid] * LOG2E; } while (0)
#define E1_WRITE(bufp) do { *(LAS u32x4*)((bufp) + E1_K + skey * KROW + sch * 16) = rk; *(LAS u32x4*)((bufp) + E1_V + skey * KROW + sch * 16) = rv; \
        if (KIND == 0 && tid < 64) ((LAS float*)((bufp) + E1_C))[tid] = rc; } while (0)
    f32x16 o0, o1;
#pragma unroll
    for (int r = 0; r < 16; ++r) { o0[r] = 0.f; o1[r] = 0.f; }
    float m = 0.f, l = 0.f, carry = 0.f; bool have = false;
    bool wave_done = false;
    LAS unsigned* flags = (LAS unsigned*)(lds + E1_FLAGS);
    if (KIND != 1) { if (tid < 8) flags[tid] = 0u; }
    __syncthreads();
    E1_LOAD(KIND != 1 ? j1 : j0);
    for (int it = 0; it < ntile; ++it) {
        const int j = (KIND != 1) ? (j1 - it) : (j0 + it);
        LAS unsigned char* buf = lds + (it & 1) * E1_BUF;
        E1_WRITE(buf);
        __syncthreads();
        if (KIND != 1) { unsigned alld = 1u;
#pragma unroll
            for (int i = 0; i < 8; ++i) alld &= flags[i];
            if (alld) break; }
        if (it + 1 < ntile) E1_LOAD((KIND != 1) ? (j - 1) : (j + 1));
        if (!(KIND != 1 && wave_done)) {
            f32x16 p0, p1;
#pragma unroll
            for (int r = 0; r < 16; ++r) { p0[r] = 0.f; p1[r] = 0.f; }
            { const LAS unsigned char* kp_ = buf + E1_K + r32 * KROW + hh * 16;
#pragma unroll
              for (int d0 = 0; d0 < 4; ++d0) { const bf16x8 a0 = *(const LAS bf16x8*)(kp_ + d0 * 32), a1 = *(const LAS bf16x8*)(kp_ + 32 * KROW + d0 * 32);
                  p0 = __builtin_amdgcn_mfma_f32_32x32x16_bf16(a0, qf[d0], p0, 0, 0, 0); p1 = __builtin_amdgcn_mfma_f32_32x32x16_bf16(a1, qf[d0], p1, 0, 0, 0); } }
            const int kb = j * 64 + 4 * hh;
            if (KIND == 2) {
                float lk0[16], lk1[16], gs[8];
#pragma unroll
                for (int reg = 0; reg < 16; ++reg) { const int kpos = kb + CROW(reg, 0);
                    const float z0 = p0[reg] * SCALE, z1 = p1[reg] * SCALE; const bool v0 = kpos < tq, v1 = kpos + 32 < tq;
                    const float lb0 = fminf(z0, 0.f) - __logf(1.f + __expf(-fabsf(z0))), lb1 = fminf(z1, 0.f) - __logf(1.f + __expf(-fabsf(z1)));
                    lk0[reg] = v0 ? (lb0 - z0) : 0.f; lk1[reg] = v1 ? (lb1 - z1) : 0.f;
                    p0[reg] = v0 ? lb0 : -INFINITY; p1[reg] = v1 ? lb1 : -INFINITY; }
#pragma unroll
                for (int g4 = 0; g4 < 4; ++g4) { gs[g4] = (lk0[4 * g4] + lk0[4 * g4 + 1]) + (lk0[4 * g4 + 2] + lk0[4 * g4 + 3]); gs[4 + g4] = (lk1[4 * g4] + lk1[4 * g4 + 1]) + (lk1[4 * g4 + 2] + lk1[4 * g4 + 3]); }
                float oth[8];
#pragma unroll
                for (int gi = 0; gi < 8; ++gi) oth[gi] = __shfl_xor(gs[gi], 32);
                float run = 0.f;
#pragma unroll
                for (int gi = 7; gi >= 0; --gi) {
                    float later = carry + run + (hh == 0 ? oth[gi] : 0.f);
#pragma unroll
                    for (int e = 3; e >= 0; --e) { const int reg = (gi & 3) * 4 + e;
                        if (gi >> 2) { p1[reg] = __expf(p1[reg] + later); later += lk1[reg]; } else { p0[reg] = __expf(p0[reg] + later); later += lk0[reg]; } }
                    run += gs[gi] + oth[gi]; }
                carry += run;
            } else {
                if (KIND == 0) {
                    const LAS float* cs = (const LAS float*)(buf + E1_C) + 4 * hh; const float ctm = ct2 - m;
#pragma unroll
                    for (int i = 0; i < 4; ++i) { const f32x4 c0 = *(const LAS f32x4*)(cs + 8 * i), c1 = *(const LAS f32x4*)(cs + 32 + 8 * i);
#pragma unroll
                        for (int e = 0; e < 4; ++e) { const int reg = 4 * i + e; p0[reg] = p0[reg] * (SCALE * LOG2E) + (ctm - c0[e]); p1[reg] = p1[reg] * (SCALE * LOG2E) + (ctm - c1[e]); } }
                    if (!(j * 64 + 63 <= qrow0)) {
#pragma unroll
                        for (int reg = 0; reg < 16; ++reg) { const int kpos = kb + CROW(reg, 0); p0[reg] = (kpos <= tq) ? p0[reg] : -INFINITY; p1[reg] = (kpos + 32 <= tq) ? p1[reg] : -INFINITY; } }
                } else {
                    const float basef = sl2 * ((float)kb - tqf) - m, base1 = basef + 32.f * sl2;
#pragma unroll
                    for (int reg = 0; reg < 16; ++reg) { p0[reg] = p0[reg] * (SCALE * LOG2E) + __builtin_fmaf(sl2, (float)CROW(reg, 0), basef); p1[reg] = p1[reg] * (SCALE * LOG2E) + __builtin_fmaf(sl2, (float)CROW(reg, 0), base1); }
                    if (!(j * 64 + 63 <= qrow0 && qrow0 + 31 - j * 64 < 512)) {
#pragma unroll
                        for (int reg = 0; reg < 16; ++reg) { const int kpos = kb + CROW(reg, 0);
                            p0[reg] = (kpos <= tq && tq - kpos < 512) ? p0[reg] : -INFINITY; p1[reg] = (kpos + 32 <= tq && tq - kpos - 32 < 512) ? p1[reg] : -INFINITY; } }
                }
                SM_CORE(p0, p1, m, l, have, o0, o1);
            }
            { const int gq_ = lane >> 4, li_ = lane & 15;
              const LAS unsigned char* tb = buf + E1_V + (4 * hh + (li_ >> 2)) * KROW + (16 * (gq_ & 1) + 4 * (li_ & 3)) * 2;
#pragma unroll
              for (int s = 0; s < 4; ++s) {
                  u32x4 pw;
                  if (s < 2) { pw.x = cvtpk(p0[8 * s + 0], p0[8 * s + 1]); pw.y = cvtpk(p0[8 * s + 2], p0[8 * s + 3]); pw.z = cvtpk(p0[8 * s + 4], p0[8 * s + 5]); pw.w = cvtpk(p0[8 * s + 6], p0[8 * s + 7]); }
                  else { const int s2 = s - 2; pw.x = cvtpk(p1[8 * s2 + 0], p1[8 * s2 + 1]); pw.y = cvtpk(p1[8 * s2 + 2], p1[8 * s2 + 3]); pw.z = cvtpk(p1[8 * s2 + 4], p1[8 * s2 + 5]); pw.w = cvtpk(p1[8 * s2 + 6], p1[8 * s2 + 7]); }
                  const bf16x8 pb = __builtin_bit_cast(bf16x8, pw);
                  const v4i16_t a0l = __builtin_amdgcn_ds_read_tr16_b64_v4i16((LAS v4i16_t*)(tb + (16 * s) * KROW)), a0h = __builtin_amdgcn_ds_read_tr16_b64_v4i16((LAS v4i16_t*)(tb + (16 * s + 8) * KROW));
                  const v4i16_t a1l = __builtin_amdgcn_ds_read_tr16_b64_v4i16((LAS v4i16_t*)(tb + (16 * s) * KROW + 64)), a1h = __builtin_amdgcn_ds_read_tr16_b64_v4i16((LAS v4i16_t*)(tb + (16 * s + 8) * KROW + 64));
                  const bf16x8 va0 = (bf16x8){a0l[0], a0l[1], a0l[2], a0l[3], a0h[0], a0h[1], a0h[2], a0h[3]}, va1 = (bf16x8){a1l[0], a1l[1], a1l[2], a1l[3], a1h[0], a1h[1], a1h[2], a1h[3]};
                  o0 = __builtin_amdgcn_mfma_f32_32x32x16_bf16(va0, pb, o0, 0, 0, 0); o1 = __builtin_amdgcn_mfma_f32_32x32x16_bf16(va1, pb, o1, 0, 0, 0); } }
            if (KIND == 0) {
                const float c0 = *(const LAS float*)(buf + E1_C); const bool dn = __all(have && (qkb + (ct2 - c0) - m < -150.f));
                if (dn && !wave_done) { wave_done = true; if (lane == 0) flags[w] = 1u; } }
            if (KIND == 2) { const bool dn = __all(carry < -110.f);
                if (dn && !wave_done) { wave_done = true; if (lane == 0) flags[w] = 1u; } }
        }
    }
    float inv = 1.f, gate = 1.f;
    if (KIND != 2) { l += __shfl_xor(l, 32); inv = (l > 0.f) ? 1.f / l : 0.f; }
    bf16_t* orow;
    if (KIND == 0) orow = obase + (size_t)(b * S_ + tq) * D_ + 512 + h * 64;
    else if (KIND == 2) orow = obase + (size_t)(b * S_ + tq) * D_ + 768 + h * 64;
    else { orow = owin + (size_t)(b * S_ + tq) * 512 + h * 64; gate = WSP(float, O_GF)[(size_t)(b * S_ + tq) * 32 + 2 * 8 + h]; }
    const float sc = inv * gate;
#pragma unroll
    for (int i = 0; i < 4; ++i) {
        *(u32x2*)(orow + 8 * i + 4 * hh) = (u32x2){cvtpk(o0[4 * i] * sc, o0[4 * i + 1] * sc), cvtpk(o0[4 * i + 2] * sc, o0[4 * i + 3] * sc)};
        *(u32x2*)(orow + 32 + 8 * i + 4 * hh) = (u32x2){cvtpk(o1[4 * i] * sc, o1[4 * i + 1] * sc), cvtpk(o1[4 * i + 2] * sc, o1[4 * i + 3] * sc)}; }
#undef E1_LOAD
#undef E1_WRITE
}
}
namespace mk {
constexpr int E2_WAVE = 64 * KROW + 512;
template <bool USE_MASK>
__device__ __forceinline__ void e2_wave_unit(LAS unsigned char* ldsw, KP p, int b, int g, int t0, bf16_t* __restrict__ obase, const bf16_t* __restrict__ csrc, int cpitch) {
    const int lane = ftid() & 63, r32 = lane & 31, hh = lane >> 5, qi = r32 >> 2, r4 = r32 & 3;
    const int h = 4 * g + r4, tq = t0 + qi;
    const bf16_t* projb = WSP(bf16_t, O_PROJB);
    const bf16_t* kbase = projb + (size_t)(b * S_) * PB + C_KV + ((1 * 2 + 0) * 2 + g) * 64;
    const bf16_t* vbase = projb + (size_t)(b * S_) * PB + C_KV + ((1 * 2 + 1) * 2 + g) * 64;
    bf16x8 qf[4];
    { const bf16_t* qptr = projb + (size_t)(b * S_ + tq) * PB + h * 64 + 8 * hh;
#pragma unroll
      for (int d0 = 0; d0 < 4; ++d0) qf[d0] = *(const bf16x8*)(qptr + 16 * d0); }
    unsigned qm0 = 0u, qm1 = 0u, qm2 = 0u, qm3 = 0u;
    if (USE_MASK) { const u32x4 mw = *(const u32x4*)(WSP(unsigned, O_SELMASK) + ((size_t)((b * 2 + g) * S_ + t0 + (lane >> 3))) * 4); qm0 = mw.x; qm1 = mw.y; qm2 = mw.z; qm3 = mw.w; }
    else { const int* sp = WSP(int, O_SEL) + ((size_t)((b * 2 + g) * S_ + t0)) * NSEL + lane * 2;
      const int e0 = sp[0], e1 = sp[1];
#pragma unroll
      for (int k = 0; k < 2; ++k) { const int e = k ? e1 : e0; const unsigned bit = 1u << (e & 31); const int wd = e >> 5;
          qm0 |= (wd == 0) ? bit : 0u; qm1 |= (wd == 1) ? bit : 0u; qm2 |= (wd == 2) ? bit : 0u; qm3 |= (wd == 3) ? bit : 0u; }
#pragma unroll
      for (int o = 1; o < 8; o <<= 1) { qm0 |= __shfl_xor(qm0, o); qm1 |= __shfl_xor(qm1, o); qm2 |= __shfl_xor(qm2, o); qm3 |= __shfl_xor(qm3, o); } }
    const unsigned rm0 = __shfl(qm0, qi * 8), rm1 = __shfl(qm1, qi * 8), rm2 = __shfl(qm2, qi * 8), rm3 = __shfl(qm3, qi * 8);
    unsigned um0 = qm0, um1 = qm1, um2 = qm2, um3 = qm3;
#pragma unroll
    for (int o = 8; o < 64; o <<= 1) { um0 |= __shfl_xor(um0, o); um1 |= __shfl_xor(um1, o); um2 |= __shfl_xor(um2, o); um3 |= __shfl_xor(um3, o); }
    LAS int* list = (LAS int*)(ldsw + 64 * KROW);
    int nblk;
    { const bool s0 = (((lane < 32) ? um0 : um1) >> (lane & 31)) & 1u, s1 = (((lane < 32) ? um2 : um3) >> (lane & 31)) & 1u;
      const unsigned long long b0 = __ballot(s0), b1 = __ballot(s1);
      const unsigned long long lower = (lane == 0) ? 0ull : (~0ull >> (64 - lane));
      const int n0 = __popcll(b0);
      if (s0) list[__popcll(b0 & lower)] = lane;
      if (s1) list[n0 + __popcll(b1 & lower)] = lane + 64;
      nblk = n0 + __popcll(b1); }
    asm volatile("s_waitcnt lgkmcnt(0)" ::: "memory");
    const float sl2 = exp2f(-(float)(h + 1)) * LOG2E, tqf = (float)tq;
    f32x16 o0, o1;
#pragma unroll
    for (int r = 0; r < 16; ++r) { o0[r] = 0.f; o1[r] = 0.f; }
    float m = 0.f, l = 0.f; bool have = false;
    const int curq = tq >> 6;
    const int vrow = lane >> 3, vch = lane & 7;
    const int gq = lane >> 4, li = lane & 15;
    const LAS unsigned char* trb = ldsw + (4 * hh + (li >> 2)) * KROW + (16 * (gq & 1) + 4 * (li & 3)) * 2;
    bf16x8 kn0[4], kn1[4]; u32x4 vn[8];
#define E2_LOAD(blk) do { const bf16_t* kp_ = kbase + (size_t)((blk) * 64 + r32) * PB + 8 * hh; const bf16_t* vp_ = vbase + (size_t)((blk) * 64 + vrow) * PB + vch * 8; \
        _Pragma("unroll") for (int d0 = 0; d0 < 4; ++d0) { kn0[d0] = *(const bf16x8*)(kp_ + 16 * d0); kn1[d0] = *(const bf16x8*)(kp_ + (size_t)32 * PB + 16 * d0); } \
        _Pragma("unroll") for (int i = 0; i < 8; ++i) vn[i] = *(const u32x4*)(vp_ + (size_t)(8 * i) * PB); } while (0)
    int blk = list[0];
    blk = __builtin_amdgcn_readfirstlane(blk);
    E2_LOAD(blk);
    for (int it = 0; it < nblk; ++it) {
#pragma unroll
        for (int i = 0; i < 8; ++i) *(LAS u32x4*)(ldsw + (vrow + 8 * i) * KROW + vch * 16) = vn[i];
        const int cur = blk;
        f32x16 p0, p1;
#pragma unroll
        for (int r = 0; r < 16; ++r) { p0[r] = 0.f; p1[r] = 0.f; }
#pragma unroll
        for (int d0 = 0; d0 < 4; ++d0) { p0 = __builtin_amdgcn_mfma_f32_32x32x16_bf16(kn0[d0], qf[d0], p0, 0, 0, 0); p1 = __builtin_amdgcn_mfma_f32_32x32x16_bf16(kn1[d0], qf[d0], p1, 0, 0, 0); }
        if (it + 1 < nblk) { blk = __builtin_amdgcn_readfirstlane(list[it + 1]); E2_LOAD(blk); }
        const unsigned rw = (cur < 32) ? rm0 : (cur < 64) ? rm1 : (cur < 96) ? rm2 : rm3;
        const bool rowsel = (rw >> (cur & 31)) & 1u;
        const int kb = cur * 64 + 4 * hh;
        { const float basef = rowsel ? (sl2 * ((float)kb - tqf) - m) : -INFINITY, base1 = basef + 32.f * sl2;
#pragma unroll
          for (int reg = 0; reg < 16; ++reg) { p0[reg] = p0[reg] * (SCALE * LOG2E) + __builtin_fmaf(sl2, (float)CROW(reg, 0), basef); p1[reg] = p1[reg] * (SCALE * LOG2E) + __builtin_fmaf(sl2, (float)CROW(reg, 0), base1); } }
        if (cur >= curq) {
#pragma unroll
            for (int reg = 0; reg < 16; ++reg) { const int kpos = kb + CROW(reg, 0); p0[reg] = (kpos <= tq) ? p0[reg] : -INFINITY; p1[reg] = (kpos + 32 <= tq) ? p1[reg] : -INFINITY; } }
        SM_CORE(p0, p1, m, l, have, o0, o1);
#pragma unroll
        for (int s = 0; s < 4; ++s) {
            u32x4 pw;
            if (s < 2) { pw.x = cvtpk(p0[8 * s + 0], p0[8 * s + 1]); pw.y = cvtpk(p0[8 * s + 2], p0[8 * s + 3]); pw.z = cvtpk(p0[8 * s + 4], p0[8 * s + 5]); pw.w = cvtpk(p0[8 * s + 6], p0[8 * s + 7]); }
            else { const int s2 = s - 2; pw.x = cvtpk(p1[8 * s2 + 0], p1[8 * s2 + 1]); pw.y = cvtpk(p1[8 * s2 + 2], p1[8 * s2 + 3]); pw.z = cvtpk(p1[8 * s2 + 4], p1[8 * s2 + 5]); pw.w = cvtpk(p1[8 * s2 + 6], p1[8 * s2 + 7]); }
            const bf16x8 pb = __builtin_bit_cast(bf16x8, pw);
            const v4i16_t a0l = __builtin_amdgcn_ds_read_tr16_b64_v4i16((LAS v4i16_t*)(trb + (16 * s) * KROW)), a0h = __builtin_amdgcn_ds_read_tr16_b64_v4i16((LAS v4i16_t*)(trb + (16 * s + 8) * KROW));
            const v4i16_t a1l = __builtin_amdgcn_ds_read_tr16_b64_v4i16((LAS v4i16_t*)(trb + (16 * s) * KROW + 64)), a1h = __builtin_amdgcn_ds_read_tr16_b64_v4i16((LAS v4i16_t*)(trb + (16 * s + 8) * KROW + 64));
            const bf16x8 va0 = (bf16x8){a0l[0], a0l[1], a0l[2], a0l[3], a0h[0], a0h[1], a0h[2], a0h[3]}, va1 = (bf16x8){a1l[0], a1l[1], a1l[2], a1l[3], a1h[0], a1h[1], a1h[2], a1h[3]};
            o0 = __builtin_amdgcn_mfma_f32_32x32x16_bf16(va0, pb, o0, 0, 0, 0); o1 = __builtin_amdgcn_mfma_f32_32x32x16_bf16(va1, pb, o1, 0, 0, 0); }
    }
    l += __shfl_xor(l, 32);
    const float sc = ((l > 0.f) ? 1.f / l : 0.f) * WSP(float, O_GF)[(size_t)(b * S_ + tq) * 32 + 1 * 8 + h];
    bf16_t* orow = obase + (size_t)(b * S_ + tq) * D_ + h * 64; const bf16_t* crow = csrc + (size_t)(b * S_ + tq) * cpitch + h * 64;
#pragma unroll
    for (int i = 0; i < 4; ++i) {
        const u32x2 c0 = *(const u32x2*)(crow + 8 * i + 4 * hh), c1 = *(const u32x2*)(crow + 32 + 8 * i + 4 * hh);
        const float x00 = __uint_as_float(c0.x << 16) + o0[4 * i] * sc, x01 = __uint_as_float(c0.x & 0xffff0000u) + o0[4 * i + 1] * sc, x02 = __uint_as_float(c0.y << 16) + o0[4 * i + 2] * sc, x03 = __uint_as_float(c0.y & 0xffff0000u) + o0[4 * i + 3] * sc;
        const float x10 = __uint_as_float(c1.x << 16) + o1[4 * i] * sc, x11 = __uint_as_float(c1.x & 0xffff0000u) + o1[4 * i + 1] * sc, x12 = __uint_as_float(c1.y << 16) + o1[4 * i + 2] * sc, x13 = __uint_as_float(c1.y & 0xffff0000u) + o1[4 * i + 3] * sc;
        *(u32x2*)(orow + 8 * i + 4 * hh) = (u32x2){cvtpk(x00, x01), cvtpk(x02, x03)}; *(u32x2*)(orow + 32 + 8 * i + 4 * hh) = (u32x2){cvtpk(x10, x11), cvtpk(x12, x13)}; }
#undef E2_LOAD
}
template <bool USE_MASK>
__device__ __forceinline__ void ph_attn_sel2(LAS unsigned char* lds3, KP p, bf16_t* __restrict__ obase, const bf16_t* __restrict__ csrc, int cpitch) {
    const int w = __builtin_amdgcn_readfirstlane(ftid() >> 6);
    LAS unsigned char* ldsw = lds3 + w * E2_WAVE;
    MK_LOOP(u, 512) { const int bg = u & 3, qblk = u >> 2; e2_wave_unit<USE_MASK>(ldsw, p, bg >> 1, bg & 1, qblk * 64 + 8 * w, obase, csrc, cpitch); }
}
}
namespace mk {
constexpr int E3_K = 0, E3_V = 512 * KROW, E3_BYTES = 2 * 512 * KROW;
__device__ __forceinline__ void e3_unit(LAS unsigned char* lds, KP p, int b, int g, int qb, bf16_t* __restrict__ ocmp, unsigned* __restrict__ selmask) {
    const int tid = ftid(), lane = tid & 63, w = __builtin_amdgcn_readfirstlane(tid >> 6), r32 = lane & 31, hh = lane >> 5;
    const int bg = b * 2 + g, q0 = qb * 256, qrow0 = q0 + 32 * w, tq = qrow0 + r32;
    const bf16_t* projb = WSP(bf16_t, O_PROJB);
    int nun = (q0 + 255 - 31) / 16 + 1; if (nun > 511) nun = 511;
    const int ntile_u = (nun + 63) >> 6;
    __syncthreads();
    { const int srow = tid >> 3, sch = tid & 7; const bf16_t* ks = WSP(bf16_t, O_KCMPB) + ((size_t)bg * 512 + srow) * 64 + sch * 8; const bf16_t* vs = WSP(bf16_t, O_VCMPB) + ((size_t)bg * 512 + srow) * 64 + sch * 8;
      for (int i = 0; i < ntile_u; ++i) { const u32x4 kv = *(const u32x4*)(ks + (size_t)i * 64 * 64), vv = *(const u32x4*)(vs + (size_t)i * 64 * 64);
          *(LAS u32x4*)(lds + E3_K + (srow + 64 * i) * KROW + sch * 16) = kv; *(LAS u32x4*)(lds + E3_V + (srow + 64 * i) * KROW + sch * 16) = vv; } }
    __syncthreads();
    int nw = qrow0 / 16 + 1; if (nw > 511) nw = 511;
    const int ntile_w = (qrow0 + 31 < 31) ? 0 : ((nw + 63) >> 6);
    const float tqf = (float)tq;
    const int gq = lane >> 4, li = lane & 15;
    const LAS unsigned char* trb = lds + E3_V + (4 * hh + (li >> 2)) * KROW + (16 * (gq & 1) + 4 * (li & 3)) * 2;
    const LAS unsigned char* kfb = lds + E3_K + r32 * KROW + hh * 16;
    float imp[64];
#pragma unroll
    for (int i = 0; i < 64; ++i) imp[i] = 0.f;
#pragma unroll 1
    for (int r4 = 0; r4 < 4; ++r4) {
        const int h = 4 * g + r4; const float sl2 = exp2f(-(float)(h + 1)) * LOG2E;
        const bf16_t* qptr = projb + (size_t)(b * S_ + tq) * PB + h * 64 + 8 * hh;
        f32x16 o0, o1;
#pragma unroll
        for (int r = 0; r < 16; ++r) { o0[r] = 0.f; o1[r] = 0.f; }
        float m = 0.f, l = 0.f; bool have = false;
#define E3_ST(jt) f32x16 p0, p1; { bf16x8 qf[4]; _Pragma("unroll") for (int d0 = 0; d0 < 4; ++d0) qf[d0] = *(const bf16x8*)(qptr + 16 * d0); \
            _Pragma("unroll") for (int r = 0; r < 16; ++r) { p0[r] = 0.f; p1[r] = 0.f; } \
            _Pragma("unroll") for (int d0 = 0; d0 < 4; ++d0) { const bf16x8 a0 = *(const LAS bf16x8*)(kfb + (64 * (jt)) * KROW + d0 * 32), a1 = *(const LAS bf16x8*)(kfb + (64 * (jt) + 32) * KROW + d0 * 32); \
                p0 = __builtin_amdgcn_mfma_f32_32x32x16_bf16(a0, qf[d0], p0, 0, 0, 0); p1 = __builtin_amdgcn_mfma_f32_32x32x16_bf16(a1, qf[d0], p1, 0, 0, 0); } \
            int tq_ = tq; asm volatile("" : "+v"(tq_));     \
            int hh_ = hh; asm volatile("" : "+v"(hh_)); \
            const float tqf_ = (float)tq_; const int ce0_ = 16 * (64 * (jt) + 4 * hh_) + 31; \
            const float basef_ = sl2 * ((float)ce0_ - tqf_) - m, base1_ = basef_ + 512.f * sl2; \
            _Pragma("unroll") for (int reg = 0; reg < 16; ++reg) { const float cr_ = sl2 * (float)(16 * CROW(reg, 0)); p0[reg] = p0[reg] * (SCALE * LOG2E) + (basef_ + cr_); p1[reg] = p1[reg] * (SCALE * LOG2E) + (base1_ + cr_); } \
            if (ce0_ + 16 * 27 + 512 > qrow0) {     \
                _Pragma("unroll") for (int reg = 0; reg < 16; ++reg) { const int ce = ce0_ + 16 * CROW(reg, 0); p0[reg] = (ce <= tq_) ? p0[reg] : -INFINITY; p1[reg] = (ce + 512 <= tq_) ? p1[reg] : -INFINITY; } } }
        float imh[64];
#pragma unroll
        for (int i = 0; i < 64; ++i) imh[i] = 0.f;
#pragma unroll
        for (int jt = 0; jt < 8; ++jt) {
            if (jt < ntile_w) {
                E3_ST(jt);
                {
                    float rm_ = fmaxf(p0[0], p1[0]);
#pragma unroll
                    for (int reg_ = 1; reg_ < 16; ++reg_) rm_ = fmaxf(rm_, fmaxf(p0[reg_], p1[reg_]));
                    rm_ = fmaxf(rm_, __shfl_xor(rm_, 32));
                    const bool fin_ = rm_ > -1e37f;
                    if (__any((rm_ > RESC_THR) || (!have && fin_))) {
                        const float dl_ = have ? fmaxf(rm_, 0.f) : (fin_ ? rm_ : 0.f); const float al_ = have ? __builtin_amdgcn_exp2f(-dl_) : 1.f;
                        m += dl_; l *= al_; have = have || fin_;
#pragma unroll
                        for (int r_ = 0; r_ < 16; ++r_) { o0[r_] *= al_; o1[r_] *= al_; p0[r_] -= dl_; p1[r_] -= dl_; }
#pragma unroll
                        for (int i = 0; i < 64; ++i) imh[i] *= al_; }
                    float ls_ = 0.f;
#pragma unroll
                    for (int reg_ = 0; reg_ < 16; ++reg_) { p0[reg_] = __builtin_amdgcn_exp2f(p0[reg_]); p1[reg_] = __builtin_amdgcn_exp2f(p1[reg_]); ls_ += p0[reg_] + p1[reg_]; }
                    l += ls_; }
#pragma unroll
                for (int pa = 0; pa < 2; ++pa)
#pragma unroll
                    for (int i = 0; i < 4; ++i) { const int jj = 8 * jt + 4 * pa + i;
                        const float x0 = pa ? p1[4 * i] : p0[4 * i], x1 = pa ? p1[4 * i + 1] : p0[4 * i + 1], x2 = pa ? p1[4 * i + 2] : p0[4 * i + 2], x3 = pa ? p1[4 * i + 3] : p0[4 * i + 3];
                        const float c = 0.5f * x3, a = (x0 + x1) + (x2 + c), r = __shfl_xor(c, 32);
                        imh[jj] += a + (hh ? r : 0.f);
                        if (jj + 1 < 64) imh[jj + 1] += (hh ? 0.f : r); }
                const LAS unsigned char* tb = trb + (64 * jt) * KROW;
#pragma unroll
                for (int s = 0; s < 4; ++s) {
                    u32x4 pw;
                    if (s < 2) { pw.x = cvtpk(p0[8 * s + 0], p0[8 * s + 1]); pw.y = cvtpk(p0[8 * s + 2], p0[8 * s + 3]); pw.z = cvtpk(p0[8 * s + 4], p0[8 * s + 5]); pw.w = cvtpk(p0[8 * s + 6], p0[8 * s + 7]); }
                    else { const int s2 = s - 2; pw.x = cvtpk(p1[8 * s2 + 0], p1[8 * s2 + 1]); pw.y = cvtpk(p1[8 * s2 + 2], p1[8 * s2 + 3]); pw.z = cvtpk(p1[8 * s2 + 4], p1[8 * s2 + 5]); pw.w = cvtpk(p1[8 * s2 + 6], p1[8 * s2 + 7]); }
                    const bf16x8 pb = __builtin_bit_cast(bf16x8, pw);
                    const v4i16_t a0l = __builtin_amdgcn_ds_read_tr16_b64_v4i16((LAS v4i16_t*)(tb + (16 * s) * KROW)), a0h = __builtin_amdgcn_ds_read_tr16_b64_v4i16((LAS v4i16_t*)(tb + (16 * s + 8) * KROW));
                    const v4i16_t a1l = __builtin_amdgcn_ds_read_tr16_b64_v4i16((LAS v4i16_t*)(tb + (16 * s) * KROW + 64)), a1h = __builtin_amdgcn_ds_read_tr16_b64_v4i16((LAS v4i16_t*)(tb + (16 * s + 8) * KROW + 64));
                    const bf16x8 va0 = (bf16x8){a0l[0], a0l[1], a0l[2], a0l[3], a0h[0], a0h[1], a0h[2], a0h[3]}, va1 = (bf16x8){a1l[0], a1l[1], a1l[2], a1l[3], a1h[0], a1h[1], a1h[2], a1h[3]};
                    o0 = __builtin_amdgcn_mfma_f32_32x32x16_bf16(va0, pb, o0, 0, 0, 0); o1 = __builtin_amdgcn_mfma_f32_32x32x16_bf16(va1, pb, o1, 0, 0, 0); }
            }
        }
        l += __shfl_xor(l, 32);
        const float inv = (l > 0.f) ? 1.f / l : 0.f;
#pragma unroll
        for (int i = 0; i < 64; ++i) imp[i] += imh[i] * inv;
        { const float sc = inv * WSP(float, O_GF)[(size_t)(b * S_ + tq) * 32 + 0 * 8 + h];
          bf16_t* orow = ocmp + (size_t)(b * S_ + tq) * 512 + h * 64;
#pragma unroll
          for (int i = 0; i < 4; ++i) {
              *(u32x2*)(orow + 8 * i + 4 * hh) = (u32x2){cvtpk(o0[4 * i] * sc, o0[4 * i + 1] * sc), cvtpk(o0[4 * i + 2] * sc, o0[4 * i + 3] * sc)};
              *(u32x2*)(orow + 32 + 8 * i + 4 * hh) = (u32x2){cvtpk(o1[4 * i] * sc, o1[4 * i + 1] * sc), cvtpk(o1[4 * i + 2] * sc, o1[4 * i + 3] * sc)}; } }
#undef E3_ST
    }
    const int cur = tq >> 6;
#pragma unroll
    for (int jj = 0; jj < 64; ++jj) { const int j = 2 * jj + hh; imp[jj] = (j != 0 && j < cur - 1) ? imp[jj] : -1.f; }
    unsigned m0 = 1u, m1 = 0u, m2 = 0u, m3 = 0u;
#define E3_SETBIT(j) do { const unsigned bit_ = 1u << ((j) & 31); const int wd_ = (j) >> 5; m0 |= (wd_ == 0) ? bit_ : 0u; m1 |= (wd_ == 1) ? bit_ : 0u; m2 |= (wd_ == 2) ? bit_ : 0u; m3 |= (wd_ == 3) ? bit_ : 0u; } while (0)
    E3_SETBIT(cur); if (cur >= 1) E3_SETBIT(cur - 1);
#pragma unroll 1
    for (int it = 0; it < NSEL - 3; ++it) {
        float best = -0.5f; int bj = 0;
#pragma unroll
        for (int jj = 0; jj < 64; ++jj) { if (imp[jj] > best) { best = imp[jj]; bj = jj; } }
        const int myj = 2 * bj + hh; const float ob = __shfl_xor(best, 32); const int oj = __shfl_xor(myj, 32);
        const bool mine = (best > ob) || (best == ob && myj < oj);
        const float wv = mine ? best : ob; const int wj = mine ? myj : oj;
        if (wv >= 0.f) E3_SETBIT(wj);
        if (mine && best >= 0.f) {
#pragma unroll
            for (int jj = 0; jj < 64; ++jj) imp[jj] = (jj == bj) ? -2.f : imp[jj]; }
    }
#undef E3_SETBIT
    if (hh == 0) *(u32x4*)(selmask + ((size_t)bg * S_ + tq) * 4) = (u32x4){m0, m1, m2, m3};
}
}
namespace mk {
constexpr int SB_EARLY = 232;
template <int MODE>
__device__ __forceinline__ void ph_attn1(float* lds, LAS unsigned char* lds3, KP p, unsigned* qctr, bf16_t* obase, bf16_t* owin, const unsigned* kmax2) {
    LAS int* qslot = (LAS int*)(lds3 + E3_BYTES);
    constexpr int N_E3 = (MODE & 2) ? 128 : 0, N_CMP = (MODE & 1) ? 64 : 0, N_FOX = (MODE & 4) ? 256 : 0, N_WIN = (MODE & 8) ? 512 : 0, N_SB = (MODE & 16) ? (256 - SB_EARLY) : 0;
    for (;;) {
        __syncthreads();
        if (ftid() == 0) *qslot = (int)atomicAdd(qctr, 1u);
        __syncthreads();
        int u = __builtin_amdgcn_readfirstlane(*qslot);
        if (u >= N_E3 + N_CMP + N_FOX + N_WIN + N_SB) break;
        if (u < N_E3) { e3_unit(lds3, p, (u & 3) >> 1, u & 1, 31 - (u >> 2), WSP(bf16_t, O_OCMP), WSP(unsigned, O_SELMASK)); continue; } u -= N_E3;
        if (u < N_FOX) { e1_unit<0>(lds3, p, (u & 7) >> 2, u & 3, 31 - (u >> 3), obase, owin, kmax2); continue; } u -= N_FOX;
        if (u < N_WIN) { e1_unit<1>(lds3, p, (u & 3) >> 1, u & 1, 127 - (u >> 2), obase, owin, kmax2); continue; } u -= N_WIN;
        if (u < N_SB) { u += SB_EARLY; e1_unit<2>(lds3, p, (u & 7) >> 2, u & 3, 31 - (u >> 3), obase, owin, kmax2); }
    }
}
__device__ __forceinline__ void ph_sb_early(LAS unsigned char* lds3, KP p) {
    const int u = fbid() - 24; if (u < 0 || u >= SB_EARLY) return;
    e1_unit<2>(lds3, p, (u & 7) >> 2, u & 3, 31 - (u >> 3), WSP(bf16_t, O_O), WSP(bf16_t, O_OWIN), nullptr);
}
}
namespace mk {
#define RLX_AGENT __ATOMIC_RELAXED, __HIP_MEMORY_SCOPE_AGENT
#define XB_TMO      128
#define XB_XCNT(j)  (256  + 64 * (j))
#define XB_XSUB(j)  (1280 + 64 * (j))
#define XB_XGEN(j)  (2304 + 64 * (j))
#define XB_TOP      3328
#define XB_TOPGEN   3392
#define XCD_BAR_WORDS 3456
#define XB_SPIN_CAP (1u << 18)

__device__ __forceinline__ unsigned xb_ld(unsigned* p)              { return __hip_atomic_load(p, __ATOMIC_RELAXED, __HIP_MEMORY_SCOPE_AGENT); }
__device__ __forceinline__ unsigned xb_add(unsigned* p, unsigned v) { return __hip_atomic_fetch_add(p, v, __ATOMIC_RELAXED, __HIP_MEMORY_SCOPE_AGENT); }
__device__ __forceinline__ unsigned xb_xcc_id() { return (unsigned)__builtin_amdgcn_s_getreg((3 << 11) | 20) & 0xFu; }
#define XB_SPIN(cond, bar) do { unsigned _sp = 0; while (cond) { __builtin_amdgcn_s_sleep(1); \
    if ((++_sp & 255u) == 0u) { if (xb_ld(&(bar)[XB_TMO])) break; if (_sp > XB_SPIN_CAP) { atomicAdd(&(bar)[XB_TMO], 1u); break; } } } } while (0)

struct XcdBarrier {
    unsigned* bar; unsigned x;
    volatile LAS unsigned* st;
};

__device__ __forceinline__ XcdBarrier xcd_barrier_post(unsigned* bar, volatile LAS unsigned* st) {
    XcdBarrier b; b.bar = bar; b.x = xb_xcc_id(); b.st = st;
    if (threadIdx.x == 0) (void)xb_add(&bar[XB_XCNT(b.x)], 1u);
    return b;
}
__device__ __forceinline__ void xcd_barrier_complete(unsigned* bar, unsigned x, unsigned& nloc, unsigned& nx) {
    const unsigned G = gridDim.x * gridDim.y * gridDim.z;
    unsigned sum, cnt, mine, sp = 0u;
    for (;;) {
        sum = 0u; cnt = 0u; mine = 0u;
#pragma unroll
        for (unsigned j = 0; j < 16; ++j) { const unsigned c = xb_ld(&bar[XB_XCNT(j)]); sum += c; cnt += (c > 0u) ? 1u : 0u; mine = (j == x) ? c : mine; }
        if (sum == G) break;
        __builtin_amdgcn_s_sleep(1);
        if ((++sp & 255u) == 0u) { if (xb_ld(&bar[XB_TMO])) break; if (sp > XB_SPIN_CAP) { atomicAdd(&bar[XB_TMO], 1u); break; } }
    }
    nloc = mine > 0u ? mine : 1u; nx = cnt > 0u ? cnt : 1u;
}

__device__ __forceinline__ void xcd_barrier(const XcdBarrier& b) {
    asm volatile("s_waitcnt vmcnt(0)" ::: "memory");
    __syncthreads();
    if (threadIdx.x == 0) {
        unsigned* bar = b.bar;
        __builtin_amdgcn_s_waitcnt(0);
        unsigned nloc = b.st[0], nx = b.st[1];
        if (nloc == 0u) { xcd_barrier_complete(bar, b.x, nloc, nx); b.st[0] = nloc; b.st[1] = nx; }
        const unsigned old = xb_add(&bar[XB_XSUB(b.x)], 1u);
        const unsigned gen = old / nloc;
        if (old + 1u == (gen + 1u) * nloc) {
            __builtin_amdgcn_fence(__ATOMIC_RELEASE, "agent");
            asm volatile("s_waitcnt vmcnt(0)" ::: "memory");
            const unsigned og = xb_add(&bar[XB_TOP], 1u);
            const unsigned tg = og / nx;
            if (og + 1u == (tg + 1u) * nx) xb_add(&bar[XB_TOPGEN], 1u);
            else XB_SPIN(xb_ld(&bar[XB_TOPGEN]) == tg, bar);
            __builtin_amdgcn_fence(__ATOMIC_ACQUIRE, "agent");
            xb_add(&bar[XB_XGEN(b.x)], 1u);
            asm volatile("s_waitcnt vmcnt(0)" ::: "memory");
        } else {
            XB_SPIN(xb_ld(&bar[XB_XGEN(b.x)]) == gen, bar);
            __builtin_amdgcn_fence(__ATOMIC_ACQUIRE, "agent");
            asm volatile("s_waitcnt vmcnt(0)" ::: "memory");
        }
    }
    __syncthreads();
}

}
namespace cg = cooperative_groups;
constexpr int NSTEP = 12;
__global__ void __launch_bounds__(512, 2) mega(mk::P p_unused) {
    extern __shared__ __attribute__((aligned(16))) unsigned char lds_raw[];
    float* lds = (float*)lds_raw;
    LAS unsigned char* lds3 = (LAS unsigned char*)lds_raw;
    using namespace nv; using namespace mk;
    volatile LAS unsigned* bst = (volatile LAS unsigned*)(lds3 + E3_BYTES + 128);
    if (threadIdx.x < 2) bst[threadIdx.x] = 0u;
    __syncthreads();
    XcdBarrier bar;
    { const KP p = fresh_kp(); bar = xcd_barrier_post(WSP(unsigned, O_COUNTS + 16384), bst); }
    cg::this_grid().sync();
    for (int step = 0; step < 1 + NSTEP * L_; ++step) {
        const KP p = fresh_kp();
        const int l = (step - 1) / NSTEP, k = (step == 0) ? -1 : (step - 1) % NSTEP;
        const bool isg = (k == 0 || k == 1 || k == 6 || k == 9 || k == 10);
#ifdef PROBE_K
        const int nrep = (k == PROBE_K) ? PROBE_N : 1;
#else
        const int nrep = 1;
#endif
        for (int rep = 0; rep < nrep; ++rep) {
        if (isg) {
            const int kind = (k == 0) ? 0 : (k == 1) ? 4 : (k == 6) ? 1 : (k == 9) ? 2 : 3;
            GSched S; GEpi E; S.kind = kind; E.kind = kind; E.l = l;
            S.G = (int)gridDim.x; S.c = fbid(); S.meta = WSP(int, O_META); S.rowtok = WSP(int, O_ROWTOK); S.estep = 0;
            const char* A; int N, K = D_;
            if (kind == 0) { A = (const char*)WSP(bf16_t, O_XB); S.Bt = (const char*)(WSP(bf16_t, O_WTIN) + (size_t)l * NPAD * D_); N = NPAD; }
            else if (kind == 1) { A = (const char*)WSP(bf16_t, O_OB); S.Bt = (const char*)(WSP(bf16_t, O_WTOUT) + (size_t)l * D_ * D_); N = D_; }
            else if (kind == 2) { A = (const char*)WSP(bf16_t, O_X1B); S.Bt = (const char*)(WSP(bf16_t, O_WTGU) + (size_t)l * NE * 2048 * D_); S.estep = (size_t)2048 * D_ * 2; N = 2048; }
            else if (kind == 3) { A = (const char*)WSP(bf16_t, O_ACT); S.Bt = (const char*)(WSP(bf16_t, O_WTDN) + (size_t)l * NE * D_ * D_); S.estep = (size_t)D_ * D_ * 2; N = D_; }
            else { A = (const char*)WSP(bf16_t, O_PROJB); S.Bt = (const char*)(WSP(bf16_t, O_WT1) + (size_t)l * 2 * 256 * 2048); S.estep = (size_t)256 * 2048 * 2; N = 256; K = 2048; }
            S.nN = N / 256; S.nM = (kind < 2) ? T_ / 256 : (kind == 4) ? 16 : S.meta[32]; S.nunits = S.nM * S.nN;
            pg8::gemm_phase<GEpi, GSched>(lds3, A, K, S, E);
            if (kind == 4) { ph_cumsum(lds, p, 16); ph_sb_early(lds3, p); }
            if (kind == 0) ph_bias1_reduce(p, l);
        } else {
            switch (k) {
                case -1: ph_convert(lds3, p); break;
                case 2: ph_prep2(p, l); break;
#ifdef PROBE_AMODE
                case 3: if (rep == 0) ph_attn1<30>(lds, lds3, p, WSP(unsigned, O_COUNTS) + 128 + l * 8 + rep, WSP(bf16_t, O_O), WSP(bf16_t, O_OWIN), WSP(unsigned, O_COUNTS) + 192 + l * 8);
                        else ph_attn1<PROBE_AMODE>(lds, lds3, p, WSP(unsigned, O_COUNTS) + 128 + l * 8 + rep, WSP(bf16_t, O_O), WSP(bf16_t, O_OWIN), WSP(unsigned, O_COUNTS) + 192 + l * 8);
                        break;
#else
                case 3: ph_attn1<30>(lds, lds3, p, WSP(unsigned, O_COUNTS) + 128 + l * 8 + rep, WSP(bf16_t, O_O), WSP(bf16_t, O_OWIN), WSP(unsigned, O_COUNTS) + 192 + l * 8); break;
#endif
                case 4: ph_attn_sel2<true>(lds3, p, WSP(bf16_t, O_O), WSP(bf16_t, O_OCMP), 512); break;
                case 5: ph_rmsnorm(p, l); break;
                case 7: ph_ln<true>(lds, p, l, WSP(float, O_X1), (rep + 1 < nrep) ? 2048 * (rep + 1) : 0); break;
                case 8: ph_moe_scatter2(lds, p, l); break;
                default: { float* xout = (l == L_ - 1) ? p->out : WSP(float, O_XA); ph_ln<false>(lds, p, l, xout); } break;
            }
        }
        xcd_barrier(bar);
        }
    }
#ifdef PROBE_SYNC
    for (int i = 0; i < PROBE_SYNC; ++i) xcd_barrier(bar);
#endif
}

extern "C" void kernel_launch(void* const* d_in, const int* in_sizes, int n_in,
                              void* d_out, int out_size, void* d_ws, size_t ws_size,
                              hipStream_t stream) {
    constexpr size_t kDynLds = 147456 + 1024;
    static int grid_blocks = 0;
    if (!grid_blocks) {
        int dev = 0, cus = 0, per_cu = 0;
        (void)hipGetDevice(&dev);
        (void)hipDeviceGetAttribute(&cus, hipDeviceAttributeMultiprocessorCount, dev);
        (void)hipFuncSetAttribute((const void*)mega, hipFuncAttributeMaxDynamicSharedMemorySize, (int)kDynLds);
        (void)hipOccupancyMaxActiveBlocksPerMultiprocessor(&per_cu, mega, 512, kDynLds);
        if (per_cu < 1) per_cu = 1;
        if (per_cu > 1) per_cu = 1;
        grid_blocks = cus * per_cu;
        if (ws_size < mk::O_END) fprintf(stderr, "workspace too small: %zu < %zu\n", ws_size, (size_t)mk::O_END);
    }
    mk::P p{};
    p.in = nv::inputs(d_in); p.ws = (unsigned char*)d_ws; p.out = (float*)d_out;
    (void)hipMemsetAsync((char*)d_ws + mk::O_COUNTS, 0, 65536, stream);
    void* args[] = {&p};
    hipError_t e = hipLaunchCooperativeKernel((void*)mega, dim3(grid_blocks), dim3(512), args, kDynLds, stream);
    if (e != hipSuccess) fprintf(stderr, "cooperative launch failed: %s (grid %d)\n", hipGetErrorString(e), grid_blocks);
}
```

```cpp
#include <hip/hip_runtime.h>
#include <hip/hip_cooperative_groups.h>
#include <cstdio>
#include <cstdint>

namespace nv {

constexpr int B_ = 2, S_ = 8192, D_ = 1024, T_ = B_ * S_, L_ = 2;
constexpr int DIN = 2844;
constexpr int OFF_NSA_KV = 512, OFF_NSA_GATE = 1280, OFF_FOX_QKV = 1304, OFF_FOX_F = 2072, OFF_SB_QKV = 2076;
constexpr int NCMP = 511, NBLK = 128, NSEL = 16;
constexpr int NE = 32, TOPK = 4, MROWS = T_ * TOPK;
constexpr float LN_EPS = 1e-5f, RMS_EPS = 1e-6f;
constexpr float ALPHA = 1.4142135623730951f;
constexpr float SCALE = 0.125f;

__device__ __forceinline__ float sigmoidf_(float x) { return 1.f / (1.f + __expf(-x)); }
__device__ __forceinline__ float logsig(float x) { return fminf(x, 0.f) - log1pf(expf(-fabsf(x))); }

__device__ __forceinline__ float gelu_tanh(float x) { return 0.5f * x * (1.f + tanhf(0.7978845608028654f * (x + 0.044715f * x * x * x))); }
__device__ __forceinline__ float wsum(float v) {
#pragma unroll
    for (int o = 1; o < 64; o <<= 1) v += __shfl_xor(v, o);
    return v;
}
struct In {
    const float *x, *w_in, *b_in, *pos_k, *pos_v, *w1k, *w2k, *w1v, *w2v, *g_out, *w_out, *ln1_g, *ln1_b, *rw, *rb, *wgu, *bgu, *wdn, *bdn, *ln2_g, *ln2_b;
};
inline In inputs(void* const* d) {
    In i; i.x = (const float*)d[0]; i.w_in = (const float*)d[1]; i.b_in = (const float*)d[2]; i.pos_k = (const float*)d[3]; i.pos_v = (const float*)d[4];
    i.w1k = (const float*)d[5]; i.w2k = (const float*)d[6]; i.w1v = (const float*)d[7]; i.w2v = (const float*)d[8]; i.g_out = (const float*)d[9]; i.w_out = (const float*)d[10];
    i.ln1_g = (const float*)d[11]; i.ln1_b = (const float*)d[12]; i.rw = (const float*)d[13]; i.rb = (const float*)d[14]; i.wgu = (const float*)d[15]; i.bgu = (const float*)d[16];
    i.wdn = (const float*)d[17]; i.bdn = (const float*)d[18]; i.ln2_g = (const float*)d[19]; i.ln2_b = (const float*)d[20]; return i;
}


}
namespace pg8 {
#define PG8_LAS __attribute__((address_space(3)))
typedef unsigned short bf16_t;
typedef short bf16x8 __attribute__((ext_vector_type(8)));
typedef float f32x4 __attribute__((ext_vector_type(4)));
typedef unsigned u32x4 __attribute__((ext_vector_type(4)));
constexpr int BM = 256, BK = 64, HALF = 128, HTB = HALF * BK * 2  , STAGE_BYTES = 8 * HTB, NXCD = 8, WGM = 8;

__host__ __device__ __forceinline__ int lds_byte(int r, int c) { const int st = (r >> 4) * 2 + (c >> 5), rr = r & 15, cc = c & 31, ob = rr * 64 + cc * 2; return st * 1024 + (ob ^ (((ob >> 9) & 1) << 5)); }
__host__ __device__ __forceinline__ void stage_rc(int b, int& R, int& C) { const int st = b / 1024, sb = b % 1024, swz = sb ^ (((sb >> 9) & 1) << 5); R = (st >> 1) * 16 + swz / 64; C = (st & 1) * 32 + (swz % 64) / 2; }
__host__ __device__ __forceinline__ int perm32(int rho) { const int n = rho >> 4, i = rho & 15; return 8 * (i >> 2) + 4 * n + (i & 3); }

struct Unit { int pm, pn, e, nr; };

__device__ __forceinline__ unsigned cvt_pk_bf16(float lo, float hi) { unsigned r; asm volatile("v_cvt_pk_bf16_f32 %0, %1, %2" : "=v"(r) : "v"(lo), "v"(hi)); return r; }
template <class Epi, class Sched, bool ALIGN_EPI = true, bool SP2 = true>
__device__ __forceinline__ void gemm_phase(PG8_LAS unsigned char* lds, const char* Abase, const int K, const Sched& S, const Epi& E) {
    int tid_ = threadIdx.x; asm volatile("" : "+v"(tid_));
    const int tid = tid_, wid = __builtin_amdgcn_readfirstlane(tid >> 6), lane = tid & 63, wr = wid >> 2, wc = wid & 3, fr = lane & 15, fq = lane >> 4;
    const int nt = K / BK;
    unsigned voffB[2];
#pragma unroll
    for (int i = 0; i < 2; ++i) { int R, C; stage_rc(tid * 16 + i * 8192, R, C); const int Rb = Epi::PERM ? ((R & ~31) + perm32(R & 31)) : R;
        voffB[i] = (unsigned)(Rb * K + C) * 2u; }
#define PG8_AOFF(u, o0, o1) do { int _t = tid; asm volatile("" : "+v"(_t)); _Pragma("unroll") for (int _i = 0; _i < 2; ++_i) { int _R, _C; stage_rc(_t * 16 + _i * 8192, _R, _C); \
        (o0)[_i] = S.a_off((u), _R) + (unsigned)_C * 2u; (o1)[_i] = S.a_off((u), HALF + _R) + (unsigned)_C * 2u; } } while (0)
    const size_t kstep = (size_t)(BK * 2);
    const size_t akstep = S.a_kstep();
    const size_t hstep = (size_t)HALF * K * 2;
    const unsigned ldsw = (unsigned)wid * 1024u;
    const int aoff = lds_byte(wr * 64 + fr, fq * 8), boff = lds_byte(wc * 32 + fr, fq * 8);
#define PG8_SA(b, h) (((b) * 2 + (h)) * HTB)
#define PG8_SB(b, h) ((4 + (b) * 2 + (h)) * HTB)
#define PG8_STAGE(bufoff, gbase, voff) do { _Pragma("unroll") for (int _i = 0; _i < 2; ++_i) { unsigned _o = (voff)[_i]; asm volatile("" : "+v"(_o));     \
        __builtin_amdgcn_global_load_lds((const unsigned*)((const char*)(gbase) + _o), (PG8_LAS unsigned*)(lds + (bufoff) + ldsw + _i * 8192), 16, 0, 0); } } while (0)
#define PG8_LDA(dst, b, h) do { _Pragma("unroll") for (int m = 0; m < 4; ++m) _Pragma("unroll") for (int k = 0; k < 2; ++k) dst[m][k] = *(const PG8_LAS bf16x8*)(lds + PG8_SA(b, h) + aoff + m * 2048 + k * 1024); } while (0)
#define PG8_LDB(dst, b, h) do { _Pragma("unroll") for (int n = 0; n < 2; ++n) _Pragma("unroll") for (int k = 0; k < 2; ++k) dst[n][k] = *(const PG8_LAS bf16x8*)(lds + PG8_SB(b, h) + boff + n * 2048 + k * 1024); } while (0)
#define PG8_MMA(ai, bj, At, Bt) do { __builtin_amdgcn_s_setprio(1); _Pragma("unroll") for (int m = 0; m < 4; ++m) _Pragma("unroll") for (int n = 0; n < 2; ++n) _Pragma("unroll") for (int k = 0; k < 2; ++k) \
        acc[ai][bj][m][n] = __builtin_amdgcn_mfma_f32_16x16x32_bf16(Bt[n][k], At[m][k], acc[ai][bj][m][n], 0, 0, 0); __builtin_amdgcn_s_setprio(0); } while (0)
#define PG8_WAIT_V(n) asm volatile("s_waitcnt vmcnt(" #n ")" ::: "memory")
#define PG8_WAIT_L(n) asm volatile("s_waitcnt lgkmcnt(" #n ")" ::: "memory")
#define PG8_BAR __builtin_amdgcn_s_barrier()
#define PG8_SCHED __builtin_amdgcn_sched_barrier(0)
    Unit cur, nxt; int ui = 0;
    if (!S.next(0, cur)) return;
    f32x4 acc[2][2][4][2];
    float zf_ = 0.f; asm volatile("" : "+v"(zf_));
#pragma unroll
    for (int a = 0; a < 2; ++a)
#pragma unroll
        for (int b = 0; b < 2; ++b)
#pragma unroll
            for (int m = 0; m < 4; ++m)
#pragma unroll
                for (int n = 0; n < 2; ++n) acc[a][b][m][n] = (f32x4){zf_, zf_, zf_, zf_};
    bf16x8 At[4][2], B0[2][2], B1[2][2];
    unsigned ca0[2], ca1[2], na0[2], na1[2];
    PG8_AOFF(cur, ca0, ca1);
    const char* const cA = Abase; const char* cB = S.b_base(cur);
    if constexpr (SP2) {
        PG8_STAGE(PG8_SB(0, 0), cB, voffB); PG8_STAGE(PG8_SB(0, 1), cB + hstep, voffB); PG8_STAGE(PG8_SA(0, 0), cA, ca0); PG8_STAGE(PG8_SA(0, 1), cA, ca1);
        if (wr == 1) PG8_BAR;
        PG8_WAIT_V(2); PG8_BAR;
        PG8_STAGE(PG8_SB(1, 0), cB + kstep, voffB); PG8_STAGE(PG8_SA(1, 0), cA + akstep, ca0); PG8_STAGE(PG8_SB(1, 1), cB + hstep + kstep, voffB);
        PG8_WAIT_V(6); PG8_BAR;
    } else { static_assert(SP2, "only the SP2 loop is kept"); }
    for (;;) {
        const bool has_next = S.next(ui + 1, nxt);
        const char* nB = has_next ? S.b_base(nxt) : cB;
        if (has_next) { PG8_AOFF(nxt, na0, na1); } else { na0[0] = ca0[0]; na0[1] = ca0[1]; na1[0] = ca1[0]; na1[1] = ca1[1]; }
        for (int t = 0; t < nt - 2; t += 2) {
            const char* a1 = cA + (size_t)(t + 1) * akstep;
            const char* a2 = cA + (size_t)(t + 2) * akstep; const char* b2 = cB + (size_t)(t + 2) * kstep;
            const char* a3 = a2 + akstep; const char* b3 = b2 + kstep;
            PG8_LDB(B0, 0, 0); PG8_LDB(B1, 0, 1); PG8_SCHED; PG8_LDA(At, 0, 0); PG8_STAGE(PG8_SA(1, 1), a1, ca1);
            PG8_WAIT_V(8); PG8_WAIT_L(0); PG8_BAR; PG8_MMA(0, 0, At, B0); PG8_MMA(0, 1, At, B1); PG8_BAR; PG8_SCHED;
            PG8_LDA(At, 0, 1); PG8_STAGE(PG8_SB(0, 0), b2, voffB); PG8_STAGE(PG8_SB(0, 1), b2 + hstep, voffB); PG8_STAGE(PG8_SA(0, 0), a2, ca0);
            PG8_WAIT_V(8); PG8_WAIT_L(0); PG8_BAR; PG8_MMA(1, 0, At, B0); PG8_MMA(1, 1, At, B1); PG8_BAR; PG8_SCHED;
            PG8_LDB(B0, 1, 0); PG8_LDB(B1, 1, 1); PG8_SCHED; PG8_LDA(At, 1, 0); PG8_STAGE(PG8_SA(0, 1), a2, ca1);
            PG8_WAIT_V(8); PG8_WAIT_L(0); PG8_BAR; PG8_MMA(0, 0, At, B0); PG8_MMA(0, 1, At, B1); PG8_BAR; PG8_SCHED;
            PG8_LDA(At, 1, 1); PG8_STAGE(PG8_SB(1, 0), b3, voffB); PG8_STAGE(PG8_SB(1, 1), b3 + hstep, voffB); PG8_STAGE(PG8_SA(1, 0), a3, ca0);
            PG8_WAIT_V(8); PG8_WAIT_L(0); PG8_BAR; PG8_MMA(1, 0, At, B0); PG8_MMA(1, 1, At, B1); PG8_BAR; PG8_SCHED;
        }
        {
            const char* a1 = cA + (size_t)(nt - 1) * akstep;
            const char* a2 = cA; const char* b2 = nB; const char* a3 = a2 + akstep; const char* b3 = b2 + kstep;
            PG8_LDB(B0, 0, 0); PG8_LDB(B1, 0, 1); PG8_SCHED; PG8_LDA(At, 0, 0); PG8_STAGE(PG8_SA(1, 1), a1, ca1);
            PG8_WAIT_V(8); PG8_WAIT_L(0); PG8_BAR; PG8_MMA(0, 0, At, B0); PG8_MMA(0, 1, At, B1); PG8_BAR; PG8_SCHED;
            PG8_LDA(At, 0, 1); PG8_STAGE(PG8_SB(0, 0), b2, voffB); PG8_STAGE(PG8_SB(0, 1), b2 + hstep, voffB); PG8_STAGE(PG8_SA(0, 0), a2, na0);
            PG8_WAIT_V(8); PG8_WAIT_L(0); PG8_BAR; PG8_MMA(1, 0, At, B0); PG8_MMA(1, 1, At, B1); PG8_BAR; PG8_SCHED;
            PG8_LDB(B0, 1, 0); PG8_LDB(B1, 1, 1); PG8_SCHED; PG8_LDA(At, 1, 0); PG8_STAGE(PG8_SA(0, 1), a2, na1);
            PG8_WAIT_V(8); PG8_WAIT_L(0); PG8_BAR; PG8_MMA(0, 0, At, B0); PG8_MMA(0, 1, At, B1); PG8_BAR; PG8_SCHED;
            PG8_LDA(At, 1, 1); PG8_STAGE(PG8_SB(1, 0), b3, voffB); PG8_STAGE(PG8_SB(1, 1), b3 + hstep, voffB); PG8_STAGE(PG8_SA(1, 0), a3, na0);
            PG8_WAIT_V(8); PG8_WAIT_L(0); PG8_BAR; PG8_MMA(1, 0, At, B0); PG8_MMA(1, 1, At, B1); PG8_BAR; PG8_SCHED;
        }
        if constexpr (ALIGN_EPI) { if (wr == 0) PG8_BAR; }
        E(acc, cur, wr, wc, fr, fq);
        if (!has_next) break;
#pragma unroll
        for (int a = 0; a < 2; ++a)
#pragma unroll
            for (int b = 0; b < 2; ++b)
#pragma unroll
                for (int m = 0; m < 4; ++m)
#pragma unroll
                    for (int n = 0; n < 2; ++n) acc[a][b][m][n] = (f32x4){zf_, zf_, zf_, zf_};
        cur = nxt; cB = nB; ++ui; ca0[0] = na0[0]; ca0[1] = na0[1]; ca1[0] = na1[0]; ca1[1] = na1[1];
        if constexpr (ALIGN_EPI) { if (wr == 1) PG8_BAR; }
    }
    PG8_WAIT_V(0);
    if constexpr (!ALIGN_EPI) { if (wr == 0) PG8_BAR; }
    PG8_BAR;
#undef PG8_AOFF
#undef PG8_SA
#undef PG8_SB
#undef PG8_STAGE
#undef PG8_LDA
#undef PG8_LDB
#undef PG8_MMA
#undef PG8_WAIT_V
#undef PG8_WAIT_L
#undef PG8_BAR
#undef PG8_SCHED
}

}
namespace mk {
using namespace nv;
typedef unsigned short bf16_t;
typedef unsigned u32x4 __attribute__((ext_vector_type(4)));
typedef float f32x4 __attribute__((ext_vector_type(4)));
#define LAS __attribute__((address_space(3)))
constexpr int NT = 512;
constexpr int PB = 2816;
constexpr int NPAD = 3072;
constexpr int C_KV = 512, C_FOX = 1280, C_SB = 2048, C_GATE = 2816;
constexpr int MAXT = MROWS / 256 + NE;
constexpr int PROWS = MAXT * 256;
#define CNT_IDX(l, e) (8192 + ((l) * NE + (e)) * 32)
__device__ __forceinline__ int ftid() { int t = threadIdx.x; asm volatile("" : "+v"(t)); return t; }
__device__ __forceinline__ int fbid() { int b = blockIdx.x; asm volatile("" : "+s"(b)); return b; }
#define MK_LOOP(vb, n) for (int vb = fbid(); vb < (n); vb += gridDim.x)

constexpr size_t al_(size_t x) { return (x + 4095) & ~(size_t)4095; }
constexpr size_t O_WTIN = 0;
constexpr size_t O_WTOUT = O_WTIN + al_((size_t)L_ * NPAD * D_ * 2);
constexpr size_t O_WTGU = O_WTOUT + al_((size_t)L_ * D_ * D_ * 2);
constexpr size_t O_WTDN = O_WTGU + al_((size_t)L_ * NE * 2048 * D_ * 2);
constexpr size_t O_BIASP = O_WTDN + al_((size_t)L_ * NE * D_ * D_ * 2);
constexpr size_t O_XB = O_BIASP + al_((size_t)L_ * NPAD * 4);
constexpr size_t O_PROJB = O_XB + al_((size_t)T_ * D_ * 2);
constexpr size_t O_GF = O_PROJB + al_((size_t)T_ * PB * 2);
constexpr size_t O_CFOX = O_GF + al_((size_t)T_ * 32 * 4);
constexpr size_t O_KCMP = O_CFOX + al_((size_t)B_ * 4 * S_ * 4);
constexpr size_t O_VCMP = O_KCMP + al_((size_t)B_ * 2 * 512 * 64 * 4);
constexpr size_t O_O = O_VCMP + al_((size_t)B_ * 2 * 512 * 64 * 4);
constexpr size_t O_OB = O_O + al_((size_t)T_ * D_ * 4);
constexpr size_t O_PTOT = O_OB + al_((size_t)T_ * D_ * 2);
constexpr size_t O_SEL = O_PTOT + al_((size_t)B_ * 2 * S_ * 512 * 4);
constexpr size_t O_MIX = O_SEL + al_((size_t)B_ * 2 * S_ * NSEL * 4);
constexpr size_t O_X1 = O_MIX + al_((size_t)T_ * D_ * 4);
constexpr size_t O_X1B = O_X1 + al_((size_t)T_ * D_ * 4);
constexpr size_t O_XA = O_X1B + al_((size_t)T_ * D_ * 2);
constexpr size_t O_ACT = O_XA + al_((size_t)T_ * D_ * 4);
constexpr size_t O_Y = O_ACT + al_((size_t)PROWS * D_ * 2);
constexpr size_t O_TOPE = O_Y + al_((size_t)PROWS * D_ * 2);
constexpr size_t O_TOPW = O_TOPE + al_((size_t)MROWS * 4);
constexpr size_t O_POS = O_TOPW + al_((size_t)MROWS * 4);
constexpr size_t O_ROWTOK = O_POS + al_((size_t)MROWS * 4);
constexpr size_t O_ROWW = O_ROWTOK + al_((size_t)PROWS * 4);
constexpr size_t O_SLOT = O_ROWW + al_((size_t)PROWS * 4);
constexpr size_t O_COUNTS = O_SLOT + al_((size_t)MROWS * 4);
constexpr size_t O_META = O_COUNTS + 65536;
constexpr size_t O_OWIN = O_META + 4096;
constexpr size_t O_O2 = O_OWIN + al_((size_t)T_ * 512 * 4);
constexpr size_t O_OWIN2 = O_O2 + al_((size_t)T_ * D_ * 4);
constexpr size_t O_KCMPB = O_OWIN2 + al_((size_t)T_ * 512 * 4);
constexpr size_t O_VCMPB = O_KCMPB + al_((size_t)B_ * 2 * 512 * 64 * 2);
constexpr size_t O_OCMP = O_VCMPB + al_((size_t)B_ * 2 * 512 * 64 * 2);
constexpr size_t O_SELMASK = O_OCMP + al_((size_t)T_ * 512 * 4);
constexpr size_t O_WT1 = O_SELMASK + al_((size_t)B_ * 2 * S_ * 16);
constexpr size_t O_BIAS1 = O_WT1 + al_((size_t)L_ * 2 * 256 * 2048 * 2);
constexpr size_t O_HID = O_BIAS1 + al_((size_t)L_ * 2 * 128 * 4);
constexpr size_t O_BIAS1P = O_HID + al_((size_t)8 * 512 * 128 * 2);
constexpr size_t O_END = O_BIAS1P + al_((size_t)L_ * 2 * 64 * 128 * 4);

struct P {
    In in; unsigned char* ws; float* out;
};
typedef const __attribute__((address_space(4))) P* KP;
__device__ __forceinline__ KP fresh_kp() { KP k = (KP)__builtin_amdgcn_kernarg_segment_ptr(); asm volatile("" : "+s"(k)); return k; }
#define WSP(T, off) ((T*)(p->ws + (off)))

__device__ __forceinline__ float bf2f(unsigned short b) { return __uint_as_float((unsigned)b << 16); }
__device__ __forceinline__ unsigned f2bf(float f) { unsigned u = __float_as_uint(f); return (u + 0x7fffu + ((u >> 16) & 1u)) >> 16; }
__device__ __forceinline__ unsigned pk2(float lo, float hi) { return f2bf(lo) | (f2bf(hi) << 16); }
__device__ __forceinline__ void ld8(const bf16_t* __restrict__ src, float* dst) {
    const u32x4 v = *(const u32x4*)src;
    dst[0] = __uint_as_float(v.x << 16); dst[1] = __uint_as_float(v.x & 0xffff0000u); dst[2] = __uint_as_float(v.y << 16); dst[3] = __uint_as_float(v.y & 0xffff0000u);
    dst[4] = __uint_as_float(v.z << 16); dst[5] = __uint_as_float(v.z & 0xffff0000u); dst[6] = __uint_as_float(v.w << 16); dst[7] = __uint_as_float(v.w & 0xffff0000u);
}


__device__ __forceinline__ int perm_in(int n) {
    if (n < 1280) return n;
    if (n < 1304) return C_GATE + (n - 1280);
    if (n < 2072) return C_FOX + (n - 1304);
    if (n < 2076) return C_GATE + 24 + (n - 2072);
    return C_SB + (n - 2076);
}
__device__ __forceinline__ int perm_gu(int n) { const int up = n >> 10, c = n & 1023; return 256 * (c >> 7) + 128 * up + (c & 127); }
template <int MAP>
__device__ __forceinline__ void transpose_item(const float* __restrict__ W, int K, int N, bf16_t* __restrict__ WT, LAS float* scr, int item, int lane) {
    const int nblk = (N + 31) / 32, kb = item / nblk, nb = item % nblk, k0 = 64 * kb, n0 = 32 * nb;
    { const int n4 = (lane & 7) * 4; const bool okn = (n0 + n4) < N;
      f32x4 t[8];
#pragma unroll
      for (int i = 0; i < 8; ++i) { const int kk = (lane >> 3) + 8 * i; t[i] = okn ? *(const f32x4*)(W + (size_t)(k0 + kk) * N + n0 + n4) : (f32x4){0.f, 0.f, 0.f, 0.f}; }
#pragma unroll
      for (int i = 0; i < 8; ++i) { const int kk = (lane >> 3) + 8 * i; LAS float* d = scr + kk * 33 + n4; d[0] = t[i].x; d[1] = t[i].y; d[2] = t[i].z; d[3] = t[i].w; } }
    asm volatile("s_waitcnt lgkmcnt(0)" ::: "memory");
    const int c = lane & 7;
#pragma unroll
    for (int j = 0; j < 4; ++j) { const int n = (lane >> 3) + 8 * j; const LAS float* sp = scr + (8 * c) * 33 + n;
        u32x4 o; o.x = pk2(sp[0 * 33], sp[1 * 33]); o.y = pk2(sp[2 * 33], sp[3 * 33]); o.z = pk2(sp[4 * 33], sp[5 * 33]); o.w = pk2(sp[6 * 33], sp[7 * 33]);
        const int ng = n0 + n;
        if (ng < N) { const int ro = (MAP == 1) ? perm_in(ng) : (MAP == 2) ? perm_gu(ng) : ng; *(u32x4*)(WT + (size_t)ro * K + k0 + 8 * c) = o; } }
    asm volatile("s_waitcnt lgkmcnt(0)" ::: "memory");
}
constexpr int CV_I_IN = 16 * 89, CV_I_OUT = 16 * 32, CV_I_GU = 16 * 64, CV_I_DN = 16 * 32, CV_I_W1 = 32 * 4;
constexpr int CV_N_IN = L_ * CV_I_IN, CV_N_OUT = L_ * CV_I_OUT, CV_N_GU = L_ * NE * CV_I_GU, CV_N_DN = L_ * NE * CV_I_DN, CV_N_W1 = L_ * 2 * CV_I_W1, CV_N_ALL = CV_N_IN + CV_N_OUT + CV_N_GU + CV_N_DN + CV_N_W1;
constexpr int CV_DEF_GU0 = CV_N_W1 + NE * CV_I_GU, CV_DEF_GU = NE * CV_I_GU, CV_DEF_DN0 = CV_N_W1 + CV_N_GU + NE * CV_I_DN, CV_DEF_DN = NE * CV_I_DN, CV_DEF_ALL = CV_DEF_GU + CV_DEF_DN;
__device__ __forceinline__ void cv_one(KP p, LAS float* scr, int it, int lane) {
    int r = it;
    if (r < CV_N_W1) { const int mtx = r / CV_I_W1, ll = mtx >> 1, kv = mtx & 1; transpose_item<0>((kv ? p->in.w1v : p->in.w1k) + (size_t)ll * 2048 * 128, 2048, 128, WSP(bf16_t, O_WT1) + (size_t)mtx * 256 * 2048, scr, r % CV_I_W1, lane); return; } r -= CV_N_W1;
    if (r < CV_N_GU) { const int mtx = r / CV_I_GU; transpose_item<2>(p->in.wgu + (size_t)mtx * D_ * 2048, D_, 2048, WSP(bf16_t, O_WTGU) + (size_t)mtx * 2048 * D_, scr, r % CV_I_GU, lane); return; } r -= CV_N_GU;
    if (r < CV_N_DN) { const int mtx = r / CV_I_DN; transpose_item<0>(p->in.wdn + (size_t)mtx * D_ * D_, D_, D_, WSP(bf16_t, O_WTDN) + (size_t)mtx * D_ * D_, scr, r % CV_I_DN, lane); return; } r -= CV_N_DN;
    if (r < CV_N_IN) { const int mtx = r / CV_I_IN; transpose_item<1>(p->in.w_in + (size_t)mtx * D_ * DIN, D_, DIN, WSP(bf16_t, O_WTIN) + (size_t)mtx * NPAD * D_, scr, r % CV_I_IN, lane); return; } r -= CV_N_IN;
    { const int mtx = r / CV_I_OUT; transpose_item<0>(p->in.w_out + (size_t)mtx * D_ * D_, D_, D_, WSP(bf16_t, O_WTOUT) + (size_t)mtx * D_ * D_, scr, r % CV_I_OUT, lane); }
}
__device__ __forceinline__ void cv_help(LAS unsigned char* lds, KP p, int maxchunks) {
    const int tid = ftid(), lane = tid & 63, wv = tid >> 6; LAS float* scr = (LAS float*)(lds + wv * 8448);
    unsigned* cursor = WSP(unsigned, O_COUNTS) + 64;
    for (int c = 0; c < maxchunks; ++c) {
        unsigned base = 0u; if (lane == 0) base = atomicAdd(cursor, 8u);
        base = (unsigned)__builtin_amdgcn_readfirstlane((int)base);
        if (base >= (unsigned)CV_DEF_ALL) break;
        for (int i = 0; i < 8; ++i) { const int d = (int)base + i; if (d < CV_DEF_ALL) cv_one(p, scr, d < CV_DEF_GU ? CV_DEF_GU0 + d : CV_DEF_DN0 + (d - CV_DEF_GU), lane); }
    }
}
__device__ __forceinline__ void ph_convert(LAS unsigned char* lds, KP p) {
    const int tid = ftid(), lane = tid & 63, wv = tid >> 6;
    LAS float* scr = (LAS float*)(lds + wv * 8448);
    const int gw = fbid() * 8 + wv, NGW = gridDim.x * 8;
    for (int it = gw; it < CV_N_ALL; it += NGW) {
        if ((it >= CV_DEF_GU0 && it < CV_DEF_GU0 + CV_DEF_GU) || (it >= CV_DEF_DN0 && it < CV_DEF_DN0 + CV_DEF_DN)) continue;
        cv_one(p, scr, it, lane);
    }
    const int gt = fbid() * NT + tid, NG = gridDim.x * NT;
    for (int i = gt; i < L_ * (NPAD - DIN) * (D_ / 8); i += NG) { const int l = i / ((NPAD - DIN) * (D_ / 8)), r = i % ((NPAD - DIN) * (D_ / 8));
        unsigned z_ = 0u; asm volatile("" : "+v"(z_));
        *(u32x4*)(WSP(bf16_t, O_WTIN) + ((size_t)l * NPAD + DIN) * D_ + (size_t)r * 8) = (u32x4){z_, z_, z_, z_}; }
    for (int i = gt; i < L_ * 2 * 128 * (2048 / 8); i += NG) { const int mtx = i / (128 * 256), r = i % (128 * 256); unsigned z_ = 0u; asm volatile("" : "+v"(z_));
        *(u32x4*)(WSP(bf16_t, O_WT1) + ((size_t)mtx * 256 + 128) * 2048 + (size_t)r * 8) = (u32x4){z_, z_, z_, z_}; }
    for (int i = gt; i < L_ * 2 * 64 * 128; i += NG) { const int j = i & 127, seg = (i >> 7) & 63, mtx = i >> 13, ll = mtx >> 1, kv = mtx & 1;
        const float* pos = (kv ? p->in.pos_v : p->in.pos_k) + (size_t)ll * 2048 + seg * 32; const float* w1 = (kv ? p->in.w1v : p->in.w1k) + (size_t)ll * 2048 * 128 + (size_t)seg * 32 * 128; float a = 0.f;
#pragma unroll 8
        for (int k = 0; k < 32; ++k) a += pos[k] * w1[(size_t)k * 128 + j];
        WSP(float, O_BIAS1P)[i] = a; }
    for (int i = gt; i < L_ * NPAD; i += NG) { const int l = i / NPAD, c = i % NPAD; if (c >= DIN) WSP(float, O_BIASP)[i] = 0.f; }
    for (int i = gt; i < L_ * DIN; i += NG) { const int l = i / DIN, n = i % DIN; WSP(float, O_BIASP)[l * NPAD + perm_in(n)] = p->in.b_in[i]; }
    for (int i = gt; i < T_ * D_ / 8; i += NG) { const f32x4 a = *(const f32x4*)(p->in.x + (size_t)i * 8), b = *(const f32x4*)(p->in.x + (size_t)i * 8 + 4);
        *(u32x4*)(WSP(bf16_t, O_XB) + (size_t)i * 8) = (u32x4){pk2(a.x, a.y), pk2(a.z, a.w), pk2(b.x, b.y), pk2(b.z, b.w)}; }
}

struct EpiProj {
    static constexpr bool PERM = true;
    bf16_t* projb; float* gf; const float* bias;
    __device__ __forceinline__ void operator()(const pg8::f32x4 (&acc)[2][2][4][2], const pg8::Unit& u, int wr, int wc, int fr, int fq) const {
        const int row0 = u.pm * 256 + wr * 64 + fr, col0 = u.pn * 256 + wc * 32 + 8 * fq;
        if (u.pn < 11) {
#pragma unroll
            for (int ai = 0; ai < 2; ++ai)
#pragma unroll
                for (int m = 0; m < 4; ++m) { bf16_t* rowp = projb + (size_t)(row0 + ai * 128 + m * 16) * PB + col0;
#pragma unroll
                    for (int bj = 0; bj < 2; ++bj) { const f32x4 v0 = acc[ai][bj][m][0] + *(const f32x4*)(bias + col0 + bj * 128), v1 = acc[ai][bj][m][1] + *(const f32x4*)(bias + col0 + bj * 128 + 4);
                        u32x4 w; w.x = pg8::cvt_pk_bf16(v0[0], v0[1]); w.y = pg8::cvt_pk_bf16(v0[2], v0[3]); w.z = pg8::cvt_pk_bf16(v1[0], v1[1]); w.w = pg8::cvt_pk_bf16(v1[2], v1[3]);
                        *(u32x4*)(rowp + bj * 128) = w; }
                    asm volatile("" ::: "memory"); }
        } else if (wc == 0) {
            const f32x4 b0 = *(const f32x4*)(bias + col0), b1 = *(const f32x4*)(bias + col0 + 4);
#pragma unroll
            for (int ai = 0; ai < 2; ++ai)
#pragma unroll
                for (int m = 0; m < 4; ++m) { float* rowp = gf + (size_t)(row0 + ai * 128 + m * 16) * 32 + 8 * fq;
                    const f32x4 v0 = acc[ai][0][m][0] + b0, v1 = acc[ai][0][m][1] + b1; f32x4 o0, o1;
#pragma unroll
                    for (int i = 0; i < 4; ++i) { const int j0 = 8 * fq + i, j1 = j0 + 4;
                        o0[i] = (j0 < 24) ? sigmoidf_(v0[i]) : (j0 < 28 ? logsig(v0[i]) : 0.f); o1[i] = (j1 < 24) ? sigmoidf_(v1[i]) : (j1 < 28 ? logsig(v1[i]) : 0.f); }
                    *(f32x4*)rowp = o0; *(f32x4*)(rowp + 4) = o1; }
        }
    }
};
struct EpiOut {
    static constexpr bool PERM = true;
    const float* x; float* y1;
    __device__ __forceinline__ void operator()(const pg8::f32x4 (&acc)[2][2][4][2], const pg8::Unit& u, int wr, int wc, int fr, int fq) const {
        const int row0 = u.pm * 256 + wr * 64 + fr, col0 = u.pn * 256 + wc * 32 + 8 * fq;
#pragma unroll
        for (int ai = 0; ai < 2; ++ai)
#pragma unroll
            for (int m = 0; m < 4; ++m) { const size_t off = (size_t)(row0 + ai * 128 + m * 16) * D_ + col0;
#pragma unroll
                for (int bj = 0; bj < 2; ++bj) { const f32x4 x0 = *(const f32x4*)(x + off + bj * 128), x1 = *(const f32x4*)(x + off + bj * 128 + 4);
                    *(f32x4*)(y1 + off + bj * 128) = x0 * ALPHA + acc[ai][bj][m][0]; *(f32x4*)(y1 + off + bj * 128 + 4) = x1 * ALPHA + acc[ai][bj][m][1]; }
                asm volatile("" ::: "memory"); }
    }
};
struct EpiGU {
    static constexpr bool PERM = true;
    bf16_t* act; const float* bgu;
    __device__ __forceinline__ void operator()(const pg8::f32x4 (&acc)[2][2][4][2], const pg8::Unit& u, int wr, int wc, int fr, int fq) const {
        const int row0 = u.pm * 256 + wr * 64 + fr, col0 = u.pn * 128 + wc * 32 + 8 * fq;
        const float* bb = bgu + (size_t)u.e * 2048 + col0;
        const f32x4 bg0 = *(const f32x4*)bb, bg1 = *(const f32x4*)(bb + 4), bu0 = *(const f32x4*)(bb + 1024), bu1 = *(const f32x4*)(bb + 1028);
#pragma unroll
        for (int ai = 0; ai < 2; ++ai)
#pragma unroll
            for (int m = 0; m < 4; ++m) { f32x4 a0, a1;
                const f32x4 g0 = acc[ai][0][m][0] + bg0, g1 = acc[ai][0][m][1] + bg1, u0 = acc[ai][1][m][0] + bu0, u1 = acc[ai][1][m][1] + bu1;
#pragma unroll
                for (int i = 0; i < 4; ++i) { const float gt0 = fminf(g0[i], 7.0f), up0 = fminf(fmaxf(u0[i], -7.0f), 7.0f), gt1 = fminf(g1[i], 7.0f), up1 = fminf(fmaxf(u1[i], -7.0f), 7.0f);
                    a0[i] = gt0 * sigmoidf_(1.702f * gt0) * (up0 + 1.0f); a1[i] = gt1 * sigmoidf_(1.702f * gt1) * (up1 + 1.0f); }
                u32x4 w; w.x = pg8::cvt_pk_bf16(a0[0], a0[1]); w.y = pg8::cvt_pk_bf16(a0[2], a0[3]); w.z = pg8::cvt_pk_bf16(a1[0], a1[1]); w.w = pg8::cvt_pk_bf16(a1[2], a1[3]);
                *(u32x4*)(act + (size_t)(row0 + ai * 128 + m * 16) * D_ + col0) = w; asm volatile("" ::: "memory"); }
    }
};
struct EpiDN {
    static constexpr bool PERM = true;
    bf16_t* y; const float* bdn; const float* roww;
    __device__ __forceinline__ void operator()(const pg8::f32x4 (&acc)[2][2][4][2], const pg8::Unit& u, int wr, int wc, int fr, int fq) const {
        const int row0 = u.pm * 256 + wr * 64 + fr, col0 = u.pn * 256 + wc * 32 + 8 * fq;
        const float* bb = bdn + (size_t)u.e * D_ + col0;
#pragma unroll
        for (int ai = 0; ai < 2; ++ai)
#pragma unroll
            for (int m = 0; m < 4; ++m) { const int row = row0 + ai * 128 + m * 16; const float w = roww[row];
#pragma unroll
                for (int bj = 0; bj < 2; ++bj) { const f32x4 v0 = (acc[ai][bj][m][0] + *(const f32x4*)(bb + bj * 128)) * w, v1 = (acc[ai][bj][m][1] + *(const f32x4*)(bb + bj * 128 + 4)) * w;
                    u32x4 o; o.x = pg8::cvt_pk_bf16(v0[0], v0[1]); o.y = pg8::cvt_pk_bf16(v0[2], v0[3]); o.z = pg8::cvt_pk_bf16(v1[0], v1[1]); o.w = pg8::cvt_pk_bf16(v1[2], v1[3]);
                    *(u32x4*)(y + (size_t)row * D_ + col0 + bj * 128) = o; }
                asm volatile("" ::: "memory"); }
    }
};
struct EpiCmp {
    static constexpr bool PERM = true;
    bf16_t* hid; const float* bias1;
    __device__ __forceinline__ void operator()(const pg8::f32x4 (&acc)[2][2][4][2], const pg8::Unit& u, int wr, int wc, int fr, int fq) const {
        const int row0 = u.pm * 256 + wr * 64 + fr, col0 = wc * 32 + 8 * fq;
        const float* bb = bias1 + (u.e & 1) * 128 + col0; const f32x4 b0 = *(const f32x4*)bb, b1 = *(const f32x4*)(bb + 4);
#pragma unroll
        for (int ai = 0; ai < 2; ++ai)
#pragma unroll
            for (int m = 0; m < 4; ++m) { const f32x4 v0 = acc[ai][0][m][0] + b0, v1 = acc[ai][0][m][1] + b1;
                u32x4 w; w.x = pg8::cvt_pk_bf16(gelu_tanh(v0[0]), gelu_tanh(v0[1])); w.y = pg8::cvt_pk_bf16(gelu_tanh(v0[2]), gelu_tanh(v0[3])); w.z = pg8::cvt_pk_bf16(gelu_tanh(v1[0]), gelu_tanh(v1[1])); w.w = pg8::cvt_pk_bf16(gelu_tanh(v1[2]), gelu_tanh(v1[3]));
                *(u32x4*)(hid + ((size_t)u.e * 512 + row0 + ai * 128 + m * 16) * 128 + col0) = w; asm volatile("" ::: "memory"); }
    }
};
struct GEpi {
    static constexpr bool PERM = true;
    int kind, l;
    __device__ __forceinline__ void operator()(const pg8::f32x4 (&acc)[2][2][4][2], const pg8::Unit& u, int wr, int wc, int fr, int fq) const {
        const KP p = fresh_kp();
        if (kind == 0) { const EpiProj e{WSP(bf16_t, O_PROJB), WSP(float, O_GF), WSP(float, O_BIASP) + l * NPAD}; e(acc, u, wr, wc, fr, fq); }
        else if (kind == 1) { const EpiOut e{(l == 0) ? p->in.x : WSP(float, O_XA), WSP(float, O_MIX)}; e(acc, u, wr, wc, fr, fq); }
        else if (kind == 2) { const EpiGU e{WSP(bf16_t, O_ACT), p->in.bgu + (size_t)l * NE * 2048}; e(acc, u, wr, wc, fr, fq); }
        else if (kind == 3) { const EpiDN e{WSP(bf16_t, O_Y), p->in.bdn + (size_t)l * NE * D_, WSP(float, O_ROWW)}; e(acc, u, wr, wc, fr, fq); }
        else { const EpiCmp e{WSP(bf16_t, O_HID), WSP(float, O_BIAS1) + l * 256}; e(acc, u, wr, wc, fr, fq); }
    }
};
struct GSched {
    int kind, nM, nN, nunits, G, c; const int* meta; const int* rowtok; const char* Bt; size_t estep;
    __device__ __forceinline__ bool next(int i, pg8::Unit& u) const {
        const int L = i * G + c; if (L >= nunits) return false;
        if (kind == 1) {
            int wgid = L; { const int q = nunits / pg8::NXCD, r = nunits % pg8::NXCD, xcd = wgid % pg8::NXCD, off = wgid / pg8::NXCD; wgid = (xcd < r ? xcd * (q + 1) : r * (q + 1) + (xcd - r) * q) + off; }
            const int nig = pg8::WGM * nN, gid = wgid / nig, fm = gid * pg8::WGM, gsz = (nM - fm) < pg8::WGM ? (nM - fm) : pg8::WGM;
            u.pm = fm + ((wgid % nig) % gsz); u.pn = (wgid % nig) / gsz; u.e = 0; u.nr = 256;
        } else if (kind == 4) { u.e = L >> 1; u.pm = L & 1; u.pn = 0; u.nr = (L & 1) ? 255 : 256; }
        else if (kind == 0) { const int gt = L / nN; u.pm = gt; u.pn = L - gt * nN; u.e = 0; u.nr = 256; }
        else { const int gt = L / nN; u.pm = gt; u.pn = L - gt * nN; u.e = meta[64 + 2 * gt]; u.nr = meta[65 + 2 * gt]; }
        return true; }
    __device__ __forceinline__ unsigned a_off(const pg8::Unit& u, int r) const { const int rr = r < u.nr ? r : u.nr - 1; const int row = u.pm * 256 + rr;
        if (kind == 4) { const int kv = u.e & 1, bg = u.e >> 1; return (unsigned)(((bg >> 1) * S_ + 16 * row) * PB + C_KV + ((0 * 2 + kv) * 2 + (bg & 1)) * 64) * 2u; }
        return (unsigned)((kind == 2) ? rowtok[row] : row) * (unsigned)(D_ * 2); }
    __device__ __forceinline__ size_t a_kstep() const { return kind == 4 ? (size_t)PB * 2 : (size_t)128; }
    __device__ __forceinline__ const char* b_base(const pg8::Unit& u) const { return Bt + (size_t)(kind == 4 ? (u.e & 1) : u.e) * estep + (size_t)u.pn * ((size_t)256 * D_ * 2); }
};

__device__ __forceinline__ void ph_rmsnorm(KP p, int l) {
    const int lane = ftid() & 63, wv = ftid() >> 6; const float* g = p->in.g_out + (size_t)l * D_;
    constexpr int NB = 4; const int rstride = (int)gridDim.x * 8;
    f32x4 gg[4];
#pragma unroll
    for (int j = 0; j < 2; ++j) { gg[2 * j] = *(const f32x4*)(g + 512 * j + lane * 8); gg[2 * j + 1] = *(const f32x4*)(g + 512 * j + lane * 8 + 4); }
    for (int row0 = fbid() * 8 + wv; row0 < T_; row0 += rstride * NB) {
        u32x4 ra[NB], rb2[NB], rw2[NB];
#pragma unroll
        for (int bi = 0; bi < NB; ++bi) { const int row = (row0 + bi * rstride < T_) ? row0 + bi * rstride : row0; const bf16_t* r = WSP(bf16_t, O_O) + (size_t)row * D_ + lane * 8;
            ra[bi] = *(const u32x4*)r; rb2[bi] = *(const u32x4*)(r + 512); rw2[bi] = *(const u32x4*)(WSP(bf16_t, O_OWIN) + (size_t)row * 512 + lane * 8); }
#pragma unroll
        for (int bi = 0; bi < NB; ++bi) { const int row = row0 + bi * rstride; if (row < T_) {
#define BF_LO(u) __uint_as_float((u) << 16)
#define BF_HI(u) __uint_as_float((u) & 0xffff0000u)
            const f32x4 x0 = (f32x4){BF_LO(ra[bi].x) + BF_LO(rw2[bi].x), BF_HI(ra[bi].x) + BF_HI(rw2[bi].x), BF_LO(ra[bi].y) + BF_LO(rw2[bi].y), BF_HI(ra[bi].y) + BF_HI(rw2[bi].y)};
            const f32x4 x1 = (f32x4){BF_LO(ra[bi].z) + BF_LO(rw2[bi].z), BF_HI(ra[bi].z) + BF_HI(rw2[bi].z), BF_LO(ra[bi].w) + BF_LO(rw2[bi].w), BF_HI(ra[bi].w) + BF_HI(rw2[bi].w)};
            const f32x4 y0 = (f32x4){BF_LO(rb2[bi].x), BF_HI(rb2[bi].x), BF_LO(rb2[bi].y), BF_HI(rb2[bi].y)}, y1 = (f32x4){BF_LO(rb2[bi].z), BF_HI(rb2[bi].z), BF_LO(rb2[bi].w), BF_HI(rb2[bi].w)};
#undef BF_LO
#undef BF_HI
            float s = (x0.x * x0.x + x0.y * x0.y) + (x0.z * x0.z + x0.w * x0.w) + (x1.x * x1.x + x1.y * x1.y) + (x1.z * x1.z + x1.w * x1.w);
            float s2 = (y0.x * y0.x + y0.y * y0.y) + (y0.z * y0.z + y0.w * y0.w) + (y1.x * y1.x + y1.y * y1.y) + (y1.z * y1.z + y1.w * y1.w);
            const float sc0 = rsqrtf(wsum(s) * (1.f / 512.f) + RMS_EPS);
#pragma unroll
            for (int o = 1; o < 32; o <<= 1) s2 += __shfl_xor(s2, o);
            const float sc1 = rsqrtf(s2 * (1.f / 256.f) + RMS_EPS);
            const f32x4 u0 = x0 * sc0 * gg[0], u1 = x1 * sc0 * gg[1], w0 = y0 * sc1 * gg[2], w1 = y1 * sc1 * gg[3];
            bf16_t* ro = WSP(bf16_t, O_OB) + (size_t)row * D_;
            *(u32x4*)(ro + lane * 8) = (u32x4){pk2(u0.x, u0.y), pk2(u0.z, u0.w), pk2(u1.x, u1.y), pk2(u1.z, u1.w)};
            *(u32x4*)(ro + 512 + lane * 8) = (u32x4){pk2(w0.x, w0.y), pk2(w0.z, w0.w), pk2(w1.x, w1.y), pk2(w1.z, w1.w)}; } }
    }
}
template <bool ROUTER>
__device__ __forceinline__ void ph_ln(float* lds, KP p, int l, float* __restrict__ yout, int cnt_off = 0) {
    const int lane = ftid() & 63, wv = ftid() >> 6;
    const float* g = (ROUTER ? p->in.ln1_g : p->in.ln2_g) + (size_t)l * D_; const float* bb = (ROUTER ? p->in.ln1_b : p->in.ln2_b) + (size_t)l * D_;
    constexpr int NB = ROUTER ? 4 : 2;
    const int rstride = (int)gridDim.x * 8;
    for (int row0 = fbid() * 8 + wv; row0 < T_; row0 += rstride * NB) {
        float v[NB][16];
        if (ROUTER) {
#pragma unroll
            for (int bi = 0; bi < NB; ++bi) { const int row = row0 + bi * rstride; const float* src = WSP(float, O_MIX) + (size_t)(row < T_ ? row : row0) * D_;
#pragma unroll
                for (int j = 0; j < 2; ++j) { const f32x4 a = *(const f32x4*)(src + 512 * j + lane * 8), b = *(const f32x4*)(src + 512 * j + lane * 8 + 4);
                    v[bi][8 * j + 0] = a.x; v[bi][8 * j + 1] = a.y; v[bi][8 * j + 2] = a.z; v[bi][8 * j + 3] = a.w; v[bi][8 * j + 4] = b.x; v[bi][8 * j + 5] = b.y; v[bi][8 * j + 6] = b.z; v[bi][8 * j + 7] = b.w; } }
        } else { const bf16_t* y = WSP(bf16_t, O_Y);
            int sl[NB][TOPK];
#pragma unroll
            for (int bi = 0; bi < NB; ++bi) { const int row = (row0 + bi * rstride < T_) ? row0 + bi * rstride : row0;
#pragma unroll
                for (int k = 0; k < TOPK; ++k) sl[bi][k] = WSP(int, O_SLOT)[row * TOPK + k]; }
            u32x4 yv[NB][TOPK][2]; f32x4 xv[NB][4];
#pragma unroll
            for (int bi = 0; bi < NB; ++bi) { const int row = (row0 + bi * rstride < T_) ? row0 + bi * rstride : row0; const float* src = WSP(float, O_X1) + (size_t)row * D_;
#pragma unroll
                for (int j = 0; j < 2; ++j) { xv[bi][2 * j] = *(const f32x4*)(src + 512 * j + lane * 8); xv[bi][2 * j + 1] = *(const f32x4*)(src + 512 * j + lane * 8 + 4); }
#pragma unroll
                for (int k = 0; k < TOPK; ++k)
#pragma unroll
                    for (int j = 0; j < 2; ++j) yv[bi][k][j] = *(const u32x4*)(y + (size_t)sl[bi][k] * D_ + 512 * j + lane * 8); }
#pragma unroll
            for (int bi = 0; bi < NB; ++bi)
#pragma unroll
                for (int j = 0; j < 2; ++j) { float acc[8];
#pragma unroll
                    for (int e = 0; e < 8; ++e) acc[e] = 0.f;
#pragma unroll
                    for (int k = 0; k < TOPK; ++k) { const u32x4 q = yv[bi][k][j];
                        acc[0] += __uint_as_float(q.x << 16); acc[1] += __uint_as_float(q.x & 0xffff0000u); acc[2] += __uint_as_float(q.y << 16); acc[3] += __uint_as_float(q.y & 0xffff0000u);
                        acc[4] += __uint_as_float(q.z << 16); acc[5] += __uint_as_float(q.z & 0xffff0000u); acc[6] += __uint_as_float(q.w << 16); acc[7] += __uint_as_float(q.w & 0xffff0000u); }
                    const f32x4 a = xv[bi][2 * j], b = xv[bi][2 * j + 1];
                    v[bi][8 * j + 0] = ALPHA * a.x + acc[0]; v[bi][8 * j + 1] = ALPHA * a.y + acc[1]; v[bi][8 * j + 2] = ALPHA * a.z + acc[2]; v[bi][8 * j + 3] = ALPHA * a.w + acc[3];
                    v[bi][8 * j + 4] = ALPHA * b.x + acc[4]; v[bi][8 * j + 5] = ALPHA * b.y + acc[5]; v[bi][8 * j + 6] = ALPHA * b.z + acc[6]; v[bi][8 * j + 7] = ALPHA * b.w + acc[7]; } }
#pragma unroll
        for (int bi = 0; bi < NB; ++bi) { const int row = row0 + bi * rstride; if (row < T_) {
            float s = 0.f;
#pragma unroll
            for (int i = 0; i < 16; ++i) s += v[bi][i];
            const float mu = wsum(s) * (1.f / D_); float s2 = 0.f;
#pragma unroll
            for (int i = 0; i < 16; ++i) { v[bi][i] -= mu; s2 += v[bi][i] * v[bi][i]; }
            const float rstd = rsqrtf(wsum(s2) * (1.f / D_) + LN_EPS);
            bf16_t* ybf = (ROUTER ? WSP(bf16_t, O_X1B) : WSP(bf16_t, O_XB)) + (size_t)row * D_;
#pragma unroll
            for (int j = 0; j < 2; ++j) { const int c0 = 512 * j + lane * 8; float o8[8];
                const f32x4 g0 = *(const f32x4*)(g + c0), g1 = *(const f32x4*)(g + c0 + 4), b0 = *(const f32x4*)(bb + c0), b1 = *(const f32x4*)(bb + c0 + 4);
                o8[0] = v[bi][8 * j + 0] * rstd * g0.x + b0.x; o8[1] = v[bi][8 * j + 1] * rstd * g0.y + b0.y; o8[2] = v[bi][8 * j + 2] * rstd * g0.z + b0.z; o8[3] = v[bi][8 * j + 3] * rstd * g0.w + b0.w;
                o8[4] = v[bi][8 * j + 4] * rstd * g1.x + b1.x; o8[5] = v[bi][8 * j + 5] * rstd * g1.y + b1.y; o8[6] = v[bi][8 * j + 6] * rstd * g1.z + b1.z; o8[7] = v[bi][8 * j + 7] * rstd * g1.w + b1.w;
                *(f32x4*)(yout + (size_t)row * D_ + c0) = (f32x4){o8[0], o8[1], o8[2], o8[3]};
                *(f32x4*)(yout + (size_t)row * D_ + c0 + 4) = (f32x4){o8[4], o8[5], o8[6], o8[7]};
                *(u32x4*)(ybf + c0) = (u32x4){pk2(o8[0], o8[1]), pk2(o8[2], o8[3]), pk2(o8[4], o8[5]), pk2(o8[6], o8[7])}; } } }
    }
    if (ROUTER) {
        const float* rw = p->in.rw + (size_t)l * D_ * NE; const float* rb = p->in.rb + (size_t)l * NE;
        float* wl = lds; float* rl = lds + 16384 + wv * 2048; float* lgl = lds + 32768 + wv * 256;
        int nrow = 0; for (int r_ = fbid() * 8 + wv; r_ < T_; r_ += (int)gridDim.x * 8) { ++nrow; asm volatile("" : "+s"(nrow)); }
        const int e = lane & 31, half = lane >> 5;
        float acc[2][4];
#pragma unroll
        for (int gi = 0; gi < 2; ++gi)
#pragma unroll
            for (int bi = 0; bi < 4; ++bi) acc[gi][bi] = 0.f;
#pragma unroll 1
        for (int c = 0; c < 2; ++c) {
            __syncthreads();
#pragma unroll
            for (int i = 0; i < 8; ++i) { const int f4 = i * NT + ftid(); *(f32x4*)(wl + 4 * f4) = *(const f32x4*)(rw + (size_t)c * 512 * NE + 4 * f4); }
            __syncthreads();
#pragma unroll
            for (int gi = 0; gi < 2; ++gi) {
                asm volatile("s_waitcnt lgkmcnt(0)" ::: "memory");
#pragma unroll
                for (int bi = 0; bi < 4; ++bi) { const int ri = (4 * gi + bi < nrow) ? 4 * gi + bi : 0; const float* src = yout + (size_t)(fbid() * 8 + wv + ri * (int)gridDim.x * 8) * D_ + c * 512 + lane * 8;
                    *(f32x4*)(rl + bi * 512 + lane * 8) = *(const f32x4*)src; *(f32x4*)(rl + bi * 512 + lane * 8 + 4) = *(const f32x4*)(src + 4); }
                asm volatile("s_waitcnt lgkmcnt(0)" ::: "memory");
                const float* wp = wl + (half * 256) * NE + e; const float* rp = rl + half * 256;
#pragma unroll 4
                for (int kk = 0; kk < 64; ++kk) { const float w0 = wp[(4 * kk) * NE], w1 = wp[(4 * kk + 1) * NE], w2 = wp[(4 * kk + 2) * NE], w3 = wp[(4 * kk + 3) * NE];
#pragma unroll
                    for (int bi = 0; bi < 4; ++bi) { const f32x4 r = *(const f32x4*)(rp + bi * 512 + 4 * kk); acc[gi][bi] += (r.x * w0 + r.y * w1) + (r.z * w2 + r.w * w3); } }
            }
        }
#pragma unroll
        for (int gi = 0; gi < 2; ++gi)
#pragma unroll
            for (int bi = 0; bi < 4; ++bi) { const float t = acc[gi][bi] + __shfl_xor(acc[gi][bi], 32); if (lane < 32) lgl[(4 * gi + bi) * 32 + e] = t; }
        asm volatile("s_waitcnt lgkmcnt(0)" ::: "memory");
        int* lcnt = (int*)(lds + 32768 + 8 * 256);
        if (ftid() < NE) lcnt[ftid()] = 0;
        __syncthreads();
#pragma unroll 1
        for (int ri = 0; ri < nrow; ++ri) { const int row = fbid() * 8 + wv + ri * (int)gridDim.x * 8;
            const int e = lane & 31; const float lg = lgl[ri * 32 + e] + rb[e];
            float cur = lg, tv0 = 0.f, den = 0.f, myw = 0.f; int mye = 0;
#pragma unroll
            for (int k = 0; k < TOPK; ++k) { float bv = cur; int bi = e;
#pragma unroll
                for (int o = 16; o >= 1; o >>= 1) { const float ov = __shfl_xor(bv, o); const int oi = __shfl_xor(bi, o); if (ov > bv || (ov == bv && oi < bi)) { bv = ov; bi = oi; } }
                if (k == 0) tv0 = bv;
                const float w = __expf(bv - tv0); den += w;
                if (lane == k) { mye = bi; myw = w; }
                if (e == bi) cur = -3.4e38f; }
            if (lane < TOPK) { WSP(int, O_TOPE)[row * TOPK + lane] = mye; WSP(float, O_TOPW)[row * TOPK + lane] = myw / den; WSP(int, O_POS)[row * TOPK + lane] = atomicAdd(&lcnt[mye], 1); } }
        __syncthreads();
        if (ftid() < NE) { const int c = lcnt[ftid()]; lcnt[ftid()] = (c > 0) ? atomicAdd(WSP(int, O_COUNTS) + CNT_IDX(l, ftid()) + cnt_off, c) : 0; }
        __syncthreads();
#pragma unroll 1
        for (int ri = 0; ri < nrow; ++ri) { const int row = fbid() * 8 + wv + ri * (int)gridDim.x * 8;
            if (lane < TOPK) WSP(int, O_POS)[row * TOPK + lane] += lcnt[WSP(int, O_TOPE)[row * TOPK + lane]]; }
        __syncthreads();
    }
}
__device__ __forceinline__ void ph_bias1_reduce(KP p, int l) {
    if (fbid() != (int)gridDim.x - 1) return;
    const int tid = ftid(); if (tid < 256) { const float* pp = WSP(float, O_BIAS1P) + ((size_t)(l * 2 + (tid >> 7)) * 64) * 128 + (tid & 127); float a = 0.f;
        for (int s = 0; s < 64; ++s) a += pp[s * 128];
        WSP(float, O_BIAS1)[l * 256 + tid] = a; }
}
__device__ __forceinline__ void ph_cumsum(float* lds, KP p, int blk0) {
    const int tid = ftid(), lane = tid & 63, wv = tid >> 6; const int bh = fbid() - blk0;
    if (bh < 0 || bh >= B_ * 4) return;
    const int b = bh >> 2, h = bh & 3; const float* gf = WSP(float, O_GF) + (size_t)(b * S_ + tid * 16) * 32 + 24 + h;
    float v[16], run = 0.f;
#pragma unroll
    for (int i = 0; i < 16; ++i) { run += gf[(size_t)i * 32]; v[i] = run; }
    float inc = run;
#pragma unroll
    for (int o = 1; o < 64; o <<= 1) { const float t = __shfl_up(inc, o); if (lane >= o) inc += t; }
    if (lane == 63) lds[wv] = inc;
    __syncthreads();
    float woff = 0.f;
#pragma unroll
    for (int i = 0; i < 8; ++i) woff += (i < wv) ? lds[i] : 0.f;
    const float off = woff + inc - run; float* c = WSP(float, O_CFOX) + (size_t)bh * S_ + tid * 16;
#pragma unroll
    for (int i = 0; i < 4; ++i) *(f32x4*)(c + 4 * i) = (f32x4){v[4 * i] + off, v[4 * i + 1] + off, v[4 * i + 2] + off, v[4 * i + 3] + off};
    __syncthreads();
}
__device__ __forceinline__ void ph_prep2(KP p, int l) {
    { unsigned* kmax2 = WSP(unsigned, O_COUNTS) + 192 + l * 8;
      for (int i = fbid() * NT + ftid(); i < B_ * 4 * S_ * 2; i += gridDim.x * NT) { const int half = i & 1, t = (i >> 1) % S_, bh = (i >> 1) / S_, b = bh >> 2, h = bh & 3;
          const bf16_t* kr = WSP(bf16_t, O_PROJB) + (size_t)(b * S_ + t) * PB + C_FOX + (4 + h) * 64 + half * 32; float ss = 0.f;
#pragma unroll
          for (int c = 0; c < 4; ++c) { float k8[8]; ld8(kr + 8 * c, k8);
#pragma unroll
              for (int e = 0; e < 8; ++e) ss += k8[e] * k8[e]; }
          ss += __shfl_xor(ss, 1);
#pragma unroll
          for (int o = 2; o < 64; o <<= 1) ss = fmaxf(ss, __shfl_xor(ss, o));
          if ((ftid() & 63) == 0) atomicMax(kmax2 + bh, __float_as_uint(ss)); } }
    for (int i = fbid() * NT + ftid(); i < 8 * 512 * 64; i += gridDim.x * NT) {
        const int d = i & 63, n = (i >> 6) & 511, combo = i >> 15, kv = combo & 1, bg = combo >> 1;
        const float* w2 = (kv ? p->in.w2v : p->in.w2k) + (size_t)l * 128 * 64; const bf16_t* hr = WSP(bf16_t, O_HID) + ((size_t)combo * 512 + n) * 128;
        float a = 0.f;
#pragma unroll 4
        for (int c = 0; c < 16; ++c) { float h8[8]; ld8(hr + 8 * c, h8);
#pragma unroll
            for (int e = 0; e < 8; ++e) a += h8[e] * w2[(8 * c + e) * 64 + d]; }
        (kv ? WSP(bf16_t, O_VCMPB) : WSP(bf16_t, O_KCMPB))[((size_t)bg * 512 + n) * 64 + d] = (n < NCMP) ? (bf16_t)f2bf(a) : (bf16_t)0; }
}
__device__ __forceinline__ void ph_moe_scatter2(float* lds, KP p, int l) {
    const int tid = ftid(); int* ts = (int*)lds;
    const int* counts = WSP(int, O_COUNTS) + CNT_IDX(l, 0); int* meta = WSP(int, O_META); int* cl = ts + 64;
    __syncthreads();
    if (tid < NE) cl[tid] = counts[tid * 32];
    __syncthreads();
    if (tid == 0) { int nt = 0; for (int e = 0; e < NE; ++e) { ts[e] = nt; nt += (cl[e] + 255) >> 8; } ts[32] = nt; }
    __syncthreads();
    if (fbid() == 0) { if (tid < NE) { const int c = cl[tid], t0 = ts[tid]; meta[tid] = t0; for (int r = 0, t = t0; r < c; r += 256, ++t) { meta[64 + 2 * t] = tid; meta[65 + 2 * t] = (c - r) < 256 ? (c - r) : 256; } }
        if (tid == 0) meta[32] = ts[32]; }
    for (int i = fbid() * NT + tid; i < MROWS; i += gridDim.x * NT) {
        const int row = ts[WSP(int, O_TOPE)[i]] * 256 + WSP(int, O_POS)[i];
        WSP(int, O_ROWTOK)[row] = i >> 2; WSP(float, O_ROWW)[row] = WSP(float, O_TOPW)[i]; WSP(int, O_SLOT)[i] = row; }
    __syncthreads();
}
}
namespace mk {
typedef short bf16x8 __attribute__((ext_vector_type(8)));
typedef float f32x16 __attribute__((ext_vector_type(16)));
typedef float f32x2_t __attribute__((ext_vector_type(2)));
typedef __bf16 bf16x2_t __attribute__((ext_vector_type(2)));
typedef unsigned u32x2 __attribute__((ext_vector_type(2)));
typedef short v4i16_t __attribute__((ext_vector_type(4)));
__device__ __forceinline__ unsigned cvtpk(float lo, float hi) { f32x2_t v = {lo, hi}; bf16x2_t b = __builtin_convertvector(v, bf16x2_t); return __builtin_bit_cast(unsigned, b); }
constexpr int KROW = 144, VROW = 136;
constexpr int E1_K = 0, E1_V = 64 * KROW, E1_C = E1_V + 64 * KROW, E1_BUF = E1_C + 256;
constexpr int E1_FLAGS = 2 * E1_BUF;
constexpr float LOG2E = 1.4426950408889634f;
constexpr float RESC_THR = 8.0f;
#define CROW(reg, hh) (((reg) & 3) + 8 * ((reg) >> 2) + 4 * (hh))

#define SM_CORE(p0, p1, m, l, have, o0, o1) do { \
    float rm_ = fmaxf(p0[0], p1[0]); \
    _Pragma("unroll") for (int reg_ = 1; reg_ < 16; ++reg_) rm_ = fmaxf(rm_, fmaxf(p0[reg_], p1[reg_])); \
    rm_ = fmaxf(rm_, __shfl_xor(rm_, 32)); \
    const bool fin_ = rm_ > -1e37f; \
    if (__any((rm_ > RESC_THR) || (!have && fin_))) { \
        const float dl_ = have ? fmaxf(rm_, 0.f) : (fin_ ? rm_ : 0.f); const float al_ = have ? __builtin_amdgcn_exp2f(-dl_) : 1.f; \
        m += dl_; l *= al_; have = have || fin_; \
        _Pragma("unroll") for (int r_ = 0; r_ < 16; ++r_) { o0[r_] *= al_; o1[r_] *= al_; p0[r_] -= dl_; p1[r_] -= dl_; } } \
    float ls_ = 0.f; \
    _Pragma("unroll") for (int reg_ = 0; reg_ < 16; ++reg_) { p0[reg_] = __builtin_amdgcn_exp2f(p0[reg_]); p1[reg_] = __builtin_amdgcn_exp2f(p1[reg_]); ls_ += p0[reg_] + p1[reg_]; } \
    l += ls_; } while (0)

struct E1Geom { int b, q0, h; const bf16_t* qp; const bf16_t* kp; const bf16_t* vp; size_t pitch; };

template <int KIND>
__device__ __forceinline__ void e1_unit(LAS unsigned char* lds, KP p, int b, int hg, int qb, bf16_t* __restrict__ obase, bf16_t* __restrict__ owin, const unsigned* __restrict__ kmax2) {
    const int tid = ftid(), lane = tid & 63, w = __builtin_amdgcn_readfirstlane(tid >> 6), r32 = lane & 31, hh = lane >> 5;
    const bf16_t* projb = WSP(bf16_t, O_PROJB);
    int h, q0, qrow0, qcol, kcol, vcol, nrows;
    if (KIND == 0) { h = hg; q0 = qb * 256; qrow0 = q0 + 32 * w; qcol = C_FOX + h * 64; kcol = C_FOX + (4 + h) * 64; vcol = C_FOX + (8 + h) * 64; nrows = 256; }
    else if (KIND == 2) { h = hg; q0 = qb * 256; qrow0 = q0 + 32 * w; qcol = C_SB + h * 64; kcol = C_SB + (4 + h) * 64; vcol = C_SB + (8 + h) * 64; nrows = 256; }
    else { h = 4 * hg + (w & 3); q0 = qb * 64; qrow0 = q0 + 32 * (w >> 2); qcol = h * 64; kcol = C_KV + ((2 * 2 + 0) * 2 + hg) * 64; vcol = C_KV + ((2 * 2 + 1) * 2 + hg) * 64; nrows = 64; }
    const int tq = qrow0 + r32;
    const bf16_t* kbase = projb + (size_t)(b * S_) * PB + kcol; const bf16_t* vbase = projb + (size_t)(b * S_) * PB + vcol;
    bf16x8 qf[4];
    { const bf16_t* qptr = projb + (size_t)(b * S_ + tq) * PB + qcol + 8 * hh;
#pragma unroll
      for (int d0 = 0; d0 < 4; ++d0) qf[d0] = *(const bf16x8*)(qptr + 16 * d0); }
    int j0 = 0; const int j1 = (q0 + nrows - 1) >> 6;
    if (KIND == 1) { j0 = (q0 - 511) >> 6; if (j0 < 0) j0 = 0; }
    const int ntile = j1 - j0 + 1;
    float ct2 = 0.f, sl2 = 0.f; const float* cb = nullptr;
    if (KIND == 0) { cb = WSP(float, O_CFOX) + (size_t)(b * 4 + h) * S_; ct2 = cb[tq] * LOG2E; }
    if (KIND == 1) sl2 = exp2f(-(float)(h + 1)) * LOG2E;
    float qkb = 0.f;
    if (KIND == 0) { float qs = 0.f;
#pragma unroll
        for (int d0 = 0; d0 < 4; ++d0)
#pragma unroll
            for (int e = 0; e < 8; ++e) { const float x = bf2f((unsigned short)qf[d0][e]); qs += x * x; }
        qs += __shfl_xor(qs, 32);
        const float km2 = __uint_as_float(kmax2[b * 4 + h]);
        qkb = sqrtf(qs * km2) * (SCALE * LOG2E * 1.01f); }
    const float tqf = (float)tq;
    const int skey = tid >> 3, sch = tid & 7;
    u32x4 rk, rv; float rc = 0.f;
#define E1_LOAD(jj) do { const size_t ro_ = (size_t)((jj) * 64 + skey) * PB + sch * 8; rk = *(const u32x4*)(kbase + ro_); rv = *(const u32x4*)(vbase + ro_); \
        if (KIND == 0 && tid < 64) rc = cb[(jj) * 64 + tid] * LOG2E; } while (0)
#define E1_WRITE(bufp) do { *(LAS u32x4*)((bufp) + E1_K + skey * KROW + sch * 16) = rk; *(LAS u32x4*)((bufp) + E1_V + skey * KROW + sch * 16) = rv; \
        if (KIND == 0 && tid < 64) ((LAS float*)((bufp) + E1_C))[tid] = rc; } while (0)
    f32x16 o0, o1;
#pragma unroll
    for (int r = 0; r < 16; ++r) { o0[r] = 0.f; o1[r] = 0.f; }
    float m = 0.f, l = 0.f, carry = 0.f; bool have = false;
    bool wave_done = false;
    LAS unsigned* flags = (LAS unsigned*)(lds + E1_FLAGS);
    if (KIND != 1) { if (tid < 8) flags[tid] = 0u; }
    __syncthreads();
    E1_LOAD(KIND != 1 ? j1 : j0);
    for (int it = 0; it < ntile; ++it) {
        const int j = (KIND != 1) ? (j1 - it) : (j0 + it);
        LAS unsigned char* buf = lds + (it & 1) * E1_BUF;
        E1_WRITE(buf);
        __syncthreads();
        if (KIND != 1) { unsigned alld = 1u;
#pragma unroll
            for (int i = 0; i < 8; ++i) alld &= flags[i];
            if (alld) break; }
        if (it + 1 < ntile) E1_LOAD((KIND != 1) ? (j - 1) : (j + 1));
        if (!(KIND != 1 && wave_done)) {
            f32x16 p0, p1;
#pragma unroll
            for (int r = 0; r < 16; ++r) { p0[r] = 0.f; p1[r] = 0.f; }
            { const LAS unsigned char* kp_ = buf + E1_K + r32 * KROW + hh * 16;
#pragma unroll
              for (int d0 = 0; d0 < 4; ++d0) { const bf16x8 a0 = *(const LAS bf16x8*)(kp_ + d0 * 32), a1 = *(const LAS bf16x8*)(kp_ + 32 * KROW + d0 * 32);
                  p0 = __builtin_amdgcn_mfma_f32_32x32x16_bf16(a0, qf[d0], p0, 0, 0, 0); p1 = __builtin_amdgcn_mfma_f32_32x32x16_bf16(a1, qf[d0], p1, 0, 0, 0); } }
            const int kb = j * 64 + 4 * hh;
            if (KIND == 2) {
                float lk0[16], lk1[16], gs[8];
#pragma unroll
                for (int reg = 0; reg < 16; ++reg) { const int kpos = kb + CROW(reg, 0);
                    const float z0 = p0[reg] * SCALE, z1 = p1[reg] * SCALE; const bool v0 = kpos < tq, v1 = kpos + 32 < tq;
                    const float lb0 = fminf(z0, 0.f) - __logf(1.f + __expf(-fabsf(z0))), lb1 = fminf(z1, 0.f) - __logf(1.f + __expf(-fabsf(z1)));
                    lk0[reg] = v0 ? (lb0 - z0) : 0.f; lk1[reg] = v1 ? (lb1 - z1) : 0.f;
                    p0[reg] = v0 ? lb0 : -INFINITY; p1[reg] = v1 ? lb1 : -INFINITY; }
#pragma unroll
                for (int g4 = 0; g4 < 4; ++g4) { gs[g4] = (lk0[4 * g4] + lk0[4 * g4 + 1]) + (lk0[4 * g4 + 2] + lk0[4 * g4 + 3]); gs[4 + g4] = (lk1[4 * g4] + lk1[4 * g4 + 1]) + (lk1[4 * g4 + 2] + lk1[4 * g4 + 3]); }
                float oth[8];
#pragma unroll
                for (int gi = 0; gi < 8; ++gi) oth[gi] = __shfl_xor(gs[gi], 32);
                float run = 0.f;
#pragma unroll
                for (int gi = 7; gi >= 0; --gi) {
                    float later = carry + run + (hh == 0 ? oth[gi] : 0.f);
#pragma unroll
                    for (int e = 3; e >= 0; --e) { const int reg = (gi & 3) * 4 + e;
                        if (gi >> 2) { p1[reg] = __expf(p1[reg] + later); later += lk1[reg]; } else { p0[reg] = __expf(p0[reg] + later); later += lk0[reg]; } }
                    run += gs[gi] + oth[gi]; }
                carry += run;
            } else {
                if (KIND == 0) {
                    const LAS float* cs = (const LAS float*)(buf + E1_C) + 4 * hh; const float ctm = ct2 - m;
#pragma unroll
                    for (int i = 0; i < 4; ++i) { const f32x4 c0 = *(const LAS f32x4*)(cs + 8 * i), c1 = *(const LAS f32x4*)(cs + 32 + 8 * i);
#pragma unroll
                        for (int e = 0; e < 4; ++e) { const int reg = 4 * i + e; p0[reg] = p0[reg] * (SCALE * LOG2E) + (ctm - c0[e]); p1[reg] = p1[reg] * (SCALE * LOG2E) + (ctm - c1[e]); } }
                    if (!(j * 64 + 63 <= qrow0)) {
#pragma unroll
                        for (int reg = 0; reg < 16; ++reg) { const int kpos = kb + CROW(reg, 0); p0[reg] = (kpos <= tq) ? p0[reg] : -INFINITY; p1[reg] = (kpos + 32 <= tq) ? p1[reg] : -INFINITY; } }
                } else {
                    const float basef = sl2 * ((float)kb - tqf) - m, base1 = basef + 32.f * sl2;
#pragma unroll
                    for (int reg = 0; reg < 16; ++reg) { p0[reg] = p0[reg] * (SCALE * LOG2E) + __builtin_fmaf(sl2, (float)CROW(reg, 0), basef); p1[reg] = p1[reg] * (SCALE * LOG2E) + __builtin_fmaf(sl2, (float)CROW(reg, 0), base1); }
                    if (!(j * 64 + 63 <= qrow0 && qrow0 + 31 - j * 64 < 512)) {
#pragma unroll
                        for (int reg = 0; reg < 16; ++reg) { const int kpos = kb + CROW(reg, 0);
                            p0[reg] = (kpos <= tq && tq - kpos < 512) ? p0[reg] : -INFINITY; p1[reg] = (kpos + 32 <= tq && tq - kpos - 32 < 512) ? p1[reg] : -INFINITY; } }
                }
                SM_CORE(p0, p1, m, l, have, o0, o1);
            }
            { const int gq_ = lane >> 4, li_ = lane & 15;
              const LAS unsigned char* tb = buf + E1_V + (4 * hh + (li_ >> 2)) * KROW + (16 * (gq_ & 1) + 4 * (li_ & 3)) * 2;
#pragma unroll
              for (int s = 0; s < 4; ++s) {
                  u32x4 pw;
                  if (s < 2) { pw.x = cvtpk(p0[8 * s + 0], p0[8 * s + 1]); pw.y = cvtpk(p0[8 * s + 2], p0[8 * s + 3]); pw.z = cvtpk(p0[8 * s + 4], p0[8 * s + 5]); pw.w = cvtpk(p0[8 * s + 6], p0[8 * s + 7]); }
                  else { const int s2 = s - 2; pw.x = cvtpk(p1[8 * s2 + 0], p1[8 * s2 + 1]); pw.y = cvtpk(p1[8 * s2 + 2], p1[8 * s2 + 3]); pw.z = cvtpk(p1[8 * s2 + 4], p1[8 * s2 + 5]); pw.w = cvtpk(p1[8 * s2 + 6], p1[8 * s2 + 7]); }
                  const bf16x8 pb = __builtin_bit_cast(bf16x8, pw);
                  const v4i16_t a0l = __builtin_amdgcn_ds_read_tr16_b64_v4i16((LAS v4i16_t*)(tb + (16 * s) * KROW)), a0h = __builtin_amdgcn_ds_read_tr16_b64_v4i16((LAS v4i16_t*)(tb + (16 * s + 8) * KROW));
                  const v4i16_t a1l = __builtin_amdgcn_ds_read_tr16_b64_v4i16((LAS v4i16_t*)(tb + (16 * s) * KROW + 64)), a1h = __builtin_amdgcn_ds_read_tr16_b64_v4i16((LAS v4i16_t*)(tb + (16 * s + 8) * KROW + 64));
                  const bf16x8 va0 = (bf16x8){a0l[0], a0l[1], a0l[2], a0l[3], a0h[0], a0h[1], a0h[2], a0h[3]}, va1 = (bf16x8){a1l[0], a1l[1], a1l[2], a1l[3], a1h[0], a1h[1], a1h[2], a1h[3]};
                  o0 = __builtin_amdgcn_mfma_f32_32x32x16_bf16(va0, pb, o0, 0, 0, 0); o1 = __builtin_amdgcn_mfma_f32_32x32x16_bf16(va1, pb, o1, 0, 0, 0); } }
            if (KIND == 0) {
                const float c0 = *(const LAS float*)(buf + E1_C); const bool dn = __all(have && (qkb + (ct2 - c0) - m < -150.f));
                if (dn && !wave_done) { wave_done = true; if (lane == 0) flags[w] = 1u; } }
            if (KIND == 2) { const bool dn = __all(carry < -110.f);
                if (dn && !wave_done) { wave_done = true; if (lane == 0) flags[w] = 1u; } }
        }
    }
    float inv = 1.f, gate = 1.f;
    if (KIND != 2) { l += __shfl_xor(l, 32); inv = (l > 0.f) ? 1.f / l : 0.f; }
    bf16_t* orow;
    if (KIND == 0) orow = obase + (size_t)(b * S_ + tq) * D_ + 512 + h * 64;
    else if (KIND == 2) orow = obase + (size_t)(b * S_ + tq) * D_ + 768 + h * 64;
    else { orow = owin + (size_t)(b * S_ + tq) * 512 + h * 64; gate = WSP(float, O_GF)[(size_t)(b * S_ + tq) * 32 + 2 * 8 + h]; }
    const float sc = inv * gate;
#pragma unroll
    for (int i = 0; i < 4; ++i) {
        *(u32x2*)(orow + 8 * i + 4 * hh) = (u32x2){cvtpk(o0[4 * i] * sc, o0[4 * i + 1] * sc), cvtpk(o0[4 * i + 2] * sc, o0[4 * i + 3] * sc)};
        *(u32x2*)(orow + 32 + 8 * i + 4 * hh) = (u32x2){cvtpk(o1[4 * i] * sc, o1[4 * i + 1] * sc), cvtpk(o1[4 * i + 2] * sc, o1[4 * i + 3] * sc)}; }
#undef E1_LOAD
#undef E1_WRITE
}
}
namespace mk {
constexpr int E2_WAVE = 64 * KROW + 512;
template <bool USE_MASK>
__device__ __forceinline__ void e2_wave_unit(LAS unsigned char* ldsw, KP p, int b, int g, int t0, bf16_t* __restrict__ obase, const bf16_t* __restrict__ csrc, int cpitch) {
    const int lane = ftid() & 63, r32 = lane & 31, hh = lane >> 5, qi = r32 >> 2, r4 = r32 & 3;
    const int h = 4 * g + r4, tq = t0 + qi;
    const bf16_t* projb = WSP(bf16_t, O_PROJB);
    const bf16_t* kbase = projb + (size_t)(b * S_) * PB + C_KV + ((1 * 2 + 0) * 2 + g) * 64;
    const bf16_t* vbase = projb + (size_t)(b * S_) * PB + C_KV + ((1 * 2 + 1) * 2 + g) * 64;
    bf16x8 qf[4];
    { const bf16_t* qptr = projb + (size_t)(b * S_ + tq) * PB + h * 64 + 8 * hh;
#pragma unroll
      for (int d0 = 0; d0 < 4; ++d0) qf[d0] = *(const bf16x8*)(qptr + 16 * d0); }
    unsigned qm0 = 0u, qm1 = 0u, qm2 = 0u, qm3 = 0u;
    if (USE_MASK) { const u32x4 mw = *(const u32x4*)(WSP(unsigned, O_SELMASK) + ((size_t)((b * 2 + g) * S_ + t0 + (lane >> 3))) * 4); qm0 = mw.x; qm1 = mw.y; qm2 = mw.z; qm3 = mw.w; }
    else { const int* sp = WSP(int, O_SEL) + ((size_t)((b * 2 + g) * S_ + t0)) * NSEL + lane * 2;
      const int e0 = sp[0], e1 = sp[1];
#pragma unroll
      for (int k = 0; k < 2; ++k) { const int e = k ? e1 : e0; const unsigned bit = 1u << (e & 31); const int wd = e >> 5;
          qm0 |= (wd == 0) ? bit : 0u; qm1 |= (wd == 1) ? bit : 0u; qm2 |= (wd == 2) ? bit : 0u; qm3 |= (wd == 3) ? bit : 0u; }
#pragma unroll
      for (int o = 1; o < 8; o <<= 1) { qm0 |= __shfl_xor(qm0, o); qm1 |= __shfl_xor(qm1, o); qm2 |= __shfl_xor(qm2, o); qm3 |= __shfl_xor(qm3, o); } }
    const unsigned rm0 = __shfl(qm0, qi * 8), rm1 = __shfl(qm1, qi * 8), rm2 = __shfl(qm2, qi * 8), rm3 = __shfl(qm3, qi * 8);
    const unsigned* rowmask = WSP(unsigned, O_SELMASK) + ((size_t)((b * 2 + g) * S_ + tq)) * 4;
    unsigned um0 = qm0, um1 = qm1, um2 = qm2, um3 = qm3;
#pragma unroll
    for (int o = 8; o < 64; o <<= 1) { um0 |= __shfl_xor(um0, o); um1 |= __shfl_xor(um1, o); um2 |= __shfl_xor(um2, o); um3 |= __shfl_xor(um3, o); }
    LAS int* list = (LAS int*)(ldsw + 64 * KROW);
    int nblk;
    { const bool s0 = (((lane < 32) ? um0 : um1) >> (lane & 31)) & 1u, s1 = (((lane < 32) ? um2 : um3) >> (lane & 31)) & 1u;
      const unsigned long long b0 = __ballot(s0), b1 = __ballot(s1);
      const unsigned long long lower = (lane == 0) ? 0ull : (~0ull >> (64 - lane));
      const int n0 = __popcll(b0);
      if (s0) list[__popcll(b0 & lower)] = lane;
      if (s1) list[n0 + __popcll(b1 & lower)] = lane + 64;
      nblk = n0 + __popcll(b1); }
    asm volatile("s_waitcnt lgkmcnt(0)" ::: "memory");
    const float sl2 = exp2f(-(float)(h + 1)) * LOG2E, tqf = (float)tq;
    f32x16 o0, o1;
#pragma unroll
    for (int r = 0; r < 16; ++r) { o0[r] = 0.f; o1[r] = 0.f; }
    float m = 0.f, l = 0.f; bool have = false;
    const int curq = tq >> 6;
    const int vrow = lane >> 3, vch = lane & 7;
    const int gq = lane >> 4, li = lane & 15;
    const LAS unsigned char* trb = ldsw + (4 * hh + (li >> 2)) * KROW + (16 * (gq & 1) + 4 * (li & 3)) * 2;
    bf16x8 kn0[4], kn1[4]; u32x4 vn[8];
#define E2_LOAD(blk) do { const bf16_t* kp_ = kbase + (size_t)((blk) * 64 + r32) * PB + 8 * hh; const bf16_t* vp_ = vbase + (size_t)((blk) * 64 + vrow) * PB + vch * 8; \
        _Pragma("unroll") for (int d0 = 0; d0 < 4; ++d0) { kn0[d0] = *(const bf16x8*)(kp_ + 16 * d0); kn1[d0] = *(const bf16x8*)(kp_ + (size_t)32 * PB + 16 * d0); } \
        _Pragma("unroll") for (int i = 0; i < 8; ++i) vn[i] = *(const u32x4*)(vp_ + (size_t)(8 * i) * PB); } while (0)
    int blk = list[0];
    blk = __builtin_amdgcn_readfirstlane(blk);
    E2_LOAD(blk);
    for (int it = 0; it < nblk; ++it) {
#pragma unroll
        for (int i = 0; i < 8; ++i) *(LAS u32x4*)(ldsw + (vrow + 8 * i) * KROW + vch * 16) = vn[i];
        const int cur = blk;
        const unsigned rw = USE_MASK ? rowmask[cur >> 5] : ((cur < 32) ? rm0 : (cur < 64) ? rm1 : (cur < 96) ? rm2 : rm3);
        f32x16 p0, p1;
#pragma unroll
        for (int r = 0; r < 16; ++r) { p0[r] = 0.f; p1[r] = 0.f; }
#pragma unroll
        for (int d0 = 0; d0 < 4; ++d0) { p0 = __builtin_amdgcn_mfma_f32_32x32x16_bf16(kn0[d0], qf[d0], p0, 0, 0, 0); p1 = __builtin_amdgcn_mfma_f32_32x32x16_bf16(kn1[d0], qf[d0], p1, 0, 0, 0); }
        if (it + 1 < nblk) { blk = __builtin_amdgcn_readfirstlane(list[it + 1]); E2_LOAD(blk); }
        const bool rowsel = (rw >> (cur & 31)) & 1u;
        const int kb = cur * 64 + 4 * hh;
        { const float basef = rowsel ? (sl2 * ((float)kb - tqf) - m) : -INFINITY, base1 = basef + 32.f * sl2;
#pragma unroll
          for (int reg = 0; reg < 16; ++reg) { p0[reg] = p0[reg] * (SCALE * LOG2E) + __builtin_fmaf(sl2, (float)CROW(reg, 0), basef); p1[reg] = p1[reg] * (SCALE * LOG2E) + __builtin_fmaf(sl2, (float)CROW(reg, 0), base1); } }
        if (cur >= curq) {
#pragma unroll
            for (int reg = 0; reg < 16; ++reg) { const int kpos = kb + CROW(reg, 0); p0[reg] = (kpos <= tq) ? p0[reg] : -INFINITY; p1[reg] = (kpos + 32 <= tq) ? p1[reg] : -INFINITY; } }
        SM_CORE(p0, p1, m, l, have, o0, o1);
#pragma unroll
        for (int s = 0; s < 4; ++s) {
            u32x4 pw;
            if (s < 2) { pw.x = cvtpk(p0[8 * s + 0], p0[8 * s + 1]); pw.y = cvtpk(p0[8 * s + 2], p0[8 * s + 3]); pw.z = cvtpk(p0[8 * s + 4], p0[8 * s + 5]); pw.w = cvtpk(p0[8 * s + 6], p0[8 * s + 7]); }
            else { const int s2 = s - 2; pw.x = cvtpk(p1[8 * s2 + 0], p1[8 * s2 + 1]); pw.y = cvtpk(p1[8 * s2 + 2], p1[8 * s2 + 3]); pw.z = cvtpk(p1[8 * s2 + 4], p1[8 * s2 + 5]); pw.w = cvtpk(p1[8 * s2 + 6], p1[8 * s2 + 7]); }
            const bf16x8 pb = __builtin_bit_cast(bf16x8, pw);
            const v4i16_t a0l = __builtin_amdgcn_ds_read_tr16_b64_v4i16((LAS v4i16_t*)(trb + (16 * s) * KROW)), a0h = __builtin_amdgcn_ds_read_tr16_b64_v4i16((LAS v4i16_t*)(trb + (16 * s + 8) * KROW));
            const v4i16_t a1l = __builtin_amdgcn_ds_read_tr16_b64_v4i16((LAS v4i16_t*)(trb + (16 * s) * KROW + 64)), a1h = __builtin_amdgcn_ds_read_tr16_b64_v4i16((LAS v4i16_t*)(trb + (16 * s + 8) * KROW + 64));
            const bf16x8 va0 = (bf16x8){a0l[0], a0l[1], a0l[2], a0l[3], a0h[0], a0h[1], a0h[2], a0h[3]}, va1 = (bf16x8){a1l[0], a1l[1], a1l[2], a1l[3], a1h[0], a1h[1], a1h[2], a1h[3]};
            o0 = __builtin_amdgcn_mfma_f32_32x32x16_bf16(va0, pb, o0, 0, 0, 0); o1 = __builtin_amdgcn_mfma_f32_32x32x16_bf16(va1, pb, o1, 0, 0, 0); }
    }
    l += __shfl_xor(l, 32);
    const float sc = ((l > 0.f) ? 1.f / l : 0.f) * WSP(float, O_GF)[(size_t)(b * S_ + tq) * 32 + 1 * 8 + h];
    bf16_t* orow = obase + (size_t)(b * S_ + tq) * D_ + h * 64; const bf16_t* crow = csrc + (size_t)(b * S_ + tq) * cpitch + h * 64;
#pragma unroll
    for (int i = 0; i < 4; ++i) {
        const u32x2 c0 = *(const u32x2*)(crow + 8 * i + 4 * hh), c1 = *(const u32x2*)(crow + 32 + 8 * i + 4 * hh);
        const float x00 = __uint_as_float(c0.x << 16) + o0[4 * i] * sc, x01 = __uint_as_float(c0.x & 0xffff0000u) + o0[4 * i + 1] * sc, x02 = __uint_as_float(c0.y << 16) + o0[4 * i + 2] * sc, x03 = __uint_as_float(c0.y & 0xffff0000u) + o0[4 * i + 3] * sc;
        const float x10 = __uint_as_float(c1.x << 16) + o1[4 * i] * sc, x11 = __uint_as_float(c1.x & 0xffff0000u) + o1[4 * i + 1] * sc, x12 = __uint_as_float(c1.y << 16) + o1[4 * i + 2] * sc, x13 = __uint_as_float(c1.y & 0xffff0000u) + o1[4 * i + 3] * sc;
        *(u32x2*)(orow + 8 * i + 4 * hh) = (u32x2){cvtpk(x00, x01), cvtpk(x02, x03)}; *(u32x2*)(orow + 32 + 8 * i + 4 * hh) = (u32x2){cvtpk(x10, x11), cvtpk(x12, x13)}; }
#undef E2_LOAD
}
template <bool USE_MASK>
__device__ __forceinline__ void ph_attn_sel2(LAS unsigned char* lds3, KP p, bf16_t* __restrict__ obase, const bf16_t* __restrict__ csrc, int cpitch) {
    const int w = __builtin_amdgcn_readfirstlane(ftid() >> 6);
    LAS unsigned char* ldsw = lds3 + w * E2_WAVE;
    MK_LOOP(u, 512) { const int bg = u & 3, qblk = u >> 2; e2_wave_unit<USE_MASK>(ldsw, p, bg >> 1, bg & 1, qblk * 64 + 8 * w, obase, csrc, cpitch); }
}
}
namespace mk {
constexpr int E3_K = 0, E3_V = 512 * KROW, E3_BYTES = 2 * 512 * KROW;
__device__ __forceinline__ void e3_unit(LAS unsigned char* lds, KP p, int b, int g, int qb, bf16_t* __restrict__ ocmp, unsigned* __restrict__ selmask) {
    const int tid = ftid(), lane = tid & 63, w = __builtin_amdgcn_readfirstlane(tid >> 6), r32 = lane & 31, hh = lane >> 5;
    const int bg = b * 2 + g, q0 = qb * 256, qrow0 = q0 + 32 * w, tq = qrow0 + r32;
    const bf16_t* projb = WSP(bf16_t, O_PROJB);
    int nun = (q0 + 255 - 31) / 16 + 1; if (nun > 511) nun = 511;
    const int ntile_u = (nun + 63) >> 6;
    __syncthreads();
    { const int srow = tid >> 3, sch = tid & 7; const bf16_t* ks = WSP(bf16_t, O_KCMPB) + ((size_t)bg * 512 + srow) * 64 + sch * 8; const bf16_t* vs = WSP(bf16_t, O_VCMPB) + ((size_t)bg * 512 + srow) * 64 + sch * 8;
      for (int i = 0; i < ntile_u; ++i) { const u32x4 kv = *(const u32x4*)(ks + (size_t)i * 64 * 64), vv = *(const u32x4*)(vs + (size_t)i * 64 * 64);
          *(LAS u32x4*)(lds + E3_K + (srow + 64 * i) * KROW + sch * 16) = kv; *(LAS u32x4*)(lds + E3_V + (srow + 64 * i) * KROW + sch * 16) = vv; } }
    __syncthreads();
    int nw = qrow0 / 16 + 1; if (nw > 511) nw = 511;
    const int ntile_w = (qrow0 + 31 < 31) ? 0 : ((nw + 63) >> 6);
    const float tqf = (float)tq;
    const int gq = lane >> 4, li = lane & 15;
    const LAS unsigned char* trb = lds + E3_V + (4 * hh + (li >> 2)) * KROW + (16 * (gq & 1) + 4 * (li & 3)) * 2;
    const LAS unsigned char* kfb = lds + E3_K + r32 * KROW + hh * 16;
    float imp[64];
#pragma unroll
    for (int i = 0; i < 64; ++i) imp[i] = 0.f;
#pragma unroll 1
    for (int r4 = 0; r4 < 4; ++r4) {
        const int h = 4 * g + r4; const float sl2 = exp2f(-(float)(h + 1)) * LOG2E;
        const unsigned qoff = (unsigned)((b * S_ + tq) * PB + h * 64 + 8 * hh);
        f32x16 o0, o1;
#pragma unroll
        for (int r = 0; r < 16; ++r) { o0[r] = 0.f; o1[r] = 0.f; }
        float m = 0.f, l = 0.f; bool have = false;
#define E3_ST(jt) f32x16 p0, p1; { bf16x8 qf[4]; _Pragma("unroll") for (int d0 = 0; d0 < 4; ++d0) qf[d0] = *(const bf16x8*)(projb + qoff + 16 * d0); \
            _Pragma("unroll") for (int r = 0; r < 16; ++r) { p0[r] = 0.f; p1[r] = 0.f; } \
            _Pragma("unroll") for (int d0 = 0; d0 < 4; ++d0) { const bf16x8 a0 = *(const LAS bf16x8*)(kfb + (64 * (jt)) * KROW + d0 * 32), a1 = *(const LAS bf16x8*)(kfb + (64 * (jt) + 32) * KROW + d0 * 32); \
                p0 = __builtin_amdgcn_mfma_f32_32x32x16_bf16(a0, qf[d0], p0, 0, 0, 0); p1 = __builtin_amdgcn_mfma_f32_32x32x16_bf16(a1, qf[d0], p1, 0, 0, 0); } \
            int tq_ = tq; asm volatile("" : "+v"(tq_));     \
            int hh_ = hh; asm volatile("" : "+v"(hh_)); \
            const float tqf_ = (float)tq_; const int ce0_ = 16 * (64 * (jt) + 4 * hh_) + 31; \
            const float basef_ = sl2 * ((float)ce0_ - tqf_) - m, base1_ = basef_ + 512.f * sl2; \
            _Pragma("unroll") for (int reg = 0; reg < 16; ++reg) { const float cr_ = sl2 * (float)(16 * CROW(reg, 0)); p0[reg] = p0[reg] * (SCALE * LOG2E) + (basef_ + cr_); p1[reg] = p1[reg] * (SCALE * LOG2E) + (base1_ + cr_); } \
            if (ce0_ + 16 * 27 + 512 > qrow0) {     \
                _Pragma("unroll") for (int reg = 0; reg < 16; ++reg) { const int ce = ce0_ + 16 * CROW(reg, 0); p0[reg] = (ce <= tq_) ? p0[reg] : -INFINITY; p1[reg] = (ce + 512 <= tq_) ? p1[reg] : -INFINITY; } } }
        float imh[64];
#pragma unroll
        for (int i = 0; i < 64; ++i) imh[i] = 0.f;
#pragma unroll
        for (int jt = 0; jt < 8; ++jt) {
            if (jt < ntile_w) {
                E3_ST(jt);
                {
                    float rm_ = fmaxf(p0[0], p1[0]);
#pragma unroll
                    for (int reg_ = 1; reg_ < 16; ++reg_) rm_ = fmaxf(rm_, fmaxf(p0[reg_], p1[reg_]));
                    rm_ = fmaxf(rm_, __shfl_xor(rm_, 32));
                    const bool fin_ = rm_ > -1e37f;
                    if (__any((rm_ > RESC_THR) || (!have && fin_))) {
                        const float dl_ = have ? fmaxf(rm_, 0.f) : (fin_ ? rm_ : 0.f); const float al_ = have ? __builtin_amdgcn_exp2f(-dl_) : 1.f;
                        m += dl_; l *= al_; have = have || fin_;
#pragma unroll
                        for (int r_ = 0; r_ < 16; ++r_) { o0[r_] *= al_; o1[r_] *= al_; p0[r_] -= dl_; p1[r_] -= dl_; }
#pragma unroll
                        for (int i = 0; i < 64; ++i) imh[i] *= al_; }
                    float ls_ = 0.f;
#pragma unroll
                    for (int reg_ = 0; reg_ < 16; ++reg_) { p0[reg_] = __builtin_amdgcn_exp2f(p0[reg_]); p1[reg_] = __builtin_amdgcn_exp2f(p1[reg_]); ls_ += p0[reg_] + p1[reg_]; }
                    l += ls_; }
#pragma unroll
                for (int pa = 0; pa < 2; ++pa)
#pragma unroll
                    for (int i = 0; i < 4; ++i) { const int jj = 8 * jt + 4 * pa + i;
                        const float x0 = pa ? p1[4 * i] : p0[4 * i], x1 = pa ? p1[4 * i + 1] : p0[4 * i + 1], x2 = pa ? p1[4 * i + 2] : p0[4 * i + 2], x3 = pa ? p1[4 * i + 3] : p0[4 * i + 3];
                        const float c = 0.5f * x3, a = (x0 + x1) + (x2 + c), r = __shfl_xor(c, 32);
                        imh[jj] += a + (hh ? r : 0.f);
                        if (jj + 1 < 64) imh[jj + 1] += (hh ? 0.f : r); }
                const LAS unsigned char* tb = trb + (64 * jt) * KROW;
#pragma unroll
                for (int s = 0; s < 4; ++s) {
                    u32x4 pw;
                    if (s < 2) { pw.x = cvtpk(p0[8 * s + 0], p0[8 * s + 1]); pw.y = cvtpk(p0[8 * s + 2], p0[8 * s + 3]); pw.z = cvtpk(p0[8 * s + 4], p0[8 * s + 5]); pw.w = cvtpk(p0[8 * s + 6], p0[8 * s + 7]); }
                    else { const int s2 = s - 2; pw.x = cvtpk(p1[8 * s2 + 0], p1[8 * s2 + 1]); pw.y = cvtpk(p1[8 * s2 + 2], p1[8 * s2 + 3]); pw.z = cvtpk(p1[8 * s2 + 4], p1[8 * s2 + 5]); pw.w = cvtpk(p1[8 * s2 + 6], p1[8 * s2 + 7]); }
                    const bf16x8 pb = __builtin_bit_cast(bf16x8, pw);
                    const v4i16_t a0l = __builtin_amdgcn_ds_read_tr16_b64_v4i16((LAS v4i16_t*)(tb + (16 * s) * KROW)), a0h = __builtin_amdgcn_ds_read_tr16_b64_v4i16((LAS v4i16_t*)(tb + (16 * s + 8) * KROW));
                    const v4i16_t a1l = __builtin_amdgcn_ds_read_tr16_b64_v4i16((LAS v4i16_t*)(tb + (16 * s) * KROW + 64)), a1h = __builtin_amdgcn_ds_read_tr16_b64_v4i16((LAS v4i16_t*)(tb + (16 * s + 8) * KROW + 64));
                    const bf16x8 va0 = (bf16x8){a0l[0], a0l[1], a0l[2], a0l[3], a0h[0], a0h[1], a0h[2], a0h[3]}, va1 = (bf16x8){a1l[0], a1l[1], a1l[2], a1l[3], a1h[0], a1h[1], a1h[2], a1h[3]};
                    o0 = __builtin_amdgcn_mfma_f32_32x32x16_bf16(va0, pb, o0, 0, 0, 0); o1 = __builtin_amdgcn_mfma_f32_32x32x16_bf16(va1, pb, o1, 0, 0, 0); }
            }
        }
        l += __shfl_xor(l, 32);
        const float inv = (l > 0.f) ? 1.f / l : 0.f;
#pragma unroll
        for (int i = 0; i < 64; ++i) imp[i] += imh[i] * inv;
        { const float sc = inv * WSP(float, O_GF)[(size_t)(b * S_ + tq) * 32 + 0 * 8 + h];
          bf16_t* orow = ocmp + (size_t)(b * S_ + tq) * 512 + h * 64;
#pragma unroll
          for (int i = 0; i < 4; ++i) {
              *(u32x2*)(orow + 8 * i + 4 * hh) = (u32x2){cvtpk(o0[4 * i] * sc, o0[4 * i + 1] * sc), cvtpk(o0[4 * i + 2] * sc, o0[4 * i + 3] * sc)};
              *(u32x2*)(orow + 32 + 8 * i + 4 * hh) = (u32x2){cvtpk(o1[4 * i] * sc, o1[4 * i + 1] * sc), cvtpk(o1[4 * i + 2] * sc, o1[4 * i + 3] * sc)}; } }
#undef E3_ST
    }
    const int cur = tq >> 6;
#pragma unroll
    for (int jj = 0; jj < 64; ++jj) { const int j = 2 * jj + hh; imp[jj] = (j != 0 && j < cur - 1) ? imp[jj] : -1.f; }
    unsigned m0 = 1u, m1 = 0u, m2 = 0u, m3 = 0u;
#define E3_SETBIT(j) do { const unsigned bit_ = 1u << ((j) & 31); const int wd_ = (j) >> 5; m0 |= (wd_ == 0) ? bit_ : 0u; m1 |= (wd_ == 1) ? bit_ : 0u; m2 |= (wd_ == 2) ? bit_ : 0u; m3 |= (wd_ == 3) ? bit_ : 0u; } while (0)
    E3_SETBIT(cur); if (cur >= 1) E3_SETBIT(cur - 1);
#pragma unroll 1
    for (int it = 0; it < NSEL - 3; ++it) {
        float best = -0.5f; int bj = 0;
#pragma unroll
        for (int jj = 0; jj < 64; ++jj) { if (imp[jj] > best) { best = imp[jj]; bj = jj; } }
        const int myj = 2 * bj + hh; const float ob = __shfl_xor(best, 32); const int oj = __shfl_xor(myj, 32);
        const bool mine = (best > ob) || (best == ob && myj < oj);
        const float wv = mine ? best : ob; const int wj = mine ? myj : oj;
        if (wv >= 0.f) E3_SETBIT(wj);
        if (mine && best >= 0.f) {
#pragma unroll
            for (int jj = 0; jj < 64; ++jj) imp[jj] = (jj == bj) ? -2.f : imp[jj]; }
    }
#undef E3_SETBIT
    if (hh == 0) *(u32x4*)(selmask + ((size_t)bg * S_ + tq) * 4) = (u32x4){m0, m1, m2, m3};
}
}
namespace mk {
constexpr int SB_EARLY = 232;
template <int MODE>
__device__ __forceinline__ void ph_attn1(float* lds, LAS unsigned char* lds3, KP p, unsigned* qctr, bf16_t* obase, bf16_t* owin, const unsigned* kmax2) {
    LAS int* qslot = (LAS int*)(lds3 + E3_BYTES);
    constexpr int N_E3 = (MODE & 2) ? 128 : 0, N_CMP = (MODE & 1) ? 64 : 0, N_FOX = (MODE & 4) ? 256 : 0, N_WIN = (MODE & 8) ? 512 : 0, N_SB = (MODE & 16) ? (256 - SB_EARLY) : 0;
    for (;;) {
        __syncthreads();
        if (ftid() == 0) *qslot = (int)atomicAdd(qctr, 1u);
        __syncthreads();
        int u = __builtin_amdgcn_readfirstlane(*qslot);
        if (u >= N_E3 + N_CMP + N_FOX + N_WIN + N_SB) break;
        if (u < N_E3) { e3_unit(lds3, p, (u & 3) >> 1, u & 1, 31 - (u >> 2), WSP(bf16_t, O_OCMP), WSP(unsigned, O_SELMASK)); continue; } u -= N_E3;
        if (u < N_FOX) { e1_unit<0>(lds3, p, (u & 7) >> 2, u & 3, 31 - (u >> 3), obase, owin, kmax2); continue; } u -= N_FOX;
        if (u < N_WIN) { e1_unit<1>(lds3, p, (u & 3) >> 1, u & 1, 127 - (u >> 2), obase, owin, kmax2); continue; } u -= N_WIN;
        if (u < N_SB) { u += SB_EARLY; e1_unit<2>(lds3, p, (u & 7) >> 2, u & 3, 31 - (u >> 3), obase, owin, kmax2); }
    }
}
__device__ __forceinline__ void ph_sb_early(LAS unsigned char* lds3, KP p) {
    const int u = fbid() - 24; if (u < 0 || u >= SB_EARLY) return;
    e1_unit<2>(lds3, p, (u & 7) >> 2, u & 3, 31 - (u >> 3), WSP(bf16_t, O_O), WSP(bf16_t, O_OWIN), nullptr);
}
}
namespace mk {
#define RLX_AGENT __ATOMIC_RELAXED, __HIP_MEMORY_SCOPE_AGENT
#define XB_TMO      128
#define XB_XCNT(j)  (256  + 64 * (j))
#define XB_XSUB(j)  (1280 + 64 * (j))
#define XB_XGEN(j)  (2304 + 64 * (j))
#define XB_TOP      3328
#define XB_TOPGEN   3392
#define XCD_BAR_WORDS 3456
#define XB_SPIN_CAP (1u << 18)

__device__ __forceinline__ unsigned xb_ld(unsigned* p)              { return __hip_atomic_load(p, __ATOMIC_RELAXED, __HIP_MEMORY_SCOPE_AGENT); }
__device__ __forceinline__ unsigned xb_add(unsigned* p, unsigned v) { return __hip_atomic_fetch_add(p, v, __ATOMIC_RELAXED, __HIP_MEMORY_SCOPE_AGENT); }
__device__ __forceinline__ unsigned xb_xcc_id() { return (unsigned)__builtin_amdgcn_s_getreg((3 << 11) | 20) & 0xFu; }
#define XB_SPIN(cond, bar) do { unsigned _sp = 0; while (cond) { __builtin_amdgcn_s_sleep(1); \
    if ((++_sp & 255u) == 0u) { if (xb_ld(&(bar)[XB_TMO])) break; if (_sp > XB_SPIN_CAP) { atomicAdd(&(bar)[XB_TMO], 1u); break; } } } } while (0)

struct XcdBarrier {
    unsigned* bar; unsigned x;
    volatile LAS unsigned* st;
};

__device__ __forceinline__ XcdBarrier xcd_barrier_post(unsigned* bar, volatile LAS unsigned* st) {
    XcdBarrier b; b.bar = bar; b.x = xb_xcc_id(); b.st = st;
    if (threadIdx.x == 0) (void)xb_add(&bar[XB_XCNT(b.x)], 1u);
    return b;
}
__device__ __forceinline__ void xcd_barrier_complete(unsigned* bar, unsigned x, unsigned& nloc, unsigned& nx) {
    const unsigned G = gridDim.x * gridDim.y * gridDim.z;
    unsigned sum, cnt, mine, sp = 0u;
    for (;;) {
        sum = 0u; cnt = 0u; mine = 0u;
#pragma unroll
        for (unsigned j = 0; j < 16; ++j) { const unsigned c = xb_ld(&bar[XB_XCNT(j)]); sum += c; cnt += (c > 0u) ? 1u : 0u; mine = (j == x) ? c : mine; }
        if (sum == G) break;
        __builtin_amdgcn_s_sleep(1);
        if ((++sp & 255u) == 0u) { if (xb_ld(&bar[XB_TMO])) break; if (sp > XB_SPIN_CAP) { atomicAdd(&bar[XB_TMO], 1u); break; } }
    }
    nloc = mine > 0u ? mine : 1u; nx = cnt > 0u ? cnt : 1u;
}

__device__ __forceinline__ void xcd_barrier(const XcdBarrier& b) {
    asm volatile("s_waitcnt vmcnt(0)" ::: "memory");
    __syncthreads();
    if (threadIdx.x == 0) {
        unsigned* bar = b.bar;
        __builtin_amdgcn_s_waitcnt(0);
        unsigned nloc = b.st[0], nx = b.st[1];
        if (nloc == 0u) { xcd_barrier_complete(bar, b.x, nloc, nx); b.st[0] = nloc; b.st[1] = nx; }
        const unsigned old = xb_add(&bar[XB_XSUB(b.x)], 1u);
        const unsigned gen = old / nloc;
        if (old + 1u == (gen + 1u) * nloc) {
            __builtin_amdgcn_fence(__ATOMIC_RELEASE, "agent");
            asm volatile("s_waitcnt vmcnt(0)" ::: "memory");
            const unsigned og = xb_add(&bar[XB_TOP], 1u);
            const unsigned tg = og / nx;
            if (og + 1u == (tg + 1u) * nx) xb_add(&bar[XB_TOPGEN], 1u);
            else XB_SPIN(xb_ld(&bar[XB_TOPGEN]) == tg, bar);
            __builtin_amdgcn_fence(__ATOMIC_ACQUIRE, "agent");
            xb_add(&bar[XB_XGEN(b.x)], 1u);
            asm volatile("s_waitcnt vmcnt(0)" ::: "memory");
        } else {
            XB_SPIN(xb_ld(&bar[XB_XGEN(b.x)]) == gen, bar);
            __builtin_amdgcn_fence(__ATOMIC_ACQUIRE, "agent");
            asm volatile("s_waitcnt vmcnt(0)" ::: "memory");
        }
    }
    __syncthreads();
}

}
namespace cg = cooperative_groups;
constexpr int NSTEP = 12;
#ifndef CVH_GU
#define CVH_GU 1
#define CVH_DN 1
#endif
__global__ void __launch_bounds__(512, 2) mega(mk::P p_unused) {
    extern __shared__ __attribute__((aligned(16))) unsigned char lds_raw[];
    float* lds = (float*)lds_raw;
    LAS unsigned char* lds3 = (LAS unsigned char*)lds_raw;
    using namespace nv; using namespace mk;
    volatile LAS unsigned* bst = (volatile LAS unsigned*)(lds3 + E3_BYTES + 128);
    if (threadIdx.x < 2) bst[threadIdx.x] = 0u;
    __syncthreads();
    XcdBarrier bar;
    { const KP p = fresh_kp(); bar = xcd_barrier_post(WSP(unsigned, O_COUNTS + 16384), bst); }
    cg::this_grid().sync();
    for (int step = 0; step < 1 + NSTEP * L_; ++step) {
        const KP p = fresh_kp();
        const int l = (step - 1) / NSTEP, k = (step == 0) ? -1 : (step - 1) % NSTEP;
        const bool isg = (k == 0 || k == 1 || k == 6 || k == 9 || k == 10);
#ifdef PROBE_K
        const int nrep = (k == PROBE_K) ? PROBE_N : 1;
#else
        const int nrep = 1;
#endif
        for (int rep = 0; rep < nrep; ++rep) {
        int helpchunks = 0;
        if (isg) {
            const int kind = (k == 0) ? 0 : (k == 1) ? 4 : (k == 6) ? 1 : (k == 9) ? 2 : 3;
            GSched S; GEpi E; S.kind = kind; E.kind = kind; E.l = l;
            S.G = (int)gridDim.x; S.c = fbid(); S.meta = WSP(int, O_META); S.rowtok = WSP(int, O_ROWTOK); S.estep = 0;
            const char* A; int N, K = D_;
            if (kind == 0) { A = (const char*)WSP(bf16_t, O_XB); S.Bt = (const char*)(WSP(bf16_t, O_WTIN) + (size_t)l * NPAD * D_); N = NPAD; }
            else if (kind == 1) { A = (const char*)WSP(bf16_t, O_OB); S.Bt = (const char*)(WSP(bf16_t, O_WTOUT) + (size_t)l * D_ * D_); N = D_; }
            else if (kind == 2) { A = (const char*)WSP(bf16_t, O_X1B); S.Bt = (const char*)(WSP(bf16_t, O_WTGU) + (size_t)l * NE * 2048 * D_); S.estep = (size_t)2048 * D_ * 2; N = 2048; }
            else if (kind == 3) { A = (const char*)WSP(bf16_t, O_ACT); S.Bt = (const char*)(WSP(bf16_t, O_WTDN) + (size_t)l * NE * D_ * D_); S.estep = (size_t)D_ * D_ * 2; N = D_; }
            else { A = (const char*)WSP(bf16_t, O_PROJB); S.Bt = (const char*)(WSP(bf16_t, O_WT1) + (size_t)l * 2 * 256 * 2048); S.estep = (size_t)256 * 2048 * 2; N = 256; K = 2048; }
            S.nN = N / 256; S.nM = (kind < 2) ? T_ / 256 : (kind == 4) ? 16 : S.meta[32]; S.nunits = S.nM * S.nN;
            pg8::gemm_phase<GEpi, GSched>(lds3, A, K, S, E);
            if (l == 0 && kind >= 2 && kind <= 3 && S.G == 256) {
                const int mine = (S.nunits - S.c + 255) >> 8, most = (S.nunits + 255) >> 8;
                if (mine < most) helpchunks = (kind == 2) ? CVH_GU : CVH_DN; }
            if (kind == 4) { ph_cumsum(lds, p, 16); ph_sb_early(lds3, p); }
            if (kind == 0) ph_bias1_reduce(p, l);
        } else {
            switch (k) {
                case -1: ph_convert(lds3, p); break;
                case 2: ph_prep2(p, l); break;
#ifdef PROBE_AMODE
                case 3: if (rep == 0) ph_attn1<30>(lds, lds3, p, WSP(unsigned, O_COUNTS) + 128 + l * 8 + rep, WSP(bf16_t, O_O), WSP(bf16_t, O_OWIN), WSP(unsigned, O_COUNTS) + 192 + l * 8);
                        else ph_attn1<PROBE_AMODE>(lds, lds3, p, WSP(unsigned, O_COUNTS) + 128 + l * 8 + rep, WSP(bf16_t, O_O), WSP(bf16_t, O_OWIN), WSP(unsigned, O_COUNTS) + 192 + l * 8);
                        break;
#else
                case 3: ph_attn1<30>(lds, lds3, p, WSP(unsigned, O_COUNTS) + 128 + l * 8 + rep, WSP(bf16_t, O_O), WSP(bf16_t, O_OWIN), WSP(unsigned, O_COUNTS) + 192 + l * 8); break;
#endif
                case 4: ph_attn_sel2<true>(lds3, p, WSP(bf16_t, O_O), WSP(bf16_t, O_OCMP), 512); break;
                case 5: ph_rmsnorm(p, l); break;
                case 7: ph_ln<true>(lds, p, l, WSP(float, O_X1), (rep + 1 < nrep) ? 2048 * (rep + 1) : 0); break;
                case 8: ph_moe_scatter2(lds, p, l); break;
                default: { if (l == 0) helpchunks = 1 << 20;
                           float* xout = (l == L_ - 1) ? p->out : WSP(float, O_XA); ph_ln<false>(lds, p, l, xout); } break;
            }
        }
        if (helpchunks > 0) cv_help(lds3, fresh_kp(), helpchunks);
        xcd_barrier(bar);
        }
    }
#ifdef PROBE_SYNC
    for (int i = 0; i < PROBE_SYNC; ++i) xcd_barrier(bar);
#endif
}

extern "C" void kernel_launch(void* const* d_in, const int* in_sizes, int n_in,
                              void* d_out, int out_size, void* d_ws, size_t ws_size,
                              hipStream_t stream) {
    constexpr size_t kDynLds = 147456 + 1024;
    static int grid_blocks = 0;
    if (!grid_blocks) {
        int dev = 0, cus = 0, per_cu = 0;
        (void)hipGetDevice(&dev);
        (void)hipDeviceGetAttribute(&cus, hipDeviceAttributeMultiprocessorCount, dev);
        (void)hipFuncSetAttribute((const void*)mega, hipFuncAttributeMaxDynamicSharedMemorySize, (int)kDynLds);
        (void)hipOccupancyMaxActiveBlocksPerMultiprocessor(&per_cu, mega, 512, kDynLds);
        if (per_cu < 1) per_cu = 1;
        if (per_cu > 1) per_cu = 1;
        grid_blocks = cus * per_cu;
        if (ws_size < mk::O_END) fprintf(stderr, "workspace too small: %zu < %zu\n", ws_size, (size_t)mk::O_END);
    }
    mk::P p{};
    p.in = nv::inputs(d_in); p.ws = (unsigned char*)d_ws; p.out = (float*)d_out;
    (void)hipMemsetAsync((char*)d_ws + mk::O_COUNTS, 0, 65536, stream);
    void* args[] = {&p};
    hipError_t e = hipLaunchCooperativeKernel((void*)mega, dim3(grid_blocks), dim3(512), args, kDynLds, stream);
    if (e != hipSuccess) fprintf(stderr, "cooperative launch failed: %s (grid %d)\n", hipGetErrorString(e), grid_blocks);
}
```

```cpp
#include <hip/hip_runtime.h>
#include <hip/hip_cooperative_groups.h>
#include <cstdio>
#include <cstdint>

namespace nv {

constexpr int B_ = 2, S_ = 8192, D_ = 1024, T_ = B_ * S_, L_ = 2;
constexpr int DIN = 2844;
constexpr int OFF_NSA_KV = 512, OFF_NSA_GATE = 1280, OFF_FOX_QKV = 1304, OFF_FOX_F = 2072, OFF_SB_QKV = 2076;
constexpr int NCMP = 511, NBLK = 128, NSEL = 16;
constexpr int NE = 32, TOPK = 4, MROWS = T_ * TOPK;
constexpr float LN_EPS = 1e-5f, RMS_EPS = 1e-6f;
constexpr float ALPHA = 1.4142135623730951f;
constexpr float SCALE = 0.125f;

__device__ __forceinline__ float sigmoidf_(float x) { return 1.f / (1.f + __expf(-x)); }
__device__ __forceinline__ float logsig(float x) { return fminf(x, 0.f) - log1pf(expf(-fabsf(x))); }

__device__ __forceinline__ float gelu_tanh(float x) { return 0.5f * x * (1.f + tanhf(0.7978845608028654f * (x + 0.044715f * x * x * x))); }
__device__ __forceinline__ float wsum(float v) {
#pragma unroll
    for (int o = 1; o < 64; o <<= 1) v += __shfl_xor(v, o);
    return v;
}
struct In {
    const float *x, *w_in, *b_in, *pos_k, *pos_v, *w1k, *w2k, *w1v, *w2v, *g_out, *w_out, *ln1_g, *ln1_b, *rw, *rb, *wgu, *bgu, *wdn, *bdn, *ln2_g, *ln2_b;
};
inline In inputs(void* const* d) {
    In i; i.x = (const float*)d[0]; i.w_in = (const float*)d[1]; i.b_in = (const float*)d[2]; i.pos_k = (const float*)d[3]; i.pos_v = (const float*)d[4];
    i.w1k = (const float*)d[5]; i.w2k = (const float*)d[6]; i.w1v = (const float*)d[7]; i.w2v = (const float*)d[8]; i.g_out = (const float*)d[9]; i.w_out = (const float*)d[10];
    i.ln1_g = (const float*)d[11]; i.ln1_b = (const float*)d[12]; i.rw = (const float*)d[13]; i.rb = (const float*)d[14]; i.wgu = (const float*)d[15]; i.bgu = (const float*)d[16];
    i.wdn = (const float*)d[17]; i.bdn = (const float*)d[18]; i.ln2_g = (const float*)d[19]; i.ln2_b = (const float*)d[20]; return i;
}


}
namespace pg8 {
#define PG8_LAS __attribute__((address_space(3)))
typedef unsigned short bf16_t;
typedef short bf16x8 __attribute__((ext_vector_type(8)));
typedef float f32x4 __attribute__((ext_vector_type(4)));
typedef unsigned u32x4 __attribute__((ext_vector_type(4)));
constexpr int BM = 256, BK = 64, HALF = 128, HTB = HALF * BK * 2  , STAGE_BYTES = 8 * HTB, NXCD = 8, WGM = 8;

__host__ __device__ __forceinline__ int lds_byte(int r, int c) { const int st = (r >> 4) * 2 + (c >> 5), rr = r & 15, cc = c & 31, ob = rr * 64 + cc * 2; return st * 1024 + (ob ^ (((ob >> 9) & 1) << 5)); }
__host__ __device__ __forceinline__ void stage_rc(int b, int& R, int& C) { const int st = b / 1024, sb = b % 1024, swz = sb ^ (((sb >> 9) & 1) << 5); R = (st >> 1) * 16 + swz / 64; C = (st & 1) * 32 + (swz % 64) / 2; }
__host__ __device__ __forceinline__ int perm32(int rho) { const int n = rho >> 4, i = rho & 15; return 8 * (i >> 2) + 4 * n + (i & 3); }

struct Unit { int pm, pn, e, nr; };

__device__ __forceinline__ unsigned cvt_pk_bf16(float lo, float hi) { unsigned r; asm volatile("v_cvt_pk_bf16_f32 %0, %1, %2" : "=v"(r) : "v"(lo), "v"(hi)); return r; }
template <class Epi, class Sched, bool ALIGN_EPI = true, bool SP2 = true>
__device__ __forceinline__ void gemm_phase(PG8_LAS unsigned char* lds, const char* Abase, const int K, const Sched& S, const Epi& E) {
    int tid_ = threadIdx.x; asm volatile("" : "+v"(tid_));
    const int tid = tid_, wid = __builtin_amdgcn_readfirstlane(tid >> 6), lane = tid & 63, wr = wid >> 2, wc = wid & 3, fr = lane & 15, fq = lane >> 4;
    const int nt = K / BK;
    unsigned voffB[2];
#pragma unroll
    for (int i = 0; i < 2; ++i) { int R, C; stage_rc(tid * 16 + i * 8192, R, C); const int Rb = Epi::PERM ? ((R & ~31) + perm32(R & 31)) : R;
        voffB[i] = (unsigned)(Rb * K + C) * 2u; }
#define PG8_AOFF(u, o0, o1) do { int _t = tid; asm volatile("" : "+v"(_t)); _Pragma("unroll") for (int _i = 0; _i < 2; ++_i) { int _R, _C; stage_rc(_t * 16 + _i * 8192, _R, _C); \
        (o0)[_i] = S.a_off((u), _R) + (unsigned)_C * 2u; (o1)[_i] = S.a_off((u), HALF + _R) + (unsigned)_C * 2u; } } while (0)
    const size_t kstep = (size_t)(BK * 2);
    const size_t akstep = S.a_kstep();
    const size_t hstep = (size_t)HALF * K * 2;
    const unsigned ldsw = (unsigned)wid * 1024u;
    const int aoff = lds_byte(wr * 64 + fr, fq * 8), boff = lds_byte(wc * 32 + fr, fq * 8);
#define PG8_SA(b, h) (((b) * 2 + (h)) * HTB)
#define PG8_SB(b, h) ((4 + (b) * 2 + (h)) * HTB)
#define PG8_STAGE(bufoff, gbase, voff) do { _Pragma("unroll") for (int _i = 0; _i < 2; ++_i) { unsigned _o = (voff)[_i]; asm volatile("" : "+v"(_o));     \
        __builtin_amdgcn_global_load_lds((const unsigned*)((const char*)(gbase) + _o), (PG8_LAS unsigned*)(lds + (bufoff) + ldsw + _i * 8192), 16, 0, 0); } } while (0)
#define PG8_LDA(dst, b, h) do { _Pragma("unroll") for (int m = 0; m < 4; ++m) _Pragma("unroll") for (int k = 0; k < 2; ++k) dst[m][k] = *(const PG8_LAS bf16x8*)(lds + PG8_SA(b, h) + aoff + m * 2048 + k * 1024); } while (0)
#define PG8_LDB(dst, b, h) do { _Pragma("unroll") for (int n = 0; n < 2; ++n) _Pragma("unroll") for (int k = 0; k < 2; ++k) dst[n][k] = *(const PG8_LAS bf16x8*)(lds + PG8_SB(b, h) + boff + n * 2048 + k * 1024); } while (0)
#define PG8_MMA(ai, bj, At, Bt) do { __builtin_amdgcn_s_setprio(1); _Pragma("unroll") for (int m = 0; m < 4; ++m) _Pragma("unroll") for (int n = 0; n < 2; ++n) _Pragma("unroll") for (int k = 0; k < 2; ++k) \
        acc[ai][bj][m][n] = __builtin_amdgcn_mfma_f32_16x16x32_bf16(Bt[n][k], At[m][k], acc[ai][bj][m][n], 0, 0, 0); __builtin_amdgcn_s_setprio(0); } while (0)
#define PG8_WAIT_V(n) asm volatile("s_waitcnt vmcnt(" #n ")" ::: "memory")
#define PG8_WAIT_L(n) asm volatile("s_waitcnt lgkmcnt(" #n ")" ::: "memory")
#define PG8_BAR __builtin_amdgcn_s_barrier()
#define PG8_SCHED __builtin_amdgcn_sched_barrier(0)
    Unit cur, nxt; int ui = 0;
    if (!S.next(0, cur)) return;
    f32x4 acc[2][2][4][2];
    float zf_ = 0.f; asm volatile("" : "+v"(zf_));
#pragma unroll
    for (int a = 0; a < 2; ++a)
#pragma unroll
        for (int b = 0; b < 2; ++b)
#pragma unroll
            for (int m = 0; m < 4; ++m)
#pragma unroll
                for (int n = 0; n < 2; ++n) acc[a][b][m][n] = (f32x4){zf_, zf_, zf_, zf_};
    bf16x8 At[4][2], B0[2][2], B1[2][2];
    unsigned ca0[2], ca1[2], na0[2], na1[2];
    PG8_AOFF(cur, ca0, ca1);
    const char* const cA = Abase; const char* cB = S.b_base(cur);
    if constexpr (SP2) {
        PG8_STAGE(PG8_SB(0, 0), cB, voffB); PG8_STAGE(PG8_SB(0, 1), cB + hstep, voffB); PG8_STAGE(PG8_SA(0, 0), cA, ca0); PG8_STAGE(PG8_SA(0, 1), cA, ca1);
        if (wr == 1) PG8_BAR;
        PG8_WAIT_V(2); PG8_BAR;
        PG8_STAGE(PG8_SB(1, 0), cB + kstep, voffB); PG8_STAGE(PG8_SA(1, 0), cA + akstep, ca0); PG8_STAGE(PG8_SB(1, 1), cB + hstep + kstep, voffB);
        PG8_WAIT_V(6); PG8_BAR;
    } else { static_assert(SP2, "only the SP2 loop is kept"); }
    for (;;) {
        const bool has_next = S.next(ui + 1, nxt);
        const char* nB = has_next ? S.b_base(nxt) : cB;
        if (has_next) { PG8_AOFF(nxt, na0, na1); } else { na0[0] = ca0[0]; na0[1] = ca0[1]; na1[0] = ca1[0]; na1[1] = ca1[1]; }
        for (int t = 0; t < nt - 2; t += 2) {
            const char* a1 = cA + (size_t)(t + 1) * akstep;
            const char* a2 = cA + (size_t)(t + 2) * akstep; const char* b2 = cB + (size_t)(t + 2) * kstep;
            const char* a3 = a2 + akstep; const char* b3 = b2 + kstep;
            PG8_LDB(B0, 0, 0); PG8_LDB(B1, 0, 1); PG8_SCHED; PG8_LDA(At, 0, 0); PG8_STAGE(PG8_SA(1, 1), a1, ca1);
            PG8_WAIT_V(8); PG8_WAIT_L(0); PG8_BAR; PG8_MMA(0, 0, At, B0); PG8_MMA(0, 1, At, B1); PG8_BAR; PG8_SCHED;
            PG8_LDA(At, 0, 1); PG8_STAGE(PG8_SB(0, 0), b2, voffB); PG8_STAGE(PG8_SB(0, 1), b2 + hstep, voffB); PG8_STAGE(PG8_SA(0, 0), a2, ca0);
            PG8_WAIT_V(8); PG8_WAIT_L(0); PG8_BAR; PG8_MMA(1, 0, At, B0); PG8_MMA(1, 1, At, B1); PG8_BAR; PG8_SCHED;
            PG8_LDB(B0, 1, 0); PG8_LDB(B1, 1, 1); PG8_SCHED; PG8_LDA(At, 1, 0); PG8_STAGE(PG8_SA(0, 1), a2, ca1);
            PG8_WAIT_V(8); PG8_WAIT_L(0); PG8_BAR; PG8_MMA(0, 0, At, B0); PG8_MMA(0, 1, At, B1); PG8_BAR; PG8_SCHED;
            PG8_LDA(At, 1, 1); PG8_STAGE(PG8_SB(1, 0), b3, voffB); PG8_STAGE(PG8_SB(1, 1), b3 + hstep, voffB); PG8_STAGE(PG8_SA(1, 0), a3, ca0);
            PG8_WAIT_V(8); PG8_WAIT_L(0); PG8_BAR; PG8_MMA(1, 0, At, B0); PG8_MMA(1, 1, At, B1); PG8_BAR; PG8_SCHED;
        }
        {
            const char* a1 = cA + (size_t)(nt - 1) * akstep;
            const char* a2 = cA; const char* b2 = nB; const char* a3 = a2 + akstep; const char* b3 = b2 + kstep;
            PG8_LDB(B0, 0, 0); PG8_LDB(B1, 0, 1); PG8_SCHED; PG8_LDA(At, 0, 0); PG8_STAGE(PG8_SA(1, 1), a1, ca1);
            PG8_WAIT_V(8); PG8_WAIT_L(0); PG8_BAR; PG8_MMA(0, 0, At, B0); PG8_MMA(0, 1, At, B1); PG8_BAR; PG8_SCHED;
            PG8_LDA(At, 0, 1); PG8_STAGE(PG8_SB(0, 0), b2, voffB); PG8_STAGE(PG8_SB(0, 1), b2 + hstep, voffB); PG8_STAGE(PG8_SA(0, 0), a2, na0);
            PG8_WAIT_V(8); PG8_WAIT_L(0); PG8_BAR; PG8_MMA(1, 0, At, B0); PG8_MMA(1, 1, At, B1); PG8_BAR; PG8_SCHED;
            PG8_LDB(B0, 1, 0); PG8_LDB(B1, 1, 1); PG8_SCHED; PG8_LDA(At, 1, 0); PG8_STAGE(PG8_SA(0, 1), a2, na1);
            PG8_WAIT_V(8); PG8_WAIT_L(0); PG8_BAR; PG8_MMA(0, 0, At, B0); PG8_MMA(0, 1, At, B1); PG8_BAR; PG8_SCHED;
            PG8_LDA(At, 1, 1); PG8_STAGE(PG8_SB(1, 0), b3, voffB); PG8_STAGE(PG8_SB(1, 1), b3 + hstep, voffB); PG8_STAGE(PG8_SA(1, 0), a3, na0);
            PG8_WAIT_V(8); PG8_WAIT_L(0); PG8_BAR; PG8_MMA(1, 0, At, B0); PG8_MMA(1, 1, At, B1); PG8_BAR; PG8_SCHED;
        }
        if constexpr (ALIGN_EPI) { if (wr == 0) PG8_BAR; }
        E(acc, cur, wr, wc, fr, fq);
        if (!has_next) break;
#pragma unroll
        for (int a = 0; a < 2; ++a)
#pragma unroll
            for (int b = 0; b < 2; ++b)
#pragma unroll
                for (int m = 0; m < 4; ++m)
#pragma unroll
                    for (int n = 0; n < 2; ++n) acc[a][b][m][n] = (f32x4){zf_, zf_, zf_, zf_};
        cur = nxt; cB = nB; ++ui; ca0[0] = na0[0]; ca0[1] = na0[1]; ca1[0] = na1[0]; ca1[1] = na1[1];
        if constexpr (ALIGN_EPI) { if (wr == 1) PG8_BAR; }
    }
    PG8_WAIT_V(0);
    if constexpr (!ALIGN_EPI) { if (wr == 0) PG8_BAR; }
    PG8_BAR;
#undef PG8_AOFF
#undef PG8_SA
#undef PG8_SB
#undef PG8_STAGE
#undef PG8_LDA
#undef PG8_LDB
#undef PG8_MMA
#undef PG8_WAIT_V
#undef PG8_WAIT_L
#undef PG8_BAR
#undef PG8_SCHED
}

}
namespace mk {
using namespace nv;
typedef unsigned short bf16_t;
typedef unsigned u32x4 __attribute__((ext_vector_type(4)));
typedef float f32x4 __attribute__((ext_vector_type(4)));
#define LAS __attribute__((address_space(3)))
constexpr int NT = 512;
constexpr int PB = 2816;
constexpr int NPAD = 3072;
constexpr int C_KV = 512, C_FOX = 1280, C_SB = 2048, C_GATE = 2816;
constexpr int MAXT = MROWS / 256 + NE;
constexpr int PROWS = MAXT * 256;
#define CNT_IDX(l, e) (8192 + ((l) * NE + (e)) * 32)
__device__ __forceinline__ int ftid() { int t = threadIdx.x; asm volatile("" : "+v"(t)); return t; }
__device__ __forceinline__ int fbid() { int b = blockIdx.x; asm volatile("" : "+s"(b)); return b; }
#define MK_LOOP(vb, n) for (int vb = fbid(); vb < (n); vb += gridDim.x)

constexpr size_t al_(size_t x) { return (x + 4095) & ~(size_t)4095; }
constexpr size_t O_WTIN = 0;
constexpr size_t O_WTOUT = O_WTIN + al_((size_t)L_ * NPAD * D_ * 2);
constexpr size_t O_WTGU = O_WTOUT + al_((size_t)L_ * D_ * D_ * 2);
constexpr size_t O_WTDN = O_WTGU + al_((size_t)L_ * NE * 2048 * D_ * 2);
constexpr size_t O_BIASP = O_WTDN + al_((size_t)L_ * NE * D_ * D_ * 2);
constexpr size_t O_XB = O_BIASP + al_((size_t)L_ * NPAD * 4);
constexpr size_t O_PROJB = O_XB + al_((size_t)T_ * D_ * 2);
constexpr size_t O_GF = O_PROJB + al_((size_t)T_ * PB * 2);
constexpr size_t O_CFOX = O_GF + al_((size_t)T_ * 32 * 4);
constexpr size_t O_KCMP = O_CFOX + al_((size_t)B_ * 4 * S_ * 4);
constexpr size_t O_VCMP = O_KCMP + al_((size_t)B_ * 2 * 512 * 64 * 4);
constexpr size_t O_O = O_VCMP + al_((size_t)B_ * 2 * 512 * 64 * 4);
constexpr size_t O_OB = O_O + al_((size_t)T_ * D_ * 4);
constexpr size_t O_PTOT = O_OB + al_((size_t)T_ * D_ * 2);
constexpr size_t O_SEL = O_PTOT + al_((size_t)B_ * 2 * S_ * 512 * 4);
constexpr size_t O_MIX = O_SEL + al_((size_t)B_ * 2 * S_ * NSEL * 4);
constexpr size_t O_X1 = O_MIX + al_((size_t)T_ * D_ * 4);
constexpr size_t O_X1B = O_X1 + al_((size_t)T_ * D_ * 4);
constexpr size_t O_XA = O_X1B + al_((size_t)T_ * D_ * 2);
constexpr size_t O_ACT = O_XA + al_((size_t)T_ * D_ * 4);
constexpr size_t O_Y = O_ACT + al_((size_t)PROWS * D_ * 2);
constexpr size_t O_TOPE = O_Y + al_((size_t)PROWS * D_ * 2);
constexpr size_t O_TOPW = O_TOPE + al_((size_t)MROWS * 4);
constexpr size_t O_POS = O_TOPW + al_((size_t)MROWS * 4);
constexpr size_t O_ROWTOK = O_POS + al_((size_t)MROWS * 4);
constexpr size_t O_ROWW = O_ROWTOK + al_((size_t)PROWS * 4);
constexpr size_t O_SLOT = O_ROWW + al_((size_t)PROWS * 4);
constexpr size_t O_COUNTS = O_SLOT + al_((size_t)MROWS * 4);
constexpr size_t O_META = O_COUNTS + 65536;
constexpr size_t O_OWIN = O_META + 4096;
constexpr size_t O_O2 = O_OWIN + al_((size_t)T_ * 512 * 4);
constexpr size_t O_OWIN2 = O_O2 + al_((size_t)T_ * D_ * 4);
constexpr size_t O_KCMPB = O_OWIN2 + al_((size_t)T_ * 512 * 4);
constexpr size_t O_VCMPB = O_KCMPB + al_((size_t)B_ * 2 * 512 * 64 * 2);
constexpr size_t O_OCMP = O_VCMPB + al_((size_t)B_ * 2 * 512 * 64 * 2);
constexpr size_t O_SELMASK = O_OCMP + al_((size_t)T_ * 512 * 4);
constexpr size_t O_WT1 = O_SELMASK + al_((size_t)B_ * 2 * S_ * 16);
constexpr size_t O_BIAS1 = O_WT1 + al_((size_t)L_ * 2 * 256 * 2048 * 2);
constexpr size_t O_HID = O_BIAS1 + al_((size_t)L_ * 2 * 128 * 4);
constexpr size_t O_BIAS1P = O_HID + al_((size_t)8 * 512 * 128 * 2);
constexpr size_t O_END = O_BIAS1P + al_((size_t)L_ * 2 * 64 * 128 * 4);

struct P {
    In in; unsigned char* ws; float* out;
};
typedef const __attribute__((address_space(4))) P* KP;
__device__ __forceinline__ KP fresh_kp() { KP k = (KP)__builtin_amdgcn_kernarg_segment_ptr(); asm volatile("" : "+s"(k)); return k; }
#define WSP(T, off) ((T*)(p->ws + (off)))

__device__ __forceinline__ float bf2f(unsigned short b) { return __uint_as_float((unsigned)b << 16); }
__device__ __forceinline__ unsigned f2bf(float f) { unsigned u = __float_as_uint(f); return (u + 0x7fffu + ((u >> 16) & 1u)) >> 16; }
__device__ __forceinline__ unsigned pk2(float lo, float hi) { return f2bf(lo) | (f2bf(hi) << 16); }
__device__ __forceinline__ void ld8(const bf16_t* __restrict__ src, float* dst) {
    const u32x4 v = *(const u32x4*)src;
    dst[0] = __uint_as_float(v.x << 16); dst[1] = __uint_as_float(v.x & 0xffff0000u); dst[2] = __uint_as_float(v.y << 16); dst[3] = __uint_as_float(v.y & 0xffff0000u);
    dst[4] = __uint_as_float(v.z << 16); dst[5] = __uint_as_float(v.z & 0xffff0000u); dst[6] = __uint_as_float(v.w << 16); dst[7] = __uint_as_float(v.w & 0xffff0000u);
}


__device__ __forceinline__ int perm_in(int n) {
    if (n < 1280) return n;
    if (n < 1304) return C_GATE + (n - 1280);
    if (n < 2072) return C_FOX + (n - 1304);
    if (n < 2076) return C_GATE + 24 + (n - 2072);
    return C_SB + (n - 2076);
}
__device__ __forceinline__ int perm_gu(int n) { const int up = n >> 10, c = n & 1023; return 256 * (c >> 7) + 128 * up + (c & 127); }
template <int MAP>
__device__ __forceinline__ void transpose_item(const float* __restrict__ W, int K, int N, bf16_t* __restrict__ WT, LAS float* scr, int item, int lane) {
    const int nblk = (N + 31) / 32, kb = item / nblk, nb = item % nblk, k0 = 64 * kb, n0 = 32 * nb;
    { const int n4 = (lane & 7) * 4; const bool okn = (n0 + n4) < N;
      f32x4 t[8];
#pragma unroll
      for (int i = 0; i < 8; ++i) { const int kk = (lane >> 3) + 8 * i; t[i] = okn ? *(const f32x4*)(W + (size_t)(k0 + kk) * N + n0 + n4) : (f32x4){0.f, 0.f, 0.f, 0.f}; }
#pragma unroll
      for (int i = 0; i < 8; ++i) { const int kk = (lane >> 3) + 8 * i; LAS float* d = scr + kk * 33 + n4; d[0] = t[i].x; d[1] = t[i].y; d[2] = t[i].z; d[3] = t[i].w; } }
    asm volatile("s_waitcnt lgkmcnt(0)" ::: "memory");
    const int c = lane & 7;
#pragma unroll
    for (int j = 0; j < 4; ++j) { const int n = (lane >> 3) + 8 * j; const LAS float* sp = scr + (8 * c) * 33 + n;
        u32x4 o; o.x = pk2(sp[0 * 33], sp[1 * 33]); o.y = pk2(sp[2 * 33], sp[3 * 33]); o.z = pk2(sp[4 * 33], sp[5 * 33]); o.w = pk2(sp[6 * 33], sp[7 * 33]);
        const int ng = n0 + n;
        if (ng < N) { const int ro = (MAP == 1) ? perm_in(ng) : (MAP == 2) ? perm_gu(ng) : ng; *(u32x4*)(WT + (size_t)ro * K + k0 + 8 * c) = o; } }
    asm volatile("s_waitcnt lgkmcnt(0)" ::: "memory");
}
constexpr int CV_I_IN = 16 * 89, CV_I_OUT = 16 * 32, CV_I_GU = 16 * 64, CV_I_DN = 16 * 32, CV_I_W1 = 32 * 4;
constexpr int CV_N_IN = L_ * CV_I_IN, CV_N_OUT = L_ * CV_I_OUT, CV_N_GU = L_ * NE * CV_I_GU, CV_N_DN = L_ * NE * CV_I_DN, CV_N_W1 = L_ * 2 * CV_I_W1, CV_N_ALL = CV_N_IN + CV_N_OUT + CV_N_GU + CV_N_DN + CV_N_W1;
constexpr int CV_DEF_GU0 = CV_N_W1 + NE * CV_I_GU, CV_DEF_GU = NE * CV_I_GU, CV_DEF_DN0 = CV_N_W1 + CV_N_GU + NE * CV_I_DN, CV_DEF_DN = NE * CV_I_DN, CV_DEF_ALL = CV_DEF_GU + CV_DEF_DN;
__device__ __forceinline__ void cv_one(KP p, LAS float* scr, int it, int lane) {
    int r = it;
    if (r < CV_N_W1) { const int mtx = r / CV_I_W1, ll = mtx >> 1, kv = mtx & 1; transpose_item<0>((kv ? p->in.w1v : p->in.w1k) + (size_t)ll * 2048 * 128, 2048, 128, WSP(bf16_t, O_WT1) + (size_t)mtx * 256 * 2048, scr, r % CV_I_W1, lane); return; } r -= CV_N_W1;
    if (r < CV_N_GU) { const int mtx = r / CV_I_GU; transpose_item<2>(p->in.wgu + (size_t)mtx * D_ * 2048, D_, 2048, WSP(bf16_t, O_WTGU) + (size_t)mtx * 2048 * D_, scr, r % CV_I_GU, lane); return; } r -= CV_N_GU;
    if (r < CV_N_DN) { const int mtx = r / CV_I_DN; transpose_item<0>(p->in.wdn + (size_t)mtx * D_ * D_, D_, D_, WSP(bf16_t, O_WTDN) + (size_t)mtx * D_ * D_, scr, r % CV_I_DN, lane); return; } r -= CV_N_DN;
    if (r < CV_N_IN) { const int mtx = r / CV_I_IN; transpose_item<1>(p->in.w_in + (size_t)mtx * D_ * DIN, D_, DIN, WSP(bf16_t, O_WTIN) + (size_t)mtx * NPAD * D_, scr, r % CV_I_IN, lane); return; } r -= CV_N_IN;
    { const int mtx = r / CV_I_OUT; transpose_item<0>(p->in.w_out + (size_t)mtx * D_ * D_, D_, D_, WSP(bf16_t, O_WTOUT) + (size_t)mtx * D_ * D_, scr, r % CV_I_OUT, lane); }
}
__device__ __forceinline__ void cv_help(LAS unsigned char* lds, KP p, int maxchunks) {
    const int tid = ftid(), lane = tid & 63, wv = tid >> 6; LAS float* scr = (LAS float*)(lds + wv * 8448);
    unsigned* cursor = WSP(unsigned, O_COUNTS) + 64;
    for (int c = 0; c < maxchunks; ++c) {
        unsigned base = 0u; if (lane == 0) base = atomicAdd(cursor, 8u);
        base = (unsigned)__builtin_amdgcn_readfirstlane((int)base);
        if (base >= (unsigned)CV_DEF_ALL) break;
        for (int i = 0; i < 8; ++i) { const int d = (int)base + i; if (d < CV_DEF_ALL) cv_one(p, scr, d < CV_DEF_GU ? CV_DEF_GU0 + d : CV_DEF_DN0 + (d - CV_DEF_GU), lane); }
    }
}
__device__ __forceinline__ void ph_convert(LAS unsigned char* lds, KP p) {
    const int tid = ftid(), lane = tid & 63, wv = tid >> 6;
    LAS float* scr = (LAS float*)(lds + wv * 8448);
    const int gw = fbid() * 8 + wv, NGW = gridDim.x * 8;
    for (int it = gw; it < CV_N_ALL; it += NGW) {
        if ((it >= CV_DEF_GU0 && it < CV_DEF_GU0 + CV_DEF_GU) || (it >= CV_DEF_DN0 && it < CV_DEF_DN0 + CV_DEF_DN)) continue;
        cv_one(p, scr, it, lane);
    }
    const int gt = fbid() * NT + tid, NG = gridDim.x * NT;
    for (int i = gt; i < L_ * (NPAD - DIN) * (D_ / 8); i += NG) { const int l = i / ((NPAD - DIN) * (D_ / 8)), r = i % ((NPAD - DIN) * (D_ / 8));
        unsigned z_ = 0u; asm volatile("" : "+v"(z_));
        *(u32x4*)(WSP(bf16_t, O_WTIN) + ((size_t)l * NPAD + DIN) * D_ + (size_t)r * 8) = (u32x4){z_, z_, z_, z_}; }
    for (int i = gt; i < L_ * 2 * 128 * (2048 / 8); i += NG) { const int mtx = i / (128 * 256), r = i % (128 * 256); unsigned z_ = 0u; asm volatile("" : "+v"(z_));
        *(u32x4*)(WSP(bf16_t, O_WT1) + ((size_t)mtx * 256 + 128) * 2048 + (size_t)r * 8) = (u32x4){z_, z_, z_, z_}; }
    for (int i = gt; i < L_ * 2 * 64 * 128; i += NG) { const int j = i & 127, seg = (i >> 7) & 63, mtx = i >> 13, ll = mtx >> 1, kv = mtx & 1;
        const float* pos = (kv ? p->in.pos_v : p->in.pos_k) + (size_t)ll * 2048 + seg * 32; const float* w1 = (kv ? p->in.w1v : p->in.w1k) + (size_t)ll * 2048 * 128 + (size_t)seg * 32 * 128; float a = 0.f;
#pragma unroll 8
        for (int k = 0; k < 32; ++k) a += pos[k] * w1[(size_t)k * 128 + j];
        WSP(float, O_BIAS1P)[i] = a; }
    for (int i = gt; i < L_ * NPAD; i += NG) { const int l = i / NPAD, c = i % NPAD; if (c >= DIN) WSP(float, O_BIASP)[i] = 0.f; }
    for (int i = gt; i < L_ * DIN; i += NG) { const int l = i / DIN, n = i % DIN; WSP(float, O_BIASP)[l * NPAD + perm_in(n)] = p->in.b_in[i]; }
    for (int i = gt; i < T_ * D_ / 8; i += NG) { const f32x4 a = *(const f32x4*)(p->in.x + (size_t)i * 8), b = *(const f32x4*)(p->in.x + (size_t)i * 8 + 4);
        *(u32x4*)(WSP(bf16_t, O_XB) + (size_t)i * 8) = (u32x4){pk2(a.x, a.y), pk2(a.z, a.w), pk2(b.x, b.y), pk2(b.z, b.w)}; }
}

struct EpiProj {
    static constexpr bool PERM = true;
    bf16_t* projb; float* gf; const float* bias;
    __device__ __forceinline__ void operator()(const pg8::f32x4 (&acc)[2][2][4][2], const pg8::Unit& u, int wr, int wc, int fr, int fq) const {
        const int row0 = u.pm * 256 + wr * 64 + fr, col0 = u.pn * 256 + wc * 32 + 8 * fq;
        if (u.pn < 11) {
#pragma unroll
            for (int ai = 0; ai < 2; ++ai)
#pragma unroll
                for (int m = 0; m < 4; ++m) { bf16_t* rowp = projb + (size_t)(row0 + ai * 128 + m * 16) * PB + col0;
#pragma unroll
                    for (int bj = 0; bj < 2; ++bj) { const f32x4 v0 = acc[ai][bj][m][0] + *(const f32x4*)(bias + col0 + bj * 128), v1 = acc[ai][bj][m][1] + *(const f32x4*)(bias + col0 + bj * 128 + 4);
                        u32x4 w; w.x = pg8::cvt_pk_bf16(v0[0], v0[1]); w.y = pg8::cvt_pk_bf16(v0[2], v0[3]); w.z = pg8::cvt_pk_bf16(v1[0], v1[1]); w.w = pg8::cvt_pk_bf16(v1[2], v1[3]);
                        *(u32x4*)(rowp + bj * 128) = w; }
                    asm volatile("" ::: "memory"); }
        } else if (wc == 0) {
            const f32x4 b0 = *(const f32x4*)(bias + col0), b1 = *(const f32x4*)(bias + col0 + 4);
#pragma unroll
            for (int ai = 0; ai < 2; ++ai)
#pragma unroll
                for (int m = 0; m < 4; ++m) { float* rowp = gf + (size_t)(row0 + ai * 128 + m * 16) * 32 + 8 * fq;
                    const f32x4 v0 = acc[ai][0][m][0] + b0, v1 = acc[ai][0][m][1] + b1; f32x4 o0, o1;
#pragma unroll
                    for (int i = 0; i < 4; ++i) { const int j0 = 8 * fq + i, j1 = j0 + 4;
                        o0[i] = (j0 < 24) ? sigmoidf_(v0[i]) : (j0 < 28 ? logsig(v0[i]) : 0.f); o1[i] = (j1 < 24) ? sigmoidf_(v1[i]) : (j1 < 28 ? logsig(v1[i]) : 0.f); }
                    *(f32x4*)rowp = o0; *(f32x4*)(rowp + 4) = o1; }
        }
    }
};
struct EpiOut {
    static constexpr bool PERM = true;
    const float* x; float* y1;
    __device__ __forceinline__ void operator()(const pg8::f32x4 (&acc)[2][2][4][2], const pg8::Unit& u, int wr, int wc, int fr, int fq) const {
        const int row0 = u.pm * 256 + wr * 64 + fr, col0 = u.pn * 256 + wc * 32 + 8 * fq;
#pragma unroll
        for (int ai = 0; ai < 2; ++ai)
#pragma unroll
            for (int m = 0; m < 4; ++m) { const size_t off = (size_t)(row0 + ai * 128 + m * 16) * D_ + col0;
#pragma unroll
                for (int bj = 0; bj < 2; ++bj) { const f32x4 x0 = *(const f32x4*)(x + off + bj * 128), x1 = *(const f32x4*)(x + off + bj * 128 + 4);
                    *(f32x4*)(y1 + off + bj * 128) = x0 * ALPHA + acc[ai][bj][m][0]; *(f32x4*)(y1 + off + bj * 128 + 4) = x1 * ALPHA + acc[ai][bj][m][1]; }
                asm volatile("" ::: "memory"); }
    }
};
struct EpiGU {
    static constexpr bool PERM = true;
    bf16_t* act; const float* bgu;
    __device__ __forceinline__ void operator()(const pg8::f32x4 (&acc)[2][2][4][2], const pg8::Unit& u, int wr, int wc, int fr, int fq) const {
        const int row0 = u.pm * 256 + wr * 64 + fr, col0 = u.pn * 128 + wc * 32 + 8 * fq;
        const float* bb = bgu + (size_t)u.e * 2048 + col0;
        const f32x4 bg0 = *(const f32x4*)bb, bg1 = *(const f32x4*)(bb + 4), bu0 = *(const f32x4*)(bb + 1024), bu1 = *(const f32x4*)(bb + 1028);
#pragma unroll
        for (int ai = 0; ai < 2; ++ai)
#pragma unroll
            for (int m = 0; m < 4; ++m) { f32x4 a0, a1;
                const f32x4 g0 = acc[ai][0][m][0] + bg0, g1 = acc[ai][0][m][1] + bg1, u0 = acc[ai][1][m][0] + bu0, u1 = acc[ai][1][m][1] + bu1;
#pragma unroll
                for (int i = 0; i < 4; ++i) { const float gt0 = fminf(g0[i], 7.0f), up0 = fminf(fmaxf(u0[i], -7.0f), 7.0f), gt1 = fminf(g1[i], 7.0f), up1 = fminf(fmaxf(u1[i], -7.0f), 7.0f);
                    a0[i] = gt0 * sigmoidf_(1.702f * gt0) * (up0 + 1.0f); a1[i] = gt1 * sigmoidf_(1.702f * gt1) * (up1 + 1.0f); }
                u32x4 w; w.x = pg8::cvt_pk_bf16(a0[0], a0[1]); w.y = pg8::cvt_pk_bf16(a0[2], a0[3]); w.z = pg8::cvt_pk_bf16(a1[0], a1[1]); w.w = pg8::cvt_pk_bf16(a1[2], a1[3]);
                *(u32x4*)(act + (size_t)(row0 + ai * 128 + m * 16) * D_ + col0) = w; asm volatile("" ::: "memory"); }
    }
};
struct EpiDN {
    static constexpr bool PERM = true;
    bf16_t* y; const float* bdn; const float* roww;
    __device__ __forceinline__ void operator()(const pg8::f32x4 (&acc)[2][2][4][2], const pg8::Unit& u, int wr, int wc, int fr, int fq) const {
        const int row0 = u.pm * 256 + wr * 64 + fr, col0 = u.pn * 256 + wc * 32 + 8 * fq;
        const float* bb = bdn + (size_t)u.e * D_ + col0;
#pragma unroll
        for (int ai = 0; ai < 2; ++ai)
#pragma unroll
            for (int m = 0; m < 4; ++m) { const int row = row0 + ai * 128 + m * 16; const float w = roww[row];
#pragma unroll
                for (int bj = 0; bj < 2; ++bj) { const f32x4 v0 = (acc[ai][bj][m][0] + *(const f32x4*)(bb + bj * 128)) * w, v1 = (acc[ai][bj][m][1] + *(const f32x4*)(bb + bj * 128 + 4)) * w;
                    u32x4 o; o.x = pg8::cvt_pk_bf16(v0[0], v0[1]); o.y = pg8::cvt_pk_bf16(v0[2], v0[3]); o.z = pg8::cvt_pk_bf16(v1[0], v1[1]); o.w = pg8::cvt_pk_bf16(v1[2], v1[3]);
                    *(u32x4*)(y + (size_t)row * D_ + col0 + bj * 128) = o; }
                asm volatile("" ::: "memory"); }
    }
};
struct EpiCmp {
    static constexpr bool PERM = true;
    bf16_t* hid; const float* bias1;
    __device__ __forceinline__ void operator()(const pg8::f32x4 (&acc)[2][2][4][2], const pg8::Unit& u, int wr, int wc, int fr, int fq) const {
        const int row0 = u.pm * 256 + wr * 64 + fr, col0 = wc * 32 + 8 * fq;
        const float* bb = bias1 + (u.e & 1) * 128 + col0; const f32x4 b0 = *(const f32x4*)bb, b1 = *(const f32x4*)(bb + 4);
#pragma unroll
        for (int ai = 0; ai < 2; ++ai)
#pragma unroll
            for (int m = 0; m < 4; ++m) { const f32x4 v0 = acc[ai][0][m][0] + b0, v1 = acc[ai][0][m][1] + b1;
                u32x4 w; w.x = pg8::cvt_pk_bf16(gelu_tanh(v0[0]), gelu_tanh(v0[1])); w.y = pg8::cvt_pk_bf16(gelu_tanh(v0[2]), gelu_tanh(v0[3])); w.z = pg8::cvt_pk_bf16(gelu_tanh(v1[0]), gelu_tanh(v1[1])); w.w = pg8::cvt_pk_bf16(gelu_tanh(v1[2]), gelu_tanh(v1[3]));
                *(u32x4*)(hid + ((size_t)u.e * 512 + row0 + ai * 128 + m * 16) * 128 + col0) = w; asm volatile("" ::: "memory"); }
    }
};
struct GEpi {
    static constexpr bool PERM = true;
    int kind, l;
    __device__ __forceinline__ void operator()(const pg8::f32x4 (&acc)[2][2][4][2], const pg8::Unit& u, int wr, int wc, int fr, int fq) const {
        const KP p = fresh_kp();
        if (kind == 0) { const EpiProj e{WSP(bf16_t, O_PROJB), WSP(float, O_GF), WSP(float, O_BIASP) + l * NPAD}; e(acc, u, wr, wc, fr, fq); }
        else if (kind == 1) { const EpiOut e{(l == 0) ? p->in.x : WSP(float, O_XA), WSP(float, O_MIX)}; e(acc, u, wr, wc, fr, fq); }
        else if (kind == 2) { const EpiGU e{WSP(bf16_t, O_ACT), p->in.bgu + (size_t)l * NE * 2048}; e(acc, u, wr, wc, fr, fq); }
        else if (kind == 3) { const EpiDN e{WSP(bf16_t, O_Y), p->in.bdn + (size_t)l * NE * D_, WSP(float, O_ROWW)}; e(acc, u, wr, wc, fr, fq); }
        else { const EpiCmp e{WSP(bf16_t, O_HID), WSP(float, O_BIAS1) + l * 256}; e(acc, u, wr, wc, fr, fq); }
    }
};
struct GSched {
    int kind, nM, nN, nunits, G, c; const int* meta; const int* rowtok; const char* Bt; size_t estep;
    __device__ __forceinline__ bool next(int i, pg8::Unit& u) const {
        const int L = i * G + c; if (L >= nunits) return false;
        if (kind == 1) {
            int wgid = L; { const int q = nunits / pg8::NXCD, r = nunits % pg8::NXCD, xcd = wgid % pg8::NXCD, off = wgid / pg8::NXCD; wgid = (xcd < r ? xcd * (q + 1) : r * (q + 1) + (xcd - r) * q) + off; }
            const int nig = pg8::WGM * nN, gid = wgid / nig, fm = gid * pg8::WGM, gsz = (nM - fm) < pg8::WGM ? (nM - fm) : pg8::WGM;
            u.pm = fm + ((wgid % nig) % gsz); u.pn = (wgid % nig) / gsz; u.e = 0; u.nr = 256;
        } else if (kind == 4) { u.e = L >> 1; u.pm = L & 1; u.pn = 0; u.nr = (L & 1) ? 255 : 256; }
        else if (kind == 0) { const int gt = L / nN; u.pm = gt; u.pn = L - gt * nN; u.e = 0; u.nr = 256; }
        else { const int gt = L / nN; u.pm = gt; u.pn = L - gt * nN; u.e = meta[64 + 2 * gt]; u.nr = meta[65 + 2 * gt]; }
        return true; }
    __device__ __forceinline__ unsigned a_off(const pg8::Unit& u, int r) const { const int rr = r < u.nr ? r : u.nr - 1; const int row = u.pm * 256 + rr;
        if (kind == 4) { const int kv = u.e & 1, bg = u.e >> 1; return (unsigned)(((bg >> 1) * S_ + 16 * row) * PB + C_KV + ((0 * 2 + kv) * 2 + (bg & 1)) * 64) * 2u; }
        return (unsigned)((kind == 2) ? rowtok[row] : row) * (unsigned)(D_ * 2); }
    __device__ __forceinline__ size_t a_kstep() const { return kind == 4 ? (size_t)PB * 2 : (size_t)128; }
    __device__ __forceinline__ const char* b_base(const pg8::Unit& u) const { return Bt + (size_t)(kind == 4 ? (u.e & 1) : u.e) * estep + (size_t)u.pn * ((size_t)256 * D_ * 2); }
};

__device__ __forceinline__ void ph_rmsnorm(KP p, int l) {
    const int lane = ftid() & 63, wv = ftid() >> 6; const float* g = p->in.g_out + (size_t)l * D_;
    constexpr int NB = 4; const int rstride = (int)gridDim.x * 8;
    f32x4 gg[4];
#pragma unroll
    for (int j = 0; j < 2; ++j) { gg[2 * j] = *(const f32x4*)(g + 512 * j + lane * 8); gg[2 * j + 1] = *(const f32x4*)(g + 512 * j + lane * 8 + 4); }
    for (int row0 = fbid() * 8 + wv; row0 < T_; row0 += rstride * NB) {
        u32x4 ra[NB], rb2[NB], rw2[NB];
#pragma unroll
        for (int bi = 0; bi < NB; ++bi) { const int row = (row0 + bi * rstride < T_) ? row0 + bi * rstride : row0; const bf16_t* r = WSP(bf16_t, O_O) + (size_t)row * D_ + lane * 8;
            ra[bi] = *(const u32x4*)r; rb2[bi] = *(const u32x4*)(r + 512); rw2[bi] = *(const u32x4*)(WSP(bf16_t, O_OWIN) + (size_t)row * 512 + lane * 8); }
#pragma unroll
        for (int bi = 0; bi < NB; ++bi) { const int row = row0 + bi * rstride; if (row < T_) {
#define BF_LO(u) __uint_as_float((u) << 16)
#define BF_HI(u) __uint_as_float((u) & 0xffff0000u)
            const f32x4 x0 = (f32x4){BF_LO(ra[bi].x) + BF_LO(rw2[bi].x), BF_HI(ra[bi].x) + BF_HI(rw2[bi].x), BF_LO(ra[bi].y) + BF_LO(rw2[bi].y), BF_HI(ra[bi].y) + BF_HI(rw2[bi].y)};
            const f32x4 x1 = (f32x4){BF_LO(ra[bi].z) + BF_LO(rw2[bi].z), BF_HI(ra[bi].z) + BF_HI(rw2[bi].z), BF_LO(ra[bi].w) + BF_LO(rw2[bi].w), BF_HI(ra[bi].w) + BF_HI(rw2[bi].w)};
            const f32x4 y0 = (f32x4){BF_LO(rb2[bi].x), BF_HI(rb2[bi].x), BF_LO(rb2[bi].y), BF_HI(rb2[bi].y)}, y1 = (f32x4){BF_LO(rb2[bi].z), BF_HI(rb2[bi].z), BF_LO(rb2[bi].w), BF_HI(rb2[bi].w)};
#undef BF_LO
#undef BF_HI
            float s = (x0.x * x0.x + x0.y * x0.y) + (x0.z * x0.z + x0.w * x0.w) + (x1.x * x1.x + x1.y * x1.y) + (x1.z * x1.z + x1.w * x1.w);
            float s2 = (y0.x * y0.x + y0.y * y0.y) + (y0.z * y0.z + y0.w * y0.w) + (y1.x * y1.x + y1.y * y1.y) + (y1.z * y1.z + y1.w * y1.w);
            const float sc0 = rsqrtf(wsum(s) * (1.f / 512.f) + RMS_EPS);
#pragma unroll
            for (int o = 1; o < 32; o <<= 1) s2 += __shfl_xor(s2, o);
            const float sc1 = rsqrtf(s2 * (1.f / 256.f) + RMS_EPS);
            const f32x4 u0 = x0 * sc0 * gg[0], u1 = x1 * sc0 * gg[1], w0 = y0 * sc1 * gg[2], w1 = y1 * sc1 * gg[3];
            bf16_t* ro = WSP(bf16_t, O_OB) + (size_t)row * D_;
            *(u32x4*)(ro + lane * 8) = (u32x4){pk2(u0.x, u0.y), pk2(u0.z, u0.w), pk2(u1.x, u1.y), pk2(u1.z, u1.w)};
            *(u32x4*)(ro + 512 + lane * 8) = (u32x4){pk2(w0.x, w0.y), pk2(w0.z, w0.w), pk2(w1.x, w1.y), pk2(w1.z, w1.w)}; } }
    }
}
template <bool ROUTER>
__device__ __forceinline__ void ph_ln(float* lds, KP p, int l, float* __restrict__ yout, int cnt_off = 0) {
    const int lane = ftid() & 63, wv = ftid() >> 6;
    const float* g = (ROUTER ? p->in.ln1_g : p->in.ln2_g) + (size_t)l * D_; const float* bb = (ROUTER ? p->in.ln1_b : p->in.ln2_b) + (size_t)l * D_;
    constexpr int NB = ROUTER ? 4 : 2;
    const int rstride = (int)gridDim.x * 8;
    for (int row0 = fbid() * 8 + wv; row0 < T_; row0 += rstride * NB) {
        float v[NB][16];
        if (ROUTER) {
#pragma unroll
            for (int bi = 0; bi < NB; ++bi) { const int row = row0 + bi * rstride; const float* src = WSP(float, O_MIX) + (size_t)(row < T_ ? row : row0) * D_;
#pragma unroll
                for (int j = 0; j < 2; ++j) { const f32x4 a = *(const f32x4*)(src + 512 * j + lane * 8), b = *(const f32x4*)(src + 512 * j + lane * 8 + 4);
                    v[bi][8 * j + 0] = a.x; v[bi][8 * j + 1] = a.y; v[bi][8 * j + 2] = a.z; v[bi][8 * j + 3] = a.w; v[bi][8 * j + 4] = b.x; v[bi][8 * j + 5] = b.y; v[bi][8 * j + 6] = b.z; v[bi][8 * j + 7] = b.w; } }
        } else { const bf16_t* y = WSP(bf16_t, O_Y);
            int sl[NB][TOPK];
#pragma unroll
            for (int bi = 0; bi < NB; ++bi) { const int row = (row0 + bi * rstride < T_) ? row0 + bi * rstride : row0;
#pragma unroll
                for (int k = 0; k < TOPK; ++k) sl[bi][k] = WSP(int, O_SLOT)[row * TOPK + k]; }
            u32x4 yv[NB][TOPK][2]; f32x4 xv[NB][4];
#pragma unroll
            for (int bi = 0; bi < NB; ++bi) { const int row = (row0 + bi * rstride < T_) ? row0 + bi * rstride : row0; const float* src = WSP(float, O_X1) + (size_t)row * D_;
#pragma unroll
                for (int j = 0; j < 2; ++j) { xv[bi][2 * j] = *(const f32x4*)(src + 512 * j + lane * 8); xv[bi][2 * j + 1] = *(const f32x4*)(src + 512 * j + lane * 8 + 4); }
#pragma unroll
                for (int k = 0; k < TOPK; ++k)
#pragma unroll
                    for (int j = 0; j < 2; ++j) yv[bi][k][j] = *(const u32x4*)(y + (size_t)sl[bi][k] * D_ + 512 * j + lane * 8); }
#pragma unroll
            for (int bi = 0; bi < NB; ++bi)
#pragma unroll
                for (int j = 0; j < 2; ++j) { float acc[8];
#pragma unroll
                    for (int e = 0; e < 8; ++e) acc[e] = 0.f;
#pragma unroll
                    for (int k = 0; k < TOPK; ++k) { const u32x4 q = yv[bi][k][j];
                        acc[0] += __uint_as_float(q.x << 16); acc[1] += __uint_as_float(q.x & 0xffff0000u); acc[2] += __uint_as_float(q.y << 16); acc[3] += __uint_as_float(q.y & 0xffff0000u);
                        acc[4] += __uint_as_float(q.z << 16); acc[5] += __uint_as_float(q.z & 0xffff0000u); acc[6] += __uint_as_float(q.w << 16); acc[7] += __uint_as_float(q.w & 0xffff0000u); }
                    const f32x4 a = xv[bi][2 * j], b = xv[bi][2 * j + 1];
                    v[bi][8 * j + 0] = ALPHA * a.x + acc[0]; v[bi][8 * j + 1] = ALPHA * a.y + acc[1]; v[bi][8 * j + 2] = ALPHA * a.z + acc[2]; v[bi][8 * j + 3] = ALPHA * a.w + acc[3];
                    v[bi][8 * j + 4] = ALPHA * b.x + acc[4]; v[bi][8 * j + 5] = ALPHA * b.y + acc[5]; v[bi][8 * j + 6] = ALPHA * b.z + acc[6]; v[bi][8 * j + 7] = ALPHA * b.w + acc[7]; } }
#pragma unroll
        for (int bi = 0; bi < NB; ++bi) { const int row = row0 + bi * rstride; if (row < T_) {
            float s = 0.f;
#pragma unroll
            for (int i = 0; i < 16; ++i) s += v[bi][i];
            const float mu = wsum(s) * (1.f / D_); float s2 = 0.f;
#pragma unroll
            for (int i = 0; i < 16; ++i) { v[bi][i] -= mu; s2 += v[bi][i] * v[bi][i]; }
            const float rstd = rsqrtf(wsum(s2) * (1.f / D_) + LN_EPS);
            bf16_t* ybf = (ROUTER ? WSP(bf16_t, O_X1B) : WSP(bf16_t, O_XB)) + (size_t)row * D_;
#pragma unroll
            for (int j = 0; j < 2; ++j) { const int c0 = 512 * j + lane * 8; float o8[8];
                const f32x4 g0 = *(const f32x4*)(g + c0), g1 = *(const f32x4*)(g + c0 + 4), b0 = *(const f32x4*)(bb + c0), b1 = *(const f32x4*)(bb + c0 + 4);
                o8[0] = v[bi][8 * j + 0] * rstd * g0.x + b0.x; o8[1] = v[bi][8 * j + 1] * rstd * g0.y + b0.y; o8[2] = v[bi][8 * j + 2] * rstd * g0.z + b0.z; o8[3] = v[bi][8 * j + 3] * rstd * g0.w + b0.w;
                o8[4] = v[bi][8 * j + 4] * rstd * g1.x + b1.x; o8[5] = v[bi][8 * j + 5] * rstd * g1.y + b1.y; o8[6] = v[bi][8 * j + 6] * rstd * g1.z + b1.z; o8[7] = v[bi][8 * j + 7] * rstd * g1.w + b1.w;
                *(f32x4*)(yout + (size_t)row * D_ + c0) = (f32x4){o8[0], o8[1], o8[2], o8[3]};
                *(f32x4*)(yout + (size_t)row * D_ + c0 + 4) = (f32x4){o8[4], o8[5], o8[6], o8[7]};
                *(u32x4*)(ybf + c0) = (u32x4){pk2(o8[0], o8[1]), pk2(o8[2], o8[3]), pk2(o8[4], o8[5]), pk2(o8[6], o8[7])}; } } }
    }
    if (ROUTER) {
        const float* rw = p->in.rw + (size_t)l * D_ * NE; const float* rb = p->in.rb + (size_t)l * NE;
        float* wl = lds; float* rl = lds + 16384 + wv * 2048; float* lgl = lds + 32768 + wv * 256;
        int nrow = 0; for (int r_ = fbid() * 8 + wv; r_ < T_; r_ += (int)gridDim.x * 8) { ++nrow; asm volatile("" : "+s"(nrow)); }
        const int e = lane & 31, half = lane >> 5;
        float acc[2][4];
#pragma unroll
        for (int gi = 0; gi < 2; ++gi)
#pragma unroll
            for (int bi = 0; bi < 4; ++bi) acc[gi][bi] = 0.f;
#pragma unroll 1
        for (int c = 0; c < 2; ++c) {
            __syncthreads();
#pragma unroll
            for (int i = 0; i < 8; ++i) { const int f4 = i * NT + ftid(); *(f32x4*)(wl + 4 * f4) = *(const f32x4*)(rw + (size_t)c * 512 * NE + 4 * f4); }
            __syncthreads();
#pragma unroll
            for (int gi = 0; gi < 2; ++gi) {
                asm volatile("s_waitcnt lgkmcnt(0)" ::: "memory");
#pragma unroll
                for (int bi = 0; bi < 4; ++bi) { const int ri = (4 * gi + bi < nrow) ? 4 * gi + bi : 0; const float* src = yout + (size_t)(fbid() * 8 + wv + ri * (int)gridDim.x * 8) * D_ + c * 512 + lane * 8;
                    *(f32x4*)(rl + bi * 512 + lane * 8) = *(const f32x4*)src; *(f32x4*)(rl + bi * 512 + lane * 8 + 4) = *(const f32x4*)(src + 4); }
                asm volatile("s_waitcnt lgkmcnt(0)" ::: "memory");
                const float* wp = wl + (half * 256) * NE + e; const float* rp = rl + half * 256;
#pragma unroll 4
                for (int kk = 0; kk < 64; ++kk) { const float w0 = wp[(4 * kk) * NE], w1 = wp[(4 * kk + 1) * NE], w2 = wp[(4 * kk + 2) * NE], w3 = wp[(4 * kk + 3) * NE];
#pragma unroll
                    for (int bi = 0; bi < 4; ++bi) { const f32x4 r = *(const f32x4*)(rp + bi * 512 + 4 * kk); acc[gi][bi] += (r.x * w0 + r.y * w1) + (r.z * w2 + r.w * w3); } }
            }
        }
#pragma unroll
        for (int gi = 0; gi < 2; ++gi)
#pragma unroll
            for (int bi = 0; bi < 4; ++bi) { const float t = acc[gi][bi] + __shfl_xor(acc[gi][bi], 32); if (lane < 32) lgl[(4 * gi + bi) * 32 + e] = t; }
        asm volatile("s_waitcnt lgkmcnt(0)" ::: "memory");
        int* lcnt = (int*)(lds + 32768 + 8 * 256);
        if (ftid() < NE) lcnt[ftid()] = 0;
        __syncthreads();
#pragma unroll 1
        for (int ri = 0; ri < nrow; ++ri) { const int row = fbid() * 8 + wv + ri * (int)gridDim.x * 8;
            const int e = lane & 31; const float lg = lgl[ri * 32 + e] + rb[e];
            float cur = lg, tv0 = 0.f, den = 0.f, myw = 0.f; int mye = 0;
#pragma unroll
            for (int k = 0; k < TOPK; ++k) { float bv = cur; int bi = e;
#pragma unroll
                for (int o = 16; o >= 1; o >>= 1) { const float ov = __shfl_xor(bv, o); const int oi = __shfl_xor(bi, o); if (ov > bv || (ov == bv && oi < bi)) { bv = ov; bi = oi; } }
                if (k == 0) tv0 = bv;
                const float w = __expf(bv - tv0); den += w;
                if (lane == k) { mye = bi; myw = w; }
                if (e == bi) cur = -3.4e38f; }
            if (lane < TOPK) { WSP(int, O_TOPE)[row * TOPK + lane] = mye; WSP(float, O_TOPW)[row * TOPK + lane] = myw / den; WSP(int, O_POS)[row * TOPK + lane] = atomicAdd(&lcnt[mye], 1); } }
        __syncthreads();
        if (ftid() < NE) { const int c = lcnt[ftid()]; lcnt[ftid()] = (c > 0) ? atomicAdd(WSP(int, O_COUNTS) + CNT_IDX(l, ftid()) + cnt_off, c) : 0; }
        __syncthreads();
#pragma unroll 1
        for (int ri = 0; ri < nrow; ++ri) { const int row = fbid() * 8 + wv + ri * (int)gridDim.x * 8;
            if (lane < TOPK) WSP(int, O_POS)[row * TOPK + lane] += lcnt[WSP(int, O_TOPE)[row * TOPK + lane]]; }
        __syncthreads();
    }
}
__device__ __forceinline__ void ph_bias1_reduce(KP p, int l) {
    if (fbid() != (int)gridDim.x - 1) return;
    const int tid = ftid(); if (tid < 256) { const float* pp = WSP(float, O_BIAS1P) + ((size_t)(l * 2 + (tid >> 7)) * 64) * 128 + (tid & 127);
        float v[64];
#pragma unroll
        for (int s = 0; s < 64; ++s) v[s] = pp[s * 128];
        float a = 0.f;
#pragma unroll
        for (int s = 0; s < 64; ++s) a += v[s];
        WSP(float, O_BIAS1)[l * 256 + tid] = a; }
}
__device__ __forceinline__ void ph_cumsum(float* lds, KP p, int blk0) {
    const int tid = ftid(), lane = tid & 63, wv = tid >> 6; const int bh = fbid() - blk0;
    if (bh < 0 || bh >= B_ * 4) return;
    const int b = bh >> 2, h = bh & 3; const float* gf = WSP(float, O_GF) + (size_t)(b * S_ + tid * 16) * 32 + 24 + h;
    float v[16], run = 0.f;
#pragma unroll
    for (int i = 0; i < 16; ++i) { run += gf[(size_t)i * 32]; v[i] = run; }
    float inc = run;
#pragma unroll
    for (int o = 1; o < 64; o <<= 1) { const float t = __shfl_up(inc, o); if (lane >= o) inc += t; }
    if (lane == 63) lds[wv] = inc;
    __syncthreads();
    float woff = 0.f;
#pragma unroll
    for (int i = 0; i < 8; ++i) woff += (i < wv) ? lds[i] : 0.f;
    const float off = woff + inc - run; float* c = WSP(float, O_CFOX) + (size_t)bh * S_ + tid * 16;
#pragma unroll
    for (int i = 0; i < 4; ++i) *(f32x4*)(c + 4 * i) = (f32x4){v[4 * i] + off, v[4 * i + 1] + off, v[4 * i + 2] + off, v[4 * i + 3] + off};
    __syncthreads();
}
__device__ __forceinline__ void ph_prep2(KP p, int l) {
    { unsigned* kmax2 = WSP(unsigned, O_COUNTS) + 192 + l * 8;
      for (int i = fbid() * NT + ftid(); i < B_ * 4 * S_ * 2; i += gridDim.x * NT) { const int half = i & 1, t = (i >> 1) % S_, bh = (i >> 1) / S_, b = bh >> 2, h = bh & 3;
          const bf16_t* kr = WSP(bf16_t, O_PROJB) + (size_t)(b * S_ + t) * PB + C_FOX + (4 + h) * 64 + half * 32; float ss = 0.f;
#pragma unroll
          for (int c = 0; c < 4; ++c) { float k8[8]; ld8(kr + 8 * c, k8);
#pragma unroll
              for (int e = 0; e < 8; ++e) ss += k8[e] * k8[e]; }
          ss += __shfl_xor(ss, 1);
#pragma unroll
          for (int o = 2; o < 64; o <<= 1) ss = fmaxf(ss, __shfl_xor(ss, o));
          if ((ftid() & 63) == 0) atomicMax(kmax2 + bh, __float_as_uint(ss)); } }
    for (int i = fbid() * NT + ftid(); i < 8 * 512 * 64; i += gridDim.x * NT) {
        const int d = i & 63, n = (i >> 6) & 511, combo = i >> 15, kv = combo & 1, bg = combo >> 1;
        const float* w2 = (kv ? p->in.w2v : p->in.w2k) + (size_t)l * 128 * 64; const bf16_t* hr = WSP(bf16_t, O_HID) + ((size_t)combo * 512 + n) * 128;
        float a = 0.f;
#pragma unroll 4
        for (int c = 0; c < 16; ++c) { float h8[8]; ld8(hr + 8 * c, h8);
#pragma unroll
            for (int e = 0; e < 8; ++e) a += h8[e] * w2[(8 * c + e) * 64 + d]; }
        (kv ? WSP(bf16_t, O_VCMPB) : WSP(bf16_t, O_KCMPB))[((size_t)bg * 512 + n) * 64 + d] = (n < NCMP) ? (bf16_t)f2bf(a) : (bf16_t)0; }
}
__device__ __forceinline__ void ph_moe_scatter2(float* lds, KP p, int l) {
    const int tid = ftid(); int* ts = (int*)lds;
    const int* counts = WSP(int, O_COUNTS) + CNT_IDX(l, 0); int* meta = WSP(int, O_META); int* cl = ts + 64;
    __syncthreads();
    if (tid < NE) cl[tid] = counts[tid * 32];
    __syncthreads();
    if (tid == 0) { int nt = 0; for (int e = 0; e < NE; ++e) { ts[e] = nt; nt += (cl[e] + 255) >> 8; } ts[32] = nt; }
    __syncthreads();
    if (fbid() == 0) { if (tid < NE) { const int c = cl[tid], t0 = ts[tid]; meta[tid] = t0; for (int r = 0, t = t0; r < c; r += 256, ++t) { meta[64 + 2 * t] = tid; meta[65 + 2 * t] = (c - r) < 256 ? (c - r) : 256; } }
        if (tid == 0) meta[32] = ts[32]; }
    for (int i = fbid() * NT + tid; i < MROWS; i += gridDim.x * NT) {
        const int row = ts[WSP(int, O_TOPE)[i]] * 256 + WSP(int, O_POS)[i];
        WSP(int, O_ROWTOK)[row] = i >> 2; WSP(float, O_ROWW)[row] = WSP(float, O_TOPW)[i]; WSP(int, O_SLOT)[i] = row; }
    __syncthreads();
}
}
namespace mk {
typedef short bf16x8 __attribute__((ext_vector_type(8)));
typedef float f32x16 __attribute__((ext_vector_type(16)));
typedef float f32x2_t __attribute__((ext_vector_type(2)));
typedef __bf16 bf16x2_t __attribute__((ext_vector_type(2)));
typedef unsigned u32x2 __attribute__((ext_vector_type(2)));
typedef short v4i16_t __attribute__((ext_vector_type(4)));
__device__ __forceinline__ unsigned cvtpk(float lo, float hi) { f32x2_t v = {lo, hi}; bf16x2_t b = __builtin_convertvector(v, bf16x2_t); return __builtin_bit_cast(unsigned, b); }
constexpr int KROW = 144, VROW = 136;
constexpr int E1_K = 0, E1_V = 64 * KROW, E1_C = E1_V + 64 * KROW, E1_BUF = E1_C + 256;
constexpr int E1_FLAGS = 2 * E1_BUF;
constexpr float LOG2E = 1.4426950408889634f;
constexpr float RESC_THR = 8.0f;
#define CROW(reg, hh) (((reg) & 3) + 8 * ((reg) >> 2) + 4 * (hh))

#define SM_CORE(p0, p1, m, l, have, o0, o1) do { \
    float rm_ = fmaxf(p0[0], p1[0]); \
    _Pragma("unroll") for (int reg_ = 1; reg_ < 16; ++reg_) rm_ = fmaxf(rm_, fmaxf(p0[reg_], p1[reg_])); \
    rm_ = fmaxf(rm_, __shfl_xor(rm_, 32)); \
    const bool fin_ = rm_ > -1e37f; \
    if (__any((rm_ > RESC_THR) || (!have && fin_))) { \
        const float dl_ = have ? fmaxf(rm_, 0.f) : (fin_ ? rm_ : 0.f); const float al_ = have ? __builtin_amdgcn_exp2f(-dl_) : 1.f; \
        m += dl_; l *= al_; have = have || fin_; \
        _Pragma("unroll") for (int r_ = 0; r_ < 16; ++r_) { o0[r_] *= al_; o1[r_] *= al_; p0[r_] -= dl_; p1[r_] -= dl_; } } \
    float ls_ = 0.f; \
    _Pragma("unroll") for (int reg_ = 0; reg_ < 16; ++reg_) { p0[reg_] = __builtin_amdgcn_exp2f(p0[reg_]); p1[reg_] = __builtin_amdgcn_exp2f(p1[reg_]); ls_ += p0[reg_] + p1[reg_]; } \
    l += ls_; } while (0)

struct E1Geom { int b, q0, h; const bf16_t* qp; const bf16_t* kp; const bf16_t* vp; size_t pitch; };

template <int KIND>
__device__ __forceinline__ void e1_unit(LAS unsigned char* lds, KP p, int b, int hg, int qb, bf16_t* __restrict__ obase, bf16_t* __restrict__ owin, const unsigned* __restrict__ kmax2) {
    const int tid = ftid(), lane = tid & 63, w = __builtin_amdgcn_readfirstlane(tid >> 6), r32 = lane & 31, hh = lane >> 5;
    const bf16_t* projb = WSP(bf16_t, O_PROJB);
    int h, q0, qrow0, qcol, kcol, vcol, nrows;
    if (KIND == 0) { h = hg; q0 = qb * 256; qrow0 = q0 + 32 * w; qcol = C_FOX + h * 64; kcol = C_FOX + (4 + h) * 64; vcol = C_FOX + (8 + h) * 64; nrows = 256; }
    else if (KIND == 2) { h = hg; q0 = qb * 256; qrow0 = q0 + 32 * w; qcol = C_SB + h * 64; kcol = C_SB + (4 + h) * 64; vcol = C_SB + (8 + h) * 64; nrows = 256; }
    else { h = 4 * hg + (w & 3); q0 = qb * 64; qrow0 = q0 + 32 * (w >> 2); qcol = h * 64; kcol = C_KV + ((2 * 2 + 0) * 2 + hg) * 64; vcol = C_KV + ((2 * 2 + 1) * 2 + hg) * 64; nrows = 64; }
    const int tq = qrow0 + r32;
    const bf16_t* kbase = projb + (size_t)(b * S_) * PB + kcol; const bf16_t* vbase = projb + (size_t)(b * S_) * PB + vcol;
    bf16x8 qf[4];
    { const bf16_t* qptr = projb + (size_t)(b * S_ + tq) * PB + qcol + 8 * hh;
#pragma unroll
      for (int d0 = 0; d0 < 4; ++d0) qf[d0] = *(const bf16x8*)(qptr + 16 * d0); }
    int j0 = 0; const int j1 = (q0 + nrows - 1) >> 6;
    if (KIND == 1) { j0 = (q0 - 511) >> 6; if (j0 < 0) j0 = 0; }
    const int ntile = j1 - j0 + 1;
    float ct2 = 0.f, sl2 = 0.f; const float* cb = nullptr;
    if (KIND == 0) { cb = WSP(float, O_CFOX) + (size_t)(b * 4 + h) * S_; ct2 = cb[tq] * LOG2E; }
    if (KIND == 1) sl2 = exp2f(-(float)(h + 1)) * LOG2E;
    float qkb = 0.f;
    if (KIND == 0) { float qs = 0.f;
#pragma unroll
        for (int d0 = 0; d0 < 4; ++d0)
#pragma unroll
            for (int e = 0; e < 8; ++e) { const float x = bf2f((unsigned short)qf[d0][e]); qs += x * x; }
        qs += __shfl_xor(qs, 32);
        const float km2 = __uint_as_float(kmax2[b * 4 + h]);
        qkb = sqrtf(qs * km2) * (SCALE * LOG2E * 1.01f); }
    const float tqf = (float)tq;
    const int skey = tid >> 3, sch = tid & 7;
    u32x4 rk, rv; float rc = 0.f;
#define E1_LOAD(jj) do { const size_t ro_ = (size_t)((jj) * 64 + skey) * PB + sch * 8; rk = *(const u32x4*)(kbase + ro_); rv = *(const u32x4*)(vbase + ro_); \
        if (KIND == 0 && tid < 64) rc = cb[(jj) * 64 + tid] * LOG2E; } while (0)
#define E1_WRITE(bufp) do { *(LAS u32x4*)((bufp) + E1_K + skey * KROW + sch * 16) = rk; *(LAS u32x4*)((bufp) + E1_V + skey * KROW + sch * 16) = rv; \
        if (KIND == 0 && tid < 64) ((LAS float*)((bufp) + E1_C))[tid] = rc; } while (0)
    f32x16 o0, o1;
#pragma unroll
    for (int r = 0; r < 16; ++r) { o0[r] = 0.f; o1[r] = 0.f; }
    float m = 0.f, l = 0.f, carry = 0.f; bool have = false;
    bool wave_done = false;
    LAS unsigned* flags = (LAS unsigned*)(lds + E1_FLAGS);
    if (KIND != 1) { if (tid < 8) flags[tid] = 0u; }
    __syncthreads();
    E1_LOAD(KIND != 1 ? j1 : j0);
    for (int it = 0; it < ntile; ++it) {
        const int j = (KIND != 1) ? (j1 - it) : (j0 + it);
        LAS unsigned char* buf = lds + (it & 1) * E1_BUF;
        E1_WRITE(buf);
        __syncthreads();
        if (KIND != 1) { unsigned alld = 1u;
#pragma unroll
            for (int i = 0; i < 8; ++i) alld &= flags[i];
            if (alld) break; }
        if (it + 1 < ntile) E1_LOAD((KIND != 1) ? (j - 1) : (j + 1));
        if (!(KIND != 1 && wave_done)) {
            f32x16 p0, p1;
#pragma unroll
            for (int r = 0; r < 16; ++r) { p0[r] = 0.f; p1[r] = 0.f; }
            { const LAS unsigned char* kp_ = buf + E1_K + r32 * KROW + hh * 16;
#pragma unroll
              for (int d0 = 0; d0 < 4; ++d0) { const bf16x8 a0 = *(const LAS bf16x8*)(kp_ + d0 * 32), a1 = *(const LAS bf16x8*)(kp_ + 32 * KROW + d0 * 32);
                  p0 = __builtin_amdgcn_mfma_f32_32x32x16_bf16(a0, qf[d0], p0, 0, 0, 0); p1 = __builtin_amdgcn_mfma_f32_32x32x16_bf16(a1, qf[d0], p1, 0, 0, 0); } }
            const int kb = j * 64 + 4 * hh;
            if (KIND == 2) {
                float lk0[16], lk1[16], gs[8];
#pragma unroll
                for (int reg = 0; reg < 16; ++reg) { const int kpos = kb + CROW(reg, 0);
                    const float z0 = p0[reg] * SCALE, z1 = p1[reg] * SCALE; const bool v0 = kpos < tq, v1 = kpos + 32 < tq;
                    const float lb0 = fminf(z0, 0.f) - __logf(1.f + __expf(-fabsf(z0))), lb1 = fminf(z1, 0.f) - __logf(1.f + __expf(-fabsf(z1)));
                    lk0[reg] = v0 ? (lb0 - z0) : 0.f; lk1[reg] = v1 ? (lb1 - z1) : 0.f;
                    p0[reg] = v0 ? lb0 : -INFINITY; p1[reg] = v1 ? lb1 : -INFINITY; }
#pragma unroll
                for (int g4 = 0; g4 < 4; ++g4) { gs[g4] = (lk0[4 * g4] + lk0[4 * g4 + 1]) + (lk0[4 * g4 + 2] + lk0[4 * g4 + 3]); gs[4 + g4] = (lk1[4 * g4] + lk1[4 * g4 + 1]) + (lk1[4 * g4 + 2] + lk1[4 * g4 + 3]); }
                float oth[8];
#pragma unroll
                for (int gi = 0; gi < 8; ++gi) oth[gi] = __shfl_xor(gs[gi], 32);
                float run = 0.f;
#pragma unroll
                for (int gi = 7; gi >= 0; --gi) {
                    float later = carry + run + (hh == 0 ? oth[gi] : 0.f);
#pragma unroll
                    for (int e = 3; e >= 0; --e) { const int reg = (gi & 3) * 4 + e;
                        if (gi >> 2) { p1[reg] = __expf(p1[reg] + later); later += lk1[reg]; } else { p0[reg] = __expf(p0[reg] + later); later += lk0[reg]; } }
                    run += gs[gi] + oth[gi]; }
                carry += run;
            } else {
                if (KIND == 0) {
                    const LAS float* cs = (const LAS float*)(buf + E1_C) + 4 * hh; const float ctm = ct2 - m;
#pragma unroll
                    for (int i = 0; i < 4; ++i) { const f32x4 c0 = *(const LAS f32x4*)(cs + 8 * i), c1 = *(const LAS f32x4*)(cs + 32 + 8 * i);
#pragma unroll
                        for (int e = 0; e < 4; ++e) { const int reg = 4 * i + e; p0[reg] = p0[reg] * (SCALE * LOG2E) + (ctm - c0[e]); p1[reg] = p1[reg] * (SCALE * LOG2E) + (ctm - c1[e]); } }
                    if (!(j * 64 + 63 <= qrow0)) {
#pragma unroll
                        for (int reg = 0; reg < 16; ++reg) { const int kpos = kb + CROW(reg, 0); p0[reg] = (kpos <= tq) ? p0[reg] : -INFINITY; p1[reg] = (kpos + 32 <= tq) ? p1[reg] : -INFINITY; } }
                } else {
                    const float basef = sl2 * ((float)kb - tqf) - m, base1 = basef + 32.f * sl2;
#pragma unroll
                    for (int reg = 0; reg < 16; ++reg) { p0[reg] = p0[reg] * (SCALE * LOG2E) + __builtin_fmaf(sl2, (float)CROW(reg, 0), basef); p1[reg] = p1[reg] * (SCALE * LOG2E) + __builtin_fmaf(sl2, (float)CROW(reg, 0), base1); }
                    if (!(j * 64 + 63 <= qrow0 && qrow0 + 31 - j * 64 < 512)) {
#pragma unroll
                        for (int reg = 0; reg < 16; ++reg) { const int kpos = kb + CROW(reg, 0);
                            p0[reg] = (kpos <= tq && tq - kpos < 512) ? p0[reg] : -INFINITY; p1[reg] = (kpos + 32 <= tq && tq - kpos - 32 < 512) ? p1[reg] : -INFINITY; } }
                }
                SM_CORE(p0, p1, m, l, have, o0, o1);
            }
            { const int gq_ = lane >> 4, li_ = lane & 15;
              const LAS unsigned char* tb = buf + E1_V + (4 * hh + (li_ >> 2)) * KROW + (16 * (gq_ & 1) + 4 * (li_ & 3)) * 2;
#pragma unroll
              for (int s = 0; s < 4; ++s) {
                  u32x4 pw;
                  if (s < 2) { pw.x = cvtpk(p0[8 * s + 0], p0[8 * s + 1]); pw.y = cvtpk(p0[8 * s + 2], p0[8 * s + 3]); pw.z = cvtpk(p0[8 * s + 4], p0[8 * s + 5]); pw.w = cvtpk(p0[8 * s + 6], p0[8 * s + 7]); }
                  else { const int s2 = s - 2; pw.x = cvtpk(p1[8 * s2 + 0], p1[8 * s2 + 1]); pw.y = cvtpk(p1[8 * s2 + 2], p1[8 * s2 + 3]); pw.z = cvtpk(p1[8 * s2 + 4], p1[8 * s2 + 5]); pw.w = cvtpk(p1[8 * s2 + 6], p1[8 * s2 + 7]); }
                  const bf16x8 pb = __builtin_bit_cast(bf16x8, pw);
                  const v4i16_t a0l = __builtin_amdgcn_ds_read_tr16_b64_v4i16((LAS v4i16_t*)(tb + (16 * s) * KROW)), a0h = __builtin_amdgcn_ds_read_tr16_b64_v4i16((LAS v4i16_t*)(tb + (16 * s + 8) * KROW));
                  const v4i16_t a1l = __builtin_amdgcn_ds_read_tr16_b64_v4i16((LAS v4i16_t*)(tb + (16 * s) * KROW + 64)), a1h = __builtin_amdgcn_ds_read_tr16_b64_v4i16((LAS v4i16_t*)(tb + (16 * s + 8) * KROW + 64));
                  const bf16x8 va0 = (bf16x8){a0l[0], a0l[1], a0l[2], a0l[3], a0h[0], a0h[1], a0h[2], a0h[3]}, va1 = (bf16x8){a1l[0], a1l[1], a1l[2], a1l[3], a1h[0], a1h[1], a1h[2], a1h[3]};
                  o0 = __builtin_amdgcn_mfma_f32_32x32x16_bf16(va0, pb, o0, 0, 0, 0); o1 = __builtin_amdgcn_mfma_f32_32x32x16_bf16(va1, pb, o1, 0, 0, 0); } }
            if (KIND == 0) {
                const float c0 = *(const LAS float*)(buf + E1_C); const bool dn = __all(have && (qkb + (ct2 - c0) - m < -150.f));
                if (dn && !wave_done) { wave_done = true; if (lane == 0) flags[w] = 1u; } }
            if (KIND == 2) { const bool dn = __all(carry < -110.f);
                if (dn && !wave_done) { wave_done = true; if (lane == 0) flags[w] = 1u; } }
        }
    }
    float inv = 1.f, gate = 1.f;
    if (KIND != 2) { l += __shfl_xor(l, 32); inv = (l > 0.f) ? 1.f / l : 0.f; }
    bf16_t* orow;
    if (KIND == 0) orow = obase + (size_t)(b * S_ + tq) * D_ + 512 + h * 64;
    else if (KIND == 2) orow = obase + (size_t)(b * S_ + tq) * D_ + 768 + h * 64;
    else { orow = owin + (size_t)(b * S_ + tq) * 512 + h * 64; gate = WSP(float, O_GF)[(size_t)(b * S_ + tq) * 32 + 2 * 8 + h]; }
    const float sc = inv * gate;
#pragma unroll
    for (int i = 0; i < 4; ++i) {
        *(u32x2*)(orow + 8 * i + 4 * hh) = (u32x2){cvtpk(o0[4 * i] * sc, o0[4 * i + 1] * sc), cvtpk(o0[4 * i + 2] * sc, o0[4 * i + 3] * sc)};
        *(u32x2*)(orow + 32 + 8 * i + 4 * hh) = (u32x2){cvtpk(o1[4 * i] * sc, o1[4 * i + 1] * sc), cvtpk(o1[4 * i + 2] * sc, o1[4 * i + 3] * sc)}; }
#undef E1_LOAD
#undef E1_WRITE
}
}
namespace mk {
constexpr int E2_WAVE = 64 * KROW + 512;
template <bool USE_MASK>
__device__ __forceinline__ void e2_wave_unit(LAS unsigned char* ldsw, KP p, int b, int g, int t0, bf16_t* __restrict__ obase, const bf16_t* __restrict__ csrc, int cpitch) {
    const int lane = ftid() & 63, r32 = lane & 31, hh = lane >> 5, qi = r32 >> 2, r4 = r32 & 3;
    const int h = 4 * g + r4, tq = t0 + qi;
    const bf16_t* projb = WSP(bf16_t, O_PROJB);
    const bf16_t* kbase = projb + (size_t)(b * S_) * PB + C_KV + ((1 * 2 + 0) * 2 + g) * 64;
    const bf16_t* vbase = projb + (size_t)(b * S_) * PB + C_KV + ((1 * 2 + 1) * 2 + g) * 64;
    bf16x8 qf[4];
    { const bf16_t* qptr = projb + (size_t)(b * S_ + tq) * PB + h * 64 + 8 * hh;
#pragma unroll
      for (int d0 = 0; d0 < 4; ++d0) qf[d0] = *(const bf16x8*)(qptr + 16 * d0); }
    unsigned qm0 = 0u, qm1 = 0u, qm2 = 0u, qm3 = 0u;
    if (USE_MASK) { const u32x4 mw = *(const u32x4*)(WSP(unsigned, O_SELMASK) + ((size_t)((b * 2 + g) * S_ + t0 + (lane >> 3))) * 4); qm0 = mw.x; qm1 = mw.y; qm2 = mw.z; qm3 = mw.w; }
    else { const int* sp = WSP(int, O_SEL) + ((size_t)((b * 2 + g) * S_ + t0)) * NSEL + lane * 2;
      const int e0 = sp[0], e1 = sp[1];
#pragma unroll
      for (int k = 0; k < 2; ++k) { const int e = k ? e1 : e0; const unsigned bit = 1u << (e & 31); const int wd = e >> 5;
          qm0 |= (wd == 0) ? bit : 0u; qm1 |= (wd == 1) ? bit : 0u; qm2 |= (wd == 2) ? bit : 0u; qm3 |= (wd == 3) ? bit : 0u; }
#pragma unroll
      for (int o = 1; o < 8; o <<= 1) { qm0 |= __shfl_xor(qm0, o); qm1 |= __shfl_xor(qm1, o); qm2 |= __shfl_xor(qm2, o); qm3 |= __shfl_xor(qm3, o); } }
    const unsigned rm0 = __shfl(qm0, qi * 8), rm1 = __shfl(qm1, qi * 8), rm2 = __shfl(qm2, qi * 8), rm3 = __shfl(qm3, qi * 8);
    const unsigned* rowmask = WSP(unsigned, O_SELMASK) + ((size_t)((b * 2 + g) * S_ + tq)) * 4;
    unsigned um0 = qm0, um1 = qm1, um2 = qm2, um3 = qm3;
#pragma unroll
    for (int o = 8; o < 64; o <<= 1) { um0 |= __shfl_xor(um0, o); um1 |= __shfl_xor(um1, o); um2 |= __shfl_xor(um2, o); um3 |= __shfl_xor(um3, o); }
    LAS int* list = (LAS int*)(ldsw + 64 * KROW);
    int nblk;
    { const bool s0 = (((lane < 32) ? um0 : um1) >> (lane & 31)) & 1u, s1 = (((lane < 32) ? um2 : um3) >> (lane & 31)) & 1u;
      const unsigned long long b0 = __ballot(s0), b1 = __ballot(s1);
      const unsigned long long lower = (lane == 0) ? 0ull : (~0ull >> (64 - lane));
      const int n0 = __popcll(b0);
      if (s0) list[__popcll(b0 & lower)] = lane;
      if (s1) list[n0 + __popcll(b1 & lower)] = lane + 64;
      nblk = n0 + __popcll(b1); }
    asm volatile("s_waitcnt lgkmcnt(0)" ::: "memory");
    const float sl2 = exp2f(-(float)(h + 1)) * LOG2E, tqf = (float)tq;
    f32x16 o0, o1;
#pragma unroll
    for (int r = 0; r < 16; ++r) { o0[r] = 0.f; o1[r] = 0.f; }
    float m = 0.f, l = 0.f; bool have = false;
    const int curq = tq >> 6;
    const int vrow = lane >> 3, vch = lane & 7;
    const int gq = lane >> 4, li = lane & 15;
    const LAS unsigned char* trb = ldsw + (4 * hh + (li >> 2)) * KROW + (16 * (gq & 1) + 4 * (li & 3)) * 2;
    bf16x8 kn0[4], kn1[4]; u32x4 vn[8];
#define E2_LOAD(blk) do { const bf16_t* kp_ = kbase + (size_t)((blk) * 64 + r32) * PB + 8 * hh; const bf16_t* vp_ = vbase + (size_t)((blk) * 64 + vrow) * PB + vch * 8; \
        _Pragma("unroll") for (int d0 = 0; d0 < 4; ++d0) { kn0[d0] = *(const bf16x8*)(kp_ + 16 * d0); kn1[d0] = *(const bf16x8*)(kp_ + (size_t)32 * PB + 16 * d0); } \
        _Pragma("unroll") for (int i = 0; i < 8; ++i) vn[i] = *(const u32x4*)(vp_ + (size_t)(8 * i) * PB); } while (0)
    int blk = list[0];
    blk = __builtin_amdgcn_readfirstlane(blk);
    E2_LOAD(blk);
    for (int it = 0; it < nblk; ++it) {
#pragma unroll
        for (int i = 0; i < 8; ++i) *(LAS u32x4*)(ldsw + (vrow + 8 * i) * KROW + vch * 16) = vn[i];
        const int cur = blk;
        const unsigned rw = USE_MASK ? rowmask[cur >> 5] : ((cur < 32) ? rm0 : (cur < 64) ? rm1 : (cur < 96) ? rm2 : rm3);
        f32x16 p0, p1;
#pragma unroll
        for (int r = 0; r < 16; ++r) { p0[r] = 0.f; p1[r] = 0.f; }
#pragma unroll
        for (int d0 = 0; d0 < 4; ++d0) { p0 = __builtin_amdgcn_mfma_f32_32x32x16_bf16(kn0[d0], qf[d0], p0, 0, 0, 0); p1 = __builtin_amdgcn_mfma_f32_32x32x16_bf16(kn1[d0], qf[d0], p1, 0, 0, 0); }
        if (it + 1 < nblk) { blk = __builtin_amdgcn_readfirstlane(list[it + 1]); E2_LOAD(blk); }
        const bool rowsel = (rw >> (cur & 31)) & 1u;
        const int kb = cur * 64 + 4 * hh;
        { const float basef = rowsel ? (sl2 * ((float)kb - tqf) - m) : -INFINITY, base1 = basef + 32.f * sl2;
#pragma unroll
          for (int reg = 0; reg < 16; ++reg) { p0[reg] = p0[reg] * (SCALE * LOG2E) + __builtin_fmaf(sl2, (float)CROW(reg, 0), basef); p1[reg] = p1[reg] * (SCALE * LOG2E) + __builtin_fmaf(sl2, (float)CROW(reg, 0), base1); } }
        if (cur >= curq) {
#pragma unroll
            for (int reg = 0; reg < 16; ++reg) { const int kpos = kb + CROW(reg, 0); p0[reg] = (kpos <= tq) ? p0[reg] : -INFINITY; p1[reg] = (kpos + 32 <= tq) ? p1[reg] : -INFINITY; } }
        SM_CORE(p0, p1, m, l, have, o0, o1);
#pragma unroll
        for (int s = 0; s < 4; ++s) {
            u32x4 pw;
            if (s < 2) { pw.x = cvtpk(p0[8 * s + 0], p0[8 * s + 1]); pw.y = cvtpk(p0[8 * s + 2], p0[8 * s + 3]); pw.z = cvtpk(p0[8 * s + 4], p0[8 * s + 5]); pw.w = cvtpk(p0[8 * s + 6], p0[8 * s + 7]); }
            else { const int s2 = s - 2; pw.x = cvtpk(p1[8 * s2 + 0], p1[8 * s2 + 1]); pw.y = cvtpk(p1[8 * s2 + 2], p1[8 * s2 + 3]); pw.z = cvtpk(p1[8 * s2 + 4], p1[8 * s2 + 5]); pw.w = cvtpk(p1[8 * s2 + 6], p1[8 * s2 + 7]); }
            const bf16x8 pb = __builtin_bit_cast(bf16x8, pw);
            const v4i16_t a0l = __builtin_amdgcn_ds_read_tr16_b64_v4i16((LAS v4i16_t*)(trb + (16 * s) * KROW)), a0h = __builtin_amdgcn_ds_read_tr16_b64_v4i16((LAS v4i16_t*)(trb + (16 * s + 8) * KROW));
            const v4i16_t a1l = __builtin_amdgcn_ds_read_tr16_b64_v4i16((LAS v4i16_t*)(trb + (16 * s) * KROW + 64)), a1h = __builtin_amdgcn_ds_read_tr16_b64_v4i16((LAS v4i16_t*)(trb + (16 * s + 8) * KROW + 64));
            const bf16x8 va0 = (bf16x8){a0l[0], a0l[1], a0l[2], a0l[3], a0h[0], a0h[1], a0h[2], a0h[3]}, va1 = (bf16x8){a1l[0], a1l[1], a1l[2], a1l[3], a1h[0], a1h[1], a1h[2], a1h[3]};
            o0 = __builtin_amdgcn_mfma_f32_32x32x16_bf16(va0, pb, o0, 0, 0, 0); o1 = __builtin_amdgcn_mfma_f32_32x32x16_bf16(va1, pb, o1, 0, 0, 0); }
    }
    l += __shfl_xor(l, 32);
    const float sc = ((l > 0.f) ? 1.f / l : 0.f) * WSP(float, O_GF)[(size_t)(b * S_ + tq) * 32 + 1 * 8 + h];
    bf16_t* orow = obase + (size_t)(b * S_ + tq) * D_ + h * 64; const bf16_t* crow = csrc + (size_t)(b * S_ + tq) * cpitch + h * 64;
#pragma unroll
    for (int i = 0; i < 4; ++i) {
        const u32x2 c0 = *(const u32x2*)(crow + 8 * i + 4 * hh), c1 = *(const u32x2*)(crow + 32 + 8 * i + 4 * hh);
        const float x00 = __uint_as_float(c0.x << 16) + o0[4 * i] * sc, x01 = __uint_as_float(c0.x & 0xffff0000u) + o0[4 * i + 1] * sc, x02 = __uint_as_float(c0.y << 16) + o0[4 * i + 2] * sc, x03 = __uint_as_float(c0.y & 0xffff0000u) + o0[4 * i + 3] * sc;
        const float x10 = __uint_as_float(c1.x << 16) + o1[4 * i] * sc, x11 = __uint_as_float(c1.x & 0xffff0000u) + o1[4 * i + 1] * sc, x12 = __uint_as_float(c1.y << 16) + o1[4 * i + 2] * sc, x13 = __uint_as_float(c1.y & 0xffff0000u) + o1[4 * i + 3] * sc;
        *(u32x2*)(orow + 8 * i + 4 * hh) = (u32x2){cvtpk(x00, x01), cvtpk(x02, x03)}; *(u32x2*)(orow + 32 + 8 * i + 4 * hh) = (u32x2){cvtpk(x10, x11), cvtpk(x12, x13)}; }
#undef E2_LOAD
}
template <bool USE_MASK>
__device__ __forceinline__ void ph_attn_sel2(LAS unsigned char* lds3, KP p, bf16_t* __restrict__ obase, const bf16_t* __restrict__ csrc, int cpitch) {
    const int w = __builtin_amdgcn_readfirstlane(ftid() >> 6);
    LAS unsigned char* ldsw = lds3 + w * E2_WAVE;
    MK_LOOP(u, 512) { const int bg = u & 3, qblk = u >> 2; e2_wave_unit<USE_MASK>(ldsw, p, bg >> 1, bg & 1, qblk * 64 + 8 * w, obase, csrc, cpitch); }
}
}
namespace mk {
constexpr int E3_K = 0, E3_V = 512 * KROW, E3_BYTES = 2 * 512 * KROW;
__device__ __forceinline__ void e3_unit(LAS unsigned char* lds, KP p, int b, int g, int qb, bf16_t* __restrict__ ocmp, unsigned* __restrict__ selmask) {
    const int tid = ftid(), lane = tid & 63, w = __builtin_amdgcn_readfirstlane(tid >> 6), r32 = lane & 31, hh = lane >> 5;
    const int bg = b * 2 + g, q0 = qb * 256, qrow0 = q0 + 32 * w, tq = qrow0 + r32;
    const bf16_t* projb = WSP(bf16_t, O_PROJB);
    int nun = (q0 + 255 - 31) / 16 + 1; if (nun > 511) nun = 511;
    const int ntile_u = (nun + 63) >> 6;
    __syncthreads();
    { const int srow = tid >> 3, sch = tid & 7; const bf16_t* ks = WSP(bf16_t, O_KCMPB) + ((size_t)bg * 512 + srow) * 64 + sch * 8; const bf16_t* vs = WSP(bf16_t, O_VCMPB) + ((size_t)bg * 512 + srow) * 64 + sch * 8;
      for (int i = 0; i < ntile_u; ++i) { const u32x4 kv = *(const u32x4*)(ks + (size_t)i * 64 * 64), vv = *(const u32x4*)(vs + (size_t)i * 64 * 64);
          *(LAS u32x4*)(lds + E3_K + (srow + 64 * i) * KROW + sch * 16) = kv; *(LAS u32x4*)(lds + E3_V + (srow + 64 * i) * KROW + sch * 16) = vv; } }
    __syncthreads();
    int nw = qrow0 / 16 + 1; if (nw > 511) nw = 511;
    const int ntile_w = (qrow0 + 31 < 31) ? 0 : ((nw + 63) >> 6);
    const float tqf = (float)tq;
    const int gq = lane >> 4, li = lane & 15;
    const LAS unsigned char* trb = lds + E3_V + (4 * hh + (li >> 2)) * KROW + (16 * (gq & 1) + 4 * (li & 3)) * 2;
    const LAS unsigned char* kfb = lds + E3_K + r32 * KROW + hh * 16;
    float imp[64];
#pragma unroll
    for (int i = 0; i < 64; ++i) imp[i] = 0.f;
#pragma unroll 1
    for (int r4 = 0; r4 < 4; ++r4) {
        const int h = 4 * g + r4; const float sl2 = exp2f(-(float)(h + 1)) * LOG2E;
        const unsigned qoff = (unsigned)((b * S_ + tq) * PB + h * 64 + 8 * hh);
        f32x16 o0, o1;
#pragma unroll
        for (int r = 0; r < 16; ++r) { o0[r] = 0.f; o1[r] = 0.f; }
        float m = 0.f, l = 0.f; bool have = false;
#define E3_ST(jt) f32x16 p0, p1; { bf16x8 qf[4]; _Pragma("unroll") for (int d0 = 0; d0 < 4; ++d0) qf[d0] = *(const bf16x8*)(projb + qoff + 16 * d0); \
            _Pragma("unroll") for (int r = 0; r < 16; ++r) { p0[r] = 0.f; p1[r] = 0.f; } \
            _Pragma("unroll") for (int d0 = 0; d0 < 4; ++d0) { const bf16x8 a0 = *(const LAS bf16x8*)(kfb + (64 * (jt)) * KROW + d0 * 32), a1 = *(const LAS bf16x8*)(kfb + (64 * (jt) + 32) * KROW + d0 * 32); \
                p0 = __builtin_amdgcn_mfma_f32_32x32x16_bf16(a0, qf[d0], p0, 0, 0, 0); p1 = __builtin_amdgcn_mfma_f32_32x32x16_bf16(a1, qf[d0], p1, 0, 0, 0); } \
            int tq_ = tq; asm volatile("" : "+v"(tq_));     \
            int hh_ = hh; asm volatile("" : "+v"(hh_)); \
            const float tqf_ = (float)tq_; const int ce0_ = 16 * (64 * (jt) + 4 * hh_) + 31; \
            const float basef_ = sl2 * ((float)ce0_ - tqf_) - m, base1_ = basef_ + 512.f * sl2; \
            _Pragma("unroll") for (int reg = 0; reg < 16; ++reg) { const float cr_ = sl2 * (float)(16 * CROW(reg, 0)); p0[reg] = p0[reg] * (SCALE * LOG2E) + (basef_ + cr_); p1[reg] = p1[reg] * (SCALE * LOG2E) + (base1_ + cr_); } \
            if (ce0_ + 16 * 27 + 512 > qrow0) {     \
                _Pragma("unroll") for (int reg = 0; reg < 16; ++reg) { const int ce = ce0_ + 16 * CROW(reg, 0); p0[reg] = (ce <= tq_) ? p0[reg] : -INFINITY; p1[reg] = (ce + 512 <= tq_) ? p1[reg] : -INFINITY; } } }
        float imh[64];
#pragma unroll
        for (int i = 0; i < 64; ++i) imh[i] = 0.f;
#pragma unroll
        for (int jt = 0; jt < 8; ++jt) {
            if (jt < ntile_w) {
                E3_ST(jt);
                {
                    float rm_ = fmaxf(p0[0], p1[0]);
#pragma unroll
                    for (int reg_ = 1; reg_ < 16; ++reg_) rm_ = fmaxf(rm_, fmaxf(p0[reg_], p1[reg_]));
                    rm_ = fmaxf(rm_, __shfl_xor(rm_, 32));
                    const bool fin_ = rm_ > -1e37f;
                    if (__any((rm_ > RESC_THR) || (!have && fin_))) {
                        const float dl_ = have ? fmaxf(rm_, 0.f) : (fin_ ? rm_ : 0.f); const float al_ = have ? __builtin_amdgcn_exp2f(-dl_) : 1.f;
                        m += dl_; l *= al_; have = have || fin_;
#pragma unroll
                        for (int r_ = 0; r_ < 16; ++r_) { o0[r_] *= al_; o1[r_] *= al_; p0[r_] -= dl_; p1[r_] -= dl_; }
#pragma unroll
                        for (int i = 0; i < 64; ++i) imh[i] *= al_; }
                    float ls_ = 0.f;
#pragma unroll
                    for (int reg_ = 0; reg_ < 16; ++reg_) { p0[reg_] = __builtin_amdgcn_exp2f(p0[reg_]); p1[reg_] = __builtin_amdgcn_exp2f(p1[reg_]); ls_ += p0[reg_] + p1[reg_]; }
                    l += ls_; }
#pragma unroll
                for (int pa = 0; pa < 2; ++pa)
#pragma unroll
                    for (int i = 0; i < 4; ++i) { const int jj = 8 * jt + 4 * pa + i;
                        const float x0 = pa ? p1[4 * i] : p0[4 * i], x1 = pa ? p1[4 * i + 1] : p0[4 * i + 1], x2 = pa ? p1[4 * i + 2] : p0[4 * i + 2], x3 = pa ? p1[4 * i + 3] : p0[4 * i + 3];
                        const float c = 0.5f * x3, a = (x0 + x1) + (x2 + c), r = __shfl_xor(c, 32);
                        imh[jj] += a + (hh ? r : 0.f);
                        if (jj + 1 < 64) imh[jj + 1] += (hh ? 0.f : r); }
                const LAS unsigned char* tb = trb + (64 * jt) * KROW;
#pragma unroll
                for (int s = 0; s < 4; ++s) {
                    u32x4 pw;
                    if (s < 2) { pw.x = cvtpk(p0[8 * s + 0], p0[8 * s + 1]); pw.y = cvtpk(p0[8 * s + 2], p0[8 * s + 3]); pw.z = cvtpk(p0[8 * s + 4], p0[8 * s + 5]); pw.w = cvtpk(p0[8 * s + 6], p0[8 * s + 7]); }
                    else { const int s2 = s - 2; pw.x = cvtpk(p1[8 * s2 + 0], p1[8 * s2 + 1]); pw.y = cvtpk(p1[8 * s2 + 2], p1[8 * s2 + 3]); pw.z = cvtpk(p1[8 * s2 + 4], p1[8 * s2 + 5]); pw.w = cvtpk(p1[8 * s2 + 6], p1[8 * s2 + 7]); }
                    const bf16x8 pb = __builtin_bit_cast(bf16x8, pw);
                    const v4i16_t a0l = __builtin_amdgcn_ds_read_tr16_b64_v4i16((LAS v4i16_t*)(tb + (16 * s) * KROW)), a0h = __builtin_amdgcn_ds_read_tr16_b64_v4i16((LAS v4i16_t*)(tb + (16 * s + 8) * KROW));
                    const v4i16_t a1l = __builtin_amdgcn_ds_read_tr16_b64_v4i16((LAS v4i16_t*)(tb + (16 * s) * KROW + 64)), a1h = __builtin_amdgcn_ds_read_tr16_b64_v4i16((LAS v4i16_t*)(tb + (16 * s + 8) * KROW + 64));
                    const bf16x8 va0 = (bf16x8){a0l[0], a0l[1], a0l[2], a0l[3], a0h[0], a0h[1], a0h[2], a0h[3]}, va1 = (bf16x8){a1l[0], a1l[1], a1l[2], a1l[3], a1h[0], a1h[1], a1h[2], a1h[3]};
                    o0 = __builtin_amdgcn_mfma_f32_32x32x16_bf16(va0, pb, o0, 0, 0, 0); o1 = __builtin_amdgcn_mfma_f32_32x32x16_bf16(va1, pb, o1, 0, 0, 0); }
            }
        }
        l += __shfl_xor(l, 32);
        const float inv = (l > 0.f) ? 1.f / l : 0.f;
#pragma unroll
        for (int i = 0; i < 64; ++i) imp[i] += imh[i] * inv;
        { const float sc = inv * WSP(float, O_GF)[(size_t)(b * S_ + tq) * 32 + 0 * 8 + h];
          bf16_t* orow = ocmp + (size_t)(b * S_ + tq) * 512 + h * 64;
#pragma unroll
          for (int i = 0; i < 4; ++i) {
              *(u32x2*)(orow + 8 * i + 4 * hh) = (u32x2){cvtpk(o0[4 * i] * sc, o0[4 * i + 1] * sc), cvtpk(o0[4 * i + 2] * sc, o0[4 * i + 3] * sc)};
              *(u32x2*)(orow + 32 + 8 * i + 4 * hh) = (u32x2){cvtpk(o1[4 * i] * sc, o1[4 * i + 1] * sc), cvtpk(o1[4 * i + 2] * sc, o1[4 * i + 3] * sc)}; } }
#undef E3_ST
    }
    const int cur = tq >> 6;
#pragma unroll
    for (int jj = 0; jj < 64; ++jj) { const int j = 2 * jj + hh; imp[jj] = (j != 0 && j < cur - 1) ? imp[jj] : -1.f; }
    unsigned m0 = 1u, m1 = 0u, m2 = 0u, m3 = 0u;
#define E3_SETBIT(j) do { const unsigned bit_ = 1u << ((j) & 31); const int wd_ = (j) >> 5; m0 |= (wd_ == 0) ? bit_ : 0u; m1 |= (wd_ == 1) ? bit_ : 0u; m2 |= (wd_ == 2) ? bit_ : 0u; m3 |= (wd_ == 3) ? bit_ : 0u; } while (0)
    E3_SETBIT(cur); if (cur >= 1) E3_SETBIT(cur - 1);
#pragma unroll 1
    for (int it = 0; it < NSEL - 3; ++it) {
        float best = -0.5f; int bj = 0;
#pragma unroll
        for (int jj = 0; jj < 64; ++jj) { if (imp[jj] > best) { best = imp[jj]; bj = jj; } }
        const int myj = 2 * bj + hh; const float ob = __shfl_xor(best, 32); const int oj = __shfl_xor(myj, 32);
        const bool mine = (best > ob) || (best == ob && myj < oj);
        const float wv = mine ? best : ob; const int wj = mine ? myj : oj;
        if (wv >= 0.f) E3_SETBIT(wj);
        if (mine && best >= 0.f) {
#pragma unroll
            for (int jj = 0; jj < 64; ++jj) imp[jj] = (jj == bj) ? -2.f : imp[jj]; }
    }
#undef E3_SETBIT
    if (hh == 0) *(u32x4*)(selmask + ((size_t)bg * S_ + tq) * 4) = (u32x4){m0, m1, m2, m3};
}
}
namespace mk {
constexpr int SB_EARLY = 232;
template <int MODE>
__device__ __forceinline__ void ph_attn1(float* lds, LAS unsigned char* lds3, KP p, unsigned* qctr, bf16_t* obase, bf16_t* owin, const unsigned* kmax2) {
    LAS int* qslot = (LAS int*)(lds3 + E3_BYTES);
    constexpr int N_E3 = (MODE & 2) ? 128 : 0, N_CMP = (MODE & 1) ? 64 : 0, N_FOX = (MODE & 4) ? 256 : 0, N_WIN = (MODE & 8) ? 512 : 0, N_SB = (MODE & 16) ? (256 - SB_EARLY) : 0;
    for (;;) {
        __syncthreads();
        if (ftid() == 0) *qslot = (int)atomicAdd(qctr, 1u);
        __syncthreads();
        int u = __builtin_amdgcn_readfirstlane(*qslot);
        if (u >= N_E3 + N_CMP + N_FOX + N_WIN + N_SB) break;
        if (u < N_E3) { e3_unit(lds3, p, (u & 3) >> 1, u & 1, 31 - (u >> 2), WSP(bf16_t, O_OCMP), WSP(unsigned, O_SELMASK)); continue; } u -= N_E3;
        if (u < N_FOX) { e1_unit<0>(lds3, p, (u & 7) >> 2, u & 3, 31 - (u >> 3), obase, owin, kmax2); continue; } u -= N_FOX;
        if (u < N_WIN) { e1_unit<1>(lds3, p, (u & 3) >> 1, u & 1, 127 - (u >> 2), obase, owin, kmax2); continue; } u -= N_WIN;
        if (u < N_SB) { u += SB_EARLY; e1_unit<2>(lds3, p, (u & 7) >> 2, u & 3, 31 - (u >> 3), obase, owin, kmax2); }
    }
}
__device__ __forceinline__ void ph_sb_early(LAS unsigned char* lds3, KP p) {
    const int u = fbid() - 24; if (u < 0 || u >= SB_EARLY) return;
    e1_unit<2>(lds3, p, (u & 7) >> 2, u & 3, 31 - (u >> 3), WSP(bf16_t, O_O), WSP(bf16_t, O_OWIN), nullptr);
}
}
namespace mk {
#define RLX_AGENT __ATOMIC_RELAXED, __HIP_MEMORY_SCOPE_AGENT
#define XB_TMO      128
#define XB_XCNT(j)  (256  + 64 * (j))
#define XB_XSUB(j)  (1280 + 64 * (j))
#define XB_XGEN(j)  (2304 + 64 * (j))
#define XB_TOP      3328
#define XB_TOPGEN   3392
#define XCD_BAR_WORDS 3456
#define XB_SPIN_CAP (1u << 18)

__device__ __forceinline__ unsigned xb_ld(unsigned* p)              { return __hip_atomic_load(p, __ATOMIC_RELAXED, __HIP_MEMORY_SCOPE_AGENT); }
__device__ __forceinline__ unsigned xb_add(unsigned* p, unsigned v) { return __hip_atomic_fetch_add(p, v, __ATOMIC_RELAXED, __HIP_MEMORY_SCOPE_AGENT); }
__device__ __forceinline__ unsigned xb_xcc_id() { return (unsigned)__builtin_amdgcn_s_getreg((3 << 11) | 20) & 0xFu; }
#define XB_SPIN(cond, bar) do { unsigned _sp = 0; while (cond) { __builtin_amdgcn_s_sleep(1); \
    if ((++_sp & 255u) == 0u) { if (xb_ld(&(bar)[XB_TMO])) break; if (_sp > XB_SPIN_CAP) { atomicAdd(&(bar)[XB_TMO], 1u); break; } } } } while (0)

struct XcdBarrier {
    unsigned* bar; unsigned x;
    volatile LAS unsigned* st;
};

__device__ __forceinline__ XcdBarrier xcd_barrier_post(unsigned* bar, volatile LAS unsigned* st) {
    XcdBarrier b; b.bar = bar; b.x = xb_xcc_id(); b.st = st;
    if (threadIdx.x == 0) (void)xb_add(&bar[XB_XCNT(b.x)], 1u);
    return b;
}
__device__ __forceinline__ void xcd_barrier_complete(unsigned* bar, unsigned x, unsigned& nloc, unsigned& nx) {
    const unsigned G = gridDim.x * gridDim.y * gridDim.z;
    unsigned sum, cnt, mine, sp = 0u;
    for (;;) {
        sum = 0u; cnt = 0u; mine = 0u;
#pragma unroll
        for (unsigned j = 0; j < 16; ++j) { const unsigned c = xb_ld(&bar[XB_XCNT(j)]); sum += c; cnt += (c > 0u) ? 1u : 0u; mine = (j == x) ? c : mine; }
        if (sum == G) break;
        __builtin_amdgcn_s_sleep(1);
        if ((++sp & 255u) == 0u) { if (xb_ld(&bar[XB_TMO])) break; if (sp > XB_SPIN_CAP) { atomicAdd(&bar[XB_TMO], 1u); break; } }
    }
    nloc = mine > 0u ? mine : 1u; nx = cnt > 0u ? cnt : 1u;
}

__device__ __forceinline__ void xcd_barrier(const XcdBarrier& b) {
    asm volatile("s_waitcnt vmcnt(0)" ::: "memory");
    __syncthreads();
    if (threadIdx.x == 0) {
        unsigned* bar = b.bar;
        __builtin_amdgcn_s_waitcnt(0);
        unsigned nloc = b.st[0], nx = b.st[1];
        if (nloc == 0u) { xcd_barrier_complete(bar, b.x, nloc, nx); b.st[0] = nloc; b.st[1] = nx; }
        const unsigned old = xb_add(&bar[XB_XSUB(b.x)], 1u);
        const unsigned gen = old / nloc;
        if (old + 1u == (gen + 1u) * nloc) {
            __builtin_amdgcn_fence(__ATOMIC_RELEASE, "agent");
            asm volatile("s_waitcnt vmcnt(0)" ::: "memory");
            const unsigned og = xb_add(&bar[XB_TOP], 1u);
            const unsigned tg = og / nx;
            if (og + 1u == (tg + 1u) * nx) xb_add(&bar[XB_TOPGEN], 1u);
            else XB_SPIN(xb_ld(&bar[XB_TOPGEN]) == tg, bar);
            __builtin_amdgcn_fence(__ATOMIC_ACQUIRE, "agent");
            xb_add(&bar[XB_XGEN(b.x)], 1u);
            asm volatile("s_waitcnt vmcnt(0)" ::: "memory");
        } else {
            XB_SPIN(xb_ld(&bar[XB_XGEN(b.x)]) == gen, bar);
            __builtin_amdgcn_fence(__ATOMIC_ACQUIRE, "agent");
            asm volatile("s_waitcnt vmcnt(0)" ::: "memory");
        }
    }
    __syncthreads();
}

}
namespace cg = cooperative_groups;
constexpr int NSTEP = 12;
#ifndef CVH_GU
#define CVH_GU 1
#define CVH_DN 1
#endif
__global__ void __launch_bounds__(512, 2) mega(mk::P p_unused) {
    extern __shared__ __attribute__((aligned(16))) unsigned char lds_raw[];
    float* lds = (float*)lds_raw;
    LAS unsigned char* lds3 = (LAS unsigned char*)lds_raw;
    using namespace nv; using namespace mk;
    volatile LAS unsigned* bst = (volatile LAS unsigned*)(lds3 + E3_BYTES + 128);
    if (threadIdx.x < 2) bst[threadIdx.x] = 0u;
    __syncthreads();
    XcdBarrier bar;
    { const KP p = fresh_kp(); bar = xcd_barrier_post(WSP(unsigned, O_COUNTS + 16384), bst); }
    cg::this_grid().sync();
    for (int step = 0; step < 1 + NSTEP * L_; ++step) {
        const KP p = fresh_kp();
        const int l = (step - 1) / NSTEP, k = (step == 0) ? -1 : (step - 1) % NSTEP;
        const bool isg = (k == 0 || k == 1 || k == 6 || k == 9 || k == 10);
#ifdef PROBE_K
        const int nrep = (k == PROBE_K) ? PROBE_N : 1;
#else
        const int nrep = 1;
#endif
        for (int rep = 0; rep < nrep; ++rep) {
        int helpchunks = 0;
        if (isg) {
            const int kind = (k == 0) ? 0 : (k == 1) ? 4 : (k == 6) ? 1 : (k == 9) ? 2 : 3;
            GSched S; GEpi E; S.kind = kind; E.kind = kind; E.l = l;
            S.G = (int)gridDim.x; S.c = fbid(); S.meta = WSP(int, O_META); S.rowtok = WSP(int, O_ROWTOK); S.estep = 0;
            const char* A; int N, K = D_;
            if (kind == 0) { A = (const char*)WSP(bf16_t, O_XB); S.Bt = (const char*)(WSP(bf16_t, O_WTIN) + (size_t)l * NPAD * D_); N = NPAD; }
            else if (kind == 1) { A = (const char*)WSP(bf16_t, O_OB); S.Bt = (const char*)(WSP(bf16_t, O_WTOUT) + (size_t)l * D_ * D_); N = D_; }
            else if (kind == 2) { A = (const char*)WSP(bf16_t, O_X1B); S.Bt = (const char*)(WSP(bf16_t, O_WTGU) + (size_t)l * NE * 2048 * D_); S.estep = (size_t)2048 * D_ * 2; N = 2048; }
            else if (kind == 3) { A = (const char*)WSP(bf16_t, O_ACT); S.Bt = (const char*)(WSP(bf16_t, O_WTDN) + (size_t)l * NE * D_ * D_); S.estep = (size_t)D_ * D_ * 2; N = D_; }
            else { A = (const char*)WSP(bf16_t, O_PROJB); S.Bt = (const char*)(WSP(bf16_t, O_WT1) + (size_t)l * 2 * 256 * 2048); S.estep = (size_t)256 * 2048 * 2; N = 256; K = 2048; }
            S.nN = N / 256; S.nM = (kind < 2) ? T_ / 256 : (kind == 4) ? 16 : S.meta[32]; S.nunits = S.nM * S.nN;
            pg8::gemm_phase<GEpi, GSched>(lds3, A, K, S, E);
            if (l == 0 && kind >= 2 && kind <= 3 && S.G == 256) {
                const int mine = (S.nunits - S.c + 255) >> 8, most = (S.nunits + 255) >> 8;
                if (mine < most) helpchunks = (kind == 2) ? CVH_GU : CVH_DN; }
            if (kind == 4) { ph_cumsum(lds, p, 16); ph_sb_early(lds3, p); }
            if (kind == 0) ph_bias1_reduce(p, l);
        } else {
            switch (k) {
                case -1: ph_convert(lds3, p); break;
                case 2: ph_prep2(p, l); break;
#ifdef PROBE_AMODE
                case 3: if (rep == 0) ph_attn1<30>(lds, lds3, p, WSP(unsigned, O_COUNTS) + 128 + l * 8 + rep, WSP(bf16_t, O_O), WSP(bf16_t, O_OWIN), WSP(unsigned, O_COUNTS) + 192 + l * 8);
                        else ph_attn1<PROBE_AMODE>(lds, lds3, p, WSP(unsigned, O_COUNTS) + 128 + l * 8 + rep, WSP(bf16_t, O_O), WSP(bf16_t, O_OWIN), WSP(unsigned, O_COUNTS) + 192 + l * 8);
                        break;
#else
                case 3: ph_attn1<30>(lds, lds3, p, WSP(unsigned, O_COUNTS) + 128 + l * 8 + rep, WSP(bf16_t, O_O), WSP(bf16_t, O_OWIN), WSP(unsigned, O_COUNTS) + 192 + l * 8); break;
#endif
                case 4: ph_attn_sel2<true>(lds3, p, WSP(bf16_t, O_O), WSP(bf16_t, O_OCMP), 512); break;
                case 5: ph_rmsnorm(p, l); break;
                case 7: ph_ln<true>(lds, p, l, WSP(float, O_X1), (rep + 1 < nrep) ? 2048 * (rep + 1) : 0); break;
                case 8: ph_moe_scatter2(lds, p, l); break;
                default: { if (l == 0) helpchunks = 1 << 20;
                           float* xout = (l == L_ - 1) ? p->out : WSP(float, O_XA); ph_ln<false>(lds, p, l, xout); } break;
            }
        }
        if (helpchunks > 0) cv_help(lds3, fresh_kp(), helpchunks);
        xcd_barrier(bar);
        }
    }
#ifdef PROBE_SYNC
    for (int i = 0; i < PROBE_SYNC; ++i) xcd_barrier(bar);
#endif
}

extern "C" void kernel_launch(void* const* d_in, const int* in_sizes, int n_in,
                              void* d_out, int out_size, void* d_ws, size_t ws_size,
                              hipStream_t stream) {
    constexpr size_t kDynLds = 147456 + 1024;
    static int grid_blocks = 0;
    if (!grid_blocks) {
        int dev = 0, cus = 0, per_cu = 0;
        (void)hipGetDevice(&dev);
        (void)hipDeviceGetAttribute(&cus, hipDeviceAttributeMultiprocessorCount, dev);
        (void)hipFuncSetAttribute((const void*)mega, hipFuncAttributeMaxDynamicSharedMemorySize, (int)kDynLds);
        (void)hipOccupancyMaxActiveBlocksPerMultiprocessor(&per_cu, mega, 512, kDynLds);
        if (per_cu < 1) per_cu = 1;
        if (per_cu > 1) per_cu = 1;
        grid_blocks = cus * per_cu;
        if (ws_size < mk::O_END) fprintf(stderr, "workspace too small: %zu < %zu\n", ws_size, (size_t)mk::O_END);
    }
    mk::P p{};
    p.in = nv::inputs(d_in); p.ws = (unsigned char*)d_ws; p.out = (float*)d_out;
    (void)hipMemsetAsync((char*)d_ws + mk::O_COUNTS, 0, 65536, stream);
    void* args[] = {&p};
    hipError_t e = hipLaunchCooperativeKernel((void*)mega, dim3(grid_blocks), dim3(512), args, kDynLds, stream);
    if (e != hipSuccess) fprintf(stderr, "cooperative launch failed: %s (grid %d)\n", hipGetErrorString(e), grid_blocks);
}
```

```cpp
#include <hip/hip_runtime.h>
#include <hip/hip_cooperative_groups.h>
#include <cstdio>
#include <cstdint>

namespace nv {

constexpr int B_ = 2, S_ = 8192, D_ = 1024, T_ = B_ * S_, L_ = 2;
constexpr int DIN = 2844;
constexpr int OFF_NSA_KV = 512, OFF_NSA_GATE = 1280, OFF_FOX_QKV = 1304, OFF_FOX_F = 2072, OFF_SB_QKV = 2076;
constexpr int NCMP = 511, NBLK = 128, NSEL = 16;
constexpr int NE = 32, TOPK = 4, MROWS = T_ * TOPK;
constexpr float LN_EPS = 1e-5f, RMS_EPS = 1e-6f;
constexpr float ALPHA = 1.4142135623730951f;
constexpr float SCALE = 0.125f;

__device__ __forceinline__ float sigmoidf_(float x) { return 1.f / (1.f + __expf(-x)); }
__device__ __forceinline__ float logsig(float x) { return fminf(x, 0.f) - log1pf(expf(-fabsf(x))); }

__device__ __forceinline__ float gelu_tanh(float x) { return 0.5f * x * (1.f + tanhf(0.7978845608028654f * (x + 0.044715f * x * x * x))); }
__device__ __forceinline__ float wsum(float v) {
#pragma unroll
    for (int o = 1; o < 64; o <<= 1) v += __shfl_xor(v, o);
    return v;
}
struct In {
    const float *x, *w_in, *b_in, *pos_k, *pos_v, *w1k, *w2k, *w1v, *w2v, *g_out, *w_out, *ln1_g, *ln1_b, *rw, *rb, *wgu, *bgu, *wdn, *bdn, *ln2_g, *ln2_b;
};
inline In inputs(void* const* d) {
    In i; i.x = (const float*)d[0]; i.w_in = (const float*)d[1]; i.b_in = (const float*)d[2]; i.pos_k = (const float*)d[3]; i.pos_v = (const float*)d[4];
    i.w1k = (const float*)d[5]; i.w2k = (const float*)d[6]; i.w1v = (const float*)d[7]; i.w2v = (const float*)d[8]; i.g_out = (const float*)d[9]; i.w_out = (const float*)d[10];
    i.ln1_g = (const float*)d[11]; i.ln1_b = (const float*)d[12]; i.rw = (const float*)d[13]; i.rb = (const float*)d[14]; i.wgu = (const float*)d[15]; i.bgu = (const float*)d[16];
    i.wdn = (const float*)d[17]; i.bdn = (const float*)d[18]; i.ln2_g = (const float*)d[19]; i.ln2_b = (const float*)d[20]; return i;
}


}
namespace pg8 {
#define PG8_LAS __attribute__((address_space(3)))
typedef unsigned short bf16_t;
typedef short bf16x8 __attribute__((ext_vector_type(8)));
typedef float f32x4 __attribute__((ext_vector_type(4)));
typedef unsigned u32x4 __attribute__((ext_vector_type(4)));
constexpr int BM = 256, BK = 64, HALF = 128, HTB = HALF * BK * 2  , STAGE_BYTES = 8 * HTB, NXCD = 8, WGM = 8;

__host__ __device__ __forceinline__ int lds_byte(int r, int c) { const int st = (r >> 4) * 2 + (c >> 5), rr = r & 15, cc = c & 31, ob = rr * 64 + cc * 2; return st * 1024 + (ob ^ (((ob >> 9) & 1) << 5)); }
__host__ __device__ __forceinline__ void stage_rc(int b, int& R, int& C) { const int st = b / 1024, sb = b % 1024, swz = sb ^ (((sb >> 9) & 1) << 5); R = (st >> 1) * 16 + swz / 64; C = (st & 1) * 32 + (swz % 64) / 2; }
__host__ __device__ __forceinline__ int perm32(int rho) { const int n = rho >> 4, i = rho & 15; return 8 * (i >> 2) + 4 * n + (i & 3); }

struct Unit { int pm, pn, e, nr; };

__device__ __forceinline__ unsigned cvt_pk_bf16(float lo, float hi) { unsigned r; asm volatile("v_cvt_pk_bf16_f32 %0, %1, %2" : "=v"(r) : "v"(lo), "v"(hi)); return r; }
template <class Epi, class Sched, bool ALIGN_EPI = true, bool SP2 = true>
__device__ __forceinline__ void gemm_phase(PG8_LAS unsigned char* lds, const char* Abase, const int K, const Sched& S, const Epi& E) {
    int tid_ = threadIdx.x; asm volatile("" : "+v"(tid_));
    const int tid = tid_, wid = __builtin_amdgcn_readfirstlane(tid >> 6), lane = tid & 63, wr = wid >> 2, wc = wid & 3, fr = lane & 15, fq = lane >> 4;
    const int nt = K / BK;
    unsigned voffB[2];
#pragma unroll
    for (int i = 0; i < 2; ++i) { int R, C; stage_rc(tid * 16 + i * 8192, R, C); const int Rb = Epi::PERM ? ((R & ~31) + perm32(R & 31)) : R;
        voffB[i] = (unsigned)(Rb * K + C) * 2u; }
#define PG8_AOFF(u, o0, o1) do { int _t = tid; asm volatile("" : "+v"(_t)); _Pragma("unroll") for (int _i = 0; _i < 2; ++_i) { int _R, _C; stage_rc(_t * 16 + _i * 8192, _R, _C); \
        (o0)[_i] = S.a_off((u), _R) + (unsigned)_C * 2u; (o1)[_i] = S.a_off((u), HALF + _R) + (unsigned)_C * 2u; } } while (0)
    const size_t kstep = (size_t)(BK * 2);
    const size_t akstep = S.a_kstep();
    const size_t hstep = (size_t)HALF * K * 2;
    const unsigned ldsw = (unsigned)wid * 1024u;
    const int aoff = lds_byte(wr * 64 + fr, fq * 8), boff = lds_byte(wc * 32 + fr, fq * 8);
#define PG8_SA(b, h) (((b) * 2 + (h)) * HTB)
#define PG8_SB(b, h) ((4 + (b) * 2 + (h)) * HTB)
#define PG8_STAGE(bufoff, gbase, voff) do { _Pragma("unroll") for (int _i = 0; _i < 2; ++_i) { unsigned _o = (voff)[_i]; asm volatile("" : "+v"(_o));     \
        __builtin_amdgcn_global_load_lds((const unsigned*)((const char*)(gbase) + _o), (PG8_LAS unsigned*)(lds + (bufoff) + ldsw + _i * 8192), 16, 0, 0); } } while (0)
#define PG8_LDA(dst, b, h) do { _Pragma("unroll") for (int m = 0; m < 4; ++m) _Pragma("unroll") for (int k = 0; k < 2; ++k) dst[m][k] = *(const PG8_LAS bf16x8*)(lds + PG8_SA(b, h) + aoff + m * 2048 + k * 1024); } while (0)
#define PG8_LDB(dst, b, h) do { _Pragma("unroll") for (int n = 0; n < 2; ++n) _Pragma("unroll") for (int k = 0; k < 2; ++k) dst[n][k] = *(const PG8_LAS bf16x8*)(lds + PG8_SB(b, h) + boff + n * 2048 + k * 1024); } while (0)
#define PG8_MMA(ai, bj, At, Bt) do { __builtin_amdgcn_s_setprio(1); _Pragma("unroll") for (int m = 0; m < 4; ++m) _Pragma("unroll") for (int n = 0; n < 2; ++n) _Pragma("unroll") for (int k = 0; k < 2; ++k) \
        acc[ai][bj][m][n] = __builtin_amdgcn_mfma_f32_16x16x32_bf16(Bt[n][k], At[m][k], acc[ai][bj][m][n], 0, 0, 0); __builtin_amdgcn_s_setprio(0); } while (0)
#define PG8_WAIT_V(n) asm volatile("s_waitcnt vmcnt(" #n ")" ::: "memory")
#define PG8_WAIT_L(n) asm volatile("s_waitcnt lgkmcnt(" #n ")" ::: "memory")
#define PG8_BAR __builtin_amdgcn_s_barrier()
#define PG8_SCHED __builtin_amdgcn_sched_barrier(0)
    Unit cur, nxt; int ui = 0;
    if (!S.next(0, cur)) return;
    f32x4 acc[2][2][4][2];
    float zf_ = 0.f; asm volatile("" : "+v"(zf_));
#pragma unroll
    for (int a = 0; a < 2; ++a)
#pragma unroll
        for (int b = 0; b < 2; ++b)
#pragma unroll
            for (int m = 0; m < 4; ++m)
#pragma unroll
                for (int n = 0; n < 2; ++n) acc[a][b][m][n] = (f32x4){zf_, zf_, zf_, zf_};
    bf16x8 At[4][2], B0[2][2], B1[2][2];
    unsigned ca0[2], ca1[2], na0[2], na1[2];
    PG8_AOFF(cur, ca0, ca1);
    const char* const cA = Abase; const char* cB = S.b_base(cur);
    if constexpr (SP2) {
        PG8_STAGE(PG8_SB(0, 0), cB, voffB); PG8_STAGE(PG8_SB(0, 1), cB + hstep, voffB); PG8_STAGE(PG8_SA(0, 0), cA, ca0); PG8_STAGE(PG8_SA(0, 1), cA, ca1);
        if (wr == 1) PG8_BAR;
        PG8_WAIT_V(2); PG8_BAR;
        PG8_STAGE(PG8_SB(1, 0), cB + kstep, voffB); PG8_STAGE(PG8_SA(1, 0), cA + akstep, ca0); PG8_STAGE(PG8_SB(1, 1), cB + hstep + kstep, voffB);
        PG8_WAIT_V(6); PG8_BAR;
    } else { static_assert(SP2, "only the SP2 loop is kept"); }
    for (;;) {
        const bool has_next = S.next(ui + 1, nxt);
        const char* nB = has_next ? S.b_base(nxt) : cB;
        if (has_next) { PG8_AOFF(nxt, na0, na1); } else { na0[0] = ca0[0]; na0[1] = ca0[1]; na1[0] = ca1[0]; na1[1] = ca1[1]; }
        for (int t = 0; t < nt - 2; t += 2) {
            const char* a1 = cA + (size_t)(t + 1) * akstep;
            const char* a2 = cA + (size_t)(t + 2) * akstep; const char* b2 = cB + (size_t)(t + 2) * kstep;
            const char* a3 = a2 + akstep; const char* b3 = b2 + kstep;
            PG8_LDB(B0, 0, 0); PG8_LDB(B1, 0, 1); PG8_SCHED; PG8_LDA(At, 0, 0); PG8_STAGE(PG8_SA(1, 1), a1, ca1);
            PG8_WAIT_V(8); PG8_WAIT_L(0); PG8_BAR; PG8_MMA(0, 0, At, B0); PG8_MMA(0, 1, At, B1); PG8_BAR; PG8_SCHED;
            PG8_LDA(At, 0, 1); PG8_STAGE(PG8_SB(0, 0), b2, voffB); PG8_STAGE(PG8_SB(0, 1), b2 + hstep, voffB); PG8_STAGE(PG8_SA(0, 0), a2, ca0);
            PG8_WAIT_V(8); PG8_WAIT_L(0); PG8_BAR; PG8_MMA(1, 0, At, B0); PG8_MMA(1, 1, At, B1); PG8_BAR; PG8_SCHED;
            PG8_LDB(B0, 1, 0); PG8_LDB(B1, 1, 1); PG8_SCHED; PG8_LDA(At, 1, 0); PG8_STAGE(PG8_SA(0, 1), a2, ca1);
            PG8_WAIT_V(8); PG8_WAIT_L(0); PG8_BAR; PG8_MMA(0, 0, At, B0); PG8_MMA(0, 1, At, B1); PG8_BAR; PG8_SCHED;
            PG8_LDA(At, 1, 1); PG8_STAGE(PG8_SB(1, 0), b3, voffB); PG8_STAGE(PG8_SB(1, 1), b3 + hstep, voffB); PG8_STAGE(PG8_SA(1, 0), a3, ca0);
            PG8_WAIT_V(8); PG8_WAIT_L(0); PG8_BAR; PG8_MMA(1, 0, At, B0); PG8_MMA(1, 1, At, B1); PG8_BAR; PG8_SCHED;
        }
        {
            const char* a1 = cA + (size_t)(nt - 1) * akstep;
            const char* a2 = cA; const char* b2 = nB; const char* a3 = a2 + akstep; const char* b3 = b2 + kstep;
            PG8_LDB(B0, 0, 0); PG8_LDB(B1, 0, 1); PG8_SCHED; PG8_LDA(At, 0, 0); PG8_STAGE(PG8_SA(1, 1), a1, ca1);
            PG8_WAIT_V(8); PG8_WAIT_L(0); PG8_BAR; PG8_MMA(0, 0, At, B0); PG8_MMA(0, 1, At, B1); PG8_BAR; PG8_SCHED;
            PG8_LDA(At, 0, 1); PG8_STAGE(PG8_SB(0, 0), b2, voffB); PG8_STAGE(PG8_SB(0, 1), b2 + hstep, voffB); PG8_STAGE(PG8_SA(0, 0), a2, na0);
            PG8_WAIT_V(8); PG8_WAIT_L(0); PG8_BAR; PG8_MMA(1, 0, At, B0); PG8_MMA(1, 1, At, B1); PG8_BAR; PG8_SCHED;
            PG8_LDB(B0, 1, 0); PG8_LDB(B1, 1, 1); PG8_SCHED; PG8_LDA(At, 1, 0); PG8_STAGE(PG8_SA(0, 1), a2, na1);
            PG8_WAIT_V(8); PG8_WAIT_L(0); PG8_BAR; PG8_MMA(0, 0, At, B0); PG8_MMA(0, 1, At, B1); PG8_BAR; PG8_SCHED;
            PG8_LDA(At, 1, 1); PG8_STAGE(PG8_SB(1, 0), b3, voffB); PG8_STAGE(PG8_SB(1, 1), b3 + hstep, voffB); PG8_STAGE(PG8_SA(1, 0), a3, na0);
            PG8_WAIT_V(8); PG8_WAIT_L(0); PG8_BAR; PG8_MMA(1, 0, At, B0); PG8_MMA(1, 1, At, B1); PG8_BAR; PG8_SCHED;
        }
        if constexpr (ALIGN_EPI) { if (wr == 0) PG8_BAR; }
        E(acc, cur, wr, wc, fr, fq);
        if (!has_next) break;
#pragma unroll
        for (int a = 0; a < 2; ++a)
#pragma unroll
            for (int b = 0; b < 2; ++b)
#pragma unroll
                for (int m = 0; m < 4; ++m)
#pragma unroll
                    for (int n = 0; n < 2; ++n) acc[a][b][m][n] = (f32x4){zf_, zf_, zf_, zf_};
        cur = nxt; cB = nB; ++ui; ca0[0] = na0[0]; ca0[1] = na0[1]; ca1[0] = na1[0]; ca1[1] = na1[1];
        if constexpr (ALIGN_EPI) { if (wr == 1) PG8_BAR; }
    }
    PG8_WAIT_V(0);
    if constexpr (!ALIGN_EPI) { if (wr == 0) PG8_BAR; }
    PG8_BAR;
#undef PG8_AOFF
#undef PG8_SA
#undef PG8_SB
#undef PG8_STAGE
#undef PG8_LDA
#undef PG8_LDB
#undef PG8_MMA
#undef PG8_WAIT_V
#undef PG8_WAIT_L
#undef PG8_BAR
#undef PG8_SCHED
}

}
namespace mk {
using namespace nv;
typedef unsigned short bf16_t;
typedef unsigned u32x4 __attribute__((ext_vector_type(4)));
typedef float f32x4 __attribute__((ext_vector_type(4)));
#define LAS __attribute__((address_space(3)))
constexpr int NT = 512;
constexpr int PB = 2816;
constexpr int NPAD = 3072;
constexpr int C_KV = 512, C_FOX = 1280, C_SB = 2048, C_GATE = 2816;
constexpr int MAXT = MROWS / 256 + NE;
constexpr int PROWS = MAXT * 256;
#define CNT_IDX(l, e) (8192 + ((l) * NE + (e)) * 32)
__device__ __forceinline__ int ftid() { int t = threadIdx.x; asm volatile("" : "+v"(t)); return t; }
__device__ __forceinline__ int fbid() { int b = blockIdx.x; asm volatile("" : "+s"(b)); return b; }
#define MK_LOOP(vb, n) for (int vb = fbid(); vb < (n); vb += gridDim.x)

constexpr size_t al_(size_t x) { return (x + 4095) & ~(size_t)4095; }
constexpr size_t O_WTIN = 0;
constexpr size_t O_WTOUT = O_WTIN + al_((size_t)L_ * NPAD * D_ * 2);
constexpr size_t O_WTGU = O_WTOUT + al_((size_t)L_ * D_ * D_ * 2);
constexpr size_t O_WTDN = O_WTGU + al_((size_t)L_ * NE * 2048 * D_ * 2);
constexpr size_t O_BIASP = O_WTDN + al_((size_t)L_ * NE * D_ * D_ * 2);
constexpr size_t O_XB = O_BIASP + al_((size_t)L_ * NPAD * 4);
constexpr size_t O_PROJB = O_XB + al_((size_t)T_ * D_ * 2);
constexpr size_t O_GF = O_PROJB + al_((size_t)T_ * PB * 2);
constexpr size_t O_CFOX = O_GF + al_((size_t)T_ * 32 * 4);
constexpr size_t O_KCMP = O_CFOX + al_((size_t)B_ * 4 * S_ * 4);
constexpr size_t O_VCMP = O_KCMP + al_((size_t)B_ * 2 * 512 * 64 * 4);
constexpr size_t O_O = O_VCMP + al_((size_t)B_ * 2 * 512 * 64 * 4);
constexpr size_t O_OB = O_O + al_((size_t)T_ * D_ * 4);
constexpr size_t O_PTOT = O_OB + al_((size_t)T_ * D_ * 2);
constexpr size_t O_SEL = O_PTOT + al_((size_t)B_ * 2 * S_ * 512 * 4);
constexpr size_t O_MIX = O_SEL + al_((size_t)B_ * 2 * S_ * NSEL * 4);
constexpr size_t O_X1 = O_MIX + al_((size_t)T_ * D_ * 4);
constexpr size_t O_X1B = O_X1 + al_((size_t)T_ * D_ * 4);
constexpr size_t O_XA = O_X1B + al_((size_t)T_ * D_ * 2);
constexpr size_t O_ACT = O_XA + al_((size_t)T_ * D_ * 4);
constexpr size_t O_Y = O_ACT + al_((size_t)PROWS * D_ * 2);
constexpr size_t O_TOPE = O_Y + al_((size_t)PROWS * D_ * 2);
constexpr size_t O_TOPW = O_TOPE + al_((size_t)MROWS * 4);
constexpr size_t O_POS = O_TOPW + al_((size_t)MROWS * 4);
constexpr size_t O_ROWTOK = O_POS + al_((size_t)MROWS * 4);
constexpr size_t O_ROWW = O_ROWTOK + al_((size_t)PROWS * 4);
constexpr size_t O_SLOT = O_ROWW + al_((size_t)PROWS * 4);
constexpr size_t O_COUNTS = O_SLOT + al_((size_t)MROWS * 4);
constexpr size_t O_META = O_COUNTS + 65536;
constexpr size_t O_OWIN = O_META + 4096;
constexpr size_t O_O2 = O_OWIN + al_((size_t)T_ * 512 * 4);
constexpr size_t O_OWIN2 = O_O2 + al_((size_t)T_ * D_ * 4);
constexpr size_t O_KCMPB = O_OWIN2 + al_((size_t)T_ * 512 * 4);
constexpr size_t O_VCMPB = O_KCMPB + al_((size_t)B_ * 2 * 512 * 64 * 2);
constexpr size_t O_OCMP = O_VCMPB + al_((size_t)B_ * 2 * 512 * 64 * 2);
constexpr size_t O_SELMASK = O_OCMP + al_((size_t)T_ * 512 * 4);
constexpr size_t O_WT1 = O_SELMASK + al_((size_t)B_ * 2 * S_ * 16);
constexpr size_t O_BIAS1 = O_WT1 + al_((size_t)L_ * 2 * 256 * 2048 * 2);
constexpr size_t O_HID = O_BIAS1 + al_((size_t)L_ * 2 * 128 * 4);
constexpr size_t O_BIAS1P = O_HID + al_((size_t)8 * 512 * 128 * 2);
constexpr size_t O_END = O_BIAS1P + al_((size_t)L_ * 2 * 64 * 128 * 4);

struct P {
    In in; unsigned char* ws; float* out;
};
typedef const __attribute__((address_space(4))) P* KP;
__device__ __forceinline__ KP fresh_kp() { KP k = (KP)__builtin_amdgcn_kernarg_segment_ptr(); asm volatile("" : "+s"(k)); return k; }
#define WSP(T, off) ((T*)(p->ws + (off)))

__device__ __forceinline__ float bf2f(unsigned short b) { return __uint_as_float((unsigned)b << 16); }
__device__ __forceinline__ unsigned f2bf(float f) { unsigned u = __float_as_uint(f); return (u + 0x7fffu + ((u >> 16) & 1u)) >> 16; }
__device__ __forceinline__ unsigned pk2(float lo, float hi) { return f2bf(lo) | (f2bf(hi) << 16); }
__device__ __forceinline__ void ld8(const bf16_t* __restrict__ src, float* dst) {
    const u32x4 v = *(const u32x4*)src;
    dst[0] = __uint_as_float(v.x << 16); dst[1] = __uint_as_float(v.x & 0xffff0000u); dst[2] = __uint_as_float(v.y << 16); dst[3] = __uint_as_float(v.y & 0xffff0000u);
    dst[4] = __uint_as_float(v.z << 16); dst[5] = __uint_as_float(v.z & 0xffff0000u); dst[6] = __uint_as_float(v.w << 16); dst[7] = __uint_as_float(v.w & 0xffff0000u);
}


__device__ __forceinline__ int perm_in(int n) {
    if (n < 1280) return n;
    if (n < 1304) return C_GATE + (n - 1280);
    if (n < 2072) return C_FOX + (n - 1304);
    if (n < 2076) return C_GATE + 24 + (n - 2072);
    return C_SB + (n - 2076);
}
__device__ __forceinline__ int perm_gu(int n) { const int up = n >> 10, c = n & 1023; return 256 * (c >> 7) + 128 * up + (c & 127); }
template <int MAP>
__device__ __forceinline__ void transpose_item(const float* __restrict__ W, int K, int N, bf16_t* __restrict__ WT, LAS float* scr, int item, int lane) {
    const int nblk = (N + 31) / 32, kb = item / nblk, nb = item % nblk, k0 = 64 * kb, n0 = 32 * nb;
    { const int n4 = (lane & 7) * 4; const bool okn = (n0 + n4) < N;
      f32x4 t[8];
#pragma unroll
      for (int i = 0; i < 8; ++i) { const int kk = (lane >> 3) + 8 * i; t[i] = okn ? *(const f32x4*)(W + (size_t)(k0 + kk) * N + n0 + n4) : (f32x4){0.f, 0.f, 0.f, 0.f}; }
#pragma unroll
      for (int i = 0; i < 8; ++i) { const int kk = (lane >> 3) + 8 * i; LAS float* d = scr + kk * 33 + n4; d[0] = t[i].x; d[1] = t[i].y; d[2] = t[i].z; d[3] = t[i].w; } }
    asm volatile("s_waitcnt lgkmcnt(0)" ::: "memory");
    const int c = lane & 7;
#pragma unroll
    for (int j = 0; j < 4; ++j) { const int n = (lane >> 3) + 8 * j; const LAS float* sp = scr + (8 * c) * 33 + n;
        u32x4 o; o.x = pk2(sp[0 * 33], sp[1 * 33]); o.y = pk2(sp[2 * 33], sp[3 * 33]); o.z = pk2(sp[4 * 33], sp[5 * 33]); o.w = pk2(sp[6 * 33], sp[7 * 33]);
        const int ng = n0 + n;
        if (ng < N) { const int ro = (MAP == 1) ? perm_in(ng) : (MAP == 2) ? perm_gu(ng) : ng; *(u32x4*)(WT + (size_t)ro * K + k0 + 8 * c) = o; } }
    asm volatile("s_waitcnt lgkmcnt(0)" ::: "memory");
}
constexpr int CV_I_IN = 16 * 89, CV_I_OUT = 16 * 32, CV_I_GU = 16 * 64, CV_I_DN = 16 * 32, CV_I_W1 = 32 * 4;
constexpr int CV_N_IN = L_ * CV_I_IN, CV_N_OUT = L_ * CV_I_OUT, CV_N_GU = L_ * NE * CV_I_GU, CV_N_DN = L_ * NE * CV_I_DN, CV_N_W1 = L_ * 2 * CV_I_W1, CV_N_ALL = CV_N_IN + CV_N_OUT + CV_N_GU + CV_N_DN + CV_N_W1;
constexpr int CV_DEF_GU0 = CV_N_W1 + NE * CV_I_GU, CV_DEF_GU = NE * CV_I_GU, CV_DEF_DN0 = CV_N_W1 + CV_N_GU + NE * CV_I_DN, CV_DEF_DN = NE * CV_I_DN, CV_DEF_ALL = CV_DEF_GU + CV_DEF_DN;
__device__ __forceinline__ void cv_one(KP p, LAS float* scr, int it, int lane) {
    int r = it;
    if (r < CV_N_W1) { const int mtx = r / CV_I_W1, ll = mtx >> 1, kv = mtx & 1; transpose_item<0>((kv ? p->in.w1v : p->in.w1k) + (size_t)ll * 2048 * 128, 2048, 128, WSP(bf16_t, O_WT1) + (size_t)mtx * 256 * 2048, scr, r % CV_I_W1, lane); return; } r -= CV_N_W1;
    if (r < CV_N_GU) { const int mtx = r / CV_I_GU; transpose_item<2>(p->in.wgu + (size_t)mtx * D_ * 2048, D_, 2048, WSP(bf16_t, O_WTGU) + (size_t)mtx * 2048 * D_, scr, r % CV_I_GU, lane); return; } r -= CV_N_GU;
    if (r < CV_N_DN) { const int mtx = r / CV_I_DN; transpose_item<0>(p->in.wdn + (size_t)mtx * D_ * D_, D_, D_, WSP(bf16_t, O_WTDN) + (size_t)mtx * D_ * D_, scr, r % CV_I_DN, lane); return; } r -= CV_N_DN;
    if (r < CV_N_IN) { const int mtx = r / CV_I_IN; transpose_item<1>(p->in.w_in + (size_t)mtx * D_ * DIN, D_, DIN, WSP(bf16_t, O_WTIN) + (size_t)mtx * NPAD * D_, scr, r % CV_I_IN, lane); return; } r -= CV_N_IN;
    { const int mtx = r / CV_I_OUT; transpose_item<0>(p->in.w_out + (size_t)mtx * D_ * D_, D_, D_, WSP(bf16_t, O_WTOUT) + (size_t)mtx * D_ * D_, scr, r % CV_I_OUT, lane); }
}
__device__ __forceinline__ void cv_help(LAS unsigned char* lds, KP p, int maxchunks) {
    const int tid = ftid(), lane = tid & 63, wv = tid >> 6; LAS float* scr = (LAS float*)(lds + wv * 8448);
    unsigned* cursor = WSP(unsigned, O_COUNTS) + 64;
    for (int c = 0; c < maxchunks; ++c) {
        unsigned base = 0u; if (lane == 0) base = atomicAdd(cursor, 8u);
        base = (unsigned)__builtin_amdgcn_readfirstlane((int)base);
        if (base >= (unsigned)CV_DEF_ALL) break;
        for (int i = 0; i < 8; ++i) { const int d = (int)base + i; if (d < CV_DEF_ALL) cv_one(p, scr, d < CV_DEF_GU ? CV_DEF_GU0 + d : CV_DEF_DN0 + (d - CV_DEF_GU), lane); }
    }
}
__device__ __forceinline__ void ph_convert(LAS unsigned char* lds, KP p) {
    const int tid = ftid(), lane = tid & 63, wv = tid >> 6;
    LAS float* scr = (LAS float*)(lds + wv * 8448);
    const int gw = fbid() * 8 + wv, NGW = gridDim.x * 8;
    for (int it = gw; it < CV_N_ALL; it += NGW) {
        if ((it >= CV_DEF_GU0 && it < CV_DEF_GU0 + CV_DEF_GU) || (it >= CV_DEF_DN0 && it < CV_DEF_DN0 + CV_DEF_DN)) continue;
        cv_one(p, scr, it, lane);
    }
    const int gt = fbid() * NT + tid, NG = gridDim.x * NT;
    for (int i = gt; i < L_ * (NPAD - DIN) * (D_ / 8); i += NG) { const int l = i / ((NPAD - DIN) * (D_ / 8)), r = i % ((NPAD - DIN) * (D_ / 8));
        unsigned z_ = 0u; asm volatile("" : "+v"(z_));
        *(u32x4*)(WSP(bf16_t, O_WTIN) + ((size_t)l * NPAD + DIN) * D_ + (size_t)r * 8) = (u32x4){z_, z_, z_, z_}; }
    for (int i = gt; i < L_ * 2 * 128 * (2048 / 8); i += NG) { const int mtx = i / (128 * 256), r = i % (128 * 256); unsigned z_ = 0u; asm volatile("" : "+v"(z_));
        *(u32x4*)(WSP(bf16_t, O_WT1) + ((size_t)mtx * 256 + 128) * 2048 + (size_t)r * 8) = (u32x4){z_, z_, z_, z_}; }
    for (int i = gt; i < L_ * 2 * 64 * 128; i += NG) { const int j = i & 127, seg = (i >> 7) & 63, mtx = i >> 13, ll = mtx >> 1, kv = mtx & 1;
        const float* pos = (kv ? p->in.pos_v : p->in.pos_k) + (size_t)ll * 2048 + seg * 32; const float* w1 = (kv ? p->in.w1v : p->in.w1k) + (size_t)ll * 2048 * 128 + (size_t)seg * 32 * 128; float a = 0.f;
#pragma unroll 8
        for (int k = 0; k < 32; ++k) a += pos[k] * w1[(size_t)k * 128 + j];
        WSP(float, O_BIAS1P)[i] = a; }
    for (int i = gt; i < L_ * NPAD; i += NG) { const int l = i / NPAD, c = i % NPAD; if (c >= DIN) WSP(float, O_BIASP)[i] = 0.f; }
    for (int i = gt; i < L_ * DIN; i += NG) { const int l = i / DIN, n = i % DIN; WSP(float, O_BIASP)[l * NPAD + perm_in(n)] = p->in.b_in[i]; }
    for (int i = gt; i < T_ * D_ / 8; i += NG) { const f32x4 a = *(const f32x4*)(p->in.x + (size_t)i * 8), b = *(const f32x4*)(p->in.x + (size_t)i * 8 + 4);
        *(u32x4*)(WSP(bf16_t, O_XB) + (size_t)i * 8) = (u32x4){pk2(a.x, a.y), pk2(a.z, a.w), pk2(b.x, b.y), pk2(b.z, b.w)}; }
}

struct EpiProj {
    static constexpr bool PERM = true;
    bf16_t* projb; float* gf; const float* bias;
    __device__ __forceinline__ void operator()(const pg8::f32x4 (&acc)[2][2][4][2], const pg8::Unit& u, int wr, int wc, int fr, int fq) const {
        const int row0 = u.pm * 256 + wr * 64 + fr, col0 = u.pn * 256 + wc * 32 + 8 * fq;
        if (u.pn < 11) {
#pragma unroll
            for (int ai = 0; ai < 2; ++ai)
#pragma unroll
                for (int m = 0; m < 4; ++m) { bf16_t* rowp = projb + (size_t)(row0 + ai * 128 + m * 16) * PB + col0;
#pragma unroll
                    for (int bj = 0; bj < 2; ++bj) { const f32x4 v0 = acc[ai][bj][m][0] + *(const f32x4*)(bias + col0 + bj * 128), v1 = acc[ai][bj][m][1] + *(const f32x4*)(bias + col0 + bj * 128 + 4);
                        u32x4 w; w.x = pg8::cvt_pk_bf16(v0[0], v0[1]); w.y = pg8::cvt_pk_bf16(v0[2], v0[3]); w.z = pg8::cvt_pk_bf16(v1[0], v1[1]); w.w = pg8::cvt_pk_bf16(v1[2], v1[3]);
                        *(u32x4*)(rowp + bj * 128) = w; }
                    asm volatile("" ::: "memory"); }
        } else if (wc == 0) {
            const f32x4 b0 = *(const f32x4*)(bias + col0), b1 = *(const f32x4*)(bias + col0 + 4);
#pragma unroll
            for (int ai = 0; ai < 2; ++ai)
#pragma unroll
                for (int m = 0; m < 4; ++m) { float* rowp = gf + (size_t)(row0 + ai * 128 + m * 16) * 32 + 8 * fq;
                    const f32x4 v0 = acc[ai][0][m][0] + b0, v1 = acc[ai][0][m][1] + b1; f32x4 o0, o1;
#pragma unroll
                    for (int i = 0; i < 4; ++i) { const int j0 = 8 * fq + i, j1 = j0 + 4;
                        o0[i] = (j0 < 24) ? sigmoidf_(v0[i]) : (j0 < 28 ? logsig(v0[i]) : 0.f); o1[i] = (j1 < 24) ? sigmoidf_(v1[i]) : (j1 < 28 ? logsig(v1[i]) : 0.f); }
                    *(f32x4*)rowp = o0; *(f32x4*)(rowp + 4) = o1; }
        }
    }
};
struct EpiOut {
    static constexpr bool PERM = true;
    const float* x; float* y1;
    __device__ __forceinline__ void operator()(const pg8::f32x4 (&acc)[2][2][4][2], const pg8::Unit& u, int wr, int wc, int fr, int fq) const {
        const int row0 = u.pm * 256 + wr * 64 + fr, col0 = u.pn * 256 + wc * 32 + 8 * fq;
#pragma unroll
        for (int ai = 0; ai < 2; ++ai)
#pragma unroll
            for (int m = 0; m < 4; ++m) { const size_t off = (size_t)(row0 + ai * 128 + m * 16) * D_ + col0;
#pragma unroll
                for (int bj = 0; bj < 2; ++bj) { const f32x4 x0 = *(const f32x4*)(x + off + bj * 128), x1 = *(const f32x4*)(x + off + bj * 128 + 4);
                    *(f32x4*)(y1 + off + bj * 128) = x0 * ALPHA + acc[ai][bj][m][0]; *(f32x4*)(y1 + off + bj * 128 + 4) = x1 * ALPHA + acc[ai][bj][m][1]; }
                asm volatile("" ::: "memory"); }
    }
};
struct EpiGU {
    static constexpr bool PERM = true;
    bf16_t* act; const float* bgu;
    __device__ __forceinline__ void operator()(const pg8::f32x4 (&acc)[2][2][4][2], const pg8::Unit& u, int wr, int wc, int fr, int fq) const {
        const int row0 = u.pm * 256 + wr * 64 + fr, col0 = u.pn * 128 + wc * 32 + 8 * fq;
        const float* bb = bgu + (size_t)u.e * 2048 + col0;
        const f32x4 bg0 = *(const f32x4*)bb, bg1 = *(const f32x4*)(bb + 4), bu0 = *(const f32x4*)(bb + 1024), bu1 = *(const f32x4*)(bb + 1028);
#pragma unroll
        for (int ai = 0; ai < 2; ++ai)
#pragma unroll
            for (int m = 0; m < 4; ++m) { f32x4 a0, a1;
                const f32x4 g0 = acc[ai][0][m][0] + bg0, g1 = acc[ai][0][m][1] + bg1, u0 = acc[ai][1][m][0] + bu0, u1 = acc[ai][1][m][1] + bu1;
#pragma unroll
                for (int i = 0; i < 4; ++i) { const float gt0 = fminf(g0[i], 7.0f), up0 = fminf(fmaxf(u0[i], -7.0f), 7.0f), gt1 = fminf(g1[i], 7.0f), up1 = fminf(fmaxf(u1[i], -7.0f), 7.0f);
                    a0[i] = gt0 * sigmoidf_(1.702f * gt0) * (up0 + 1.0f); a1[i] = gt1 * sigmoidf_(1.702f * gt1) * (up1 + 1.0f); }
                u32x4 w; w.x = pg8::cvt_pk_bf16(a0[0], a0[1]); w.y = pg8::cvt_pk_bf16(a0[2], a0[3]); w.z = pg8::cvt_pk_bf16(a1[0], a1[1]); w.w = pg8::cvt_pk_bf16(a1[2], a1[3]);
                *(u32x4*)(act + (size_t)(row0 + ai * 128 + m * 16) * D_ + col0) = w; asm volatile("" ::: "memory"); }
    }
};
struct EpiDN {
    static constexpr bool PERM = true;
    bf16_t* y; const float* bdn; const float* roww;
    __device__ __forceinline__ void operator()(const pg8::f32x4 (&acc)[2][2][4][2], const pg8::Unit& u, int wr, int wc, int fr, int fq) const {
        const int row0 = u.pm * 256 + wr * 64 + fr, col0 = u.pn * 256 + wc * 32 + 8 * fq;
        const float* bb = bdn + (size_t)u.e * D_ + col0;
#pragma unroll
        for (int ai = 0; ai < 2; ++ai)
#pragma unroll
            for (int m = 0; m < 4; ++m) { const int row = row0 + ai * 128 + m * 16; const float w = roww[row];
#pragma unroll
                for (int bj = 0; bj < 2; ++bj) { const f32x4 v0 = (acc[ai][bj][m][0] + *(const f32x4*)(bb + bj * 128)) * w, v1 = (acc[ai][bj][m][1] + *(const f32x4*)(bb + bj * 128 + 4)) * w;
                    u32x4 o; o.x = pg8::cvt_pk_bf16(v0[0], v0[1]); o.y = pg8::cvt_pk_bf16(v0[2], v0[3]); o.z = pg8::cvt_pk_bf16(v1[0], v1[1]); o.w = pg8::cvt_pk_bf16(v1[2], v1[3]);
                    *(u32x4*)(y + (size_t)row * D_ + col0 + bj * 128) = o; }
                asm volatile("" ::: "memory"); }
    }
};
struct EpiCmp {
    static constexpr bool PERM = true;
    bf16_t* hid; const float* bias1;
    __device__ __forceinline__ void operator()(const pg8::f32x4 (&acc)[2][2][4][2], const pg8::Unit& u, int wr, int wc, int fr, int fq) const {
        const int row0 = u.pm * 256 + wr * 64 + fr, col0 = wc * 32 + 8 * fq;
        const float* bb = bias1 + (u.e & 1) * 128 + col0; const f32x4 b0 = *(const f32x4*)bb, b1 = *(const f32x4*)(bb + 4);
#pragma unroll
        for (int ai = 0; ai < 2; ++ai)
#pragma unroll
            for (int m = 0; m < 4; ++m) { const f32x4 v0 = acc[ai][0][m][0] + b0, v1 = acc[ai][0][m][1] + b1;
                u32x4 w; w.x = pg8::cvt_pk_bf16(gelu_tanh(v0[0]), gelu_tanh(v0[1])); w.y = pg8::cvt_pk_bf16(gelu_tanh(v0[2]), gelu_tanh(v0[3])); w.z = pg8::cvt_pk_bf16(gelu_tanh(v1[0]), gelu_tanh(v1[1])); w.w = pg8::cvt_pk_bf16(gelu_tanh(v1[2]), gelu_tanh(v1[3]));
                *(u32x4*)(hid + ((size_t)u.e * 512 + row0 + ai * 128 + m * 16) * 128 + col0) = w; asm volatile("" ::: "memory"); }
    }
};
struct GEpi {
    static constexpr bool PERM = true;
    int kind, l;
    __device__ __forceinline__ void operator()(const pg8::f32x4 (&acc)[2][2][4][2], const pg8::Unit& u, int wr, int wc, int fr, int fq) const {
        const KP p = fresh_kp();
        if (kind == 0) { const EpiProj e{WSP(bf16_t, O_PROJB), WSP(float, O_GF), WSP(float, O_BIASP) + l * NPAD}; e(acc, u, wr, wc, fr, fq); }
        else if (kind == 1) { const EpiOut e{(l == 0) ? p->in.x : WSP(float, O_XA), WSP(float, O_MIX)}; e(acc, u, wr, wc, fr, fq); }
        else if (kind == 2) { const EpiGU e{WSP(bf16_t, O_ACT), p->in.bgu + (size_t)l * NE * 2048}; e(acc, u, wr, wc, fr, fq); }
        else if (kind == 3) { const EpiDN e{WSP(bf16_t, O_Y), p->in.bdn + (size_t)l * NE * D_, WSP(float, O_ROWW)}; e(acc, u, wr, wc, fr, fq); }
        else { const EpiCmp e{WSP(bf16_t, O_HID), WSP(float, O_BIAS1) + l * 256}; e(acc, u, wr, wc, fr, fq); }
    }
};
struct GSched {
    int kind, nM, nN, nunits, G, c; const int* meta; const int* rowtok; const char* Bt; size_t estep;
    __device__ __forceinline__ bool next(int i, pg8::Unit& u) const {
        const int L = i * G + c; if (L >= nunits) return false;
        if (kind == 1) {
            int wgid = L; { const int q = nunits / pg8::NXCD, r = nunits % pg8::NXCD, xcd = wgid % pg8::NXCD, off = wgid / pg8::NXCD; wgid = (xcd < r ? xcd * (q + 1) : r * (q + 1) + (xcd - r) * q) + off; }
            const int nig = pg8::WGM * nN, gid = wgid / nig, fm = gid * pg8::WGM, gsz = (nM - fm) < pg8::WGM ? (nM - fm) : pg8::WGM;
            u.pm = fm + ((wgid % nig) % gsz); u.pn = (wgid % nig) / gsz; u.e = 0; u.nr = 256;
        } else if (kind == 4) { u.e = L >> 1; u.pm = L & 1; u.pn = 0; u.nr = (L & 1) ? 255 : 256; }
        else if (kind == 0) { const int gt = L / nN; u.pm = gt; u.pn = L - gt * nN; u.e = 0; u.nr = 256; }
        else { const int gt = L / nN; u.pm = gt; u.pn = L - gt * nN; u.e = meta[64 + 2 * gt]; u.nr = meta[65 + 2 * gt]; }
        return true; }
    __device__ __forceinline__ unsigned a_off(const pg8::Unit& u, int r) const { const int rr = r < u.nr ? r : u.nr - 1; const int row = u.pm * 256 + rr;
        if (kind == 4) { const int kv = u.e & 1, bg = u.e >> 1; return (unsigned)(((bg >> 1) * S_ + 16 * row) * PB + C_KV + ((0 * 2 + kv) * 2 + (bg & 1)) * 64) * 2u; }
        return (unsigned)((kind == 2) ? rowtok[row] : row) * (unsigned)(D_ * 2); }
    __device__ __forceinline__ size_t a_kstep() const { return kind == 4 ? (size_t)PB * 2 : (size_t)128; }
    __device__ __forceinline__ const char* b_base(const pg8::Unit& u) const { return Bt + (size_t)(kind == 4 ? (u.e & 1) : u.e) * estep + (size_t)u.pn * ((size_t)256 * D_ * 2); }
};

__device__ __forceinline__ void ph_rmsnorm(KP p, int l) {
    const int lane = ftid() & 63, wv = ftid() >> 6; const float* g = p->in.g_out + (size_t)l * D_;
    constexpr int NB = 4; const int rstride = (int)gridDim.x * 8;
    f32x4 gg[4];
#pragma unroll
    for (int j = 0; j < 2; ++j) { gg[2 * j] = *(const f32x4*)(g + 512 * j + lane * 8); gg[2 * j + 1] = *(const f32x4*)(g + 512 * j + lane * 8 + 4); }
    for (int row0 = fbid() * 8 + wv; row0 < T_; row0 += rstride * NB) {
        u32x4 ra[NB], rb2[NB], rw2[NB];
#pragma unroll
        for (int bi = 0; bi < NB; ++bi) { const int row = (row0 + bi * rstride < T_) ? row0 + bi * rstride : row0; const bf16_t* r = WSP(bf16_t, O_O) + (size_t)row * D_ + lane * 8;
            ra[bi] = *(const u32x4*)r; rb2[bi] = *(const u32x4*)(r + 512); rw2[bi] = *(const u32x4*)(WSP(bf16_t, O_OWIN) + (size_t)row * 512 + lane * 8); }
#pragma unroll
        for (int bi = 0; bi < NB; ++bi) { const int row = row0 + bi * rstride; if (row < T_) {
#define BF_LO(u) __uint_as_float((u) << 16)
#define BF_HI(u) __uint_as_float((u) & 0xffff0000u)
            const f32x4 x0 = (f32x4){BF_LO(ra[bi].x) + BF_LO(rw2[bi].x), BF_HI(ra[bi].x) + BF_HI(rw2[bi].x), BF_LO(ra[bi].y) + BF_LO(rw2[bi].y), BF_HI(ra[bi].y) + BF_HI(rw2[bi].y)};
            const f32x4 x1 = (f32x4){BF_LO(ra[bi].z) + BF_LO(rw2[bi].z), BF_HI(ra[bi].z) + BF_HI(rw2[bi].z), BF_LO(ra[bi].w) + BF_LO(rw2[bi].w), BF_HI(ra[bi].w) + BF_HI(rw2[bi].w)};
            const f32x4 y0 = (f32x4){BF_LO(rb2[bi].x), BF_HI(rb2[bi].x), BF_LO(rb2[bi].y), BF_HI(rb2[bi].y)}, y1 = (f32x4){BF_LO(rb2[bi].z), BF_HI(rb2[bi].z), BF_LO(rb2[bi].w), BF_HI(rb2[bi].w)};
#undef BF_LO
#undef BF_HI
            float s = (x0.x * x0.x + x0.y * x0.y) + (x0.z * x0.z + x0.w * x0.w) + (x1.x * x1.x + x1.y * x1.y) + (x1.z * x1.z + x1.w * x1.w);
            float s2 = (y0.x * y0.x + y0.y * y0.y) + (y0.z * y0.z + y0.w * y0.w) + (y1.x * y1.x + y1.y * y1.y) + (y1.z * y1.z + y1.w * y1.w);
            const float sc0 = rsqrtf(wsum(s) * (1.f / 512.f) + RMS_EPS);
#pragma unroll
            for (int o = 1; o < 32; o <<= 1) s2 += __shfl_xor(s2, o);
            const float sc1 = rsqrtf(s2 * (1.f / 256.f) + RMS_EPS);
            const f32x4 u0 = x0 * sc0 * gg[0], u1 = x1 * sc0 * gg[1], w0 = y0 * sc1 * gg[2], w1 = y1 * sc1 * gg[3];
            bf16_t* ro = WSP(bf16_t, O_OB) + (size_t)row * D_;
            *(u32x4*)(ro + lane * 8) = (u32x4){pk2(u0.x, u0.y), pk2(u0.z, u0.w), pk2(u1.x, u1.y), pk2(u1.z, u1.w)};
            *(u32x4*)(ro + 512 + lane * 8) = (u32x4){pk2(w0.x, w0.y), pk2(w0.z, w0.w), pk2(w1.x, w1.y), pk2(w1.z, w1.w)}; } }
    }
}
template <bool ROUTER>
__device__ __forceinline__ void ph_ln(float* lds, KP p, int l, float* __restrict__ yout, int cnt_off = 0) {
    const int lane = ftid() & 63, wv = ftid() >> 6;
    const float* g = (ROUTER ? p->in.ln1_g : p->in.ln2_g) + (size_t)l * D_; const float* bb = (ROUTER ? p->in.ln1_b : p->in.ln2_b) + (size_t)l * D_;
    constexpr int NB = ROUTER ? 4 : 2;
    const int rstride = (int)gridDim.x * 8;
    for (int row0 = fbid() * 8 + wv; row0 < T_; row0 += rstride * NB) {
        float v[NB][16];
        if (ROUTER) {
#pragma unroll
            for (int bi = 0; bi < NB; ++bi) { const int row = row0 + bi * rstride; const float* src = WSP(float, O_MIX) + (size_t)(row < T_ ? row : row0) * D_;
#pragma unroll
                for (int j = 0; j < 2; ++j) { const f32x4 a = *(const f32x4*)(src + 512 * j + lane * 8), b = *(const f32x4*)(src + 512 * j + lane * 8 + 4);
                    v[bi][8 * j + 0] = a.x; v[bi][8 * j + 1] = a.y; v[bi][8 * j + 2] = a.z; v[bi][8 * j + 3] = a.w; v[bi][8 * j + 4] = b.x; v[bi][8 * j + 5] = b.y; v[bi][8 * j + 6] = b.z; v[bi][8 * j + 7] = b.w; } }
        } else { const bf16_t* y = WSP(bf16_t, O_Y);
            int sl[NB][TOPK];
#pragma unroll
            for (int bi = 0; bi < NB; ++bi) { const int row = (row0 + bi * rstride < T_) ? row0 + bi * rstride : row0;
#pragma unroll
                for (int k = 0; k < TOPK; ++k) sl[bi][k] = WSP(int, O_SLOT)[row * TOPK + k]; }
            u32x4 yv[NB][TOPK][2]; f32x4 xv[NB][4];
#pragma unroll
            for (int bi = 0; bi < NB; ++bi) { const int row = (row0 + bi * rstride < T_) ? row0 + bi * rstride : row0; const float* src = WSP(float, O_X1) + (size_t)row * D_;
#pragma unroll
                for (int j = 0; j < 2; ++j) { xv[bi][2 * j] = *(const f32x4*)(src + 512 * j + lane * 8); xv[bi][2 * j + 1] = *(const f32x4*)(src + 512 * j + lane * 8 + 4); }
#pragma unroll
                for (int k = 0; k < TOPK; ++k)
#pragma unroll
                    for (int j = 0; j < 2; ++j) yv[bi][k][j] = *(const u32x4*)(y + (size_t)sl[bi][k] * D_ + 512 * j + lane * 8); }
#pragma unroll
            for (int bi = 0; bi < NB; ++bi)
#pragma unroll
                for (int j = 0; j < 2; ++j) { float acc[8];
#pragma unroll
                    for (int e = 0; e < 8; ++e) acc[e] = 0.f;
#pragma unroll
                    for (int k = 0; k < TOPK; ++k) { const u32x4 q = yv[bi][k][j];
                        acc[0] += __uint_as_float(q.x << 16); acc[1] += __uint_as_float(q.x & 0xffff0000u); acc[2] += __uint_as_float(q.y << 16); acc[3] += __uint_as_float(q.y & 0xffff0000u);
                        acc[4] += __uint_as_float(q.z << 16); acc[5] += __uint_as_float(q.z & 0xffff0000u); acc[6] += __uint_as_float(q.w << 16); acc[7] += __uint_as_float(q.w & 0xffff0000u); }
                    const f32x4 a = xv[bi][2 * j], b = xv[bi][2 * j + 1];
                    v[bi][8 * j + 0] = ALPHA * a.x + acc[0]; v[bi][8 * j + 1] = ALPHA * a.y + acc[1]; v[bi][8 * j + 2] = ALPHA * a.z + acc[2]; v[bi][8 * j + 3] = ALPHA * a.w + acc[3];
                    v[bi][8 * j + 4] = ALPHA * b.x + acc[4]; v[bi][8 * j + 5] = ALPHA * b.y + acc[5]; v[bi][8 * j + 6] = ALPHA * b.z + acc[6]; v[bi][8 * j + 7] = ALPHA * b.w + acc[7]; } }
#pragma unroll
        for (int bi = 0; bi < NB; ++bi) { const int row = row0 + bi * rstride; if (row < T_) {
            float s = 0.f;
#pragma unroll
            for (int i = 0; i < 16; ++i) s += v[bi][i];
            const float mu = wsum(s) * (1.f / D_); float s2 = 0.f;
#pragma unroll
            for (int i = 0; i < 16; ++i) { v[bi][i] -= mu; s2 += v[bi][i] * v[bi][i]; }
            const float rstd = rsqrtf(wsum(s2) * (1.f / D_) + LN_EPS);
            bf16_t* ybf = (ROUTER ? WSP(bf16_t, O_X1B) : WSP(bf16_t, O_XB)) + (size_t)row * D_;
#pragma unroll
            for (int j = 0; j < 2; ++j) { const int c0 = 512 * j + lane * 8; float o8[8];
                const f32x4 g0 = *(const f32x4*)(g + c0), g1 = *(const f32x4*)(g + c0 + 4), b0 = *(const f32x4*)(bb + c0), b1 = *(const f32x4*)(bb + c0 + 4);
                o8[0] = v[bi][8 * j + 0] * rstd * g0.x + b0.x; o8[1] = v[bi][8 * j + 1] * rstd * g0.y + b0.y; o8[2] = v[bi][8 * j + 2] * rstd * g0.z + b0.z; o8[3] = v[bi][8 * j + 3] * rstd * g0.w + b0.w;
                o8[4] = v[bi][8 * j + 4] * rstd * g1.x + b1.x; o8[5] = v[bi][8 * j + 5] * rstd * g1.y + b1.y; o8[6] = v[bi][8 * j + 6] * rstd * g1.z + b1.z; o8[7] = v[bi][8 * j + 7] * rstd * g1.w + b1.w;
                *(f32x4*)(yout + (size_t)row * D_ + c0) = (f32x4){o8[0], o8[1], o8[2], o8[3]};
                *(f32x4*)(yout + (size_t)row * D_ + c0 + 4) = (f32x4){o8[4], o8[5], o8[6], o8[7]};
                *(u32x4*)(ybf + c0) = (u32x4){pk2(o8[0], o8[1]), pk2(o8[2], o8[3]), pk2(o8[4], o8[5]), pk2(o8[6], o8[7])}; } } }
    }
    if (ROUTER) {
        const float* rw = p->in.rw + (size_t)l * D_ * NE; const float* rb = p->in.rb + (size_t)l * NE;
        float* wl = lds; float* rl = lds + 16384 + wv * 2048; float* lgl = lds + 32768 + wv * 256;
        int nrow = 0; for (int r_ = fbid() * 8 + wv; r_ < T_; r_ += (int)gridDim.x * 8) { ++nrow; asm volatile("" : "+s"(nrow)); }
        const int e = lane & 31, half = lane >> 5;
        float acc[2][4];
#pragma unroll
        for (int gi = 0; gi < 2; ++gi)
#pragma unroll
            for (int bi = 0; bi < 4; ++bi) acc[gi][bi] = 0.f;
#pragma unroll 1
        for (int c = 0; c < 2; ++c) {
            __syncthreads();
#pragma unroll
            for (int i = 0; i < 8; ++i) { const int f4 = i * NT + ftid(); *(f32x4*)(wl + 4 * f4) = *(const f32x4*)(rw + (size_t)c * 512 * NE + 4 * f4); }
            __syncthreads();
#pragma unroll
            for (int gi = 0; gi < 2; ++gi) {
                asm volatile("s_waitcnt lgkmcnt(0)" ::: "memory");
#pragma unroll
                for (int bi = 0; bi < 4; ++bi) { const int ri = (4 * gi + bi < nrow) ? 4 * gi + bi : 0; const float* src = yout + (size_t)(fbid() * 8 + wv + ri * (int)gridDim.x * 8) * D_ + c * 512 + lane * 8;
                    *(f32x4*)(rl + bi * 512 + lane * 8) = *(const f32x4*)src; *(f32x4*)(rl + bi * 512 + lane * 8 + 4) = *(const f32x4*)(src + 4); }
                asm volatile("s_waitcnt lgkmcnt(0)" ::: "memory");
                const float* wp = wl + (half * 256) * NE + e; const float* rp = rl + half * 256;
#pragma unroll 4
                for (int kk = 0; kk < 64; ++kk) { const float w0 = wp[(4 * kk) * NE], w1 = wp[(4 * kk + 1) * NE], w2 = wp[(4 * kk + 2) * NE], w3 = wp[(4 * kk + 3) * NE];
#pragma unroll
                    for (int bi = 0; bi < 4; ++bi) { const f32x4 r = *(const f32x4*)(rp + bi * 512 + 4 * kk); acc[gi][bi] += (r.x * w0 + r.y * w1) + (r.z * w2 + r.w * w3); } }
            }
        }
#pragma unroll
        for (int gi = 0; gi < 2; ++gi)
#pragma unroll
            for (int bi = 0; bi < 4; ++bi) { const float t = acc[gi][bi] + __shfl_xor(acc[gi][bi], 32); if (lane < 32) lgl[(4 * gi + bi) * 32 + e] = t; }
        asm volatile("s_waitcnt lgkmcnt(0)" ::: "memory");
        int* lcnt = (int*)(lds + 32768 + 8 * 256);
        if (ftid() < NE) lcnt[ftid()] = 0;
        __syncthreads();
#pragma unroll 1
        for (int ri = 0; ri < nrow; ++ri) { const int row = fbid() * 8 + wv + ri * (int)gridDim.x * 8;
            const int e = lane & 31; const float lg = lgl[ri * 32 + e] + rb[e];
            float cur = lg, tv0 = 0.f, den = 0.f, myw = 0.f; int mye = 0;
#pragma unroll
            for (int k = 0; k < TOPK; ++k) { float bv = cur; int bi = e;
#pragma unroll
                for (int o = 16; o >= 1; o >>= 1) { const float ov = __shfl_xor(bv, o); const int oi = __shfl_xor(bi, o); if (ov > bv || (ov == bv && oi < bi)) { bv = ov; bi = oi; } }
                if (k == 0) tv0 = bv;
                const float w = __expf(bv - tv0); den += w;
                if (lane == k) { mye = bi; myw = w; }
                if (e == bi) cur = -3.4e38f; }
            if (lane < TOPK) { WSP(int, O_TOPE)[row * TOPK + lane] = mye; WSP(float, O_TOPW)[row * TOPK + lane] = myw / den; WSP(int, O_POS)[row * TOPK + lane] = atomicAdd(&lcnt[mye], 1); } }
        __syncthreads();
        if (ftid() < NE) { const int c = lcnt[ftid()]; lcnt[ftid()] = (c > 0) ? atomicAdd(WSP(int, O_COUNTS) + CNT_IDX(l, ftid()) + cnt_off, c) : 0; }
        __syncthreads();
#pragma unroll 1
        for (int ri = 0; ri < nrow; ++ri) { const int row = fbid() * 8 + wv + ri * (int)gridDim.x * 8;
            if (lane < TOPK) WSP(int, O_POS)[row * TOPK + lane] += lcnt[WSP(int, O_TOPE)[row * TOPK + lane]]; }
        __syncthreads();
    }
}
__device__ __forceinline__ void ph_bias1_reduce(KP p, int l) {
    if (fbid() != (int)gridDim.x - 1) return;
    const int tid = ftid(); if (tid < 256) { const float* pp = WSP(float, O_BIAS1P) + ((size_t)(l * 2 + (tid >> 7)) * 64) * 128 + (tid & 127);
        float v[64];
#pragma unroll
        for (int s = 0; s < 64; ++s) v[s] = pp[s * 128];
        float a = 0.f;
#pragma unroll
        for (int s = 0; s < 64; ++s) a += v[s];
        WSP(float, O_BIAS1)[l * 256 + tid] = a; }
}
__device__ __forceinline__ void ph_cumsum(float* lds, KP p, int blk0) {
    const int tid = ftid(), lane = tid & 63, wv = tid >> 6; const int bh = fbid() - blk0;
    if (bh < 0 || bh >= B_ * 4) return;
    const int b = bh >> 2, h = bh & 3; const float* gf = WSP(float, O_GF) + (size_t)(b * S_ + tid * 16) * 32 + 24 + h;
    float v[16], run = 0.f;
#pragma unroll
    for (int i = 0; i < 16; ++i) { run += gf[(size_t)i * 32]; v[i] = run; }
    float inc = run;
#pragma unroll
    for (int o = 1; o < 64; o <<= 1) { const float t = __shfl_up(inc, o); if (lane >= o) inc += t; }
    if (lane == 63) lds[wv] = inc;
    __syncthreads();
    float woff = 0.f;
#pragma unroll
    for (int i = 0; i < 8; ++i) woff += (i < wv) ? lds[i] : 0.f;
    const float off = woff + inc - run; float* c = WSP(float, O_CFOX) + (size_t)bh * S_ + tid * 16;
#pragma unroll
    for (int i = 0; i < 4; ++i) *(f32x4*)(c + 4 * i) = (f32x4){v[4 * i] + off, v[4 * i + 1] + off, v[4 * i + 2] + off, v[4 * i + 3] + off};
    __syncthreads();
}
__device__ __forceinline__ void ph_prep2(KP p, int l) {
    { unsigned* kmax2 = WSP(unsigned, O_COUNTS) + 192 + l * 8;
      for (int i = fbid() * NT + ftid(); i < B_ * 4 * S_ * 2; i += gridDim.x * NT) { const int half = i & 1, t = (i >> 1) % S_, bh = (i >> 1) / S_, b = bh >> 2, h = bh & 3;
          const bf16_t* kr = WSP(bf16_t, O_PROJB) + (size_t)(b * S_ + t) * PB + C_FOX + (4 + h) * 64 + half * 32; float ss = 0.f;
#pragma unroll
          for (int c = 0; c < 4; ++c) { float k8[8]; ld8(kr + 8 * c, k8);
#pragma unroll
              for (int e = 0; e < 8; ++e) ss += k8[e] * k8[e]; }
          ss += __shfl_xor(ss, 1);
#pragma unroll
          for (int o = 2; o < 64; o <<= 1) ss = fmaxf(ss, __shfl_xor(ss, o));
          if ((ftid() & 63) == 0) atomicMax(kmax2 + bh, __float_as_uint(ss)); } }
    for (int i = fbid() * NT + ftid(); i < 8 * 512 * 64; i += gridDim.x * NT) {
        const int d = i & 63, n = (i >> 6) & 511, combo = i >> 15, kv = combo & 1, bg = combo >> 1;
        const float* w2 = (kv ? p->in.w2v : p->in.w2k) + (size_t)l * 128 * 64; const bf16_t* hr = WSP(bf16_t, O_HID) + ((size_t)combo * 512 + n) * 128;
        float a = 0.f;
#pragma unroll 4
        for (int c = 0; c < 16; ++c) { float h8[8]; ld8(hr + 8 * c, h8);
#pragma unroll
            for (int e = 0; e < 8; ++e) a += h8[e] * w2[(8 * c + e) * 64 + d]; }
        (kv ? WSP(bf16_t, O_VCMPB) : WSP(bf16_t, O_KCMPB))[((size_t)bg * 512 + n) * 64 + d] = (n < NCMP) ? (bf16_t)f2bf(a) : (bf16_t)0; }
}
__device__ __forceinline__ void ph_moe_scatter2(float* lds, KP p, int l) {
    const int tid = ftid(); int* ts = (int*)lds;
    const int* counts = WSP(int, O_COUNTS) + CNT_IDX(l, 0); int* meta = WSP(int, O_META); int* cl = ts + 64;
    __syncthreads();
    if (tid < NE) cl[tid] = counts[tid * 32];
    __syncthreads();
    if (tid == 0) { int nt = 0; for (int e = 0; e < NE; ++e) { ts[e] = nt; nt += (cl[e] + 255) >> 8; } ts[32] = nt; }
    __syncthreads();
    if (fbid() == 0) { if (tid < NE) { const int c = cl[tid], t0 = ts[tid]; meta[tid] = t0; for (int r = 0, t = t0; r < c; r += 256, ++t) { meta[64 + 2 * t] = tid; meta[65 + 2 * t] = (c - r) < 256 ? (c - r) : 256; } }
        if (tid == 0) meta[32] = ts[32]; }
    for (int i = fbid() * NT + tid; i < MROWS; i += gridDim.x * NT) {
        const int row = ts[WSP(int, O_TOPE)[i]] * 256 + WSP(int, O_POS)[i];
        WSP(int, O_ROWTOK)[row] = i >> 2; WSP(float, O_ROWW)[row] = WSP(float, O_TOPW)[i]; WSP(int, O_SLOT)[i] = row; }
    __syncthreads();
}
}
namespace mk {
typedef short bf16x8 __attribute__((ext_vector_type(8)));
typedef float f32x16 __attribute__((ext_vector_type(16)));
typedef float f32x2_t __attribute__((ext_vector_type(2)));
typedef __bf16 bf16x2_t __attribute__((ext_vector_type(2)));
typedef unsigned u32x2 __attribute__((ext_vector_type(2)));
typedef short v4i16_t __attribute__((ext_vector_type(4)));
__device__ __forceinline__ unsigned cvtpk(float lo, float hi) { f32x2_t v = {lo, hi}; bf16x2_t b = __builtin_convertvector(v, bf16x2_t); return __builtin_bit_cast(unsigned, b); }
constexpr int KROW = 144, VROW = 136;
constexpr int E1_K = 0, E1_V = 64 * KROW, E1_C = E1_V + 64 * KROW, E1_BUF = E1_C + 256;
constexpr int E1_FLAGS = 2 * E1_BUF;
constexpr float LOG2E = 1.4426950408889634f;
constexpr float RESC_THR = 8.0f;
#define CROW(reg, hh) (((reg) & 3) + 8 * ((reg) >> 2) + 4 * (hh))

#define SM_CORE(p0, p1, m, l, have, o0, o1) do { \
    float rm_ = fmaxf(p0[0], p1[0]); \
    _Pragma("unroll") for (int reg_ = 1; reg_ < 16; ++reg_) rm_ = fmaxf(rm_, fmaxf(p0[reg_], p1[reg_])); \
    rm_ = fmaxf(rm_, __shfl_xor(rm_, 32)); \
    const bool fin_ = rm_ > -1e37f; \
    if (__any((rm_ > RESC_THR) || (!have && fin_))) { \
        const float dl_ = have ? fmaxf(rm_, 0.f) : (fin_ ? rm_ : 0.f); const float al_ = have ? __builtin_amdgcn_exp2f(-dl_) : 1.f; \
        m += dl_; l *= al_; have = have || fin_; \
        _Pragma("unroll") for (int r_ = 0; r_ < 16; ++r_) { o0[r_] *= al_; o1[r_] *= al_; p0[r_] -= dl_; p1[r_] -= dl_; } } \
    float ls_ = 0.f; \
    _Pragma("unroll") for (int reg_ = 0; reg_ < 16; ++reg_) { p0[reg_] = __builtin_amdgcn_exp2f(p0[reg_]); p1[reg_] = __builtin_amdgcn_exp2f(p1[reg_]); ls_ += p0[reg_] + p1[reg_]; } \
    l += ls_; } while (0)

struct E1Geom { int b, q0, h; const bf16_t* qp; const bf16_t* kp; const bf16_t* vp; size_t pitch; };

template <int KIND>
__device__ __forceinline__ void e1_unit(LAS unsigned char* lds, KP p, int b, int hg, int qb, bf16_t* __restrict__ obase, bf16_t* __restrict__ owin, const unsigned* __restrict__ kmax2) {
    const int tid = ftid(), lane = tid & 63, w = __builtin_amdgcn_readfirstlane(tid >> 6), r32 = lane & 31, hh = lane >> 5;
    const bf16_t* projb = WSP(bf16_t, O_PROJB);
    int h, q0, qrow0, qcol, kcol, vcol, nrows;
    if (KIND == 0) { h = hg; q0 = qb * 256; qrow0 = q0 + 32 * w; qcol = C_FOX + h * 64; kcol = C_FOX + (4 + h) * 64; vcol = C_FOX + (8 + h) * 64; nrows = 256; }
    else if (KIND == 2) { h = hg; q0 = qb * 256; qrow0 = q0 + 32 * w; qcol = C_SB + h * 64; kcol = C_SB + (4 + h) * 64; vcol = C_SB + (8 + h) * 64; nrows = 256; }
    else { h = 4 * hg + (w & 3); q0 = qb * 64; qrow0 = q0 + 32 * (w >> 2); qcol = h * 64; kcol = C_KV + ((2 * 2 + 0) * 2 + hg) * 64; vcol = C_KV + ((2 * 2 + 1) * 2 + hg) * 64; nrows = 64; }
    const int tq = qrow0 + r32;
    const bf16_t* kbase = projb + (size_t)(b * S_) * PB + kcol; const bf16_t* vbase = projb + (size_t)(b * S_) * PB + vcol;
    bf16x8 qf[4];
    { const bf16_t* qptr = projb + (size_t)(b * S_ + tq) * PB + qcol + 8 * hh;
#pragma unroll
      for (int d0 = 0; d0 < 4; ++d0) qf[d0] = *(const bf16x8*)(qptr + 16 * d0);
      if (KIND == 1) {
#pragma unroll
          for (int d0 = 0; d0 < 4; ++d0) { u32x4 w_;
#pragma unroll
              for (int e2 = 0; e2 < 4; ++e2) { const float lo_ = bf2f((unsigned short)qf[d0][2 * e2]) * (SCALE * LOG2E), hi_ = bf2f((unsigned short)qf[d0][2 * e2 + 1]) * (SCALE * LOG2E); w_[e2] = cvtpk(lo_, hi_); }
              qf[d0] = __builtin_bit_cast(bf16x8, w_); } } }
    int j0 = 0; const int j1 = (q0 + nrows - 1) >> 6;
    if (KIND == 1) { j0 = (q0 - 511) >> 6; if (j0 < 0) j0 = 0; }
    const int ntile = j1 - j0 + 1;
    float ct2 = 0.f, sl2 = 0.f; const float* cb = nullptr;
    if (KIND == 0) { cb = WSP(float, O_CFOX) + (size_t)(b * 4 + h) * S_; ct2 = cb[tq] * LOG2E; }
    if (KIND == 1) sl2 = exp2f(-(float)(h + 1)) * LOG2E;
    bf16x8 kx0 = {0, 0, 0, 0, 0, 0, 0, 0}, kx1 = {0, 0, 0, 0, 0, 0, 0, 0}; float sl2h = 0.f, sl2l = 0.f;
    if (KIND == 1) { const unsigned one_ = 0x3f80u; const unsigned k0_ = f2bf((float)r32), k1_ = f2bf((float)(r32 + 32));
        if (hh == 0) { kx0 = __builtin_bit_cast(bf16x8, (u32x4){k0_ | (k0_ << 16), one_ | (one_ << 16), one_, 0u}); kx1 = __builtin_bit_cast(bf16x8, (u32x4){k1_ | (k1_ << 16), one_ | (one_ << 16), one_, 0u}); }
        sl2h = bf2f((unsigned short)f2bf(sl2)); sl2l = sl2 - sl2h; }
    float qkb = 0.f;
    if (KIND == 0) { float qs = 0.f;
#pragma unroll
        for (int d0 = 0; d0 < 4; ++d0)
#pragma unroll
            for (int e = 0; e < 8; ++e) { const float x = bf2f((unsigned short)qf[d0][e]); qs += x * x; }
        qs += __shfl_xor(qs, 32);
        const float km2 = __uint_as_float(kmax2[b * 4 + h]);
        qkb = sqrtf(qs * km2) * (SCALE * LOG2E * 1.01f); }
    const float tqf = (float)tq;
    const int skey = tid >> 3, sch = tid & 7;
    u32x4 rk, rv; float rc = 0.f;
#define E1_LOAD(jj) do { const size_t ro_ = (size_t)((jj) * 64 + skey) * PB + sch * 8; rk = *(const u32x4*)(kbase + ro_); rv = *(const u32x4*)(vbase + ro_); \
        if (KIND == 0 && tid < 64) rc = cb[(jj) * 64 + tid] * LOG2E; } while (0)
#define E1_WRITE(bufp) do { *(LAS u32x4*)((bufp) + E1_K + skey * KROW + sch * 16) = rk; *(LAS u32x4*)((bufp) + E1_V + skey * KROW + sch * 16) = rv; \
        if (KIND == 0 && tid < 64) ((LAS float*)((bufp) + E1_C))[tid] = rc; } while (0)
    f32x16 o0, o1;
#pragma unroll
    for (int r = 0; r < 16; ++r) { o0[r] = 0.f; o1[r] = 0.f; }
    float m = 0.f, l = 0.f, carry = 0.f; bool have = false;
    bool wave_done = false;
    LAS unsigned* flags = (LAS unsigned*)(lds + E1_FLAGS);
    if (KIND != 1) { if (tid < 8) flags[tid] = 0u; }
    __syncthreads();
    E1_LOAD(KIND != 1 ? j1 : j0);
    for (int it = 0; it < ntile; ++it) {
        const int j = (KIND != 1) ? (j1 - it) : (j0 + it);
        LAS unsigned char* buf = lds + (it & 1) * E1_BUF;
        E1_WRITE(buf);
        __syncthreads();
        if (KIND != 1) { unsigned alld = 1u;
#pragma unroll
            for (int i = 0; i < 8; ++i) alld &= flags[i];
            if (alld) break; }
        if (it + 1 < ntile) E1_LOAD((KIND != 1) ? (j - 1) : (j + 1));
        if (!(KIND != 1 && wave_done)) {
            f32x16 p0, p1;
#pragma unroll
            for (int r = 0; r < 16; ++r) { p0[r] = 0.f; p1[r] = 0.f; }
            { const LAS unsigned char* kp_ = buf + E1_K + r32 * KROW + hh * 16;
#pragma unroll
              for (int d0 = 0; d0 < 4; ++d0) { const bf16x8 a0 = *(const LAS bf16x8*)(kp_ + d0 * 32), a1 = *(const LAS bf16x8*)(kp_ + 32 * KROW + d0 * 32);
                  p0 = __builtin_amdgcn_mfma_f32_32x32x16_bf16(a0, qf[d0], p0, 0, 0, 0); p1 = __builtin_amdgcn_mfma_f32_32x32x16_bf16(a1, qf[d0], p1, 0, 0, 0); } }
            const int kb = j * 64 + 4 * hh;
            if (KIND == 2) {
                float lk0[16], lk1[16], gs[8];
#pragma unroll
                for (int reg = 0; reg < 16; ++reg) { const int kpos = kb + CROW(reg, 0);
                    const float z0 = p0[reg] * SCALE, z1 = p1[reg] * SCALE; const bool v0 = kpos < tq, v1 = kpos + 32 < tq;
                    const float lb0 = fminf(z0, 0.f) - __logf(1.f + __expf(-fabsf(z0))), lb1 = fminf(z1, 0.f) - __logf(1.f + __expf(-fabsf(z1)));
                    lk0[reg] = v0 ? (lb0 - z0) : 0.f; lk1[reg] = v1 ? (lb1 - z1) : 0.f;
                    p0[reg] = v0 ? lb0 : -INFINITY; p1[reg] = v1 ? lb1 : -INFINITY; }
#pragma unroll
                for (int g4 = 0; g4 < 4; ++g4) { gs[g4] = (lk0[4 * g4] + lk0[4 * g4 + 1]) + (lk0[4 * g4 + 2] + lk0[4 * g4 + 3]); gs[4 + g4] = (lk1[4 * g4] + lk1[4 * g4 + 1]) + (lk1[4 * g4 + 2] + lk1[4 * g4 + 3]); }
                float oth[8];
#pragma unroll
                for (int gi = 0; gi < 8; ++gi) oth[gi] = __shfl_xor(gs[gi], 32);
                float run = 0.f;
#pragma unroll
                for (int gi = 7; gi >= 0; --gi) {
                    float later = carry + run + (hh == 0 ? oth[gi] : 0.f);
#pragma unroll
                    for (int e = 3; e >= 0; --e) { const int reg = (gi & 3) * 4 + e;
                        if (gi >> 2) { p1[reg] = __expf(p1[reg] + later); later += lk1[reg]; } else { p0[reg] = __expf(p0[reg] + later); later += lk0[reg]; } }
                    run += gs[gi] + oth[gi]; }
                carry += run;
            } else {
                if (KIND == 0) {
                    const LAS float* cs = (const LAS float*)(buf + E1_C) + 4 * hh; const float ctm = ct2 - m;
#pragma unroll
                    for (int i = 0; i < 4; ++i) { const f32x4 c0 = *(const LAS f32x4*)(cs + 8 * i), c1 = *(const LAS f32x4*)(cs + 32 + 8 * i);
#pragma unroll
                        for (int e = 0; e < 4; ++e) { const int reg = 4 * i + e; p0[reg] = p0[reg] * (SCALE * LOG2E) + (ctm - c0[e]); p1[reg] = p1[reg] * (SCALE * LOG2E) + (ctm - c1[e]); } }
                    if (!(j * 64 + 63 <= qrow0)) {
#pragma unroll
                        for (int reg = 0; reg < 16; ++reg) { const int kpos = kb + CROW(reg, 0); p0[reg] = (kpos <= tq) ? p0[reg] : -INFINITY; p1[reg] = (kpos + 32 <= tq) ? p1[reg] : -INFINITY; } }
                } else {
                    { const float r_ = sl2 * ((float)(j * 64) - tqf) - m; const float rh_ = bf2f((unsigned short)f2bf(r_)), rm2_ = bf2f((unsigned short)f2bf(r_ - rh_)), rl_ = (r_ - rh_) - rm2_;
                      u32x4 qx_ = {0u, 0u, 0u, 0u}; if (hh == 0) qx_ = (u32x4){cvtpk(sl2h, sl2l), cvtpk(rh_, rm2_), cvtpk(rl_, 0.f), 0u};
                      const bf16x8 qx = __builtin_bit_cast(bf16x8, qx_);
                      p0 = __builtin_amdgcn_mfma_f32_32x32x16_bf16(kx0, qx, p0, 0, 0, 0); p1 = __builtin_amdgcn_mfma_f32_32x32x16_bf16(kx1, qx, p1, 0, 0, 0); }
                    if (!(j * 64 + 63 <= qrow0 && qrow0 + 31 - j * 64 < 512)) {
#pragma unroll
                        for (int reg = 0; reg < 16; ++reg) { const int kpos = kb + CROW(reg, 0);
                            p0[reg] = (kpos <= tq && tq - kpos < 512) ? p0[reg] : -INFINITY; p1[reg] = (kpos + 32 <= tq && tq - kpos - 32 < 512) ? p1[reg] : -INFINITY; } }
                }
                SM_CORE(p0, p1, m, l, have, o0, o1);
            }
            { const int gq_ = lane >> 4, li_ = lane & 15;
              const LAS unsigned char* tb = buf + E1_V + (4 * hh + (li_ >> 2)) * KROW + (16 * (gq_ & 1) + 4 * (li_ & 3)) * 2;
#pragma unroll
              for (int s = 0; s < 4; ++s) {
                  u32x4 pw;
                  if (s < 2) { pw.x = cvtpk(p0[8 * s + 0], p0[8 * s + 1]); pw.y = cvtpk(p0[8 * s + 2], p0[8 * s + 3]); pw.z = cvtpk(p0[8 * s + 4], p0[8 * s + 5]); pw.w = cvtpk(p0[8 * s + 6], p0[8 * s + 7]); }
                  else { const int s2 = s - 2; pw.x = cvtpk(p1[8 * s2 + 0], p1[8 * s2 + 1]); pw.y = cvtpk(p1[8 * s2 + 2], p1[8 * s2 + 3]); pw.z = cvtpk(p1[8 * s2 + 4], p1[8 * s2 + 5]); pw.w = cvtpk(p1[8 * s2 + 6], p1[8 * s2 + 7]); }
                  const bf16x8 pb = __builtin_bit_cast(bf16x8, pw);
                  const v4i16_t a0l = __builtin_amdgcn_ds_read_tr16_b64_v4i16((LAS v4i16_t*)(tb + (16 * s) * KROW)), a0h = __builtin_amdgcn_ds_read_tr16_b64_v4i16((LAS v4i16_t*)(tb + (16 * s + 8) * KROW));
                  const v4i16_t a1l = __builtin_amdgcn_ds_read_tr16_b64_v4i16((LAS v4i16_t*)(tb + (16 * s) * KROW + 64)), a1h = __builtin_amdgcn_ds_read_tr16_b64_v4i16((LAS v4i16_t*)(tb + (16 * s + 8) * KROW + 64));
                  const bf16x8 va0 = (bf16x8){a0l[0], a0l[1], a0l[2], a0l[3], a0h[0], a0h[1], a0h[2], a0h[3]}, va1 = (bf16x8){a1l[0], a1l[1], a1l[2], a1l[3], a1h[0], a1h[1], a1h[2], a1h[3]};
                  o0 = __builtin_amdgcn_mfma_f32_32x32x16_bf16(va0, pb, o0, 0, 0, 0); o1 = __builtin_amdgcn_mfma_f32_32x32x16_bf16(va1, pb, o1, 0, 0, 0); } }
            if (KIND == 0) {
                const float c0 = *(const LAS float*)(buf + E1_C); const bool dn = __all(have && (qkb + (ct2 - c0) - m < -150.f));
                if (dn && !wave_done) { wave_done = true; if (lane == 0) flags[w] = 1u; } }
            if (KIND == 2) { const bool dn = __all(carry < -110.f);
                if (dn && !wave_done) { wave_done = true; if (lane == 0) flags[w] = 1u; } }
        }
    }
    float inv = 1.f, gate = 1.f;
    if (KIND != 2) { l += __shfl_xor(l, 32); inv = (l > 0.f) ? 1.f / l : 0.f; }
    bf16_t* orow;
    if (KIND == 0) orow = obase + (size_t)(b * S_ + tq) * D_ + 512 + h * 64;
    else if (KIND == 2) orow = obase + (size_t)(b * S_ + tq) * D_ + 768 + h * 64;
    else { orow = owin + (size_t)(b * S_ + tq) * 512 + h * 64; gate = WSP(float, O_GF)[(size_t)(b * S_ + tq) * 32 + 2 * 8 + h]; }
    const float sc = inv * gate;
#pragma unroll
    for (int i = 0; i < 4; ++i) {
        *(u32x2*)(orow + 8 * i + 4 * hh) = (u32x2){cvtpk(o0[4 * i] * sc, o0[4 * i + 1] * sc), cvtpk(o0[4 * i + 2] * sc, o0[4 * i + 3] * sc)};
        *(u32x2*)(orow + 32 + 8 * i + 4 * hh) = (u32x2){cvtpk(o1[4 * i] * sc, o1[4 * i + 1] * sc), cvtpk(o1[4 * i + 2] * sc, o1[4 * i + 3] * sc)}; }
#undef E1_LOAD
#undef E1_WRITE
}
}
namespace mk {
constexpr int E2_WAVE = 64 * KROW + 512;
template <bool USE_MASK>
__device__ __forceinline__ void e2_wave_unit(LAS unsigned char* ldsw, KP p, int b, int g, int t0, bf16_t* __restrict__ obase, const bf16_t* __restrict__ csrc, int cpitch) {
    const int lane = ftid() & 63, r32 = lane & 31, hh = lane >> 5, qi = r32 >> 2, r4 = r32 & 3;
    const int h = 4 * g + r4, tq = t0 + qi;
    const bf16_t* projb = WSP(bf16_t, O_PROJB);
    const bf16_t* kbase = projb + (size_t)(b * S_) * PB + C_KV + ((1 * 2 + 0) * 2 + g) * 64;
    const bf16_t* vbase = projb + (size_t)(b * S_) * PB + C_KV + ((1 * 2 + 1) * 2 + g) * 64;
    bf16x8 qf[4];
    { const bf16_t* qptr = projb + (size_t)(b * S_ + tq) * PB + h * 64 + 8 * hh;
#pragma unroll
      for (int d0 = 0; d0 < 4; ++d0) qf[d0] = *(const bf16x8*)(qptr + 16 * d0); }
    unsigned qm0 = 0u, qm1 = 0u, qm2 = 0u, qm3 = 0u;
    if (USE_MASK) { const u32x4 mw = *(const u32x4*)(WSP(unsigned, O_SELMASK) + ((size_t)((b * 2 + g) * S_ + t0 + (lane >> 3))) * 4); qm0 = mw.x; qm1 = mw.y; qm2 = mw.z; qm3 = mw.w; }
    else { const int* sp = WSP(int, O_SEL) + ((size_t)((b * 2 + g) * S_ + t0)) * NSEL + lane * 2;
      const int e0 = sp[0], e1 = sp[1];
#pragma unroll
      for (int k = 0; k < 2; ++k) { const int e = k ? e1 : e0; const unsigned bit = 1u << (e & 31); const int wd = e >> 5;
          qm0 |= (wd == 0) ? bit : 0u; qm1 |= (wd == 1) ? bit : 0u; qm2 |= (wd == 2) ? bit : 0u; qm3 |= (wd == 3) ? bit : 0u; }
#pragma unroll
      for (int o = 1; o < 8; o <<= 1) { qm0 |= __shfl_xor(qm0, o); qm1 |= __shfl_xor(qm1, o); qm2 |= __shfl_xor(qm2, o); qm3 |= __shfl_xor(qm3, o); } }
    const unsigned rm0 = __shfl(qm0, qi * 8), rm1 = __shfl(qm1, qi * 8), rm2 = __shfl(qm2, qi * 8), rm3 = __shfl(qm3, qi * 8);
    const unsigned* rowmask = WSP(unsigned, O_SELMASK) + ((size_t)((b * 2 + g) * S_ + tq)) * 4;
    unsigned um0 = qm0, um1 = qm1, um2 = qm2, um3 = qm3;
#pragma unroll
    for (int o = 8; o < 64; o <<= 1) { um0 |= __shfl_xor(um0, o); um1 |= __shfl_xor(um1, o); um2 |= __shfl_xor(um2, o); um3 |= __shfl_xor(um3, o); }
    LAS int* list = (LAS int*)(ldsw + 64 * KROW);
    int nblk;
    { const bool s0 = (((lane < 32) ? um0 : um1) >> (lane & 31)) & 1u, s1 = (((lane < 32) ? um2 : um3) >> (lane & 31)) & 1u;
      const unsigned long long b0 = __ballot(s0), b1 = __ballot(s1);
      const unsigned long long lower = (lane == 0) ? 0ull : (~0ull >> (64 - lane));
      const int n0 = __popcll(b0);
      if (s0) list[__popcll(b0 & lower)] = lane;
      if (s1) list[n0 + __popcll(b1 & lower)] = lane + 64;
      nblk = n0 + __popcll(b1); }
    asm volatile("s_waitcnt lgkmcnt(0)" ::: "memory");
    const float sl2 = exp2f(-(float)(h + 1)) * LOG2E, tqf = (float)tq;
    f32x16 o0, o1;
#pragma unroll
    for (int r = 0; r < 16; ++r) { o0[r] = 0.f; o1[r] = 0.f; }
    float m = 0.f, l = 0.f; bool have = false;
    const int curq = tq >> 6;
    const int vrow = lane >> 3, vch = lane & 7;
    const int gq = lane >> 4, li = lane & 15;
    const LAS unsigned char* trb = ldsw + (4 * hh + (li >> 2)) * KROW + (16 * (gq & 1) + 4 * (li & 3)) * 2;
    bf16x8 kn0[4], kn1[4]; u32x4 vn[8];
#define E2_LOAD(blk) do { const bf16_t* kp_ = kbase + (size_t)((blk) * 64 + r32) * PB + 8 * hh; const bf16_t* vp_ = vbase + (size_t)((blk) * 64 + vrow) * PB + vch * 8; \
        _Pragma("unroll") for (int d0 = 0; d0 < 4; ++d0) { kn0[d0] = *(const bf16x8*)(kp_ + 16 * d0); kn1[d0] = *(const bf16x8*)(kp_ + (size_t)32 * PB + 16 * d0); } \
        _Pragma("unroll") for (int i = 0; i < 8; ++i) vn[i] = *(const u32x4*)(vp_ + (size_t)(8 * i) * PB); } while (0)
    int blk = list[0];
    blk = __builtin_amdgcn_readfirstlane(blk);
    E2_LOAD(blk);
    for (int it = 0; it < nblk; ++it) {
#pragma unroll
        for (int i = 0; i < 8; ++i) *(LAS u32x4*)(ldsw + (vrow + 8 * i) * KROW + vch * 16) = vn[i];
        const int cur = blk;
        const unsigned rw = USE_MASK ? rowmask[cur >> 5] : ((cur < 32) ? rm0 : (cur < 64) ? rm1 : (cur < 96) ? rm2 : rm3);
        f32x16 p0, p1;
#pragma unroll
        for (int r = 0; r < 16; ++r) { p0[r] = 0.f; p1[r] = 0.f; }
#pragma unroll
        for (int d0 = 0; d0 < 4; ++d0) { p0 = __builtin_amdgcn_mfma_f32_32x32x16_bf16(kn0[d0], qf[d0], p0, 0, 0, 0); p1 = __builtin_amdgcn_mfma_f32_32x32x16_bf16(kn1[d0], qf[d0], p1, 0, 0, 0); }
        if (it + 1 < nblk) { blk = __builtin_amdgcn_readfirstlane(list[it + 1]); E2_LOAD(blk); }
        const bool rowsel = (rw >> (cur & 31)) & 1u;
        const int kb = cur * 64 + 4 * hh;
        { const float basef = rowsel ? (sl2 * ((float)kb - tqf) - m) : -INFINITY, base1 = basef + 32.f * sl2;
#pragma unroll
          for (int reg = 0; reg < 16; ++reg) { p0[reg] = p0[reg] * (SCALE * LOG2E) + __builtin_fmaf(sl2, (float)CROW(reg, 0), basef); p1[reg] = p1[reg] * (SCALE * LOG2E) + __builtin_fmaf(sl2, (float)CROW(reg, 0), base1); } }
        if (cur >= curq) {
#pragma unroll
            for (int reg = 0; reg < 16; ++reg) { const int kpos = kb + CROW(reg, 0); p0[reg] = (kpos <= tq) ? p0[reg] : -INFINITY; p1[reg] = (kpos + 32 <= tq) ? p1[reg] : -INFINITY; } }
        SM_CORE(p0, p1, m, l, have, o0, o1);
#pragma unroll
        for (int s = 0; s < 4; ++s) {
            u32x4 pw;
            if (s < 2) { pw.x = cvtpk(p0[8 * s + 0], p0[8 * s + 1]); pw.y = cvtpk(p0[8 * s + 2], p0[8 * s + 3]); pw.z = cvtpk(p0[8 * s + 4], p0[8 * s + 5]); pw.w = cvtpk(p0[8 * s + 6], p0[8 * s + 7]); }
            else { const int s2 = s - 2; pw.x = cvtpk(p1[8 * s2 + 0], p1[8 * s2 + 1]); pw.y = cvtpk(p1[8 * s2 + 2], p1[8 * s2 + 3]); pw.z = cvtpk(p1[8 * s2 + 4], p1[8 * s2 + 5]); pw.w = cvtpk(p1[8 * s2 + 6], p1[8 * s2 + 7]); }
            const bf16x8 pb = __builtin_bit_cast(bf16x8, pw);
            const v4i16_t a0l = __builtin_amdgcn_ds_read_tr16_b64_v4i16((LAS v4i16_t*)(trb + (16 * s) * KROW)), a0h = __builtin_amdgcn_ds_read_tr16_b64_v4i16((LAS v4i16_t*)(trb + (16 * s + 8) * KROW));
            const v4i16_t a1l = __builtin_amdgcn_ds_read_tr16_b64_v4i16((LAS v4i16_t*)(trb + (16 * s) * KROW + 64)), a1h = __builtin_amdgcn_ds_read_tr16_b64_v4i16((LAS v4i16_t*)(trb + (16 * s + 8) * KROW + 64));
            const bf16x8 va0 = (bf16x8){a0l[0], a0l[1], a0l[2], a0l[3], a0h[0], a0h[1], a0h[2], a0h[3]}, va1 = (bf16x8){a1l[0], a1l[1], a1l[2], a1l[3], a1h[0], a1h[1], a1h[2], a1h[3]};
            o0 = __builtin_amdgcn_mfma_f32_32x32x16_bf16(va0, pb, o0, 0, 0, 0); o1 = __builtin_amdgcn_mfma_f32_32x32x16_bf16(va1, pb, o1, 0, 0, 0); }
    }
    l += __shfl_xor(l, 32);
    const float sc = ((l > 0.f) ? 1.f / l : 0.f) * WSP(float, O_GF)[(size_t)(b * S_ + tq) * 32 + 1 * 8 + h];
    bf16_t* orow = obase + (size_t)(b * S_ + tq) * D_ + h * 64; const bf16_t* crow = csrc + (size_t)(b * S_ + tq) * cpitch + h * 64;
#pragma unroll
    for (int i = 0; i < 4; ++i) {
        const u32x2 c0 = *(const u32x2*)(crow + 8 * i + 4 * hh), c1 = *(const u32x2*)(crow + 32 + 8 * i + 4 * hh);
        const float x00 = __uint_as_float(c0.x << 16) + o0[4 * i] * sc, x01 = __uint_as_float(c0.x & 0xffff0000u) + o0[4 * i + 1] * sc, x02 = __uint_as_float(c0.y << 16) + o0[4 * i + 2] * sc, x03 = __uint_as_float(c0.y & 0xffff0000u) + o0[4 * i + 3] * sc;
        const float x10 = __uint_as_float(c1.x << 16) + o1[4 * i] * sc, x11 = __uint_as_float(c1.x & 0xffff0000u) + o1[4 * i + 1] * sc, x12 = __uint_as_float(c1.y << 16) + o1[4 * i + 2] * sc, x13 = __uint_as_float(c1.y & 0xffff0000u) + o1[4 * i + 3] * sc;
        *(u32x2*)(orow + 8 * i + 4 * hh) = (u32x2){cvtpk(x00, x01), cvtpk(x02, x03)}; *(u32x2*)(orow + 32 + 8 * i + 4 * hh) = (u32x2){cvtpk(x10, x11), cvtpk(x12, x13)}; }
#undef E2_LOAD
}
template <bool USE_MASK>
__device__ __forceinline__ void ph_attn_sel2(LAS unsigned char* lds3, KP p, bf16_t* __restrict__ obase, const bf16_t* __restrict__ csrc, int cpitch) {
    const int w = __builtin_amdgcn_readfirstlane(ftid() >> 6);
    LAS unsigned char* ldsw = lds3 + w * E2_WAVE;
    MK_LOOP(u, 512) { const int bg = u & 3, qblk = u >> 2; e2_wave_unit<USE_MASK>(ldsw, p, bg >> 1, bg & 1, qblk * 64 + 8 * w, obase, csrc, cpitch); }
}
}
namespace mk {
constexpr int E3_K = 0, E3_V = 512 * KROW, E3_BYTES = 2 * 512 * KROW;
__device__ __forceinline__ void e3_unit(LAS unsigned char* lds, KP p, int b, int g, int qb, bf16_t* __restrict__ ocmp, unsigned* __restrict__ selmask) {
    const int tid = ftid(), lane = tid & 63, w = __builtin_amdgcn_readfirstlane(tid >> 6), r32 = lane & 31, hh = lane >> 5;
    const int bg = b * 2 + g, q0 = qb * 256, qrow0 = q0 + 32 * w, tq = qrow0 + r32;
    const bf16_t* projb = WSP(bf16_t, O_PROJB);
    int nun = (q0 + 255 - 31) / 16 + 1; if (nun > 511) nun = 511;
    const int ntile_u = (nun + 63) >> 6;
    __syncthreads();
    { const int srow = tid >> 3, sch = tid & 7; const bf16_t* ks = WSP(bf16_t, O_KCMPB) + ((size_t)bg * 512 + srow) * 64 + sch * 8; const bf16_t* vs = WSP(bf16_t, O_VCMPB) + ((size_t)bg * 512 + srow) * 64 + sch * 8;
      for (int i = 0; i < ntile_u; ++i) { const u32x4 kv = *(const u32x4*)(ks + (size_t)i * 64 * 64), vv = *(const u32x4*)(vs + (size_t)i * 64 * 64);
          *(LAS u32x4*)(lds + E3_K + (srow + 64 * i) * KROW + sch * 16) = kv; *(LAS u32x4*)(lds + E3_V + (srow + 64 * i) * KROW + sch * 16) = vv; } }
    __syncthreads();
    int nw = qrow0 / 16 + 1; if (nw > 511) nw = 511;
    const int ntile_w = (qrow0 + 31 < 31) ? 0 : ((nw + 63) >> 6);
    const float tqf = (float)tq;
    const int gq = lane >> 4, li = lane & 15;
    const LAS unsigned char* trb = lds + E3_V + (4 * hh + (li >> 2)) * KROW + (16 * (gq & 1) + 4 * (li & 3)) * 2;
    const LAS unsigned char* kfb = lds + E3_K + r32 * KROW + hh * 16;
    float imp[64];
#pragma unroll
    for (int i = 0; i < 64; ++i) imp[i] = 0.f;
#pragma unroll 1
    for (int r4 = 0; r4 < 4; ++r4) {
        const int h = 4 * g + r4; const float sl2 = exp2f(-(float)(h + 1)) * LOG2E;
        const unsigned qoff = (unsigned)((b * S_ + tq) * PB + h * 64 + 8 * hh);
        f32x16 o0, o1;
#pragma unroll
        for (int r = 0; r < 16; ++r) { o0[r] = 0.f; o1[r] = 0.f; }
        float m = 0.f, l = 0.f; bool have = false;
#define E3_ST(jt) f32x16 p0, p1; { bf16x8 qf[4]; _Pragma("unroll") for (int d0 = 0; d0 < 4; ++d0) qf[d0] = *(const bf16x8*)(projb + qoff + 16 * d0); \
            _Pragma("unroll") for (int r = 0; r < 16; ++r) { p0[r] = 0.f; p1[r] = 0.f; } \
            _Pragma("unroll") for (int d0 = 0; d0 < 4; ++d0) { const bf16x8 a0 = *(const LAS bf16x8*)(kfb + (64 * (jt)) * KROW + d0 * 32), a1 = *(const LAS bf16x8*)(kfb + (64 * (jt) + 32) * KROW + d0 * 32); \
                p0 = __builtin_amdgcn_mfma_f32_32x32x16_bf16(a0, qf[d0], p0, 0, 0, 0); p1 = __builtin_amdgcn_mfma_f32_32x32x16_bf16(a1, qf[d0], p1, 0, 0, 0); } \
            int tq_ = tq; asm volatile("" : "+v"(tq_));     \
            int hh_ = hh; asm volatile("" : "+v"(hh_)); \
            const float tqf_ = (float)tq_; const int ce0_ = 16 * (64 * (jt) + 4 * hh_) + 31; \
            const float basef_ = sl2 * ((float)ce0_ - tqf_) - m, base1_ = basef_ + 512.f * sl2; \
            _Pragma("unroll") for (int reg = 0; reg < 16; ++reg) { const float cr_ = sl2 * (float)(16 * CROW(reg, 0)); p0[reg] = p0[reg] * (SCALE * LOG2E) + (basef_ + cr_); p1[reg] = p1[reg] * (SCALE * LOG2E) + (base1_ + cr_); } \
            if (ce0_ + 16 * 27 + 512 > qrow0) {     \
                _Pragma("unroll") for (int reg = 0; reg < 16; ++reg) { const int ce = ce0_ + 16 * CROW(reg, 0); p0[reg] = (ce <= tq_) ? p0[reg] : -INFINITY; p1[reg] = (ce + 512 <= tq_) ? p1[reg] : -INFINITY; } } }
        float imh[64];
#pragma unroll
        for (int i = 0; i < 64; ++i) imh[i] = 0.f;
#pragma unroll
        for (int jt = 0; jt < 8; ++jt) {
            if (jt < ntile_w) {
                E3_ST(jt);
                {
                    float rm_ = fmaxf(p0[0], p1[0]);
#pragma unroll
                    for (int reg_ = 1; reg_ < 16; ++reg_) rm_ = fmaxf(rm_, fmaxf(p0[reg_], p1[reg_]));
                    rm_ = fmaxf(rm_, __shfl_xor(rm_, 32));
                    const bool fin_ = rm_ > -1e37f;
                    if (__any((rm_ > RESC_THR) || (!have && fin_))) {
                        const float dl_ = have ? fmaxf(rm_, 0.f) : (fin_ ? rm_ : 0.f); const float al_ = have ? __builtin_amdgcn_exp2f(-dl_) : 1.f;
                        m += dl_; l *= al_; have = have || fin_;
#pragma unroll
                        for (int r_ = 0; r_ < 16; ++r_) { o0[r_] *= al_; o1[r_] *= al_; p0[r_] -= dl_; p1[r_] -= dl_; }
#pragma unroll
                        for (int i = 0; i < 64; ++i) imh[i] *= al_; }
                    float ls_ = 0.f;
#pragma unroll
                    for (int reg_ = 0; reg_ < 16; ++reg_) { p0[reg_] = __builtin_amdgcn_exp2f(p0[reg_]); p1[reg_] = __builtin_amdgcn_exp2f(p1[reg_]); ls_ += p0[reg_] + p1[reg_]; }
                    l += ls_; }
#pragma unroll
                for (int pa = 0; pa < 2; ++pa)
#pragma unroll
                    for (int i = 0; i < 4; ++i) { const int jj = 8 * jt + 4 * pa + i;
                        const float x0 = pa ? p1[4 * i] : p0[4 * i], x1 = pa ? p1[4 * i + 1] : p0[4 * i + 1], x2 = pa ? p1[4 * i + 2] : p0[4 * i + 2], x3 = pa ? p1[4 * i + 3] : p0[4 * i + 3];
                        const float c = 0.5f * x3, a = (x0 + x1) + (x2 + c), r = __shfl_xor(c, 32);
                        imh[jj] += a + (hh ? r : 0.f);
                        if (jj + 1 < 64) imh[jj + 1] += (hh ? 0.f : r); }
                const LAS unsigned char* tb = trb + (64 * jt) * KROW;
#pragma unroll
                for (int s = 0; s < 4; ++s) {
                    u32x4 pw;
                    if (s < 2) { pw.x = cvtpk(p0[8 * s + 0], p0[8 * s + 1]); pw.y = cvtpk(p0[8 * s + 2], p0[8 * s + 3]); pw.z = cvtpk(p0[8 * s + 4], p0[8 * s + 5]); pw.w = cvtpk(p0[8 * s + 6], p0[8 * s + 7]); }
                    else { const int s2 = s - 2; pw.x = cvtpk(p1[8 * s2 + 0], p1[8 * s2 + 1]); pw.y = cvtpk(p1[8 * s2 + 2], p1[8 * s2 + 3]); pw.z = cvtpk(p1[8 * s2 + 4], p1[8 * s2 + 5]); pw.w = cvtpk(p1[8 * s2 + 6], p1[8 * s2 + 7]); }
                    const bf16x8 pb = __builtin_bit_cast(bf16x8, pw);
                    const v4i16_t a0l = __builtin_amdgcn_ds_read_tr16_b64_v4i16((LAS v4i16_t*)(tb + (16 * s) * KROW)), a0h = __builtin_amdgcn_ds_read_tr16_b64_v4i16((LAS v4i16_t*)(tb + (16 * s + 8) * KROW));
                    const v4i16_t a1l = __builtin_amdgcn_ds_read_tr16_b64_v4i16((LAS v4i16_t*)(tb + (16 * s) * KROW + 64)), a1h = __builtin_amdgcn_ds_read_tr16_b64_v4i16((LAS v4i16_t*)(tb + (16 * s + 8) * KROW + 64));
                    const bf16x8 va0 = (bf16x8){a0l[0], a0l[1], a0l[2], a0l[3], a0h[0], a0h[1], a0h[2], a0h[3]}, va1 = (bf16x8){a1l[0], a1l[1], a1l[2], a1l[3], a1h[0], a1h[1], a1h[2], a1h[3]};
                    o0 = __builtin_amdgcn_mfma_f32_32x32x16_bf16(va0, pb, o0, 0, 0, 0); o1 = __builtin_amdgcn_mfma_f32_32x32x16_bf16(va1, pb, o1, 0, 0, 0); }
            }
        }
        l += __shfl_xor(l, 32);
        const float inv = (l > 0.f) ? 1.f / l : 0.f;
#pragma unroll
        for (int i = 0; i < 64; ++i) imp[i] += imh[i] * inv;
        { const float sc = inv * WSP(float, O_GF)[(size_t)(b * S_ + tq) * 32 + 0 * 8 + h];
          bf16_t* orow = ocmp + (size_t)(b * S_ + tq) * 512 + h * 64;
#pragma unroll
          for (int i = 0; i < 4; ++i) {
              *(u32x2*)(orow + 8 * i + 4 * hh) = (u32x2){cvtpk(o0[4 * i] * sc, o0[4 * i + 1] * sc), cvtpk(o0[4 * i + 2] * sc, o0[4 * i + 3] * sc)};
              *(u32x2*)(orow + 32 + 8 * i + 4 * hh) = (u32x2){cvtpk(o1[4 * i] * sc, o1[4 * i + 1] * sc), cvtpk(o1[4 * i + 2] * sc, o1[4 * i + 3] * sc)}; } }
#undef E3_ST
    }
    const int cur = tq >> 6;
#pragma unroll
    for (int jj = 0; jj < 64; ++jj) { const int j = 2 * jj + hh; imp[jj] = (j != 0 && j < cur - 1) ? imp[jj] : -1.f; }
    unsigned m0 = 1u, m1 = 0u, m2 = 0u, m3 = 0u;
#define E3_SETBIT(j) do { const unsigned bit_ = 1u << ((j) & 31); const int wd_ = (j) >> 5; m0 |= (wd_ == 0) ? bit_ : 0u; m1 |= (wd_ == 1) ? bit_ : 0u; m2 |= (wd_ == 2) ? bit_ : 0u; m3 |= (wd_ == 3) ? bit_ : 0u; } while (0)
    E3_SETBIT(cur); if (cur >= 1) E3_SETBIT(cur - 1);
#pragma unroll 1
    for (int it = 0; it < NSEL - 3; ++it) {
        float best = -0.5f; int bj = 0;
#pragma unroll
        for (int jj = 0; jj < 64; ++jj) { if (imp[jj] > best) { best = imp[jj]; bj = jj; } }
        const int myj = 2 * bj + hh; const float ob = __shfl_xor(best, 32); const int oj = __shfl_xor(myj, 32);
        const bool mine = (best > ob) || (best == ob && myj < oj);
        const float wv = mine ? best : ob; const int wj = mine ? myj : oj;
        if (wv >= 0.f) E3_SETBIT(wj);
        if (mine && best >= 0.f) {
#pragma unroll
            for (int jj = 0; jj < 64; ++jj) imp[jj] = (jj == bj) ? -2.f : imp[jj]; }
    }
#undef E3_SETBIT
    if (hh == 0) *(u32x4*)(selmask + ((size_t)bg * S_ + tq) * 4) = (u32x4){m0, m1, m2, m3};
}
}
namespace mk {
constexpr int SB_EARLY = 232;
template <int MODE>
__device__ __forceinline__ void ph_attn1(float* lds, LAS unsigned char* lds3, KP p, unsigned* qctr, bf16_t* obase, bf16_t* owin, const unsigned* kmax2) {
    LAS int* qslot = (LAS int*)(lds3 + E3_BYTES);
    constexpr int N_E3 = (MODE & 2) ? 128 : 0, N_CMP = (MODE & 1) ? 64 : 0, N_FOX = (MODE & 4) ? 256 : 0, N_WIN = (MODE & 8) ? 512 : 0, N_SB = (MODE & 16) ? (256 - SB_EARLY) : 0;
    for (;;) {
        __syncthreads();
        if (ftid() == 0) *qslot = (int)atomicAdd(qctr, 1u);
        __syncthreads();
        int u = __builtin_amdgcn_readfirstlane(*qslot);
        if (u >= N_E3 + N_CMP + N_FOX + N_WIN + N_SB) break;
        if (u < N_E3) { e3_unit(lds3, p, (u & 3) >> 1, u & 1, 31 - (u >> 2), WSP(bf16_t, O_OCMP), WSP(unsigned, O_SELMASK)); continue; } u -= N_E3;
        if (u < N_FOX) { e1_unit<0>(lds3, p, (u & 7) >> 2, u & 3, 31 - (u >> 3), obase, owin, kmax2); continue; } u -= N_FOX;
        if (u < N_WIN) { e1_unit<1>(lds3, p, (u & 3) >> 1, u & 1, 127 - (u >> 2), obase, owin, kmax2); continue; } u -= N_WIN;
        if (u < N_SB) { u += SB_EARLY; e1_unit<2>(lds3, p, (u & 7) >> 2, u & 3, 31 - (u >> 3), obase, owin, kmax2); }
    }
}
__device__ __forceinline__ void ph_sb_early(LAS unsigned char* lds3, KP p) {
    const int u = fbid() - 24; if (u < 0 || u >= SB_EARLY) return;
    e1_unit<2>(lds3, p, (u & 7) >> 2, u & 3, 31 - (u >> 3), WSP(bf16_t, O_O), WSP(bf16_t, O_OWIN), nullptr);
}
}
namespace mk {
#define RLX_AGENT __ATOMIC_RELAXED, __HIP_MEMORY_SCOPE_AGENT
#define XB_TMO      128
#define XB_XCNT(j)  (256  + 64 * (j))
#define XB_XSUB(j)  (1280 + 64 * (j))
#define XB_XGEN(j)  (2304 + 64 * (j))
#define XB_TOP      3328
#define XB_TOPGEN   3392
#define XCD_BAR_WORDS 3456
#define XB_SPIN_CAP (1u << 18)

__device__ __forceinline__ unsigned xb_ld(unsigned* p)              { return __hip_atomic_load(p, __ATOMIC_RELAXED, __HIP_MEMORY_SCOPE_AGENT); }
__device__ __forceinline__ unsigned xb_add(unsigned* p, unsigned v) { return __hip_atomic_fetch_add(p, v, __ATOMIC_RELAXED, __HIP_MEMORY_SCOPE_AGENT); }
__device__ __forceinline__ unsigned xb_xcc_id() { return (unsigned)__builtin_amdgcn_s_getreg((3 << 11) | 20) & 0xFu; }
#define XB_SPIN(cond, bar) do { unsigned _sp = 0; while (cond) { __builtin_amdgcn_s_sleep(1); \
    if ((++_sp & 255u) == 0u) { if (xb_ld(&(bar)[XB_TMO])) break; if (_sp > XB_SPIN_CAP) { atomicAdd(&(bar)[XB_TMO], 1u); break; } } } } while (0)

struct XcdBarrier {
    unsigned* bar; unsigned x;
    volatile LAS unsigned* st;
};

__device__ __forceinline__ XcdBarrier xcd_barrier_post(unsigned* bar, volatile LAS unsigned* st) {
    XcdBarrier b; b.bar = bar; b.x = xb_xcc_id(); b.st = st;
    if (threadIdx.x == 0) (void)xb_add(&bar[XB_XCNT(b.x)], 1u);
    return b;
}
__device__ __forceinline__ void xcd_barrier_complete(unsigned* bar, unsigned x, unsigned& nloc, unsigned& nx) {
    const unsigned G = gridDim.x * gridDim.y * gridDim.z;
    unsigned sum, cnt, mine, sp = 0u;
    for (;;) {
        sum = 0u; cnt = 0u; mine = 0u;
#pragma unroll
        for (unsigned j = 0; j < 16; ++j) { const unsigned c = xb_ld(&bar[XB_XCNT(j)]); sum += c; cnt += (c > 0u) ? 1u : 0u; mine = (j == x) ? c : mine; }
        if (sum == G) break;
        __builtin_amdgcn_s_sleep(1);
        if ((++sp & 255u) == 0u) { if (xb_ld(&bar[XB_TMO])) break; if (sp > XB_SPIN_CAP) { atomicAdd(&bar[XB_TMO], 1u); break; } }
    }
    nloc = mine > 0u ? mine : 1u; nx = cnt > 0u ? cnt : 1u;
}

__device__ __forceinline__ void xcd_barrier(const XcdBarrier& b) {
    asm volatile("s_waitcnt vmcnt(0)" ::: "memory");
    __syncthreads();
    if (threadIdx.x == 0) {
        unsigned* bar = b.bar;
        __builtin_amdgcn_s_waitcnt(0);
        unsigned nloc = b.st[0], nx = b.st[1];
        if (nloc == 0u) { xcd_barrier_complete(bar, b.x, nloc, nx); b.st[0] = nloc; b.st[1] = nx; }
        const unsigned old = xb_add(&bar[XB_XSUB(b.x)], 1u);
        const unsigned gen = old / nloc;
        if (old + 1u == (gen + 1u) * nloc) {
            __builtin_amdgcn_fence(__ATOMIC_RELEASE, "agent");
            asm volatile("s_waitcnt vmcnt(0)" ::: "memory");
            const unsigned og = xb_add(&bar[XB_TOP], 1u);
            const unsigned tg = og / nx;
            if (og + 1u == (tg + 1u) * nx) xb_add(&bar[XB_TOPGEN], 1u);
            else XB_SPIN(xb_ld(&bar[XB_TOPGEN]) == tg, bar);
            __builtin_amdgcn_fence(__ATOMIC_ACQUIRE, "agent");
            xb_add(&bar[XB_XGEN(b.x)], 1u);
            asm volatile("s_waitcnt vmcnt(0)" ::: "memory");
        } else {
            XB_SPIN(xb_ld(&bar[XB_XGEN(b.x)]) == gen, bar);
            __builtin_amdgcn_fence(__ATOMIC_ACQUIRE, "agent");
            asm volatile("s_waitcnt vmcnt(0)" ::: "memory");
        }
    }
    __syncthreads();
}

}
namespace cg = cooperative_groups;
constexpr int NSTEP = 12;
#ifndef CVH_GU
#define CVH_GU 1
#define CVH_DN 1
#endif
__global__ void __launch_bounds__(512, 2) mega(mk::P p_unused) {
    extern __shared__ __attribute__((aligned(16))) unsigned char lds_raw[];
    float* lds = (float*)lds_raw;
    LAS unsigned char* lds3 = (LAS unsigned char*)lds_raw;
    using namespace nv; using namespace mk;
    volatile LAS unsigned* bst = (volatile LAS unsigned*)(lds3 + E3_BYTES + 128);
    if (threadIdx.x < 2) bst[threadIdx.x] = 0u;
    __syncthreads();
    XcdBarrier bar;
    { const KP p = fresh_kp(); bar = xcd_barrier_post(WSP(unsigned, O_COUNTS + 16384), bst); }
    cg::this_grid().sync();
    for (int step = 0; step < 1 + NSTEP * L_; ++step) {
        const KP p = fresh_kp();
        const int l = (step - 1) / NSTEP, k = (step == 0) ? -1 : (step - 1) % NSTEP;
        const bool isg = (k == 0 || k == 1 || k == 6 || k == 9 || k == 10);
#ifdef PROBE_K
        const int nrep = (k == PROBE_K) ? PROBE_N : 1;
#else
        const int nrep = 1;
#endif
        for (int rep = 0; rep < nrep; ++rep) {
        int helpchunks = 0;
        if (isg) {
            const int kind = (k == 0) ? 0 : (k == 1) ? 4 : (k == 6) ? 1 : (k == 9) ? 2 : 3;
            GSched S; GEpi E; S.kind = kind; E.kind = kind; E.l = l;
            S.G = (int)gridDim.x; S.c = fbid(); S.meta = WSP(int, O_META); S.rowtok = WSP(int, O_ROWTOK); S.estep = 0;
            const char* A; int N, K = D_;
            if (kind == 0) { A = (const char*)WSP(bf16_t, O_XB); S.Bt = (const char*)(WSP(bf16_t, O_WTIN) + (size_t)l * NPAD * D_); N = NPAD; }
            else if (kind == 1) { A = (const char*)WSP(bf16_t, O_OB); S.Bt = (const char*)(WSP(bf16_t, O_WTOUT) + (size_t)l * D_ * D_); N = D_; }
            else if (kind == 2) { A = (const char*)WSP(bf16_t, O_X1B); S.Bt = (const char*)(WSP(bf16_t, O_WTGU) + (size_t)l * NE * 2048 * D_); S.estep = (size_t)2048 * D_ * 2; N = 2048; }
            else if (kind == 3) { A = (const char*)WSP(bf16_t, O_ACT); S.Bt = (const char*)(WSP(bf16_t, O_WTDN) + (size_t)l * NE * D_ * D_); S.estep = (size_t)D_ * D_ * 2; N = D_; }
            else { A = (const char*)WSP(bf16_t, O_PROJB); S.Bt = (const char*)(WSP(bf16_t, O_WT1) + (size_t)l * 2 * 256 * 2048); S.estep = (size_t)256 * 2048 * 2; N = 256; K = 2048; }
            S.nN = N / 256; S.nM = (kind < 2) ? T_ / 256 : (kind == 4) ? 16 : S.meta[32]; S.nunits = S.nM * S.nN;
            pg8::gemm_phase<GEpi, GSched>(lds3, A, K, S, E);
            if (l == 0 && kind >= 2 && kind <= 3 && S.G == 256) {
                const int mine = (S.nunits - S.c + 255) >> 8, most = (S.nunits + 255) >> 8;
                if (mine < most) helpchunks = (kind == 2) ? CVH_GU : CVH_DN; }
            if (kind == 4) { ph_cumsum(lds, p, 16); ph_sb_early(lds3, p); }
            if (kind == 0) ph_bias1_reduce(p, l);
        } else {
            switch (k) {
                case -1: ph_convert(lds3, p); break;
                case 2: ph_prep2(p, l); break;
#ifdef PROBE_AMODE
                case 3: if (rep == 0) ph_attn1<30>(lds, lds3, p, WSP(unsigned, O_COUNTS) + 128 + l * 8 + rep, WSP(bf16_t, O_O), WSP(bf16_t, O_OWIN), WSP(unsigned, O_COUNTS) + 192 + l * 8);
                        else ph_attn1<PROBE_AMODE>(lds, lds3, p, WSP(unsigned, O_COUNTS) + 128 + l * 8 + rep, WSP(bf16_t, O_O), WSP(bf16_t, O_OWIN), WSP(unsigned, O_COUNTS) + 192 + l * 8);
                        break;
#else
                case 3: ph_attn1<30>(lds, lds3, p, WSP(unsigned, O_COUNTS) + 128 + l * 8 + rep, WSP(bf16_t, O_O), WSP(bf16_t, O_OWIN), WSP(unsigned, O_COUNTS) + 192 + l * 8); break;
#endif
                case 4: ph_attn_sel2<true>(lds3, p, WSP(bf16_t, O_O), WSP(bf16_t, O_OCMP), 512); break;
                case 5: ph_rmsnorm(p, l); break;
                case 7: ph_ln<true>(lds, p, l, WSP(float, O_X1), (rep + 1 < nrep) ? 2048 * (rep + 1) : 0); break;
                case 8: ph_moe_scatter2(lds, p, l); break;
                default: { if (l == 0) helpchunks = 1 << 20;
                           float* xout = (l == L_ - 1) ? p->out : WSP(float, O_XA); ph_ln<false>(lds, p, l, xout); } break;
            }
        }
        if (helpchunks > 0) cv_help(lds3, fresh_kp(), helpchunks);
        xcd_barrier(bar);
        }
    }
#ifdef PROBE_SYNC
    for (int i = 0; i < PROBE_SYNC; ++i) xcd_barrier(bar);
#endif
}

extern "C" void kernel_launch(void* const* d_in, const int* in_sizes, int n_in,
                              void* d_out, int out_size, void* d_ws, size_t ws_size,
                              hipStream_t stream) {
    constexpr size_t kDynLds = 147456 + 1024;
    static int grid_blocks = 0;
    if (!grid_blocks) {
        int dev = 0, cus = 0, per_cu = 0;
        (void)hipGetDevice(&dev);
        (void)hipDeviceGetAttribute(&cus, hipDeviceAttributeMultiprocessorCount, dev);
        (void)hipFuncSetAttribute((const void*)mega, hipFuncAttributeMaxDynamicSharedMemorySize, (int)kDynLds);
        (void)hipOccupancyMaxActiveBlocksPerMultiprocessor(&per_cu, mega, 512, kDynLds);
        if (per_cu < 1) per_cu = 1;
        if (per_cu > 1) per_cu = 1;
        grid_blocks = cus * per_cu;
        if (ws_size < mk::O_END) fprintf(stderr, "workspace too small: %zu < %zu\n", ws_size, (size_t)mk::O_END);
    }
    mk::P p{};
    p.in = nv::inputs(d_in); p.ws = (unsigned char*)d_ws; p.out = (float*)d_out;
    (void)hipMemsetAsync((char*)d_ws + mk::O_COUNTS, 0, 65536, stream);
    void* args[] = {&p};
    hipError_t e = hipLaunchCooperativeKernel((void*)mega, dim3(grid_blocks), dim3(512), args, kDynLds, stream);
    if (e != hipSuccess) fprintf(stderr, "cooperative launch failed: %s (grid %d)\n", hipGetErrorString(e), grid_blocks);
}
```

```cpp
#include <hip/hip_runtime.h>
#include <hip/hip_cooperative_groups.h>
#include <cstdio>
#include <cstdint>

namespace nv {

constexpr int B_ = 2, S_ = 8192, D_ = 1024, T_ = B_ * S_, L_ = 2;
constexpr int DIN = 2844;
constexpr int OFF_NSA_KV = 512, OFF_NSA_GATE = 1280, OFF_FOX_QKV = 1304, OFF_FOX_F = 2072, OFF_SB_QKV = 2076;
constexpr int NCMP = 511, NBLK = 128, NSEL = 16;
constexpr int NE = 32, TOPK = 4, MROWS = T_ * TOPK;
constexpr float LN_EPS = 1e-5f, RMS_EPS = 1e-6f;
constexpr float ALPHA = 1.4142135623730951f;
constexpr float SCALE = 0.125f;

__device__ __forceinline__ float sigmoidf_(float x) { return 1.f / (1.f + __expf(-x)); }
__device__ __forceinline__ float logsig(float x) { return fminf(x, 0.f) - log1pf(expf(-fabsf(x))); }

__device__ __forceinline__ float gelu_tanh(float x) { return 0.5f * x * (1.f + tanhf(0.7978845608028654f * (x + 0.044715f * x * x * x))); }
__device__ __forceinline__ float wsum(float v) {
#pragma unroll
    for (int o = 1; o < 64; o <<= 1) v += __shfl_xor(v, o);
    return v;
}
struct In {
    const float *x, *w_in, *b_in, *pos_k, *pos_v, *w1k, *w2k, *w1v, *w2v, *g_out, *w_out, *ln1_g, *ln1_b, *rw, *rb, *wgu, *bgu, *wdn, *bdn, *ln2_g, *ln2_b;
};
inline In inputs(void* const* d) {
    In i; i.x = (const float*)d[0]; i.w_in = (const float*)d[1]; i.b_in = (const float*)d[2]; i.pos_k = (const float*)d[3]; i.pos_v = (const float*)d[4];
    i.w1k = (const float*)d[5]; i.w2k = (const float*)d[6]; i.w1v = (const float*)d[7]; i.w2v = (const float*)d[8]; i.g_out = (const float*)d[9]; i.w_out = (const float*)d[10];
    i.ln1_g = (const float*)d[11]; i.ln1_b = (const float*)d[12]; i.rw = (const float*)d[13]; i.rb = (const float*)d[14]; i.wgu = (const float*)d[15]; i.bgu = (const float*)d[16];
    i.wdn = (const float*)d[17]; i.bdn = (const float*)d[18]; i.ln2_g = (const float*)d[19]; i.ln2_b = (const float*)d[20]; return i;
}


}
namespace pg8 {
#define PG8_LAS __attribute__((address_space(3)))
typedef unsigned short bf16_t;
typedef short bf16x8 __attribute__((ext_vector_type(8)));
typedef float f32x4 __attribute__((ext_vector_type(4)));
typedef unsigned u32x4 __attribute__((ext_vector_type(4)));
constexpr int BM = 256, BK = 64, HALF = 128, HTB = HALF * BK * 2  , STAGE_BYTES = 8 * HTB, NXCD = 8, WGM = 8;

__host__ __device__ __forceinline__ int lds_byte(int r, int c) { const int st = (r >> 4) * 2 + (c >> 5), rr = r & 15, cc = c & 31, ob = rr * 64 + cc * 2; return st * 1024 + (ob ^ (((ob >> 9) & 1) << 5)); }
__host__ __device__ __forceinline__ void stage_rc(int b, int& R, int& C) { const int st = b / 1024, sb = b % 1024, swz = sb ^ (((sb >> 9) & 1) << 5); R = (st >> 1) * 16 + swz / 64; C = (st & 1) * 32 + (swz % 64) / 2; }
__host__ __device__ __forceinline__ int perm32(int rho) { const int n = rho >> 4, i = rho & 15; return 8 * (i >> 2) + 4 * n + (i & 3); }

struct Unit { int pm, pn, e, nr; };

__device__ __forceinline__ unsigned cvt_pk_bf16(float lo, float hi) { unsigned r; asm volatile("v_cvt_pk_bf16_f32 %0, %1, %2" : "=v"(r) : "v"(lo), "v"(hi)); return r; }
template <class Epi, class Sched, bool ALIGN_EPI = true, bool SP2 = true>
__device__ __forceinline__ void gemm_phase(PG8_LAS unsigned char* lds, const char* Abase, const int K, const Sched& S, const Epi& E) {
    int tid_ = threadIdx.x; asm volatile("" : "+v"(tid_));
    const int tid = tid_, wid = __builtin_amdgcn_readfirstlane(tid >> 6), lane = tid & 63, wr = wid >> 2, wc = wid & 3, fr = lane & 15, fq = lane >> 4;
    const int nt = K / BK;
    unsigned voffB[2];
#pragma unroll
    for (int i = 0; i < 2; ++i) { int R, C; stage_rc(tid * 16 + i * 8192, R, C); const int Rb = Epi::PERM ? ((R & ~31) + perm32(R & 31)) : R;
        voffB[i] = (unsigned)(Rb * K + C) * 2u; }
#define PG8_AOFF(u, o0, o1) do { int _t = tid; asm volatile("" : "+v"(_t)); _Pragma("unroll") for (int _i = 0; _i < 2; ++_i) { int _R, _C; stage_rc(_t * 16 + _i * 8192, _R, _C); \
        (o0)[_i] = S.a_off((u), _R) + (unsigned)_C * 2u; (o1)[_i] = S.a_off((u), HALF + _R) + (unsigned)_C * 2u; } } while (0)
    const size_t kstep = (size_t)(BK * 2);
    const size_t akstep = S.a_kstep();
    const size_t hstep = (size_t)HALF * K * 2;
    const unsigned ldsw = (unsigned)wid * 1024u;
    const int aoff = lds_byte(wr * 64 + fr, fq * 8), boff = lds_byte(wc * 32 + fr, fq * 8);
#define PG8_SA(b, h) (((b) * 2 + (h)) * HTB)
#define PG8_SB(b, h) ((4 + (b) * 2 + (h)) * HTB)
#define PG8_STAGE(bufoff, gbase, voff) do { _Pragma("unroll") for (int _i = 0; _i < 2; ++_i) { unsigned _o = (voff)[_i]; asm volatile("" : "+v"(_o));     \
        __builtin_amdgcn_global_load_lds((const unsigned*)((const char*)(gbase) + _o), (PG8_LAS unsigned*)(lds + (bufoff) + ldsw + _i * 8192), 16, 0, 0); } } while (0)
#define PG8_LDA(dst, b, h) do { _Pragma("unroll") for (int m = 0; m < 4; ++m) _Pragma("unroll") for (int k = 0; k < 2; ++k) dst[m][k] = *(const PG8_LAS bf16x8*)(lds + PG8_SA(b, h) + aoff + m * 2048 + k * 1024); } while (0)
#define PG8_LDB(dst, b, h) do { _Pragma("unroll") for (int n = 0; n < 2; ++n) _Pragma("unroll") for (int k = 0; k < 2; ++k) dst[n][k] = *(const PG8_LAS bf16x8*)(lds + PG8_SB(b, h) + boff + n * 2048 + k * 1024); } while (0)
#define PG8_MMA(ai, bj, At, Bt) do { __builtin_amdgcn_s_setprio(1); _Pragma("unroll") for (int m = 0; m < 4; ++m) _Pragma("unroll") for (int n = 0; n < 2; ++n) _Pragma("unroll") for (int k = 0; k < 2; ++k) \
        acc[ai][bj][m][n] = __builtin_amdgcn_mfma_f32_16x16x32_bf16(Bt[n][k], At[m][k], acc[ai][bj][m][n], 0, 0, 0); __builtin_amdgcn_s_setprio(0); } while (0)
#define PG8_WAIT_V(n) asm volatile("s_waitcnt vmcnt(" #n ")" ::: "memory")
#define PG8_WAIT_L(n) asm volatile("s_waitcnt lgkmcnt(" #n ")" ::: "memory")
#define PG8_BAR __builtin_amdgcn_s_barrier()
#define PG8_SCHED __builtin_amdgcn_sched_barrier(0)
    Unit cur, nxt; int ui = 0;
    if (!S.next(0, cur)) return;
    f32x4 acc[2][2][4][2];
    float zf_ = 0.f; asm volatile("" : "+v"(zf_));
#pragma unroll
    for (int a = 0; a < 2; ++a)
#pragma unroll
        for (int b = 0; b < 2; ++b)
#pragma unroll
            for (int m = 0; m < 4; ++m)
#pragma unroll
                for (int n = 0; n < 2; ++n) acc[a][b][m][n] = (f32x4){zf_, zf_, zf_, zf_};
    bf16x8 At[4][2], B0[2][2], B1[2][2];
    unsigned ca0[2], ca1[2], na0[2], na1[2];
    PG8_AOFF(cur, ca0, ca1);
    const char* const cA = Abase; const char* cB = S.b_base(cur);
    if constexpr (SP2) {
        PG8_STAGE(PG8_SB(0, 0), cB, voffB); PG8_STAGE(PG8_SB(0, 1), cB + hstep, voffB); PG8_STAGE(PG8_SA(0, 0), cA, ca0); PG8_STAGE(PG8_SA(0, 1), cA, ca1);
        if (wr == 1) PG8_BAR;
        PG8_WAIT_V(2); PG8_BAR;
        PG8_STAGE(PG8_SB(1, 0), cB + kstep, voffB); PG8_STAGE(PG8_SA(1, 0), cA + akstep, ca0); PG8_STAGE(PG8_SB(1, 1), cB + hstep + kstep, voffB);
        PG8_WAIT_V(6); PG8_BAR;
    } else { static_assert(SP2, "only the SP2 loop is kept"); }
    for (;;) {
        const bool has_next = S.next(ui + 1, nxt);
        const char* nB = has_next ? S.b_base(nxt) : cB;
        if (has_next) { PG8_AOFF(nxt, na0, na1); } else { na0[0] = ca0[0]; na0[1] = ca0[1]; na1[0] = ca1[0]; na1[1] = ca1[1]; }
        for (int t = 0; t < nt - 2; t += 2) {
            const char* a1 = cA + (size_t)(t + 1) * akstep;
            const char* a2 = cA + (size_t)(t + 2) * akstep; const char* b2 = cB + (size_t)(t + 2) * kstep;
            const char* a3 = a2 + akstep; const char* b3 = b2 + kstep;
            PG8_LDB(B0, 0, 0); PG8_LDB(B1, 0, 1); PG8_SCHED; PG8_LDA(At, 0, 0); PG8_STAGE(PG8_SA(1, 1), a1, ca1);
            PG8_WAIT_V(8); PG8_WAIT_L(0); PG8_BAR; PG8_MMA(0, 0, At, B0); PG8_MMA(0, 1, At, B1); PG8_BAR; PG8_SCHED;
            PG8_LDA(At, 0, 1); PG8_STAGE(PG8_SB(0, 0), b2, voffB); PG8_STAGE(PG8_SB(0, 1), b2 + hstep, voffB); PG8_STAGE(PG8_SA(0, 0), a2, ca0);
            PG8_WAIT_V(8); PG8_WAIT_L(0); PG8_BAR; PG8_MMA(1, 0, At, B0); PG8_MMA(1, 1, At, B1); PG8_BAR; PG8_SCHED;
            PG8_LDB(B0, 1, 0); PG8_LDB(B1, 1, 1); PG8_SCHED; PG8_LDA(At, 1, 0); PG8_STAGE(PG8_SA(0, 1), a2, ca1);
            PG8_WAIT_V(8); PG8_WAIT_L(0); PG8_BAR; PG8_MMA(0, 0, At, B0); PG8_MMA(0, 1, At, B1); PG8_BAR; PG8_SCHED;
            PG8_LDA(At, 1, 1); PG8_STAGE(PG8_SB(1, 0), b3, voffB); PG8_STAGE(PG8_SB(1, 1), b3 + hstep, voffB); PG8_STAGE(PG8_SA(1, 0), a3, ca0);
            PG8_WAIT_V(8); PG8_WAIT_L(0); PG8_BAR; PG8_MMA(1, 0, At, B0); PG8_MMA(1, 1, At, B1); PG8_BAR; PG8_SCHED;
        }
        {
            const char* a1 = cA + (size_t)(nt - 1) * akstep;
            const char* a2 = cA; const char* b2 = nB; const char* a3 = a2 + akstep; const char* b3 = b2 + kstep;
            PG8_LDB(B0, 0, 0); PG8_LDB(B1, 0, 1); PG8_SCHED; PG8_LDA(At, 0, 0); PG8_STAGE(PG8_SA(1, 1), a1, ca1);
            PG8_WAIT_V(8); PG8_WAIT_L(0); PG8_BAR; PG8_MMA(0, 0, At, B0); PG8_MMA(0, 1, At, B1); PG8_BAR; PG8_SCHED;
            PG8_LDA(At, 0, 1); PG8_STAGE(PG8_SB(0, 0), b2, voffB); PG8_STAGE(PG8_SB(0, 1), b2 + hstep, voffB); PG8_STAGE(PG8_SA(0, 0), a2, na0);
            PG8_WAIT_V(8); PG8_WAIT_L(0); PG8_BAR; PG8_MMA(1, 0, At, B0); PG8_MMA(1, 1, At, B1); PG8_BAR; PG8_SCHED;
            PG8_LDB(B0, 1, 0); PG8_LDB(B1, 1, 1); PG8_SCHED; PG8_LDA(At, 1, 0); PG8_STAGE(PG8_SA(0, 1), a2, na1);
            PG8_WAIT_V(8); PG8_WAIT_L(0); PG8_BAR; PG8_MMA(0, 0, At, B0); PG8_MMA(0, 1, At, B1); PG8_BAR; PG8_SCHED;
            PG8_LDA(At, 1, 1); PG8_STAGE(PG8_SB(1, 0), b3, voffB); PG8_STAGE(PG8_SB(1, 1), b3 + hstep, voffB); PG8_STAGE(PG8_SA(1, 0), a3, na0);
            PG8_WAIT_V(8); PG8_WAIT_L(0); PG8_BAR; PG8_MMA(1, 0, At, B0); PG8_MMA(1, 1, At, B1); PG8_BAR; PG8_SCHED;
        }
        if constexpr (ALIGN_EPI) { if (wr == 0) PG8_BAR; }
        E(acc, cur, wr, wc, fr, fq);
        if (!has_next) break;
#pragma unroll
        for (int a = 0; a < 2; ++a)
#pragma unroll
            for (int b = 0; b < 2; ++b)
#pragma unroll
                for (int m = 0; m < 4; ++m)
#pragma unroll
                    for (int n = 0; n < 2; ++n) acc[a][b][m][n] = (f32x4){zf_, zf_, zf_, zf_};
        cur = nxt; cB = nB; ++ui; ca0[0] = na0[0]; ca0[1] = na0[1]; ca1[0] = na1[0]; ca1[1] = na1[1];
        if constexpr (ALIGN_EPI) { if (wr == 1) PG8_BAR; }
    }
    PG8_WAIT_V(0);
    if constexpr (!ALIGN_EPI) { if (wr == 0) PG8_BAR; }
    PG8_BAR;
#undef PG8_AOFF
#undef PG8_SA
#undef PG8_SB
#undef PG8_STAGE
#undef PG8_LDA
#undef PG8_LDB
#undef PG8_MMA
#undef PG8_WAIT_V
#undef PG8_WAIT_L
#undef PG8_BAR
#undef PG8_SCHED
}

}
namespace mk {
using namespace nv;
typedef unsigned short bf16_t;
typedef unsigned u32x4 __attribute__((ext_vector_type(4)));
typedef float f32x4 __attribute__((ext_vector_type(4)));
#define LAS __attribute__((address_space(3)))
typedef short bf16x8 __attribute__((ext_vector_type(8)));
typedef float f32x16 __attribute__((ext_vector_type(16)));
#define CROW(reg, hh) (((reg) & 3) + 8 * ((reg) >> 2) + 4 * (hh))
constexpr int NT = 512;
constexpr int PB = 2816;
constexpr int NPAD = 3072;
constexpr int C_KV = 512, C_FOX = 1280, C_SB = 2048, C_GATE = 2816;
constexpr int MAXT = MROWS / 256 + NE;
constexpr int PROWS = MAXT * 256;
#define CNT_IDX(l, e) (8192 + ((l) * NE + (e)) * 32)
__device__ __forceinline__ int ftid() { int t = threadIdx.x; asm volatile("" : "+v"(t)); return t; }
__device__ __forceinline__ int fbid() { int b = blockIdx.x; asm volatile("" : "+s"(b)); return b; }
#define MK_LOOP(vb, n) for (int vb = fbid(); vb < (n); vb += gridDim.x)

constexpr size_t al_(size_t x) { return (x + 4095) & ~(size_t)4095; }
constexpr size_t O_WTIN = 0;
constexpr size_t O_WTOUT = O_WTIN + al_((size_t)L_ * NPAD * D_ * 2);
constexpr size_t O_WTGU = O_WTOUT + al_((size_t)L_ * D_ * D_ * 2);
constexpr size_t O_WTDN = O_WTGU + al_((size_t)L_ * NE * 2048 * D_ * 2);
constexpr size_t O_BIASP = O_WTDN + al_((size_t)L_ * NE * D_ * D_ * 2);
constexpr size_t O_XB = O_BIASP + al_((size_t)L_ * NPAD * 4);
constexpr size_t O_PROJB = O_XB + al_((size_t)T_ * D_ * 2);
constexpr size_t O_GF = O_PROJB + al_((size_t)T_ * PB * 2);
constexpr size_t O_CFOX = O_GF + al_((size_t)T_ * 32 * 4);
constexpr size_t O_KCMP = O_CFOX + al_((size_t)B_ * 4 * S_ * 4);
constexpr size_t O_VCMP = O_KCMP + al_((size_t)B_ * 2 * 512 * 64 * 4);
constexpr size_t O_O = O_VCMP + al_((size_t)B_ * 2 * 512 * 64 * 4);
constexpr size_t O_OB = O_O + al_((size_t)T_ * D_ * 4);
constexpr size_t O_PTOT = O_OB + al_((size_t)T_ * D_ * 2);
constexpr size_t O_SEL = O_PTOT + al_((size_t)B_ * 2 * S_ * 512 * 4);
constexpr size_t O_MIX = O_SEL + al_((size_t)B_ * 2 * S_ * NSEL * 4);
constexpr size_t O_X1 = O_MIX + al_((size_t)T_ * D_ * 4);
constexpr size_t O_X1B = O_X1 + al_((size_t)T_ * D_ * 4);
constexpr size_t O_XA = O_X1B + al_((size_t)T_ * D_ * 2);
constexpr size_t O_ACT = O_XA + al_((size_t)T_ * D_ * 4);
constexpr size_t O_Y = O_ACT + al_((size_t)PROWS * D_ * 2);
constexpr size_t O_TOPE = O_Y + al_((size_t)PROWS * D_ * 2);
constexpr size_t O_TOPW = O_TOPE + al_((size_t)MROWS * 4);
constexpr size_t O_POS = O_TOPW + al_((size_t)MROWS * 4);
constexpr size_t O_ROWTOK = O_POS + al_((size_t)MROWS * 4);
constexpr size_t O_ROWW = O_ROWTOK + al_((size_t)PROWS * 4);
constexpr size_t O_SLOT = O_ROWW + al_((size_t)PROWS * 4);
constexpr size_t O_COUNTS = O_SLOT + al_((size_t)MROWS * 4);
constexpr size_t O_META = O_COUNTS + 65536;
constexpr size_t O_OWIN = O_META + 4096;
constexpr size_t O_O2 = O_OWIN + al_((size_t)T_ * 512 * 4);
constexpr size_t O_OWIN2 = O_O2 + al_((size_t)T_ * D_ * 4);
constexpr size_t O_KCMPB = O_OWIN2 + al_((size_t)T_ * 512 * 4);
constexpr size_t O_VCMPB = O_KCMPB + al_((size_t)B_ * 2 * 512 * 64 * 2);
constexpr size_t O_OCMP = O_VCMPB + al_((size_t)B_ * 2 * 512 * 64 * 2);
constexpr size_t O_SELMASK = O_OCMP + al_((size_t)T_ * 512 * 4);
constexpr size_t O_WT1 = O_SELMASK + al_((size_t)B_ * 2 * S_ * 16);
constexpr size_t O_BIAS1 = O_WT1 + al_((size_t)L_ * 2 * 256 * 2048 * 2);
constexpr size_t O_HID = O_BIAS1 + al_((size_t)L_ * 2 * 128 * 4);
constexpr size_t O_BIAS1P = O_HID + al_((size_t)8 * 512 * 128 * 2);
constexpr size_t O_RWT = O_BIAS1P + al_((size_t)L_ * 2 * 64 * 128 * 4);
constexpr size_t O_HIDP = O_RWT + al_((size_t)L_ * 2 * NE * D_ * 2);
constexpr size_t O_END = O_HIDP + al_((size_t)2 * 8 * 512 * 128 * 4);

struct P {
    In in; unsigned char* ws; float* out;
};
typedef const __attribute__((address_space(4))) P* KP;
__device__ __forceinline__ KP fresh_kp() { KP k = (KP)__builtin_amdgcn_kernarg_segment_ptr(); asm volatile("" : "+s"(k)); return k; }
#define WSP(T, off) ((T*)(p->ws + (off)))

__device__ __forceinline__ float bf2f(unsigned short b) { return __uint_as_float((unsigned)b << 16); }
__device__ __forceinline__ unsigned f2bf(float f) { unsigned u = __float_as_uint(f); return (u + 0x7fffu + ((u >> 16) & 1u)) >> 16; }
__device__ __forceinline__ unsigned pk2(float lo, float hi) { return f2bf(lo) | (f2bf(hi) << 16); }
__device__ __forceinline__ void ld8(const bf16_t* __restrict__ src, float* dst) {
    const u32x4 v = *(const u32x4*)src;
    dst[0] = __uint_as_float(v.x << 16); dst[1] = __uint_as_float(v.x & 0xffff0000u); dst[2] = __uint_as_float(v.y << 16); dst[3] = __uint_as_float(v.y & 0xffff0000u);
    dst[4] = __uint_as_float(v.z << 16); dst[5] = __uint_as_float(v.z & 0xffff0000u); dst[6] = __uint_as_float(v.w << 16); dst[7] = __uint_as_float(v.w & 0xffff0000u);
}


__device__ __forceinline__ int perm_in(int n) {
    if (n < 1280) return n;
    if (n < 1304) return C_GATE + (n - 1280);
    if (n < 2072) return C_FOX + (n - 1304);
    if (n < 2076) return C_GATE + 24 + (n - 2072);
    return C_SB + (n - 2076);
}
__device__ __forceinline__ int perm_gu(int n) { const int up = n >> 10, c = n & 1023; return 256 * (c >> 7) + 128 * up + (c & 127); }
template <int MAP>
__device__ __forceinline__ void transpose_item(const float* __restrict__ W, int K, int N, bf16_t* __restrict__ WT, LAS float* scr, int item, int lane) {
    const int nblk = (N + 31) / 32, kb = item / nblk, nb = item % nblk, k0 = 64 * kb, n0 = 32 * nb;
    { const int n4 = (lane & 7) * 4; const bool okn = (n0 + n4) < N;
      f32x4 t[8];
#pragma unroll
      for (int i = 0; i < 8; ++i) { const int kk = (lane >> 3) + 8 * i; t[i] = okn ? *(const f32x4*)(W + (size_t)(k0 + kk) * N + n0 + n4) : (f32x4){0.f, 0.f, 0.f, 0.f}; }
#pragma unroll
      for (int i = 0; i < 8; ++i) { const int kk = (lane >> 3) + 8 * i; LAS float* d = scr + kk * 33 + n4; d[0] = t[i].x; d[1] = t[i].y; d[2] = t[i].z; d[3] = t[i].w; } }
    asm volatile("s_waitcnt lgkmcnt(0)" ::: "memory");
    const int c = lane & 7;
#pragma unroll
    for (int j = 0; j < 4; ++j) { const int n = (lane >> 3) + 8 * j; const LAS float* sp = scr + (8 * c) * 33 + n;
        u32x4 o; o.x = pk2(sp[0 * 33], sp[1 * 33]); o.y = pk2(sp[2 * 33], sp[3 * 33]); o.z = pk2(sp[4 * 33], sp[5 * 33]); o.w = pk2(sp[6 * 33], sp[7 * 33]);
        const int ng = n0 + n;
        if (ng < N) { const int ro = (MAP == 1) ? perm_in(ng) : (MAP == 2) ? perm_gu(ng) : ng;
            if (MAP == 3) *(u32x4*)(WT + (size_t)(k0 >> 10) * 256 * 1024 + (size_t)ro * 1024 + (k0 & 1023) + 8 * c) = o;
            else *(u32x4*)(WT + (size_t)ro * K + k0 + 8 * c) = o; } }
    asm volatile("s_waitcnt lgkmcnt(0)" ::: "memory");
}
constexpr int CV_I_IN = 16 * 89, CV_I_OUT = 16 * 32, CV_I_GU = 16 * 64, CV_I_DN = 16 * 32, CV_I_W1 = 32 * 4;
constexpr int CV_N_IN = L_ * CV_I_IN, CV_N_OUT = L_ * CV_I_OUT, CV_N_GU = L_ * NE * CV_I_GU, CV_N_DN = L_ * NE * CV_I_DN, CV_N_W1 = L_ * 2 * CV_I_W1, CV_N_ALL = CV_N_IN + CV_N_OUT + CV_N_GU + CV_N_DN + CV_N_W1;
constexpr int CV_DEF_GU0 = CV_N_W1 + NE * CV_I_GU, CV_DEF_GU = NE * CV_I_GU, CV_DEF_DN0 = CV_N_W1 + CV_N_GU + NE * CV_I_DN, CV_DEF_DN = NE * CV_I_DN, CV_DEF_ALL = CV_DEF_GU + CV_DEF_DN;
__device__ __forceinline__ void cv_one(KP p, LAS float* scr, int it, int lane) {
    int r = it;
    if (r < CV_N_W1) { const int mtx = r / CV_I_W1, ll = mtx >> 1, kv = mtx & 1; transpose_item<3>((kv ? p->in.w1v : p->in.w1k) + (size_t)ll * 2048 * 128, 2048, 128, WSP(bf16_t, O_WT1) + (size_t)mtx * 256 * 2048, scr, r % CV_I_W1, lane); return; } r -= CV_N_W1;
    if (r < CV_N_GU) { const int mtx = r / CV_I_GU; transpose_item<2>(p->in.wgu + (size_t)mtx * D_ * 2048, D_, 2048, WSP(bf16_t, O_WTGU) + (size_t)mtx * 2048 * D_, scr, r % CV_I_GU, lane); return; } r -= CV_N_GU;
    if (r < CV_N_DN) { const int mtx = r / CV_I_DN; transpose_item<0>(p->in.wdn + (size_t)mtx * D_ * D_, D_, D_, WSP(bf16_t, O_WTDN) + (size_t)mtx * D_ * D_, scr, r % CV_I_DN, lane); return; } r -= CV_N_DN;
    if (r < CV_N_IN) { const int mtx = r / CV_I_IN; transpose_item<1>(p->in.w_in + (size_t)mtx * D_ * DIN, D_, DIN, WSP(bf16_t, O_WTIN) + (size_t)mtx * NPAD * D_, scr, r % CV_I_IN, lane); return; } r -= CV_N_IN;
    { const int mtx = r / CV_I_OUT; transpose_item<0>(p->in.w_out + (size_t)mtx * D_ * D_, D_, D_, WSP(bf16_t, O_WTOUT) + (size_t)mtx * D_ * D_, scr, r % CV_I_OUT, lane); }
}
__device__ __forceinline__ void cv_help(LAS unsigned char* lds, KP p, int maxchunks) {
    const int tid = ftid(), lane = tid & 63, wv = tid >> 6; LAS float* scr = (LAS float*)(lds + wv * 8448);
    unsigned* cursor = WSP(unsigned, O_COUNTS) + 64;
    for (int c = 0; c < maxchunks; ++c) {
        unsigned base = 0u; if (lane == 0) base = atomicAdd(cursor, 8u);
        base = (unsigned)__builtin_amdgcn_readfirstlane((int)base);
        if (base >= (unsigned)CV_DEF_ALL) break;
        for (int i = 0; i < 8; ++i) { const int d = (int)base + i; if (d < CV_DEF_ALL) cv_one(p, scr, d < CV_DEF_GU ? CV_DEF_GU0 + d : CV_DEF_DN0 + (d - CV_DEF_GU), lane); }
    }
}
__device__ __forceinline__ void ph_convert(LAS unsigned char* lds, KP p) {
    const int tid = ftid(), lane = tid & 63, wv = tid >> 6;
    LAS float* scr = (LAS float*)(lds + wv * 8448);
    const int gw = fbid() * 8 + wv, NGW = gridDim.x * 8;
    for (int it = gw; it < CV_N_ALL; it += NGW) {
        if ((it >= CV_DEF_GU0 && it < CV_DEF_GU0 + CV_DEF_GU) || (it >= CV_DEF_DN0 && it < CV_DEF_DN0 + CV_DEF_DN)) continue;
        cv_one(p, scr, it, lane);
    }
    const int gt = fbid() * NT + tid, NG = gridDim.x * NT;
    for (int i = gt; i < L_ * (NPAD - DIN) * (D_ / 8); i += NG) { const int l = i / ((NPAD - DIN) * (D_ / 8)), r = i % ((NPAD - DIN) * (D_ / 8));
        unsigned z_ = 0u; asm volatile("" : "+v"(z_));
        *(u32x4*)(WSP(bf16_t, O_WTIN) + ((size_t)l * NPAD + DIN) * D_ + (size_t)r * 8) = (u32x4){z_, z_, z_, z_}; }
    for (int i = gt; i < L_ * 2 * 2 * 128 * (1024 / 8); i += NG) { const int mtxh = i / (128 * 128), r = i % (128 * 128); unsigned z_ = 0u; asm volatile("" : "+v"(z_));
        *(u32x4*)(WSP(bf16_t, O_WT1) + ((size_t)mtxh * 256 + 128) * 1024 + (size_t)r * 8) = (u32x4){z_, z_, z_, z_}; }
    for (int i = gt; i < L_ * 2 * 64 * 128; i += NG) { const int j = i & 127, seg = (i >> 7) & 63, mtx = i >> 13, ll = mtx >> 1, kv = mtx & 1;
        const float* pos = (kv ? p->in.pos_v : p->in.pos_k) + (size_t)ll * 2048 + seg * 32; const float* w1 = (kv ? p->in.w1v : p->in.w1k) + (size_t)ll * 2048 * 128 + (size_t)seg * 32 * 128; float a = 0.f;
#pragma unroll 8
        for (int k = 0; k < 32; ++k) a += pos[k] * w1[(size_t)k * 128 + j];
        WSP(float, O_BIAS1P)[i] = a; }
    for (int i = gt; i < L_ * NPAD; i += NG) { const int l = i / NPAD, c = i % NPAD; if (c >= DIN) WSP(float, O_BIASP)[i] = 0.f; }
    for (int i = gt; i < L_ * DIN; i += NG) { const int l = i / DIN, n = i % DIN; WSP(float, O_BIASP)[l * NPAD + perm_in(n)] = p->in.b_in[i]; }
    for (int i = gt; i < L_ * NE * D_; i += NG) { const int k = i & (D_ - 1), e = (i >> 10) & (NE - 1), l = i >> 15;
        const float v = p->in.rw[((size_t)l * D_ + k) * NE + e]; const unsigned h = f2bf(v); const float lo = v - bf2f((unsigned short)h);
        WSP(bf16_t, O_RWT)[((size_t)(l * 2 + 0) * NE + e) * D_ + k] = (bf16_t)h; WSP(bf16_t, O_RWT)[((size_t)(l * 2 + 1) * NE + e) * D_ + k] = (bf16_t)f2bf(lo); }
    for (int i = gt; i < T_ * D_ / 8; i += NG) { const f32x4 a = *(const f32x4*)(p->in.x + (size_t)i * 8), b = *(const f32x4*)(p->in.x + (size_t)i * 8 + 4);
        *(u32x4*)(WSP(bf16_t, O_XB) + (size_t)i * 8) = (u32x4){pk2(a.x, a.y), pk2(a.z, a.w), pk2(b.x, b.y), pk2(b.z, b.w)}; }
}

struct EpiProj {
    static constexpr bool PERM = true;
    bf16_t* projb; float* gf; const float* bias;
    __device__ __forceinline__ void operator()(const pg8::f32x4 (&acc)[2][2][4][2], const pg8::Unit& u, int wr, int wc, int fr, int fq) const {
        const int row0 = u.pm * 256 + wr * 64 + fr, col0 = u.pn * 256 + wc * 32 + 8 * fq;
        if (u.pn < 11) {
#pragma unroll
            for (int ai = 0; ai < 2; ++ai)
#pragma unroll
                for (int m = 0; m < 4; ++m) { bf16_t* rowp = projb + (size_t)(row0 + ai * 128 + m * 16) * PB + col0;
#pragma unroll
                    for (int bj = 0; bj < 2; ++bj) { const f32x4 v0 = acc[ai][bj][m][0] + *(const f32x4*)(bias + col0 + bj * 128), v1 = acc[ai][bj][m][1] + *(const f32x4*)(bias + col0 + bj * 128 + 4);
                        u32x4 w; w.x = pg8::cvt_pk_bf16(v0[0], v0[1]); w.y = pg8::cvt_pk_bf16(v0[2], v0[3]); w.z = pg8::cvt_pk_bf16(v1[0], v1[1]); w.w = pg8::cvt_pk_bf16(v1[2], v1[3]);
                        *(u32x4*)(rowp + bj * 128) = w; }
                    asm volatile("" ::: "memory"); }
        } else if (wc == 0) {
            const f32x4 b0 = *(const f32x4*)(bias + col0), b1 = *(const f32x4*)(bias + col0 + 4);
#pragma unroll
            for (int ai = 0; ai < 2; ++ai)
#pragma unroll
                for (int m = 0; m < 4; ++m) { float* rowp = gf + (size_t)(row0 + ai * 128 + m * 16) * 32 + 8 * fq;
                    const f32x4 v0 = acc[ai][0][m][0] + b0, v1 = acc[ai][0][m][1] + b1; f32x4 o0, o1;
#pragma unroll
                    for (int i = 0; i < 4; ++i) { const int j0 = 8 * fq + i, j1 = j0 + 4;
                        o0[i] = (j0 < 24) ? sigmoidf_(v0[i]) : (j0 < 28 ? logsig(v0[i]) : 0.f); o1[i] = (j1 < 24) ? sigmoidf_(v1[i]) : (j1 < 28 ? logsig(v1[i]) : 0.f); }
                    *(f32x4*)rowp = o0; *(f32x4*)(rowp + 4) = o1; }
        }
    }
};
struct EpiOut {
    static constexpr bool PERM = true;
    bf16_t* mixb;
    __device__ __forceinline__ void operator()(const pg8::f32x4 (&acc)[2][2][4][2], const pg8::Unit& u, int wr, int wc, int fr, int fq) const {
        const int row0 = u.pm * 256 + wr * 64 + fr, col0 = u.pn * 256 + wc * 32 + 8 * fq;
#pragma unroll
        for (int ai = 0; ai < 2; ++ai)
#pragma unroll
            for (int m = 0; m < 4; ++m) { bf16_t* rowp = mixb + (size_t)(row0 + ai * 128 + m * 16) * D_ + col0;
#pragma unroll
                for (int bj = 0; bj < 2; ++bj) { const f32x4 v0 = acc[ai][bj][m][0], v1 = acc[ai][bj][m][1];
                    u32x4 w; w.x = pg8::cvt_pk_bf16(v0[0], v0[1]); w.y = pg8::cvt_pk_bf16(v0[2], v0[3]); w.z = pg8::cvt_pk_bf16(v1[0], v1[1]); w.w = pg8::cvt_pk_bf16(v1[2], v1[3]);
                    *(u32x4*)(rowp + bj * 128) = w; }
                asm volatile("" ::: "memory"); }
    }
};
struct EpiGU {
    static constexpr bool PERM = true;
    bf16_t* act; const float* bgu;
    __device__ __forceinline__ void operator()(const pg8::f32x4 (&acc)[2][2][4][2], const pg8::Unit& u, int wr, int wc, int fr, int fq) const {
        const int row0 = u.pm * 256 + wr * 64 + fr, col0 = u.pn * 128 + wc * 32 + 8 * fq;
        const float* bb = bgu + (size_t)u.e * 2048 + col0;
        const f32x4 bg0 = *(const f32x4*)bb, bg1 = *(const f32x4*)(bb + 4), bu0 = *(const f32x4*)(bb + 1024), bu1 = *(const f32x4*)(bb + 1028);
#pragma unroll
        for (int ai = 0; ai < 2; ++ai)
#pragma unroll
            for (int m = 0; m < 4; ++m) { f32x4 a0, a1;
                const f32x4 g0 = acc[ai][0][m][0] + bg0, g1 = acc[ai][0][m][1] + bg1, u0 = acc[ai][1][m][0] + bu0, u1 = acc[ai][1][m][1] + bu1;
#pragma unroll
                for (int i = 0; i < 4; ++i) { const float gt0 = fminf(g0[i], 7.0f), up0 = fminf(fmaxf(u0[i], -7.0f), 7.0f), gt1 = fminf(g1[i], 7.0f), up1 = fminf(fmaxf(u1[i], -7.0f), 7.0f);
                    a0[i] = gt0 * sigmoidf_(1.702f * gt0) * (up0 + 1.0f); a1[i] = gt1 * sigmoidf_(1.702f * gt1) * (up1 + 1.0f); }
                u32x4 w; w.x = pg8::cvt_pk_bf16(a0[0], a0[1]); w.y = pg8::cvt_pk_bf16(a0[2], a0[3]); w.z = pg8::cvt_pk_bf16(a1[0], a1[1]); w.w = pg8::cvt_pk_bf16(a1[2], a1[3]);
                *(u32x4*)(act + (size_t)(row0 + ai * 128 + m * 16) * D_ + col0) = w; asm volatile("" ::: "memory"); }
    }
};
struct EpiDN {
    static constexpr bool PERM = true;
    bf16_t* y; const float* bdn; const float* roww;
    __device__ __forceinline__ void operator()(const pg8::f32x4 (&acc)[2][2][4][2], const pg8::Unit& u, int wr, int wc, int fr, int fq) const {
        const int row0 = u.pm * 256 + wr * 64 + fr, col0 = u.pn * 256 + wc * 32 + 8 * fq;
        const float* bb = bdn + (size_t)u.e * D_ + col0;
#pragma unroll
        for (int ai = 0; ai < 2; ++ai)
#pragma unroll
            for (int m = 0; m < 4; ++m) { const int row = row0 + ai * 128 + m * 16; const float w = roww[row];
#pragma unroll
                for (int bj = 0; bj < 2; ++bj) { const f32x4 v0 = (acc[ai][bj][m][0] + *(const f32x4*)(bb + bj * 128)) * w, v1 = (acc[ai][bj][m][1] + *(const f32x4*)(bb + bj * 128 + 4)) * w;
                    u32x4 o; o.x = pg8::cvt_pk_bf16(v0[0], v0[1]); o.y = pg8::cvt_pk_bf16(v0[2], v0[3]); o.z = pg8::cvt_pk_bf16(v1[0], v1[1]); o.w = pg8::cvt_pk_bf16(v1[2], v1[3]);
                    *(u32x4*)(y + (size_t)row * D_ + col0 + bj * 128) = o; }
                asm volatile("" ::: "memory"); }
    }
};
struct EpiCmp {
    static constexpr bool PERM = true;
    float* hidp;
    __device__ __forceinline__ void operator()(const pg8::f32x4 (&acc)[2][2][4][2], const pg8::Unit& u, int wr, int wc, int fr, int fq) const {
        const int row0 = u.pm * 256 + wr * 64 + fr, col0 = wc * 32 + 8 * fq;
#pragma unroll
        for (int ai = 0; ai < 2; ++ai)
#pragma unroll
            for (int m = 0; m < 4; ++m) { float* d = hidp + (((size_t)u.pn * 8 + u.e) * 512 + row0 + ai * 128 + m * 16) * 128 + col0;
                *(f32x4*)d = acc[ai][0][m][0]; *(f32x4*)(d + 4) = acc[ai][0][m][1]; asm volatile("" ::: "memory"); }
    }
};
struct GEpi {
    static constexpr bool PERM = true;
    int kind, l;
    __device__ __forceinline__ void operator()(const pg8::f32x4 (&acc)[2][2][4][2], const pg8::Unit& u, int wr, int wc, int fr, int fq) const {
        const KP p = fresh_kp();
        if (kind == 0) { const EpiProj e{WSP(bf16_t, O_PROJB), WSP(float, O_GF), WSP(float, O_BIASP) + l * NPAD}; e(acc, u, wr, wc, fr, fq); }
        else if (kind == 1) { const EpiOut e{WSP(bf16_t, O_MIX)}; e(acc, u, wr, wc, fr, fq); }
        else if (kind == 2) { const EpiGU e{WSP(bf16_t, O_ACT), p->in.bgu + (size_t)l * NE * 2048}; e(acc, u, wr, wc, fr, fq); }
        else if (kind == 3) { const EpiDN e{WSP(bf16_t, O_Y), p->in.bdn + (size_t)l * NE * D_, WSP(float, O_ROWW)}; e(acc, u, wr, wc, fr, fq); }
        else { const EpiCmp e{WSP(float, O_HIDP)}; e(acc, u, wr, wc, fr, fq); }
    }
};
struct GSched {
    int kind, nM, nN, nunits, G, c; const int* meta; const int* rowtok; const char* Bt; size_t estep;
    __device__ __forceinline__ bool next(int i, pg8::Unit& u) const {
        const int L = i * G + c; if (L >= nunits) return false;
        if (kind == 1) {
            int wgid = L; { const int q = nunits / pg8::NXCD, r = nunits % pg8::NXCD, xcd = wgid % pg8::NXCD, off = wgid / pg8::NXCD; wgid = (xcd < r ? xcd * (q + 1) : r * (q + 1) + (xcd - r) * q) + off; }
            const int nig = pg8::WGM * nN, gid = wgid / nig, fm = gid * pg8::WGM, gsz = (nM - fm) < pg8::WGM ? (nM - fm) : pg8::WGM;
            u.pm = fm + ((wgid % nig) % gsz); u.pn = (wgid % nig) / gsz; u.e = 0; u.nr = 256;
        } else if (kind == 4) { u.e = L >> 2; u.pm = (L >> 1) & 1; u.pn = L & 1; u.nr = ((L >> 1) & 1) ? 255 : 256; }
        else if (kind == 0) { const int gt = L / nN; u.pm = gt; u.pn = L - gt * nN; u.e = 0; u.nr = 256; }
        else { const int gt = L / nN; u.pm = gt; u.pn = L - gt * nN; u.e = meta[64 + 2 * gt]; u.nr = meta[65 + 2 * gt]; }
        return true; }
    __device__ __forceinline__ unsigned a_off(const pg8::Unit& u, int r) const { const int rr = r < u.nr ? r : u.nr - 1; const int row = u.pm * 256 + rr;
        if (kind == 4) { const int kv = u.e & 1, bg = u.e >> 1; return (unsigned)(((bg >> 1) * S_ + 16 * row + 16 * u.pn) * PB + C_KV + ((0 * 2 + kv) * 2 + (bg & 1)) * 64) * 2u; }
        return (unsigned)((kind == 2) ? rowtok[row] : row) * (unsigned)(D_ * 2); }
    __device__ __forceinline__ size_t a_kstep() const { return kind == 4 ? (size_t)PB * 2 : (size_t)128; }
    __device__ __forceinline__ const char* b_base(const pg8::Unit& u) const { return Bt + (size_t)(kind == 4 ? (u.e & 1) : u.e) * estep + (size_t)u.pn * ((size_t)256 * D_ * 2); }
};

__device__ __forceinline__ void ph_rmsnorm(KP p, int l) {
    const int lane = ftid() & 63, wv = ftid() >> 6; const float* g = p->in.g_out + (size_t)l * D_;
    constexpr int NB = 4; const int rstride = (int)gridDim.x * 8;
    f32x4 gg[4];
#pragma unroll
    for (int j = 0; j < 2; ++j) { gg[2 * j] = *(const f32x4*)(g + 512 * j + lane * 8); gg[2 * j + 1] = *(const f32x4*)(g + 512 * j + lane * 8 + 4); }
    for (int row0 = fbid() * 8 + wv; row0 < T_; row0 += rstride * NB) {
        u32x4 ra[NB], rb2[NB], rw2[NB];
#pragma unroll
        for (int bi = 0; bi < NB; ++bi) { const int row = (row0 + bi * rstride < T_) ? row0 + bi * rstride : row0; const bf16_t* r = WSP(bf16_t, O_O) + (size_t)row * D_ + lane * 8;
            ra[bi] = *(const u32x4*)r; rb2[bi] = *(const u32x4*)(r + 512); rw2[bi] = *(const u32x4*)(WSP(bf16_t, O_OWIN) + (size_t)row * 512 + lane * 8); }
#pragma unroll
        for (int bi = 0; bi < NB; ++bi) { const int row = row0 + bi * rstride; if (row < T_) {
#define BF_LO(u) __uint_as_float((u) << 16)
#define BF_HI(u) __uint_as_float((u) & 0xffff0000u)
            const f32x4 x0 = (f32x4){BF_LO(ra[bi].x) + BF_LO(rw2[bi].x), BF_HI(ra[bi].x) + BF_HI(rw2[bi].x), BF_LO(ra[bi].y) + BF_LO(rw2[bi].y), BF_HI(ra[bi].y) + BF_HI(rw2[bi].y)};
            const f32x4 x1 = (f32x4){BF_LO(ra[bi].z) + BF_LO(rw2[bi].z), BF_HI(ra[bi].z) + BF_HI(rw2[bi].z), BF_LO(ra[bi].w) + BF_LO(rw2[bi].w), BF_HI(ra[bi].w) + BF_HI(rw2[bi].w)};
            const f32x4 y0 = (f32x4){BF_LO(rb2[bi].x), BF_HI(rb2[bi].x), BF_LO(rb2[bi].y), BF_HI(rb2[bi].y)}, y1 = (f32x4){BF_LO(rb2[bi].z), BF_HI(rb2[bi].z), BF_LO(rb2[bi].w), BF_HI(rb2[bi].w)};
#undef BF_LO
#undef BF_HI
            float s = (x0.x * x0.x + x0.y * x0.y) + (x0.z * x0.z + x0.w * x0.w) + (x1.x * x1.x + x1.y * x1.y) + (x1.z * x1.z + x1.w * x1.w);
            float s2 = (y0.x * y0.x + y0.y * y0.y) + (y0.z * y0.z + y0.w * y0.w) + (y1.x * y1.x + y1.y * y1.y) + (y1.z * y1.z + y1.w * y1.w);
            const float sc0 = rsqrtf(wsum(s) * (1.f / 512.f) + RMS_EPS);
#pragma unroll
            for (int o = 1; o < 32; o <<= 1) s2 += __shfl_xor(s2, o);
            const float sc1 = rsqrtf(s2 * (1.f / 256.f) + RMS_EPS);
            const f32x4 u0 = x0 * sc0 * gg[0], u1 = x1 * sc0 * gg[1], w0 = y0 * sc1 * gg[2], w1 = y1 * sc1 * gg[3];
            bf16_t* ro = WSP(bf16_t, O_OB) + (size_t)row * D_;
            *(u32x4*)(ro + lane * 8) = (u32x4){pk2(u0.x, u0.y), pk2(u0.z, u0.w), pk2(u1.x, u1.y), pk2(u1.z, u1.w)};
            *(u32x4*)(ro + 512 + lane * 8) = (u32x4){pk2(w0.x, w0.y), pk2(w0.z, w0.w), pk2(w1.x, w1.y), pk2(w1.z, w1.w)}; } }
    }
}
template <bool ROUTER>
__device__ __forceinline__ void ph_ln(float* lds, KP p, int l, float* __restrict__ yout, int cnt_off = 0) {
    const int lane = ftid() & 63, wv = ftid() >> 6;
    const float* g = (ROUTER ? p->in.ln1_g : p->in.ln2_g) + (size_t)l * D_; const float* bb = (ROUTER ? p->in.ln1_b : p->in.ln2_b) + (size_t)l * D_;
    constexpr int NB = ROUTER ? 4 : 2;
    const int rstride = (int)gridDim.x * 8;
    LAS unsigned char* L3 = (LAS unsigned char*)lds; float* lgl = lds + 33024 + wv * 256;
    int oi = 0;
    for (int row0 = fbid() * 8 + wv; row0 < T_; row0 += rstride * NB, ++oi) {
        float v[NB][16];
        if (ROUTER) { const float* xin = (l == 0) ? p->in.x : WSP(float, O_XA);
#pragma unroll
            for (int bi = 0; bi < NB; ++bi) { const int row = (row0 + bi * rstride < T_) ? row0 + bi * rstride : row0; const float* src = xin + (size_t)row * D_; const bf16_t* mx = WSP(bf16_t, O_MIX) + (size_t)row * D_;
#pragma unroll
                for (int j = 0; j < 2; ++j) { const f32x4 a = *(const f32x4*)(src + 512 * j + lane * 8), b = *(const f32x4*)(src + 512 * j + lane * 8 + 4); const u32x4 q = *(const u32x4*)(mx + 512 * j + lane * 8);
                    v[bi][8 * j + 0] = ALPHA * a.x + __uint_as_float(q.x << 16); v[bi][8 * j + 1] = ALPHA * a.y + __uint_as_float(q.x & 0xffff0000u); v[bi][8 * j + 2] = ALPHA * a.z + __uint_as_float(q.y << 16); v[bi][8 * j + 3] = ALPHA * a.w + __uint_as_float(q.y & 0xffff0000u);
                    v[bi][8 * j + 4] = ALPHA * b.x + __uint_as_float(q.z << 16); v[bi][8 * j + 5] = ALPHA * b.y + __uint_as_float(q.z & 0xffff0000u); v[bi][8 * j + 6] = ALPHA * b.z + __uint_as_float(q.w << 16); v[bi][8 * j + 7] = ALPHA * b.w + __uint_as_float(q.w & 0xffff0000u); } }
        } else { const bf16_t* y = WSP(bf16_t, O_Y);
            int sl[NB][TOPK];
#pragma unroll
            for (int bi = 0; bi < NB; ++bi) { const int row = (row0 + bi * rstride < T_) ? row0 + bi * rstride : row0;
#pragma unroll
                for (int k = 0; k < TOPK; ++k) sl[bi][k] = WSP(int, O_SLOT)[row * TOPK + k]; }
            u32x4 yv[NB][TOPK][2]; f32x4 xv[NB][4];
#pragma unroll
            for (int bi = 0; bi < NB; ++bi) { const int row = (row0 + bi * rstride < T_) ? row0 + bi * rstride : row0; const float* src = WSP(float, O_X1) + (size_t)row * D_;
#pragma unroll
                for (int j = 0; j < 2; ++j) { xv[bi][2 * j] = *(const f32x4*)(src + 512 * j + lane * 8); xv[bi][2 * j + 1] = *(const f32x4*)(src + 512 * j + lane * 8 + 4); }
#pragma unroll
                for (int k = 0; k < TOPK; ++k)
#pragma unroll
                    for (int j = 0; j < 2; ++j) yv[bi][k][j] = *(const u32x4*)(y + (size_t)sl[bi][k] * D_ + 512 * j + lane * 8); }
#pragma unroll
            for (int bi = 0; bi < NB; ++bi)
#pragma unroll
                for (int j = 0; j < 2; ++j) { float acc[8];
#pragma unroll
                    for (int e = 0; e < 8; ++e) acc[e] = 0.f;
#pragma unroll
                    for (int k = 0; k < TOPK; ++k) { const u32x4 q = yv[bi][k][j];
                        acc[0] += __uint_as_float(q.x << 16); acc[1] += __uint_as_float(q.x & 0xffff0000u); acc[2] += __uint_as_float(q.y << 16); acc[3] += __uint_as_float(q.y & 0xffff0000u);
                        acc[4] += __uint_as_float(q.z << 16); acc[5] += __uint_as_float(q.z & 0xffff0000u); acc[6] += __uint_as_float(q.w << 16); acc[7] += __uint_as_float(q.w & 0xffff0000u); }
                    const f32x4 a = xv[bi][2 * j], b = xv[bi][2 * j + 1];
                    v[bi][8 * j + 0] = ALPHA * a.x + acc[0]; v[bi][8 * j + 1] = ALPHA * a.y + acc[1]; v[bi][8 * j + 2] = ALPHA * a.z + acc[2]; v[bi][8 * j + 3] = ALPHA * a.w + acc[3];
                    v[bi][8 * j + 4] = ALPHA * b.x + acc[4]; v[bi][8 * j + 5] = ALPHA * b.y + acc[5]; v[bi][8 * j + 6] = ALPHA * b.z + acc[6]; v[bi][8 * j + 7] = ALPHA * b.w + acc[7]; } }
#pragma unroll
        for (int bi = 0; bi < NB; ++bi) { const int row = row0 + bi * rstride; if (row < T_) {
            float s = 0.f;
#pragma unroll
            for (int i = 0; i < 16; ++i) s += v[bi][i];
            const float mu = wsum(s) * (1.f / D_); float s2 = 0.f;
#pragma unroll
            for (int i = 0; i < 16; ++i) { v[bi][i] -= mu; s2 += v[bi][i] * v[bi][i]; }
            const float rstd = rsqrtf(wsum(s2) * (1.f / D_) + LN_EPS);
            bf16_t* ybf = (ROUTER ? WSP(bf16_t, O_X1B) : WSP(bf16_t, O_XB)) + (size_t)row * D_;
#pragma unroll
            for (int j = 0; j < 2; ++j) { const int c0 = 512 * j + lane * 8; float o8[8];
                const f32x4 g0 = *(const f32x4*)(g + c0), g1 = *(const f32x4*)(g + c0 + 4), b0 = *(const f32x4*)(bb + c0), b1 = *(const f32x4*)(bb + c0 + 4);
                o8[0] = v[bi][8 * j + 0] * rstd * g0.x + b0.x; o8[1] = v[bi][8 * j + 1] * rstd * g0.y + b0.y; o8[2] = v[bi][8 * j + 2] * rstd * g0.z + b0.z; o8[3] = v[bi][8 * j + 3] * rstd * g0.w + b0.w;
                o8[4] = v[bi][8 * j + 4] * rstd * g1.x + b1.x; o8[5] = v[bi][8 * j + 5] * rstd * g1.y + b1.y; o8[6] = v[bi][8 * j + 6] * rstd * g1.z + b1.z; o8[7] = v[bi][8 * j + 7] * rstd * g1.w + b1.w;
                *(f32x4*)(yout + (size_t)row * D_ + c0) = (f32x4){o8[0], o8[1], o8[2], o8[3]};
                *(f32x4*)(yout + (size_t)row * D_ + c0 + 4) = (f32x4){o8[4], o8[5], o8[6], o8[7]};
                const u32x4 hv = (u32x4){pk2(o8[0], o8[1]), pk2(o8[2], o8[3]), pk2(o8[4], o8[5]), pk2(o8[6], o8[7])};
                *(u32x4*)(ybf + c0) = hv;
                if (ROUTER) {
                    float r8[8];
#pragma unroll
                    for (int i = 0; i < 4; ++i) { const unsigned w_ = (i == 0) ? hv.x : (i == 1) ? hv.y : (i == 2) ? hv.z : hv.w; r8[2 * i] = o8[2 * i] - __uint_as_float(w_ << 16); r8[2 * i + 1] = o8[2 * i + 1] - __uint_as_float(w_ & 0xffff0000u); }
                    LAS unsigned char* tp = L3 + (bi * 8 + wv) * 2064 + c0 * 2;
                    *(LAS u32x4*)tp = hv; *(LAS u32x4*)(tp + 66048) = (u32x4){pk2(r8[0], r8[1]), pk2(r8[2], r8[3]), pk2(r8[4], r8[5]), pk2(r8[6], r8[7])}; } } } }
        if (ROUTER) {
            __syncthreads();
            const int n32 = lane & 31, hh = lane >> 5;
            f32x16 acc;
#pragma unroll
            for (int r = 0; r < 16; ++r) acc[r] = 0.f;
            { const bf16_t* bh = WSP(bf16_t, O_RWT) + ((size_t)(l * 2) * NE + n32) * D_ + 128 * wv + 8 * hh; const bf16_t* bl = bh + (size_t)NE * D_;
              const LAS unsigned char* ah = L3 + n32 * 2064 + (128 * wv + 8 * hh) * 2;
              bf16x8 bhf[8], blf[8];
#pragma unroll
              for (int s_ = 0; s_ < 8; ++s_) { bhf[s_] = *(const bf16x8*)(bh + 16 * s_); blf[s_] = *(const bf16x8*)(bl + 16 * s_); }
#pragma unroll
              for (int s_ = 0; s_ < 8; ++s_) { const bf16x8 xh = *(const LAS bf16x8*)(ah + 32 * s_), xl = *(const LAS bf16x8*)(ah + 66048 + 32 * s_);
                  acc = __builtin_amdgcn_mfma_f32_32x32x16_bf16(xh, bhf[s_], acc, 0, 0, 0); acc = __builtin_amdgcn_mfma_f32_32x32x16_bf16(xh, blf[s_], acc, 0, 0, 0); acc = __builtin_amdgcn_mfma_f32_32x32x16_bf16(xl, bhf[s_], acc, 0, 0, 0); } }
            __syncthreads();
            { LAS float* red = (LAS float*)L3;
#pragma unroll
              for (int r = 0; r < 16; ++r) red[(wv * 32 + CROW(r, hh)) * 32 + n32] = acc[r];
              __syncthreads();
#pragma unroll
              for (int bi = 0; bi < NB; ++bi) { const int m = bi * 8 + wv; float sm = 0.f;
#pragma unroll
                  for (int q = 0; q < 4; ++q) sm += red[((hh * 4 + q) * 32 + m) * 32 + n32];
                  sm += __shfl_xor(sm, 32);
                  if (lane < 32) lgl[(NB * oi + bi) * 32 + n32] = sm; } }
            __syncthreads();
        }
    }
    if (ROUTER) {
        const float* rb = p->in.rb + (size_t)l * NE;
        int nrow = 0; for (int r_ = fbid() * 8 + wv; r_ < T_; r_ += (int)gridDim.x * 8) { ++nrow; asm volatile("" : "+s"(nrow)); }
        asm volatile("s_waitcnt lgkmcnt(0)" ::: "memory");
        int* lcnt = (int*)(lds + 33024 + 8 * 256);
        if (ftid() < NE) lcnt[ftid()] = 0;
        __syncthreads();
#pragma unroll 1
        for (int ri = 0; ri < nrow; ++ri) { const int row = fbid() * 8 + wv + ri * (int)gridDim.x * 8;
            const int e = lane & 31; const float lg = lgl[ri * 32 + e] + rb[e];
            float cur = lg, tv0 = 0.f, den = 0.f, myw = 0.f; int mye = 0;
#pragma unroll
            for (int k = 0; k < TOPK; ++k) { float bv = cur; int bi = e;
#pragma unroll
                for (int o = 16; o >= 1; o >>= 1) { const float ov = __shfl_xor(bv, o); const int oi = __shfl_xor(bi, o); if (ov > bv || (ov == bv && oi < bi)) { bv = ov; bi = oi; } }
                if (k == 0) tv0 = bv;
                const float w = __expf(bv - tv0); den += w;
                if (lane == k) { mye = bi; myw = w; }
                if (e == bi) cur = -3.4e38f; }
            if (lane < TOPK) { WSP(int, O_TOPE)[row * TOPK + lane] = mye; WSP(float, O_TOPW)[row * TOPK + lane] = myw / den; WSP(int, O_POS)[row * TOPK + lane] = atomicAdd(&lcnt[mye], 1); } }
        __syncthreads();
        if (ftid() < NE) { const int c = lcnt[ftid()]; lcnt[ftid()] = (c > 0) ? atomicAdd(WSP(int, O_COUNTS) + CNT_IDX(l, ftid()) + cnt_off, c) : 0; }
        __syncthreads();
#pragma unroll 1
        for (int ri = 0; ri < nrow; ++ri) { const int row = fbid() * 8 + wv + ri * (int)gridDim.x * 8;
            if (lane < TOPK) WSP(int, O_POS)[row * TOPK + lane] += lcnt[WSP(int, O_TOPE)[row * TOPK + lane]]; }
        __syncthreads();
    }
}
__device__ __forceinline__ void ph_bias1_reduce(KP p, int l) {
    if (fbid() != (int)gridDim.x - 1) return;
    const int tid = ftid(); if (tid < 256) { const float* pp = WSP(float, O_BIAS1P) + ((size_t)(l * 2 + (tid >> 7)) * 64) * 128 + (tid & 127);
        float v[64];
#pragma unroll
        for (int s = 0; s < 64; ++s) v[s] = pp[s * 128];
        float a = 0.f;
#pragma unroll
        for (int s = 0; s < 64; ++s) a += v[s];
        WSP(float, O_BIAS1)[l * 256 + tid] = a; }
}
__device__ __forceinline__ void ph_cumsum(float* lds, KP p, int blk0) {
    const int tid = ftid(), lane = tid & 63, wv = tid >> 6; const int bh = fbid() - blk0;
    if (bh < 0 || bh >= B_ * 4) return;
    const int b = bh >> 2, h = bh & 3; const float* gf = WSP(float, O_GF) + (size_t)(b * S_ + tid * 16) * 32 + 24 + h;
    float v[16], run = 0.f;
#pragma unroll
    for (int i = 0; i < 16; ++i) { run += gf[(size_t)i * 32]; v[i] = run; }
    float inc = run;
#pragma unroll
    for (int o = 1; o < 64; o <<= 1) { const float t = __shfl_up(inc, o); if (lane >= o) inc += t; }
    if (lane == 63) lds[wv] = inc;
    __syncthreads();
    float woff = 0.f;
#pragma unroll
    for (int i = 0; i < 8; ++i) woff += (i < wv) ? lds[i] : 0.f;
    const float off = woff + inc - run; float* c = WSP(float, O_CFOX) + (size_t)bh * S_ + tid * 16;
#pragma unroll
    for (int i = 0; i < 4; ++i) *(f32x4*)(c + 4 * i) = (f32x4){v[4 * i] + off, v[4 * i + 1] + off, v[4 * i + 2] + off, v[4 * i + 3] + off};
    __syncthreads();
}
__device__ __forceinline__ void ph_prep2(KP p, int l) {
    { unsigned* kmax2 = WSP(unsigned, O_COUNTS) + 192 + l * 8;
      for (int i = fbid() * NT + ftid(); i < B_ * 4 * S_ * 2; i += gridDim.x * NT) { const int half = i & 1, t = (i >> 1) % S_, bh = (i >> 1) / S_, b = bh >> 2, h = bh & 3;
          const bf16_t* kr = WSP(bf16_t, O_PROJB) + (size_t)(b * S_ + t) * PB + C_FOX + (4 + h) * 64 + half * 32; float ss = 0.f;
#pragma unroll
          for (int c = 0; c < 4; ++c) { float k8[8]; ld8(kr + 8 * c, k8);
#pragma unroll
              for (int e = 0; e < 8; ++e) ss += k8[e] * k8[e]; }
          ss += __shfl_xor(ss, 1);
#pragma unroll
          for (int o = 2; o < 64; o <<= 1) ss = fmaxf(ss, __shfl_xor(ss, o));
          if ((ftid() & 63) == 0) atomicMax(kmax2 + bh, __float_as_uint(ss)); } }
    for (int i = fbid() * NT + ftid(); i < 8 * 512 * 64; i += gridDim.x * NT) {
        const int d = i & 63, n = (i >> 6) & 511, combo = i >> 15, kv = combo & 1, bg = combo >> 1;
        const float* w2 = (kv ? p->in.w2v : p->in.w2k) + (size_t)l * 128 * 64; const float* h0 = WSP(float, O_HIDP) + ((size_t)combo * 512 + n) * 128; const float* h1 = h0 + (size_t)8 * 512 * 128;
        const float* b1 = WSP(float, O_BIAS1) + l * 256 + kv * 128;
        const float hv0 = gelu_tanh(h0[d] + h1[d] + b1[d]), hv1 = gelu_tanh(h0[64 + d] + h1[64 + d] + b1[64 + d]);
        float a = 0.f;
#pragma unroll 16
        for (int c = 0; c < 64; ++c) a += __int_as_float(__builtin_amdgcn_readlane(__float_as_int(hv0), c)) * w2[c * 64 + d];
#pragma unroll 16
        for (int c = 0; c < 64; ++c) a += __int_as_float(__builtin_amdgcn_readlane(__float_as_int(hv1), c)) * w2[(64 + c) * 64 + d];
        (kv ? WSP(bf16_t, O_VCMPB) : WSP(bf16_t, O_KCMPB))[((size_t)bg * 512 + n) * 64 + d] = (n < NCMP) ? (bf16_t)f2bf(a) : (bf16_t)0; }
}
__device__ __forceinline__ void ph_moe_scatter2(float* lds, KP p, int l) {
    const int tid = ftid(); int* ts = (int*)lds;
    const int* counts = WSP(int, O_COUNTS) + CNT_IDX(l, 0); int* meta = WSP(int, O_META); int* cl = ts + 64;
    __syncthreads();
    if (tid < NE) cl[tid] = counts[tid * 32];
    __syncthreads();
    if (tid == 0) { int nt = 0; for (int e = 0; e < NE; ++e) { ts[e] = nt; nt += (cl[e] + 255) >> 8; } ts[32] = nt; }
    __syncthreads();
    if (fbid() == 0) { if (tid < NE) { const int c = cl[tid], t0 = ts[tid]; meta[tid] = t0; for (int r = 0, t = t0; r < c; r += 256, ++t) { meta[64 + 2 * t] = tid; meta[65 + 2 * t] = (c - r) < 256 ? (c - r) : 256; } }
        if (tid == 0) meta[32] = ts[32]; }
    for (int i = fbid() * NT + tid; i < MROWS; i += gridDim.x * NT) {
        const int row = ts[WSP(int, O_TOPE)[i]] * 256 + WSP(int, O_POS)[i];
        WSP(int, O_ROWTOK)[row] = i >> 2; WSP(float, O_ROWW)[row] = WSP(float, O_TOPW)[i]; WSP(int, O_SLOT)[i] = row; }
    __syncthreads();
}
}
namespace mk {
typedef short bf16x8 __attribute__((ext_vector_type(8)));
typedef float f32x16 __attribute__((ext_vector_type(16)));
typedef float f32x2_t __attribute__((ext_vector_type(2)));
typedef __bf16 bf16x2_t __attribute__((ext_vector_type(2)));
typedef unsigned u32x2 __attribute__((ext_vector_type(2)));
typedef short v4i16_t __attribute__((ext_vector_type(4)));
__device__ __forceinline__ unsigned cvtpk(float lo, float hi) { f32x2_t v = {lo, hi}; bf16x2_t b = __builtin_convertvector(v, bf16x2_t); return __builtin_bit_cast(unsigned, b); }
constexpr int KROW = 144, VROW = 136;
constexpr int E1_K = 0, E1_V = 64 * KROW, E1_C = E1_V + 64 * KROW, E1_BUF = E1_C + 256;
constexpr int E1_FLAGS = 2 * E1_BUF;
constexpr float LOG2E = 1.4426950408889634f;
constexpr float RESC_THR = 8.0f;
#define CROW(reg, hh) (((reg) & 3) + 8 * ((reg) >> 2) + 4 * (hh))

__device__ __forceinline__ float max3f(float a, float b, float c) { float r; asm("v_max3_f32 %0, %1, %2, %3" : "=v"(r) : "v"(a), "v"(b), "v"(c)); return r; }
typedef float f32x2_t __attribute__((ext_vector_type(2)));
#define SM_V(p0, p1, i_) (((i_) & 1) ? p1[(i_) >> 1] : p0[(i_) >> 1])
#define SM_ROWMAX(p0, p1, rm_) do { \
    rm_ = max3f(p0[0], p1[0], p0[1]); \
    _Pragma("unroll") for (int k_ = 0; k_ < 14; ++k_) rm_ = max3f(rm_, SM_V(p0, p1, 3 + 2 * k_), SM_V(p0, p1, 4 + 2 * k_)); \
    rm_ = max3f(rm_, p1[15], p1[15]); \
    { const float x_ = __shfl_xor(rm_, 32); rm_ = max3f(rm_, x_, x_); } } while (0)
#define SM_CORE(p0, p1, m, l, have, o0, o1) do { \
    float rm_; SM_ROWMAX(p0, p1, rm_); \
    const bool fin_ = rm_ > -1e37f; \
    if (__any((rm_ > RESC_THR) || (!have && fin_))) { \
        const float dl_ = have ? fmaxf(rm_, 0.f) : (fin_ ? rm_ : 0.f); const float al_ = have ? __builtin_amdgcn_exp2f(-dl_) : 1.f; \
        m += dl_; l *= al_; have = have || fin_; \
        _Pragma("unroll") for (int r_ = 0; r_ < 16; ++r_) { o0[r_] *= al_; o1[r_] *= al_; p0[r_] -= dl_; p1[r_] -= dl_; } } \
    f32x2_t ls2_ = {0.f, 0.f}; \
    _Pragma("unroll") for (int reg_ = 0; reg_ < 16; reg_ += 2) { \
        p0[reg_] = __builtin_amdgcn_exp2f(p0[reg_]); p0[reg_ + 1] = __builtin_amdgcn_exp2f(p0[reg_ + 1]); p1[reg_] = __builtin_amdgcn_exp2f(p1[reg_]); p1[reg_ + 1] = __builtin_amdgcn_exp2f(p1[reg_ + 1]); \
        ls2_ += (f32x2_t){p0[reg_], p0[reg_ + 1]}; ls2_ += (f32x2_t){p1[reg_], p1[reg_ + 1]}; } \
    l += ls2_.x + ls2_.y; } while (0)

struct E1Geom { int b, q0, h; const bf16_t* qp; const bf16_t* kp; const bf16_t* vp; size_t pitch; };

template <int KIND>
__device__ __forceinline__ void e1_unit(LAS unsigned char* lds, KP p, int b, int hg, int qb, bf16_t* __restrict__ obase, bf16_t* __restrict__ owin, const unsigned* __restrict__ kmax2) {
    const int tid = ftid(), lane = tid & 63, w = __builtin_amdgcn_readfirstlane(tid >> 6), r32 = lane & 31, hh = lane >> 5;
    const bf16_t* projb = WSP(bf16_t, O_PROJB);
    int h, q0, qrow0, qcol, kcol, vcol, nrows;
    if (KIND == 0) { h = hg; q0 = qb * 256; qrow0 = q0 + 32 * w; qcol = C_FOX + h * 64; kcol = C_FOX + (4 + h) * 64; vcol = C_FOX + (8 + h) * 64; nrows = 256; }
    else if (KIND == 2) { h = hg; q0 = qb * 256; qrow0 = q0 + 32 * w; qcol = C_SB + h * 64; kcol = C_SB + (4 + h) * 64; vcol = C_SB + (8 + h) * 64; nrows = 256; }
    else { h = 4 * hg + (w & 3); q0 = qb * 64; qrow0 = q0 + 32 * (w >> 2); qcol = h * 64; kcol = C_KV + ((2 * 2 + 0) * 2 + hg) * 64; vcol = C_KV + ((2 * 2 + 1) * 2 + hg) * 64; nrows = 64; }
    const int tq = qrow0 + r32;
    const bf16_t* kbase = projb + (size_t)(b * S_) * PB + kcol; const bf16_t* vbase = projb + (size_t)(b * S_) * PB + vcol;
    bf16x8 qf[4];
    { const bf16_t* qptr = projb + (size_t)(b * S_ + tq) * PB + qcol + 8 * hh;
#pragma unroll
      for (int d0 = 0; d0 < 4; ++d0) qf[d0] = *(const bf16x8*)(qptr + 16 * d0);
      if (KIND == 1) {
#pragma unroll
          for (int d0 = 0; d0 < 4; ++d0) { u32x4 w_;
#pragma unroll
              for (int e2 = 0; e2 < 4; ++e2) { const float lo_ = bf2f((unsigned short)qf[d0][2 * e2]) * (SCALE * LOG2E), hi_ = bf2f((unsigned short)qf[d0][2 * e2 + 1]) * (SCALE * LOG2E); w_[e2] = cvtpk(lo_, hi_); }
              qf[d0] = __builtin_bit_cast(bf16x8, w_); } } }
    int j0 = 0; const int j1 = (q0 + nrows - 1) >> 6;
    if (KIND == 1) { j0 = (q0 - 511) >> 6; if (j0 < 0) j0 = 0; }
    const int ntile = j1 - j0 + 1;
    float ct2 = 0.f, sl2 = 0.f; const float* cb = nullptr;
    if (KIND == 0) { cb = WSP(float, O_CFOX) + (size_t)(b * 4 + h) * S_; ct2 = cb[tq] * LOG2E; }
    if (KIND == 1) sl2 = exp2f(-(float)(h + 1)) * LOG2E;
    bf16x8 kx0 = {0, 0, 0, 0, 0, 0, 0, 0}, kx1 = {0, 0, 0, 0, 0, 0, 0, 0}; float sl2h = 0.f, sl2l = 0.f;
    if (KIND == 1) { const unsigned one_ = 0x3f80u; const unsigned k0_ = f2bf((float)r32), k1_ = f2bf((float)(r32 + 32));
        if (hh == 0) { kx0 = __builtin_bit_cast(bf16x8, (u32x4){k0_ | (k0_ << 16), one_ | (one_ << 16), one_, 0u}); kx1 = __builtin_bit_cast(bf16x8, (u32x4){k1_ | (k1_ << 16), one_ | (one_ << 16), one_, 0u}); }
        sl2h = bf2f((unsigned short)f2bf(sl2)); sl2l = sl2 - sl2h; }
    float qkb = 0.f;
    if (KIND == 0) { float qs = 0.f;
#pragma unroll
        for (int d0 = 0; d0 < 4; ++d0)
#pragma unroll
            for (int e = 0; e < 8; ++e) { const float x = bf2f((unsigned short)qf[d0][e]); qs += x * x; }
        qs += __shfl_xor(qs, 32);
        const float km2 = __uint_as_float(kmax2[b * 4 + h]);
        qkb = sqrtf(qs * km2) * (SCALE * LOG2E * 1.01f); }
    const float tqf = (float)tq;
    const int skey = tid >> 3, sch = tid & 7;
    u32x4 rk, rv; float rc = 0.f;
#define E1_LOAD(jj) do { const size_t ro_ = (size_t)((jj) * 64 + skey) * PB + sch * 8; rk = *(const u32x4*)(kbase + ro_); rv = *(const u32x4*)(vbase + ro_); \
        if (KIND == 0 && tid < 64) rc = cb[(jj) * 64 + tid] * LOG2E; } while (0)
#define E1_WRITE(bufp) do { *(LAS u32x4*)((bufp) + E1_K + skey * KROW + sch * 16) = rk; *(LAS u32x4*)((bufp) + E1_V + skey * KROW + sch * 16) = rv; \
        if (KIND == 0 && tid < 64) ((LAS float*)((bufp) + E1_C))[tid] = rc; } while (0)
    f32x16 o0, o1;
#pragma unroll
    for (int r = 0; r < 16; ++r) { o0[r] = 0.f; o1[r] = 0.f; }
    float m = 0.f, l = 0.f, carry = 0.f; bool have = false;
    bool wave_done = false;
    LAS unsigned* flags = (LAS unsigned*)(lds + E1_FLAGS);
    if (KIND != 1) { if (tid < 8) flags[tid] = 0u; }
    __syncthreads();
    E1_LOAD(KIND != 1 ? j1 : j0);
    for (int it = 0; it < ntile; ++it) {
        const int j = (KIND != 1) ? (j1 - it) : (j0 + it);
        LAS unsigned char* buf = lds + (it & 1) * E1_BUF;
        E1_WRITE(buf);
        __syncthreads();
        if (KIND != 1) { unsigned alld = 1u;
#pragma unroll
            for (int i = 0; i < 8; ++i) alld &= flags[i];
            if (alld) break; }
        if (it + 1 < ntile) E1_LOAD((KIND != 1) ? (j - 1) : (j + 1));
        if (!(KIND != 1 && wave_done)) {
            f32x16 p0, p1;
#pragma unroll
            for (int r = 0; r < 16; ++r) { p0[r] = 0.f; p1[r] = 0.f; }
            { const LAS unsigned char* kp_ = buf + E1_K + r32 * KROW + hh * 16;
#pragma unroll
              for (int d0 = 0; d0 < 4; ++d0) { const bf16x8 a0 = *(const LAS bf16x8*)(kp_ + d0 * 32), a1 = *(const LAS bf16x8*)(kp_ + 32 * KROW + d0 * 32);
                  p0 = __builtin_amdgcn_mfma_f32_32x32x16_bf16(a0, qf[d0], p0, 0, 0, 0); p1 = __builtin_amdgcn_mfma_f32_32x32x16_bf16(a1, qf[d0], p1, 0, 0, 0); } }
            const int kb = j * 64 + 4 * hh;
            if (KIND == 2) {
                float lk0[16], lk1[16], gs[8];
#pragma unroll
                for (int reg = 0; reg < 16; ++reg) { const int kpos = kb + CROW(reg, 0);
                    const float z0 = p0[reg] * SCALE, z1 = p1[reg] * SCALE; const bool v0 = kpos < tq, v1 = kpos + 32 < tq;
                    const float lb0 = fminf(z0, 0.f) - __logf(1.f + __expf(-fabsf(z0))), lb1 = fminf(z1, 0.f) - __logf(1.f + __expf(-fabsf(z1)));
                    lk0[reg] = v0 ? (lb0 - z0) : 0.f; lk1[reg] = v1 ? (lb1 - z1) : 0.f;
                    p0[reg] = v0 ? lb0 : -INFINITY; p1[reg] = v1 ? lb1 : -INFINITY; }
#pragma unroll
                for (int g4 = 0; g4 < 4; ++g4) { gs[g4] = (lk0[4 * g4] + lk0[4 * g4 + 1]) + (lk0[4 * g4 + 2] + lk0[4 * g4 + 3]); gs[4 + g4] = (lk1[4 * g4] + lk1[4 * g4 + 1]) + (lk1[4 * g4 + 2] + lk1[4 * g4 + 3]); }
                float oth[8];
#pragma unroll
                for (int gi = 0; gi < 8; ++gi) oth[gi] = __shfl_xor(gs[gi], 32);
                float run = 0.f;
#pragma unroll
                for (int gi = 7; gi >= 0; --gi) {
                    float later = carry + run + (hh == 0 ? oth[gi] : 0.f);
#pragma unroll
                    for (int e = 3; e >= 0; --e) { const int reg = (gi & 3) * 4 + e;
                        if (gi >> 2) { p1[reg] = __expf(p1[reg] + later); later += lk1[reg]; } else { p0[reg] = __expf(p0[reg] + later); later += lk0[reg]; } }
                    run += gs[gi] + oth[gi]; }
                carry += run;
            } else {
                if (KIND == 0) {
                    const LAS float* cs = (const LAS float*)(buf + E1_C) + 4 * hh; const float ctm = ct2 - m;
#pragma unroll
                    for (int i = 0; i < 4; ++i) { const f32x4 c0 = *(const LAS f32x4*)(cs + 8 * i), c1 = *(const LAS f32x4*)(cs + 32 + 8 * i);
#pragma unroll
                        for (int e = 0; e < 4; ++e) { const int reg = 4 * i + e; p0[reg] = p0[reg] * (SCALE * LOG2E) + (ctm - c0[e]); p1[reg] = p1[reg] * (SCALE * LOG2E) + (ctm - c1[e]); } }
                    if (!(j * 64 + 63 <= qrow0)) {
#pragma unroll
                        for (int reg = 0; reg < 16; ++reg) { const int kpos = kb + CROW(reg, 0); p0[reg] = (kpos <= tq) ? p0[reg] : -INFINITY; p1[reg] = (kpos + 32 <= tq) ? p1[reg] : -INFINITY; } }
                } else {
                    { const float r_ = sl2 * ((float)(j * 64) - tqf) - m; const float rh_ = bf2f((unsigned short)f2bf(r_)), rm2_ = bf2f((unsigned short)f2bf(r_ - rh_)), rl_ = (r_ - rh_) - rm2_;
                      u32x4 qx_ = {0u, 0u, 0u, 0u}; if (hh == 0) qx_ = (u32x4){cvtpk(sl2h, sl2l), cvtpk(rh_, rm2_), cvtpk(rl_, 0.f), 0u};
                      const bf16x8 qx = __builtin_bit_cast(bf16x8, qx_);
                      p0 = __builtin_amdgcn_mfma_f32_32x32x16_bf16(kx0, qx, p0, 0, 0, 0); p1 = __builtin_amdgcn_mfma_f32_32x32x16_bf16(kx1, qx, p1, 0, 0, 0); }
                    if (!(j * 64 + 63 <= qrow0 && qrow0 + 31 - j * 64 < 512)) {
#pragma unroll
                        for (int reg = 0; reg < 16; ++reg) { const int kpos = kb + CROW(reg, 0);
                            p0[reg] = (kpos <= tq && tq - kpos < 512) ? p0[reg] : -INFINITY; p1[reg] = (kpos + 32 <= tq && tq - kpos - 32 < 512) ? p1[reg] : -INFINITY; } }
                }
                SM_CORE(p0, p1, m, l, have, o0, o1);
            }
            { const int gq_ = lane >> 4, li_ = lane & 15;
              const LAS unsigned char* tb = buf + E1_V + (4 * hh + (li_ >> 2)) * KROW + (16 * (gq_ & 1) + 4 * (li_ & 3)) * 2;
#pragma unroll
              for (int s = 0; s < 4; ++s) {
                  u32x4 pw;
                  if (s < 2) { pw.x = cvtpk(p0[8 * s + 0], p0[8 * s + 1]); pw.y = cvtpk(p0[8 * s + 2], p0[8 * s + 3]); pw.z = cvtpk(p0[8 * s + 4], p0[8 * s + 5]); pw.w = cvtpk(p0[8 * s + 6], p0[8 * s + 7]); }
                  else { const int s2 = s - 2; pw.x = cvtpk(p1[8 * s2 + 0], p1[8 * s2 + 1]); pw.y = cvtpk(p1[8 * s2 + 2], p1[8 * s2 + 3]); pw.z = cvtpk(p1[8 * s2 + 4], p1[8 * s2 + 5]); pw.w = cvtpk(p1[8 * s2 + 6], p1[8 * s2 + 7]); }
                  const bf16x8 pb = __builtin_bit_cast(bf16x8, pw);
                  const v4i16_t a0l = __builtin_amdgcn_ds_read_tr16_b64_v4i16((LAS v4i16_t*)(tb + (16 * s) * KROW)), a0h = __builtin_amdgcn_ds_read_tr16_b64_v4i16((LAS v4i16_t*)(tb + (16 * s + 8) * KROW));
                  const v4i16_t a1l = __builtin_amdgcn_ds_read_tr16_b64_v4i16((LAS v4i16_t*)(tb + (16 * s) * KROW + 64)), a1h = __builtin_amdgcn_ds_read_tr16_b64_v4i16((LAS v4i16_t*)(tb + (16 * s + 8) * KROW + 64));
                  const bf16x8 va0 = (bf16x8){a0l[0], a0l[1], a0l[2], a0l[3], a0h[0], a0h[1], a0h[2], a0h[3]}, va1 = (bf16x8){a1l[0], a1l[1], a1l[2], a1l[3], a1h[0], a1h[1], a1h[2], a1h[3]};
                  o0 = __builtin_amdgcn_mfma_f32_32x32x16_bf16(va0, pb, o0, 0, 0, 0); o1 = __builtin_amdgcn_mfma_f32_32x32x16_bf16(va1, pb, o1, 0, 0, 0); } }
            if (KIND == 0) {
                const float c0 = *(const LAS float*)(buf + E1_C); const bool dn = __all(have && (qkb + (ct2 - c0) - m < -150.f));
                if (dn && !wave_done) { wave_done = true; if (lane == 0) flags[w] = 1u; } }
            if (KIND == 2) { const bool dn = __all(carry < -110.f);
                if (dn && !wave_done) { wave_done = true; if (lane == 0) flags[w] = 1u; } }
        }
    }
    float inv = 1.f, gate = 1.f;
    if (KIND != 2) { l += __shfl_xor(l, 32); inv = (l > 0.f) ? 1.f / l : 0.f; }
    bf16_t* orow;
    if (KIND == 0) orow = obase + (size_t)(b * S_ + tq) * D_ + 512 + h * 64;
    else if (KIND == 2) orow = obase + (size_t)(b * S_ + tq) * D_ + 768 + h * 64;
    else { orow = owin + (size_t)(b * S_ + tq) * 512 + h * 64; gate = WSP(float, O_GF)[(size_t)(b * S_ + tq) * 32 + 2 * 8 + h]; }
    const float sc = inv * gate;
#pragma unroll
    for (int i = 0; i < 4; ++i) {
        *(u32x2*)(orow + 8 * i + 4 * hh) = (u32x2){cvtpk(o0[4 * i] * sc, o0[4 * i + 1] * sc), cvtpk(o0[4 * i + 2] * sc, o0[4 * i + 3] * sc)};
        *(u32x2*)(orow + 32 + 8 * i + 4 * hh) = (u32x2){cvtpk(o1[4 * i] * sc, o1[4 * i + 1] * sc), cvtpk(o1[4 * i + 2] * sc, o1[4 * i + 3] * sc)}; }
#undef E1_LOAD
#undef E1_WRITE
}
}
namespace mk {
constexpr int E2_VT = 64 * 128;
constexpr int E2_WAVE = 2 * E2_VT + 512 + 128;
template <bool USE_MASK>
__device__ __forceinline__ void e2_wave_unit(LAS unsigned char* ldsw, KP p, int b, int g, int t0, bf16_t* __restrict__ obase, const bf16_t* __restrict__ csrc, int cpitch) {
    const int lane = ftid() & 63, r32 = lane & 31, hh = lane >> 5, qi = r32 >> 2, r4 = r32 & 3;
    const int h = 4 * g + r4, tq = t0 + qi;
    const bf16_t* projb = WSP(bf16_t, O_PROJB);
    const bf16_t* kbase = projb + (size_t)(b * S_) * PB + C_KV + ((1 * 2 + 0) * 2 + g) * 64;
    const bf16_t* vbase = projb + (size_t)(b * S_) * PB + C_KV + ((1 * 2 + 1) * 2 + g) * 64;
    bf16x8 qf[4];
    { const bf16_t* qptr = projb + (size_t)(b * S_ + tq) * PB + h * 64 + 8 * hh;
#pragma unroll
      for (int d0 = 0; d0 < 4; ++d0) qf[d0] = *(const bf16x8*)(qptr + 16 * d0); }
    unsigned qm0 = 0u, qm1 = 0u, qm2 = 0u, qm3 = 0u;
    if (USE_MASK) { const u32x4 mw = *(const u32x4*)(WSP(unsigned, O_SELMASK) + ((size_t)((b * 2 + g) * S_ + t0 + (lane >> 3))) * 4); qm0 = mw.x; qm1 = mw.y; qm2 = mw.z; qm3 = mw.w; }
    else { const int* sp = WSP(int, O_SEL) + ((size_t)((b * 2 + g) * S_ + t0)) * NSEL + lane * 2;
      const int e0 = sp[0], e1 = sp[1];
#pragma unroll
      for (int k = 0; k < 2; ++k) { const int e = k ? e1 : e0; const unsigned bit = 1u << (e & 31); const int wd = e >> 5;
          qm0 |= (wd == 0) ? bit : 0u; qm1 |= (wd == 1) ? bit : 0u; qm2 |= (wd == 2) ? bit : 0u; qm3 |= (wd == 3) ? bit : 0u; }
#pragma unroll
      for (int o = 1; o < 8; o <<= 1) { qm0 |= __shfl_xor(qm0, o); qm1 |= __shfl_xor(qm1, o); qm2 |= __shfl_xor(qm2, o); qm3 |= __shfl_xor(qm3, o); } }
    unsigned um0 = qm0, um1 = qm1, um2 = qm2, um3 = qm3;
#pragma unroll
    for (int o = 8; o < 64; o <<= 1) { um0 |= __shfl_xor(um0, o); um1 |= __shfl_xor(um1, o); um2 |= __shfl_xor(um2, o); um3 |= __shfl_xor(um3, o); }
    LAS int* list = (LAS int*)(ldsw + 2 * E2_VT);
    LAS unsigned* rowml = (LAS unsigned*)(ldsw + 2 * E2_VT + 512);
    if ((lane & 7) == 0) *(LAS u32x4*)(rowml + (lane >> 3) * 4) = (u32x4){qm0, qm1, qm2, qm3};
    const LAS unsigned* rowm = rowml + qi * 4;
    int nblk;
    const int curq = __builtin_amdgcn_readfirstlane(t0 >> 6);
    bool diag;
    { const bool s0 = ((((lane < 32) ? um0 : um1) >> (lane & 31)) & 1u) && lane <= curq, s1 = ((((lane < 32) ? um2 : um3) >> (lane & 31)) & 1u) && lane + 64 <= curq;
      const unsigned long long b0 = __ballot(s0), b1 = __ballot(s1);
      const unsigned long long lower = (lane == 0) ? 0ull : (~0ull >> (64 - lane));
      const int n0 = __popcll(b0);
      if (s0) list[__popcll(b0 & lower)] = lane;
      if (s1) list[n0 + __popcll(b1 & lower)] = lane + 64;
      nblk = n0 + __popcll(b1); diag = (((curq < 64) ? (b0 >> curq) : (b1 >> (curq - 64))) & 1ull) != 0ull; }
    const int nfull = nblk - (diag ? 1 : 0);
    asm volatile("s_waitcnt lgkmcnt(0)" ::: "memory");
    const float sl2 = exp2f(-(float)(h + 1)) * LOG2E, tqf = (float)tq;
    f32x16 o0, o1;
#pragma unroll
    for (int r = 0; r < 16; ++r) { o0[r] = 0.f; o1[r] = 0.f; }
    float m = 0.f, l = 0.f; bool have = false;
    const int vrow = lane >> 3, vch = lane & 7;
    const int gq = lane >> 4, li = lane & 15;
    const LAS unsigned char* trb = ldsw + (4 * hh + (li >> 2)) * 128 + (16 * (gq & 1) + 4 * (li & 3)) * 2;
    bf16x8 ka0[4], ka1[4], kb0[4], kb1[4];
#define E2_LOADK(blk, k0_, k1_) do { const bf16_t* kp_ = kbase + (size_t)((blk) * 64 + r32) * PB + 8 * hh; \
        _Pragma("unroll") for (int d0 = 0; d0 < 4; ++d0) { k0_[d0] = *(const bf16x8*)(kp_ + 16 * d0); k1_[d0] = *(const bf16x8*)(kp_ + (size_t)32 * PB + 16 * d0); } } while (0)
#define E2_VDMA(blk, vb_) do { const bf16_t* vp_ = vbase + (size_t)((blk) * 64 + vrow) * PB + vch * 8; \
        _Pragma("unroll") for (int i = 0; i < 8; ++i) __builtin_amdgcn_global_load_lds((const unsigned*)(vp_ + (size_t)(8 * i) * PB), (LAS unsigned*)((vb_) + i * 1024), 16, 0, 0); } while (0)
    { const int b0_ = __builtin_amdgcn_readfirstlane(list[0]);
      E2_VDMA(b0_, ldsw); E2_LOADK(b0_, ka0, ka1);
      { const int b1_ = __builtin_amdgcn_readfirstlane(list[(nblk > 1) ? 1 : 0]); E2_LOADK(b1_, kb0, kb1); } }
    int it = 0;
    auto body = [&](auto mtag_, auto ptag_) __attribute__((always_inline)) {
        constexpr bool MASKED_ = decltype(mtag_)::value; constexpr bool PAR_ = decltype(ptag_)::value;
        const int cur = __builtin_amdgcn_readfirstlane(list[it]);
        const unsigned rw = rowm[cur >> 5];
        LAS unsigned char* vcur = ldsw + (PAR_ ? E2_VT : 0); LAS unsigned char* voth = ldsw + (PAR_ ? 0 : E2_VT);
        { const int nb_ = __builtin_amdgcn_readfirstlane(list[(it + 1 < nblk) ? it + 1 : nblk - 1]); E2_VDMA(nb_, voth); }
        const int nb2_ = __builtin_amdgcn_readfirstlane(list[(it + 2 < nblk) ? it + 2 : nblk - 1]);
        f32x16 p0, p1;
#pragma unroll
        for (int r = 0; r < 16; ++r) { p0[r] = 0.f; p1[r] = 0.f; }
        if (PAR_) {
#pragma unroll
            for (int d0 = 0; d0 < 4; ++d0) { p0 = __builtin_amdgcn_mfma_f32_32x32x16_bf16(kb0[d0], qf[d0], p0, 0, 0, 0); p1 = __builtin_amdgcn_mfma_f32_32x32x16_bf16(kb1[d0], qf[d0], p1, 0, 0, 0); }
            asm volatile("" : "+v"(p0), "+v"(p1) :: "memory");
            E2_LOADK(nb2_, kb0, kb1);
        } else {
#pragma unroll
            for (int d0 = 0; d0 < 4; ++d0) { p0 = __builtin_amdgcn_mfma_f32_32x32x16_bf16(ka0[d0], qf[d0], p0, 0, 0, 0); p1 = __builtin_amdgcn_mfma_f32_32x32x16_bf16(ka1[d0], qf[d0], p1, 0, 0, 0); }
            asm volatile("" : "+v"(p0), "+v"(p1) :: "memory");
            E2_LOADK(nb2_, ka0, ka1);
        }
        const bool rowsel = (rw >> (cur & 31)) & 1u;
        const int kb = cur * 64 + 4 * hh;
        { const float basef = rowsel ? (sl2 * ((float)kb - tqf) - m) : -INFINITY, base1 = basef + 32.f * sl2;
#pragma unroll
          for (int reg = 0; reg < 16; ++reg) { p0[reg] = p0[reg] * (SCALE * LOG2E) + __builtin_fmaf(sl2, (float)CROW(reg, 0), basef); p1[reg] = p1[reg] * (SCALE * LOG2E) + __builtin_fmaf(sl2, (float)CROW(reg, 0), base1); } }
        if (MASKED_) {
#pragma unroll
            for (int reg = 0; reg < 16; ++reg) { const int kpos = kb + CROW(reg, 0); p0[reg] = (kpos <= tq) ? p0[reg] : -INFINITY; p1[reg] = (kpos + 32 <= tq) ? p1[reg] : -INFINITY; } }
        SM_CORE(p0, p1, m, l, have, o0, o1);
        asm volatile("s_waitcnt vmcnt(16)" ::: "memory");
        const LAS unsigned char* trv = trb + (PAR_ ? E2_VT : 0);
#pragma unroll
        for (int s = 0; s < 4; ++s) {
            u32x4 pw;
            if (s < 2) { pw.x = cvtpk(p0[8 * s + 0], p0[8 * s + 1]); pw.y = cvtpk(p0[8 * s + 2], p0[8 * s + 3]); pw.z = cvtpk(p0[8 * s + 4], p0[8 * s + 5]); pw.w = cvtpk(p0[8 * s + 6], p0[8 * s + 7]); }
            else { const int s2 = s - 2; pw.x = cvtpk(p1[8 * s2 + 0], p1[8 * s2 + 1]); pw.y = cvtpk(p1[8 * s2 + 2], p1[8 * s2 + 3]); pw.z = cvtpk(p1[8 * s2 + 4], p1[8 * s2 + 5]); pw.w = cvtpk(p1[8 * s2 + 6], p1[8 * s2 + 7]); }
            const bf16x8 pb = __builtin_bit_cast(bf16x8, pw);
            const v4i16_t a0l = __builtin_amdgcn_ds_read_tr16_b64_v4i16((LAS v4i16_t*)(trv + (16 * s) * 128)), a0h = __builtin_amdgcn_ds_read_tr16_b64_v4i16((LAS v4i16_t*)(trv + (16 * s + 8) * 128));
            const v4i16_t a1l = __builtin_amdgcn_ds_read_tr16_b64_v4i16((LAS v4i16_t*)(trv + (16 * s) * 128 + 64)), a1h = __builtin_amdgcn_ds_read_tr16_b64_v4i16((LAS v4i16_t*)(trv + (16 * s + 8) * 128 + 64));
            const bf16x8 va0 = (bf16x8){a0l[0], a0l[1], a0l[2], a0l[3], a0h[0], a0h[1], a0h[2], a0h[3]}, va1 = (bf16x8){a1l[0], a1l[1], a1l[2], a1l[3], a1h[0], a1h[1], a1h[2], a1h[3]};
            o0 = __builtin_amdgcn_mfma_f32_32x32x16_bf16(va0, pb, o0, 0, 0, 0); o1 = __builtin_amdgcn_mfma_f32_32x32x16_bf16(va1, pb, o1, 0, 0, 0); }
        asm volatile("" ::: "memory");
    };
    for (; it + 1 < nfull; it += 2) { body(std::false_type{}, std::false_type{}); ++it; body(std::false_type{}, std::true_type{}); --it; }
    if (it < nfull) { body(std::false_type{}, std::false_type{}); ++it; if (diag) body(std::true_type{}, std::true_type{}); }
    else if (diag) body(std::true_type{}, std::false_type{});
    asm volatile("s_waitcnt vmcnt(0)" ::: "memory");
#undef E2_LOADK
#undef E2_VDMA
    l += __shfl_xor(l, 32);
    const float sc = ((l > 0.f) ? 1.f / l : 0.f) * WSP(float, O_GF)[(size_t)(b * S_ + tq) * 32 + 1 * 8 + h];
    bf16_t* orow = obase + (size_t)(b * S_ + tq) * D_ + h * 64; const bf16_t* crow = csrc + (size_t)(b * S_ + tq) * cpitch + h * 64;
#pragma unroll
    for (int i = 0; i < 4; ++i) {
        const u32x2 c0 = *(const u32x2*)(crow + 8 * i + 4 * hh), c1 = *(const u32x2*)(crow + 32 + 8 * i + 4 * hh);
        const float x00 = __uint_as_float(c0.x << 16) + o0[4 * i] * sc, x01 = __uint_as_float(c0.x & 0xffff0000u) + o0[4 * i + 1] * sc, x02 = __uint_as_float(c0.y << 16) + o0[4 * i + 2] * sc, x03 = __uint_as_float(c0.y & 0xffff0000u) + o0[4 * i + 3] * sc;
        const float x10 = __uint_as_float(c1.x << 16) + o1[4 * i] * sc, x11 = __uint_as_float(c1.x & 0xffff0000u) + o1[4 * i + 1] * sc, x12 = __uint_as_float(c1.y << 16) + o1[4 * i + 2] * sc, x13 = __uint_as_float(c1.y & 0xffff0000u) + o1[4 * i + 3] * sc;
        *(u32x2*)(orow + 8 * i + 4 * hh) = (u32x2){cvtpk(x00, x01), cvtpk(x02, x03)}; *(u32x2*)(orow + 32 + 8 * i + 4 * hh) = (u32x2){cvtpk(x10, x11), cvtpk(x12, x13)}; }
}
template <bool USE_MASK>
__device__ __forceinline__ void ph_attn_sel2(LAS unsigned char* lds3, KP p, bf16_t* __restrict__ obase, const bf16_t* __restrict__ csrc, int cpitch) {
    const int w = __builtin_amdgcn_readfirstlane(ftid() >> 6);
    LAS unsigned char* ldsw = lds3 + w * E2_WAVE;
    MK_LOOP(u, 512) { const int bg = u & 3, qblk = u >> 2; e2_wave_unit<USE_MASK>(ldsw, p, bg >> 1, bg & 1, qblk * 64 + 8 * w, obase, csrc, cpitch); }
}
}
namespace mk {
constexpr int E3_K = 0, E3_V = 512 * KROW, E3_BYTES = 2 * 512 * KROW;
__device__ __forceinline__ void e3_unit(LAS unsigned char* lds, KP p, int b, int g, int qb, bf16_t* __restrict__ ocmp, unsigned* __restrict__ selmask) {
    const int tid = ftid(), lane = tid & 63, w = __builtin_amdgcn_readfirstlane(tid >> 6), r32 = lane & 31, hh = lane >> 5;
    const int bg = b * 2 + g, q0 = qb * 256, qrow0 = q0 + 32 * w, tq = qrow0 + r32;
    const bf16_t* projb = WSP(bf16_t, O_PROJB);
    int nun = (q0 + 255 - 31) / 16 + 1; if (nun > 511) nun = 511;
    const int ntile_u = (nun + 63) >> 6;
    __syncthreads();
    { const int srow = tid >> 3, sch = tid & 7; const bf16_t* ks = WSP(bf16_t, O_KCMPB) + ((size_t)bg * 512 + srow) * 64 + sch * 8; const bf16_t* vs = WSP(bf16_t, O_VCMPB) + ((size_t)bg * 512 + srow) * 64 + sch * 8;
      for (int i = 0; i < ntile_u; ++i) { const u32x4 kv = *(const u32x4*)(ks + (size_t)i * 64 * 64), vv = *(const u32x4*)(vs + (size_t)i * 64 * 64);
          *(LAS u32x4*)(lds + E3_K + (srow + 64 * i) * KROW + sch * 16) = kv; *(LAS u32x4*)(lds + E3_V + (srow + 64 * i) * KROW + sch * 16) = vv; } }
    __syncthreads();
    int nw = qrow0 / 16 + 1; if (nw > 511) nw = 511;
    const int ntile_w = (qrow0 + 31 < 31) ? 0 : ((nw + 63) >> 6);
    const float tqf = (float)tq;
    const int gq = lane >> 4, li = lane & 15;
    const LAS unsigned char* trb = lds + E3_V + (4 * hh + (li >> 2)) * KROW + (16 * (gq & 1) + 4 * (li & 3)) * 2;
    const LAS unsigned char* kfb = lds + E3_K + r32 * KROW + hh * 16;
    float imp[64];
#pragma unroll
    for (int i = 0; i < 64; ++i) imp[i] = 0.f;
#pragma unroll 1
    for (int r4 = 0; r4 < 4; ++r4) {
        const int h = 4 * g + r4; const float sl2 = exp2f(-(float)(h + 1)) * LOG2E;
        const unsigned qoff = (unsigned)((b * S_ + tq) * PB + h * 64 + 8 * hh);
        f32x16 o0, o1;
#pragma unroll
        for (int r = 0; r < 16; ++r) { o0[r] = 0.f; o1[r] = 0.f; }
        float m = 0.f, l = 0.f; bool have = false;
#define E3_ST(jt) f32x16 p0, p1; { bf16x8 qf[4]; _Pragma("unroll") for (int d0 = 0; d0 < 4; ++d0) qf[d0] = *(const bf16x8*)(projb + qoff + 16 * d0); \
            _Pragma("unroll") for (int r = 0; r < 16; ++r) { p0[r] = 0.f; p1[r] = 0.f; } \
            _Pragma("unroll") for (int d0 = 0; d0 < 4; ++d0) { const bf16x8 a0 = *(const LAS bf16x8*)(kfb + (64 * (jt)) * KROW + d0 * 32), a1 = *(const LAS bf16x8*)(kfb + (64 * (jt) + 32) * KROW + d0 * 32); \
                p0 = __builtin_amdgcn_mfma_f32_32x32x16_bf16(a0, qf[d0], p0, 0, 0, 0); p1 = __builtin_amdgcn_mfma_f32_32x32x16_bf16(a1, qf[d0], p1, 0, 0, 0); } \
            int tq_ = tq; asm volatile("" : "+v"(tq_));     \
            int hh_ = hh; asm volatile("" : "+v"(hh_)); \
            const float tqf_ = (float)tq_; const int ce0_ = 16 * (64 * (jt) + 4 * hh_) + 31; \
            const float basef_ = sl2 * ((float)ce0_ - tqf_) - m, base1_ = basef_ + 512.f * sl2; \
            _Pragma("unroll") for (int reg = 0; reg < 16; ++reg) { const float cr_ = sl2 * (float)(16 * CROW(reg, 0)); p0[reg] = p0[reg] * (SCALE * LOG2E) + (basef_ + cr_); p1[reg] = p1[reg] * (SCALE * LOG2E) + (base1_ + cr_); } \
            if (ce0_ + 16 * 27 + 512 > qrow0) {     \
                _Pragma("unroll") for (int reg = 0; reg < 16; ++reg) { const int ce = ce0_ + 16 * CROW(reg, 0); p0[reg] = (ce <= tq_) ? p0[reg] : -INFINITY; p1[reg] = (ce + 512 <= tq_) ? p1[reg] : -INFINITY; } } }
        float imh[64];
#pragma unroll
        for (int i = 0; i < 64; ++i) imh[i] = 0.f;
#pragma unroll
        for (int jt = 0; jt < 8; ++jt) {
            if (jt < ntile_w) {
                E3_ST(jt);
                {
                    float rm_; SM_ROWMAX(p0, p1, rm_);
                    const bool fin_ = rm_ > -1e37f;
                    if (__any((rm_ > RESC_THR) || (!have && fin_))) {
                        const float dl_ = have ? fmaxf(rm_, 0.f) : (fin_ ? rm_ : 0.f); const float al_ = have ? __builtin_amdgcn_exp2f(-dl_) : 1.f;
                        m += dl_; l *= al_; have = have || fin_;
#pragma unroll
                        for (int r_ = 0; r_ < 16; ++r_) { o0[r_] *= al_; o1[r_] *= al_; p0[r_] -= dl_; p1[r_] -= dl_; }
#pragma unroll
                        for (int i = 0; i < 64; ++i) imh[i] *= al_; }
                    float ls_ = 0.f;
#pragma unroll
                    for (int reg_ = 0; reg_ < 16; ++reg_) { p0[reg_] = __builtin_amdgcn_exp2f(p0[reg_]); p1[reg_] = __builtin_amdgcn_exp2f(p1[reg_]); ls_ += p0[reg_] + p1[reg_]; }
                    l += ls_; }
#pragma unroll
                for (int pa = 0; pa < 2; ++pa)
#pragma unroll
                    for (int i = 0; i < 4; ++i) { const int jj = 8 * jt + 4 * pa + i;
                        const float x0 = pa ? p1[4 * i] : p0[4 * i], x1 = pa ? p1[4 * i + 1] : p0[4 * i + 1], x2 = pa ? p1[4 * i + 2] : p0[4 * i + 2], x3 = pa ? p1[4 * i + 3] : p0[4 * i + 3];
                        const float c = 0.5f * x3, a = (x0 + x1) + (x2 + c), r = __shfl_xor(c, 32);
                        imh[jj] += a + (hh ? r : 0.f);
                        if (jj + 1 < 64) imh[jj + 1] += (hh ? 0.f : r); }
                const LAS unsigned char* tb = trb + (64 * jt) * KROW;
#pragma unroll
                for (int s = 0; s < 4; ++s) {
                    u32x4 pw;
                    if (s < 2) { pw.x = cvtpk(p0[8 * s + 0], p0[8 * s + 1]); pw.y = cvtpk(p0[8 * s + 2], p0[8 * s + 3]); pw.z = cvtpk(p0[8 * s + 4], p0[8 * s + 5]); pw.w = cvtpk(p0[8 * s + 6], p0[8 * s + 7]); }
                    else { const int s2 = s - 2; pw.x = cvtpk(p1[8 * s2 + 0], p1[8 * s2 + 1]); pw.y = cvtpk(p1[8 * s2 + 2], p1[8 * s2 + 3]); pw.z = cvtpk(p1[8 * s2 + 4], p1[8 * s2 + 5]); pw.w = cvtpk(p1[8 * s2 + 6], p1[8 * s2 + 7]); }
                    const bf16x8 pb = __builtin_bit_cast(bf16x8, pw);
                    const v4i16_t a0l = __builtin_amdgcn_ds_read_tr16_b64_v4i16((LAS v4i16_t*)(tb + (16 * s) * KROW)), a0h = __builtin_amdgcn_ds_read_tr16_b64_v4i16((LAS v4i16_t*)(tb + (16 * s + 8) * KROW));
                    const v4i16_t a1l = __builtin_amdgcn_ds_read_tr16_b64_v4i16((LAS v4i16_t*)(tb + (16 * s) * KROW + 64)), a1h = __builtin_amdgcn_ds_read_tr16_b64_v4i16((LAS v4i16_t*)(tb + (16 * s + 8) * KROW + 64));
                    const bf16x8 va0 = (bf16x8){a0l[0], a0l[1], a0l[2], a0l[3], a0h[0], a0h[1], a0h[2], a0h[3]}, va1 = (bf16x8){a1l[0], a1l[1], a1l[2], a1l[3], a1h[0], a1h[1], a1h[2], a1h[3]};
                    o0 = __builtin_amdgcn_mfma_f32_32x32x16_bf16(va0, pb, o0, 0, 0, 0); o1 = __builtin_amdgcn_mfma_f32_32x32x16_bf16(va1, pb, o1, 0, 0, 0); }
            }
        }
        l += __shfl_xor(l, 32);
        const float inv = (l > 0.f) ? 1.f / l : 0.f;
#pragma unroll
        for (int i = 0; i < 64; ++i) imp[i] += imh[i] * inv;
        { const float sc = inv * WSP(float, O_GF)[(size_t)(b * S_ + tq) * 32 + 0 * 8 + h];
          bf16_t* orow = ocmp + (size_t)(b * S_ + tq) * 512 + h * 64;
#pragma unroll
          for (int i = 0; i < 4; ++i) {
              *(u32x2*)(orow + 8 * i + 4 * hh) = (u32x2){cvtpk(o0[4 * i] * sc, o0[4 * i + 1] * sc), cvtpk(o0[4 * i + 2] * sc, o0[4 * i + 3] * sc)};
              *(u32x2*)(orow + 32 + 8 * i + 4 * hh) = (u32x2){cvtpk(o1[4 * i] * sc, o1[4 * i + 1] * sc), cvtpk(o1[4 * i + 2] * sc, o1[4 * i + 3] * sc)}; } }
#undef E3_ST
    }
    const int cur = tq >> 6;
#pragma unroll
    for (int jj = 0; jj < 64; ++jj) { const int j = 2 * jj + hh; imp[jj] = (j != 0 && j < cur - 1) ? imp[jj] : -1.f; }
    unsigned m0 = 1u, m1 = 0u, m2 = 0u, m3 = 0u;
#define E3_SETBIT(j) do { const unsigned bit_ = 1u << ((j) & 31); const int wd_ = (j) >> 5; m0 |= (wd_ == 0) ? bit_ : 0u; m1 |= (wd_ == 1) ? bit_ : 0u; m2 |= (wd_ == 2) ? bit_ : 0u; m3 |= (wd_ == 3) ? bit_ : 0u; } while (0)
    E3_SETBIT(cur); if (cur >= 1) E3_SETBIT(cur - 1);
#pragma unroll 1
    for (int it = 0; it < NSEL - 3; ++it) {
        float best = -0.5f; int bj = 0;
#pragma unroll
        for (int jj = 0; jj < 64; ++jj) { if (imp[jj] > best) { best = imp[jj]; bj = jj; } }
        const int myj = 2 * bj + hh; const float ob = __shfl_xor(best, 32); const int oj = __shfl_xor(myj, 32);
        const bool mine = (best > ob) || (best == ob && myj < oj);
        const float wv = mine ? best : ob; const int wj = mine ? myj : oj;
        if (wv >= 0.f) E3_SETBIT(wj);
        if (mine && best >= 0.f) {
#pragma unroll
            for (int jj = 0; jj < 64; ++jj) imp[jj] = (jj == bj) ? -2.f : imp[jj]; }
    }
#undef E3_SETBIT
    if (hh == 0) *(u32x4*)(selmask + ((size_t)bg * S_ + tq) * 4) = (u32x4){m0, m1, m2, m3};
}
}
namespace mk {
constexpr int SB_EARLY = 216;
template <int MODE>
__device__ __forceinline__ void ph_attn1(float* lds, LAS unsigned char* lds3, KP p, unsigned* qctr, bf16_t* obase, bf16_t* owin, const unsigned* kmax2) {
    LAS int* qslot = (LAS int*)(lds3 + E3_BYTES);
    constexpr int N_E3 = (MODE & 2) ? 128 : 0, N_CMP = (MODE & 1) ? 64 : 0, N_FOX = (MODE & 4) ? 256 : 0, N_WIN = (MODE & 8) ? 512 : 0, N_SB = (MODE & 16) ? (256 - SB_EARLY) : 0;
    for (;;) {
        __syncthreads();
        if (ftid() == 0) *qslot = (int)atomicAdd(qctr, 1u);
        __syncthreads();
        int u = __builtin_amdgcn_readfirstlane(*qslot);
        if (u >= N_E3 + N_CMP + N_FOX + N_WIN + N_SB) break;
        if (u < N_E3) { e3_unit(lds3, p, (u & 3) >> 1, u & 1, 31 - (u >> 2), WSP(bf16_t, O_OCMP), WSP(unsigned, O_SELMASK)); continue; } u -= N_E3;
        if (u < N_FOX) { e1_unit<0>(lds3, p, (u & 7) >> 2, u & 3, 31 - (u >> 3), obase, owin, kmax2); continue; } u -= N_FOX;
        if (u < N_WIN) { e1_unit<1>(lds3, p, (u & 3) >> 1, u & 1, 127 - (u >> 2), obase, owin, kmax2); continue; } u -= N_WIN;
        if (u < N_SB) { u += SB_EARLY; e1_unit<2>(lds3, p, (u & 7) >> 2, u & 3, 31 - (u >> 3), obase, owin, kmax2); }
    }
}
__device__ __forceinline__ void ph_sb_early(LAS unsigned char* lds3, KP p) {
    const int u = fbid() - 40; if (u < 0 || u >= SB_EARLY) return;
    e1_unit<2>(lds3, p, (u & 7) >> 2, u & 3, 31 - (u >> 3), WSP(bf16_t, O_O), WSP(bf16_t, O_OWIN), nullptr);
}
}
namespace mk {
#define RLX_AGENT __ATOMIC_RELAXED, __HIP_MEMORY_SCOPE_AGENT
#define XB_TMO      128
#define XB_XCNT(j)  (256  + 64 * (j))
#define XB_XSUB(j)  (1280 + 64 * (j))
#define XB_XGEN(j)  (2304 + 64 * (j))
#define XB_TOP      3328
#define XB_TOPGEN   3392
#define XCD_BAR_WORDS 3456
#define XB_SPIN_CAP (1u << 18)

__device__ __forceinline__ unsigned xb_ld(unsigned* p)              { return __hip_atomic_load(p, __ATOMIC_RELAXED, __HIP_MEMORY_SCOPE_AGENT); }
__device__ __forceinline__ unsigned xb_add(unsigned* p, unsigned v) { return __hip_atomic_fetch_add(p, v, __ATOMIC_RELAXED, __HIP_MEMORY_SCOPE_AGENT); }
__device__ __forceinline__ unsigned xb_xcc_id() { return (unsigned)__builtin_amdgcn_s_getreg((3 << 11) | 20) & 0xFu; }
#define XB_SPIN(cond, bar) do { unsigned _sp = 0; while (cond) { __builtin_amdgcn_s_sleep(1); \
    if ((++_sp & 255u) == 0u) { if (xb_ld(&(bar)[XB_TMO])) break; if (_sp > XB_SPIN_CAP) { atomicAdd(&(bar)[XB_TMO], 1u); break; } } } } while (0)

struct XcdBarrier {
    unsigned* bar; unsigned x;
    volatile LAS unsigned* st;
};

__device__ __forceinline__ XcdBarrier xcd_barrier_post(unsigned* bar, volatile LAS unsigned* st) {
    XcdBarrier b; b.bar = bar; b.x = xb_xcc_id(); b.st = st;
    if (threadIdx.x == 0) (void)xb_add(&bar[XB_XCNT(b.x)], 1u);
    return b;
}
__device__ __forceinline__ void xcd_barrier_complete(unsigned* bar, unsigned x, unsigned& nloc, unsigned& nx) {
    const unsigned G = gridDim.x * gridDim.y * gridDim.z;
    unsigned sum, cnt, mine, sp = 0u;
    for (;;) {
        sum = 0u; cnt = 0u; mine = 0u;
#pragma unroll
        for (unsigned j = 0; j < 16; ++j) { const unsigned c = xb_ld(&bar[XB_XCNT(j)]); sum += c; cnt += (c > 0u) ? 1u : 0u; mine = (j == x) ? c : mine; }
        if (sum == G) break;
        __builtin_amdgcn_s_sleep(1);
        if ((++sp & 255u) == 0u) { if (xb_ld(&bar[XB_TMO])) break; if (sp > XB_SPIN_CAP) { atomicAdd(&bar[XB_TMO], 1u); break; } }
    }
    nloc = mine > 0u ? mine : 1u; nx = cnt > 0u ? cnt : 1u;
}

__device__ __forceinline__ void xcd_barrier(const XcdBarrier& b) {
    asm volatile("s_waitcnt vmcnt(0)" ::: "memory");
    __syncthreads();
    if (threadIdx.x == 0) {
        unsigned* bar = b.bar;
        __builtin_amdgcn_s_waitcnt(0);
        unsigned nloc = b.st[0], nx = b.st[1];
        if (nloc == 0u) { xcd_barrier_complete(bar, b.x, nloc, nx); b.st[0] = nloc; b.st[1] = nx; }
        const unsigned old = xb_add(&bar[XB_XSUB(b.x)], 1u);
        const unsigned gen = old / nloc;
        if (old + 1u == (gen + 1u) * nloc) {
            __builtin_amdgcn_fence(__ATOMIC_RELEASE, "agent");
            asm volatile("s_waitcnt vmcnt(0)" ::: "memory");
            const unsigned og = xb_add(&bar[XB_TOP], 1u);
            const unsigned tg = og / nx;
            if (og + 1u == (tg + 1u) * nx) xb_add(&bar[XB_TOPGEN], 1u);
            else XB_SPIN(xb_ld(&bar[XB_TOPGEN]) == tg, bar);
            __builtin_amdgcn_fence(__ATOMIC_ACQUIRE, "agent");
            xb_add(&bar[XB_XGEN(b.x)], 1u);
            asm volatile("s_waitcnt vmcnt(0)" ::: "memory");
        } else {
            XB_SPIN(xb_ld(&bar[XB_XGEN(b.x)]) == gen, bar);
            __builtin_amdgcn_fence(__ATOMIC_ACQUIRE, "agent");
            asm volatile("s_waitcnt vmcnt(0)" ::: "memory");
        }
    }
    __syncthreads();
}

}
namespace cg = cooperative_groups;
constexpr int NSTEP = 12;
#ifndef CVH_GU
#define CVH_GU 1
#define CVH_DN 1
#endif
__global__ void __launch_bounds__(512, 2) mega(mk::P p_unused) {
    extern __shared__ __attribute__((aligned(16))) unsigned char lds_raw[];
    float* lds = (float*)lds_raw;
    LAS unsigned char* lds3 = (LAS unsigned char*)lds_raw;
    using namespace nv; using namespace mk;
    volatile LAS unsigned* bst = (volatile LAS unsigned*)(lds3 + E3_BYTES + 128);
    if (threadIdx.x < 2) bst[threadIdx.x] = 0u;
    __syncthreads();
    XcdBarrier bar;
    { const KP p = fresh_kp(); bar = xcd_barrier_post(WSP(unsigned, O_COUNTS + 16384), bst); }
    cg::this_grid().sync();
    for (int step = 0; step < 1 + NSTEP * L_; ++step) {
        const KP p = fresh_kp();
        const int l = (step - 1) / NSTEP, k = (step == 0) ? -1 : (step - 1) % NSTEP;
        const bool isg = (k == 0 || k == 1 || k == 6 || k == 9 || k == 10);
#ifdef PROBE_K
        const int nrep = (k == PROBE_K) ? PROBE_N : 1;
#else
        const int nrep = 1;
#endif
        for (int rep = 0; rep < nrep; ++rep) {
        int helpchunks = 0;
        if (isg) {
            const int kind = (k == 0) ? 0 : (k == 1) ? 4 : (k == 6) ? 1 : (k == 9) ? 2 : 3;
            GSched S; GEpi E; S.kind = kind; E.kind = kind; E.l = l;
            S.G = (int)gridDim.x; S.c = fbid(); S.meta = WSP(int, O_META); S.rowtok = WSP(int, O_ROWTOK); S.estep = 0;
            const char* A; int N, K = D_;
            if (kind == 0) { A = (const char*)WSP(bf16_t, O_XB); S.Bt = (const char*)(WSP(bf16_t, O_WTIN) + (size_t)l * NPAD * D_); N = NPAD; }
            else if (kind == 1) { A = (const char*)WSP(bf16_t, O_OB); S.Bt = (const char*)(WSP(bf16_t, O_WTOUT) + (size_t)l * D_ * D_); N = D_; }
            else if (kind == 2) { A = (const char*)WSP(bf16_t, O_X1B); S.Bt = (const char*)(WSP(bf16_t, O_WTGU) + (size_t)l * NE * 2048 * D_); S.estep = (size_t)2048 * D_ * 2; N = 2048; }
            else if (kind == 3) { A = (const char*)WSP(bf16_t, O_ACT); S.Bt = (const char*)(WSP(bf16_t, O_WTDN) + (size_t)l * NE * D_ * D_); S.estep = (size_t)D_ * D_ * 2; N = D_; }
            else { A = (const char*)WSP(bf16_t, O_PROJB); S.Bt = (const char*)(WSP(bf16_t, O_WT1) + (size_t)l * 2 * 256 * 2048); S.estep = (size_t)256 * 2048 * 2; N = 256; K = 1024; }
            S.nN = N / 256; S.nM = (kind < 2) ? T_ / 256 : (kind == 4) ? 16 : S.meta[32]; S.nunits = S.nM * S.nN; if (kind == 4) S.nunits = 32;
            pg8::gemm_phase<GEpi, GSched>(lds3, A, K, S, E);
            if (l == 0 && kind >= 2 && kind <= 3 && S.G == 256) {
                const int mine = (S.nunits - S.c + 255) >> 8, most = (S.nunits + 255) >> 8;
                if (mine < most) helpchunks = (kind == 2) ? CVH_GU : CVH_DN; }
            if (kind == 4) { ph_cumsum(lds, p, 32); ph_sb_early(lds3, p); }
            if (kind == 0) ph_bias1_reduce(p, l);
        } else {
            switch (k) {
                case -1: ph_convert(lds3, p); break;
                case 2: ph_prep2(p, l); break;
#ifdef PROBE_AMODE
                case 3: if (rep == 0) ph_attn1<30>(lds, lds3, p, WSP(unsigned, O_COUNTS) + 128 + l * 8 + rep, WSP(bf16_t, O_O), WSP(bf16_t, O_OWIN), WSP(unsigned, O_COUNTS) + 192 + l * 8);
                        else ph_attn1<PROBE_AMODE>(lds, lds3, p, WSP(unsigned, O_COUNTS) + 128 + l * 8 + rep, WSP(bf16_t, O_O), WSP(bf16_t, O_OWIN), WSP(unsigned, O_COUNTS) + 192 + l * 8);
                        break;
#else
                case 3: ph_attn1<30>(lds, lds3, p, WSP(unsigned, O_COUNTS) + 128 + l * 8 + rep, WSP(bf16_t, O_O), WSP(bf16_t, O_OWIN), WSP(unsigned, O_COUNTS) + 192 + l * 8); break;
#endif
                case 4: ph_attn_sel2<true>(lds3, p, WSP(bf16_t, O_O), WSP(bf16_t, O_OCMP), 512); break;
                case 5: ph_rmsnorm(p, l); break;
                case 7: ph_ln<true>(lds, p, l, WSP(float, O_X1), (rep + 1 < nrep) ? 2048 * (rep + 1) : 0); break;
                case 8: ph_moe_scatter2(lds, p, l); break;
                default: { if (l == 0) helpchunks = 1 << 20;
                           float* xout = (l == L_ - 1) ? p->out : WSP(float, O_XA); ph_ln<false>(lds, p, l, xout); } break;
            }
        }
        if (helpchunks > 0) cv_help(lds3, fresh_kp(), helpchunks);
        xcd_barrier(bar);
        }
    }
#ifdef PROBE_SYNC
    for (int i = 0; i < PROBE_SYNC; ++i) xcd_barrier(bar);
#endif
}

extern "C" void kernel_launch(void* const* d_in, const int* in_sizes, int n_in,
                              void* d_out, int out_size, void* d_ws, size_t ws_size,
                              hipStream_t stream) {
    constexpr size_t kDynLds = 147456 + 1024;
    static int grid_blocks = 0;
    if (!grid_blocks) {
        int dev = 0, cus = 0, per_cu = 0;
        (void)hipGetDevice(&dev);
        (void)hipDeviceGetAttribute(&cus, hipDeviceAttributeMultiprocessorCount, dev);
        (void)hipFuncSetAttribute((const void*)mega, hipFuncAttributeMaxDynamicSharedMemorySize, (int)kDynLds);
        (void)hipOccupancyMaxActiveBlocksPerMultiprocessor(&per_cu, mega, 512, kDynLds);
        if (per_cu < 1) per_cu = 1;
        if (per_cu > 1) per_cu = 1;
        grid_blocks = cus * per_cu;
        if (ws_size < mk::O_END) fprintf(stderr, "workspace too small: %zu < %zu\n", ws_size, (size_t)mk::O_END);
        if (grid_blocks != 256) fprintf(stderr, "this kernel's static work split is built for 256 workgroups (MI355X: 256 CUs); got %d\n", grid_blocks);
    }
    mk::P p{};
    p.in = nv::inputs(d_in); p.ws = (unsigned char*)d_ws; p.out = (float*)d_out;
    (void)hipMemsetAsync((char*)d_ws + mk::O_COUNTS, 0, 65536, stream);
    void* args[] = {&p};
    hipError_t e = hipLaunchCooperativeKernel((void*)mega, dim3(grid_blocks), dim3(512), args, kDynLds, stream);
    if (e != hipSuccess) fprintf(stderr, "cooperative launch failed: %s (grid %d)\n", hipGetErrorString(e), grid_blocks);
}
```

```cpp
#include <hip/hip_runtime.h>
#include <hip/hip_cooperative_groups.h>
#include <cstdio>
#include <cstdint>

namespace nv {

constexpr int B_ = 2, S_ = 8192, D_ = 1024, T_ = B_ * S_, L_ = 2;
constexpr int DIN = 2844;
constexpr int OFF_NSA_KV = 512, OFF_NSA_GATE = 1280, OFF_FOX_QKV = 1304, OFF_FOX_F = 2072, OFF_SB_QKV = 2076;
constexpr int NCMP = 511, NBLK = 128, NSEL = 16;
constexpr int NE = 32, TOPK = 4, MROWS = T_ * TOPK;
constexpr float LN_EPS = 1e-5f, RMS_EPS = 1e-6f;
constexpr float ALPHA = 1.4142135623730951f;
constexpr float SCALE = 0.125f;

__device__ __forceinline__ float sigmoidf_(float x) { return 1.f / (1.f + __expf(-x)); }
__device__ __forceinline__ float logsig(float x) { return fminf(x, 0.f) - log1pf(expf(-fabsf(x))); }

__device__ __forceinline__ float gelu_tanh(float x) { return 0.5f * x * (1.f + tanhf(0.7978845608028654f * (x + 0.044715f * x * x * x))); }
__device__ __forceinline__ float wsum(float v) {
#pragma unroll
    for (int o = 1; o < 64; o <<= 1) v += __shfl_xor(v, o);
    return v;
}
struct In {
    const float *x, *w_in, *b_in, *pos_k, *pos_v, *w1k, *w2k, *w1v, *w2v, *g_out, *w_out, *ln1_g, *ln1_b, *rw, *rb, *wgu, *bgu, *wdn, *bdn, *ln2_g, *ln2_b;
};
inline In inputs(void* const* d) {
    In i; i.x = (const float*)d[0]; i.w_in = (const float*)d[1]; i.b_in = (const float*)d[2]; i.pos_k = (const float*)d[3]; i.pos_v = (const float*)d[4];
    i.w1k = (const float*)d[5]; i.w2k = (const float*)d[6]; i.w1v = (const float*)d[7]; i.w2v = (const float*)d[8]; i.g_out = (const float*)d[9]; i.w_out = (const float*)d[10];
    i.ln1_g = (const float*)d[11]; i.ln1_b = (const float*)d[12]; i.rw = (const float*)d[13]; i.rb = (const float*)d[14]; i.wgu = (const float*)d[15]; i.bgu = (const float*)d[16];
    i.wdn = (const float*)d[17]; i.bdn = (const float*)d[18]; i.ln2_g = (const float*)d[19]; i.ln2_b = (const float*)d[20]; return i;
}


}
namespace pg8 {
#define PG8_LAS __attribute__((address_space(3)))
typedef unsigned short bf16_t;
typedef short bf16x8 __attribute__((ext_vector_type(8)));
typedef float f32x4 __attribute__((ext_vector_type(4)));
typedef unsigned u32x4 __attribute__((ext_vector_type(4)));
constexpr int BM = 256, BK = 64, HALF = 128, HTB = HALF * BK * 2  , STAGE_BYTES = 8 * HTB, NXCD = 8, WGM = 8;

__host__ __device__ __forceinline__ int lds_byte(int r, int c) { const int st = (r >> 4) * 2 + (c >> 5), rr = r & 15, cc = c & 31, ob = rr * 64 + cc * 2; return st * 1024 + (ob ^ (((ob >> 9) & 1) << 5)); }
__host__ __device__ __forceinline__ void stage_rc(int b, int& R, int& C) { const int st = b / 1024, sb = b % 1024, swz = sb ^ (((sb >> 9) & 1) << 5); R = (st >> 1) * 16 + swz / 64; C = (st & 1) * 32 + (swz % 64) / 2; }
__host__ __device__ __forceinline__ int perm32(int rho) { const int n = rho >> 4, i = rho & 15; return 8 * (i >> 2) + 4 * n + (i & 3); }

struct Unit { int pm, pn, e, nr; };

__device__ __forceinline__ unsigned cvt_pk_bf16(float lo, float hi) { unsigned r; asm volatile("v_cvt_pk_bf16_f32 %0, %1, %2" : "=v"(r) : "v"(lo), "v"(hi)); return r; }
template <class Epi, class Sched, bool ALIGN_EPI = true, bool SP2 = true>
__device__ __forceinline__ void gemm_phase(PG8_LAS unsigned char* lds, const char* Abase, const int K, const Sched& S, const Epi& E) {
    int tid_ = threadIdx.x; asm volatile("" : "+v"(tid_));
    const int tid = tid_, wid = __builtin_amdgcn_readfirstlane(tid >> 6), lane = tid & 63, wr = wid >> 2, wc = wid & 3, fr = lane & 15, fq = lane >> 4;
    const int nt = K / BK;
    unsigned voffB[2];
#pragma unroll
    for (int i = 0; i < 2; ++i) { int R, C; stage_rc(tid * 16 + i * 8192, R, C); const int Rb = Epi::PERM ? ((R & ~31) + perm32(R & 31)) : R;
        voffB[i] = (unsigned)(Rb * K + C) * 2u; }
#define PG8_AOFF(u, o0, o1) do { int _t = tid; asm volatile("" : "+v"(_t)); _Pragma("unroll") for (int _i = 0; _i < 2; ++_i) { int _R, _C; stage_rc(_t * 16 + _i * 8192, _R, _C); \
        (o0)[_i] = S.a_off((u), _R) + (unsigned)_C * 2u; (o1)[_i] = S.a_off((u), HALF + _R) + (unsigned)_C * 2u; } } while (0)
    const size_t kstep = (size_t)(BK * 2);
    const size_t akstep = S.a_kstep();
    const size_t hstep = (size_t)HALF * K * 2;
    const unsigned ldsw = (unsigned)wid * 1024u;
    const int aoff = lds_byte(wr * 64 + fr, fq * 8), boff = lds_byte(wc * 32 + fr, fq * 8);
#define PG8_SA(b, h) (((b) * 2 + (h)) * HTB)
#define PG8_SB(b, h) ((4 + (b) * 2 + (h)) * HTB)
#define PG8_STAGE(bufoff, gbase, voff) do { _Pragma("unroll") for (int _i = 0; _i < 2; ++_i) { unsigned _o = (voff)[_i]; asm volatile("" : "+v"(_o));     \
        __builtin_amdgcn_global_load_lds((const unsigned*)((const char*)(gbase) + _o), (PG8_LAS unsigned*)(lds + (bufoff) + ldsw + _i * 8192), 16, 0, 0); } } while (0)
#define PG8_LDA(dst, b, h) do { _Pragma("unroll") for (int m = 0; m < 4; ++m) _Pragma("unroll") for (int k = 0; k < 2; ++k) dst[m][k] = *(const PG8_LAS bf16x8*)(lds + PG8_SA(b, h) + aoff + m * 2048 + k * 1024); } while (0)
#define PG8_LDB(dst, b, h) do { _Pragma("unroll") for (int n = 0; n < 2; ++n) _Pragma("unroll") for (int k = 0; k < 2; ++k) dst[n][k] = *(const PG8_LAS bf16x8*)(lds + PG8_SB(b, h) + boff + n * 2048 + k * 1024); } while (0)
#define PG8_MMA(ai, bj, At, Bt) do { __builtin_amdgcn_s_setprio(1); _Pragma("unroll") for (int m = 0; m < 4; ++m) _Pragma("unroll") for (int n = 0; n < 2; ++n) _Pragma("unroll") for (int k = 0; k < 2; ++k) \
        acc[ai][bj][m][n] = __builtin_amdgcn_mfma_f32_16x16x32_bf16(Bt[n][k], At[m][k], acc[ai][bj][m][n], 0, 0, 0); __builtin_amdgcn_s_setprio(0); } while (0)
#define PG8_WAIT_V(n) asm volatile("s_waitcnt vmcnt(" #n ")" ::: "memory")
#define PG8_WAIT_L(n) asm volatile("s_waitcnt lgkmcnt(" #n ")" ::: "memory")
#define PG8_BAR __builtin_amdgcn_s_barrier()
#define PG8_SCHED __builtin_amdgcn_sched_barrier(0)
    Unit cur, nxt; int ui = 0;
    if (!S.next(0, cur)) return;
    f32x4 acc[2][2][4][2];
    float zf_ = 0.f; asm volatile("" : "+v"(zf_));
#pragma unroll
    for (int a = 0; a < 2; ++a)
#pragma unroll
        for (int b = 0; b < 2; ++b)
#pragma unroll
            for (int m = 0; m < 4; ++m)
#pragma unroll
                for (int n = 0; n < 2; ++n) acc[a][b][m][n] = (f32x4){zf_, zf_, zf_, zf_};
    bf16x8 At[4][2], B0[2][2], B1[2][2];
    unsigned ca0[2], ca1[2], na0[2], na1[2];
    PG8_AOFF(cur, ca0, ca1);
    const char* const cA = Abase; const char* cB = S.b_base(cur);
    if constexpr (SP2) {
        PG8_STAGE(PG8_SB(0, 0), cB, voffB); PG8_STAGE(PG8_SB(0, 1), cB + hstep, voffB); PG8_STAGE(PG8_SA(0, 0), cA, ca0); PG8_STAGE(PG8_SA(0, 1), cA, ca1);
        if (wr == 1) PG8_BAR;
        PG8_WAIT_V(2); PG8_BAR;
        PG8_STAGE(PG8_SB(1, 0), cB + kstep, voffB); PG8_STAGE(PG8_SA(1, 0), cA + akstep, ca0); PG8_STAGE(PG8_SB(1, 1), cB + hstep + kstep, voffB);
        PG8_WAIT_V(6); PG8_BAR;
    } else { static_assert(SP2, "only the SP2 loop is kept"); }
    for (;;) {
        const bool has_next = S.next(ui + 1, nxt);
        const char* nB = has_next ? S.b_base(nxt) : cB;
        if (has_next) { PG8_AOFF(nxt, na0, na1); } else { na0[0] = ca0[0]; na0[1] = ca0[1]; na1[0] = ca1[0]; na1[1] = ca1[1]; }
        for (int t = 0; t < nt - 2; t += 2) {
            const char* a1 = cA + (size_t)(t + 1) * akstep;
            const char* a2 = cA + (size_t)(t + 2) * akstep; const char* b2 = cB + (size_t)(t + 2) * kstep;
            const char* a3 = a2 + akstep; const char* b3 = b2 + kstep;
            PG8_LDB(B0, 0, 0); PG8_LDB(B1, 0, 1); PG8_SCHED; PG8_LDA(At, 0, 0); PG8_STAGE(PG8_SA(1, 1), a1, ca1);
            PG8_WAIT_V(8); PG8_WAIT_L(0); PG8_BAR; PG8_MMA(0, 0, At, B0); PG8_MMA(0, 1, At, B1); PG8_BAR; PG8_SCHED;
            PG8_LDA(At, 0, 1); PG8_STAGE(PG8_SB(0, 0), b2, voffB); PG8_STAGE(PG8_SB(0, 1), b2 + hstep, voffB); PG8_STAGE(PG8_SA(0, 0), a2, ca0);
            PG8_WAIT_V(8); PG8_WAIT_L(0); PG8_BAR; PG8_MMA(1, 0, At, B0); PG8_MMA(1, 1, At, B1); PG8_BAR; PG8_SCHED;
            PG8_LDB(B0, 1, 0); PG8_LDB(B1, 1, 1); PG8_SCHED; PG8_LDA(At, 1, 0); PG8_STAGE(PG8_SA(0, 1), a2, ca1);
            PG8_WAIT_V(8); PG8_WAIT_L(0); PG8_BAR; PG8_MMA(0, 0, At, B0); PG8_MMA(0, 1, At, B1); PG8_BAR; PG8_SCHED;
            PG8_LDA(At, 1, 1); PG8_STAGE(PG8_SB(1, 0), b3, voffB); PG8_STAGE(PG8_SB(1, 1), b3 + hstep, voffB); PG8_STAGE(PG8_SA(1, 0), a3, ca0);
            PG8_WAIT_V(8); PG8_WAIT_L(0); PG8_BAR; PG8_MMA(1, 0, At, B0); PG8_MMA(1, 1, At, B1); PG8_BAR; PG8_SCHED;
        }
        {
            const char* a1 = cA + (size_t)(nt - 1) * akstep;
            const char* a2 = cA; const char* b2 = nB; const char* a3 = a2 + akstep; const char* b3 = b2 + kstep;
            PG8_LDB(B0, 0, 0); PG8_LDB(B1, 0, 1); PG8_SCHED; PG8_LDA(At, 0, 0); PG8_STAGE(PG8_SA(1, 1), a1, ca1);
            PG8_WAIT_V(8); PG8_WAIT_L(0); PG8_BAR; PG8_MMA(0, 0, At, B0); PG8_MMA(0, 1, At, B1); PG8_BAR; PG8_SCHED;
            PG8_LDA(At, 0, 1); PG8_STAGE(PG8_SB(0, 0), b2, voffB); PG8_STAGE(PG8_SB(0, 1), b2 + hstep, voffB); PG8_STAGE(PG8_SA(0, 0), a2, na0);
            PG8_WAIT_V(8); PG8_WAIT_L(0); PG8_BAR; PG8_MMA(1, 0, At, B0); PG8_MMA(1, 1, At, B1); PG8_BAR; PG8_SCHED;
            PG8_LDB(B0, 1, 0); PG8_LDB(B1, 1, 1); PG8_SCHED; PG8_LDA(At, 1, 0); PG8_STAGE(PG8_SA(0, 1), a2, na1);
            PG8_WAIT_V(8); PG8_WAIT_L(0); PG8_BAR; PG8_MMA(0, 0, At, B0); PG8_MMA(0, 1, At, B1); PG8_BAR; PG8_SCHED;
            PG8_LDA(At, 1, 1); PG8_STAGE(PG8_SB(1, 0), b3, voffB); PG8_STAGE(PG8_SB(1, 1), b3 + hstep, voffB); PG8_STAGE(PG8_SA(1, 0), a3, na0);
            PG8_WAIT_V(8); PG8_WAIT_L(0); PG8_BAR; PG8_MMA(1, 0, At, B0); PG8_MMA(1, 1, At, B1); PG8_BAR; PG8_SCHED;
        }
        if constexpr (ALIGN_EPI) { if (wr == 0) PG8_BAR; }
        E(acc, cur, wr, wc, fr, fq);
        if (!has_next) break;
#pragma unroll
        for (int a = 0; a < 2; ++a)
#pragma unroll
            for (int b = 0; b < 2; ++b)
#pragma unroll
                for (int m = 0; m < 4; ++m)
#pragma unroll
                    for (int n = 0; n < 2; ++n) acc[a][b][m][n] = (f32x4){zf_, zf_, zf_, zf_};
        cur = nxt; cB = nB; ++ui; ca0[0] = na0[0]; ca0[1] = na0[1]; ca1[0] = na1[0]; ca1[1] = na1[1];
        if constexpr (ALIGN_EPI) { if (wr == 1) PG8_BAR; }
    }
    PG8_WAIT_V(0);
    if constexpr (!ALIGN_EPI) { if (wr == 0) PG8_BAR; }
    PG8_BAR;
#undef PG8_AOFF
#undef PG8_SA
#undef PG8_SB
#undef PG8_STAGE
#undef PG8_LDA
#undef PG8_LDB
#undef PG8_MMA
#undef PG8_WAIT_V
#undef PG8_WAIT_L
#undef PG8_BAR
#undef PG8_SCHED
}

}
namespace mk {
using namespace nv;
typedef unsigned short bf16_t;
typedef unsigned u32x4 __attribute__((ext_vector_type(4)));
typedef float f32x4 __attribute__((ext_vector_type(4)));
#define LAS __attribute__((address_space(3)))
typedef short bf16x8 __attribute__((ext_vector_type(8)));
typedef float f32x16 __attribute__((ext_vector_type(16)));
#define CROW(reg, hh) (((reg) & 3) + 8 * ((reg) >> 2) + 4 * (hh))
constexpr int NT = 512;
constexpr int PB = 2816;
constexpr int NPAD = 3072;
constexpr int C_KV = 512, C_FOX = 1280, C_SB = 2048, C_GATE = 2816;
constexpr int MAXT = MROWS / 256 + NE;
constexpr int PROWS = MAXT * 256;
#define CNT_IDX(l, e) (8192 + ((l) * NE + (e)) * 32)
__device__ __forceinline__ int ftid() { int t = threadIdx.x; asm volatile("" : "+v"(t)); return t; }
__device__ __forceinline__ int fbid() { int b = blockIdx.x; asm volatile("" : "+s"(b)); return b; }
#define MK_LOOP(vb, n) for (int vb = fbid(); vb < (n); vb += gridDim.x)

constexpr size_t al_(size_t x) { return (x + 4095) & ~(size_t)4095; }
constexpr size_t O_WTIN = 0;
constexpr size_t O_WTOUT = O_WTIN + al_((size_t)L_ * NPAD * D_ * 2);
constexpr size_t O_WTGU = O_WTOUT + al_((size_t)L_ * D_ * D_ * 2);
constexpr size_t O_WTDN = O_WTGU + al_((size_t)L_ * NE * 2048 * D_ * 2);
constexpr size_t O_BIASP = O_WTDN + al_((size_t)L_ * NE * D_ * D_ * 2);
constexpr size_t O_XB = O_BIASP + al_((size_t)L_ * NPAD * 4);
constexpr size_t O_PROJB = O_XB + al_((size_t)T_ * D_ * 2);
constexpr size_t O_GF = O_PROJB + al_((size_t)T_ * PB * 2);
constexpr size_t O_CFOX = O_GF + al_((size_t)T_ * 32 * 4);
constexpr size_t O_KCMP = O_CFOX + al_((size_t)B_ * 4 * S_ * 4);
constexpr size_t O_VCMP = O_KCMP + al_((size_t)B_ * 2 * 512 * 64 * 4);
constexpr size_t O_O = O_VCMP + al_((size_t)B_ * 2 * 512 * 64 * 4);
constexpr size_t O_OB = O_O + al_((size_t)T_ * D_ * 4);
constexpr size_t O_PTOT = O_OB + al_((size_t)T_ * D_ * 2);
constexpr size_t O_SEL = O_PTOT + al_((size_t)B_ * 2 * S_ * 512 * 4);
constexpr size_t O_MIX = O_SEL + al_((size_t)B_ * 2 * S_ * NSEL * 4);
constexpr size_t O_X1 = O_MIX + al_((size_t)T_ * D_ * 4);
constexpr size_t O_X1B = O_X1 + al_((size_t)T_ * D_ * 4);
constexpr size_t O_XA = O_X1B + al_((size_t)T_ * D_ * 2);
constexpr size_t O_ACT = O_XA + al_((size_t)T_ * D_ * 4);
constexpr size_t O_Y = O_ACT + al_((size_t)PROWS * D_ * 2);
constexpr size_t O_TOPE = O_Y + al_((size_t)PROWS * D_ * 2);
constexpr size_t O_TOPW = O_TOPE + al_((size_t)MROWS * 4);
constexpr size_t O_POS = O_TOPW + al_((size_t)MROWS * 4);
constexpr size_t O_ROWTOK = O_POS + al_((size_t)MROWS * 4);
constexpr size_t O_ROWW = O_ROWTOK + al_((size_t)PROWS * 4);
constexpr size_t O_SLOT = O_ROWW + al_((size_t)PROWS * 4);
constexpr size_t O_COUNTS = O_SLOT + al_((size_t)MROWS * 4);
constexpr size_t O_META = O_COUNTS + 65536;
constexpr size_t O_OWIN = O_META + 4096;
constexpr size_t O_O2 = O_OWIN + al_((size_t)T_ * 512 * 4);
constexpr size_t O_OWIN2 = O_O2 + al_((size_t)T_ * D_ * 4);
constexpr size_t O_KCMPB = O_OWIN2 + al_((size_t)T_ * 512 * 4);
constexpr size_t O_VCMPB = O_KCMPB + al_((size_t)B_ * 2 * 512 * 64 * 2);
constexpr size_t O_OCMP = O_VCMPB + al_((size_t)B_ * 2 * 512 * 64 * 2);
constexpr size_t O_SELMASK = O_OCMP + al_((size_t)T_ * 512 * 4);
constexpr size_t O_WT1 = O_SELMASK + al_((size_t)B_ * 2 * S_ * 16);
constexpr size_t O_BIAS1 = O_WT1 + al_((size_t)L_ * 2 * 256 * 2048 * 2);
constexpr size_t O_HID = O_BIAS1 + al_((size_t)L_ * 2 * 128 * 4);
constexpr size_t O_BIAS1P = O_HID + al_((size_t)8 * 512 * 128 * 2);
constexpr size_t O_RWT = O_BIAS1P + al_((size_t)L_ * 2 * 64 * 128 * 4);
constexpr size_t O_HIDP = O_RWT + al_((size_t)L_ * 2 * NE * D_ * 2);
constexpr size_t O_END = O_HIDP + al_((size_t)2 * 8 * 512 * 128 * 4);

struct P {
    In in; unsigned char* ws; float* out;
};
typedef const __attribute__((address_space(4))) P* KP;
__device__ __forceinline__ KP fresh_kp() { KP k = (KP)__builtin_amdgcn_kernarg_segment_ptr(); asm volatile("" : "+s"(k)); return k; }
#define WSP(T, off) ((T*)(p->ws + (off)))

__device__ __forceinline__ float bf2f(unsigned short b) { return __uint_as_float((unsigned)b << 16); }
__device__ __forceinline__ unsigned f2bf(float f) { unsigned u = __float_as_uint(f); return (u + 0x7fffu + ((u >> 16) & 1u)) >> 16; }
__device__ __forceinline__ unsigned pk2(float lo, float hi) { return f2bf(lo) | (f2bf(hi) << 16); }
__device__ __forceinline__ void ld8(const bf16_t* __restrict__ src, float* dst) {
    const u32x4 v = *(const u32x4*)src;
    dst[0] = __uint_as_float(v.x << 16); dst[1] = __uint_as_float(v.x & 0xffff0000u); dst[2] = __uint_as_float(v.y << 16); dst[3] = __uint_as_float(v.y & 0xffff0000u);
    dst[4] = __uint_as_float(v.z << 16); dst[5] = __uint_as_float(v.z & 0xffff0000u); dst[6] = __uint_as_float(v.w << 16); dst[7] = __uint_as_float(v.w & 0xffff0000u);
}


__device__ __forceinline__ int perm_in(int n) {
    if (n < 1280) return n;
    if (n < 1304) return C_GATE + (n - 1280);
    if (n < 2072) return C_FOX + (n - 1304);
    if (n < 2076) return C_GATE + 24 + (n - 2072);
    return C_SB + (n - 2076);
}
__device__ __forceinline__ int perm_gu(int n) { const int up = n >> 10, c = n & 1023; return 256 * (c >> 7) + 128 * up + (c & 127); }
template <int MAP>
__device__ __forceinline__ void transpose_item(const float* __restrict__ W, int K, int N, bf16_t* __restrict__ WT, LAS float* scr, int item, int lane) {
    const int nblk = (N + 31) / 32, kb = item / nblk, nb = item % nblk, k0 = 64 * kb, n0 = 32 * nb;
    { const int n4 = (lane & 7) * 4; const bool okn = (n0 + n4) < N;
      f32x4 t[8];
#pragma unroll
      for (int i = 0; i < 8; ++i) { const int kk = (lane >> 3) + 8 * i; t[i] = okn ? *(const f32x4*)(W + (size_t)(k0 + kk) * N + n0 + n4) : (f32x4){0.f, 0.f, 0.f, 0.f}; }
#pragma unroll
      for (int i = 0; i < 8; ++i) { const int kk = (lane >> 3) + 8 * i; LAS float* d = scr + kk * 33 + n4; d[0] = t[i].x; d[1] = t[i].y; d[2] = t[i].z; d[3] = t[i].w; } }
    asm volatile("s_waitcnt lgkmcnt(0)" ::: "memory");
    const int c = lane & 7;
#pragma unroll
    for (int j = 0; j < 4; ++j) { const int n = (lane >> 3) + 8 * j; const LAS float* sp = scr + (8 * c) * 33 + n;
        u32x4 o; o.x = pk2(sp[0 * 33], sp[1 * 33]); o.y = pk2(sp[2 * 33], sp[3 * 33]); o.z = pk2(sp[4 * 33], sp[5 * 33]); o.w = pk2(sp[6 * 33], sp[7 * 33]);
        const int ng = n0 + n;
        if (ng < N) { const int ro = (MAP == 1) ? perm_in(ng) : (MAP == 2) ? perm_gu(ng) : ng;
            if (MAP == 3) *(u32x4*)(WT + (size_t)(k0 >> 10) * 256 * 1024 + (size_t)ro * 1024 + (k0 & 1023) + 8 * c) = o;
            else *(u32x4*)(WT + (size_t)ro * K + k0 + 8 * c) = o; } }
    asm volatile("s_waitcnt lgkmcnt(0)" ::: "memory");
}
constexpr int CV_I_IN = 16 * 89, CV_I_OUT = 16 * 32, CV_I_GU = 16 * 64, CV_I_DN = 16 * 32, CV_I_W1 = 32 * 4;
constexpr int CV_N_IN = L_ * CV_I_IN, CV_N_OUT = L_ * CV_I_OUT, CV_N_GU = L_ * NE * CV_I_GU, CV_N_DN = L_ * NE * CV_I_DN, CV_N_W1 = L_ * 2 * CV_I_W1, CV_N_ALL = CV_N_IN + CV_N_OUT + CV_N_GU + CV_N_DN + CV_N_W1;
constexpr int CV_DEF_GU0 = CV_N_W1 + NE * CV_I_GU, CV_DEF_GU = NE * CV_I_GU, CV_DEF_DN0 = CV_N_W1 + CV_N_GU + NE * CV_I_DN, CV_DEF_DN = NE * CV_I_DN, CV_DEF_ALL = CV_DEF_GU + CV_DEF_DN;
__device__ __forceinline__ void cv_one(KP p, LAS float* scr, int it, int lane) {
    int r = it;
    if (r < CV_N_W1) { const int mtx = r / CV_I_W1, ll = mtx >> 1, kv = mtx & 1; transpose_item<3>((kv ? p->in.w1v : p->in.w1k) + (size_t)ll * 2048 * 128, 2048, 128, WSP(bf16_t, O_WT1) + (size_t)mtx * 256 * 2048, scr, r % CV_I_W1, lane); return; } r -= CV_N_W1;
    if (r < CV_N_GU) { const int mtx = r / CV_I_GU; transpose_item<2>(p->in.wgu + (size_t)mtx * D_ * 2048, D_, 2048, WSP(bf16_t, O_WTGU) + (size_t)mtx * 2048 * D_, scr, r % CV_I_GU, lane); return; } r -= CV_N_GU;
    if (r < CV_N_DN) { const int mtx = r / CV_I_DN; transpose_item<0>(p->in.wdn + (size_t)mtx * D_ * D_, D_, D_, WSP(bf16_t, O_WTDN) + (size_t)mtx * D_ * D_, scr, r % CV_I_DN, lane); return; } r -= CV_N_DN;
    if (r < CV_N_IN) { const int mtx = r / CV_I_IN; transpose_item<1>(p->in.w_in + (size_t)mtx * D_ * DIN, D_, DIN, WSP(bf16_t, O_WTIN) + (size_t)mtx * NPAD * D_, scr, r % CV_I_IN, lane); return; } r -= CV_N_IN;
    { const int mtx = r / CV_I_OUT; transpose_item<0>(p->in.w_out + (size_t)mtx * D_ * D_, D_, D_, WSP(bf16_t, O_WTOUT) + (size_t)mtx * D_ * D_, scr, r % CV_I_OUT, lane); }
}
__device__ __forceinline__ void cv_help(LAS unsigned char* lds, KP p, int maxchunks) {
    const int tid = ftid(), lane = tid & 63, wv = tid >> 6; LAS float* scr = (LAS float*)(lds + wv * 8448);
    unsigned* cursor = WSP(unsigned, O_COUNTS) + 64;
    for (int c = 0; c < maxchunks; ++c) {
        unsigned base = 0u; if (lane == 0) base = atomicAdd(cursor, 8u);
        base = (unsigned)__builtin_amdgcn_readfirstlane((int)base);
        if (base >= (unsigned)CV_DEF_ALL) break;
        for (int i = 0; i < 8; ++i) { const int d = (int)base + i; if (d < CV_DEF_ALL) cv_one(p, scr, d < CV_DEF_GU ? CV_DEF_GU0 + d : CV_DEF_DN0 + (d - CV_DEF_GU), lane); }
    }
}
__device__ __forceinline__ void ph_convert(LAS unsigned char* lds, KP p) {
    const int tid = ftid(), lane = tid & 63, wv = tid >> 6;
    LAS float* scr = (LAS float*)(lds + wv * 8448);
    const int gw = fbid() * 8 + wv, NGW = gridDim.x * 8;
    for (int it = gw; it < CV_N_ALL; it += NGW) {
        if ((it >= CV_DEF_GU0 && it < CV_DEF_GU0 + CV_DEF_GU) || (it >= CV_DEF_DN0 && it < CV_DEF_DN0 + CV_DEF_DN)) continue;
        cv_one(p, scr, it, lane);
    }
    const int gt = fbid() * NT + tid, NG = gridDim.x * NT;
    for (int i = gt; i < L_ * (NPAD - DIN) * (D_ / 8); i += NG) { const int l = i / ((NPAD - DIN) * (D_ / 8)), r = i % ((NPAD - DIN) * (D_ / 8));
        unsigned z_ = 0u; asm volatile("" : "+v"(z_));
        *(u32x4*)(WSP(bf16_t, O_WTIN) + ((size_t)l * NPAD + DIN) * D_ + (size_t)r * 8) = (u32x4){z_, z_, z_, z_}; }
    for (int i = gt; i < L_ * 2 * 2 * 128 * (1024 / 8); i += NG) { const int mtxh = i / (128 * 128), r = i % (128 * 128); unsigned z_ = 0u; asm volatile("" : "+v"(z_));
        *(u32x4*)(WSP(bf16_t, O_WT1) + ((size_t)mtxh * 256 + 128) * 1024 + (size_t)r * 8) = (u32x4){z_, z_, z_, z_}; }
    for (int i = gt; i < L_ * 2 * 64 * 128; i += NG) { const int j = i & 127, seg = (i >> 7) & 63, mtx = i >> 13, ll = mtx >> 1, kv = mtx & 1;
        const float* pos = (kv ? p->in.pos_v : p->in.pos_k) + (size_t)ll * 2048 + seg * 32; const float* w1 = (kv ? p->in.w1v : p->in.w1k) + (size_t)ll * 2048 * 128 + (size_t)seg * 32 * 128; float a = 0.f;
#pragma unroll 8
        for (int k = 0; k < 32; ++k) a += pos[k] * w1[(size_t)k * 128 + j];
        WSP(float, O_BIAS1P)[i] = a; }
    for (int i = gt; i < L_ * NPAD; i += NG) { const int l = i / NPAD, c = i % NPAD; if (c >= DIN) WSP(float, O_BIASP)[i] = 0.f; }
    for (int i = gt; i < L_ * DIN; i += NG) { const int l = i / DIN, n = i % DIN; WSP(float, O_BIASP)[l * NPAD + perm_in(n)] = p->in.b_in[i]; }
    for (int i = gt; i < L_ * NE * D_; i += NG) { const int k = i & (D_ - 1), e = (i >> 10) & (NE - 1), l = i >> 15;
        const float v = p->in.rw[((size_t)l * D_ + k) * NE + e]; const unsigned h = f2bf(v); const float lo = v - bf2f((unsigned short)h);
        WSP(bf16_t, O_RWT)[((size_t)(l * 2 + 0) * NE + e) * D_ + k] = (bf16_t)h; WSP(bf16_t, O_RWT)[((size_t)(l * 2 + 1) * NE + e) * D_ + k] = (bf16_t)f2bf(lo); }
    for (int i = gt; i < T_ * D_ / 8; i += NG) { const f32x4 a = *(const f32x4*)(p->in.x + (size_t)i * 8), b = *(const f32x4*)(p->in.x + (size_t)i * 8 + 4);
        *(u32x4*)(WSP(bf16_t, O_XB) + (size_t)i * 8) = (u32x4){pk2(a.x, a.y), pk2(a.z, a.w), pk2(b.x, b.y), pk2(b.z, b.w)}; }
}

struct EpiProj {
    static constexpr bool PERM = true;
    bf16_t* projb; float* gf; const float* bias;
    __device__ __forceinline__ void operator()(const pg8::f32x4 (&acc)[2][2][4][2], const pg8::Unit& u, int wr, int wc, int fr, int fq) const {
        const int row0 = u.pm * 256 + wr * 64 + fr, col0 = u.pn * 256 + wc * 32 + 8 * fq;
        if (u.pn < 11) {
#pragma unroll
            for (int ai = 0; ai < 2; ++ai)
#pragma unroll
                for (int m = 0; m < 4; ++m) { bf16_t* rowp = projb + (size_t)(row0 + ai * 128 + m * 16) * PB + col0;
#pragma unroll
                    for (int bj = 0; bj < 2; ++bj) { const f32x4 v0 = acc[ai][bj][m][0] + *(const f32x4*)(bias + col0 + bj * 128), v1 = acc[ai][bj][m][1] + *(const f32x4*)(bias + col0 + bj * 128 + 4);
                        u32x4 w; w.x = pg8::cvt_pk_bf16(v0[0], v0[1]); w.y = pg8::cvt_pk_bf16(v0[2], v0[3]); w.z = pg8::cvt_pk_bf16(v1[0], v1[1]); w.w = pg8::cvt_pk_bf16(v1[2], v1[3]);
                        *(u32x4*)(rowp + bj * 128) = w; }
                    asm volatile("" ::: "memory"); }
        } else if (wc == 0) {
            const f32x4 b0 = *(const f32x4*)(bias + col0), b1 = *(const f32x4*)(bias + col0 + 4);
#pragma unroll
            for (int ai = 0; ai < 2; ++ai)
#pragma unroll
                for (int m = 0; m < 4; ++m) { float* rowp = gf + (size_t)(row0 + ai * 128 + m * 16) * 32 + 8 * fq;
                    const f32x4 v0 = acc[ai][0][m][0] + b0, v1 = acc[ai][0][m][1] + b1; f32x4 o0, o1;
#pragma unroll
                    for (int i = 0; i < 4; ++i) { const int j0 = 8 * fq + i, j1 = j0 + 4;
                        o0[i] = (j0 < 24) ? sigmoidf_(v0[i]) : (j0 < 28 ? logsig(v0[i]) : 0.f); o1[i] = (j1 < 24) ? sigmoidf_(v1[i]) : (j1 < 28 ? logsig(v1[i]) : 0.f); }
                    *(f32x4*)rowp = o0; *(f32x4*)(rowp + 4) = o1; }
        }
    }
};
struct EpiOut {
    static constexpr bool PERM = true;
    bf16_t* mixb;
    __device__ __forceinline__ void operator()(const pg8::f32x4 (&acc)[2][2][4][2], const pg8::Unit& u, int wr, int wc, int fr, int fq) const {
        const int row0 = u.pm * 256 + wr * 64 + fr, col0 = u.pn * 256 + wc * 32 + 8 * fq;
#pragma unroll
        for (int ai = 0; ai < 2; ++ai)
#pragma unroll
            for (int m = 0; m < 4; ++m) { bf16_t* rowp = mixb + (size_t)(row0 + ai * 128 + m * 16) * D_ + col0;
#pragma unroll
                for (int bj = 0; bj < 2; ++bj) { const f32x4 v0 = acc[ai][bj][m][0], v1 = acc[ai][bj][m][1];
                    u32x4 w; w.x = pg8::cvt_pk_bf16(v0[0], v0[1]); w.y = pg8::cvt_pk_bf16(v0[2], v0[3]); w.z = pg8::cvt_pk_bf16(v1[0], v1[1]); w.w = pg8::cvt_pk_bf16(v1[2], v1[3]);
                    *(u32x4*)(rowp + bj * 128) = w; }
                asm volatile("" ::: "memory"); }
    }
};
struct EpiGU {
    static constexpr bool PERM = true;
    bf16_t* act; const float* bgu;
    __device__ __forceinline__ void operator()(const pg8::f32x4 (&acc)[2][2][4][2], const pg8::Unit& u, int wr, int wc, int fr, int fq) const {
        const int row0 = u.pm * 256 + wr * 64 + fr, col0 = u.pn * 128 + wc * 32 + 8 * fq;
        const float* bb = bgu + (size_t)u.e * 2048 + col0;
        const f32x4 bg0 = *(const f32x4*)bb, bg1 = *(const f32x4*)(bb + 4), bu0 = *(const f32x4*)(bb + 1024), bu1 = *(const f32x4*)(bb + 1028);
#pragma unroll
        for (int ai = 0; ai < 2; ++ai)
#pragma unroll
            for (int m = 0; m < 4; ++m) { f32x4 a0, a1;
                const f32x4 g0 = acc[ai][0][m][0] + bg0, g1 = acc[ai][0][m][1] + bg1, u0 = acc[ai][1][m][0] + bu0, u1 = acc[ai][1][m][1] + bu1;
#pragma unroll
                for (int i = 0; i < 4; ++i) { const float gt0 = fminf(g0[i], 7.0f), up0 = fminf(fmaxf(u0[i], -7.0f), 7.0f), gt1 = fminf(g1[i], 7.0f), up1 = fminf(fmaxf(u1[i], -7.0f), 7.0f);
                    a0[i] = gt0 * sigmoidf_(1.702f * gt0) * (up0 + 1.0f); a1[i] = gt1 * sigmoidf_(1.702f * gt1) * (up1 + 1.0f); }
                u32x4 w; w.x = pg8::cvt_pk_bf16(a0[0], a0[1]); w.y = pg8::cvt_pk_bf16(a0[2], a0[3]); w.z = pg8::cvt_pk_bf16(a1[0], a1[1]); w.w = pg8::cvt_pk_bf16(a1[2], a1[3]);
                *(u32x4*)(act + (size_t)(row0 + ai * 128 + m * 16) * D_ + col0) = w; asm volatile("" ::: "memory"); }
    }
};
struct EpiDN {
    static constexpr bool PERM = true;
    bf16_t* y; const float* bdn; const float* roww;
    __device__ __forceinline__ void operator()(const pg8::f32x4 (&acc)[2][2][4][2], const pg8::Unit& u, int wr, int wc, int fr, int fq) const {
        const int row0 = u.pm * 256 + wr * 64 + fr, col0 = u.pn * 256 + wc * 32 + 8 * fq;
        const float* bb = bdn + (size_t)u.e * D_ + col0;
#pragma unroll
        for (int ai = 0; ai < 2; ++ai)
#pragma unroll
            for (int m = 0; m < 4; ++m) { const int row = row0 + ai * 128 + m * 16; const float w = roww[row];
#pragma unroll
                for (int bj = 0; bj < 2; ++bj) { const f32x4 v0 = (acc[ai][bj][m][0] + *(const f32x4*)(bb + bj * 128)) * w, v1 = (acc[ai][bj][m][1] + *(const f32x4*)(bb + bj * 128 + 4)) * w;
                    u32x4 o; o.x = pg8::cvt_pk_bf16(v0[0], v0[1]); o.y = pg8::cvt_pk_bf16(v0[2], v0[3]); o.z = pg8::cvt_pk_bf16(v1[0], v1[1]); o.w = pg8::cvt_pk_bf16(v1[2], v1[3]);
                    *(u32x4*)(y + (size_t)row * D_ + col0 + bj * 128) = o; }
                asm volatile("" ::: "memory"); }
    }
};
struct EpiCmp {
    static constexpr bool PERM = true;
    float* hidp;
    __device__ __forceinline__ void operator()(const pg8::f32x4 (&acc)[2][2][4][2], const pg8::Unit& u, int wr, int wc, int fr, int fq) const {
        const int row0 = u.pm * 256 + wr * 64 + fr, col0 = wc * 32 + 8 * fq;
#pragma unroll
        for (int ai = 0; ai < 2; ++ai)
#pragma unroll
            for (int m = 0; m < 4; ++m) { float* d = hidp + (((size_t)u.pn * 8 + u.e) * 512 + row0 + ai * 128 + m * 16) * 128 + col0;
                *(f32x4*)d = acc[ai][0][m][0]; *(f32x4*)(d + 4) = acc[ai][0][m][1]; asm volatile("" ::: "memory"); }
    }
};
struct GEpi {
    static constexpr bool PERM = true;
    int kind, l;
    __device__ __forceinline__ void operator()(const pg8::f32x4 (&acc)[2][2][4][2], const pg8::Unit& u, int wr, int wc, int fr, int fq) const {
        const KP p = fresh_kp();
        if (kind == 0) { const EpiProj e{WSP(bf16_t, O_PROJB), WSP(float, O_GF), WSP(float, O_BIASP) + l * NPAD}; e(acc, u, wr, wc, fr, fq); }
        else if (kind == 1) { const EpiOut e{WSP(bf16_t, O_MIX)}; e(acc, u, wr, wc, fr, fq); }
        else if (kind == 2) { const EpiGU e{WSP(bf16_t, O_ACT), p->in.bgu + (size_t)l * NE * 2048}; e(acc, u, wr, wc, fr, fq); }
        else if (kind == 3) { const EpiDN e{WSP(bf16_t, O_Y), p->in.bdn + (size_t)l * NE * D_, WSP(float, O_ROWW)}; e(acc, u, wr, wc, fr, fq); }
        else { const EpiCmp e{WSP(float, O_HIDP)}; e(acc, u, wr, wc, fr, fq); }
    }
};
struct GSched {
    int kind, nM, nN, nunits, G, c; const int* meta; const int* rowtok; const char* Bt; size_t estep;
    __device__ __forceinline__ bool next(int i, pg8::Unit& u) const {
        const int L = i * G + c; if (L >= nunits) return false;
        if (kind == 1) {
            int wgid = L; { const int q = nunits / pg8::NXCD, r = nunits % pg8::NXCD, xcd = wgid % pg8::NXCD, off = wgid / pg8::NXCD; wgid = (xcd < r ? xcd * (q + 1) : r * (q + 1) + (xcd - r) * q) + off; }
            const int nig = pg8::WGM * nN, gid = wgid / nig, fm = gid * pg8::WGM, gsz = (nM - fm) < pg8::WGM ? (nM - fm) : pg8::WGM;
            u.pm = fm + ((wgid % nig) % gsz); u.pn = (wgid % nig) / gsz; u.e = 0; u.nr = 256;
        } else if (kind == 4) { u.e = L >> 2; u.pm = (L >> 1) & 1; u.pn = L & 1; u.nr = ((L >> 1) & 1) ? 255 : 256; }
        else if (kind == 0) { const int gt = L / nN; u.pm = gt; u.pn = L - gt * nN; u.e = 0; u.nr = 256; }
        else { const int gt = L / nN; u.pm = gt; u.pn = L - gt * nN; u.e = meta[64 + 2 * gt]; u.nr = meta[65 + 2 * gt]; }
        return true; }
    __device__ __forceinline__ unsigned a_off(const pg8::Unit& u, int r) const { const int rr = r < u.nr ? r : u.nr - 1; const int row = u.pm * 256 + rr;
        if (kind == 4) { const int kv = u.e & 1, bg = u.e >> 1; return (unsigned)(((bg >> 1) * S_ + 16 * row + 16 * u.pn) * PB + C_KV + ((0 * 2 + kv) * 2 + (bg & 1)) * 64) * 2u; }
        return (unsigned)((kind == 2) ? rowtok[row] : row) * (unsigned)(D_ * 2); }
    __device__ __forceinline__ size_t a_kstep() const { return kind == 4 ? (size_t)PB * 2 : (size_t)128; }
    __device__ __forceinline__ const char* b_base(const pg8::Unit& u) const { return Bt + (size_t)(kind == 4 ? (u.e & 1) : u.e) * estep + (size_t)u.pn * ((size_t)256 * D_ * 2); }
};

__device__ __forceinline__ void ph_rmsnorm(KP p, int l) {
    const int lane = ftid() & 63, wv = ftid() >> 6; const float* g = p->in.g_out + (size_t)l * D_;
    constexpr int NB = 4; const int rstride = (int)gridDim.x * 8;
    f32x4 gg[4];
#pragma unroll
    for (int j = 0; j < 2; ++j) { gg[2 * j] = *(const f32x4*)(g + 512 * j + lane * 8); gg[2 * j + 1] = *(const f32x4*)(g + 512 * j + lane * 8 + 4); }
    for (int row0 = fbid() * 8 + wv; row0 < T_; row0 += rstride * NB) {
        u32x4 ra[NB], rb2[NB], rw2[NB];
#pragma unroll
        for (int bi = 0; bi < NB; ++bi) { const int row = (row0 + bi * rstride < T_) ? row0 + bi * rstride : row0; const bf16_t* r = WSP(bf16_t, O_O) + (size_t)row * D_ + lane * 8;
            ra[bi] = *(const u32x4*)r; rb2[bi] = *(const u32x4*)(r + 512); rw2[bi] = *(const u32x4*)(WSP(bf16_t, O_OWIN) + (size_t)row * 512 + lane * 8); }
#pragma unroll
        for (int bi = 0; bi < NB; ++bi) { const int row = row0 + bi * rstride; if (row < T_) {
#define BF_LO(u) __uint_as_float((u) << 16)
#define BF_HI(u) __uint_as_float((u) & 0xffff0000u)
            const f32x4 x0 = (f32x4){BF_LO(ra[bi].x) + BF_LO(rw2[bi].x), BF_HI(ra[bi].x) + BF_HI(rw2[bi].x), BF_LO(ra[bi].y) + BF_LO(rw2[bi].y), BF_HI(ra[bi].y) + BF_HI(rw2[bi].y)};
            const f32x4 x1 = (f32x4){BF_LO(ra[bi].z) + BF_LO(rw2[bi].z), BF_HI(ra[bi].z) + BF_HI(rw2[bi].z), BF_LO(ra[bi].w) + BF_LO(rw2[bi].w), BF_HI(ra[bi].w) + BF_HI(rw2[bi].w)};
            const f32x4 y0 = (f32x4){BF_LO(rb2[bi].x), BF_HI(rb2[bi].x), BF_LO(rb2[bi].y), BF_HI(rb2[bi].y)}, y1 = (f32x4){BF_LO(rb2[bi].z), BF_HI(rb2[bi].z), BF_LO(rb2[bi].w), BF_HI(rb2[bi].w)};
#undef BF_LO
#undef BF_HI
            float s = (x0.x * x0.x + x0.y * x0.y) + (x0.z * x0.z + x0.w * x0.w) + (x1.x * x1.x + x1.y * x1.y) + (x1.z * x1.z + x1.w * x1.w);
            float s2 = (y0.x * y0.x + y0.y * y0.y) + (y0.z * y0.z + y0.w * y0.w) + (y1.x * y1.x + y1.y * y1.y) + (y1.z * y1.z + y1.w * y1.w);
            const float sc0 = rsqrtf(wsum(s) * (1.f / 512.f) + RMS_EPS);
#pragma unroll
            for (int o = 1; o < 32; o <<= 1) s2 += __shfl_xor(s2, o);
            const float sc1 = rsqrtf(s2 * (1.f / 256.f) + RMS_EPS);
            const f32x4 u0 = x0 * sc0 * gg[0], u1 = x1 * sc0 * gg[1], w0 = y0 * sc1 * gg[2], w1 = y1 * sc1 * gg[3];
            bf16_t* ro = WSP(bf16_t, O_OB) + (size_t)row * D_;
            *(u32x4*)(ro + lane * 8) = (u32x4){pk2(u0.x, u0.y), pk2(u0.z, u0.w), pk2(u1.x, u1.y), pk2(u1.z, u1.w)};
            *(u32x4*)(ro + 512 + lane * 8) = (u32x4){pk2(w0.x, w0.y), pk2(w0.z, w0.w), pk2(w1.x, w1.y), pk2(w1.z, w1.w)}; } }
    }
}
template <bool ROUTER>
__device__ __forceinline__ void ph_ln(float* lds, KP p, int l, float* __restrict__ yout, int cnt_off = 0) {
    const int lane = ftid() & 63, wv = ftid() >> 6;
    const float* g = (ROUTER ? p->in.ln1_g : p->in.ln2_g) + (size_t)l * D_; const float* bb = (ROUTER ? p->in.ln1_b : p->in.ln2_b) + (size_t)l * D_;
    constexpr int NB = ROUTER ? 4 : 2;
    const int rstride = (int)gridDim.x * 8;
    LAS unsigned char* L3 = (LAS unsigned char*)lds; float* lgl = lds + 33024 + wv * 256;
    int oi = 0;
    for (int row0 = fbid() * 8 + wv; row0 < T_; row0 += rstride * NB, ++oi) {
        float v[NB][16];
        if (ROUTER) { const float* xin = (l == 0) ? p->in.x : WSP(float, O_XA);
#pragma unroll
            for (int bi = 0; bi < NB; ++bi) { const int row = (row0 + bi * rstride < T_) ? row0 + bi * rstride : row0; const float* src = xin + (size_t)row * D_; const bf16_t* mx = WSP(bf16_t, O_MIX) + (size_t)row * D_;
#pragma unroll
                for (int j = 0; j < 2; ++j) { const f32x4 a = *(const f32x4*)(src + 512 * j + lane * 8), b = *(const f32x4*)(src + 512 * j + lane * 8 + 4); const u32x4 q = *(const u32x4*)(mx + 512 * j + lane * 8);
                    v[bi][8 * j + 0] = ALPHA * a.x + __uint_as_float(q.x << 16); v[bi][8 * j + 1] = ALPHA * a.y + __uint_as_float(q.x & 0xffff0000u); v[bi][8 * j + 2] = ALPHA * a.z + __uint_as_float(q.y << 16); v[bi][8 * j + 3] = ALPHA * a.w + __uint_as_float(q.y & 0xffff0000u);
                    v[bi][8 * j + 4] = ALPHA * b.x + __uint_as_float(q.z << 16); v[bi][8 * j + 5] = ALPHA * b.y + __uint_as_float(q.z & 0xffff0000u); v[bi][8 * j + 6] = ALPHA * b.z + __uint_as_float(q.w << 16); v[bi][8 * j + 7] = ALPHA * b.w + __uint_as_float(q.w & 0xffff0000u); } }
        } else { const bf16_t* y = WSP(bf16_t, O_Y);
            int sl[NB][TOPK];
#pragma unroll
            for (int bi = 0; bi < NB; ++bi) { const int row = (row0 + bi * rstride < T_) ? row0 + bi * rstride : row0;
#pragma unroll
                for (int k = 0; k < TOPK; ++k) sl[bi][k] = WSP(int, O_SLOT)[row * TOPK + k]; }
            u32x4 yv[NB][TOPK][2]; f32x4 xv[NB][4];
#pragma unroll
            for (int bi = 0; bi < NB; ++bi) { const int row = (row0 + bi * rstride < T_) ? row0 + bi * rstride : row0; const float* src = WSP(float, O_X1) + (size_t)row * D_;
#pragma unroll
                for (int j = 0; j < 2; ++j) { xv[bi][2 * j] = *(const f32x4*)(src + 512 * j + lane * 8); xv[bi][2 * j + 1] = *(const f32x4*)(src + 512 * j + lane * 8 + 4); }
#pragma unroll
                for (int k = 0; k < TOPK; ++k)
#pragma unroll
                    for (int j = 0; j < 2; ++j) yv[bi][k][j] = *(const u32x4*)(y + (size_t)sl[bi][k] * D_ + 512 * j + lane * 8); }
#pragma unroll
            for (int bi = 0; bi < NB; ++bi)
#pragma unroll
                for (int j = 0; j < 2; ++j) { float acc[8];
#pragma unroll
                    for (int e = 0; e < 8; ++e) acc[e] = 0.f;
#pragma unroll
                    for (int k = 0; k < TOPK; ++k) { const u32x4 q = yv[bi][k][j];
                        acc[0] += __uint_as_float(q.x << 16); acc[1] += __uint_as_float(q.x & 0xffff0000u); acc[2] += __uint_as_float(q.y << 16); acc[3] += __uint_as_float(q.y & 0xffff0000u);
                        acc[4] += __uint_as_float(q.z << 16); acc[5] += __uint_as_float(q.z & 0xffff0000u); acc[6] += __uint_as_float(q.w << 16); acc[7] += __uint_as_float(q.w & 0xffff0000u); }
                    const f32x4 a = xv[bi][2 * j], b = xv[bi][2 * j + 1];
                    v[bi][8 * j + 0] = ALPHA * a.x + acc[0]; v[bi][8 * j + 1] = ALPHA * a.y + acc[1]; v[bi][8 * j + 2] = ALPHA * a.z + acc[2]; v[bi][8 * j + 3] = ALPHA * a.w + acc[3];
                    v[bi][8 * j + 4] = ALPHA * b.x + acc[4]; v[bi][8 * j + 5] = ALPHA * b.y + acc[5]; v[bi][8 * j + 6] = ALPHA * b.z + acc[6]; v[bi][8 * j + 7] = ALPHA * b.w + acc[7]; } }
#pragma unroll
        for (int bi = 0; bi < NB; ++bi) { const int row = row0 + bi * rstride; if (row < T_) {
            float s = 0.f;
#pragma unroll
            for (int i = 0; i < 16; ++i) s += v[bi][i];
            const float mu = wsum(s) * (1.f / D_); float s2 = 0.f;
#pragma unroll
            for (int i = 0; i < 16; ++i) { v[bi][i] -= mu; s2 += v[bi][i] * v[bi][i]; }
            const float rstd = rsqrtf(wsum(s2) * (1.f / D_) + LN_EPS);
            bf16_t* ybf = (ROUTER ? WSP(bf16_t, O_X1B) : WSP(bf16_t, O_XB)) + (size_t)row * D_;
#pragma unroll
            for (int j = 0; j < 2; ++j) { const int c0 = 512 * j + lane * 8; float o8[8];
                const f32x4 g0 = *(const f32x4*)(g + c0), g1 = *(const f32x4*)(g + c0 + 4), b0 = *(const f32x4*)(bb + c0), b1 = *(const f32x4*)(bb + c0 + 4);
                o8[0] = v[bi][8 * j + 0] * rstd * g0.x + b0.x; o8[1] = v[bi][8 * j + 1] * rstd * g0.y + b0.y; o8[2] = v[bi][8 * j + 2] * rstd * g0.z + b0.z; o8[3] = v[bi][8 * j + 3] * rstd * g0.w + b0.w;
                o8[4] = v[bi][8 * j + 4] * rstd * g1.x + b1.x; o8[5] = v[bi][8 * j + 5] * rstd * g1.y + b1.y; o8[6] = v[bi][8 * j + 6] * rstd * g1.z + b1.z; o8[7] = v[bi][8 * j + 7] * rstd * g1.w + b1.w;
                *(f32x4*)(yout + (size_t)row * D_ + c0) = (f32x4){o8[0], o8[1], o8[2], o8[3]};
                *(f32x4*)(yout + (size_t)row * D_ + c0 + 4) = (f32x4){o8[4], o8[5], o8[6], o8[7]};
                const u32x4 hv = (u32x4){pk2(o8[0], o8[1]), pk2(o8[2], o8[3]), pk2(o8[4], o8[5]), pk2(o8[6], o8[7])};
                *(u32x4*)(ybf + c0) = hv;
                if (ROUTER) {
                    float r8[8];
#pragma unroll
                    for (int i = 0; i < 4; ++i) { const unsigned w_ = (i == 0) ? hv.x : (i == 1) ? hv.y : (i == 2) ? hv.z : hv.w; r8[2 * i] = o8[2 * i] - __uint_as_float(w_ << 16); r8[2 * i + 1] = o8[2 * i + 1] - __uint_as_float(w_ & 0xffff0000u); }
                    LAS unsigned char* tp = L3 + (bi * 8 + wv) * 2064 + c0 * 2;
                    *(LAS u32x4*)tp = hv; *(LAS u32x4*)(tp + 66048) = (u32x4){pk2(r8[0], r8[1]), pk2(r8[2], r8[3]), pk2(r8[4], r8[5]), pk2(r8[6], r8[7])}; } } } }
        if (ROUTER) {
            __syncthreads();
            const int n32 = lane & 31, hh = lane >> 5;
            f32x16 acc;
#pragma unroll
            for (int r = 0; r < 16; ++r) acc[r] = 0.f;
            { const bf16_t* bh = WSP(bf16_t, O_RWT) + ((size_t)(l * 2) * NE + n32) * D_ + 128 * wv + 8 * hh; const bf16_t* bl = bh + (size_t)NE * D_;
              const LAS unsigned char* ah = L3 + n32 * 2064 + (128 * wv + 8 * hh) * 2;
              bf16x8 bhf[8], blf[8];
#pragma unroll
              for (int s_ = 0; s_ < 8; ++s_) { bhf[s_] = *(const bf16x8*)(bh + 16 * s_); blf[s_] = *(const bf16x8*)(bl + 16 * s_); }
#pragma unroll
              for (int s_ = 0; s_ < 8; ++s_) { const bf16x8 xh = *(const LAS bf16x8*)(ah + 32 * s_), xl = *(const LAS bf16x8*)(ah + 66048 + 32 * s_);
                  acc = __builtin_amdgcn_mfma_f32_32x32x16_bf16(xh, bhf[s_], acc, 0, 0, 0); acc = __builtin_amdgcn_mfma_f32_32x32x16_bf16(xh, blf[s_], acc, 0, 0, 0); acc = __builtin_amdgcn_mfma_f32_32x32x16_bf16(xl, bhf[s_], acc, 0, 0, 0); } }
            __syncthreads();
            { LAS float* red = (LAS float*)L3;
#pragma unroll
              for (int r = 0; r < 16; ++r) red[(wv * 32 + CROW(r, hh)) * 32 + n32] = acc[r];
              __syncthreads();
#pragma unroll
              for (int bi = 0; bi < NB; ++bi) { const int m = bi * 8 + wv; float sm = 0.f;
#pragma unroll
                  for (int q = 0; q < 4; ++q) sm += red[((hh * 4 + q) * 32 + m) * 32 + n32];
                  sm += __shfl_xor(sm, 32);
                  if (lane < 32) lgl[(NB * oi + bi) * 32 + n32] = sm; } }
            __syncthreads();
        }
    }
    if (ROUTER) {
        const float* rb = p->in.rb + (size_t)l * NE;
        int nrow = 0; for (int r_ = fbid() * 8 + wv; r_ < T_; r_ += (int)gridDim.x * 8) { ++nrow; asm volatile("" : "+s"(nrow)); }
        asm volatile("s_waitcnt lgkmcnt(0)" ::: "memory");
        int* lcnt = (int*)(lds + 33024 + 8 * 256);
        if (ftid() < NE) lcnt[ftid()] = 0;
        __syncthreads();
#pragma unroll 1
        for (int ri = 0; ri < nrow; ++ri) { const int row = fbid() * 8 + wv + ri * (int)gridDim.x * 8;
            const int e = lane & 31; const float lg = lgl[ri * 32 + e] + rb[e];
            float cur = lg, tv0 = 0.f, den = 0.f, myw = 0.f; int mye = 0;
#pragma unroll
            for (int k = 0; k < TOPK; ++k) { float bv = cur; int bi = e;
#pragma unroll
                for (int o = 16; o >= 1; o >>= 1) { const float ov = __shfl_xor(bv, o); const int oi = __shfl_xor(bi, o); if (ov > bv || (ov == bv && oi < bi)) { bv = ov; bi = oi; } }
                if (k == 0) tv0 = bv;
                const float w = __expf(bv - tv0); den += w;
                if (lane == k) { mye = bi; myw = w; }
                if (e == bi) cur = -3.4e38f; }
            if (lane < TOPK) { WSP(int, O_TOPE)[row * TOPK + lane] = mye; WSP(float, O_TOPW)[row * TOPK + lane] = myw / den; WSP(int, O_POS)[row * TOPK + lane] = atomicAdd(&lcnt[mye], 1); } }
        __syncthreads();
        if (ftid() < NE) { const int c = lcnt[ftid()]; lcnt[ftid()] = (c > 0) ? atomicAdd(WSP(int, O_COUNTS) + CNT_IDX(l, ftid()) + cnt_off, c) : 0; }
        __syncthreads();
#pragma unroll 1
        for (int ri = 0; ri < nrow; ++ri) { const int row = fbid() * 8 + wv + ri * (int)gridDim.x * 8;
            if (lane < TOPK) WSP(int, O_POS)[row * TOPK + lane] += lcnt[WSP(int, O_TOPE)[row * TOPK + lane]]; }
        __syncthreads();
    }
}
__device__ __forceinline__ void ph_bias1_reduce(KP p, int l) {
    if (fbid() != (int)gridDim.x - 1) return;
    const int tid = ftid(); if (tid < 256) { const float* pp = WSP(float, O_BIAS1P) + ((size_t)(l * 2 + (tid >> 7)) * 64) * 128 + (tid & 127);
        float v[64];
#pragma unroll
        for (int s = 0; s < 64; ++s) v[s] = pp[s * 128];
        float a = 0.f;
#pragma unroll
        for (int s = 0; s < 64; ++s) a += v[s];
        WSP(float, O_BIAS1)[l * 256 + tid] = a; }
}
__device__ __forceinline__ void ph_cumsum(float* lds, KP p, int blk0) {
    const int tid = ftid(), lane = tid & 63, wv = tid >> 6; const int bh = fbid() - blk0;
    if (bh < 0 || bh >= B_ * 4) return;
    const int b = bh >> 2, h = bh & 3; const float* gf = WSP(float, O_GF) + (size_t)(b * S_ + tid * 16) * 32 + 24 + h;
    float v[16], run = 0.f;
#pragma unroll
    for (int i = 0; i < 16; ++i) { run += gf[(size_t)i * 32]; v[i] = run; }
    float inc = run;
#pragma unroll
    for (int o = 1; o < 64; o <<= 1) { const float t = __shfl_up(inc, o); if (lane >= o) inc += t; }
    if (lane == 63) lds[wv] = inc;
    __syncthreads();
    float woff = 0.f;
#pragma unroll
    for (int i = 0; i < 8; ++i) woff += (i < wv) ? lds[i] : 0.f;
    const float off = woff + inc - run; float* c = WSP(float, O_CFOX) + (size_t)bh * S_ + tid * 16;
#pragma unroll
    for (int i = 0; i < 4; ++i) *(f32x4*)(c + 4 * i) = (f32x4){v[4 * i] + off, v[4 * i + 1] + off, v[4 * i + 2] + off, v[4 * i + 3] + off};
    __syncthreads();
}
__device__ __forceinline__ void ph_prep2(float* lds, KP p, int l) {
    { unsigned* kmax2 = WSP(unsigned, O_COUNTS) + 192 + l * 8;
      for (int i = fbid() * NT + ftid(); i < B_ * 4 * S_ * 2; i += gridDim.x * NT) { const int half = i & 1, t = (i >> 1) % S_, bh = (i >> 1) / S_, b = bh >> 2, h = bh & 3;
          const bf16_t* kr = WSP(bf16_t, O_PROJB) + (size_t)(b * S_ + t) * PB + C_FOX + (4 + h) * 64 + half * 32; float ss = 0.f;
#pragma unroll
          for (int c = 0; c < 4; ++c) { float k8[8]; ld8(kr + 8 * c, k8);
#pragma unroll
              for (int e = 0; e < 8; ++e) ss += k8[e] * k8[e]; }
          ss += __shfl_xor(ss, 1);
#pragma unroll
          for (int o = 2; o < 64; o <<= 1) ss = fmaxf(ss, __shfl_xor(ss, o));
          __syncthreads();
          if ((ftid() & 63) == 0) lds[ftid() >> 6] = ss;
          __syncthreads();
          if (ftid() == 0) { float mx = lds[0];
#pragma unroll
              for (int w_ = 1; w_ < 8; ++w_) mx = fmaxf(mx, lds[w_]);
              atomicMax(kmax2 + bh, __float_as_uint(mx)); } } }
    for (int i = fbid() * NT + ftid(); i < 8 * 512 * 64; i += gridDim.x * NT) {
        const int d = i & 63, n = (i >> 6) & 511, combo = i >> 15, kv = combo & 1, bg = combo >> 1;
        const float* w2 = (kv ? p->in.w2v : p->in.w2k) + (size_t)l * 128 * 64; const float* h0 = WSP(float, O_HIDP) + ((size_t)combo * 512 + n) * 128; const float* h1 = h0 + (size_t)8 * 512 * 128;
        const float* b1 = WSP(float, O_BIAS1) + l * 256 + kv * 128;
        __syncthreads();
#pragma unroll
        for (int q = 0; q < 4; ++q) *(f32x4*)(lds + 16 + 4 * (q * NT + ftid())) = *(const f32x4*)(w2 + 4 * (q * NT + ftid()));
        const float hv0 = gelu_tanh(h0[d] + h1[d] + b1[d]), hv1 = gelu_tanh(h0[64 + d] + h1[64 + d] + b1[64 + d]);
        __syncthreads();
        const float* w2s = lds + 16 + d;
        float a = 0.f;
#pragma unroll 16
        for (int c = 0; c < 64; ++c) a += __int_as_float(__builtin_amdgcn_readlane(__float_as_int(hv0), c)) * w2s[c * 64];
#pragma unroll 16
        for (int c = 0; c < 64; ++c) a += __int_as_float(__builtin_amdgcn_readlane(__float_as_int(hv1), c)) * w2s[(64 + c) * 64];
        (kv ? WSP(bf16_t, O_VCMPB) : WSP(bf16_t, O_KCMPB))[((size_t)bg * 512 + n) * 64 + d] = (n < NCMP) ? (bf16_t)f2bf(a) : (bf16_t)0; }
}
__device__ __forceinline__ void ph_moe_scatter2(float* lds, KP p, int l) {
    const int tid = ftid(); int* ts = (int*)lds;
    const int* counts = WSP(int, O_COUNTS) + CNT_IDX(l, 0); int* meta = WSP(int, O_META); int* cl = ts + 64;
    __syncthreads();
    if (tid < NE) cl[tid] = counts[tid * 32];
    __syncthreads();
    if (tid == 0) { int nt = 0; for (int e = 0; e < NE; ++e) { ts[e] = nt; nt += (cl[e] + 255) >> 8; } ts[32] = nt; }
    __syncthreads();
    if (fbid() == 0) { if (tid < NE) { const int c = cl[tid], t0 = ts[tid]; meta[tid] = t0; for (int r = 0, t = t0; r < c; r += 256, ++t) { meta[64 + 2 * t] = tid; meta[65 + 2 * t] = (c - r) < 256 ? (c - r) : 256; } }
        if (tid == 0) meta[32] = ts[32]; }
    for (int i = fbid() * NT + tid; i < MROWS; i += gridDim.x * NT) {
        const int row = ts[WSP(int, O_TOPE)[i]] * 256 + WSP(int, O_POS)[i];
        WSP(int, O_ROWTOK)[row] = i >> 2; WSP(float, O_ROWW)[row] = WSP(float, O_TOPW)[i]; WSP(int, O_SLOT)[i] = row; }
    __syncthreads();
}
}
namespace mk {
typedef short bf16x8 __attribute__((ext_vector_type(8)));
typedef float f32x16 __attribute__((ext_vector_type(16)));
typedef float f32x2_t __attribute__((ext_vector_type(2)));
typedef __bf16 bf16x2_t __attribute__((ext_vector_type(2)));
typedef unsigned u32x2 __attribute__((ext_vector_type(2)));
typedef short v4i16_t __attribute__((ext_vector_type(4)));
__device__ __forceinline__ unsigned cvtpk(float lo, float hi) { f32x2_t v = {lo, hi}; bf16x2_t b = __builtin_convertvector(v, bf16x2_t); return __builtin_bit_cast(unsigned, b); }
constexpr int KROW = 144, VROW = 136;
constexpr int E1_K = 0, E1_V = 64 * KROW, E1_C = E1_V + 64 * KROW, E1_BUF = E1_C + 256;
constexpr int E1_FLAGS = 2 * E1_BUF;
constexpr float LOG2E = 1.4426950408889634f;
constexpr float RESC_THR = 8.0f;
#define CROW(reg, hh) (((reg) & 3) + 8 * ((reg) >> 2) + 4 * (hh))

__device__ __forceinline__ float max3f(float a, float b, float c) { float r; asm("v_max3_f32 %0, %1, %2, %3" : "=v"(r) : "v"(a), "v"(b), "v"(c)); return r; }
typedef float f32x2_t __attribute__((ext_vector_type(2)));
#define SM_V(p0, p1, i_) (((i_) & 1) ? p1[(i_) >> 1] : p0[(i_) >> 1])
#define SM_ROWMAX(p0, p1, rm_) do { \
    rm_ = max3f(p0[0], p1[0], p0[1]); \
    _Pragma("unroll") for (int k_ = 0; k_ < 14; ++k_) rm_ = max3f(rm_, SM_V(p0, p1, 3 + 2 * k_), SM_V(p0, p1, 4 + 2 * k_)); \
    rm_ = max3f(rm_, p1[15], p1[15]); \
    { const float x_ = __shfl_xor(rm_, 32); rm_ = max3f(rm_, x_, x_); } } while (0)
#define SM_CORE(p0, p1, m, l, have, o0, o1) do { \
    float rm_; SM_ROWMAX(p0, p1, rm_); \
    const bool fin_ = rm_ > -1e37f; \
    if (__any((rm_ > RESC_THR) || (!have && fin_))) { \
        const float dl_ = have ? fmaxf(rm_, 0.f) : (fin_ ? rm_ : 0.f); const float al_ = have ? __builtin_amdgcn_exp2f(-dl_) : 1.f; \
        m += dl_; l *= al_; have = have || fin_; \
        _Pragma("unroll") for (int r_ = 0; r_ < 16; ++r_) { o0[r_] *= al_; o1[r_] *= al_; p0[r_] -= dl_; p1[r_] -= dl_; } } \
    f32x2_t ls2_ = {0.f, 0.f}; \
    _Pragma("unroll") for (int reg_ = 0; reg_ < 16; reg_ += 2) { \
        p0[reg_] = __builtin_amdgcn_exp2f(p0[reg_]); p0[reg_ + 1] = __builtin_amdgcn_exp2f(p0[reg_ + 1]); p1[reg_] = __builtin_amdgcn_exp2f(p1[reg_]); p1[reg_ + 1] = __builtin_amdgcn_exp2f(p1[reg_ + 1]); \
        ls2_ += (f32x2_t){p0[reg_], p0[reg_ + 1]}; ls2_ += (f32x2_t){p1[reg_], p1[reg_ + 1]}; } \
    l += ls2_.x + ls2_.y; } while (0)

struct E1Geom { int b, q0, h; const bf16_t* qp; const bf16_t* kp; const bf16_t* vp; size_t pitch; };

template <int KIND>
__device__ __forceinline__ void e1_unit(LAS unsigned char* lds, KP p, int b, int hg, int qb, bf16_t* __restrict__ obase, bf16_t* __restrict__ owin, const unsigned* __restrict__ kmax2) {
    const int tid = ftid(), lane = tid & 63, w = __builtin_amdgcn_readfirstlane(tid >> 6), r32 = lane & 31, hh = lane >> 5;
    const bf16_t* projb = WSP(bf16_t, O_PROJB);
    int h, q0, qrow0, qcol, kcol, vcol, nrows;
    if (KIND == 0) { h = hg; q0 = qb * 256; qrow0 = q0 + 32 * w; qcol = C_FOX + h * 64; kcol = C_FOX + (4 + h) * 64; vcol = C_FOX + (8 + h) * 64; nrows = 256; }
    else if (KIND == 2) { h = hg; q0 = qb * 256; qrow0 = q0 + 32 * w; qcol = C_SB + h * 64; kcol = C_SB + (4 + h) * 64; vcol = C_SB + (8 + h) * 64; nrows = 256; }
    else { h = 4 * hg + (w & 3); q0 = qb * 64; qrow0 = q0 + 32 * (w >> 2); qcol = h * 64; kcol = C_KV + ((2 * 2 + 0) * 2 + hg) * 64; vcol = C_KV + ((2 * 2 + 1) * 2 + hg) * 64; nrows = 64; }
    const int tq = qrow0 + r32;
    const bf16_t* kbase = projb + (size_t)(b * S_) * PB + kcol; const bf16_t* vbase = projb + (size_t)(b * S_) * PB + vcol;
    bf16x8 qf[4];
    { const bf16_t* qptr = projb + (size_t)(b * S_ + tq) * PB + qcol + 8 * hh;
#pragma unroll
      for (int d0 = 0; d0 < 4; ++d0) qf[d0] = *(const bf16x8*)(qptr + 16 * d0);
      if (KIND == 1) {
#pragma unroll
          for (int d0 = 0; d0 < 4; ++d0) { u32x4 w_;
#pragma unroll
              for (int e2 = 0; e2 < 4; ++e2) { const float lo_ = bf2f((unsigned short)qf[d0][2 * e2]) * (SCALE * LOG2E), hi_ = bf2f((unsigned short)qf[d0][2 * e2 + 1]) * (SCALE * LOG2E); w_[e2] = cvtpk(lo_, hi_); }
              qf[d0] = __builtin_bit_cast(bf16x8, w_); } } }
    int j0 = 0; const int j1 = (q0 + nrows - 1) >> 6;
    if (KIND == 1) { j0 = (q0 - 511) >> 6; if (j0 < 0) j0 = 0; }
    const int ntile = j1 - j0 + 1;
    float ct2 = 0.f, sl2 = 0.f; const float* cb = nullptr;
    if (KIND == 0) { cb = WSP(float, O_CFOX) + (size_t)(b * 4 + h) * S_; ct2 = cb[tq] * LOG2E; }
    if (KIND == 1) sl2 = exp2f(-(float)(h + 1)) * LOG2E;
    bf16x8 kx0 = {0, 0, 0, 0, 0, 0, 0, 0}, kx1 = {0, 0, 0, 0, 0, 0, 0, 0}; float sl2h = 0.f, sl2l = 0.f;
    if (KIND == 1) { const unsigned one_ = 0x3f80u; const unsigned k0_ = f2bf((float)r32), k1_ = f2bf((float)(r32 + 32));
        if (hh == 0) { kx0 = __builtin_bit_cast(bf16x8, (u32x4){k0_ | (k0_ << 16), one_ | (one_ << 16), one_, 0u}); kx1 = __builtin_bit_cast(bf16x8, (u32x4){k1_ | (k1_ << 16), one_ | (one_ << 16), one_, 0u}); }
        sl2h = bf2f((unsigned short)f2bf(sl2)); sl2l = sl2 - sl2h; }
    float qkb = 0.f;
    if (KIND == 0) { float qs = 0.f;
#pragma unroll
        for (int d0 = 0; d0 < 4; ++d0)
#pragma unroll
            for (int e = 0; e < 8; ++e) { const float x = bf2f((unsigned short)qf[d0][e]); qs += x * x; }
        qs += __shfl_xor(qs, 32);
        const float km2 = __uint_as_float(kmax2[b * 4 + h]);
        qkb = sqrtf(qs * km2) * (SCALE * LOG2E * 1.01f); }
    const float tqf = (float)tq;
    const int skey = tid >> 3, sch = tid & 7;
    u32x4 rk, rv; float rc = 0.f;
#define E1_LOAD(jj) do { const size_t ro_ = (size_t)((jj) * 64 + skey) * PB + sch * 8; rk = *(const u32x4*)(kbase + ro_); rv = *(const u32x4*)(vbase + ro_); \
        if (KIND == 0 && tid < 64) rc = cb[(jj) * 64 + tid] * LOG2E; } while (0)
#define E1_WRITE(bufp) do { *(LAS u32x4*)((bufp) + E1_K + skey * KROW + sch * 16) = rk; *(LAS u32x4*)((bufp) + E1_V + skey * KROW + sch * 16) = rv; \
        if (KIND == 0 && tid < 64) ((LAS float*)((bufp) + E1_C))[tid] = rc; } while (0)
    f32x16 o0, o1;
#pragma unroll
    for (int r = 0; r < 16; ++r) { o0[r] = 0.f; o1[r] = 0.f; }
    float m = 0.f, l = 0.f, carry = 0.f; bool have = false;
    bool wave_done = false;
    LAS unsigned* flags = (LAS unsigned*)(lds + E1_FLAGS);
    if (KIND != 1) { if (tid < 8) flags[tid] = 0u; }
    __syncthreads();
    E1_LOAD(KIND != 1 ? j1 : j0);
    for (int it = 0; it < ntile; ++it) {
        const int j = (KIND != 1) ? (j1 - it) : (j0 + it);
        LAS unsigned char* buf = lds + (it & 1) * E1_BUF;
        E1_WRITE(buf);
        __syncthreads();
        if (KIND != 1) { unsigned alld = 1u;
#pragma unroll
            for (int i = 0; i < 8; ++i) alld &= flags[i];
            if (alld) break; }
        if (it + 1 < ntile) E1_LOAD((KIND != 1) ? (j - 1) : (j + 1));
        if (!(KIND != 1 && wave_done)) {
            f32x16 p0, p1;
#pragma unroll
            for (int r = 0; r < 16; ++r) { p0[r] = 0.f; p1[r] = 0.f; }
            { const LAS unsigned char* kp_ = buf + E1_K + r32 * KROW + hh * 16;
#pragma unroll
              for (int d0 = 0; d0 < 4; ++d0) { const bf16x8 a0 = *(const LAS bf16x8*)(kp_ + d0 * 32), a1 = *(const LAS bf16x8*)(kp_ + 32 * KROW + d0 * 32);
                  p0 = __builtin_amdgcn_mfma_f32_32x32x16_bf16(a0, qf[d0], p0, 0, 0, 0); p1 = __builtin_amdgcn_mfma_f32_32x32x16_bf16(a1, qf[d0], p1, 0, 0, 0); } }
            const int kb = j * 64 + 4 * hh;
            if (KIND == 2) {
                float lk0[16], lk1[16], gs[8];
#pragma unroll
                for (int reg = 0; reg < 16; ++reg) { const int kpos = kb + CROW(reg, 0);
                    const float z0 = p0[reg] * SCALE, z1 = p1[reg] * SCALE; const bool v0 = kpos < tq, v1 = kpos + 32 < tq;
                    const float lb0 = fminf(z0, 0.f) - __logf(1.f + __expf(-fabsf(z0))), lb1 = fminf(z1, 0.f) - __logf(1.f + __expf(-fabsf(z1)));
                    lk0[reg] = v0 ? (lb0 - z0) : 0.f; lk1[reg] = v1 ? (lb1 - z1) : 0.f;
                    p0[reg] = v0 ? lb0 : -INFINITY; p1[reg] = v1 ? lb1 : -INFINITY; }
#pragma unroll
                for (int g4 = 0; g4 < 4; ++g4) { gs[g4] = (lk0[4 * g4] + lk0[4 * g4 + 1]) + (lk0[4 * g4 + 2] + lk0[4 * g4 + 3]); gs[4 + g4] = (lk1[4 * g4] + lk1[4 * g4 + 1]) + (lk1[4 * g4 + 2] + lk1[4 * g4 + 3]); }
                float oth[8];
#pragma unroll
                for (int gi = 0; gi < 8; ++gi) oth[gi] = __shfl_xor(gs[gi], 32);
                float run = 0.f;
#pragma unroll
                for (int gi = 7; gi >= 0; --gi) {
                    float later = carry + run + (hh == 0 ? oth[gi] : 0.f);
#pragma unroll
                    for (int e = 3; e >= 0; --e) { const int reg = (gi & 3) * 4 + e;
                        if (gi >> 2) { p1[reg] = __expf(p1[reg] + later); later += lk1[reg]; } else { p0[reg] = __expf(p0[reg] + later); later += lk0[reg]; } }
                    run += gs[gi] + oth[gi]; }
                carry += run;
            } else {
                if (KIND == 0) {
                    const LAS float* cs = (const LAS float*)(buf + E1_C) + 4 * hh; const float ctm = ct2 - m;
#pragma unroll
                    for (int i = 0; i < 4; ++i) { const f32x4 c0 = *(const LAS f32x4*)(cs + 8 * i), c1 = *(const LAS f32x4*)(cs + 32 + 8 * i);
#pragma unroll
                        for (int e = 0; e < 4; ++e) { const int reg = 4 * i + e; p0[reg] = p0[reg] * (SCALE * LOG2E) + (ctm - c0[e]); p1[reg] = p1[reg] * (SCALE * LOG2E) + (ctm - c1[e]); } }
                    if (!(j * 64 + 63 <= qrow0)) {
#pragma unroll
                        for (int reg = 0; reg < 16; ++reg) { const int kpos = kb + CROW(reg, 0); p0[reg] = (kpos <= tq) ? p0[reg] : -INFINITY; p1[reg] = (kpos + 32 <= tq) ? p1[reg] : -INFINITY; } }
                } else {
                    { const float r_ = sl2 * ((float)(j * 64) - tqf) - m; const float rh_ = bf2f((unsigned short)f2bf(r_)), rm2_ = bf2f((unsigned short)f2bf(r_ - rh_)), rl_ = (r_ - rh_) - rm2_;
                      u32x4 qx_ = {0u, 0u, 0u, 0u}; if (hh == 0) qx_ = (u32x4){cvtpk(sl2h, sl2l), cvtpk(rh_, rm2_), cvtpk(rl_, 0.f), 0u};
                      const bf16x8 qx = __builtin_bit_cast(bf16x8, qx_);
                      p0 = __builtin_amdgcn_mfma_f32_32x32x16_bf16(kx0, qx, p0, 0, 0, 0); p1 = __builtin_amdgcn_mfma_f32_32x32x16_bf16(kx1, qx, p1, 0, 0, 0); }
                    if (!(j * 64 + 63 <= qrow0 && qrow0 + 31 - j * 64 < 512)) {
#pragma unroll
                        for (int reg = 0; reg < 16; ++reg) { const int kpos = kb + CROW(reg, 0);
                            p0[reg] = (kpos <= tq && tq - kpos < 512) ? p0[reg] : -INFINITY; p1[reg] = (kpos + 32 <= tq && tq - kpos - 32 < 512) ? p1[reg] : -INFINITY; } }
                }
                SM_CORE(p0, p1, m, l, have, o0, o1);
            }
            { const int gq_ = lane >> 4, li_ = lane & 15;
              const LAS unsigned char* tb = buf + E1_V + (4 * hh + (li_ >> 2)) * KROW + (16 * (gq_ & 1) + 4 * (li_ & 3)) * 2;
#pragma unroll
              for (int s = 0; s < 4; ++s) {
                  u32x4 pw;
                  if (s < 2) { pw.x = cvtpk(p0[8 * s + 0], p0[8 * s + 1]); pw.y = cvtpk(p0[8 * s + 2], p0[8 * s + 3]); pw.z = cvtpk(p0[8 * s + 4], p0[8 * s + 5]); pw.w = cvtpk(p0[8 * s + 6], p0[8 * s + 7]); }
                  else { const int s2 = s - 2; pw.x = cvtpk(p1[8 * s2 + 0], p1[8 * s2 + 1]); pw.y = cvtpk(p1[8 * s2 + 2], p1[8 * s2 + 3]); pw.z = cvtpk(p1[8 * s2 + 4], p1[8 * s2 + 5]); pw.w = cvtpk(p1[8 * s2 + 6], p1[8 * s2 + 7]); }
                  const bf16x8 pb = __builtin_bit_cast(bf16x8, pw);
                  const v4i16_t a0l = __builtin_amdgcn_ds_read_tr16_b64_v4i16((LAS v4i16_t*)(tb + (16 * s) * KROW)), a0h = __builtin_amdgcn_ds_read_tr16_b64_v4i16((LAS v4i16_t*)(tb + (16 * s + 8) * KROW));
                  const v4i16_t a1l = __builtin_amdgcn_ds_read_tr16_b64_v4i16((LAS v4i16_t*)(tb + (16 * s) * KROW + 64)), a1h = __builtin_amdgcn_ds_read_tr16_b64_v4i16((LAS v4i16_t*)(tb + (16 * s + 8) * KROW + 64));
                  const bf16x8 va0 = (bf16x8){a0l[0], a0l[1], a0l[2], a0l[3], a0h[0], a0h[1], a0h[2], a0h[3]}, va1 = (bf16x8){a1l[0], a1l[1], a1l[2], a1l[3], a1h[0], a1h[1], a1h[2], a1h[3]};
                  o0 = __builtin_amdgcn_mfma_f32_32x32x16_bf16(va0, pb, o0, 0, 0, 0); o1 = __builtin_amdgcn_mfma_f32_32x32x16_bf16(va1, pb, o1, 0, 0, 0); } }
            if (KIND == 0) {
                const float c0 = *(const LAS float*)(buf + E1_C); const bool dn = __all(have && (qkb + (ct2 - c0) - m < -150.f));
                if (dn && !wave_done) { wave_done = true; if (lane == 0) flags[w] = 1u; } }
            if (KIND == 2) { const bool dn = __all(carry < -110.f);
                if (dn && !wave_done) { wave_done = true; if (lane == 0) flags[w] = 1u; } }
        }
    }
    float inv = 1.f, gate = 1.f;
    if (KIND != 2) { l += __shfl_xor(l, 32); inv = (l > 0.f) ? 1.f / l : 0.f; }
    bf16_t* orow;
    if (KIND == 0) orow = obase + (size_t)(b * S_ + tq) * D_ + 512 + h * 64;
    else if (KIND == 2) orow = obase + (size_t)(b * S_ + tq) * D_ + 768 + h * 64;
    else { orow = owin + (size_t)(b * S_ + tq) * 512 + h * 64; gate = WSP(float, O_GF)[(size_t)(b * S_ + tq) * 32 + 2 * 8 + h]; }
    const float sc = inv * gate;
#pragma unroll
    for (int i = 0; i < 4; ++i) {
        *(u32x2*)(orow + 8 * i + 4 * hh) = (u32x2){cvtpk(o0[4 * i] * sc, o0[4 * i + 1] * sc), cvtpk(o0[4 * i + 2] * sc, o0[4 * i + 3] * sc)};
        *(u32x2*)(orow + 32 + 8 * i + 4 * hh) = (u32x2){cvtpk(o1[4 * i] * sc, o1[4 * i + 1] * sc), cvtpk(o1[4 * i + 2] * sc, o1[4 * i + 3] * sc)}; }
#undef E1_LOAD
#undef E1_WRITE
}
}
namespace mk {
constexpr int E2_VT = 64 * 128;
constexpr int E2_WAVE = 2 * E2_VT + 512 + 128;
template <bool USE_MASK>
__device__ __forceinline__ void e2_wave_unit(LAS unsigned char* ldsw, KP p, int b, int g, int t0, bf16_t* __restrict__ obase, const bf16_t* __restrict__ csrc, int cpitch) {
    const int lane = ftid() & 63, r32 = lane & 31, hh = lane >> 5, qi = r32 >> 2, r4 = r32 & 3;
    const int h = 4 * g + r4, tq = t0 + qi;
    const bf16_t* projb = WSP(bf16_t, O_PROJB);
    const bf16_t* kbase = projb + (size_t)(b * S_) * PB + C_KV + ((1 * 2 + 0) * 2 + g) * 64;
    const bf16_t* vbase = projb + (size_t)(b * S_) * PB + C_KV + ((1 * 2 + 1) * 2 + g) * 64;
    bf16x8 qf[4];
    { const bf16_t* qptr = projb + (size_t)(b * S_ + tq) * PB + h * 64 + 8 * hh;
#pragma unroll
      for (int d0 = 0; d0 < 4; ++d0) qf[d0] = *(const bf16x8*)(qptr + 16 * d0); }
    unsigned qm0 = 0u, qm1 = 0u, qm2 = 0u, qm3 = 0u;
    if (USE_MASK) { const u32x4 mw = *(const u32x4*)(WSP(unsigned, O_SELMASK) + ((size_t)((b * 2 + g) * S_ + t0 + (lane >> 3))) * 4); qm0 = mw.x; qm1 = mw.y; qm2 = mw.z; qm3 = mw.w; }
    else { const int* sp = WSP(int, O_SEL) + ((size_t)((b * 2 + g) * S_ + t0)) * NSEL + lane * 2;
      const int e0 = sp[0], e1 = sp[1];
#pragma unroll
      for (int k = 0; k < 2; ++k) { const int e = k ? e1 : e0; const unsigned bit = 1u << (e & 31); const int wd = e >> 5;
          qm0 |= (wd == 0) ? bit : 0u; qm1 |= (wd == 1) ? bit : 0u; qm2 |= (wd == 2) ? bit : 0u; qm3 |= (wd == 3) ? bit : 0u; }
#pragma unroll
      for (int o = 1; o < 8; o <<= 1) { qm0 |= __shfl_xor(qm0, o); qm1 |= __shfl_xor(qm1, o); qm2 |= __shfl_xor(qm2, o); qm3 |= __shfl_xor(qm3, o); } }
    unsigned um0 = qm0, um1 = qm1, um2 = qm2, um3 = qm3;
#pragma unroll
    for (int o = 8; o < 64; o <<= 1) { um0 |= __shfl_xor(um0, o); um1 |= __shfl_xor(um1, o); um2 |= __shfl_xor(um2, o); um3 |= __shfl_xor(um3, o); }
    LAS int* list = (LAS int*)(ldsw + 2 * E2_VT);
    LAS unsigned* rowml = (LAS unsigned*)(ldsw + 2 * E2_VT + 512);
    if ((lane & 7) == 0) *(LAS u32x4*)(rowml + (lane >> 3) * 4) = (u32x4){qm0, qm1, qm2, qm3};
    const LAS unsigned* rowm = rowml + qi * 4;
    int nblk;
    const int curq = __builtin_amdgcn_readfirstlane(t0 >> 6);
    bool diag;
    { const bool s0 = ((((lane < 32) ? um0 : um1) >> (lane & 31)) & 1u) && lane <= curq, s1 = ((((lane < 32) ? um2 : um3) >> (lane & 31)) & 1u) && lane + 64 <= curq;
      const unsigned long long b0 = __ballot(s0), b1 = __ballot(s1);
      const unsigned long long lower = (lane == 0) ? 0ull : (~0ull >> (64 - lane));
      const int n0 = __popcll(b0);
      if (s0) list[__popcll(b0 & lower)] = lane;
      if (s1) list[n0 + __popcll(b1 & lower)] = lane + 64;
      nblk = n0 + __popcll(b1); diag = (((curq < 64) ? (b0 >> curq) : (b1 >> (curq - 64))) & 1ull) != 0ull; }
    const int nfull = nblk - (diag ? 1 : 0);
    asm volatile("s_waitcnt lgkmcnt(0)" ::: "memory");
    const float sl2 = exp2f(-(float)(h + 1)) * LOG2E, tqf = (float)tq;
    f32x16 o0, o1;
#pragma unroll
    for (int r = 0; r < 16; ++r) { o0[r] = 0.f; o1[r] = 0.f; }
    float m = 0.f, l = 0.f; bool have = false;
    const int vrow = lane >> 3, vch = lane & 7;
    const int gq = lane >> 4, li = lane & 15;
    const LAS unsigned char* trb = ldsw + (4 * hh + (li >> 2)) * 128 + (16 * (gq & 1) + 4 * (li & 3)) * 2;
    bf16x8 ka0[4], ka1[4], kb0[4], kb1[4];
#define E2_LOADK(blk, k0_, k1_) do { const bf16_t* kp_ = kbase + (size_t)((blk) * 64 + r32) * PB + 8 * hh; \
        _Pragma("unroll") for (int d0 = 0; d0 < 4; ++d0) { k0_[d0] = *(const bf16x8*)(kp_ + 16 * d0); k1_[d0] = *(const bf16x8*)(kp_ + (size_t)32 * PB + 16 * d0); } } while (0)
#define E2_VDMA(blk, vb_) do { const bf16_t* vp_ = vbase + (size_t)((blk) * 64 + vrow) * PB + vch * 8; \
        _Pragma("unroll") for (int i = 0; i < 8; ++i) __builtin_amdgcn_global_load_lds((const unsigned*)(vp_ + (size_t)(8 * i) * PB), (LAS unsigned*)((vb_) + i * 1024), 16, 0, 0); } while (0)
    { const int b0_ = __builtin_amdgcn_readfirstlane(list[0]);
      E2_VDMA(b0_, ldsw); E2_LOADK(b0_, ka0, ka1);
      { const int b1_ = __builtin_amdgcn_readfirstlane(list[(nblk > 1) ? 1 : 0]); E2_LOADK(b1_, kb0, kb1); } }
    int it = 0;
    auto body = [&](auto mtag_, auto ptag_) __attribute__((always_inline)) {
        constexpr bool MASKED_ = decltype(mtag_)::value; constexpr bool PAR_ = decltype(ptag_)::value;
        const int cur = __builtin_amdgcn_readfirstlane(list[it]);
        const unsigned rw = rowm[cur >> 5];
        LAS unsigned char* vcur = ldsw + (PAR_ ? E2_VT : 0); LAS unsigned char* voth = ldsw + (PAR_ ? 0 : E2_VT);
        { const int nb_ = __builtin_amdgcn_readfirstlane(list[(it + 1 < nblk) ? it + 1 : nblk - 1]); E2_VDMA(nb_, voth); }
        const int nb2_ = __builtin_amdgcn_readfirstlane(list[(it + 2 < nblk) ? it + 2 : nblk - 1]);
        f32x16 p0, p1;
#pragma unroll
        for (int r = 0; r < 16; ++r) { p0[r] = 0.f; p1[r] = 0.f; }
        if (PAR_) {
#pragma unroll
            for (int d0 = 0; d0 < 4; ++d0) { p0 = __builtin_amdgcn_mfma_f32_32x32x16_bf16(kb0[d0], qf[d0], p0, 0, 0, 0); p1 = __builtin_amdgcn_mfma_f32_32x32x16_bf16(kb1[d0], qf[d0], p1, 0, 0, 0); }
            asm volatile("" : "+v"(p0), "+v"(p1) :: "memory");
            E2_LOADK(nb2_, kb0, kb1);
        } else {
#pragma unroll
            for (int d0 = 0; d0 < 4; ++d0) { p0 = __builtin_amdgcn_mfma_f32_32x32x16_bf16(ka0[d0], qf[d0], p0, 0, 0, 0); p1 = __builtin_amdgcn_mfma_f32_32x32x16_bf16(ka1[d0], qf[d0], p1, 0, 0, 0); }
            asm volatile("" : "+v"(p0), "+v"(p1) :: "memory");
            E2_LOADK(nb2_, ka0, ka1);
        }
        const bool rowsel = (rw >> (cur & 31)) & 1u;
        const int kb = cur * 64 + 4 * hh;
        { const float basef = rowsel ? (sl2 * ((float)kb - tqf) - m) : -INFINITY, base1 = basef + 32.f * sl2;
#pragma unroll
          for (int reg = 0; reg < 16; ++reg) { p0[reg] = p0[reg] * (SCALE * LOG2E) + __builtin_fmaf(sl2, (float)CROW(reg, 0), basef); p1[reg] = p1[reg] * (SCALE * LOG2E) + __builtin_fmaf(sl2, (float)CROW(reg, 0), base1); } }
        if (MASKED_) {
#pragma unroll
            for (int reg = 0; reg < 16; ++reg) { const int kpos = kb + CROW(reg, 0); p0[reg] = (kpos <= tq) ? p0[reg] : -INFINITY; p1[reg] = (kpos + 32 <= tq) ? p1[reg] : -INFINITY; } }
        SM_CORE(p0, p1, m, l, have, o0, o1);
        asm volatile("s_waitcnt vmcnt(16)" ::: "memory");
        const LAS unsigned char* trv = trb + (PAR_ ? E2_VT : 0);
#pragma unroll
        for (int s = 0; s < 4; ++s) {
            u32x4 pw;
            if (s < 2) { pw.x = cvtpk(p0[8 * s + 0], p0[8 * s + 1]); pw.y = cvtpk(p0[8 * s + 2], p0[8 * s + 3]); pw.z = cvtpk(p0[8 * s + 4], p0[8 * s + 5]); pw.w = cvtpk(p0[8 * s + 6], p0[8 * s + 7]); }
            else { const int s2 = s - 2; pw.x = cvtpk(p1[8 * s2 + 0], p1[8 * s2 + 1]); pw.y = cvtpk(p1[8 * s2 + 2], p1[8 * s2 + 3]); pw.z = cvtpk(p1[8 * s2 + 4], p1[8 * s2 + 5]); pw.w = cvtpk(p1[8 * s2 + 6], p1[8 * s2 + 7]); }
            const bf16x8 pb = __builtin_bit_cast(bf16x8, pw);
            const v4i16_t a0l = __builtin_amdgcn_ds_read_tr16_b64_v4i16((LAS v4i16_t*)(trv + (16 * s) * 128)), a0h = __builtin_amdgcn_ds_read_tr16_b64_v4i16((LAS v4i16_t*)(trv + (16 * s + 8) * 128));
            const v4i16_t a1l = __builtin_amdgcn_ds_read_tr16_b64_v4i16((LAS v4i16_t*)(trv + (16 * s) * 128 + 64)), a1h = __builtin_amdgcn_ds_read_tr16_b64_v4i16((LAS v4i16_t*)(trv + (16 * s + 8) * 128 + 64));
            const bf16x8 va0 = (bf16x8){a0l[0], a0l[1], a0l[2], a0l[3], a0h[0], a0h[1], a0h[2], a0h[3]}, va1 = (bf16x8){a1l[0], a1l[1], a1l[2], a1l[3], a1h[0], a1h[1], a1h[2], a1h[3]};
            o0 = __builtin_amdgcn_mfma_f32_32x32x16_bf16(va0, pb, o0, 0, 0, 0); o1 = __builtin_amdgcn_mfma_f32_32x32x16_bf16(va1, pb, o1, 0, 0, 0); }
        asm volatile("" ::: "memory");
    };
    for (; it + 1 < nfull; it += 2) { body(std::false_type{}, std::false_type{}); ++it; body(std::false_type{}, std::true_type{}); --it; }
    if (it < nfull) { body(std::false_type{}, std::false_type{}); ++it; if (diag) body(std::true_type{}, std::true_type{}); }
    else if (diag) body(std::true_type{}, std::false_type{});
    asm volatile("s_waitcnt vmcnt(0)" ::: "memory");
#undef E2_LOADK
#undef E2_VDMA
    l += __shfl_xor(l, 32);
    const float sc = ((l > 0.f) ? 1.f / l : 0.f) * WSP(float, O_GF)[(size_t)(b * S_ + tq) * 32 + 1 * 8 + h];
    bf16_t* orow = obase + (size_t)(b * S_ + tq) * D_ + h * 64; const bf16_t* crow = csrc + (size_t)(b * S_ + tq) * cpitch + h * 64;
#pragma unroll
    for (int i = 0; i < 4; ++i) {
        const u32x2 c0 = *(const u32x2*)(crow + 8 * i + 4 * hh), c1 = *(const u32x2*)(crow + 32 + 8 * i + 4 * hh);
        const float x00 = __uint_as_float(c0.x << 16) + o0[4 * i] * sc, x01 = __uint_as_float(c0.x & 0xffff0000u) + o0[4 * i + 1] * sc, x02 = __uint_as_float(c0.y << 16) + o0[4 * i + 2] * sc, x03 = __uint_as_float(c0.y & 0xffff0000u) + o0[4 * i + 3] * sc;
        const float x10 = __uint_as_float(c1.x << 16) + o1[4 * i] * sc, x11 = __uint_as_float(c1.x & 0xffff0000u) + o1[4 * i + 1] * sc, x12 = __uint_as_float(c1.y << 16) + o1[4 * i + 2] * sc, x13 = __uint_as_float(c1.y & 0xffff0000u) + o1[4 * i + 3] * sc;
        *(u32x2*)(orow + 8 * i + 4 * hh) = (u32x2){cvtpk(x00, x01), cvtpk(x02, x03)}; *(u32x2*)(orow + 32 + 8 * i + 4 * hh) = (u32x2){cvtpk(x10, x11), cvtpk(x12, x13)}; }
}
template <bool USE_MASK>
__device__ __forceinline__ void ph_attn_sel2(LAS unsigned char* lds3, KP p, bf16_t* __restrict__ obase, const bf16_t* __restrict__ csrc, int cpitch) {
    const int w = __builtin_amdgcn_readfirstlane(ftid() >> 6);
    LAS unsigned char* ldsw = lds3 + w * E2_WAVE;
    MK_LOOP(u, 512) { const int bg = u & 3, qblk = u >> 2; e2_wave_unit<USE_MASK>(ldsw, p, bg >> 1, bg & 1, qblk * 64 + 8 * w, obase, csrc, cpitch); }
}
}
namespace mk {
constexpr int E3_K = 0, E3_V = 512 * KROW, E3_BYTES = 2 * 512 * KROW;
__device__ __forceinline__ void e3_unit(LAS unsigned char* lds, KP p, int b, int g, int qb, bf16_t* __restrict__ ocmp, unsigned* __restrict__ selmask) {
    const int tid = ftid(), lane = tid & 63, w = __builtin_amdgcn_readfirstlane(tid >> 6), r32 = lane & 31, hh = lane >> 5;
    const int bg = b * 2 + g, q0 = qb * 256, qrow0 = q0 + 32 * w, tq = qrow0 + r32;
    const bf16_t* projb = WSP(bf16_t, O_PROJB);
    int nun = (q0 + 255 - 31) / 16 + 1; if (nun > 511) nun = 511;
    const int ntile_u = (nun + 63) >> 6;
    __syncthreads();
    { const int srow = tid >> 3, sch = tid & 7; const bf16_t* ks = WSP(bf16_t, O_KCMPB) + ((size_t)bg * 512 + srow) * 64 + sch * 8; const bf16_t* vs = WSP(bf16_t, O_VCMPB) + ((size_t)bg * 512 + srow) * 64 + sch * 8;
      for (int i = 0; i < ntile_u; ++i) { const u32x4 kv = *(const u32x4*)(ks + (size_t)i * 64 * 64), vv = *(const u32x4*)(vs + (size_t)i * 64 * 64);
          *(LAS u32x4*)(lds + E3_K + (srow + 64 * i) * KROW + sch * 16) = kv; *(LAS u32x4*)(lds + E3_V + (srow + 64 * i) * KROW + sch * 16) = vv; } }
    __syncthreads();
    int nw = qrow0 / 16 + 1; if (nw > 511) nw = 511;
    const int ntile_w = (qrow0 + 31 < 31) ? 0 : ((nw + 63) >> 6);
    const float tqf = (float)tq;
    const int gq = lane >> 4, li = lane & 15;
    const LAS unsigned char* trb = lds + E3_V + (4 * hh + (li >> 2)) * KROW + (16 * (gq & 1) + 4 * (li & 3)) * 2;
    const LAS unsigned char* kfb = lds + E3_K + r32 * KROW + hh * 16;
    float imp[64];
#pragma unroll
    for (int i = 0; i < 64; ++i) imp[i] = 0.f;
#pragma unroll 1
    for (int r4 = 0; r4 < 4; ++r4) {
        const int h = 4 * g + r4; const float sl2 = exp2f(-(float)(h + 1)) * LOG2E;
        const unsigned qoff = (unsigned)((b * S_ + tq) * PB + h * 64 + 8 * hh);
        f32x16 o0, o1;
#pragma unroll
        for (int r = 0; r < 16; ++r) { o0[r] = 0.f; o1[r] = 0.f; }
        float m = 0.f, l = 0.f; bool have = false;
#define E3_ST(jt) f32x16 p0, p1; { bf16x8 qf[4]; _Pragma("unroll") for (int d0 = 0; d0 < 4; ++d0) qf[d0] = *(const bf16x8*)(projb + qoff + 16 * d0); \
            _Pragma("unroll") for (int r = 0; r < 16; ++r) { p0[r] = 0.f; p1[r] = 0.f; } \
            _Pragma("unroll") for (int d0 = 0; d0 < 4; ++d0) { const bf16x8 a0 = *(const LAS bf16x8*)(kfb + (64 * (jt)) * KROW + d0 * 32), a1 = *(const LAS bf16x8*)(kfb + (64 * (jt) + 32) * KROW + d0 * 32); \
                p0 = __builtin_amdgcn_mfma_f32_32x32x16_bf16(a0, qf[d0], p0, 0, 0, 0); p1 = __builtin_amdgcn_mfma_f32_32x32x16_bf16(a1, qf[d0], p1, 0, 0, 0); } \
            int tq_ = tq; asm volatile("" : "+v"(tq_));     \
            int hh_ = hh; asm volatile("" : "+v"(hh_)); \
            const float tqf_ = (float)tq_; const int ce0_ = 16 * (64 * (jt) + 4 * hh_) + 31; \
            const float basef_ = sl2 * ((float)ce0_ - tqf_) - m, base1_ = basef_ + 512.f * sl2; \
            _Pragma("unroll") for (int reg = 0; reg < 16; ++reg) { const float cr_ = sl2 * (float)(16 * CROW(reg, 0)); p0[reg] = p0[reg] * (SCALE * LOG2E) + (basef_ + cr_); p1[reg] = p1[reg] * (SCALE * LOG2E) + (base1_ + cr_); } \
            if (ce0_ + 16 * 27 + 512 > qrow0) {     \
                _Pragma("unroll") for (int reg = 0; reg < 16; ++reg) { const int ce = ce0_ + 16 * CROW(reg, 0); p0[reg] = (ce <= tq_) ? p0[reg] : -INFINITY; p1[reg] = (ce + 512 <= tq_) ? p1[reg] : -INFINITY; } } }
        float imh[64];
#pragma unroll
        for (int i = 0; i < 64; ++i) imh[i] = 0.f;
#pragma unroll
        for (int jt = 0; jt < 8; ++jt) {
            if (jt < ntile_w) {
                E3_ST(jt);
                {
                    float rm_; SM_ROWMAX(p0, p1, rm_);
                    const bool fin_ = rm_ > -1e37f;
                    if (__any((rm_ > RESC_THR) || (!have && fin_))) {
                        const float dl_ = have ? fmaxf(rm_, 0.f) : (fin_ ? rm_ : 0.f); const float al_ = have ? __builtin_amdgcn_exp2f(-dl_) : 1.f;
                        m += dl_; l *= al_; have = have || fin_;
#pragma unroll
                        for (int r_ = 0; r_ < 16; ++r_) { o0[r_] *= al_; o1[r_] *= al_; p0[r_] -= dl_; p1[r_] -= dl_; }
#pragma unroll
                        for (int i = 0; i < 64; ++i) imh[i] *= al_; }
                    float ls_ = 0.f;
#pragma unroll
                    for (int reg_ = 0; reg_ < 16; ++reg_) { p0[reg_] = __builtin_amdgcn_exp2f(p0[reg_]); p1[reg_] = __builtin_amdgcn_exp2f(p1[reg_]); ls_ += p0[reg_] + p1[reg_]; }
                    l += ls_; }
#pragma unroll
                for (int pa = 0; pa < 2; ++pa)
#pragma unroll
                    for (int i = 0; i < 4; ++i) { const int jj = 8 * jt + 4 * pa + i;
                        const float x0 = pa ? p1[4 * i] : p0[4 * i], x1 = pa ? p1[4 * i + 1] : p0[4 * i + 1], x2 = pa ? p1[4 * i + 2] : p0[4 * i + 2], x3 = pa ? p1[4 * i + 3] : p0[4 * i + 3];
                        const float c = 0.5f * x3, a = (x0 + x1) + (x2 + c), r = __shfl_xor(c, 32);
                        imh[jj] += a + (hh ? r : 0.f);
                        if (jj + 1 < 64) imh[jj + 1] += (hh ? 0.f : r); }
                const LAS unsigned char* tb = trb + (64 * jt) * KROW;
#pragma unroll
                for (int s = 0; s < 4; ++s) {
                    u32x4 pw;
                    if (s < 2) { pw.x = cvtpk(p0[8 * s + 0], p0[8 * s + 1]); pw.y = cvtpk(p0[8 * s + 2], p0[8 * s + 3]); pw.z = cvtpk(p0[8 * s + 4], p0[8 * s + 5]); pw.w = cvtpk(p0[8 * s + 6], p0[8 * s + 7]); }
                    else { const int s2 = s - 2; pw.x = cvtpk(p1[8 * s2 + 0], p1[8 * s2 + 1]); pw.y = cvtpk(p1[8 * s2 + 2], p1[8 * s2 + 3]); pw.z = cvtpk(p1[8 * s2 + 4], p1[8 * s2 + 5]); pw.w = cvtpk(p1[8 * s2 + 6], p1[8 * s2 + 7]); }
                    const bf16x8 pb = __builtin_bit_cast(bf16x8, pw);
                    const v4i16_t a0l = __builtin_amdgcn_ds_read_tr16_b64_v4i16((LAS v4i16_t*)(tb + (16 * s) * KROW)), a0h = __builtin_amdgcn_ds_read_tr16_b64_v4i16((LAS v4i16_t*)(tb + (16 * s + 8) * KROW));
                    const v4i16_t a1l = __builtin_amdgcn_ds_read_tr16_b64_v4i16((LAS v4i16_t*)(tb + (16 * s) * KROW + 64)), a1h = __builtin_amdgcn_ds_read_tr16_b64_v4i16((LAS v4i16_t*)(tb + (16 * s + 8) * KROW + 64));
                    const bf16x8 va0 = (bf16x8){a0l[0], a0l[1], a0l[2], a0l[3], a0h[0], a0h[1], a0h[2], a0h[3]}, va1 = (bf16x8){a1l[0], a1l[1], a1l[2], a1l[3], a1h[0], a1h[1], a1h[2], a1h[3]};
                    o0 = __builtin_amdgcn_mfma_f32_32x32x16_bf16(va0, pb, o0, 0, 0, 0); o1 = __builtin_amdgcn_mfma_f32_32x32x16_bf16(va1, pb, o1, 0, 0, 0); }
            }
        }
        l += __shfl_xor(l, 32);
        const float inv = (l > 0.f) ? 1.f / l : 0.f;
#pragma unroll
        for (int i = 0; i < 64; ++i) imp[i] += imh[i] * inv;
        { const float sc = inv * WSP(float, O_GF)[(size_t)(b * S_ + tq) * 32 + 0 * 8 + h];
          bf16_t* orow = ocmp + (size_t)(b * S_ + tq) * 512 + h * 64;
#pragma unroll
          for (int i = 0; i < 4; ++i) {
              *(u32x2*)(orow + 8 * i + 4 * hh) = (u32x2){cvtpk(o0[4 * i] * sc, o0[4 * i + 1] * sc), cvtpk(o0[4 * i + 2] * sc, o0[4 * i + 3] * sc)};
              *(u32x2*)(orow + 32 + 8 * i + 4 * hh) = (u32x2){cvtpk(o1[4 * i] * sc, o1[4 * i + 1] * sc), cvtpk(o1[4 * i + 2] * sc, o1[4 * i + 3] * sc)}; } }
#undef E3_ST
    }
    const int cur = tq >> 6;
#pragma unroll
    for (int jj = 0; jj < 64; ++jj) { const int j = 2 * jj + hh; imp[jj] = (j != 0 && j < cur - 1) ? imp[jj] : -1.f; }
    unsigned m0 = 1u, m1 = 0u, m2 = 0u, m3 = 0u;
#define E3_SETBIT(j) do { const unsigned bit_ = 1u << ((j) & 31); const int wd_ = (j) >> 5; m0 |= (wd_ == 0) ? bit_ : 0u; m1 |= (wd_ == 1) ? bit_ : 0u; m2 |= (wd_ == 2) ? bit_ : 0u; m3 |= (wd_ == 3) ? bit_ : 0u; } while (0)
    E3_SETBIT(cur); if (cur >= 1) E3_SETBIT(cur - 1);
#pragma unroll 1
    for (int it = 0; it < NSEL - 3; ++it) {
        float best = -0.5f; int bj = 0;
#pragma unroll
        for (int jj = 0; jj < 64; ++jj) { if (imp[jj] > best) { best = imp[jj]; bj = jj; } }
        const int myj = 2 * bj + hh; const float ob = __shfl_xor(best, 32); const int oj = __shfl_xor(myj, 32);
        const bool mine = (best > ob) || (best == ob && myj < oj);
        const float wv = mine ? best : ob; const int wj = mine ? myj : oj;
        if (wv >= 0.f) E3_SETBIT(wj);
        if (mine && best >= 0.f) {
#pragma unroll
            for (int jj = 0; jj < 64; ++jj) imp[jj] = (jj == bj) ? -2.f : imp[jj]; }
    }
#undef E3_SETBIT
    if (hh == 0) *(u32x4*)(selmask + ((size_t)bg * S_ + tq) * 4) = (u32x4){m0, m1, m2, m3};
}
}
namespace mk {
constexpr int SB_EARLY = 216;
template <int MODE>
__device__ __forceinline__ void ph_attn1(float* lds, LAS unsigned char* lds3, KP p, unsigned* qctr, bf16_t* obase, bf16_t* owin, const unsigned* kmax2) {
    LAS int* qslot = (LAS int*)(lds3 + E3_BYTES);
    constexpr int N_E3 = (MODE & 2) ? 128 : 0, N_CMP = (MODE & 1) ? 64 : 0, N_FOX = (MODE & 4) ? 256 : 0, N_WIN = (MODE & 8) ? 512 : 0, N_SB = (MODE & 16) ? (256 - SB_EARLY) : 0;
    for (;;) {
        __syncthreads();
        if (ftid() == 0) *qslot = (int)atomicAdd(qctr, 1u);
        __syncthreads();
        int u = __builtin_amdgcn_readfirstlane(*qslot);
        if (u >= N_E3 + N_CMP + N_FOX + N_WIN + N_SB) break;
        if (u < N_E3) { e3_unit(lds3, p, (u & 3) >> 1, u & 1, 31 - (u >> 2), WSP(bf16_t, O_OCMP), WSP(unsigned, O_SELMASK)); continue; } u -= N_E3;
        if (u < N_FOX) { e1_unit<0>(lds3, p, (u & 7) >> 2, u & 3, 31 - (u >> 3), obase, owin, kmax2); continue; } u -= N_FOX;
        if (u < N_WIN) { e1_unit<1>(lds3, p, (u & 3) >> 1, u & 1, 127 - (u >> 2), obase, owin, kmax2); continue; } u -= N_WIN;
        if (u < N_SB) { u += SB_EARLY; e1_unit<2>(lds3, p, (u & 7) >> 2, u & 3, 31 - (u >> 3), obase, owin, kmax2); }
    }
}
__device__ __forceinline__ void ph_sb_early(LAS unsigned char* lds3, KP p) {
    const int u = fbid() - 40; if (u < 0 || u >= SB_EARLY) return;
    e1_unit<2>(lds3, p, (u & 7) >> 2, u & 3, 31 - (u >> 3), WSP(bf16_t, O_O), WSP(bf16_t, O_OWIN), nullptr);
}
}
namespace mk {
#define RLX_AGENT __ATOMIC_RELAXED, __HIP_MEMORY_SCOPE_AGENT
#define XB_TMO      128
#define XB_XCNT(j)  (256  + 64 * (j))
#define XB_XSUB(j)  (1280 + 64 * (j))
#define XB_XGEN(j)  (2304 + 64 * (j))
#define XB_TOP      3328
#define XB_TOPGEN   3392
#define XCD_BAR_WORDS 3456
#define XB_SPIN_CAP (1u << 18)

__device__ __forceinline__ unsigned xb_ld(unsigned* p)              { return __hip_atomic_load(p, __ATOMIC_RELAXED, __HIP_MEMORY_SCOPE_AGENT); }
__device__ __forceinline__ unsigned xb_add(unsigned* p, unsigned v) { return __hip_atomic_fetch_add(p, v, __ATOMIC_RELAXED, __HIP_MEMORY_SCOPE_AGENT); }
__device__ __forceinline__ unsigned xb_xcc_id() { return (unsigned)__builtin_amdgcn_s_getreg((3 << 11) | 20) & 0xFu; }
#define XB_SPIN(cond, bar) do { unsigned _sp = 0; while (cond) { __builtin_amdgcn_s_sleep(1); \
    if ((++_sp & 255u) == 0u) { if (xb_ld(&(bar)[XB_TMO])) break; if (_sp > XB_SPIN_CAP) { atomicAdd(&(bar)[XB_TMO], 1u); break; } } } } while (0)

struct XcdBarrier {
    unsigned* bar; unsigned x;
    volatile LAS unsigned* st;
};

__device__ __forceinline__ XcdBarrier xcd_barrier_post(unsigned* bar, volatile LAS unsigned* st) {
    XcdBarrier b; b.bar = bar; b.x = xb_xcc_id(); b.st = st;
    if (threadIdx.x == 0) (void)xb_add(&bar[XB_XCNT(b.x)], 1u);
    return b;
}
__device__ __forceinline__ void xcd_barrier_complete(unsigned* bar, unsigned x, unsigned& nloc, unsigned& nx) {
    const unsigned G = gridDim.x * gridDim.y * gridDim.z;
    unsigned sum, cnt, mine, sp = 0u;
    for (;;) {
        sum = 0u; cnt = 0u; mine = 0u;
#pragma unroll
        for (unsigned j = 0; j < 16; ++j) { const unsigned c = xb_ld(&bar[XB_XCNT(j)]); sum += c; cnt += (c > 0u) ? 1u : 0u; mine = (j == x) ? c : mine; }
        if (sum == G) break;
        __builtin_amdgcn_s_sleep(1);
        if ((++sp & 255u) == 0u) { if (xb_ld(&bar[XB_TMO])) break; if (sp > XB_SPIN_CAP) { atomicAdd(&bar[XB_TMO], 1u); break; } }
    }
    nloc = mine > 0u ? mine : 1u; nx = cnt > 0u ? cnt : 1u;
}

__device__ __forceinline__ void xcd_barrier(const XcdBarrier& b) {
    asm volatile("s_waitcnt vmcnt(0)" ::: "memory");
    __syncthreads();
    if (threadIdx.x == 0) {
        unsigned* bar = b.bar;
        __builtin_amdgcn_s_waitcnt(0);
        unsigned nloc = b.st[0], nx = b.st[1];
        if (nloc == 0u) { xcd_barrier_complete(bar, b.x, nloc, nx); b.st[0] = nloc; b.st[1] = nx; }
        const unsigned old = xb_add(&bar[XB_XSUB(b.x)], 1u);
        const unsigned gen = old / nloc;
        if (old + 1u == (gen + 1u) * nloc) {
            __builtin_amdgcn_fence(__ATOMIC_RELEASE, "agent");
            asm volatile("s_waitcnt vmcnt(0)" ::: "memory");
            const unsigned og = xb_add(&bar[XB_TOP], 1u);
            const unsigned tg = og / nx;
            if (og + 1u == (tg + 1u) * nx) xb_add(&bar[XB_TOPGEN], 1u);
            else XB_SPIN(xb_ld(&bar[XB_TOPGEN]) == tg, bar);
            __builtin_amdgcn_fence(__ATOMIC_ACQUIRE, "agent");
            xb_add(&bar[XB_XGEN(b.x)], 1u);
            asm volatile("s_waitcnt vmcnt(0)" ::: "memory");
        } else {
            XB_SPIN(xb_ld(&bar[XB_XGEN(b.x)]) == gen, bar);
            __builtin_amdgcn_fence(__ATOMIC_ACQUIRE, "agent");
            asm volatile("s_waitcnt vmcnt(0)" ::: "memory");
        }
    }
    __syncthreads();
}

}
namespace cg = cooperative_groups;
constexpr int NSTEP = 12;
#ifndef CVH_GU
#define CVH_GU 1
#define CVH_DN 1
#endif
__global__ void __launch_bounds__(512, 2) mega(mk::P p_unused) {
    extern __shared__ __attribute__((aligned(16))) unsigned char lds_raw[];
    float* lds = (float*)lds_raw;
    LAS unsigned char* lds3 = (LAS unsigned char*)lds_raw;
    using namespace nv; using namespace mk;
    volatile LAS unsigned* bst = (volatile LAS unsigned*)(lds3 + E3_BYTES + 128);
    if (threadIdx.x < 2) bst[threadIdx.x] = 0u;
    __syncthreads();
    XcdBarrier bar;
    { const KP p = fresh_kp(); bar = xcd_barrier_post(WSP(unsigned, O_COUNTS + 16384), bst); }
    cg::this_grid().sync();
    for (int step = 0; step < 1 + NSTEP * L_; ++step) {
        const KP p = fresh_kp();
        const int l = (step - 1) / NSTEP, k = (step == 0) ? -1 : (step - 1) % NSTEP;
        const bool isg = (k == 0 || k == 1 || k == 6 || k == 9 || k == 10);
#ifdef PROBE_K
        const int nrep = (k == PROBE_K) ? PROBE_N : 1;
#else
        const int nrep = 1;
#endif
        for (int rep = 0; rep < nrep; ++rep) {
        int helpchunks = 0;
        if (isg) {
            const int kind = (k == 0) ? 0 : (k == 1) ? 4 : (k == 6) ? 1 : (k == 9) ? 2 : 3;
            GSched S; GEpi E; S.kind = kind; E.kind = kind; E.l = l;
            S.G = (int)gridDim.x; S.c = fbid(); S.meta = WSP(int, O_META); S.rowtok = WSP(int, O_ROWTOK); S.estep = 0;
            const char* A; int N, K = D_;
            if (kind == 0) { A = (const char*)WSP(bf16_t, O_XB); S.Bt = (const char*)(WSP(bf16_t, O_WTIN) + (size_t)l * NPAD * D_); N = NPAD; }
            else if (kind == 1) { A = (const char*)WSP(bf16_t, O_OB); S.Bt = (const char*)(WSP(bf16_t, O_WTOUT) + (size_t)l * D_ * D_); N = D_; }
            else if (kind == 2) { A = (const char*)WSP(bf16_t, O_X1B); S.Bt = (const char*)(WSP(bf16_t, O_WTGU) + (size_t)l * NE * 2048 * D_); S.estep = (size_t)2048 * D_ * 2; N = 2048; }
            else if (kind == 3) { A = (const char*)WSP(bf16_t, O_ACT); S.Bt = (const char*)(WSP(bf16_t, O_WTDN) + (size_t)l * NE * D_ * D_); S.estep = (size_t)D_ * D_ * 2; N = D_; }
            else { A = (const char*)WSP(bf16_t, O_PROJB); S.Bt = (const char*)(WSP(bf16_t, O_WT1) + (size_t)l * 2 * 256 * 2048); S.estep = (size_t)256 * 2048 * 2; N = 256; K = 1024; }
            S.nN = N / 256; S.nM = (kind < 2) ? T_ / 256 : (kind == 4) ? 16 : S.meta[32]; S.nunits = S.nM * S.nN; if (kind == 4) S.nunits = 32;
            pg8::gemm_phase<GEpi, GSched>(lds3, A, K, S, E);
            if (l == 0 && kind >= 2 && kind <= 3 && S.G == 256) {
                const int mine = (S.nunits - S.c + 255) >> 8, most = (S.nunits + 255) >> 8;
                if (mine < most) helpchunks = (kind == 2) ? CVH_GU : CVH_DN; }
            if (kind == 4) { ph_cumsum(lds, p, 32); ph_sb_early(lds3, p); }
            if (kind == 0) ph_bias1_reduce(p, l);
        } else {
            switch (k) {
                case -1: ph_convert(lds3, p); break;
                case 2: ph_prep2(lds, p, l); break;
#ifdef PROBE_AMODE
                case 3: if (rep == 0) ph_attn1<30>(lds, lds3, p, WSP(unsigned, O_COUNTS) + 128 + l * 8 + rep, WSP(bf16_t, O_O), WSP(bf16_t, O_OWIN), WSP(unsigned, O_COUNTS) + 192 + l * 8);
                        else ph_attn1<PROBE_AMODE>(lds, lds3, p, WSP(unsigned, O_COUNTS) + 128 + l * 8 + rep, WSP(bf16_t, O_O), WSP(bf16_t, O_OWIN), WSP(unsigned, O_COUNTS) + 192 + l * 8);
                        break;
#else
                case 3: ph_attn1<30>(lds, lds3, p, WSP(unsigned, O_COUNTS) + 128 + l * 8 + rep, WSP(bf16_t, O_O), WSP(bf16_t, O_OWIN), WSP(unsigned, O_COUNTS) + 192 + l * 8); break;
#endif
                case 4: ph_attn_sel2<true>(lds3, p, WSP(bf16_t, O_O), WSP(bf16_t, O_OCMP), 512); break;
                case 5: ph_rmsnorm(p, l); break;
                case 7: ph_ln<true>(lds, p, l, WSP(float, O_X1), (rep + 1 < nrep) ? 2048 * (rep + 1) : 0); break;
                case 8: ph_moe_scatter2(lds, p, l); break;
                default: { if (l == 0) helpchunks = 1 << 20;
                           float* xout = (l == L_ - 1) ? p->out : WSP(float, O_XA); ph_ln<false>(lds, p, l, xout); } break;
            }
        }
        if (helpchunks > 0) cv_help(lds3, fresh_kp(), helpchunks);
        xcd_barrier(bar);
        }
    }
#ifdef PROBE_SYNC
    for (int i = 0; i < PROBE_SYNC; ++i) xcd_barrier(bar);
#endif
}

extern "C" void kernel_launch(void* const* d_in, const int* in_sizes, int n_in,
                              void* d_out, int out_size, void* d_ws, size_t ws_size,
                              hipStream_t stream) {
    constexpr size_t kDynLds = 147456 + 1024;
    static int grid_blocks = 0;
    if (!grid_blocks) {
        int dev = 0, cus = 0, per_cu = 0;
        (void)hipGetDevice(&dev);
        (void)hipDeviceGetAttribute(&cus, hipDeviceAttributeMultiprocessorCount, dev);
        (void)hipFuncSetAttribute((const void*)mega, hipFuncAttributeMaxDynamicSharedMemorySize, (int)kDynLds);
        (void)hipOccupancyMaxActiveBlocksPerMultiprocessor(&per_cu, mega, 512, kDynLds);
        if (per_cu < 1) per_cu = 1;
        if (per_cu > 1) per_cu = 1;
        grid_blocks = cus * per_cu;
        if (ws_size < mk::O_END) fprintf(stderr, "workspace too small: %zu < %zu\n", ws_size, (size_t)mk::O_END);
        if (grid_blocks != 256) fprintf(stderr, "this kernel's static work split is built for 256 workgroups (MI355X: 256 CUs); got %d\n", grid_blocks);
    }
    mk::P p{};
    p.in = nv::inputs(d_in); p.ws = (unsigned char*)d_ws; p.out = (float*)d_out;
    (void)hipMemsetAsync((char*)d_ws + mk::O_COUNTS, 0, 65536, stream);
    void* args[] = {&p};
    hipError_t e = hipLaunchCooperativeKernel((void*)mega, dim3(grid_blocks), dim3(512), args, kDynLds, stream);
    if (e != hipSuccess) fprintf(stderr, "cooperative launch failed: %s (grid %d)\n", hipGetErrorString(e), grid_blocks);
}
```

```cpp
#include <hip/hip_runtime.h>
#include <hip/hip_cooperative_groups.h>
#include <cstdio>
#include <cstdint>

namespace nv {

constexpr int B_ = 2, S_ = 8192, D_ = 1024, T_ = B_ * S_, L_ = 2;
constexpr int DIN = 2844;
constexpr int OFF_NSA_KV = 512, OFF_NSA_GATE = 1280, OFF_FOX_QKV = 1304, OFF_FOX_F = 2072, OFF_SB_QKV = 2076;
constexpr int NCMP = 511, NBLK = 128, NSEL = 16;
constexpr int NE = 32, TOPK = 4, MROWS = T_ * TOPK;
constexpr float LN_EPS = 1e-5f, RMS_EPS = 1e-6f;
constexpr float ALPHA = 1.4142135623730951f;
constexpr float SCALE = 0.125f;

__device__ __forceinline__ float sigmoidf_(float x) { return 1.f / (1.f + __expf(-x)); }
__device__ __forceinline__ float logsig(float x) { return fminf(x, 0.f) - log1pf(expf(-fabsf(x))); }

__device__ __forceinline__ float gelu_tanh(float x) { return 0.5f * x * (1.f + tanhf(0.7978845608028654f * (x + 0.044715f * x * x * x))); }
__device__ __forceinline__ float wsum(float v) {
#pragma unroll
    for (int o = 1; o < 64; o <<= 1) v += __shfl_xor(v, o);
    return v;
}
struct In {
    const float *x, *w_in, *b_in, *pos_k, *pos_v, *w1k, *w2k, *w1v, *w2v, *g_out, *w_out, *ln1_g, *ln1_b, *rw, *rb, *wgu, *bgu, *wdn, *bdn, *ln2_g, *ln2_b;
};
inline In inputs(void* const* d) {
    In i; i.x = (const float*)d[0]; i.w_in = (const float*)d[1]; i.b_in = (const float*)d[2]; i.pos_k = (const float*)d[3]; i.pos_v = (const float*)d[4];
    i.w1k = (const float*)d[5]; i.w2k = (const float*)d[6]; i.w1v = (const float*)d[7]; i.w2v = (const float*)d[8]; i.g_out = (const float*)d[9]; i.w_out = (const float*)d[10];
    i.ln1_g = (const float*)d[11]; i.ln1_b = (const float*)d[12]; i.rw = (const float*)d[13]; i.rb = (const float*)d[14]; i.wgu = (const float*)d[15]; i.bgu = (const float*)d[16];
    i.wdn = (const float*)d[17]; i.bdn = (const float*)d[18]; i.ln2_g = (const float*)d[19]; i.ln2_b = (const float*)d[20]; return i;
}


}
namespace pg8 {
#define PG8_LAS __attribute__((address_space(3)))
typedef unsigned short bf16_t;
typedef short bf16x8 __attribute__((ext_vector_type(8)));
typedef float f32x4 __attribute__((ext_vector_type(4)));
typedef unsigned u32x4 __attribute__((ext_vector_type(4)));
constexpr int BM = 256, BK = 64, HALF = 128, HTB = HALF * BK * 2  , STAGE_BYTES = 8 * HTB, NXCD = 8, WGM = 8;

__host__ __device__ __forceinline__ int lds_byte(int r, int c) { const int st = (r >> 4) * 2 + (c >> 5), rr = r & 15, cc = c & 31, ob = rr * 64 + cc * 2; return st * 1024 + (ob ^ (((ob >> 9) & 1) << 5)); }
__host__ __device__ __forceinline__ void stage_rc(int b, int& R, int& C) { const int st = b / 1024, sb = b % 1024, swz = sb ^ (((sb >> 9) & 1) << 5); R = (st >> 1) * 16 + swz / 64; C = (st & 1) * 32 + (swz % 64) / 2; }
__host__ __device__ __forceinline__ int perm32(int rho) { const int n = rho >> 4, i = rho & 15; return 8 * (i >> 2) + 4 * n + (i & 3); }

struct Unit { int pm, pn, e, nr; };

__device__ __forceinline__ unsigned cvt_pk_bf16(float lo, float hi) { unsigned r; asm volatile("v_cvt_pk_bf16_f32 %0, %1, %2" : "=v"(r) : "v"(lo), "v"(hi)); return r; }
template <class Epi, class Sched, bool ALIGN_EPI = true, bool SP2 = true>
__device__ __forceinline__ void gemm_phase(PG8_LAS unsigned char* lds, const char* Abase, const int K, const Sched& S, const Epi& E) {
    int tid_ = threadIdx.x; asm volatile("" : "+v"(tid_));
    const int tid = tid_, wid = __builtin_amdgcn_readfirstlane(tid >> 6), lane = tid & 63, wr = wid >> 2, wc = wid & 3, fr = lane & 15, fq = lane >> 4;
    const int nt = K / BK;
    unsigned voffB[2];
#pragma unroll
    for (int i = 0; i < 2; ++i) { int R, C; stage_rc(tid * 16 + i * 8192, R, C); const int Rb = Epi::PERM ? ((R & ~31) + perm32(R & 31)) : R;
        voffB[i] = (unsigned)(Rb * K + C) * 2u; }
#define PG8_AOFF(u, o0, o1) do { int _t = tid; asm volatile("" : "+v"(_t)); _Pragma("unroll") for (int _i = 0; _i < 2; ++_i) { int _R, _C; stage_rc(_t * 16 + _i * 8192, _R, _C); \
        (o0)[_i] = S.a_off((u), _R) + (unsigned)_C * 2u; (o1)[_i] = S.a_off((u), HALF + _R) + (unsigned)_C * 2u; } } while (0)
    const size_t kstep = (size_t)(BK * 2);
    const size_t akstep = S.a_kstep();
    const size_t hstep = (size_t)HALF * K * 2;
    const unsigned ldsw = (unsigned)wid * 1024u;
    const int aoff = lds_byte(wr * 64 + fr, fq * 8), boff = lds_byte(wc * 32 + fr, fq * 8);
#define PG8_SA(b, h) (((b) * 2 + (h)) * HTB)
#define PG8_SB(b, h) ((4 + (b) * 2 + (h)) * HTB)
#define PG8_STAGE(bufoff, gbase, voff) do { _Pragma("unroll") for (int _i = 0; _i < 2; ++_i) { unsigned _o = (voff)[_i]; asm volatile("" : "+v"(_o));     \
        __builtin_amdgcn_global_load_lds((const unsigned*)((const char*)(gbase) + _o), (PG8_LAS unsigned*)(lds + (bufoff) + ldsw + _i * 8192), 16, 0, 0); } } while (0)
#define PG8_LDA(dst, b, h) do { _Pragma("unroll") for (int m = 0; m < 4; ++m) _Pragma("unroll") for (int k = 0; k < 2; ++k) dst[m][k] = *(const PG8_LAS bf16x8*)(lds + PG8_SA(b, h) + aoff + m * 2048 + k * 1024); } while (0)
#define PG8_LDB(dst, b, h) do { _Pragma("unroll") for (int n = 0; n < 2; ++n) _Pragma("unroll") for (int k = 0; k < 2; ++k) dst[n][k] = *(const PG8_LAS bf16x8*)(lds + PG8_SB(b, h) + boff + n * 2048 + k * 1024); } while (0)
#define PG8_MMA(ai, bj, At, Bt) do { __builtin_amdgcn_s_setprio(1); _Pragma("unroll") for (int m = 0; m < 4; ++m) _Pragma("unroll") for (int n = 0; n < 2; ++n) _Pragma("unroll") for (int k = 0; k < 2; ++k) \
        acc[ai][bj][m][n] = __builtin_amdgcn_mfma_f32_16x16x32_bf16(Bt[n][k], At[m][k], acc[ai][bj][m][n], 0, 0, 0); __builtin_amdgcn_s_setprio(0); } while (0)
#define PG8_WAIT_V(n) asm volatile("s_waitcnt vmcnt(" #n ")" ::: "memory")
#define PG8_WAIT_L(n) asm volatile("s_waitcnt lgkmcnt(" #n ")" ::: "memory")
#define PG8_BAR __builtin_amdgcn_s_barrier()
#define PG8_SCHED __builtin_amdgcn_sched_barrier(0)
    Unit cur, nxt; int ui = 0;
    if (!S.next(0, cur)) return;
    f32x4 acc[2][2][4][2];
    float zf_ = 0.f; asm volatile("" : "+v"(zf_));
#pragma unroll
    for (int a = 0; a < 2; ++a)
#pragma unroll
        for (int b = 0; b < 2; ++b)
#pragma unroll
            for (int m = 0; m < 4; ++m)
#pragma unroll
                for (int n = 0; n < 2; ++n) acc[a][b][m][n] = (f32x4){zf_, zf_, zf_, zf_};
    bf16x8 At[4][2], B0[2][2], B1[2][2];
    unsigned ca0[2], ca1[2], na0[2], na1[2];
    PG8_AOFF(cur, ca0, ca1);
    const char* const cA = Abase; const char* cB = S.b_base(cur);
    if constexpr (SP2) {
        PG8_STAGE(PG8_SB(0, 0), cB, voffB); PG8_STAGE(PG8_SB(0, 1), cB + hstep, voffB); PG8_STAGE(PG8_SA(0, 0), cA, ca0); PG8_STAGE(PG8_SA(0, 1), cA, ca1);
        if (wr == 1) PG8_BAR;
        PG8_WAIT_V(2); PG8_BAR;
        PG8_STAGE(PG8_SB(1, 0), cB + kstep, voffB); PG8_STAGE(PG8_SA(1, 0), cA + akstep, ca0); PG8_STAGE(PG8_SB(1, 1), cB + hstep + kstep, voffB);
        PG8_WAIT_V(6); PG8_BAR;
    } else { static_assert(SP2, "only the SP2 loop is kept"); }
    for (;;) {
        const bool has_next = S.next(ui + 1, nxt);
        const char* nB = has_next ? S.b_base(nxt) : cB;
        if (has_next) { PG8_AOFF(nxt, na0, na1); } else { na0[0] = ca0[0]; na0[1] = ca0[1]; na1[0] = ca1[0]; na1[1] = ca1[1]; }
        for (int t = 0; t < nt - 2; t += 2) {
            const char* a1 = cA + (size_t)(t + 1) * akstep;
            const char* a2 = cA + (size_t)(t + 2) * akstep; const char* b2 = cB + (size_t)(t + 2) * kstep;
            const char* a3 = a2 + akstep; const char* b3 = b2 + kstep;
            PG8_LDB(B0, 0, 0); PG8_LDB(B1, 0, 1); PG8_SCHED; PG8_LDA(At, 0, 0); PG8_STAGE(PG8_SA(1, 1), a1, ca1);
            PG8_WAIT_V(8); PG8_WAIT_L(0); PG8_BAR; PG8_MMA(0, 0, At, B0); PG8_MMA(0, 1, At, B1); PG8_BAR; PG8_SCHED;
            PG8_LDA(At, 0, 1); PG8_STAGE(PG8_SB(0, 0), b2, voffB); PG8_STAGE(PG8_SB(0, 1), b2 + hstep, voffB); PG8_STAGE(PG8_SA(0, 0), a2, ca0);
            PG8_WAIT_V(8); PG8_WAIT_L(0); PG8_BAR; PG8_MMA(1, 0, At, B0); PG8_MMA(1, 1, At, B1); PG8_BAR; PG8_SCHED;
            PG8_LDB(B0, 1, 0); PG8_LDB(B1, 1, 1); PG8_SCHED; PG8_LDA(At, 1, 0); PG8_STAGE(PG8_SA(0, 1), a2, ca1);
            PG8_WAIT_V(8); PG8_WAIT_L(0); PG8_BAR; PG8_MMA(0, 0, At, B0); PG8_MMA(0, 1, At, B1); PG8_BAR; PG8_SCHED;
            PG8_LDA(At, 1, 1); PG8_STAGE(PG8_SB(1, 0), b3, voffB); PG8_STAGE(PG8_SB(1, 1), b3 + hstep, voffB); PG8_STAGE(PG8_SA(1, 0), a3, ca0);
            PG8_WAIT_V(8); PG8_WAIT_L(0); PG8_BAR; PG8_MMA(1, 0, At, B0); PG8_MMA(1, 1, At, B1); PG8_BAR; PG8_SCHED;
        }
        {
            const char* a1 = cA + (size_t)(nt - 1) * akstep;
            const char* a2 = cA; const char* b2 = nB; const char* a3 = a2 + akstep; const char* b3 = b2 + kstep;
            PG8_LDB(B0, 0, 0); PG8_LDB(B1, 0, 1); PG8_SCHED; PG8_LDA(At, 0, 0); PG8_STAGE(PG8_SA(1, 1), a1, ca1);
            PG8_WAIT_V(8); PG8_WAIT_L(0); PG8_BAR; PG8_MMA(0, 0, At, B0); PG8_MMA(0, 1, At, B1); PG8_BAR; PG8_SCHED;
            PG8_LDA(At, 0, 1); PG8_STAGE(PG8_SB(0, 0), b2, voffB); PG8_STAGE(PG8_SB(0, 1), b2 + hstep, voffB); PG8_STAGE(PG8_SA(0, 0), a2, na0);
            PG8_WAIT_V(8); PG8_WAIT_L(0); PG8_BAR; PG8_MMA(1, 0, At, B0); PG8_MMA(1, 1, At, B1); PG8_BAR; PG8_SCHED;
            PG8_LDB(B0, 1, 0); PG8_LDB(B1, 1, 1); PG8_SCHED; PG8_LDA(At, 1, 0); PG8_STAGE(PG8_SA(0, 1), a2, na1);
            PG8_WAIT_V(8); PG8_WAIT_L(0); PG8_BAR; PG8_MMA(0, 0, At, B0); PG8_MMA(0, 1, At, B1); PG8_BAR; PG8_SCHED;
            PG8_LDA(At, 1, 1); PG8_STAGE(PG8_SB(1, 0), b3, voffB); PG8_STAGE(PG8_SB(1, 1), b3 + hstep, voffB); PG8_STAGE(PG8_SA(1, 0), a3, na0);
            PG8_WAIT_V(8); PG8_WAIT_L(0); PG8_BAR; PG8_MMA(1, 0, At, B0); PG8_MMA(1, 1, At, B1); PG8_BAR; PG8_SCHED;
        }
        if constexpr (ALIGN_EPI) { if (wr == 0) PG8_BAR; }
        E(acc, cur, wr, wc, fr, fq);
        if (!has_next) break;
#pragma unroll
        for (int a = 0; a < 2; ++a)
#pragma unroll
            for (int b = 0; b < 2; ++b)
#pragma unroll
                for (int m = 0; m < 4; ++m)
#pragma unroll
                    for (int n = 0; n < 2; ++n) acc[a][b][m][n] = (f32x4){zf_, zf_, zf_, zf_};
        cur = nxt; cB = nB; ++ui; ca0[0] = na0[0]; ca0[1] = na0[1]; ca1[0] = na1[0]; ca1[1] = na1[1];
        if constexpr (ALIGN_EPI) { if (wr == 1) PG8_BAR; }
    }
    PG8_WAIT_V(0);
    if constexpr (!ALIGN_EPI) { if (wr == 0) PG8_BAR; }
    PG8_BAR;
#undef PG8_AOFF
#undef PG8_SA
#undef PG8_SB
#undef PG8_STAGE
#undef PG8_LDA
#undef PG8_LDB
#undef PG8_MMA
#undef PG8_WAIT_V
#undef PG8_WAIT_L
#undef PG8_BAR
#undef PG8_SCHED
}

}
namespace mk {
using namespace nv;
typedef unsigned short bf16_t;
typedef unsigned u32x4 __attribute__((ext_vector_type(4)));
typedef float f32x4 __attribute__((ext_vector_type(4)));
#define LAS __attribute__((address_space(3)))
typedef short bf16x8 __attribute__((ext_vector_type(8)));
typedef float f32x16 __attribute__((ext_vector_type(16)));
#define CROW(reg, hh) (((reg) & 3) + 8 * ((reg) >> 2) + 4 * (hh))
constexpr int NT = 512;
constexpr int PB = 2816;
constexpr int NPAD = 3072;
constexpr int C_KV = 512, C_FOX = 1280, C_SB = 2048, C_GATE = 2816;
constexpr int MAXT = MROWS / 256 + NE;
constexpr int PROWS = MAXT * 256;
#define CNT_IDX(l, e) (8192 + ((l) * NE + (e)) * 32)
__device__ __forceinline__ int ftid() { int t = threadIdx.x; asm volatile("" : "+v"(t)); return t; }
__device__ __forceinline__ int fbid() { int b = blockIdx.x; asm volatile("" : "+s"(b)); return b; }
#define MK_LOOP(vb, n) for (int vb = fbid(); vb < (n); vb += gridDim.x)

constexpr size_t al_(size_t x) { return (x + 4095) & ~(size_t)4095; }
constexpr size_t O_WTIN = 0;
constexpr size_t O_WTOUT = O_WTIN + al_((size_t)L_ * NPAD * D_ * 2);
constexpr size_t O_WTGU = O_WTOUT + al_((size_t)L_ * D_ * D_ * 2);
constexpr size_t O_WTDN = O_WTGU + al_((size_t)L_ * NE * 2048 * D_ * 2);
constexpr size_t O_BIASP = O_WTDN + al_((size_t)L_ * NE * D_ * D_ * 2);
constexpr size_t O_XB = O_BIASP + al_((size_t)L_ * NPAD * 4);
constexpr size_t O_PROJB = O_XB + al_((size_t)T_ * D_ * 2);
constexpr size_t O_GF = O_PROJB + al_((size_t)T_ * PB * 2);
constexpr size_t O_CFOX = O_GF + al_((size_t)T_ * 32 * 4);
constexpr size_t O_KCMP = O_CFOX + al_((size_t)B_ * 4 * S_ * 4);
constexpr size_t O_VCMP = O_KCMP + al_((size_t)B_ * 2 * 512 * 64 * 4);
constexpr size_t O_O = O_VCMP + al_((size_t)B_ * 2 * 512 * 64 * 4);
constexpr size_t O_OB = O_O + al_((size_t)T_ * D_ * 4);
constexpr size_t O_PTOT = O_OB + al_((size_t)T_ * D_ * 2);
constexpr size_t O_SEL = O_PTOT + al_((size_t)B_ * 2 * S_ * 512 * 4);
constexpr size_t O_MIX = O_SEL + al_((size_t)B_ * 2 * S_ * NSEL * 4);
constexpr size_t O_X1 = O_MIX + al_((size_t)T_ * D_ * 4);
constexpr size_t O_X1B = O_X1 + al_((size_t)T_ * D_ * 4);
constexpr size_t O_XA = O_X1B + al_((size_t)T_ * D_ * 2);
constexpr size_t O_ACT = O_XA + al_((size_t)T_ * D_ * 4);
constexpr size_t O_Y = O_ACT + al_((size_t)PROWS * D_ * 2);
constexpr size_t O_TOPE = O_Y + al_((size_t)PROWS * D_ * 2);
constexpr size_t O_TOPW = O_TOPE + al_((size_t)MROWS * 4);
constexpr size_t O_POS = O_TOPW + al_((size_t)MROWS * 4);
constexpr size_t O_ROWTOK = O_POS + al_((size_t)MROWS * 4);
constexpr size_t O_ROWW = O_ROWTOK + al_((size_t)PROWS * 4);
constexpr size_t O_SLOT = O_ROWW + al_((size_t)PROWS * 4);
constexpr size_t O_COUNTS = O_SLOT + al_((size_t)MROWS * 4);
constexpr size_t O_META = O_COUNTS + 65536;
constexpr size_t O_OWIN = O_META + 4096;
constexpr size_t O_O2 = O_OWIN + al_((size_t)T_ * 512 * 4);
constexpr size_t O_OWIN2 = O_O2 + al_((size_t)T_ * D_ * 4);
constexpr size_t O_KCMPB = O_OWIN2 + al_((size_t)T_ * 512 * 4);
constexpr size_t O_VCMPB = O_KCMPB + al_((size_t)B_ * 2 * 512 * 64 * 2);
constexpr size_t O_OCMP = O_VCMPB + al_((size_t)B_ * 2 * 512 * 64 * 2);
constexpr size_t O_SELMASK = O_OCMP + al_((size_t)T_ * 512 * 4);
constexpr size_t O_WT1 = O_SELMASK + al_((size_t)B_ * 2 * S_ * 16);
constexpr size_t O_BIAS1 = O_WT1 + al_((size_t)L_ * 2 * 256 * 2048 * 2);
constexpr size_t O_HID = O_BIAS1 + al_((size_t)L_ * 2 * 128 * 4);
constexpr size_t O_BIAS1P = O_HID + al_((size_t)8 * 512 * 128 * 2);
constexpr size_t O_RWT = O_BIAS1P + al_((size_t)L_ * 2 * 64 * 128 * 4);
constexpr size_t O_HIDP = O_RWT + al_((size_t)L_ * 2 * NE * D_ * 2);
constexpr size_t O_END = O_HIDP + al_((size_t)2 * 8 * 512 * 128 * 4);

struct P {
    In in; unsigned char* ws; float* out;
};
typedef const __attribute__((address_space(4))) P* KP;
__device__ __forceinline__ KP fresh_kp() { KP k = (KP)__builtin_amdgcn_kernarg_segment_ptr(); asm volatile("" : "+s"(k)); return k; }
#define WSP(T, off) ((T*)(p->ws + (off)))

__device__ __forceinline__ float bf2f(unsigned short b) { return __uint_as_float((unsigned)b << 16); }
__device__ __forceinline__ unsigned f2bf(float f) { unsigned u = __float_as_uint(f); return (u + 0x7fffu + ((u >> 16) & 1u)) >> 16; }
__device__ __forceinline__ unsigned pk2(float lo, float hi) { return f2bf(lo) | (f2bf(hi) << 16); }
__device__ __forceinline__ void ld8(const bf16_t* __restrict__ src, float* dst) {
    const u32x4 v = *(const u32x4*)src;
    dst[0] = __uint_as_float(v.x << 16); dst[1] = __uint_as_float(v.x & 0xffff0000u); dst[2] = __uint_as_float(v.y << 16); dst[3] = __uint_as_float(v.y & 0xffff0000u);
    dst[4] = __uint_as_float(v.z << 16); dst[5] = __uint_as_float(v.z & 0xffff0000u); dst[6] = __uint_as_float(v.w << 16); dst[7] = __uint_as_float(v.w & 0xffff0000u);
}


__device__ __forceinline__ int perm_in(int n) {
    if (n < 1280) return n;
    if (n < 1304) return C_GATE + (n - 1280);
    if (n < 2072) return C_FOX + (n - 1304);
    if (n < 2076) return C_GATE + 24 + (n - 2072);
    return C_SB + (n - 2076);
}
__device__ __forceinline__ int perm_gu(int n) { const int up = n >> 10, c = n & 1023; return 256 * (c >> 7) + 128 * up + (c & 127); }
template <int MAP>
__device__ __forceinline__ void transpose_item(const float* __restrict__ W, int K, int N, bf16_t* __restrict__ WT, LAS float* scr, int item, int lane) {
    const int nblk = (N + 31) / 32, kb = item / nblk, nb = item % nblk, k0 = 64 * kb, n0 = 32 * nb;
    { const int n4 = (lane & 7) * 4; const bool okn = (n0 + n4) < N;
      f32x4 t[8];
#pragma unroll
      for (int i = 0; i < 8; ++i) { const int kk = (lane >> 3) + 8 * i; t[i] = okn ? *(const f32x4*)(W + (size_t)(k0 + kk) * N + n0 + n4) : (f32x4){0.f, 0.f, 0.f, 0.f}; }
#pragma unroll
      for (int i = 0; i < 8; ++i) { const int kk = (lane >> 3) + 8 * i; LAS float* d = scr + kk * 33 + n4; d[0] = t[i].x; d[1] = t[i].y; d[2] = t[i].z; d[3] = t[i].w; } }
    asm volatile("s_waitcnt lgkmcnt(0)" ::: "memory");
    const int c = lane & 7;
#pragma unroll
    for (int j = 0; j < 4; ++j) { const int n = (lane >> 3) + 8 * j; const LAS float* sp = scr + (8 * c) * 33 + n;
        u32x4 o; o.x = pk2(sp[0 * 33], sp[1 * 33]); o.y = pk2(sp[2 * 33], sp[3 * 33]); o.z = pk2(sp[4 * 33], sp[5 * 33]); o.w = pk2(sp[6 * 33], sp[7 * 33]);
        const int ng = n0 + n;
        if (ng < N) { const int ro = (MAP == 1) ? perm_in(ng) : (MAP == 2) ? perm_gu(ng) : ng;
            if (MAP == 3) *(u32x4*)(WT + (size_t)(k0 >> 10) * 256 * 1024 + (size_t)ro * 1024 + (k0 & 1023) + 8 * c) = o;
            else *(u32x4*)(WT + (size_t)ro * K + k0 + 8 * c) = o; } }
    asm volatile("s_waitcnt lgkmcnt(0)" ::: "memory");
}
constexpr int CV_I_IN = 16 * 89, CV_I_OUT = 16 * 32, CV_I_GU = 16 * 64, CV_I_DN = 16 * 32, CV_I_W1 = 32 * 4;
constexpr int CV_N_IN = L_ * CV_I_IN, CV_N_OUT = L_ * CV_I_OUT, CV_N_GU = L_ * NE * CV_I_GU, CV_N_DN = L_ * NE * CV_I_DN, CV_N_W1 = L_ * 2 * CV_I_W1, CV_N_ALL = CV_N_IN + CV_N_OUT + CV_N_GU + CV_N_DN + CV_N_W1;
constexpr int CV_DEF_GU0 = CV_N_W1 + NE * CV_I_GU, CV_DEF_GU = NE * CV_I_GU, CV_DEF_DN0 = CV_N_W1 + CV_N_GU + NE * CV_I_DN, CV_DEF_DN = NE * CV_I_DN, CV_DEF_ALL = CV_DEF_GU + CV_DEF_DN;
__device__ __forceinline__ void cv_one(KP p, LAS float* scr, int it, int lane) {
    int r = it;
    if (r < CV_N_W1) { const int mtx = r / CV_I_W1, ll = mtx >> 1, kv = mtx & 1; transpose_item<3>((kv ? p->in.w1v : p->in.w1k) + (size_t)ll * 2048 * 128, 2048, 128, WSP(bf16_t, O_WT1) + (size_t)mtx * 256 * 2048, scr, r % CV_I_W1, lane); return; } r -= CV_N_W1;
    if (r < CV_N_GU) { const int mtx = r / CV_I_GU; transpose_item<2>(p->in.wgu + (size_t)mtx * D_ * 2048, D_, 2048, WSP(bf16_t, O_WTGU) + (size_t)mtx * 2048 * D_, scr, r % CV_I_GU, lane); return; } r -= CV_N_GU;
    if (r < CV_N_DN) { const int mtx = r / CV_I_DN; transpose_item<0>(p->in.wdn + (size_t)mtx * D_ * D_, D_, D_, WSP(bf16_t, O_WTDN) + (size_t)mtx * D_ * D_, scr, r % CV_I_DN, lane); return; } r -= CV_N_DN;
    if (r < CV_N_IN) { const int mtx = r / CV_I_IN; transpose_item<1>(p->in.w_in + (size_t)mtx * D_ * DIN, D_, DIN, WSP(bf16_t, O_WTIN) + (size_t)mtx * NPAD * D_, scr, r % CV_I_IN, lane); return; } r -= CV_N_IN;
    { const int mtx = r / CV_I_OUT; transpose_item<0>(p->in.w_out + (size_t)mtx * D_ * D_, D_, D_, WSP(bf16_t, O_WTOUT) + (size_t)mtx * D_ * D_, scr, r % CV_I_OUT, lane); }
}
__device__ __forceinline__ void cv_help(LAS unsigned char* lds, KP p, int maxchunks) {
    const int tid = ftid(), lane = tid & 63, wv = tid >> 6; LAS float* scr = (LAS float*)(lds + wv * 8448);
    unsigned* cursor = WSP(unsigned, O_COUNTS) + 64;
    for (int c = 0; c < maxchunks; ++c) {
        unsigned base = 0u; if (lane == 0) base = atomicAdd(cursor, 8u);
        base = (unsigned)__builtin_amdgcn_readfirstlane((int)base);
        if (base >= (unsigned)CV_DEF_ALL) break;
        for (int i = 0; i < 8; ++i) { const int d = (int)base + i; if (d < CV_DEF_ALL) cv_one(p, scr, d < CV_DEF_GU ? CV_DEF_GU0 + d : CV_DEF_DN0 + (d - CV_DEF_GU), lane); }
    }
}
__device__ __forceinline__ void ph_convert(LAS unsigned char* lds, KP p) {
    const int tid = ftid(), lane = tid & 63, wv = tid >> 6;
    LAS float* scr = (LAS float*)(lds + wv * 8448);
    const int gw = fbid() * 8 + wv, NGW = gridDim.x * 8;
    for (int it = gw; it < CV_N_ALL; it += NGW) {
        if ((it >= CV_DEF_GU0 && it < CV_DEF_GU0 + CV_DEF_GU) || (it >= CV_DEF_DN0 && it < CV_DEF_DN0 + CV_DEF_DN)) continue;
        cv_one(p, scr, it, lane);
    }
    const int gt = fbid() * NT + tid, NG = gridDim.x * NT;
    for (int i = gt; i < L_ * (NPAD - DIN) * (D_ / 8); i += NG) { const int l = i / ((NPAD - DIN) * (D_ / 8)), r = i % ((NPAD - DIN) * (D_ / 8));
        unsigned z_ = 0u; asm volatile("" : "+v"(z_));
        *(u32x4*)(WSP(bf16_t, O_WTIN) + ((size_t)l * NPAD + DIN) * D_ + (size_t)r * 8) = (u32x4){z_, z_, z_, z_}; }
    for (int i = gt; i < L_ * 2 * 2 * 128 * (1024 / 8); i += NG) { const int mtxh = i / (128 * 128), r = i % (128 * 128); unsigned z_ = 0u; asm volatile("" : "+v"(z_));
        *(u32x4*)(WSP(bf16_t, O_WT1) + ((size_t)mtxh * 256 + 128) * 1024 + (size_t)r * 8) = (u32x4){z_, z_, z_, z_}; }
    for (int i = gt; i < L_ * 2 * 64 * 128; i += NG) { const int j = i & 127, seg = (i >> 7) & 63, mtx = i >> 13, ll = mtx >> 1, kv = mtx & 1;
        const float* pos = (kv ? p->in.pos_v : p->in.pos_k) + (size_t)ll * 2048 + seg * 32; const float* w1 = (kv ? p->in.w1v : p->in.w1k) + (size_t)ll * 2048 * 128 + (size_t)seg * 32 * 128; float a = 0.f;
#pragma unroll 8
        for (int k = 0; k < 32; ++k) a += pos[k] * w1[(size_t)k * 128 + j];
        WSP(float, O_BIAS1P)[i] = a; }
    for (int i = gt; i < L_ * NPAD; i += NG) { const int l = i / NPAD, c = i % NPAD; if (c >= DIN) WSP(float, O_BIASP)[i] = 0.f; }
    for (int i = gt; i < L_ * DIN; i += NG) { const int l = i / DIN, n = i % DIN; WSP(float, O_BIASP)[l * NPAD + perm_in(n)] = p->in.b_in[i]; }
    for (int i = gt; i < L_ * NE * D_; i += NG) { const int k = i & (D_ - 1), e = (i >> 10) & (NE - 1), l = i >> 15;
        const float v = p->in.rw[((size_t)l * D_ + k) * NE + e]; const unsigned h = f2bf(v); const float lo = v - bf2f((unsigned short)h);
        WSP(bf16_t, O_RWT)[((size_t)(l * 2 + 0) * NE + e) * D_ + k] = (bf16_t)h; WSP(bf16_t, O_RWT)[((size_t)(l * 2 + 1) * NE + e) * D_ + k] = (bf16_t)f2bf(lo); }
    for (int i = gt; i < T_ * D_ / 8; i += NG) { const f32x4 a = *(const f32x4*)(p->in.x + (size_t)i * 8), b = *(const f32x4*)(p->in.x + (size_t)i * 8 + 4);
        *(u32x4*)(WSP(bf16_t, O_XB) + (size_t)i * 8) = (u32x4){pk2(a.x, a.y), pk2(a.z, a.w), pk2(b.x, b.y), pk2(b.z, b.w)}; }
}

struct EpiProj {
    static constexpr bool PERM = true;
    bf16_t* projb; float* gf; const float* bias;
    __device__ __forceinline__ void operator()(const pg8::f32x4 (&acc)[2][2][4][2], const pg8::Unit& u, int wr, int wc, int fr, int fq) const {
        const int row0 = u.pm * 256 + wr * 64 + fr, col0 = u.pn * 256 + wc * 32 + 8 * fq;
        if (u.pn < 11) {
#pragma unroll
            for (int ai = 0; ai < 2; ++ai)
#pragma unroll
                for (int m = 0; m < 4; ++m) { bf16_t* rowp = projb + (size_t)(row0 + ai * 128 + m * 16) * PB + col0;
#pragma unroll
                    for (int bj = 0; bj < 2; ++bj) { const f32x4 v0 = acc[ai][bj][m][0] + *(const f32x4*)(bias + col0 + bj * 128), v1 = acc[ai][bj][m][1] + *(const f32x4*)(bias + col0 + bj * 128 + 4);
                        u32x4 w; w.x = pg8::cvt_pk_bf16(v0[0], v0[1]); w.y = pg8::cvt_pk_bf16(v0[2], v0[3]); w.z = pg8::cvt_pk_bf16(v1[0], v1[1]); w.w = pg8::cvt_pk_bf16(v1[2], v1[3]);
                        *(u32x4*)(rowp + bj * 128) = w; }
                    asm volatile("" ::: "memory"); }
        } else if (wc == 0) {
            const f32x4 b0 = *(const f32x4*)(bias + col0), b1 = *(const f32x4*)(bias + col0 + 4);
#pragma unroll
            for (int ai = 0; ai < 2; ++ai)
#pragma unroll
                for (int m = 0; m < 4; ++m) { float* rowp = gf + (size_t)(row0 + ai * 128 + m * 16) * 32 + 8 * fq;
                    const f32x4 v0 = acc[ai][0][m][0] + b0, v1 = acc[ai][0][m][1] + b1; f32x4 o0, o1;
#pragma unroll
                    for (int i = 0; i < 4; ++i) { const int j0 = 8 * fq + i, j1 = j0 + 4;
                        o0[i] = (j0 < 24) ? sigmoidf_(v0[i]) : (j0 < 28 ? logsig(v0[i]) : 0.f); o1[i] = (j1 < 24) ? sigmoidf_(v1[i]) : (j1 < 28 ? logsig(v1[i]) : 0.f); }
                    *(f32x4*)rowp = o0; *(f32x4*)(rowp + 4) = o1; }
        }
    }
};
struct EpiOut {
    static constexpr bool PERM = true;
    bf16_t* mixb;
    __device__ __forceinline__ void operator()(const pg8::f32x4 (&acc)[2][2][4][2], const pg8::Unit& u, int wr, int wc, int fr, int fq) const {
        const int row0 = u.pm * 256 + wr * 64 + fr, col0 = u.pn * 256 + wc * 32 + 8 * fq;
#pragma unroll
        for (int ai = 0; ai < 2; ++ai)
#pragma unroll
            for (int m = 0; m < 4; ++m) { bf16_t* rowp = mixb + (size_t)(row0 + ai * 128 + m * 16) * D_ + col0;
#pragma unroll
                for (int bj = 0; bj < 2; ++bj) { const f32x4 v0 = acc[ai][bj][m][0], v1 = acc[ai][bj][m][1];
                    u32x4 w; w.x = pg8::cvt_pk_bf16(v0[0], v0[1]); w.y = pg8::cvt_pk_bf16(v0[2], v0[3]); w.z = pg8::cvt_pk_bf16(v1[0], v1[1]); w.w = pg8::cvt_pk_bf16(v1[2], v1[3]);
                    *(u32x4*)(rowp + bj * 128) = w; }
                asm volatile("" ::: "memory"); }
    }
};
struct EpiGU {
    static constexpr bool PERM = true;
    bf16_t* act; const float* bgu;
    __device__ __forceinline__ void operator()(const pg8::f32x4 (&acc)[2][2][4][2], const pg8::Unit& u, int wr, int wc, int fr, int fq) const {
        const int row0 = u.pm * 256 + wr * 64 + fr, col0 = u.pn * 128 + wc * 32 + 8 * fq;
        const float* bb = bgu + (size_t)u.e * 2048 + col0;
        const f32x4 bg0 = *(const f32x4*)bb, bg1 = *(const f32x4*)(bb + 4), bu0 = *(const f32x4*)(bb + 1024), bu1 = *(const f32x4*)(bb + 1028);
#pragma unroll
        for (int ai = 0; ai < 2; ++ai)
#pragma unroll
            for (int m = 0; m < 4; ++m) { f32x4 a0, a1;
                const f32x4 g0 = acc[ai][0][m][0] + bg0, g1 = acc[ai][0][m][1] + bg1, u0 = acc[ai][1][m][0] + bu0, u1 = acc[ai][1][m][1] + bu1;
#pragma unroll
                for (int i = 0; i < 4; ++i) { const float gt0 = fminf(g0[i], 7.0f), up0 = fminf(fmaxf(u0[i], -7.0f), 7.0f), gt1 = fminf(g1[i], 7.0f), up1 = fminf(fmaxf(u1[i], -7.0f), 7.0f);
                    a0[i] = gt0 * sigmoidf_(1.702f * gt0) * (up0 + 1.0f); a1[i] = gt1 * sigmoidf_(1.702f * gt1) * (up1 + 1.0f); }
                u32x4 w; w.x = pg8::cvt_pk_bf16(a0[0], a0[1]); w.y = pg8::cvt_pk_bf16(a0[2], a0[3]); w.z = pg8::cvt_pk_bf16(a1[0], a1[1]); w.w = pg8::cvt_pk_bf16(a1[2], a1[3]);
                *(u32x4*)(act + (size_t)(row0 + ai * 128 + m * 16) * D_ + col0) = w; asm volatile("" ::: "memory"); }
    }
};
struct EpiDN {
    static constexpr bool PERM = true;
    bf16_t* y; const float* bdn; const float* roww;
    __device__ __forceinline__ void operator()(const pg8::f32x4 (&acc)[2][2][4][2], const pg8::Unit& u, int wr, int wc, int fr, int fq) const {
        const int row0 = u.pm * 256 + wr * 64 + fr, col0 = u.pn * 256 + wc * 32 + 8 * fq;
        const float* bb = bdn + (size_t)u.e * D_ + col0;
#pragma unroll
        for (int ai = 0; ai < 2; ++ai)
#pragma unroll
            for (int m = 0; m < 4; ++m) { const int row = row0 + ai * 128 + m * 16; const float w = roww[row];
#pragma unroll
                for (int bj = 0; bj < 2; ++bj) { const f32x4 v0 = (acc[ai][bj][m][0] + *(const f32x4*)(bb + bj * 128)) * w, v1 = (acc[ai][bj][m][1] + *(const f32x4*)(bb + bj * 128 + 4)) * w;
                    u32x4 o; o.x = pg8::cvt_pk_bf16(v0[0], v0[1]); o.y = pg8::cvt_pk_bf16(v0[2], v0[3]); o.z = pg8::cvt_pk_bf16(v1[0], v1[1]); o.w = pg8::cvt_pk_bf16(v1[2], v1[3]);
                    *(u32x4*)(y + (size_t)row * D_ + col0 + bj * 128) = o; }
                asm volatile("" ::: "memory"); }
    }
};
struct EpiCmp {
    static constexpr bool PERM = true;
    float* hidp;
    __device__ __forceinline__ void operator()(const pg8::f32x4 (&acc)[2][2][4][2], const pg8::Unit& u, int wr, int wc, int fr, int fq) const {
        const int row0 = u.pm * 256 + wr * 64 + fr, col0 = wc * 32 + 8 * fq;
#pragma unroll
        for (int ai = 0; ai < 2; ++ai)
#pragma unroll
            for (int m = 0; m < 4; ++m) { float* d = hidp + (((size_t)u.pn * 8 + u.e) * 512 + row0 + ai * 128 + m * 16) * 128 + col0;
                *(f32x4*)d = acc[ai][0][m][0]; *(f32x4*)(d + 4) = acc[ai][0][m][1]; asm volatile("" ::: "memory"); }
    }
};
struct GEpi {
    static constexpr bool PERM = true;
    int kind, l;
    __device__ __forceinline__ void operator()(const pg8::f32x4 (&acc)[2][2][4][2], const pg8::Unit& u, int wr, int wc, int fr, int fq) const {
        const KP p = fresh_kp();
        if (kind == 0) { const EpiProj e{WSP(bf16_t, O_PROJB), WSP(float, O_GF), WSP(float, O_BIASP) + l * NPAD}; e(acc, u, wr, wc, fr, fq); }
        else if (kind == 1) { const EpiOut e{WSP(bf16_t, O_MIX)}; e(acc, u, wr, wc, fr, fq); }
        else if (kind == 2) { const EpiGU e{WSP(bf16_t, O_ACT), p->in.bgu + (size_t)l * NE * 2048}; e(acc, u, wr, wc, fr, fq); }
        else if (kind == 3) { const EpiDN e{WSP(bf16_t, O_Y), p->in.bdn + (size_t)l * NE * D_, WSP(float, O_ROWW)}; e(acc, u, wr, wc, fr, fq); }
        else { const EpiCmp e{WSP(float, O_HIDP)}; e(acc, u, wr, wc, fr, fq); }
    }
};
struct GSched {
    int kind, nM, nN, nunits, G, c; const int* meta; const int* rowtok; const char* Bt; size_t estep;
    __device__ __forceinline__ bool next(int i, pg8::Unit& u) const {
        const int L = i * G + c; if (L >= nunits) return false;
        if (kind == 1) {
            int wgid = L; { const int q = nunits / pg8::NXCD, r = nunits % pg8::NXCD, xcd = wgid % pg8::NXCD, off = wgid / pg8::NXCD; wgid = (xcd < r ? xcd * (q + 1) : r * (q + 1) + (xcd - r) * q) + off; }
            const int nig = pg8::WGM * nN, gid = wgid / nig, fm = gid * pg8::WGM, gsz = (nM - fm) < pg8::WGM ? (nM - fm) : pg8::WGM;
            u.pm = fm + ((wgid % nig) % gsz); u.pn = (wgid % nig) / gsz; u.e = 0; u.nr = 256;
        } else if (kind == 4) { u.e = L >> 2; u.pm = (L >> 1) & 1; u.pn = L & 1; u.nr = ((L >> 1) & 1) ? 255 : 256; }
        else if (kind == 0) { const int gt = L / nN; u.pm = gt; u.pn = L - gt * nN; u.e = 0; u.nr = 256; }
        else { const int gt = L / nN; u.pm = gt; u.pn = L - gt * nN; u.e = meta[64 + 2 * gt]; u.nr = meta[65 + 2 * gt]; }
        return true; }
    __device__ __forceinline__ unsigned a_off(const pg8::Unit& u, int r) const { const int rr = r < u.nr ? r : u.nr - 1; const int row = u.pm * 256 + rr;
        if (kind == 4) { const int kv = u.e & 1, bg = u.e >> 1; return (unsigned)(((bg >> 1) * S_ + 16 * row + 16 * u.pn) * PB + C_KV + ((0 * 2 + kv) * 2 + (bg & 1)) * 64) * 2u; }
        return (unsigned)((kind == 2) ? rowtok[row] : row) * (unsigned)(D_ * 2); }
    __device__ __forceinline__ size_t a_kstep() const { return kind == 4 ? (size_t)PB * 2 : (size_t)128; }
    __device__ __forceinline__ const char* b_base(const pg8::Unit& u) const { return Bt + (size_t)(kind == 4 ? (u.e & 1) : u.e) * estep + (size_t)u.pn * ((size_t)256 * D_ * 2); }
};

__device__ __forceinline__ void ph_rmsnorm(KP p, int l) {
    const int lane = ftid() & 63, wv = ftid() >> 6; const float* g = p->in.g_out + (size_t)l * D_;
    constexpr int NB = 4; const int rstride = (int)gridDim.x * 8;
    f32x4 gg[4];
#pragma unroll
    for (int j = 0; j < 2; ++j) { gg[2 * j] = *(const f32x4*)(g + 512 * j + lane * 8); gg[2 * j + 1] = *(const f32x4*)(g + 512 * j + lane * 8 + 4); }
    for (int row0 = fbid() * 8 + wv; row0 < T_; row0 += rstride * NB) {
        u32x4 ra[NB], rb2[NB], rw2[NB];
#pragma unroll
        for (int bi = 0; bi < NB; ++bi) { const int row = (row0 + bi * rstride < T_) ? row0 + bi * rstride : row0; const bf16_t* r = WSP(bf16_t, O_O) + (size_t)row * D_ + lane * 8;
            ra[bi] = *(const u32x4*)r; rb2[bi] = *(const u32x4*)(r + 512); rw2[bi] = *(const u32x4*)(WSP(bf16_t, O_OWIN) + (size_t)row * 512 + lane * 8); }
#pragma unroll
        for (int bi = 0; bi < NB; ++bi) { const int row = row0 + bi * rstride; if (row < T_) {
#define BF_LO(u) __uint_as_float((u) << 16)
#define BF_HI(u) __uint_as_float((u) & 0xffff0000u)
            const f32x4 x0 = (f32x4){BF_LO(ra[bi].x) + BF_LO(rw2[bi].x), BF_HI(ra[bi].x) + BF_HI(rw2[bi].x), BF_LO(ra[bi].y) + BF_LO(rw2[bi].y), BF_HI(ra[bi].y) + BF_HI(rw2[bi].y)};
            const f32x4 x1 = (f32x4){BF_LO(ra[bi].z) + BF_LO(rw2[bi].z), BF_HI(ra[bi].z) + BF_HI(rw2[bi].z), BF_LO(ra[bi].w) + BF_LO(rw2[bi].w), BF_HI(ra[bi].w) + BF_HI(rw2[bi].w)};
            const f32x4 y0 = (f32x4){BF_LO(rb2[bi].x), BF_HI(rb2[bi].x), BF_LO(rb2[bi].y), BF_HI(rb2[bi].y)}, y1 = (f32x4){BF_LO(rb2[bi].z), BF_HI(rb2[bi].z), BF_LO(rb2[bi].w), BF_HI(rb2[bi].w)};
#undef BF_LO
#undef BF_HI
            float s = (x0.x * x0.x + x0.y * x0.y) + (x0.z * x0.z + x0.w * x0.w) + (x1.x * x1.x + x1.y * x1.y) + (x1.z * x1.z + x1.w * x1.w);
            float s2 = (y0.x * y0.x + y0.y * y0.y) + (y0.z * y0.z + y0.w * y0.w) + (y1.x * y1.x + y1.y * y1.y) + (y1.z * y1.z + y1.w * y1.w);
            const float sc0 = rsqrtf(wsum(s) * (1.f / 512.f) + RMS_EPS);
#pragma unroll
            for (int o = 1; o < 32; o <<= 1) s2 += __shfl_xor(s2, o);
            const float sc1 = rsqrtf(s2 * (1.f / 256.f) + RMS_EPS);
            const f32x4 u0 = x0 * sc0 * gg[0], u1 = x1 * sc0 * gg[1], w0 = y0 * sc1 * gg[2], w1 = y1 * sc1 * gg[3];
            bf16_t* ro = WSP(bf16_t, O_OB) + (size_t)row * D_;
            *(u32x4*)(ro + lane * 8) = (u32x4){pk2(u0.x, u0.y), pk2(u0.z, u0.w), pk2(u1.x, u1.y), pk2(u1.z, u1.w)};
            *(u32x4*)(ro + 512 + lane * 8) = (u32x4){pk2(w0.x, w0.y), pk2(w0.z, w0.w), pk2(w1.x, w1.y), pk2(w1.z, w1.w)}; } }
    }
}
template <bool ROUTER>
__device__ __forceinline__ void ph_ln(float* lds, KP p, int l, float* __restrict__ yout, int cnt_off = 0) {
    const int lane = ftid() & 63, wv = ftid() >> 6;
    const float* g = (ROUTER ? p->in.ln1_g : p->in.ln2_g) + (size_t)l * D_; const float* bb = (ROUTER ? p->in.ln1_b : p->in.ln2_b) + (size_t)l * D_;
    constexpr int NB = ROUTER ? 4 : 2;
    const int rstride = (int)gridDim.x * 8;
    LAS unsigned char* L3 = (LAS unsigned char*)lds; float* lgl = lds + 33024 + wv * 256;
    int oi = 0;
    for (int row0 = fbid() * 8 + wv; row0 < T_; row0 += rstride * NB, ++oi) {
        float v[NB][16];
        if (ROUTER) { const float* xin = (l == 0) ? p->in.x : WSP(float, O_XA);
#pragma unroll
            for (int bi = 0; bi < NB; ++bi) { const int row = (row0 + bi * rstride < T_) ? row0 + bi * rstride : row0; const float* src = xin + (size_t)row * D_; const bf16_t* mx = WSP(bf16_t, O_MIX) + (size_t)row * D_;
#pragma unroll
                for (int j = 0; j < 2; ++j) { const f32x4 a = *(const f32x4*)(src + 512 * j + lane * 8), b = *(const f32x4*)(src + 512 * j + lane * 8 + 4); const u32x4 q = *(const u32x4*)(mx + 512 * j + lane * 8);
                    v[bi][8 * j + 0] = ALPHA * a.x + __uint_as_float(q.x << 16); v[bi][8 * j + 1] = ALPHA * a.y + __uint_as_float(q.x & 0xffff0000u); v[bi][8 * j + 2] = ALPHA * a.z + __uint_as_float(q.y << 16); v[bi][8 * j + 3] = ALPHA * a.w + __uint_as_float(q.y & 0xffff0000u);
                    v[bi][8 * j + 4] = ALPHA * b.x + __uint_as_float(q.z << 16); v[bi][8 * j + 5] = ALPHA * b.y + __uint_as_float(q.z & 0xffff0000u); v[bi][8 * j + 6] = ALPHA * b.z + __uint_as_float(q.w << 16); v[bi][8 * j + 7] = ALPHA * b.w + __uint_as_float(q.w & 0xffff0000u); } }
        } else { const bf16_t* y = WSP(bf16_t, O_Y);
            int sl[NB][TOPK];
#pragma unroll
            for (int bi = 0; bi < NB; ++bi) { const int row = (row0 + bi * rstride < T_) ? row0 + bi * rstride : row0;
#pragma unroll
                for (int k = 0; k < TOPK; ++k) sl[bi][k] = WSP(int, O_SLOT)[row * TOPK + k]; }
            u32x4 yv[NB][TOPK][2]; f32x4 xv[NB][4];
#pragma unroll
            for (int bi = 0; bi < NB; ++bi) { const int row = (row0 + bi * rstride < T_) ? row0 + bi * rstride : row0; const float* src = WSP(float, O_X1) + (size_t)row * D_;
#pragma unroll
                for (int j = 0; j < 2; ++j) { xv[bi][2 * j] = *(const f32x4*)(src + 512 * j + lane * 8); xv[bi][2 * j + 1] = *(const f32x4*)(src + 512 * j + lane * 8 + 4); }
#pragma unroll
                for (int k = 0; k < TOPK; ++k)
#pragma unroll
                    for (int j = 0; j < 2; ++j) yv[bi][k][j] = *(const u32x4*)(y + (size_t)sl[bi][k] * D_ + 512 * j + lane * 8); }
#pragma unroll
            for (int bi = 0; bi < NB; ++bi)
#pragma unroll
                for (int j = 0; j < 2; ++j) { float acc[8];
#pragma unroll
                    for (int e = 0; e < 8; ++e) acc[e] = 0.f;
#pragma unroll
                    for (int k = 0; k < TOPK; ++k) { const u32x4 q = yv[bi][k][j];
                        acc[0] += __uint_as_float(q.x << 16); acc[1] += __uint_as_float(q.x & 0xffff0000u); acc[2] += __uint_as_float(q.y << 16); acc[3] += __uint_as_float(q.y & 0xffff0000u);
                        acc[4] += __uint_as_float(q.z << 16); acc[5] += __uint_as_float(q.z & 0xffff0000u); acc[6] += __uint_as_float(q.w << 16); acc[7] += __uint_as_float(q.w & 0xffff0000u); }
                    const f32x4 a = xv[bi][2 * j], b = xv[bi][2 * j + 1];
                    v[bi][8 * j + 0] = ALPHA * a.x + acc[0]; v[bi][8 * j + 1] = ALPHA * a.y + acc[1]; v[bi][8 * j + 2] = ALPHA * a.z + acc[2]; v[bi][8 * j + 3] = ALPHA * a.w + acc[3];
                    v[bi][8 * j + 4] = ALPHA * b.x + acc[4]; v[bi][8 * j + 5] = ALPHA * b.y + acc[5]; v[bi][8 * j + 6] = ALPHA * b.z + acc[6]; v[bi][8 * j + 7] = ALPHA * b.w + acc[7]; } }
#pragma unroll
        for (int bi = 0; bi < NB; ++bi) { const int row = row0 + bi * rstride; if (row < T_) {
            float s = 0.f;
#pragma unroll
            for (int i = 0; i < 16; ++i) s += v[bi][i];
            const float mu = wsum(s) * (1.f / D_); float s2 = 0.f;
#pragma unroll
            for (int i = 0; i < 16; ++i) { v[bi][i] -= mu; s2 += v[bi][i] * v[bi][i]; }
            const float rstd = rsqrtf(wsum(s2) * (1.f / D_) + LN_EPS);
            bf16_t* ybf = (ROUTER ? WSP(bf16_t, O_X1B) : WSP(bf16_t, O_XB)) + (size_t)row * D_;
#pragma unroll
            for (int j = 0; j < 2; ++j) { const int c0 = 512 * j + lane * 8; float o8[8];
                const f32x4 g0 = *(const f32x4*)(g + c0), g1 = *(const f32x4*)(g + c0 + 4), b0 = *(const f32x4*)(bb + c0), b1 = *(const f32x4*)(bb + c0 + 4);
                o8[0] = v[bi][8 * j + 0] * rstd * g0.x + b0.x; o8[1] = v[bi][8 * j + 1] * rstd * g0.y + b0.y; o8[2] = v[bi][8 * j + 2] * rstd * g0.z + b0.z; o8[3] = v[bi][8 * j + 3] * rstd * g0.w + b0.w;
                o8[4] = v[bi][8 * j + 4] * rstd * g1.x + b1.x; o8[5] = v[bi][8 * j + 5] * rstd * g1.y + b1.y; o8[6] = v[bi][8 * j + 6] * rstd * g1.z + b1.z; o8[7] = v[bi][8 * j + 7] * rstd * g1.w + b1.w;
                *(f32x4*)(yout + (size_t)row * D_ + c0) = (f32x4){o8[0], o8[1], o8[2], o8[3]};
                *(f32x4*)(yout + (size_t)row * D_ + c0 + 4) = (f32x4){o8[4], o8[5], o8[6], o8[7]};
                const u32x4 hv = (u32x4){pk2(o8[0], o8[1]), pk2(o8[2], o8[3]), pk2(o8[4], o8[5]), pk2(o8[6], o8[7])};
                *(u32x4*)(ybf + c0) = hv;
                if (ROUTER) {
                    float r8[8];
#pragma unroll
                    for (int i = 0; i < 4; ++i) { const unsigned w_ = (i == 0) ? hv.x : (i == 1) ? hv.y : (i == 2) ? hv.z : hv.w; r8[2 * i] = o8[2 * i] - __uint_as_float(w_ << 16); r8[2 * i + 1] = o8[2 * i + 1] - __uint_as_float(w_ & 0xffff0000u); }
                    LAS unsigned char* tp = L3 + (bi * 8 + wv) * 2064 + c0 * 2;
                    *(LAS u32x4*)tp = hv; *(LAS u32x4*)(tp + 66048) = (u32x4){pk2(r8[0], r8[1]), pk2(r8[2], r8[3]), pk2(r8[4], r8[5]), pk2(r8[6], r8[7])}; } } } }
        if (ROUTER) {
            __syncthreads();
            const int n32 = lane & 31, hh = lane >> 5;
            f32x16 acc;
#pragma unroll
            for (int r = 0; r < 16; ++r) acc[r] = 0.f;
            { const bf16_t* bh = WSP(bf16_t, O_RWT) + ((size_t)(l * 2) * NE + n32) * D_ + 128 * wv + 8 * hh; const bf16_t* bl = bh + (size_t)NE * D_;
              const LAS unsigned char* ah = L3 + n32 * 2064 + (128 * wv + 8 * hh) * 2;
              bf16x8 bhf[8], blf[8];
#pragma unroll
              for (int s_ = 0; s_ < 8; ++s_) { bhf[s_] = *(const bf16x8*)(bh + 16 * s_); blf[s_] = *(const bf16x8*)(bl + 16 * s_); }
#pragma unroll
              for (int s_ = 0; s_ < 8; ++s_) { const bf16x8 xh = *(const LAS bf16x8*)(ah + 32 * s_), xl = *(const LAS bf16x8*)(ah + 66048 + 32 * s_);
                  acc = __builtin_amdgcn_mfma_f32_32x32x16_bf16(xh, bhf[s_], acc, 0, 0, 0); acc = __builtin_amdgcn_mfma_f32_32x32x16_bf16(xh, blf[s_], acc, 0, 0, 0); acc = __builtin_amdgcn_mfma_f32_32x32x16_bf16(xl, bhf[s_], acc, 0, 0, 0); } }
            __syncthreads();
            { LAS float* red = (LAS float*)L3;
#pragma unroll
              for (int r = 0; r < 16; ++r) red[(wv * 32 + CROW(r, hh)) * 32 + n32] = acc[r];
              __syncthreads();
#pragma unroll
              for (int bi = 0; bi < NB; ++bi) { const int m = bi * 8 + wv; float sm = 0.f;
#pragma unroll
                  for (int q = 0; q < 4; ++q) sm += red[((hh * 4 + q) * 32 + m) * 32 + n32];
                  sm += __shfl_xor(sm, 32);
                  if (lane < 32) lgl[(NB * oi + bi) * 32 + n32] = sm; } }
            __syncthreads();
        }
    }
    if (ROUTER) {
        const float* rb = p->in.rb + (size_t)l * NE;
        int nrow = 0; for (int r_ = fbid() * 8 + wv; r_ < T_; r_ += (int)gridDim.x * 8) { ++nrow; asm volatile("" : "+s"(nrow)); }
        asm volatile("s_waitcnt lgkmcnt(0)" ::: "memory");
        int* lcnt = (int*)(lds + 33024 + 8 * 256);
        if (ftid() < NE) lcnt[ftid()] = 0;
        __syncthreads();
#pragma unroll 1
        for (int ri = 0; ri < nrow; ++ri) { const int row = fbid() * 8 + wv + ri * (int)gridDim.x * 8;
            const int e = lane & 31; const float lg = lgl[ri * 32 + e] + rb[e];
            float cur = lg, tv0 = 0.f, den = 0.f, myw = 0.f; int mye = 0;
#pragma unroll
            for (int k = 0; k < TOPK; ++k) { float bv = cur; int bi = e;
#pragma unroll
                for (int o = 16; o >= 1; o >>= 1) { const float ov = __shfl_xor(bv, o); const int oi = __shfl_xor(bi, o); if (ov > bv || (ov == bv && oi < bi)) { bv = ov; bi = oi; } }
                if (k == 0) tv0 = bv;
                const float w = __expf(bv - tv0); den += w;
                if (lane == k) { mye = bi; myw = w; }
                if (e == bi) cur = -3.4e38f; }
            if (lane < TOPK) { WSP(int, O_TOPE)[row * TOPK + lane] = mye; WSP(float, O_TOPW)[row * TOPK + lane] = myw / den; WSP(int, O_POS)[row * TOPK + lane] = atomicAdd(&lcnt[mye], 1); } }
        __syncthreads();
        if (ftid() < NE) { const int c = lcnt[ftid()]; lcnt[ftid()] = (c > 0) ? atomicAdd(WSP(int, O_COUNTS) + CNT_IDX(l, ftid()) + cnt_off, c) : 0; }
        __syncthreads();
#pragma unroll 1
        for (int ri = 0; ri < nrow; ++ri) { const int row = fbid() * 8 + wv + ri * (int)gridDim.x * 8;
            if (lane < TOPK) WSP(int, O_POS)[row * TOPK + lane] += lcnt[WSP(int, O_TOPE)[row * TOPK + lane]]; }
        __syncthreads();
    }
}
__device__ __forceinline__ void ph_bias1_reduce(KP p, int l) {
    if (fbid() != (int)gridDim.x - 1) return;
    const int tid = ftid(); if (tid < 256) { const float* pp = WSP(float, O_BIAS1P) + ((size_t)(l * 2 + (tid >> 7)) * 64) * 128 + (tid & 127);
        float v[64];
#pragma unroll
        for (int s = 0; s < 64; ++s) v[s] = pp[s * 128];
        float a = 0.f;
#pragma unroll
        for (int s = 0; s < 64; ++s) a += v[s];
        WSP(float, O_BIAS1)[l * 256 + tid] = a; }
}
__device__ __forceinline__ void ph_cumsum(float* lds, KP p, int blk0) {
    const int tid = ftid(), lane = tid & 63, wv = tid >> 6; const int bh = fbid() - blk0;
    if (bh < 0 || bh >= B_ * 4) return;
    const int b = bh >> 2, h = bh & 3; const float* gf = WSP(float, O_GF) + (size_t)(b * S_ + tid * 16) * 32 + 24 + h;
    float v[16], run = 0.f;
#pragma unroll
    for (int i = 0; i < 16; ++i) { run += gf[(size_t)i * 32]; v[i] = run; }
    float inc = run;
#pragma unroll
    for (int o = 1; o < 64; o <<= 1) { const float t = __shfl_up(inc, o); if (lane >= o) inc += t; }
    if (lane == 63) lds[wv] = inc;
    __syncthreads();
    float woff = 0.f;
#pragma unroll
    for (int i = 0; i < 8; ++i) woff += (i < wv) ? lds[i] : 0.f;
    const float off = woff + inc - run; float* c = WSP(float, O_CFOX) + (size_t)bh * S_ + tid * 16;
#pragma unroll
    for (int i = 0; i < 4; ++i) *(f32x4*)(c + 4 * i) = (f32x4){v[4 * i] + off, v[4 * i + 1] + off, v[4 * i + 2] + off, v[4 * i + 3] + off};
    __syncthreads();
}
__device__ __forceinline__ void ph_prep2(float* lds, KP p, int l) {
    { unsigned* kmax2 = WSP(unsigned, O_COUNTS) + 192 + l * 8;
      for (int i = fbid() * NT + ftid(); i < B_ * 4 * S_ * 2; i += gridDim.x * NT) { const int half = i & 1, t = (i >> 1) % S_, bh = (i >> 1) / S_, b = bh >> 2, h = bh & 3;
          const bf16_t* kr = WSP(bf16_t, O_PROJB) + (size_t)(b * S_ + t) * PB + C_FOX + (4 + h) * 64 + half * 32; float ss = 0.f;
#pragma unroll
          for (int c = 0; c < 4; ++c) { float k8[8]; ld8(kr + 8 * c, k8);
#pragma unroll
              for (int e = 0; e < 8; ++e) ss += k8[e] * k8[e]; }
          ss += __shfl_xor(ss, 1);
#pragma unroll
          for (int o = 2; o < 64; o <<= 1) ss = fmaxf(ss, __shfl_xor(ss, o));
          __syncthreads();
          if ((ftid() & 63) == 0) lds[ftid() >> 6] = ss;
          __syncthreads();
          if (ftid() == 0) { float mx = lds[0];
#pragma unroll
              for (int w_ = 1; w_ < 8; ++w_) mx = fmaxf(mx, lds[w_]);
              atomicMax(kmax2 + bh, __float_as_uint(mx)); } } }
    for (int i = fbid() * NT + ftid(); i < 8 * 512 * 64; i += gridDim.x * NT) {
        const int d = i & 63, n = (i >> 6) & 511, combo = i >> 15, kv = combo & 1, bg = combo >> 1;
        const float* w2 = (kv ? p->in.w2v : p->in.w2k) + (size_t)l * 128 * 64; const float* h0 = WSP(float, O_HIDP) + ((size_t)combo * 512 + n) * 128; const float* h1 = h0 + (size_t)8 * 512 * 128;
        const float* b1 = WSP(float, O_BIAS1) + l * 256 + kv * 128;
        __syncthreads();
#pragma unroll
        for (int q = 0; q < 4; ++q) *(f32x4*)(lds + 16 + 4 * (q * NT + ftid())) = *(const f32x4*)(w2 + 4 * (q * NT + ftid()));
        const float hv0 = gelu_tanh(h0[d] + h1[d] + b1[d]), hv1 = gelu_tanh(h0[64 + d] + h1[64 + d] + b1[64 + d]);
        __syncthreads();
        const float* w2s = lds + 16 + d;
        float a = 0.f;
#pragma unroll 16
        for (int c = 0; c < 64; ++c) a += __int_as_float(__builtin_amdgcn_readlane(__float_as_int(hv0), c)) * w2s[c * 64];
#pragma unroll 16
        for (int c = 0; c < 64; ++c) a += __int_as_float(__builtin_amdgcn_readlane(__float_as_int(hv1), c)) * w2s[(64 + c) * 64];
        (kv ? WSP(bf16_t, O_VCMPB) : WSP(bf16_t, O_KCMPB))[((size_t)bg * 512 + n) * 64 + d] = (n < NCMP) ? (bf16_t)f2bf(a) : (bf16_t)0; }
}
__device__ __forceinline__ void ph_moe_scatter2(float* lds, KP p, int l) {
    const int tid = ftid(); int* ts = (int*)lds;
    const int* counts = WSP(int, O_COUNTS) + CNT_IDX(l, 0); int* meta = WSP(int, O_META); int* cl = ts + 64;
    __syncthreads();
    if (tid < NE) cl[tid] = counts[tid * 32];
    __syncthreads();
    if (tid == 0) { int nt = 0; for (int e = 0; e < NE; ++e) { ts[e] = nt; nt += (cl[e] + 255) >> 8; } ts[32] = nt; }
    __syncthreads();
    if (fbid() == 0) { if (tid < NE) { const int c = cl[tid], t0 = ts[tid]; meta[tid] = t0; for (int r = 0, t = t0; r < c; r += 256, ++t) { meta[64 + 2 * t] = tid; meta[65 + 2 * t] = (c - r) < 256 ? (c - r) : 256; } }
        if (tid == 0) meta[32] = ts[32]; }
    for (int i = fbid() * NT + tid; i < MROWS; i += gridDim.x * NT) {
        const int row = ts[WSP(int, O_TOPE)[i]] * 256 + WSP(int, O_POS)[i];
        WSP(int, O_ROWTOK)[row] = i >> 2; WSP(float, O_ROWW)[row] = WSP(float, O_TOPW)[i]; WSP(int, O_SLOT)[i] = row; }
    __syncthreads();
}
}
namespace mk {
typedef short bf16x8 __attribute__((ext_vector_type(8)));
typedef float f32x16 __attribute__((ext_vector_type(16)));
typedef float f32x2_t __attribute__((ext_vector_type(2)));
typedef __bf16 bf16x2_t __attribute__((ext_vector_type(2)));
typedef unsigned u32x2 __attribute__((ext_vector_type(2)));
typedef short v4i16_t __attribute__((ext_vector_type(4)));
__device__ __forceinline__ unsigned cvtpk(float lo, float hi) { f32x2_t v = {lo, hi}; bf16x2_t b = __builtin_convertvector(v, bf16x2_t); return __builtin_bit_cast(unsigned, b); }
constexpr int KROW = 144, VROW = 136;
constexpr int E1_K = 0, E1_V = 64 * KROW, E1_C = E1_V + 64 * KROW, E1_BUF = E1_C + 256;
constexpr int E1_FLAGS = 2 * E1_BUF;
constexpr float LOG2E = 1.4426950408889634f;
constexpr float RESC_THR = 8.0f;
#define CROW(reg, hh) (((reg) & 3) + 8 * ((reg) >> 2) + 4 * (hh))

__device__ __forceinline__ float max3f(float a, float b, float c) { float r; asm("v_max3_f32 %0, %1, %2, %3" : "=v"(r) : "v"(a), "v"(b), "v"(c)); return r; }
typedef float f32x2_t __attribute__((ext_vector_type(2)));
__device__ __forceinline__ float lane32_other(float x, int hh) { const auto rr = __builtin_amdgcn_permlane32_swap(__float_as_uint(x), __float_as_uint(x), false, false); return __uint_as_float(hh ? rr[0] : rr[1]); }
#define SM_V(p0, p1, i_) (((i_) & 1) ? p1[(i_) >> 1] : p0[(i_) >> 1])
#define SM_ROWMAX(p0, p1, rm_) do { \
    rm_ = max3f(p0[0], p1[0], p0[1]); \
    _Pragma("unroll") for (int k_ = 0; k_ < 14; ++k_) rm_ = max3f(rm_, SM_V(p0, p1, 3 + 2 * k_), SM_V(p0, p1, 4 + 2 * k_)); \
    rm_ = max3f(rm_, p1[15], p1[15]); \
    { const auto rr_ = __builtin_amdgcn_permlane32_swap(__float_as_uint(rm_), __float_as_uint(rm_), false, false);     \
      rm_ = max3f(__uint_as_float(rr_[0]), __uint_as_float(rr_[1]), __uint_as_float(rr_[1])); } } while (0)
#define SM_CORE(p0, p1, m, l, have, o0, o1) do { \
    float rm_; SM_ROWMAX(p0, p1, rm_); \
    const bool fin_ = rm_ > -1e37f; \
    if (__any((rm_ > RESC_THR) || (!have && fin_))) { \
        const float dl_ = have ? fmaxf(rm_, 0.f) : (fin_ ? rm_ : 0.f); const float al_ = have ? __builtin_amdgcn_exp2f(-dl_) : 1.f; \
        m += dl_; l *= al_; have = have || fin_; \
        _Pragma("unroll") for (int r_ = 0; r_ < 16; ++r_) { o0[r_] *= al_; o1[r_] *= al_; p0[r_] -= dl_; p1[r_] -= dl_; } } \
    f32x2_t ls2_ = {0.f, 0.f}; \
    _Pragma("unroll") for (int reg_ = 0; reg_ < 16; reg_ += 2) { \
        p0[reg_] = __builtin_amdgcn_exp2f(p0[reg_]); p0[reg_ + 1] = __builtin_amdgcn_exp2f(p0[reg_ + 1]); p1[reg_] = __builtin_amdgcn_exp2f(p1[reg_]); p1[reg_ + 1] = __builtin_amdgcn_exp2f(p1[reg_ + 1]); \
        ls2_ += (f32x2_t){p0[reg_], p0[reg_ + 1]}; ls2_ += (f32x2_t){p1[reg_], p1[reg_ + 1]}; } \
    l += ls2_.x + ls2_.y; } while (0)

struct E1Geom { int b, q0, h; const bf16_t* qp; const bf16_t* kp; const bf16_t* vp; size_t pitch; };

template <int KIND>
__device__ __forceinline__ void e1_unit(LAS unsigned char* lds, KP p, int b, int hg, int qb, bf16_t* __restrict__ obase, bf16_t* __restrict__ owin, const unsigned* __restrict__ kmax2) {
    const int tid = ftid(), lane = tid & 63, w = __builtin_amdgcn_readfirstlane(tid >> 6), r32 = lane & 31, hh = lane >> 5;
    const bf16_t* projb = WSP(bf16_t, O_PROJB);
    int h, q0, qrow0, qcol, kcol, vcol, nrows;
    if (KIND == 0) { h = hg; q0 = qb * 256; qrow0 = q0 + 32 * w; qcol = C_FOX + h * 64; kcol = C_FOX + (4 + h) * 64; vcol = C_FOX + (8 + h) * 64; nrows = 256; }
    else if (KIND == 2) { h = hg; q0 = qb * 256; qrow0 = q0 + 32 * w; qcol = C_SB + h * 64; kcol = C_SB + (4 + h) * 64; vcol = C_SB + (8 + h) * 64; nrows = 256; }
    else { h = 4 * hg + (w & 3); q0 = qb * 64; qrow0 = q0 + 32 * (w >> 2); qcol = h * 64; kcol = C_KV + ((2 * 2 + 0) * 2 + hg) * 64; vcol = C_KV + ((2 * 2 + 1) * 2 + hg) * 64; nrows = 64; }
    const int tq = qrow0 + r32;
    const bf16_t* kbase = projb + (size_t)(b * S_) * PB + kcol; const bf16_t* vbase = projb + (size_t)(b * S_) * PB + vcol;
    bf16x8 qf[4];
    { const bf16_t* qptr = projb + (size_t)(b * S_ + tq) * PB + qcol + 8 * hh;
#pragma unroll
      for (int d0 = 0; d0 < 4; ++d0) qf[d0] = *(const bf16x8*)(qptr + 16 * d0);
      if (KIND == 1) {
#pragma unroll
          for (int d0 = 0; d0 < 4; ++d0) { u32x4 w_;
#pragma unroll
              for (int e2 = 0; e2 < 4; ++e2) { const float lo_ = bf2f((unsigned short)qf[d0][2 * e2]) * (SCALE * LOG2E), hi_ = bf2f((unsigned short)qf[d0][2 * e2 + 1]) * (SCALE * LOG2E); w_[e2] = cvtpk(lo_, hi_); }
              qf[d0] = __builtin_bit_cast(bf16x8, w_); } } }
    int j0 = 0; const int j1 = (q0 + nrows - 1) >> 6;
    if (KIND == 1) { j0 = (q0 - 511) >> 6; if (j0 < 0) j0 = 0; }
    const int ntile = j1 - j0 + 1;
    float ct2 = 0.f, sl2 = 0.f; const float* cb = nullptr;
    if (KIND == 0) { cb = WSP(float, O_CFOX) + (size_t)(b * 4 + h) * S_; ct2 = cb[tq] * LOG2E; }
    if (KIND == 1) sl2 = exp2f(-(float)(h + 1)) * LOG2E;
    bf16x8 kx0 = {0, 0, 0, 0, 0, 0, 0, 0}, kx1 = {0, 0, 0, 0, 0, 0, 0, 0}; float sl2h = 0.f, sl2l = 0.f;
    if (KIND == 1) { const unsigned one_ = 0x3f80u; const unsigned k0_ = f2bf((float)r32), k1_ = f2bf((float)(r32 + 32));
        if (hh == 0) { kx0 = __builtin_bit_cast(bf16x8, (u32x4){k0_ | (k0_ << 16), one_ | (one_ << 16), one_, 0u}); kx1 = __builtin_bit_cast(bf16x8, (u32x4){k1_ | (k1_ << 16), one_ | (one_ << 16), one_, 0u}); }
        sl2h = bf2f((unsigned short)f2bf(sl2)); sl2l = sl2 - sl2h; }
    float qkb = 0.f;
    if (KIND == 0) { float qs = 0.f;
#pragma unroll
        for (int d0 = 0; d0 < 4; ++d0)
#pragma unroll
            for (int e = 0; e < 8; ++e) { const float x = bf2f((unsigned short)qf[d0][e]); qs += x * x; }
        qs += __shfl_xor(qs, 32);
        const float km2 = __uint_as_float(kmax2[b * 4 + h]);
        qkb = sqrtf(qs * km2) * (SCALE * LOG2E * 1.01f); }
    const float tqf = (float)tq;
    const int skey = tid >> 3, sch = tid & 7;
    u32x4 rk, rv; float rc = 0.f;
#define E1_LOAD(jj) do { const size_t ro_ = (size_t)((jj) * 64 + skey) * PB + sch * 8; rk = *(const u32x4*)(kbase + ro_); rv = *(const u32x4*)(vbase + ro_); \
        if (KIND == 0 && tid < 64) rc = cb[(jj) * 64 + tid] * LOG2E; } while (0)
#define E1_WRITE(bufp) do { *(LAS u32x4*)((bufp) + E1_K + skey * KROW + sch * 16) = rk; *(LAS u32x4*)((bufp) + E1_V + skey * KROW + sch * 16) = rv; \
        if (KIND == 0 && tid < 64) ((LAS float*)((bufp) + E1_C))[tid] = rc; } while (0)
    f32x16 o0, o1;
#pragma unroll
    for (int r = 0; r < 16; ++r) { o0[r] = 0.f; o1[r] = 0.f; }
    float m = 0.f, l = 0.f, carry = 0.f; bool have = false;
    bool wave_done = false;
    LAS unsigned* flags = (LAS unsigned*)(lds + E1_FLAGS);
    if (KIND != 1) { if (tid < 8) flags[tid] = 0u; }
    __syncthreads();
    E1_LOAD(KIND != 1 ? j1 : j0);
    for (int it = 0; it < ntile; ++it) {
        const int j = (KIND != 1) ? (j1 - it) : (j0 + it);
        LAS unsigned char* buf = lds + (it & 1) * E1_BUF;
        E1_WRITE(buf);
        __syncthreads();
        if (KIND != 1) { unsigned alld = 1u;
#pragma unroll
            for (int i = 0; i < 8; ++i) alld &= flags[i];
            if (alld) break; }
        if (it + 1 < ntile) E1_LOAD((KIND != 1) ? (j - 1) : (j + 1));
        if (!(KIND != 1 && wave_done)) {
            f32x16 p0, p1;
#pragma unroll
            for (int r = 0; r < 16; ++r) { p0[r] = 0.f; p1[r] = 0.f; }
            { const LAS unsigned char* kp_ = buf + E1_K + r32 * KROW + hh * 16;
#pragma unroll
              for (int d0 = 0; d0 < 4; ++d0) { const bf16x8 a0 = *(const LAS bf16x8*)(kp_ + d0 * 32), a1 = *(const LAS bf16x8*)(kp_ + 32 * KROW + d0 * 32);
                  p0 = __builtin_amdgcn_mfma_f32_32x32x16_bf16(a0, qf[d0], p0, 0, 0, 0); p1 = __builtin_amdgcn_mfma_f32_32x32x16_bf16(a1, qf[d0], p1, 0, 0, 0); } }
            const int kb = j * 64 + 4 * hh;
            if (KIND == 2) {
                float lk0[16], lk1[16], gs[8];
#pragma unroll
                for (int reg = 0; reg < 16; ++reg) { const int kpos = kb + CROW(reg, 0);
                    const float z0 = p0[reg] * SCALE, z1 = p1[reg] * SCALE; const bool v0 = kpos < tq, v1 = kpos + 32 < tq;
                    const float lb0 = fminf(z0, 0.f) - __logf(1.f + __expf(-fabsf(z0))), lb1 = fminf(z1, 0.f) - __logf(1.f + __expf(-fabsf(z1)));
                    lk0[reg] = v0 ? (lb0 - z0) : 0.f; lk1[reg] = v1 ? (lb1 - z1) : 0.f;
                    p0[reg] = v0 ? lb0 : -INFINITY; p1[reg] = v1 ? lb1 : -INFINITY; }
#pragma unroll
                for (int g4 = 0; g4 < 4; ++g4) { gs[g4] = (lk0[4 * g4] + lk0[4 * g4 + 1]) + (lk0[4 * g4 + 2] + lk0[4 * g4 + 3]); gs[4 + g4] = (lk1[4 * g4] + lk1[4 * g4 + 1]) + (lk1[4 * g4 + 2] + lk1[4 * g4 + 3]); }
                float oth[8];
#pragma unroll
                for (int gi = 0; gi < 8; ++gi) oth[gi] = lane32_other(gs[gi], hh);
                float run = 0.f;
#pragma unroll
                for (int gi = 7; gi >= 0; --gi) {
                    float later = carry + run + (hh == 0 ? oth[gi] : 0.f);
#pragma unroll
                    for (int e = 3; e >= 0; --e) { const int reg = (gi & 3) * 4 + e;
                        if (gi >> 2) { p1[reg] = __expf(p1[reg] + later); later += lk1[reg]; } else { p0[reg] = __expf(p0[reg] + later); later += lk0[reg]; } }
                    run += gs[gi] + oth[gi]; }
                carry += run;
            } else {
                if (KIND == 0) {
                    const LAS float* cs = (const LAS float*)(buf + E1_C) + 4 * hh; const float ctm = ct2 - m;
#pragma unroll
                    for (int i = 0; i < 4; ++i) { const f32x4 c0 = *(const LAS f32x4*)(cs + 8 * i), c1 = *(const LAS f32x4*)(cs + 32 + 8 * i);
#pragma unroll
                        for (int e = 0; e < 4; ++e) { const int reg = 4 * i + e; p0[reg] = p0[reg] * (SCALE * LOG2E) + (ctm - c0[e]); p1[reg] = p1[reg] * (SCALE * LOG2E) + (ctm - c1[e]); } }
                    if (!(j * 64 + 63 <= qrow0)) {
#pragma unroll
                        for (int reg = 0; reg < 16; ++reg) { const int kpos = kb + CROW(reg, 0); p0[reg] = (kpos <= tq) ? p0[reg] : -INFINITY; p1[reg] = (kpos + 32 <= tq) ? p1[reg] : -INFINITY; } }
                } else {
                    { const float r_ = sl2 * ((float)(j * 64) - tqf) - m; const float rh_ = bf2f((unsigned short)f2bf(r_)), rm2_ = bf2f((unsigned short)f2bf(r_ - rh_)), rl_ = (r_ - rh_) - rm2_;
                      u32x4 qx_ = {0u, 0u, 0u, 0u}; if (hh == 0) qx_ = (u32x4){cvtpk(sl2h, sl2l), cvtpk(rh_, rm2_), cvtpk(rl_, 0.f), 0u};
                      const bf16x8 qx = __builtin_bit_cast(bf16x8, qx_);
                      p0 = __builtin_amdgcn_mfma_f32_32x32x16_bf16(kx0, qx, p0, 0, 0, 0); p1 = __builtin_amdgcn_mfma_f32_32x32x16_bf16(kx1, qx, p1, 0, 0, 0); }
                    if (!(j * 64 + 63 <= qrow0 && qrow0 + 31 - j * 64 < 512)) {
#pragma unroll
                        for (int reg = 0; reg < 16; ++reg) { const int kpos = kb + CROW(reg, 0);
                            p0[reg] = (kpos <= tq && tq - kpos < 512) ? p0[reg] : -INFINITY; p1[reg] = (kpos + 32 <= tq && tq - kpos - 32 < 512) ? p1[reg] : -INFINITY; } }
                }
                SM_CORE(p0, p1, m, l, have, o0, o1);
            }
            { const int gq_ = lane >> 4, li_ = lane & 15;
              const LAS unsigned char* tb = buf + E1_V + (4 * hh + (li_ >> 2)) * KROW + (16 * (gq_ & 1) + 4 * (li_ & 3)) * 2;
#pragma unroll
              for (int s = 0; s < 4; ++s) {
                  u32x4 pw;
                  if (s < 2) { pw.x = cvtpk(p0[8 * s + 0], p0[8 * s + 1]); pw.y = cvtpk(p0[8 * s + 2], p0[8 * s + 3]); pw.z = cvtpk(p0[8 * s + 4], p0[8 * s + 5]); pw.w = cvtpk(p0[8 * s + 6], p0[8 * s + 7]); }
                  else { const int s2 = s - 2; pw.x = cvtpk(p1[8 * s2 + 0], p1[8 * s2 + 1]); pw.y = cvtpk(p1[8 * s2 + 2], p1[8 * s2 + 3]); pw.z = cvtpk(p1[8 * s2 + 4], p1[8 * s2 + 5]); pw.w = cvtpk(p1[8 * s2 + 6], p1[8 * s2 + 7]); }
                  const bf16x8 pb = __builtin_bit_cast(bf16x8, pw);
                  const v4i16_t a0l = __builtin_amdgcn_ds_read_tr16_b64_v4i16((LAS v4i16_t*)(tb + (16 * s) * KROW)), a0h = __builtin_amdgcn_ds_read_tr16_b64_v4i16((LAS v4i16_t*)(tb + (16 * s + 8) * KROW));
                  const v4i16_t a1l = __builtin_amdgcn_ds_read_tr16_b64_v4i16((LAS v4i16_t*)(tb + (16 * s) * KROW + 64)), a1h = __builtin_amdgcn_ds_read_tr16_b64_v4i16((LAS v4i16_t*)(tb + (16 * s + 8) * KROW + 64));
                  const bf16x8 va0 = (bf16x8){a0l[0], a0l[1], a0l[2], a0l[3], a0h[0], a0h[1], a0h[2], a0h[3]}, va1 = (bf16x8){a1l[0], a1l[1], a1l[2], a1l[3], a1h[0], a1h[1], a1h[2], a1h[3]};
                  o0 = __builtin_amdgcn_mfma_f32_32x32x16_bf16(va0, pb, o0, 0, 0, 0); o1 = __builtin_amdgcn_mfma_f32_32x32x16_bf16(va1, pb, o1, 0, 0, 0); } }
            if (KIND == 0) {
                const float c0 = *(const LAS float*)(buf + E1_C); const bool dn = __all(have && (qkb + (ct2 - c0) - m < -150.f));
                if (dn && !wave_done) { wave_done = true; if (lane == 0) flags[w] = 1u; } }
            if (KIND == 2) { const bool dn = __all(carry < -110.f);
                if (dn && !wave_done) { wave_done = true; if (lane == 0) flags[w] = 1u; } }
        }
    }
    float inv = 1.f, gate = 1.f;
    if (KIND != 2) { l += __shfl_xor(l, 32); inv = (l > 0.f) ? 1.f / l : 0.f; }
    bf16_t* orow;
    if (KIND == 0) orow = obase + (size_t)(b * S_ + tq) * D_ + 512 + h * 64;
    else if (KIND == 2) orow = obase + (size_t)(b * S_ + tq) * D_ + 768 + h * 64;
    else { orow = owin + (size_t)(b * S_ + tq) * 512 + h * 64; gate = WSP(float, O_GF)[(size_t)(b * S_ + tq) * 32 + 2 * 8 + h]; }
    const float sc = inv * gate;
#pragma unroll
    for (int i = 0; i < 4; ++i) {
        *(u32x2*)(orow + 8 * i + 4 * hh) = (u32x2){cvtpk(o0[4 * i] * sc, o0[4 * i + 1] * sc), cvtpk(o0[4 * i + 2] * sc, o0[4 * i + 3] * sc)};
        *(u32x2*)(orow + 32 + 8 * i + 4 * hh) = (u32x2){cvtpk(o1[4 * i] * sc, o1[4 * i + 1] * sc), cvtpk(o1[4 * i + 2] * sc, o1[4 * i + 3] * sc)}; }
#undef E1_LOAD
#undef E1_WRITE
}
}
namespace mk {
constexpr int E2_VT = 64 * 128;
constexpr int E2_WAVE = 2 * E2_VT + 512 + 128;
template <bool USE_MASK>
__device__ __forceinline__ void e2_wave_unit(LAS unsigned char* ldsw, KP p, int b, int g, int t0, bf16_t* __restrict__ obase, const bf16_t* __restrict__ csrc, int cpitch) {
    const int lane = ftid() & 63, r32 = lane & 31, hh = lane >> 5, qi = r32 >> 2, r4 = r32 & 3;
    const int h = 4 * g + r4, tq = t0 + qi;
    const bf16_t* projb = WSP(bf16_t, O_PROJB);
    const bf16_t* kbase = projb + (size_t)(b * S_) * PB + C_KV + ((1 * 2 + 0) * 2 + g) * 64;
    const bf16_t* vbase = projb + (size_t)(b * S_) * PB + C_KV + ((1 * 2 + 1) * 2 + g) * 64;
    bf16x8 qf[4];
    { const bf16_t* qptr = projb + (size_t)(b * S_ + tq) * PB + h * 64 + 8 * hh;
#pragma unroll
      for (int d0 = 0; d0 < 4; ++d0) qf[d0] = *(const bf16x8*)(qptr + 16 * d0); }
    unsigned qm0 = 0u, qm1 = 0u, qm2 = 0u, qm3 = 0u;
    if (USE_MASK) { const u32x4 mw = *(const u32x4*)(WSP(unsigned, O_SELMASK) + ((size_t)((b * 2 + g) * S_ + t0 + (lane >> 3))) * 4); qm0 = mw.x; qm1 = mw.y; qm2 = mw.z; qm3 = mw.w; }
    else { const int* sp = WSP(int, O_SEL) + ((size_t)((b * 2 + g) * S_ + t0)) * NSEL + lane * 2;
      const int e0 = sp[0], e1 = sp[1];
#pragma unroll
      for (int k = 0; k < 2; ++k) { const int e = k ? e1 : e0; const unsigned bit = 1u << (e & 31); const int wd = e >> 5;
          qm0 |= (wd == 0) ? bit : 0u; qm1 |= (wd == 1) ? bit : 0u; qm2 |= (wd == 2) ? bit : 0u; qm3 |= (wd == 3) ? bit : 0u; }
#pragma unroll
      for (int o = 1; o < 8; o <<= 1) { qm0 |= __shfl_xor(qm0, o); qm1 |= __shfl_xor(qm1, o); qm2 |= __shfl_xor(qm2, o); qm3 |= __shfl_xor(qm3, o); } }
    unsigned um0 = qm0, um1 = qm1, um2 = qm2, um3 = qm3;
#pragma unroll
    for (int o = 8; o < 64; o <<= 1) { um0 |= __shfl_xor(um0, o); um1 |= __shfl_xor(um1, o); um2 |= __shfl_xor(um2, o); um3 |= __shfl_xor(um3, o); }
    LAS int* list = (LAS int*)(ldsw + 2 * E2_VT);
    LAS unsigned* rowml = (LAS unsigned*)(ldsw + 2 * E2_VT + 512);
    if ((lane & 7) == 0) *(LAS u32x4*)(rowml + (lane >> 3) * 4) = (u32x4){qm0, qm1, qm2, qm3};
    const LAS unsigned* rowm = rowml + qi * 4;
    int nblk;
    const int curq = __builtin_amdgcn_readfirstlane(t0 >> 6);
    bool diag;
    { const bool s0 = ((((lane < 32) ? um0 : um1) >> (lane & 31)) & 1u) && lane <= curq, s1 = ((((lane < 32) ? um2 : um3) >> (lane & 31)) & 1u) && lane + 64 <= curq;
      const unsigned long long b0 = __ballot(s0), b1 = __ballot(s1);
      const unsigned long long lower = (lane == 0) ? 0ull : (~0ull >> (64 - lane));
      const int n0 = __popcll(b0);
      if (s0) list[__popcll(b0 & lower)] = lane;
      if (s1) list[n0 + __popcll(b1 & lower)] = lane + 64;
      nblk = n0 + __popcll(b1); diag = (((curq < 64) ? (b0 >> curq) : (b1 >> (curq - 64))) & 1ull) != 0ull; }
    const int nfull = nblk - (diag ? 1 : 0);
    asm volatile("s_waitcnt lgkmcnt(0)" ::: "memory");
    const float sl2 = exp2f(-(float)(h + 1)) * LOG2E, tqf = (float)tq;
    f32x16 o0, o1;
#pragma unroll
    for (int r = 0; r < 16; ++r) { o0[r] = 0.f; o1[r] = 0.f; }
    float m = 0.f, l = 0.f; bool have = false;
    const int vrow = lane >> 3, vch = lane & 7;
    const int gq = lane >> 4, li = lane & 15;
    const LAS unsigned char* trb = ldsw + (4 * hh + (li >> 2)) * 128 + (16 * (gq & 1) + 4 * (li & 3)) * 2;
    bf16x8 ka0[4], ka1[4], kb0[4], kb1[4];
#define E2_LOADK(blk, k0_, k1_) do { const bf16_t* kp_ = kbase + (size_t)((blk) * 64 + r32) * PB + 8 * hh; \
        _Pragma("unroll") for (int d0 = 0; d0 < 4; ++d0) { k0_[d0] = *(const bf16x8*)(kp_ + 16 * d0); k1_[d0] = *(const bf16x8*)(kp_ + (size_t)32 * PB + 16 * d0); } } while (0)
#define E2_VDMA(blk, vb_) do { const bf16_t* vp_ = vbase + (size_t)((blk) * 64 + vrow) * PB + vch * 8; \
        _Pragma("unroll") for (int i = 0; i < 8; ++i) __builtin_amdgcn_global_load_lds((const unsigned*)(vp_ + (size_t)(8 * i) * PB), (LAS unsigned*)((vb_) + i * 1024), 16, 0, 0); } while (0)
    { const int b0_ = __builtin_amdgcn_readfirstlane(list[0]);
      E2_VDMA(b0_, ldsw); E2_LOADK(b0_, ka0, ka1);
      { const int b1_ = __builtin_amdgcn_readfirstlane(list[(nblk > 1) ? 1 : 0]); E2_LOADK(b1_, kb0, kb1); } }
    int it = 0;
    auto body = [&](auto mtag_, auto ptag_) __attribute__((always_inline)) {
        constexpr bool MASKED_ = decltype(mtag_)::value; constexpr bool PAR_ = decltype(ptag_)::value;
        const int cur = __builtin_amdgcn_readfirstlane(list[it]);
        const unsigned rw = rowm[cur >> 5];
        LAS unsigned char* vcur = ldsw + (PAR_ ? E2_VT : 0); LAS unsigned char* voth = ldsw + (PAR_ ? 0 : E2_VT);
        { const int nb_ = __builtin_amdgcn_readfirstlane(list[(it + 1 < nblk) ? it + 1 : nblk - 1]); E2_VDMA(nb_, voth); }
        const int nb2_ = __builtin_amdgcn_readfirstlane(list[(it + 2 < nblk) ? it + 2 : nblk - 1]);
        f32x16 p0, p1;
#pragma unroll
        for (int r = 0; r < 16; ++r) { p0[r] = 0.f; p1[r] = 0.f; }
        if (PAR_) {
#pragma unroll
            for (int d0 = 0; d0 < 4; ++d0) { p0 = __builtin_amdgcn_mfma_f32_32x32x16_bf16(kb0[d0], qf[d0], p0, 0, 0, 0); p1 = __builtin_amdgcn_mfma_f32_32x32x16_bf16(kb1[d0], qf[d0], p1, 0, 0, 0); }
            asm volatile("" : "+v"(p0), "+v"(p1) :: "memory");
            E2_LOADK(nb2_, kb0, kb1);
        } else {
#pragma unroll
            for (int d0 = 0; d0 < 4; ++d0) { p0 = __builtin_amdgcn_mfma_f32_32x32x16_bf16(ka0[d0], qf[d0], p0, 0, 0, 0); p1 = __builtin_amdgcn_mfma_f32_32x32x16_bf16(ka1[d0], qf[d0], p1, 0, 0, 0); }
            asm volatile("" : "+v"(p0), "+v"(p1) :: "memory");
            E2_LOADK(nb2_, ka0, ka1);
        }
        const bool rowsel = (rw >> (cur & 31)) & 1u;
        const int kb = cur * 64 + 4 * hh;
        { const float basef = rowsel ? (sl2 * ((float)kb - tqf) - m) : -INFINITY, base1 = basef + 32.f * sl2;
#pragma unroll
          for (int reg = 0; reg < 16; ++reg) { p0[reg] = p0[reg] * (SCALE * LOG2E) + __builtin_fmaf(sl2, (float)CROW(reg, 0), basef); p1[reg] = p1[reg] * (SCALE * LOG2E) + __builtin_fmaf(sl2, (float)CROW(reg, 0), base1); } }
        if (MASKED_) {
#pragma unroll
            for (int reg = 0; reg < 16; ++reg) { const int kpos = kb + CROW(reg, 0); p0[reg] = (kpos <= tq) ? p0[reg] : -INFINITY; p1[reg] = (kpos + 32 <= tq) ? p1[reg] : -INFINITY; } }
        SM_CORE(p0, p1, m, l, have, o0, o1);
        asm volatile("s_waitcnt vmcnt(16)" ::: "memory");
        const LAS unsigned char* trv = trb + (PAR_ ? E2_VT : 0);
#pragma unroll
        for (int s = 0; s < 4; ++s) {
            u32x4 pw;
            if (s < 2) { pw.x = cvtpk(p0[8 * s + 0], p0[8 * s + 1]); pw.y = cvtpk(p0[8 * s + 2], p0[8 * s + 3]); pw.z = cvtpk(p0[8 * s + 4], p0[8 * s + 5]); pw.w = cvtpk(p0[8 * s + 6], p0[8 * s + 7]); }
            else { const int s2 = s - 2; pw.x = cvtpk(p1[8 * s2 + 0], p1[8 * s2 + 1]); pw.y = cvtpk(p1[8 * s2 + 2], p1[8 * s2 + 3]); pw.z = cvtpk(p1[8 * s2 + 4], p1[8 * s2 + 5]); pw.w = cvtpk(p1[8 * s2 + 6], p1[8 * s2 + 7]); }
            const bf16x8 pb = __builtin_bit_cast(bf16x8, pw);
            const v4i16_t a0l = __builtin_amdgcn_ds_read_tr16_b64_v4i16((LAS v4i16_t*)(trv + (16 * s) * 128)), a0h = __builtin_amdgcn_ds_read_tr16_b64_v4i16((LAS v4i16_t*)(trv + (16 * s + 8) * 128));
            const v4i16_t a1l = __builtin_amdgcn_ds_read_tr16_b64_v4i16((LAS v4i16_t*)(trv + (16 * s) * 128 + 64)), a1h = __builtin_amdgcn_ds_read_tr16_b64_v4i16((LAS v4i16_t*)(trv + (16 * s + 8) * 128 + 64));
            const bf16x8 va0 = (bf16x8){a0l[0], a0l[1], a0l[2], a0l[3], a0h[0], a0h[1], a0h[2], a0h[3]}, va1 = (bf16x8){a1l[0], a1l[1], a1l[2], a1l[3], a1h[0], a1h[1], a1h[2], a1h[3]};
            o0 = __builtin_amdgcn_mfma_f32_32x32x16_bf16(va0, pb, o0, 0, 0, 0); o1 = __builtin_amdgcn_mfma_f32_32x32x16_bf16(va1, pb, o1, 0, 0, 0); }
        asm volatile("" ::: "memory");
    };
    for (; it + 1 < nfull; it += 2) { body(std::false_type{}, std::false_type{}); ++it; body(std::false_type{}, std::true_type{}); --it; }
    if (it < nfull) { body(std::false_type{}, std::false_type{}); ++it; if (diag) body(std::true_type{}, std::true_type{}); }
    else if (diag) body(std::true_type{}, std::false_type{});
    asm volatile("s_waitcnt vmcnt(0)" ::: "memory");
#undef E2_LOADK
#undef E2_VDMA
    l += __shfl_xor(l, 32);
    const float sc = ((l > 0.f) ? 1.f / l : 0.f) * WSP(float, O_GF)[(size_t)(b * S_ + tq) * 32 + 1 * 8 + h];
    bf16_t* orow = obase + (size_t)(b * S_ + tq) * D_ + h * 64; const bf16_t* crow = csrc + (size_t)(b * S_ + tq) * cpitch + h * 64;
#pragma unroll
    for (int i = 0; i < 4; ++i) {
        const u32x2 c0 = *(const u32x2*)(crow + 8 * i + 4 * hh), c1 = *(const u32x2*)(crow + 32 + 8 * i + 4 * hh);
        const float x00 = __uint_as_float(c0.x << 16) + o0[4 * i] * sc, x01 = __uint_as_float(c0.x & 0xffff0000u) + o0[4 * i + 1] * sc, x02 = __uint_as_float(c0.y << 16) + o0[4 * i + 2] * sc, x03 = __uint_as_float(c0.y & 0xffff0000u) + o0[4 * i + 3] * sc;
        const float x10 = __uint_as_float(c1.x << 16) + o1[4 * i] * sc, x11 = __uint_as_float(c1.x & 0xffff0000u) + o1[4 * i + 1] * sc, x12 = __uint_as_float(c1.y << 16) + o1[4 * i + 2] * sc, x13 = __uint_as_float(c1.y & 0xffff0000u) + o1[4 * i + 3] * sc;
        *(u32x2*)(orow + 8 * i + 4 * hh) = (u32x2){cvtpk(x00, x01), cvtpk(x02, x03)}; *(u32x2*)(orow + 32 + 8 * i + 4 * hh) = (u32x2){cvtpk(x10, x11), cvtpk(x12, x13)}; }
}
template <bool USE_MASK>
__device__ __forceinline__ void ph_attn_sel2(LAS unsigned char* lds3, KP p, bf16_t* __restrict__ obase, const bf16_t* __restrict__ csrc, int cpitch) {
    const int w = __builtin_amdgcn_readfirstlane(ftid() >> 6);
    LAS unsigned char* ldsw = lds3 + w * E2_WAVE;
    MK_LOOP(u, 512) { const int bg = u & 3, qblk = u >> 2; e2_wave_unit<USE_MASK>(ldsw, p, bg >> 1, bg & 1, qblk * 64 + 8 * w, obase, csrc, cpitch); }
}
}
namespace mk {
constexpr int E3_K = 0, E3_V = 512 * KROW, E3_BYTES = 2 * 512 * KROW;
__device__ __forceinline__ void e3_unit(LAS unsigned char* lds, KP p, int b, int g, int qb, bf16_t* __restrict__ ocmp, unsigned* __restrict__ selmask) {
    const int tid = ftid(), lane = tid & 63, w = __builtin_amdgcn_readfirstlane(tid >> 6), r32 = lane & 31, hh = lane >> 5;
    const int bg = b * 2 + g, q0 = qb * 256, qrow0 = q0 + 32 * w, tq = qrow0 + r32;
    const bf16_t* projb = WSP(bf16_t, O_PROJB);
    int nun = (q0 + 255 - 31) / 16 + 1; if (nun > 511) nun = 511;
    const int ntile_u = (nun + 63) >> 6;
    __syncthreads();
    { const int srow = tid >> 3, sch = tid & 7; const bf16_t* ks = WSP(bf16_t, O_KCMPB) + ((size_t)bg * 512 + srow) * 64 + sch * 8; const bf16_t* vs = WSP(bf16_t, O_VCMPB) + ((size_t)bg * 512 + srow) * 64 + sch * 8;
      for (int i = 0; i < ntile_u; ++i) { const u32x4 kv = *(const u32x4*)(ks + (size_t)i * 64 * 64), vv = *(const u32x4*)(vs + (size_t)i * 64 * 64);
          *(LAS u32x4*)(lds + E3_K + (srow + 64 * i) * KROW + sch * 16) = kv; *(LAS u32x4*)(lds + E3_V + (srow + 64 * i) * KROW + sch * 16) = vv; } }
    __syncthreads();
    int nw = qrow0 / 16 + 1; if (nw > 511) nw = 511;
    const int ntile_w = (qrow0 + 31 < 31) ? 0 : ((nw + 63) >> 6);
    const float tqf = (float)tq;
    const int gq = lane >> 4, li = lane & 15;
    const LAS unsigned char* trb = lds + E3_V + (4 * hh + (li >> 2)) * KROW + (16 * (gq & 1) + 4 * (li & 3)) * 2;
    const LAS unsigned char* kfb = lds + E3_K + r32 * KROW + hh * 16;
    float imp[64];
#pragma unroll
    for (int i = 0; i < 64; ++i) imp[i] = 0.f;
#pragma unroll 1
    for (int r4 = 0; r4 < 4; ++r4) {
        const int h = 4 * g + r4; const float sl2 = exp2f(-(float)(h + 1)) * LOG2E;
        const unsigned qoff = (unsigned)((b * S_ + tq) * PB + h * 64 + 8 * hh);
        f32x16 o0, o1;
#pragma unroll
        for (int r = 0; r < 16; ++r) { o0[r] = 0.f; o1[r] = 0.f; }
        float m = 0.f, l = 0.f; bool have = false;
#define E3_ST(jt) f32x16 p0, p1; { bf16x8 qf[4]; _Pragma("unroll") for (int d0 = 0; d0 < 4; ++d0) qf[d0] = *(const bf16x8*)(projb + qoff + 16 * d0); \
            _Pragma("unroll") for (int r = 0; r < 16; ++r) { p0[r] = 0.f; p1[r] = 0.f; } \
            _Pragma("unroll") for (int d0 = 0; d0 < 4; ++d0) { const bf16x8 a0 = *(const LAS bf16x8*)(kfb + (64 * (jt)) * KROW + d0 * 32), a1 = *(const LAS bf16x8*)(kfb + (64 * (jt) + 32) * KROW + d0 * 32); \
                p0 = __builtin_amdgcn_mfma_f32_32x32x16_bf16(a0, qf[d0], p0, 0, 0, 0); p1 = __builtin_amdgcn_mfma_f32_32x32x16_bf16(a1, qf[d0], p1, 0, 0, 0); } \
            int tq_ = tq; asm volatile("" : "+v"(tq_));     \
            int hh_ = hh; asm volatile("" : "+v"(hh_)); \
            const float tqf_ = (float)tq_; const int ce0_ = 16 * (64 * (jt) + 4 * hh_) + 31; \
            const float basef_ = sl2 * ((float)ce0_ - tqf_) - m, base1_ = basef_ + 512.f * sl2; \
            _Pragma("unroll") for (int reg = 0; reg < 16; ++reg) { const float cr_ = sl2 * (float)(16 * CROW(reg, 0)); p0[reg] = p0[reg] * (SCALE * LOG2E) + (basef_ + cr_); p1[reg] = p1[reg] * (SCALE * LOG2E) + (base1_ + cr_); } \
            if (ce0_ + 16 * 27 + 512 > qrow0) {     \
                _Pragma("unroll") for (int reg = 0; reg < 16; ++reg) { const int ce = ce0_ + 16 * CROW(reg, 0); p0[reg] = (ce <= tq_) ? p0[reg] : -INFINITY; p1[reg] = (ce + 512 <= tq_) ? p1[reg] : -INFINITY; } } }
        float imh[64];
#pragma unroll
        for (int i = 0; i < 64; ++i) imh[i] = 0.f;
#pragma unroll
        for (int jt = 0; jt < 8; ++jt) {
            if (jt < ntile_w) {
                E3_ST(jt);
                {
                    float rm_; SM_ROWMAX(p0, p1, rm_);
                    const bool fin_ = rm_ > -1e37f;
                    if (__any((rm_ > RESC_THR) || (!have && fin_))) {
                        const float dl_ = have ? fmaxf(rm_, 0.f) : (fin_ ? rm_ : 0.f); const float al_ = have ? __builtin_amdgcn_exp2f(-dl_) : 1.f;
                        m += dl_; l *= al_; have = have || fin_;
#pragma unroll
                        for (int r_ = 0; r_ < 16; ++r_) { o0[r_] *= al_; o1[r_] *= al_; p0[r_] -= dl_; p1[r_] -= dl_; }
#pragma unroll
                        for (int i = 0; i < 64; ++i) imh[i] *= al_; }
                    float ls_ = 0.f;
#pragma unroll
                    for (int reg_ = 0; reg_ < 16; ++reg_) { p0[reg_] = __builtin_amdgcn_exp2f(p0[reg_]); p1[reg_] = __builtin_amdgcn_exp2f(p1[reg_]); ls_ += p0[reg_] + p1[reg_]; }
                    l += ls_; }
#pragma unroll
                for (int pa = 0; pa < 2; ++pa)
#pragma unroll
                    for (int i = 0; i < 4; ++i) { const int jj = 8 * jt + 4 * pa + i;
                        const float x0 = pa ? p1[4 * i] : p0[4 * i], x1 = pa ? p1[4 * i + 1] : p0[4 * i + 1], x2 = pa ? p1[4 * i + 2] : p0[4 * i + 2], x3 = pa ? p1[4 * i + 3] : p0[4 * i + 3];
                        const float c = 0.5f * x3, a = (x0 + x1) + (x2 + c), r = lane32_other(c, hh);
                        imh[jj] += a + (hh ? r : 0.f);
                        if (jj + 1 < 64) imh[jj + 1] += (hh ? 0.f : r); }
                const LAS unsigned char* tb = trb + (64 * jt) * KROW;
#pragma unroll
                for (int s = 0; s < 4; ++s) {
                    u32x4 pw;
                    if (s < 2) { pw.x = cvtpk(p0[8 * s + 0], p0[8 * s + 1]); pw.y = cvtpk(p0[8 * s + 2], p0[8 * s + 3]); pw.z = cvtpk(p0[8 * s + 4], p0[8 * s + 5]); pw.w = cvtpk(p0[8 * s + 6], p0[8 * s + 7]); }
                    else { const int s2 = s - 2; pw.x = cvtpk(p1[8 * s2 + 0], p1[8 * s2 + 1]); pw.y = cvtpk(p1[8 * s2 + 2], p1[8 * s2 + 3]); pw.z = cvtpk(p1[8 * s2 + 4], p1[8 * s2 + 5]); pw.w = cvtpk(p1[8 * s2 + 6], p1[8 * s2 + 7]); }
                    const bf16x8 pb = __builtin_bit_cast(bf16x8, pw);
                    const v4i16_t a0l = __builtin_amdgcn_ds_read_tr16_b64_v4i16((LAS v4i16_t*)(tb + (16 * s) * KROW)), a0h = __builtin_amdgcn_ds_read_tr16_b64_v4i16((LAS v4i16_t*)(tb + (16 * s + 8) * KROW));
                    const v4i16_t a1l = __builtin_amdgcn_ds_read_tr16_b64_v4i16((LAS v4i16_t*)(tb + (16 * s) * KROW + 64)), a1h = __builtin_amdgcn_ds_read_tr16_b64_v4i16((LAS v4i16_t*)(tb + (16 * s + 8) * KROW + 64));
                    const bf16x8 va0 = (bf16x8){a0l[0], a0l[1], a0l[2], a0l[3], a0h[0], a0h[1], a0h[2], a0h[3]}, va1 = (bf16x8){a1l[0], a1l[1], a1l[2], a1l[3], a1h[0], a1h[1], a1h[2], a1h[3]};
                    o0 = __builtin_amdgcn_mfma_f32_32x32x16_bf16(va0, pb, o0, 0, 0, 0); o1 = __builtin_amdgcn_mfma_f32_32x32x16_bf16(va1, pb, o1, 0, 0, 0); }
            }
        }
        l += __shfl_xor(l, 32);
        const float inv = (l > 0.f) ? 1.f / l : 0.f;
#pragma unroll
        for (int i = 0; i < 64; ++i) imp[i] += imh[i] * inv;
        { const float sc = inv * WSP(float, O_GF)[(size_t)(b * S_ + tq) * 32 + 0 * 8 + h];
          bf16_t* orow = ocmp + (size_t)(b * S_ + tq) * 512 + h * 64;
#pragma unroll
          for (int i = 0; i < 4; ++i) {
              *(u32x2*)(orow + 8 * i + 4 * hh) = (u32x2){cvtpk(o0[4 * i] * sc, o0[4 * i + 1] * sc), cvtpk(o0[4 * i + 2] * sc, o0[4 * i + 3] * sc)};
              *(u32x2*)(orow + 32 + 8 * i + 4 * hh) = (u32x2){cvtpk(o1[4 * i] * sc, o1[4 * i + 1] * sc), cvtpk(o1[4 * i + 2] * sc, o1[4 * i + 3] * sc)}; } }
#undef E3_ST
    }
    const int cur = tq >> 6;
#pragma unroll
    for (int jj = 0; jj < 64; ++jj) { const int j = 2 * jj + hh; imp[jj] = (j != 0 && j < cur - 1) ? imp[jj] : -1.f; }
    unsigned m0 = 1u, m1 = 0u, m2 = 0u, m3 = 0u;
#define E3_SETBIT(j) do { const unsigned bit_ = 1u << ((j) & 31); const int wd_ = (j) >> 5; m0 |= (wd_ == 0) ? bit_ : 0u; m1 |= (wd_ == 1) ? bit_ : 0u; m2 |= (wd_ == 2) ? bit_ : 0u; m3 |= (wd_ == 3) ? bit_ : 0u; } while (0)
    E3_SETBIT(cur); if (cur >= 1) E3_SETBIT(cur - 1);
#pragma unroll 1
    for (int it = 0; it < NSEL - 3; ++it) {
        float best = -0.5f; int bj = 0;
#pragma unroll
        for (int jj = 0; jj < 64; ++jj) { if (imp[jj] > best) { best = imp[jj]; bj = jj; } }
        const int myj = 2 * bj + hh; const float ob = __shfl_xor(best, 32); const int oj = __shfl_xor(myj, 32);
        const bool mine = (best > ob) || (best == ob && myj < oj);
        const float wv = mine ? best : ob; const int wj = mine ? myj : oj;
        if (wv >= 0.f) E3_SETBIT(wj);
        if (mine && best >= 0.f) {
#pragma unroll
            for (int jj = 0; jj < 64; ++jj) imp[jj] = (jj == bj) ? -2.f : imp[jj]; }
    }
#undef E3_SETBIT
    if (hh == 0) *(u32x4*)(selmask + ((size_t)bg * S_ + tq) * 4) = (u32x4){m0, m1, m2, m3};
}
}
namespace mk {
constexpr int SB_EARLY = 216;
template <int MODE>
__device__ __forceinline__ void ph_attn1(float* lds, LAS unsigned char* lds3, KP p, unsigned* qctr, bf16_t* obase, bf16_t* owin, const unsigned* kmax2) {
    LAS int* qslot = (LAS int*)(lds3 + E3_BYTES);
    constexpr int N_E3 = (MODE & 2) ? 128 : 0, N_CMP = (MODE & 1) ? 64 : 0, N_FOX = (MODE & 4) ? 256 : 0, N_WIN = (MODE & 8) ? 512 : 0, N_SB = (MODE & 16) ? (256 - SB_EARLY) : 0;
    for (;;) {
        __syncthreads();
        if (ftid() == 0) *qslot = (int)atomicAdd(qctr, 1u);
        __syncthreads();
        int u = __builtin_amdgcn_readfirstlane(*qslot);
        if (u >= N_E3 + N_CMP + N_FOX + N_WIN + N_SB) break;
        if (u < N_E3) { e3_unit(lds3, p, (u & 3) >> 1, u & 1, 31 - (u >> 2), WSP(bf16_t, O_OCMP), WSP(unsigned, O_SELMASK)); continue; } u -= N_E3;
        if (u < N_FOX) { e1_unit<0>(lds3, p, (u & 7) >> 2, u & 3, 31 - (u >> 3), obase, owin, kmax2); continue; } u -= N_FOX;
        if (u < N_WIN) { e1_unit<1>(lds3, p, (u & 3) >> 1, u & 1, 127 - (u >> 2), obase, owin, kmax2); continue; } u -= N_WIN;
        if (u < N_SB) { u += SB_EARLY; e1_unit<2>(lds3, p, (u & 7) >> 2, u & 3, 31 - (u >> 3), obase, owin, kmax2); }
    }
}
__device__ __forceinline__ void ph_sb_early(LAS unsigned char* lds3, KP p) {
    const int u = fbid() - 40; if (u < 0 || u >= SB_EARLY) return;
    e1_unit<2>(lds3, p, (u & 7) >> 2, u & 3, 31 - (u >> 3), WSP(bf16_t, O_O), WSP(bf16_t, O_OWIN), nullptr);
}
}
namespace mk {
#define RLX_AGENT __ATOMIC_RELAXED, __HIP_MEMORY_SCOPE_AGENT
#define XB_TMO      128
#define XB_XCNT(j)  (256  + 64 * (j))
#define XB_XSUB(j)  (1280 + 64 * (j))
#define XB_XGEN(j)  (2304 + 64 * (j))
#define XB_TOP      3328
#define XB_TOPGEN   3392
#define XCD_BAR_WORDS 3456
#define XB_SPIN_CAP (1u << 18)

__device__ __forceinline__ unsigned xb_ld(unsigned* p)              { return __hip_atomic_load(p, __ATOMIC_RELAXED, __HIP_MEMORY_SCOPE_AGENT); }
__device__ __forceinline__ unsigned xb_add(unsigned* p, unsigned v) { return __hip_atomic_fetch_add(p, v, __ATOMIC_RELAXED, __HIP_MEMORY_SCOPE_AGENT); }
__device__ __forceinline__ unsigned xb_xcc_id() { return (unsigned)__builtin_amdgcn_s_getreg((3 << 11) | 20) & 0xFu; }
#define XB_SPIN(cond, bar) do { unsigned _sp = 0; while (cond) { __builtin_amdgcn_s_sleep(1); \
    if ((++_sp & 255u) == 0u) { if (xb_ld(&(bar)[XB_TMO])) break; if (_sp > XB_SPIN_CAP) { atomicAdd(&(bar)[XB_TMO], 1u); break; } } } } while (0)

struct XcdBarrier {
    unsigned* bar; unsigned x;
    volatile LAS unsigned* st;
};

__device__ __forceinline__ XcdBarrier xcd_barrier_post(unsigned* bar, volatile LAS unsigned* st) {
    XcdBarrier b; b.bar = bar; b.x = xb_xcc_id(); b.st = st;
    if (threadIdx.x == 0) (void)xb_add(&bar[XB_XCNT(b.x)], 1u);
    return b;
}
__device__ __forceinline__ void xcd_barrier_complete(unsigned* bar, unsigned x, unsigned& nloc, unsigned& nx) {
    const unsigned G = gridDim.x * gridDim.y * gridDim.z;
    unsigned sum, cnt, mine, sp = 0u;
    for (;;) {
        sum = 0u; cnt = 0u; mine = 0u;
#pragma unroll
        for (unsigned j = 0; j < 16; ++j) { const unsigned c = xb_ld(&bar[XB_XCNT(j)]); sum += c; cnt += (c > 0u) ? 1u : 0u; mine = (j == x) ? c : mine; }
        if (sum == G) break;
        __builtin_amdgcn_s_sleep(1);
        if ((++sp & 255u) == 0u) { if (xb_ld(&bar[XB_TMO])) break; if (sp > XB_SPIN_CAP) { atomicAdd(&bar[XB_TMO], 1u); break; } }
    }
    nloc = mine > 0u ? mine : 1u; nx = cnt > 0u ? cnt : 1u;
}

__device__ __forceinline__ void xcd_barrier(const XcdBarrier& b) {
    asm volatile("s_waitcnt vmcnt(0)" ::: "memory");
    __syncthreads();
    if (threadIdx.x == 0) {
        unsigned* bar = b.bar;
        __builtin_amdgcn_s_waitcnt(0);
        unsigned nloc = b.st[0], nx = b.st[1];
        if (nloc == 0u) { xcd_barrier_complete(bar, b.x, nloc, nx); b.st[0] = nloc; b.st[1] = nx; }
        const unsigned old = xb_add(&bar[XB_XSUB(b.x)], 1u);
        const unsigned gen = old / nloc;
        if (old + 1u == (gen + 1u) * nloc) {
            __builtin_amdgcn_fence(__ATOMIC_RELEASE, "agent");
            asm volatile("s_waitcnt vmcnt(0)" ::: "memory");
            const unsigned og = xb_add(&bar[XB_TOP], 1u);
            const unsigned tg = og / nx;
            if (og + 1u == (tg + 1u) * nx) xb_add(&bar[XB_TOPGEN], 1u);
            else XB_SPIN(xb_ld(&bar[XB_TOPGEN]) == tg, bar);
            __builtin_amdgcn_fence(__ATOMIC_ACQUIRE, "agent");
            xb_add(&bar[XB_XGEN(b.x)], 1u);
            asm volatile("s_waitcnt vmcnt(0)" ::: "memory");
        } else {
            XB_SPIN(xb_ld(&bar[XB_XGEN(b.x)]) == gen, bar);
            __builtin_amdgcn_fence(__ATOMIC_ACQUIRE, "agent");
            asm volatile("s_waitcnt vmcnt(0)" ::: "memory");
        }
    }
    __syncthreads();
}

}
namespace cg = cooperative_groups;
constexpr int NSTEP = 12;
#ifndef CVH_GU
#define CVH_GU 1
#define CVH_DN 1
#endif
__global__ void __launch_bounds__(512, 2) mega(mk::P p_unused) {
    extern __shared__ __attribute__((aligned(16))) unsigned char lds_raw[];
    float* lds = (float*)lds_raw;
    LAS unsigned char* lds3 = (LAS unsigned char*)lds_raw;
    using namespace nv; using namespace mk;
    volatile LAS unsigned* bst = (volatile LAS unsigned*)(lds3 + E3_BYTES + 128);
    if (threadIdx.x < 2) bst[threadIdx.x] = 0u;
    __syncthreads();
    XcdBarrier bar;
    { const KP p = fresh_kp(); bar = xcd_barrier_post(WSP(unsigned, O_COUNTS + 16384), bst); }
    cg::this_grid().sync();
    for (int step = 0; step < 1 + NSTEP * L_; ++step) {
        const KP p = fresh_kp();
        const int l = (step - 1) / NSTEP, k = (step == 0) ? -1 : (step - 1) % NSTEP;
        const bool isg = (k == 0 || k == 1 || k == 6 || k == 9 || k == 10);
#ifdef PROBE_K
        const int nrep = (k == PROBE_K) ? PROBE_N : 1;
#else
        const int nrep = 1;
#endif
        for (int rep = 0; rep < nrep; ++rep) {
        int helpchunks = 0;
        if (isg) {
            const int kind = (k == 0) ? 0 : (k == 1) ? 4 : (k == 6) ? 1 : (k == 9) ? 2 : 3;
            GSched S; GEpi E; S.kind = kind; E.kind = kind; E.l = l;
            S.G = (int)gridDim.x; S.c = fbid(); S.meta = WSP(int, O_META); S.rowtok = WSP(int, O_ROWTOK); S.estep = 0;
            const char* A; int N, K = D_;
            if (kind == 0) { A = (const char*)WSP(bf16_t, O_XB); S.Bt = (const char*)(WSP(bf16_t, O_WTIN) + (size_t)l * NPAD * D_); N = NPAD; }
            else if (kind == 1) { A = (const char*)WSP(bf16_t, O_OB); S.Bt = (const char*)(WSP(bf16_t, O_WTOUT) + (size_t)l * D_ * D_); N = D_; }
            else if (kind == 2) { A = (const char*)WSP(bf16_t, O_X1B); S.Bt = (const char*)(WSP(bf16_t, O_WTGU) + (size_t)l * NE * 2048 * D_); S.estep = (size_t)2048 * D_ * 2; N = 2048; }
            else if (kind == 3) { A = (const char*)WSP(bf16_t, O_ACT); S.Bt = (const char*)(WSP(bf16_t, O_WTDN) + (size_t)l * NE * D_ * D_); S.estep = (size_t)D_ * D_ * 2; N = D_; }
            else { A = (const char*)WSP(bf16_t, O_PROJB); S.Bt = (const char*)(WSP(bf16_t, O_WT1) + (size_t)l * 2 * 256 * 2048); S.estep = (size_t)256 * 2048 * 2; N = 256; K = 1024; }
            S.nN = N / 256; S.nM = (kind < 2) ? T_ / 256 : (kind == 4) ? 16 : S.meta[32]; S.nunits = S.nM * S.nN; if (kind == 4) S.nunits = 32;
            pg8::gemm_phase<GEpi, GSched>(lds3, A, K, S, E);
            if (l == 0 && kind >= 2 && kind <= 3 && S.G == 256) {
                const int mine = (S.nunits - S.c + 255) >> 8, most = (S.nunits + 255) >> 8;
                if (mine < most) helpchunks = (kind == 2) ? CVH_GU : CVH_DN; }
            if (kind == 4) { ph_cumsum(lds, p, 32); ph_sb_early(lds3, p); }
            if (kind == 0) ph_bias1_reduce(p, l);
        } else {
            switch (k) {
                case -1: ph_convert(lds3, p); break;
                case 2: ph_prep2(lds, p, l); break;
#ifdef PROBE_AMODE
                case 3: if (rep == 0) ph_attn1<30>(lds, lds3, p, WSP(unsigned, O_COUNTS) + 128 + l * 8 + rep, WSP(bf16_t, O_O), WSP(bf16_t, O_OWIN), WSP(unsigned, O_COUNTS) + 192 + l * 8);
                        else ph_attn1<PROBE_AMODE>(lds, lds3, p, WSP(unsigned, O_COUNTS) + 128 + l * 8 + rep, WSP(bf16_t, O_O), WSP(bf16_t, O_OWIN), WSP(unsigned, O_COUNTS) + 192 + l * 8);
                        break;
#else
                case 3: ph_attn1<30>(lds, lds3, p, WSP(unsigned, O_COUNTS) + 128 + l * 8 + rep, WSP(bf16_t, O_O), WSP(bf16_t, O_OWIN), WSP(unsigned, O_COUNTS) + 192 + l * 8); break;
#endif
                case 4: ph_attn_sel2<true>(lds3, p, WSP(bf16_t, O_O), WSP(bf16_t, O_OCMP), 512); break;
                case 5: ph_rmsnorm(p, l); break;
                case 7: ph_ln<true>(lds, p, l, WSP(float, O_X1), (rep + 1 < nrep) ? 2048 * (rep + 1) : 0); break;
                case 8: ph_moe_scatter2(lds, p, l); break;
                default: { if (l == 0) helpchunks = 1 << 20;
                           float* xout = (l == L_ - 1) ? p->out : WSP(float, O_XA); ph_ln<false>(lds, p, l, xout); } break;
            }
        }
        if (helpchunks > 0) cv_help(lds3, fresh_kp(), helpchunks);
        xcd_barrier(bar);
        }
    }
#ifdef PROBE_SYNC
    for (int i = 0; i < PROBE_SYNC; ++i) xcd_barrier(bar);
#endif
}

extern "C" void kernel_launch(void* const* d_in, const int* in_sizes, int n_in,
                              void* d_out, int out_size, void* d_ws, size_t ws_size,
                              hipStream_t stream) {
    constexpr size_t kDynLds = 147456 + 1024;
    static int grid_blocks = 0;
    if (!grid_blocks) {
        int dev = 0, cus = 0, per_cu = 0;
        (void)hipGetDevice(&dev);
        (void)hipDeviceGetAttribute(&cus, hipDeviceAttributeMultiprocessorCount, dev);
        (void)hipFuncSetAttribute((const void*)mega, hipFuncAttributeMaxDynamicSharedMemorySize, (int)kDynLds);
        (void)hipOccupancyMaxActiveBlocksPerMultiprocessor(&per_cu, mega, 512, kDynLds);
        if (per_cu < 1) per_cu = 1;
        if (per_cu > 1) per_cu = 1;
        grid_blocks = cus * per_cu;
        if (ws_size < mk::O_END) fprintf(stderr, "workspace too small: %zu < %zu\n", ws_size, (size_t)mk::O_END);
        if (grid_blocks != 256) fprintf(stderr, "this kernel's static work split is built for 256 workgroups (MI355X: 256 CUs); got %d\n", grid_blocks);
    }
    mk::P p{};
    p.in = nv::inputs(d_in); p.ws = (unsigned char*)d_ws; p.out = (float*)d_out;
    (void)hipMemsetAsync((char*)d_ws + mk::O_COUNTS, 0, 65536, stream);
    void* args[] = {&p};
    hipError_t e = hipLaunchCooperativeKernel((void*)mega, dim3(grid_blocks), dim3(512), args, kDynLds, stream);
    if (e != hipSuccess) fprintf(stderr, "cooperative launch failed: %s (grid %d)\n", hipGetErrorString(e), grid_blocks);
}
```

```cpp
#include <hip/hip_runtime.h>
#include <hip/hip_cooperative_groups.h>
#include <cstdio>
#include <cstdint>

namespace nv {

constexpr int B_ = 2, S_ = 8192, D_ = 1024, T_ = B_ * S_, L_ = 2;
constexpr int DIN = 2844;
constexpr int OFF_NSA_KV = 512, OFF_NSA_GATE = 1280, OFF_FOX_QKV = 1304, OFF_FOX_F = 2072, OFF_SB_QKV = 2076;
constexpr int NCMP = 511, NBLK = 128, NSEL = 16;
constexpr int NE = 32, TOPK = 4, MROWS = T_ * TOPK;
constexpr float LN_EPS = 1e-5f, RMS_EPS = 1e-6f;
constexpr float ALPHA = 1.4142135623730951f;
constexpr float SCALE = 0.125f;

__device__ __forceinline__ float sigmoidf_(float x) { return 1.f / (1.f + __expf(-x)); }
__device__ __forceinline__ float logsig(float x) { return fminf(x, 0.f) - log1pf(expf(-fabsf(x))); }

__device__ __forceinline__ float gelu_tanh(float x) { return 0.5f * x * (1.f + tanhf(0.7978845608028654f * (x + 0.044715f * x * x * x))); }
__device__ __forceinline__ float wsum(float v) {
#pragma unroll
    for (int o = 1; o < 64; o <<= 1) v += __shfl_xor(v, o);
    return v;
}
struct In {
    const float *x, *w_in, *b_in, *pos_k, *pos_v, *w1k, *w2k, *w1v, *w2v, *g_out, *w_out, *ln1_g, *ln1_b, *rw, *rb, *wgu, *bgu, *wdn, *bdn, *ln2_g, *ln2_b;
};
inline In inputs(void* const* d) {
    In i; i.x = (const float*)d[0]; i.w_in = (const float*)d[1]; i.b_in = (const float*)d[2]; i.pos_k = (const float*)d[3]; i.pos_v = (const float*)d[4];
    i.w1k = (const float*)d[5]; i.w2k = (const float*)d[6]; i.w1v = (const float*)d[7]; i.w2v = (const float*)d[8]; i.g_out = (const float*)d[9]; i.w_out = (const float*)d[10];
    i.ln1_g = (const float*)d[11]; i.ln1_b = (const float*)d[12]; i.rw = (const float*)d[13]; i.rb = (const float*)d[14]; i.wgu = (const float*)d[15]; i.bgu = (const float*)d[16];
    i.wdn = (const float*)d[17]; i.bdn = (const float*)d[18]; i.ln2_g = (const float*)d[19]; i.ln2_b = (const float*)d[20]; return i;
}


}
namespace pg8 {
#define PG8_LAS __attribute__((address_space(3)))
typedef unsigned short bf16_t;
typedef short bf16x8 __attribute__((ext_vector_type(8)));
typedef float f32x4 __attribute__((ext_vector_type(4)));
typedef unsigned u32x4 __attribute__((ext_vector_type(4)));
constexpr int BM = 256, BK = 64, HALF = 128, HTB = HALF * BK * 2  , STAGE_BYTES = 8 * HTB, NXCD = 8, WGM = 8;

__host__ __device__ __forceinline__ int lds_byte(int r, int c) { const int st = (r >> 4) * 2 + (c >> 5), rr = r & 15, cc = c & 31, ob = rr * 64 + cc * 2; return st * 1024 + (ob ^ (((ob >> 9) & 1) << 5)); }
__host__ __device__ __forceinline__ void stage_rc(int b, int& R, int& C) { const int st = b / 1024, sb = b % 1024, swz = sb ^ (((sb >> 9) & 1) << 5); R = (st >> 1) * 16 + swz / 64; C = (st & 1) * 32 + (swz % 64) / 2; }
__host__ __device__ __forceinline__ int perm32(int rho) { const int n = rho >> 4, i = rho & 15; return 8 * (i >> 2) + 4 * n + (i & 3); }

struct Unit { int pm, pn, e, nr; };

__device__ __forceinline__ unsigned cvt_pk_bf16(float lo, float hi) { unsigned r; asm volatile("v_cvt_pk_bf16_f32 %0, %1, %2" : "=v"(r) : "v"(lo), "v"(hi)); return r; }
template <class Epi, class Sched, bool ALIGN_EPI = true, bool SP2 = true>
__device__ __forceinline__ void gemm_phase(PG8_LAS unsigned char* lds, const char* Abase, const int K, const Sched& S, const Epi& E) {
    int tid_ = threadIdx.x; asm volatile("" : "+v"(tid_));
    const int tid = tid_, wid = __builtin_amdgcn_readfirstlane(tid >> 6), lane = tid & 63, wr = wid >> 2, wc = wid & 3, fr = lane & 15, fq = lane >> 4;
    const int nt = K / BK;
    unsigned voffB[2];
#pragma unroll
    for (int i = 0; i < 2; ++i) { int R, C; stage_rc(tid * 16 + i * 8192, R, C); const int Rb = Epi::PERM ? ((R & ~31) + perm32(R & 31)) : R;
        voffB[i] = (unsigned)(Rb * K + C) * 2u; }
#define PG8_AOFF(u, o0, o1) do { int _t = tid; asm volatile("" : "+v"(_t)); _Pragma("unroll") for (int _i = 0; _i < 2; ++_i) { int _R, _C; stage_rc(_t * 16 + _i * 8192, _R, _C); \
        (o0)[_i] = S.a_off((u), _R) + (unsigned)_C * 2u; (o1)[_i] = S.a_off((u), HALF + _R) + (unsigned)_C * 2u; } } while (0)
    const size_t kstep = (size_t)(BK * 2);
    const size_t akstep = S.a_kstep();
    const size_t hstep = (size_t)HALF * K * 2;
    const unsigned ldsw = (unsigned)wid * 1024u;
    const int aoff = lds_byte(wr * 64 + fr, fq * 8), boff = lds_byte(wc * 32 + fr, fq * 8);
#define PG8_SA(b, h) (((b) * 2 + (h)) * HTB)
#define PG8_SB(b, h) ((4 + (b) * 2 + (h)) * HTB)
#define PG8_STAGE(bufoff, gbase, voff) do { _Pragma("unroll") for (int _i = 0; _i < 2; ++_i) { unsigned _o = (voff)[_i]; asm volatile("" : "+v"(_o));     \
        __builtin_amdgcn_global_load_lds((const unsigned*)((const char*)(gbase) + _o), (PG8_LAS unsigned*)(lds + (bufoff) + ldsw + _i * 8192), 16, 0, 0); } } while (0)
#define PG8_LDA(dst, b, h) do { _Pragma("unroll") for (int m = 0; m < 4; ++m) _Pragma("unroll") for (int k = 0; k < 2; ++k) dst[m][k] = *(const PG8_LAS bf16x8*)(lds + PG8_SA(b, h) + aoff + m * 2048 + k * 1024); } while (0)
#define PG8_LDB(dst, b, h) do { _Pragma("unroll") for (int n = 0; n < 2; ++n) _Pragma("unroll") for (int k = 0; k < 2; ++k) dst[n][k] = *(const PG8_LAS bf16x8*)(lds + PG8_SB(b, h) + boff + n * 2048 + k * 1024); } while (0)
#define PG8_MMA(ai, bj, At, Bt) do { __builtin_amdgcn_s_setprio(1); _Pragma("unroll") for (int m = 0; m < 4; ++m) _Pragma("unroll") for (int n = 0; n < 2; ++n) _Pragma("unroll") for (int k = 0; k < 2; ++k) \
        acc[ai][bj][m][n] = __builtin_amdgcn_mfma_f32_16x16x32_bf16(Bt[n][k], At[m][k], acc[ai][bj][m][n], 0, 0, 0); __builtin_amdgcn_s_setprio(0); } while (0)
#define PG8_WAIT_V(n) asm volatile("s_waitcnt vmcnt(" #n ")" ::: "memory")
#define PG8_WAIT_L(n) asm volatile("s_waitcnt lgkmcnt(" #n ")" ::: "memory")
#define PG8_BAR __builtin_amdgcn_s_barrier()
#define PG8_SCHED __builtin_amdgcn_sched_barrier(0)
    Unit cur, nxt; int ui = 0;
    if (!S.next(0, cur)) return;
    f32x4 acc[2][2][4][2];
    float zf_ = 0.f; asm volatile("" : "+v"(zf_));
#pragma unroll
    for (int a = 0; a < 2; ++a)
#pragma unroll
        for (int b = 0; b < 2; ++b)
#pragma unroll
            for (int m = 0; m < 4; ++m)
#pragma unroll
                for (int n = 0; n < 2; ++n) acc[a][b][m][n] = (f32x4){zf_, zf_, zf_, zf_};
    bf16x8 At[4][2], B0[2][2], B1[2][2];
    unsigned ca0[2], ca1[2], na0[2], na1[2];
    PG8_AOFF(cur, ca0, ca1);
    const char* const cA = Abase; const char* cB = S.b_base(cur);
    if constexpr (SP2) {
        PG8_STAGE(PG8_SB(0, 0), cB, voffB); PG8_STAGE(PG8_SB(0, 1), cB + hstep, voffB); PG8_STAGE(PG8_SA(0, 0), cA, ca0); PG8_STAGE(PG8_SA(0, 1), cA, ca1);
        if (wr == 1) PG8_BAR;
        PG8_WAIT_V(2); PG8_BAR;
        PG8_STAGE(PG8_SB(1, 0), cB + kstep, voffB); PG8_STAGE(PG8_SA(1, 0), cA + akstep, ca0); PG8_STAGE(PG8_SB(1, 1), cB + hstep + kstep, voffB);
        PG8_WAIT_V(6); PG8_BAR;
    } else { static_assert(SP2, "only the SP2 loop is kept"); }
    for (;;) {
        const bool has_next = S.next(ui + 1, nxt);
        const char* nB = has_next ? S.b_base(nxt) : cB;
        if (has_next) { PG8_AOFF(nxt, na0, na1); } else { na0[0] = ca0[0]; na0[1] = ca0[1]; na1[0] = ca1[0]; na1[1] = ca1[1]; }
        for (int t = 0; t < nt - 2; t += 2) {
            const char* a1 = cA + (size_t)(t + 1) * akstep;
            const char* a2 = cA + (size_t)(t + 2) * akstep; const char* b2 = cB + (size_t)(t + 2) * kstep;
            const char* a3 = a2 + akstep; const char* b3 = b2 + kstep;
            PG8_LDB(B0, 0, 0); PG8_LDB(B1, 0, 1); PG8_SCHED; PG8_LDA(At, 0, 0); PG8_STAGE(PG8_SA(1, 1), a1, ca1);
            PG8_WAIT_V(8); PG8_WAIT_L(0); PG8_BAR; PG8_MMA(0, 0, At, B0); PG8_MMA(0, 1, At, B1); PG8_BAR; PG8_SCHED;
            PG8_LDA(At, 0, 1); PG8_STAGE(PG8_SB(0, 0), b2, voffB); PG8_STAGE(PG8_SB(0, 1), b2 + hstep, voffB); PG8_STAGE(PG8_SA(0, 0), a2, ca0);
            PG8_WAIT_V(8); PG8_WAIT_L(0); PG8_BAR; PG8_MMA(1, 0, At, B0); PG8_MMA(1, 1, At, B1); PG8_BAR; PG8_SCHED;
            PG8_LDB(B0, 1, 0); PG8_LDB(B1, 1, 1); PG8_SCHED; PG8_LDA(At, 1, 0); PG8_STAGE(PG8_SA(0, 1), a2, ca1);
            PG8_WAIT_V(8); PG8_WAIT_L(0); PG8_BAR; PG8_MMA(0, 0, At, B0); PG8_MMA(0, 1, At, B1); PG8_BAR; PG8_SCHED;
            PG8_LDA(At, 1, 1); PG8_STAGE(PG8_SB(1, 0), b3, voffB); PG8_STAGE(PG8_SB(1, 1), b3 + hstep, voffB); PG8_STAGE(PG8_SA(1, 0), a3, ca0);
            PG8_WAIT_V(8); PG8_WAIT_L(0); PG8_BAR; PG8_MMA(1, 0, At, B0); PG8_MMA(1, 1, At, B1); PG8_BAR; PG8_SCHED;
        }
        {
            const char* a1 = cA + (size_t)(nt - 1) * akstep;
            const char* a2 = cA; const char* b2 = nB; const char* a3 = a2 + akstep; const char* b3 = b2 + kstep;
            PG8_LDB(B0, 0, 0); PG8_LDB(B1, 0, 1); PG8_SCHED; PG8_LDA(At, 0, 0); PG8_STAGE(PG8_SA(1, 1), a1, ca1);
            PG8_WAIT_V(8); PG8_WAIT_L(0); PG8_BAR; PG8_MMA(0, 0, At, B0); PG8_MMA(0, 1, At, B1); PG8_BAR; PG8_SCHED;
            PG8_LDA(At, 0, 1); PG8_STAGE(PG8_SB(0, 0), b2, voffB); PG8_STAGE(PG8_SB(0, 1), b2 + hstep, voffB); PG8_STAGE(PG8_SA(0, 0), a2, na0);
            PG8_WAIT_V(8); PG8_WAIT_L(0); PG8_BAR; PG8_MMA(1, 0, At, B0); PG8_MMA(1, 1, At, B1); PG8_BAR; PG8_SCHED;
            PG8_LDB(B0, 1, 0); PG8_LDB(B1, 1, 1); PG8_SCHED; PG8_LDA(At, 1, 0); PG8_STAGE(PG8_SA(0, 1), a2, na1);
            PG8_WAIT_V(8); PG8_WAIT_L(0); PG8_BAR; PG8_MMA(0, 0, At, B0); PG8_MMA(0, 1, At, B1); PG8_BAR; PG8_SCHED;
            PG8_LDA(At, 1, 1); PG8_STAGE(PG8_SB(1, 0), b3, voffB); PG8_STAGE(PG8_SB(1, 1), b3 + hstep, voffB); PG8_STAGE(PG8_SA(1, 0), a3, na0);
            PG8_WAIT_V(8); PG8_WAIT_L(0); PG8_BAR; PG8_MMA(1, 0, At, B0); PG8_MMA(1, 1, At, B1); PG8_BAR; PG8_SCHED;
        }
        if constexpr (ALIGN_EPI) { if (wr == 0) PG8_BAR; }
        E(acc, cur, wr, wc, fr, fq);
        if (!has_next) break;
#pragma unroll
        for (int a = 0; a < 2; ++a)
#pragma unroll
            for (int b = 0; b < 2; ++b)
#pragma unroll
                for (int m = 0; m < 4; ++m)
#pragma unroll
                    for (int n = 0; n < 2; ++n) acc[a][b][m][n] = (f32x4){zf_, zf_, zf_, zf_};
        cur = nxt; cB = nB; ++ui; ca0[0] = na0[0]; ca0[1] = na0[1]; ca1[0] = na1[0]; ca1[1] = na1[1];
        if constexpr (ALIGN_EPI) { if (wr == 1) PG8_BAR; }
    }
    PG8_WAIT_V(0);
    if constexpr (!ALIGN_EPI) { if (wr == 0) PG8_BAR; }
    PG8_BAR;
#undef PG8_AOFF
#undef PG8_SA
#undef PG8_SB
#undef PG8_STAGE
#undef PG8_LDA
#undef PG8_LDB
#undef PG8_MMA
#undef PG8_WAIT_V
#undef PG8_WAIT_L
#undef PG8_BAR
#undef PG8_SCHED
}

}
namespace mk {
using namespace nv;
typedef unsigned short bf16_t;
typedef unsigned u32x4 __attribute__((ext_vector_type(4)));
typedef float f32x4 __attribute__((ext_vector_type(4)));
#define LAS __attribute__((address_space(3)))
typedef short bf16x8 __attribute__((ext_vector_type(8)));
typedef float f32x16 __attribute__((ext_vector_type(16)));
#define CROW(reg, hh) (((reg) & 3) + 8 * ((reg) >> 2) + 4 * (hh))
constexpr int NT = 512;
constexpr int PB = 2816;
constexpr int NPAD = 3072;
constexpr int C_KV = 512, C_FOX = 1280, C_SB = 2048, C_GATE = 2816;
constexpr int MAXT = MROWS / 256 + NE;
constexpr int PROWS = MAXT * 256;
#define CNT_IDX(l, e) (8192 + ((l) * NE + (e)) * 32)
__device__ __forceinline__ int ftid() { int t = threadIdx.x; asm volatile("" : "+v"(t)); return t; }
__device__ __forceinline__ int fbid() { int b = blockIdx.x; asm volatile("" : "+s"(b)); return b; }
#define MK_LOOP(vb, n) for (int vb = fbid(); vb < (n); vb += gridDim.x)

constexpr size_t al_(size_t x) { return (x + 4095) & ~(size_t)4095; }
constexpr size_t O_WTIN = 0;
constexpr size_t O_WTOUT = O_WTIN + al_((size_t)L_ * NPAD * D_ * 2);
constexpr size_t O_WTGU = O_WTOUT + al_((size_t)L_ * D_ * D_ * 2);
constexpr size_t O_WTDN = O_WTGU + al_((size_t)L_ * NE * 2048 * D_ * 2);
constexpr size_t O_BIASP = O_WTDN + al_((size_t)L_ * NE * D_ * D_ * 2);
constexpr size_t O_XB = O_BIASP + al_((size_t)L_ * NPAD * 4);
constexpr size_t O_PROJB = O_XB + al_((size_t)T_ * D_ * 2);
constexpr size_t O_GF = O_PROJB + al_((size_t)T_ * PB * 2);
constexpr size_t O_CFOX = O_GF + al_((size_t)T_ * 32 * 4);
constexpr size_t O_KCMP = O_CFOX + al_((size_t)B_ * 4 * S_ * 4);
constexpr size_t O_VCMP = O_KCMP + al_((size_t)B_ * 2 * 512 * 64 * 4);
constexpr size_t O_O = O_VCMP + al_((size_t)B_ * 2 * 512 * 64 * 4);
constexpr size_t O_OB = O_O + al_((size_t)T_ * D_ * 4);
constexpr size_t O_PTOT = O_OB + al_((size_t)T_ * D_ * 2);
constexpr size_t O_SEL = O_PTOT + al_((size_t)B_ * 2 * S_ * 512 * 4);
constexpr size_t O_MIX = O_SEL + al_((size_t)B_ * 2 * S_ * NSEL * 4);
constexpr size_t O_X1 = O_MIX + al_((size_t)T_ * D_ * 4);
constexpr size_t O_X1B = O_X1 + al_((size_t)T_ * D_ * 4);
constexpr size_t O_XA = O_X1B + al_((size_t)T_ * D_ * 2);
constexpr size_t O_ACT = O_XA + al_((size_t)T_ * D_ * 4);
constexpr size_t O_Y = O_ACT + al_((size_t)PROWS * D_ * 2);
constexpr size_t O_TOPE = O_Y + al_((size_t)PROWS * D_ * 2);
constexpr size_t O_TOPW = O_TOPE + al_((size_t)MROWS * 4);
constexpr size_t O_POS = O_TOPW + al_((size_t)MROWS * 4);
constexpr size_t O_ROWTOK = O_POS + al_((size_t)MROWS * 4);
constexpr size_t O_ROWW = O_ROWTOK + al_((size_t)PROWS * 4);
constexpr size_t O_SLOT = O_ROWW + al_((size_t)PROWS * 4);
constexpr size_t O_COUNTS = O_SLOT + al_((size_t)MROWS * 4);
constexpr size_t O_META = O_COUNTS + 65536;
constexpr size_t O_OWIN = O_META + 4096;
constexpr size_t O_O2 = O_OWIN + al_((size_t)T_ * 512 * 4);
constexpr size_t O_OWIN2 = O_O2 + al_((size_t)T_ * D_ * 4);
constexpr size_t O_KCMPB = O_OWIN2 + al_((size_t)T_ * 512 * 4);
constexpr size_t O_VCMPB = O_KCMPB + al_((size_t)B_ * 2 * 512 * 64 * 2);
constexpr size_t O_OCMP = O_VCMPB + al_((size_t)B_ * 2 * 512 * 64 * 2);
constexpr size_t O_SELMASK = O_OCMP + al_((size_t)T_ * 512 * 4);
constexpr size_t O_WT1 = O_SELMASK + al_((size_t)B_ * 2 * S_ * 16);
constexpr size_t O_BIAS1 = O_WT1 + al_((size_t)L_ * 2 * 256 * 2048 * 2);
constexpr size_t O_HID = O_BIAS1 + al_((size_t)L_ * 2 * 128 * 4);
constexpr size_t O_BIAS1P = O_HID + al_((size_t)8 * 512 * 128 * 2);
constexpr size_t O_RWT = O_BIAS1P + al_((size_t)L_ * 2 * 64 * 128 * 4);
constexpr size_t O_HIDP = O_RWT + al_((size_t)L_ * 2 * NE * D_ * 2);
constexpr size_t O_END = O_HIDP + al_((size_t)2 * 8 * 512 * 128 * 4);

struct P {
    In in; unsigned char* ws; float* out;
};
typedef const __attribute__((address_space(4))) P* KP;
__device__ __forceinline__ KP fresh_kp() { KP k = (KP)__builtin_amdgcn_kernarg_segment_ptr(); asm volatile("" : "+s"(k)); return k; }
#define WSP(T, off) ((T*)(p->ws + (off)))

__device__ __forceinline__ float bf2f(unsigned short b) { return __uint_as_float((unsigned)b << 16); }
__device__ __forceinline__ unsigned f2bf(float f) { unsigned u = __float_as_uint(f); return (u + 0x7fffu + ((u >> 16) & 1u)) >> 16; }
__device__ __forceinline__ unsigned pk2(float lo, float hi) { return f2bf(lo) | (f2bf(hi) << 16); }
__device__ __forceinline__ void ld8(const bf16_t* __restrict__ src, float* dst) {
    const u32x4 v = *(const u32x4*)src;
    dst[0] = __uint_as_float(v.x << 16); dst[1] = __uint_as_float(v.x & 0xffff0000u); dst[2] = __uint_as_float(v.y << 16); dst[3] = __uint_as_float(v.y & 0xffff0000u);
    dst[4] = __uint_as_float(v.z << 16); dst[5] = __uint_as_float(v.z & 0xffff0000u); dst[6] = __uint_as_float(v.w << 16); dst[7] = __uint_as_float(v.w & 0xffff0000u);
}


__device__ __forceinline__ int perm_in(int n) {
    if (n < 1280) return n;
    if (n < 1304) return C_GATE + (n - 1280);
    if (n < 2072) return C_FOX + (n - 1304);
    if (n < 2076) return C_GATE + 24 + (n - 2072);
    return C_SB + (n - 2076);
}
__device__ __forceinline__ int perm_gu(int n) { const int up = n >> 10, c = n & 1023; return 256 * (c >> 7) + 128 * up + (c & 127); }
template <int MAP>
__device__ __forceinline__ void transpose_item(const float* __restrict__ W, int K, int N, bf16_t* __restrict__ WT, LAS float* scr, int item, int lane) {
    const int nblk = (N + 31) / 32, kb = item / nblk, nb = item % nblk, k0 = 64 * kb, n0 = 32 * nb;
    { const int n4 = (lane & 7) * 4; const bool okn = (n0 + n4) < N;
      f32x4 t[8];
#pragma unroll
      for (int i = 0; i < 8; ++i) { const int kk = (lane >> 3) + 8 * i; t[i] = okn ? *(const f32x4*)(W + (size_t)(k0 + kk) * N + n0 + n4) : (f32x4){0.f, 0.f, 0.f, 0.f}; }
#pragma unroll
      for (int i = 0; i < 8; ++i) { const int kk = (lane >> 3) + 8 * i; LAS float* d = scr + kk * 33 + n4; d[0] = t[i].x; d[1] = t[i].y; d[2] = t[i].z; d[3] = t[i].w; } }
    asm volatile("s_waitcnt lgkmcnt(0)" ::: "memory");
    const int c = lane & 7;
#pragma unroll
    for (int j = 0; j < 4; ++j) { const int n = (lane >> 3) + 8 * j; const LAS float* sp = scr + (8 * c) * 33 + n;
        u32x4 o; o.x = pk2(sp[0 * 33], sp[1 * 33]); o.y = pk2(sp[2 * 33], sp[3 * 33]); o.z = pk2(sp[4 * 33], sp[5 * 33]); o.w = pk2(sp[6 * 33], sp[7 * 33]);
        const int ng = n0 + n;
        if (ng < N) { const int ro = (MAP == 1) ? perm_in(ng) : (MAP == 2) ? perm_gu(ng) : ng;
            if (MAP == 3) *(u32x4*)(WT + (size_t)(k0 >> 10) * 256 * 1024 + (size_t)ro * 1024 + (k0 & 1023) + 8 * c) = o;
            else *(u32x4*)(WT + (size_t)ro * K + k0 + 8 * c) = o; } }
    asm volatile("s_waitcnt lgkmcnt(0)" ::: "memory");
}
constexpr int CV_I_IN = 16 * 89, CV_I_OUT = 16 * 32, CV_I_GU = 16 * 64, CV_I_DN = 16 * 32, CV_I_W1 = 32 * 4;
constexpr int CV_N_IN = L_ * CV_I_IN, CV_N_OUT = L_ * CV_I_OUT, CV_N_GU = L_ * NE * CV_I_GU, CV_N_DN = L_ * NE * CV_I_DN, CV_N_W1 = L_ * 2 * CV_I_W1, CV_N_ALL = CV_N_IN + CV_N_OUT + CV_N_GU + CV_N_DN + CV_N_W1;
constexpr int CV_DEF_GU0 = CV_N_W1 + NE * CV_I_GU, CV_DEF_GU = NE * CV_I_GU, CV_DEF_DN0 = CV_N_W1 + CV_N_GU + NE * CV_I_DN, CV_DEF_DN = NE * CV_I_DN, CV_DEF_ALL = CV_DEF_GU + CV_DEF_DN;
__device__ __forceinline__ void cv_one(KP p, LAS float* scr, int it, int lane) {
    int r = it;
    if (r < CV_N_W1) { const int mtx = r / CV_I_W1, ll = mtx >> 1, kv = mtx & 1; transpose_item<3>((kv ? p->in.w1v : p->in.w1k) + (size_t)ll * 2048 * 128, 2048, 128, WSP(bf16_t, O_WT1) + (size_t)mtx * 256 * 2048, scr, r % CV_I_W1, lane); return; } r -= CV_N_W1;
    if (r < CV_N_GU) { const int mtx = r / CV_I_GU; transpose_item<2>(p->in.wgu + (size_t)mtx * D_ * 2048, D_, 2048, WSP(bf16_t, O_WTGU) + (size_t)mtx * 2048 * D_, scr, r % CV_I_GU, lane); return; } r -= CV_N_GU;
    if (r < CV_N_DN) { const int mtx = r / CV_I_DN; transpose_item<0>(p->in.wdn + (size_t)mtx * D_ * D_, D_, D_, WSP(bf16_t, O_WTDN) + (size_t)mtx * D_ * D_, scr, r % CV_I_DN, lane); return; } r -= CV_N_DN;
    if (r < CV_N_IN) { const int mtx = r / CV_I_IN; transpose_item<1>(p->in.w_in + (size_t)mtx * D_ * DIN, D_, DIN, WSP(bf16_t, O_WTIN) + (size_t)mtx * NPAD * D_, scr, r % CV_I_IN, lane); return; } r -= CV_N_IN;
    { const int mtx = r / CV_I_OUT; transpose_item<0>(p->in.w_out + (size_t)mtx * D_ * D_, D_, D_, WSP(bf16_t, O_WTOUT) + (size_t)mtx * D_ * D_, scr, r % CV_I_OUT, lane); }
}
__device__ __forceinline__ void cv_help(LAS unsigned char* lds, KP p, int maxchunks) {
    const int tid = ftid(), lane = tid & 63, wv = tid >> 6; LAS float* scr = (LAS float*)(lds + wv * 8448);
    unsigned* cursor = WSP(unsigned, O_COUNTS) + 64;
    for (int c = 0; c < maxchunks; ++c) {
        unsigned base = 0u; if (lane == 0) base = atomicAdd(cursor, 8u);
        base = (unsigned)__builtin_amdgcn_readfirstlane((int)base);
        if (base >= (unsigned)CV_DEF_ALL) break;
        for (int i = 0; i < 8; ++i) { const int d = (int)base + i; if (d < CV_DEF_ALL) cv_one(p, scr, d < CV_DEF_GU ? CV_DEF_GU0 + d : CV_DEF_DN0 + (d - CV_DEF_GU), lane); }
    }
}
__device__ __forceinline__ void ph_convert(LAS unsigned char* lds, KP p) {
    const int tid = ftid(), lane = tid & 63, wv = tid >> 6;
    LAS float* scr = (LAS float*)(lds + wv * 8448);
    const int gw = fbid() * 8 + wv, NGW = gridDim.x * 8;
    for (int it = gw; it < CV_N_ALL; it += NGW) {
        if ((it >= CV_DEF_GU0 && it < CV_DEF_GU0 + CV_DEF_GU) || (it >= CV_DEF_DN0 && it < CV_DEF_DN0 + CV_DEF_DN)) continue;
        cv_one(p, scr, it, lane);
    }
    const int gt = fbid() * NT + tid, NG = gridDim.x * NT;
    for (int i = gt; i < L_ * (NPAD - DIN) * (D_ / 8); i += NG) { const int l = i / ((NPAD - DIN) * (D_ / 8)), r = i % ((NPAD - DIN) * (D_ / 8));
        unsigned z_ = 0u; asm volatile("" : "+v"(z_));
        *(u32x4*)(WSP(bf16_t, O_WTIN) + ((size_t)l * NPAD + DIN) * D_ + (size_t)r * 8) = (u32x4){z_, z_, z_, z_}; }
    for (int i = gt; i < L_ * 2 * 2 * 128 * (1024 / 8); i += NG) { const int mtxh = i / (128 * 128), r = i % (128 * 128); unsigned z_ = 0u; asm volatile("" : "+v"(z_));
        *(u32x4*)(WSP(bf16_t, O_WT1) + ((size_t)mtxh * 256 + 128) * 1024 + (size_t)r * 8) = (u32x4){z_, z_, z_, z_}; }
    for (int i = gt; i < L_ * 2 * 64 * 128; i += NG) { const int j = i & 127, seg = (i >> 7) & 63, mtx = i >> 13, ll = mtx >> 1, kv = mtx & 1;
        const float* pos = (kv ? p->in.pos_v : p->in.pos_k) + (size_t)ll * 2048 + seg * 32; const float* w1 = (kv ? p->in.w1v : p->in.w1k) + (size_t)ll * 2048 * 128 + (size_t)seg * 32 * 128; float a = 0.f;
#pragma unroll 8
        for (int k = 0; k < 32; ++k) a += pos[k] * w1[(size_t)k * 128 + j];
        WSP(float, O_BIAS1P)[i] = a; }
    for (int i = gt; i < L_ * NPAD; i += NG) { const int l = i / NPAD, c = i % NPAD; if (c >= DIN) WSP(float, O_BIASP)[i] = 0.f; }
    for (int i = gt; i < L_ * DIN; i += NG) { const int l = i / DIN, n = i % DIN; WSP(float, O_BIASP)[l * NPAD + perm_in(n)] = p->in.b_in[i]; }
    for (int i = gt; i < L_ * NE * D_; i += NG) { const int k = i & (D_ - 1), e = (i >> 10) & (NE - 1), l = i >> 15;
        const float v = p->in.rw[((size_t)l * D_ + k) * NE + e]; const unsigned h = f2bf(v); const float lo = v - bf2f((unsigned short)h);
        WSP(bf16_t, O_RWT)[((size_t)(l * 2 + 0) * NE + e) * D_ + k] = (bf16_t)h; WSP(bf16_t, O_RWT)[((size_t)(l * 2 + 1) * NE + e) * D_ + k] = (bf16_t)f2bf(lo); }
    for (int i = gt; i < T_ * D_ / 8; i += NG) { const f32x4 a = *(const f32x4*)(p->in.x + (size_t)i * 8), b = *(const f32x4*)(p->in.x + (size_t)i * 8 + 4);
        *(u32x4*)(WSP(bf16_t, O_XB) + (size_t)i * 8) = (u32x4){pk2(a.x, a.y), pk2(a.z, a.w), pk2(b.x, b.y), pk2(b.z, b.w)}; }
}

struct EpiProj {
    static constexpr bool PERM = true;
    bf16_t* projb; float* gf; const float* bias;
    __device__ __forceinline__ void operator()(const pg8::f32x4 (&acc)[2][2][4][2], const pg8::Unit& u, int wr, int wc, int fr, int fq) const {
        const int row0 = u.pm * 256 + wr * 64 + fr, col0 = u.pn * 256 + wc * 32 + 8 * fq;
        if (u.pn < 11) {
#pragma unroll
            for (int ai = 0; ai < 2; ++ai)
#pragma unroll
                for (int m = 0; m < 4; ++m) { bf16_t* rowp = projb + (size_t)(row0 + ai * 128 + m * 16) * PB + col0;
#pragma unroll
                    for (int bj = 0; bj < 2; ++bj) { const f32x4 v0 = acc[ai][bj][m][0] + *(const f32x4*)(bias + col0 + bj * 128), v1 = acc[ai][bj][m][1] + *(const f32x4*)(bias + col0 + bj * 128 + 4);
                        u32x4 w; w.x = pg8::cvt_pk_bf16(v0[0], v0[1]); w.y = pg8::cvt_pk_bf16(v0[2], v0[3]); w.z = pg8::cvt_pk_bf16(v1[0], v1[1]); w.w = pg8::cvt_pk_bf16(v1[2], v1[3]);
                        *(u32x4*)(rowp + bj * 128) = w; }
                    asm volatile("" ::: "memory"); }
        } else if (wc == 0) {
            const f32x4 b0 = *(const f32x4*)(bias + col0), b1 = *(const f32x4*)(bias + col0 + 4);
#pragma unroll
            for (int ai = 0; ai < 2; ++ai)
#pragma unroll
                for (int m = 0; m < 4; ++m) { float* rowp = gf + (size_t)(row0 + ai * 128 + m * 16) * 32 + 8 * fq;
                    const f32x4 v0 = acc[ai][0][m][0] + b0, v1 = acc[ai][0][m][1] + b1; f32x4 o0, o1;
#pragma unroll
                    for (int i = 0; i < 4; ++i) { const int j0 = 8 * fq + i, j1 = j0 + 4;
                        o0[i] = (j0 < 24) ? sigmoidf_(v0[i]) : (j0 < 28 ? logsig(v0[i]) : 0.f); o1[i] = (j1 < 24) ? sigmoidf_(v1[i]) : (j1 < 28 ? logsig(v1[i]) : 0.f); }
                    *(f32x4*)rowp = o0; *(f32x4*)(rowp + 4) = o1; }
        }
    }
};
struct EpiOut {
    static constexpr bool PERM = true;
    bf16_t* mixb;
    __device__ __forceinline__ void operator()(const pg8::f32x4 (&acc)[2][2][4][2], const pg8::Unit& u, int wr, int wc, int fr, int fq) const {
        const int row0 = u.pm * 256 + wr * 64 + fr, col0 = u.pn * 256 + wc * 32 + 8 * fq;
#pragma unroll
        for (int ai = 0; ai < 2; ++ai)
#pragma unroll
            for (int m = 0; m < 4; ++m) { bf16_t* rowp = mixb + (size_t)(row0 + ai * 128 + m * 16) * D_ + col0;
#pragma unroll
                for (int bj = 0; bj < 2; ++bj) { const f32x4 v0 = acc[ai][bj][m][0], v1 = acc[ai][bj][m][1];
                    u32x4 w; w.x = pg8::cvt_pk_bf16(v0[0], v0[1]); w.y = pg8::cvt_pk_bf16(v0[2], v0[3]); w.z = pg8::cvt_pk_bf16(v1[0], v1[1]); w.w = pg8::cvt_pk_bf16(v1[2], v1[3]);
                    *(u32x4*)(rowp + bj * 128) = w; }
                asm volatile("" ::: "memory"); }
    }
};
struct EpiGU {
    static constexpr bool PERM = true;
    bf16_t* act; const float* bgu;
    __device__ __forceinline__ void operator()(const pg8::f32x4 (&acc)[2][2][4][2], const pg8::Unit& u, int wr, int wc, int fr, int fq) const {
        const int row0 = u.pm * 256 + wr * 64 + fr, col0 = u.pn * 128 + wc * 32 + 8 * fq;
        const float* bb = bgu + (size_t)u.e * 2048 + col0;
        const f32x4 bg0 = *(const f32x4*)bb, bg1 = *(const f32x4*)(bb + 4), bu0 = *(const f32x4*)(bb + 1024), bu1 = *(const f32x4*)(bb + 1028);
#pragma unroll
        for (int ai = 0; ai < 2; ++ai)
#pragma unroll
            for (int m = 0; m < 4; ++m) { f32x4 a0, a1;
                const f32x4 g0 = acc[ai][0][m][0] + bg0, g1 = acc[ai][0][m][1] + bg1, u0 = acc[ai][1][m][0] + bu0, u1 = acc[ai][1][m][1] + bu1;
#pragma unroll
                for (int i = 0; i < 4; ++i) { const float gt0 = fminf(g0[i], 7.0f), up0 = fminf(fmaxf(u0[i], -7.0f), 7.0f), gt1 = fminf(g1[i], 7.0f), up1 = fminf(fmaxf(u1[i], -7.0f), 7.0f);
                    a0[i] = gt0 * sigmoidf_(1.702f * gt0) * (up0 + 1.0f); a1[i] = gt1 * sigmoidf_(1.702f * gt1) * (up1 + 1.0f); }
                u32x4 w; w.x = pg8::cvt_pk_bf16(a0[0], a0[1]); w.y = pg8::cvt_pk_bf16(a0[2], a0[3]); w.z = pg8::cvt_pk_bf16(a1[0], a1[1]); w.w = pg8::cvt_pk_bf16(a1[2], a1[3]);
                *(u32x4*)(act + (size_t)(row0 + ai * 128 + m * 16) * D_ + col0) = w; asm volatile("" ::: "memory"); }
    }
};
struct EpiDN {
    static constexpr bool PERM = true;
    bf16_t* y; const float* bdn; const float* roww;
    __device__ __forceinline__ void operator()(const pg8::f32x4 (&acc)[2][2][4][2], const pg8::Unit& u, int wr, int wc, int fr, int fq) const {
        const int row0 = u.pm * 256 + wr * 64 + fr, col0 = u.pn * 256 + wc * 32 + 8 * fq;
        const float* bb = bdn + (size_t)u.e * D_ + col0;
#pragma unroll
        for (int ai = 0; ai < 2; ++ai)
#pragma unroll
            for (int m = 0; m < 4; ++m) { const int row = row0 + ai * 128 + m * 16; const float w = roww[row];
#pragma unroll
                for (int bj = 0; bj < 2; ++bj) { const f32x4 v0 = (acc[ai][bj][m][0] + *(const f32x4*)(bb + bj * 128)) * w, v1 = (acc[ai][bj][m][1] + *(const f32x4*)(bb + bj * 128 + 4)) * w;
                    u32x4 o; o.x = pg8::cvt_pk_bf16(v0[0], v0[1]); o.y = pg8::cvt_pk_bf16(v0[2], v0[3]); o.z = pg8::cvt_pk_bf16(v1[0], v1[1]); o.w = pg8::cvt_pk_bf16(v1[2], v1[3]);
                    *(u32x4*)(y + (size_t)row * D_ + col0 + bj * 128) = o; }
                asm volatile("" ::: "memory"); }
    }
};
struct EpiCmp {
    static constexpr bool PERM = true;
    float* hidp;
    __device__ __forceinline__ void operator()(const pg8::f32x4 (&acc)[2][2][4][2], const pg8::Unit& u, int wr, int wc, int fr, int fq) const {
        const int row0 = u.pm * 256 + wr * 64 + fr, col0 = wc * 32 + 8 * fq;
#pragma unroll
        for (int ai = 0; ai < 2; ++ai)
#pragma unroll
            for (int m = 0; m < 4; ++m) { float* d = hidp + (((size_t)u.pn * 8 + u.e) * 512 + row0 + ai * 128 + m * 16) * 128 + col0;
                *(f32x4*)d = acc[ai][0][m][0]; *(f32x4*)(d + 4) = acc[ai][0][m][1]; asm volatile("" ::: "memory"); }
    }
};
struct GEpi {
    static constexpr bool PERM = true;
    int kind, l;
    __device__ __forceinline__ void operator()(const pg8::f32x4 (&acc)[2][2][4][2], const pg8::Unit& u, int wr, int wc, int fr, int fq) const {
        const KP p = fresh_kp();
        if (kind == 0) { const EpiProj e{WSP(bf16_t, O_PROJB), WSP(float, O_GF), WSP(float, O_BIASP) + l * NPAD}; e(acc, u, wr, wc, fr, fq); }
        else if (kind == 1) { const EpiOut e{WSP(bf16_t, O_MIX)}; e(acc, u, wr, wc, fr, fq); }
        else if (kind == 2) { const EpiGU e{WSP(bf16_t, O_ACT), p->in.bgu + (size_t)l * NE * 2048}; e(acc, u, wr, wc, fr, fq); }
        else if (kind == 3) { const EpiDN e{WSP(bf16_t, O_Y), p->in.bdn + (size_t)l * NE * D_, WSP(float, O_ROWW)}; e(acc, u, wr, wc, fr, fq); }
        else { const EpiCmp e{WSP(float, O_HIDP)}; e(acc, u, wr, wc, fr, fq); }
    }
};
struct GSched {
    int kind, nM, nN, nunits, G, c; const int* meta; const int* rowtok; const char* Bt; size_t estep;
    __device__ __forceinline__ bool next(int i, pg8::Unit& u) const {
        const int L = i * G + c; if (L >= nunits) return false;
        if (kind == 1) {
            int wgid = L; { const int q = nunits / pg8::NXCD, r = nunits % pg8::NXCD, xcd = wgid % pg8::NXCD, off = wgid / pg8::NXCD; wgid = (xcd < r ? xcd * (q + 1) : r * (q + 1) + (xcd - r) * q) + off; }
            const int nig = pg8::WGM * nN, gid = wgid / nig, fm = gid * pg8::WGM, gsz = (nM - fm) < pg8::WGM ? (nM - fm) : pg8::WGM;
            u.pm = fm + ((wgid % nig) % gsz); u.pn = (wgid % nig) / gsz; u.e = 0; u.nr = 256;
        } else if (kind == 4) { u.e = L >> 2; u.pm = (L >> 1) & 1; u.pn = L & 1; u.nr = ((L >> 1) & 1) ? 255 : 256; }
        else if (kind == 0) { const int gt = L / nN; u.pm = gt; u.pn = L - gt * nN; u.e = 0; u.nr = 256; }
        else { const int gt = L / nN; u.pm = gt; u.pn = L - gt * nN; u.e = meta[64 + 2 * gt]; u.nr = meta[65 + 2 * gt]; }
        return true; }
    __device__ __forceinline__ unsigned a_off(const pg8::Unit& u, int r) const { const int rr = r < u.nr ? r : u.nr - 1; const int row = u.pm * 256 + rr;
        if (kind == 4) { const int kv = u.e & 1, bg = u.e >> 1; return (unsigned)(((bg >> 1) * S_ + 16 * row + 16 * u.pn) * PB + C_KV + ((0 * 2 + kv) * 2 + (bg & 1)) * 64) * 2u; }
        return (unsigned)((kind == 2) ? rowtok[row] : row) * (unsigned)(D_ * 2); }
    __device__ __forceinline__ size_t a_kstep() const { return kind == 4 ? (size_t)PB * 2 : (size_t)128; }
    __device__ __forceinline__ const char* b_base(const pg8::Unit& u) const { return Bt + (size_t)(kind == 4 ? (u.e & 1) : u.e) * estep + (size_t)u.pn * ((size_t)256 * D_ * 2); }
};

__device__ __forceinline__ void ph_rmsnorm(KP p, int l) {
    const int lane = ftid() & 63, wv = ftid() >> 6; const float* g = p->in.g_out + (size_t)l * D_;
    constexpr int NB = 4; const int rstride = (int)gridDim.x * 8;
    f32x4 gg[4];
#pragma unroll
    for (int j = 0; j < 2; ++j) { gg[2 * j] = *(const f32x4*)(g + 512 * j + lane * 8); gg[2 * j + 1] = *(const f32x4*)(g + 512 * j + lane * 8 + 4); }
    for (int row0 = fbid() * 8 + wv; row0 < T_; row0 += rstride * NB) {
        u32x4 ra[NB], rb2[NB], rw2[NB];
#pragma unroll
        for (int bi = 0; bi < NB; ++bi) { const int row = (row0 + bi * rstride < T_) ? row0 + bi * rstride : row0; const bf16_t* r = WSP(bf16_t, O_O) + (size_t)row * D_ + lane * 8;
            ra[bi] = *(const u32x4*)r; rb2[bi] = *(const u32x4*)(r + 512); rw2[bi] = *(const u32x4*)(WSP(bf16_t, O_OWIN) + (size_t)row * 512 + lane * 8); }
#pragma unroll
        for (int bi = 0; bi < NB; ++bi) { const int row = row0 + bi * rstride; if (row < T_) {
#define BF_LO(u) __uint_as_float((u) << 16)
#define BF_HI(u) __uint_as_float((u) & 0xffff0000u)
            const f32x4 x0 = (f32x4){BF_LO(ra[bi].x) + BF_LO(rw2[bi].x), BF_HI(ra[bi].x) + BF_HI(rw2[bi].x), BF_LO(ra[bi].y) + BF_LO(rw2[bi].y), BF_HI(ra[bi].y) + BF_HI(rw2[bi].y)};
            const f32x4 x1 = (f32x4){BF_LO(ra[bi].z) + BF_LO(rw2[bi].z), BF_HI(ra[bi].z) + BF_HI(rw2[bi].z), BF_LO(ra[bi].w) + BF_LO(rw2[bi].w), BF_HI(ra[bi].w) + BF_HI(rw2[bi].w)};
            const f32x4 y0 = (f32x4){BF_LO(rb2[bi].x), BF_HI(rb2[bi].x), BF_LO(rb2[bi].y), BF_HI(rb2[bi].y)}, y1 = (f32x4){BF_LO(rb2[bi].z), BF_HI(rb2[bi].z), BF_LO(rb2[bi].w), BF_HI(rb2[bi].w)};
#undef BF_LO
#undef BF_HI
            float s = (x0.x * x0.x + x0.y * x0.y) + (x0.z * x0.z + x0.w * x0.w) + (x1.x * x1.x + x1.y * x1.y) + (x1.z * x1.z + x1.w * x1.w);
            float s2 = (y0.x * y0.x + y0.y * y0.y) + (y0.z * y0.z + y0.w * y0.w) + (y1.x * y1.x + y1.y * y1.y) + (y1.z * y1.z + y1.w * y1.w);
            const float sc0 = rsqrtf(wsum(s) * (1.f / 512.f) + RMS_EPS);
#pragma unroll
            for (int o = 1; o < 32; o <<= 1) s2 += __shfl_xor(s2, o);
            const float sc1 = rsqrtf(s2 * (1.f / 256.f) + RMS_EPS);
            const f32x4 u0 = x0 * sc0 * gg[0], u1 = x1 * sc0 * gg[1], w0 = y0 * sc1 * gg[2], w1 = y1 * sc1 * gg[3];
            bf16_t* ro = WSP(bf16_t, O_OB) + (size_t)row * D_;
            *(u32x4*)(ro + lane * 8) = (u32x4){pk2(u0.x, u0.y), pk2(u0.z, u0.w), pk2(u1.x, u1.y), pk2(u1.z, u1.w)};
            *(u32x4*)(ro + 512 + lane * 8) = (u32x4){pk2(w0.x, w0.y), pk2(w0.z, w0.w), pk2(w1.x, w1.y), pk2(w1.z, w1.w)}; } }
    }
}
template <bool ROUTER>
__device__ __forceinline__ void ph_ln(float* lds, KP p, int l, float* __restrict__ yout, int cnt_off = 0) {
    const int lane = ftid() & 63, wv = ftid() >> 6;
    const float* g = (ROUTER ? p->in.ln1_g : p->in.ln2_g) + (size_t)l * D_; const float* bb = (ROUTER ? p->in.ln1_b : p->in.ln2_b) + (size_t)l * D_;
    constexpr int NB = ROUTER ? 4 : 2;
    const int rstride = (int)gridDim.x * 8;
    LAS unsigned char* L3 = (LAS unsigned char*)lds; float* lgl = lds + 33024 + wv * 256;
    int oi = 0;
    for (int row0 = fbid() * 8 + wv; row0 < T_; row0 += rstride * NB, ++oi) {
        float v[NB][16];
        if (ROUTER) { const float* xin = (l == 0) ? p->in.x : WSP(float, O_XA);
#pragma unroll
            for (int bi = 0; bi < NB; ++bi) { const int row = (row0 + bi * rstride < T_) ? row0 + bi * rstride : row0; const float* src = xin + (size_t)row * D_; const bf16_t* mx = WSP(bf16_t, O_MIX) + (size_t)row * D_;
#pragma unroll
                for (int j = 0; j < 2; ++j) { const f32x4 a = *(const f32x4*)(src + 512 * j + lane * 8), b = *(const f32x4*)(src + 512 * j + lane * 8 + 4); const u32x4 q = *(const u32x4*)(mx + 512 * j + lane * 8);
                    v[bi][8 * j + 0] = ALPHA * a.x + __uint_as_float(q.x << 16); v[bi][8 * j + 1] = ALPHA * a.y + __uint_as_float(q.x & 0xffff0000u); v[bi][8 * j + 2] = ALPHA * a.z + __uint_as_float(q.y << 16); v[bi][8 * j + 3] = ALPHA * a.w + __uint_as_float(q.y & 0xffff0000u);
                    v[bi][8 * j + 4] = ALPHA * b.x + __uint_as_float(q.z << 16); v[bi][8 * j + 5] = ALPHA * b.y + __uint_as_float(q.z & 0xffff0000u); v[bi][8 * j + 6] = ALPHA * b.z + __uint_as_float(q.w << 16); v[bi][8 * j + 7] = ALPHA * b.w + __uint_as_float(q.w & 0xffff0000u); } }
        } else { const bf16_t* y = WSP(bf16_t, O_Y);
            int sl[NB][TOPK];
#pragma unroll
            for (int bi = 0; bi < NB; ++bi) { const int row = (row0 + bi * rstride < T_) ? row0 + bi * rstride : row0;
#pragma unroll
                for (int k = 0; k < TOPK; ++k) sl[bi][k] = WSP(int, O_SLOT)[row * TOPK + k]; }
            u32x4 yv[NB][TOPK][2]; f32x4 xv[NB][4];
#pragma unroll
            for (int bi = 0; bi < NB; ++bi) { const int row = (row0 + bi * rstride < T_) ? row0 + bi * rstride : row0; const float* src = WSP(float, O_X1) + (size_t)row * D_;
#pragma unroll
                for (int j = 0; j < 2; ++j) { xv[bi][2 * j] = *(const f32x4*)(src + 512 * j + lane * 8); xv[bi][2 * j + 1] = *(const f32x4*)(src + 512 * j + lane * 8 + 4); }
#pragma unroll
                for (int k = 0; k < TOPK; ++k)
#pragma unroll
                    for (int j = 0; j < 2; ++j) yv[bi][k][j] = *(const u32x4*)(y + (size_t)sl[bi][k] * D_ + 512 * j + lane * 8); }
#pragma unroll
            for (int bi = 0; bi < NB; ++bi)
#pragma unroll
                for (int j = 0; j < 2; ++j) { float acc[8];
#pragma unroll
                    for (int e = 0; e < 8; ++e) acc[e] = 0.f;
#pragma unroll
                    for (int k = 0; k < TOPK; ++k) { const u32x4 q = yv[bi][k][j];
                        acc[0] += __uint_as_float(q.x << 16); acc[1] += __uint_as_float(q.x & 0xffff0000u); acc[2] += __uint_as_float(q.y << 16); acc[3] += __uint_as_float(q.y & 0xffff0000u);
                        acc[4] += __uint_as_float(q.z << 16); acc[5] += __uint_as_float(q.z & 0xffff0000u); acc[6] += __uint_as_float(q.w << 16); acc[7] += __uint_as_float(q.w & 0xffff0000u); }
                    const f32x4 a = xv[bi][2 * j], b = xv[bi][2 * j + 1];
                    v[bi][8 * j + 0] = ALPHA * a.x + acc[0]; v[bi][8 * j + 1] = ALPHA * a.y + acc[1]; v[bi][8 * j + 2] = ALPHA * a.z + acc[2]; v[bi][8 * j + 3] = ALPHA * a.w + acc[3];
                    v[bi][8 * j + 4] = ALPHA * b.x + acc[4]; v[bi][8 * j + 5] = ALPHA * b.y + acc[5]; v[bi][8 * j + 6] = ALPHA * b.z + acc[6]; v[bi][8 * j + 7] = ALPHA * b.w + acc[7]; } }
#pragma unroll
        for (int bi = 0; bi < NB; ++bi) { const int row = row0 + bi * rstride; if (row < T_) {
            float s = 0.f;
#pragma unroll
            for (int i = 0; i < 16; ++i) s += v[bi][i];
            const float mu = wsum(s) * (1.f / D_); float s2 = 0.f;
#pragma unroll
            for (int i = 0; i < 16; ++i) { v[bi][i] -= mu; s2 += v[bi][i] * v[bi][i]; }
            const float rstd = rsqrtf(wsum(s2) * (1.f / D_) + LN_EPS);
            bf16_t* ybf = (ROUTER ? WSP(bf16_t, O_X1B) : WSP(bf16_t, O_XB)) + (size_t)row * D_;
#pragma unroll
            for (int j = 0; j < 2; ++j) { const int c0 = 512 * j + lane * 8; float o8[8];
                const f32x4 g0 = *(const f32x4*)(g + c0), g1 = *(const f32x4*)(g + c0 + 4), b0 = *(const f32x4*)(bb + c0), b1 = *(const f32x4*)(bb + c0 + 4);
                o8[0] = v[bi][8 * j + 0] * rstd * g0.x + b0.x; o8[1] = v[bi][8 * j + 1] * rstd * g0.y + b0.y; o8[2] = v[bi][8 * j + 2] * rstd * g0.z + b0.z; o8[3] = v[bi][8 * j + 3] * rstd * g0.w + b0.w;
                o8[4] = v[bi][8 * j + 4] * rstd * g1.x + b1.x; o8[5] = v[bi][8 * j + 5] * rstd * g1.y + b1.y; o8[6] = v[bi][8 * j + 6] * rstd * g1.z + b1.z; o8[7] = v[bi][8 * j + 7] * rstd * g1.w + b1.w;
                *(f32x4*)(yout + (size_t)row * D_ + c0) = (f32x4){o8[0], o8[1], o8[2], o8[3]};
                *(f32x4*)(yout + (size_t)row * D_ + c0 + 4) = (f32x4){o8[4], o8[5], o8[6], o8[7]};
                const u32x4 hv = (u32x4){pk2(o8[0], o8[1]), pk2(o8[2], o8[3]), pk2(o8[4], o8[5]), pk2(o8[6], o8[7])};
                *(u32x4*)(ybf + c0) = hv;
                if (ROUTER) {
                    float r8[8];
#pragma unroll
                    for (int i = 0; i < 4; ++i) { const unsigned w_ = (i == 0) ? hv.x : (i == 1) ? hv.y : (i == 2) ? hv.z : hv.w; r8[2 * i] = o8[2 * i] - __uint_as_float(w_ << 16); r8[2 * i + 1] = o8[2 * i + 1] - __uint_as_float(w_ & 0xffff0000u); }
                    LAS unsigned char* tp = L3 + (bi * 8 + wv) * 2064 + c0 * 2;
                    *(LAS u32x4*)tp = hv; *(LAS u32x4*)(tp + 66048) = (u32x4){pk2(r8[0], r8[1]), pk2(r8[2], r8[3]), pk2(r8[4], r8[5]), pk2(r8[6], r8[7])}; } } } }
        if (ROUTER) {
            __syncthreads();
            const int n32 = lane & 31, hh = lane >> 5;
            f32x16 acc;
#pragma unroll
            for (int r = 0; r < 16; ++r) acc[r] = 0.f;
            { const bf16_t* bh = WSP(bf16_t, O_RWT) + ((size_t)(l * 2) * NE + n32) * D_ + 128 * wv + 8 * hh; const bf16_t* bl = bh + (size_t)NE * D_;
              const LAS unsigned char* ah = L3 + n32 * 2064 + (128 * wv + 8 * hh) * 2;
              bf16x8 bhf[8], blf[8];
#pragma unroll
              for (int s_ = 0; s_ < 8; ++s_) { bhf[s_] = *(const bf16x8*)(bh + 16 * s_); blf[s_] = *(const bf16x8*)(bl + 16 * s_); }
#pragma unroll
              for (int s_ = 0; s_ < 8; ++s_) { const bf16x8 xh = *(const LAS bf16x8*)(ah + 32 * s_), xl = *(const LAS bf16x8*)(ah + 66048 + 32 * s_);
                  acc = __builtin_amdgcn_mfma_f32_32x32x16_bf16(xh, bhf[s_], acc, 0, 0, 0); acc = __builtin_amdgcn_mfma_f32_32x32x16_bf16(xh, blf[s_], acc, 0, 0, 0); acc = __builtin_amdgcn_mfma_f32_32x32x16_bf16(xl, bhf[s_], acc, 0, 0, 0); } }
            __syncthreads();
            { LAS float* red = (LAS float*)L3;
#pragma unroll
              for (int r = 0; r < 16; ++r) red[(wv * 32 + CROW(r, hh)) * 32 + n32] = acc[r];
              __syncthreads();
#pragma unroll
              for (int bi = 0; bi < NB; ++bi) { const int m = bi * 8 + wv; float sm = 0.f;
#pragma unroll
                  for (int q = 0; q < 4; ++q) sm += red[((hh * 4 + q) * 32 + m) * 32 + n32];
                  sm += __shfl_xor(sm, 32);
                  if (lane < 32) lgl[(NB * oi + bi) * 32 + n32] = sm; } }
            __syncthreads();
        }
    }
    if (ROUTER) {
        const float* rb = p->in.rb + (size_t)l * NE;
        int nrow = 0; for (int r_ = fbid() * 8 + wv; r_ < T_; r_ += (int)gridDim.x * 8) { ++nrow; asm volatile("" : "+s"(nrow)); }
        asm volatile("s_waitcnt lgkmcnt(0)" ::: "memory");
        int* lcnt = (int*)(lds + 33024 + 8 * 256);
        if (ftid() < NE) lcnt[ftid()] = 0;
        __syncthreads();
#pragma unroll 1
        for (int ri = 0; ri < nrow; ++ri) { const int row = fbid() * 8 + wv + ri * (int)gridDim.x * 8;
            const int e = lane & 31; const float lg = lgl[ri * 32 + e] + rb[e];
            float cur = lg, tv0 = 0.f, den = 0.f, myw = 0.f; int mye = 0;
#pragma unroll
            for (int k = 0; k < TOPK; ++k) { float bv = cur; int bi = e;
#pragma unroll
                for (int o = 16; o >= 1; o >>= 1) { const float ov = __shfl_xor(bv, o); const int oi = __shfl_xor(bi, o); if (ov > bv || (ov == bv && oi < bi)) { bv = ov; bi = oi; } }
                if (k == 0) tv0 = bv;
                const float w = __expf(bv - tv0); den += w;
                if (lane == k) { mye = bi; myw = w; }
                if (e == bi) cur = -3.4e38f; }
            if (lane < TOPK) { WSP(int, O_TOPE)[row * TOPK + lane] = mye; WSP(float, O_TOPW)[row * TOPK + lane] = myw / den; WSP(int, O_POS)[row * TOPK + lane] = atomicAdd(&lcnt[mye], 1); } }
        __syncthreads();
        if (ftid() < NE) { const int c = lcnt[ftid()]; lcnt[ftid()] = (c > 0) ? atomicAdd(WSP(int, O_COUNTS) + CNT_IDX(l, ftid()) + cnt_off, c) : 0; }
        __syncthreads();
#pragma unroll 1
        for (int ri = 0; ri < nrow; ++ri) { const int row = fbid() * 8 + wv + ri * (int)gridDim.x * 8;
            if (lane < TOPK) WSP(int, O_POS)[row * TOPK + lane] += lcnt[WSP(int, O_TOPE)[row * TOPK + lane]]; }
        __syncthreads();
    }
}
__device__ __forceinline__ void ph_bias1_reduce(KP p, int l) {
    if (fbid() != (int)gridDim.x - 1) return;
    const int tid = ftid(); if (tid < 256) { const float* pp = WSP(float, O_BIAS1P) + ((size_t)(l * 2 + (tid >> 7)) * 64) * 128 + (tid & 127);
        float v[64];
#pragma unroll
        for (int s = 0; s < 64; ++s) v[s] = pp[s * 128];
        float a = 0.f;
#pragma unroll
        for (int s = 0; s < 64; ++s) a += v[s];
        WSP(float, O_BIAS1)[l * 256 + tid] = a; }
}
__device__ __forceinline__ void ph_cumsum(float* lds, KP p, int blk0) {
    const int tid = ftid(), lane = tid & 63, wv = tid >> 6; const int bh = fbid() - blk0;
    if (bh < 0 || bh >= B_ * 4) return;
    const int b = bh >> 2, h = bh & 3; const float* gf = WSP(float, O_GF) + (size_t)(b * S_ + tid * 16) * 32 + 24 + h;
    float v[16], run = 0.f;
#pragma unroll
    for (int i = 0; i < 16; ++i) { run += gf[(size_t)i * 32]; v[i] = run; }
    float inc = run;
#pragma unroll
    for (int o = 1; o < 64; o <<= 1) { const float t = __shfl_up(inc, o); if (lane >= o) inc += t; }
    if (lane == 63) lds[wv] = inc;
    __syncthreads();
    float woff = 0.f;
#pragma unroll
    for (int i = 0; i < 8; ++i) woff += (i < wv) ? lds[i] : 0.f;
    const float off = woff + inc - run; float* c = WSP(float, O_CFOX) + (size_t)bh * S_ + tid * 16;
#pragma unroll
    for (int i = 0; i < 4; ++i) *(f32x4*)(c + 4 * i) = (f32x4){v[4 * i] + off, v[4 * i + 1] + off, v[4 * i + 2] + off, v[4 * i + 3] + off};
    __syncthreads();
}
__device__ __forceinline__ void ph_prep2(float* lds, KP p, int l) {
    { unsigned* kmax2 = WSP(unsigned, O_COUNTS) + 192 + l * 8;
      for (int i = fbid() * NT + ftid(); i < B_ * 4 * S_ * 2; i += gridDim.x * NT) { const int half = i & 1, t = (i >> 1) % S_, bh = (i >> 1) / S_, b = bh >> 2, h = bh & 3;
          const bf16_t* kr = WSP(bf16_t, O_PROJB) + (size_t)(b * S_ + t) * PB + C_FOX + (4 + h) * 64 + half * 32; float ss = 0.f;
#pragma unroll
          for (int c = 0; c < 4; ++c) { float k8[8]; ld8(kr + 8 * c, k8);
#pragma unroll
              for (int e = 0; e < 8; ++e) ss += k8[e] * k8[e]; }
          ss += __shfl_xor(ss, 1);
#pragma unroll
          for (int o = 2; o < 64; o <<= 1) ss = fmaxf(ss, __shfl_xor(ss, o));
          __syncthreads();
          if ((ftid() & 63) == 0) lds[ftid() >> 6] = ss;
          __syncthreads();
          if (ftid() == 0) { float mx = lds[0];
#pragma unroll
              for (int w_ = 1; w_ < 8; ++w_) mx = fmaxf(mx, lds[w_]);
              atomicMax(kmax2 + bh, __float_as_uint(mx)); } } }
    for (int i = fbid() * NT + ftid(); i < 8 * 512 * 64; i += gridDim.x * NT) {
        const int d = i & 63, n = (i >> 6) & 511, combo = i >> 15, kv = combo & 1, bg = combo >> 1;
        const float* w2 = (kv ? p->in.w2v : p->in.w2k) + (size_t)l * 128 * 64; const float* h0 = WSP(float, O_HIDP) + ((size_t)combo * 512 + n) * 128; const float* h1 = h0 + (size_t)8 * 512 * 128;
        const float* b1 = WSP(float, O_BIAS1) + l * 256 + kv * 128;
        __syncthreads();
#pragma unroll
        for (int q = 0; q < 4; ++q) *(f32x4*)(lds + 16 + 4 * (q * NT + ftid())) = *(const f32x4*)(w2 + 4 * (q * NT + ftid()));
        const float hv0 = gelu_tanh(h0[d] + h1[d] + b1[d]), hv1 = gelu_tanh(h0[64 + d] + h1[64 + d] + b1[64 + d]);
        __syncthreads();
        const float* w2s = lds + 16 + d;
        float a = 0.f;
#pragma unroll 16
        for (int c = 0; c < 64; ++c) a += __int_as_float(__builtin_amdgcn_readlane(__float_as_int(hv0), c)) * w2s[c * 64];
#pragma unroll 16
        for (int c = 0; c < 64; ++c) a += __int_as_float(__builtin_amdgcn_readlane(__float_as_int(hv1), c)) * w2s[(64 + c) * 64];
        (kv ? WSP(bf16_t, O_VCMPB) : WSP(bf16_t, O_KCMPB))[((size_t)bg * 512 + n) * 64 + d] = (n < NCMP) ? (bf16_t)f2bf(a) : (bf16_t)0; }
}
__device__ __forceinline__ void ph_moe_scatter2(float* lds, KP p, int l) {
    const int tid = ftid(); int* ts = (int*)lds;
    const int* counts = WSP(int, O_COUNTS) + CNT_IDX(l, 0); int* meta = WSP(int, O_META); int* cl = ts + 64;
    __syncthreads();
    if (tid < NE) cl[tid] = counts[tid * 32];
    __syncthreads();
    if (tid == 0) { int nt = 0; for (int e = 0; e < NE; ++e) { ts[e] = nt; nt += (cl[e] + 255) >> 8; } ts[32] = nt; }
    __syncthreads();
    if (fbid() == 0) { if (tid < NE) { const int c = cl[tid], t0 = ts[tid]; meta[tid] = t0; for (int r = 0, t = t0; r < c; r += 256, ++t) { meta[64 + 2 * t] = tid; meta[65 + 2 * t] = (c - r) < 256 ? (c - r) : 256; } }
        if (tid == 0) meta[32] = ts[32]; }
    for (int i = fbid() * NT + tid; i < MROWS; i += gridDim.x * NT) {
        const int row = ts[WSP(int, O_TOPE)[i]] * 256 + WSP(int, O_POS)[i];
        WSP(int, O_ROWTOK)[row] = i >> 2; WSP(float, O_ROWW)[row] = WSP(float, O_TOPW)[i]; WSP(int, O_SLOT)[i] = row; }
    __syncthreads();
}
}
namespace mk {
typedef short bf16x8 __attribute__((ext_vector_type(8)));
typedef float f32x16 __attribute__((ext_vector_type(16)));
typedef float f32x2_t __attribute__((ext_vector_type(2)));
typedef __bf16 bf16x2_t __attribute__((ext_vector_type(2)));
typedef unsigned u32x2 __attribute__((ext_vector_type(2)));
typedef short v4i16_t __attribute__((ext_vector_type(4)));
__device__ __forceinline__ unsigned cvtpk(float lo, float hi) { f32x2_t v = {lo, hi}; bf16x2_t b = __builtin_convertvector(v, bf16x2_t); return __builtin_bit_cast(unsigned, b); }
constexpr int KROW = 144, VROW = 136;
constexpr int E1_K = 0, E1_V = 64 * KROW, E1_C = E1_V + 64 * KROW, E1_BUF = E1_C + 256;
constexpr int E1_FLAGS = 2 * E1_BUF;
constexpr float LOG2E = 1.4426950408889634f;
constexpr float RESC_THR = 8.0f;
#define CROW(reg, hh) (((reg) & 3) + 8 * ((reg) >> 2) + 4 * (hh))

__device__ __forceinline__ float max3f(float a, float b, float c) { float r; asm("v_max3_f32 %0, %1, %2, %3" : "=v"(r) : "v"(a), "v"(b), "v"(c)); return r; }
typedef float f32x2_t __attribute__((ext_vector_type(2)));
__device__ __forceinline__ float lane32_other(float x, int hh) { const auto rr = __builtin_amdgcn_permlane32_swap(__float_as_uint(x), __float_as_uint(x), false, false); return __uint_as_float(hh ? rr[0] : rr[1]); }
#define SM_V(p0, p1, i_) (((i_) & 1) ? p1[(i_) >> 1] : p0[(i_) >> 1])
#define SM_ROWMAX(p0, p1, rm_) do { \
    rm_ = max3f(p0[0], p1[0], p0[1]); \
    _Pragma("unroll") for (int k_ = 0; k_ < 14; ++k_) rm_ = max3f(rm_, SM_V(p0, p1, 3 + 2 * k_), SM_V(p0, p1, 4 + 2 * k_)); \
    rm_ = max3f(rm_, p1[15], p1[15]); \
    { const auto rr_ = __builtin_amdgcn_permlane32_swap(__float_as_uint(rm_), __float_as_uint(rm_), false, false);     \
      rm_ = max3f(__uint_as_float(rr_[0]), __uint_as_float(rr_[1]), __uint_as_float(rr_[1])); } } while (0)
#define SM_CORE(p0, p1, m, l, have, o0, o1) do { \
    float rm_; SM_ROWMAX(p0, p1, rm_); \
    const bool fin_ = rm_ > -1e37f; \
    if (__any((rm_ > RESC_THR) || (!have && fin_))) { \
        const float dl_ = have ? fmaxf(rm_, 0.f) : (fin_ ? rm_ : 0.f); const float al_ = have ? __builtin_amdgcn_exp2f(-dl_) : 1.f; \
        m += dl_; l *= al_; have = have || fin_; \
        _Pragma("unroll") for (int r_ = 0; r_ < 16; ++r_) { o0[r_] *= al_; o1[r_] *= al_; p0[r_] -= dl_; p1[r_] -= dl_; } } \
    f32x2_t ls2_ = {0.f, 0.f}; \
    _Pragma("unroll") for (int reg_ = 0; reg_ < 16; reg_ += 2) { \
        p0[reg_] = __builtin_amdgcn_exp2f(p0[reg_]); p0[reg_ + 1] = __builtin_amdgcn_exp2f(p0[reg_ + 1]); p1[reg_] = __builtin_amdgcn_exp2f(p1[reg_]); p1[reg_ + 1] = __builtin_amdgcn_exp2f(p1[reg_ + 1]); \
        ls2_ += (f32x2_t){p0[reg_], p0[reg_ + 1]}; ls2_ += (f32x2_t){p1[reg_], p1[reg_ + 1]}; } \
    l += ls2_.x + ls2_.y; } while (0)

struct E1Geom { int b, q0, h; const bf16_t* qp; const bf16_t* kp; const bf16_t* vp; size_t pitch; };

template <int KIND>
__device__ __forceinline__ void e1_unit(LAS unsigned char* lds, KP p, int b, int hg, int qb, bf16_t* __restrict__ obase, bf16_t* __restrict__ owin, const unsigned* __restrict__ kmax2) {
    const int tid = ftid(), lane = tid & 63, w = __builtin_amdgcn_readfirstlane(tid >> 6), r32 = lane & 31, hh = lane >> 5;
    const bf16_t* projb = WSP(bf16_t, O_PROJB);
    int h, q0, qrow0, qcol, kcol, vcol, nrows;
    if (KIND == 0) { h = hg; q0 = qb * 256; qrow0 = q0 + 32 * w; qcol = C_FOX + h * 64; kcol = C_FOX + (4 + h) * 64; vcol = C_FOX + (8 + h) * 64; nrows = 256; }
    else if (KIND == 2) { h = hg; q0 = qb * 256; qrow0 = q0 + 32 * w; qcol = C_SB + h * 64; kcol = C_SB + (4 + h) * 64; vcol = C_SB + (8 + h) * 64; nrows = 256; }
    else { h = 4 * hg + (w & 3); q0 = qb * 64; qrow0 = q0 + 32 * (w >> 2); qcol = h * 64; kcol = C_KV + ((2 * 2 + 0) * 2 + hg) * 64; vcol = C_KV + ((2 * 2 + 1) * 2 + hg) * 64; nrows = 64; }
    const int tq = qrow0 + r32;
    const bf16_t* kbase = projb + (size_t)(b * S_) * PB + kcol; const bf16_t* vbase = projb + (size_t)(b * S_) * PB + vcol;
    bf16x8 qf[4];
    { const bf16_t* qptr = projb + (size_t)(b * S_ + tq) * PB + qcol + 8 * hh;
#pragma unroll
      for (int d0 = 0; d0 < 4; ++d0) qf[d0] = *(const bf16x8*)(qptr + 16 * d0);
      if (KIND == 1) {
#pragma unroll
          for (int d0 = 0; d0 < 4; ++d0) { u32x4 w_;
#pragma unroll
              for (int e2 = 0; e2 < 4; ++e2) { const float lo_ = bf2f((unsigned short)qf[d0][2 * e2]) * (SCALE * LOG2E), hi_ = bf2f((unsigned short)qf[d0][2 * e2 + 1]) * (SCALE * LOG2E); w_[e2] = cvtpk(lo_, hi_); }
              qf[d0] = __builtin_bit_cast(bf16x8, w_); } } }
    int j0 = 0; const int j1 = (q0 + nrows - 1) >> 6;
    if (KIND == 1) { j0 = (q0 - 511) >> 6; if (j0 < 0) j0 = 0; }
    const int ntile = j1 - j0 + 1;
    float ct2 = 0.f, sl2 = 0.f; const float* cb = nullptr;
    if (KIND == 0) { cb = WSP(float, O_CFOX) + (size_t)(b * 4 + h) * S_; ct2 = cb[tq] * LOG2E; }
    if (KIND == 1) sl2 = exp2f(-(float)(h + 1)) * LOG2E;
    bf16x8 kx0 = {0, 0, 0, 0, 0, 0, 0, 0}, kx1 = {0, 0, 0, 0, 0, 0, 0, 0}; float sl2h = 0.f, sl2l = 0.f;
    if (KIND == 1) { const unsigned one_ = 0x3f80u; const unsigned k0_ = f2bf((float)r32), k1_ = f2bf((float)(r32 + 32));
        if (hh == 0) { kx0 = __builtin_bit_cast(bf16x8, (u32x4){k0_ | (k0_ << 16), one_ | (one_ << 16), one_, 0u}); kx1 = __builtin_bit_cast(bf16x8, (u32x4){k1_ | (k1_ << 16), one_ | (one_ << 16), one_, 0u}); }
        sl2h = bf2f((unsigned short)f2bf(sl2)); sl2l = sl2 - sl2h; }
    float qkb = 0.f;
    if (KIND == 0) { float qs = 0.f;
#pragma unroll
        for (int d0 = 0; d0 < 4; ++d0)
#pragma unroll
            for (int e = 0; e < 8; ++e) { const float x = bf2f((unsigned short)qf[d0][e]); qs += x * x; }
        qs += __shfl_xor(qs, 32);
        const float km2 = __uint_as_float(kmax2[b * 4 + h]);
        qkb = sqrtf(qs * km2) * (SCALE * LOG2E * 1.01f); }
    const float tqf = (float)tq;
    const int skey = tid >> 3, sch = tid & 7;
    u32x4 rk, rv; float rc = 0.f;
#define E1_LOAD(jj) do { const size_t ro_ = (size_t)((jj) * 64 + skey) * PB + sch * 8; rk = *(const u32x4*)(kbase + ro_); rv = *(const u32x4*)(vbase + ro_); \
        if (KIND == 0 && tid < 64) rc = cb[(jj) * 64 + tid] * LOG2E; } while (0)
#define E1_WRITE(bufp) do { *(LAS u32x4*)((bufp) + E1_K + skey * KROW + sch * 16) = rk; *(LAS u32x4*)((bufp) + E1_V + skey * KROW + sch * 16) = rv; \
        if (KIND == 0 && tid < 64) ((LAS float*)((bufp) + E1_C))[tid] = rc; } while (0)
    f32x16 o0, o1;
#pragma unroll
    for (int r = 0; r < 16; ++r) { o0[r] = 0.f; o1[r] = 0.f; }
    float m = 0.f, l = 0.f, carry = 0.f; bool have = false;
    bool wave_done = false;
    LAS unsigned* flags = (LAS unsigned*)(lds + E1_FLAGS);
    if (KIND != 1) { if (tid < 8) flags[tid] = 0u; }
    __syncthreads();
    E1_LOAD(KIND != 1 ? j1 : j0);
    for (int it = 0; it < ntile; ++it) {
        const int j = (KIND != 1) ? (j1 - it) : (j0 + it);
        LAS unsigned char* buf = lds + (it & 1) * E1_BUF;
        E1_WRITE(buf);
        __syncthreads();
        if (KIND != 1) { unsigned alld = 1u;
#pragma unroll
            for (int i = 0; i < 8; ++i) alld &= flags[i];
            if (alld) break; }
        if (it + 1 < ntile) E1_LOAD((KIND != 1) ? (j - 1) : (j + 1));
        if (!(KIND != 1 && wave_done)) {
            f32x16 p0, p1;
#pragma unroll
            for (int r = 0; r < 16; ++r) { p0[r] = 0.f; p1[r] = 0.f; }
            { const LAS unsigned char* kp_ = buf + E1_K + r32 * KROW + hh * 16;
#pragma unroll
              for (int d0 = 0; d0 < 4; ++d0) { const bf16x8 a0 = *(const LAS bf16x8*)(kp_ + d0 * 32), a1 = *(const LAS bf16x8*)(kp_ + 32 * KROW + d0 * 32);
                  p0 = __builtin_amdgcn_mfma_f32_32x32x16_bf16(a0, qf[d0], p0, 0, 0, 0); p1 = __builtin_amdgcn_mfma_f32_32x32x16_bf16(a1, qf[d0], p1, 0, 0, 0); } }
            const int kb = j * 64 + 4 * hh;
            if (KIND == 2) {
                float lk0[16], lk1[16], gs[8];
#pragma unroll
                for (int reg = 0; reg < 16; ++reg) { const int kpos = kb + CROW(reg, 0);
                    const float z0 = p0[reg] * (SCALE * LOG2E), z1 = p1[reg] * (SCALE * LOG2E); const bool v0 = kpos < tq, v1 = kpos + 32 < tq;
                    const float lb0 = fminf(z0, 0.f) - __builtin_amdgcn_logf(1.f + __builtin_amdgcn_exp2f(-fabsf(z0))), lb1 = fminf(z1, 0.f) - __builtin_amdgcn_logf(1.f + __builtin_amdgcn_exp2f(-fabsf(z1)));
                    lk0[reg] = v0 ? (lb0 - z0) : 0.f; lk1[reg] = v1 ? (lb1 - z1) : 0.f;
                    p0[reg] = v0 ? lb0 : -INFINITY; p1[reg] = v1 ? lb1 : -INFINITY; }
#pragma unroll
                for (int g4 = 0; g4 < 4; ++g4) { gs[g4] = (lk0[4 * g4] + lk0[4 * g4 + 1]) + (lk0[4 * g4 + 2] + lk0[4 * g4 + 3]); gs[4 + g4] = (lk1[4 * g4] + lk1[4 * g4 + 1]) + (lk1[4 * g4 + 2] + lk1[4 * g4 + 3]); }
                float oth[8];
#pragma unroll
                for (int gi = 0; gi < 8; ++gi) oth[gi] = lane32_other(gs[gi], hh);
                float run = 0.f;
#pragma unroll
                for (int gi = 7; gi >= 0; --gi) {
                    float later = carry + run + (hh == 0 ? oth[gi] : 0.f);
#pragma unroll
                    for (int e = 3; e >= 0; --e) { const int reg = (gi & 3) * 4 + e;
                        if (gi >> 2) { p1[reg] = __builtin_amdgcn_exp2f(p1[reg] + later); later += lk1[reg]; } else { p0[reg] = __builtin_amdgcn_exp2f(p0[reg] + later); later += lk0[reg]; } }
                    run += gs[gi] + oth[gi]; }
                carry += run;
            } else {
                if (KIND == 0) {
                    const LAS float* cs = (const LAS float*)(buf + E1_C) + 4 * hh; const float ctm = ct2 - m;
#pragma unroll
                    for (int i = 0; i < 4; ++i) { const f32x4 c0 = *(const LAS f32x4*)(cs + 8 * i), c1 = *(const LAS f32x4*)(cs + 32 + 8 * i);
#pragma unroll
                        for (int e = 0; e < 4; ++e) { const int reg = 4 * i + e; p0[reg] = p0[reg] * (SCALE * LOG2E) + (ctm - c0[e]); p1[reg] = p1[reg] * (SCALE * LOG2E) + (ctm - c1[e]); } }
                    if (!(j * 64 + 63 <= qrow0)) {
#pragma unroll
                        for (int reg = 0; reg < 16; ++reg) { const int kpos = kb + CROW(reg, 0); p0[reg] = (kpos <= tq) ? p0[reg] : -INFINITY; p1[reg] = (kpos + 32 <= tq) ? p1[reg] : -INFINITY; } }
                } else {
                    { const float r_ = sl2 * ((float)(j * 64) - tqf) - m; const float rh_ = bf2f((unsigned short)f2bf(r_)), rm2_ = bf2f((unsigned short)f2bf(r_ - rh_)), rl_ = (r_ - rh_) - rm2_;
                      u32x4 qx_ = {0u, 0u, 0u, 0u}; if (hh == 0) qx_ = (u32x4){cvtpk(sl2h, sl2l), cvtpk(rh_, rm2_), cvtpk(rl_, 0.f), 0u};
                      const bf16x8 qx = __builtin_bit_cast(bf16x8, qx_);
                      p0 = __builtin_amdgcn_mfma_f32_32x32x16_bf16(kx0, qx, p0, 0, 0, 0); p1 = __builtin_amdgcn_mfma_f32_32x32x16_bf16(kx1, qx, p1, 0, 0, 0); }
                    if (!(j * 64 + 63 <= qrow0 && qrow0 + 31 - j * 64 < 512)) {
#pragma unroll
                        for (int reg = 0; reg < 16; ++reg) { const int kpos = kb + CROW(reg, 0);
                            p0[reg] = (kpos <= tq && tq - kpos < 512) ? p0[reg] : -INFINITY; p1[reg] = (kpos + 32 <= tq && tq - kpos - 32 < 512) ? p1[reg] : -INFINITY; } }
                }
                SM_CORE(p0, p1, m, l, have, o0, o1);
            }
            { const int gq_ = lane >> 4, li_ = lane & 15;
              const LAS unsigned char* tb = buf + E1_V + (4 * hh + (li_ >> 2)) * KROW + (16 * (gq_ & 1) + 4 * (li_ & 3)) * 2;
#pragma unroll
              for (int s = 0; s < 4; ++s) {
                  u32x4 pw;
                  if (s < 2) { pw.x = cvtpk(p0[8 * s + 0], p0[8 * s + 1]); pw.y = cvtpk(p0[8 * s + 2], p0[8 * s + 3]); pw.z = cvtpk(p0[8 * s + 4], p0[8 * s + 5]); pw.w = cvtpk(p0[8 * s + 6], p0[8 * s + 7]); }
                  else { const int s2 = s - 2; pw.x = cvtpk(p1[8 * s2 + 0], p1[8 * s2 + 1]); pw.y = cvtpk(p1[8 * s2 + 2], p1[8 * s2 + 3]); pw.z = cvtpk(p1[8 * s2 + 4], p1[8 * s2 + 5]); pw.w = cvtpk(p1[8 * s2 + 6], p1[8 * s2 + 7]); }
                  const bf16x8 pb = __builtin_bit_cast(bf16x8, pw);
                  const v4i16_t a0l = __builtin_amdgcn_ds_read_tr16_b64_v4i16((LAS v4i16_t*)(tb + (16 * s) * KROW)), a0h = __builtin_amdgcn_ds_read_tr16_b64_v4i16((LAS v4i16_t*)(tb + (16 * s + 8) * KROW));
                  const v4i16_t a1l = __builtin_amdgcn_ds_read_tr16_b64_v4i16((LAS v4i16_t*)(tb + (16 * s) * KROW + 64)), a1h = __builtin_amdgcn_ds_read_tr16_b64_v4i16((LAS v4i16_t*)(tb + (16 * s + 8) * KROW + 64));
                  const bf16x8 va0 = (bf16x8){a0l[0], a0l[1], a0l[2], a0l[3], a0h[0], a0h[1], a0h[2], a0h[3]}, va1 = (bf16x8){a1l[0], a1l[1], a1l[2], a1l[3], a1h[0], a1h[1], a1h[2], a1h[3]};
                  o0 = __builtin_amdgcn_mfma_f32_32x32x16_bf16(va0, pb, o0, 0, 0, 0); o1 = __builtin_amdgcn_mfma_f32_32x32x16_bf16(va1, pb, o1, 0, 0, 0); } }
            if (KIND == 0) {
                const float c0 = *(const LAS float*)(buf + E1_C); const bool dn = __all(have && (qkb + (ct2 - c0) - m < -150.f));
                if (dn && !wave_done) { wave_done = true; if (lane == 0) flags[w] = 1u; } }
            if (KIND == 2) { const bool dn = __all(carry < -110.f * LOG2E);
                if (dn && !wave_done) { wave_done = true; if (lane == 0) flags[w] = 1u; } }
        }
    }
    float inv = 1.f, gate = 1.f;
    if (KIND != 2) { l += __shfl_xor(l, 32); inv = (l > 0.f) ? 1.f / l : 0.f; }
    bf16_t* orow;
    if (KIND == 0) orow = obase + (size_t)(b * S_ + tq) * D_ + 512 + h * 64;
    else if (KIND == 2) orow = obase + (size_t)(b * S_ + tq) * D_ + 768 + h * 64;
    else { orow = owin + (size_t)(b * S_ + tq) * 512 + h * 64; gate = WSP(float, O_GF)[(size_t)(b * S_ + tq) * 32 + 2 * 8 + h]; }
    const float sc = inv * gate;
#pragma unroll
    for (int i = 0; i < 4; ++i) {
        *(u32x2*)(orow + 8 * i + 4 * hh) = (u32x2){cvtpk(o0[4 * i] * sc, o0[4 * i + 1] * sc), cvtpk(o0[4 * i + 2] * sc, o0[4 * i + 3] * sc)};
        *(u32x2*)(orow + 32 + 8 * i + 4 * hh) = (u32x2){cvtpk(o1[4 * i] * sc, o1[4 * i + 1] * sc), cvtpk(o1[4 * i + 2] * sc, o1[4 * i + 3] * sc)}; }
#undef E1_LOAD
#undef E1_WRITE
}
}
namespace mk {
constexpr int E2_VT = 64 * 128;
constexpr int E2_WAVE = 2 * E2_VT + 512 + 128;
template <bool USE_MASK>
__device__ __forceinline__ void e2_wave_unit(LAS unsigned char* ldsw, KP p, int b, int g, int t0, bf16_t* __restrict__ obase, const bf16_t* __restrict__ csrc, int cpitch) {
    const int lane = ftid() & 63, r32 = lane & 31, hh = lane >> 5, qi = r32 >> 2, r4 = r32 & 3;
    const int h = 4 * g + r4, tq = t0 + qi;
    const bf16_t* projb = WSP(bf16_t, O_PROJB);
    const bf16_t* kbase = projb + (size_t)(b * S_) * PB + C_KV + ((1 * 2 + 0) * 2 + g) * 64;
    const bf16_t* vbase = projb + (size_t)(b * S_) * PB + C_KV + ((1 * 2 + 1) * 2 + g) * 64;
    bf16x8 qf[4];
    { const bf16_t* qptr = projb + (size_t)(b * S_ + tq) * PB + h * 64 + 8 * hh;
#pragma unroll
      for (int d0 = 0; d0 < 4; ++d0) qf[d0] = *(const bf16x8*)(qptr + 16 * d0); }
    unsigned qm0 = 0u, qm1 = 0u, qm2 = 0u, qm3 = 0u;
    if (USE_MASK) { const u32x4 mw = *(const u32x4*)(WSP(unsigned, O_SELMASK) + ((size_t)((b * 2 + g) * S_ + t0 + (lane >> 3))) * 4); qm0 = mw.x; qm1 = mw.y; qm2 = mw.z; qm3 = mw.w; }
    else { const int* sp = WSP(int, O_SEL) + ((size_t)((b * 2 + g) * S_ + t0)) * NSEL + lane * 2;
      const int e0 = sp[0], e1 = sp[1];
#pragma unroll
      for (int k = 0; k < 2; ++k) { const int e = k ? e1 : e0; const unsigned bit = 1u << (e & 31); const int wd = e >> 5;
          qm0 |= (wd == 0) ? bit : 0u; qm1 |= (wd == 1) ? bit : 0u; qm2 |= (wd == 2) ? bit : 0u; qm3 |= (wd == 3) ? bit : 0u; }
#pragma unroll
      for (int o = 1; o < 8; o <<= 1) { qm0 |= __shfl_xor(qm0, o); qm1 |= __shfl_xor(qm1, o); qm2 |= __shfl_xor(qm2, o); qm3 |= __shfl_xor(qm3, o); } }
    unsigned um0 = qm0, um1 = qm1, um2 = qm2, um3 = qm3;
#pragma unroll
    for (int o = 8; o < 64; o <<= 1) { um0 |= __shfl_xor(um0, o); um1 |= __shfl_xor(um1, o); um2 |= __shfl_xor(um2, o); um3 |= __shfl_xor(um3, o); }
    LAS int* list = (LAS int*)(ldsw + 2 * E2_VT);
    LAS unsigned* rowml = (LAS unsigned*)(ldsw + 2 * E2_VT + 512);
    if ((lane & 7) == 0) *(LAS u32x4*)(rowml + (lane >> 3) * 4) = (u32x4){qm0, qm1, qm2, qm3};
    const LAS unsigned* rowm = rowml + qi * 4;
    int nblk;
    const int curq = __builtin_amdgcn_readfirstlane(t0 >> 6);
    bool diag;
    { const bool s0 = ((((lane < 32) ? um0 : um1) >> (lane & 31)) & 1u) && lane <= curq, s1 = ((((lane < 32) ? um2 : um3) >> (lane & 31)) & 1u) && lane + 64 <= curq;
      const unsigned long long b0 = __ballot(s0), b1 = __ballot(s1);
      const unsigned long long lower = (lane == 0) ? 0ull : (~0ull >> (64 - lane));
      const int n0 = __popcll(b0);
      if (s0) list[__popcll(b0 & lower)] = lane;
      if (s1) list[n0 + __popcll(b1 & lower)] = lane + 64;
      nblk = n0 + __popcll(b1); diag = (((curq < 64) ? (b0 >> curq) : (b1 >> (curq - 64))) & 1ull) != 0ull; }
    const int nfull = nblk - (diag ? 1 : 0);
    asm volatile("s_waitcnt lgkmcnt(0)" ::: "memory");
    const float sl2 = exp2f(-(float)(h + 1)) * LOG2E, tqf = (float)tq;
    f32x16 o0, o1;
#pragma unroll
    for (int r = 0; r < 16; ++r) { o0[r] = 0.f; o1[r] = 0.f; }
    float m = 0.f, l = 0.f; bool have = false;
    const int vrow = lane >> 3, vch = lane & 7;
    const int gq = lane >> 4, li = lane & 15;
    const LAS unsigned char* trb = ldsw + (4 * hh + (li >> 2)) * 128 + (16 * (gq & 1) + 4 * (li & 3)) * 2;
    bf16x8 ka0[4], ka1[4], kb0[4], kb1[4];
#define E2_LOADK(blk, k0_, k1_) do { const bf16_t* kp_ = kbase + (size_t)((blk) * 64 + r32) * PB + 8 * hh; \
        _Pragma("unroll") for (int d0 = 0; d0 < 4; ++d0) { k0_[d0] = *(const bf16x8*)(kp_ + 16 * d0); k1_[d0] = *(const bf16x8*)(kp_ + (size_t)32 * PB + 16 * d0); } } while (0)
#define E2_VDMA(blk, vb_) do { const bf16_t* vp_ = vbase + (size_t)((blk) * 64 + vrow) * PB + vch * 8; \
        _Pragma("unroll") for (int i = 0; i < 8; ++i) __builtin_amdgcn_global_load_lds((const unsigned*)(vp_ + (size_t)(8 * i) * PB), (LAS unsigned*)((vb_) + i * 1024), 16, 0, 0); } while (0)
    { const int b0_ = __builtin_amdgcn_readfirstlane(list[0]);
      E2_VDMA(b0_, ldsw); E2_LOADK(b0_, ka0, ka1);
      { const int b1_ = __builtin_amdgcn_readfirstlane(list[(nblk > 1) ? 1 : 0]); E2_LOADK(b1_, kb0, kb1); } }
    int it = 0;
    auto body = [&](auto mtag_, auto ptag_) __attribute__((always_inline)) {
        constexpr bool MASKED_ = decltype(mtag_)::value; constexpr bool PAR_ = decltype(ptag_)::value;
        const int cur = __builtin_amdgcn_readfirstlane(list[it]);
        const unsigned rw = rowm[cur >> 5];
        LAS unsigned char* vcur = ldsw + (PAR_ ? E2_VT : 0); LAS unsigned char* voth = ldsw + (PAR_ ? 0 : E2_VT);
        { const int nb_ = __builtin_amdgcn_readfirstlane(list[(it + 1 < nblk) ? it + 1 : nblk - 1]); E2_VDMA(nb_, voth); }
        const int nb2_ = __builtin_amdgcn_readfirstlane(list[(it + 2 < nblk) ? it + 2 : nblk - 1]);
        f32x16 p0, p1;
#pragma unroll
        for (int r = 0; r < 16; ++r) { p0[r] = 0.f; p1[r] = 0.f; }
        if (PAR_) {
#pragma unroll
            for (int d0 = 0; d0 < 4; ++d0) { p0 = __builtin_amdgcn_mfma_f32_32x32x16_bf16(kb0[d0], qf[d0], p0, 0, 0, 0); p1 = __builtin_amdgcn_mfma_f32_32x32x16_bf16(kb1[d0], qf[d0], p1, 0, 0, 0); }
            asm volatile("" : "+v"(p0), "+v"(p1) :: "memory");
            E2_LOADK(nb2_, kb0, kb1);
        } else {
#pragma unroll
            for (int d0 = 0; d0 < 4; ++d0) { p0 = __builtin_amdgcn_mfma_f32_32x32x16_bf16(ka0[d0], qf[d0], p0, 0, 0, 0); p1 = __builtin_amdgcn_mfma_f32_32x32x16_bf16(ka1[d0], qf[d0], p1, 0, 0, 0); }
            asm volatile("" : "+v"(p0), "+v"(p1) :: "memory");
            E2_LOADK(nb2_, ka0, ka1);
        }
        const bool rowsel = (rw >> (cur & 31)) & 1u;
        const int kb = cur * 64 + 4 * hh;
        { const float basef = rowsel ? (sl2 * ((float)kb - tqf) - m) : -INFINITY, base1 = basef + 32.f * sl2;
#pragma unroll
          for (int reg = 0; reg < 16; ++reg) { p0[reg] = p0[reg] * (SCALE * LOG2E) + __builtin_fmaf(sl2, (float)CROW(reg, 0), basef); p1[reg] = p1[reg] * (SCALE * LOG2E) + __builtin_fmaf(sl2, (float)CROW(reg, 0), base1); } }
        if (MASKED_) {
#pragma unroll
            for (int reg = 0; reg < 16; ++reg) { const int kpos = kb + CROW(reg, 0); p0[reg] = (kpos <= tq) ? p0[reg] : -INFINITY; p1[reg] = (kpos + 32 <= tq) ? p1[reg] : -INFINITY; } }
        SM_CORE(p0, p1, m, l, have, o0, o1);
        asm volatile("s_waitcnt vmcnt(16)" ::: "memory");
        const LAS unsigned char* trv = trb + (PAR_ ? E2_VT : 0);
#pragma unroll
        for (int s = 0; s < 4; ++s) {
            u32x4 pw;
            if (s < 2) { pw.x = cvtpk(p0[8 * s + 0], p0[8 * s + 1]); pw.y = cvtpk(p0[8 * s + 2], p0[8 * s + 3]); pw.z = cvtpk(p0[8 * s + 4], p0[8 * s + 5]); pw.w = cvtpk(p0[8 * s + 6], p0[8 * s + 7]); }
            else { const int s2 = s - 2; pw.x = cvtpk(p1[8 * s2 + 0], p1[8 * s2 + 1]); pw.y = cvtpk(p1[8 * s2 + 2], p1[8 * s2 + 3]); pw.z = cvtpk(p1[8 * s2 + 4], p1[8 * s2 + 5]); pw.w = cvtpk(p1[8 * s2 + 6], p1[8 * s2 + 7]); }
            const bf16x8 pb = __builtin_bit_cast(bf16x8, pw);
            const v4i16_t a0l = __builtin_amdgcn_ds_read_tr16_b64_v4i16((LAS v4i16_t*)(trv + (16 * s) * 128)), a0h = __builtin_amdgcn_ds_read_tr16_b64_v4i16((LAS v4i16_t*)(trv + (16 * s + 8) * 128));
            const v4i16_t a1l = __builtin_amdgcn_ds_read_tr16_b64_v4i16((LAS v4i16_t*)(trv + (16 * s) * 128 + 64)), a1h = __builtin_amdgcn_ds_read_tr16_b64_v4i16((LAS v4i16_t*)(trv + (16 * s + 8) * 128 + 64));
            const bf16x8 va0 = (bf16x8){a0l[0], a0l[1], a0l[2], a0l[3], a0h[0], a0h[1], a0h[2], a0h[3]}, va1 = (bf16x8){a1l[0], a1l[1], a1l[2], a1l[3], a1h[0], a1h[1], a1h[2], a1h[3]};
            o0 = __builtin_amdgcn_mfma_f32_32x32x16_bf16(va0, pb, o0, 0, 0, 0); o1 = __builtin_amdgcn_mfma_f32_32x32x16_bf16(va1, pb, o1, 0, 0, 0); }
        asm volatile("" ::: "memory");
    };
    for (; it + 1 < nfull; it += 2) { body(std::false_type{}, std::false_type{}); ++it; body(std::false_type{}, std::true_type{}); --it; }
    if (it < nfull) { body(std::false_type{}, std::false_type{}); ++it; if (diag) body(std::true_type{}, std::true_type{}); }
    else if (diag) body(std::true_type{}, std::false_type{});
    asm volatile("s_waitcnt vmcnt(0)" ::: "memory");
#undef E2_LOADK
#undef E2_VDMA
    l += __shfl_xor(l, 32);
    const float sc = ((l > 0.f) ? 1.f / l : 0.f) * WSP(float, O_GF)[(size_t)(b * S_ + tq) * 32 + 1 * 8 + h];
    bf16_t* orow = obase + (size_t)(b * S_ + tq) * D_ + h * 64; const bf16_t* crow = csrc + (size_t)(b * S_ + tq) * cpitch + h * 64;
#pragma unroll
    for (int i = 0; i < 4; ++i) {
        const u32x2 c0 = *(const u32x2*)(crow + 8 * i + 4 * hh), c1 = *(const u32x2*)(crow + 32 + 8 * i + 4 * hh);
        const float x00 = __uint_as_float(c0.x << 16) + o0[4 * i] * sc, x01 = __uint_as_float(c0.x & 0xffff0000u) + o0[4 * i + 1] * sc, x02 = __uint_as_float(c0.y << 16) + o0[4 * i + 2] * sc, x03 = __uint_as_float(c0.y & 0xffff0000u) + o0[4 * i + 3] * sc;
        const float x10 = __uint_as_float(c1.x << 16) + o1[4 * i] * sc, x11 = __uint_as_float(c1.x & 0xffff0000u) + o1[4 * i + 1] * sc, x12 = __uint_as_float(c1.y << 16) + o1[4 * i + 2] * sc, x13 = __uint_as_float(c1.y & 0xffff0000u) + o1[4 * i + 3] * sc;
        *(u32x2*)(orow + 8 * i + 4 * hh) = (u32x2){cvtpk(x00, x01), cvtpk(x02, x03)}; *(u32x2*)(orow + 32 + 8 * i + 4 * hh) = (u32x2){cvtpk(x10, x11), cvtpk(x12, x13)}; }
}
template <bool USE_MASK>
__device__ __forceinline__ void ph_attn_sel2(LAS unsigned char* lds3, KP p, bf16_t* __restrict__ obase, const bf16_t* __restrict__ csrc, int cpitch) {
    const int w = __builtin_amdgcn_readfirstlane(ftid() >> 6);
    LAS unsigned char* ldsw = lds3 + w * E2_WAVE;
    MK_LOOP(u, 512) { const int bg = u & 3, qblk = u >> 2; e2_wave_unit<USE_MASK>(ldsw, p, bg >> 1, bg & 1, qblk * 64 + 8 * w, obase, csrc, cpitch); }
}
}
namespace mk {
constexpr int E3_K = 0, E3_V = 512 * KROW, E3_BYTES = 2 * 512 * KROW;
__device__ __forceinline__ void e3_unit(LAS unsigned char* lds, KP p, int b, int g, int qb, bf16_t* __restrict__ ocmp, unsigned* __restrict__ selmask) {
    const int tid = ftid(), lane = tid & 63, w = __builtin_amdgcn_readfirstlane(tid >> 6), r32 = lane & 31, hh = lane >> 5;
    const int bg = b * 2 + g, q0 = qb * 256, qrow0 = q0 + 32 * w, tq = qrow0 + r32;
    const bf16_t* projb = WSP(bf16_t, O_PROJB);
    int nun = (q0 + 255 - 31) / 16 + 1; if (nun > 511) nun = 511;
    const int ntile_u = (nun + 63) >> 6;
    __syncthreads();
    { const int srow = tid >> 3, sch = tid & 7; const bf16_t* ks = WSP(bf16_t, O_KCMPB) + ((size_t)bg * 512 + srow) * 64 + sch * 8; const bf16_t* vs = WSP(bf16_t, O_VCMPB) + ((size_t)bg * 512 + srow) * 64 + sch * 8;
      for (int i = 0; i < ntile_u; ++i) { const u32x4 kv = *(const u32x4*)(ks + (size_t)i * 64 * 64), vv = *(const u32x4*)(vs + (size_t)i * 64 * 64);
          *(LAS u32x4*)(lds + E3_K + (srow + 64 * i) * KROW + sch * 16) = kv; *(LAS u32x4*)(lds + E3_V + (srow + 64 * i) * KROW + sch * 16) = vv; } }
    __syncthreads();
    int nw = qrow0 / 16 + 1; if (nw > 511) nw = 511;
    const int ntile_w = (qrow0 + 31 < 31) ? 0 : ((nw + 63) >> 6);
    const float tqf = (float)tq;
    const int gq = lane >> 4, li = lane & 15;
    const LAS unsigned char* trb = lds + E3_V + (4 * hh + (li >> 2)) * KROW + (16 * (gq & 1) + 4 * (li & 3)) * 2;
    const LAS unsigned char* kfb = lds + E3_K + r32 * KROW + hh * 16;
    float imp[64];
#pragma unroll
    for (int i = 0; i < 64; ++i) imp[i] = 0.f;
#pragma unroll 1
    for (int r4 = 0; r4 < 4; ++r4) {
        const int h = 4 * g + r4; const float sl2 = exp2f(-(float)(h + 1)) * LOG2E;
        const unsigned qoff = (unsigned)((b * S_ + tq) * PB + h * 64 + 8 * hh);
        f32x16 o0, o1;
#pragma unroll
        for (int r = 0; r < 16; ++r) { o0[r] = 0.f; o1[r] = 0.f; }
        float m = 0.f, l = 0.f; bool have = false;
#define E3_ST(jt) f32x16 p0, p1; { bf16x8 qf[4]; _Pragma("unroll") for (int d0 = 0; d0 < 4; ++d0) qf[d0] = *(const bf16x8*)(projb + qoff + 16 * d0); \
            _Pragma("unroll") for (int r = 0; r < 16; ++r) { p0[r] = 0.f; p1[r] = 0.f; } \
            _Pragma("unroll") for (int d0 = 0; d0 < 4; ++d0) { const bf16x8 a0 = *(const LAS bf16x8*)(kfb + (64 * (jt)) * KROW + d0 * 32), a1 = *(const LAS bf16x8*)(kfb + (64 * (jt) + 32) * KROW + d0 * 32); \
                p0 = __builtin_amdgcn_mfma_f32_32x32x16_bf16(a0, qf[d0], p0, 0, 0, 0); p1 = __builtin_amdgcn_mfma_f32_32x32x16_bf16(a1, qf[d0], p1, 0, 0, 0); } \
            int tq_ = tq; asm volatile("" : "+v"(tq_));     \
            int hh_ = hh; asm volatile("" : "+v"(hh_)); \
            const float tqf_ = (float)tq_; const int ce0_ = 16 * (64 * (jt) + 4 * hh_) + 31; \
            const float basef_ = sl2 * ((float)ce0_ - tqf_) - m, base1_ = basef_ + 512.f * sl2; \
            _Pragma("unroll") for (int reg = 0; reg < 16; ++reg) { const float cr_ = sl2 * (float)(16 * CROW(reg, 0)); p0[reg] = p0[reg] * (SCALE * LOG2E) + (basef_ + cr_); p1[reg] = p1[reg] * (SCALE * LOG2E) + (base1_ + cr_); } \
            if (ce0_ + 16 * 27 + 512 > qrow0) {     \
                _Pragma("unroll") for (int reg = 0; reg < 16; ++reg) { const int ce = ce0_ + 16 * CROW(reg, 0); p0[reg] = (ce <= tq_) ? p0[reg] : -INFINITY; p1[reg] = (ce + 512 <= tq_) ? p1[reg] : -INFINITY; } } }
        float imh[64];
#pragma unroll
        for (int i = 0; i < 64; ++i) imh[i] = 0.f;
#pragma unroll
        for (int jt = 0; jt < 8; ++jt) {
            if (jt < ntile_w) {
                E3_ST(jt);
                {
                    float rm_; SM_ROWMAX(p0, p1, rm_);
                    const bool fin_ = rm_ > -1e37f;
                    if (__any((rm_ > RESC_THR) || (!have && fin_))) {
                        const float dl_ = have ? fmaxf(rm_, 0.f) : (fin_ ? rm_ : 0.f); const float al_ = have ? __builtin_amdgcn_exp2f(-dl_) : 1.f;
                        m += dl_; l *= al_; have = have || fin_;
#pragma unroll
                        for (int r_ = 0; r_ < 16; ++r_) { o0[r_] *= al_; o1[r_] *= al_; p0[r_] -= dl_; p1[r_] -= dl_; }
#pragma unroll
                        for (int i = 0; i < 64; ++i) imh[i] *= al_; }
                    float ls_ = 0.f;
#pragma unroll
                    for (int reg_ = 0; reg_ < 16; ++reg_) { p0[reg_] = __builtin_amdgcn_exp2f(p0[reg_]); p1[reg_] = __builtin_amdgcn_exp2f(p1[reg_]); ls_ += p0[reg_] + p1[reg_]; }
                    l += ls_; }
#pragma unroll
                for (int pa = 0; pa < 2; ++pa)
#pragma unroll
                    for (int i = 0; i < 4; ++i) { const int jj = 8 * jt + 4 * pa + i;
                        const float x0 = pa ? p1[4 * i] : p0[4 * i], x1 = pa ? p1[4 * i + 1] : p0[4 * i + 1], x2 = pa ? p1[4 * i + 2] : p0[4 * i + 2], x3 = pa ? p1[4 * i + 3] : p0[4 * i + 3];
                        const float c = 0.5f * x3, a = (x0 + x1) + (x2 + c), r = lane32_other(c, hh);
                        imh[jj] += a + (hh ? r : 0.f);
                        if (jj + 1 < 64) imh[jj + 1] += (hh ? 0.f : r); }
                const LAS unsigned char* tb = trb + (64 * jt) * KROW;
#pragma unroll
                for (int s = 0; s < 4; ++s) {
                    u32x4 pw;
                    if (s < 2) { pw.x = cvtpk(p0[8 * s + 0], p0[8 * s + 1]); pw.y = cvtpk(p0[8 * s + 2], p0[8 * s + 3]); pw.z = cvtpk(p0[8 * s + 4], p0[8 * s + 5]); pw.w = cvtpk(p0[8 * s + 6], p0[8 * s + 7]); }
                    else { const int s2 = s - 2; pw.x = cvtpk(p1[8 * s2 + 0], p1[8 * s2 + 1]); pw.y = cvtpk(p1[8 * s2 + 2], p1[8 * s2 + 3]); pw.z = cvtpk(p1[8 * s2 + 4], p1[8 * s2 + 5]); pw.w = cvtpk(p1[8 * s2 + 6], p1[8 * s2 + 7]); }
                    const bf16x8 pb = __builtin_bit_cast(bf16x8, pw);
                    const v4i16_t a0l = __builtin_amdgcn_ds_read_tr16_b64_v4i16((LAS v4i16_t*)(tb + (16 * s) * KROW)), a0h = __builtin_amdgcn_ds_read_tr16_b64_v4i16((LAS v4i16_t*)(tb + (16 * s + 8) * KROW));
                    const v4i16_t a1l = __builtin_amdgcn_ds_read_tr16_b64_v4i16((LAS v4i16_t*)(tb + (16 * s) * KROW + 64)), a1h = __builtin_amdgcn_ds_read_tr16_b64_v4i16((LAS v4i16_t*)(tb + (16 * s + 8) * KROW + 64));
                    const bf16x8 va0 = (bf16x8){a0l[0], a0l[1], a0l[2], a0l[3], a0h[0], a0h[1], a0h[2], a0h[3]}, va1 = (bf16x8){a1l[0], a1l[1], a1l[2], a1l[3], a1h[0], a1h[1], a1h[2], a1h[3]};
                    o0 = __builtin_amdgcn_mfma_f32_32x32x16_bf16(va0, pb, o0, 0, 0, 0); o1 = __builtin_amdgcn_mfma_f32_32x32x16_bf16(va1, pb, o1, 0, 0, 0); }
            }
        }
        l += __shfl_xor(l, 32);
        const float inv = (l > 0.f) ? 1.f / l : 0.f;
#pragma unroll
        for (int i = 0; i < 64; ++i) imp[i] += imh[i] * inv;
        { const float sc = inv * WSP(float, O_GF)[(size_t)(b * S_ + tq) * 32 + 0 * 8 + h];
          bf16_t* orow = ocmp + (size_t)(b * S_ + tq) * 512 + h * 64;
#pragma unroll
          for (int i = 0; i < 4; ++i) {
              *(u32x2*)(orow + 8 * i + 4 * hh) = (u32x2){cvtpk(o0[4 * i] * sc, o0[4 * i + 1] * sc), cvtpk(o0[4 * i + 2] * sc, o0[4 * i + 3] * sc)};
              *(u32x2*)(orow + 32 + 8 * i + 4 * hh) = (u32x2){cvtpk(o1[4 * i] * sc, o1[4 * i + 1] * sc), cvtpk(o1[4 * i + 2] * sc, o1[4 * i + 3] * sc)}; } }
#undef E3_ST
    }
    const int cur = tq >> 6;
#pragma unroll
    for (int jj = 0; jj < 64; ++jj) { const int j = 2 * jj + hh; imp[jj] = (j != 0 && j < cur - 1) ? imp[jj] : -1.f; }
    unsigned m0 = 1u, m1 = 0u, m2 = 0u, m3 = 0u;
#define E3_SETBIT(j) do { const unsigned bit_ = 1u << ((j) & 31); const int wd_ = (j) >> 5; m0 |= (wd_ == 0) ? bit_ : 0u; m1 |= (wd_ == 1) ? bit_ : 0u; m2 |= (wd_ == 2) ? bit_ : 0u; m3 |= (wd_ == 3) ? bit_ : 0u; } while (0)
    E3_SETBIT(cur); if (cur >= 1) E3_SETBIT(cur - 1);
#pragma unroll 1
    for (int it = 0; it < NSEL - 3; ++it) {
        float best = -0.5f; int bj = 0;
#pragma unroll
        for (int jj = 0; jj < 64; ++jj) { if (imp[jj] > best) { best = imp[jj]; bj = jj; } }
        const int myj = 2 * bj + hh; const float ob = __shfl_xor(best, 32); const int oj = __shfl_xor(myj, 32);
        const bool mine = (best > ob) || (best == ob && myj < oj);
        const float wv = mine ? best : ob; const int wj = mine ? myj : oj;
        if (wv >= 0.f) E3_SETBIT(wj);
        if (mine && best >= 0.f) {
#pragma unroll
            for (int jj = 0; jj < 64; ++jj) imp[jj] = (jj == bj) ? -2.f : imp[jj]; }
    }
#undef E3_SETBIT
    if (hh == 0) *(u32x4*)(selmask + ((size_t)bg * S_ + tq) * 4) = (u32x4){m0, m1, m2, m3};
}
}
namespace mk {
constexpr int SB_EARLY = 216;
template <int MODE>
__device__ __forceinline__ void ph_attn1(float* lds, LAS unsigned char* lds3, KP p, unsigned* qctr, bf16_t* obase, bf16_t* owin, const unsigned* kmax2) {
    LAS int* qslot = (LAS int*)(lds3 + E3_BYTES);
    constexpr int N_E3 = (MODE & 2) ? 128 : 0, N_CMP = (MODE & 1) ? 64 : 0, N_FOX = (MODE & 4) ? 256 : 0, N_WIN = (MODE & 8) ? 512 : 0, N_SB = (MODE & 16) ? (256 - SB_EARLY) : 0;
    for (;;) {
        __syncthreads();
        if (ftid() == 0) *qslot = (int)atomicAdd(qctr, 1u);
        __syncthreads();
        int u = __builtin_amdgcn_readfirstlane(*qslot);
        if (u >= N_E3 + N_CMP + N_FOX + N_WIN + N_SB) break;
        if (u < N_E3) { e3_unit(lds3, p, (u & 3) >> 1, u & 1, 31 - (u >> 2), WSP(bf16_t, O_OCMP), WSP(unsigned, O_SELMASK)); continue; } u -= N_E3;
        if (u < N_FOX) { e1_unit<0>(lds3, p, (u & 7) >> 2, u & 3, 31 - (u >> 3), obase, owin, kmax2); continue; } u -= N_FOX;
        if (u < N_WIN) { e1_unit<1>(lds3, p, (u & 3) >> 1, u & 1, 127 - (u >> 2), obase, owin, kmax2); continue; } u -= N_WIN;
        if (u < N_SB) { u += SB_EARLY; e1_unit<2>(lds3, p, (u & 7) >> 2, u & 3, 31 - (u >> 3), obase, owin, kmax2); }
    }
}
__device__ __forceinline__ void ph_sb_early(LAS unsigned char* lds3, KP p) {
    const int u = fbid() - 40; if (u < 0 || u >= SB_EARLY) return;
    e1_unit<2>(lds3, p, (u & 7) >> 2, u & 3, 31 - (u >> 3), WSP(bf16_t, O_O), WSP(bf16_t, O_OWIN), nullptr);
}
}
namespace mk {
#define RLX_AGENT __ATOMIC_RELAXED, __HIP_MEMORY_SCOPE_AGENT
#define XB_TMO      128
#define XB_XCNT(j)  (256  + 64 * (j))
#define XB_XSUB(j)  (1280 + 64 * (j))
#define XB_XGEN(j)  (2304 + 64 * (j))
#define XB_TOP      3328
#define XB_TOPGEN   3392
#define XCD_BAR_WORDS 3456
#define XB_SPIN_CAP (1u << 18)

__device__ __forceinline__ unsigned xb_ld(unsigned* p)              { return __hip_atomic_load(p, __ATOMIC_RELAXED, __HIP_MEMORY_SCOPE_AGENT); }
__device__ __forceinline__ unsigned xb_add(unsigned* p, unsigned v) { return __hip_atomic_fetch_add(p, v, __ATOMIC_RELAXED, __HIP_MEMORY_SCOPE_AGENT); }
__device__ __forceinline__ unsigned xb_xcc_id() { return (unsigned)__builtin_amdgcn_s_getreg((3 << 11) | 20) & 0xFu; }
#define XB_SPIN(cond, bar) do { unsigned _sp = 0; while (cond) { __builtin_amdgcn_s_sleep(1); \
    if ((++_sp & 255u) == 0u) { if (xb_ld(&(bar)[XB_TMO])) break; if (_sp > XB_SPIN_CAP) { atomicAdd(&(bar)[XB_TMO], 1u); break; } } } } while (0)

struct XcdBarrier {
    unsigned* bar; unsigned x;
    volatile LAS unsigned* st;
};

__device__ __forceinline__ XcdBarrier xcd_barrier_post(unsigned* bar, volatile LAS unsigned* st) {
    XcdBarrier b; b.bar = bar; b.x = xb_xcc_id(); b.st = st;
    if (threadIdx.x == 0) (void)xb_add(&bar[XB_XCNT(b.x)], 1u);
    return b;
}
__device__ __forceinline__ void xcd_barrier_complete(unsigned* bar, unsigned x, unsigned& nloc, unsigned& nx) {
    const unsigned G = gridDim.x * gridDim.y * gridDim.z;
    unsigned sum, cnt, mine, sp = 0u;
    for (;;) {
        sum = 0u; cnt = 0u; mine = 0u;
#pragma unroll
        for (unsigned j = 0; j < 16; ++j) { const unsigned c = xb_ld(&bar[XB_XCNT(j)]); sum += c; cnt += (c > 0u) ? 1u : 0u; mine = (j == x) ? c : mine; }
        if (sum == G) break;
        __builtin_amdgcn_s_sleep(1);
        if ((++sp & 255u) == 0u) { if (xb_ld(&bar[XB_TMO])) break; if (sp > XB_SPIN_CAP) { atomicAdd(&bar[XB_TMO], 1u); break; } }
    }
    nloc = mine > 0u ? mine : 1u; nx = cnt > 0u ? cnt : 1u;
}

__device__ __forceinline__ void xcd_barrier(const XcdBarrier& b) {
    asm volatile("s_waitcnt vmcnt(0)" ::: "memory");
    __syncthreads();
    if (threadIdx.x == 0) {
        unsigned* bar = b.bar;
        __builtin_amdgcn_s_waitcnt(0);
        unsigned nloc = b.st[0], nx = b.st[1];
        if (nloc == 0u) { xcd_barrier_complete(bar, b.x, nloc, nx); b.st[0] = nloc; b.st[1] = nx; }
        const unsigned old = xb_add(&bar[XB_XSUB(b.x)], 1u);
        const unsigned gen = old / nloc;
        if (old + 1u == (gen + 1u) * nloc) {
            __builtin_amdgcn_fence(__ATOMIC_RELEASE, "agent");
            asm volatile("s_waitcnt vmcnt(0)" ::: "memory");
            const unsigned og = xb_add(&bar[XB_TOP], 1u);
            const unsigned tg = og / nx;
            if (og + 1u == (tg + 1u) * nx) xb_add(&bar[XB_TOPGEN], 1u);
            else XB_SPIN(xb_ld(&bar[XB_TOPGEN]) == tg, bar);
            __builtin_amdgcn_fence(__ATOMIC_ACQUIRE, "agent");
            xb_add(&bar[XB_XGEN(b.x)], 1u);
            asm volatile("s_waitcnt vmcnt(0)" ::: "memory");
        } else {
            XB_SPIN(xb_ld(&bar[XB_XGEN(b.x)]) == gen, bar);
            __builtin_amdgcn_fence(__ATOMIC_ACQUIRE, "agent");
            asm volatile("s_waitcnt vmcnt(0)" ::: "memory");
        }
    }
    __syncthreads();
}

}
namespace cg = cooperative_groups;
constexpr int NSTEP = 12;
#ifndef CVH_GU
#define CVH_GU 1
#define CVH_DN 1
#endif
__global__ void __launch_bounds__(512, 2) mega(mk::P p_unused) {
    extern __shared__ __attribute__((aligned(16))) unsigned char lds_raw[];
    float* lds = (float*)lds_raw;
    LAS unsigned char* lds3 = (LAS unsigned char*)lds_raw;
    using namespace nv; using namespace mk;
    volatile LAS unsigned* bst = (volatile LAS unsigned*)(lds3 + E3_BYTES + 128);
    if (threadIdx.x < 2) bst[threadIdx.x] = 0u;
    __syncthreads();
    XcdBarrier bar;
    { const KP p = fresh_kp(); bar = xcd_barrier_post(WSP(unsigned, O_COUNTS + 16384), bst); }
    cg::this_grid().sync();
    for (int step = 0; step < 1 + NSTEP * L_; ++step) {
        const KP p = fresh_kp();
        const int l = (step - 1) / NSTEP, k = (step == 0) ? -1 : (step - 1) % NSTEP;
        const bool isg = (k == 0 || k == 1 || k == 6 || k == 9 || k == 10);
#ifdef PROBE_K
        const int nrep = (k == PROBE_K) ? PROBE_N : 1;
#else
        const int nrep = 1;
#endif
        for (int rep = 0; rep < nrep; ++rep) {
        int helpchunks = 0;
        if (isg) {
            const int kind = (k == 0) ? 0 : (k == 1) ? 4 : (k == 6) ? 1 : (k == 9) ? 2 : 3;
            GSched S; GEpi E; S.kind = kind; E.kind = kind; E.l = l;
            S.G = (int)gridDim.x; S.c = fbid(); S.meta = WSP(int, O_META); S.rowtok = WSP(int, O_ROWTOK); S.estep = 0;
            const char* A; int N, K = D_;
            if (kind == 0) { A = (const char*)WSP(bf16_t, O_XB); S.Bt = (const char*)(WSP(bf16_t, O_WTIN) + (size_t)l * NPAD * D_); N = NPAD; }
            else if (kind == 1) { A = (const char*)WSP(bf16_t, O_OB); S.Bt = (const char*)(WSP(bf16_t, O_WTOUT) + (size_t)l * D_ * D_); N = D_; }
            else if (kind == 2) { A = (const char*)WSP(bf16_t, O_X1B); S.Bt = (const char*)(WSP(bf16_t, O_WTGU) + (size_t)l * NE * 2048 * D_); S.estep = (size_t)2048 * D_ * 2; N = 2048; }
            else if (kind == 3) { A = (const char*)WSP(bf16_t, O_ACT); S.Bt = (const char*)(WSP(bf16_t, O_WTDN) + (size_t)l * NE * D_ * D_); S.estep = (size_t)D_ * D_ * 2; N = D_; }
            else { A = (const char*)WSP(bf16_t, O_PROJB); S.Bt = (const char*)(WSP(bf16_t, O_WT1) + (size_t)l * 2 * 256 * 2048); S.estep = (size_t)256 * 2048 * 2; N = 256; K = 1024; }
            S.nN = N / 256; S.nM = (kind < 2) ? T_ / 256 : (kind == 4) ? 16 : S.meta[32]; S.nunits = S.nM * S.nN; if (kind == 4) S.nunits = 32;
            pg8::gemm_phase<GEpi, GSched>(lds3, A, K, S, E);
            if (l == 0 && kind >= 2 && kind <= 3 && S.G == 256) {
                const int mine = (S.nunits - S.c + 255) >> 8, most = (S.nunits + 255) >> 8;
                if (mine < most) helpchunks = (kind == 2) ? CVH_GU : CVH_DN; }
            if (kind == 4) { ph_cumsum(lds, p, 32); ph_sb_early(lds3, p); }
            if (kind == 0) ph_bias1_reduce(p, l);
        } else {
            switch (k) {
                case -1: ph_convert(lds3, p); break;
                case 2: ph_prep2(lds, p, l); break;
#ifdef PROBE_AMODE
                case 3: if (rep == 0) ph_attn1<30>(lds, lds3, p, WSP(unsigned, O_COUNTS) + 128 + l * 8 + rep, WSP(bf16_t, O_O), WSP(bf16_t, O_OWIN), WSP(unsigned, O_COUNTS) + 192 + l * 8);
                        else ph_attn1<PROBE_AMODE>(lds, lds3, p, WSP(unsigned, O_COUNTS) + 128 + l * 8 + rep, WSP(bf16_t, O_O), WSP(bf16_t, O_OWIN), WSP(unsigned, O_COUNTS) + 192 + l * 8);
                        break;
#else
                case 3: ph_attn1<30>(lds, lds3, p, WSP(unsigned, O_COUNTS) + 128 + l * 8 + rep, WSP(bf16_t, O_O), WSP(bf16_t, O_OWIN), WSP(unsigned, O_COUNTS) + 192 + l * 8); break;
#endif
                case 4: ph_attn_sel2<true>(lds3, p, WSP(bf16_t, O_O), WSP(bf16_t, O_OCMP), 512); break;
                case 5: ph_rmsnorm(p, l); break;
                case 7: ph_ln<true>(lds, p, l, WSP(float, O_X1), (rep + 1 < nrep) ? 2048 * (rep + 1) : 0); break;
                case 8: ph_moe_scatter2(lds, p, l); break;
                default: { if (l == 0) helpchunks = 1 << 20;
                           float* xout = (l == L_ - 1) ? p->out : WSP(float, O_XA); ph_ln<false>(lds, p, l, xout); } break;
            }
        }
        if (helpchunks > 0) cv_help(lds3, fresh_kp(), helpchunks);
        xcd_barrier(bar);
        }
    }
#ifdef PROBE_SYNC
    for (int i = 0; i < PROBE_SYNC; ++i) xcd_barrier(bar);
#endif
}

extern "C" void kernel_launch(void* const* d_in, const int* in_sizes, int n_in,
                              void* d_out, int out_size, void* d_ws, size_t ws_size,
                              hipStream_t stream) {
    constexpr size_t kDynLds = 147456 + 1024;
    static int grid_blocks = 0;
    if (!grid_blocks) {
        int dev = 0, cus = 0, per_cu = 0;
        (void)hipGetDevice(&dev);
        (void)hipDeviceGetAttribute(&cus, hipDeviceAttributeMultiprocessorCount, dev);
        (void)hipFuncSetAttribute((const void*)mega, hipFuncAttributeMaxDynamicSharedMemorySize, (int)kDynLds);
        (void)hipOccupancyMaxActiveBlocksPerMultiprocessor(&per_cu, mega, 512, kDynLds);
        if (per_cu < 1) per_cu = 1;
        if (per_cu > 1) per_cu = 1;
        grid_blocks = cus * per_cu;
        if (ws_size < mk::O_END) fprintf(stderr, "workspace too small: %zu < %zu\n", ws_size, (size_t)mk::O_END);
        if (grid_blocks != 256) fprintf(stderr, "this kernel's static work split is built for 256 workgroups (MI355X: 256 CUs); got %d\n", grid_blocks);
    }
    mk::P p{};
    p.in = nv::inputs(d_in); p.ws = (unsigned char*)d_ws; p.out = (float*)d_out;
    (void)hipMemsetAsync((char*)d_ws + mk::O_COUNTS, 0, 65536, stream);
    void* args[] = {&p};
    hipError_t e = hipLaunchCooperativeKernel((void*)mega, dim3(grid_blocks), dim3(512), args, kDynLds, stream);
    if (e != hipSuccess) fprintf(stderr, "cooperative launch failed: %s (grid %d)\n", hipGetErrorString(e), grid_blocks);
}
```

```cpp
#include <hip/hip_runtime.h>
#include <hip/hip_cooperative_groups.h>
#include <cstdio>
#include <cstdint>

namespace nv {

constexpr int B_ = 2, S_ = 8192, D_ = 1024, T_ = B_ * S_, L_ = 2;
constexpr int DIN = 2844;
constexpr int OFF_NSA_KV = 512, OFF_NSA_GATE = 1280, OFF_FOX_QKV = 1304, OFF_FOX_F = 2072, OFF_SB_QKV = 2076;
constexpr int NCMP = 511, NBLK = 128, NSEL = 16;
constexpr int NE = 32, TOPK = 4, MROWS = T_ * TOPK;
constexpr float LN_EPS = 1e-5f, RMS_EPS = 1e-6f;
constexpr float ALPHA = 1.4142135623730951f;
constexpr float SCALE = 0.125f;

__device__ __forceinline__ float sigmoidf_(float x) { return __builtin_amdgcn_rcpf(1.f + __builtin_amdgcn_exp2f(-1.4426950408889634f * x)); }
__device__ __forceinline__ float logsig(float x) { return fminf(x, 0.f) - log1pf(expf(-fabsf(x))); }

__device__ __forceinline__ float gelu_tanh(float x) { return 0.5f * x * (1.f + tanhf(0.7978845608028654f * (x + 0.044715f * x * x * x))); }
__device__ __forceinline__ float wsum(float v) {
#pragma unroll
    for (int o = 1; o < 64; o <<= 1) v += __shfl_xor(v, o);
    return v;
}
struct In {
    const float *x, *w_in, *b_in, *pos_k, *pos_v, *w1k, *w2k, *w1v, *w2v, *g_out, *w_out, *ln1_g, *ln1_b, *rw, *rb, *wgu, *bgu, *wdn, *bdn, *ln2_g, *ln2_b;
};
inline In inputs(void* const* d) {
    In i; i.x = (const float*)d[0]; i.w_in = (const float*)d[1]; i.b_in = (const float*)d[2]; i.pos_k = (const float*)d[3]; i.pos_v = (const float*)d[4];
    i.w1k = (const float*)d[5]; i.w2k = (const float*)d[6]; i.w1v = (const float*)d[7]; i.w2v = (const float*)d[8]; i.g_out = (const float*)d[9]; i.w_out = (const float*)d[10];
    i.ln1_g = (const float*)d[11]; i.ln1_b = (const float*)d[12]; i.rw = (const float*)d[13]; i.rb = (const float*)d[14]; i.wgu = (const float*)d[15]; i.bgu = (const float*)d[16];
    i.wdn = (const float*)d[17]; i.bdn = (const float*)d[18]; i.ln2_g = (const float*)d[19]; i.ln2_b = (const float*)d[20]; return i;
}


}
namespace pg8 {
#define PG8_LAS __attribute__((address_space(3)))
typedef unsigned short bf16_t;
typedef short bf16x8 __attribute__((ext_vector_type(8)));
typedef float f32x4 __attribute__((ext_vector_type(4)));
typedef unsigned u32x4 __attribute__((ext_vector_type(4)));
constexpr int BM = 256, BK = 64, HALF = 128, HTB = HALF * BK * 2  , STAGE_BYTES = 8 * HTB, NXCD = 8, WGM = 8;

__host__ __device__ __forceinline__ int lds_byte(int r, int c) { const int st = (r >> 4) * 2 + (c >> 5), rr = r & 15, cc = c & 31, ob = rr * 64 + cc * 2; return st * 1024 + (ob ^ (((ob >> 9) & 1) << 5)); }
__host__ __device__ __forceinline__ void stage_rc(int b, int& R, int& C) { const int st = b / 1024, sb = b % 1024, swz = sb ^ (((sb >> 9) & 1) << 5); R = (st >> 1) * 16 + swz / 64; C = (st & 1) * 32 + (swz % 64) / 2; }
__host__ __device__ __forceinline__ int perm32(int rho) { const int n = rho >> 4, i = rho & 15; return 8 * (i >> 2) + 4 * n + (i & 3); }

struct Unit { int pm, pn, e, nr; };

__device__ __forceinline__ unsigned cvt_pk_bf16(float lo, float hi) { unsigned r; asm volatile("v_cvt_pk_bf16_f32 %0, %1, %2" : "=v"(r) : "v"(lo), "v"(hi)); return r; }
template <class Epi, class Sched, bool ALIGN_EPI = true, bool SP2 = true>
__device__ __forceinline__ void gemm_phase(PG8_LAS unsigned char* lds, const char* Abase, const int K, const Sched& S, const Epi& E) {
    int tid_ = threadIdx.x; asm volatile("" : "+v"(tid_));
    const int tid = tid_, wid = __builtin_amdgcn_readfirstlane(tid >> 6), lane = tid & 63, wr = wid >> 2, wc = wid & 3, fr = lane & 15, fq = lane >> 4;
    const int nt = K / BK;
    unsigned voffB[2];
#pragma unroll
    for (int i = 0; i < 2; ++i) { int R, C; stage_rc(tid * 16 + i * 8192, R, C); const int Rb = Epi::PERM ? ((R & ~31) + perm32(R & 31)) : R;
        voffB[i] = (unsigned)(Rb * K + C) * 2u; }
#define PG8_AOFF(u, o0, o1) do { int _t = tid; asm volatile("" : "+v"(_t)); _Pragma("unroll") for (int _i = 0; _i < 2; ++_i) { int _R, _C; stage_rc(_t * 16 + _i * 8192, _R, _C); \
        (o0)[_i] = S.a_off((u), _R) + (unsigned)_C * 2u; (o1)[_i] = S.a_off((u), HALF + _R) + (unsigned)_C * 2u; } } while (0)
    const size_t kstep = (size_t)(BK * 2);
    const size_t akstep = S.a_kstep();
    const size_t hstep = (size_t)HALF * K * 2;
    const unsigned ldsw = (unsigned)wid * 1024u;
    const int aoff = lds_byte(wr * 64 + fr, fq * 8), boff = lds_byte(wc * 32 + fr, fq * 8);
#define PG8_SA(b, h) (((b) * 2 + (h)) * HTB)
#define PG8_SB(b, h) ((4 + (b) * 2 + (h)) * HTB)
#define PG8_STAGE(bufoff, gbase, voff) do { _Pragma("unroll") for (int _i = 0; _i < 2; ++_i) { unsigned _o = (voff)[_i]; asm volatile("" : "+v"(_o));     \
        __builtin_amdgcn_global_load_lds((const unsigned*)((const char*)(gbase) + _o), (PG8_LAS unsigned*)(lds + (bufoff) + ldsw + _i * 8192), 16, 0, 0); } } while (0)
#define PG8_LDA(dst, b, h) do { _Pragma("unroll") for (int m = 0; m < 4; ++m) _Pragma("unroll") for (int k = 0; k < 2; ++k) dst[m][k] = *(const PG8_LAS bf16x8*)(lds + PG8_SA(b, h) + aoff + m * 2048 + k * 1024); } while (0)
#define PG8_LDB(dst, b, h) do { _Pragma("unroll") for (int n = 0; n < 2; ++n) _Pragma("unroll") for (int k = 0; k < 2; ++k) dst[n][k] = *(const PG8_LAS bf16x8*)(lds + PG8_SB(b, h) + boff + n * 2048 + k * 1024); } while (0)
#define PG8_MMA(ai, bj, At, Bt) do { __builtin_amdgcn_s_setprio(1); _Pragma("unroll") for (int m = 0; m < 4; ++m) _Pragma("unroll") for (int n = 0; n < 2; ++n) _Pragma("unroll") for (int k = 0; k < 2; ++k) \
        acc[ai][bj][m][n] = __builtin_amdgcn_mfma_f32_16x16x32_bf16(Bt[n][k], At[m][k], acc[ai][bj][m][n], 0, 0, 0); __builtin_amdgcn_s_setprio(0); } while (0)
#define PG8_WAIT_V(n) asm volatile("s_waitcnt vmcnt(" #n ")" ::: "memory")
#define PG8_WAIT_L(n) asm volatile("s_waitcnt lgkmcnt(" #n ")" ::: "memory")
#define PG8_BAR __builtin_amdgcn_s_barrier()
#define PG8_SCHED __builtin_amdgcn_sched_barrier(0)
    Unit cur, nxt; int ui = 0;
    if (!S.next(0, cur)) return;
    f32x4 acc[2][2][4][2];
    float zf_ = 0.f; asm volatile("" : "+v"(zf_));
#pragma unroll
    for (int a = 0; a < 2; ++a)
#pragma unroll
        for (int b = 0; b < 2; ++b)
#pragma unroll
            for (int m = 0; m < 4; ++m)
#pragma unroll
                for (int n = 0; n < 2; ++n) acc[a][b][m][n] = (f32x4){zf_, zf_, zf_, zf_};
    bf16x8 At[4][2], B0[2][2], B1[2][2];
    unsigned ca0[2], ca1[2], na0[2], na1[2];
    PG8_AOFF(cur, ca0, ca1);
    const char* const cA = Abase; const char* cB = S.b_base(cur);
    if constexpr (SP2) {
        PG8_STAGE(PG8_SB(0, 0), cB, voffB); PG8_STAGE(PG8_SB(0, 1), cB + hstep, voffB); PG8_STAGE(PG8_SA(0, 0), cA, ca0); PG8_STAGE(PG8_SA(0, 1), cA, ca1);
        if (wr == 1) PG8_BAR;
        PG8_WAIT_V(2); PG8_BAR;
        PG8_STAGE(PG8_SB(1, 0), cB + kstep, voffB); PG8_STAGE(PG8_SA(1, 0), cA + akstep, ca0); PG8_STAGE(PG8_SB(1, 1), cB + hstep + kstep, voffB);
        PG8_WAIT_V(6); PG8_BAR;
    } else { static_assert(SP2, "only the SP2 loop is kept"); }
    for (;;) {
        const bool has_next = S.next(ui + 1, nxt);
        const char* nB = has_next ? S.b_base(nxt) : cB;
        if (has_next) { PG8_AOFF(nxt, na0, na1); } else { na0[0] = ca0[0]; na0[1] = ca0[1]; na1[0] = ca1[0]; na1[1] = ca1[1]; }
        for (int t = 0; t < nt - 2; t += 2) {
            const char* a1 = cA + (size_t)(t + 1) * akstep;
            const char* a2 = cA + (size_t)(t + 2) * akstep; const char* b2 = cB + (size_t)(t + 2) * kstep;
            const char* a3 = a2 + akstep; const char* b3 = b2 + kstep;
            PG8_LDB(B0, 0, 0); PG8_LDB(B1, 0, 1); PG8_SCHED; PG8_LDA(At, 0, 0); PG8_STAGE(PG8_SA(1, 1), a1, ca1);
            PG8_WAIT_V(8); PG8_WAIT_L(0); PG8_BAR; PG8_MMA(0, 0, At, B0); PG8_MMA(0, 1, At, B1); PG8_BAR; PG8_SCHED;
            PG8_LDA(At, 0, 1); PG8_STAGE(PG8_SB(0, 0), b2, voffB); PG8_STAGE(PG8_SB(0, 1), b2 + hstep, voffB); PG8_STAGE(PG8_SA(0, 0), a2, ca0);
            PG8_WAIT_V(8); PG8_WAIT_L(0); PG8_BAR; PG8_MMA(1, 0, At, B0); PG8_MMA(1, 1, At, B1); PG8_BAR; PG8_SCHED;
            PG8_LDB(B0, 1, 0); PG8_LDB(B1, 1, 1); PG8_SCHED; PG8_LDA(At, 1, 0); PG8_STAGE(PG8_SA(0, 1), a2, ca1);
            PG8_WAIT_V(8); PG8_WAIT_L(0); PG8_BAR; PG8_MMA(0, 0, At, B0); PG8_MMA(0, 1, At, B1); PG8_BAR; PG8_SCHED;
            PG8_LDA(At, 1, 1); PG8_STAGE(PG8_SB(1, 0), b3, voffB); PG8_STAGE(PG8_SB(1, 1), b3 + hstep, voffB); PG8_STAGE(PG8_SA(1, 0), a3, ca0);
            PG8_WAIT_V(8); PG8_WAIT_L(0); PG8_BAR; PG8_MMA(1, 0, At, B0); PG8_MMA(1, 1, At, B1); PG8_BAR; PG8_SCHED;
        }
        {
            const char* a1 = cA + (size_t)(nt - 1) * akstep;
            const char* a2 = cA; const char* b2 = nB; const char* a3 = a2 + akstep; const char* b3 = b2 + kstep;
            PG8_LDB(B0, 0, 0); PG8_LDB(B1, 0, 1); PG8_SCHED; PG8_LDA(At, 0, 0); PG8_STAGE(PG8_SA(1, 1), a1, ca1);
            PG8_WAIT_V(8); PG8_WAIT_L(0); PG8_BAR; PG8_MMA(0, 0, At, B0); PG8_MMA(0, 1, At, B1); PG8_BAR; PG8_SCHED;
            PG8_LDA(At, 0, 1); PG8_STAGE(PG8_SB(0, 0), b2, voffB); PG8_STAGE(PG8_SB(0, 1), b2 + hstep, voffB); PG8_STAGE(PG8_SA(0, 0), a2, na0);
            PG8_WAIT_V(8); PG8_WAIT_L(0); PG8_BAR; PG8_MMA(1, 0, At, B0); PG8_MMA(1, 1, At, B1); PG8_BAR; PG8_SCHED;
            PG8_LDB(B0, 1, 0); PG8_LDB(B1, 1, 1); PG8_SCHED; PG8_LDA(At, 1, 0); PG8_STAGE(PG8_SA(0, 1), a2, na1);
            PG8_WAIT_V(8); PG8_WAIT_L(0); PG8_BAR; PG8_MMA(0, 0, At, B0); PG8_MMA(0, 1, At, B1); PG8_BAR; PG8_SCHED;
            PG8_LDA(At, 1, 1); PG8_STAGE(PG8_SB(1, 0), b3, voffB); PG8_STAGE(PG8_SB(1, 1), b3 + hstep, voffB); PG8_STAGE(PG8_SA(1, 0), a3, na0);
            PG8_WAIT_V(8); PG8_WAIT_L(0); PG8_BAR; PG8_MMA(1, 0, At, B0); PG8_MMA(1, 1, At, B1); PG8_BAR; PG8_SCHED;
        }
        if constexpr (ALIGN_EPI) { if (wr == 0) PG8_BAR; }
        E(acc, cur, wr, wc, fr, fq);
        if (!has_next) break;
#pragma unroll
        for (int a = 0; a < 2; ++a)
#pragma unroll
            for (int b = 0; b < 2; ++b)
#pragma unroll
                for (int m = 0; m < 4; ++m)
#pragma unroll
                    for (int n = 0; n < 2; ++n) acc[a][b][m][n] = (f32x4){zf_, zf_, zf_, zf_};
        cur = nxt; cB = nB; ++ui; ca0[0] = na0[0]; ca0[1] = na0[1]; ca1[0] = na1[0]; ca1[1] = na1[1];
        if constexpr (ALIGN_EPI) { if (wr == 1) PG8_BAR; }
    }
    PG8_WAIT_V(0);
    if constexpr (!ALIGN_EPI) { if (wr == 0) PG8_BAR; }
    PG8_BAR;
#undef PG8_AOFF
#undef PG8_SA
#undef PG8_SB
#undef PG8_STAGE
#undef PG8_LDA
#undef PG8_LDB
#undef PG8_MMA
#undef PG8_WAIT_V
#undef PG8_WAIT_L
#undef PG8_BAR
#undef PG8_SCHED
}

}
namespace mk {
using namespace nv;
typedef unsigned short bf16_t;
typedef unsigned u32x4 __attribute__((ext_vector_type(4)));
typedef float f32x4 __attribute__((ext_vector_type(4)));
#define LAS __attribute__((address_space(3)))
typedef short bf16x8 __attribute__((ext_vector_type(8)));
typedef float f32x16 __attribute__((ext_vector_type(16)));
#define CROW(reg, hh) (((reg) & 3) + 8 * ((reg) >> 2) + 4 * (hh))
constexpr int NT = 512;
constexpr int PB = 2816;
constexpr int NPAD = 3072;
constexpr int C_KV = 512, C_FOX = 1280, C_SB = 2048, C_GATE = 2816;
constexpr int MAXT = MROWS / 256 + NE;
constexpr int PROWS = MAXT * 256;
#define CNT_IDX(l, e) (8192 + ((l) * NE + (e)) * 32)
__device__ __forceinline__ int ftid() { int t = threadIdx.x; asm volatile("" : "+v"(t)); return t; }
__device__ __forceinline__ int fbid() { int b = blockIdx.x; asm volatile("" : "+s"(b)); return b; }
#define MK_LOOP(vb, n) for (int vb = fbid(); vb < (n); vb += gridDim.x)

constexpr size_t al_(size_t x) { return (x + 4095) & ~(size_t)4095; }
constexpr size_t O_WTIN = 0;
constexpr size_t O_WTOUT = O_WTIN + al_((size_t)L_ * NPAD * D_ * 2);
constexpr size_t O_WTGU = O_WTOUT + al_((size_t)L_ * D_ * D_ * 2);
constexpr size_t O_WTDN = O_WTGU + al_((size_t)L_ * NE * 2048 * D_ * 2);
constexpr size_t O_BIASP = O_WTDN + al_((size_t)L_ * NE * D_ * D_ * 2);
constexpr size_t O_XB = O_BIASP + al_((size_t)L_ * NPAD * 4);
constexpr size_t O_PROJB = O_XB + al_((size_t)T_ * D_ * 2);
constexpr size_t O_GF = O_PROJB + al_((size_t)T_ * PB * 2);
constexpr size_t O_CFOX = O_GF + al_((size_t)T_ * 32 * 4);
constexpr size_t O_KCMP = O_CFOX + al_((size_t)B_ * 4 * S_ * 4);
constexpr size_t O_VCMP = O_KCMP + al_((size_t)B_ * 2 * 512 * 64 * 4);
constexpr size_t O_O = O_VCMP + al_((size_t)B_ * 2 * 512 * 64 * 4);
constexpr size_t O_OB = O_O + al_((size_t)T_ * D_ * 4);
constexpr size_t O_PTOT = O_OB + al_((size_t)T_ * D_ * 2);
constexpr size_t O_SEL = O_PTOT + al_((size_t)B_ * 2 * S_ * 512 * 4);
constexpr size_t O_MIX = O_SEL + al_((size_t)B_ * 2 * S_ * NSEL * 4);
constexpr size_t O_X1 = O_MIX + al_((size_t)T_ * D_ * 4);
constexpr size_t O_X1B = O_X1 + al_((size_t)T_ * D_ * 4);
constexpr size_t O_XA = O_X1B + al_((size_t)T_ * D_ * 2);
constexpr size_t O_ACT = O_XA + al_((size_t)T_ * D_ * 4);
constexpr size_t O_Y = O_ACT + al_((size_t)PROWS * D_ * 2);
constexpr size_t O_TOPE = O_Y + al_((size_t)PROWS * D_ * 2);
constexpr size_t O_TOPW = O_TOPE + al_((size_t)MROWS * 4);
constexpr size_t O_POS = O_TOPW + al_((size_t)MROWS * 4);
constexpr size_t O_ROWTOK = O_POS + al_((size_t)MROWS * 4);
constexpr size_t O_ROWW = O_ROWTOK + al_((size_t)PROWS * 4);
constexpr size_t O_SLOT = O_ROWW + al_((size_t)PROWS * 4);
constexpr size_t O_COUNTS = O_SLOT + al_((size_t)MROWS * 4);
constexpr size_t O_META = O_COUNTS + 65536;
constexpr size_t O_OWIN = O_META + 4096;
constexpr size_t O_O2 = O_OWIN + al_((size_t)T_ * 512 * 4);
constexpr size_t O_OWIN2 = O_O2 + al_((size_t)T_ * D_ * 4);
constexpr size_t O_KCMPB = O_OWIN2 + al_((size_t)T_ * 512 * 4);
constexpr size_t O_VCMPB = O_KCMPB + al_((size_t)B_ * 2 * 512 * 64 * 2);
constexpr size_t O_OCMP = O_VCMPB + al_((size_t)B_ * 2 * 512 * 64 * 2);
constexpr size_t O_SELMASK = O_OCMP + al_((size_t)T_ * 512 * 4);
constexpr size_t O_WT1 = O_SELMASK + al_((size_t)B_ * 2 * S_ * 16);
constexpr size_t O_BIAS1 = O_WT1 + al_((size_t)L_ * 2 * 256 * 2048 * 2);
constexpr size_t O_HID = O_BIAS1 + al_((size_t)L_ * 2 * 128 * 4);
constexpr size_t O_BIAS1P = O_HID + al_((size_t)8 * 512 * 128 * 2);
constexpr size_t O_RWT = O_BIAS1P + al_((size_t)L_ * 2 * 64 * 128 * 4);
constexpr size_t O_HIDP = O_RWT + al_((size_t)L_ * 2 * NE * D_ * 2);
constexpr size_t O_END = O_HIDP + al_((size_t)2 * 8 * 512 * 128 * 4);

struct P {
    In in; unsigned char* ws; float* out;
};
typedef const __attribute__((address_space(4))) P* KP;
__device__ __forceinline__ KP fresh_kp() { KP k = (KP)__builtin_amdgcn_kernarg_segment_ptr(); asm volatile("" : "+s"(k)); return k; }
#define WSP(T, off) ((T*)(p->ws + (off)))

__device__ __forceinline__ float bf2f(unsigned short b) { return __uint_as_float((unsigned)b << 16); }
__device__ __forceinline__ unsigned f2bf(float f) { unsigned u = __float_as_uint(f); return (u + 0x7fffu + ((u >> 16) & 1u)) >> 16; }
__device__ __forceinline__ unsigned pk2(float lo, float hi) { return f2bf(lo) | (f2bf(hi) << 16); }
__device__ __forceinline__ void ld8(const bf16_t* __restrict__ src, float* dst) {
    const u32x4 v = *(const u32x4*)src;
    dst[0] = __uint_as_float(v.x << 16); dst[1] = __uint_as_float(v.x & 0xffff0000u); dst[2] = __uint_as_float(v.y << 16); dst[3] = __uint_as_float(v.y & 0xffff0000u);
    dst[4] = __uint_as_float(v.z << 16); dst[5] = __uint_as_float(v.z & 0xffff0000u); dst[6] = __uint_as_float(v.w << 16); dst[7] = __uint_as_float(v.w & 0xffff0000u);
}


__device__ __forceinline__ int perm_in(int n) {
    if (n < 1280) return n;
    if (n < 1304) return C_GATE + (n - 1280);
    if (n < 2072) return C_FOX + (n - 1304);
    if (n < 2076) return C_GATE + 24 + (n - 2072);
    return C_SB + (n - 2076);
}
__device__ __forceinline__ int perm_gu(int n) { const int up = n >> 10, c = n & 1023; return 256 * (c >> 7) + 128 * up + (c & 127); }
template <int MAP>
__device__ __forceinline__ void transpose_item(const float* __restrict__ W, int K, int N, bf16_t* __restrict__ WT, LAS float* scr, int item, int lane) {
    const int nblk = (N + 31) / 32, kb = item / nblk, nb = item % nblk, k0 = 64 * kb, n0 = 32 * nb;
    { const int n4 = (lane & 7) * 4; const bool okn = (n0 + n4) < N;
      f32x4 t[8];
#pragma unroll
      for (int i = 0; i < 8; ++i) { const int kk = (lane >> 3) + 8 * i; t[i] = okn ? *(const f32x4*)(W + (size_t)(k0 + kk) * N + n0 + n4) : (f32x4){0.f, 0.f, 0.f, 0.f}; }
#pragma unroll
      for (int i = 0; i < 8; ++i) { const int kk = (lane >> 3) + 8 * i; LAS float* d = scr + kk * 33 + n4; d[0] = t[i].x; d[1] = t[i].y; d[2] = t[i].z; d[3] = t[i].w; } }
    asm volatile("s_waitcnt lgkmcnt(0)" ::: "memory");
    const int c = lane & 7;
#pragma unroll
    for (int j = 0; j < 4; ++j) { const int n = (lane >> 3) + 8 * j; const LAS float* sp = scr + (8 * c) * 33 + n;
        u32x4 o; o.x = pk2(sp[0 * 33], sp[1 * 33]); o.y = pk2(sp[2 * 33], sp[3 * 33]); o.z = pk2(sp[4 * 33], sp[5 * 33]); o.w = pk2(sp[6 * 33], sp[7 * 33]);
        const int ng = n0 + n;
        if (ng < N) { const int ro = (MAP == 1) ? perm_in(ng) : (MAP == 2) ? perm_gu(ng) : ng;
            if (MAP == 3) *(u32x4*)(WT + (size_t)(k0 >> 10) * 256 * 1024 + (size_t)ro * 1024 + (k0 & 1023) + 8 * c) = o;
            else *(u32x4*)(WT + (size_t)ro * K + k0 + 8 * c) = o; } }
    asm volatile("s_waitcnt lgkmcnt(0)" ::: "memory");
}
constexpr int CV_I_IN = 16 * 89, CV_I_OUT = 16 * 32, CV_I_GU = 16 * 64, CV_I_DN = 16 * 32, CV_I_W1 = 32 * 4;
constexpr int CV_N_IN = L_ * CV_I_IN, CV_N_OUT = L_ * CV_I_OUT, CV_N_GU = L_ * NE * CV_I_GU, CV_N_DN = L_ * NE * CV_I_DN, CV_N_W1 = L_ * 2 * CV_I_W1, CV_N_ALL = CV_N_IN + CV_N_OUT + CV_N_GU + CV_N_DN + CV_N_W1;
constexpr int CV_DEF_GU0 = CV_N_W1 + NE * CV_I_GU, CV_DEF_GU = NE * CV_I_GU, CV_DEF_DN0 = CV_N_W1 + CV_N_GU + NE * CV_I_DN, CV_DEF_DN = NE * CV_I_DN, CV_DEF_ALL = CV_DEF_GU + CV_DEF_DN;
__device__ __forceinline__ void cv_one(KP p, LAS float* scr, int it, int lane) {
    int r = it;
    if (r < CV_N_W1) { const int mtx = r / CV_I_W1, ll = mtx >> 1, kv = mtx & 1; transpose_item<3>((kv ? p->in.w1v : p->in.w1k) + (size_t)ll * 2048 * 128, 2048, 128, WSP(bf16_t, O_WT1) + (size_t)mtx * 256 * 2048, scr, r % CV_I_W1, lane); return; } r -= CV_N_W1;
    if (r < CV_N_GU) { const int mtx = r / CV_I_GU; transpose_item<2>(p->in.wgu + (size_t)mtx * D_ * 2048, D_, 2048, WSP(bf16_t, O_WTGU) + (size_t)mtx * 2048 * D_, scr, r % CV_I_GU, lane); return; } r -= CV_N_GU;
    if (r < CV_N_DN) { const int mtx = r / CV_I_DN; transpose_item<0>(p->in.wdn + (size_t)mtx * D_ * D_, D_, D_, WSP(bf16_t, O_WTDN) + (size_t)mtx * D_ * D_, scr, r % CV_I_DN, lane); return; } r -= CV_N_DN;
    if (r < CV_N_IN) { const int mtx = r / CV_I_IN; transpose_item<1>(p->in.w_in + (size_t)mtx * D_ * DIN, D_, DIN, WSP(bf16_t, O_WTIN) + (size_t)mtx * NPAD * D_, scr, r % CV_I_IN, lane); return; } r -= CV_N_IN;
    { const int mtx = r / CV_I_OUT; transpose_item<0>(p->in.w_out + (size_t)mtx * D_ * D_, D_, D_, WSP(bf16_t, O_WTOUT) + (size_t)mtx * D_ * D_, scr, r % CV_I_OUT, lane); }
}
__device__ __forceinline__ void cv_help(LAS unsigned char* lds, KP p, int maxchunks) {
    const int tid = ftid(), lane = tid & 63, wv = tid >> 6; LAS float* scr = (LAS float*)(lds + wv * 8448);
    unsigned* cursor = WSP(unsigned, O_COUNTS) + 64;
    for (int c = 0; c < maxchunks; ++c) {
        unsigned base = 0u; if (lane == 0) base = atomicAdd(cursor, 8u);
        base = (unsigned)__builtin_amdgcn_readfirstlane((int)base);
        if (base >= (unsigned)CV_DEF_ALL) break;
        for (int i = 0; i < 8; ++i) { const int d = (int)base + i; if (d < CV_DEF_ALL) cv_one(p, scr, d < CV_DEF_GU ? CV_DEF_GU0 + d : CV_DEF_DN0 + (d - CV_DEF_GU), lane); }
    }
}
__device__ __forceinline__ void ph_convert(LAS unsigned char* lds, KP p) {
    const int tid = ftid(), lane = tid & 63, wv = tid >> 6;
    LAS float* scr = (LAS float*)(lds + wv * 8448);
    const int gw = fbid() * 8 + wv, NGW = gridDim.x * 8;
    for (int it = gw; it < CV_N_ALL; it += NGW) {
        if ((it >= CV_DEF_GU0 && it < CV_DEF_GU0 + CV_DEF_GU) || (it >= CV_DEF_DN0 && it < CV_DEF_DN0 + CV_DEF_DN)) continue;
        cv_one(p, scr, it, lane);
    }
    const int gt = fbid() * NT + tid, NG = gridDim.x * NT;
    for (int i = gt; i < L_ * (NPAD - DIN) * (D_ / 8); i += NG) { const int l = i / ((NPAD - DIN) * (D_ / 8)), r = i % ((NPAD - DIN) * (D_ / 8));
        unsigned z_ = 0u; asm volatile("" : "+v"(z_));
        *(u32x4*)(WSP(bf16_t, O_WTIN) + ((size_t)l * NPAD + DIN) * D_ + (size_t)r * 8) = (u32x4){z_, z_, z_, z_}; }
    for (int i = gt; i < L_ * 2 * 2 * 128 * (1024 / 8); i += NG) { const int mtxh = i / (128 * 128), r = i % (128 * 128); unsigned z_ = 0u; asm volatile("" : "+v"(z_));
        *(u32x4*)(WSP(bf16_t, O_WT1) + ((size_t)mtxh * 256 + 128) * 1024 + (size_t)r * 8) = (u32x4){z_, z_, z_, z_}; }
    for (int i = gt; i < L_ * 2 * 64 * 128; i += NG) { const int j = i & 127, seg = (i >> 7) & 63, mtx = i >> 13, ll = mtx >> 1, kv = mtx & 1;
        const float* pos = (kv ? p->in.pos_v : p->in.pos_k) + (size_t)ll * 2048 + seg * 32; const float* w1 = (kv ? p->in.w1v : p->in.w1k) + (size_t)ll * 2048 * 128 + (size_t)seg * 32 * 128; float a = 0.f;
#pragma unroll 8
        for (int k = 0; k < 32; ++k) a += pos[k] * w1[(size_t)k * 128 + j];
        WSP(float, O_BIAS1P)[i] = a; }
    for (int i = gt; i < L_ * NPAD; i += NG) { const int l = i / NPAD, c = i % NPAD; if (c >= DIN) WSP(float, O_BIASP)[i] = 0.f; }
    for (int i = gt; i < L_ * DIN; i += NG) { const int l = i / DIN, n = i % DIN; WSP(float, O_BIASP)[l * NPAD + perm_in(n)] = p->in.b_in[i]; }
    for (int i = gt; i < L_ * NE * D_; i += NG) { const int k = i & (D_ - 1), e = (i >> 10) & (NE - 1), l = i >> 15;
        const float v = p->in.rw[((size_t)l * D_ + k) * NE + e]; const unsigned h = f2bf(v); const float lo = v - bf2f((unsigned short)h);
        WSP(bf16_t, O_RWT)[((size_t)(l * 2 + 0) * NE + e) * D_ + k] = (bf16_t)h; WSP(bf16_t, O_RWT)[((size_t)(l * 2 + 1) * NE + e) * D_ + k] = (bf16_t)f2bf(lo); }
    for (int i = gt; i < T_ * D_ / 8; i += NG) { const f32x4 a = *(const f32x4*)(p->in.x + (size_t)i * 8), b = *(const f32x4*)(p->in.x + (size_t)i * 8 + 4);
        *(u32x4*)(WSP(bf16_t, O_XB) + (size_t)i * 8) = (u32x4){pk2(a.x, a.y), pk2(a.z, a.w), pk2(b.x, b.y), pk2(b.z, b.w)}; }
}

struct EpiProj {
    static constexpr bool PERM = true;
    bf16_t* projb; float* gf; const float* bias;
    __device__ __forceinline__ void operator()(const pg8::f32x4 (&acc)[2][2][4][2], const pg8::Unit& u, int wr, int wc, int fr, int fq) const {
        const int row0 = u.pm * 256 + wr * 64 + fr, col0 = u.pn * 256 + wc * 32 + 8 * fq;
        if (u.pn < 11) {
#pragma unroll
            for (int ai = 0; ai < 2; ++ai)
#pragma unroll
                for (int m = 0; m < 4; ++m) { bf16_t* rowp = projb + (size_t)(row0 + ai * 128 + m * 16) * PB + col0;
#pragma unroll
                    for (int bj = 0; bj < 2; ++bj) { const f32x4 v0 = acc[ai][bj][m][0] + *(const f32x4*)(bias + col0 + bj * 128), v1 = acc[ai][bj][m][1] + *(const f32x4*)(bias + col0 + bj * 128 + 4);
                        u32x4 w; w.x = pg8::cvt_pk_bf16(v0[0], v0[1]); w.y = pg8::cvt_pk_bf16(v0[2], v0[3]); w.z = pg8::cvt_pk_bf16(v1[0], v1[1]); w.w = pg8::cvt_pk_bf16(v1[2], v1[3]);
                        *(u32x4*)(rowp + bj * 128) = w; }
                    asm volatile("" ::: "memory"); }
        } else if (wc == 0) {
            const f32x4 b0 = *(const f32x4*)(bias + col0), b1 = *(const f32x4*)(bias + col0 + 4);
#pragma unroll
            for (int ai = 0; ai < 2; ++ai)
#pragma unroll
                for (int m = 0; m < 4; ++m) { float* rowp = gf + (size_t)(row0 + ai * 128 + m * 16) * 32 + 8 * fq;
                    const f32x4 v0 = acc[ai][0][m][0] + b0, v1 = acc[ai][0][m][1] + b1; f32x4 o0, o1;
#pragma unroll
                    for (int i = 0; i < 4; ++i) { const int j0 = 8 * fq + i, j1 = j0 + 4;
                        o0[i] = (j0 < 24) ? sigmoidf_(v0[i]) : (j0 < 28 ? logsig(v0[i]) : 0.f); o1[i] = (j1 < 24) ? sigmoidf_(v1[i]) : (j1 < 28 ? logsig(v1[i]) : 0.f); }
                    *(f32x4*)rowp = o0; *(f32x4*)(rowp + 4) = o1; }
        }
    }
};
struct EpiOut {
    static constexpr bool PERM = true;
    bf16_t* mixb;
    __device__ __forceinline__ void operator()(const pg8::f32x4 (&acc)[2][2][4][2], const pg8::Unit& u, int wr, int wc, int fr, int fq) const {
        const int row0 = u.pm * 256 + wr * 64 + fr, col0 = u.pn * 256 + wc * 32 + 8 * fq;
#pragma unroll
        for (int ai = 0; ai < 2; ++ai)
#pragma unroll
            for (int m = 0; m < 4; ++m) { bf16_t* rowp = mixb + (size_t)(row0 + ai * 128 + m * 16) * D_ + col0;
#pragma unroll
                for (int bj = 0; bj < 2; ++bj) { const f32x4 v0 = acc[ai][bj][m][0], v1 = acc[ai][bj][m][1];
                    u32x4 w; w.x = pg8::cvt_pk_bf16(v0[0], v0[1]); w.y = pg8::cvt_pk_bf16(v0[2], v0[3]); w.z = pg8::cvt_pk_bf16(v1[0], v1[1]); w.w = pg8::cvt_pk_bf16(v1[2], v1[3]);
                    *(u32x4*)(rowp + bj * 128) = w; }
                asm volatile("" ::: "memory"); }
    }
};
struct EpiGU {
    static constexpr bool PERM = true;
    bf16_t* act; const float* bgu;
    __device__ __forceinline__ void operator()(const pg8::f32x4 (&acc)[2][2][4][2], const pg8::Unit& u, int wr, int wc, int fr, int fq) const {
        const int row0 = u.pm * 256 + wr * 64 + fr, col0 = u.pn * 128 + wc * 32 + 8 * fq;
        const float* bb = bgu + (size_t)u.e * 2048 + col0;
        const f32x4 bg0 = *(const f32x4*)bb, bg1 = *(const f32x4*)(bb + 4), bu0 = *(const f32x4*)(bb + 1024), bu1 = *(const f32x4*)(bb + 1028);
#pragma unroll
        for (int ai = 0; ai < 2; ++ai)
#pragma unroll
            for (int m = 0; m < 4; ++m) { f32x4 a0, a1;
                const f32x4 g0 = acc[ai][0][m][0] + bg0, g1 = acc[ai][0][m][1] + bg1, u0 = acc[ai][1][m][0] + bu0, u1 = acc[ai][1][m][1] + bu1;
#pragma unroll
                for (int i = 0; i < 4; ++i) { const float gt0 = fminf(g0[i], 7.0f), up0 = fminf(fmaxf(u0[i], -7.0f), 7.0f), gt1 = fminf(g1[i], 7.0f), up1 = fminf(fmaxf(u1[i], -7.0f), 7.0f);
                    a0[i] = gt0 * sigmoidf_(1.702f * gt0) * (up0 + 1.0f); a1[i] = gt1 * sigmoidf_(1.702f * gt1) * (up1 + 1.0f); }
                u32x4 w; w.x = pg8::cvt_pk_bf16(a0[0], a0[1]); w.y = pg8::cvt_pk_bf16(a0[2], a0[3]); w.z = pg8::cvt_pk_bf16(a1[0], a1[1]); w.w = pg8::cvt_pk_bf16(a1[2], a1[3]);
                *(u32x4*)(act + (size_t)(row0 + ai * 128 + m * 16) * D_ + col0) = w; asm volatile("" ::: "memory"); }
    }
};
struct EpiDN {
    static constexpr bool PERM = true;
    bf16_t* y; const float* bdn; const float* roww;
    __device__ __forceinline__ void operator()(const pg8::f32x4 (&acc)[2][2][4][2], const pg8::Unit& u, int wr, int wc, int fr, int fq) const {
        const int row0 = u.pm * 256 + wr * 64 + fr, col0 = u.pn * 256 + wc * 32 + 8 * fq;
        const float* bb = bdn + (size_t)u.e * D_ + col0;
#pragma unroll
        for (int ai = 0; ai < 2; ++ai)
#pragma unroll
            for (int m = 0; m < 4; ++m) { const int row = row0 + ai * 128 + m * 16; const float w = roww[row];
#pragma unroll
                for (int bj = 0; bj < 2; ++bj) { const f32x4 v0 = (acc[ai][bj][m][0] + *(const f32x4*)(bb + bj * 128)) * w, v1 = (acc[ai][bj][m][1] + *(const f32x4*)(bb + bj * 128 + 4)) * w;
                    u32x4 o; o.x = pg8::cvt_pk_bf16(v0[0], v0[1]); o.y = pg8::cvt_pk_bf16(v0[2], v0[3]); o.z = pg8::cvt_pk_bf16(v1[0], v1[1]); o.w = pg8::cvt_pk_bf16(v1[2], v1[3]);
                    *(u32x4*)(y + (size_t)row * D_ + col0 + bj * 128) = o; }
                asm volatile("" ::: "memory"); }
    }
};
struct EpiCmp {
    static constexpr bool PERM = true;
    float* hidp;
    __device__ __forceinline__ void operator()(const pg8::f32x4 (&acc)[2][2][4][2], const pg8::Unit& u, int wr, int wc, int fr, int fq) const {
        const int row0 = u.pm * 256 + wr * 64 + fr, col0 = wc * 32 + 8 * fq;
#pragma unroll
        for (int ai = 0; ai < 2; ++ai)
#pragma unroll
            for (int m = 0; m < 4; ++m) { float* d = hidp + (((size_t)u.pn * 8 + u.e) * 512 + row0 + ai * 128 + m * 16) * 128 + col0;
                *(f32x4*)d = acc[ai][0][m][0]; *(f32x4*)(d + 4) = acc[ai][0][m][1]; asm volatile("" ::: "memory"); }
    }
};
struct GEpi {
    static constexpr bool PERM = true;
    int kind, l;
    __device__ __forceinline__ void operator()(const pg8::f32x4 (&acc)[2][2][4][2], const pg8::Unit& u, int wr, int wc, int fr, int fq) const {
        const KP p = fresh_kp();
        if (kind == 0) { const EpiProj e{WSP(bf16_t, O_PROJB), WSP(float, O_GF), WSP(float, O_BIASP) + l * NPAD}; e(acc, u, wr, wc, fr, fq); }
        else if (kind == 1) { const EpiOut e{WSP(bf16_t, O_MIX)}; e(acc, u, wr, wc, fr, fq); }
        else if (kind == 2) { const EpiGU e{WSP(bf16_t, O_ACT), p->in.bgu + (size_t)l * NE * 2048}; e(acc, u, wr, wc, fr, fq); }
        else if (kind == 3) { const EpiDN e{WSP(bf16_t, O_Y), p->in.bdn + (size_t)l * NE * D_, WSP(float, O_ROWW)}; e(acc, u, wr, wc, fr, fq); }
        else { const EpiCmp e{WSP(float, O_HIDP)}; e(acc, u, wr, wc, fr, fq); }
    }
};
struct GSched {
    int kind, nM, nN, nunits, G, c; const int* meta; const int* rowtok; const char* Bt; size_t estep;
    __device__ __forceinline__ bool next(int i, pg8::Unit& u) const {
        const int L = i * G + c; if (L >= nunits) return false;
        if (kind == 1) {
            int wgid = L; { const int q = nunits / pg8::NXCD, r = nunits % pg8::NXCD, xcd = wgid % pg8::NXCD, off = wgid / pg8::NXCD; wgid = (xcd < r ? xcd * (q + 1) : r * (q + 1) + (xcd - r) * q) + off; }
            const int nig = pg8::WGM * nN, gid = wgid / nig, fm = gid * pg8::WGM, gsz = (nM - fm) < pg8::WGM ? (nM - fm) : pg8::WGM;
            u.pm = fm + ((wgid % nig) % gsz); u.pn = (wgid % nig) / gsz; u.e = 0; u.nr = 256;
        } else if (kind == 4) { u.e = L >> 2; u.pm = (L >> 1) & 1; u.pn = L & 1; u.nr = ((L >> 1) & 1) ? 255 : 256; }
        else if (kind == 0) { const int gt = L / nN; u.pm = gt; u.pn = L - gt * nN; u.e = 0; u.nr = 256; }
        else { const int gt = L / nN; u.pm = gt; u.pn = L - gt * nN; u.e = meta[64 + 2 * gt]; u.nr = meta[65 + 2 * gt]; }
        return true; }
    __device__ __forceinline__ unsigned a_off(const pg8::Unit& u, int r) const { const int rr = r < u.nr ? r : u.nr - 1; const int row = u.pm * 256 + rr;
        if (kind == 4) { const int kv = u.e & 1, bg = u.e >> 1; return (unsigned)(((bg >> 1) * S_ + 16 * row + 16 * u.pn) * PB + C_KV + ((0 * 2 + kv) * 2 + (bg & 1)) * 64) * 2u; }
        return (unsigned)((kind == 2) ? rowtok[row] : row) * (unsigned)(D_ * 2); }
    __device__ __forceinline__ size_t a_kstep() const { return kind == 4 ? (size_t)PB * 2 : (size_t)128; }
    __device__ __forceinline__ const char* b_base(const pg8::Unit& u) const { return Bt + (size_t)(kind == 4 ? (u.e & 1) : u.e) * estep + (size_t)u.pn * ((size_t)256 * D_ * 2); }
};

__device__ __forceinline__ void ph_rmsnorm(KP p, int l) {
    const int lane = ftid() & 63, wv = ftid() >> 6; const float* g = p->in.g_out + (size_t)l * D_;
    constexpr int NB = 4; const int rstride = (int)gridDim.x * 8;
    f32x4 gg[4];
#pragma unroll
    for (int j = 0; j < 2; ++j) { gg[2 * j] = *(const f32x4*)(g + 512 * j + lane * 8); gg[2 * j + 1] = *(const f32x4*)(g + 512 * j + lane * 8 + 4); }
    for (int row0 = fbid() * 8 + wv; row0 < T_; row0 += rstride * NB) {
        u32x4 ra[NB], rb2[NB], rw2[NB];
#pragma unroll
        for (int bi = 0; bi < NB; ++bi) { const int row = (row0 + bi * rstride < T_) ? row0 + bi * rstride : row0; const bf16_t* r = WSP(bf16_t, O_O) + (size_t)row * D_ + lane * 8;
            ra[bi] = *(const u32x4*)r; rb2[bi] = *(const u32x4*)(r + 512); rw2[bi] = *(const u32x4*)(WSP(bf16_t, O_OWIN) + (size_t)row * 512 + lane * 8); }
#pragma unroll
        for (int bi = 0; bi < NB; ++bi) { const int row = row0 + bi * rstride; if (row < T_) {
#define BF_LO(u) __uint_as_float((u) << 16)
#define BF_HI(u) __uint_as_float((u) & 0xffff0000u)
            const f32x4 x0 = (f32x4){BF_LO(ra[bi].x) + BF_LO(rw2[bi].x), BF_HI(ra[bi].x) + BF_HI(rw2[bi].x), BF_LO(ra[bi].y) + BF_LO(rw2[bi].y), BF_HI(ra[bi].y) + BF_HI(rw2[bi].y)};
            const f32x4 x1 = (f32x4){BF_LO(ra[bi].z) + BF_LO(rw2[bi].z), BF_HI(ra[bi].z) + BF_HI(rw2[bi].z), BF_LO(ra[bi].w) + BF_LO(rw2[bi].w), BF_HI(ra[bi].w) + BF_HI(rw2[bi].w)};
            const f32x4 y0 = (f32x4){BF_LO(rb2[bi].x), BF_HI(rb2[bi].x), BF_LO(rb2[bi].y), BF_HI(rb2[bi].y)}, y1 = (f32x4){BF_LO(rb2[bi].z), BF_HI(rb2[bi].z), BF_LO(rb2[bi].w), BF_HI(rb2[bi].w)};
#undef BF_LO
#undef BF_HI
            float s = (x0.x * x0.x + x0.y * x0.y) + (x0.z * x0.z + x0.w * x0.w) + (x1.x * x1.x + x1.y * x1.y) + (x1.z * x1.z + x1.w * x1.w);
            float s2 = (y0.x * y0.x + y0.y * y0.y) + (y0.z * y0.z + y0.w * y0.w) + (y1.x * y1.x + y1.y * y1.y) + (y1.z * y1.z + y1.w * y1.w);
            const float sc0 = rsqrtf(wsum(s) * (1.f / 512.f) + RMS_EPS);
#pragma unroll
            for (int o = 1; o < 32; o <<= 1) s2 += __shfl_xor(s2, o);
            const float sc1 = rsqrtf(s2 * (1.f / 256.f) + RMS_EPS);
            const f32x4 u0 = x0 * sc0 * gg[0], u1 = x1 * sc0 * gg[1], w0 = y0 * sc1 * gg[2], w1 = y1 * sc1 * gg[3];
            bf16_t* ro = WSP(bf16_t, O_OB) + (size_t)row * D_;
            *(u32x4*)(ro + lane * 8) = (u32x4){pk2(u0.x, u0.y), pk2(u0.z, u0.w), pk2(u1.x, u1.y), pk2(u1.z, u1.w)};
            *(u32x4*)(ro + 512 + lane * 8) = (u32x4){pk2(w0.x, w0.y), pk2(w0.z, w0.w), pk2(w1.x, w1.y), pk2(w1.z, w1.w)}; } }
    }
}
template <bool ROUTER>
__device__ __forceinline__ void ph_ln(float* lds, KP p, int l, float* __restrict__ yout, int cnt_off = 0) {
    const int lane = ftid() & 63, wv = ftid() >> 6;
    const float* g = (ROUTER ? p->in.ln1_g : p->in.ln2_g) + (size_t)l * D_; const float* bb = (ROUTER ? p->in.ln1_b : p->in.ln2_b) + (size_t)l * D_;
    constexpr int NB = ROUTER ? 4 : 2;
    const int rstride = (int)gridDim.x * 8;
    LAS unsigned char* L3 = (LAS unsigned char*)lds; float* lgl = lds + 33024 + wv * 256;
    int oi = 0;
    for (int row0 = fbid() * 8 + wv; row0 < T_; row0 += rstride * NB, ++oi) {
        float v[NB][16];
        if (ROUTER) { const float* xin = (l == 0) ? p->in.x : WSP(float, O_XA);
#pragma unroll
            for (int bi = 0; bi < NB; ++bi) { const int row = (row0 + bi * rstride < T_) ? row0 + bi * rstride : row0; const float* src = xin + (size_t)row * D_; const bf16_t* mx = WSP(bf16_t, O_MIX) + (size_t)row * D_;
#pragma unroll
                for (int j = 0; j < 2; ++j) { const f32x4 a = *(const f32x4*)(src + 512 * j + lane * 8), b = *(const f32x4*)(src + 512 * j + lane * 8 + 4); const u32x4 q = *(const u32x4*)(mx + 512 * j + lane * 8);
                    v[bi][8 * j + 0] = ALPHA * a.x + __uint_as_float(q.x << 16); v[bi][8 * j + 1] = ALPHA * a.y + __uint_as_float(q.x & 0xffff0000u); v[bi][8 * j + 2] = ALPHA * a.z + __uint_as_float(q.y << 16); v[bi][8 * j + 3] = ALPHA * a.w + __uint_as_float(q.y & 0xffff0000u);
                    v[bi][8 * j + 4] = ALPHA * b.x + __uint_as_float(q.z << 16); v[bi][8 * j + 5] = ALPHA * b.y + __uint_as_float(q.z & 0xffff0000u); v[bi][8 * j + 6] = ALPHA * b.z + __uint_as_float(q.w << 16); v[bi][8 * j + 7] = ALPHA * b.w + __uint_as_float(q.w & 0xffff0000u); } }
        } else { const bf16_t* y = WSP(bf16_t, O_Y);
            int sl[NB][TOPK];
#pragma unroll
            for (int bi = 0; bi < NB; ++bi) { const int row = (row0 + bi * rstride < T_) ? row0 + bi * rstride : row0;
#pragma unroll
                for (int k = 0; k < TOPK; ++k) sl[bi][k] = WSP(int, O_SLOT)[row * TOPK + k]; }
            u32x4 yv[NB][TOPK][2]; f32x4 xv[NB][4];
#pragma unroll
            for (int bi = 0; bi < NB; ++bi) { const int row = (row0 + bi * rstride < T_) ? row0 + bi * rstride : row0; const float* src = WSP(float, O_X1) + (size_t)row * D_;
#pragma unroll
                for (int j = 0; j < 2; ++j) { xv[bi][2 * j] = *(const f32x4*)(src + 512 * j + lane * 8); xv[bi][2 * j + 1] = *(const f32x4*)(src + 512 * j + lane * 8 + 4); }
#pragma unroll
                for (int k = 0; k < TOPK; ++k)
#pragma unroll
                    for (int j = 0; j < 2; ++j) yv[bi][k][j] = *(const u32x4*)(y + (size_t)sl[bi][k] * D_ + 512 * j + lane * 8); }
#pragma unroll
            for (int bi = 0; bi < NB; ++bi)
#pragma unroll
                for (int j = 0; j < 2; ++j) { float acc[8];
#pragma unroll
                    for (int e = 0; e < 8; ++e) acc[e] = 0.f;
#pragma unroll
                    for (int k = 0; k < TOPK; ++k) { const u32x4 q = yv[bi][k][j];
                        acc[0] += __uint_as_float(q.x << 16); acc[1] += __uint_as_float(q.x & 0xffff0000u); acc[2] += __uint_as_float(q.y << 16); acc[3] += __uint_as_float(q.y & 0xffff0000u);
                        acc[4] += __uint_as_float(q.z << 16); acc[5] += __uint_as_float(q.z & 0xffff0000u); acc[6] += __uint_as_float(q.w << 16); acc[7] += __uint_as_float(q.w & 0xffff0000u); }
                    const f32x4 a = xv[bi][2 * j], b = xv[bi][2 * j + 1];
                    v[bi][8 * j + 0] = ALPHA * a.x + acc[0]; v[bi][8 * j + 1] = ALPHA * a.y + acc[1]; v[bi][8 * j + 2] = ALPHA * a.z + acc[2]; v[bi][8 * j + 3] = ALPHA * a.w + acc[3];
                    v[bi][8 * j + 4] = ALPHA * b.x + acc[4]; v[bi][8 * j + 5] = ALPHA * b.y + acc[5]; v[bi][8 * j + 6] = ALPHA * b.z + acc[6]; v[bi][8 * j + 7] = ALPHA * b.w + acc[7]; } }
#pragma unroll
        for (int bi = 0; bi < NB; ++bi) { const int row = row0 + bi * rstride; if (row < T_) {
            float s = 0.f;
#pragma unroll
            for (int i = 0; i < 16; ++i) s += v[bi][i];
            const float mu = wsum(s) * (1.f / D_); float s2 = 0.f;
#pragma unroll
            for (int i = 0; i < 16; ++i) { v[bi][i] -= mu; s2 += v[bi][i] * v[bi][i]; }
            const float rstd = rsqrtf(wsum(s2) * (1.f / D_) + LN_EPS);
            bf16_t* ybf = (ROUTER ? WSP(bf16_t, O_X1B) : WSP(bf16_t, O_XB)) + (size_t)row * D_;
#pragma unroll
            for (int j = 0; j < 2; ++j) { const int c0 = 512 * j + lane * 8; float o8[8];
                const f32x4 g0 = *(const f32x4*)(g + c0), g1 = *(const f32x4*)(g + c0 + 4), b0 = *(const f32x4*)(bb + c0), b1 = *(const f32x4*)(bb + c0 + 4);
                o8[0] = v[bi][8 * j + 0] * rstd * g0.x + b0.x; o8[1] = v[bi][8 * j + 1] * rstd * g0.y + b0.y; o8[2] = v[bi][8 * j + 2] * rstd * g0.z + b0.z; o8[3] = v[bi][8 * j + 3] * rstd * g0.w + b0.w;
                o8[4] = v[bi][8 * j + 4] * rstd * g1.x + b1.x; o8[5] = v[bi][8 * j + 5] * rstd * g1.y + b1.y; o8[6] = v[bi][8 * j + 6] * rstd * g1.z + b1.z; o8[7] = v[bi][8 * j + 7] * rstd * g1.w + b1.w;
                *(f32x4*)(yout + (size_t)row * D_ + c0) = (f32x4){o8[0], o8[1], o8[2], o8[3]};
                *(f32x4*)(yout + (size_t)row * D_ + c0 + 4) = (f32x4){o8[4], o8[5], o8[6], o8[7]};
                const u32x4 hv = (u32x4){pk2(o8[0], o8[1]), pk2(o8[2], o8[3]), pk2(o8[4], o8[5]), pk2(o8[6], o8[7])};
                *(u32x4*)(ybf + c0) = hv;
                if (ROUTER) {
                    float r8[8];
#pragma unroll
                    for (int i = 0; i < 4; ++i) { const unsigned w_ = (i == 0) ? hv.x : (i == 1) ? hv.y : (i == 2) ? hv.z : hv.w; r8[2 * i] = o8[2 * i] - __uint_as_float(w_ << 16); r8[2 * i + 1] = o8[2 * i + 1] - __uint_as_float(w_ & 0xffff0000u); }
                    LAS unsigned char* tp = L3 + (bi * 8 + wv) * 2064 + c0 * 2;
                    *(LAS u32x4*)tp = hv; *(LAS u32x4*)(tp + 66048) = (u32x4){pk2(r8[0], r8[1]), pk2(r8[2], r8[3]), pk2(r8[4], r8[5]), pk2(r8[6], r8[7])}; } } } }
        if (ROUTER) {
            __syncthreads();
            const int n32 = lane & 31, hh = lane >> 5;
            f32x16 acc;
#pragma unroll
            for (int r = 0; r < 16; ++r) acc[r] = 0.f;
            { const bf16_t* bh = WSP(bf16_t, O_RWT) + ((size_t)(l * 2) * NE + n32) * D_ + 128 * wv + 8 * hh; const bf16_t* bl = bh + (size_t)NE * D_;
              const LAS unsigned char* ah = L3 + n32 * 2064 + (128 * wv + 8 * hh) * 2;
              bf16x8 bhf[8], blf[8];
#pragma unroll
              for (int s_ = 0; s_ < 8; ++s_) { bhf[s_] = *(const bf16x8*)(bh + 16 * s_); blf[s_] = *(const bf16x8*)(bl + 16 * s_); }
#pragma unroll
              for (int s_ = 0; s_ < 8; ++s_) { const bf16x8 xh = *(const LAS bf16x8*)(ah + 32 * s_), xl = *(const LAS bf16x8*)(ah + 66048 + 32 * s_);
                  acc = __builtin_amdgcn_mfma_f32_32x32x16_bf16(xh, bhf[s_], acc, 0, 0, 0); acc = __builtin_amdgcn_mfma_f32_32x32x16_bf16(xh, blf[s_], acc, 0, 0, 0); acc = __builtin_amdgcn_mfma_f32_32x32x16_bf16(xl, bhf[s_], acc, 0, 0, 0); } }
            __syncthreads();
            { LAS float* red = (LAS float*)L3;
#pragma unroll
              for (int r = 0; r < 16; ++r) red[(wv * 32 + CROW(r, hh)) * 32 + n32] = acc[r];
              __syncthreads();
#pragma unroll
              for (int bi = 0; bi < NB; ++bi) { const int m = bi * 8 + wv; float sm = 0.f;
#pragma unroll
                  for (int q = 0; q < 4; ++q) sm += red[((hh * 4 + q) * 32 + m) * 32 + n32];
                  sm += __shfl_xor(sm, 32);
                  if (lane < 32) lgl[(NB * oi + bi) * 32 + n32] = sm; } }
            __syncthreads();
        }
    }
    if (ROUTER) {
        const float* rb = p->in.rb + (size_t)l * NE;
        int nrow = 0; for (int r_ = fbid() * 8 + wv; r_ < T_; r_ += (int)gridDim.x * 8) { ++nrow; asm volatile("" : "+s"(nrow)); }
        asm volatile("s_waitcnt lgkmcnt(0)" ::: "memory");
        int* lcnt = (int*)(lds + 33024 + 8 * 256);
        if (ftid() < NE) lcnt[ftid()] = 0;
        __syncthreads();
#pragma unroll 1
        for (int ri = 0; ri < nrow; ++ri) { const int row = fbid() * 8 + wv + ri * (int)gridDim.x * 8;
            const int e = lane & 31; const float lg = lgl[ri * 32 + e] + rb[e];
            float cur = lg, tv0 = 0.f, den = 0.f, myw = 0.f; int mye = 0;
#pragma unroll
            for (int k = 0; k < TOPK; ++k) { float bv = cur; int bi = e;
#pragma unroll
                for (int o = 16; o >= 1; o >>= 1) { const float ov = __shfl_xor(bv, o); const int oi = __shfl_xor(bi, o); if (ov > bv || (ov == bv && oi < bi)) { bv = ov; bi = oi; } }
                if (k == 0) tv0 = bv;
                const float w = __expf(bv - tv0); den += w;
                if (lane == k) { mye = bi; myw = w; }
                if (e == bi) cur = -3.4e38f; }
            if (lane < TOPK) { WSP(int, O_TOPE)[row * TOPK + lane] = mye; WSP(float, O_TOPW)[row * TOPK + lane] = myw / den; WSP(int, O_POS)[row * TOPK + lane] = atomicAdd(&lcnt[mye], 1); } }
        __syncthreads();
        if (ftid() < NE) { const int c = lcnt[ftid()]; lcnt[ftid()] = (c > 0) ? atomicAdd(WSP(int, O_COUNTS) + CNT_IDX(l, ftid()) + cnt_off, c) : 0; }
        __syncthreads();
#pragma unroll 1
        for (int ri = 0; ri < nrow; ++ri) { const int row = fbid() * 8 + wv + ri * (int)gridDim.x * 8;
            if (lane < TOPK) WSP(int, O_POS)[row * TOPK + lane] += lcnt[WSP(int, O_TOPE)[row * TOPK + lane]]; }
        __syncthreads();
    }
}
__device__ __forceinline__ void ph_bias1_reduce(KP p, int l) {
    if (fbid() != (int)gridDim.x - 1) return;
    const int tid = ftid(); if (tid < 256) { const float* pp = WSP(float, O_BIAS1P) + ((size_t)(l * 2 + (tid >> 7)) * 64) * 128 + (tid & 127);
        float v[64];
#pragma unroll
        for (int s = 0; s < 64; ++s) v[s] = pp[s * 128];
        float a = 0.f;
#pragma unroll
        for (int s = 0; s < 64; ++s) a += v[s];
        WSP(float, O_BIAS1)[l * 256 + tid] = a; }
}
__device__ __forceinline__ void ph_cumsum(float* lds, KP p, int blk0) {
    const int tid = ftid(), lane = tid & 63, wv = tid >> 6; const int bh = fbid() - blk0;
    if (bh < 0 || bh >= B_ * 4) return;
    const int b = bh >> 2, h = bh & 3; const float* gf = WSP(float, O_GF) + (size_t)(b * S_ + tid * 16) * 32 + 24 + h;
    float v[16], run = 0.f;
#pragma unroll
    for (int i = 0; i < 16; ++i) { run += gf[(size_t)i * 32]; v[i] = run; }
    float inc = run;
#pragma unroll
    for (int o = 1; o < 64; o <<= 1) { const float t = __shfl_up(inc, o); if (lane >= o) inc += t; }
    if (lane == 63) lds[wv] = inc;
    __syncthreads();
    float woff = 0.f;
#pragma unroll
    for (int i = 0; i < 8; ++i) woff += (i < wv) ? lds[i] : 0.f;
    const float off = woff + inc - run; float* c = WSP(float, O_CFOX) + (size_t)bh * S_ + tid * 16;
#pragma unroll
    for (int i = 0; i < 4; ++i) *(f32x4*)(c + 4 * i) = (f32x4){v[4 * i] + off, v[4 * i + 1] + off, v[4 * i + 2] + off, v[4 * i + 3] + off};
    __syncthreads();
}
__device__ __forceinline__ void ph_prep2(float* lds, KP p, int l) {
    { unsigned* kmax2 = WSP(unsigned, O_COUNTS) + 192 + l * 8;
      for (int i = fbid() * NT + ftid(); i < B_ * 4 * S_ * 2; i += gridDim.x * NT) { const int half = i & 1, t = (i >> 1) % S_, bh = (i >> 1) / S_, b = bh >> 2, h = bh & 3;
          const bf16_t* kr = WSP(bf16_t, O_PROJB) + (size_t)(b * S_ + t) * PB + C_FOX + (4 + h) * 64 + half * 32; float ss = 0.f;
#pragma unroll
          for (int c = 0; c < 4; ++c) { float k8[8]; ld8(kr + 8 * c, k8);
#pragma unroll
              for (int e = 0; e < 8; ++e) ss += k8[e] * k8[e]; }
          ss += __shfl_xor(ss, 1);
#pragma unroll
          for (int o = 2; o < 64; o <<= 1) ss = fmaxf(ss, __shfl_xor(ss, o));
          __syncthreads();
          if ((ftid() & 63) == 0) lds[ftid() >> 6] = ss;
          __syncthreads();
          if (ftid() == 0) { float mx = lds[0];
#pragma unroll
              for (int w_ = 1; w_ < 8; ++w_) mx = fmaxf(mx, lds[w_]);
              atomicMax(kmax2 + bh, __float_as_uint(mx)); } } }
    for (int i = fbid() * NT + ftid(); i < 8 * 512 * 64; i += gridDim.x * NT) {
        const int d = i & 63, n = (i >> 6) & 511, combo = i >> 15, kv = combo & 1, bg = combo >> 1;
        const float* w2 = (kv ? p->in.w2v : p->in.w2k) + (size_t)l * 128 * 64; const float* h0 = WSP(float, O_HIDP) + ((size_t)combo * 512 + n) * 128; const float* h1 = h0 + (size_t)8 * 512 * 128;
        const float* b1 = WSP(float, O_BIAS1) + l * 256 + kv * 128;
        __syncthreads();
#pragma unroll
        for (int q = 0; q < 4; ++q) *(f32x4*)(lds + 16 + 4 * (q * NT + ftid())) = *(const f32x4*)(w2 + 4 * (q * NT + ftid()));
        const float hv0 = gelu_tanh(h0[d] + h1[d] + b1[d]), hv1 = gelu_tanh(h0[64 + d] + h1[64 + d] + b1[64 + d]);
        __syncthreads();
        const float* w2s = lds + 16 + d;
        float a = 0.f;
#pragma unroll 16
        for (int c = 0; c < 64; ++c) a += __int_as_float(__builtin_amdgcn_readlane(__float_as_int(hv0), c)) * w2s[c * 64];
#pragma unroll 16
        for (int c = 0; c < 64; ++c) a += __int_as_float(__builtin_amdgcn_readlane(__float_as_int(hv1), c)) * w2s[(64 + c) * 64];
        (kv ? WSP(bf16_t, O_VCMPB) : WSP(bf16_t, O_KCMPB))[((size_t)bg * 512 + n) * 64 + d] = (n < NCMP) ? (bf16_t)f2bf(a) : (bf16_t)0; }
}
__device__ __forceinline__ void ph_moe_scatter2(float* lds, KP p, int l) {
    const int tid = ftid(); int* ts = (int*)lds;
    const int* counts = WSP(int, O_COUNTS) + CNT_IDX(l, 0); int* meta = WSP(int, O_META); int* cl = ts + 64;
    __syncthreads();
    if (tid < NE) cl[tid] = counts[tid * 32];
    __syncthreads();
    if (tid == 0) { int nt = 0; for (int e = 0; e < NE; ++e) { ts[e] = nt; nt += (cl[e] + 255) >> 8; } ts[32] = nt; }
    __syncthreads();
    if (fbid() == 0) { if (tid < NE) { const int c = cl[tid], t0 = ts[tid]; meta[tid] = t0; for (int r = 0, t = t0; r < c; r += 256, ++t) { meta[64 + 2 * t] = tid; meta[65 + 2 * t] = (c - r) < 256 ? (c - r) : 256; } }
        if (tid == 0) meta[32] = ts[32]; }
    for (int i = fbid() * NT + tid; i < MROWS; i += gridDim.x * NT) {
        const int row = ts[WSP(int, O_TOPE)[i]] * 256 + WSP(int, O_POS)[i];
        WSP(int, O_ROWTOK)[row] = i >> 2; WSP(float, O_ROWW)[row] = WSP(float, O_TOPW)[i]; WSP(int, O_SLOT)[i] = row; }
    __syncthreads();
}
}
namespace mk {
typedef short bf16x8 __attribute__((ext_vector_type(8)));
typedef float f32x16 __attribute__((ext_vector_type(16)));
typedef float f32x2_t __attribute__((ext_vector_type(2)));
typedef __bf16 bf16x2_t __attribute__((ext_vector_type(2)));
typedef unsigned u32x2 __attribute__((ext_vector_type(2)));
typedef short v4i16_t __attribute__((ext_vector_type(4)));
__device__ __forceinline__ unsigned cvtpk(float lo, float hi) { f32x2_t v = {lo, hi}; bf16x2_t b = __builtin_convertvector(v, bf16x2_t); return __builtin_bit_cast(unsigned, b); }
constexpr int KROW = 144, VROW = 136;
constexpr int E1_K = 0, E1_V = 64 * KROW, E1_C = E1_V + 64 * KROW, E1_BUF = E1_C + 256;
constexpr int E1_FLAGS = 2 * E1_BUF;
constexpr float LOG2E = 1.4426950408889634f;
constexpr float RESC_THR = 8.0f;
#define CROW(reg, hh) (((reg) & 3) + 8 * ((reg) >> 2) + 4 * (hh))

__device__ __forceinline__ float max3f(float a, float b, float c) { float r; asm("v_max3_f32 %0, %1, %2, %3" : "=v"(r) : "v"(a), "v"(b), "v"(c)); return r; }
typedef float f32x2_t __attribute__((ext_vector_type(2)));
__device__ __forceinline__ float lane32_other(float x, int hh) { const auto rr = __builtin_amdgcn_permlane32_swap(__float_as_uint(x), __float_as_uint(x), false, false); return __uint_as_float(hh ? rr[0] : rr[1]); }
#define SM_V(p0, p1, i_) (((i_) & 1) ? p1[(i_) >> 1] : p0[(i_) >> 1])
#define SM_ROWMAX(p0, p1, rm_) do { \
    rm_ = max3f(p0[0], p1[0], p0[1]); \
    _Pragma("unroll") for (int k_ = 0; k_ < 14; ++k_) rm_ = max3f(rm_, SM_V(p0, p1, 3 + 2 * k_), SM_V(p0, p1, 4 + 2 * k_)); \
    rm_ = max3f(rm_, p1[15], p1[15]); \
    { const auto rr_ = __builtin_amdgcn_permlane32_swap(__float_as_uint(rm_), __float_as_uint(rm_), false, false);     \
      rm_ = max3f(__uint_as_float(rr_[0]), __uint_as_float(rr_[1]), __uint_as_float(rr_[1])); } } while (0)
#define SM_CORE(p0, p1, m, l, have, o0, o1) do { \
    float rm_; SM_ROWMAX(p0, p1, rm_); \
    const bool fin_ = rm_ > -1e37f; \
    if (__any((rm_ > RESC_THR) || (!have && fin_))) { \
        const float dl_ = have ? fmaxf(rm_, 0.f) : (fin_ ? rm_ : 0.f); const float al_ = have ? __builtin_amdgcn_exp2f(-dl_) : 1.f; \
        m += dl_; l *= al_; have = have || fin_; \
        _Pragma("unroll") for (int r_ = 0; r_ < 16; ++r_) { o0[r_] *= al_; o1[r_] *= al_; p0[r_] -= dl_; p1[r_] -= dl_; } } \
    f32x2_t ls2_ = {0.f, 0.f}; \
    _Pragma("unroll") for (int reg_ = 0; reg_ < 16; reg_ += 2) { \
        p0[reg_] = __builtin_amdgcn_exp2f(p0[reg_]); p0[reg_ + 1] = __builtin_amdgcn_exp2f(p0[reg_ + 1]); p1[reg_] = __builtin_amdgcn_exp2f(p1[reg_]); p1[reg_ + 1] = __builtin_amdgcn_exp2f(p1[reg_ + 1]); \
        ls2_ += (f32x2_t){p0[reg_], p0[reg_ + 1]}; ls2_ += (f32x2_t){p1[reg_], p1[reg_ + 1]}; } \
    l += ls2_.x + ls2_.y; } while (0)

struct E1Geom { int b, q0, h; const bf16_t* qp; const bf16_t* kp; const bf16_t* vp; size_t pitch; };

template <int KIND>
__device__ __forceinline__ void e1_unit(LAS unsigned char* lds, KP p, int b, int hg, int qb, bf16_t* __restrict__ obase, bf16_t* __restrict__ owin, const unsigned* __restrict__ kmax2) {
    const int tid = ftid(), lane = tid & 63, w = __builtin_amdgcn_readfirstlane(tid >> 6), r32 = lane & 31, hh = lane >> 5;
    const bf16_t* projb = WSP(bf16_t, O_PROJB);
    int h, q0, qrow0, qcol, kcol, vcol, nrows;
    if (KIND == 0) { h = hg; q0 = qb * 256; qrow0 = q0 + 32 * w; qcol = C_FOX + h * 64; kcol = C_FOX + (4 + h) * 64; vcol = C_FOX + (8 + h) * 64; nrows = 256; }
    else if (KIND == 2) { h = hg; q0 = qb * 256; qrow0 = q0 + 32 * w; qcol = C_SB + h * 64; kcol = C_SB + (4 + h) * 64; vcol = C_SB + (8 + h) * 64; nrows = 256; }
    else { h = 4 * hg + (w & 3); q0 = qb * 64; qrow0 = q0 + 32 * (w >> 2); qcol = h * 64; kcol = C_KV + ((2 * 2 + 0) * 2 + hg) * 64; vcol = C_KV + ((2 * 2 + 1) * 2 + hg) * 64; nrows = 64; }
    const int tq = qrow0 + r32;
    const bf16_t* kbase = projb + (size_t)(b * S_) * PB + kcol; const bf16_t* vbase = projb + (size_t)(b * S_) * PB + vcol;
    bf16x8 qf[4];
    { const bf16_t* qptr = projb + (size_t)(b * S_ + tq) * PB + qcol + 8 * hh;
#pragma unroll
      for (int d0 = 0; d0 < 4; ++d0) qf[d0] = *(const bf16x8*)(qptr + 16 * d0);
      if (KIND == 1) {
#pragma unroll
          for (int d0 = 0; d0 < 4; ++d0) { u32x4 w_;
#pragma unroll
              for (int e2 = 0; e2 < 4; ++e2) { const float lo_ = bf2f((unsigned short)qf[d0][2 * e2]) * (SCALE * LOG2E), hi_ = bf2f((unsigned short)qf[d0][2 * e2 + 1]) * (SCALE * LOG2E); w_[e2] = cvtpk(lo_, hi_); }
              qf[d0] = __builtin_bit_cast(bf16x8, w_); } } }
    int j0 = 0; const int j1 = (q0 + nrows - 1) >> 6;
    if (KIND == 1) { j0 = (q0 - 511) >> 6; if (j0 < 0) j0 = 0; }
    const int ntile = j1 - j0 + 1;
    float ct2 = 0.f, sl2 = 0.f; const float* cb = nullptr;
    if (KIND == 0) { cb = WSP(float, O_CFOX) + (size_t)(b * 4 + h) * S_; ct2 = cb[tq] * LOG2E; }
    if (KIND == 1) sl2 = exp2f(-(float)(h + 1)) * LOG2E;
    bf16x8 kx0 = {0, 0, 0, 0, 0, 0, 0, 0}, kx1 = {0, 0, 0, 0, 0, 0, 0, 0}; float sl2h = 0.f, sl2l = 0.f;
    if (KIND == 1) { const unsigned one_ = 0x3f80u; const unsigned k0_ = f2bf((float)r32), k1_ = f2bf((float)(r32 + 32));
        if (hh == 0) { kx0 = __builtin_bit_cast(bf16x8, (u32x4){k0_ | (k0_ << 16), one_ | (one_ << 16), one_, 0u}); kx1 = __builtin_bit_cast(bf16x8, (u32x4){k1_ | (k1_ << 16), one_ | (one_ << 16), one_, 0u}); }
        sl2h = bf2f((unsigned short)f2bf(sl2)); sl2l = sl2 - sl2h; }
    float qkb = 0.f;
    if (KIND == 0) { float qs = 0.f;
#pragma unroll
        for (int d0 = 0; d0 < 4; ++d0)
#pragma unroll
            for (int e = 0; e < 8; ++e) { const float x = bf2f((unsigned short)qf[d0][e]); qs += x * x; }
        qs += __shfl_xor(qs, 32);
        const float km2 = __uint_as_float(kmax2[b * 4 + h]);
        qkb = sqrtf(qs * km2) * (SCALE * LOG2E * 1.01f); }
    const float tqf = (float)tq;
    const int skey = tid >> 3, sch = tid & 7;
    u32x4 rk, rv; float rc = 0.f;
#define E1_LOAD(jj) do { const size_t ro_ = (size_t)((jj) * 64 + skey) * PB + sch * 8; rk = *(const u32x4*)(kbase + ro_); rv = *(const u32x4*)(vbase + ro_); \
        if (KIND == 0 && tid < 64) rc = cb[(jj) * 64 + tid] * LOG2E; } while (0)
#define E1_WRITE(bufp) do { *(LAS u32x4*)((bufp) + E1_K + skey * KROW + sch * 16) = rk; *(LAS u32x4*)((bufp) + E1_V + skey * KROW + sch * 16) = rv; \
        if (KIND == 0 && tid < 64) ((LAS float*)((bufp) + E1_C))[tid] = rc; } while (0)
    f32x16 o0, o1;
#pragma unroll
    for (int r = 0; r < 16; ++r) { o0[r] = 0.f; o1[r] = 0.f; }
    float m = 0.f, l = 0.f, carry = 0.f; bool have = false;
    bool wave_done = false;
    LAS unsigned* flags = (LAS unsigned*)(lds + E1_FLAGS);
    if (KIND != 1) { if (tid < 8) flags[tid] = 0u; }
    __syncthreads();
    E1_LOAD(KIND != 1 ? j1 : j0);
    for (int it = 0; it < ntile; ++it) {
        const int j = (KIND != 1) ? (j1 - it) : (j0 + it);
        LAS unsigned char* buf = lds + (it & 1) * E1_BUF;
        E1_WRITE(buf);
        __syncthreads();
        if (KIND != 1) { unsigned alld = 1u;
#pragma unroll
            for (int i = 0; i < 8; ++i) alld &= flags[i];
            if (alld) break; }
        if (it + 1 < ntile) E1_LOAD((KIND != 1) ? (j - 1) : (j + 1));
        if (!(KIND != 1 && wave_done)) {
            f32x16 p0, p1;
#pragma unroll
            for (int r = 0; r < 16; ++r) { p0[r] = 0.f; p1[r] = 0.f; }
            { const LAS unsigned char* kp_ = buf + E1_K + r32 * KROW + hh * 16;
#pragma unroll
              for (int d0 = 0; d0 < 4; ++d0) { const bf16x8 a0 = *(const LAS bf16x8*)(kp_ + d0 * 32), a1 = *(const LAS bf16x8*)(kp_ + 32 * KROW + d0 * 32);
                  p0 = __builtin_amdgcn_mfma_f32_32x32x16_bf16(a0, qf[d0], p0, 0, 0, 0); p1 = __builtin_amdgcn_mfma_f32_32x32x16_bf16(a1, qf[d0], p1, 0, 0, 0); } }
            const int kb = j * 64 + 4 * hh;
            if (KIND == 2) {
                float lk0[16], lk1[16], gs[8];
#pragma unroll
                for (int reg = 0; reg < 16; ++reg) { const int kpos = kb + CROW(reg, 0);
                    const float z0 = p0[reg] * (SCALE * LOG2E), z1 = p1[reg] * (SCALE * LOG2E); const bool v0 = kpos < tq, v1 = kpos + 32 < tq;
                    const float lb0 = fminf(z0, 0.f) - __builtin_amdgcn_logf(1.f + __builtin_amdgcn_exp2f(-fabsf(z0))), lb1 = fminf(z1, 0.f) - __builtin_amdgcn_logf(1.f + __builtin_amdgcn_exp2f(-fabsf(z1)));
                    lk0[reg] = v0 ? (lb0 - z0) : 0.f; lk1[reg] = v1 ? (lb1 - z1) : 0.f;
                    p0[reg] = v0 ? lb0 : -INFINITY; p1[reg] = v1 ? lb1 : -INFINITY; }
#pragma unroll
                for (int g4 = 0; g4 < 4; ++g4) { gs[g4] = (lk0[4 * g4] + lk0[4 * g4 + 1]) + (lk0[4 * g4 + 2] + lk0[4 * g4 + 3]); gs[4 + g4] = (lk1[4 * g4] + lk1[4 * g4 + 1]) + (lk1[4 * g4 + 2] + lk1[4 * g4 + 3]); }
                float oth[8];
#pragma unroll
                for (int gi = 0; gi < 8; ++gi) oth[gi] = lane32_other(gs[gi], hh);
                float run = 0.f;
#pragma unroll
                for (int gi = 7; gi >= 0; --gi) {
                    float later = carry + run + (hh == 0 ? oth[gi] : 0.f);
#pragma unroll
                    for (int e = 3; e >= 0; --e) { const int reg = (gi & 3) * 4 + e;
                        if (gi >> 2) { p1[reg] = __builtin_amdgcn_exp2f(p1[reg] + later); later += lk1[reg]; } else { p0[reg] = __builtin_amdgcn_exp2f(p0[reg] + later); later += lk0[reg]; } }
                    run += gs[gi] + oth[gi]; }
                carry += run;
            } else {
                if (KIND == 0) {
                    const LAS float* cs = (const LAS float*)(buf + E1_C) + 4 * hh; const float ctm = ct2 - m;
#pragma unroll
                    for (int i = 0; i < 4; ++i) { const f32x4 c0 = *(const LAS f32x4*)(cs + 8 * i), c1 = *(const LAS f32x4*)(cs + 32 + 8 * i);
#pragma unroll
                        for (int e = 0; e < 4; ++e) { const int reg = 4 * i + e; p0[reg] = p0[reg] * (SCALE * LOG2E) + (ctm - c0[e]); p1[reg] = p1[reg] * (SCALE * LOG2E) + (ctm - c1[e]); } }
                    if (!(j * 64 + 63 <= qrow0)) {
#pragma unroll
                        for (int reg = 0; reg < 16; ++reg) { const int kpos = kb + CROW(reg, 0); p0[reg] = (kpos <= tq) ? p0[reg] : -INFINITY; p1[reg] = (kpos + 32 <= tq) ? p1[reg] : -INFINITY; } }
                } else {
                    { const float r_ = sl2 * ((float)(j * 64) - tqf) - m; const float rh_ = bf2f((unsigned short)f2bf(r_)), rm2_ = bf2f((unsigned short)f2bf(r_ - rh_)), rl_ = (r_ - rh_) - rm2_;
                      u32x4 qx_ = {0u, 0u, 0u, 0u}; if (hh == 0) qx_ = (u32x4){cvtpk(sl2h, sl2l), cvtpk(rh_, rm2_), cvtpk(rl_, 0.f), 0u};
                      const bf16x8 qx = __builtin_bit_cast(bf16x8, qx_);
                      p0 = __builtin_amdgcn_mfma_f32_32x32x16_bf16(kx0, qx, p0, 0, 0, 0); p1 = __builtin_amdgcn_mfma_f32_32x32x16_bf16(kx1, qx, p1, 0, 0, 0); }
                    if (!(j * 64 + 63 <= qrow0 && qrow0 + 31 - j * 64 < 512)) {
#pragma unroll
                        for (int reg = 0; reg < 16; ++reg) { const int kpos = kb + CROW(reg, 0);
                            p0[reg] = (kpos <= tq && tq - kpos < 512) ? p0[reg] : -INFINITY; p1[reg] = (kpos + 32 <= tq && tq - kpos - 32 < 512) ? p1[reg] : -INFINITY; } }
                }
                SM_CORE(p0, p1, m, l, have, o0, o1);
            }
            { const int gq_ = lane >> 4, li_ = lane & 15;
              const LAS unsigned char* tb = buf + E1_V + (4 * hh + (li_ >> 2)) * KROW + (16 * (gq_ & 1) + 4 * (li_ & 3)) * 2;
#pragma unroll
              for (int s = 0; s < 4; ++s) {
                  u32x4 pw;
                  if (s < 2) { pw.x = cvtpk(p0[8 * s + 0], p0[8 * s + 1]); pw.y = cvtpk(p0[8 * s + 2], p0[8 * s + 3]); pw.z = cvtpk(p0[8 * s + 4], p0[8 * s + 5]); pw.w = cvtpk(p0[8 * s + 6], p0[8 * s + 7]); }
                  else { const int s2 = s - 2; pw.x = cvtpk(p1[8 * s2 + 0], p1[8 * s2 + 1]); pw.y = cvtpk(p1[8 * s2 + 2], p1[8 * s2 + 3]); pw.z = cvtpk(p1[8 * s2 + 4], p1[8 * s2 + 5]); pw.w = cvtpk(p1[8 * s2 + 6], p1[8 * s2 + 7]); }
                  const bf16x8 pb = __builtin_bit_cast(bf16x8, pw);
                  const v4i16_t a0l = __builtin_amdgcn_ds_read_tr16_b64_v4i16((LAS v4i16_t*)(tb + (16 * s) * KROW)), a0h = __builtin_amdgcn_ds_read_tr16_b64_v4i16((LAS v4i16_t*)(tb + (16 * s + 8) * KROW));
                  const v4i16_t a1l = __builtin_amdgcn_ds_read_tr16_b64_v4i16((LAS v4i16_t*)(tb + (16 * s) * KROW + 64)), a1h = __builtin_amdgcn_ds_read_tr16_b64_v4i16((LAS v4i16_t*)(tb + (16 * s + 8) * KROW + 64));
                  const bf16x8 va0 = (bf16x8){a0l[0], a0l[1], a0l[2], a0l[3], a0h[0], a0h[1], a0h[2], a0h[3]}, va1 = (bf16x8){a1l[0], a1l[1], a1l[2], a1l[3], a1h[0], a1h[1], a1h[2], a1h[3]};
                  o0 = __builtin_amdgcn_mfma_f32_32x32x16_bf16(va0, pb, o0, 0, 0, 0); o1 = __builtin_amdgcn_mfma_f32_32x32x16_bf16(va1, pb, o1, 0, 0, 0); } }
            if (KIND == 0) {
                const float c0 = *(const LAS float*)(buf + E1_C); const bool dn = __all(have && (qkb + (ct2 - c0) - m < -150.f));
                if (dn && !wave_done) { wave_done = true; if (lane == 0) flags[w] = 1u; } }
            if (KIND == 2) { const bool dn = __all(carry < -110.f * LOG2E);
                if (dn && !wave_done) { wave_done = true; if (lane == 0) flags[w] = 1u; } }
        }
    }
    float inv = 1.f, gate = 1.f;
    if (KIND != 2) { l += __shfl_xor(l, 32); inv = (l > 0.f) ? 1.f / l : 0.f; }
    bf16_t* orow;
    if (KIND == 0) orow = obase + (size_t)(b * S_ + tq) * D_ + 512 + h * 64;
    else if (KIND == 2) orow = obase + (size_t)(b * S_ + tq) * D_ + 768 + h * 64;
    else { orow = owin + (size_t)(b * S_ + tq) * 512 + h * 64; gate = WSP(float, O_GF)[(size_t)(b * S_ + tq) * 32 + 2 * 8 + h]; }
    const float sc = inv * gate;
#pragma unroll
    for (int i = 0; i < 4; ++i) {
        *(u32x2*)(orow + 8 * i + 4 * hh) = (u32x2){cvtpk(o0[4 * i] * sc, o0[4 * i + 1] * sc), cvtpk(o0[4 * i + 2] * sc, o0[4 * i + 3] * sc)};
        *(u32x2*)(orow + 32 + 8 * i + 4 * hh) = (u32x2){cvtpk(o1[4 * i] * sc, o1[4 * i + 1] * sc), cvtpk(o1[4 * i + 2] * sc, o1[4 * i + 3] * sc)}; }
#undef E1_LOAD
#undef E1_WRITE
}
}
namespace mk {
constexpr int E2_VT = 64 * 128;
constexpr int E2_WAVE = 2 * E2_VT + 512 + 128;
template <bool USE_MASK>
__device__ __forceinline__ void e2_wave_unit(LAS unsigned char* ldsw, KP p, int b, int g, int t0, bf16_t* __restrict__ obase, const bf16_t* __restrict__ csrc, int cpitch) {
    const int lane = ftid() & 63, r32 = lane & 31, hh = lane >> 5, qi = r32 >> 2, r4 = r32 & 3;
    const int h = 4 * g + r4, tq = t0 + qi;
    const bf16_t* projb = WSP(bf16_t, O_PROJB);
    const bf16_t* kbase = projb + (size_t)(b * S_) * PB + C_KV + ((1 * 2 + 0) * 2 + g) * 64;
    const bf16_t* vbase = projb + (size_t)(b * S_) * PB + C_KV + ((1 * 2 + 1) * 2 + g) * 64;
    bf16x8 qf[4];
    { const bf16_t* qptr = projb + (size_t)(b * S_ + tq) * PB + h * 64 + 8 * hh;
#pragma unroll
      for (int d0 = 0; d0 < 4; ++d0) qf[d0] = *(const bf16x8*)(qptr + 16 * d0); }
    unsigned qm0 = 0u, qm1 = 0u, qm2 = 0u, qm3 = 0u;
    if (USE_MASK) { const u32x4 mw = *(const u32x4*)(WSP(unsigned, O_SELMASK) + ((size_t)((b * 2 + g) * S_ + t0 + (lane >> 3))) * 4); qm0 = mw.x; qm1 = mw.y; qm2 = mw.z; qm3 = mw.w; }
    else { const int* sp = WSP(int, O_SEL) + ((size_t)((b * 2 + g) * S_ + t0)) * NSEL + lane * 2;
      const int e0 = sp[0], e1 = sp[1];
#pragma unroll
      for (int k = 0; k < 2; ++k) { const int e = k ? e1 : e0; const unsigned bit = 1u << (e & 31); const int wd = e >> 5;
          qm0 |= (wd == 0) ? bit : 0u; qm1 |= (wd == 1) ? bit : 0u; qm2 |= (wd == 2) ? bit : 0u; qm3 |= (wd == 3) ? bit : 0u; }
#pragma unroll
      for (int o = 1; o < 8; o <<= 1) { qm0 |= __shfl_xor(qm0, o); qm1 |= __shfl_xor(qm1, o); qm2 |= __shfl_xor(qm2, o); qm3 |= __shfl_xor(qm3, o); } }
    unsigned um0 = qm0, um1 = qm1, um2 = qm2, um3 = qm3;
#pragma unroll
    for (int o = 8; o < 64; o <<= 1) { um0 |= __shfl_xor(um0, o); um1 |= __shfl_xor(um1, o); um2 |= __shfl_xor(um2, o); um3 |= __shfl_xor(um3, o); }
    LAS int* list = (LAS int*)(ldsw + 2 * E2_VT);
    LAS unsigned* rowml = (LAS unsigned*)(ldsw + 2 * E2_VT + 512);
    if ((lane & 7) == 0) *(LAS u32x4*)(rowml + (lane >> 3) * 4) = (u32x4){qm0, qm1, qm2, qm3};
    const LAS unsigned* rowm = rowml + qi * 4;
    int nblk;
    const int curq = __builtin_amdgcn_readfirstlane(t0 >> 6);
    bool diag;
    { const bool s0 = ((((lane < 32) ? um0 : um1) >> (lane & 31)) & 1u) && lane <= curq, s1 = ((((lane < 32) ? um2 : um3) >> (lane & 31)) & 1u) && lane + 64 <= curq;
      const unsigned long long b0 = __ballot(s0), b1 = __ballot(s1);
      const unsigned long long lower = (lane == 0) ? 0ull : (~0ull >> (64 - lane));
      const int n0 = __popcll(b0);
      if (s0) list[__popcll(b0 & lower)] = lane;
      if (s1) list[n0 + __popcll(b1 & lower)] = lane + 64;
      nblk = n0 + __popcll(b1); diag = (((curq < 64) ? (b0 >> curq) : (b1 >> (curq - 64))) & 1ull) != 0ull; }
    const int nfull = nblk - (diag ? 1 : 0);
    asm volatile("s_waitcnt lgkmcnt(0)" ::: "memory");
    const float sl2 = exp2f(-(float)(h + 1)) * LOG2E, tqf = (float)tq;
    f32x16 o0, o1;
#pragma unroll
    for (int r = 0; r < 16; ++r) { o0[r] = 0.f; o1[r] = 0.f; }
    float m = 0.f, l = 0.f; bool have = false;
    const int vrow = lane >> 3, vch = lane & 7;
    const int gq = lane >> 4, li = lane & 15;
    const LAS unsigned char* trb = ldsw + (4 * hh + (li >> 2)) * 128 + (16 * (gq & 1) + 4 * (li & 3)) * 2;
    bf16x8 ka0[4], ka1[4], kb0[4], kb1[4];
#define E2_LOADK(blk, k0_, k1_) do { const bf16_t* kp_ = kbase + (size_t)((blk) * 64 + r32) * PB + 8 * hh; \
        _Pragma("unroll") for (int d0 = 0; d0 < 4; ++d0) { k0_[d0] = *(const bf16x8*)(kp_ + 16 * d0); k1_[d0] = *(const bf16x8*)(kp_ + (size_t)32 * PB + 16 * d0); } } while (0)
#define E2_VDMA(blk, vb_) do { const bf16_t* vp_ = vbase + (size_t)((blk) * 64 + vrow) * PB + vch * 8; \
        _Pragma("unroll") for (int i = 0; i < 8; ++i) __builtin_amdgcn_global_load_lds((const unsigned*)(vp_ + (size_t)(8 * i) * PB), (LAS unsigned*)((vb_) + i * 1024), 16, 0, 0); } while (0)
    { const int b0_ = __builtin_amdgcn_readfirstlane(list[0]);
      E2_VDMA(b0_, ldsw); E2_LOADK(b0_, ka0, ka1);
      { const int b1_ = __builtin_amdgcn_readfirstlane(list[(nblk > 1) ? 1 : 0]); E2_LOADK(b1_, kb0, kb1); } }
    int it = 0;
    auto body = [&](auto mtag_, auto ptag_) __attribute__((always_inline)) {
        constexpr bool MASKED_ = decltype(mtag_)::value; constexpr bool PAR_ = decltype(ptag_)::value;
        const int cur = __builtin_amdgcn_readfirstlane(list[it]);
        const unsigned rw = rowm[cur >> 5];
        LAS unsigned char* vcur = ldsw + (PAR_ ? E2_VT : 0); LAS unsigned char* voth = ldsw + (PAR_ ? 0 : E2_VT);
        { const int nb_ = __builtin_amdgcn_readfirstlane(list[(it + 1 < nblk) ? it + 1 : nblk - 1]); E2_VDMA(nb_, voth); }
        const int nb2_ = __builtin_amdgcn_readfirstlane(list[(it + 2 < nblk) ? it + 2 : nblk - 1]);
        f32x16 p0, p1;
#pragma unroll
        for (int r = 0; r < 16; ++r) { p0[r] = 0.f; p1[r] = 0.f; }
        if (PAR_) {
#pragma unroll
            for (int d0 = 0; d0 < 4; ++d0) { p0 = __builtin_amdgcn_mfma_f32_32x32x16_bf16(kb0[d0], qf[d0], p0, 0, 0, 0); p1 = __builtin_amdgcn_mfma_f32_32x32x16_bf16(kb1[d0], qf[d0], p1, 0, 0, 0); }
            asm volatile("" : "+v"(p0), "+v"(p1) :: "memory");
            E2_LOADK(nb2_, kb0, kb1);
        } else {
#pragma unroll
            for (int d0 = 0; d0 < 4; ++d0) { p0 = __builtin_amdgcn_mfma_f32_32x32x16_bf16(ka0[d0], qf[d0], p0, 0, 0, 0); p1 = __builtin_amdgcn_mfma_f32_32x32x16_bf16(ka1[d0], qf[d0], p1, 0, 0, 0); }
            asm volatile("" : "+v"(p0), "+v"(p1) :: "memory");
            E2_LOADK(nb2_, ka0, ka1);
        }
        const bool rowsel = (rw >> (cur & 31)) & 1u;
        const int kb = cur * 64 + 4 * hh;
        { const float basef = rowsel ? (sl2 * ((float)kb - tqf) - m) : -INFINITY, base1 = basef + 32.f * sl2;
#pragma unroll
          for (int reg = 0; reg < 16; ++reg) { p0[reg] = p0[reg] * (SCALE * LOG2E) + __builtin_fmaf(sl2, (float)CROW(reg, 0), basef); p1[reg] = p1[reg] * (SCALE * LOG2E) + __builtin_fmaf(sl2, (float)CROW(reg, 0), base1); } }
        if (MASKED_) {
#pragma unroll
            for (int reg = 0; reg < 16; ++reg) { const int kpos = kb + CROW(reg, 0); p0[reg] = (kpos <= tq) ? p0[reg] : -INFINITY; p1[reg] = (kpos + 32 <= tq) ? p1[reg] : -INFINITY; } }
        SM_CORE(p0, p1, m, l, have, o0, o1);
        asm volatile("s_waitcnt vmcnt(16)" ::: "memory");
        const LAS unsigned char* trv = trb + (PAR_ ? E2_VT : 0);
#pragma unroll
        for (int s = 0; s < 4; ++s) {
            u32x4 pw;
            if (s < 2) { pw.x = cvtpk(p0[8 * s + 0], p0[8 * s + 1]); pw.y = cvtpk(p0[8 * s + 2], p0[8 * s + 3]); pw.z = cvtpk(p0[8 * s + 4], p0[8 * s + 5]); pw.w = cvtpk(p0[8 * s + 6], p0[8 * s + 7]); }
            else { const int s2 = s - 2; pw.x = cvtpk(p1[8 * s2 + 0], p1[8 * s2 + 1]); pw.y = cvtpk(p1[8 * s2 + 2], p1[8 * s2 + 3]); pw.z = cvtpk(p1[8 * s2 + 4], p1[8 * s2 + 5]); pw.w = cvtpk(p1[8 * s2 + 6], p1[8 * s2 + 7]); }
            const bf16x8 pb = __builtin_bit_cast(bf16x8, pw);
            const v4i16_t a0l = __builtin_amdgcn_ds_read_tr16_b64_v4i16((LAS v4i16_t*)(trv + (16 * s) * 128)), a0h = __builtin_amdgcn_ds_read_tr16_b64_v4i16((LAS v4i16_t*)(trv + (16 * s + 8) * 128));
            const v4i16_t a1l = __builtin_amdgcn_ds_read_tr16_b64_v4i16((LAS v4i16_t*)(trv + (16 * s) * 128 + 64)), a1h = __builtin_amdgcn_ds_read_tr16_b64_v4i16((LAS v4i16_t*)(trv + (16 * s + 8) * 128 + 64));
            const bf16x8 va0 = (bf16x8){a0l[0], a0l[1], a0l[2], a0l[3], a0h[0], a0h[1], a0h[2], a0h[3]}, va1 = (bf16x8){a1l[0], a1l[1], a1l[2], a1l[3], a1h[0], a1h[1], a1h[2], a1h[3]};
            o0 = __builtin_amdgcn_mfma_f32_32x32x16_bf16(va0, pb, o0, 0, 0, 0); o1 = __builtin_amdgcn_mfma_f32_32x32x16_bf16(va1, pb, o1, 0, 0, 0); }
        asm volatile("" ::: "memory");
    };
    for (; it + 1 < nfull; it += 2) { body(std::false_type{}, std::false_type{}); ++it; body(std::false_type{}, std::true_type{}); --it; }
    if (it < nfull) { body(std::false_type{}, std::false_type{}); ++it; if (diag) body(std::true_type{}, std::true_type{}); }
    else if (diag) body(std::true_type{}, std::false_type{});
    asm volatile("s_waitcnt vmcnt(0)" ::: "memory");
#undef E2_LOADK
#undef E2_VDMA
    l += __shfl_xor(l, 32);
    const float sc = ((l > 0.f) ? 1.f / l : 0.f) * WSP(float, O_GF)[(size_t)(b * S_ + tq) * 32 + 1 * 8 + h];
    bf16_t* orow = obase + (size_t)(b * S_ + tq) * D_ + h * 64; const bf16_t* crow = csrc + (size_t)(b * S_ + tq) * cpitch + h * 64;
#pragma unroll
    for (int i = 0; i < 4; ++i) {
        const u32x2 c0 = *(const u32x2*)(crow + 8 * i + 4 * hh), c1 = *(const u32x2*)(crow + 32 + 8 * i + 4 * hh);
        const float x00 = __uint_as_float(c0.x << 16) + o0[4 * i] * sc, x01 = __uint_as_float(c0.x & 0xffff0000u) + o0[4 * i + 1] * sc, x02 = __uint_as_float(c0.y << 16) + o0[4 * i + 2] * sc, x03 = __uint_as_float(c0.y & 0xffff0000u) + o0[4 * i + 3] * sc;
        const float x10 = __uint_as_float(c1.x << 16) + o1[4 * i] * sc, x11 = __uint_as_float(c1.x & 0xffff0000u) + o1[4 * i + 1] * sc, x12 = __uint_as_float(c1.y << 16) + o1[4 * i + 2] * sc, x13 = __uint_as_float(c1.y & 0xffff0000u) + o1[4 * i + 3] * sc;
        *(u32x2*)(orow + 8 * i + 4 * hh) = (u32x2){cvtpk(x00, x01), cvtpk(x02, x03)}; *(u32x2*)(orow + 32 + 8 * i + 4 * hh) = (u32x2){cvtpk(x10, x11), cvtpk(x12, x13)}; }
}
template <bool USE_MASK>
__device__ __forceinline__ void ph_attn_sel2(LAS unsigned char* lds3, KP p, bf16_t* __restrict__ obase, const bf16_t* __restrict__ csrc, int cpitch) {
    const int w = __builtin_amdgcn_readfirstlane(ftid() >> 6);
    LAS unsigned char* ldsw = lds3 + w * E2_WAVE;
    MK_LOOP(u, 512) { const int bg = u & 3, qblk = u >> 2; e2_wave_unit<USE_MASK>(ldsw, p, bg >> 1, bg & 1, qblk * 64 + 8 * w, obase, csrc, cpitch); }
}
}
namespace mk {
constexpr int E3_K = 0, E3_V = 512 * KROW, E3_BYTES = 2 * 512 * KROW;
__device__ __forceinline__ void e3_unit(LAS unsigned char* lds, KP p, int b, int g, int qb, bf16_t* __restrict__ ocmp, unsigned* __restrict__ selmask) {
    const int tid = ftid(), lane = tid & 63, w = __builtin_amdgcn_readfirstlane(tid >> 6), r32 = lane & 31, hh = lane >> 5;
    const int bg = b * 2 + g, q0 = qb * 256, qrow0 = q0 + 32 * w, tq = qrow0 + r32;
    const bf16_t* projb = WSP(bf16_t, O_PROJB);
    int nun = (q0 + 255 - 31) / 16 + 1; if (nun > 511) nun = 511;
    const int ntile_u = (nun + 63) >> 6;
    __syncthreads();
    { const int srow = tid >> 3, sch = tid & 7; const bf16_t* ks = WSP(bf16_t, O_KCMPB) + ((size_t)bg * 512 + srow) * 64 + sch * 8; const bf16_t* vs = WSP(bf16_t, O_VCMPB) + ((size_t)bg * 512 + srow) * 64 + sch * 8;
      for (int i = 0; i < ntile_u; ++i) { const u32x4 kv = *(const u32x4*)(ks + (size_t)i * 64 * 64), vv = *(const u32x4*)(vs + (size_t)i * 64 * 64);
          *(LAS u32x4*)(lds + E3_K + (srow + 64 * i) * KROW + sch * 16) = kv; *(LAS u32x4*)(lds + E3_V + (srow + 64 * i) * KROW + sch * 16) = vv; } }
    __syncthreads();
    int nw = qrow0 / 16 + 1; if (nw > 511) nw = 511;
    const int ntile_w = (qrow0 + 31 < 31) ? 0 : ((nw + 63) >> 6);
    const float tqf = (float)tq;
    const int gq = lane >> 4, li = lane & 15;
    const LAS unsigned char* trb = lds + E3_V + (4 * hh + (li >> 2)) * KROW + (16 * (gq & 1) + 4 * (li & 3)) * 2;
    const LAS unsigned char* kfb = lds + E3_K + r32 * KROW + hh * 16;
    float imp[64];
#pragma unroll
    for (int i = 0; i < 64; ++i) imp[i] = 0.f;
#pragma unroll 1
    for (int r4 = 0; r4 < 4; ++r4) {
        const int h = 4 * g + r4; const float sl2 = exp2f(-(float)(h + 1)) * LOG2E;
        const unsigned qoff = (unsigned)((b * S_ + tq) * PB + h * 64 + 8 * hh);
        f32x16 o0, o1;
#pragma unroll
        for (int r = 0; r < 16; ++r) { o0[r] = 0.f; o1[r] = 0.f; }
        float m = 0.f, l = 0.f; bool have = false;
#define E3_ST(jt) f32x16 p0, p1; { bf16x8 qf[4]; _Pragma("unroll") for (int d0 = 0; d0 < 4; ++d0) qf[d0] = *(const bf16x8*)(projb + qoff + 16 * d0); \
            _Pragma("unroll") for (int r = 0; r < 16; ++r) { p0[r] = 0.f; p1[r] = 0.f; } \
            _Pragma("unroll") for (int d0 = 0; d0 < 4; ++d0) { const bf16x8 a0 = *(const LAS bf16x8*)(kfb + (64 * (jt)) * KROW + d0 * 32), a1 = *(const LAS bf16x8*)(kfb + (64 * (jt) + 32) * KROW + d0 * 32); \
                p0 = __builtin_amdgcn_mfma_f32_32x32x16_bf16(a0, qf[d0], p0, 0, 0, 0); p1 = __builtin_amdgcn_mfma_f32_32x32x16_bf16(a1, qf[d0], p1, 0, 0, 0); } \
            int tq_ = tq; asm volatile("" : "+v"(tq_));     \
            int hh_ = hh; asm volatile("" : "+v"(hh_)); \
            const float tqf_ = (float)tq_; const int ce0_ = 16 * (64 * (jt) + 4 * hh_) + 31; \
            const float basef_ = sl2 * ((float)ce0_ - tqf_) - m, base1_ = basef_ + 512.f * sl2; \
            _Pragma("unroll") for (int reg = 0; reg < 16; ++reg) { const float cr_ = sl2 * (float)(16 * CROW(reg, 0)); p0[reg] = p0[reg] * (SCALE * LOG2E) + (basef_ + cr_); p1[reg] = p1[reg] * (SCALE * LOG2E) + (base1_ + cr_); } \
            if (ce0_ + 16 * 27 + 512 > qrow0) {     \
                _Pragma("unroll") for (int reg = 0; reg < 16; ++reg) { const int ce = ce0_ + 16 * CROW(reg, 0); p0[reg] = (ce <= tq_) ? p0[reg] : -INFINITY; p1[reg] = (ce + 512 <= tq_) ? p1[reg] : -INFINITY; } } }
        float imh[64];
#pragma unroll
        for (int i = 0; i < 64; ++i) imh[i] = 0.f;
#pragma unroll
        for (int jt = 0; jt < 8; ++jt) {
            if (jt < ntile_w) {
                E3_ST(jt);
                {
                    float rm_; SM_ROWMAX(p0, p1, rm_);
                    const bool fin_ = rm_ > -1e37f;
                    if (__any((rm_ > RESC_THR) || (!have && fin_))) {
                        const float dl_ = have ? fmaxf(rm_, 0.f) : (fin_ ? rm_ : 0.f); const float al_ = have ? __builtin_amdgcn_exp2f(-dl_) : 1.f;
                        m += dl_; l *= al_; have = have || fin_;
#pragma unroll
                        for (int r_ = 0; r_ < 16; ++r_) { o0[r_] *= al_; o1[r_] *= al_; p0[r_] -= dl_; p1[r_] -= dl_; }
#pragma unroll
                        for (int i = 0; i < 64; ++i) imh[i] *= al_; }
                    float ls_ = 0.f;
#pragma unroll
                    for (int reg_ = 0; reg_ < 16; ++reg_) { p0[reg_] = __builtin_amdgcn_exp2f(p0[reg_]); p1[reg_] = __builtin_amdgcn_exp2f(p1[reg_]); ls_ += p0[reg_] + p1[reg_]; }
                    l += ls_; }
#pragma unroll
                for (int pa = 0; pa < 2; ++pa)
#pragma unroll
                    for (int i = 0; i < 4; ++i) { const int jj = 8 * jt + 4 * pa + i;
                        const float x0 = pa ? p1[4 * i] : p0[4 * i], x1 = pa ? p1[4 * i + 1] : p0[4 * i + 1], x2 = pa ? p1[4 * i + 2] : p0[4 * i + 2], x3 = pa ? p1[4 * i + 3] : p0[4 * i + 3];
                        const float c = 0.5f * x3, a = (x0 + x1) + (x2 + c), r = lane32_other(c, hh);
                        imh[jj] += a + (hh ? r : 0.f);
                        if (jj + 1 < 64) imh[jj + 1] += (hh ? 0.f : r); }
                const LAS unsigned char* tb = trb + (64 * jt) * KROW;
#pragma unroll
                for (int s = 0; s < 4; ++s) {
                    u32x4 pw;
                    if (s < 2) { pw.x = cvtpk(p0[8 * s + 0], p0[8 * s + 1]); pw.y = cvtpk(p0[8 * s + 2], p0[8 * s + 3]); pw.z = cvtpk(p0[8 * s + 4], p0[8 * s + 5]); pw.w = cvtpk(p0[8 * s + 6], p0[8 * s + 7]); }
                    else { const int s2 = s - 2; pw.x = cvtpk(p1[8 * s2 + 0], p1[8 * s2 + 1]); pw.y = cvtpk(p1[8 * s2 + 2], p1[8 * s2 + 3]); pw.z = cvtpk(p1[8 * s2 + 4], p1[8 * s2 + 5]); pw.w = cvtpk(p1[8 * s2 + 6], p1[8 * s2 + 7]); }
                    const bf16x8 pb = __builtin_bit_cast(bf16x8, pw);
                    const v4i16_t a0l = __builtin_amdgcn_ds_read_tr16_b64_v4i16((LAS v4i16_t*)(tb + (16 * s) * KROW)), a0h = __builtin_amdgcn_ds_read_tr16_b64_v4i16((LAS v4i16_t*)(tb + (16 * s + 8) * KROW));
                    const v4i16_t a1l = __builtin_amdgcn_ds_read_tr16_b64_v4i16((LAS v4i16_t*)(tb + (16 * s) * KROW + 64)), a1h = __builtin_amdgcn_ds_read_tr16_b64_v4i16((LAS v4i16_t*)(tb + (16 * s + 8) * KROW + 64));
                    const bf16x8 va0 = (bf16x8){a0l[0], a0l[1], a0l[2], a0l[3], a0h[0], a0h[1], a0h[2], a0h[3]}, va1 = (bf16x8){a1l[0], a1l[1], a1l[2], a1l[3], a1h[0], a1h[1], a1h[2], a1h[3]};
                    o0 = __builtin_amdgcn_mfma_f32_32x32x16_bf16(va0, pb, o0, 0, 0, 0); o1 = __builtin_amdgcn_mfma_f32_32x32x16_bf16(va1, pb, o1, 0, 0, 0); }
            }
        }
        l += __shfl_xor(l, 32);
        const float inv = (l > 0.f) ? 1.f / l : 0.f;
#pragma unroll
        for (int i = 0; i < 64; ++i) imp[i] += imh[i] * inv;
        { const float sc = inv * WSP(float, O_GF)[(size_t)(b * S_ + tq) * 32 + 0 * 8 + h];
          bf16_t* orow = ocmp + (size_t)(b * S_ + tq) * 512 + h * 64;
#pragma unroll
          for (int i = 0; i < 4; ++i) {
              *(u32x2*)(orow + 8 * i + 4 * hh) = (u32x2){cvtpk(o0[4 * i] * sc, o0[4 * i + 1] * sc), cvtpk(o0[4 * i + 2] * sc, o0[4 * i + 3] * sc)};
              *(u32x2*)(orow + 32 + 8 * i + 4 * hh) = (u32x2){cvtpk(o1[4 * i] * sc, o1[4 * i + 1] * sc), cvtpk(o1[4 * i + 2] * sc, o1[4 * i + 3] * sc)}; } }
#undef E3_ST
    }
    const int cur = tq >> 6;
#pragma unroll
    for (int jj = 0; jj < 64; ++jj) { const int j = 2 * jj + hh; imp[jj] = (j != 0 && j < cur - 1) ? imp[jj] : -1.f; }
    unsigned m0 = 1u, m1 = 0u, m2 = 0u, m3 = 0u;
#define E3_SETBIT(j) do { const unsigned bit_ = 1u << ((j) & 31); const int wd_ = (j) >> 5; m0 |= (wd_ == 0) ? bit_ : 0u; m1 |= (wd_ == 1) ? bit_ : 0u; m2 |= (wd_ == 2) ? bit_ : 0u; m3 |= (wd_ == 3) ? bit_ : 0u; } while (0)
    E3_SETBIT(cur); if (cur >= 1) E3_SETBIT(cur - 1);
#pragma unroll 1
    for (int it = 0; it < NSEL - 3; ++it) {
        float best = -0.5f; int bj = 0;
#pragma unroll
        for (int jj = 0; jj < 64; ++jj) { if (imp[jj] > best) { best = imp[jj]; bj = jj; } }
        const int myj = 2 * bj + hh; const float ob = __shfl_xor(best, 32); const int oj = __shfl_xor(myj, 32);
        const bool mine = (best > ob) || (best == ob && myj < oj);
        const float wv = mine ? best : ob; const int wj = mine ? myj : oj;
        if (wv >= 0.f) E3_SETBIT(wj);
        if (mine && best >= 0.f) {
#pragma unroll
            for (int jj = 0; jj < 64; ++jj) imp[jj] = (jj == bj) ? -2.f : imp[jj]; }
    }
#undef E3_SETBIT
    if (hh == 0) *(u32x4*)(selmask + ((size_t)bg * S_ + tq) * 4) = (u32x4){m0, m1, m2, m3};
}
}
namespace mk {
constexpr int SB_EARLY = 216;
template <int MODE>
__device__ __forceinline__ void ph_attn1(float* lds, LAS unsigned char* lds3, KP p, unsigned* qctr, bf16_t* obase, bf16_t* owin, const unsigned* kmax2) {
    LAS int* qslot = (LAS int*)(lds3 + E3_BYTES);
    constexpr int N_E3 = (MODE & 2) ? 128 : 0, N_CMP = (MODE & 1) ? 64 : 0, N_FOX = (MODE & 4) ? 256 : 0, N_WIN = (MODE & 8) ? 512 : 0, N_SB = (MODE & 16) ? (256 - SB_EARLY) : 0;
    for (;;) {
        __syncthreads();
        if (ftid() == 0) *qslot = (int)atomicAdd(qctr, 1u);
        __syncthreads();
        int u = __builtin_amdgcn_readfirstlane(*qslot);
        if (u >= N_E3 + N_CMP + N_FOX + N_WIN + N_SB) break;
        if (u < N_E3) { e3_unit(lds3, p, (u & 3) >> 1, u & 1, 31 - (u >> 2), WSP(bf16_t, O_OCMP), WSP(unsigned, O_SELMASK)); continue; } u -= N_E3;
        if (u < N_FOX) { e1_unit<0>(lds3, p, (u & 7) >> 2, u & 3, 31 - (u >> 3), obase, owin, kmax2); continue; } u -= N_FOX;
        if (u < N_WIN) { e1_unit<1>(lds3, p, (u & 3) >> 1, u & 1, 127 - (u >> 2), obase, owin, kmax2); continue; } u -= N_WIN;
        if (u < N_SB) { u += SB_EARLY; e1_unit<2>(lds3, p, (u & 7) >> 2, u & 3, 31 - (u >> 3), obase, owin, kmax2); }
    }
}
__device__ __forceinline__ void ph_sb_early(LAS unsigned char* lds3, KP p) {
    const int u = fbid() - 40; if (u < 0 || u >= SB_EARLY) return;
    e1_unit<2>(lds3, p, (u & 7) >> 2, u & 3, 31 - (u >> 3), WSP(bf16_t, O_O), WSP(bf16_t, O_OWIN), nullptr);
}
}
namespace mk {
#define RLX_AGENT __ATOMIC_RELAXED, __HIP_MEMORY_SCOPE_AGENT
#define XB_TMO      128
#define XB_XCNT(j)  (256  + 64 * (j))
#define XB_XSUB(j)  (1280 + 64 * (j))
#define XB_XGEN(j)  (2304 + 64 * (j))
#define XB_TOP      3328
#define XB_TOPGEN   3392
#define XCD_BAR_WORDS 3456
#define XB_SPIN_CAP (1u << 18)

__device__ __forceinline__ unsigned xb_ld(unsigned* p)              { return __hip_atomic_load(p, __ATOMIC_RELAXED, __HIP_MEMORY_SCOPE_AGENT); }
__device__ __forceinline__ unsigned xb_add(unsigned* p, unsigned v) { return __hip_atomic_fetch_add(p, v, __ATOMIC_RELAXED, __HIP_MEMORY_SCOPE_AGENT); }
__device__ __forceinline__ unsigned xb_xcc_id() { return (unsigned)__builtin_amdgcn_s_getreg((3 << 11) | 20) & 0xFu; }
#define XB_SPIN(cond, bar) do { unsigned _sp = 0; while (cond) { __builtin_amdgcn_s_sleep(1); \
    if ((++_sp & 255u) == 0u) { if (xb_ld(&(bar)[XB_TMO])) break; if (_sp > XB_SPIN_CAP) { atomicAdd(&(bar)[XB_TMO], 1u); break; } } } } while (0)

struct XcdBarrier {
    unsigned* bar; unsigned x;
    volatile LAS unsigned* st;
};

__device__ __forceinline__ XcdBarrier xcd_barrier_post(unsigned* bar, volatile LAS unsigned* st) {
    XcdBarrier b; b.bar = bar; b.x = xb_xcc_id(); b.st = st;
    if (threadIdx.x == 0) (void)xb_add(&bar[XB_XCNT(b.x)], 1u);
    return b;
}
__device__ __forceinline__ void xcd_barrier_complete(unsigned* bar, unsigned x, unsigned& nloc, unsigned& nx) {
    const unsigned G = gridDim.x * gridDim.y * gridDim.z;
    unsigned sum, cnt, mine, sp = 0u;
    for (;;) {
        sum = 0u; cnt = 0u; mine = 0u;
#pragma unroll
        for (unsigned j = 0; j < 16; ++j) { const unsigned c = xb_ld(&bar[XB_XCNT(j)]); sum += c; cnt += (c > 0u) ? 1u : 0u; mine = (j == x) ? c : mine; }
        if (sum == G) break;
        __builtin_amdgcn_s_sleep(1);
        if ((++sp & 255u) == 0u) { if (xb_ld(&bar[XB_TMO])) break; if (sp > XB_SPIN_CAP) { atomicAdd(&bar[XB_TMO], 1u); break; } }
    }
    nloc = mine > 0u ? mine : 1u; nx = cnt > 0u ? cnt : 1u;
}

__device__ __forceinline__ void xcd_barrier(const XcdBarrier& b) {
    asm volatile("s_waitcnt vmcnt(0)" ::: "memory");
    __syncthreads();
    if (threadIdx.x == 0) {
        unsigned* bar = b.bar;
        __builtin_amdgcn_s_waitcnt(0);
        unsigned nloc = b.st[0], nx = b.st[1];
        if (nloc == 0u) { xcd_barrier_complete(bar, b.x, nloc, nx); b.st[0] = nloc; b.st[1] = nx; }
        const unsigned old = xb_add(&bar[XB_XSUB(b.x)], 1u);
        const unsigned gen = old / nloc;
        if (old + 1u == (gen + 1u) * nloc) {
            __builtin_amdgcn_fence(__ATOMIC_RELEASE, "agent");
            asm volatile("s_waitcnt vmcnt(0)" ::: "memory");
            const unsigned og = xb_add(&bar[XB_TOP], 1u);
            const unsigned tg = og / nx;
            if (og + 1u == (tg + 1u) * nx) xb_add(&bar[XB_TOPGEN], 1u);
            else XB_SPIN(xb_ld(&bar[XB_TOPGEN]) == tg, bar);
            __builtin_amdgcn_fence(__ATOMIC_ACQUIRE, "agent");
            xb_add(&bar[XB_XGEN(b.x)], 1u);
            asm volatile("s_waitcnt vmcnt(0)" ::: "memory");
        } else {
            XB_SPIN(xb_ld(&bar[XB_XGEN(b.x)]) == gen, bar);
            __builtin_amdgcn_fence(__ATOMIC_ACQUIRE, "agent");
            asm volatile("s_waitcnt vmcnt(0)" ::: "memory");
        }
    }
    __syncthreads();
}

}
namespace cg = cooperative_groups;
constexpr int NSTEP = 12;
#ifndef CVH_GU
#define CVH_GU 1
#define CVH_DN 1
#endif
__global__ void __launch_bounds__(512, 2) mega(mk::P p_unused) {
    extern __shared__ __attribute__((aligned(16))) unsigned char lds_raw[];
    float* lds = (float*)lds_raw;
    LAS unsigned char* lds3 = (LAS unsigned char*)lds_raw;
    using namespace nv; using namespace mk;
    volatile LAS unsigned* bst = (volatile LAS unsigned*)(lds3 + E3_BYTES + 128);
    if (threadIdx.x < 2) bst[threadIdx.x] = 0u;
    __syncthreads();
    XcdBarrier bar;
    { const KP p = fresh_kp(); bar = xcd_barrier_post(WSP(unsigned, O_COUNTS + 16384), bst); }
    cg::this_grid().sync();
    for (int step = 0; step < 1 + NSTEP * L_; ++step) {
        const KP p = fresh_kp();
        const int l = (step - 1) / NSTEP, k = (step == 0) ? -1 : (step - 1) % NSTEP;
        const bool isg = (k == 0 || k == 1 || k == 6 || k == 9 || k == 10);
#ifdef PROBE_K
        const int nrep = (k == PROBE_K) ? PROBE_N : 1;
#else
        const int nrep = 1;
#endif
        for (int rep = 0; rep < nrep; ++rep) {
        int helpchunks = 0;
        if (isg) {
            const int kind = (k == 0) ? 0 : (k == 1) ? 4 : (k == 6) ? 1 : (k == 9) ? 2 : 3;
            GSched S; GEpi E; S.kind = kind; E.kind = kind; E.l = l;
            S.G = (int)gridDim.x; S.c = fbid(); S.meta = WSP(int, O_META); S.rowtok = WSP(int, O_ROWTOK); S.estep = 0;
            const char* A; int N, K = D_;
            if (kind == 0) { A = (const char*)WSP(bf16_t, O_XB); S.Bt = (const char*)(WSP(bf16_t, O_WTIN) + (size_t)l * NPAD * D_); N = NPAD; }
            else if (kind == 1) { A = (const char*)WSP(bf16_t, O_OB); S.Bt = (const char*)(WSP(bf16_t, O_WTOUT) + (size_t)l * D_ * D_); N = D_; }
            else if (kind == 2) { A = (const char*)WSP(bf16_t, O_X1B); S.Bt = (const char*)(WSP(bf16_t, O_WTGU) + (size_t)l * NE * 2048 * D_); S.estep = (size_t)2048 * D_ * 2; N = 2048; }
            else if (kind == 3) { A = (const char*)WSP(bf16_t, O_ACT); S.Bt = (const char*)(WSP(bf16_t, O_WTDN) + (size_t)l * NE * D_ * D_); S.estep = (size_t)D_ * D_ * 2; N = D_; }
            else { A = (const char*)WSP(bf16_t, O_PROJB); S.Bt = (const char*)(WSP(bf16_t, O_WT1) + (size_t)l * 2 * 256 * 2048); S.estep = (size_t)256 * 2048 * 2; N = 256; K = 1024; }
            S.nN = N / 256; S.nM = (kind < 2) ? T_ / 256 : (kind == 4) ? 16 : S.meta[32]; S.nunits = S.nM * S.nN; if (kind == 4) S.nunits = 32;
            pg8::gemm_phase<GEpi, GSched>(lds3, A, K, S, E);
            if (l == 0 && kind >= 2 && kind <= 3 && S.G == 256) {
                const int mine = (S.nunits - S.c + 255) >> 8, most = (S.nunits + 255) >> 8;
                if (mine < most) helpchunks = (kind == 2) ? CVH_GU : CVH_DN; }
            if (kind == 4) { ph_cumsum(lds, p, 32); ph_sb_early(lds3, p); }
            if (kind == 0) ph_bias1_reduce(p, l);
        } else {
            switch (k) {
                case -1: ph_convert(lds3, p); break;
                case 2: ph_prep2(lds, p, l); break;
#ifdef PROBE_AMODE
                case 3: if (rep == 0) ph_attn1<30>(lds, lds3, p, WSP(unsigned, O_COUNTS) + 128 + l * 8 + rep, WSP(bf16_t, O_O), WSP(bf16_t, O_OWIN), WSP(unsigned, O_COUNTS) + 192 + l * 8);
                        else ph_attn1<PROBE_AMODE>(lds, lds3, p, WSP(unsigned, O_COUNTS) + 128 + l * 8 + rep, WSP(bf16_t, O_O), WSP(bf16_t, O_OWIN), WSP(unsigned, O_COUNTS) + 192 + l * 8);
                        break;
#else
                case 3: ph_attn1<30>(lds, lds3, p, WSP(unsigned, O_COUNTS) + 128 + l * 8 + rep, WSP(bf16_t, O_O), WSP(bf16_t, O_OWIN), WSP(unsigned, O_COUNTS) + 192 + l * 8); break;
#endif
                case 4: ph_attn_sel2<true>(lds3, p, WSP(bf16_t, O_O), WSP(bf16_t, O_OCMP), 512); break;
                case 5: ph_rmsnorm(p, l); break;
                case 7: ph_ln<true>(lds, p, l, WSP(float, O_X1), (rep + 1 < nrep) ? 2048 * (rep + 1) : 0); break;
                case 8: ph_moe_scatter2(lds, p, l); break;
                default: { if (l == 0) helpchunks = 1 << 20;
                           float* xout = (l == L_ - 1) ? p->out : WSP(float, O_XA); ph_ln<false>(lds, p, l, xout); } break;
            }
        }
        if (helpchunks > 0) cv_help(lds3, fresh_kp(), helpchunks);
        xcd_barrier(bar);
        }
    }
#ifdef PROBE_SYNC
    for (int i = 0; i < PROBE_SYNC; ++i) xcd_barrier(bar);
#endif
}

extern "C" void kernel_launch(void* const* d_in, const int* in_sizes, int n_in,
                              void* d_out, int out_size, void* d_ws, size_t ws_size,
                              hipStream_t stream) {
    constexpr size_t kDynLds = 147456 + 1024;
    static int grid_blocks = 0;
    if (!grid_blocks) {
        int dev = 0, cus = 0, per_cu = 0;
        (void)hipGetDevice(&dev);
        (void)hipDeviceGetAttribute(&cus, hipDeviceAttributeMultiprocessorCount, dev);
        (void)hipFuncSetAttribute((const void*)mega, hipFuncAttributeMaxDynamicSharedMemorySize, (int)kDynLds);
        (void)hipOccupancyMaxActiveBlocksPerMultiprocessor(&per_cu, mega, 512, kDynLds);
        if (per_cu < 1) per_cu = 1;
        if (per_cu > 1) per_cu = 1;
        grid_blocks = cus * per_cu;
        if (ws_size < mk::O_END) fprintf(stderr, "workspace too small: %zu < %zu\n", ws_size, (size_t)mk::O_END);
        if (grid_blocks != 256) fprintf(stderr, "this kernel's static work split is built for 256 workgroups (MI355X: 256 CUs); got %d\n", grid_blocks);
    }
    mk::P p{};
    p.in = nv::inputs(d_in); p.ws = (unsigned char*)d_ws; p.out = (float*)d_out;
    (void)hipMemsetAsync((char*)d_ws + mk::O_COUNTS, 0, 65536, stream);
    void* args[] = {&p};
    hipError_t e = hipLaunchCooperativeKernel((void*)mega, dim3(grid_blocks), dim3(512), args, kDynLds, stream);
    if (e != hipSuccess) fprintf(stderr, "cooperative launch failed: %s (grid %d)\n", hipGetErrorString(e), grid_blocks);
}
```

```cpp
#include <hip/hip_runtime.h>
#include <hip/hip_cooperative_groups.h>
#include <cstdio>
#include <cstdint>

namespace nv {

constexpr int B_ = 2, S_ = 8192, D_ = 1024, T_ = B_ * S_, L_ = 2;
constexpr int DIN = 2844;
constexpr int OFF_NSA_KV = 512, OFF_NSA_GATE = 1280, OFF_FOX_QKV = 1304, OFF_FOX_F = 2072, OFF_SB_QKV = 2076;
constexpr int NCMP = 511, NBLK = 128, NSEL = 16;
constexpr int NE = 32, TOPK = 4, MROWS = T_ * TOPK;
constexpr float LN_EPS = 1e-5f, RMS_EPS = 1e-6f;
constexpr float ALPHA = 1.4142135623730951f;
constexpr float SCALE = 0.125f;

__device__ __forceinline__ float sigmoidf_(float x) { return __builtin_amdgcn_rcpf(1.f + __builtin_amdgcn_exp2f(-1.4426950408889634f * x)); }
__device__ __forceinline__ float logsig(float x) { return fminf(x, 0.f) - 0.6931471805599453f * __builtin_amdgcn_logf(1.f + __builtin_amdgcn_exp2f(-1.4426950408889634f * fabsf(x))); }

__device__ __forceinline__ float gelu_tanh(float x) { return 0.5f * x * (1.f + tanhf(0.7978845608028654f * (x + 0.044715f * x * x * x))); }
__device__ __forceinline__ float wsum(float v) {
#pragma unroll
    for (int o = 1; o < 64; o <<= 1) v += __shfl_xor(v, o);
    return v;
}
struct In {
    const float *x, *w_in, *b_in, *pos_k, *pos_v, *w1k, *w2k, *w1v, *w2v, *g_out, *w_out, *ln1_g, *ln1_b, *rw, *rb, *wgu, *bgu, *wdn, *bdn, *ln2_g, *ln2_b;
};
inline In inputs(void* const* d) {
    In i; i.x = (const float*)d[0]; i.w_in = (const float*)d[1]; i.b_in = (const float*)d[2]; i.pos_k = (const float*)d[3]; i.pos_v = (const float*)d[4];
    i.w1k = (const float*)d[5]; i.w2k = (const float*)d[6]; i.w1v = (const float*)d[7]; i.w2v = (const float*)d[8]; i.g_out = (const float*)d[9]; i.w_out = (const float*)d[10];
    i.ln1_g = (const float*)d[11]; i.ln1_b = (const float*)d[12]; i.rw = (const float*)d[13]; i.rb = (const float*)d[14]; i.wgu = (const float*)d[15]; i.bgu = (const float*)d[16];
    i.wdn = (const float*)d[17]; i.bdn = (const float*)d[18]; i.ln2_g = (const float*)d[19]; i.ln2_b = (const float*)d[20]; return i;
}


}
namespace pg8 {
#define PG8_LAS __attribute__((address_space(3)))
typedef unsigned short bf16_t;
typedef short bf16x8 __attribute__((ext_vector_type(8)));
typedef float f32x4 __attribute__((ext_vector_type(4)));
typedef unsigned u32x4 __attribute__((ext_vector_type(4)));
constexpr int BM = 256, BK = 64, HALF = 128, HTB = HALF * BK * 2  , STAGE_BYTES = 8 * HTB, NXCD = 8, WGM = 8;

__host__ __device__ __forceinline__ int lds_byte(int r, int c) { const int st = (r >> 4) * 2 + (c >> 5), rr = r & 15, cc = c & 31, ob = rr * 64 + cc * 2; return st * 1024 + (ob ^ (((ob >> 9) & 1) << 5)); }
__host__ __device__ __forceinline__ void stage_rc(int b, int& R, int& C) { const int st = b / 1024, sb = b % 1024, swz = sb ^ (((sb >> 9) & 1) << 5); R = (st >> 1) * 16 + swz / 64; C = (st & 1) * 32 + (swz % 64) / 2; }
__host__ __device__ __forceinline__ int perm32(int rho) { const int n = rho >> 4, i = rho & 15; return 8 * (i >> 2) + 4 * n + (i & 3); }

struct Unit { int pm, pn, e, nr; };

__device__ __forceinline__ unsigned cvt_pk_bf16(float lo, float hi) { unsigned r; asm volatile("v_cvt_pk_bf16_f32 %0, %1, %2" : "=v"(r) : "v"(lo), "v"(hi)); return r; }
template <class Epi, class Sched, bool ALIGN_EPI = true, bool SP2 = true>
__device__ __forceinline__ void gemm_phase(PG8_LAS unsigned char* lds, const char* Abase, const int K, const Sched& S, const Epi& E) {
    int tid_ = threadIdx.x; asm volatile("" : "+v"(tid_));
    const int tid = tid_, wid = __builtin_amdgcn_readfirstlane(tid >> 6), lane = tid & 63, wr = wid >> 2, wc = wid & 3, fr = lane & 15, fq = lane >> 4;
    const int nt = K / BK;
    unsigned voffB[2];
#pragma unroll
    for (int i = 0; i < 2; ++i) { int R, C; stage_rc(tid * 16 + i * 8192, R, C); const int Rb = Epi::PERM ? ((R & ~31) + perm32(R & 31)) : R;
        voffB[i] = (unsigned)(Rb * K + C) * 2u; }
#define PG8_AOFF(u, o0, o1) do { int _t = tid; asm volatile("" : "+v"(_t)); _Pragma("unroll") for (int _i = 0; _i < 2; ++_i) { int _R, _C; stage_rc(_t * 16 + _i * 8192, _R, _C); \
        (o0)[_i] = S.a_off((u), _R) + (unsigned)_C * 2u; (o1)[_i] = S.a_off((u), HALF + _R) + (unsigned)_C * 2u; } } while (0)
    const size_t kstep = (size_t)(BK * 2);
    const size_t akstep = S.a_kstep();
    const size_t hstep = (size_t)HALF * K * 2;
    const unsigned ldsw = (unsigned)wid * 1024u;
    const int aoff = lds_byte(wr * 64 + fr, fq * 8), boff = lds_byte(wc * 32 + fr, fq * 8);
#define PG8_SA(b, h) (((b) * 2 + (h)) * HTB)
#define PG8_SB(b, h) ((4 + (b) * 2 + (h)) * HTB)
#define PG8_STAGE(bufoff, gbase, voff) do { _Pragma("unroll") for (int _i = 0; _i < 2; ++_i) { unsigned _o = (voff)[_i]; asm volatile("" : "+v"(_o));     \
        __builtin_amdgcn_global_load_lds((const unsigned*)((const char*)(gbase) + _o), (PG8_LAS unsigned*)(lds + (bufoff) + ldsw + _i * 8192), 16, 0, 0); } } while (0)
#define PG8_LDA(dst, b, h) do { _Pragma("unroll") for (int m = 0; m < 4; ++m) _Pragma("unroll") for (int k = 0; k < 2; ++k) dst[m][k] = *(const PG8_LAS bf16x8*)(lds + PG8_SA(b, h) + aoff + m * 2048 + k * 1024); } while (0)
#define PG8_LDB(dst, b, h) do { _Pragma("unroll") for (int n = 0; n < 2; ++n) _Pragma("unroll") for (int k = 0; k < 2; ++k) dst[n][k] = *(const PG8_LAS bf16x8*)(lds + PG8_SB(b, h) + boff + n * 2048 + k * 1024); } while (0)
#define PG8_MMA(ai, bj, At, Bt) do { __builtin_amdgcn_s_setprio(1); _Pragma("unroll") for (int m = 0; m < 4; ++m) _Pragma("unroll") for (int n = 0; n < 2; ++n) _Pragma("unroll") for (int k = 0; k < 2; ++k) \
        acc[ai][bj][m][n] = __builtin_amdgcn_mfma_f32_16x16x32_bf16(Bt[n][k], At[m][k], acc[ai][bj][m][n], 0, 0, 0); __builtin_amdgcn_s_setprio(0); } while (0)
#define PG8_WAIT_V(n) asm volatile("s_waitcnt vmcnt(" #n ")" ::: "memory")
#define PG8_WAIT_L(n) asm volatile("s_waitcnt lgkmcnt(" #n ")" ::: "memory")
#define PG8_BAR __builtin_amdgcn_s_barrier()
#define PG8_SCHED __builtin_amdgcn_sched_barrier(0)
    Unit cur, nxt; int ui = 0;
    if (!S.next(0, cur)) return;
    f32x4 acc[2][2][4][2];
    float zf_ = 0.f; asm volatile("" : "+v"(zf_));
#pragma unroll
    for (int a = 0; a < 2; ++a)
#pragma unroll
        for (int b = 0; b < 2; ++b)
#pragma unroll
            for (int m = 0; m < 4; ++m)
#pragma unroll
                for (int n = 0; n < 2; ++n) acc[a][b][m][n] = (f32x4){zf_, zf_, zf_, zf_};
    bf16x8 At[4][2], B0[2][2], B1[2][2];
    unsigned ca0[2], ca1[2], na0[2], na1[2];
    PG8_AOFF(cur, ca0, ca1);
    const char* const cA = Abase; const char* cB = S.b_base(cur);
    if constexpr (SP2) {
        PG8_STAGE(PG8_SB(0, 0), cB, voffB); PG8_STAGE(PG8_SB(0, 1), cB + hstep, voffB); PG8_STAGE(PG8_SA(0, 0), cA, ca0); PG8_STAGE(PG8_SA(0, 1), cA, ca1);
        if (wr == 1) PG8_BAR;
        PG8_WAIT_V(2); PG8_BAR;
        PG8_STAGE(PG8_SB(1, 0), cB + kstep, voffB); PG8_STAGE(PG8_SA(1, 0), cA + akstep, ca0); PG8_STAGE(PG8_SB(1, 1), cB + hstep + kstep, voffB);
        PG8_WAIT_V(6); PG8_BAR;
    } else { static_assert(SP2, "only the SP2 loop is kept"); }
    for (;;) {
        const bool has_next = S.next(ui + 1, nxt);
        const char* nB = has_next ? S.b_base(nxt) : cB;
        if (has_next) { PG8_AOFF(nxt, na0, na1); } else { na0[0] = ca0[0]; na0[1] = ca0[1]; na1[0] = ca1[0]; na1[1] = ca1[1]; }
        for (int t = 0; t < nt - 2; t += 2) {
            const char* a1 = cA + (size_t)(t + 1) * akstep;
            const char* a2 = cA + (size_t)(t + 2) * akstep; const char* b2 = cB + (size_t)(t + 2) * kstep;
            const char* a3 = a2 + akstep; const char* b3 = b2 + kstep;
            PG8_LDB(B0, 0, 0); PG8_LDB(B1, 0, 1); PG8_SCHED; PG8_LDA(At, 0, 0); PG8_STAGE(PG8_SA(1, 1), a1, ca1);
            PG8_WAIT_V(8); PG8_WAIT_L(0); PG8_BAR; PG8_MMA(0, 0, At, B0); PG8_MMA(0, 1, At, B1); PG8_BAR; PG8_SCHED;
            PG8_LDA(At, 0, 1); PG8_STAGE(PG8_SB(0, 0), b2, voffB); PG8_STAGE(PG8_SB(0, 1), b2 + hstep, voffB); PG8_STAGE(PG8_SA(0, 0), a2, ca0);
            PG8_WAIT_V(8); PG8_WAIT_L(0); PG8_BAR; PG8_MMA(1, 0, At, B0); PG8_MMA(1, 1, At, B1); PG8_BAR; PG8_SCHED;
            PG8_LDB(B0, 1, 0); PG8_LDB(B1, 1, 1); PG8_SCHED; PG8_LDA(At, 1, 0); PG8_STAGE(PG8_SA(0, 1), a2, ca1);
            PG8_WAIT_V(8); PG8_WAIT_L(0); PG8_BAR; PG8_MMA(0, 0, At, B0); PG8_MMA(0, 1, At, B1); PG8_BAR; PG8_SCHED;
            PG8_LDA(At, 1, 1); PG8_STAGE(PG8_SB(1, 0), b3, voffB); PG8_STAGE(PG8_SB(1, 1), b3 + hstep, voffB); PG8_STAGE(PG8_SA(1, 0), a3, ca0);
            PG8_WAIT_V(8); PG8_WAIT_L(0); PG8_BAR; PG8_MMA(1, 0, At, B0); PG8_MMA(1, 1, At, B1); PG8_BAR; PG8_SCHED;
        }
        {
            const char* a1 = cA + (size_t)(nt - 1) * akstep;
            const char* a2 = cA; const char* b2 = nB; const char* a3 = a2 + akstep; const char* b3 = b2 + kstep;
            PG8_LDB(B0, 0, 0); PG8_LDB(B1, 0, 1); PG8_SCHED; PG8_LDA(At, 0, 0); PG8_STAGE(PG8_SA(1, 1), a1, ca1);
            PG8_WAIT_V(8); PG8_WAIT_L(0); PG8_BAR; PG8_MMA(0, 0, At, B0); PG8_MMA(0, 1, At, B1); PG8_BAR; PG8_SCHED;
            PG8_LDA(At, 0, 1); PG8_STAGE(PG8_SB(0, 0), b2, voffB); PG8_STAGE(PG8_SB(0, 1), b2 + hstep, voffB); PG8_STAGE(PG8_SA(0, 0), a2, na0);
            PG8_WAIT_V(8); PG8_WAIT_L(0); PG8_BAR; PG8_MMA(1, 0, At, B0); PG8_MMA(1, 1, At, B1); PG8_BAR; PG8_SCHED;
            PG8_LDB(B0, 1, 0); PG8_LDB(B1, 1, 1); PG8_SCHED; PG8_LDA(At, 1, 0); PG8_STAGE(PG8_SA(0, 1), a2, na1);
            PG8_WAIT_V(8); PG8_WAIT_L(0); PG8_BAR; PG8_MMA(0, 0, At, B0); PG8_MMA(0, 1, At, B1); PG8_BAR; PG8_SCHED;
            PG8_LDA(At, 1, 1); PG8_STAGE(PG8_SB(1, 0), b3, voffB); PG8_STAGE(PG8_SB(1, 1), b3 + hstep, voffB); PG8_STAGE(PG8_SA(1, 0), a3, na0);
            PG8_WAIT_V(8); PG8_WAIT_L(0); PG8_BAR; PG8_MMA(1, 0, At, B0); PG8_MMA(1, 1, At, B1); PG8_BAR; PG8_SCHED;
        }
        if constexpr (ALIGN_EPI) { if (wr == 0) PG8_BAR; }
        E(acc, cur, wr, wc, fr, fq);
        if (!has_next) break;
#pragma unroll
        for (int a = 0; a < 2; ++a)
#pragma unroll
            for (int b = 0; b < 2; ++b)
#pragma unroll
                for (int m = 0; m < 4; ++m)
#pragma unroll
                    for (int n = 0; n < 2; ++n) acc[a][b][m][n] = (f32x4){zf_, zf_, zf_, zf_};
        cur = nxt; cB = nB; ++ui; ca0[0] = na0[0]; ca0[1] = na0[1]; ca1[0] = na1[0]; ca1[1] = na1[1];
        if constexpr (ALIGN_EPI) { if (wr == 1) PG8_BAR; }
    }
    PG8_WAIT_V(0);
    if constexpr (!ALIGN_EPI) { if (wr == 0) PG8_BAR; }
    PG8_BAR;
#undef PG8_AOFF
#undef PG8_SA
#undef PG8_SB
#undef PG8_STAGE
#undef PG8_LDA
#undef PG8_LDB
#undef PG8_MMA
#undef PG8_WAIT_V
#undef PG8_WAIT_L
#undef PG8_BAR
#undef PG8_SCHED
}

}
namespace mk {
using namespace nv;
typedef unsigned short bf16_t;
typedef unsigned u32x4 __attribute__((ext_vector_type(4)));
typedef float f32x4 __attribute__((ext_vector_type(4)));
#define LAS __attribute__((address_space(3)))
typedef short bf16x8 __attribute__((ext_vector_type(8)));
typedef float f32x16 __attribute__((ext_vector_type(16)));
#define CROW(reg, hh) (((reg) & 3) + 8 * ((reg) >> 2) + 4 * (hh))
constexpr int NT = 512;
constexpr int PB = 2816;
constexpr int NPAD = 3072;
constexpr int C_KV = 512, C_FOX = 1280, C_SB = 2048, C_GATE = 2816;
constexpr int MAXT = MROWS / 256 + NE;
constexpr int PROWS = MAXT * 256;
#define CNT_IDX(l, e) (8192 + ((l) * NE + (e)) * 32)
__device__ __forceinline__ int ftid() { int t = threadIdx.x; asm volatile("" : "+v"(t)); return t; }
__device__ __forceinline__ int fbid() { int b = blockIdx.x; asm volatile("" : "+s"(b)); return b; }
#define MK_LOOP(vb, n) for (int vb = fbid(); vb < (n); vb += gridDim.x)

constexpr size_t al_(size_t x) { return (x + 4095) & ~(size_t)4095; }
constexpr size_t O_WTIN = 0;
constexpr size_t O_WTOUT = O_WTIN + al_((size_t)L_ * NPAD * D_ * 2);
constexpr size_t O_WTGU = O_WTOUT + al_((size_t)L_ * D_ * D_ * 2);
constexpr size_t O_WTDN = O_WTGU + al_((size_t)L_ * NE * 2048 * D_ * 2);
constexpr size_t O_BIASP = O_WTDN + al_((size_t)L_ * NE * D_ * D_ * 2);
constexpr size_t O_XB = O_BIASP + al_((size_t)L_ * NPAD * 4);
constexpr size_t O_PROJB = O_XB + al_((size_t)T_ * D_ * 2);
constexpr size_t O_GF = O_PROJB + al_((size_t)T_ * PB * 2);
constexpr size_t O_CFOX = O_GF + al_((size_t)T_ * 32 * 4);
constexpr size_t O_KCMP = O_CFOX + al_((size_t)B_ * 4 * S_ * 4);
constexpr size_t O_VCMP = O_KCMP + al_((size_t)B_ * 2 * 512 * 64 * 4);
constexpr size_t O_O = O_VCMP + al_((size_t)B_ * 2 * 512 * 64 * 4);
constexpr size_t O_OB = O_O + al_((size_t)T_ * D_ * 4);
constexpr size_t O_PTOT = O_OB + al_((size_t)T_ * D_ * 2);
constexpr size_t O_SEL = O_PTOT + al_((size_t)B_ * 2 * S_ * 512 * 4);
constexpr size_t O_MIX = O_SEL + al_((size_t)B_ * 2 * S_ * NSEL * 4);
constexpr size_t O_X1 = O_MIX + al_((size_t)T_ * D_ * 4);
constexpr size_t O_X1B = O_X1 + al_((size_t)T_ * D_ * 4);
constexpr size_t O_XA = O_X1B + al_((size_t)T_ * D_ * 2);
constexpr size_t O_ACT = O_XA + al_((size_t)T_ * D_ * 4);
constexpr size_t O_Y = O_ACT + al_((size_t)PROWS * D_ * 2);
constexpr size_t O_TOPE = O_Y + al_((size_t)PROWS * D_ * 2);
constexpr size_t O_TOPW = O_TOPE + al_((size_t)MROWS * 4);
constexpr size_t O_POS = O_TOPW + al_((size_t)MROWS * 4);
constexpr size_t O_ROWTOK = O_POS + al_((size_t)MROWS * 4);
constexpr size_t O_ROWW = O_ROWTOK + al_((size_t)PROWS * 4);
constexpr size_t O_SLOT = O_ROWW + al_((size_t)PROWS * 4);
constexpr size_t O_COUNTS = O_SLOT + al_((size_t)MROWS * 4);
constexpr size_t O_META = O_COUNTS + 65536;
constexpr size_t O_OWIN = O_META + 4096;
constexpr size_t O_O2 = O_OWIN + al_((size_t)T_ * 512 * 4);
constexpr size_t O_OWIN2 = O_O2 + al_((size_t)T_ * D_ * 4);
constexpr size_t O_KCMPB = O_OWIN2 + al_((size_t)T_ * 512 * 4);
constexpr size_t O_VCMPB = O_KCMPB + al_((size_t)B_ * 2 * 512 * 64 * 2);
constexpr size_t O_OCMP = O_VCMPB + al_((size_t)B_ * 2 * 512 * 64 * 2);
constexpr size_t O_SELMASK = O_OCMP + al_((size_t)T_ * 512 * 4);
constexpr size_t O_WT1 = O_SELMASK + al_((size_t)B_ * 2 * S_ * 16);
constexpr size_t O_BIAS1 = O_WT1 + al_((size_t)L_ * 2 * 256 * 2048 * 2);
constexpr size_t O_HID = O_BIAS1 + al_((size_t)L_ * 2 * 128 * 4);
constexpr size_t O_BIAS1P = O_HID + al_((size_t)8 * 512 * 128 * 2);
constexpr size_t O_RWT = O_BIAS1P + al_((size_t)L_ * 2 * 64 * 128 * 4);
constexpr size_t O_HIDP = O_RWT + al_((size_t)L_ * 2 * NE * D_ * 2);
constexpr size_t O_END = O_HIDP + al_((size_t)2 * 8 * 512 * 128 * 4);

struct P {
    In in; unsigned char* ws; float* out;
};
typedef const __attribute__((address_space(4))) P* KP;
__device__ __forceinline__ KP fresh_kp() { KP k = (KP)__builtin_amdgcn_kernarg_segment_ptr(); asm volatile("" : "+s"(k)); return k; }
#define WSP(T, off) ((T*)(p->ws + (off)))

__device__ __forceinline__ float bf2f(unsigned short b) { return __uint_as_float((unsigned)b << 16); }
__device__ __forceinline__ unsigned f2bf(float f) { unsigned u = __float_as_uint(f); return (u + 0x7fffu + ((u >> 16) & 1u)) >> 16; }
__device__ __forceinline__ unsigned pk2(float lo, float hi) { return f2bf(lo) | (f2bf(hi) << 16); }
__device__ __forceinline__ void ld8(const bf16_t* __restrict__ src, float* dst) {
    const u32x4 v = *(const u32x4*)src;
    dst[0] = __uint_as_float(v.x << 16); dst[1] = __uint_as_float(v.x & 0xffff0000u); dst[2] = __uint_as_float(v.y << 16); dst[3] = __uint_as_float(v.y & 0xffff0000u);
    dst[4] = __uint_as_float(v.z << 16); dst[5] = __uint_as_float(v.z & 0xffff0000u); dst[6] = __uint_as_float(v.w << 16); dst[7] = __uint_as_float(v.w & 0xffff0000u);
}


__device__ __forceinline__ int perm_in(int n) {
    if (n < 1280) return n;
    if (n < 1304) return C_GATE + (n - 1280);
    if (n < 2072) return C_FOX + (n - 1304);
    if (n < 2076) return C_GATE + 24 + (n - 2072);
    return C_SB + (n - 2076);
}
__device__ __forceinline__ int perm_gu(int n) { const int up = n >> 10, c = n & 1023; return 256 * (c >> 7) + 128 * up + (c & 127); }
template <int MAP>
__device__ __forceinline__ void transpose_item(const float* __restrict__ W, int K, int N, bf16_t* __restrict__ WT, LAS float* scr, int item, int lane) {
    const int nblk = (N + 31) / 32, kb = item / nblk, nb = item % nblk, k0 = 64 * kb, n0 = 32 * nb;
    { const int n4 = (lane & 7) * 4; const bool okn = (n0 + n4) < N;
      f32x4 t[8];
#pragma unroll
      for (int i = 0; i < 8; ++i) { const int kk = (lane >> 3) + 8 * i; t[i] = okn ? *(const f32x4*)(W + (size_t)(k0 + kk) * N + n0 + n4) : (f32x4){0.f, 0.f, 0.f, 0.f}; }
#pragma unroll
      for (int i = 0; i < 8; ++i) { const int kk = (lane >> 3) + 8 * i; LAS float* d = scr + kk * 33 + n4; d[0] = t[i].x; d[1] = t[i].y; d[2] = t[i].z; d[3] = t[i].w; } }
    asm volatile("s_waitcnt lgkmcnt(0)" ::: "memory");
    const int c = lane & 7;
#pragma unroll
    for (int j = 0; j < 4; ++j) { const int n = (lane >> 3) + 8 * j; const LAS float* sp = scr + (8 * c) * 33 + n;
        u32x4 o; o.x = pk2(sp[0 * 33], sp[1 * 33]); o.y = pk2(sp[2 * 33], sp[3 * 33]); o.z = pk2(sp[4 * 33], sp[5 * 33]); o.w = pk2(sp[6 * 33], sp[7 * 33]);
        const int ng = n0 + n;
        if (ng < N) { const int ro = (MAP == 1) ? perm_in(ng) : (MAP == 2) ? perm_gu(ng) : ng;
            if (MAP == 3) *(u32x4*)(WT + (size_t)(k0 >> 10) * 256 * 1024 + (size_t)ro * 1024 + (k0 & 1023) + 8 * c) = o;
            else *(u32x4*)(WT + (size_t)ro * K + k0 + 8 * c) = o; } }
    asm volatile("s_waitcnt lgkmcnt(0)" ::: "memory");
}
constexpr int CV_I_IN = 16 * 89, CV_I_OUT = 16 * 32, CV_I_GU = 16 * 64, CV_I_DN = 16 * 32, CV_I_W1 = 32 * 4;
constexpr int CV_N_IN = L_ * CV_I_IN, CV_N_OUT = L_ * CV_I_OUT, CV_N_GU = L_ * NE * CV_I_GU, CV_N_DN = L_ * NE * CV_I_DN, CV_N_W1 = L_ * 2 * CV_I_W1, CV_N_ALL = CV_N_IN + CV_N_OUT + CV_N_GU + CV_N_DN + CV_N_W1;
constexpr int CV_DEF_GU0 = CV_N_W1 + NE * CV_I_GU, CV_DEF_GU = NE * CV_I_GU, CV_DEF_DN0 = CV_N_W1 + CV_N_GU + NE * CV_I_DN, CV_DEF_DN = NE * CV_I_DN, CV_DEF_ALL = CV_DEF_GU + CV_DEF_DN;
__device__ __forceinline__ void cv_one(KP p, LAS float* scr, int it, int lane) {
    int r = it;
    if (r < CV_N_W1) { const int mtx = r / CV_I_W1, ll = mtx >> 1, kv = mtx & 1; transpose_item<3>((kv ? p->in.w1v : p->in.w1k) + (size_t)ll * 2048 * 128, 2048, 128, WSP(bf16_t, O_WT1) + (size_t)mtx * 256 * 2048, scr, r % CV_I_W1, lane); return; } r -= CV_N_W1;
    if (r < CV_N_GU) { const int mtx = r / CV_I_GU; transpose_item<2>(p->in.wgu + (size_t)mtx * D_ * 2048, D_, 2048, WSP(bf16_t, O_WTGU) + (size_t)mtx * 2048 * D_, scr, r % CV_I_GU, lane); return; } r -= CV_N_GU;
    if (r < CV_N_DN) { const int mtx = r / CV_I_DN; transpose_item<0>(p->in.wdn + (size_t)mtx * D_ * D_, D_, D_, WSP(bf16_t, O_WTDN) + (size_t)mtx * D_ * D_, scr, r % CV_I_DN, lane); return; } r -= CV_N_DN;
    if (r < CV_N_IN) { const int mtx = r / CV_I_IN; transpose_item<1>(p->in.w_in + (size_t)mtx * D_ * DIN, D_, DIN, WSP(bf16_t, O_WTIN) + (size_t)mtx * NPAD * D_, scr, r % CV_I_IN, lane); return; } r -= CV_N_IN;
    { const int mtx = r / CV_I_OUT; transpose_item<0>(p->in.w_out + (size_t)mtx * D_ * D_, D_, D_, WSP(bf16_t, O_WTOUT) + (size_t)mtx * D_ * D_, scr, r % CV_I_OUT, lane); }
}
__device__ __forceinline__ void cv_help(LAS unsigned char* lds, KP p, int maxchunks) {
    const int tid = ftid(), lane = tid & 63, wv = tid >> 6; LAS float* scr = (LAS float*)(lds + wv * 8448);
    unsigned* cursor = WSP(unsigned, O_COUNTS) + 64;
    for (int c = 0; c < maxchunks; ++c) {
        unsigned base = 0u; if (lane == 0) base = atomicAdd(cursor, 8u);
        base = (unsigned)__builtin_amdgcn_readfirstlane((int)base);
        if (base >= (unsigned)CV_DEF_ALL) break;
        for (int i = 0; i < 8; ++i) { const int d = (int)base + i; if (d < CV_DEF_ALL) cv_one(p, scr, d < CV_DEF_GU ? CV_DEF_GU0 + d : CV_DEF_DN0 + (d - CV_DEF_GU), lane); }
    }
}
__device__ __forceinline__ void ph_convert(LAS unsigned char* lds, KP p) {
    const int tid = ftid(), lane = tid & 63, wv = tid >> 6;
    LAS float* scr = (LAS float*)(lds + wv * 8448);
    const int gw = fbid() * 8 + wv, NGW = gridDim.x * 8;
    for (int it = gw; it < CV_N_ALL; it += NGW) {
        if ((it >= CV_DEF_GU0 && it < CV_DEF_GU0 + CV_DEF_GU) || (it >= CV_DEF_DN0 && it < CV_DEF_DN0 + CV_DEF_DN)) continue;
        cv_one(p, scr, it, lane);
    }
    const int gt = fbid() * NT + tid, NG = gridDim.x * NT;
    for (int i = gt; i < L_ * (NPAD - DIN) * (D_ / 8); i += NG) { const int l = i / ((NPAD - DIN) * (D_ / 8)), r = i % ((NPAD - DIN) * (D_ / 8));
        unsigned z_ = 0u; asm volatile("" : "+v"(z_));
        *(u32x4*)(WSP(bf16_t, O_WTIN) + ((size_t)l * NPAD + DIN) * D_ + (size_t)r * 8) = (u32x4){z_, z_, z_, z_}; }
    for (int i = gt; i < L_ * 2 * 2 * 128 * (1024 / 8); i += NG) { const int mtxh = i / (128 * 128), r = i % (128 * 128); unsigned z_ = 0u; asm volatile("" : "+v"(z_));
        *(u32x4*)(WSP(bf16_t, O_WT1) + ((size_t)mtxh * 256 + 128) * 1024 + (size_t)r * 8) = (u32x4){z_, z_, z_, z_}; }
    for (int i = gt; i < L_ * 2 * 64 * 128; i += NG) { const int j = i & 127, seg = (i >> 7) & 63, mtx = i >> 13, ll = mtx >> 1, kv = mtx & 1;
        const float* pos = (kv ? p->in.pos_v : p->in.pos_k) + (size_t)ll * 2048 + seg * 32; const float* w1 = (kv ? p->in.w1v : p->in.w1k) + (size_t)ll * 2048 * 128 + (size_t)seg * 32 * 128; float a = 0.f;
#pragma unroll 8
        for (int k = 0; k < 32; ++k) a += pos[k] * w1[(size_t)k * 128 + j];
        WSP(float, O_BIAS1P)[i] = a; }
    for (int i = gt; i < L_ * NPAD; i += NG) { const int l = i / NPAD, c = i % NPAD; if (c >= DIN) WSP(float, O_BIASP)[i] = 0.f; }
    for (int i = gt; i < L_ * DIN; i += NG) { const int l = i / DIN, n = i % DIN; WSP(float, O_BIASP)[l * NPAD + perm_in(n)] = p->in.b_in[i]; }
    for (int i = gt; i < L_ * NE * D_; i += NG) { const int k = i & (D_ - 1), e = (i >> 10) & (NE - 1), l = i >> 15;
        const float v = p->in.rw[((size_t)l * D_ + k) * NE + e]; const unsigned h = f2bf(v); const float lo = v - bf2f((unsigned short)h);
        WSP(bf16_t, O_RWT)[((size_t)(l * 2 + 0) * NE + e) * D_ + k] = (bf16_t)h; WSP(bf16_t, O_RWT)[((size_t)(l * 2 + 1) * NE + e) * D_ + k] = (bf16_t)f2bf(lo); }
    for (int i = gt; i < T_ * D_ / 8; i += NG) { const f32x4 a = *(const f32x4*)(p->in.x + (size_t)i * 8), b = *(const f32x4*)(p->in.x + (size_t)i * 8 + 4);
        *(u32x4*)(WSP(bf16_t, O_XB) + (size_t)i * 8) = (u32x4){pk2(a.x, a.y), pk2(a.z, a.w), pk2(b.x, b.y), pk2(b.z, b.w)}; }
}

struct EpiProj {
    static constexpr bool PERM = true;
    bf16_t* projb; float* gf; const float* bias;
    __device__ __forceinline__ void operator()(const pg8::f32x4 (&acc)[2][2][4][2], const pg8::Unit& u, int wr, int wc, int fr, int fq) const {
        const int row0 = u.pm * 256 + wr * 64 + fr, col0 = u.pn * 256 + wc * 32 + 8 * fq;
        if (u.pn < 11) {
#pragma unroll
            for (int ai = 0; ai < 2; ++ai)
#pragma unroll
                for (int m = 0; m < 4; ++m) { bf16_t* rowp = projb + (size_t)(row0 + ai * 128 + m * 16) * PB + col0;
#pragma unroll
                    for (int bj = 0; bj < 2; ++bj) { const f32x4 v0 = acc[ai][bj][m][0] + *(const f32x4*)(bias + col0 + bj * 128), v1 = acc[ai][bj][m][1] + *(const f32x4*)(bias + col0 + bj * 128 + 4);
                        u32x4 w; w.x = pg8::cvt_pk_bf16(v0[0], v0[1]); w.y = pg8::cvt_pk_bf16(v0[2], v0[3]); w.z = pg8::cvt_pk_bf16(v1[0], v1[1]); w.w = pg8::cvt_pk_bf16(v1[2], v1[3]);
                        *(u32x4*)(rowp + bj * 128) = w; }
                    asm volatile("" ::: "memory"); }
        } else if (wc == 0) {
            const f32x4 b0 = *(const f32x4*)(bias + col0), b1 = *(const f32x4*)(bias + col0 + 4);
#pragma unroll
            for (int ai = 0; ai < 2; ++ai)
#pragma unroll
                for (int m = 0; m < 4; ++m) { float* rowp = gf + (size_t)(row0 + ai * 128 + m * 16) * 32 + 8 * fq;
                    const f32x4 v0 = acc[ai][0][m][0] + b0, v1 = acc[ai][0][m][1] + b1; f32x4 o0, o1;
#pragma unroll
                    for (int i = 0; i < 4; ++i) { const int j0 = 8 * fq + i, j1 = j0 + 4;
                        o0[i] = (j0 < 24) ? sigmoidf_(v0[i]) : (j0 < 28 ? logsig(v0[i]) : 0.f); o1[i] = (j1 < 24) ? sigmoidf_(v1[i]) : (j1 < 28 ? logsig(v1[i]) : 0.f); }
                    *(f32x4*)rowp = o0; *(f32x4*)(rowp + 4) = o1; }
        }
    }
};
struct EpiOut {
    static constexpr bool PERM = true;
    bf16_t* mixb;
    __device__ __forceinline__ void operator()(const pg8::f32x4 (&acc)[2][2][4][2], const pg8::Unit& u, int wr, int wc, int fr, int fq) const {
        const int row0 = u.pm * 256 + wr * 64 + fr, col0 = u.pn * 256 + wc * 32 + 8 * fq;
#pragma unroll
        for (int ai = 0; ai < 2; ++ai)
#pragma unroll
            for (int m = 0; m < 4; ++m) { bf16_t* rowp = mixb + (size_t)(row0 + ai * 128 + m * 16) * D_ + col0;
#pragma unroll
                for (int bj = 0; bj < 2; ++bj) { const f32x4 v0 = acc[ai][bj][m][0], v1 = acc[ai][bj][m][1];
                    u32x4 w; w.x = pg8::cvt_pk_bf16(v0[0], v0[1]); w.y = pg8::cvt_pk_bf16(v0[2], v0[3]); w.z = pg8::cvt_pk_bf16(v1[0], v1[1]); w.w = pg8::cvt_pk_bf16(v1[2], v1[3]);
                    *(u32x4*)(rowp + bj * 128) = w; }
                asm volatile("" ::: "memory"); }
    }
};
struct EpiGU {
    static constexpr bool PERM = true;
    bf16_t* act; const float* bgu;
    __device__ __forceinline__ void operator()(const pg8::f32x4 (&acc)[2][2][4][2], const pg8::Unit& u, int wr, int wc, int fr, int fq) const {
        const int row0 = u.pm * 256 + wr * 64 + fr, col0 = u.pn * 128 + wc * 32 + 8 * fq;
        const float* bb = bgu + (size_t)u.e * 2048 + col0;
        const f32x4 bg0 = *(const f32x4*)bb, bg1 = *(const f32x4*)(bb + 4), bu0 = *(const f32x4*)(bb + 1024), bu1 = *(const f32x4*)(bb + 1028);
#pragma unroll
        for (int ai = 0; ai < 2; ++ai)
#pragma unroll
            for (int m = 0; m < 4; ++m) { f32x4 a0, a1;
                const f32x4 g0 = acc[ai][0][m][0] + bg0, g1 = acc[ai][0][m][1] + bg1, u0 = acc[ai][1][m][0] + bu0, u1 = acc[ai][1][m][1] + bu1;
#pragma unroll
                for (int i = 0; i < 4; ++i) { const float gt0 = fminf(g0[i], 7.0f), up0 = fminf(fmaxf(u0[i], -7.0f), 7.0f), gt1 = fminf(g1[i], 7.0f), up1 = fminf(fmaxf(u1[i], -7.0f), 7.0f);
                    a0[i] = gt0 * sigmoidf_(1.702f * gt0) * (up0 + 1.0f); a1[i] = gt1 * sigmoidf_(1.702f * gt1) * (up1 + 1.0f); }
                u32x4 w; w.x = pg8::cvt_pk_bf16(a0[0], a0[1]); w.y = pg8::cvt_pk_bf16(a0[2], a0[3]); w.z = pg8::cvt_pk_bf16(a1[0], a1[1]); w.w = pg8::cvt_pk_bf16(a1[2], a1[3]);
                *(u32x4*)(act + (size_t)(row0 + ai * 128 + m * 16) * D_ + col0) = w; asm volatile("" ::: "memory"); }
    }
};
struct EpiDN {
    static constexpr bool PERM = true;
    bf16_t* y; const float* bdn; const float* roww;
    __device__ __forceinline__ void operator()(const pg8::f32x4 (&acc)[2][2][4][2], const pg8::Unit& u, int wr, int wc, int fr, int fq) const {
        const int row0 = u.pm * 256 + wr * 64 + fr, col0 = u.pn * 256 + wc * 32 + 8 * fq;
        const float* bb = bdn + (size_t)u.e * D_ + col0;
#pragma unroll
        for (int ai = 0; ai < 2; ++ai)
#pragma unroll
            for (int m = 0; m < 4; ++m) { const int row = row0 + ai * 128 + m * 16; const float w = roww[row];
#pragma unroll
                for (int bj = 0; bj < 2; ++bj) { const f32x4 v0 = (acc[ai][bj][m][0] + *(const f32x4*)(bb + bj * 128)) * w, v1 = (acc[ai][bj][m][1] + *(const f32x4*)(bb + bj * 128 + 4)) * w;
                    u32x4 o; o.x = pg8::cvt_pk_bf16(v0[0], v0[1]); o.y = pg8::cvt_pk_bf16(v0[2], v0[3]); o.z = pg8::cvt_pk_bf16(v1[0], v1[1]); o.w = pg8::cvt_pk_bf16(v1[2], v1[3]);
                    *(u32x4*)(y + (size_t)row * D_ + col0 + bj * 128) = o; }
                asm volatile("" ::: "memory"); }
    }
};
struct EpiCmp {
    static constexpr bool PERM = true;
    float* hidp;
    __device__ __forceinline__ void operator()(const pg8::f32x4 (&acc)[2][2][4][2], const pg8::Unit& u, int wr, int wc, int fr, int fq) const {
        const int row0 = u.pm * 256 + wr * 64 + fr, col0 = wc * 32 + 8 * fq;
#pragma unroll
        for (int ai = 0; ai < 2; ++ai)
#pragma unroll
            for (int m = 0; m < 4; ++m) { float* d = hidp + (((size_t)u.pn * 8 + u.e) * 512 + row0 + ai * 128 + m * 16) * 128 + col0;
                *(f32x4*)d = acc[ai][0][m][0]; *(f32x4*)(d + 4) = acc[ai][0][m][1]; asm volatile("" ::: "memory"); }
    }
};
struct GEpi {
    static constexpr bool PERM = true;
    int kind, l;
    __device__ __forceinline__ void operator()(const pg8::f32x4 (&acc)[2][2][4][2], const pg8::Unit& u, int wr, int wc, int fr, int fq) const {
        const KP p = fresh_kp();
        if (kind == 0) { const EpiProj e{WSP(bf16_t, O_PROJB), WSP(float, O_GF), WSP(float, O_BIASP) + l * NPAD}; e(acc, u, wr, wc, fr, fq); }
        else if (kind == 1) { const EpiOut e{WSP(bf16_t, O_MIX)}; e(acc, u, wr, wc, fr, fq); }
        else if (kind == 2) { const EpiGU e{WSP(bf16_t, O_ACT), p->in.bgu + (size_t)l * NE * 2048}; e(acc, u, wr, wc, fr, fq); }
        else if (kind == 3) { const EpiDN e{WSP(bf16_t, O_Y), p->in.bdn + (size_t)l * NE * D_, WSP(float, O_ROWW)}; e(acc, u, wr, wc, fr, fq); }
        else { const EpiCmp e{WSP(float, O_HIDP)}; e(acc, u, wr, wc, fr, fq); }
    }
};
struct GSched {
    int kind, nM, nN, nunits, G, c; const int* meta; const int* rowtok; const char* Bt; size_t estep;
    __device__ __forceinline__ bool next(int i, pg8::Unit& u) const {
        const int L = i * G + c; if (L >= nunits) return false;
        if (kind == 1) {
            int wgid = L; { const int q = nunits / pg8::NXCD, r = nunits % pg8::NXCD, xcd = wgid % pg8::NXCD, off = wgid / pg8::NXCD; wgid = (xcd < r ? xcd * (q + 1) : r * (q + 1) + (xcd - r) * q) + off; }
            const int nig = pg8::WGM * nN, gid = wgid / nig, fm = gid * pg8::WGM, gsz = (nM - fm) < pg8::WGM ? (nM - fm) : pg8::WGM;
            u.pm = fm + ((wgid % nig) % gsz); u.pn = (wgid % nig) / gsz; u.e = 0; u.nr = 256;
        } else if (kind == 4) { u.e = L >> 2; u.pm = (L >> 1) & 1; u.pn = L & 1; u.nr = ((L >> 1) & 1) ? 255 : 256; }
        else if (kind == 0) { const int gt = L / nN; u.pm = gt; u.pn = L - gt * nN; u.e = 0; u.nr = 256; }
        else { const int gt = L / nN; u.pm = gt; u.pn = L - gt * nN; u.e = meta[64 + 2 * gt]; u.nr = meta[65 + 2 * gt]; }
        return true; }
    __device__ __forceinline__ unsigned a_off(const pg8::Unit& u, int r) const { const int rr = r < u.nr ? r : u.nr - 1; const int row = u.pm * 256 + rr;
        if (kind == 4) { const int kv = u.e & 1, bg = u.e >> 1; return (unsigned)(((bg >> 1) * S_ + 16 * row + 16 * u.pn) * PB + C_KV + ((0 * 2 + kv) * 2 + (bg & 1)) * 64) * 2u; }
        return (unsigned)((kind == 2) ? rowtok[row] : row) * (unsigned)(D_ * 2); }
    __device__ __forceinline__ size_t a_kstep() const { return kind == 4 ? (size_t)PB * 2 : (size_t)128; }
    __device__ __forceinline__ const char* b_base(const pg8::Unit& u) const { return Bt + (size_t)(kind == 4 ? (u.e & 1) : u.e) * estep + (size_t)u.pn * ((size_t)256 * D_ * 2); }
};

__device__ __forceinline__ void ph_rmsnorm(KP p, int l) {
    const int lane = ftid() & 63, wv = ftid() >> 6; const float* g = p->in.g_out + (size_t)l * D_;
    constexpr int NB = 4; const int rstride = (int)gridDim.x * 8;
    f32x4 gg[4];
#pragma unroll
    for (int j = 0; j < 2; ++j) { gg[2 * j] = *(const f32x4*)(g + 512 * j + lane * 8); gg[2 * j + 1] = *(const f32x4*)(g + 512 * j + lane * 8 + 4); }
    for (int row0 = fbid() * 8 + wv; row0 < T_; row0 += rstride * NB) {
        u32x4 ra[NB], rb2[NB], rw2[NB];
#pragma unroll
        for (int bi = 0; bi < NB; ++bi) { const int row = (row0 + bi * rstride < T_) ? row0 + bi * rstride : row0; const bf16_t* r = WSP(bf16_t, O_O) + (size_t)row * D_ + lane * 8;
            ra[bi] = *(const u32x4*)r; rb2[bi] = *(const u32x4*)(r + 512); rw2[bi] = *(const u32x4*)(WSP(bf16_t, O_OWIN) + (size_t)row * 512 + lane * 8); }
#pragma unroll
        for (int bi = 0; bi < NB; ++bi) { const int row = row0 + bi * rstride; if (row < T_) {
#define BF_LO(u) __uint_as_float((u) << 16)
#define BF_HI(u) __uint_as_float((u) & 0xffff0000u)
            const f32x4 x0 = (f32x4){BF_LO(ra[bi].x) + BF_LO(rw2[bi].x), BF_HI(ra[bi].x) + BF_HI(rw2[bi].x), BF_LO(ra[bi].y) + BF_LO(rw2[bi].y), BF_HI(ra[bi].y) + BF_HI(rw2[bi].y)};
            const f32x4 x1 = (f32x4){BF_LO(ra[bi].z) + BF_LO(rw2[bi].z), BF_HI(ra[bi].z) + BF_HI(rw2[bi].z), BF_LO(ra[bi].w) + BF_LO(rw2[bi].w), BF_HI(ra[bi].w) + BF_HI(rw2[bi].w)};
            const f32x4 y0 = (f32x4){BF_LO(rb2[bi].x), BF_HI(rb2[bi].x), BF_LO(rb2[bi].y), BF_HI(rb2[bi].y)}, y1 = (f32x4){BF_LO(rb2[bi].z), BF_HI(rb2[bi].z), BF_LO(rb2[bi].w), BF_HI(rb2[bi].w)};
#undef BF_LO
#undef BF_HI
            float s = (x0.x * x0.x + x0.y * x0.y) + (x0.z * x0.z + x0.w * x0.w) + (x1.x * x1.x + x1.y * x1.y) + (x1.z * x1.z + x1.w * x1.w);
            float s2 = (y0.x * y0.x + y0.y * y0.y) + (y0.z * y0.z + y0.w * y0.w) + (y1.x * y1.x + y1.y * y1.y) + (y1.z * y1.z + y1.w * y1.w);
            const float sc0 = rsqrtf(wsum(s) * (1.f / 512.f) + RMS_EPS);
#pragma unroll
            for (int o = 1; o < 32; o <<= 1) s2 += __shfl_xor(s2, o);
            const float sc1 = rsqrtf(s2 * (1.f / 256.f) + RMS_EPS);
            const f32x4 u0 = x0 * sc0 * gg[0], u1 = x1 * sc0 * gg[1], w0 = y0 * sc1 * gg[2], w1 = y1 * sc1 * gg[3];
            bf16_t* ro = WSP(bf16_t, O_OB) + (size_t)row * D_;
            *(u32x4*)(ro + lane * 8) = (u32x4){pk2(u0.x, u0.y), pk2(u0.z, u0.w), pk2(u1.x, u1.y), pk2(u1.z, u1.w)};
            *(u32x4*)(ro + 512 + lane * 8) = (u32x4){pk2(w0.x, w0.y), pk2(w0.z, w0.w), pk2(w1.x, w1.y), pk2(w1.z, w1.w)}; } }
    }
}
template <bool ROUTER>
__device__ __forceinline__ void ph_ln(float* lds, KP p, int l, float* __restrict__ yout, int cnt_off = 0) {
    const int lane = ftid() & 63, wv = ftid() >> 6;
    const float* g = (ROUTER ? p->in.ln1_g : p->in.ln2_g) + (size_t)l * D_; const float* bb = (ROUTER ? p->in.ln1_b : p->in.ln2_b) + (size_t)l * D_;
    constexpr int NB = ROUTER ? 4 : 2;
    const int rstride = (int)gridDim.x * 8;
    LAS unsigned char* L3 = (LAS unsigned char*)lds; float* lgl = lds + 33024 + wv * 256;
    int oi = 0;
    for (int row0 = fbid() * 8 + wv; row0 < T_; row0 += rstride * NB, ++oi) {
        float v[NB][16];
        if (ROUTER) { const float* xin = (l == 0) ? p->in.x : WSP(float, O_XA);
#pragma unroll
            for (int bi = 0; bi < NB; ++bi) { const int row = (row0 + bi * rstride < T_) ? row0 + bi * rstride : row0; const float* src = xin + (size_t)row * D_; const bf16_t* mx = WSP(bf16_t, O_MIX) + (size_t)row * D_;
#pragma unroll
                for (int j = 0; j < 2; ++j) { const f32x4 a = *(const f32x4*)(src + 512 * j + lane * 8), b = *(const f32x4*)(src + 512 * j + lane * 8 + 4); const u32x4 q = *(const u32x4*)(mx + 512 * j + lane * 8);
                    v[bi][8 * j + 0] = ALPHA * a.x + __uint_as_float(q.x << 16); v[bi][8 * j + 1] = ALPHA * a.y + __uint_as_float(q.x & 0xffff0000u); v[bi][8 * j + 2] = ALPHA * a.z + __uint_as_float(q.y << 16); v[bi][8 * j + 3] = ALPHA * a.w + __uint_as_float(q.y & 0xffff0000u);
                    v[bi][8 * j + 4] = ALPHA * b.x + __uint_as_float(q.z << 16); v[bi][8 * j + 5] = ALPHA * b.y + __uint_as_float(q.z & 0xffff0000u); v[bi][8 * j + 6] = ALPHA * b.z + __uint_as_float(q.w << 16); v[bi][8 * j + 7] = ALPHA * b.w + __uint_as_float(q.w & 0xffff0000u); } }
        } else { const bf16_t* y = WSP(bf16_t, O_Y);
            int sl[NB][TOPK];
#pragma unroll
            for (int bi = 0; bi < NB; ++bi) { const int row = (row0 + bi * rstride < T_) ? row0 + bi * rstride : row0;
#pragma unroll
                for (int k = 0; k < TOPK; ++k) sl[bi][k] = WSP(int, O_SLOT)[row * TOPK + k]; }
            u32x4 yv[NB][TOPK][2]; f32x4 xv[NB][4];
#pragma unroll
            for (int bi = 0; bi < NB; ++bi) { const int row = (row0 + bi * rstride < T_) ? row0 + bi * rstride : row0; const float* src = WSP(float, O_X1) + (size_t)row * D_;
#pragma unroll
                for (int j = 0; j < 2; ++j) { xv[bi][2 * j] = *(const f32x4*)(src + 512 * j + lane * 8); xv[bi][2 * j + 1] = *(const f32x4*)(src + 512 * j + lane * 8 + 4); }
#pragma unroll
                for (int k = 0; k < TOPK; ++k)
#pragma unroll
                    for (int j = 0; j < 2; ++j) yv[bi][k][j] = *(const u32x4*)(y + (size_t)sl[bi][k] * D_ + 512 * j + lane * 8); }
#pragma unroll
            for (int bi = 0; bi < NB; ++bi)
#pragma unroll
                for (int j = 0; j < 2; ++j) { float acc[8];
#pragma unroll
                    for (int e = 0; e < 8; ++e) acc[e] = 0.f;
#pragma unroll
                    for (int k = 0; k < TOPK; ++k) { const u32x4 q = yv[bi][k][j];
                        acc[0] += __uint_as_float(q.x << 16); acc[1] += __uint_as_float(q.x & 0xffff0000u); acc[2] += __uint_as_float(q.y << 16); acc[3] += __uint_as_float(q.y & 0xffff0000u);
                        acc[4] += __uint_as_float(q.z << 16); acc[5] += __uint_as_float(q.z & 0xffff0000u); acc[6] += __uint_as_float(q.w << 16); acc[7] += __uint_as_float(q.w & 0xffff0000u); }
                    const f32x4 a = xv[bi][2 * j], b = xv[bi][2 * j + 1];
                    v[bi][8 * j + 0] = ALPHA * a.x + acc[0]; v[bi][8 * j + 1] = ALPHA * a.y + acc[1]; v[bi][8 * j + 2] = ALPHA * a.z + acc[2]; v[bi][8 * j + 3] = ALPHA * a.w + acc[3];
                    v[bi][8 * j + 4] = ALPHA * b.x + acc[4]; v[bi][8 * j + 5] = ALPHA * b.y + acc[5]; v[bi][8 * j + 6] = ALPHA * b.z + acc[6]; v[bi][8 * j + 7] = ALPHA * b.w + acc[7]; } }
#pragma unroll
        for (int bi = 0; bi < NB; ++bi) { const int row = row0 + bi * rstride; if (row < T_) {
            float s = 0.f;
#pragma unroll
            for (int i = 0; i < 16; ++i) s += v[bi][i];
            const float mu = wsum(s) * (1.f / D_); float s2 = 0.f;
#pragma unroll
            for (int i = 0; i < 16; ++i) { v[bi][i] -= mu; s2 += v[bi][i] * v[bi][i]; }
            const float rstd = rsqrtf(wsum(s2) * (1.f / D_) + LN_EPS);
            bf16_t* ybf = (ROUTER ? WSP(bf16_t, O_X1B) : WSP(bf16_t, O_XB)) + (size_t)row * D_;
#pragma unroll
            for (int j = 0; j < 2; ++j) { const int c0 = 512 * j + lane * 8; float o8[8];
                const f32x4 g0 = *(const f32x4*)(g + c0), g1 = *(const f32x4*)(g + c0 + 4), b0 = *(const f32x4*)(bb + c0), b1 = *(const f32x4*)(bb + c0 + 4);
                o8[0] = v[bi][8 * j + 0] * rstd * g0.x + b0.x; o8[1] = v[bi][8 * j + 1] * rstd * g0.y + b0.y; o8[2] = v[bi][8 * j + 2] * rstd * g0.z + b0.z; o8[3] = v[bi][8 * j + 3] * rstd * g0.w + b0.w;
                o8[4] = v[bi][8 * j + 4] * rstd * g1.x + b1.x; o8[5] = v[bi][8 * j + 5] * rstd * g1.y + b1.y; o8[6] = v[bi][8 * j + 6] * rstd * g1.z + b1.z; o8[7] = v[bi][8 * j + 7] * rstd * g1.w + b1.w;
                *(f32x4*)(yout + (size_t)row * D_ + c0) = (f32x4){o8[0], o8[1], o8[2], o8[3]};
                *(f32x4*)(yout + (size_t)row * D_ + c0 + 4) = (f32x4){o8[4], o8[5], o8[6], o8[7]};
                const u32x4 hv = (u32x4){pk2(o8[0], o8[1]), pk2(o8[2], o8[3]), pk2(o8[4], o8[5]), pk2(o8[6], o8[7])};
                *(u32x4*)(ybf + c0) = hv;
                if (ROUTER) {
                    float r8[8];
#pragma unroll
                    for (int i = 0; i < 4; ++i) { const unsigned w_ = (i == 0) ? hv.x : (i == 1) ? hv.y : (i == 2) ? hv.z : hv.w; r8[2 * i] = o8[2 * i] - __uint_as_float(w_ << 16); r8[2 * i + 1] = o8[2 * i + 1] - __uint_as_float(w_ & 0xffff0000u); }
                    LAS unsigned char* tp = L3 + (bi * 8 + wv) * 2064 + c0 * 2;
                    *(LAS u32x4*)tp = hv; *(LAS u32x4*)(tp + 66048) = (u32x4){pk2(r8[0], r8[1]), pk2(r8[2], r8[3]), pk2(r8[4], r8[5]), pk2(r8[6], r8[7])}; } } } }
        if (ROUTER) {
            __syncthreads();
            const int n32 = lane & 31, hh = lane >> 5;
            f32x16 acc;
#pragma unroll
            for (int r = 0; r < 16; ++r) acc[r] = 0.f;
            { const bf16_t* bh = WSP(bf16_t, O_RWT) + ((size_t)(l * 2) * NE + n32) * D_ + 128 * wv + 8 * hh; const bf16_t* bl = bh + (size_t)NE * D_;
              const LAS unsigned char* ah = L3 + n32 * 2064 + (128 * wv + 8 * hh) * 2;
              bf16x8 bhf[8], blf[8];
#pragma unroll
              for (int s_ = 0; s_ < 8; ++s_) { bhf[s_] = *(const bf16x8*)(bh + 16 * s_); blf[s_] = *(const bf16x8*)(bl + 16 * s_); }
#pragma unroll
              for (int s_ = 0; s_ < 8; ++s_) { const bf16x8 xh = *(const LAS bf16x8*)(ah + 32 * s_), xl = *(const LAS bf16x8*)(ah + 66048 + 32 * s_);
                  acc = __builtin_amdgcn_mfma_f32_32x32x16_bf16(xh, bhf[s_], acc, 0, 0, 0); acc = __builtin_amdgcn_mfma_f32_32x32x16_bf16(xh, blf[s_], acc, 0, 0, 0); acc = __builtin_amdgcn_mfma_f32_32x32x16_bf16(xl, bhf[s_], acc, 0, 0, 0); } }
            __syncthreads();
            { LAS float* red = (LAS float*)L3;
#pragma unroll
              for (int r = 0; r < 16; ++r) red[(wv * 32 + CROW(r, hh)) * 32 + n32] = acc[r];
              __syncthreads();
#pragma unroll
              for (int bi = 0; bi < NB; ++bi) { const int m = bi * 8 + wv; float sm = 0.f;
#pragma unroll
                  for (int q = 0; q < 4; ++q) sm += red[((hh * 4 + q) * 32 + m) * 32 + n32];
                  sm += __shfl_xor(sm, 32);
                  if (lane < 32) lgl[(NB * oi + bi) * 32 + n32] = sm; } }
            __syncthreads();
        }
    }
    if (ROUTER) {
        const float* rb = p->in.rb + (size_t)l * NE;
        int nrow = 0; for (int r_ = fbid() * 8 + wv; r_ < T_; r_ += (int)gridDim.x * 8) { ++nrow; asm volatile("" : "+s"(nrow)); }
        asm volatile("s_waitcnt lgkmcnt(0)" ::: "memory");
        int* lcnt = (int*)(lds + 33024 + 8 * 256);
        if (ftid() < NE) lcnt[ftid()] = 0;
        __syncthreads();
#pragma unroll 1
        for (int ri = 0; ri < nrow; ++ri) { const int row = fbid() * 8 + wv + ri * (int)gridDim.x * 8;
            const int e = lane & 31; const float lg = lgl[ri * 32 + e] + rb[e];
            float cur = lg, tv0 = 0.f, den = 0.f, myw = 0.f; int mye = 0;
#pragma unroll
            for (int k = 0; k < TOPK; ++k) { float bv = cur; int bi = e;
#pragma unroll
                for (int o = 16; o >= 1; o >>= 1) { const float ov = __shfl_xor(bv, o); const int oi = __shfl_xor(bi, o); if (ov > bv || (ov == bv && oi < bi)) { bv = ov; bi = oi; } }
                if (k == 0) tv0 = bv;
                const float w = __expf(bv - tv0); den += w;
                if (lane == k) { mye = bi; myw = w; }
                if (e == bi) cur = -3.4e38f; }
            if (lane < TOPK) { WSP(int, O_TOPE)[row * TOPK + lane] = mye; WSP(float, O_TOPW)[row * TOPK + lane] = myw / den; WSP(int, O_POS)[row * TOPK + lane] = atomicAdd(&lcnt[mye], 1); } }
        __syncthreads();
        if (ftid() < NE) { const int c = lcnt[ftid()]; lcnt[ftid()] = (c > 0) ? atomicAdd(WSP(int, O_COUNTS) + CNT_IDX(l, ftid()) + cnt_off, c) : 0; }
        __syncthreads();
#pragma unroll 1
        for (int ri = 0; ri < nrow; ++ri) { const int row = fbid() * 8 + wv + ri * (int)gridDim.x * 8;
            if (lane < TOPK) WSP(int, O_POS)[row * TOPK + lane] += lcnt[WSP(int, O_TOPE)[row * TOPK + lane]]; }
        __syncthreads();
    }
}
__device__ __forceinline__ void ph_bias1_reduce(KP p, int l) {
    if (fbid() != (int)gridDim.x - 1) return;
    const int tid = ftid(); if (tid < 256) { const float* pp = WSP(float, O_BIAS1P) + ((size_t)(l * 2 + (tid >> 7)) * 64) * 128 + (tid & 127);
        float v[64];
#pragma unroll
        for (int s = 0; s < 64; ++s) v[s] = pp[s * 128];
        float a = 0.f;
#pragma unroll
        for (int s = 0; s < 64; ++s) a += v[s];
        WSP(float, O_BIAS1)[l * 256 + tid] = a; }
}
__device__ __forceinline__ void ph_cumsum(float* lds, KP p, int blk0) {
    const int tid = ftid(), lane = tid & 63, wv = tid >> 6; const int bh = fbid() - blk0;
    if (bh < 0 || bh >= B_ * 4) return;
    const int b = bh >> 2, h = bh & 3; const float* gf = WSP(float, O_GF) + (size_t)(b * S_ + tid * 16) * 32 + 24 + h;
    float v[16], run = 0.f;
#pragma unroll
    for (int i = 0; i < 16; ++i) { run += gf[(size_t)i * 32]; v[i] = run; }
    float inc = run;
#pragma unroll
    for (int o = 1; o < 64; o <<= 1) { const float t = __shfl_up(inc, o); if (lane >= o) inc += t; }
    if (lane == 63) lds[wv] = inc;
    __syncthreads();
    float woff = 0.f;
#pragma unroll
    for (int i = 0; i < 8; ++i) woff += (i < wv) ? lds[i] : 0.f;
    const float off = woff + inc - run; float* c = WSP(float, O_CFOX) + (size_t)bh * S_ + tid * 16;
#pragma unroll
    for (int i = 0; i < 4; ++i) *(f32x4*)(c + 4 * i) = (f32x4){v[4 * i] + off, v[4 * i + 1] + off, v[4 * i + 2] + off, v[4 * i + 3] + off};
    __syncthreads();
}
__device__ __forceinline__ void ph_prep2(float* lds, KP p, int l) {
    { unsigned* kmax2 = WSP(unsigned, O_COUNTS) + 192 + l * 8;
      for (int i = fbid() * NT + ftid(); i < B_ * 4 * S_ * 2; i += gridDim.x * NT) { const int half = i & 1, t = (i >> 1) % S_, bh = (i >> 1) / S_, b = bh >> 2, h = bh & 3;
          const bf16_t* kr = WSP(bf16_t, O_PROJB) + (size_t)(b * S_ + t) * PB + C_FOX + (4 + h) * 64 + half * 32; float ss = 0.f;
#pragma unroll
          for (int c = 0; c < 4; ++c) { float k8[8]; ld8(kr + 8 * c, k8);
#pragma unroll
              for (int e = 0; e < 8; ++e) ss += k8[e] * k8[e]; }
          ss += __shfl_xor(ss, 1);
#pragma unroll
          for (int o = 2; o < 64; o <<= 1) ss = fmaxf(ss, __shfl_xor(ss, o));
          __syncthreads();
          if ((ftid() & 63) == 0) lds[ftid() >> 6] = ss;
          __syncthreads();
          if (ftid() == 0) { float mx = lds[0];
#pragma unroll
              for (int w_ = 1; w_ < 8; ++w_) mx = fmaxf(mx, lds[w_]);
              atomicMax(kmax2 + bh, __float_as_uint(mx)); } } }
    for (int i = fbid() * NT + ftid(); i < 8 * 512 * 64; i += gridDim.x * NT) {
        const int d = i & 63, n = (i >> 6) & 511, combo = i >> 15, kv = combo & 1, bg = combo >> 1;
        const float* w2 = (kv ? p->in.w2v : p->in.w2k) + (size_t)l * 128 * 64; const float* h0 = WSP(float, O_HIDP) + ((size_t)combo * 512 + n) * 128; const float* h1 = h0 + (size_t)8 * 512 * 128;
        const float* b1 = WSP(float, O_BIAS1) + l * 256 + kv * 128;
        __syncthreads();
#pragma unroll
        for (int q = 0; q < 4; ++q) *(f32x4*)(lds + 16 + 4 * (q * NT + ftid())) = *(const f32x4*)(w2 + 4 * (q * NT + ftid()));
        const float hv0 = gelu_tanh(h0[d] + h1[d] + b1[d]), hv1 = gelu_tanh(h0[64 + d] + h1[64 + d] + b1[64 + d]);
        __syncthreads();
        const float* w2s = lds + 16 + d;
        float a = 0.f;
#pragma unroll 16
        for (int c = 0; c < 64; ++c) a += __int_as_float(__builtin_amdgcn_readlane(__float_as_int(hv0), c)) * w2s[c * 64];
#pragma unroll 16
        for (int c = 0; c < 64; ++c) a += __int_as_float(__builtin_amdgcn_readlane(__float_as_int(hv1), c)) * w2s[(64 + c) * 64];
        (kv ? WSP(bf16_t, O_VCMPB) : WSP(bf16_t, O_KCMPB))[((size_t)bg * 512 + n) * 64 + d] = (n < NCMP) ? (bf16_t)f2bf(a) : (bf16_t)0; }
}
__device__ __forceinline__ void ph_moe_scatter2(float* lds, KP p, int l) {
    const int tid = ftid(); int* ts = (int*)lds;
    const int* counts = WSP(int, O_COUNTS) + CNT_IDX(l, 0); int* meta = WSP(int, O_META); int* cl = ts + 64;
    __syncthreads();
    if (tid < NE) cl[tid] = counts[tid * 32];
    __syncthreads();
    if (tid == 0) { int nt = 0; for (int e = 0; e < NE; ++e) { ts[e] = nt; nt += (cl[e] + 255) >> 8; } ts[32] = nt; }
    __syncthreads();
    if (fbid() == 0) { if (tid < NE) { const int c = cl[tid], t0 = ts[tid]; meta[tid] = t0; for (int r = 0, t = t0; r < c; r += 256, ++t) { meta[64 + 2 * t] = tid; meta[65 + 2 * t] = (c - r) < 256 ? (c - r) : 256; } }
        if (tid == 0) meta[32] = ts[32]; }
    for (int i = fbid() * NT + tid; i < MROWS; i += gridDim.x * NT) {
        const int row = ts[WSP(int, O_TOPE)[i]] * 256 + WSP(int, O_POS)[i];
        WSP(int, O_ROWTOK)[row] = i >> 2; WSP(float, O_ROWW)[row] = WSP(float, O_TOPW)[i]; WSP(int, O_SLOT)[i] = row; }
    __syncthreads();
}
}
namespace mk {
typedef short bf16x8 __attribute__((ext_vector_type(8)));
typedef float f32x16 __attribute__((ext_vector_type(16)));
typedef float f32x2_t __attribute__((ext_vector_type(2)));
typedef __bf16 bf16x2_t __attribute__((ext_vector_type(2)));
typedef unsigned u32x2 __attribute__((ext_vector_type(2)));
typedef short v4i16_t __attribute__((ext_vector_type(4)));
__device__ __forceinline__ unsigned cvtpk(float lo, float hi) { f32x2_t v = {lo, hi}; bf16x2_t b = __builtin_convertvector(v, bf16x2_t); return __builtin_bit_cast(unsigned, b); }
constexpr int KROW = 144, VROW = 136;
constexpr int E1_K = 0, E1_V = 64 * KROW, E1_C = E1_V + 64 * KROW, E1_BUF = E1_C + 256;
constexpr int E1_FLAGS = 2 * E1_BUF;
constexpr float LOG2E = 1.4426950408889634f;
constexpr float RESC_THR = 8.0f;
#define CROW(reg, hh) (((reg) & 3) + 8 * ((reg) >> 2) + 4 * (hh))

__device__ __forceinline__ float max3f(float a, float b, float c) { float r; asm("v_max3_f32 %0, %1, %2, %3" : "=v"(r) : "v"(a), "v"(b), "v"(c)); return r; }
typedef float f32x2_t __attribute__((ext_vector_type(2)));
__device__ __forceinline__ float lane32_other(float x, int hh) { const auto rr = __builtin_amdgcn_permlane32_swap(__float_as_uint(x), __float_as_uint(x), false, false); return __uint_as_float(hh ? rr[0] : rr[1]); }
#define SM_V(p0, p1, i_) (((i_) & 1) ? p1[(i_) >> 1] : p0[(i_) >> 1])
#define SM_ROWMAX(p0, p1, rm_) do { \
    rm_ = max3f(p0[0], p1[0], p0[1]); \
    _Pragma("unroll") for (int k_ = 0; k_ < 14; ++k_) rm_ = max3f(rm_, SM_V(p0, p1, 3 + 2 * k_), SM_V(p0, p1, 4 + 2 * k_)); \
    rm_ = max3f(rm_, p1[15], p1[15]); \
    { const auto rr_ = __builtin_amdgcn_permlane32_swap(__float_as_uint(rm_), __float_as_uint(rm_), false, false);     \
      rm_ = max3f(__uint_as_float(rr_[0]), __uint_as_float(rr_[1]), __uint_as_float(rr_[1])); } } while (0)
#define SM_CORE(p0, p1, m, l, have, o0, o1) do { \
    float rm_; SM_ROWMAX(p0, p1, rm_); \
    const bool fin_ = rm_ > -1e37f; \
    if (__any((rm_ > RESC_THR) || (!have && fin_))) { \
        const float dl_ = have ? fmaxf(rm_, 0.f) : (fin_ ? rm_ : 0.f); const float al_ = have ? __builtin_amdgcn_exp2f(-dl_) : 1.f; \
        m += dl_; l *= al_; have = have || fin_; \
        _Pragma("unroll") for (int r_ = 0; r_ < 16; ++r_) { o0[r_] *= al_; o1[r_] *= al_; p0[r_] -= dl_; p1[r_] -= dl_; } } \
    f32x2_t ls2_ = {0.f, 0.f}; \
    _Pragma("unroll") for (int reg_ = 0; reg_ < 16; reg_ += 2) { \
        p0[reg_] = __builtin_amdgcn_exp2f(p0[reg_]); p0[reg_ + 1] = __builtin_amdgcn_exp2f(p0[reg_ + 1]); p1[reg_] = __builtin_amdgcn_exp2f(p1[reg_]); p1[reg_ + 1] = __builtin_amdgcn_exp2f(p1[reg_ + 1]); \
        ls2_ += (f32x2_t){p0[reg_], p0[reg_ + 1]}; ls2_ += (f32x2_t){p1[reg_], p1[reg_ + 1]}; } \
    l += ls2_.x + ls2_.y; } while (0)

struct E1Geom { int b, q0, h; const bf16_t* qp; const bf16_t* kp; const bf16_t* vp; size_t pitch; };

template <int KIND>
__device__ __forceinline__ void e1_unit(LAS unsigned char* lds, KP p, int b, int hg, int qb, bf16_t* __restrict__ obase, bf16_t* __restrict__ owin, const unsigned* __restrict__ kmax2) {
    const int tid = ftid(), lane = tid & 63, w = __builtin_amdgcn_readfirstlane(tid >> 6), r32 = lane & 31, hh = lane >> 5;
    const bf16_t* projb = WSP(bf16_t, O_PROJB);
    int h, q0, qrow0, qcol, kcol, vcol, nrows;
    if (KIND == 0) { h = hg; q0 = qb * 256; qrow0 = q0 + 32 * w; qcol = C_FOX + h * 64; kcol = C_FOX + (4 + h) * 64; vcol = C_FOX + (8 + h) * 64; nrows = 256; }
    else if (KIND == 2) { h = hg; q0 = qb * 256; qrow0 = q0 + 32 * w; qcol = C_SB + h * 64; kcol = C_SB + (4 + h) * 64; vcol = C_SB + (8 + h) * 64; nrows = 256; }
    else { h = 4 * hg + (w & 3); q0 = qb * 64; qrow0 = q0 + 32 * (w >> 2); qcol = h * 64; kcol = C_KV + ((2 * 2 + 0) * 2 + hg) * 64; vcol = C_KV + ((2 * 2 + 1) * 2 + hg) * 64; nrows = 64; }
    const int tq = qrow0 + r32;
    const bf16_t* kbase = projb + (size_t)(b * S_) * PB + kcol; const bf16_t* vbase = projb + (size_t)(b * S_) * PB + vcol;
    bf16x8 qf[4];
    { const bf16_t* qptr = projb + (size_t)(b * S_ + tq) * PB + qcol + 8 * hh;
#pragma unroll
      for (int d0 = 0; d0 < 4; ++d0) qf[d0] = *(const bf16x8*)(qptr + 16 * d0);
      if (KIND == 1) {
#pragma unroll
          for (int d0 = 0; d0 < 4; ++d0) { u32x4 w_;
#pragma unroll
              for (int e2 = 0; e2 < 4; ++e2) { const float lo_ = bf2f((unsigned short)qf[d0][2 * e2]) * (SCALE * LOG2E), hi_ = bf2f((unsigned short)qf[d0][2 * e2 + 1]) * (SCALE * LOG2E); w_[e2] = cvtpk(lo_, hi_); }
              qf[d0] = __builtin_bit_cast(bf16x8, w_); } } }
    int j0 = 0; const int j1 = (q0 + nrows - 1) >> 6;
    if (KIND == 1) { j0 = (q0 - 511) >> 6; if (j0 < 0) j0 = 0; }
    const int ntile = j1 - j0 + 1;
    float ct2 = 0.f, sl2 = 0.f; const float* cb = nullptr;
    if (KIND == 0) { cb = WSP(float, O_CFOX) + (size_t)(b * 4 + h) * S_; ct2 = cb[tq] * LOG2E; }
    if (KIND == 1) sl2 = exp2f(-(float)(h + 1)) * LOG2E;
    bf16x8 kx0 = {0, 0, 0, 0, 0, 0, 0, 0}, kx1 = {0, 0, 0, 0, 0, 0, 0, 0}; float sl2h = 0.f, sl2l = 0.f;
    if (KIND == 1) { const unsigned one_ = 0x3f80u; const unsigned k0_ = f2bf((float)r32), k1_ = f2bf((float)(r32 + 32));
        if (hh == 0) { kx0 = __builtin_bit_cast(bf16x8, (u32x4){k0_ | (k0_ << 16), one_ | (one_ << 16), one_, 0u}); kx1 = __builtin_bit_cast(bf16x8, (u32x4){k1_ | (k1_ << 16), one_ | (one_ << 16), one_, 0u}); }
        sl2h = bf2f((unsigned short)f2bf(sl2)); sl2l = sl2 - sl2h; }
    float qkb = 0.f;
    if (KIND == 0) { float qs = 0.f;
#pragma unroll
        for (int d0 = 0; d0 < 4; ++d0)
#pragma unroll
            for (int e = 0; e < 8; ++e) { const float x = bf2f((unsigned short)qf[d0][e]); qs += x * x; }
        qs += __shfl_xor(qs, 32);
        const float km2 = __uint_as_float(kmax2[b * 4 + h]);
        qkb = sqrtf(qs * km2) * (SCALE * LOG2E * 1.01f); }
    const float tqf = (float)tq;
    const int skey = tid >> 3, sch = tid & 7;
    u32x4 rk, rv; float rc = 0.f;
#define E1_LOAD(jj) do { const size_t ro_ = (size_t)((jj) * 64 + skey) * PB + sch * 8; rk = *(const u32x4*)(kbase + ro_); rv = *(const u32x4*)(vbase + ro_); \
        if (KIND == 0 && tid < 64) rc = cb[(jj) * 64 + tid] * LOG2E; } while (0)
#define E1_WRITE(bufp) do { *(LAS u32x4*)((bufp) + E1_K + skey * KROW + sch * 16) = rk; *(LAS u32x4*)((bufp) + E1_V + skey * KROW + sch * 16) = rv; \
        if (KIND == 0 && tid < 64) ((LAS float*)((bufp) + E1_C))[tid] = rc; } while (0)
    f32x16 o0, o1;
#pragma unroll
    for (int r = 0; r < 16; ++r) { o0[r] = 0.f; o1[r] = 0.f; }
    float m = 0.f, l = 0.f, carry = 0.f; bool have = false;
    bool wave_done = false;
    LAS unsigned* flags = (LAS unsigned*)(lds + E1_FLAGS);
    if (KIND != 1) { if (tid < 8) flags[tid] = 0u; }
    __syncthreads();
    E1_LOAD(KIND != 1 ? j1 : j0);
    for (int it = 0; it < ntile; ++it) {
        const int j = (KIND != 1) ? (j1 - it) : (j0 + it);
        LAS unsigned char* buf = lds + (it & 1) * E1_BUF;
        E1_WRITE(buf);
        __syncthreads();
        if (KIND != 1) { unsigned alld = 1u;
#pragma unroll
            for (int i = 0; i < 8; ++i) alld &= flags[i];
            if (alld) break; }
        if (it + 1 < ntile) E1_LOAD((KIND != 1) ? (j - 1) : (j + 1));
        if (!(KIND != 1 && wave_done)) {
            f32x16 p0, p1;
#pragma unroll
            for (int r = 0; r < 16; ++r) { p0[r] = 0.f; p1[r] = 0.f; }
            { const LAS unsigned char* kp_ = buf + E1_K + r32 * KROW + hh * 16;
#pragma unroll
              for (int d0 = 0; d0 < 4; ++d0) { const bf16x8 a0 = *(const LAS bf16x8*)(kp_ + d0 * 32), a1 = *(const LAS bf16x8*)(kp_ + 32 * KROW + d0 * 32);
                  p0 = __builtin_amdgcn_mfma_f32_32x32x16_bf16(a0, qf[d0], p0, 0, 0, 0); p1 = __builtin_amdgcn_mfma_f32_32x32x16_bf16(a1, qf[d0], p1, 0, 0, 0); } }
            const int kb = j * 64 + 4 * hh;
            if (KIND == 2) {
                float lk0[16], lk1[16], gs[8];
#pragma unroll
                for (int reg = 0; reg < 16; ++reg) { const int kpos = kb + CROW(reg, 0);
                    const float z0 = p0[reg] * (SCALE * LOG2E), z1 = p1[reg] * (SCALE * LOG2E); const bool v0 = kpos < tq, v1 = kpos + 32 < tq;
                    const float lb0 = fminf(z0, 0.f) - __builtin_amdgcn_logf(1.f + __builtin_amdgcn_exp2f(-fabsf(z0))), lb1 = fminf(z1, 0.f) - __builtin_amdgcn_logf(1.f + __builtin_amdgcn_exp2f(-fabsf(z1)));
                    lk0[reg] = v0 ? (lb0 - z0) : 0.f; lk1[reg] = v1 ? (lb1 - z1) : 0.f;
                    p0[reg] = v0 ? lb0 : -INFINITY; p1[reg] = v1 ? lb1 : -INFINITY; }
#pragma unroll
                for (int g4 = 0; g4 < 4; ++g4) { gs[g4] = (lk0[4 * g4] + lk0[4 * g4 + 1]) + (lk0[4 * g4 + 2] + lk0[4 * g4 + 3]); gs[4 + g4] = (lk1[4 * g4] + lk1[4 * g4 + 1]) + (lk1[4 * g4 + 2] + lk1[4 * g4 + 3]); }
                float oth[8];
#pragma unroll
                for (int gi = 0; gi < 8; ++gi) oth[gi] = lane32_other(gs[gi], hh);
                float run = 0.f;
#pragma unroll
                for (int gi = 7; gi >= 0; --gi) {
                    float later = carry + run + (hh == 0 ? oth[gi] : 0.f);
#pragma unroll
                    for (int e = 3; e >= 0; --e) { const int reg = (gi & 3) * 4 + e;
                        if (gi >> 2) { p1[reg] = __builtin_amdgcn_exp2f(p1[reg] + later); later += lk1[reg]; } else { p0[reg] = __builtin_amdgcn_exp2f(p0[reg] + later); later += lk0[reg]; } }
                    run += gs[gi] + oth[gi]; }
                carry += run;
            } else {
                if (KIND == 0) {
                    const LAS float* cs = (const LAS float*)(buf + E1_C) + 4 * hh; const float ctm = ct2 - m;
#pragma unroll
                    for (int i = 0; i < 4; ++i) { const f32x4 c0 = *(const LAS f32x4*)(cs + 8 * i), c1 = *(const LAS f32x4*)(cs + 32 + 8 * i);
#pragma unroll
                        for (int e = 0; e < 4; ++e) { const int reg = 4 * i + e; p0[reg] = p0[reg] * (SCALE * LOG2E) + (ctm - c0[e]); p1[reg] = p1[reg] * (SCALE * LOG2E) + (ctm - c1[e]); } }
                    if (!(j * 64 + 63 <= qrow0)) {
#pragma unroll
                        for (int reg = 0; reg < 16; ++reg) { const int kpos = kb + CROW(reg, 0); p0[reg] = (kpos <= tq) ? p0[reg] : -INFINITY; p1[reg] = (kpos + 32 <= tq) ? p1[reg] : -INFINITY; } }
                } else {
                    { const float r_ = sl2 * ((float)(j * 64) - tqf) - m; const float rh_ = bf2f((unsigned short)f2bf(r_)), rm2_ = bf2f((unsigned short)f2bf(r_ - rh_)), rl_ = (r_ - rh_) - rm2_;
                      u32x4 qx_ = {0u, 0u, 0u, 0u}; if (hh == 0) qx_ = (u32x4){cvtpk(sl2h, sl2l), cvtpk(rh_, rm2_), cvtpk(rl_, 0.f), 0u};
                      const bf16x8 qx = __builtin_bit_cast(bf16x8, qx_);
                      p0 = __builtin_amdgcn_mfma_f32_32x32x16_bf16(kx0, qx, p0, 0, 0, 0); p1 = __builtin_amdgcn_mfma_f32_32x32x16_bf16(kx1, qx, p1, 0, 0, 0); }
                    if (!(j * 64 + 63 <= qrow0 && qrow0 + 31 - j * 64 < 512)) {
#pragma unroll
                        for (int reg = 0; reg < 16; ++reg) { const int kpos = kb + CROW(reg, 0);
                            p0[reg] = (kpos <= tq && tq - kpos < 512) ? p0[reg] : -INFINITY; p1[reg] = (kpos + 32 <= tq && tq - kpos - 32 < 512) ? p1[reg] : -INFINITY; } }
                }
                SM_CORE(p0, p1, m, l, have, o0, o1);
            }
            { const int gq_ = lane >> 4, li_ = lane & 15;
              const LAS unsigned char* tb = buf + E1_V + (4 * hh + (li_ >> 2)) * KROW + (16 * (gq_ & 1) + 4 * (li_ & 3)) * 2;
#pragma unroll
              for (int s = 0; s < 4; ++s) {
                  u32x4 pw;
                  if (s < 2) { pw.x = cvtpk(p0[8 * s + 0], p0[8 * s + 1]); pw.y = cvtpk(p0[8 * s + 2], p0[8 * s + 3]); pw.z = cvtpk(p0[8 * s + 4], p0[8 * s + 5]); pw.w = cvtpk(p0[8 * s + 6], p0[8 * s + 7]); }
                  else { const int s2 = s - 2; pw.x = cvtpk(p1[8 * s2 + 0], p1[8 * s2 + 1]); pw.y = cvtpk(p1[8 * s2 + 2], p1[8 * s2 + 3]); pw.z = cvtpk(p1[8 * s2 + 4], p1[8 * s2 + 5]); pw.w = cvtpk(p1[8 * s2 + 6], p1[8 * s2 + 7]); }
                  const bf16x8 pb = __builtin_bit_cast(bf16x8, pw);
                  const v4i16_t a0l = __builtin_amdgcn_ds_read_tr16_b64_v4i16((LAS v4i16_t*)(tb + (16 * s) * KROW)), a0h = __builtin_amdgcn_ds_read_tr16_b64_v4i16((LAS v4i16_t*)(tb + (16 * s + 8) * KROW));
                  const v4i16_t a1l = __builtin_amdgcn_ds_read_tr16_b64_v4i16((LAS v4i16_t*)(tb + (16 * s) * KROW + 64)), a1h = __builtin_amdgcn_ds_read_tr16_b64_v4i16((LAS v4i16_t*)(tb + (16 * s + 8) * KROW + 64));
                  const bf16x8 va0 = (bf16x8){a0l[0], a0l[1], a0l[2], a0l[3], a0h[0], a0h[1], a0h[2], a0h[3]}, va1 = (bf16x8){a1l[0], a1l[1], a1l[2], a1l[3], a1h[0], a1h[1], a1h[2], a1h[3]};
                  o0 = __builtin_amdgcn_mfma_f32_32x32x16_bf16(va0, pb, o0, 0, 0, 0); o1 = __builtin_amdgcn_mfma_f32_32x32x16_bf16(va1, pb, o1, 0, 0, 0); } }
            if (KIND == 0) {
                const float c0 = *(const LAS float*)(buf + E1_C); const bool dn = __all(have && (qkb + (ct2 - c0) - m < -150.f));
                if (dn && !wave_done) { wave_done = true; if (lane == 0) flags[w] = 1u; } }
            if (KIND == 2) { const bool dn = __all(carry < -110.f * LOG2E);
                if (dn && !wave_done) { wave_done = true; if (lane == 0) flags[w] = 1u; } }
        }
    }
    float inv = 1.f, gate = 1.f;
    if (KIND != 2) { l += __shfl_xor(l, 32); inv = (l > 0.f) ? 1.f / l : 0.f; }
    bf16_t* orow;
    if (KIND == 0) orow = obase + (size_t)(b * S_ + tq) * D_ + 512 + h * 64;
    else if (KIND == 2) orow = obase + (size_t)(b * S_ + tq) * D_ + 768 + h * 64;
    else { orow = owin + (size_t)(b * S_ + tq) * 512 + h * 64; gate = WSP(float, O_GF)[(size_t)(b * S_ + tq) * 32 + 2 * 8 + h]; }
    const float sc = inv * gate;
#pragma unroll
    for (int i = 0; i < 4; ++i) {
        *(u32x2*)(orow + 8 * i + 4 * hh) = (u32x2){cvtpk(o0[4 * i] * sc, o0[4 * i + 1] * sc), cvtpk(o0[4 * i + 2] * sc, o0[4 * i + 3] * sc)};
        *(u32x2*)(orow + 32 + 8 * i + 4 * hh) = (u32x2){cvtpk(o1[4 * i] * sc, o1[4 * i + 1] * sc), cvtpk(o1[4 * i + 2] * sc, o1[4 * i + 3] * sc)}; }
#undef E1_LOAD
#undef E1_WRITE
}
}
namespace mk {
constexpr int E2_VT = 64 * 128;
constexpr int E2_WAVE = 2 * E2_VT + 512 + 128;
template <bool USE_MASK>
__device__ __forceinline__ void e2_wave_unit(LAS unsigned char* ldsw, KP p, int b, int g, int t0, bf16_t* __restrict__ obase, const bf16_t* __restrict__ csrc, int cpitch) {
    const int lane = ftid() & 63, r32 = lane & 31, hh = lane >> 5, qi = r32 >> 2, r4 = r32 & 3;
    const int h = 4 * g + r4, tq = t0 + qi;
    const bf16_t* projb = WSP(bf16_t, O_PROJB);
    const bf16_t* kbase = projb + (size_t)(b * S_) * PB + C_KV + ((1 * 2 + 0) * 2 + g) * 64;
    const bf16_t* vbase = projb + (size_t)(b * S_) * PB + C_KV + ((1 * 2 + 1) * 2 + g) * 64;
    bf16x8 qf[4];
    { const bf16_t* qptr = projb + (size_t)(b * S_ + tq) * PB + h * 64 + 8 * hh;
#pragma unroll
      for (int d0 = 0; d0 < 4; ++d0) qf[d0] = *(const bf16x8*)(qptr + 16 * d0); }
    unsigned qm0 = 0u, qm1 = 0u, qm2 = 0u, qm3 = 0u;
    if (USE_MASK) { const u32x4 mw = *(const u32x4*)(WSP(unsigned, O_SELMASK) + ((size_t)((b * 2 + g) * S_ + t0 + (lane >> 3))) * 4); qm0 = mw.x; qm1 = mw.y; qm2 = mw.z; qm3 = mw.w; }
    else { const int* sp = WSP(int, O_SEL) + ((size_t)((b * 2 + g) * S_ + t0)) * NSEL + lane * 2;
      const int e0 = sp[0], e1 = sp[1];
#pragma unroll
      for (int k = 0; k < 2; ++k) { const int e = k ? e1 : e0; const unsigned bit = 1u << (e & 31); const int wd = e >> 5;
          qm0 |= (wd == 0) ? bit : 0u; qm1 |= (wd == 1) ? bit : 0u; qm2 |= (wd == 2) ? bit : 0u; qm3 |= (wd == 3) ? bit : 0u; }
#pragma unroll
      for (int o = 1; o < 8; o <<= 1) { qm0 |= __shfl_xor(qm0, o); qm1 |= __shfl_xor(qm1, o); qm2 |= __shfl_xor(qm2, o); qm3 |= __shfl_xor(qm3, o); } }
    unsigned um0 = qm0, um1 = qm1, um2 = qm2, um3 = qm3;
#pragma unroll
    for (int o = 8; o < 64; o <<= 1) { um0 |= __shfl_xor(um0, o); um1 |= __shfl_xor(um1, o); um2 |= __shfl_xor(um2, o); um3 |= __shfl_xor(um3, o); }
    LAS int* list = (LAS int*)(ldsw + 2 * E2_VT);
    LAS unsigned* rowml = (LAS unsigned*)(ldsw + 2 * E2_VT + 512);
    if ((lane & 7) == 0) *(LAS u32x4*)(rowml + (lane >> 3) * 4) = (u32x4){qm0, qm1, qm2, qm3};
    const LAS unsigned* rowm = rowml + qi * 4;
    int nblk;
    const int curq = __builtin_amdgcn_readfirstlane(t0 >> 6);
    bool diag;
    { const bool s0 = ((((lane < 32) ? um0 : um1) >> (lane & 31)) & 1u) && lane <= curq, s1 = ((((lane < 32) ? um2 : um3) >> (lane & 31)) & 1u) && lane + 64 <= curq;
      const unsigned long long b0 = __ballot(s0), b1 = __ballot(s1);
      const unsigned long long lower = (lane == 0) ? 0ull : (~0ull >> (64 - lane));
      const int n0 = __popcll(b0);
      if (s0) list[__popcll(b0 & lower)] = lane;
      if (s1) list[n0 + __popcll(b1 & lower)] = lane + 64;
      nblk = n0 + __popcll(b1); diag = (((curq < 64) ? (b0 >> curq) : (b1 >> (curq - 64))) & 1ull) != 0ull; }
    const int nfull = nblk - (diag ? 1 : 0);
    asm volatile("s_waitcnt lgkmcnt(0)" ::: "memory");
    const float sl2 = exp2f(-(float)(h + 1)) * LOG2E, tqf = (float)tq;
    f32x16 o0, o1;
#pragma unroll
    for (int r = 0; r < 16; ++r) { o0[r] = 0.f; o1[r] = 0.f; }
    float m = 0.f, l = 0.f; bool have = false;
    const int vrow = lane >> 3, vch = lane & 7;
    const int gq = lane >> 4, li = lane & 15;
    const LAS unsigned char* trb = ldsw + (4 * hh + (li >> 2)) * 128 + (16 * (gq & 1) + 4 * (li & 3)) * 2;
    bf16x8 ka0[4], ka1[4], kb0[4], kb1[4];
#define E2_LOADK(blk, k0_, k1_) do { const bf16_t* kp_ = kbase + (size_t)((blk) * 64 + r32) * PB + 8 * hh; \
        _Pragma("unroll") for (int d0 = 0; d0 < 4; ++d0) { k0_[d0] = *(const bf16x8*)(kp_ + 16 * d0); k1_[d0] = *(const bf16x8*)(kp_ + (size_t)32 * PB + 16 * d0); } } while (0)
#define E2_VDMA(blk, vb_) do { const bf16_t* vp_ = vbase + (size_t)((blk) * 64 + vrow) * PB + vch * 8; \
        _Pragma("unroll") for (int i = 0; i < 8; ++i) __builtin_amdgcn_global_load_lds((const unsigned*)(vp_ + (size_t)(8 * i) * PB), (LAS unsigned*)((vb_) + i * 1024), 16, 0, 0); } while (0)
    { const int b0_ = __builtin_amdgcn_readfirstlane(list[0]);
      E2_VDMA(b0_, ldsw); E2_LOADK(b0_, ka0, ka1);
      { const int b1_ = __builtin_amdgcn_readfirstlane(list[(nblk > 1) ? 1 : 0]); E2_LOADK(b1_, kb0, kb1); } }
    int it = 0;
    auto body = [&](auto mtag_, auto ptag_) __attribute__((always_inline)) {
        constexpr bool MASKED_ = decltype(mtag_)::value; constexpr bool PAR_ = decltype(ptag_)::value;
        const int cur = __builtin_amdgcn_readfirstlane(list[it]);
        const unsigned rw = rowm[cur >> 5];
        LAS unsigned char* vcur = ldsw + (PAR_ ? E2_VT : 0); LAS unsigned char* voth = ldsw + (PAR_ ? 0 : E2_VT);
        { const int nb_ = __builtin_amdgcn_readfirstlane(list[(it + 1 < nblk) ? it + 1 : nblk - 1]); E2_VDMA(nb_, voth); }
        const int nb2_ = __builtin_amdgcn_readfirstlane(list[(it + 2 < nblk) ? it + 2 : nblk - 1]);
        f32x16 p0, p1;
#pragma unroll
        for (int r = 0; r < 16; ++r) { p0[r] = 0.f; p1[r] = 0.f; }
        if (PAR_) {
#pragma unroll
            for (int d0 = 0; d0 < 4; ++d0) { p0 = __builtin_amdgcn_mfma_f32_32x32x16_bf16(kb0[d0], qf[d0], p0, 0, 0, 0); p1 = __builtin_amdgcn_mfma_f32_32x32x16_bf16(kb1[d0], qf[d0], p1, 0, 0, 0); }
            asm volatile("" : "+v"(p0), "+v"(p1) :: "memory");
            E2_LOADK(nb2_, kb0, kb1);
        } else {
#pragma unroll
            for (int d0 = 0; d0 < 4; ++d0) { p0 = __builtin_amdgcn_mfma_f32_32x32x16_bf16(ka0[d0], qf[d0], p0, 0, 0, 0); p1 = __builtin_amdgcn_mfma_f32_32x32x16_bf16(ka1[d0], qf[d0], p1, 0, 0, 0); }
            asm volatile("" : "+v"(p0), "+v"(p1) :: "memory");
            E2_LOADK(nb2_, ka0, ka1);
        }
        const bool rowsel = (rw >> (cur & 31)) & 1u;
        const int kb = cur * 64 + 4 * hh;
        { const float basef = rowsel ? (sl2 * ((float)kb - tqf) - m) : -INFINITY, base1 = basef + 32.f * sl2;
#pragma unroll
          for (int reg = 0; reg < 16; ++reg) { p0[reg] = p0[reg] * (SCALE * LOG2E) + __builtin_fmaf(sl2, (float)CROW(reg, 0), basef); p1[reg] = p1[reg] * (SCALE * LOG2E) + __builtin_fmaf(sl2, (float)CROW(reg, 0), base1); } }
        if (MASKED_) {
#pragma unroll
            for (int reg = 0; reg < 16; ++reg) { const int kpos = kb + CROW(reg, 0); p0[reg] = (kpos <= tq) ? p0[reg] : -INFINITY; p1[reg] = (kpos + 32 <= tq) ? p1[reg] : -INFINITY; } }
        SM_CORE(p0, p1, m, l, have, o0, o1);
        asm volatile("s_waitcnt vmcnt(16)" ::: "memory");
        const LAS unsigned char* trv = trb + (PAR_ ? E2_VT : 0);
#pragma unroll
        for (int s = 0; s < 4; ++s) {
            u32x4 pw;
            if (s < 2) { pw.x = cvtpk(p0[8 * s + 0], p0[8 * s + 1]); pw.y = cvtpk(p0[8 * s + 2], p0[8 * s + 3]); pw.z = cvtpk(p0[8 * s + 4], p0[8 * s + 5]); pw.w = cvtpk(p0[8 * s + 6], p0[8 * s + 7]); }
            else { const int s2 = s - 2; pw.x = cvtpk(p1[8 * s2 + 0], p1[8 * s2 + 1]); pw.y = cvtpk(p1[8 * s2 + 2], p1[8 * s2 + 3]); pw.z = cvtpk(p1[8 * s2 + 4], p1[8 * s2 + 5]); pw.w = cvtpk(p1[8 * s2 + 6], p1[8 * s2 + 7]); }
            const bf16x8 pb = __builtin_bit_cast(bf16x8, pw);
            const v4i16_t a0l = __builtin_amdgcn_ds_read_tr16_b64_v4i16((LAS v4i16_t*)(trv + (16 * s) * 128)), a0h = __builtin_amdgcn_ds_read_tr16_b64_v4i16((LAS v4i16_t*)(trv + (16 * s + 8) * 128));
            const v4i16_t a1l = __builtin_amdgcn_ds_read_tr16_b64_v4i16((LAS v4i16_t*)(trv + (16 * s) * 128 + 64)), a1h = __builtin_amdgcn_ds_read_tr16_b64_v4i16((LAS v4i16_t*)(trv + (16 * s + 8) * 128 + 64));
            const bf16x8 va0 = (bf16x8){a0l[0], a0l[1], a0l[2], a0l[3], a0h[0], a0h[1], a0h[2], a0h[3]}, va1 = (bf16x8){a1l[0], a1l[1], a1l[2], a1l[3], a1h[0], a1h[1], a1h[2], a1h[3]};
            o0 = __builtin_amdgcn_mfma_f32_32x32x16_bf16(va0, pb, o0, 0, 0, 0); o1 = __builtin_amdgcn_mfma_f32_32x32x16_bf16(va1, pb, o1, 0, 0, 0); }
        asm volatile("" ::: "memory");
    };
    for (; it + 1 < nfull; it += 2) { body(std::false_type{}, std::false_type{}); ++it; body(std::false_type{}, std::true_type{}); --it; }
    if (it < nfull) { body(std::false_type{}, std::false_type{}); ++it; if (diag) body(std::true_type{}, std::true_type{}); }
    else if (diag) body(std::true_type{}, std::false_type{});
    asm volatile("s_waitcnt vmcnt(0)" ::: "memory");
#undef E2_LOADK
#undef E2_VDMA
    l += __shfl_xor(l, 32);
    const float sc = ((l > 0.f) ? 1.f / l : 0.f) * WSP(float, O_GF)[(size_t)(b * S_ + tq) * 32 + 1 * 8 + h];
    bf16_t* orow = obase + (size_t)(b * S_ + tq) * D_ + h * 64; const bf16_t* crow = csrc + (size_t)(b * S_ + tq) * cpitch + h * 64;
#pragma unroll
    for (int i = 0; i < 4; ++i) {
        const u32x2 c0 = *(const u32x2*)(crow + 8 * i + 4 * hh), c1 = *(const u32x2*)(crow + 32 + 8 * i + 4 * hh);
        const float x00 = __uint_as_float(c0.x << 16) + o0[4 * i] * sc, x01 = __uint_as_float(c0.x & 0xffff0000u) + o0[4 * i + 1] * sc, x02 = __uint_as_float(c0.y << 16) + o0[4 * i + 2] * sc, x03 = __uint_as_float(c0.y & 0xffff0000u) + o0[4 * i + 3] * sc;
        const float x10 = __uint_as_float(c1.x << 16) + o1[4 * i] * sc, x11 = __uint_as_float(c1.x & 0xffff0000u) + o1[4 * i + 1] * sc, x12 = __uint_as_float(c1.y << 16) + o1[4 * i + 2] * sc, x13 = __uint_as_float(c1.y & 0xffff0000u) + o1[4 * i + 3] * sc;
        *(u32x2*)(orow + 8 * i + 4 * hh) = (u32x2){cvtpk(x00, x01), cvtpk(x02, x03)}; *(u32x2*)(orow + 32 + 8 * i + 4 * hh) = (u32x2){cvtpk(x10, x11), cvtpk(x12, x13)}; }
}
template <bool USE_MASK>
__device__ __forceinline__ void ph_attn_sel2(LAS unsigned char* lds3, KP p, bf16_t* __restrict__ obase, const bf16_t* __restrict__ csrc, int cpitch) {
    const int w = __builtin_amdgcn_readfirstlane(ftid() >> 6);
    LAS unsigned char* ldsw = lds3 + w * E2_WAVE;
    MK_LOOP(u, 512) { const int bg = u & 3, qblk = u >> 2; e2_wave_unit<USE_MASK>(ldsw, p, bg >> 1, bg & 1, qblk * 64 + 8 * w, obase, csrc, cpitch); }
}
}
namespace mk {
constexpr int E3_K = 0, E3_V = 512 * KROW, E3_BYTES = 2 * 512 * KROW;
__device__ __forceinline__ void e3_unit(LAS unsigned char* lds, KP p, int b, int g, int qb, bf16_t* __restrict__ ocmp, unsigned* __restrict__ selmask) {
    const int tid = ftid(), lane = tid & 63, w = __builtin_amdgcn_readfirstlane(tid >> 6), r32 = lane & 31, hh = lane >> 5;
    const int bg = b * 2 + g, q0 = qb * 256, qrow0 = q0 + 32 * w, tq = qrow0 + r32;
    const bf16_t* projb = WSP(bf16_t, O_PROJB);
    int nun = (q0 + 255 - 31) / 16 + 1; if (nun > 511) nun = 511;
    const int ntile_u = (nun + 63) >> 6;
    __syncthreads();
    { const int srow = tid >> 3, sch = tid & 7; const bf16_t* ks = WSP(bf16_t, O_KCMPB) + ((size_t)bg * 512 + srow) * 64 + sch * 8; const bf16_t* vs = WSP(bf16_t, O_VCMPB) + ((size_t)bg * 512 + srow) * 64 + sch * 8;
      for (int i = 0; i < ntile_u; ++i) { const u32x4 kv = *(const u32x4*)(ks + (size_t)i * 64 * 64), vv = *(const u32x4*)(vs + (size_t)i * 64 * 64);
          *(LAS u32x4*)(lds + E3_K + (srow + 64 * i) * KROW + sch * 16) = kv; *(LAS u32x4*)(lds + E3_V + (srow + 64 * i) * KROW + sch * 16) = vv; } }
    __syncthreads();
    int nw = qrow0 / 16 + 1; if (nw > 511) nw = 511;
    const int ntile_w = (qrow0 + 31 < 31) ? 0 : ((nw + 63) >> 6);
    const float tqf = (float)tq;
    const int gq = lane >> 4, li = lane & 15;
    const LAS unsigned char* trb = lds + E3_V + (4 * hh + (li >> 2)) * KROW + (16 * (gq & 1) + 4 * (li & 3)) * 2;
    const LAS unsigned char* kfb = lds + E3_K + r32 * KROW + hh * 16;
    float imp[64];
#pragma unroll
    for (int i = 0; i < 64; ++i) imp[i] = 0.f;
#pragma unroll 1
    for (int r4 = 0; r4 < 4; ++r4) {
        const int h = 4 * g + r4; const float sl2 = exp2f(-(float)(h + 1)) * LOG2E;
        const unsigned qoff = (unsigned)((b * S_ + tq) * PB + h * 64 + 8 * hh);
        f32x16 o0, o1;
#pragma unroll
        for (int r = 0; r < 16; ++r) { o0[r] = 0.f; o1[r] = 0.f; }
        float m = 0.f, l = 0.f; bool have = false;
#define E3_ST(jt) f32x16 p0, p1; { bf16x8 qf[4]; _Pragma("unroll") for (int d0 = 0; d0 < 4; ++d0) qf[d0] = *(const bf16x8*)(projb + qoff + 16 * d0); \
            _Pragma("unroll") for (int r = 0; r < 16; ++r) { p0[r] = 0.f; p1[r] = 0.f; } \
            _Pragma("unroll") for (int d0 = 0; d0 < 4; ++d0) { const bf16x8 a0 = *(const LAS bf16x8*)(kfb + (64 * (jt)) * KROW + d0 * 32), a1 = *(const LAS bf16x8*)(kfb + (64 * (jt) + 32) * KROW + d0 * 32); \
                p0 = __builtin_amdgcn_mfma_f32_32x32x16_bf16(a0, qf[d0], p0, 0, 0, 0); p1 = __builtin_amdgcn_mfma_f32_32x32x16_bf16(a1, qf[d0], p1, 0, 0, 0); } \
            int tq_ = tq; asm volatile("" : "+v"(tq_));     \
            int hh_ = hh; asm volatile("" : "+v"(hh_)); \
            const float tqf_ = (float)tq_; const int ce0_ = 16 * (64 * (jt) + 4 * hh_) + 31; \
            const float basef_ = sl2 * ((float)ce0_ - tqf_) - m, base1_ = basef_ + 512.f * sl2; \
            _Pragma("unroll") for (int reg = 0; reg < 16; ++reg) { const float cr_ = sl2 * (float)(16 * CROW(reg, 0)); p0[reg] = p0[reg] * (SCALE * LOG2E) + (basef_ + cr_); p1[reg] = p1[reg] * (SCALE * LOG2E) + (base1_ + cr_); } \
            if (ce0_ + 16 * 27 + 512 > qrow0) {     \
                _Pragma("unroll") for (int reg = 0; reg < 16; ++reg) { const int ce = ce0_ + 16 * CROW(reg, 0); p0[reg] = (ce <= tq_) ? p0[reg] : -INFINITY; p1[reg] = (ce + 512 <= tq_) ? p1[reg] : -INFINITY; } } }
        float imh[64];
#pragma unroll
        for (int i = 0; i < 64; ++i) imh[i] = 0.f;
#pragma unroll
        for (int jt = 0; jt < 8; ++jt) {
            if (jt < ntile_w) {
                E3_ST(jt);
                {
                    float rm_; SM_ROWMAX(p0, p1, rm_);
                    const bool fin_ = rm_ > -1e37f;
                    if (__any((rm_ > RESC_THR) || (!have && fin_))) {
                        const float dl_ = have ? fmaxf(rm_, 0.f) : (fin_ ? rm_ : 0.f); const float al_ = have ? __builtin_amdgcn_exp2f(-dl_) : 1.f;
                        m += dl_; l *= al_; have = have || fin_;
#pragma unroll
                        for (int r_ = 0; r_ < 16; ++r_) { o0[r_] *= al_; o1[r_] *= al_; p0[r_] -= dl_; p1[r_] -= dl_; }
#pragma unroll
                        for (int i = 0; i < 64; ++i) imh[i] *= al_; }
                    float ls_ = 0.f;
#pragma unroll
                    for (int reg_ = 0; reg_ < 16; ++reg_) { p0[reg_] = __builtin_amdgcn_exp2f(p0[reg_]); p1[reg_] = __builtin_amdgcn_exp2f(p1[reg_]); ls_ += p0[reg_] + p1[reg_]; }
                    l += ls_; }
#pragma unroll
                for (int pa = 0; pa < 2; ++pa)
#pragma unroll
                    for (int i = 0; i < 4; ++i) { const int jj = 8 * jt + 4 * pa + i;
                        const float x0 = pa ? p1[4 * i] : p0[4 * i], x1 = pa ? p1[4 * i + 1] : p0[4 * i + 1], x2 = pa ? p1[4 * i + 2] : p0[4 * i + 2], x3 = pa ? p1[4 * i + 3] : p0[4 * i + 3];
                        const float c = 0.5f * x3, a = (x0 + x1) + (x2 + c), r = lane32_other(c, hh);
                        imh[jj] += a + (hh ? r : 0.f);
                        if (jj + 1 < 64) imh[jj + 1] += (hh ? 0.f : r); }
                const LAS unsigned char* tb = trb + (64 * jt) * KROW;
#pragma unroll
                for (int s = 0; s < 4; ++s) {
                    u32x4 pw;
                    if (s < 2) { pw.x = cvtpk(p0[8 * s + 0], p0[8 * s + 1]); pw.y = cvtpk(p0[8 * s + 2], p0[8 * s + 3]); pw.z = cvtpk(p0[8 * s + 4], p0[8 * s + 5]); pw.w = cvtpk(p0[8 * s + 6], p0[8 * s + 7]); }
                    else { const int s2 = s - 2; pw.x = cvtpk(p1[8 * s2 + 0], p1[8 * s2 + 1]); pw.y = cvtpk(p1[8 * s2 + 2], p1[8 * s2 + 3]); pw.z = cvtpk(p1[8 * s2 + 4], p1[8 * s2 + 5]); pw.w = cvtpk(p1[8 * s2 + 6], p1[8 * s2 + 7]); }
                    const bf16x8 pb = __builtin_bit_cast(bf16x8, pw);
                    const v4i16_t a0l = __builtin_amdgcn_ds_read_tr16_b64_v4i16((LAS v4i16_t*)(tb + (16 * s) * KROW)), a0h = __builtin_amdgcn_ds_read_tr16_b64_v4i16((LAS v4i16_t*)(tb + (16 * s + 8) * KROW));
                    const v4i16_t a1l = __builtin_amdgcn_ds_read_tr16_b64_v4i16((LAS v4i16_t*)(tb + (16 * s) * KROW + 64)), a1h = __builtin_amdgcn_ds_read_tr16_b64_v4i16((LAS v4i16_t*)(tb + (16 * s + 8) * KROW + 64));
                    const bf16x8 va0 = (bf16x8){a0l[0], a0l[1], a0l[2], a0l[3], a0h[0], a0h[1], a0h[2], a0h[3]}, va1 = (bf16x8){a1l[0], a1l[1], a1l[2], a1l[3], a1h[0], a1h[1], a1h[2], a1h[3]};
                    o0 = __builtin_amdgcn_mfma_f32_32x32x16_bf16(va0, pb, o0, 0, 0, 0); o1 = __builtin_amdgcn_mfma_f32_32x32x16_bf16(va1, pb, o1, 0, 0, 0); }
            }
        }
        l += __shfl_xor(l, 32);
        const float inv = (l > 0.f) ? 1.f / l : 0.f;
#pragma unroll
        for (int i = 0; i < 64; ++i) imp[i] += imh[i] * inv;
        { const float sc = inv * WSP(float, O_GF)[(size_t)(b * S_ + tq) * 32 + 0 * 8 + h];
          bf16_t* orow = ocmp + (size_t)(b * S_ + tq) * 512 + h * 64;
#pragma unroll
          for (int i = 0; i < 4; ++i) {
              *(u32x2*)(orow + 8 * i + 4 * hh) = (u32x2){cvtpk(o0[4 * i] * sc, o0[4 * i + 1] * sc), cvtpk(o0[4 * i + 2] * sc, o0[4 * i + 3] * sc)};
              *(u32x2*)(orow + 32 + 8 * i + 4 * hh) = (u32x2){cvtpk(o1[4 * i] * sc, o1[4 * i + 1] * sc), cvtpk(o1[4 * i + 2] * sc, o1[4 * i + 3] * sc)}; } }
#undef E3_ST
    }
    const int cur = tq >> 6;
#pragma unroll
    for (int jj = 0; jj < 64; ++jj) { const int j = 2 * jj + hh; imp[jj] = (j != 0 && j < cur - 1) ? imp[jj] : -1.f; }
    unsigned m0 = 1u, m1 = 0u, m2 = 0u, m3 = 0u;
#define E3_SETBIT(j) do { const unsigned bit_ = 1u << ((j) & 31); const int wd_ = (j) >> 5; m0 |= (wd_ == 0) ? bit_ : 0u; m1 |= (wd_ == 1) ? bit_ : 0u; m2 |= (wd_ == 2) ? bit_ : 0u; m3 |= (wd_ == 3) ? bit_ : 0u; } while (0)
    E3_SETBIT(cur); if (cur >= 1) E3_SETBIT(cur - 1);
#pragma unroll 1
    for (int it = 0; it < NSEL - 3; ++it) {
        float best = -0.5f; int bj = 0;
#pragma unroll
        for (int jj = 0; jj < 64; ++jj) { if (imp[jj] > best) { best = imp[jj]; bj = jj; } }
        const int myj = 2 * bj + hh; const float ob = __shfl_xor(best, 32); const int oj = __shfl_xor(myj, 32);
        const bool mine = (best > ob) || (best == ob && myj < oj);
        const float wv = mine ? best : ob; const int wj = mine ? myj : oj;
        if (wv >= 0.f) E3_SETBIT(wj);
        if (mine && best >= 0.f) {
#pragma unroll
            for (int jj = 0; jj < 64; ++jj) imp[jj] = (jj == bj) ? -2.f : imp[jj]; }
    }
#undef E3_SETBIT
    if (hh == 0) *(u32x4*)(selmask + ((size_t)bg * S_ + tq) * 4) = (u32x4){m0, m1, m2, m3};
}
}
namespace mk {
constexpr int SB_EARLY = 216;
template <int MODE>
__device__ __forceinline__ void ph_attn1(float* lds, LAS unsigned char* lds3, KP p, unsigned* qctr, bf16_t* obase, bf16_t* owin, const unsigned* kmax2) {
    LAS int* qslot = (LAS int*)(lds3 + E3_BYTES);
    constexpr int N_E3 = (MODE & 2) ? 128 : 0, N_CMP = (MODE & 1) ? 64 : 0, N_FOX = (MODE & 4) ? 256 : 0, N_WIN = (MODE & 8) ? 512 : 0, N_SB = (MODE & 16) ? (256 - SB_EARLY) : 0;
    for (;;) {
        __syncthreads();
        if (ftid() == 0) *qslot = (int)atomicAdd(qctr, 1u);
        __syncthreads();
        int u = __builtin_amdgcn_readfirstlane(*qslot);
        if (u >= N_E3 + N_CMP + N_FOX + N_WIN + N_SB) break;
        if (u < N_E3) { e3_unit(lds3, p, (u & 3) >> 1, u & 1, 31 - (u >> 2), WSP(bf16_t, O_OCMP), WSP(unsigned, O_SELMASK)); continue; } u -= N_E3;
        if (u < N_FOX) { e1_unit<0>(lds3, p, (u & 7) >> 2, u & 3, 31 - (u >> 3), obase, owin, kmax2); continue; } u -= N_FOX;
        if (u < N_WIN) { e1_unit<1>(lds3, p, (u & 3) >> 1, u & 1, 127 - (u >> 2), obase, owin, kmax2); continue; } u -= N_WIN;
        if (u < N_SB) { u += SB_EARLY; e1_unit<2>(lds3, p, (u & 7) >> 2, u & 3, 31 - (u >> 3), obase, owin, kmax2); }
    }
}
__device__ __forceinline__ void ph_sb_early(LAS unsigned char* lds3, KP p) {
    const int u = fbid() - 40; if (u < 0 || u >= SB_EARLY) return;
    e1_unit<2>(lds3, p, (u & 7) >> 2, u & 3, 31 - (u >> 3), WSP(bf16_t, O_O), WSP(bf16_t, O_OWIN), nullptr);
}
}
namespace mk {
#define RLX_AGENT __ATOMIC_RELAXED, __HIP_MEMORY_SCOPE_AGENT
#define XB_TMO      128
#define XB_XCNT(j)  (256  + 64 * (j))
#define XB_XSUB(j)  (1280 + 64 * (j))
#define XB_XGEN(j)  (2304 + 64 * (j))
#define XB_TOP      3328
#define XB_TOPGEN   3392
#define XCD_BAR_WORDS 3456
#define XB_SPIN_CAP (1u << 18)

__device__ __forceinline__ unsigned xb_ld(unsigned* p)              { return __hip_atomic_load(p, __ATOMIC_RELAXED, __HIP_MEMORY_SCOPE_AGENT); }
__device__ __forceinline__ unsigned xb_add(unsigned* p, unsigned v) { return __hip_atomic_fetch_add(p, v, __ATOMIC_RELAXED, __HIP_MEMORY_SCOPE_AGENT); }
__device__ __forceinline__ unsigned xb_xcc_id() { return (unsigned)__builtin_amdgcn_s_getreg((3 << 11) | 20) & 0xFu; }
#define XB_SPIN(cond, bar) do { unsigned _sp = 0; while (cond) { __builtin_amdgcn_s_sleep(1); \
    if ((++_sp & 255u) == 0u) { if (xb_ld(&(bar)[XB_TMO])) break; if (_sp > XB_SPIN_CAP) { atomicAdd(&(bar)[XB_TMO], 1u); break; } } } } while (0)

struct XcdBarrier {
    unsigned* bar; unsigned x;
    volatile LAS unsigned* st;
};

__device__ __forceinline__ XcdBarrier xcd_barrier_post(unsigned* bar, volatile LAS unsigned* st) {
    XcdBarrier b; b.bar = bar; b.x = xb_xcc_id(); b.st = st;
    if (threadIdx.x == 0) (void)xb_add(&bar[XB_XCNT(b.x)], 1u);
    return b;
}
__device__ __forceinline__ void xcd_barrier_complete(unsigned* bar, unsigned x, unsigned& nloc, unsigned& nx) {
    const unsigned G = gridDim.x * gridDim.y * gridDim.z;
    unsigned sum, cnt, mine, sp = 0u;
    for (;;) {
        sum = 0u; cnt = 0u; mine = 0u;
#pragma unroll
        for (unsigned j = 0; j < 16; ++j) { const unsigned c = xb_ld(&bar[XB_XCNT(j)]); sum += c; cnt += (c > 0u) ? 1u : 0u; mine = (j == x) ? c : mine; }
        if (sum == G) break;
        __builtin_amdgcn_s_sleep(1);
        if ((++sp & 255u) == 0u) { if (xb_ld(&bar[XB_TMO])) break; if (sp > XB_SPIN_CAP) { atomicAdd(&bar[XB_TMO], 1u); break; } }
    }
    nloc = mine > 0u ? mine : 1u; nx = cnt > 0u ? cnt : 1u;
}

__device__ __forceinline__ void xcd_barrier(const XcdBarrier& b) {
    asm volatile("s_waitcnt vmcnt(0)" ::: "memory");
    __syncthreads();
    if (threadIdx.x == 0) {
        unsigned* bar = b.bar;
        __builtin_amdgcn_s_waitcnt(0);
        unsigned nloc = b.st[0], nx = b.st[1];
        if (nloc == 0u) { xcd_barrier_complete(bar, b.x, nloc, nx); b.st[0] = nloc; b.st[1] = nx; }
        const unsigned old = xb_add(&bar[XB_XSUB(b.x)], 1u);
        const unsigned gen = old / nloc;
        if (old + 1u == (gen + 1u) * nloc) {
            __builtin_amdgcn_fence(__ATOMIC_RELEASE, "agent");
            asm volatile("s_waitcnt vmcnt(0)" ::: "memory");
            const unsigned og = xb_add(&bar[XB_TOP], 1u);
            const unsigned tg = og / nx;
            if (og + 1u == (tg + 1u) * nx) xb_add(&bar[XB_TOPGEN], 1u);
            else XB_SPIN(xb_ld(&bar[XB_TOPGEN]) == tg, bar);
            __builtin_amdgcn_fence(__ATOMIC_ACQUIRE, "agent");
            xb_add(&bar[XB_XGEN(b.x)], 1u);
            asm volatile("s_waitcnt vmcnt(0)" ::: "memory");
        } else {
            XB_SPIN(xb_ld(&bar[XB_XGEN(b.x)]) == gen, bar);
            __builtin_amdgcn_fence(__ATOMIC_ACQUIRE, "agent");
            asm volatile("s_waitcnt vmcnt(0)" ::: "memory");
        }
    }
    __syncthreads();
}

}
namespace cg = cooperative_groups;
constexpr int NSTEP = 12;
#ifndef CVH_GU
#define CVH_GU 1
#define CVH_DN 1
#endif
__global__ void __launch_bounds__(512, 2) mega(mk::P p_unused) {
    extern __shared__ __attribute__((aligned(16))) unsigned char lds_raw[];
    float* lds = (float*)lds_raw;
    LAS unsigned char* lds3 = (LAS unsigned char*)lds_raw;
    using namespace nv; using namespace mk;
    volatile LAS unsigned* bst = (volatile LAS unsigned*)(lds3 + E3_BYTES + 128);
    if (threadIdx.x < 2) bst[threadIdx.x] = 0u;
    __syncthreads();
    XcdBarrier bar;
    { const KP p = fresh_kp(); bar = xcd_barrier_post(WSP(unsigned, O_COUNTS + 16384), bst); }
    cg::this_grid().sync();
    for (int step = 0; step < 1 + NSTEP * L_; ++step) {
        const KP p = fresh_kp();
        const int l = (step - 1) / NSTEP, k = (step == 0) ? -1 : (step - 1) % NSTEP;
        const bool isg = (k == 0 || k == 1 || k == 6 || k == 9 || k == 10);
#ifdef PROBE_K
        const int nrep = (k == PROBE_K) ? PROBE_N : 1;
#else
        const int nrep = 1;
#endif
        for (int rep = 0; rep < nrep; ++rep) {
        int helpchunks = 0;
        if (isg) {
            const int kind = (k == 0) ? 0 : (k == 1) ? 4 : (k == 6) ? 1 : (k == 9) ? 2 : 3;
            GSched S; GEpi E; S.kind = kind; E.kind = kind; E.l = l;
            S.G = (int)gridDim.x; S.c = fbid(); S.meta = WSP(int, O_META); S.rowtok = WSP(int, O_ROWTOK); S.estep = 0;
            const char* A; int N, K = D_;
            if (kind == 0) { A = (const char*)WSP(bf16_t, O_XB); S.Bt = (const char*)(WSP(bf16_t, O_WTIN) + (size_t)l * NPAD * D_); N = NPAD; }
            else if (kind == 1) { A = (const char*)WSP(bf16_t, O_OB); S.Bt = (const char*)(WSP(bf16_t, O_WTOUT) + (size_t)l * D_ * D_); N = D_; }
            else if (kind == 2) { A = (const char*)WSP(bf16_t, O_X1B); S.Bt = (const char*)(WSP(bf16_t, O_WTGU) + (size_t)l * NE * 2048 * D_); S.estep = (size_t)2048 * D_ * 2; N = 2048; }
            else if (kind == 3) { A = (const char*)WSP(bf16_t, O_ACT); S.Bt = (const char*)(WSP(bf16_t, O_WTDN) + (size_t)l * NE * D_ * D_); S.estep = (size_t)D_ * D_ * 2; N = D_; }
            else { A = (const char*)WSP(bf16_t, O_PROJB); S.Bt = (const char*)(WSP(bf16_t, O_WT1) + (size_t)l * 2 * 256 * 2048); S.estep = (size_t)256 * 2048 * 2; N = 256; K = 1024; }
            S.nN = N / 256; S.nM = (kind < 2) ? T_ / 256 : (kind == 4) ? 16 : S.meta[32]; S.nunits = S.nM * S.nN; if (kind == 4) S.nunits = 32;
            pg8::gemm_phase<GEpi, GSched>(lds3, A, K, S, E);
            if (l == 0 && kind >= 2 && kind <= 3 && S.G == 256) {
                const int mine = (S.nunits - S.c + 255) >> 8, most = (S.nunits + 255) >> 8;
                if (mine < most) helpchunks = (kind == 2) ? CVH_GU : CVH_DN; }
            if (kind == 4) { ph_cumsum(lds, p, 32); ph_sb_early(lds3, p); }
            if (kind == 0) ph_bias1_reduce(p, l);
        } else {
            switch (k) {
                case -1: ph_convert(lds3, p); break;
                case 2: ph_prep2(lds, p, l); break;
#ifdef PROBE_AMODE
                case 3: if (rep == 0) ph_attn1<30>(lds, lds3, p, WSP(unsigned, O_COUNTS) + 128 + l * 8 + rep, WSP(bf16_t, O_O), WSP(bf16_t, O_OWIN), WSP(unsigned, O_COUNTS) + 192 + l * 8);
                        else ph_attn1<PROBE_AMODE>(lds, lds3, p, WSP(unsigned, O_COUNTS) + 128 + l * 8 + rep, WSP(bf16_t, O_O), WSP(bf16_t, O_OWIN), WSP(unsigned, O_COUNTS) + 192 + l * 8);
                        break;
#else
                case 3: ph_attn1<30>(lds, lds3, p, WSP(unsigned, O_COUNTS) + 128 + l * 8 + rep, WSP(bf16_t, O_O), WSP(bf16_t, O_OWIN), WSP(unsigned, O_COUNTS) + 192 + l * 8); break;
#endif
                case 4: ph_attn_sel2<true>(lds3, p, WSP(bf16_t, O_O), WSP(bf16_t, O_OCMP), 512); break;
                case 5: ph_rmsnorm(p, l); break;
                case 7: ph_ln<true>(lds, p, l, WSP(float, O_X1), (rep + 1 < nrep) ? 2048 * (rep + 1) : 0); break;
                case 8: ph_moe_scatter2(lds, p, l); break;
                default: { if (l == 0) helpchunks = 1 << 20;
                           float* xout = (l == L_ - 1) ? p->out : WSP(float, O_XA); ph_ln<false>(lds, p, l, xout); } break;
            }
        }
        if (helpchunks > 0) cv_help(lds3, fresh_kp(), helpchunks);
        xcd_barrier(bar);
        }
    }
#ifdef PROBE_SYNC
    for (int i = 0; i < PROBE_SYNC; ++i) xcd_barrier(bar);
#endif
}

extern "C" void kernel_launch(void* const* d_in, const int* in_sizes, int n_in,
                              void* d_out, int out_size, void* d_ws, size_t ws_size,
                              hipStream_t stream) {
    constexpr size_t kDynLds = 147456 + 1024;
    static int grid_blocks = 0;
    if (!grid_blocks) {
        int dev = 0, cus = 0, per_cu = 0;
        (void)hipGetDevice(&dev);
        (void)hipDeviceGetAttribute(&cus, hipDeviceAttributeMultiprocessorCount, dev);
        (void)hipFuncSetAttribute((const void*)mega, hipFuncAttributeMaxDynamicSharedMemorySize, (int)kDynLds);
        (void)hipOccupancyMaxActiveBlocksPerMultiprocessor(&per_cu, mega, 512, kDynLds);
        if (per_cu < 1) per_cu = 1;
        if (per_cu > 1) per_cu = 1;
        grid_blocks = cus * per_cu;
        if (ws_size < mk::O_END) fprintf(stderr, "workspace too small: %zu < %zu\n", ws_size, (size_t)mk::O_END);
        if (grid_blocks != 256) fprintf(stderr, "this kernel's static work split is built for 256 workgroups (MI355X: 256 CUs); got %d\n", grid_blocks);
    }
    mk::P p{};
    p.in = nv::inputs(d_in); p.ws = (unsigned char*)d_ws; p.out = (float*)d_out;
    (void)hipMemsetAsync((char*)d_ws + mk::O_COUNTS, 0, 65536, stream);
    void* args[] = {&p};
    hipError_t e = hipLaunchCooperativeKernel((void*)mega, dim3(grid_blocks), dim3(512), args, kDynLds, stream);
    if (e != hipSuccess) fprintf(stderr, "cooperative launch failed: %s (grid %d)\n", hipGetErrorString(e), grid_blocks);
}
```

```cpp
#include <hip/hip_runtime.h>
#include <hip/hip_cooperative_groups.h>
#include <cstdio>
#include <cstdint>

namespace nv {

constexpr int B_ = 2, S_ = 8192, D_ = 1024, T_ = B_ * S_, L_ = 2;
constexpr int DIN = 2844;
constexpr int OFF_NSA_KV = 512, OFF_NSA_GATE = 1280, OFF_FOX_QKV = 1304, OFF_FOX_F = 2072, OFF_SB_QKV = 2076;
constexpr int NCMP = 511, NBLK = 128, NSEL = 16;
constexpr int NE = 32, TOPK = 4, MROWS = T_ * TOPK;
constexpr float LN_EPS = 1e-5f, RMS_EPS = 1e-6f;
constexpr float ALPHA = 1.4142135623730951f;
constexpr float SCALE = 0.125f;

__device__ __forceinline__ float sigmoidf_(float x) { return __builtin_amdgcn_rcpf(1.f + __builtin_amdgcn_exp2f(-1.4426950408889634f * x)); }
__device__ __forceinline__ float logsig(float x) { return fminf(x, 0.f) - 0.6931471805599453f * __builtin_amdgcn_logf(1.f + __builtin_amdgcn_exp2f(-1.4426950408889634f * fabsf(x))); }

__device__ __forceinline__ float gelu_tanh(float x) { return 0.5f * x * (1.f + tanhf(0.7978845608028654f * (x + 0.044715f * x * x * x))); }
__device__ __forceinline__ float wsum(float v) {
    v += __int_as_float(__builtin_amdgcn_update_dpp(0, __float_as_int(v), 0xB1, 0xF, 0xF, true));
    v += __int_as_float(__builtin_amdgcn_update_dpp(0, __float_as_int(v), 0x4E, 0xF, 0xF, true));
    v += __int_as_float(__builtin_amdgcn_update_dpp(0, __float_as_int(v), 0x141, 0xF, 0xF, true));
    v += __int_as_float(__builtin_amdgcn_update_dpp(0, __float_as_int(v), 0x140, 0xF, 0xF, true));
    const float r0 = __int_as_float(__builtin_amdgcn_readlane(__float_as_int(v), 0)), r1 = __int_as_float(__builtin_amdgcn_readlane(__float_as_int(v), 16));
    const float r2 = __int_as_float(__builtin_amdgcn_readlane(__float_as_int(v), 32)), r3 = __int_as_float(__builtin_amdgcn_readlane(__float_as_int(v), 48));
    return (r0 + r1) + (r2 + r3);
}
struct In {
    const float *x, *w_in, *b_in, *pos_k, *pos_v, *w1k, *w2k, *w1v, *w2v, *g_out, *w_out, *ln1_g, *ln1_b, *rw, *rb, *wgu, *bgu, *wdn, *bdn, *ln2_g, *ln2_b;
};
inline In inputs(void* const* d) {
    In i; i.x = (const float*)d[0]; i.w_in = (const float*)d[1]; i.b_in = (const float*)d[2]; i.pos_k = (const float*)d[3]; i.pos_v = (const float*)d[4];
    i.w1k = (const float*)d[5]; i.w2k = (const float*)d[6]; i.w1v = (const float*)d[7]; i.w2v = (const float*)d[8]; i.g_out = (const float*)d[9]; i.w_out = (const float*)d[10];
    i.ln1_g = (const float*)d[11]; i.ln1_b = (const float*)d[12]; i.rw = (const float*)d[13]; i.rb = (const float*)d[14]; i.wgu = (const float*)d[15]; i.bgu = (const float*)d[16];
    i.wdn = (const float*)d[17]; i.bdn = (const float*)d[18]; i.ln2_g = (const float*)d[19]; i.ln2_b = (const float*)d[20]; return i;
}


}
namespace pg8 {
#define PG8_LAS __attribute__((address_space(3)))
typedef unsigned short bf16_t;
typedef short bf16x8 __attribute__((ext_vector_type(8)));
typedef float f32x4 __attribute__((ext_vector_type(4)));
typedef unsigned u32x4 __attribute__((ext_vector_type(4)));
constexpr int BM = 256, BK = 64, HALF = 128, HTB = HALF * BK * 2  , STAGE_BYTES = 8 * HTB, NXCD = 8, WGM = 8;

__host__ __device__ __forceinline__ int lds_byte(int r, int c) { const int st = (r >> 4) * 2 + (c >> 5), rr = r & 15, cc = c & 31, ob = rr * 64 + cc * 2; return st * 1024 + (ob ^ (((ob >> 9) & 1) << 5)); }
__host__ __device__ __forceinline__ void stage_rc(int b, int& R, int& C) { const int st = b / 1024, sb = b % 1024, swz = sb ^ (((sb >> 9) & 1) << 5); R = (st >> 1) * 16 + swz / 64; C = (st & 1) * 32 + (swz % 64) / 2; }
__host__ __device__ __forceinline__ int perm32(int rho) { const int n = rho >> 4, i = rho & 15; return 8 * (i >> 2) + 4 * n + (i & 3); }

struct Unit { int pm, pn, e, nr; };

__device__ __forceinline__ unsigned cvt_pk_bf16(float lo, float hi) { unsigned r; asm volatile("v_cvt_pk_bf16_f32 %0, %1, %2" : "=v"(r) : "v"(lo), "v"(hi)); return r; }
template <class Epi, class Sched, bool ALIGN_EPI = true, bool SP2 = true>
__device__ __forceinline__ void gemm_phase(PG8_LAS unsigned char* lds, const char* Abase, const int K, const Sched& S, const Epi& E) {
    int tid_ = threadIdx.x; asm volatile("" : "+v"(tid_));
    const int tid = tid_, wid = __builtin_amdgcn_readfirstlane(tid >> 6), lane = tid & 63, wr = wid >> 2, wc = wid & 3, fr = lane & 15, fq = lane >> 4;
    const int nt_full = K / BK;
    unsigned voffB[2];
#pragma unroll
    for (int i = 0; i < 2; ++i) { int R, C; stage_rc(tid * 16 + i * 8192, R, C); const int Rb = Epi::PERM ? ((R & ~31) + perm32(R & 31)) : R;
        voffB[i] = (unsigned)(Rb * K + C) * 2u; }
#define PG8_AOFF(u, o0, o1) do { int _t = tid; asm volatile("" : "+v"(_t)); _Pragma("unroll") for (int _i = 0; _i < 2; ++_i) { int _R, _C; stage_rc(_t * 16 + _i * 8192, _R, _C); \
        (o0)[_i] = S.a_off((u), _R) + (unsigned)_C * 2u; (o1)[_i] = S.a_off((u), HALF + _R) + (unsigned)_C * 2u; } } while (0)
    const size_t kstep = (size_t)(BK * 2);
    const size_t akstep = S.a_kstep();
    const size_t hstep = (size_t)HALF * K * 2;
    const unsigned ldsw = (unsigned)wid * 1024u;
    const int aoff = lds_byte(wr * 64 + fr, fq * 8), boff = lds_byte(wc * 32 + fr, fq * 8);
#define PG8_SA(b, h) (((b) * 2 + (h)) * HTB)
#define PG8_SB(b, h) ((4 + (b) * 2 + (h)) * HTB)
#define PG8_STAGE(bufoff, gbase, voff) do { _Pragma("unroll") for (int _i = 0; _i < 2; ++_i) { unsigned _o = (voff)[_i]; asm volatile("" : "+v"(_o));     \
        __builtin_amdgcn_global_load_lds((const unsigned*)((const char*)(gbase) + _o), (PG8_LAS unsigned*)(lds + (bufoff) + ldsw + _i * 8192), 16, 0, 0); } } while (0)
#define PG8_LDA(dst, b, h) do { _Pragma("unroll") for (int m = 0; m < 4; ++m) _Pragma("unroll") for (int k = 0; k < 2; ++k) dst[m][k] = *(const PG8_LAS bf16x8*)(lds + PG8_SA(b, h) + aoff + m * 2048 + k * 1024); } while (0)
#define PG8_LDB(dst, b, h) do { _Pragma("unroll") for (int n = 0; n < 2; ++n) _Pragma("unroll") for (int k = 0; k < 2; ++k) dst[n][k] = *(const PG8_LAS bf16x8*)(lds + PG8_SB(b, h) + boff + n * 2048 + k * 1024); } while (0)
#define PG8_MMA(ai, bj, At, Bt) do { __builtin_amdgcn_s_setprio(1); _Pragma("unroll") for (int m = 0; m < 4; ++m) _Pragma("unroll") for (int n = 0; n < 2; ++n) _Pragma("unroll") for (int k = 0; k < 2; ++k) \
        acc[ai][bj][m][n] = __builtin_amdgcn_mfma_f32_16x16x32_bf16(Bt[n][k], At[m][k], acc[ai][bj][m][n], 0, 0, 0); __builtin_amdgcn_s_setprio(0); } while (0)
#define PG8_WAIT_V(n) asm volatile("s_waitcnt vmcnt(" #n ")" ::: "memory")
#define PG8_WAIT_L(n) asm volatile("s_waitcnt lgkmcnt(" #n ")" ::: "memory")
#define PG8_BAR __builtin_amdgcn_s_barrier()
#define PG8_SCHED __builtin_amdgcn_sched_barrier(0)
    Unit cur, nxt; int ui = 0;
    if (!S.next(0, cur)) return;
    f32x4 acc[2][2][4][2];
    float zf_ = 0.f; asm volatile("" : "+v"(zf_));
#pragma unroll
    for (int a = 0; a < 2; ++a)
#pragma unroll
        for (int b = 0; b < 2; ++b)
#pragma unroll
            for (int m = 0; m < 4; ++m)
#pragma unroll
                for (int n = 0; n < 2; ++n) acc[a][b][m][n] = (f32x4){zf_, zf_, zf_, zf_};
    bf16x8 At[4][2], B0[2][2], B1[2][2];
    unsigned ca0[2], ca1[2], na0[2], na1[2];
    PG8_AOFF(cur, ca0, ca1);
    const char* const cA = Abase; const char* cB = S.b_base(cur);
    if constexpr (SP2) {
        PG8_STAGE(PG8_SB(0, 0), cB, voffB); PG8_STAGE(PG8_SB(0, 1), cB + hstep, voffB); PG8_STAGE(PG8_SA(0, 0), cA, ca0); PG8_STAGE(PG8_SA(0, 1), cA, ca1);
        if (wr == 1) PG8_BAR;
        PG8_WAIT_V(2); PG8_BAR;
        PG8_STAGE(PG8_SB(1, 0), cB + kstep, voffB); PG8_STAGE(PG8_SA(1, 0), cA + akstep, ca0); PG8_STAGE(PG8_SB(1, 1), cB + hstep + kstep, voffB);
        PG8_WAIT_V(6); PG8_BAR;
    } else { static_assert(SP2, "only the SP2 loop is kept"); }
    for (;;) {
        const bool has_next = S.next(ui + 1, nxt);
        const int nt = S.unit_nt(cur, nt_full);
        const char* nB = has_next ? S.b_base(nxt) : cB;
        if (has_next) { PG8_AOFF(nxt, na0, na1); } else { na0[0] = ca0[0]; na0[1] = ca0[1]; na1[0] = ca1[0]; na1[1] = ca1[1]; }
        for (int t = 0; t < nt - 2; t += 2) {
            const char* a1 = cA + (size_t)(t + 1) * akstep;
            const char* a2 = cA + (size_t)(t + 2) * akstep; const char* b2 = cB + (size_t)(t + 2) * kstep;
            const char* a3 = a2 + akstep; const char* b3 = b2 + kstep;
            PG8_LDB(B0, 0, 0); PG8_LDB(B1, 0, 1); PG8_SCHED; PG8_LDA(At, 0, 0); PG8_STAGE(PG8_SA(1, 1), a1, ca1);
            PG8_WAIT_V(8); PG8_WAIT_L(0); PG8_BAR; PG8_MMA(0, 0, At, B0); PG8_MMA(0, 1, At, B1); PG8_BAR; PG8_SCHED;
            PG8_LDA(At, 0, 1); PG8_STAGE(PG8_SB(0, 0), b2, voffB); PG8_STAGE(PG8_SB(0, 1), b2 + hstep, voffB); PG8_STAGE(PG8_SA(0, 0), a2, ca0);
            PG8_WAIT_V(8); PG8_WAIT_L(0); PG8_BAR; PG8_MMA(1, 0, At, B0); PG8_MMA(1, 1, At, B1); PG8_BAR; PG8_SCHED;
            PG8_LDB(B0, 1, 0); PG8_LDB(B1, 1, 1); PG8_SCHED; PG8_LDA(At, 1, 0); PG8_STAGE(PG8_SA(0, 1), a2, ca1);
            PG8_WAIT_V(8); PG8_WAIT_L(0); PG8_BAR; PG8_MMA(0, 0, At, B0); PG8_MMA(0, 1, At, B1); PG8_BAR; PG8_SCHED;
            PG8_LDA(At, 1, 1); PG8_STAGE(PG8_SB(1, 0), b3, voffB); PG8_STAGE(PG8_SB(1, 1), b3 + hstep, voffB); PG8_STAGE(PG8_SA(1, 0), a3, ca0);
            PG8_WAIT_V(8); PG8_WAIT_L(0); PG8_BAR; PG8_MMA(1, 0, At, B0); PG8_MMA(1, 1, At, B1); PG8_BAR; PG8_SCHED;
        }
        {
            const char* a1 = cA + (size_t)(nt - 1) * akstep;
            const char* a2 = cA; const char* b2 = nB; const char* a3 = a2 + akstep; const char* b3 = b2 + kstep;
            PG8_LDB(B0, 0, 0); PG8_LDB(B1, 0, 1); PG8_SCHED; PG8_LDA(At, 0, 0); PG8_STAGE(PG8_SA(1, 1), a1, ca1);
            PG8_WAIT_V(8); PG8_WAIT_L(0); PG8_BAR; PG8_MMA(0, 0, At, B0); PG8_MMA(0, 1, At, B1); PG8_BAR; PG8_SCHED;
            PG8_LDA(At, 0, 1); PG8_STAGE(PG8_SB(0, 0), b2, voffB); PG8_STAGE(PG8_SB(0, 1), b2 + hstep, voffB); PG8_STAGE(PG8_SA(0, 0), a2, na0);
            PG8_WAIT_V(8); PG8_WAIT_L(0); PG8_BAR; PG8_MMA(1, 0, At, B0); PG8_MMA(1, 1, At, B1); PG8_BAR; PG8_SCHED;
            PG8_LDB(B0, 1, 0); PG8_LDB(B1, 1, 1); PG8_SCHED; PG8_LDA(At, 1, 0); PG8_STAGE(PG8_SA(0, 1), a2, na1);
            PG8_WAIT_V(8); PG8_WAIT_L(0); PG8_BAR; PG8_MMA(0, 0, At, B0); PG8_MMA(0, 1, At, B1); PG8_BAR; PG8_SCHED;
            PG8_LDA(At, 1, 1); PG8_STAGE(PG8_SB(1, 0), b3, voffB); PG8_STAGE(PG8_SB(1, 1), b3 + hstep, voffB); PG8_STAGE(PG8_SA(1, 0), a3, na0);
            PG8_WAIT_V(8); PG8_WAIT_L(0); PG8_BAR; PG8_MMA(1, 0, At, B0); PG8_MMA(1, 1, At, B1); PG8_BAR; PG8_SCHED;
        }
        if constexpr (ALIGN_EPI) { if (wr == 0) PG8_BAR; }
        E(acc, cur, wr, wc, fr, fq);
        if (!has_next) break;
#pragma unroll
        for (int a = 0; a < 2; ++a)
#pragma unroll
            for (int b = 0; b < 2; ++b)
#pragma unroll
                for (int m = 0; m < 4; ++m)
#pragma unroll
                    for (int n = 0; n < 2; ++n) acc[a][b][m][n] = (f32x4){zf_, zf_, zf_, zf_};
        cur = nxt; cB = nB; ++ui; ca0[0] = na0[0]; ca0[1] = na0[1]; ca1[0] = na1[0]; ca1[1] = na1[1];
        if constexpr (ALIGN_EPI) { if (wr == 1) PG8_BAR; }
    }
    PG8_WAIT_V(0);
    if constexpr (!ALIGN_EPI) { if (wr == 0) PG8_BAR; }
    PG8_BAR;
#undef PG8_AOFF
#undef PG8_SA
#undef PG8_SB
#undef PG8_STAGE
#undef PG8_LDA
#undef PG8_LDB
#undef PG8_MMA
#undef PG8_WAIT_V
#undef PG8_WAIT_L
#undef PG8_BAR
#undef PG8_SCHED
}

}
namespace mk {
using namespace nv;
typedef unsigned short bf16_t;
typedef unsigned u32x4 __attribute__((ext_vector_type(4)));
typedef float f32x4 __attribute__((ext_vector_type(4)));
#define LAS __attribute__((address_space(3)))
typedef short bf16x8 __attribute__((ext_vector_type(8)));
typedef float f32x16 __attribute__((ext_vector_type(16)));
#define CROW(reg, hh) (((reg) & 3) + 8 * ((reg) >> 2) + 4 * (hh))
constexpr int NT = 512;
constexpr int PB = 2816;
constexpr int NPAD = 3072;
constexpr int C_KV = 512, C_FOX = 1280, C_SB = 2048, C_GATE = 2816;
constexpr int MAXT = MROWS / 256 + NE;
constexpr int PROWS = MAXT * 256;
#define CNT_IDX(l, e) (8192 + ((l) * NE + (e)) * 32)
__device__ __forceinline__ int ftid() { int t = threadIdx.x; asm volatile("" : "+v"(t)); return t; }
__device__ __forceinline__ int fbid() { int b = blockIdx.x; asm volatile("" : "+s"(b)); return b; }
#define MK_LOOP(vb, n) for (int vb = fbid(); vb < (n); vb += gridDim.x)

constexpr size_t al_(size_t x) { return (x + 4095) & ~(size_t)4095; }
constexpr size_t O_WTIN = 0;
constexpr size_t O_WTOUT = O_WTIN + al_((size_t)L_ * NPAD * D_ * 2);
constexpr size_t O_WTGU = O_WTOUT + al_((size_t)L_ * D_ * D_ * 2);
constexpr size_t O_WTDN = O_WTGU + al_((size_t)L_ * NE * 2048 * D_ * 2);
constexpr size_t O_BIASP = O_WTDN + al_((size_t)L_ * NE * D_ * D_ * 2);
constexpr size_t O_XB = O_BIASP + al_((size_t)L_ * NPAD * 4);
constexpr size_t O_PROJB = O_XB + al_((size_t)T_ * D_ * 2);
constexpr size_t O_GF = O_PROJB + al_((size_t)T_ * PB * 2);
constexpr size_t O_CFOX = O_GF + al_((size_t)T_ * 32 * 4);
constexpr size_t O_KCMP = O_CFOX + al_((size_t)B_ * 4 * S_ * 4);
constexpr size_t O_VCMP = O_KCMP + al_((size_t)B_ * 2 * 512 * 64 * 4);
constexpr size_t O_O = O_VCMP + al_((size_t)B_ * 2 * 512 * 64 * 4);
constexpr size_t O_OB = O_O + al_((size_t)T_ * D_ * 4);
constexpr size_t O_PTOT = O_OB + al_((size_t)T_ * D_ * 2);
constexpr size_t O_SEL = O_PTOT + al_((size_t)B_ * 2 * S_ * 512 * 4);
constexpr size_t O_MIX = O_SEL + al_((size_t)B_ * 2 * S_ * NSEL * 4);
constexpr size_t O_X1 = O_MIX + al_((size_t)T_ * D_ * 4);
constexpr size_t O_X1B = O_X1 + al_((size_t)T_ * D_ * 4);
constexpr size_t O_XA = O_X1B + al_((size_t)T_ * D_ * 2);
constexpr size_t O_ACT = O_XA + al_((size_t)T_ * D_ * 4);
constexpr size_t O_Y = O_ACT + al_((size_t)PROWS * D_ * 2);
constexpr size_t O_TOPE = O_Y + al_((size_t)PROWS * D_ * 2);
constexpr size_t O_TOPW = O_TOPE + al_((size_t)MROWS * 4);
constexpr size_t O_POS = O_TOPW + al_((size_t)MROWS * 4);
constexpr size_t O_ROWTOK = O_POS + al_((size_t)MROWS * 4);
constexpr size_t O_ROWW = O_ROWTOK + al_((size_t)PROWS * 4);
constexpr size_t O_SLOT = O_ROWW + al_((size_t)PROWS * 4);
constexpr size_t O_COUNTS = O_SLOT + al_((size_t)MROWS * 4);
constexpr size_t O_META = O_COUNTS + 65536;
constexpr size_t O_OWIN = O_META + 4096;
constexpr size_t O_O2 = O_OWIN + al_((size_t)T_ * 512 * 4);
constexpr size_t O_OWIN2 = O_O2 + al_((size_t)T_ * D_ * 4);
constexpr size_t O_KCMPB = O_OWIN2 + al_((size_t)T_ * 512 * 4);
constexpr size_t O_VCMPB = O_KCMPB + al_((size_t)B_ * 2 * 512 * 64 * 2);
constexpr size_t O_OCMP = O_VCMPB + al_((size_t)B_ * 2 * 512 * 64 * 2);
constexpr size_t O_SELMASK = O_OCMP + al_((size_t)T_ * 512 * 4);
constexpr size_t O_WT1 = O_SELMASK + al_((size_t)B_ * 2 * S_ * 16);
constexpr size_t O_BIAS1 = O_WT1 + al_((size_t)L_ * 2 * 256 * 2048 * 2);
constexpr size_t O_HID = O_BIAS1 + al_((size_t)L_ * 2 * 128 * 4);
constexpr size_t O_BIAS1P = O_HID + al_((size_t)8 * 512 * 128 * 2);
constexpr size_t O_RWT = O_BIAS1P + al_((size_t)L_ * 2 * 64 * 128 * 4);
constexpr size_t O_HIDP = O_RWT + al_((size_t)L_ * 2 * NE * D_ * 2);
constexpr size_t O_BC = O_HIDP + al_((size_t)2 * 8 * 512 * 128 * 4);
constexpr size_t O_Y2 = O_BC + al_((size_t)L_ * 256 * NE * 4);
constexpr size_t O_KSELF = O_Y2 + al_((size_t)(PROWS - 65536) * D_ * 2);
constexpr size_t O_VSELF = O_KSELF + al_((size_t)B_ * 2 * S_ * 64 * 2);
constexpr size_t O_END = O_VSELF + al_((size_t)B_ * 2 * S_ * 64 * 2);

struct P {
    In in; unsigned char* ws; float* out;
};
typedef const __attribute__((address_space(4))) P* KP;
__device__ __forceinline__ KP fresh_kp() { KP k = (KP)__builtin_amdgcn_kernarg_segment_ptr(); asm volatile("" : "+s"(k)); return k; }
#define WSP(T, off) ((T*)(p->ws + (off)))

__device__ __forceinline__ float bf2f(unsigned short b) { return __uint_as_float((unsigned)b << 16); }
__device__ __forceinline__ unsigned f2bf(float f) { unsigned u = __float_as_uint(f); return (u + 0x7fffu + ((u >> 16) & 1u)) >> 16; }
__device__ __forceinline__ unsigned pk2(float lo, float hi) { return pg8::cvt_pk_bf16(lo, hi); }
__device__ __forceinline__ void ld8(const bf16_t* __restrict__ src, float* dst) {
    const u32x4 v = *(const u32x4*)src;
    dst[0] = __uint_as_float(v.x << 16); dst[1] = __uint_as_float(v.x & 0xffff0000u); dst[2] = __uint_as_float(v.y << 16); dst[3] = __uint_as_float(v.y & 0xffff0000u);
    dst[4] = __uint_as_float(v.z << 16); dst[5] = __uint_as_float(v.z & 0xffff0000u); dst[6] = __uint_as_float(v.w << 16); dst[7] = __uint_as_float(v.w & 0xffff0000u);
}


__device__ __forceinline__ int perm_in(int n) {
    if (n < 1280) return n;
    if (n < 1304) return C_GATE + (n - 1280);
    if (n < 2072) return C_FOX + (n - 1304);
    if (n < 2076) return C_GATE + 24 + (n - 2072);
    return C_SB + (n - 2076);
}
__device__ __forceinline__ int perm_gu(int n) { const int up = n >> 10, c = n & 1023; return 256 * (c >> 7) + 128 * up + (c & 127); }
template <int MAP>
__device__ __forceinline__ void transpose_item(const float* __restrict__ W, int K, int N, bf16_t* __restrict__ WT, LAS float* scr, int item, int lane) {
    const int nblk = (N + 31) / 32, kb = item / nblk, nb = item % nblk, k0 = 64 * kb, n0 = 32 * nb;
    { const int n4 = (lane & 7) * 4; const bool okn = (n0 + n4) < N;
      f32x4 t[8];
#pragma unroll
      for (int i = 0; i < 8; ++i) { const int kk = (lane >> 3) + 8 * i; t[i] = okn ? __builtin_nontemporal_load((const f32x4*)(W + (size_t)(k0 + kk) * N + n0 + n4)) : (f32x4){0.f, 0.f, 0.f, 0.f}; }
#pragma unroll
      for (int i = 0; i < 8; ++i) { const int kk = (lane >> 3) + 8 * i; LAS float* d = scr + kk * 33 + n4; d[0] = t[i].x; d[1] = t[i].y; d[2] = t[i].z; d[3] = t[i].w; } }
    asm volatile("s_waitcnt lgkmcnt(0)" ::: "memory");
    const int c = lane & 7;
#pragma unroll
    for (int j = 0; j < 4; ++j) { const int n = (lane >> 3) + 8 * j; const LAS float* sp = scr + (8 * c) * 33 + n;
        u32x4 o; o.x = pk2(sp[0 * 33], sp[1 * 33]); o.y = pk2(sp[2 * 33], sp[3 * 33]); o.z = pk2(sp[4 * 33], sp[5 * 33]); o.w = pk2(sp[6 * 33], sp[7 * 33]);
        const int ng = n0 + n;
        if (ng < N) { const int ro = (MAP == 1) ? perm_in(ng) : (MAP == 2) ? perm_gu(ng) : ng;
            if (MAP == 3) *(u32x4*)(WT + (size_t)(k0 >> 10) * 256 * 1024 + (size_t)ro * 1024 + (k0 & 1023) + 8 * c) = o;
            else *(u32x4*)(WT + (size_t)ro * K + k0 + 8 * c) = o; } }
    asm volatile("s_waitcnt lgkmcnt(0)" ::: "memory");
}
constexpr int CV_I_IN = 16 * 89, CV_I_OUT = 16 * 32, CV_I_GU = 16 * 64, CV_I_DN = 16 * 32, CV_I_W1 = 32 * 4;
constexpr int CV_N_IN = L_ * CV_I_IN, CV_N_OUT = L_ * CV_I_OUT, CV_N_GU = L_ * NE * CV_I_GU, CV_N_DN = L_ * NE * CV_I_DN, CV_N_W1 = L_ * 2 * CV_I_W1, CV_N_ALL = CV_N_IN + CV_N_OUT + CV_N_GU + CV_N_DN + CV_N_W1;
constexpr int CV_DEF_GU0 = CV_N_W1 + NE * CV_I_GU, CV_DEF_GU = NE * CV_I_GU, CV_DEF_DN0 = CV_N_W1 + CV_N_GU + NE * CV_I_DN, CV_DEF_DN = NE * CV_I_DN, CV_DEF_ALL = CV_DEF_GU + CV_DEF_DN;
__device__ __forceinline__ void cv_one(KP p, LAS float* scr, int it, int lane) {
    int r = it;
    if (r < CV_N_W1) { const int mtx = r / CV_I_W1, ll = mtx >> 1, kv = mtx & 1; transpose_item<3>((kv ? p->in.w1v : p->in.w1k) + (size_t)ll * 2048 * 128, 2048, 128, WSP(bf16_t, O_WT1) + (size_t)mtx * 256 * 2048, scr, r % CV_I_W1, lane); return; } r -= CV_N_W1;
    if (r < CV_N_GU) { const int mtx = r / CV_I_GU; transpose_item<2>(p->in.wgu + (size_t)mtx * D_ * 2048, D_, 2048, WSP(bf16_t, O_WTGU) + (size_t)mtx * 2048 * D_, scr, r % CV_I_GU, lane); return; } r -= CV_N_GU;
    if (r < CV_N_DN) { const int mtx = r / CV_I_DN; transpose_item<0>(p->in.wdn + (size_t)mtx * D_ * D_, D_, D_, WSP(bf16_t, O_WTDN) + (size_t)mtx * D_ * D_, scr, r % CV_I_DN, lane); return; } r -= CV_N_DN;
    if (r < CV_N_IN) { const int mtx = r / CV_I_IN; transpose_item<1>(p->in.w_in + (size_t)mtx * D_ * DIN, D_, DIN, WSP(bf16_t, O_WTIN) + (size_t)mtx * NPAD * D_, scr, r % CV_I_IN, lane); return; } r -= CV_N_IN;
    { const int mtx = r / CV_I_OUT; transpose_item<0>(p->in.w_out + (size_t)mtx * D_ * D_, D_, D_, WSP(bf16_t, O_WTOUT) + (size_t)mtx * D_ * D_, scr, r % CV_I_OUT, lane); }
}
__device__ __forceinline__ void cv_help(LAS unsigned char* lds, KP p, int maxchunks, int csz = 8) {
    const int tid = ftid(), lane = tid & 63, wv = tid >> 6; LAS float* scr = (LAS float*)(lds + wv * 8448);
    unsigned* cursor = WSP(unsigned, O_COUNTS) + 64;
    for (int c = 0; c < maxchunks; ++c) {
        unsigned base = 0u; if (lane == 0) base = atomicAdd(cursor, (unsigned)csz);
        base = (unsigned)__builtin_amdgcn_readfirstlane((int)base);
        if (base >= (unsigned)CV_DEF_ALL) break;
        for (int i = 0; i < csz; ++i) { const int d = (int)base + i; if (d < CV_DEF_ALL) cv_one(p, scr, d < CV_DEF_GU ? CV_DEF_GU0 + d : CV_DEF_DN0 + (d - CV_DEF_GU), lane); }
    }
}
__device__ __forceinline__ void ph_convert(LAS unsigned char* lds, KP p) {
    const int tid = ftid(), lane = tid & 63, wv = tid >> 6;
    LAS float* scr = (LAS float*)(lds + wv * 8448);
    const int gw = fbid() * 8 + wv, NGW = gridDim.x * 8;
    for (int it = gw; it < CV_N_ALL; it += NGW) {
        if ((it >= CV_DEF_GU0 && it < CV_DEF_GU0 + CV_DEF_GU) || (it >= CV_DEF_DN0 && it < CV_DEF_DN0 + CV_DEF_DN)) continue;
        cv_one(p, scr, it, lane);
    }
    const int gt = fbid() * NT + tid, NG = gridDim.x * NT;
    for (int i = gt; i < L_ * (NPAD - DIN) * (D_ / 8); i += NG) { const int l = i / ((NPAD - DIN) * (D_ / 8)), r = i % ((NPAD - DIN) * (D_ / 8));
        unsigned z_ = 0u; asm volatile("" : "+v"(z_));
        *(u32x4*)(WSP(bf16_t, O_WTIN) + ((size_t)l * NPAD + DIN) * D_ + (size_t)r * 8) = (u32x4){z_, z_, z_, z_}; }
    for (int i = gt; i < L_ * 2 * 2 * 128 * (1024 / 8); i += NG) { const int mtxh = i / (128 * 128), r = i % (128 * 128); unsigned z_ = 0u; asm volatile("" : "+v"(z_));
        *(u32x4*)(WSP(bf16_t, O_WT1) + ((size_t)mtxh * 256 + 128) * 1024 + (size_t)r * 8) = (u32x4){z_, z_, z_, z_}; }
    for (int i = gt; i < L_ * 2 * 64 * 128; i += NG) { const int j = i & 127, seg = (i >> 7) & 63, mtx = i >> 13, ll = mtx >> 1, kv = mtx & 1;
        const float* pos = (kv ? p->in.pos_v : p->in.pos_k) + (size_t)ll * 2048 + seg * 32; const float* w1 = (kv ? p->in.w1v : p->in.w1k) + (size_t)ll * 2048 * 128 + (size_t)seg * 32 * 128; float a = 0.f;
#pragma unroll 8
        for (int k = 0; k < 32; ++k) a += pos[k] * w1[(size_t)k * 128 + j];
        WSP(float, O_BIAS1P)[i] = a; }
    for (int i = gt; i < L_ * NPAD; i += NG) { const int l = i / NPAD, c = i % NPAD; if (c >= DIN) WSP(float, O_BIASP)[i] = 0.f; }
    for (int i = gt; i < L_ * DIN; i += NG) { const int l = i / DIN, n = i % DIN; WSP(float, O_BIASP)[l * NPAD + perm_in(n)] = p->in.b_in[i]; }
    for (int i = gt; i < L_ * NE * D_; i += NG) { const int k = i & (D_ - 1), e = (i >> 10) & (NE - 1), l = i >> 15;
        const float v = p->in.rw[((size_t)l * D_ + k) * NE + e]; const unsigned h = f2bf(v); const float lo = v - bf2f((unsigned short)h);
        WSP(bf16_t, O_RWT)[((size_t)(l * 2 + 0) * NE + e) * D_ + k] = (bf16_t)h; WSP(bf16_t, O_RWT)[((size_t)(l * 2 + 1) * NE + e) * D_ + k] = (bf16_t)f2bf(lo); }
    for (int i = gt; i < T_ * D_ / 8; i += NG) { const f32x4 a = __builtin_nontemporal_load((const f32x4*)(p->in.x + (size_t)i * 8)), b = __builtin_nontemporal_load((const f32x4*)(p->in.x + (size_t)i * 8 + 4));
        *(u32x4*)(WSP(bf16_t, O_XB) + (size_t)i * 8) = (u32x4){pk2(a.x, a.y), pk2(a.z, a.w), pk2(b.x, b.y), pk2(b.z, b.w)}; }
}

struct EpiProj {
    static constexpr bool PERM = true;
    bf16_t* projb; float* gf; const float* bias;
    __device__ __forceinline__ void operator()(const pg8::f32x4 (&acc)[2][2][4][2], const pg8::Unit& u, int wr, int wc, int fr, int fq) const {
        const int row0 = u.pm * 256 + wr * 64 + fr, col0 = u.pn * 256 + wc * 32 + 8 * fq;
        if (u.pn < 11) {
            const f32x4 bs[2][2] = {{*(const f32x4*)(bias + col0), *(const f32x4*)(bias + col0 + 4)}, {*(const f32x4*)(bias + col0 + 128), *(const f32x4*)(bias + col0 + 132)}};
#pragma unroll
            for (int ai = 0; ai < 2; ++ai)
#pragma unroll
                for (int m = 0; m < 4; ++m) { bf16_t* rowp = projb + (size_t)(row0 + ai * 128 + m * 16) * PB + col0;
#pragma unroll
                    for (int bj = 0; bj < 2; ++bj) { const f32x4 v0 = acc[ai][bj][m][0] + bs[bj][0], v1 = acc[ai][bj][m][1] + bs[bj][1];
                        u32x4 w; w.x = pg8::cvt_pk_bf16(v0[0], v0[1]); w.y = pg8::cvt_pk_bf16(v0[2], v0[3]); w.z = pg8::cvt_pk_bf16(v1[0], v1[1]); w.w = pg8::cvt_pk_bf16(v1[2], v1[3]);
                        *(u32x4*)(rowp + bj * 128) = w; }
                    }
        } else if (wc == 0) {
            const f32x4 b0 = *(const f32x4*)(bias + col0), b1 = *(const f32x4*)(bias + col0 + 4);
#pragma unroll
            for (int ai = 0; ai < 2; ++ai)
#pragma unroll
                for (int m = 0; m < 4; ++m) { float* rowp = gf + (size_t)(row0 + ai * 128 + m * 16) * 32 + 8 * fq;
                    const f32x4 v0 = acc[ai][0][m][0] + b0, v1 = acc[ai][0][m][1] + b1; f32x4 o0, o1;
#pragma unroll
                    for (int i = 0; i < 4; ++i) { const int j0 = 8 * fq + i, j1 = j0 + 4;
                        o0[i] = (j0 < 24) ? sigmoidf_(v0[i]) : (j0 < 28 ? logsig(v0[i]) : 0.f); o1[i] = (j1 < 24) ? sigmoidf_(v1[i]) : (j1 < 28 ? logsig(v1[i]) : 0.f); }
                    *(f32x4*)rowp = o0; *(f32x4*)(rowp + 4) = o1; }
        }
    }
};
struct EpiOut {
    static constexpr bool PERM = true;
    bf16_t* mixb;
    __device__ __forceinline__ void operator()(const pg8::f32x4 (&acc)[2][2][4][2], const pg8::Unit& u, int wr, int wc, int fr, int fq) const {
        const int row0 = u.pm * 256 + wr * 64 + fr, col0 = u.pn * 256 + wc * 32 + 8 * fq;
#pragma unroll
        for (int ai = 0; ai < 2; ++ai)
#pragma unroll
            for (int m = 0; m < 4; ++m) { bf16_t* rowp = mixb + (size_t)(row0 + ai * 128 + m * 16) * D_ + col0;
#pragma unroll
                for (int bj = 0; bj < 2; ++bj) { const f32x4 v0 = acc[ai][bj][m][0], v1 = acc[ai][bj][m][1];
                    u32x4 w; w.x = pg8::cvt_pk_bf16(v0[0], v0[1]); w.y = pg8::cvt_pk_bf16(v0[2], v0[3]); w.z = pg8::cvt_pk_bf16(v1[0], v1[1]); w.w = pg8::cvt_pk_bf16(v1[2], v1[3]);
                    *(u32x4*)(rowp + bj * 128) = w; }
                }
    }
};
struct EpiGU {
    static constexpr bool PERM = true;
    bf16_t* act; const float* bgu;
    __device__ __forceinline__ void operator()(const pg8::f32x4 (&acc)[2][2][4][2], const pg8::Unit& u, int wr, int wc, int fr, int fq) const {
        const int row0 = u.pm * 256 + wr * 64 + fr, col0 = u.pn * 128 + wc * 32 + 8 * fq;
        const float* bb = bgu + (size_t)u.e * 2048 + col0;
        const f32x4 bg0 = *(const f32x4*)bb, bg1 = *(const f32x4*)(bb + 4), bu0 = *(const f32x4*)(bb + 1024) + 1.0f, bu1 = *(const f32x4*)(bb + 1028) + 1.0f;
#pragma unroll
        for (int ai = 0; ai < 2; ++ai)
#pragma unroll
            for (int m = 0; m < 4; ++m) { f32x4 a0, a1;
                f32x4 g0 = acc[ai][0][m][0] + bg0, g1 = acc[ai][0][m][1] + bg1, u0 = acc[ai][1][m][0] + bu0, u1 = acc[ai][1][m][1] + bu1;
#pragma unroll
                for (int i = 0; i < 4; ++i) { g0[i] = fminf(g0[i], 7.0f); g1[i] = fminf(g1[i], 7.0f); u0[i] = fminf(fmaxf(u0[i], -6.0f), 8.0f); u1[i] = fminf(fmaxf(u1[i], -6.0f), 8.0f); }
                f32x4 e0 = g0 * (-1.702f * 1.4426950408889634f), e1 = g1 * (-1.702f * 1.4426950408889634f);
#pragma unroll
                for (int i = 0; i < 4; ++i) { e0[i] = __builtin_amdgcn_exp2f(e0[i]); e1[i] = __builtin_amdgcn_exp2f(e1[i]); }
                e0 = e0 + 1.0f; e1 = e1 + 1.0f;
#pragma unroll
                for (int i = 0; i < 4; ++i) { e0[i] = __builtin_amdgcn_rcpf(e0[i]); e1[i] = __builtin_amdgcn_rcpf(e1[i]); }
                a0 = (g0 * e0) * u0; a1 = (g1 * e1) * u1;
                u32x4 w; w.x = pg8::cvt_pk_bf16(a0[0], a0[1]); w.y = pg8::cvt_pk_bf16(a0[2], a0[3]); w.z = pg8::cvt_pk_bf16(a1[0], a1[1]); w.w = pg8::cvt_pk_bf16(a1[2], a1[3]);
                *(u32x4*)(act + (size_t)(row0 + ai * 128 + m * 16) * D_ + col0) = w; }
    }
};
struct EpiDN {
    static constexpr bool PERM = true;
    bf16_t* y; const float* bdn; const float* roww; bf16_t* y2;
    __device__ __forceinline__ void operator()(const pg8::f32x4 (&acc)[2][2][4][2], const pg8::Unit& u, int wr, int wc, int fr, int fq) const {
        const int kh = u.pn >> 2;
        const int row0 = u.pm * 256 + wr * 64 + fr, col0 = (u.pn & 3) * 256 + wc * 32 + 8 * fq;
        const float* bb = bdn + (size_t)u.e * D_ + col0; const float bsel = kh ? 0.f : 1.f;
        const f32x4 bs[2][2] = {{*(const f32x4*)bb * bsel, *(const f32x4*)(bb + 4) * bsel}, {*(const f32x4*)(bb + 128) * bsel, *(const f32x4*)(bb + 132) * bsel}};
        bf16_t* const yo = kh ? (y2 - (size_t)65536 * D_) : y;
        float wrow[2][4];
#pragma unroll
        for (int ai = 0; ai < 2; ++ai)
#pragma unroll
            for (int m = 0; m < 4; ++m) wrow[ai][m] = roww[row0 + ai * 128 + m * 16];
#pragma unroll
        for (int ai = 0; ai < 2; ++ai)
#pragma unroll
            for (int m = 0; m < 4; ++m) { const int row = row0 + ai * 128 + m * 16; const float w = wrow[ai][m];
#pragma unroll
                for (int bj = 0; bj < 2; ++bj) { const f32x4 v0 = (acc[ai][bj][m][0] + bs[bj][0]) * w, v1 = (acc[ai][bj][m][1] + bs[bj][1]) * w;
                    u32x4 o; o.x = pg8::cvt_pk_bf16(v0[0], v0[1]); o.y = pg8::cvt_pk_bf16(v0[2], v0[3]); o.z = pg8::cvt_pk_bf16(v1[0], v1[1]); o.w = pg8::cvt_pk_bf16(v1[2], v1[3]);
                    *(u32x4*)(yo + (size_t)row * D_ + col0 + bj * 128) = o; }
                }
    }
};
struct EpiCmp {
    static constexpr bool PERM = true;
    float* hidp;
    __device__ __forceinline__ void operator()(const pg8::f32x4 (&acc)[2][2][4][2], const pg8::Unit& u, int wr, int wc, int fr, int fq) const {
        const int row0 = u.pm * 256 + wr * 64 + fr, col0 = wc * 32 + 8 * fq;
#pragma unroll
        for (int ai = 0; ai < 2; ++ai)
#pragma unroll
            for (int m = 0; m < 4; ++m) { float* d = hidp + (((size_t)u.pn * 8 + u.e) * 512 + row0 + ai * 128 + m * 16) * 128 + col0;
                *(f32x4*)d = acc[ai][0][m][0]; *(f32x4*)(d + 4) = acc[ai][0][m][1]; asm volatile("" ::: "memory"); }
    }
};
struct GEpi {
    static constexpr bool PERM = true;
    int kind, l;
    __device__ __forceinline__ void operator()(const pg8::f32x4 (&acc)[2][2][4][2], const pg8::Unit& u, int wr, int wc, int fr, int fq) const {
        const KP p = fresh_kp();
        if (kind == 0) { const EpiProj e{WSP(bf16_t, O_PROJB), WSP(float, O_GF), WSP(float, O_BIASP) + l * NPAD}; e(acc, u, wr, wc, fr, fq); }
        else if (kind == 1) { const EpiOut e{WSP(bf16_t, O_MIX)}; e(acc, u, wr, wc, fr, fq); }
        else if (kind == 2) { const EpiGU e{WSP(bf16_t, O_ACT), p->in.bgu + (size_t)l * NE * 2048}; e(acc, u, wr, wc, fr, fq); }
        else if (kind == 3) { const EpiDN e{WSP(bf16_t, O_Y), p->in.bdn + (size_t)l * NE * D_, WSP(float, O_ROWW), WSP(bf16_t, O_Y2)}; e(acc, u, wr, wc, fr, fq); }
        else { const EpiCmp e{WSP(float, O_HIDP)}; e(acc, u, wr, wc, fr, fq); }
    }
};
struct GSched {
    int kind, nM, nN, nunits, G, c; const int* meta; const int* rowtok; const char* Bt; size_t estep;
    __device__ __forceinline__ bool next(int i, pg8::Unit& u) const {
        const int L = i * G + c; if (L >= nunits) return false;
        if (kind == 1) {
            int wgid = L; { const int q = nunits / pg8::NXCD, r = nunits % pg8::NXCD, xcd = wgid % pg8::NXCD, off = wgid / pg8::NXCD; wgid = (xcd < r ? xcd * (q + 1) : r * (q + 1) + (xcd - r) * q) + off; }
            const int nig = pg8::WGM * nN, gid = wgid / nig, fm = gid * pg8::WGM, gsz = (nM - fm) < pg8::WGM ? (nM - fm) : pg8::WGM;
            u.pm = fm + ((wgid % nig) % gsz); u.pn = (wgid % nig) / gsz; u.e = 0; u.nr = 256;
        } else if (kind == 4) { u.e = L >> 2; u.pm = (L >> 1) & 1; u.pn = L & 1; u.nr = ((L >> 1) & 1) ? 255 : 256; }
        else if (kind == 0) { const int gt = L / nN; u.pm = gt; u.pn = L - gt * nN; u.e = 0; u.nr = 256; }
        else if (kind == 3 && L >= 1024) {
            const int L2 = 1024 + ((L - 1024) >> 1), gt = L2 >> 2; u.pm = gt; u.pn = (L2 & 3) | (((L - 1024) & 1) << 2); u.e = meta[64 + 2 * gt]; u.nr = meta[65 + 2 * gt]; }
        else { const int gt = L / nN; u.pm = gt; u.pn = L - gt * nN; u.e = meta[64 + 2 * gt]; u.nr = meta[65 + 2 * gt]; }
        return true; }
    __device__ __forceinline__ unsigned a_off(const pg8::Unit& u, int r) const { const int rr = r < u.nr ? r : u.nr - 1; const int row = u.pm * 256 + rr;
        if (kind == 4) { const int kv = u.e & 1, bg = u.e >> 1; return (unsigned)(((bg >> 1) * S_ + 16 * row + 16 * u.pn) * PB + C_KV + ((0 * 2 + kv) * 2 + (bg & 1)) * 64) * 2u; }
        return (unsigned)((kind == 2) ? rowtok[row] : row) * (unsigned)(D_ * 2) + ((kind == 3) ? (unsigned)(u.pn >> 2) * 1024u : 0u); }
    __device__ __forceinline__ size_t a_kstep() const { return kind == 4 ? (size_t)PB * 2 : (size_t)128; }
    __device__ __forceinline__ const char* b_base(const pg8::Unit& u) const {
        if (kind == 3) return Bt + (size_t)u.e * estep + (size_t)(u.pn & 3) * ((size_t)256 * D_ * 2) + (size_t)(u.pn >> 2) * 1024;
        return Bt + (size_t)(kind == 4 ? (u.e & 1) : u.e) * estep + (size_t)u.pn * ((size_t)256 * D_ * 2); }
    __device__ __forceinline__ int unit_nt(const pg8::Unit& u, int nt) const { return (kind == 3 && nunits > 1024 && u.pm >= 256) ? (nt >> 1) : nt; }
};

__device__ __forceinline__ void ph_rmsnorm(KP p, int l) {
    const int lane = ftid() & 63, wv = ftid() >> 6; const float* g = p->in.g_out + (size_t)l * D_;
    constexpr int NB = 4; const int rstride = (int)gridDim.x * 8;
    f32x4 gg[4];
#pragma unroll
    for (int j = 0; j < 2; ++j) { gg[2 * j] = *(const f32x4*)(g + 512 * j + lane * 8); gg[2 * j + 1] = *(const f32x4*)(g + 512 * j + lane * 8 + 4); }
    for (int row0 = fbid() * 8 + wv; row0 < T_; row0 += rstride * NB) {
        u32x4 ra[NB], rb2[NB], rw2[NB];
#pragma unroll
        for (int bi = 0; bi < NB; ++bi) { const int row = (row0 + bi * rstride < T_) ? row0 + bi * rstride : row0; const bf16_t* r = WSP(bf16_t, O_O) + (size_t)row * D_ + lane * 8;
            ra[bi] = *(const u32x4*)r; rb2[bi] = *(const u32x4*)(r + 512); rw2[bi] = *(const u32x4*)(WSP(bf16_t, O_OWIN) + (size_t)row * 512 + lane * 8); }
#pragma unroll
        for (int bi = 0; bi < NB; ++bi) { const int row = row0 + bi * rstride; if (row < T_) {
#define BF_LO(u) __uint_as_float((u) << 16)
#define BF_HI(u) __uint_as_float((u) & 0xffff0000u)
            const f32x4 x0 = (f32x4){BF_LO(ra[bi].x) + BF_LO(rw2[bi].x), BF_HI(ra[bi].x) + BF_HI(rw2[bi].x), BF_LO(ra[bi].y) + BF_LO(rw2[bi].y), BF_HI(ra[bi].y) + BF_HI(rw2[bi].y)};
            const f32x4 x1 = (f32x4){BF_LO(ra[bi].z) + BF_LO(rw2[bi].z), BF_HI(ra[bi].z) + BF_HI(rw2[bi].z), BF_LO(ra[bi].w) + BF_LO(rw2[bi].w), BF_HI(ra[bi].w) + BF_HI(rw2[bi].w)};
            const f32x4 y0 = (f32x4){BF_LO(rb2[bi].x), BF_HI(rb2[bi].x), BF_LO(rb2[bi].y), BF_HI(rb2[bi].y)}, y1 = (f32x4){BF_LO(rb2[bi].z), BF_HI(rb2[bi].z), BF_LO(rb2[bi].w), BF_HI(rb2[bi].w)};
#undef BF_LO
#undef BF_HI
            float s = (x0.x * x0.x + x0.y * x0.y) + (x0.z * x0.z + x0.w * x0.w) + (x1.x * x1.x + x1.y * x1.y) + (x1.z * x1.z + x1.w * x1.w);
            float s2 = (y0.x * y0.x + y0.y * y0.y) + (y0.z * y0.z + y0.w * y0.w) + (y1.x * y1.x + y1.y * y1.y) + (y1.z * y1.z + y1.w * y1.w);
            const float sc0 = rsqrtf(wsum(s) * (1.f / 512.f) + RMS_EPS);
#pragma unroll
            for (int o = 1; o < 32; o <<= 1) s2 += __shfl_xor(s2, o);
            const float sc1 = rsqrtf(s2 * (1.f / 256.f) + RMS_EPS);
            const f32x4 u0 = x0 * sc0 * gg[0], u1 = x1 * sc0 * gg[1], w0 = y0 * sc1 * gg[2], w1 = y1 * sc1 * gg[3];
            bf16_t* ro = WSP(bf16_t, O_OB) + (size_t)row * D_;
            *(u32x4*)(ro + lane * 8) = (u32x4){pk2(u0.x, u0.y), pk2(u0.z, u0.w), pk2(u1.x, u1.y), pk2(u1.z, u1.w)};
            *(u32x4*)(ro + 512 + lane * 8) = (u32x4){pk2(w0.x, w0.y), pk2(w0.z, w0.w), pk2(w1.x, w1.y), pk2(w1.z, w1.w)}; } }
    }
}
template <bool ROUTER>
__device__ __forceinline__ void ph_ln(float* lds, KP p, int l, float* __restrict__ yout, int cnt_off = 0) {
    const int lane = ftid() & 63, wv = ftid() >> 6;
    const float* g = (ROUTER ? p->in.ln1_g : p->in.ln2_g) + (size_t)l * D_; const float* bb = (ROUTER ? p->in.ln1_b : p->in.ln2_b) + (size_t)l * D_;
    constexpr int NB = ROUTER ? 4 : 3;
    const int rstride = (int)gridDim.x * 8;
    LAS unsigned char* L3 = (LAS unsigned char*)lds; float* lgl = lds + 33024 + wv * 256;
    int oi = 0;
    f32x4 gq[2][2], bq[2][2];
#pragma unroll
    for (int j = 0; j < 2; ++j) { const int c0 = 512 * j + lane * 8; gq[j][0] = *(const f32x4*)(g + c0); gq[j][1] = *(const f32x4*)(g + c0 + 4); bq[j][0] = *(const f32x4*)(bb + c0); bq[j][1] = *(const f32x4*)(bb + c0 + 4); }
    bf16x8 bhf[8], blf[8];
    if (ROUTER) { const int n32_ = lane & 31, hh_ = lane >> 5; const bf16_t* bh = WSP(bf16_t, O_RWT) + ((size_t)(l * 2) * NE + n32_) * D_ + 128 * wv + 8 * hh_; const bf16_t* bl = bh + (size_t)NE * D_;
#pragma unroll
        for (int s_ = 0; s_ < 8; ++s_) { bhf[s_] = *(const bf16x8*)(bh + 16 * s_); blf[s_] = *(const bf16x8*)(bl + 16 * s_); } }
    int sn[NB][TOPK];
#define LN_LOADSLOTS(r0_) do { _Pragma("unroll") for (int bi = 0; bi < NB; ++bi) { const int row = ((r0_) + bi * rstride < T_) ? (r0_) + bi * rstride : (r0_); \
        _Pragma("unroll") for (int k = 0; k < TOPK; ++k) sn[bi][k] = WSP(int, O_SLOT)[row * TOPK + k]; } } while (0)
    if (!ROUTER) LN_LOADSLOTS(fbid() * 8 + wv);
    for (int row0 = fbid() * 8 + wv; row0 < T_; row0 += rstride * NB, ++oi) {
        float v[NB][16];
        if (ROUTER) { const bf16_t* xin = WSP(bf16_t, O_XB);
#pragma unroll
            for (int bi = 0; bi < NB; ++bi) { const int row = (row0 + bi * rstride < T_) ? row0 + bi * rstride : row0; const bf16_t* src = xin + (size_t)row * D_; const bf16_t* mx = WSP(bf16_t, O_MIX) + (size_t)row * D_;
#pragma unroll
                for (int j = 0; j < 2; ++j) { const u32x4 xq = *(const u32x4*)(src + 512 * j + lane * 8); const u32x4 q = *(const u32x4*)(mx + 512 * j + lane * 8);
                    const f32x4 a = (f32x4){__uint_as_float(xq.x << 16), __uint_as_float(xq.x & 0xffff0000u), __uint_as_float(xq.y << 16), __uint_as_float(xq.y & 0xffff0000u)}, b = (f32x4){__uint_as_float(xq.z << 16), __uint_as_float(xq.z & 0xffff0000u), __uint_as_float(xq.w << 16), __uint_as_float(xq.w & 0xffff0000u)};
                    v[bi][8 * j + 0] = ALPHA * a.x + __uint_as_float(q.x << 16); v[bi][8 * j + 1] = ALPHA * a.y + __uint_as_float(q.x & 0xffff0000u); v[bi][8 * j + 2] = ALPHA * a.z + __uint_as_float(q.y << 16); v[bi][8 * j + 3] = ALPHA * a.w + __uint_as_float(q.y & 0xffff0000u);
                    v[bi][8 * j + 4] = ALPHA * b.x + __uint_as_float(q.z << 16); v[bi][8 * j + 5] = ALPHA * b.y + __uint_as_float(q.z & 0xffff0000u); v[bi][8 * j + 6] = ALPHA * b.z + __uint_as_float(q.w << 16); v[bi][8 * j + 7] = ALPHA * b.w + __uint_as_float(q.w & 0xffff0000u); } }
        } else { const bf16_t* y = WSP(bf16_t, O_Y);
            int sl[NB][TOPK];
#pragma unroll
            for (int bi = 0; bi < NB; ++bi)
#pragma unroll
                for (int k = 0; k < TOPK; ++k) sl[bi][k] = sn[bi][k];
            u32x4 yv[NB][TOPK][2]; u32x4 xv[NB][2];
#pragma unroll
            for (int bi = 0; bi < NB; ++bi) { const int row = (row0 + bi * rstride < T_) ? row0 + bi * rstride : row0; const bf16_t* src = WSP(bf16_t, O_X1B) + (size_t)row * D_;
#pragma unroll
                for (int j = 0; j < 2; ++j) xv[bi][j] = *(const u32x4*)(src + 512 * j + lane * 8);
#pragma unroll
                for (int k = 0; k < TOPK; ++k)
#pragma unroll
                    for (int j = 0; j < 2; ++j) yv[bi][k][j] = *(const u32x4*)(y + (size_t)sl[bi][k] * D_ + 512 * j + lane * 8); }
            if (row0 + rstride * NB < T_) LN_LOADSLOTS(row0 + rstride * NB);
#pragma unroll
            for (int bi = 0; bi < NB; ++bi)
#pragma unroll
                for (int j = 0; j < 2; ++j) { float acc[8];
#pragma unroll
                    for (int e = 0; e < 8; ++e) acc[e] = 0.f;
#pragma unroll
                    for (int k = 0; k < TOPK; ++k) { const u32x4 q = yv[bi][k][j];
                        if (sl[bi][k] >= 65536) {
                            const u32x4 q2 = *(const u32x4*)(WSP(bf16_t, O_Y2) + (size_t)(sl[bi][k] - 65536) * D_ + 512 * j + lane * 8);
                            acc[0] += __uint_as_float(q2.x << 16); acc[1] += __uint_as_float(q2.x & 0xffff0000u); acc[2] += __uint_as_float(q2.y << 16); acc[3] += __uint_as_float(q2.y & 0xffff0000u);
                            acc[4] += __uint_as_float(q2.z << 16); acc[5] += __uint_as_float(q2.z & 0xffff0000u); acc[6] += __uint_as_float(q2.w << 16); acc[7] += __uint_as_float(q2.w & 0xffff0000u); }
                        acc[0] += __uint_as_float(q.x << 16); acc[1] += __uint_as_float(q.x & 0xffff0000u); acc[2] += __uint_as_float(q.y << 16); acc[3] += __uint_as_float(q.y & 0xffff0000u);
                        acc[4] += __uint_as_float(q.z << 16); acc[5] += __uint_as_float(q.z & 0xffff0000u); acc[6] += __uint_as_float(q.w << 16); acc[7] += __uint_as_float(q.w & 0xffff0000u); }
                    const u32x4 xq = xv[bi][j];
                    const f32x4 a = (f32x4){__uint_as_float(xq.x << 16), __uint_as_float(xq.x & 0xffff0000u), __uint_as_float(xq.y << 16), __uint_as_float(xq.y & 0xffff0000u)}, b = (f32x4){__uint_as_float(xq.z << 16), __uint_as_float(xq.z & 0xffff0000u), __uint_as_float(xq.w << 16), __uint_as_float(xq.w & 0xffff0000u)};
                    v[bi][8 * j + 0] = ALPHA * a.x + acc[0]; v[bi][8 * j + 1] = ALPHA * a.y + acc[1]; v[bi][8 * j + 2] = ALPHA * a.z + acc[2]; v[bi][8 * j + 3] = ALPHA * a.w + acc[3];
                    v[bi][8 * j + 4] = ALPHA * b.x + acc[4]; v[bi][8 * j + 5] = ALPHA * b.y + acc[5]; v[bi][8 * j + 6] = ALPHA * b.z + acc[6]; v[bi][8 * j + 7] = ALPHA * b.w + acc[7]; } }
#pragma unroll
        for (int bi = 0; bi < NB; ++bi) { const int row = row0 + bi * rstride; if (row < T_) {
            float s = 0.f;
#pragma unroll
            for (int i = 0; i < 16; ++i) s += v[bi][i];
            const float mu = wsum(s) * (1.f / D_); float s2 = 0.f;
#pragma unroll
            for (int i = 0; i < 16; ++i) { v[bi][i] -= mu; s2 += v[bi][i] * v[bi][i]; }
            const float rstd = rsqrtf(wsum(s2) * (1.f / D_) + LN_EPS);
            bf16_t* ybf = (ROUTER ? WSP(bf16_t, O_X1B) : WSP(bf16_t, O_XB)) + (size_t)row * D_;
#pragma unroll
            for (int j = 0; j < 2; ++j) { const int c0 = 512 * j + lane * 8; float o8[8];
                const f32x4 g0 = gq[j][0], g1 = gq[j][1], b0 = bq[j][0], b1 = bq[j][1];
                o8[0] = v[bi][8 * j + 0] * rstd * g0.x + b0.x; o8[1] = v[bi][8 * j + 1] * rstd * g0.y + b0.y; o8[2] = v[bi][8 * j + 2] * rstd * g0.z + b0.z; o8[3] = v[bi][8 * j + 3] * rstd * g0.w + b0.w;
                o8[4] = v[bi][8 * j + 4] * rstd * g1.x + b1.x; o8[5] = v[bi][8 * j + 5] * rstd * g1.y + b1.y; o8[6] = v[bi][8 * j + 6] * rstd * g1.z + b1.z; o8[7] = v[bi][8 * j + 7] * rstd * g1.w + b1.w;
                if (yout != nullptr) { *(f32x4*)(yout + (size_t)row * D_ + c0) = (f32x4){o8[0], o8[1], o8[2], o8[3]};
                    *(f32x4*)(yout + (size_t)row * D_ + c0 + 4) = (f32x4){o8[4], o8[5], o8[6], o8[7]}; }
                const u32x4 hv = (u32x4){pk2(o8[0], o8[1]), pk2(o8[2], o8[3]), pk2(o8[4], o8[5]), pk2(o8[6], o8[7])};
                if (ROUTER || yout == nullptr) *(u32x4*)(ybf + c0) = hv;
                if (ROUTER) {
                    float r8[8];
#pragma unroll
                    for (int i = 0; i < 4; ++i) { const unsigned w_ = (i == 0) ? hv.x : (i == 1) ? hv.y : (i == 2) ? hv.z : hv.w; r8[2 * i] = o8[2 * i] - __uint_as_float(w_ << 16); r8[2 * i + 1] = o8[2 * i + 1] - __uint_as_float(w_ & 0xffff0000u); }
                    LAS unsigned char* tp = L3 + (bi * 8 + wv) * 2064 + c0 * 2;
                    *(LAS u32x4*)tp = hv; *(LAS u32x4*)(tp + 66048) = (u32x4){pk2(r8[0], r8[1]), pk2(r8[2], r8[3]), pk2(r8[4], r8[5]), pk2(r8[6], r8[7])}; } } } }
        if (ROUTER) {
            __syncthreads();
            const int n32 = lane & 31, hh = lane >> 5;
            f32x16 acc;
#pragma unroll
            for (int r = 0; r < 16; ++r) acc[r] = 0.f;
            { const LAS unsigned char* ah = L3 + n32 * 2064 + (128 * wv + 8 * hh) * 2;
#pragma unroll
              for (int s_ = 0; s_ < 8; ++s_) { const bf16x8 xh = *(const LAS bf16x8*)(ah + 32 * s_), xl = *(const LAS bf16x8*)(ah + 66048 + 32 * s_);
                  acc = __builtin_amdgcn_mfma_f32_32x32x16_bf16(xh, bhf[s_], acc, 0, 0, 0); acc = __builtin_amdgcn_mfma_f32_32x32x16_bf16(xh, blf[s_], acc, 0, 0, 0); acc = __builtin_amdgcn_mfma_f32_32x32x16_bf16(xl, bhf[s_], acc, 0, 0, 0); } }
            __syncthreads();
            { LAS float* red = (LAS float*)L3;
#pragma unroll
              for (int r = 0; r < 16; ++r) red[(wv * 32 + CROW(r, hh)) * 32 + n32] = acc[r];
              __syncthreads();
#pragma unroll
              for (int bi = 0; bi < NB; ++bi) { const int m = bi * 8 + wv; float sm = 0.f;
#pragma unroll
                  for (int q = 0; q < 4; ++q) sm += red[((hh * 4 + q) * 32 + m) * 32 + n32];
                  sm += __shfl_xor(sm, 32);
                  if (lane < 32) lgl[(NB * oi + bi) * 32 + n32] = sm; } }
            __syncthreads();
        }
    }
    if (ROUTER) {
        const float* rb = p->in.rb + (size_t)l * NE;
        int nrow = 0; for (int r_ = fbid() * 8 + wv; r_ < T_; r_ += (int)gridDim.x * 8) { ++nrow; asm volatile("" : "+s"(nrow)); }
        asm volatile("s_waitcnt lgkmcnt(0)" ::: "memory");
        int* wcnt = (int*)(lds + 33024 + 8 * 256);
        if (ftid() < 8 * NE) wcnt[ftid()] = 0;
        __syncthreads();
        int myes[8], poss[8];
        int* slot = (int*)(lds + 33024 + 8 * 256) + 8 * NE + wv * 64;
        { const int e = lane & 31; const float rbe = rb[e];
#pragma unroll
          for (int ri = 0; ri < 8; ++ri) if (lane < 32) lgl[ri * 32 + e] += rbe; }
        asm volatile("s_waitcnt lgkmcnt(0)" ::: "memory");
#pragma unroll
        for (int ri = 0; ri < 8; ++ri) { myes[ri] = 0; poss[ri] = 0; if (ri < nrow) { const int row = fbid() * 8 + wv + ri * (int)gridDim.x * 8;
            const int e = lane & 31; const float lg = lgl[ri * 32 + e];
            int rank = 0;
#pragma unroll
            for (int q = 0; q < 8; ++q) { const f32x4 v4 = *(const f32x4*)(lgl + ri * 32 + 4 * q);
#pragma unroll
                for (int i = 0; i < 4; ++i) { const int e2 = 4 * q + i; rank += (v4[i] > lg || (v4[i] == lg && e2 < e)) ? 1 : 0; } }
            if (lane < 32 && rank < TOPK) { slot[ri * 8 + 2 * rank] = e; slot[ri * 8 + 2 * rank + 1] = __float_as_int(lg); }
            asm volatile("s_waitcnt lgkmcnt(0)" ::: "memory");
            const int e_k = slot[ri * 8 + 2 * (lane & 3)]; const float v_k = __int_as_float(slot[ri * 8 + 2 * (lane & 3) + 1]);
            const float v0 = __int_as_float(slot[ri * 8 + 1]), v1 = __int_as_float(slot[ri * 8 + 3]), v2 = __int_as_float(slot[ri * 8 + 5]), v3 = __int_as_float(slot[ri * 8 + 7]);
            const float den = ((1.f + __expf(v1 - v0)) + __expf(v2 - v0)) + __expf(v3 - v0);
            const int mye = e_k; const float myw = __expf(v_k - v0);
            if (lane < TOPK) { WSP(int, O_TOPE)[row * TOPK + lane] = mye; WSP(float, O_TOPW)[row * TOPK + lane] = myw / den; myes[ri] = mye; poss[ri] = atomicAdd(&wcnt[wv * NE + mye], 1); } } }
        __syncthreads();
        if (ftid() < NE) { int run = 0;
#pragma unroll
            for (int w_ = 0; w_ < 8; ++w_) { const int c = wcnt[w_ * NE + ftid()]; wcnt[w_ * NE + ftid()] = run; run += c; }
            WSP(int, O_BC)[((size_t)l * 256 + fbid()) * NE + ftid()] = run; }
        __syncthreads();
#pragma unroll
        for (int ri = 0; ri < 8; ++ri) { if (ri < nrow) { const int row = fbid() * 8 + wv + ri * (int)gridDim.x * 8;
            if (lane < TOPK) WSP(int, O_POS)[row * TOPK + lane] = poss[ri] + wcnt[wv * NE + myes[ri]]; } }
        __syncthreads();
    }
}
__device__ __forceinline__ void ph_bias1_reduce(KP p, int l) {
    if (fbid() != 39) return;
    const int tid = ftid(); if (tid < 256) { const float* pp = WSP(float, O_BIAS1P) + ((size_t)(l * 2 + (tid >> 7)) * 64) * 128 + (tid & 127);
        float v[64];
#pragma unroll
        for (int s = 0; s < 64; ++s) v[s] = pp[s * 128];
        float a = 0.f;
#pragma unroll
        for (int s = 0; s < 64; ++s) a += v[s];
        WSP(float, O_BIAS1)[l * 256 + tid] = a; }
}
__device__ __forceinline__ void ph_cumsum(float* lds, KP p, int blk0) {
    const int tid = ftid(), lane = tid & 63, wv = tid >> 6; const int bh = fbid() - blk0;
    if (bh < 0 || bh >= B_ * 4) return;
    const int b = bh >> 2, h = bh & 3; const float* gf = WSP(float, O_GF) + (size_t)(b * S_ + tid * 16) * 32 + 24 + h;
    float v[16], run = 0.f;
#pragma unroll
    for (int i = 0; i < 16; ++i) { run += gf[(size_t)i * 32]; v[i] = run; }
    float inc = run;
#pragma unroll
    for (int o = 1; o < 64; o <<= 1) { const float t = __shfl_up(inc, o); if (lane >= o) inc += t; }
    if (lane == 63) lds[wv] = inc;
    __syncthreads();
    float woff = 0.f;
#pragma unroll
    for (int i = 0; i < 8; ++i) woff += (i < wv) ? lds[i] : 0.f;
    const float off = woff + inc - run; float* c = WSP(float, O_CFOX) + (size_t)bh * S_ + tid * 16;
#pragma unroll
    for (int i = 0; i < 4; ++i) *(f32x4*)(c + 4 * i) = (f32x4){v[4 * i] + off, v[4 * i + 1] + off, v[4 * i + 2] + off, v[4 * i + 3] + off};
    __syncthreads();
}
__device__ __forceinline__ void ph_prep2(float* lds, KP p, int l) {
    { unsigned* kmax2 = WSP(unsigned, O_COUNTS) + 192 + l * 8;
      for (int i = fbid() * NT + ftid(); i < B_ * 4 * S_ * 2; i += gridDim.x * NT) { const int half = i & 1, t = (i >> 1) % S_, bh = (i >> 1) / S_, b = bh >> 2, h = bh & 3;
          const bf16_t* kr = WSP(bf16_t, O_PROJB) + (size_t)(b * S_ + t) * PB + C_FOX + (4 + h) * 64 + half * 32; float ss = 0.f;
#pragma unroll
          for (int c = 0; c < 4; ++c) { float k8[8]; ld8(kr + 8 * c, k8);
#pragma unroll
              for (int e = 0; e < 8; ++e) ss += k8[e] * k8[e]; }
          ss += __shfl_xor(ss, 1);
#pragma unroll
          for (int o = 2; o < 64; o <<= 1) ss = fmaxf(ss, __shfl_xor(ss, o));
          __syncthreads();
          if ((ftid() & 63) == 0) lds[ftid() >> 6] = ss;
          __syncthreads();
          if (ftid() == 0) { float mx = lds[0];
#pragma unroll
              for (int w_ = 1; w_ < 8; ++w_) mx = fmaxf(mx, lds[w_]);
              atomicMax(kmax2 + bh, __float_as_uint(mx)); } } }
    { const int i = fbid() * NT + ftid();
      const int d = i & 63, n = (i >> 6) & 511, combo = i >> 15, kv = combo & 1, bg = combo >> 1;
      const float* w2 = (kv ? p->in.w2v : p->in.w2k) + (size_t)l * 128 * 64; const float* h0 = WSP(float, O_HIDP) + ((size_t)combo * 512 + n) * 128; const float* h1 = h0 + (size_t)8 * 512 * 128;
      const float* g0 = h0 + (size_t)4 * 512 * 128; const float* g1 = g0 + (size_t)8 * 512 * 128;
      const float* b1 = WSP(float, O_BIAS1) + l * 256 + kv * 128;
      __syncthreads();
#pragma unroll
      for (int q = 0; q < 4; ++q) *(f32x4*)(lds + 16 + 4 * (q * NT + ftid())) = *(const f32x4*)(w2 + 4 * (q * NT + ftid()));
      const float hv0 = gelu_tanh(h0[d] + h1[d] + b1[d]), hv1 = gelu_tanh(h0[64 + d] + h1[64 + d] + b1[64 + d]);
      const float gv0 = gelu_tanh(g0[d] + g1[d] + b1[d]), gv1 = gelu_tanh(g0[64 + d] + g1[64 + d] + b1[64 + d]);
      __syncthreads();
      const float* w2s = lds + 16 + d;
      float a = 0.f, a2 = 0.f;
#pragma unroll 16
      for (int c = 0; c < 64; ++c) { const float w_ = w2s[c * 64]; a += __int_as_float(__builtin_amdgcn_readlane(__float_as_int(hv0), c)) * w_; a2 += __int_as_float(__builtin_amdgcn_readlane(__float_as_int(gv0), c)) * w_; }
#pragma unroll 16
      for (int c = 0; c < 64; ++c) { const float w_ = w2s[(64 + c) * 64]; a += __int_as_float(__builtin_amdgcn_readlane(__float_as_int(hv1), c)) * w_; a2 += __int_as_float(__builtin_amdgcn_readlane(__float_as_int(gv1), c)) * w_; }
      bf16_t* dst = kv ? WSP(bf16_t, O_VCMPB) : WSP(bf16_t, O_KCMPB);
      dst[((size_t)bg * 512 + n) * 64 + d] = (n < NCMP) ? (bf16_t)f2bf(a) : (bf16_t)0;
      dst[((size_t)(bg + 2) * 512 + n) * 64 + d] = (n < NCMP) ? (bf16_t)f2bf(a2) : (bf16_t)0; }
    for (int c = fbid() * NT + ftid(); c < B_ * 2 * S_ * 8; c += gridDim.x * NT) {
        const int ln = c & 63, d0 = (c >> 6) & 3, half = (c >> 8) & 1, blk = (c >> 9) & 127, bg = c >> 16, b = bg >> 1, g = bg & 1;
        const bf16_t* src = WSP(bf16_t, O_PROJB) + (size_t)(b * S_ + blk * 64 + half * 32 + (ln & 31)) * PB + C_KV + ((1 * 2 + 0) * 2 + g) * 64 + 16 * d0 + 8 * (ln >> 5);
        *(u32x4*)(WSP(bf16_t, O_KSELF) + (size_t)c * 8) = *(const u32x4*)src; }
    for (int c = fbid() * NT + ftid(); c < B_ * 2 * S_ * 8; c += gridDim.x * NT) {
        const int ln = c & 63, s_ = (c >> 6) & 3, dt = (c >> 8) & 1, blk = (c >> 9) & 127, bg = c >> 16, b = bg >> 1, g = bg & 1;
        const bf16_t* src = WSP(bf16_t, O_PROJB) + (size_t)(b * S_ + blk * 64 + 16 * s_ + 4 * (ln >> 5)) * PB + C_KV + ((1 * 2 + 1) * 2 + g) * 64 + 32 * dt + (ln & 31);
        unsigned w_[4];
#pragma unroll
        for (int q = 0; q < 4; ++q) { const int e0 = 2 * q, e1 = 2 * q + 1;
            w_[q] = (unsigned)src[(size_t)((e0 & 3) + 8 * (e0 >> 2)) * PB] | ((unsigned)src[(size_t)((e1 & 3) + 8 * (e1 >> 2)) * PB] << 16); }
        *(u32x4*)(WSP(bf16_t, O_VSELF) + (size_t)c * 8) = (u32x4){w_[0], w_[1], w_[2], w_[3]}; }
}
__device__ __forceinline__ void ph_moe_scatter2(float* lds, KP p, int l) {
    const int tid = ftid(); int* ts = (int*)lds;
    int* meta = WSP(int, O_META); int* cl = ts + 64; int* tab = ts + 256; int* seg = tab + 256 * NE;
    const int* bc = WSP(int, O_BC) + (size_t)l * 256 * NE;
    __syncthreads();
#pragma unroll
    for (int q = 0; q < 16; ++q) tab[q * NT + tid] = bc[q * NT + tid];
    __syncthreads();
    { const int e = tid & 31, sg = tid >> 5; int sum = 0;
#pragma unroll
      for (int r = 0; r < 16; ++r) sum += tab[(sg * 16 + r) * NE + e];
      seg[sg * NE + e] = sum; }
    __syncthreads();
    { const int e = tid & 31, sg = tid >> 5; int run = 0, tot = 0;
#pragma unroll
      for (int q = 0; q < 16; ++q) { const int v = seg[q * NE + e]; if (q < sg) run += v; tot += v; }
#pragma unroll
      for (int r = 0; r < 16; ++r) { const int v = tab[(sg * 16 + r) * NE + e]; tab[(sg * 16 + r) * NE + e] = run; run += v; }
      if (sg == 0) cl[e] = tot; }
    __syncthreads();
    if (tid < 64) {
        const int e = tid & 31; const int mine = (cl[e] + 255) >> 8; int inc = mine;
#pragma unroll
        for (int o = 1; o < 32; o <<= 1) { const int t = __shfl_up(inc, o, 32); if (e >= o) inc += t; }
        if (tid < 32) { ts[e] = inc - mine; if (e == 31) ts[32] = inc; } }
    __syncthreads();
    if (fbid() == 0) { if (tid < NE) { const int c = cl[tid], t0 = ts[tid]; meta[tid] = t0; for (int r = 0, t = t0; r < c; r += 256, ++t) { meta[64 + 2 * t] = tid; meta[65 + 2 * t] = (c - r) < 256 ? (c - r) : 256; } }
        if (tid == 0) meta[32] = ts[32]; }
    for (int i = fbid() * NT + tid; i < MROWS; i += gridDim.x * NT) {
        const int e = WSP(int, O_TOPE)[i], b = ((i >> 2) & 2047) >> 3;
        const int row = ts[e] * 256 + tab[b * NE + e] + WSP(int, O_POS)[i];
        WSP(int, O_ROWTOK)[row] = i >> 2; WSP(float, O_ROWW)[row] = WSP(float, O_TOPW)[i]; WSP(int, O_SLOT)[i] = row; }
    __syncthreads();
}
}
namespace mk {
typedef short bf16x8 __attribute__((ext_vector_type(8)));
typedef float f32x16 __attribute__((ext_vector_type(16)));
typedef float f32x2_t __attribute__((ext_vector_type(2)));
typedef __bf16 bf16x2_t __attribute__((ext_vector_type(2)));
typedef unsigned u32x2 __attribute__((ext_vector_type(2)));
typedef short v4i16_t __attribute__((ext_vector_type(4)));
__device__ __forceinline__ unsigned cvtpk(float lo, float hi) { f32x2_t v = {lo, hi}; bf16x2_t b = __builtin_convertvector(v, bf16x2_t); return __builtin_bit_cast(unsigned, b); }
constexpr int KROW = 144, VROW = 136;
constexpr int VPIT = 192;
constexpr int E1_K = 0, E1_V = 64 * KROW, E1_C = E1_V + 64 * VPIT, E1_BUF = E1_C + 256;
constexpr int E1_FLAGS = 2 * E1_BUF;
constexpr float LOG2E = 1.4426950408889634f;
constexpr float RESC_THR = 8.0f;
#define CROW(reg, hh) (((reg) & 3) + 8 * ((reg) >> 2) + 4 * (hh))

__device__ __forceinline__ float max3f(float a, float b, float c) { float r; asm("v_max3_f32 %0, %1, %2, %3" : "=v"(r) : "v"(a), "v"(b), "v"(c)); return r; }
typedef float f32x2_t __attribute__((ext_vector_type(2)));
__device__ __forceinline__ float lane32_other(float x, int hh) { const auto rr = __builtin_amdgcn_permlane32_swap(__float_as_uint(x), __float_as_uint(x), false, false); return __uint_as_float(hh ? rr[0] : rr[1]); }
#define SM_V(p0, p1, i_) (((i_) & 1) ? p1[(i_) >> 1] : p0[(i_) >> 1])
#define SM_ROWMAX(p0, p1, rm_) do { \
    rm_ = max3f(p0[0], p1[0], p0[1]); \
    _Pragma("unroll") for (int k_ = 0; k_ < 14; ++k_) rm_ = max3f(rm_, SM_V(p0, p1, 3 + 2 * k_), SM_V(p0, p1, 4 + 2 * k_)); \
    rm_ = max3f(rm_, p1[15], p1[15]); \
    { const auto rr_ = __builtin_amdgcn_permlane32_swap(__float_as_uint(rm_), __float_as_uint(rm_), false, false);     \
      rm_ = max3f(__uint_as_float(rr_[0]), __uint_as_float(rr_[1]), __uint_as_float(rr_[1])); } } while (0)
#define SM_CORE(p0, p1, m, l, have, o0, o1) do { \
    float rm_; SM_ROWMAX(p0, p1, rm_); \
    const bool fin_ = rm_ > -1e37f; \
    if (__any((rm_ > RESC_THR) || (!have && fin_))) { \
        const float dl_ = have ? fmaxf(rm_, 0.f) : (fin_ ? rm_ : 0.f); const float al_ = have ? __builtin_amdgcn_exp2f(-dl_) : 1.f; \
        m += dl_; l *= al_; have = have || fin_; \
        _Pragma("unroll") for (int r_ = 0; r_ < 16; ++r_) { o0[r_] *= al_; o1[r_] *= al_; p0[r_] -= dl_; p1[r_] -= dl_; } } \
    f32x2_t ls2_ = {0.f, 0.f}; \
    _Pragma("unroll") for (int reg_ = 0; reg_ < 16; reg_ += 2) { \
        p0[reg_] = __builtin_amdgcn_exp2f(p0[reg_]); p0[reg_ + 1] = __builtin_amdgcn_exp2f(p0[reg_ + 1]); p1[reg_] = __builtin_amdgcn_exp2f(p1[reg_]); p1[reg_ + 1] = __builtin_amdgcn_exp2f(p1[reg_ + 1]); \
        ls2_ += (f32x2_t){p0[reg_], p0[reg_ + 1]}; ls2_ += (f32x2_t){p1[reg_], p1[reg_ + 1]}; } \
    l += ls2_.x + ls2_.y; } while (0)

struct E1Geom { int b, q0, h; const bf16_t* qp; const bf16_t* kp; const bf16_t* vp; size_t pitch; };

template <int KIND>
__device__ __forceinline__ void e1_unit(LAS unsigned char* lds, KP p, int b, int hg, int qb, bf16_t* __restrict__ obase, bf16_t* __restrict__ owin, const unsigned* __restrict__ kmax2) {
    const int tid = ftid(), lane = tid & 63, w = __builtin_amdgcn_readfirstlane(tid >> 6), r32 = lane & 31, hh = lane >> 5;
    const bf16_t* projb = WSP(bf16_t, O_PROJB);
    int h, q0, qrow0, qcol, kcol, vcol, nrows;
    if (KIND == 0) { h = hg; q0 = qb * 256; qrow0 = q0 + 32 * w; qcol = C_FOX + h * 64; kcol = C_FOX + (4 + h) * 64; vcol = C_FOX + (8 + h) * 64; nrows = 256; }
    else if (KIND == 2) { h = hg; q0 = qb * 256; qrow0 = q0 + 32 * w; qcol = C_SB + h * 64; kcol = C_SB + (4 + h) * 64; vcol = C_SB + (8 + h) * 64; nrows = 256; }
    else { h = 4 * hg + (w & 3); q0 = qb * 64; qrow0 = q0 + 32 * (w >> 2); qcol = h * 64; kcol = C_KV + ((2 * 2 + 0) * 2 + hg) * 64; vcol = C_KV + ((2 * 2 + 1) * 2 + hg) * 64; nrows = 64; }
    const int tq = qrow0 + r32;
    const bf16_t* kbase = projb + (size_t)(b * S_) * PB + kcol; const bf16_t* vbase = projb + (size_t)(b * S_) * PB + vcol;
    bf16x8 qf[4];
    { const bf16_t* qptr = projb + (size_t)(b * S_ + tq) * PB + qcol + 8 * hh;
#pragma unroll
      for (int d0 = 0; d0 < 4; ++d0) qf[d0] = *(const bf16x8*)(qptr + 16 * d0);
      if (KIND == 1) {
#pragma unroll
          for (int d0 = 0; d0 < 4; ++d0) { u32x4 w_;
#pragma unroll
              for (int e2 = 0; e2 < 4; ++e2) { const float lo_ = bf2f((unsigned short)qf[d0][2 * e2]) * (SCALE * LOG2E), hi_ = bf2f((unsigned short)qf[d0][2 * e2 + 1]) * (SCALE * LOG2E); w_[e2] = cvtpk(lo_, hi_); }
              qf[d0] = __builtin_bit_cast(bf16x8, w_); } } }
    int j0 = 0; const int j1 = (q0 + nrows - 1) >> 6;
    if (KIND == 1) { j0 = (q0 - 511) >> 6; if (j0 < 0) j0 = 0; }
    const int ntile = j1 - j0 + 1;
    float ct2 = 0.f, sl2 = 0.f; const float* cb = nullptr;
    if (KIND == 0) { cb = WSP(float, O_CFOX) + (size_t)(b * 4 + h) * S_; ct2 = cb[tq] * LOG2E; }
    if (KIND == 1) sl2 = exp2f(-(float)(h + 1)) * LOG2E;
    const int skey = tid >> 3, sch = tid & 7;
    u32x4 rk, rv; float rc = 0.f;
#define E1_LOAD(jj) do { const size_t ro_ = (size_t)((jj) * 64 + skey) * PB + sch * 8; rk = *(const u32x4*)(kbase + ro_); rv = *(const u32x4*)(vbase + ro_); \
        if (KIND == 0 && tid < 64) rc = cb[(jj) * 64 + tid] * LOG2E; } while (0)
#define E1_WRITE(bufp) do { *(LAS u32x4*)((bufp) + E1_K + skey * KROW + sch * 16) = rk; *(LAS u32x4*)((bufp) + E1_V + skey * VPIT + sch * 16) = rv; \
        if (KIND == 0 && tid < 64) ((LAS float*)((bufp) + E1_C))[tid] = rc; } while (0)
    E1_LOAD(KIND != 1 ? j1 : j0);
    bf16x8 kx0 = {0, 0, 0, 0, 0, 0, 0, 0}, kx1 = {0, 0, 0, 0, 0, 0, 0, 0}; float sl2h = 0.f, sl2l = 0.f;
    if (KIND == 1) { const unsigned one_ = 0x3f80u; const unsigned k0_ = f2bf((float)r32), k1_ = f2bf((float)(r32 + 32));
        if (hh == 0) { kx0 = __builtin_bit_cast(bf16x8, (u32x4){k0_ | (k0_ << 16), one_ | (one_ << 16), one_, 0u}); kx1 = __builtin_bit_cast(bf16x8, (u32x4){k1_ | (k1_ << 16), one_ | (one_ << 16), one_, 0u}); }
        sl2h = bf2f((unsigned short)f2bf(sl2)); sl2l = sl2 - sl2h; }
    float qkb = 0.f;
    if (KIND == 0) { float qs = 0.f;
#pragma unroll
        for (int d0 = 0; d0 < 4; ++d0)
#pragma unroll
            for (int e = 0; e < 8; ++e) { const float x = bf2f((unsigned short)qf[d0][e]); qs += x * x; }
        qs += __shfl_xor(qs, 32);
        const float km2 = __uint_as_float(kmax2[b * 4 + h]);
        qkb = sqrtf(qs * km2) * (SCALE * LOG2E * 1.01f); }
    const float tqf = (float)tq;
    f32x16 o0, o1;
#pragma unroll
    for (int r = 0; r < 16; ++r) { o0[r] = 0.f; o1[r] = 0.f; }
    float m = 0.f, l = 0.f, carry = 0.f; bool have = false;
    bool wave_done = false;
    LAS unsigned* flags = (LAS unsigned*)(lds + E1_FLAGS);
    if (KIND != 1) { if (tid < 8) flags[tid] = 0u; }
    __syncthreads();
    for (int it = 0; it < ntile; ++it) {
        const int j = (KIND != 1) ? (j1 - it) : (j0 + it);
        LAS unsigned char* buf = lds + (it & 1) * E1_BUF;
        E1_WRITE(buf);
        __syncthreads();
        if (KIND != 1) { if (flags[0] == 8u) break; }
        if (it + 1 < ntile) E1_LOAD((KIND != 1) ? (j - 1) : (j + 1));
        if (!(KIND != 1 && (wave_done || j * 64 > qrow0 + 31))) {
            f32x16 p0, p1;
#pragma unroll
            for (int r = 0; r < 16; ++r) { p0[r] = 0.f; p1[r] = 0.f; }
            { const LAS unsigned char* kp_ = buf + E1_K + r32 * KROW + hh * 16;
#pragma unroll
              for (int d0 = 0; d0 < 4; ++d0) { const bf16x8 a0 = *(const LAS bf16x8*)(kp_ + d0 * 32), a1 = *(const LAS bf16x8*)(kp_ + 32 * KROW + d0 * 32);
                  p0 = __builtin_amdgcn_mfma_f32_32x32x16_bf16(a0, qf[d0], p0, 0, 0, 0); p1 = __builtin_amdgcn_mfma_f32_32x32x16_bf16(a1, qf[d0], p1, 0, 0, 0); } }
            const int kb = j * 64 + 4 * hh;
            if (KIND == 2) {
                float lk0[16], lk1[16], gs[8];
#pragma unroll
                for (int reg = 0; reg < 16; ++reg) { const int kpos = kb + CROW(reg, 0);
                    const float z0 = p0[reg] * (SCALE * LOG2E), z1 = p1[reg] * (SCALE * LOG2E); const bool v0 = kpos < tq, v1 = kpos + 32 < tq;
                    const float lb0 = fminf(z0, 0.f) - __builtin_amdgcn_logf(1.f + __builtin_amdgcn_exp2f(-fabsf(z0))), lb1 = fminf(z1, 0.f) - __builtin_amdgcn_logf(1.f + __builtin_amdgcn_exp2f(-fabsf(z1)));
                    lk0[reg] = v0 ? (lb0 - z0) : 0.f; lk1[reg] = v1 ? (lb1 - z1) : 0.f;
                    p0[reg] = v0 ? lb0 : -INFINITY; p1[reg] = v1 ? lb1 : -INFINITY; }
#pragma unroll
                for (int g4 = 0; g4 < 4; ++g4) { gs[g4] = (lk0[4 * g4] + lk0[4 * g4 + 1]) + (lk0[4 * g4 + 2] + lk0[4 * g4 + 3]); gs[4 + g4] = (lk1[4 * g4] + lk1[4 * g4 + 1]) + (lk1[4 * g4 + 2] + lk1[4 * g4 + 3]); }
                float oth[8];
#pragma unroll
                for (int gi = 0; gi < 8; ++gi) oth[gi] = lane32_other(gs[gi], hh);
                float run = 0.f;
#pragma unroll
                for (int gi = 7; gi >= 0; --gi) {
                    float later = carry + run + (hh == 0 ? oth[gi] : 0.f);
#pragma unroll
                    for (int e = 3; e >= 0; --e) { const int reg = (gi & 3) * 4 + e;
                        if (gi >> 2) { p1[reg] = __builtin_amdgcn_exp2f(p1[reg] + later); later += lk1[reg]; } else { p0[reg] = __builtin_amdgcn_exp2f(p0[reg] + later); later += lk0[reg]; } }
                    run += gs[gi] + oth[gi]; }
                carry += run;
            } else {
                if (KIND == 0) {
                    const LAS float* cs = (const LAS float*)(buf + E1_C) + 4 * hh; const float ctm = ct2 - m;
#pragma unroll
                    for (int i = 0; i < 4; ++i) { const f32x4 c0 = *(const LAS f32x4*)(cs + 8 * i), c1 = *(const LAS f32x4*)(cs + 32 + 8 * i);
#pragma unroll
                        for (int e = 0; e < 4; ++e) { const int reg = 4 * i + e; p0[reg] = p0[reg] * (SCALE * LOG2E) + (ctm - c0[e]); p1[reg] = p1[reg] * (SCALE * LOG2E) + (ctm - c1[e]); } }
                    if (!(j * 64 + 63 <= qrow0)) {
#pragma unroll
                        for (int reg = 0; reg < 16; ++reg) { const int kpos = kb + CROW(reg, 0); p0[reg] = (kpos <= tq) ? p0[reg] : -INFINITY; p1[reg] = (kpos + 32 <= tq) ? p1[reg] : -INFINITY; } }
                } else {
                    { const float r_ = sl2 * ((float)(j * 64) - tqf) - m; const float rh_ = bf2f((unsigned short)f2bf(r_)), rm2_ = bf2f((unsigned short)f2bf(r_ - rh_)), rl_ = (r_ - rh_) - rm2_;
                      u32x4 qx_ = {0u, 0u, 0u, 0u}; if (hh == 0) qx_ = (u32x4){cvtpk(sl2h, sl2l), cvtpk(rh_, rm2_), cvtpk(rl_, 0.f), 0u};
                      const bf16x8 qx = __builtin_bit_cast(bf16x8, qx_);
                      p0 = __builtin_amdgcn_mfma_f32_32x32x16_bf16(kx0, qx, p0, 0, 0, 0); p1 = __builtin_amdgcn_mfma_f32_32x32x16_bf16(kx1, qx, p1, 0, 0, 0); }
                    if (!(j * 64 + 63 <= qrow0 && qrow0 + 31 - j * 64 < 512)) {
#pragma unroll
                        for (int reg = 0; reg < 16; ++reg) { const int kpos = kb + CROW(reg, 0);
                            p0[reg] = (kpos <= tq && tq - kpos < 512) ? p0[reg] : -INFINITY; p1[reg] = (kpos + 32 <= tq && tq - kpos - 32 < 512) ? p1[reg] : -INFINITY; } }
                }
                SM_CORE(p0, p1, m, l, have, o0, o1);
            }
            { const int gq_ = lane >> 4, li_ = lane & 15;
              const LAS unsigned char* tb = buf + E1_V + (4 * hh + (li_ >> 2)) * VPIT + (16 * (gq_ & 1) + 4 * (li_ & 3)) * 2;
#pragma unroll
              for (int s = 0; s < 4; ++s) {
                  u32x4 pw;
                  if (s < 2) { pw.x = cvtpk(p0[8 * s + 0], p0[8 * s + 1]); pw.y = cvtpk(p0[8 * s + 2], p0[8 * s + 3]); pw.z = cvtpk(p0[8 * s + 4], p0[8 * s + 5]); pw.w = cvtpk(p0[8 * s + 6], p0[8 * s + 7]); }
                  else { const int s2 = s - 2; pw.x = cvtpk(p1[8 * s2 + 0], p1[8 * s2 + 1]); pw.y = cvtpk(p1[8 * s2 + 2], p1[8 * s2 + 3]); pw.z = cvtpk(p1[8 * s2 + 4], p1[8 * s2 + 5]); pw.w = cvtpk(p1[8 * s2 + 6], p1[8 * s2 + 7]); }
                  const bf16x8 pb = __builtin_bit_cast(bf16x8, pw);
                  const v4i16_t a0l = __builtin_amdgcn_ds_read_tr16_b64_v4i16((LAS v4i16_t*)(tb + (16 * s) * VPIT)), a0h = __builtin_amdgcn_ds_read_tr16_b64_v4i16((LAS v4i16_t*)(tb + (16 * s + 8) * VPIT));
                  const v4i16_t a1l = __builtin_amdgcn_ds_read_tr16_b64_v4i16((LAS v4i16_t*)(tb + (16 * s) * VPIT + 64)), a1h = __builtin_amdgcn_ds_read_tr16_b64_v4i16((LAS v4i16_t*)(tb + (16 * s + 8) * VPIT + 64));
                  const bf16x8 va0 = (bf16x8){a0l[0], a0l[1], a0l[2], a0l[3], a0h[0], a0h[1], a0h[2], a0h[3]}, va1 = (bf16x8){a1l[0], a1l[1], a1l[2], a1l[3], a1h[0], a1h[1], a1h[2], a1h[3]};
                  o0 = __builtin_amdgcn_mfma_f32_32x32x16_bf16(va0, pb, o0, 0, 0, 0); o1 = __builtin_amdgcn_mfma_f32_32x32x16_bf16(va1, pb, o1, 0, 0, 0); } }
            if (KIND == 0) {
                const float c0 = *(const LAS float*)(buf + E1_C); const bool dn = __all(have && (qkb + (ct2 - c0) - m < -150.f));
                if (dn && !wave_done) { wave_done = true; if (lane == 0) __hip_atomic_fetch_add(&flags[0], 1u, __ATOMIC_RELAXED, __HIP_MEMORY_SCOPE_WORKGROUP); } }
            if (KIND == 2) { const bool dn = __all(carry < -110.f * LOG2E);
                if (dn && !wave_done) { wave_done = true; if (lane == 0) __hip_atomic_fetch_add(&flags[0], 1u, __ATOMIC_RELAXED, __HIP_MEMORY_SCOPE_WORKGROUP); } }
        }
    }
    float inv = 1.f, gate = 1.f;
    if (KIND != 2) { l += __shfl_xor(l, 32); inv = (l > 0.f) ? 1.f / l : 0.f; }
    bf16_t* orow;
    if (KIND == 0) orow = obase + (size_t)(b * S_ + tq) * D_ + 512 + h * 64;
    else if (KIND == 2) orow = obase + (size_t)(b * S_ + tq) * D_ + 768 + h * 64;
    else { orow = owin + (size_t)(b * S_ + tq) * 512 + h * 64; gate = WSP(float, O_GF)[(size_t)(b * S_ + tq) * 32 + 2 * 8 + h]; }
    const float sc = inv * gate;
#pragma unroll
    for (int i = 0; i < 4; ++i) {
        *(u32x2*)(orow + 8 * i + 4 * hh) = (u32x2){cvtpk(o0[4 * i] * sc, o0[4 * i + 1] * sc), cvtpk(o0[4 * i + 2] * sc, o0[4 * i + 3] * sc)};
        *(u32x2*)(orow + 32 + 8 * i + 4 * hh) = (u32x2){cvtpk(o1[4 * i] * sc, o1[4 * i + 1] * sc), cvtpk(o1[4 * i + 2] * sc, o1[4 * i + 3] * sc)}; }
#undef E1_LOAD
#undef E1_WRITE
}
}
namespace mk {
constexpr int E2_VT = 64 * 128;
constexpr int E2_WAVE = 2 * E2_VT + 512 + 128;
template <bool USE_MASK>
__device__ __forceinline__ void e2_wave_unit(LAS unsigned char* ldsw, KP p, int b, int g, int t0, bf16_t* __restrict__ obase, const bf16_t* __restrict__ csrc, int cpitch) {
    const int lane = ftid() & 63, r32 = lane & 31, hh = lane >> 5, qi = r32 >> 2, r4 = r32 & 3;
    const int h = 4 * g + r4, tq = t0 + qi;
    const bf16_t* projb = WSP(bf16_t, O_PROJB);
    const bf16_t* kself = WSP(bf16_t, O_KSELF) + (size_t)(b * 2 + g) * S_ * 64;
    const bf16_t* vbase = projb + (size_t)(b * S_) * PB + C_KV + ((1 * 2 + 1) * 2 + g) * 64;
    bf16x8 qf[4];
    { const bf16_t* qptr = projb + (size_t)(b * S_ + tq) * PB + h * 64 + 8 * hh;
#pragma unroll
      for (int d0 = 0; d0 < 4; ++d0) qf[d0] = *(const bf16x8*)(qptr + 16 * d0); }
    unsigned qm0 = 0u, qm1 = 0u, qm2 = 0u, qm3 = 0u;
    if (USE_MASK) { const u32x4 mw = *(const u32x4*)(WSP(unsigned, O_SELMASK) + ((size_t)((b * 2 + g) * S_ + t0 + (lane >> 3))) * 4); qm0 = mw.x; qm1 = mw.y; qm2 = mw.z; qm3 = mw.w; }
    else { const int* sp = WSP(int, O_SEL) + ((size_t)((b * 2 + g) * S_ + t0)) * NSEL + lane * 2;
      const int e0 = sp[0], e1 = sp[1];
#pragma unroll
      for (int k = 0; k < 2; ++k) { const int e = k ? e1 : e0; const unsigned bit = 1u << (e & 31); const int wd = e >> 5;
          qm0 |= (wd == 0) ? bit : 0u; qm1 |= (wd == 1) ? bit : 0u; qm2 |= (wd == 2) ? bit : 0u; qm3 |= (wd == 3) ? bit : 0u; }
#pragma unroll
      for (int o = 1; o < 8; o <<= 1) { qm0 |= __shfl_xor(qm0, o); qm1 |= __shfl_xor(qm1, o); qm2 |= __shfl_xor(qm2, o); qm3 |= __shfl_xor(qm3, o); } }
    unsigned um0 = qm0, um1 = qm1, um2 = qm2, um3 = qm3;
#pragma unroll
    for (int o = 8; o < 64; o <<= 1) { um0 |= __shfl_xor(um0, o); um1 |= __shfl_xor(um1, o); um2 |= __shfl_xor(um2, o); um3 |= __shfl_xor(um3, o); }
    LAS int* list = (LAS int*)(ldsw + 2 * E2_VT);
    LAS unsigned* rowml = (LAS unsigned*)(ldsw + 2 * E2_VT + 512);
    if ((lane & 7) == 0) *(LAS u32x4*)(rowml + (lane >> 3) * 4) = (u32x4){qm0, qm1, qm2, qm3};
    const LAS unsigned* rowm = rowml + qi * 4;
    int nblk;
    const int curq = __builtin_amdgcn_readfirstlane(t0 >> 6);
    bool diag;
    { const bool s0 = ((((lane < 32) ? um0 : um1) >> (lane & 31)) & 1u) && lane <= curq, s1 = ((((lane < 32) ? um2 : um3) >> (lane & 31)) & 1u) && lane + 64 <= curq;
      const unsigned long long b0 = __ballot(s0), b1 = __ballot(s1);
      const unsigned long long lower = (lane == 0) ? 0ull : (~0ull >> (64 - lane));
      const int n0 = __popcll(b0);
      if (s0) list[__popcll(b0 & lower)] = lane;
      if (s1) list[n0 + __popcll(b1 & lower)] = lane + 64;
      nblk = n0 + __popcll(b1); diag = (((curq < 64) ? (b0 >> curq) : (b1 >> (curq - 64))) & 1ull) != 0ull; }
    const int nfull = nblk - (diag ? 1 : 0);
    asm volatile("s_waitcnt lgkmcnt(0)" ::: "memory");
    const float sl2 = exp2f(-(float)(h + 1)) * LOG2E, tqf = (float)tq;
    f32x16 o0, o1;
#pragma unroll
    for (int r = 0; r < 16; ++r) { o0[r] = 0.f; o1[r] = 0.f; }
    float m = 0.f, l = 0.f; bool have = false;
    const int vrow = lane >> 3, vch = lane & 7;
    bf16x8 ka0[4], ka1[4], vf0[4], vf1[4];
    const bf16_t* vself = WSP(bf16_t, O_VSELF) + (size_t)(b * 2 + g) * S_ * 64;
#define E2_LOADK(blk, k0_, k1_) do { const bf16_t* kp_ = kself + (size_t)(blk) * 4096 + lane * 8;     \
        _Pragma("unroll") for (int d0 = 0; d0 < 4; ++d0) { k0_[d0] = *(const bf16x8*)(kp_ + 512 * d0); k1_[d0] = *(const bf16x8*)(kp_ + 2048 + 512 * d0); } } while (0)
#define E2_LOADV(blk) do { const bf16_t* vp_ = vself + (size_t)(blk) * 4096 + lane * 8;     \
        _Pragma("unroll") for (int s_ = 0; s_ < 4; ++s_) { vf0[s_] = *(const bf16x8*)(vp_ + 512 * s_); vf1[s_] = *(const bf16x8*)(vp_ + 2048 + 512 * s_); } } while (0)
    { const int b0_ = __builtin_amdgcn_readfirstlane(list[0]);
      E2_LOADK(b0_, ka0, ka1); E2_LOADV(b0_); }
    int it = 0;
    auto body = [&](auto mtag_) __attribute__((always_inline)) {
        constexpr bool MASKED_ = decltype(mtag_)::value;
        const int cur = __builtin_amdgcn_readfirstlane(list[it]);
        const unsigned rw = rowm[cur >> 5];
        const int nb1_ = __builtin_amdgcn_readfirstlane(list[(it + 1 < nblk) ? it + 1 : nblk - 1]);
        f32x16 p0, p1;
#pragma unroll
        for (int r = 0; r < 16; ++r) { p0[r] = 0.f; p1[r] = 0.f; }
#pragma unroll
        for (int d0 = 0; d0 < 4; ++d0) { p0 = __builtin_amdgcn_mfma_f32_32x32x16_bf16(ka0[d0], qf[d0], p0, 0, 0, 0); p1 = __builtin_amdgcn_mfma_f32_32x32x16_bf16(ka1[d0], qf[d0], p1, 0, 0, 0); }
        asm volatile("" : "+v"(p0), "+v"(p1) :: "memory");
        E2_LOADK(nb1_, ka0, ka1);
        const bool rowsel = (rw >> (cur & 31)) & 1u;
        const int kb = cur * 64 + 4 * hh;
        { const float basef = rowsel ? (sl2 * ((float)kb - tqf) - m) : -INFINITY, base1 = basef + 32.f * sl2;
#pragma unroll
          for (int reg = 0; reg < 16; ++reg) { p0[reg] = p0[reg] * (SCALE * LOG2E) + __builtin_fmaf(sl2, (float)CROW(reg, 0), basef); p1[reg] = p1[reg] * (SCALE * LOG2E) + __builtin_fmaf(sl2, (float)CROW(reg, 0), base1); } }
        if (MASKED_) {
#pragma unroll
            for (int reg = 0; reg < 16; ++reg) { const int kpos = kb + CROW(reg, 0); p0[reg] = (kpos <= tq) ? p0[reg] : -INFINITY; p1[reg] = (kpos + 32 <= tq) ? p1[reg] : -INFINITY; } }
        SM_CORE(p0, p1, m, l, have, o0, o1);
#pragma unroll
        for (int s = 0; s < 4; ++s) {
            u32x4 pw;
            if (s < 2) { pw.x = cvtpk(p0[8 * s + 0], p0[8 * s + 1]); pw.y = cvtpk(p0[8 * s + 2], p0[8 * s + 3]); pw.z = cvtpk(p0[8 * s + 4], p0[8 * s + 5]); pw.w = cvtpk(p0[8 * s + 6], p0[8 * s + 7]); }
            else { const int s2 = s - 2; pw.x = cvtpk(p1[8 * s2 + 0], p1[8 * s2 + 1]); pw.y = cvtpk(p1[8 * s2 + 2], p1[8 * s2 + 3]); pw.z = cvtpk(p1[8 * s2 + 4], p1[8 * s2 + 5]); pw.w = cvtpk(p1[8 * s2 + 6], p1[8 * s2 + 7]); }
            const bf16x8 pb = __builtin_bit_cast(bf16x8, pw);
            o0 = __builtin_amdgcn_mfma_f32_32x32x16_bf16(vf0[s], pb, o0, 0, 0, 0); o1 = __builtin_amdgcn_mfma_f32_32x32x16_bf16(vf1[s], pb, o1, 0, 0, 0); }
        asm volatile("" : "+v"(o0), "+v"(o1) :: "memory");
        E2_LOADV(nb1_);
    };
    for (; it < nfull; ++it) body(std::false_type{});
    if (diag) body(std::true_type{});
#undef E2_LOADK
#undef E2_LOADV
    l += __shfl_xor(l, 32);
    const float sc = ((l > 0.f) ? 1.f / l : 0.f) * WSP(float, O_GF)[(size_t)(b * S_ + tq) * 32 + 1 * 8 + h];
    bf16_t* orow = obase + (size_t)(b * S_ + tq) * D_ + h * 64; const bf16_t* crow = csrc + (size_t)(b * S_ + tq) * cpitch + h * 64;
#pragma unroll
    for (int i = 0; i < 4; ++i) {
        const u32x2 c0 = *(const u32x2*)(crow + 8 * i + 4 * hh), c1 = *(const u32x2*)(crow + 32 + 8 * i + 4 * hh);
        const float x00 = __uint_as_float(c0.x << 16) + o0[4 * i] * sc, x01 = __uint_as_float(c0.x & 0xffff0000u) + o0[4 * i + 1] * sc, x02 = __uint_as_float(c0.y << 16) + o0[4 * i + 2] * sc, x03 = __uint_as_float(c0.y & 0xffff0000u) + o0[4 * i + 3] * sc;
        const float x10 = __uint_as_float(c1.x << 16) + o1[4 * i] * sc, x11 = __uint_as_float(c1.x & 0xffff0000u) + o1[4 * i + 1] * sc, x12 = __uint_as_float(c1.y << 16) + o1[4 * i + 2] * sc, x13 = __uint_as_float(c1.y & 0xffff0000u) + o1[4 * i + 3] * sc;
        *(u32x2*)(orow + 8 * i + 4 * hh) = (u32x2){cvtpk(x00, x01), cvtpk(x02, x03)}; *(u32x2*)(orow + 32 + 8 * i + 4 * hh) = (u32x2){cvtpk(x10, x11), cvtpk(x12, x13)}; }
}
template <bool USE_MASK>
__device__ __forceinline__ void ph_attn_sel2(LAS unsigned char* lds3, KP p, bf16_t* __restrict__ obase, const bf16_t* __restrict__ csrc, int cpitch) {
    const int w = __builtin_amdgcn_readfirstlane(ftid() >> 6);
    LAS unsigned char* ldsw = lds3 + w * E2_WAVE;
    MK_LOOP(u, 512) { const int bg = u & 3, qblk = u >> 2; e2_wave_unit<USE_MASK>(ldsw, p, bg >> 1, bg & 1, qblk * 64 + 8 * w, obase, csrc, cpitch); }
}
}
namespace mk {
constexpr int E3_K = 0, E3_V = 512 * KROW, E3_BYTES = 2 * 512 * KROW;
__device__ __forceinline__ void e3_unit(LAS unsigned char* lds, KP p, int b, int g, int qb, bf16_t* __restrict__ ocmp, unsigned* __restrict__ selmask) {
    const int tid = ftid(), lane = tid & 63, w = __builtin_amdgcn_readfirstlane(tid >> 6), r32 = lane & 31, hh = lane >> 5;
    const int bg = b * 2 + g, q0 = qb * 256, qrow0 = q0 + 32 * w, tq = qrow0 + r32;
    const bf16_t* projb = WSP(bf16_t, O_PROJB);
    int nun = (q0 + 255 - 31) / 16 + 1; if (nun > 511) nun = 511;
    const int ntile_u = (nun + 63) >> 6;
    __syncthreads();
    { const int srow = tid >> 3, sch = tid & 7; const bf16_t* ks = WSP(bf16_t, O_KCMPB) + ((size_t)bg * 512 + srow) * 64 + sch * 8; const bf16_t* vs = WSP(bf16_t, O_VCMPB) + ((size_t)bg * 512 + srow) * 64 + sch * 8;
      for (int i = 0; i < ntile_u; ++i) { const u32x4 kv = *(const u32x4*)(ks + (size_t)i * 64 * 64), vv = *(const u32x4*)(vs + (size_t)i * 64 * 64);
          *(LAS u32x4*)(lds + E3_K + (srow + 64 * i) * KROW + sch * 16) = kv; *(LAS u32x4*)(lds + E3_V + (srow + 64 * i) * KROW + sch * 16) = vv; } }
    __syncthreads();
    int nw = qrow0 / 16 + 1; if (nw > 511) nw = 511;
    const int ntile_w = (qrow0 + 31 < 31) ? 0 : ((nw + 63) >> 6);
    const float tqf = (float)tq;
    const int gq = lane >> 4, li = lane & 15;
    const LAS unsigned char* trb = lds + E3_V + (4 * hh + (li >> 2)) * KROW + (16 * (gq & 1) + 4 * (li & 3)) * 2;
    const LAS unsigned char* kfb = lds + E3_K + r32 * KROW + hh * 16;
    float imp[64];
#pragma unroll
    for (int i = 0; i < 64; ++i) imp[i] = 0.f;
#pragma unroll 1
    for (int r4 = 0; r4 < 4; ++r4) {
        const int h = 4 * g + r4; const float sl2 = exp2f(-(float)(h + 1)) * LOG2E;
        const unsigned qoff = (unsigned)((b * S_ + tq) * PB + h * 64 + 8 * hh);
        f32x16 o0, o1;
#pragma unroll
        for (int r = 0; r < 16; ++r) { o0[r] = 0.f; o1[r] = 0.f; }
        float m = 0.f, l = 0.f; bool have = false;
        bf16x8 qf[4];
#pragma unroll
        for (int d0 = 0; d0 < 4; ++d0) qf[d0] = *(const bf16x8*)(projb + qoff + 16 * d0);
#define E3_ST(jt) f32x16 p0, p1; { \
            _Pragma("unroll") for (int r = 0; r < 16; ++r) { p0[r] = 0.f; p1[r] = 0.f; } \
            _Pragma("unroll") for (int d0 = 0; d0 < 4; ++d0) { const bf16x8 a0 = *(const LAS bf16x8*)(kfb + (64 * (jt)) * KROW + d0 * 32), a1 = *(const LAS bf16x8*)(kfb + (64 * (jt) + 32) * KROW + d0 * 32); \
                p0 = __builtin_amdgcn_mfma_f32_32x32x16_bf16(a0, qf[d0], p0, 0, 0, 0); p1 = __builtin_amdgcn_mfma_f32_32x32x16_bf16(a1, qf[d0], p1, 0, 0, 0); } \
            int tq_ = tq; asm volatile("" : "+v"(tq_));     \
            int hh_ = hh; asm volatile("" : "+v"(hh_)); \
            const float tqf_ = (float)tq_; const int ce0_ = 16 * (64 * (jt) + 4 * hh_) + 31; \
            const float basef_ = sl2 * ((float)ce0_ - tqf_) - m, base1_ = basef_ + 512.f * sl2; \
            _Pragma("unroll") for (int reg = 0; reg < 16; ++reg) { const float cr_ = sl2 * (float)(16 * CROW(reg, 0)); p0[reg] = p0[reg] * (SCALE * LOG2E) + (basef_ + cr_); p1[reg] = p1[reg] * (SCALE * LOG2E) + (base1_ + cr_); } \
            if (ce0_ + 16 * 27 + 512 > qrow0) {     \
                _Pragma("unroll") for (int reg = 0; reg < 16; ++reg) { const int ce = ce0_ + 16 * CROW(reg, 0); p0[reg] = (ce <= tq_) ? p0[reg] : -INFINITY; p1[reg] = (ce + 512 <= tq_) ? p1[reg] : -INFINITY; } } }
        float imh[64];
#pragma unroll
        for (int i = 0; i < 64; ++i) imh[i] = 0.f;
#pragma unroll
        for (int jt = 0; jt < 8; ++jt) {
            if (jt < ntile_w) {
                E3_ST(jt);
                {
                    float rm_; SM_ROWMAX(p0, p1, rm_);
                    const bool fin_ = rm_ > -1e37f;
                    if (__any((rm_ > RESC_THR) || (!have && fin_))) {
                        const float dl_ = have ? fmaxf(rm_, 0.f) : (fin_ ? rm_ : 0.f); const float al_ = have ? __builtin_amdgcn_exp2f(-dl_) : 1.f;
                        m += dl_; l *= al_; have = have || fin_;
#pragma unroll
                        for (int r_ = 0; r_ < 16; ++r_) { o0[r_] *= al_; o1[r_] *= al_; p0[r_] -= dl_; p1[r_] -= dl_; }
#pragma unroll
                        for (int i = 0; i < 64; ++i) imh[i] *= al_; }
                    float ls_ = 0.f;
#pragma unroll
                    for (int reg_ = 0; reg_ < 16; ++reg_) { p0[reg_] = __builtin_amdgcn_exp2f(p0[reg_]); p1[reg_] = __builtin_amdgcn_exp2f(p1[reg_]); ls_ += p0[reg_] + p1[reg_]; }
                    l += ls_; }
#pragma unroll
                for (int pa = 0; pa < 2; ++pa)
#pragma unroll
                    for (int i = 0; i < 4; ++i) { const int jj = 8 * jt + 4 * pa + i;
                        const float x0 = pa ? p1[4 * i] : p0[4 * i], x1 = pa ? p1[4 * i + 1] : p0[4 * i + 1], x2 = pa ? p1[4 * i + 2] : p0[4 * i + 2], x3 = pa ? p1[4 * i + 3] : p0[4 * i + 3];
                        const float c = 0.5f * x3, a = (x0 + x1) + (x2 + c), r = lane32_other(c, hh);
                        imh[jj] += a + (hh ? r : 0.f);
                        if (jj + 1 < 64) imh[jj + 1] += (hh ? 0.f : r); }
                const LAS unsigned char* tb = trb + (64 * jt) * KROW;
#pragma unroll
                for (int s = 0; s < 4; ++s) {
                    u32x4 pw;
                    if (s < 2) { pw.x = cvtpk(p0[8 * s + 0], p0[8 * s + 1]); pw.y = cvtpk(p0[8 * s + 2], p0[8 * s + 3]); pw.z = cvtpk(p0[8 * s + 4], p0[8 * s + 5]); pw.w = cvtpk(p0[8 * s + 6], p0[8 * s + 7]); }
                    else { const int s2 = s - 2; pw.x = cvtpk(p1[8 * s2 + 0], p1[8 * s2 + 1]); pw.y = cvtpk(p1[8 * s2 + 2], p1[8 * s2 + 3]); pw.z = cvtpk(p1[8 * s2 + 4], p1[8 * s2 + 5]); pw.w = cvtpk(p1[8 * s2 + 6], p1[8 * s2 + 7]); }
                    const bf16x8 pb = __builtin_bit_cast(bf16x8, pw);
                    const v4i16_t a0l = __builtin_amdgcn_ds_read_tr16_b64_v4i16((LAS v4i16_t*)(tb + (16 * s) * KROW)), a0h = __builtin_amdgcn_ds_read_tr16_b64_v4i16((LAS v4i16_t*)(tb + (16 * s + 8) * KROW));
                    const v4i16_t a1l = __builtin_amdgcn_ds_read_tr16_b64_v4i16((LAS v4i16_t*)(tb + (16 * s) * KROW + 64)), a1h = __builtin_amdgcn_ds_read_tr16_b64_v4i16((LAS v4i16_t*)(tb + (16 * s + 8) * KROW + 64));
                    const bf16x8 va0 = (bf16x8){a0l[0], a0l[1], a0l[2], a0l[3], a0h[0], a0h[1], a0h[2], a0h[3]}, va1 = (bf16x8){a1l[0], a1l[1], a1l[2], a1l[3], a1h[0], a1h[1], a1h[2], a1h[3]};
                    o0 = __builtin_amdgcn_mfma_f32_32x32x16_bf16(va0, pb, o0, 0, 0, 0); o1 = __builtin_amdgcn_mfma_f32_32x32x16_bf16(va1, pb, o1, 0, 0, 0); }
            }
        }
        l += __shfl_xor(l, 32);
        const float inv = (l > 0.f) ? 1.f / l : 0.f;
#pragma unroll
        for (int i = 0; i < 64; ++i) imp[i] += imh[i] * inv;
        { const float sc = inv * WSP(float, O_GF)[(size_t)(b * S_ + tq) * 32 + 0 * 8 + h];
          bf16_t* orow = ocmp + (size_t)(b * S_ + tq) * 512 + h * 64;
#pragma unroll
          for (int i = 0; i < 4; ++i) {
              *(u32x2*)(orow + 8 * i + 4 * hh) = (u32x2){cvtpk(o0[4 * i] * sc, o0[4 * i + 1] * sc), cvtpk(o0[4 * i + 2] * sc, o0[4 * i + 3] * sc)};
              *(u32x2*)(orow + 32 + 8 * i + 4 * hh) = (u32x2){cvtpk(o1[4 * i] * sc, o1[4 * i + 1] * sc), cvtpk(o1[4 * i + 2] * sc, o1[4 * i + 3] * sc)}; } }
#undef E3_ST
    }
    const int cur = tq >> 6;
#pragma unroll
    for (int jj = 0; jj < 64; ++jj) { const int j = 2 * jj + hh; imp[jj] = (j != 0 && j < cur - 1) ? imp[jj] : -1.f; }
    unsigned m0 = 1u, m1 = 0u, m2 = 0u, m3 = 0u;
#define E3_SETBIT(j) do { const unsigned bit_ = 1u << ((j) & 31); const int wd_ = (j) >> 5; m0 |= (wd_ == 0) ? bit_ : 0u; m1 |= (wd_ == 1) ? bit_ : 0u; m2 |= (wd_ == 2) ? bit_ : 0u; m3 |= (wd_ == 3) ? bit_ : 0u; } while (0)
    E3_SETBIT(cur); if (cur >= 1) E3_SETBIT(cur - 1);
#pragma unroll 1
    for (int it = 0; it < NSEL - 3; ++it) {
        float best = -0.5f; int bj = 0;
#pragma unroll
        for (int jj = 0; jj < 64; ++jj) { if (imp[jj] > best) { best = imp[jj]; bj = jj; } }
        const int myj = 2 * bj + hh; const float ob = __shfl_xor(best, 32); const int oj = __shfl_xor(myj, 32);
        const bool mine = (best > ob) || (best == ob && myj < oj);
        const float wv = mine ? best : ob; const int wj = mine ? myj : oj;
        if (wv >= 0.f) E3_SETBIT(wj);
        if (mine && best >= 0.f) {
#pragma unroll
            for (int jj = 0; jj < 64; ++jj) imp[jj] = (jj == bj) ? -2.f : imp[jj]; }
    }
#undef E3_SETBIT
    if (hh == 0) *(u32x4*)(selmask + ((size_t)bg * S_ + tq) * 4) = (u32x4){m0, m1, m2, m3};
}
}
namespace mk {
constexpr int SB_EARLY = 216;
template <int MODE>
__device__ __forceinline__ void ph_attn1(float* lds, LAS unsigned char* lds3, KP p, unsigned* qctr, bf16_t* obase, bf16_t* owin, const unsigned* kmax2) {
    LAS int* qslot = (LAS int*)(lds3 + E3_BYTES);
    constexpr int N_E3 = (MODE & 2) ? 128 : 0, N_CMP = (MODE & 1) ? 64 : 0, N_FOX = (MODE & 4) ? 256 : 0, N_WIN = (MODE & 8) ? 512 : 0, N_SB = (MODE & 16) ? (256 - SB_EARLY) : 0;
    for (;;) {
        __syncthreads();
        if (ftid() == 0) *qslot = (int)atomicAdd(qctr, 1u);
        __syncthreads();
        int u = __builtin_amdgcn_readfirstlane(*qslot);
        if (u >= N_E3 + N_CMP + N_FOX + N_WIN + N_SB) break;
        if (u < N_E3) { e3_unit(lds3, p, (u & 3) >> 1, u & 1, 31 - (u >> 2), WSP(bf16_t, O_OCMP), WSP(unsigned, O_SELMASK)); continue; } u -= N_E3;
        if (u < N_FOX) { e1_unit<0>(lds3, p, (u & 7) >> 2, u & 3, 31 - (u >> 3), obase, owin, kmax2); continue; } u -= N_FOX;
        if (u < N_WIN) { e1_unit<1>(lds3, p, (u & 3) >> 1, u & 1, 127 - (u >> 2), obase, owin, kmax2); continue; } u -= N_WIN;
        if (u < N_SB) { u += SB_EARLY; e1_unit<2>(lds3, p, (u & 7) >> 2, u & 3, 31 - (u >> 3), obase, owin, kmax2); }
    }
}
__device__ __forceinline__ void ph_sb_early(LAS unsigned char* lds3, KP p) {
    const int u = fbid() - 40; if (u < 0 || u >= SB_EARLY) return;
    e1_unit<2>(lds3, p, (u & 7) >> 2, u & 3, 31 - (u >> 3), WSP(bf16_t, O_O), WSP(bf16_t, O_OWIN), nullptr);
}
}
namespace mk {
#define RLX_AGENT __ATOMIC_RELAXED, __HIP_MEMORY_SCOPE_AGENT
#define XB_TMO      128
#define XB_XCNT(j)  (256  + 64 * (j))
#define XB_XSUB(j)  (1280 + 64 * (j))
#define XB_XGEN(j)  (2304 + 64 * (j))
#define XB_TOP      3328
#define XB_TOPGEN   3392
#define XCD_BAR_WORDS 3456
#define XB_SPIN_CAP (1u << 18)

__device__ __forceinline__ unsigned xb_ld(unsigned* p)              { return __hip_atomic_load(p, __ATOMIC_RELAXED, __HIP_MEMORY_SCOPE_AGENT); }
__device__ __forceinline__ unsigned xb_add(unsigned* p, unsigned v) { return __hip_atomic_fetch_add(p, v, __ATOMIC_RELAXED, __HIP_MEMORY_SCOPE_AGENT); }
__device__ __forceinline__ unsigned xb_xcc_id() { return (unsigned)__builtin_amdgcn_s_getreg((3 << 11) | 20) & 0xFu; }
#define XB_SPIN(cond, bar) do { unsigned _sp = 0; while (cond) { __builtin_amdgcn_s_sleep(1); \
    if ((++_sp & 255u) == 0u) { if (xb_ld(&(bar)[XB_TMO])) break; if (_sp > XB_SPIN_CAP) { atomicAdd(&(bar)[XB_TMO], 1u); break; } } } } while (0)

struct XcdBarrier {
    unsigned* bar; unsigned x;
    volatile LAS unsigned* st;
};

__device__ __forceinline__ XcdBarrier xcd_barrier_post(unsigned* bar, volatile LAS unsigned* st) {
    XcdBarrier b; b.bar = bar; b.x = xb_xcc_id(); b.st = st;
    if (threadIdx.x == 0) (void)xb_add(&bar[XB_XCNT(b.x)], 1u);
    return b;
}
__device__ __forceinline__ void xcd_barrier_complete(unsigned* bar, unsigned x, unsigned& nloc, unsigned& nx) {
    const unsigned G = gridDim.x * gridDim.y * gridDim.z;
    unsigned sum, cnt, mine, sp = 0u;
    for (;;) {
        sum = 0u; cnt = 0u; mine = 0u;
#pragma unroll
        for (unsigned j = 0; j < 16; ++j) { const unsigned c = xb_ld(&bar[XB_XCNT(j)]); sum += c; cnt += (c > 0u) ? 1u : 0u; mine = (j == x) ? c : mine; }
        if (sum == G) break;
        __builtin_amdgcn_s_sleep(1);
        if ((++sp & 255u) == 0u) { if (xb_ld(&bar[XB_TMO])) break; if (sp > XB_SPIN_CAP) { atomicAdd(&bar[XB_TMO], 1u); break; } }
    }
    nloc = mine > 0u ? mine : 1u; nx = cnt > 0u ? cnt : 1u;
}

__device__ __forceinline__ void xcd_barrier(const XcdBarrier& b) {
    asm volatile("s_waitcnt vmcnt(0)" ::: "memory");
    __syncthreads();
    if (threadIdx.x == 0) {
        unsigned* bar = b.bar;
        __builtin_amdgcn_s_waitcnt(0);
        unsigned nloc = b.st[0], nx = b.st[1];
        if (nloc == 0u) { xcd_barrier_complete(bar, b.x, nloc, nx); b.st[0] = nloc; b.st[1] = nx; }
        const unsigned old = xb_add(&bar[XB_XSUB(b.x)], 1u);
        const unsigned gen = old / nloc;
        if (old + 1u == (gen + 1u) * nloc) {
            __builtin_amdgcn_fence(__ATOMIC_RELEASE, "agent");
            asm volatile("s_waitcnt vmcnt(0)" ::: "memory");
            const unsigned og = xb_add(&bar[XB_TOP], 1u);
            const unsigned tg = og / nx;
            if (og + 1u == (tg + 1u) * nx) xb_add(&bar[XB_TOPGEN], 1u);
            else XB_SPIN(xb_ld(&bar[XB_TOPGEN]) == tg, bar);
            __builtin_amdgcn_fence(__ATOMIC_ACQUIRE, "agent");
            xb_add(&bar[XB_XGEN(b.x)], 1u);
            asm volatile("s_waitcnt vmcnt(0)" ::: "memory");
        } else {
            XB_SPIN(xb_ld(&bar[XB_XGEN(b.x)]) == gen, bar);
            __builtin_amdgcn_fence(__ATOMIC_ACQUIRE, "agent");
            asm volatile("s_waitcnt vmcnt(0)" ::: "memory");
        }
    }
    __syncthreads();
}

}
namespace cg = cooperative_groups;
constexpr int NSTEP = 12;
#ifndef CVH_GU
#define CVH_GU 1
#define CVH_DN 1
#endif
__global__ void __launch_bounds__(512, 2) mega(mk::P p_unused) {
    extern __shared__ __attribute__((aligned(16))) unsigned char lds_raw[];
    float* lds = (float*)lds_raw;
    LAS unsigned char* lds3 = (LAS unsigned char*)lds_raw;
    using namespace nv; using namespace mk;
    volatile LAS unsigned* bst = (volatile LAS unsigned*)(lds3 + E3_BYTES + 128);
    if (threadIdx.x < 2) bst[threadIdx.x] = 0u;
    __syncthreads();
    XcdBarrier bar;
    { const KP p = fresh_kp(); bar = xcd_barrier_post(WSP(unsigned, O_COUNTS + 16384), bst); }
    cg::this_grid().sync();
    for (int step = 0; step < 1 + NSTEP * L_; ++step) {
        const KP p = fresh_kp();
        const int l = (step - 1) / NSTEP, k = (step == 0) ? -1 : (step - 1) % NSTEP;
        const bool isg = (k == 0 || k == 1 || k == 6 || k == 9 || k == 10);
#ifdef PROBE_K
        const int nrep = (k == PROBE_K) ? PROBE_N : 1;
#else
        const int nrep = 1;
#endif
        for (int rep = 0; rep < nrep; ++rep) {
        int helpchunks = 0;
        if (isg) {
            const int kind = (k == 0) ? 0 : (k == 1) ? 4 : (k == 6) ? 1 : (k == 9) ? 2 : 3;
            GSched S; GEpi E; S.kind = kind; E.kind = kind; E.l = l;
            S.G = (int)gridDim.x; S.c = fbid(); S.meta = WSP(int, O_META); S.rowtok = WSP(int, O_ROWTOK); S.estep = 0;
            const char* A; int N, K = D_;
            if (kind == 0) { A = (const char*)WSP(bf16_t, O_XB); S.Bt = (const char*)(WSP(bf16_t, O_WTIN) + (size_t)l * NPAD * D_); N = NPAD; }
            else if (kind == 1) { A = (const char*)WSP(bf16_t, O_OB); S.Bt = (const char*)(WSP(bf16_t, O_WTOUT) + (size_t)l * D_ * D_); N = D_; }
            else if (kind == 2) { A = (const char*)WSP(bf16_t, O_X1B); S.Bt = (const char*)(WSP(bf16_t, O_WTGU) + (size_t)l * NE * 2048 * D_); S.estep = (size_t)2048 * D_ * 2; N = 2048; }
            else if (kind == 3) { A = (const char*)WSP(bf16_t, O_ACT); S.Bt = (const char*)(WSP(bf16_t, O_WTDN) + (size_t)l * NE * D_ * D_); S.estep = (size_t)D_ * D_ * 2; N = D_; }
            else { A = (const char*)WSP(bf16_t, O_PROJB); S.Bt = (const char*)(WSP(bf16_t, O_WT1) + (size_t)l * 2 * 256 * 2048); S.estep = (size_t)256 * 2048 * 2; N = 256; K = 1024; }
            S.nN = N / 256; S.nM = (kind < 2) ? T_ / 256 : (kind == 4) ? 16 : S.meta[32]; S.nunits = S.nM * S.nN; if (kind == 4) S.nunits = 32;
            if (kind == 3 && S.nunits > 1024) S.nunits = 1024 + 2 * (S.nunits - 1024);
            pg8::gemm_phase<GEpi, GSched>(lds3, A, K, S, E);
            if (l == 0 && kind >= 2 && kind <= 3 && S.G == 256) {
                const int mine = (S.nunits - S.c + 255) >> 8, most = (S.nunits + 255) >> 8;
                if (mine < most) helpchunks = (kind == 2) ? CVH_GU : CVH_DN; }
            if (kind == 4) { ph_cumsum(lds, p, 32); ph_sb_early(lds3, p); ph_bias1_reduce(p, l); }
        } else {
            switch (k) {
                case -1: ph_convert(lds3, p); break;
                case 2: ph_prep2(lds, p, l); break;
#ifdef PROBE_AMODE
                case 3: if (rep == 0) ph_attn1<30>(lds, lds3, p, WSP(unsigned, O_COUNTS) + 128 + l * 8 + rep, WSP(bf16_t, O_O), WSP(bf16_t, O_OWIN), WSP(unsigned, O_COUNTS) + 192 + l * 8);
                        else ph_attn1<PROBE_AMODE>(lds, lds3, p, WSP(unsigned, O_COUNTS) + 128 + l * 8 + rep, WSP(bf16_t, O_O), WSP(bf16_t, O_OWIN), WSP(unsigned, O_COUNTS) + 192 + l * 8);
                        break;
#else
                case 3: ph_attn1<30>(lds, lds3, p, WSP(unsigned, O_COUNTS) + 128 + l * 8 + rep, WSP(bf16_t, O_O), WSP(bf16_t, O_OWIN), WSP(unsigned, O_COUNTS) + 192 + l * 8); break;
#endif
                case 4: ph_attn_sel2<true>(lds3, p, WSP(bf16_t, O_O), WSP(bf16_t, O_OCMP), 512); break;
                case 5: ph_rmsnorm(p, l); break;
                case 7: ph_ln<true>(lds, p, l, nullptr, (rep + 1 < nrep) ? 2048 * (rep + 1) : 0); break;
                case 8: ph_moe_scatter2(lds, p, l); break;
                default: { if (l == 0) helpchunks = 1 << 20;
                           float* xout = (l == L_ - 1) ? p->out : nullptr; ph_ln<false>(lds, p, l, xout); } break;
            }
        }
        if (helpchunks > 0) cv_help(lds3, fresh_kp(), helpchunks, (isg && k == 10) ? 8 : ((isg && k == 9) ? 16 : 8));
        xcd_barrier(bar);
        }
    }
#ifdef PROBE_SYNC
    for (int i = 0; i < PROBE_SYNC; ++i) xcd_barrier(bar);
#endif
}

extern "C" void kernel_launch(void* const* d_in, const int* in_sizes, int n_in,
                              void* d_out, int out_size, void* d_ws, size_t ws_size,
                              hipStream_t stream) {
    constexpr size_t kDynLds = 147456 + 1024;
    static int grid_blocks = 0;
    if (!grid_blocks) {
        int dev = 0, cus = 0, per_cu = 0;
        (void)hipGetDevice(&dev);
        (void)hipDeviceGetAttribute(&cus, hipDeviceAttributeMultiprocessorCount, dev);
        (void)hipFuncSetAttribute((const void*)mega, hipFuncAttributeMaxDynamicSharedMemorySize, (int)kDynLds);
        (void)hipOccupancyMaxActiveBlocksPerMultiprocessor(&per_cu, mega, 512, kDynLds);
        if (per_cu < 1) per_cu = 1;
        if (per_cu > 1) per_cu = 1;
        grid_blocks = cus * per_cu;
        if (ws_size < mk::O_END) fprintf(stderr, "workspace too small: %zu < %zu\n", ws_size, (size_t)mk::O_END);
        if (grid_blocks != 256) fprintf(stderr, "this kernel's static work split is built for 256 workgroups (MI355X: 256 CUs); got %d\n", grid_blocks);
    }
    mk::P p{};
    p.in = nv::inputs(d_in); p.ws = (unsigned char*)d_ws; p.out = (float*)d_out;
    (void)hipMemsetAsync((char*)d_ws + mk::O_COUNTS, 0, 65536, stream);
    void* args[] = {&p};
    hipError_t e = hipLaunchCooperativeKernel((void*)mega, dim3(grid_blocks), dim3(512), args, kDynLds, stream);
    if (e != hipSuccess) fprintf(stderr, "cooperative launch failed: %s (grid %d)\n", hipGetErrorString(e), grid_blocks);
}
```
